# Optimizing an MI355X kernel written in HIP

```python
import jax
import jax.numpy as jnp
from jax import lax
import numpy as np

D_MODEL = 1024
BATCH = 8
SEQ = 2048
DEPTH = 2

HEAD_DIM = 64
ROPE_THETA = 500000.0
PARTIAL_ROT_DIM = HEAD_DIM // 4
NORM_EPS = 1e-6
Q_BLOCK = 128

NSA_HEADS = 6
NSA_KV_HEADS = 2
NSA_REP = NSA_HEADS // NSA_KV_HEADS
CMP_LEN = 32
CMP_STRIDE = 16
SLC_LEN = 64
SLC_TOPK = 16
WINDOW = 512
SLC_Q_BLOCK = 32

MLA_HEADS = 6
MLA_Q_LORA = 256
MLA_KV_LORA = 128
MLA_NOPE = 64
MLA_ROPE = 32
MLA_V = 64

MLSTM_HEADS = 4
MLSTM_DIM = 64
MLSTM_CONV = 4
MLSTM_CHUNK = 64

WIDTH_A = NSA_HEADS * HEAD_DIM
WIDTH_B = MLA_HEADS * MLA_V
WIDTH_C = MLSTM_HEADS * MLSTM_DIM
D_MIX = WIDTH_A + WIDTH_B + WIDTH_C
FFN_HIDDEN = -(-8 * D_MODEL // 768) * 256

KV_A = NSA_KV_HEADS * HEAD_DIM
IN_SIZES = [WIDTH_A, KV_A, KV_A, KV_A, KV_A, KV_A, KV_A, 3 * NSA_HEADS,
            MLA_Q_LORA, MLA_KV_LORA, MLA_ROPE,
            WIDTH_C, WIDTH_C, WIDTH_C, MLSTM_HEADS, MLSTM_HEADS]
IN_OFFSETS = [int(v) for v in np.cumsum(IN_SIZES)[:-1]]
D_IN = sum(IN_SIZES)

kernel_name = 'hybrid_nsa_mla_mlstm_block'


def rmsnorm(x, g):
    x32 = x.astype(jnp.float32)
    y = x32 * lax.rsqrt(jnp.mean(x32 * x32, axis=-1, keepdims=True) + NORM_EPS)
    return (y * g.astype(jnp.float32)).astype(x.dtype)


def masked_softmax(s, mask):
    s = jnp.where(mask, s.astype(jnp.float32), -1e30)
    p = jax.nn.softmax(s, axis=-1)
    return jnp.where(mask, p, 0.0)


def rope_tables(positions, rot_dim):
    inv = jnp.power(ROPE_THETA, -jnp.arange(0, rot_dim, 2, dtype=jnp.float32) / rot_dim)
    ang = positions.astype(jnp.float32)[:, None, :, None] * inv
    return jnp.cos(ang), jnp.sin(ang)


def apply_rope(x, cos, sin):
    r2 = cos.shape[-1]
    cos = cos.astype(x.dtype)
    sin = sin.astype(x.dtype)
    x1, x2, rest = x[..., :r2], x[..., r2:2 * r2], x[..., 2 * r2:]
    return jnp.concatenate([x1 * cos - x2 * sin, x1 * sin + x2 * cos, rest], axis=-1)


def to_heads(x, n):
    b, s, _ = x.shape
    return x.reshape(b, s, n, -1).transpose(0, 2, 1, 3)


def from_heads(x):
    b, h, s, d = x.shape
    return x.transpose(0, 2, 1, 3).reshape(b, s, h * d)


def nsa_attention(q, k_cmp_tok, v_cmp_tok, k_slc, v_slc, k_win, v_win, gates,
                  cmp_pos, w_cmp_k, w_cmp_v):
    B, H, S, d = q.shape
    G, R = NSA_KV_HEADS, NSA_REP
    scale = d ** -0.5
    t = jnp.arange(S)
    qg = q.reshape(B, G, R, S, d)

    n_cmp = (S - CMP_LEN) // CMP_STRIDE + 1
    tok = jnp.arange(n_cmp)[:, None] * CMP_STRIDE + jnp.arange(CMP_LEN)[None, :]

    def compress(tokens, w):
        blocks = tokens[:, :, tok] + cmp_pos
        return blocks.reshape(B, G, n_cmp, CMP_LEN * d) @ w

    kc = compress(k_cmp_tok, w_cmp_k)
    vc = compress(v_cmp_tok, w_cmp_v)
    cmp_end = jnp.arange(n_cmp) * CMP_STRIDE + CMP_LEN - 1
    s_cmp = jnp.einsum('bgrqd,bgnd->bgrqn', qg, kc) * scale
    p_cmp = masked_softmax(s_cmp, cmp_end[None, :] <= t[:, None])
    o_cmp = jnp.einsum('bgrqn,bgnd->bgrqd', p_cmp.astype(vc.dtype), vc)

    n_slc = S // SLC_LEN
    ci = jnp.arange(n_cmp)[:, None] * CMP_STRIDE
    sj = jnp.arange(n_slc)[None, :] * SLC_LEN
    overlap = ((ci < sj + SLC_LEN) & (ci + CMP_LEN > sj)).astype(jnp.float32)
    imp = jnp.einsum('bgrqn,nj->bgqj', p_cmp, overlap)
    j = jnp.arange(n_slc)[None, :]
    cur = (t // SLC_LEN)[:, None]
    forced = (j == 0) | (j == cur) | (j == cur - 1)
    future = j * SLC_LEN > t[:, None]
    imp = jnp.where(forced, jnp.inf, imp)
    imp = jnp.where(future, -jnp.inf, imp)
    n_sel = min(SLC_TOPK, n_slc)
    _, idx = lax.top_k(imp, n_sel)

    kb = k_slc.reshape(B, G, n_slc, SLC_LEN, d)
    vb = v_slc.reshape(B, G, n_slc, SLC_LEN, d)
    nqc = S // SLC_Q_BLOCK
    q_ch = qg.reshape(B, G, R, nqc, SLC_Q_BLOCK, d).transpose(3, 0, 1, 2, 4, 5)
    i_ch = idx.reshape(B, G, nqc, SLC_Q_BLOCK, n_sel).transpose(2, 0, 1, 3, 4)
    bi = jnp.arange(B)[:, None, None, None]
    gi = jnp.arange(G)[None, :, None, None]
    n_keys = n_sel * SLC_LEN

    def slc_block(args):
        qc, ic, c_idx = args
        tq = c_idx * SLC_Q_BLOCK + jnp.arange(SLC_Q_BLOCK)
        kg = kb[bi, gi, ic].reshape(B, G, SLC_Q_BLOCK, n_keys, d)
        vg = vb[bi, gi, ic].reshape(B, G, SLC_Q_BLOCK, n_keys, d)
        kpos = (ic[..., None] * SLC_LEN + jnp.arange(SLC_LEN)).reshape(B, G, SLC_Q_BLOCK, n_keys)
        mask = (kpos <= tq[None, None, :, None])[:, :, None]
        s = jnp.einsum('bgrqd,bgqkd->bgrqk', qc, kg) * scale
        p = masked_softmax(s, mask)
        return jnp.einsum('bgrqk,bgqkd->bgrqd', p.astype(vg.dtype), vg)

    o_slc = lax.map(slc_block, (q_ch, i_ch, jnp.arange(nqc)))
    o_slc = o_slc.transpose(1, 2, 3, 0, 4, 5).reshape(B, G, R, S, d)

    kpad = jnp.pad(k_win, ((0, 0), (0, 0), (WINDOW, 0), (0, 0)))
    vpad = jnp.pad(v_win, ((0, 0), (0, 0), (WINDOW, 0), (0, 0)))
    nqb = S // Q_BLOCK
    span = WINDOW + Q_BLOCK
    q_bl = qg.reshape(B, G, R, nqb, Q_BLOCK, d).transpose(3, 0, 1, 2, 4, 5)

    def win_block(args):
        qc, i = args
        start = i * Q_BLOCK
        kw = lax.dynamic_slice_in_dim(kpad, start, span, axis=2)
        vw = lax.dynamic_slice_in_dim(vpad, start, span, axis=2)
        tq = start + jnp.arange(Q_BLOCK)
        kp = start - WINDOW + jnp.arange(span)
        diff = tq[:, None] - kp[None, :]
        mask = (kp[None, :] >= 0) & (diff >= 0) & (diff < WINDOW)
        s = jnp.einsum('bgrqd,bgkd->bgrqk', qc, kw) * scale
        p = masked_softmax(s, mask)
        return jnp.einsum('bgrqk,bgkd->bgrqd', p.astype(vw.dtype), vw)

    o_win = lax.map(win_block, (q_bl, jnp.arange(nqb)))
    o_win = o_win.transpose(1, 2, 3, 0, 4, 5).reshape(B, G, R, S, d)

    g = gates.reshape(B, S, H, 3).transpose(0, 2, 1, 3).reshape(B, G, R, S, 3)
    o = g[..., 0:1] * o_cmp + g[..., 1:2] * o_slc + g[..., 2:3] * o_win
    return from_heads(o.reshape(B, H, S, d))


def causal_attention_blocks(q, k, v, scale):
    B, H, S, dq = q.shape
    nb = S // Q_BLOCK
    qb = q.reshape(B, H, nb, Q_BLOCK, dq).transpose(2, 0, 1, 3, 4)
    kpos = jnp.arange(S)

    def body(args):
        qc, i = args
        tq = i * Q_BLOCK + jnp.arange(Q_BLOCK)
        s = jnp.einsum('bhqd,bhkd->bhqk', qc, k) * scale
        p = masked_softmax(s, kpos[None, :] <= tq[:, None])
        return jnp.einsum('bhqk,bhkd->bhqd', p.astype(v.dtype), v)

    o = lax.map(body, (qb, jnp.arange(nb)))
    return o.transpose(1, 2, 0, 3, 4).reshape(B, H, S, v.shape[-1])


def mla_attention(q_lora, kv_lora, k_rope, cos, sin, g_q_lora, w_uq, g_kv_lora, w_ukv):
    q = to_heads(rmsnorm(q_lora, g_q_lora) @ w_uq, MLA_HEADS)
    q = jnp.concatenate([q[..., :MLA_NOPE], apply_rope(q[..., MLA_NOPE:], cos, sin)], axis=-1)
    kv = to_heads(rmsnorm(kv_lora, g_kv_lora) @ w_ukv, MLA_HEADS)
    k_nope, v = kv[..., :MLA_NOPE], kv[..., MLA_NOPE:]
    k_r = apply_rope(k_rope[:, None], cos, sin)
    k = jnp.concatenate([k_nope, jnp.broadcast_to(k_r, k_nope.shape[:-1] + (MLA_ROPE,))], axis=-1)
    o = causal_attention_blocks(q, k, v, (MLA_NOPE + MLA_ROPE) ** -0.5)
    return from_heads(o)


def mlstm_chunkwise(q, k, v, ig, lf):
    B, NH, S, d = q.shape
    L = MLSTM_CHUNK
    NC = S // L
    f32 = jnp.float32
    qc = q.astype(f32).reshape(B, NH, NC, L, d)
    kc = k.astype(f32).reshape(B, NH, NC, L, d)
    vc = v.astype(f32).reshape(B, NH, NC, L, d)
    ig = ig.reshape(B, NH, NC, L)
    b = jnp.cumsum(lf.reshape(B, NH, NC, L), axis=-1)
    bL = b[..., -1]
    a = bL[..., None] - b + ig
    m_loc = jnp.max(a, axis=-1)
    w_loc = jnp.exp(a - m_loc[..., None])
    C_loc = jnp.einsum('bhcl,bhcld,bhcle->bhcde', w_loc, kc, vc)
    n_loc = jnp.einsum('bhcl,bhcld->bhcd', w_loc, kc)

    def step(carry, xs):
        C, n, m = carry
        Cl, nl, ml, bl = xs
        m_new = jnp.maximum(bl + m, ml)
        e_old = jnp.exp(bl + m - m_new)
        e_loc = jnp.exp(ml - m_new)
        C_new = e_old[..., None, None] * C + e_loc[..., None, None] * Cl
        n_new = e_old[..., None] * n + e_loc[..., None] * nl
        return (C_new, n_new, m_new), (C, n, m)

    init = (jnp.zeros((B, NH, d, d), f32), jnp.zeros((B, NH, d), f32), jnp.zeros((B, NH), f32))
    xs = (jnp.moveaxis(C_loc, 2, 0), jnp.moveaxis(n_loc, 2, 0),
          jnp.moveaxis(m_loc, 2, 0), jnp.moveaxis(bL, 2, 0))
    _, (C_prev, n_prev, m_prev) = lax.scan(step, init, xs)
    C_prev = jnp.moveaxis(C_prev, 0, 2)
    n_prev = jnp.moveaxis(n_prev, 0, 2)
    m_prev = jnp.moveaxis(m_prev, 0, 2)

    causal = jnp.tril(jnp.ones((L, L), dtype=bool))
    D = jnp.where(causal, b[..., :, None] - b[..., None, :] + ig[..., None, :], -jnp.inf)
    g = b + m_prev[..., None]
    m_t = jnp.maximum(g, jnp.max(D, axis=-1))
    Sw = jnp.einsum('bhcld,bhcsd->bhcls', qc, kc) * jnp.exp(D - m_t[..., None])
    inter = jnp.exp(g - m_t)
    num = inter[..., None] * jnp.einsum('bhcld,bhcde->bhcle', qc, C_prev) + jnp.einsum('bhcls,bhcse->bhcle', Sw, vc)
    den = inter * jnp.einsum('bhcld,bhcd->bhcl', qc, n_prev) + jnp.sum(Sw, axis=-1)
    h = num / jnp.maximum(jnp.abs(den), jnp.exp(-m_t))[..., None]
    return h.reshape(B, NH, S, d).astype(q.dtype)


def mlstm_mixer(x_m, v_in, o_in, i_in, f_in, conv_w, conv_b, w_q_m, w_k_m, b_igate, b_fgate, g_mh, skip_m):
    B, S, C = x_m.shape
    xc = lax.conv_general_dilated(x_m, conv_w[:, None, :], (1,), [(MLSTM_CONV - 1, 0)],
                                  dimension_numbers=('NWC', 'WIO', 'NWC'), feature_group_count=C)
    xc = jax.nn.silu(xc + conv_b)
    xh = xc.reshape(B, S, MLSTM_HEADS, MLSTM_DIM)
    q = jnp.einsum('bshd,hde->bhse', xh, w_q_m) * (MLSTM_DIM ** -0.5)
    k = jnp.einsum('bshd,hde->bhse', xh, w_k_m)
    v = to_heads(v_in, MLSTM_HEADS)
    ig = (i_in + b_igate).astype(jnp.float32).transpose(0, 2, 1)
    lf = jax.nn.log_sigmoid((f_in + b_fgate).astype(jnp.float32)).transpose(0, 2, 1)
    h = jax.nn.sigmoid(to_heads(o_in, MLSTM_HEADS)) * mlstm_chunkwise(q, k, v, ig, lf)
    h32 = h.astype(jnp.float32)
    mu = jnp.mean(h32, axis=-1, keepdims=True)
    var = jnp.mean(jnp.square(h32 - mu), axis=-1, keepdims=True)
    hn = from_heads((h32 - mu) * lax.rsqrt(var + NORM_EPS)).astype(x_m.dtype) * g_mh
    return hn + skip_m * xc


def hybrid_mixer(h, cos_p, sin_p, cos_m, sin_m, w_in, cmp_pos, w_cmp_k, w_cmp_v, g_out_a,
                 g_q_lora, w_uq, g_kv_lora, w_ukv, g_out_b, conv_w, conv_b, w_q_m, w_k_m,
                 b_igate, b_fgate, g_mh, skip_m, w_out):
    (a_q, a_ck, a_cv, a_sk, a_sv, a_wk, a_wv, a_g, b_ql, b_kvl, b_kr,
     c_x, c_v, c_o, c_i, c_f) = jnp.split(h @ w_in, IN_OFFSETS, axis=-1)

    def rp(t, n):
        return apply_rope(to_heads(t, n), cos_p, sin_p)

    ya = nsa_attention(rp(a_q, NSA_HEADS), rp(a_ck, NSA_KV_HEADS), to_heads(a_cv, NSA_KV_HEADS),
                       rp(a_sk, NSA_KV_HEADS), to_heads(a_sv, NSA_KV_HEADS),
                       rp(a_wk, NSA_KV_HEADS), to_heads(a_wv, NSA_KV_HEADS),
                       jax.nn.sigmoid(a_g), cmp_pos, w_cmp_k, w_cmp_v)
    yb = mla_attention(b_ql, b_kvl, b_kr, cos_m, sin_m, g_q_lora, w_uq, g_kv_lora, w_ukv)
    yc = mlstm_mixer(c_x, c_v, c_o, c_i, c_f, conv_w, conv_b, w_q_m, w_k_m, b_igate, b_fgate, g_mh, skip_m)
    mix = jnp.concatenate([rmsnorm(ya, g_out_a), rmsnorm(yb, g_out_b), yc], axis=-1)
    return mix @ w_out


def swiglu(h, w_gu, w_down):
    gate, up = jnp.split(h @ w_gu, 2, axis=-1)
    return (jax.nn.silu(gate) * up) @ w_down


def setup_inputs(seed: int = 0) -> dict:
    key = jax.random.key(seed)
    ks = jax.random.split(key, 32)
    f32 = jnp.float32
    L = DEPTH

    def nrm(k, shape, scale):
        return jax.random.normal(k, shape, f32) * scale

    def gain(k, shape):
        return 1.0 + 0.02 * jax.random.normal(k, shape, f32)

    positions = (jnp.arange(SEQ, dtype=jnp.int32)[None, :]
                 + jax.random.randint(ks[2], (BATCH, 1), 0, SEQ, dtype=jnp.int32))
    return {
        'x': nrm(ks[0], (BATCH, SEQ, D_MODEL), 1.0),
        'c': nrm(ks[1], (BATCH, D_MODEL), 1.0),
        'positions': positions,
        'g_norm1': gain(ks[3], (L, D_MODEL)),
        'g_norm2': gain(ks[4], (L, D_MODEL)),
        'w_ada': nrm(ks[5], (L, D_MODEL, 6 * D_MODEL), 0.5 * D_MODEL ** -0.5),
        'b_ada': nrm(ks[6], (L, 6 * D_MODEL), 0.02),
        'w_in': nrm(ks[7], (L, D_MODEL, D_IN), D_MODEL ** -0.5),
        'cmp_pos': nrm(ks[8], (L, CMP_LEN, HEAD_DIM), 0.1),
        'w_cmp_k': nrm(ks[9], (L, CMP_LEN * HEAD_DIM, HEAD_DIM), (CMP_LEN * HEAD_DIM) ** -0.5),
        'w_cmp_v': nrm(ks[10], (L, CMP_LEN * HEAD_DIM, HEAD_DIM), (CMP_LEN * HEAD_DIM) ** -0.5),
        'g_out_a': gain(ks[11], (L, WIDTH_A)),
        'g_q_lora': gain(ks[12], (L, MLA_Q_LORA)),
        'w_uq': nrm(ks[13], (L, MLA_Q_LORA, MLA_HEADS * (MLA_NOPE + MLA_ROPE)), MLA_Q_LORA ** -0.5),
        'g_kv_lora': gain(ks[14], (L, MLA_KV_LORA)),
        'w_ukv': nrm(ks[15], (L, MLA_KV_LORA, MLA_HEADS * (MLA_NOPE + MLA_V)), MLA_KV_LORA ** -0.5),
        'g_out_b': gain(ks[16], (L, WIDTH_B)),
        'conv_w': nrm(ks[17], (L, MLSTM_CONV, WIDTH_C), MLSTM_CONV ** -0.5),
        'conv_b': nrm(ks[18], (L, WIDTH_C), 0.02),
        'w_q_m': nrm(ks[19], (L, MLSTM_HEADS, MLSTM_DIM, MLSTM_DIM), MLSTM_DIM ** -0.5),
        'w_k_m': nrm(ks[20], (L, MLSTM_HEADS, MLSTM_DIM, MLSTM_DIM), MLSTM_DIM ** -0.5),
        'b_igate': nrm(ks[21], (L, MLSTM_HEADS), 0.1),
        'b_fgate': jnp.linspace(3.0, 6.0, MLSTM_HEADS, dtype=f32)[None, :] + nrm(ks[22], (L, MLSTM_HEADS), 0.01),
        'g_mh': gain(ks[23], (L, WIDTH_C)),
        'skip_m': gain(ks[24], (L, WIDTH_C)),
        'w_out': nrm(ks[25], (L, D_MIX, D_MODEL), D_MIX ** -0.5),
        'w_gu': nrm(ks[26], (L, D_MODEL, 2 * FFN_HIDDEN), D_MODEL ** -0.5),
        'w_down': nrm(ks[27], (L, FFN_HIDDEN, D_MODEL), FFN_HIDDEN ** -0.5),
        'g_final': gain(ks[28], (D_MODEL,)),
    }


def reference(x, c, positions, g_norm1, g_norm2, w_ada, b_ada, w_in, cmp_pos, w_cmp_k, w_cmp_v,
              g_out_a, g_q_lora, w_uq, g_kv_lora, w_ukv, g_out_b, conv_w, conv_b, w_q_m, w_k_m,
              b_igate, b_fgate, g_mh, skip_m, w_out, w_gu, w_down, g_final):
    cos_p, sin_p = rope_tables(positions, PARTIAL_ROT_DIM)
    cos_m, sin_m = rope_tables(positions, MLA_ROPE)
    c_act = jax.nn.silu(c)
    for l in range(DEPTH):
        mod = (c_act @ w_ada[l] + b_ada[l])[:, None, :]
        shift1, scale1, gate1, shift2, scale2, gate2 = jnp.split(mod, 6, axis=-1)
        h = rmsnorm(x, g_norm1[l]) * (1.0 + scale1) + shift1
        x = x + gate1 * hybrid_mixer(h, cos_p, sin_p, cos_m, sin_m, w_in[l], cmp_pos[l], w_cmp_k[l],
                                     w_cmp_v[l], g_out_a[l], g_q_lora[l], w_uq[l], g_kv_lora[l],
                                     w_ukv[l], g_out_b[l], conv_w[l], conv_b[l], w_q_m[l], w_k_m[l],
                                     b_igate[l], b_fgate[l], g_mh[l], skip_m[l], w_out[l])
        h = rmsnorm(x, g_norm2[l]) * (1.0 + scale2) + shift2
        x = x + gate2 * swiglu(h, w_gu[l], w_down[l])
    return rmsnorm(x, g_final)
```

```cpp
#include <hip/hip_runtime.h>
#include <cstdint>
#include <cstdio>

constexpr int B_ = 8, S_ = 2048, T_ = B_ * S_, D_ = 1024, DIN = 2362, FF = 2816, DEPTH = 2;
constexpr float EPS = 1e-6f;
constexpr float LOG2E = 1.4426950408889634f;
constexpr float QSCALE = 0.125f * LOG2E;
constexpr float MSCALE = 0.10206207261596577f * LOG2E;
enum { I_X = 0, I_C, I_POS, I_GN1, I_GN2, I_WADA, I_BADA, I_WIN, I_CMPPOS, I_WCK, I_WCV, I_GOA, I_GQL, I_WUQ, I_GKVL, I_WUKV, I_GOB,
       I_CONVW, I_CONVB, I_WQM, I_WKM, I_BIG, I_BFG, I_GMH, I_SKIP, I_WOUT, I_WGU, I_WDOWN, I_GFIN, N_IN };

constexpr size_t MiB = 1u << 20;
constexpr size_t WS_CTL = 0;
constexpr size_t WS_MOD = 1 * MiB;
constexpr size_t WS_COSP = WS_MOD + 512 * 1024;
constexpr size_t WS_SINP = WS_COSP + 512 * 1024;
constexpr size_t WS_COSM = WS_SINP + 512 * 1024;
constexpr size_t WS_SINM = WS_COSM + 1 * MiB;
constexpr size_t WS_SSQL = WS_SINM + 1 * MiB;
constexpr size_t WS_SSKV = WS_SSQL + 64 * 1024;
constexpr size_t WS_ML = WS_SSKV + 64 * 1024;
constexpr size_t WS_BL = WS_ML + 4096;
constexpr size_t WS_MP = WS_BL + 4096;
constexpr size_t WS_NL = WS_MP + 4096;
constexpr size_t WS_WT = 8 * MiB;
constexpr size_t WS_RAW = WS_WT;
constexpr size_t WS_OSLC = WS_WT + 10 * MiB;
constexpr size_t WS_HB = 34 * MiB;
constexpr size_t WS_NSA = 66 * MiB;
constexpr size_t WS_KVL = 102 * MiB;
constexpr size_t WS_QL = 106 * MiB;
constexpr size_t WS_CM = 114 * MiB;
constexpr size_t WS_GM = 138 * MiB;
constexpr size_t WS_KM = 140 * MiB;
constexpr size_t WS_QM = 158 * MiB;
constexpr size_t WS_VM = 176 * MiB;
constexpr size_t WS_KCV = 188 * MiB;
constexpr size_t WS_OCMP = 189 * MiB;
constexpr size_t WS_SEL = 201 * MiB;
constexpr size_t WS_XC = 202 * MiB;
constexpr size_t WS_MQ = 210 * MiB;
constexpr size_t WS_MK = 218 * MiB;
constexpr size_t WS_CT = 226 * MiB;
constexpr size_t WS_ACT = 66 * MiB;
constexpr size_t WS_END = 256 * MiB;
static_assert(WS_NL + 1024 * 64 * 4 <= WS_WT, "tab");
static_assert(WS_ACT + (size_t)T_ * FF * 2 <= WS_KCV, "act overlay");

typedef unsigned short bf16;
__device__ __forceinline__ float bf2f(bf16 v) { return __uint_as_float(((unsigned)v) << 16); }
__device__ __forceinline__ bf16 f2bf(float f) { unsigned u = __float_as_uint(f); return (bf16)((u + 0x7fffu + ((u >> 16) & 1u)) >> 16); }
__device__ __forceinline__ float sigmoidf_(float x) { return 1.f / (1.f + __expf(-x)); }
__device__ __forceinline__ float siluf_(float x) { return x / (1.f + __expf(-x)); }
__device__ __forceinline__ float wave_sum(float v) {
#pragma unroll
    for (int o = 1; o < 64; o <<= 1) v += __shfl_xor(v, o);
    return v;
}

__global__ void __launch_bounds__(512) k_ada(const float* c, const float* w_ada, const float* b_ada, float* mod) {
    __shared__ float ca[8 * 1024];
    __shared__ float red[8 * 8 * 64];
    const int tid = threadIdx.x, wave = tid >> 6, lane = tid & 63;
    for (int i = tid; i < 8192; i += 512) ca[i] = siluf_(c[i]);
    __syncthreads();
    for (int item = blockIdx.x; item < 192; item += gridDim.x) {
        const int l = item / 96, j = (item % 96) * 64 + lane;
        const float* w = w_ada + (size_t)l * 1024 * 6144 + j;
        float acc[8];
#pragma unroll
        for (int b = 0; b < 8; ++b) acc[b] = 0.f;
        for (int k = wave * 128; k < wave * 128 + 128; ++k) {
            const float wv = w[(size_t)k * 6144];
#pragma unroll
            for (int b = 0; b < 8; ++b) acc[b] += ca[b * 1024 + k] * wv;
        }
#pragma unroll
        for (int b = 0; b < 8; ++b) red[(wave * 8 + b) * 64 + lane] = acc[b];
        __syncthreads();
        {
            const int b = tid >> 6; float s = 0.f;
#pragma unroll
            for (int w8 = 0; w8 < 8; ++w8) s += red[(w8 * 8 + b) * 64 + lane];
            mod[((size_t)l * 8 + b) * 6144 + j] = s + b_ada[l * 6144 + j];
        }
        __syncthreads();
    }
}
__global__ void k_rope(const int* pos, float* cosP, float* sinP, float* cosM, float* sinM) {
    const int i = blockIdx.x * blockDim.x + threadIdx.x;
    if (i >= T_ * 24) return;
    const int m = i / 24, f = i % 24;
    double inv; if (f < 8) inv = pow(500000.0, -(double)(2 * f) / 16.0); else inv = pow(500000.0, -(double)(2 * (f - 8)) / 32.0);
    const float ang = (float)pos[m] * (float)inv;
    const double a = (double)ang, kq = rint(a * 0.15915494309189535), r = a - kq * 6.283185307179586476925;
    const float cs = (float)cos(r), sn = (float)sin(r);
    if (f < 8) { cosP[m * 8 + f] = cs; sinP[m * 8 + f] = sn; } else { cosM[m * 16 + f - 8] = cs; sinM[m * 16 + f - 8] = sn; }
}
__global__ void __launch_bounds__(512) k_norm(const float* x, const float* g, const float* shift, const float* scale, bf16* hb, float* outf, int mode) {
    const int gw = blockIdx.x * 8 + (threadIdx.x >> 6), ngw = gridDim.x * 8, lane = threadIdx.x & 63;
    for (int m = gw; m < T_; m += ngw) {
        const float4* xr = (const float4*)(x + (size_t)m * D_) + lane;
        float4 v[4]; float s = 0.f;
#pragma unroll
        for (int j = 0; j < 4; ++j) { v[j] = xr[64 * j]; s += v[j].x * v[j].x + v[j].y * v[j].y + v[j].z * v[j].z + v[j].w * v[j].w; }
        const float rstd = rsqrtf(wave_sum(s) * (1.f / D_) + EPS);
        const int b = m / S_;
#pragma unroll
        for (int j = 0; j < 4; ++j) {
            const int col = 4 * lane + 256 * j;
            const float4 gg = *(const float4*)(g + col);
            float4 o; o.x = v[j].x * rstd * gg.x; o.y = v[j].y * rstd * gg.y; o.z = v[j].z * rstd * gg.z; o.w = v[j].w * rstd * gg.w;
            if (mode == 2) { *(float4*)(outf + (size_t)m * D_ + col) = o; }
            else {
                const float4 sc = *(const float4*)(scale + (size_t)b * 6144 + col), sh = *(const float4*)(shift + (size_t)b * 6144 + col);
                o.x = o.x * (1.f + sc.x) + sh.x; o.y = o.y * (1.f + sc.y) + sh.y; o.z = o.z * (1.f + sc.z) + sh.z; o.w = o.w * (1.f + sc.w) + sh.w;
                uint2 w; w.x = (unsigned)f2bf(o.x) | ((unsigned)f2bf(o.y) << 16); w.y = (unsigned)f2bf(o.z) | ((unsigned)f2bf(o.w) << 16);
                *(uint2*)(hb + (size_t)m * D_ + col) = w;
            }
        }
    }
}
__global__ void __launch_bounds__(512) k_mixnorm(bf16* mix, const float* ga, const float* gb) {
    const int gw = blockIdx.x * 8 + (threadIdx.x >> 6), ngw = gridDim.x * 8, lane = threadIdx.x & 63;
    for (int m = gw; m < T_; m += ngw) {
        bf16* r = mix + (size_t)m * D_;
        float va[6], vb[6]; float sa = 0.f, sb = 0.f;
#pragma unroll
        for (int j = 0; j < 6; ++j) { va[j] = bf2f(r[lane + 64 * j]); vb[j] = bf2f(r[384 + lane + 64 * j]); sa += va[j] * va[j]; sb += vb[j] * vb[j]; }
        const float ra = rsqrtf(wave_sum(sa) * (1.f / 384.f) + EPS), rb = rsqrtf(wave_sum(sb) * (1.f / 384.f) + EPS);
#pragma unroll
        for (int j = 0; j < 6; ++j) { r[lane + 64 * j] = f2bf(va[j] * ra * ga[lane + 64 * j]); r[384 + lane + 64 * j] = f2bf(vb[j] * rb * gb[lane + 64 * j]); }
    }
}
__global__ void __launch_bounds__(512) k_mscan(float* CT, float* NL, const float* ML, const float* BL, float* MP) {
    for (int item = blockIdx.x; item < 32 * 9; item += gridDim.x) {
        const int bh = item / 9, part = item % 9, tid = threadIdx.x;
        if (part == 8 && tid >= 64) continue;
        float* base; size_t stride;
        if (part < 8) { base = CT + (size_t)bh * 32 * 4096 + part * 512 + tid; stride = 4096; } else { base = NL + (size_t)bh * 32 * 64 + tid; stride = 64; }
        float Cv = 0.f, m = 0.f;
        for (int c = 0; c < 32; ++c) {
            const float cl = base[(size_t)c * stride], ml = ML[bh * 32 + c], bl = BL[bh * 32 + c];
            base[(size_t)c * stride] = Cv;
            if (part == 8 && tid == 0) MP[bh * 32 + c] = m;
            const float mn = fmaxf(bl + m, ml);
            Cv = __expf(bl + m - mn) * Cv + __expf(ml - mn) * cl; m = mn;
        }
    }
}

enum { EPI_RAW = 0, EPI_RES = 1, EPI_GU = 2 };
struct GemmArgs { const bf16* A; int lda; const float* W; int ldw; int K; int N; int row0; int rows; const float* kscale;
                  float* raw; const float* xin; float* xout; const float* gate; bf16* act; };
template <int EPI> __global__ void __launch_bounds__(256) k_gemm_naive(GemmArgs a) {
    __shared__ float As[16][65], Bs[16][65], Bs2[16][65];
    const int tid = threadIdx.x, tx = tid & 15, ty = tid >> 4;
    const int n0 = blockIdx.x * 64, m0 = a.row0 + blockIdx.y * 64;
    float acc[4][4], acc2[4][4];
#pragma unroll
    for (int i = 0; i < 4; ++i)
#pragma unroll
        for (int j = 0; j < 4; ++j) { acc[i][j] = 0.f; acc2[i][j] = 0.f; }
    for (int k0 = 0; k0 < a.K; k0 += 16) {
        for (int i = tid; i < 1024; i += 256) { const int r = i >> 4, kk = i & 15; As[kk][r] = bf2f(a.A[(size_t)(m0 + r) * a.lda + k0 + kk]); }
        for (int i = tid; i < 1024; i += 256) { const int kk = i >> 6, c = i & 63; const int n = n0 + c;
            float w = (n < a.N) ? a.W[(size_t)(k0 + kk) * a.ldw + n] : 0.f; if (a.kscale) w *= a.kscale[k0 + kk]; Bs[kk][c] = w;
            if (EPI == EPI_GU) Bs2[kk][c] = (n < a.N) ? a.W[(size_t)(k0 + kk) * a.ldw + a.N + n] : 0.f; }
        __syncthreads();
#pragma unroll
        for (int kk = 0; kk < 16; ++kk) {
            float av[4], bv[4], bv2[4];
#pragma unroll
            for (int i = 0; i < 4; ++i) { av[i] = As[kk][ty * 4 + i]; bv[i] = Bs[kk][tx * 4 + i]; if (EPI == EPI_GU) bv2[i] = Bs2[kk][tx * 4 + i]; }
#pragma unroll
            for (int i = 0; i < 4; ++i)
#pragma unroll
                for (int j = 0; j < 4; ++j) { acc[i][j] += av[i] * bv[j]; if (EPI == EPI_GU) acc2[i][j] += av[i] * bv2[j]; }
        }
        __syncthreads();
    }
#pragma unroll
    for (int i = 0; i < 4; ++i)
#pragma unroll
        for (int j = 0; j < 4; ++j) {
            const int row = m0 + ty * 4 + i, col = n0 + tx * 4 + j;
            if (col >= a.N) continue;
            if (EPI == EPI_RAW) a.raw[(size_t)(row - a.row0) * a.N + col] = acc[i][j];
            else if (EPI == EPI_RES) { const int b = row / S_; a.xout[(size_t)row * D_ + col] = a.xin[(size_t)row * D_ + col] + a.gate[(size_t)b * 6144 + col] * acc[i][j]; }
            else { a.act[(size_t)row * FF + col] = f2bf(siluf_(acc[i][j]) * acc2[i][j]); }
        }
}
struct PostIn { const float* raw; int row0; int rows; const float *cosP, *sinP, *cosM, *sinM, *big, *bfg; bf16 *nsa, *kvl, *ql, *cm, *km; float* gm; };
__global__ void k_post_in(PostIn p) {
    const long idx = (long)blockIdx.x * blockDim.x + threadIdx.x;
    if (idx >= (long)p.rows * DIN) return;
    const int lr = (int)(idx / DIN), c = (int)(idx % DIN), row = p.row0 + lr;
    const float* r = p.raw + (size_t)lr * DIN;
    const float v = r[c];
    if (c < 1152) {
        float val = v;
        const int seg = (c < 384) ? -1 : (c - 384) / 128;
        const bool rope = (c < 384) || seg == 0 || seg == 2 || seg == 4;
        const int d = c & 63;
        if (rope && d < 16) { const int i = d & 7, hb = c - d; const float x1 = r[hb + i], x2 = r[hb + 8 + i], cs = p.cosP[row * 8 + i], sn = p.sinP[row * 8 + i];
            val = (d < 8) ? x1 * cs - x2 * sn : x1 * sn + x2 * cs; }
        if (c < 384) val *= QSCALE;
        p.nsa[(size_t)row * 1152 + c] = f2bf(val);
    } else if (c < 1170) p.gm[(size_t)row * 32 + (c - 1152)] = sigmoidf_(v);
    else if (c < 1426) p.ql[(size_t)row * 256 + (c - 1170)] = f2bf(v);
    else if (c < 1554) p.kvl[(size_t)row * 128 + (c - 1426)] = f2bf(v);
    else if (c < 1586) { const int d = c - 1554, i = d & 15; const float x1 = r[1554 + i], x2 = r[1570 + i], cs = p.cosM[row * 16 + i], sn = p.sinM[row * 16 + i];
        const bf16 o = f2bf((d < 16) ? x1 * cs - x2 * sn : x1 * sn + x2 * cs);
        for (int h = 0; h < 6; ++h) p.km[(size_t)row * 576 + h * 96 + 64 + d] = o; }
    else if (c < 2354) p.cm[(size_t)row * 768 + (c - 1586)] = f2bf(v);
    else if (c < 2358) p.gm[(size_t)row * 32 + 18 + (c - 2354)] = v + p.big[c - 2354];
    else { const float z = v + p.bfg[c - 2358]; p.gm[(size_t)row * 32 + 22 + (c - 2358)] = fminf(z, 0.f) - log1pf(__expf(-fabsf(z))); }
}
__global__ void __launch_bounds__(512) k_ssq(const bf16* ql, const bf16* kvl, float* sq, float* skv) {
    const int gw = blockIdx.x * 8 + (threadIdx.x >> 6), ngw = gridDim.x * 8, lane = threadIdx.x & 63;
    for (int m = gw; m < T_; m += ngw) {
        float a = 0.f, b = 0.f;
        for (int j = 0; j < 4; ++j) { const float v = bf2f(ql[(size_t)m * 256 + lane + 64 * j]); a += v * v; }
        for (int j = 0; j < 2; ++j) { const float v = bf2f(kvl[(size_t)m * 128 + lane + 64 * j]); b += v * v; }
        a = wave_sum(a); b = wave_sum(b);
        if (lane == 0) { sq[m] = a; skv[m] = b; }
    }
}
__global__ void k_post_uq(const float* raw, int row0, int rows, const float* ssq, const float* cosM, const float* sinM, bf16* qm) {
    const long idx = (long)blockIdx.x * blockDim.x + threadIdx.x;
    if (idx >= (long)rows * 576) return;
    const int lr = (int)(idx / 576), c = (int)(idx % 576), row = row0 + lr;
    const float* r = raw + (size_t)lr * 576;
    const float rstd = rsqrtf(ssq[row] * (1.f / 256.f) + EPS);
    const int h = c / 96, d = c % 96;
    float val = r[c] * rstd;
    if (d >= 64) { const int dd = d - 64, i = dd & 15; const float x1 = r[h * 96 + 64 + i] * rstd, x2 = r[h * 96 + 80 + i] * rstd, cs = cosM[row * 16 + i], sn = sinM[row * 16 + i];
        val = (dd < 16) ? x1 * cs - x2 * sn : x1 * sn + x2 * cs; }
    qm[(size_t)row * 576 + c] = f2bf(val * MSCALE);
}
__global__ void k_post_ukv(const float* raw, int row0, int rows, const float* ssq, bf16* km, bf16* vm) {
    const long idx = (long)blockIdx.x * blockDim.x + threadIdx.x;
    if (idx >= (long)rows * 768) return;
    const int lr = (int)(idx / 768), c = (int)(idx % 768), row = row0 + lr;
    const float rstd = rsqrtf(ssq[row] * (1.f / 128.f) + EPS);
    const float val = raw[(size_t)lr * 768 + c] * rstd;
    const int h = c / 128, w = c % 128;
    if (w < 64) km[(size_t)row * 576 + h * 96 + w] = f2bf(val); else vm[(size_t)row * 384 + h * 64 + (w - 64)] = f2bf(val);
}
__global__ void k_compress(const bf16* nsa, const float* cmp_pos, const float* wk, const float* wv, bf16* kcv) {
    const int idx = blockIdx.x * blockDim.x + threadIdx.x;
    if (idx >= 2 * 8 * 2 * 128 * 64) return;
    const int e = idx & 63, n = (idx >> 6) & 127, g = (idx >> 13) & 1, b = (idx >> 14) & 7, kv = idx >> 17;
    float acc = 0.f;
    if (n < 127) {
        const float* w = kv ? wv : wk; const int col = (kv ? 512 : 384) + g * 64;
        for (int l = 0; l < 32; ++l) { const bf16* tr = nsa + (size_t)(b * S_ + 16 * n + l) * 1152 + col;
            for (int d = 0; d < 64; ++d) acc += (bf2f(tr[d]) + cmp_pos[l * 64 + d]) * w[(size_t)(l * 64 + d) * 64 + e]; }
    }
    kcv[(size_t)kv * (8 * 2 * 128 * 64) + ((size_t)(b * 2 + g) * 128 + n) * 64 + e] = f2bf(acc);
}
__global__ void __launch_bounds__(64) k_cmp_sel(const bf16* nsa, const bf16* kcv, bf16* ocmp, unsigned* sel) {
    __shared__ float P[64][129], SC[64][129];
    const int tid = threadIdx.x, tile = blockIdx.x & 31, g = (blockIdx.x >> 5) & 1, b = blockIdx.x >> 6;
    const int t = tile * 64 + tid, row = b * S_ + t;
    const bf16* kc = kcv + (size_t)(b * 2 + g) * 128 * 64; const bf16* vc = kc + (size_t)8 * 2 * 128 * 64;
    int nvis = (t >= 31) ? ((t - 31) / 16 + 1) : 0; if (nvis > 127) nvis = 127;
    for (int n = 0; n < 128; ++n) P[tid][n] = 0.f;
    for (int r = 0; r < 3; ++r) {
        const int h = 3 * g + r;
        float q[64];
#pragma unroll
        for (int d = 0; d < 64; ++d) q[d] = bf2f(nsa[(size_t)row * 1152 + h * 64 + d]);
        float m = -1e30f;
        for (int n = 0; n < nvis; ++n) { float s = 0.f;
#pragma unroll
            for (int d = 0; d < 64; ++d) s += q[d] * bf2f(kc[n * 64 + d]);
            SC[tid][n] = s; m = fmaxf(m, s); }
        float l = 0.f;
        for (int n = 0; n < nvis; ++n) { const float p = exp2f(SC[tid][n] - m); SC[tid][n] = p; l += p; }
        const float il = (nvis > 0) ? 1.f / l : 0.f;
        float o[64];
#pragma unroll
        for (int d = 0; d < 64; ++d) o[d] = 0.f;
        for (int n = 0; n < nvis; ++n) { const float p = SC[tid][n] * il; P[tid][n] += p;
#pragma unroll
            for (int d = 0; d < 64; ++d) o[d] += p * bf2f(vc[n * 64 + d]); }
#pragma unroll
        for (int d = 0; d < 64; ++d) ocmp[(size_t)row * 384 + h * 64 + d] = f2bf(o[d]);
    }
    const int cur = t >> 6;
    for (int j = 0; j < 32; ++j) {
        float v = 0.f;
        for (int n = 4 * j - 1; n <= 4 * j + 3; ++n) if (n >= 0 && n < 127) v += P[tid][n];
        if (j == 0 || j == cur || j == cur - 1) v = INFINITY;
        if (j * 64 > t) v = -INFINITY;
        SC[tid][j] = v;
    }
    unsigned mask = 0;
    for (int j = 0; j < 32; ++j) { const float v = SC[tid][j]; int rank = 0;
        for (int k = 0; k < 32; ++k) { const float u = SC[tid][k]; rank += (u > v || (u == v && k < j)) ? 1 : 0; }
        if (rank < 16) mask |= 1u << j; }
    sel[(size_t)(b * 2 + g) * S_ + t] = mask;
}
template <int DQK, int MODE> __global__ void __launch_bounds__(64) k_attn_naive(const bf16* Q, int ldq, const bf16* K, int ldk, const bf16* V, int ldv,
        const unsigned* sel, const bf16* ocmp, const bf16* oslc_in, const float* gm, bf16* out) {
    const int t = blockIdx.x * 64 + threadIdx.x, h = blockIdx.y, b = blockIdx.z, row = b * S_ + t;
    const int g = (MODE == 2) ? h : h / 3;
    float q[DQK];
#pragma unroll
    for (int d = 0; d < DQK; ++d) q[d] = bf2f(Q[(size_t)row * ldq + h * DQK + d]);
    float o[64];
#pragma unroll
    for (int d = 0; d < 64; ++d) o[d] = 0.f;
    float m = -1e30f, l = 0.f;
    unsigned sm = 0xffffffffu; if (MODE == 0) sm = sel[(size_t)(b * 2 + g) * S_ + t];
    int j0 = 0; if (MODE == 1) j0 = (t - 511 > 0) ? t - 511 : 0;
    for (int j = j0; j <= t; ++j) {
        if (MODE == 0 && !((sm >> (j >> 6)) & 1u)) { j |= 63; continue; }
        const bf16* kr = K + (size_t)(b * S_ + j) * ldk + g * DQK;
        float s = 0.f;
#pragma unroll
        for (int d = 0; d < DQK; ++d) s += q[d] * bf2f(kr[d]);
        if (s > m) { const float f = exp2f(m - s); l *= f;
#pragma unroll
            for (int d = 0; d < 64; ++d) o[d] *= f;
            m = s; }
        const float p = exp2f(s - m); l += p;
        const bf16* vr = V + (size_t)(b * S_ + j) * ldv + g * 64;
#pragma unroll
        for (int d = 0; d < 64; ++d) o[d] += p * bf2f(vr[d]);
    }
    const float il = 1.f / l;
    if (MODE == 0) {
#pragma unroll
        for (int d = 0; d < 64; ++d) out[(size_t)row * 384 + h * 64 + d] = f2bf(o[d] * il);
    } else if (MODE == 1) {
        const float g0 = gm[(size_t)row * 32 + h * 3], g1 = gm[(size_t)row * 32 + h * 3 + 1], g2 = gm[(size_t)row * 32 + h * 3 + 2];
#pragma unroll
        for (int d = 0; d < 64; ++d) out[(size_t)row * D_ + h * 64 + d] =
            f2bf(g0 * bf2f(ocmp[(size_t)row * 384 + h * 64 + d]) + g1 * bf2f(oslc_in[(size_t)row * 384 + h * 64 + d]) + g2 * o[d] * il);
    } else {
#pragma unroll
        for (int d = 0; d < 64; ++d) out[(size_t)row * D_ + 384 + h * 64 + d] = f2bf(o[d] * il);
    }
}
__global__ void k_mconv(const bf16* cm, const float* cw, const float* cb, bf16* xc) {
    const int idx = blockIdx.x * blockDim.x + threadIdx.x;
    if (idx >= T_ * 256) return;
    const int row = idx >> 8, ch = idx & 255, s = row % S_;
    float a = cb[ch];
    for (int j = 0; j < 4; ++j) { const int ss = s - 3 + j; if (ss >= 0) a += cw[j * 256 + ch] * bf2f(cm[(size_t)(row - 3 + j) * 768 + ch]); }
    xc[idx] = f2bf(siluf_(a));
}
__global__ void k_mqk(const bf16* xc, const float* wq, const float* wk, bf16* mq, bf16* mk) {
    const int idx = blockIdx.x * blockDim.x + threadIdx.x;
    if (idx >= T_ * 256) return;
    const int row = idx >> 8, h = (idx >> 6) & 3, e = idx & 63;
    float aq = 0.f, ak = 0.f;
    for (int d = 0; d < 64; ++d) { const float x = bf2f(xc[(size_t)row * 256 + h * 64 + d]); aq += x * wq[(h * 64 + d) * 64 + e]; ak += x * wk[(h * 64 + d) * 64 + e]; }
    mq[idx] = f2bf(aq * 0.125f); mk[idx] = f2bf(ak);
}
__global__ void __launch_bounds__(64) k_mlocal(const bf16* mk, const bf16* cm, const float* gm, float* CT, float* NL, float* ML, float* BL) {
    __shared__ float w[64], bs[64];
    const int chunk = blockIdx.x, c = chunk & 31, h = (chunk >> 5) & 3, b = chunk >> 7, d = threadIdx.x;
    const int row0 = b * S_ + c * 64;
    if (d == 0) { float acc = 0.f; for (int l = 0; l < 64; ++l) { acc += gm[(size_t)(row0 + l) * 32 + 22 + h]; bs[l] = acc; } }
    __syncthreads();
    const float bL = bs[63];
    float a = bL - bs[d] + gm[(size_t)(row0 + d) * 32 + 18 + h];
    float mx = a;
#pragma unroll
    for (int o = 1; o < 64; o <<= 1) mx = fmaxf(mx, __shfl_xor(mx, o));
    w[d] = __expf(a - mx);
    __syncthreads();
    float C[64]; float n = 0.f;
#pragma unroll
    for (int e = 0; e < 64; ++e) C[e] = 0.f;
    for (int l = 0; l < 64; ++l) {
        const float kk = bf2f(mk[(size_t)(row0 + l) * 256 + h * 64 + d]) * w[l]; n += kk;
        const bf16* vr = cm + (size_t)(row0 + l) * 768 + 256 + h * 64;
#pragma unroll
        for (int e = 0; e < 64; ++e) C[e] += kk * bf2f(vr[e]);
    }
#pragma unroll
    for (int e = 0; e < 64; ++e) CT[(size_t)chunk * 4096 + e * 64 + d] = C[e];
    NL[chunk * 64 + d] = n;
    if (d == 0) { ML[chunk] = mx; BL[chunk] = bL; }
}
__global__ void __launch_bounds__(64) k_mout(const bf16* mq, const bf16* mk, const bf16* cm, const bf16* xc, const float* gm, const float* CT, const float* NL, const float* MP,
                                             const float* gmh, const float* skip, bf16* mix) {
    __shared__ float bs[64], us[64], Ks[64][65], Vs[64][65], Cs[64][65], Qs[64][65], ns[64];
    const int chunk = blockIdx.x, c = chunk & 31, h = (chunk >> 5) & 3, b = chunk >> 7, l = threadIdx.x;
    const int row0 = b * S_ + c * 64, row = row0 + l;
    if (l == 0) { float acc = 0.f; for (int i = 0; i < 64; ++i) { acc += gm[(size_t)(row0 + i) * 32 + 22 + h]; bs[i] = acc; } }
    for (int d = 0; d < 64; ++d) { Ks[l][d] = bf2f(mk[(size_t)row * 256 + h * 64 + d]); Vs[l][d] = bf2f(cm[(size_t)row * 768 + 256 + h * 64 + d]); Cs[l][d] = CT[(size_t)chunk * 4096 + l * 64 + d]; }
    ns[l] = NL[chunk * 64 + l];
    __syncthreads();
    us[l] = gm[(size_t)row * 32 + 18 + h] - bs[l];
    __syncthreads();
    const float mprev = MP[chunk];
    float cu = -INFINITY; for (int s = 0; s <= l; ++s) cu = fmaxf(cu, us[s]);
    const float mt = bs[l] + fmaxf(mprev, cu), inter = __expf(bs[l] + mprev - mt);
    for (int d = 0; d < 64; ++d) Qs[l][d] = bf2f(mq[(size_t)row * 256 + h * 64 + d]);
    float num[64]; float qn = 0.f;
#pragma unroll
    for (int e = 0; e < 64; ++e) num[e] = 0.f;
    for (int d = 0; d < 64; ++d) { const float qd = Qs[l][d]; qn += qd * ns[d];
#pragma unroll
        for (int e = 0; e < 64; ++e) num[e] += qd * Cs[e][d]; }
#pragma unroll
    for (int e = 0; e < 64; ++e) num[e] *= inter;
    float den = inter * qn;
    for (int s = 0; s < 64; ++s) {
        if (s <= l) { float sd = 0.f;
            for (int d = 0; d < 64; ++d) sd += Qs[l][d] * Ks[s][d];
            const float sw = sd * __expf(bs[l] + us[s] - mt); den += sw;
#pragma unroll
            for (int e = 0; e < 64; ++e) num[e] += sw * Vs[s][e]; }
    }
    const float dn = 1.f / fmaxf(fabsf(den), __expf(-mt));
    float mu = 0.f;
#pragma unroll
    for (int e = 0; e < 64; ++e) { num[e] = num[e] * dn * sigmoidf_(bf2f(cm[(size_t)row * 768 + 512 + h * 64 + e])); mu += num[e]; }
    mu *= (1.f / 64.f); float var = 0.f;
#pragma unroll
    for (int e = 0; e < 64; ++e) { const float dlt = num[e] - mu; var += dlt * dlt; }
    const float rs = rsqrtf(var * (1.f / 64.f) + EPS);
#pragma unroll
    for (int e = 0; e < 64; ++e) mix[(size_t)row * D_ + 768 + h * 64 + e] = f2bf((num[e] - mu) * rs * gmh[h * 64 + e] + skip[h * 64 + e] * bf2f(xc[(size_t)row * 256 + h * 64 + e]));
}

extern "C" void kernel_launch(void* const* d_in, const int* in_sizes, int n_in, void* d_out, int out_size, void* d_ws, size_t ws_size, hipStream_t stream) {
    if (n_in != N_IN || ws_size < WS_END) { fprintf(stderr, "kernel_launch: unexpected n_in %d / ws %zu\n", n_in, ws_size); return; }
    const float* in[N_IN]; for (int i = 0; i < N_IN; ++i) in[i] = (const float*)d_in[i];
    unsigned char* ws = (unsigned char*)d_ws; float* X = (float*)d_out;
    float* mod = (float*)(ws + WS_MOD); float *cosP = (float*)(ws + WS_COSP), *sinP = (float*)(ws + WS_SINP), *cosM = (float*)(ws + WS_COSM), *sinM = (float*)(ws + WS_SINM);
    float *ssql = (float*)(ws + WS_SSQL), *sskv = (float*)(ws + WS_SSKV), *ML = (float*)(ws + WS_ML), *BL = (float*)(ws + WS_BL), *MP = (float*)(ws + WS_MP), *NL = (float*)(ws + WS_NL);
    float* raw = (float*)(ws + WS_RAW); bf16* oslc = (bf16*)(ws + WS_OSLC); bf16* HB = (bf16*)(ws + WS_HB);
    bf16 *nsa = (bf16*)(ws + WS_NSA), *kvl = (bf16*)(ws + WS_KVL), *ql = (bf16*)(ws + WS_QL), *cm = (bf16*)(ws + WS_CM), *km = (bf16*)(ws + WS_KM), *qm = (bf16*)(ws + WS_QM), *vm = (bf16*)(ws + WS_VM);
    float* gm = (float*)(ws + WS_GM); bf16* kcv = (bf16*)(ws + WS_KCV); bf16* ocmp = (bf16*)(ws + WS_OCMP); unsigned* sel = (unsigned*)(ws + WS_SEL);
    bf16 *xc = (bf16*)(ws + WS_XC), *mq = (bf16*)(ws + WS_MQ), *mk = (bf16*)(ws + WS_MK); float* CT = (float*)(ws + WS_CT); bf16* act = (bf16*)(ws + WS_ACT);

    k_ada<<<192, 512, 0, stream>>>(in[I_C], in[I_WADA], in[I_BADA], mod);
    k_rope<<<(T_ * 24 + 255) / 256, 256, 0, stream>>>((const int*)d_in[I_POS], cosP, sinP, cosM, sinM);
    for (int l = 0; l < DEPTH; ++l) {
        const float* xin = (l == 0) ? in[I_X] : X;
        const float* modl = mod + (size_t)l * 8 * 6144;
        k_norm<<<256, 512, 0, stream>>>(xin, in[I_GN1] + l * D_, modl + 0, modl + 1024, HB, nullptr, 0);
        for (int ch = 0; ch < 16; ++ch) {
            GemmArgs a{}; a.A = HB; a.lda = D_; a.W = in[I_WIN] + (size_t)l * D_ * DIN; a.ldw = DIN; a.K = D_; a.N = DIN; a.row0 = ch * 1024; a.rows = 1024; a.raw = raw;
            k_gemm_naive<EPI_RAW><<<dim3((DIN + 63) / 64, 16), 256, 0, stream>>>(a);
            PostIn p{}; p.raw = raw; p.row0 = ch * 1024; p.rows = 1024; p.cosP = cosP; p.sinP = sinP; p.cosM = cosM; p.sinM = sinM; p.big = in[I_BIG] + l * 4; p.bfg = in[I_BFG] + l * 4;
            p.nsa = nsa; p.kvl = kvl; p.ql = ql; p.cm = cm; p.km = km; p.gm = gm;
            k_post_in<<<(1024 * DIN + 255) / 256, 256, 0, stream>>>(p);
        }
        k_ssq<<<256, 512, 0, stream>>>(ql, kvl, ssql, sskv);
        for (int ch = 0; ch < 16; ++ch) {
            GemmArgs a{}; a.A = ql; a.lda = 256; a.W = in[I_WUQ] + (size_t)l * 256 * 576; a.ldw = 576; a.K = 256; a.N = 576; a.row0 = ch * 1024; a.rows = 1024; a.raw = raw; a.kscale = in[I_GQL] + l * 256;
            k_gemm_naive<EPI_RAW><<<dim3(9, 16), 256, 0, stream>>>(a);
            k_post_uq<<<(1024 * 576 + 255) / 256, 256, 0, stream>>>(raw, ch * 1024, 1024, ssql, cosM, sinM, qm);
            GemmArgs a2{}; a2.A = kvl; a2.lda = 128; a2.W = in[I_WUKV] + (size_t)l * 128 * 768; a2.ldw = 768; a2.K = 128; a2.N = 768; a2.row0 = ch * 1024; a2.rows = 1024; a2.raw = raw; a2.kscale = in[I_GKVL] + l * 128;
            k_gemm_naive<EPI_RAW><<<dim3(12, 16), 256, 0, stream>>>(a2);
            k_post_ukv<<<(1024 * 768 + 255) / 256, 256, 0, stream>>>(raw, ch * 1024, 1024, sskv, km, vm);
        }
        k_compress<<<(2 * 8 * 2 * 128 * 64) / 256, 256, 0, stream>>>(nsa, in[I_CMPPOS] + l * 2048, in[I_WCK] + (size_t)l * 2048 * 64, in[I_WCV] + (size_t)l * 2048 * 64, kcv);
        k_cmp_sel<<<8 * 2 * 32, 64, 0, stream>>>(nsa, kcv, ocmp, sel);
        k_attn_naive<64, 0><<<dim3(32, 6, 8), 64, 0, stream>>>(nsa, 1152, nsa + 640, 1152, nsa + 768, 1152, sel, nullptr, nullptr, nullptr, oslc);
        k_attn_naive<64, 1><<<dim3(32, 6, 8), 64, 0, stream>>>(nsa, 1152, nsa + 896, 1152, nsa + 1024, 1152, nullptr, ocmp, oslc, gm, HB);
        k_attn_naive<96, 2><<<dim3(32, 6, 8), 64, 0, stream>>>(qm, 576, km, 576, vm, 384, nullptr, nullptr, nullptr, nullptr, HB);
        k_mconv<<<T_, 256, 0, stream>>>(cm, in[I_CONVW] + l * 1024, in[I_CONVB] + l * 256, xc);
        k_mqk<<<T_, 256, 0, stream>>>(xc, in[I_WQM] + l * 16384, in[I_WKM] + l * 16384, mq, mk);
        k_mlocal<<<1024, 64, 0, stream>>>(mk, cm, gm, CT, NL, ML, BL);
        k_mscan<<<256, 512, 0, stream>>>(CT, NL, ML, BL, MP);
        k_mout<<<1024, 64, 0, stream>>>(mq, mk, cm, xc, gm, CT, NL, MP, in[I_GMH] + l * 256, in[I_SKIP] + l * 256, HB);
        k_mixnorm<<<256, 512, 0, stream>>>(HB, in[I_GOA] + l * 384, in[I_GOB] + l * 384);
        { GemmArgs a{}; a.A = HB; a.lda = D_; a.W = in[I_WOUT] + (size_t)l * D_ * D_; a.ldw = D_; a.K = D_; a.N = D_; a.row0 = 0; a.rows = T_; a.xin = xin; a.xout = X; a.gate = modl + 2048;
          k_gemm_naive<EPI_RES><<<dim3(16, 256), 256, 0, stream>>>(a); }
        k_norm<<<256, 512, 0, stream>>>(X, in[I_GN2] + l * D_, modl + 3072, modl + 4096, HB, nullptr, 1);
        { GemmArgs a{}; a.A = HB; a.lda = D_; a.W = in[I_WGU] + (size_t)l * D_ * 2 * FF; a.ldw = 2 * FF; a.K = D_; a.N = FF; a.row0 = 0; a.rows = T_; a.act = act;
          k_gemm_naive<EPI_GU><<<dim3(44, 256), 256, 0, stream>>>(a); }
        { GemmArgs a{}; a.A = act; a.lda = FF; a.W = in[I_WDOWN] + (size_t)l * FF * D_; a.ldw = D_; a.K = FF; a.N = D_; a.row0 = 0; a.rows = T_; a.xin = X; a.xout = X; a.gate = modl + 5120;
          k_gemm_naive<EPI_RES><<<dim3(16, 256), 256, 0, stream>>>(a); }
    }
    k_norm<<<256, 512, 0, stream>>>(X, in[I_GFIN], nullptr, nullptr, nullptr, X, 2);
}
```

```cpp
#include <hip/hip_runtime.h>
#include <cstdint>
#include <cstdio>
#include <hip/hip_cooperative_groups.h>

constexpr int B_ = 8, S_ = 2048, T_ = B_ * S_, D_ = 1024, DIN = 2362, FF = 2816, DEPTH = 2;
constexpr float EPS = 1e-6f;
constexpr float LOG2E = 1.4426950408889634f;
constexpr float QSCALE = 0.125f * LOG2E;
constexpr float MSCALE = 0.10206207261596577f * LOG2E;
enum { I_X = 0, I_C, I_POS, I_GN1, I_GN2, I_WADA, I_BADA, I_WIN, I_CMPPOS, I_WCK, I_WCV, I_GOA, I_GQL, I_WUQ, I_GKVL, I_WUKV, I_GOB,
       I_CONVW, I_CONVB, I_WQM, I_WKM, I_BIG, I_BFG, I_GMH, I_SKIP, I_WOUT, I_WGU, I_WDOWN, I_GFIN, N_IN };

constexpr size_t MiB = 1u << 20;
constexpr size_t WS_CTL = 0;
constexpr size_t WS_MOD = 1 * MiB;
constexpr size_t WS_COSP = WS_MOD + 512 * 1024;
constexpr size_t WS_SINP = WS_COSP + 512 * 1024;
constexpr size_t WS_COSM = WS_SINP + 512 * 1024;
constexpr size_t WS_SINM = WS_COSM + 1 * MiB;
constexpr size_t WS_SSQL = WS_SINM + 1 * MiB;
constexpr size_t WS_SSKV = WS_SSQL + 64 * 1024;
constexpr size_t WS_ML = WS_SSKV + 64 * 1024;
constexpr size_t WS_BL = WS_ML + 4096;
constexpr size_t WS_MP = WS_BL + 4096;
constexpr size_t WS_NL = WS_MP + 4096;
constexpr size_t WS_WT = 8 * MiB;
constexpr size_t WS_RAW = WS_WT;
constexpr size_t WS_OSLC = WS_WT + 10 * MiB;
constexpr size_t WS_HB = 34 * MiB;
constexpr size_t WS_NSA = 66 * MiB;
constexpr size_t WS_KVL = 102 * MiB;
constexpr size_t WS_QL = 106 * MiB;
constexpr size_t WS_CM = 114 * MiB;
constexpr size_t WS_GM = 138 * MiB;
constexpr size_t WS_KM = 140 * MiB;
constexpr size_t WS_QM = 158 * MiB;
constexpr size_t WS_VM = 176 * MiB;
constexpr size_t WS_KCV = 188 * MiB;
constexpr size_t WS_OCMP = 189 * MiB;
constexpr size_t WS_SEL = 201 * MiB;
constexpr size_t WS_XC = 202 * MiB;
constexpr size_t WS_MQ = 210 * MiB;
constexpr size_t WS_MK = 218 * MiB;
constexpr size_t WS_CT = 226 * MiB;
constexpr size_t WS_MISCRAW = 242 * MiB;
constexpr size_t WS_KVM = 140 * MiB;
constexpr size_t WS_KR = 164 * MiB;
constexpr size_t WS_ACT = 66 * MiB;
constexpr size_t WS_END = 256 * MiB;
static_assert(WS_NL + 1024 * 64 * 4 <= WS_WT, "tab");
static_assert(WS_ACT + (size_t)T_ * FF * 2 <= WS_KCV, "act overlay");

typedef unsigned short bf16;
__device__ __forceinline__ float bf2f(bf16 v) { return __uint_as_float(((unsigned)v) << 16); }
__device__ __forceinline__ bf16 f2bf(float f) { unsigned u = __float_as_uint(f); return (bf16)((u + 0x7fffu + ((u >> 16) & 1u)) >> 16); }
__device__ __forceinline__ float sigmoidf_(float x) { return 1.f / (1.f + __expf(-x)); }
__device__ __forceinline__ float siluf_(float x) { return x / (1.f + __expf(-x)); }
__device__ __forceinline__ float wave_sum(float v) {
#pragma unroll
    for (int o = 1; o < 64; o <<= 1) v += __shfl_xor(v, o);
    return v;
}

__global__ void __launch_bounds__(512) k_ada(const float* c, const float* w_ada, const float* b_ada, float* mod) {
    __shared__ float ca[8 * 1024];
    __shared__ float red[8 * 8 * 64];
    const int tid = threadIdx.x, wave = tid >> 6, lane = tid & 63;
    for (int i = tid; i < 8192; i += 512) ca[i] = siluf_(c[i]);
    __syncthreads();
    for (int item = blockIdx.x; item < 192; item += gridDim.x) {
        const int l = item / 96, j = (item % 96) * 64 + lane;
        const float* w = w_ada + (size_t)l * 1024 * 6144 + j;
        float acc[8];
#pragma unroll
        for (int b = 0; b < 8; ++b) acc[b] = 0.f;
        for (int k = wave * 128; k < wave * 128 + 128; ++k) {
            const float wv = w[(size_t)k * 6144];
#pragma unroll
            for (int b = 0; b < 8; ++b) acc[b] += ca[b * 1024 + k] * wv;
        }
#pragma unroll
        for (int b = 0; b < 8; ++b) red[(wave * 8 + b) * 64 + lane] = acc[b];
        __syncthreads();
        {
            const int b = tid >> 6; float s = 0.f;
#pragma unroll
            for (int w8 = 0; w8 < 8; ++w8) s += red[(w8 * 8 + b) * 64 + lane];
            mod[((size_t)l * 8 + b) * 6144 + j] = s + b_ada[l * 6144 + j];
        }
        __syncthreads();
    }
}
__global__ void k_rope(const int* pos, float* cosP, float* sinP, float* cosM, float* sinM) {
    const int i = blockIdx.x * blockDim.x + threadIdx.x;
    if (i >= T_ * 24) return;
    const int m = i / 24, f = i % 24;
    double inv; if (f < 8) inv = pow(500000.0, -(double)(2 * f) / 16.0); else inv = pow(500000.0, -(double)(2 * (f - 8)) / 32.0);
    const float ang = (float)pos[m] * (float)inv;
    const double a = (double)ang, kq = rint(a * 0.15915494309189535), r = a - kq * 6.283185307179586476925;
    const float cs = (float)cos(r), sn = (float)sin(r);
    if (f < 8) { cosP[m * 8 + f] = cs; sinP[m * 8 + f] = sn; } else { cosM[m * 16 + f - 8] = cs; sinM[m * 16 + f - 8] = sn; }
}
__global__ void __launch_bounds__(512) k_norm(const float* x, const float* g, const float* shift, const float* scale, bf16* hb, float* outf, int mode) {
    const int gw = blockIdx.x * 8 + (threadIdx.x >> 6), ngw = gridDim.x * 8, lane = threadIdx.x & 63;
    for (int m = gw; m < T_; m += ngw) {
        const float4* xr = (const float4*)(x + (size_t)m * D_) + lane;
        float4 v[4]; float s = 0.f;
#pragma unroll
        for (int j = 0; j < 4; ++j) { v[j] = xr[64 * j]; s += v[j].x * v[j].x + v[j].y * v[j].y + v[j].z * v[j].z + v[j].w * v[j].w; }
        const float rstd = rsqrtf(wave_sum(s) * (1.f / D_) + EPS);
        const int b = m / S_;
#pragma unroll
        for (int j = 0; j < 4; ++j) {
            const int col = 4 * lane + 256 * j;
            const float4 gg = *(const float4*)(g + col);
            float4 o; o.x = v[j].x * rstd * gg.x; o.y = v[j].y * rstd * gg.y; o.z = v[j].z * rstd * gg.z; o.w = v[j].w * rstd * gg.w;
            if (mode == 2) { *(float4*)(outf + (size_t)m * D_ + col) = o; }
            else {
                const float4 sc = *(const float4*)(scale + (size_t)b * 6144 + col), sh = *(const float4*)(shift + (size_t)b * 6144 + col);
                o.x = o.x * (1.f + sc.x) + sh.x; o.y = o.y * (1.f + sc.y) + sh.y; o.z = o.z * (1.f + sc.z) + sh.z; o.w = o.w * (1.f + sc.w) + sh.w;
                uint2 w; w.x = (unsigned)f2bf(o.x) | ((unsigned)f2bf(o.y) << 16); w.y = (unsigned)f2bf(o.z) | ((unsigned)f2bf(o.w) << 16);
                *(uint2*)(hb + (size_t)m * D_ + col) = w;
            }
        }
    }
}
__global__ void __launch_bounds__(512) k_mixnorm(bf16* mix, const float* ga, const float* gb) {
    const int gw = blockIdx.x * 8 + (threadIdx.x >> 6), ngw = gridDim.x * 8, lane = threadIdx.x & 63;
    for (int m = gw; m < T_; m += ngw) {
        bf16* r = mix + (size_t)m * D_;
        float va[6], vb[6]; float sa = 0.f, sb = 0.f;
#pragma unroll
        for (int j = 0; j < 6; ++j) { va[j] = bf2f(r[lane + 64 * j]); vb[j] = bf2f(r[384 + lane + 64 * j]); sa += va[j] * va[j]; sb += vb[j] * vb[j]; }
        const float ra = rsqrtf(wave_sum(sa) * (1.f / 384.f) + EPS), rb = rsqrtf(wave_sum(sb) * (1.f / 384.f) + EPS);
#pragma unroll
        for (int j = 0; j < 6; ++j) { r[lane + 64 * j] = f2bf(va[j] * ra * ga[lane + 64 * j]); r[384 + lane + 64 * j] = f2bf(vb[j] * rb * gb[lane + 64 * j]); }
    }
}
__global__ void __launch_bounds__(512) k_mscan(float* CT, float* NL, const float* ML, const float* BL, float* MP) {
    for (int item = blockIdx.x; item < 32 * 9; item += gridDim.x) {
        const int bh = item / 9, part = item % 9, tid = threadIdx.x;
        if (part == 8 && tid >= 64) continue;
        float* base; size_t stride;
        if (part < 8) { base = CT + (size_t)bh * 32 * 4096 + part * 512 + tid; stride = 4096; } else { base = NL + (size_t)bh * 32 * 64 + tid; stride = 64; }
        float Cv = 0.f, m = 0.f;
        for (int c = 0; c < 32; ++c) {
            const float cl = base[(size_t)c * stride], ml = ML[bh * 32 + c], bl = BL[bh * 32 + c];
            base[(size_t)c * stride] = Cv;
            if (part == 8 && tid == 0) MP[bh * 32 + c] = m;
            const float mn = fmaxf(bl + m, ml);
            Cv = __expf(bl + m - mn) * Cv + __expf(ml - mn) * cl; m = mn;
        }
    }
}

enum { EPI_RAW = 0, EPI_RES = 1, EPI_GU = 2 };
struct GemmArgs { const bf16* A; int lda; const float* W; int ldw; int K; int N; int row0; int rows; const float* kscale;
                  float* raw; const float* xin; float* xout; const float* gate; bf16* act; };
template <int EPI> __global__ void __launch_bounds__(256) k_gemm_naive(GemmArgs a) {
    __shared__ float As[16][65], Bs[16][65], Bs2[16][65];
    const int tid = threadIdx.x, tx = tid & 15, ty = tid >> 4;
    const int n0 = blockIdx.x * 64, m0 = a.row0 + blockIdx.y * 64;
    float acc[4][4], acc2[4][4];
#pragma unroll
    for (int i = 0; i < 4; ++i)
#pragma unroll
        for (int j = 0; j < 4; ++j) { acc[i][j] = 0.f; acc2[i][j] = 0.f; }
    for (int k0 = 0; k0 < a.K; k0 += 16) {
        for (int i = tid; i < 1024; i += 256) { const int r = i >> 4, kk = i & 15; As[kk][r] = bf2f(a.A[(size_t)(m0 + r) * a.lda + k0 + kk]); }
        for (int i = tid; i < 1024; i += 256) { const int kk = i >> 6, c = i & 63; const int n = n0 + c;
            float w = (n < a.N) ? a.W[(size_t)(k0 + kk) * a.ldw + n] : 0.f; if (a.kscale) w *= a.kscale[k0 + kk]; Bs[kk][c] = w;
            if (EPI == EPI_GU) Bs2[kk][c] = (n < a.N) ? a.W[(size_t)(k0 + kk) * a.ldw + a.N + n] : 0.f; }
        __syncthreads();
#pragma unroll
        for (int kk = 0; kk < 16; ++kk) {
            float av[4], bv[4], bv2[4];
#pragma unroll
            for (int i = 0; i < 4; ++i) { av[i] = As[kk][ty * 4 + i]; bv[i] = Bs[kk][tx * 4 + i]; if (EPI == EPI_GU) bv2[i] = Bs2[kk][tx * 4 + i]; }
#pragma unroll
            for (int i = 0; i < 4; ++i)
#pragma unroll
                for (int j = 0; j < 4; ++j) { acc[i][j] += av[i] * bv[j]; if (EPI == EPI_GU) acc2[i][j] += av[i] * bv2[j]; }
        }
        __syncthreads();
    }
#pragma unroll
    for (int i = 0; i < 4; ++i)
#pragma unroll
        for (int j = 0; j < 4; ++j) {
            const int row = m0 + ty * 4 + i, col = n0 + tx * 4 + j;
            if (col >= a.N) continue;
            if (EPI == EPI_RAW) a.raw[(size_t)(row - a.row0) * a.N + col] = acc[i][j];
            else if (EPI == EPI_RES) { const int b = row / S_; a.xout[(size_t)row * D_ + col] = a.xin[(size_t)row * D_ + col] + a.gate[(size_t)b * 6144 + col] * acc[i][j]; }
            else { a.act[(size_t)row * FF + col] = f2bf(siluf_(acc[i][j]) * acc2[i][j]); }
        }
}
struct PostIn { const float* raw; int row0; int rows; const float *cosP, *sinP, *cosM, *sinM, *big, *bfg; bf16 *nsa, *kvl, *ql, *cm, *km; float* gm; };
__global__ void k_post_in(PostIn p) {
    const long idx = (long)blockIdx.x * blockDim.x + threadIdx.x;
    if (idx >= (long)p.rows * DIN) return;
    const int lr = (int)(idx / DIN), c = (int)(idx % DIN), row = p.row0 + lr;
    const float* r = p.raw + (size_t)lr * DIN;
    const float v = r[c];
    if (c < 1152) {
        float val = v;
        const int seg = (c < 384) ? -1 : (c - 384) / 128;
        const bool rope = (c < 384) || seg == 0 || seg == 2 || seg == 4;
        const int d = c & 63;
        if (rope && d < 16) { const int i = d & 7, hb = c - d; const float x1 = r[hb + i], x2 = r[hb + 8 + i], cs = p.cosP[row * 8 + i], sn = p.sinP[row * 8 + i];
            val = (d < 8) ? x1 * cs - x2 * sn : x1 * sn + x2 * cs; }
        if (c < 384) val *= QSCALE;
        p.nsa[(size_t)row * 1152 + c] = f2bf(val);
    } else if (c < 1170) p.gm[(size_t)row * 32 + (c - 1152)] = sigmoidf_(v);
    else if (c < 1426) p.ql[(size_t)row * 256 + (c - 1170)] = f2bf(v);
    else if (c < 1554) p.kvl[(size_t)row * 128 + (c - 1426)] = f2bf(v);
    else if (c < 1586) { const int d = c - 1554, i = d & 15; const float x1 = r[1554 + i], x2 = r[1570 + i], cs = p.cosM[row * 16 + i], sn = p.sinM[row * 16 + i];
        const bf16 o = f2bf((d < 16) ? x1 * cs - x2 * sn : x1 * sn + x2 * cs);
        for (int h = 0; h < 6; ++h) p.km[(size_t)row * 576 + h * 96 + 64 + d] = o; }
    else if (c < 2354) p.cm[(size_t)row * 768 + (c - 1586)] = f2bf(v);
    else if (c < 2358) p.gm[(size_t)row * 32 + 18 + (c - 2354)] = v + p.big[c - 2354];
    else { const float z = v + p.bfg[c - 2358]; p.gm[(size_t)row * 32 + 22 + (c - 2358)] = fminf(z, 0.f) - log1pf(__expf(-fabsf(z))); }
}
__global__ void __launch_bounds__(512) k_ssq(const bf16* ql, const bf16* kvl, float* sq, float* skv) {
    const int gw = blockIdx.x * 8 + (threadIdx.x >> 6), ngw = gridDim.x * 8, lane = threadIdx.x & 63;
    for (int m = gw; m < T_; m += ngw) {
        float a = 0.f, b = 0.f;
        for (int j = 0; j < 4; ++j) { const float v = bf2f(ql[(size_t)m * 256 + lane + 64 * j]); a += v * v; }
        for (int j = 0; j < 2; ++j) { const float v = bf2f(kvl[(size_t)m * 128 + lane + 64 * j]); b += v * v; }
        a = wave_sum(a); b = wave_sum(b);
        if (lane == 0) { sq[m] = a; skv[m] = b; }
    }
}
__global__ void k_post_uq(const float* raw, int row0, int rows, const float* ssq, const float* cosM, const float* sinM, bf16* qm) {
    const long idx = (long)blockIdx.x * blockDim.x + threadIdx.x;
    if (idx >= (long)rows * 576) return;
    const int lr = (int)(idx / 576), c = (int)(idx % 576), row = row0 + lr;
    const float* r = raw + (size_t)lr * 576;
    const float rstd = rsqrtf(ssq[row] * (1.f / 256.f) + EPS);
    const int h = c / 96, d = c % 96;
    float val = r[c] * rstd;
    if (d >= 64) { const int dd = d - 64, i = dd & 15; const float x1 = r[h * 96 + 64 + i] * rstd, x2 = r[h * 96 + 80 + i] * rstd, cs = cosM[row * 16 + i], sn = sinM[row * 16 + i];
        val = (dd < 16) ? x1 * cs - x2 * sn : x1 * sn + x2 * cs; }
    qm[(size_t)row * 576 + c] = f2bf(val * MSCALE);
}
__global__ void k_post_ukv(const float* raw, int row0, int rows, const float* ssq, bf16* km, bf16* vm) {
    const long idx = (long)blockIdx.x * blockDim.x + threadIdx.x;
    if (idx >= (long)rows * 768) return;
    const int lr = (int)(idx / 768), c = (int)(idx % 768), row = row0 + lr;
    const float rstd = rsqrtf(ssq[row] * (1.f / 128.f) + EPS);
    const float val = raw[(size_t)lr * 768 + c] * rstd;
    const int h = c / 128, w = c % 128;
    if (w < 64) km[(size_t)row * 576 + h * 96 + w] = f2bf(val); else vm[(size_t)row * 384 + h * 64 + (w - 64)] = f2bf(val);
}
__global__ void k_compress(const bf16* nsa, const float* cmp_pos, const float* wk, const float* wv, bf16* kcv) {
    const int idx = blockIdx.x * blockDim.x + threadIdx.x;
    if (idx >= 2 * 8 * 2 * 128 * 64) return;
    const int e = idx & 63, n = (idx >> 6) & 127, g = (idx >> 13) & 1, b = (idx >> 14) & 7, kv = idx >> 17;
    float acc = 0.f;
    if (n < 127) {
        const float* w = kv ? wv : wk; const int col = (kv ? 512 : 384) + g * 64;
        for (int l = 0; l < 32; ++l) { const bf16* tr = nsa + (size_t)(b * S_ + 16 * n + l) * 1152 + col;
            for (int d = 0; d < 64; ++d) acc += (bf2f(tr[d]) + cmp_pos[l * 64 + d]) * w[(size_t)(l * 64 + d) * 64 + e]; }
    }
    kcv[(size_t)kv * (8 * 2 * 128 * 64) + ((size_t)(b * 2 + g) * 128 + n) * 64 + e] = f2bf(acc);
}
__global__ void __launch_bounds__(64) k_cmp_sel(const bf16* nsa, const bf16* kcv, bf16* ocmp, unsigned* sel) {
    __shared__ float P[64][129], SC[64][129];
    const int tid = threadIdx.x, tile = blockIdx.x & 31, g = (blockIdx.x >> 5) & 1, b = blockIdx.x >> 6;
    const int t = tile * 64 + tid, row = b * S_ + t;
    const bf16* kc = kcv + (size_t)(b * 2 + g) * 128 * 64; const bf16* vc = kc + (size_t)8 * 2 * 128 * 64;
    int nvis = (t >= 31) ? ((t - 31) / 16 + 1) : 0; if (nvis > 127) nvis = 127;
    for (int n = 0; n < 128; ++n) P[tid][n] = 0.f;
    for (int r = 0; r < 3; ++r) {
        const int h = 3 * g + r;
        float q[64];
#pragma unroll
        for (int d = 0; d < 64; ++d) q[d] = bf2f(nsa[(size_t)row * 1152 + h * 64 + d]);
        float m = -1e30f;
        for (int n = 0; n < nvis; ++n) { float s = 0.f;
#pragma unroll
            for (int d = 0; d < 64; ++d) s += q[d] * bf2f(kc[n * 64 + d]);
            SC[tid][n] = s; m = fmaxf(m, s); }
        float l = 0.f;
        for (int n = 0; n < nvis; ++n) { const float p = exp2f(SC[tid][n] - m); SC[tid][n] = p; l += p; }
        const float il = (nvis > 0) ? 1.f / l : 0.f;
        float o[64];
#pragma unroll
        for (int d = 0; d < 64; ++d) o[d] = 0.f;
        for (int n = 0; n < nvis; ++n) { const float p = SC[tid][n] * il; P[tid][n] += p;
#pragma unroll
            for (int d = 0; d < 64; ++d) o[d] += p * bf2f(vc[n * 64 + d]); }
#pragma unroll
        for (int d = 0; d < 64; ++d) ocmp[(size_t)row * 384 + h * 64 + d] = f2bf(o[d]);
    }
    const int cur = t >> 6;
    for (int j = 0; j < 32; ++j) {
        float v = 0.f;
        for (int n = 4 * j - 1; n <= 4 * j + 3; ++n) if (n >= 0 && n < 127) v += P[tid][n];
        if (j == 0 || j == cur || j == cur - 1) v = INFINITY;
        if (j * 64 > t) v = -INFINITY;
        SC[tid][j] = v;
    }
    unsigned mask = 0;
    for (int j = 0; j < 32; ++j) { const float v = SC[tid][j]; int rank = 0;
        for (int k = 0; k < 32; ++k) { const float u = SC[tid][k]; rank += (u > v || (u == v && k < j)) ? 1 : 0; }
        if (rank < 16) mask |= 1u << j; }
    sel[(size_t)(b * 2 + g) * S_ + t] = mask;
}
template <int DQK, int MODE> __global__ void __launch_bounds__(64) k_attn_naive(const bf16* Q, int ldq, const bf16* K, int ldk, const bf16* V, int ldv,
        const unsigned* sel, const bf16* ocmp, const bf16* oslc_in, const float* gm, bf16* out) {
    const int t = blockIdx.x * 64 + threadIdx.x, h = blockIdx.y, b = blockIdx.z, row = b * S_ + t;
    const int g = (MODE == 2) ? h : h / 3;
    float q[DQK];
#pragma unroll
    for (int d = 0; d < DQK; ++d) q[d] = bf2f(Q[(size_t)row * ldq + h * DQK + d]);
    float o[64];
#pragma unroll
    for (int d = 0; d < 64; ++d) o[d] = 0.f;
    float m = -1e30f, l = 0.f;
    unsigned sm = 0xffffffffu; if (MODE == 0) sm = sel[(size_t)(b * 2 + g) * S_ + t];
    int j0 = 0; if (MODE == 1) j0 = (t - 511 > 0) ? t - 511 : 0;
    for (int j = j0; j <= t; ++j) {
        if (MODE == 0 && !((sm >> (j >> 6)) & 1u)) { j |= 63; continue; }
        const bf16* kr = K + (size_t)(b * S_ + j) * ldk + g * DQK;
        float s = 0.f;
#pragma unroll
        for (int d = 0; d < DQK; ++d) s += q[d] * bf2f(kr[d]);
        if (s > m) { const float f = exp2f(m - s); l *= f;
#pragma unroll
            for (int d = 0; d < 64; ++d) o[d] *= f;
            m = s; }
        const float p = exp2f(s - m); l += p;
        const bf16* vr = V + (size_t)(b * S_ + j) * ldv + g * 64;
#pragma unroll
        for (int d = 0; d < 64; ++d) o[d] += p * bf2f(vr[d]);
    }
    const float il = 1.f / l;
    if (MODE == 0) {
#pragma unroll
        for (int d = 0; d < 64; ++d) out[(size_t)row * 384 + h * 64 + d] = f2bf(o[d] * il);
    } else if (MODE == 1) {
        const float g0 = gm[(size_t)row * 32 + h * 3], g1 = gm[(size_t)row * 32 + h * 3 + 1], g2 = gm[(size_t)row * 32 + h * 3 + 2];
#pragma unroll
        for (int d = 0; d < 64; ++d) out[(size_t)row * D_ + h * 64 + d] =
            f2bf(g0 * bf2f(ocmp[(size_t)row * 384 + h * 64 + d]) + g1 * bf2f(oslc_in[(size_t)row * 384 + h * 64 + d]) + g2 * o[d] * il);
    } else {
#pragma unroll
        for (int d = 0; d < 64; ++d) out[(size_t)row * D_ + 384 + h * 64 + d] = f2bf(o[d] * il);
    }
}
__global__ void k_mconv(const bf16* cm, const float* cw, const float* cb, bf16* xc) {
    const int idx = blockIdx.x * blockDim.x + threadIdx.x;
    if (idx >= T_ * 256) return;
    const int row = idx >> 8, ch = idx & 255, s = row % S_;
    float a = cb[ch];
    for (int j = 0; j < 4; ++j) { const int ss = s - 3 + j; if (ss >= 0) a += cw[j * 256 + ch] * bf2f(cm[(size_t)(row - 3 + j) * 768 + ch]); }
    xc[idx] = f2bf(siluf_(a));
}
__global__ void k_mqk(const bf16* xc, const float* wq, const float* wk, bf16* mq, bf16* mk) {
    const int idx = blockIdx.x * blockDim.x + threadIdx.x;
    if (idx >= T_ * 256) return;
    const int row = idx >> 8, h = (idx >> 6) & 3, e = idx & 63;
    float aq = 0.f, ak = 0.f;
    for (int d = 0; d < 64; ++d) { const float x = bf2f(xc[(size_t)row * 256 + h * 64 + d]); aq += x * wq[(h * 64 + d) * 64 + e]; ak += x * wk[(h * 64 + d) * 64 + e]; }
    mq[idx] = f2bf(aq * 0.125f); mk[idx] = f2bf(ak);
}
__global__ void __launch_bounds__(64) k_mlocal(const bf16* mk, const bf16* cm, const float* gm, float* CT, float* NL, float* ML, float* BL) {
    __shared__ float w[64], bs[64];
    const int chunk = blockIdx.x, c = chunk & 31, h = (chunk >> 5) & 3, b = chunk >> 7, d = threadIdx.x;
    const int row0 = b * S_ + c * 64;
    if (d == 0) { float acc = 0.f; for (int l = 0; l < 64; ++l) { acc += gm[(size_t)(row0 + l) * 32 + 22 + h]; bs[l] = acc; } }
    __syncthreads();
    const float bL = bs[63];
    float a = bL - bs[d] + gm[(size_t)(row0 + d) * 32 + 18 + h];
    float mx = a;
#pragma unroll
    for (int o = 1; o < 64; o <<= 1) mx = fmaxf(mx, __shfl_xor(mx, o));
    w[d] = __expf(a - mx);
    __syncthreads();
    float C[64]; float n = 0.f;
#pragma unroll
    for (int e = 0; e < 64; ++e) C[e] = 0.f;
    for (int l = 0; l < 64; ++l) {
        const float kk = bf2f(mk[(size_t)(row0 + l) * 256 + h * 64 + d]) * w[l]; n += kk;
        const bf16* vr = cm + (size_t)(row0 + l) * 768 + 256 + h * 64;
#pragma unroll
        for (int e = 0; e < 64; ++e) C[e] += kk * bf2f(vr[e]);
    }
#pragma unroll
    for (int e = 0; e < 64; ++e) CT[(size_t)chunk * 4096 + e * 64 + d] = C[e];
    NL[chunk * 64 + d] = n;
    if (d == 0) { ML[chunk] = mx; BL[chunk] = bL; }
}
__global__ void __launch_bounds__(64) k_mout(const bf16* mq, const bf16* mk, const bf16* cm, const bf16* xc, const float* gm, const float* CT, const float* NL, const float* MP,
                                             const float* gmh, const float* skip, bf16* mix) {
    __shared__ float bs[64], us[64], Ks[64][65], Vs[64][65], Cs[64][65], Qs[64][65], ns[64];
    const int chunk = blockIdx.x, c = chunk & 31, h = (chunk >> 5) & 3, b = chunk >> 7, l = threadIdx.x;
    const int row0 = b * S_ + c * 64, row = row0 + l;
    if (l == 0) { float acc = 0.f; for (int i = 0; i < 64; ++i) { acc += gm[(size_t)(row0 + i) * 32 + 22 + h]; bs[i] = acc; } }
    for (int d = 0; d < 64; ++d) { Ks[l][d] = bf2f(mk[(size_t)row * 256 + h * 64 + d]); Vs[l][d] = bf2f(cm[(size_t)row * 768 + 256 + h * 64 + d]); Cs[l][d] = CT[(size_t)chunk * 4096 + l * 64 + d]; }
    ns[l] = NL[chunk * 64 + l];
    __syncthreads();
    us[l] = gm[(size_t)row * 32 + 18 + h] - bs[l];
    __syncthreads();
    const float mprev = MP[chunk];
    float cu = -INFINITY; for (int s = 0; s <= l; ++s) cu = fmaxf(cu, us[s]);
    const float mt = bs[l] + fmaxf(mprev, cu), inter = __expf(bs[l] + mprev - mt);
    for (int d = 0; d < 64; ++d) Qs[l][d] = bf2f(mq[(size_t)row * 256 + h * 64 + d]);
    float num[64]; float qn = 0.f;
#pragma unroll
    for (int e = 0; e < 64; ++e) num[e] = 0.f;
    for (int d = 0; d < 64; ++d) { const float qd = Qs[l][d]; qn += qd * ns[d];
#pragma unroll
        for (int e = 0; e < 64; ++e) num[e] += qd * Cs[e][d]; }
#pragma unroll
    for (int e = 0; e < 64; ++e) num[e] *= inter;
    float den = inter * qn;
    for (int s = 0; s < 64; ++s) {
        if (s <= l) { float sd = 0.f;
            for (int d = 0; d < 64; ++d) sd += Qs[l][d] * Ks[s][d];
            const float sw = sd * __expf(bs[l] + us[s] - mt); den += sw;
#pragma unroll
            for (int e = 0; e < 64; ++e) num[e] += sw * Vs[s][e]; }
    }
    const float dn = 1.f / fmaxf(fabsf(den), __expf(-mt));
    float mu = 0.f;
#pragma unroll
    for (int e = 0; e < 64; ++e) { num[e] = num[e] * dn * sigmoidf_(bf2f(cm[(size_t)row * 768 + 512 + h * 64 + e])); mu += num[e]; }
    mu *= (1.f / 64.f); float var = 0.f;
#pragma unroll
    for (int e = 0; e < 64; ++e) { const float dlt = num[e] - mu; var += dlt * dlt; }
    const float rs = rsqrtf(var * (1.f / 64.f) + EPS);
#pragma unroll
    for (int e = 0; e < 64; ++e) mix[(size_t)row * D_ + 768 + h * 64 + e] = f2bf((num[e] - mu) * rs * gmh[h * 64 + e] + skip[h * 64 + e] * bf2f(xc[(size_t)row * 256 + h * 64 + e]));
}


__device__ __forceinline__ int fresh_lane() { int l; asm volatile("v_mbcnt_lo_u32_b32 %0, -1, 0\n\tv_mbcnt_hi_u32_b32 %0, -1, %0" : "=&v"(l)); return l; }
namespace pg8 {
#define PG8_LAS __attribute__((address_space(3)))
typedef unsigned short bf16_t;
typedef short bf16x8 __attribute__((ext_vector_type(8)));
typedef float f32x4 __attribute__((ext_vector_type(4)));
typedef unsigned u32x4 __attribute__((ext_vector_type(4)));
constexpr int BM = 256, BK = 64, HALF = 128, HTB = HALF * BK * 2  , STAGE_BYTES = 8 * HTB, NXCD = 8, WGM = 8;

__host__ __device__ __forceinline__ int lds_byte(int r, int c) { const int st = (r >> 4) * 2 + (c >> 5), rr = r & 15, cc = c & 31, ob = rr * 64 + cc * 2; return st * 1024 + (ob ^ (((ob >> 9) & 1) << 5)); }
__host__ __device__ __forceinline__ void stage_rc(int b, int& R, int& C) { const int st = b / 1024, sb = b % 1024, swz = sb ^ (((sb >> 9) & 1) << 5); R = (st >> 1) * 16 + swz / 64; C = (st & 1) * 32 + (swz % 64) / 2; }
__host__ __device__ __forceinline__ int perm32(int rho) { const int n = rho >> 4, i = rho & 15; return 8 * (i >> 2) + 4 * n + (i & 3); }

struct Unit { int pm, pn; };
struct Gemm { const bf16_t* A; const bf16_t* Bt; int M, N, K; };

struct StaticOrder {
    int nM, nN, nwg, G, c;
    __host__ __device__ void init(int M, int N, int G_, int c_) { nM = M / BM; nN = N / BM; nwg = nM * nN; G = G_; c = c_; }
    __host__ __device__ bool next(int i, Unit& u) const {
        const long L = (long)i * G + c; if (L >= nwg) return false;
        int wgid = (int)L; { const int q = nwg / NXCD, r = nwg % NXCD, xcd = wgid % NXCD, off = wgid / NXCD; wgid = (xcd < r ? xcd * (q + 1) : r * (q + 1) + (xcd - r) * q) + off; }
        const int nig = WGM * nN, gid = wgid / nig, fm = gid * WGM, gsz = (nM - fm) < WGM ? (nM - fm) : WGM;
        u.pm = fm + ((wgid % nig) % gsz); u.pn = (wgid % nig) / gsz; return true;
    }
    __device__ __forceinline__ void a_ready(const Unit&) const {}
    __device__ __forceinline__ void done(const Unit&) const {}
};

__device__ __forceinline__ unsigned cvt_pk_bf16(float lo, float hi) { unsigned r; asm volatile("v_cvt_pk_bf16_f32 %0, %1, %2" : "=v"(r) : "v"(lo), "v"(hi)); return r; }
typedef float f32x2 __attribute__((ext_vector_type(2)));

typedef unsigned u32x4 __attribute__((ext_vector_type(4)));
typedef unsigned u32x2 __attribute__((ext_vector_type(2)));
struct EpiIn {
    static constexpr bool PERM = true, AFTER_DRAIN = false;
    unsigned char* ws; const float *big, *bfg;
#define EPI_ROWS(...) _Pragma("unroll") for (int ai = 0; ai < 2; ++ai) _Pragma("unroll") for (int m = 0; m < 4; ++m) { \
        const int row = u.pm * BM + ai * HALF + wr * 64 + m * 16 + fr; float v[8]; \
        _Pragma("unroll") for (int i = 0; i < 4; ++i) { v[i] = acc[ai][bj][m][0][i]; v[4 + i] = acc[ai][bj][m][1][i]; } \
        asm volatile("" : "+v"(v[0]), "+v"(v[1]), "+v"(v[2]), "+v"(v[3]), "+v"(v[4]), "+v"(v[5]), "+v"(v[6]), "+v"(v[7])); \
        __VA_ARGS__ asm volatile("" ::: "memory"); }
#define EPI_PACK(w) u32x4 w; w.x = cvt_pk_bf16(v[0], v[1]); w.y = cvt_pk_bf16(v[2], v[3]); w.z = cvt_pk_bf16(v[4], v[5]); w.w = cvt_pk_bf16(v[6], v[7]);
    __device__ __forceinline__ void operator()(const f32x4 (&acc)[2][2][4][2], const Unit& u, int wr, int wc, int fr, int fq) const {
        half<0>(acc, u, wr, wc, fr, fq); half<1>(acc, u, wr, wc, fr, fq);
    }
    template <int bj> __device__ __forceinline__ void half(const f32x4 (&acc)[2][2][4][2], const Unit& u, int wr, int wc, int fr, int fq) const {
        {
            const int hb = 2 * u.pn + bj;
            int cb = 32 * wc + 8 * fq; asm volatile("" : "+v"(cb), "+v"(fr));
            if (hb <= 8) {
                bf16_t* nsa = (bf16_t*)(ws + WS_NSA) + hb * 128 + cb;
                const bool rope_hb = (hb <= 3) || hb == 5 || hb == 7;
                if (rope_hb) {
                    const float* cosP = (const float*)(ws + WS_COSP); const float* sinP = (const float*)(ws + WS_SINP);
                    const bool mine = ((wc & 1) == 0) && fq < 2; const float sg = (fq == 0) ? -1.f : 1.f; const float sc = (hb < 3) ? QSCALE : 1.f;
                    EPI_ROWS({
                        float pv[8];
                        _Pragma("unroll") for (int i = 0; i < 8; ++i) pv[i] = __shfl_xor(v[i], 16);
                        if (mine) {
                            const f32x4 c0 = *(const f32x4*)(cosP + row * 8), c1 = *(const f32x4*)(cosP + row * 8 + 4), s0 = *(const f32x4*)(sinP + row * 8), s1 = *(const f32x4*)(sinP + row * 8 + 4);
                            _Pragma("unroll") for (int i = 0; i < 4; ++i) { v[i] = v[i] * c0[i] + sg * pv[i] * s0[i]; v[4 + i] = v[4 + i] * c1[i] + sg * pv[4 + i] * s1[i]; }
                        }
                        _Pragma("unroll") for (int i = 0; i < 8; ++i) v[i] *= sc;
                        EPI_PACK(w) *(u32x4*)(nsa + (size_t)row * 1152) = w;
                    })
                } else {
                    EPI_ROWS({ EPI_PACK(w) *(u32x4*)(nsa + (size_t)row * 1152) = w; })
                }
            } else if (hb <= 11) {
                bf16_t* dst = (hb == 9) ? (bf16_t*)(ws + WS_KVL) + cb : (bf16_t*)(ws + WS_QL) + (hb - 10) * 128 + cb;
                const int ld = (hb == 9) ? 128 : 256;
                EPI_ROWS({ EPI_PACK(w) *(u32x4*)(dst + (size_t)row * ld) = w; })
            } else if (hb <= 17) {
                bf16_t* cm = (bf16_t*)(ws + WS_CM) + (hb - 12) * 128 + cb;
                EPI_ROWS({ EPI_PACK(w) *(u32x4*)(cm + (size_t)row * 768) = w; })
            } else if (hb == 18) {
                float* mr = (float*)(ws + WS_MISCRAW) + cb;
                if (wc < 2) { EPI_ROWS({ *(f32x4*)(mr + (size_t)row * 64) = (f32x4){v[0], v[1], v[2], v[3]}; *(f32x4*)(mr + (size_t)row * 64 + 4) = (f32x4){v[4], v[5], v[6], v[7]}; }) }
            }
        }
    }
#undef EPI_ROWS
#undef EPI_PACK
};
struct EpiUKV {
    static constexpr bool PERM = true, AFTER_DRAIN = false;
    bf16_t* kvm;
    __device__ __forceinline__ void operator()(const f32x4 (&acc)[2][2][4][2], const Unit& u, int wr, int wc, int fr, int fq) const {
        asm volatile("" : "+v"(fq), "+v"(fr));
        const int col0 = u.pn * BM + wc * 32 + 8 * fq;
#pragma unroll
        for (int ai = 0; ai < 2; ++ai)
#pragma unroll
            for (int m = 0; m < 4; ++m) { bf16_t* rowp = kvm + (size_t)(u.pm * BM + ai * HALF + wr * 64 + m * 16 + fr) * 768 + col0;
#pragma unroll
                for (int bj = 0; bj < 2; ++bj) { const f32x4 a = acc[ai][bj][m][0], b = acc[ai][bj][m][1];
                    u32x4 w; w.x = cvt_pk_bf16(a[0], a[1]); w.y = cvt_pk_bf16(a[2], a[3]); w.z = cvt_pk_bf16(b[0], b[1]); w.w = cvt_pk_bf16(b[2], b[3]);
                    *(u32x4*)(rowp + bj * HALF) = w; } }
    }
};
struct EpiRes {
    static constexpr bool PERM = false, AFTER_DRAIN = false;
    const float* xin; float* xout; const float* gate;
    __device__ __forceinline__ void operator()(const f32x4 (&acc)[2][2][4][2], const Unit& u, int wr, int wc, int fr, int fq) const {
        asm volatile("" : "+v"(fq), "+v"(fr));
        const int b = (u.pm * BM) / S_; const int col0 = u.pn * BM + wc * 32 + 4 * fq;
        f32x4 gv[2][2];
#pragma unroll
        for (int bj = 0; bj < 2; ++bj)
#pragma unroll
            for (int n = 0; n < 2; ++n) gv[bj][n] = *(const f32x4*)(gate + (size_t)b * 6144 + col0 + bj * HALF + n * 16);
#pragma unroll
        for (int ai = 0; ai < 2; ++ai)
#pragma unroll
            for (int m = 0; m < 4; ++m) { const size_t off = (size_t)(u.pm * BM + ai * HALF + wr * 64 + m * 16 + fr) * D_ + col0;
#pragma unroll
                for (int bj = 0; bj < 2; ++bj)
#pragma unroll
                    for (int n = 0; n < 2; ++n) { const f32x4 xi = *(const f32x4*)(xin + off + bj * HALF + n * 16); *(f32x4*)(xout + off + bj * HALF + n * 16) = xi + gv[bj][n] * acc[ai][bj][m][n]; } }
    }
};
struct EpiGU {
    static constexpr bool PERM = true, AFTER_DRAIN = false;
    bf16_t* act;
    __device__ __forceinline__ void operator()(const f32x4 (&acc)[2][2][4][2], const Unit& u, int wr, int wc, int fr, int fq) const {
        asm volatile("" : "+v"(fq), "+v"(fr));
        const int col0 = u.pn * HALF + wc * 32 + 8 * fq;
#pragma unroll
        for (int ai = 0; ai < 2; ++ai)
#pragma unroll
            for (int m = 0; m < 4; ++m) { const int row = u.pm * BM + ai * HALF + wr * 64 + m * 16 + fr; float o[8];
#pragma unroll
                for (int n = 0; n < 2; ++n)
#pragma unroll
                    for (int i = 0; i < 4; ++i) { const float g = acc[ai][0][m][n][i], up = acc[ai][1][m][n][i]; o[4 * n + i] = g / (1.f + __expf(-g)) * up; }
                u32x4 w; w.x = cvt_pk_bf16(o[0], o[1]); w.y = cvt_pk_bf16(o[2], o[3]); w.z = cvt_pk_bf16(o[4], o[5]); w.w = cvt_pk_bf16(o[6], o[7]);
                *(u32x4*)(act + (size_t)row * FF + col0) = w; }
    }
};
template <class Epi, class Sched, bool ALIGN_EPI = false, bool SP2 = false>
__device__ __forceinline__ void gemm_phase(PG8_LAS unsigned char* lds, const Gemm g, const Sched& S, const Epi& E, int wid_in) {
    const int wid = __builtin_amdgcn_readfirstlane(wid_in), lane = fresh_lane(), tid = wid * 64 + lane, wr = wid >> 2, wc = wid & 3;
    const int K = g.K, nt = K / BK;
    unsigned voffA[2], voffB[2];
#pragma unroll
    for (int i = 0; i < 2; ++i) { int R, C; stage_rc(tid * 16 + i * 8192, R, C); const int Rb = Epi::PERM ? ((R & ~31) + perm32(R & 31)) : R;
        voffA[i] = (unsigned)(R * K + C) * 2u; voffB[i] = (unsigned)(Rb * K + C) * 2u; }
    const size_t kstep = (size_t)(BK * 2);
    const size_t hstep = (size_t)HALF * K * 2;
    const size_t tstep = 2 * hstep;
    const unsigned ldsw = (unsigned)wid * 1024u;
    const int aoff = lds_byte(wr * 64 + (lane & 15), (lane >> 4) * 8), boff = lds_byte(wc * 32 + (lane & 15), (lane >> 4) * 8);
#define PG8_SA(b, h) (((b) * 2 + (h)) * HTB)
#define PG8_SB(b, h) ((4 + (b) * 2 + (h)) * HTB)
#define PG8_STAGE(bufoff, gbase, voff) do { _Pragma("unroll") for (int _i = 0; _i < 2; ++_i) \
        __builtin_amdgcn_global_load_lds((const unsigned*)((const char*)(gbase) + (voff)[_i]), (PG8_LAS unsigned*)(lds + (bufoff) + ldsw + _i * 8192), 16, 0, 0); } while (0)
#define PG8_LDA(dst, b, h) do { _Pragma("unroll") for (int m = 0; m < 4; ++m) _Pragma("unroll") for (int k = 0; k < 2; ++k) dst[m][k] = *(const PG8_LAS bf16x8*)(lds + PG8_SA(b, h) + aoff + m * 2048 + k * 1024); } while (0)
#define PG8_LDB(dst, b, h) do { _Pragma("unroll") for (int n = 0; n < 2; ++n) _Pragma("unroll") for (int k = 0; k < 2; ++k) dst[n][k] = *(const PG8_LAS bf16x8*)(lds + PG8_SB(b, h) + boff + n * 2048 + k * 1024); } while (0)
#define PG8_MMA(ai, bj, At, Bt) do { __builtin_amdgcn_s_setprio(1); _Pragma("unroll") for (int m = 0; m < 4; ++m) _Pragma("unroll") for (int n = 0; n < 2; ++n) _Pragma("unroll") for (int k = 0; k < 2; ++k) \
        acc[ai][bj][m][n] = __builtin_amdgcn_mfma_f32_16x16x32_bf16(Bt[n][k], At[m][k], acc[ai][bj][m][n], 0, 0, 0); __builtin_amdgcn_s_setprio(0); } while (0)
#define PG8_WAIT_V(n) asm volatile("s_waitcnt vmcnt(" #n ")" ::: "memory")
#define PG8_WAIT_L(n) asm volatile("s_waitcnt lgkmcnt(" #n ")" ::: "memory")
#define PG8_BAR __builtin_amdgcn_s_barrier()
#define PG8_SCHED __builtin_amdgcn_sched_barrier(0)
    Unit cur, nxt; int ui = 0;
    if (!S.next(0, cur)) return;
    f32x4 acc[2][2][4][2];
#pragma unroll
    for (int a = 0; a < 2; ++a)
#pragma unroll
        for (int b = 0; b < 2; ++b)
#pragma unroll
            for (int m = 0; m < 4; ++m)
#pragma unroll
                for (int n = 0; n < 2; ++n) acc[a][b][m][n] = (f32x4){0.f, 0.f, 0.f, 0.f};
    bf16x8 At[4][2], B0[2][2], B1[2][2];
    const char* cA = (const char*)g.A + (size_t)cur.pm * tstep; const char* cB = (const char*)g.Bt + (size_t)cur.pn * tstep;
    S.a_ready(cur);
    if constexpr (SP2) {
        PG8_STAGE(PG8_SB(0, 0), cB, voffB); PG8_STAGE(PG8_SB(0, 1), cB + hstep, voffB); PG8_STAGE(PG8_SA(0, 0), cA, voffA); PG8_STAGE(PG8_SA(0, 1), cA + hstep, voffA);
        if (wr == 1) PG8_BAR;
        PG8_WAIT_V(2); PG8_BAR;
        PG8_STAGE(PG8_SB(1, 0), cB + kstep, voffB); PG8_STAGE(PG8_SA(1, 0), cA + kstep, voffA); PG8_STAGE(PG8_SB(1, 1), cB + hstep + kstep, voffB);
        PG8_WAIT_V(6); PG8_BAR;
    } else {
        PG8_STAGE(PG8_SB(0, 0), cB, voffB); PG8_STAGE(PG8_SA(0, 0), cA, voffA); PG8_STAGE(PG8_SB(0, 1), cB + hstep, voffB); PG8_STAGE(PG8_SA(0, 1), cA + hstep, voffA);
        if (wr == 1) PG8_BAR;
        PG8_WAIT_V(4); PG8_BAR;
        PG8_STAGE(PG8_SB(1, 0), cB + kstep, voffB); PG8_STAGE(PG8_SA(1, 0), cA + kstep, voffA); PG8_STAGE(PG8_SB(1, 1), cB + hstep + kstep, voffB);
        PG8_WAIT_V(6); PG8_BAR;
    }
    for (;;) {
        const bool has_next = S.next(ui + 1, nxt);
        const char* nA = has_next ? (const char*)g.A + (size_t)nxt.pm * tstep : cA; const char* nB = has_next ? (const char*)g.Bt + (size_t)nxt.pn * tstep : cB;
        for (int t = 0; t < nt; t += 2) {
            const bool last = (t == nt - 2);
            const char* a1 = cA + (size_t)(t + 1) * kstep;
            const char* a2 = last ? nA : cA + (size_t)(t + 2) * kstep; const char* b2 = last ? nB : cB + (size_t)(t + 2) * kstep;
            const char* a3 = a2 + kstep; const char* b3 = b2 + kstep;
            if (last && has_next) S.a_ready(nxt);
            if constexpr (SP2) {
            PG8_LDB(B0, 0, 0); PG8_LDB(B1, 0, 1); PG8_SCHED; PG8_LDA(At, 0, 0); PG8_STAGE(PG8_SA(1, 1), a1 + hstep, voffA);
            PG8_WAIT_V(8); PG8_WAIT_L(0); PG8_BAR; PG8_MMA(0, 0, At, B0); PG8_MMA(0, 1, At, B1); PG8_BAR; PG8_SCHED;
            PG8_LDA(At, 0, 1); PG8_STAGE(PG8_SB(0, 0), b2, voffB); PG8_STAGE(PG8_SB(0, 1), b2 + hstep, voffB); PG8_STAGE(PG8_SA(0, 0), a2, voffA);
            PG8_WAIT_V(8); PG8_WAIT_L(0); PG8_BAR; PG8_MMA(1, 0, At, B0); PG8_MMA(1, 1, At, B1); PG8_BAR; PG8_SCHED;
            PG8_LDB(B0, 1, 0); PG8_LDB(B1, 1, 1); PG8_SCHED; PG8_LDA(At, 1, 0); PG8_STAGE(PG8_SA(0, 1), a2 + hstep, voffA);
            PG8_WAIT_V(8); PG8_WAIT_L(0); PG8_BAR; PG8_MMA(0, 0, At, B0); PG8_MMA(0, 1, At, B1); PG8_BAR; PG8_SCHED;
            PG8_LDA(At, 1, 1); PG8_STAGE(PG8_SB(1, 0), b3, voffB); PG8_STAGE(PG8_SB(1, 1), b3 + hstep, voffB); PG8_STAGE(PG8_SA(1, 0), a3, voffA);
            PG8_WAIT_V(8); PG8_WAIT_L(0); PG8_BAR; PG8_MMA(1, 0, At, B0); PG8_MMA(1, 1, At, B1); PG8_BAR; PG8_SCHED;
            } else {
            PG8_LDB(B0, 0, 0); PG8_SCHED; PG8_LDA(At, 0, 0); PG8_STAGE(PG8_SA(1, 1), a1 + hstep, voffA);
            PG8_WAIT_L(8); PG8_BAR; PG8_WAIT_L(0); PG8_MMA(0, 0, At, B0); PG8_BAR; PG8_SCHED;
            PG8_LDB(B1, 0, 1); PG8_STAGE(PG8_SB(0, 0), b2, voffB);
            PG8_BAR; PG8_WAIT_L(0); PG8_MMA(0, 1, At, B1); PG8_BAR;
            PG8_LDA(At, 0, 1); PG8_STAGE(PG8_SA(0, 0), a2, voffA);
            PG8_BAR; PG8_WAIT_L(0); PG8_MMA(1, 0, At, B0); PG8_BAR; PG8_SCHED;
            PG8_STAGE(PG8_SB(0, 1), b2 + hstep, voffB);
            PG8_WAIT_V(6); PG8_BAR; PG8_MMA(1, 1, At, B1); PG8_BAR;
            PG8_LDB(B0, 1, 0); PG8_SCHED; PG8_LDA(At, 1, 0); PG8_STAGE(PG8_SA(0, 1), a2 + hstep, voffA);
            PG8_WAIT_L(8); PG8_BAR; PG8_WAIT_L(0); PG8_MMA(0, 0, At, B0); PG8_BAR; PG8_SCHED;
            PG8_LDB(B1, 1, 1); PG8_STAGE(PG8_SB(1, 0), b3, voffB);
            PG8_BAR; PG8_WAIT_L(0); PG8_MMA(0, 1, At, B1); PG8_BAR;
            PG8_LDA(At, 1, 1); PG8_STAGE(PG8_SA(1, 0), a3, voffA);
            PG8_BAR; PG8_WAIT_L(0); PG8_MMA(1, 0, At, B0); PG8_BAR; PG8_SCHED;
            PG8_STAGE(PG8_SB(1, 1), b3 + hstep, voffB);
            PG8_WAIT_V(6); PG8_BAR; PG8_MMA(1, 1, At, B1); PG8_BAR;
            }
        }
        if constexpr (ALIGN_EPI) { if (wr == 0) PG8_BAR; }
        if constexpr (!Epi::AFTER_DRAIN) { const int ln = fresh_lane(); E(acc, cur, wr, wc, ln & 15, ln >> 4); S.done(cur); }
        if (!has_next) break;
#pragma unroll
        for (int a = 0; a < 2; ++a)
#pragma unroll
            for (int b = 0; b < 2; ++b)
#pragma unroll
                for (int m = 0; m < 4; ++m)
#pragma unroll
                    for (int n = 0; n < 2; ++n) acc[a][b][m][n] = (f32x4){0.f, 0.f, 0.f, 0.f};
        cur = nxt; cA = nA; cB = nB; ++ui;
        if constexpr (ALIGN_EPI) { if (wr == 1) PG8_BAR; }
    }
    PG8_WAIT_V(0);
    if constexpr (!ALIGN_EPI) { if (wr == 0) PG8_BAR; }
    PG8_BAR;
    if constexpr (Epi::AFTER_DRAIN) { const int ln = fresh_lane(); E.fused(acc, cur, wr, wc, ln & 15, ln >> 4, lds, wid, ln); S.done(cur); }
#undef PG8_SA
#undef PG8_SB
#undef PG8_STAGE
#undef PG8_LDA
#undef PG8_LDB
#undef PG8_MMA
#undef PG8_WAIT_V
#undef PG8_WAIT_L
#undef PG8_BAR
#undef PG8_SCHED
}
}

#define GAS __attribute__((address_space(1)))
#define LAS __attribute__((address_space(3)))
typedef float f32x4 __attribute__((ext_vector_type(4)));
typedef unsigned v4u __attribute__((ext_vector_type(4)));
typedef GAS unsigned gu32;
#define XB_TMO      128
#define XB_XCNT(j)  (256  + 64 * (j))
#define XB_XSUB(j)  (1280 + 64 * (j))
#define XB_XGEN(j)  (2304 + 64 * (j))
#define XB_TOP      3328
#define XB_TOPGEN   3392
#define XCD_BAR_WORDS 3456
#define XB_SPIN_CAP (1u << 18)

__device__ __forceinline__ unsigned xb_ld(unsigned* p)              { return __hip_atomic_load(p, __ATOMIC_RELAXED, __HIP_MEMORY_SCOPE_AGENT); }
__device__ __forceinline__ unsigned xb_add(unsigned* p, unsigned v) { return __hip_atomic_fetch_add(p, v, __ATOMIC_RELAXED, __HIP_MEMORY_SCOPE_AGENT); }
__device__ __forceinline__ unsigned xb_xcc_id() { return (unsigned)__builtin_amdgcn_s_getreg((3 << 11) | 20) & 0xFu; }
#define XB_SPIN(cond, bar) do { unsigned _sp = 0; while (cond) { __builtin_amdgcn_s_sleep(1); \
    if ((++_sp & 255u) == 0u) { if (xb_ld(&(bar)[XB_TMO])) break; if (_sp > XB_SPIN_CAP) { atomicAdd(&(bar)[XB_TMO], 1u); break; } } } } while (0)

struct XcdBarrier {
    unsigned* bar; unsigned x;
    volatile LAS unsigned* st;
};

__device__ __forceinline__ XcdBarrier xcd_barrier_post(unsigned* bar, volatile LAS unsigned* st, int tid) {
    XcdBarrier b; b.bar = bar; b.x = xb_xcc_id(); b.st = st;
    if (tid == 0) (void)xb_add(&bar[XB_XCNT(b.x)], 1u);
    return b;
}
__device__ __forceinline__ void xcd_barrier_complete(unsigned* bar, unsigned x, unsigned& nloc, unsigned& nx) {
    const unsigned G = gridDim.x * gridDim.y * gridDim.z;
    unsigned sum, cnt, mine, sp = 0u;
    for (;;) {
        sum = 0u; cnt = 0u; mine = 0u;
#pragma unroll
        for (unsigned j = 0; j < 16; ++j) { const unsigned c = xb_ld(&bar[XB_XCNT(j)]); sum += c; cnt += (c > 0u) ? 1u : 0u; mine = (j == x) ? c : mine; }
        if (sum == G) break;
        __builtin_amdgcn_s_sleep(1);
        if ((++sp & 255u) == 0u) { if (xb_ld(&bar[XB_TMO])) break; if (sp > XB_SPIN_CAP) { atomicAdd(&bar[XB_TMO], 1u); break; } }
    }
    nloc = mine > 0u ? mine : 1u; nx = cnt > 0u ? cnt : 1u;
}

__device__ __forceinline__ void xcd_barrier(const XcdBarrier& b, int tid) {
    asm volatile("s_waitcnt vmcnt(0)" ::: "memory");
    __syncthreads();
    if (tid == 0) {
        unsigned* bar = b.bar;
        __builtin_amdgcn_s_waitcnt(0);
        unsigned nloc = b.st[0], nx = b.st[1];
        if (nloc == 0u) { xcd_barrier_complete(bar, b.x, nloc, nx); b.st[0] = nloc; b.st[1] = nx; }
        const unsigned old = xb_add(&bar[XB_XSUB(b.x)], 1u);
        const unsigned gen = old / nloc;
        if (old + 1u == (gen + 1u) * nloc) {
            __builtin_amdgcn_fence(__ATOMIC_RELEASE, "agent");
            asm volatile("s_waitcnt vmcnt(0)" ::: "memory");
            const unsigned og = xb_add(&bar[XB_TOP], 1u);
            const unsigned tg = og / nx;
            if (og + 1u == (tg + 1u) * nx) xb_add(&bar[XB_TOPGEN], 1u);
            else XB_SPIN(xb_ld(&bar[XB_TOPGEN]) == tg, bar);
            __builtin_amdgcn_fence(__ATOMIC_ACQUIRE, "agent");
            xb_add(&bar[XB_XGEN(b.x)], 1u);
            asm volatile("s_waitcnt vmcnt(0)" ::: "memory");
        } else {
            XB_SPIN(xb_ld(&bar[XB_XGEN(b.x)]) == gen, bar);
            __builtin_amdgcn_fence(__ATOMIC_ACQUIRE, "agent");
            asm volatile("s_waitcnt vmcnt(0)" ::: "memory");
        }
    }
    __syncthreads();
}

constexpr int NTHR = 512, NWAVES = 8;
constexpr int RING_BYTES = 131072, MISC_OFF = RING_BYTES + 320, LDS_BYTES = 147456;
constexpr int CW_BAR = 4096;
constexpr size_t CTL_ZERO_BYTES = 64 * 1024;
constexpr size_t WT_IN = WS_WT, WT_OUT = WT_IN + (size_t)2560 * 1024 * 2, WT_GU = WT_OUT + (size_t)1024 * 1024 * 2, WT_DOWN = WT_GU + (size_t)5632 * 1024 * 2,
                 WT_UQ = WT_DOWN + (size_t)1024 * 2816 * 2, WT_UKV = WT_UQ + (size_t)768 * 256 * 2, WT_CK = WT_UKV + (size_t)768 * 128 * 2, WT_CV = WT_CK + (size_t)64 * 2048 * 2,
                 WT_QM = WT_CV + (size_t)64 * 2048 * 2, WT_KM = WT_QM + 4 * 64 * 64 * 2, WT_END = WT_KM + 4 * 64 * 64 * 2;
static_assert(WT_END <= WS_HB, "weights");
constexpr int NPH = 24, PPL = 11;
#ifndef PHM
#define PHM 0xffff
#endif
struct MP { const float* in[N_IN]; float* out; unsigned char* ws; int ph_lo, ph_hi, coop, pad; };

struct MPK {
    const __attribute__((address_space(4))) MP* k;
    struct InArr { const __attribute__((address_space(4))) MP* k; __device__ __forceinline__ const float* operator[](int i) const { return k->in[i]; } };
    __device__ __forceinline__ InArr in_() const { return InArr{k}; }
};
#define PIN(i) (p.k->in[i])
__device__ __forceinline__ unsigned pk2(float lo, float hi) { return (unsigned)f2bf(lo) | ((unsigned)f2bf(hi) << 16); }
struct MapId { int n; __device__ __forceinline__ int operator()(int c) const { return c < n ? c : -1; } };
struct MapIn { __device__ __forceinline__ int operator()(int c) const {
    if (c < 1152) return c; if (c < 1280) return 1426 + (c - 1152); if (c < 1536) return 1170 + (c - 1280); if (c < 2304) return 1586 + (c - 1536);
    if (c < 2336) return 1554 + (c - 2304); if (c < 2354) return 1152 + (c - 2336); if (c < 2362) return c; return -1; } };
struct MapGU { __device__ __forceinline__ int operator()(int c) const { const int t = c >> 8, w = c & 255; return (w < 128) ? t * 128 + w : FF + t * 128 + (w - 128); } };
template <class Map> __device__ __forceinline__ void transpose_item(const float* W, int K, int ldw, const Map& map, const float* kscale, bf16* WT, LAS float* scr, int item, int nblk, int lane) {
    const int kb = item / nblk, nb = item % nblk, k0 = 64 * kb, n0 = 32 * nb;
    const int sc = map(n0 + (lane & 31));
#pragma unroll 8
    for (int i = 0; i < 32; ++i) { const int kk = 2 * i + (lane >> 5); float v = (sc >= 0) ? W[(size_t)(k0 + kk) * ldw + sc] : 0.f; if (kscale) v *= kscale[k0 + kk]; scr[kk * 33 + (lane & 31)] = v; }
    asm volatile("s_waitcnt lgkmcnt(0)" ::: "memory");
    const int c = lane & 7;
#pragma unroll
    for (int j = 0; j < 4; ++j) { const int n = (lane >> 3) + 8 * j; const LAS float* s = scr + (8 * c) * 33 + n;
        v4u o; o.x = pk2(s[0 * 33], s[1 * 33]); o.y = pk2(s[2 * 33], s[3 * 33]); o.z = pk2(s[4 * 33], s[5 * 33]); o.w = pk2(s[6 * 33], s[7 * 33]);
        *(v4u*)(WT + (size_t)(n0 + n) * K + k0 + 8 * c) = o; }
    asm volatile("s_waitcnt lgkmcnt(0)" ::: "memory");
}
__device__ __forceinline__ void norm_rows(const float* x, const float* g, const float* shift, const float* scale, bf16* hb, float* outf, int mode, int gw, int ngw, int lane) {
    for (int m = gw; m < T_; m += ngw) {
        const float4* xr = (const float4*)(x + (size_t)m * D_) + lane;
        float4 v[4]; float s = 0.f;
#pragma unroll
        for (int j = 0; j < 4; ++j) { v[j] = xr[64 * j]; s += v[j].x * v[j].x + v[j].y * v[j].y + v[j].z * v[j].z + v[j].w * v[j].w; }
        const float rstd = rsqrtf(wave_sum(s) * (1.f / D_) + EPS);
        const int b = m / S_;
#pragma unroll
        for (int j = 0; j < 4; ++j) {
            const int col = 4 * lane + 256 * j;
            const float4 gg = *(const float4*)(g + col);
            float4 o; o.x = v[j].x * rstd * gg.x; o.y = v[j].y * rstd * gg.y; o.z = v[j].z * rstd * gg.z; o.w = v[j].w * rstd * gg.w;
            if (mode == 2) { *(float4*)(outf + (size_t)m * D_ + col) = o; }
            else {
                const float4 sc = *(const float4*)(scale + (size_t)b * 6144 + col), sh = *(const float4*)(shift + (size_t)b * 6144 + col);
                o.x = o.x * (1.f + sc.x) + sh.x; o.y = o.y * (1.f + sc.y) + sh.y; o.z = o.z * (1.f + sc.z) + sh.z; o.w = o.w * (1.f + sc.w) + sh.w;
                uint2 w; w.x = pk2(o.x, o.y); w.y = pk2(o.z, o.w);
                *(uint2*)(hb + (size_t)m * D_ + col) = w;
            }
        }
    }
}
__device__ __forceinline__ void ph_p0(const MPK& p, LAS unsigned char* lds, int tid) {
    const int wave = tid >> 6, lane = tid & 63;
    LAS float* ca = (LAS float*)lds; LAS float* red = ca + 8192;
    unsigned char* ws = p.k->ws; float* mod = (float*)(ws + WS_MOD);
    const float* c = PIN(I_C);
    for (int i = tid; i < 8192; i += NTHR) ca[i] = siluf_(c[i]);
    __syncthreads();
    for (int item = blockIdx.x; item < 192; item += gridDim.x) {
        const int l = item / 96, j = (item % 96) * 64 + lane;
        const float* w = PIN(I_WADA) + (size_t)l * 1024 * 6144 + j;
        float acc[8];
#pragma unroll
        for (int b = 0; b < 8; ++b) acc[b] = 0.f;
#pragma unroll 4
        for (int k = wave * 128; k < wave * 128 + 128; ++k) {
            const float wv = w[(size_t)k * 6144];
#pragma unroll
            for (int b = 0; b < 8; ++b) acc[b] += ca[b * 1024 + k] * wv;
        }
#pragma unroll
        for (int b = 0; b < 8; ++b) red[(wave * 8 + b) * 64 + lane] = acc[b];
        __syncthreads();
        { const int b = wave; float s = 0.f;
#pragma unroll
          for (int w8 = 0; w8 < 8; ++w8) s += red[(w8 * 8 + b) * 64 + lane];
          mod[((size_t)l * 8 + b) * 6144 + j] = s + PIN(I_BADA)[l * 6144 + j]; }
        __syncthreads();
    }
    const int* pos = (const int*)PIN(I_POS);
    float *cosP = (float*)(ws + WS_COSP), *sinP = (float*)(ws + WS_SINP), *cosM = (float*)(ws + WS_COSM), *sinM = (float*)(ws + WS_SINM);
    for (int i = blockIdx.x * NTHR + tid; i < T_ * 24; i += gridDim.x * NTHR) {
        const int m = i / 24, f = i % 24;
        double inv; if (f < 8) inv = pow(500000.0, -(double)(2 * f) / 16.0); else inv = pow(500000.0, -(double)(2 * (f - 8)) / 32.0);
        const float ang = (float)pos[m] * (float)inv;
        const double a = (double)ang, kq = rint(a * 0.15915494309189535), r = a - kq * 6.283185307179586476925;
        const float cs = (float)cos(r), sn = (float)sin(r);
        if (f < 8) { cosP[m * 8 + f] = cs; sinP[m * 8 + f] = sn; } else { cosM[m * 16 + f - 8] = cs; sinM[m * 16 + f - 8] = sn; }
    }
}
__device__ __forceinline__ void ph_prep(const MPK& p, int l, LAS unsigned char* lds, int tid) {
    const int wave = tid >> 6, lane = tid & 63;
    const int gw = blockIdx.x * NWAVES + wave, ngw = gridDim.x * NWAVES;
    unsigned char* ws = p.k->ws;
    LAS float* scr = (LAS float*)(lds + wave * 16384);
    constexpr int I0 = 16 * 80, I1 = 16 * 32, I2 = 16 * 176, I3 = 44 * 32, I4 = 4 * 24, I5 = 2 * 24, I6 = 32 * 2, I7 = 32 * 2, I8 = 8, I9 = 8;
    constexpr int NIT = I0 + I1 + I2 + I3 + I4 + I5 + I6 + I7 + I8 + I9;
    for (int it = gw; it < NIT; it += ngw) {
        int r = it;
        if (r < I0) { transpose_item(PIN(I_WIN) + (size_t)l * D_ * DIN, D_, DIN, MapIn{}, nullptr, (bf16*)(ws + WT_IN), scr, r, 80, lane); continue; } r -= I0;
        if (r < I1) { transpose_item(PIN(I_WOUT) + (size_t)l * D_ * D_, D_, D_, MapId{D_}, nullptr, (bf16*)(ws + WT_OUT), scr, r, 32, lane); continue; } r -= I1;
        if (r < I2) { transpose_item(PIN(I_WGU) + (size_t)l * D_ * 2 * FF, D_, 2 * FF, MapGU{}, nullptr, (bf16*)(ws + WT_GU), scr, r, 176, lane); continue; } r -= I2;
        if (r < I3) { transpose_item(PIN(I_WDOWN) + (size_t)l * FF * D_, FF, D_, MapId{D_}, nullptr, (bf16*)(ws + WT_DOWN), scr, r, 32, lane); continue; } r -= I3;
        if (r < I4) { transpose_item(PIN(I_WUQ) + (size_t)l * 256 * 576, 256, 576, MapId{576}, PIN(I_GQL) + l * 256, (bf16*)(ws + WT_UQ), scr, r, 24, lane); continue; } r -= I4;
        if (r < I5) { transpose_item(PIN(I_WUKV) + (size_t)l * 128 * 768, 128, 768, MapId{768}, PIN(I_GKVL) + l * 128, (bf16*)(ws + WT_UKV), scr, r, 24, lane); continue; } r -= I5;
        if (r < I6) { transpose_item(PIN(I_WCK) + (size_t)l * 2048 * 64, 2048, 64, MapId{64}, nullptr, (bf16*)(ws + WT_CK), scr, r, 2, lane); continue; } r -= I6;
        if (r < I7) { transpose_item(PIN(I_WCV) + (size_t)l * 2048 * 64, 2048, 64, MapId{64}, nullptr, (bf16*)(ws + WT_CV), scr, r, 2, lane); continue; } r -= I7;
        if (r < I8) { const int h = r >> 1; transpose_item(PIN(I_WQM) + (size_t)l * 16384 + h * 4096, 64, 64, MapId{64}, nullptr, (bf16*)(ws + WT_QM) + h * 4096, scr, r & 1, 2, lane); continue; } r -= I8;
        { const int h = r >> 1; transpose_item(PIN(I_WKM) + (size_t)l * 16384 + h * 4096, 64, 64, MapId{64}, nullptr, (bf16*)(ws + WT_KM) + h * 4096, scr, r & 1, 2, lane); }
    }
    const float* xin = (l == 0) ? PIN(I_X) : p.k->out;
    const float* modl = (const float*)(ws + WS_MOD) + (size_t)l * 8 * 6144;
    norm_rows(xin, PIN(I_GN1) + l * D_, modl + 0, modl + 1024, (bf16*)(ws + WS_HB), nullptr, 0, gw, ngw, lane);
}
__device__ __forceinline__ void ph_mixnorm(const MPK& p, int l, int tid) {
    const int gw = blockIdx.x * NWAVES + (tid >> 6), ngw = gridDim.x * NWAVES, lane = tid & 63;
    bf16* mix = (bf16*)(p.k->ws + WS_HB); const float* ga = PIN(I_GOA) + l * 384; const float* gb = PIN(I_GOB) + l * 384;
    for (int m = gw; m < T_; m += ngw) {
        bf16* r = mix + (size_t)m * D_;
        float va[6], vb[6]; float sa = 0.f, sb = 0.f;
#pragma unroll
        for (int j = 0; j < 6; ++j) { va[j] = bf2f(r[lane + 64 * j]); vb[j] = bf2f(r[384 + lane + 64 * j]); sa += va[j] * va[j]; sb += vb[j] * vb[j]; }
        const float ra = rsqrtf(wave_sum(sa) * (1.f / 384.f) + EPS), rb = rsqrtf(wave_sum(sb) * (1.f / 384.f) + EPS);
#pragma unroll
        for (int j = 0; j < 6; ++j) { r[lane + 64 * j] = f2bf(va[j] * ra * ga[lane + 64 * j]); r[384 + lane + 64 * j] = f2bf(vb[j] * rb * gb[lane + 64 * j]); }
    }
}


typedef short bf16x8 __attribute__((ext_vector_type(8)));
typedef short s16x4 __attribute__((ext_vector_type(4)));
typedef float f32x16 __attribute__((ext_vector_type(16)));
typedef unsigned u32x2v __attribute__((ext_vector_type(2)));
constexpr int AT_BUF = 20480, AT_K32 = 8192, AT_V = 12288;
__device__ __forceinline__ unsigned cvtpk(float lo, float hi) { unsigned r; asm volatile("v_cvt_pk_bf16_f32 %0, %1, %2" : "=v"(r) : "v"(lo), "v"(hi)); return r; }
__device__ __forceinline__ int crow(int r, int hi) { return (r & 3) + 8 * (r >> 2) + 4 * hi; }
__device__ __forceinline__ s16x4 vtr(LAS const unsigned char* p) { return __builtin_bit_cast(s16x4, __builtin_amdgcn_ds_read_tr16_b64_v4i16((LAS s16x4*)p)); }
enum { AM_CAUSAL = 0, AM_WINDOW = 1, AM_SLC = 2 };
struct AttnState { float m, l; f32x16 o[2]; };
template <int NC> struct TileRegs { v4u k; v4u k2; v4u v; };
template <int NC> __device__ __forceinline__ void at_load(TileRegs<NC>& r, const bf16* Kg, int ldk, const bf16* Vg, int ldv, const bf16* K2g, int ldk2, int tile, int tid) {
    const int key = tid >> 3, c = tid & 7;
    r.k = *(const v4u*)(Kg + (size_t)(tile * 64 + key) * ldk + 8 * c);
    r.v = *(const v4u*)(Vg + (size_t)(tile * 64 + key) * ldv + 8 * c);
    if (NC == 6) { if (tid < 256) r.k2 = *(const v4u*)(K2g + (size_t)(tile * 64 + (tid >> 2)) * ldk2 + 8 * (tid & 3)); }
}
template <int NC> __device__ __forceinline__ void at_store(const TileRegs<NC>& r, LAS unsigned char* buf, int tid) {
    const int key = tid >> 3, c = tid & 7;
    *(LAS v4u*)(buf + key * 128 + 16 * (c ^ ((key >> 1) & 7))) = r.k;
    *(LAS v4u*)(buf + AT_V + (c >> 2) * 4096 + key * 64 + (c & 3) * 16) = r.v;
    if (NC == 6) { if (tid < 256) { const int k2 = tid >> 2, c2 = tid & 3; *(LAS v4u*)(buf + AT_K32 + k2 * 64 + 16 * (c2 ^ ((k2 >> 2) & 3))) = r.k2; } }
}
template <int NC, int MODE> __device__ __forceinline__ void at_tile(AttnState& st, LAS const unsigned char* buf, const bf16x8 (&qf)[NC], int kpos0, int qpos, bool need_mask, bool sel_ok, int lane) {
    const int r32 = lane & 31, hi = lane >> 5;
    f32x16 p0 = {}, p1 = {};
#pragma unroll
    for (int cc = 0; cc < NC; ++cc) {
        bf16x8 k0, k1;
        if (cc < 4) { const int k0r = r32, k1r = 32 + r32;
            k0 = *(LAS const bf16x8*)(buf + k0r * 128 + 16 * ((2 * cc + hi) ^ ((k0r >> 1) & 7)));
            k1 = *(LAS const bf16x8*)(buf + k1r * 128 + 16 * ((2 * cc + hi) ^ ((k1r >> 1) & 7))); }
        else { const int k0r = r32, k1r = 32 + r32, c2 = 2 * (cc - 4) + hi;
            k0 = *(LAS const bf16x8*)(buf + AT_K32 + k0r * 64 + 16 * (c2 ^ ((k0r >> 2) & 3)));
            k1 = *(LAS const bf16x8*)(buf + AT_K32 + k1r * 64 + 16 * (c2 ^ ((k1r >> 2) & 3))); }
        p0 = __builtin_amdgcn_mfma_f32_32x32x16_bf16(k0, qf[cc], p0, 0, 0, 0);
        p1 = __builtin_amdgcn_mfma_f32_32x32x16_bf16(k1, qf[cc], p1, 0, 0, 0);
    }
    if (need_mask) {
        const float selterm = (MODE == AM_SLC && !sel_ok) ? -INFINITY : INFINITY;
        const int dbase = qpos - kpos0 - 4 * hi;
#pragma unroll
        for (int r = 0; r < 16; ++r) {
            const int d0 = dbase - ((r & 3) + 8 * (r >> 2)), d1 = d0 - 32;
            float l0 = ((float)d0 + 0.5f) * INFINITY, l1 = ((float)d1 + 0.5f) * INFINITY;
            if (MODE == AM_WINDOW) { l0 = fminf(l0, ((float)(511 - d0) + 0.5f) * INFINITY); l1 = fminf(l1, ((float)(511 - d1) + 0.5f) * INFINITY); }
            if (MODE == AM_SLC) { l0 = fminf(l0, selterm); l1 = fminf(l1, selterm); }
            p0[r] = fminf(p0[r], l0); p1[r] = fminf(p1[r], l1);
        }
    }
    float mx = fmaxf(p0[0], p1[0]);
#pragma unroll
    for (int r = 1; r < 16; ++r) mx = fmaxf(mx, fmaxf(p0[r], p1[r]));
    mx = fmaxf(mx, __shfl_xor(mx, 32));
    const float mn = fmaxf(st.m, mx), alpha = exp2f(st.m - mn);
    st.m = mn;
    float sum = 0.f;
#pragma unroll
    for (int r = 0; r < 16; ++r) { p0[r] = exp2f(p0[r] - mn); p1[r] = exp2f(p1[r] - mn); sum += p0[r] + p1[r]; }
    st.l = st.l * alpha + sum;
#pragma unroll
    for (int r = 0; r < 16; ++r) { st.o[0][r] *= alpha; st.o[1][r] *= alpha; }
    bf16x8 pf[4];
#pragma unroll
    for (int s2 = 0; s2 < 2; ++s2) {
        v4u a, b;
        a.x = cvtpk(p0[8 * s2 + 0], p0[8 * s2 + 1]); a.y = cvtpk(p0[8 * s2 + 2], p0[8 * s2 + 3]); a.z = cvtpk(p0[8 * s2 + 4], p0[8 * s2 + 5]); a.w = cvtpk(p0[8 * s2 + 6], p0[8 * s2 + 7]);
        b.x = cvtpk(p1[8 * s2 + 0], p1[8 * s2 + 1]); b.y = cvtpk(p1[8 * s2 + 2], p1[8 * s2 + 3]); b.z = cvtpk(p1[8 * s2 + 4], p1[8 * s2 + 5]); b.w = cvtpk(p1[8 * s2 + 6], p1[8 * s2 + 7]);
        pf[s2] = __builtin_bit_cast(bf16x8, a); pf[2 + s2] = __builtin_bit_cast(bf16x8, b);
    }
    LAS const unsigned char* vb = buf + AT_V + (4 * hi + ((lane & 15) >> 2)) * 64 + ((lane >> 4) & 1) * 32 + (lane & 3) * 8;
#pragma unroll
    for (int dh = 0; dh < 2; ++dh)
#pragma unroll
        for (int s4 = 0; s4 < 4; ++s4) {
            const s16x4 lo = vtr(vb + dh * 4096 + s4 * 1024), hh = vtr(vb + dh * 4096 + s4 * 1024 + 512);
            const bf16x8 vf = {lo[0], lo[1], lo[2], lo[3], hh[0], hh[1], hh[2], hh[3]};
            st.o[dh] = __builtin_amdgcn_mfma_f32_32x32x16_bf16(vf, pf[s4], st.o[dh], 0, 0, 0);
        }
}
template <int NC, int MODE> __device__ __forceinline__ void at_stream(AttnState& st, LAS unsigned char* lds, const bf16* Kg, int ldk, const bf16* Vg, int ldv, const bf16* K2g, int ldk2, int t0, int t1,
                                                                       const bf16x8 (&qf)[NC], int qpos, int qw0, unsigned selbits, int tid) {
    const int lane = tid & 63;
    TileRegs<NC> tr;
    at_load<NC>(tr, Kg, ldk, Vg, ldv, K2g, ldk2, t0, tid);
    at_store<NC>(tr, lds, tid);
    __syncthreads();
    for (int t = t0; t < t1; ++t) {
        LAS unsigned char* cur = lds + ((t - t0) & 1) * AT_BUF;
        LAS unsigned char* nxt = lds + (((t - t0) & 1) ^ 1) * AT_BUF;
        const bool more = (t + 1 < t1);
        if (more) at_load<NC>(tr, Kg, ldk, Vg, ldv, K2g, ldk2, t + 1, tid);
        const int k0 = t * 64;
        bool skip = k0 > qw0 + 31, need_mask = (k0 + 63 > qw0);
        if (MODE == AM_WINDOW) { skip = skip || (k0 + 63 < qw0 - 511); need_mask = need_mask || (k0 < qw0 + 31 - 511); }
        bool sel_ok = true;
        if (MODE == AM_SLC) { sel_ok = (selbits >> t) & 1u; const unsigned long long bal = __ballot(sel_ok); skip = skip || (bal == 0ull); need_mask = need_mask || (bal != ~0ull); }
        if (!skip) at_tile<NC, MODE>(st, cur, qf, k0, qpos, need_mask, sel_ok, lane);
        if (more) at_store<NC>(tr, nxt, tid);
        __syncthreads();
    }
}
__device__ __forceinline__ int next_item(unsigned* ctr, LAS unsigned char* lds, int wave_u) {
    const int tid = wave_u * 64 + fresh_lane();
    LAS int* slot = (LAS int*)(lds + RING_BYTES + 64);
    if (tid == 0) *slot = (int)atomicAdd(ctr, 1u);
    __syncthreads();
    const int v = *slot;
    __syncthreads();
    return v;
}
__device__ __forceinline__ void mla_unit(unsigned char* ws, LAS unsigned char* lds, int b, int h, int qt, int wave_u) {
    const int tid = wave_u * 64 + fresh_lane();
    const int lane = tid & 63, wave = tid >> 6, r32 = lane & 31, hi = lane >> 5;
    const int qw0 = qt * 256 + wave * 32, qpos = qw0 + r32; const size_t row = (size_t)b * S_ + qpos;
    bf16x8 qf[6];
    {
        const bf16* ql = (const bf16*)(ws + WS_QL) + row * 256 + 8 * hi;
        const int sw = (r32 & 0x13) | ((r32 & 4) << 1) | ((r32 & 8) >> 1);
        const bf16* wt = (const bf16*)(ws + WT_UQ) + (size_t)(h * 96 + sw) * 256 + 8 * hi;
        f32x16 qa[3] = {f32x16{}, f32x16{}, f32x16{}};
#pragma unroll 4
        for (int ks = 0; ks < 16; ++ks) {
            const bf16x8 bq = *(const bf16x8*)(ql + 16 * ks);
#pragma unroll
            for (int blk = 0; blk < 3; ++blk) { const bf16x8 aw = *(const bf16x8*)(wt + (size_t)blk * 32 * 256 + 16 * ks); qa[blk] = __builtin_amdgcn_mfma_f32_32x32x16_bf16(aw, bq, qa[blk], 0, 0, 0); }
        }
        float msc = MSCALE; asm volatile("" : "+v"(msc));
        const float rs = rsqrtf(((const float*)(ws + WS_SSQL))[row] * (1.f / 256.f) + EPS) * msc;
        const float* cm_ = (const float*)(ws + WS_COSM) + row * 16 + 8 * hi; const float* sm_ = (const float*)(ws + WS_SINM) + row * 16 + 8 * hi;
#pragma unroll
        for (int r = 0; r < 8; ++r) { const float x1 = qa[2][r], x2 = qa[2][r + 8], cs = cm_[r], sn = sm_[r]; qa[2][r] = x1 * cs - x2 * sn; qa[2][r + 8] = x1 * sn + x2 * cs; }
#pragma unroll
        for (int blk = 0; blk < 3; ++blk)
#pragma unroll
            for (int a2 = 0; a2 < 2; ++a2) { v4u w; w.x = cvtpk(qa[blk][8 * a2 + 0] * rs, qa[blk][8 * a2 + 1] * rs); w.y = cvtpk(qa[blk][8 * a2 + 2] * rs, qa[blk][8 * a2 + 3] * rs);
                w.z = cvtpk(qa[blk][8 * a2 + 4] * rs, qa[blk][8 * a2 + 5] * rs); w.w = cvtpk(qa[blk][8 * a2 + 6] * rs, qa[blk][8 * a2 + 7] * rs); qf[2 * blk + a2] = __builtin_bit_cast(bf16x8, w); }
    }
    AttnState st; st.m = -1e30f; st.l = 0.f; st.o[0] = f32x16{}; st.o[1] = f32x16{};
    const bf16* kvb = (const bf16*)(ws + WS_KVM) + (size_t)b * S_ * 768 + h * 128;
    at_stream<6, AM_CAUSAL>(st, lds, kvb, 768, kvb + 64, 768, (const bf16*)(ws + WS_KR) + (size_t)b * S_ * 32, 32, 0, 4 * qt + 4, qf, qpos, qw0, 0u, tid);
    const float lt = st.l + __shfl_xor(st.l, 32), il = 1.f / lt;
    bf16* op = (bf16*)(ws + WS_HB) + row * D_ + 384 + h * 64 + 4 * hi;
#pragma unroll
    for (int dh = 0; dh < 2; ++dh)
#pragma unroll
        for (int g4 = 0; g4 < 4; ++g4) { u32x2v w; w.x = cvtpk(st.o[dh][4 * g4] * il, st.o[dh][4 * g4 + 1] * il); w.y = cvtpk(st.o[dh][4 * g4 + 2] * il, st.o[dh][4 * g4 + 3] * il);
            *(u32x2v*)(op + dh * 32 + 8 * g4) = w; }
}
__device__ __forceinline__ void nsa_unit(unsigned char* ws, LAS unsigned char* lds, int b, int h, int qt, int wave_u) {
    const int tid = wave_u * 64 + fresh_lane();
    const int lane = tid & 63, wave = tid >> 6, r32 = lane & 31, hi = lane >> 5, g = h / 3;
    const int qw0 = qt * 256 + wave * 32, qpos = qw0 + r32; const size_t row = (size_t)b * S_ + qpos;
    const bf16* nsa = (const bf16*)(ws + WS_NSA);
    const bf16* qp = nsa + row * 1152 + h * 64 + 8 * hi;
    bf16x8 qf[4];
#pragma unroll
    for (int cc = 0; cc < 4; ++cc) qf[cc] = *(const bf16x8*)(qp + 16 * cc);
    const unsigned selbits = ((const unsigned*)(ws + WS_SEL))[(size_t)(b * 2 + g) * S_ + qpos];
    const float* gm = (const float*)(ws + WS_GM) + row * 32 + h * 3;
    const float g0 = gm[0], g1 = gm[1], g2 = gm[2];
    const bf16* kb = nsa + (size_t)b * S_ * 1152 + g * 64;
    f32x16 comb[2];
    { AttnState st; st.m = -1e30f; st.l = 0.f; st.o[0] = f32x16{}; st.o[1] = f32x16{};
      at_stream<4, AM_SLC>(st, lds, kb + 640, 1152, kb + 768, 1152, nullptr, 0, 0, 4 * qt + 4, qf, qpos, qw0, selbits, tid);
      const float lt = st.l + __shfl_xor(st.l, 32), f = g1 / lt;
#pragma unroll
      for (int r = 0; r < 16; ++r) { comb[0][r] = st.o[0][r] * f; comb[1][r] = st.o[1][r] * f; } }
    { AttnState st; st.m = -1e30f; st.l = 0.f; st.o[0] = f32x16{}; st.o[1] = f32x16{};
      const int t0 = (4 * qt - 8 > 0) ? 4 * qt - 8 : 0;
      at_stream<4, AM_WINDOW>(st, lds, kb + 896, 1152, kb + 1024, 1152, nullptr, 0, t0, 4 * qt + 4, qf, qpos, qw0, 0u, tid);
      const float lt = st.l + __shfl_xor(st.l, 32), f = g2 / lt;
#pragma unroll
      for (int r = 0; r < 16; ++r) { comb[0][r] += st.o[0][r] * f; comb[1][r] += st.o[1][r] * f; } }
    const bf16* oc = (const bf16*)(ws + WS_OCMP) + row * 384 + h * 64 + 4 * hi;
    bf16* op = (bf16*)(ws + WS_HB) + row * D_ + h * 64 + 4 * hi;
#pragma unroll
    for (int dh = 0; dh < 2; ++dh)
#pragma unroll
        for (int g4 = 0; g4 < 4; ++g4) {
            const u32x2v c = *(const u32x2v*)(oc + dh * 32 + 8 * g4);
            const float c0 = __uint_as_float(c.x << 16), c1 = __uint_as_float(c.x & 0xffff0000u), c2 = __uint_as_float(c.y << 16), c3 = __uint_as_float(c.y & 0xffff0000u);
            u32x2v w; w.x = cvtpk(comb[dh][4 * g4] + g0 * c0, comb[dh][4 * g4 + 1] + g0 * c1); w.y = cvtpk(comb[dh][4 * g4 + 2] + g0 * c2, comb[dh][4 * g4 + 3] + g0 * c3);
            *(u32x2v*)(op + dh * 32 + 8 * g4) = w; }
}
__device__ __forceinline__ void cmp_unit(unsigned char* ws, LAS unsigned char* lds, int b, int g, int qt, int wave_u) {
    const int tid = wave_u * 64 + fresh_lane();
    const int lane = tid & 63, wave = tid >> 6, r32 = lane & 31, hi = lane >> 5;
    const int qpos = qt * 256 + wave * 32 + r32; const size_t row = (size_t)b * S_ + qpos;
    const bf16* kc = (const bf16*)(ws + WS_KCV) + (size_t)(b * 2 + g) * 128 * 64; const bf16* vc = kc + (size_t)8 * 2 * 128 * 64;
    { TileRegs<4> tr; at_load<4>(tr, kc, 64, vc, 64, nullptr, 0, 0, tid); at_store<4>(tr, lds, tid); at_load<4>(tr, kc, 64, vc, 64, nullptr, 0, 1, tid); at_store<4>(tr, lds + AT_BUF, tid); }
    __syncthreads();
    int nvis = (qpos >= 31) ? ((qpos - 31) >> 4) + 1 : 0; if (nvis > 127) nvis = 127;
    LAS float* IG = (LAS float*)(lds + 2 * AT_BUF) + wave * (32 * 33) + r32 * 33;
    LAS float* IL = IG + 8 * 32 * 33;
    const bf16* nsa = (const bf16*)(ws + WS_NSA);
    LAS const unsigned char* vb = lds + AT_V + (4 * hi + ((lane & 15) >> 2)) * 64 + ((lane >> 4) & 1) * 32 + (lane & 3) * 8;
    for (int r3 = 0; r3 < 3; ++r3) {
        const int h = 3 * g + r3;
        const bf16* qp = nsa + row * 1152 + h * 64 + 8 * hi;
        bf16x8 qf[4];
#pragma unroll
        for (int cc = 0; cc < 4; ++cc) qf[cc] = *(const bf16x8*)(qp + 16 * cc);
        f32x16 p[4];
#pragma unroll
        for (int tb = 0; tb < 4; ++tb) {
            LAS const unsigned char* buf = lds + (tb >> 1) * AT_BUF; const int kr = (tb & 1) * 32 + r32;
            p[tb] = f32x16{};
#pragma unroll
            for (int cc = 0; cc < 4; ++cc) { const bf16x8 kf = *(LAS const bf16x8*)(buf + kr * 128 + 16 * ((2 * cc + hi) ^ ((kr >> 1) & 7)));
                p[tb] = __builtin_amdgcn_mfma_f32_32x32x16_bf16(kf, qf[cc], p[tb], 0, 0, 0); }
        }
        float mx = -1e30f;
#pragma unroll
        for (int tb = 0; tb < 4; ++tb)
#pragma unroll
            for (int r = 0; r < 16; ++r) { const int n = 32 * tb + crow(r, hi); p[tb][r] = fminf(p[tb][r], ((float)(nvis - n) - 0.5f) * INFINITY); mx = fmaxf(mx, p[tb][r]); }
        mx = fmaxf(mx, __shfl_xor(mx, 32));
        float sum = 0.f;
#pragma unroll
        for (int tb = 0; tb < 4; ++tb)
#pragma unroll
            for (int r = 0; r < 16; ++r) { p[tb][r] = exp2f(p[tb][r] - mx); sum += p[tb][r]; }
        sum += __shfl_xor(sum, 32);
        const float il = (nvis > 0) ? 1.f / sum : 0.f;
#pragma unroll
        for (int tb = 0; tb < 4; ++tb)
#pragma unroll
            for (int k = 0; k < 4; ++k) { const float a0 = p[tb][4 * k] * il, a1 = p[tb][4 * k + 1] * il, a2 = p[tb][4 * k + 2] * il, a3 = p[tb][4 * k + 3] * il;
                const int j = 2 * (4 * tb + k) + hi;
                const float gs = (a0 + a1) + (a2 + a3);
                if (r3 == 0) { IG[j] = gs; IL[j + 1] = a3; } else { IG[j] += gs; IL[j + 1] += a3; } }
        f32x16 o[2] = {f32x16{}, f32x16{}};
#pragma unroll
        for (int tb = 0; tb < 4; ++tb)
#pragma unroll
            for (int s2 = 0; s2 < 2; ++s2) {
                v4u a; a.x = cvtpk(p[tb][8 * s2 + 0], p[tb][8 * s2 + 1]); a.y = cvtpk(p[tb][8 * s2 + 2], p[tb][8 * s2 + 3]); a.z = cvtpk(p[tb][8 * s2 + 4], p[tb][8 * s2 + 5]); a.w = cvtpk(p[tb][8 * s2 + 6], p[tb][8 * s2 + 7]);
                const bf16x8 pf = __builtin_bit_cast(bf16x8, a);
                LAS const unsigned char* vbb = vb + (tb >> 1) * AT_BUF + ((tb & 1) * 2 + s2) * 1024;
#pragma unroll
                for (int dh = 0; dh < 2; ++dh) { const s16x4 lo = vtr(vbb + dh * 4096), hh = vtr(vbb + dh * 4096 + 512);
                    const bf16x8 vf = {lo[0], lo[1], lo[2], lo[3], hh[0], hh[1], hh[2], hh[3]};
                    o[dh] = __builtin_amdgcn_mfma_f32_32x32x16_bf16(vf, pf, o[dh], 0, 0, 0); }
                asm volatile("" ::: "memory");
            }
        bf16* op = (bf16*)(ws + WS_OCMP) + row * 384 + h * 64 + 4 * hi;
#pragma unroll
        for (int dh = 0; dh < 2; ++dh)
#pragma unroll
            for (int g4 = 0; g4 < 4; ++g4) { u32x2v w; w.x = cvtpk(o[dh][4 * g4] * il, o[dh][4 * g4 + 1] * il); w.y = cvtpk(o[dh][4 * g4 + 2] * il, o[dh][4 * g4 + 3] * il);
                *(u32x2v*)(op + dh * 32 + 8 * g4) = w; }
    }
    const int cur = qpos >> 6;
    LAS float* imp = IG;
#pragma unroll 1
    for (int jj = 0; jj < 16; ++jj) {
        const int j = 16 * hi + jj;
        float v = IG[j] + (j > 0 ? IL[j] : 0.f);
        if (j == 0 || j == cur || j == cur - 1) v = INFINITY;
        if (j * 64 > qpos) v = -INFINITY;
        IL[j] = v;
    }
#pragma unroll 1
    for (int jj = 0; jj < 16; ++jj) { const int j = 16 * hi + jj; imp[j] = IL[j]; }
    unsigned mask = 0;
#pragma unroll 1
    for (int jj = 0; jj < 16; ++jj) {
        const int j = 16 * hi + jj; const float v = imp[j]; int rank = 0;
#pragma unroll 4
        for (int k = 0; k < 32; ++k) { const float u2 = imp[k]; rank += (u2 > v || (u2 == v && k < j)) ? 1 : 0; }
        if (rank < 16) mask |= 1u << j;
    }
    mask |= (unsigned)__shfl_xor((int)mask, 32);
    if (hi == 0) ((unsigned*)(ws + WS_SEL))[(size_t)(b * 2 + g) * S_ + qpos] = mask;
    __syncthreads();
}
__device__ __forceinline__ void lora_rows(unsigned char* ws, int tid) {
    const int gw = blockIdx.x * NWAVES + (tid >> 6), ngw = gridDim.x * NWAVES, lane = tid & 63;
    bf16* kvl = (bf16*)(ws + WS_KVL); const bf16* ql = (const bf16*)(ws + WS_QL); float* ssql = (float*)(ws + WS_SSQL);
    for (int m = gw; m < T_; m += ngw) {
        const unsigned kv = *(const unsigned*)(kvl + (size_t)m * 128 + 2 * lane);
        const float k0 = __uint_as_float(kv << 16), k1 = __uint_as_float(kv & 0xffff0000u);
        const uint2 qv = *(const uint2*)(ql + (size_t)m * 256 + 4 * lane);
        const float q0 = __uint_as_float(qv.x << 16), q1 = __uint_as_float(qv.x & 0xffff0000u), q2 = __uint_as_float(qv.y << 16), q3 = __uint_as_float(qv.y & 0xffff0000u);
        const float sk = wave_sum(k0 * k0 + k1 * k1), sq = wave_sum((q0 * q0 + q1 * q1) + (q2 * q2 + q3 * q3));
        const float rk = rsqrtf(sk * (1.f / 128.f) + EPS);
        *(unsigned*)(kvl + (size_t)m * 128 + 2 * lane) = pk2(k0 * rk, k1 * rk);
        if (lane == 0) ssql[m] = sq;
    }
}
__device__ __forceinline__ void post_misc(unsigned char* ws, const float* big, const float* bfg, int tid) {
    const float* mr = (const float*)(ws + WS_MISCRAW); const float* cosM = (const float*)(ws + WS_COSM); const float* sinM = (const float*)(ws + WS_SINM);
    bf16* kr = (bf16*)(ws + WS_KR); float* gm = (float*)(ws + WS_GM);
    for (int idx = blockIdx.x * NTHR + tid; idx < T_ * 64; idx += gridDim.x * NTHR) {
        const int row = idx >> 6, c = idx & 63; const float* r = mr + (size_t)row * 64; const float v = r[c];
        if (c < 32) { const int i = c & 15; const float x1 = r[i], x2 = r[16 + i], cs = cosM[row * 16 + i], sn = sinM[row * 16 + i];
            kr[(size_t)row * 32 + c] = f2bf((c < 16) ? x1 * cs - x2 * sn : x1 * sn + x2 * cs); }
        else if (c < 50) gm[(size_t)row * 32 + (c - 32)] = 1.f / (1.f + __expf(-v));
        else if (c < 54) gm[(size_t)row * 32 + 18 + (c - 50)] = v + big[c - 50];
        else if (c < 58) { const float z = v + bfg[c - 54]; gm[(size_t)row * 32 + 22 + (c - 54)] = fminf(z, 0.f) - __logf(1.f + __expf(-fabsf(z))); }
    }
}

typedef float f32x4v __attribute__((ext_vector_type(4)));
__device__ __forceinline__ void compress_item(unsigned char* ws, LAS unsigned char* lds, const float* cmp_pos, int item, int wave_u) {
    const int lane = fresh_lane(), tid = wave_u * 64 + lane;
    const int nb = item & 7, g = (item >> 3) & 1, b = (item >> 4) & 7, kv = item >> 7;
    const bf16* tok = (const bf16*)(ws + WS_NSA) + (size_t)b * S_ * 1152 + (kv ? 512 : 384) + g * 64;
    const bf16* wt = (const bf16*)(ws + (kv ? WT_CV : WT_CK));
    const int nrow = nb * 16 + (lane & 15), kq = lane >> 4;
    f32x4v acc[4] = {f32x4v{}, f32x4v{}, f32x4v{}, f32x4v{}};
#pragma unroll 2
    for (int ks = 0; ks < 8; ++ks) {
        const int k = wave_u * 256 + ks * 32 + kq * 8, l = k >> 6, d = k & 63;
        int trow = 16 * nrow + l; trow = trow < S_ ? trow : S_ - 1;
        const v4u t4 = *(const v4u*)(tok + (size_t)trow * 1152 + d);
        const f32x4v p0 = *(const f32x4v*)(cmp_pos + k), p1 = *(const f32x4v*)(cmp_pos + k + 4);
        v4u a4;
        a4.x = cvtpk(__uint_as_float(t4.x << 16) + p0[0], __uint_as_float(t4.x & 0xffff0000u) + p0[1]); a4.y = cvtpk(__uint_as_float(t4.y << 16) + p0[2], __uint_as_float(t4.y & 0xffff0000u) + p0[3]);
        a4.z = cvtpk(__uint_as_float(t4.z << 16) + p1[0], __uint_as_float(t4.z & 0xffff0000u) + p1[1]); a4.w = cvtpk(__uint_as_float(t4.w << 16) + p1[2], __uint_as_float(t4.w & 0xffff0000u) + p1[3]);
        const bf16x8 af = __builtin_bit_cast(bf16x8, a4);
#pragma unroll
        for (int cb = 0; cb < 4; ++cb) { const bf16x8 bfr = *(const bf16x8*)(wt + (size_t)(cb * 16 + (lane & 15)) * 2048 + k);
            acc[cb] = __builtin_amdgcn_mfma_f32_16x16x32_bf16(af, bfr, acc[cb], 0, 0, 0); }
    }
    LAS float* red = (LAS float*)lds + wave_u * 1024;
#pragma unroll
    for (int cb = 0; cb < 4; ++cb)
#pragma unroll
        for (int r = 0; r < 4; ++r) red[(4 * (lane >> 4) + r) * 64 + cb * 16 + (lane & 15)] = acc[cb][r];
    __syncthreads();
    bf16* out = (bf16*)(ws + WS_KCV) + (size_t)kv * (8 * 2 * 128 * 64) + ((size_t)(b * 2 + g) * 128 + nb * 16) * 64;
    for (int o = tid; o < 1024; o += NTHR) { float sum = 0.f;
#pragma unroll
        for (int w8 = 0; w8 < 8; ++w8) sum += ((LAS float*)lds)[w8 * 1024 + o];
        out[o] = f2bf(sum); }
    __syncthreads();
}
__device__ __forceinline__ void mlocal_item(unsigned char* ws, LAS unsigned char* lds, const float* convw, const float* convb, const float* big, const float* bfg, int chunk, int wave_u) {
    const int lane = fresh_lane(), tid = wave_u * 64 + lane;
    const int c = chunk & 31, h = (chunk >> 5) & 3, b = chunk >> 7, row0 = b * S_ + c * 64;
    LAS float* XS = (LAS float*)lds;
    LAS float* KS = XS + 64 * 65;
    LAS float* VS = KS + 64 * 65;
    LAS float* WQ = VS + 64 * 65;
    LAS float* WK = WQ + 64 * 65;
    LAS float* wl = WK + 64 * 65;
    LAS float* bs = wl + 64;
    const bf16* cm = (const bf16*)(ws + WS_CM);
    {
        const int l = tid >> 3, ch0 = (tid & 7) * 8, row = row0 + l, s = c * 64 + l;
        float a[8];
#pragma unroll
        for (int i = 0; i < 8; ++i) a[i] = convb[h * 64 + ch0 + i];
#pragma unroll
        for (int j = 0; j < 4; ++j) { if (s - 3 + j >= 0) { const v4u x4 = *(const v4u*)(cm + (size_t)(row - 3 + j) * 768 + h * 64 + ch0);
            const float* cw = convw + j * 256 + h * 64 + ch0;
            a[0] += cw[0] * __uint_as_float(x4.x << 16); a[1] += cw[1] * __uint_as_float(x4.x & 0xffff0000u); a[2] += cw[2] * __uint_as_float(x4.y << 16); a[3] += cw[3] * __uint_as_float(x4.y & 0xffff0000u);
            a[4] += cw[4] * __uint_as_float(x4.z << 16); a[5] += cw[5] * __uint_as_float(x4.z & 0xffff0000u); a[6] += cw[6] * __uint_as_float(x4.w << 16); a[7] += cw[7] * __uint_as_float(x4.w & 0xffff0000u); } }
        v4u o4; float r[8];
#pragma unroll
        for (int i = 0; i < 8; ++i) r[i] = a[i] / (1.f + __expf(-a[i]));
        o4.x = cvtpk(r[0], r[1]); o4.y = cvtpk(r[2], r[3]); o4.z = cvtpk(r[4], r[5]); o4.w = cvtpk(r[6], r[7]);
        *(v4u*)((bf16*)(ws + WS_XC) + (size_t)row * 256 + h * 64 + ch0) = o4;
        XS[l * 65 + ch0 + 0] = __uint_as_float(o4.x << 16); XS[l * 65 + ch0 + 1] = __uint_as_float(o4.x & 0xffff0000u); XS[l * 65 + ch0 + 2] = __uint_as_float(o4.y << 16); XS[l * 65 + ch0 + 3] = __uint_as_float(o4.y & 0xffff0000u);
        XS[l * 65 + ch0 + 4] = __uint_as_float(o4.z << 16); XS[l * 65 + ch0 + 5] = __uint_as_float(o4.z & 0xffff0000u); XS[l * 65 + ch0 + 6] = __uint_as_float(o4.w << 16); XS[l * 65 + ch0 + 7] = __uint_as_float(o4.w & 0xffff0000u);
        const v4u v4 = *(const v4u*)(cm + (size_t)row * 768 + 256 + h * 64 + ch0);
        VS[l * 65 + ch0 + 0] = __uint_as_float(v4.x << 16); VS[l * 65 + ch0 + 1] = __uint_as_float(v4.x & 0xffff0000u); VS[l * 65 + ch0 + 2] = __uint_as_float(v4.y << 16); VS[l * 65 + ch0 + 3] = __uint_as_float(v4.y & 0xffff0000u);
        VS[l * 65 + ch0 + 4] = __uint_as_float(v4.z << 16); VS[l * 65 + ch0 + 5] = __uint_as_float(v4.z & 0xffff0000u); VS[l * 65 + ch0 + 6] = __uint_as_float(v4.w << 16); VS[l * 65 + ch0 + 7] = __uint_as_float(v4.w & 0xffff0000u);
    }
    {
        const bf16* wq = (const bf16*)(ws + WT_QM) + h * 4096; const bf16* wk = (const bf16*)(ws + WT_KM) + h * 4096;
        for (int i = tid; i < 4096; i += NTHR) { const int e = i >> 6, d = i & 63; WQ[d * 65 + e] = bf2f(wq[i]); WK[d * 65 + e] = bf2f(wk[i]); }
    }
    if (wave_u == 0) {
        const float* mr = (const float*)(ws + WS_MISCRAW) + (size_t)(row0 + lane) * 64;
        const float z = mr[54 + h] + bfg[h]; float lf = fminf(z, 0.f) - __logf(1.f + __expf(-fabsf(z)));
        const float ig = mr[50 + h] + big[h];
#pragma unroll
        for (int o = 1; o < 64; o <<= 1) { const float t = __shfl_up(lf, o); if (lane >= o) lf += t; }
        const float bL = __shfl(lf, 63);
        const float a = bL - lf + ig; float mx = a;
#pragma unroll
        for (int o = 1; o < 64; o <<= 1) mx = fmaxf(mx, __shfl_xor(mx, o));
        wl[lane] = __expf(a - mx); bs[lane] = lf;
        if (lane == 0) { ((float*)(ws + WS_ML))[chunk] = mx; ((float*)(ws + WS_BL))[chunk] = bL; }
    }
    __syncthreads();
    {
        const int l = tid >> 3, e0 = (tid & 7) * 8, row = row0 + l;
        float aq[8], ak[8];
#pragma unroll
        for (int i = 0; i < 8; ++i) { aq[i] = 0.f; ak[i] = 0.f; }
        for (int d = 0; d < 64; ++d) { const float x = XS[l * 65 + d];
#pragma unroll
            for (int i = 0; i < 8; ++i) { aq[i] += x * WQ[d * 65 + e0 + i]; ak[i] += x * WK[d * 65 + e0 + i]; } }
        v4u q4, k4; float kr[8];
        q4.x = cvtpk(aq[0] * 0.125f, aq[1] * 0.125f); q4.y = cvtpk(aq[2] * 0.125f, aq[3] * 0.125f); q4.z = cvtpk(aq[4] * 0.125f, aq[5] * 0.125f); q4.w = cvtpk(aq[6] * 0.125f, aq[7] * 0.125f);
        k4.x = cvtpk(ak[0], ak[1]); k4.y = cvtpk(ak[2], ak[3]); k4.z = cvtpk(ak[4], ak[5]); k4.w = cvtpk(ak[6], ak[7]);
        *(v4u*)((bf16*)(ws + WS_MQ) + (size_t)row * 256 + h * 64 + e0) = q4; *(v4u*)((bf16*)(ws + WS_MK) + (size_t)row * 256 + h * 64 + e0) = k4;
        kr[0] = __uint_as_float(k4.x << 16); kr[1] = __uint_as_float(k4.x & 0xffff0000u); kr[2] = __uint_as_float(k4.y << 16); kr[3] = __uint_as_float(k4.y & 0xffff0000u);
        kr[4] = __uint_as_float(k4.z << 16); kr[5] = __uint_as_float(k4.z & 0xffff0000u); kr[6] = __uint_as_float(k4.w << 16); kr[7] = __uint_as_float(k4.w & 0xffff0000u);
        const float w = wl[l];
#pragma unroll
        for (int i = 0; i < 8; ++i) KS[l * 65 + e0 + i] = kr[i] * w;
    }
    __syncthreads();
    {
        const int d = tid & 63, e0 = (tid >> 6) * 8;
        float C[8]; float n = 0.f;
#pragma unroll
        for (int i = 0; i < 8; ++i) C[i] = 0.f;
        for (int l = 0; l < 64; ++l) { const float kk = KS[l * 65 + d]; n += kk;
#pragma unroll
            for (int i = 0; i < 8; ++i) C[i] += kk * VS[l * 65 + e0 + i]; }
        float* ct = (float*)(ws + WS_CT) + (size_t)chunk * 4096;
#pragma unroll
        for (int i = 0; i < 8; ++i) ct[(e0 + i) * 64 + d] = C[i];
        if (e0 == 0) ((float*)(ws + WS_NL))[chunk * 64 + d] = n;
    }
    __syncthreads();
}
__device__ __forceinline__ void mscan_item(unsigned char* ws, int item, int wave_u) {
    const int tid = wave_u * 64 + fresh_lane();
    const int bh = item / 9, part = item % 9;
    if (part == 8 && tid >= 64) return;
    float* base; size_t stride;
    if (part < 8) { base = (float*)(ws + WS_CT) + (size_t)bh * 32 * 4096 + part * 512 + tid; stride = 4096; } else { base = (float*)(ws + WS_NL) + (size_t)bh * 32 * 64 + tid; stride = 64; }
    const float* ML = (const float*)(ws + WS_ML); const float* BL = (const float*)(ws + WS_BL); float* MPv = (float*)(ws + WS_MP);
    float Cv = 0.f, m = 0.f;
    for (int c = 0; c < 32; ++c) {
        const float cl = base[(size_t)c * stride], ml = ML[bh * 32 + c], bl = BL[bh * 32 + c];
        base[(size_t)c * stride] = Cv;
        if (part == 8 && tid == 0) MPv[bh * 32 + c] = m;
        const float mn = fmaxf(bl + m, ml);
        Cv = __expf(bl + m - mn) * Cv + __expf(ml - mn) * cl; m = mn;
    }
}
__device__ __forceinline__ void mout_item(unsigned char* ws, LAS unsigned char* lds, const float* gmh, const float* skip, int chunk, int wave_u) {
    const int lane = fresh_lane(), tid = wave_u * 64 + lane;
    const int c = chunk & 31, h = (chunk >> 5) & 3, b = chunk >> 7, row0 = b * S_ + c * 64;
    LAS float* QS = (LAS float*)lds; LAS float* KS = QS + 64 * 65; LAS float* VS = KS + 64 * 65; LAS float* CS = VS + 64 * 65;
    LAS float* bs = CS + 64 * 65; LAS float* us = bs + 64; LAS float* ns = us + 64; LAS float* cus = ns + 64;
    const float* gm = (const float*)(ws + WS_GM);
    {
        const int l = tid >> 3, c0 = (tid & 7) * 8, row = row0 + l;
        const v4u q4 = *(const v4u*)((const bf16*)(ws + WS_MQ) + (size_t)row * 256 + h * 64 + c0), k4 = *(const v4u*)((const bf16*)(ws + WS_MK) + (size_t)row * 256 + h * 64 + c0),
                  v4 = *(const v4u*)((const bf16*)(ws + WS_CM) + (size_t)row * 768 + 256 + h * 64 + c0);
#define UNP(dst, src) dst[0] = __uint_as_float(src.x << 16); dst[1] = __uint_as_float(src.x & 0xffff0000u); dst[2] = __uint_as_float(src.y << 16); dst[3] = __uint_as_float(src.y & 0xffff0000u); \
        dst[4] = __uint_as_float(src.z << 16); dst[5] = __uint_as_float(src.z & 0xffff0000u); dst[6] = __uint_as_float(src.w << 16); dst[7] = __uint_as_float(src.w & 0xffff0000u);
        float t8[8];
        UNP(t8, q4)
#pragma unroll
        for (int i = 0; i < 8; ++i) QS[l * 65 + c0 + i] = t8[i];
        UNP(t8, k4)
#pragma unroll
        for (int i = 0; i < 8; ++i) KS[l * 65 + c0 + i] = t8[i];
        UNP(t8, v4)
#pragma unroll
        for (int i = 0; i < 8; ++i) VS[l * 65 + c0 + i] = t8[i];
        const float* ct = (const float*)(ws + WS_CT) + (size_t)chunk * 4096 + l * 64 + c0;
#pragma unroll
        for (int i = 0; i < 8; ++i) CS[l * 65 + c0 + i] = ct[i];
    }
    if (wave_u == 0) {
        const float lf0 = gm[(size_t)(row0 + lane) * 32 + 22 + h], ig = gm[(size_t)(row0 + lane) * 32 + 18 + h]; float lf = lf0;
#pragma unroll
        for (int o = 1; o < 64; o <<= 1) { const float t = __shfl_up(lf, o); if (lane >= o) lf += t; }
        float u = ig - lf, cu = u;
#pragma unroll
        for (int o = 1; o < 64; o <<= 1) { const float t = __shfl_up(cu, o); if (lane >= o) cu = fmaxf(cu, t); }
        bs[lane] = lf; us[lane] = u; cus[lane] = cu; ns[lane] = ((const float*)(ws + WS_NL))[chunk * 64 + lane];
    }
    __syncthreads();
    const int l = tid >> 3, e0 = (tid & 7) * 8, row = row0 + l;
    const float mprev = ((const float*)(ws + WS_MP))[chunk];
    const float mt = bs[l] + fmaxf(mprev, cus[l]), inter = __expf(bs[l] + mprev - mt);
    float num[8]; float qn = 0.f;
#pragma unroll
    for (int i = 0; i < 8; ++i) num[i] = 0.f;
    for (int d = 0; d < 64; ++d) { const float qd = QS[l * 65 + d]; qn += qd * ns[d];
#pragma unroll
        for (int i = 0; i < 8; ++i) num[i] += qd * CS[(e0 + i) * 65 + d]; }
#pragma unroll
    for (int i = 0; i < 8; ++i) num[i] *= inter;
    float den = inter * qn;
    float q8[8];
#pragma unroll
    for (int i = 0; i < 8; ++i) q8[i] = QS[l * 65 + e0 + i];
    for (int s2 = 0; s2 <= l; ++s2) {
        float sd = 0.f;
#pragma unroll
        for (int i = 0; i < 8; ++i) sd += q8[i] * KS[s2 * 65 + e0 + i];
        sd += __shfl_xor(sd, 1); sd += __shfl_xor(sd, 2); sd += __shfl_xor(sd, 4);
        const float sw = sd * __expf(bs[l] + us[s2] - mt); den += sw;
#pragma unroll
        for (int i = 0; i < 8; ++i) num[i] += sw * VS[s2 * 65 + e0 + i];
    }
    const float dn = 1.f / fmaxf(fabsf(den), __expf(-mt));
    const v4u o4 = *(const v4u*)((const bf16*)(ws + WS_CM) + (size_t)row * 768 + 512 + h * 64 + e0), x4 = *(const v4u*)((const bf16*)(ws + WS_XC) + (size_t)row * 256 + h * 64 + e0);
    float og[8], xv[8]; UNP(og, o4) UNP(xv, x4)
#undef UNP
    float mu = 0.f;
#pragma unroll
    for (int i = 0; i < 8; ++i) { num[i] = num[i] * dn / (1.f + __expf(-og[i])); mu += num[i]; }
    mu += __shfl_xor(mu, 1); mu += __shfl_xor(mu, 2); mu += __shfl_xor(mu, 4); mu *= (1.f / 64.f);
    float var = 0.f;
#pragma unroll
    for (int i = 0; i < 8; ++i) { const float dl = num[i] - mu; var += dl * dl; }
    var += __shfl_xor(var, 1); var += __shfl_xor(var, 2); var += __shfl_xor(var, 4);
    const float rs = rsqrtf(var * (1.f / 64.f) + EPS);
    float r[8];
#pragma unroll
    for (int i = 0; i < 8; ++i) r[i] = (num[i] - mu) * rs * gmh[h * 64 + e0 + i] + skip[h * 64 + e0 + i] * xv[i];
    v4u w4; w4.x = cvtpk(r[0], r[1]); w4.y = cvtpk(r[2], r[3]); w4.z = cvtpk(r[4], r[5]); w4.w = cvtpk(r[6], r[7]);
    *(v4u*)((bf16*)(ws + WS_HB) + (size_t)row * D_ + 768 + h * 64 + e0) = w4;
    __syncthreads();
}

__global__ void __launch_bounds__(NTHR, 2) mega(MP p_unused) {
    extern __shared__ __attribute__((aligned(16))) unsigned char lds_raw[];
    LAS unsigned char* lds = (LAS unsigned char*)lds_raw;
    const int wave0 = __builtin_amdgcn_readfirstlane((int)threadIdx.x >> 6);
    const int tid0 = wave0 * 64 + fresh_lane();
    volatile LAS unsigned* MISC = (volatile LAS unsigned*)(lds + MISC_OFF);
    for (int u = tid0; u < (LDS_BYTES - RING_BYTES) / 4; u += NTHR) ((LAS unsigned*)(lds + RING_BYTES))[u] = 0u;
    __syncthreads();
    typedef const __attribute__((address_space(4))) MP* kmp_t;
    kmp_t kp0 = (kmp_t)__builtin_amdgcn_kernarg_segment_ptr();
    unsigned char* ws0 = kp0->ws; const int coop = kp0->coop, ph_lo = kp0->ph_lo, ph_hi = kp0->ph_hi;
    XcdBarrier bar; bar.bar = (unsigned*)(ws0 + WS_CTL) + CW_BAR; bar.x = 0; bar.st = nullptr;
    if (coop) bar = xcd_barrier_post((unsigned*)(ws0 + WS_CTL) + CW_BAR, MISC + 8, tid0);
    if (coop == 2) cooperative_groups::this_grid().sync();
    int ph = ph_lo;
    if (ph == 0) {
        const MPK p{kp0}; ph_p0(p, lds, wave0 * 64 + fresh_lane()); ph = 1;
        if (ph < ph_hi) xcd_barrier(bar, wave0 * 64 + fresh_lane());
    }
    for (; ph < ph_hi; ++ph) {
        kmp_t kp = kp0; asm volatile("" : "+s"(kp));
        const MPK p{kp}; unsigned char* ws = kp->ws;
#define TID_ (wave0 * 64 + fresh_lane())
#define GW_ (blockIdx.x * NWAVES + wave0)
#define NGW_ (gridDim.x * NWAVES)
        const int l = (ph - 1) / PPL, ty = (ph == 0) ? -1 : (ph == NPH - 1) ? -2 : (ph - 1) % PPL;
        const float* modl = (const float*)(ws + WS_MOD) + (size_t)l * 8 * 6144;
        if (ty == -2) norm_rows(p.k->out, PIN(I_GFIN), nullptr, nullptr, nullptr, p.k->out, 2, GW_, NGW_, fresh_lane());
        else if (ty == 0 && (PHM & 2)) ph_prep(p, l, lds, TID_);
        else if (ty == 1 && (PHM & 4)) {
            pg8::Gemm g{(const bf16*)(ws + WS_HB), (const bf16*)(ws + WT_IN), T_, 2560, D_}; pg8::StaticOrder S; S.init(T_, 2560, gridDim.x, blockIdx.x);
            pg8::EpiIn E{ws, PIN(I_BIG) + l * 4, PIN(I_BFG) + l * 4};
            pg8::gemm_phase<pg8::EpiIn, pg8::StaticOrder, true, true>(lds, g, S, E, wave0);
        }
        else if (ty == 2 && (PHM & 64)) {
            lora_rows(ws, TID_);
            post_misc(ws, PIN(I_BIG) + l * 4, PIN(I_BFG) + l * 4, TID_);
            unsigned* ctr = (unsigned*)(ws + WS_CTL) + 64 * (1 + ph);
            for (;;) { const int it = next_item(ctr, lds, wave0); if (it >= 1024 + 256) break;
                if (it < 1024) mlocal_item(ws, lds, PIN(I_CONVW) + l * 1024, PIN(I_CONVB) + l * 256, PIN(I_BIG) + l * 4, PIN(I_BFG) + l * 4, it, wave0);
                else compress_item(ws, lds, PIN(I_CMPPOS) + l * 2048, it - 1024, wave0); }
        }
        else if (ty == 3 && (PHM & 64)) {
            pg8::Gemm g{(const bf16*)(ws + WS_KVL), (const bf16*)(ws + WT_UKV), T_, 768, 128}; pg8::StaticOrder S; S.init(T_, 768, gridDim.x, blockIdx.x);
            pg8::EpiUKV E{(bf16*)(ws + WS_KVM)}; pg8::gemm_phase<pg8::EpiUKV, pg8::StaticOrder, true, true>(lds, g, S, E, wave0);
        }
        else if (ty == 4 && (PHM & 128)) {
            unsigned* ctr = (unsigned*)(ws + WS_CTL) + 64 * (1 + ph);
            for (;;) { const int it = next_item(ctr, lds, wave0); if (it >= 384 + 128 + 288) break;
                if (it < 384) mla_unit(ws, lds, (it % 48) / 6, (it % 48) % 6, 7 - it / 48, wave0);
                else if (it < 512) { const int u = it - 384; cmp_unit(ws, lds, u >> 4, (u >> 3) & 1, u & 7, wave0); }
                else mscan_item(ws, it - 512, wave0); }
        }
        else if (ty == 5 && (PHM & 256)) {
            unsigned* ctr = (unsigned*)(ws + WS_CTL) + 64 * (1 + ph);
            for (;;) { const int u = next_item(ctr, lds, wave0); if (u >= 384 + 1024) break;
                if (u < 384) nsa_unit(ws, lds, (u % 48) / 6, (u % 48) % 6, 7 - u / 48, wave0);
                else mout_item(ws, lds, PIN(I_GMH) + l * 256, PIN(I_SKIP) + l * 256, u - 384, wave0); }
        }
        else if (ty == 6) ph_mixnorm(p, l, TID_);
        else if (ty == 7 && (PHM & 8)) {
            pg8::Gemm g{(const bf16*)(ws + WS_HB), (const bf16*)(ws + WT_OUT), T_, D_, D_}; pg8::StaticOrder S; S.init(T_, D_, gridDim.x, blockIdx.x);
            pg8::EpiRes E{(l == 0) ? PIN(I_X) : p.k->out, p.k->out, modl + 2048};
            pg8::gemm_phase<pg8::EpiRes, pg8::StaticOrder, true, true>(lds, g, S, E, wave0);
        }
        else if (ty == 8) norm_rows(p.k->out, PIN(I_GN2) + l * D_, modl + 3072, modl + 4096, (bf16*)(ws + WS_HB), nullptr, 1, GW_, NGW_, fresh_lane());
        else if (ty == 9 && (PHM & 16)) {
            pg8::Gemm g{(const bf16*)(ws + WS_HB), (const bf16*)(ws + WT_GU), T_, 2 * FF, D_}; pg8::StaticOrder S; S.init(T_, 2 * FF, gridDim.x, blockIdx.x);
            pg8::EpiGU E{(bf16*)(ws + WS_ACT)};
            pg8::gemm_phase<pg8::EpiGU, pg8::StaticOrder, true, true>(lds, g, S, E, wave0);
        }
        else if (ty == 10 && (PHM & 32)) {
            pg8::Gemm g{(const bf16*)(ws + WS_ACT), (const bf16*)(ws + WT_DOWN), T_, D_, FF}; pg8::StaticOrder S; S.init(T_, D_, gridDim.x, blockIdx.x);
            pg8::EpiRes E{p.k->out, p.k->out, modl + 5120};
            pg8::gemm_phase<pg8::EpiRes, pg8::StaticOrder, true, true>(lds, g, S, E, wave0);
        }
        if (ph + 1 < ph_hi) xcd_barrier(bar, wave0 * 64 + fresh_lane());
    }
}

__global__ void k_post_misc(const float* mr, const float* cosM, const float* sinM, const float* big, const float* bfg, bf16* km, float* gm) {
    const int idx = blockIdx.x * blockDim.x + threadIdx.x;
    if (idx >= T_ * 64) return;
    const int row = idx >> 6, c = idx & 63; const float* r = mr + (size_t)row * 64; const float v = r[c];
    if (c < 32) { const int i = c & 15; const float x1 = r[i], x2 = r[16 + i], cs = cosM[row * 16 + i], sn = sinM[row * 16 + i];
        const bf16 o = f2bf((c < 16) ? x1 * cs - x2 * sn : x1 * sn + x2 * cs);
        for (int h = 0; h < 6; ++h) km[(size_t)row * 576 + h * 96 + 64 + c] = o; }
    else if (c < 50) gm[(size_t)row * 32 + (c - 32)] = sigmoidf_(v);
    else if (c < 54) gm[(size_t)row * 32 + 18 + (c - 50)] = v + big[c - 50];
    else if (c < 58) { const float z = v + bfg[c - 54]; gm[(size_t)row * 32 + 22 + (c - 54)] = fminf(z, 0.f) - log1pf(__expf(-fabsf(z))); }
}
static void run_mega(const MP& base, int lo, int hi, hipStream_t stream) {
    for (int ph = lo; ph < hi; ++ph) { MP a = base; a.ph_lo = ph; a.ph_hi = ph + 1; a.coop = 0; hipLaunchKernelGGL(mega, dim3(256), dim3(NTHR), LDS_BYTES, stream, a); }
}
extern "C" void kernel_launch(void* const* d_in, const int* in_sizes, int n_in, void* d_out, int out_size, void* d_ws, size_t ws_size, hipStream_t stream) {
    if (n_in != N_IN || ws_size < WS_END) { fprintf(stderr, "kernel_launch: unexpected n_in %d / ws %zu\n", n_in, ws_size); return; }
    static int inited = 0;
    if (!inited) { if (hipFuncSetAttribute((const void*)mega, hipFuncAttributeMaxDynamicSharedMemorySize, LDS_BYTES) != hipSuccess) fprintf(stderr, "hipFuncSetAttribute failed\n"); inited = 1; }
    const float* in[N_IN]; for (int i = 0; i < N_IN; ++i) in[i] = (const float*)d_in[i];
    unsigned char* ws = (unsigned char*)d_ws; float* X = (float*)d_out;
    MP base{}; for (int i = 0; i < N_IN; ++i) base.in[i] = in[i]; base.out = X; base.ws = ws;
    float *cosM = (float*)(ws + WS_COSM), *sinM = (float*)(ws + WS_SINM);
    float *ssql = (float*)(ws + WS_SSQL), *sskv = (float*)(ws + WS_SSKV), *ML = (float*)(ws + WS_ML), *BL = (float*)(ws + WS_BL), *MPv = (float*)(ws + WS_MP), *NL = (float*)(ws + WS_NL);
    bf16* HB = (bf16*)(ws + WS_HB);
    bf16 *nsa = (bf16*)(ws + WS_NSA), *kvl = (bf16*)(ws + WS_KVL), *ql = (bf16*)(ws + WS_QL), *cm = (bf16*)(ws + WS_CM), *km = (bf16*)(ws + WS_KM), *qm = (bf16*)(ws + WS_QM), *vm = (bf16*)(ws + WS_VM);
    float* gm = (float*)(ws + WS_GM); bf16* kcv = (bf16*)(ws + WS_KCV); bf16* ocmp = (bf16*)(ws + WS_OCMP); unsigned* sel = (unsigned*)(ws + WS_SEL);
    bf16 *xc = (bf16*)(ws + WS_XC), *mq = (bf16*)(ws + WS_MQ), *mk = (bf16*)(ws + WS_MK); float* CT = (float*)(ws + WS_CT);
    float* raw = (float*)(ws + 246 * MiB);
    (void)hipMemsetAsync(ws + WS_CTL, 0, CTL_ZERO_BYTES, stream);
#if defined(MK_MULTI_LAUNCH)
    run_mega(base, 0, NPH, stream);
#else
    static int grid = 0;
    if (!grid) {
        int dev = 0, cus = 0, per_cu = 0;
        (void)hipGetDevice(&dev); (void)hipDeviceGetAttribute(&cus, hipDeviceAttributeMultiprocessorCount, dev);
        if (hipOccupancyMaxActiveBlocksPerMultiprocessor(&per_cu, (const void*)mega, NTHR, LDS_BYTES) != hipSuccess || per_cu < 1) { fprintf(stderr, "kernel_launch: occupancy query says %d blocks per CU\n", per_cu); per_cu = 1; }
        (void)hipGetLastError();
        grid = cus;
    }
    MP a = base; a.ph_lo = 0; a.ph_hi = NPH; a.coop = 1;
    void* args[] = {&a};
    const hipError_t e = hipLaunchCooperativeKernel((const void*)mega, dim3(grid), dim3(NTHR), args, LDS_BYTES, stream);
    if (e != hipSuccess) fprintf(stderr, "kernel_launch: cooperative launch failed: %s (grid %d)\n", hipGetErrorString(e), grid);
#endif
}
```

```cpp
#include <hip/hip_runtime.h>
#include <cstdint>
#include <cstdio>
#include <hip/hip_cooperative_groups.h>

constexpr int B_ = 8, S_ = 2048, T_ = B_ * S_, D_ = 1024, DIN = 2362, FF = 2816, DEPTH = 2;
constexpr float EPS = 1e-6f;
constexpr float LOG2E = 1.4426950408889634f;
constexpr float QSCALE = 0.125f * LOG2E;
constexpr float MSCALE = 0.10206207261596577f * LOG2E;
enum { I_X = 0, I_C, I_POS, I_GN1, I_GN2, I_WADA, I_BADA, I_WIN, I_CMPPOS, I_WCK, I_WCV, I_GOA, I_GQL, I_WUQ, I_GKVL, I_WUKV, I_GOB,
       I_CONVW, I_CONVB, I_WQM, I_WKM, I_BIG, I_BFG, I_GMH, I_SKIP, I_WOUT, I_WGU, I_WDOWN, I_GFIN, N_IN };

constexpr size_t MiB = 1u << 20;
constexpr size_t WS_CTL = 0;
constexpr size_t WS_MOD = 1 * MiB;
constexpr size_t WS_COSP = WS_MOD + 512 * 1024;
constexpr size_t WS_SINP = WS_COSP + 512 * 1024;
constexpr size_t WS_COSM = WS_SINP + 512 * 1024;
constexpr size_t WS_SINM = WS_COSM + 1 * MiB;
constexpr size_t WS_SSQL = WS_SINM + 1 * MiB;
constexpr size_t WS_SSKV = WS_SSQL + 64 * 1024;
constexpr size_t WS_ML = WS_SSKV + 64 * 1024;
constexpr size_t WS_BL = WS_ML + 4096;
constexpr size_t WS_MP = WS_BL + 4096;
constexpr size_t WS_NL = WS_MP + 4096;
constexpr size_t WS_WT = 8 * MiB;
constexpr size_t WS_RAW = WS_WT;
constexpr size_t WS_OSLC = WS_WT + 10 * MiB;
constexpr size_t WS_HB = 34 * MiB;
constexpr size_t WS_NSA = 66 * MiB;
constexpr size_t WS_KVL = 102 * MiB;
constexpr size_t WS_QL = 106 * MiB;
constexpr size_t WS_CM = 114 * MiB;
constexpr size_t WS_GM = 138 * MiB;
constexpr size_t WS_KM = 140 * MiB;
constexpr size_t WS_QM = 158 * MiB;
constexpr size_t WS_VM = 176 * MiB;
constexpr size_t WS_KCV = 188 * MiB;
constexpr size_t WS_OCMP = 189 * MiB;
constexpr size_t WS_SEL = 201 * MiB;
constexpr size_t WS_XC = 202 * MiB;
constexpr size_t WS_MQ = 210 * MiB;
constexpr size_t WS_MK = 218 * MiB;
constexpr size_t WS_CT = 226 * MiB;
constexpr size_t WS_MISCRAW = 242 * MiB;
constexpr size_t WS_KVM = 140 * MiB;
constexpr size_t WS_KR = 164 * MiB;
constexpr size_t WS_ACT = 66 * MiB;
constexpr size_t WS_END = 256 * MiB;
static_assert(WS_NL + 1024 * 64 * 4 <= WS_WT, "tab");
static_assert(WS_ACT + (size_t)T_ * FF * 2 <= WS_KCV, "act overlay");

typedef unsigned short bf16;
__device__ __forceinline__ float bf2f(bf16 v) { return __uint_as_float(((unsigned)v) << 16); }
__device__ __forceinline__ bf16 f2bf(float f) { unsigned u = __float_as_uint(f); return (bf16)((u + 0x7fffu + ((u >> 16) & 1u)) >> 16); }
__device__ __forceinline__ float sigmoidf_(float x) { return 1.f / (1.f + __expf(-x)); }
__device__ __forceinline__ float siluf_(float x) { return x / (1.f + __expf(-x)); }
__device__ __forceinline__ float wave_sum(float v) {
#pragma unroll
    for (int o = 1; o < 64; o <<= 1) v += __shfl_xor(v, o);
    return v;
}

__global__ void __launch_bounds__(512) k_ada(const float* c, const float* w_ada, const float* b_ada, float* mod) {
    __shared__ float ca[8 * 1024];
    __shared__ float red[8 * 8 * 64];
    const int tid = threadIdx.x, wave = tid >> 6, lane = tid & 63;
    for (int i = tid; i < 8192; i += 512) ca[i] = siluf_(c[i]);
    __syncthreads();
    for (int item = blockIdx.x; item < 192; item += gridDim.x) {
        const int l = item / 96, j = (item % 96) * 64 + lane;
        const float* w = w_ada + (size_t)l * 1024 * 6144 + j;
        float acc[8];
#pragma unroll
        for (int b = 0; b < 8; ++b) acc[b] = 0.f;
        for (int k = wave * 128; k < wave * 128 + 128; ++k) {
            const float wv = w[(size_t)k * 6144];
#pragma unroll
            for (int b = 0; b < 8; ++b) acc[b] += ca[b * 1024 + k] * wv;
        }
#pragma unroll
        for (int b = 0; b < 8; ++b) red[(wave * 8 + b) * 64 + lane] = acc[b];
        __syncthreads();
        {
            const int b = tid >> 6; float s = 0.f;
#pragma unroll
            for (int w8 = 0; w8 < 8; ++w8) s += red[(w8 * 8 + b) * 64 + lane];
            mod[((size_t)l * 8 + b) * 6144 + j] = s + b_ada[l * 6144 + j];
        }
        __syncthreads();
    }
}
__global__ void k_rope(const int* pos, float* cosP, float* sinP, float* cosM, float* sinM) {
    const int i = blockIdx.x * blockDim.x + threadIdx.x;
    if (i >= T_ * 24) return;
    const int m = i / 24, f = i % 24;
    double inv; if (f < 8) inv = pow(500000.0, -(double)(2 * f) / 16.0); else inv = pow(500000.0, -(double)(2 * (f - 8)) / 32.0);
    const float ang = (float)pos[m] * (float)inv;
    const double a = (double)ang, kq = rint(a * 0.15915494309189535), r = a - kq * 6.283185307179586476925;
    const float cs = (float)cos(r), sn = (float)sin(r);
    if (f < 8) { cosP[m * 8 + f] = cs; sinP[m * 8 + f] = sn; } else { cosM[m * 16 + f - 8] = cs; sinM[m * 16 + f - 8] = sn; }
}
__global__ void __launch_bounds__(512) k_norm(const float* x, const float* g, const float* shift, const float* scale, bf16* hb, float* outf, int mode) {
    const int gw = blockIdx.x * 8 + (threadIdx.x >> 6), ngw = gridDim.x * 8, lane = threadIdx.x & 63;
    for (int m = gw; m < T_; m += ngw) {
        const float4* xr = (const float4*)(x + (size_t)m * D_) + lane;
        float4 v[4]; float s = 0.f;
#pragma unroll
        for (int j = 0; j < 4; ++j) { v[j] = xr[64 * j]; s += v[j].x * v[j].x + v[j].y * v[j].y + v[j].z * v[j].z + v[j].w * v[j].w; }
        const float rstd = rsqrtf(wave_sum(s) * (1.f / D_) + EPS);
        const int b = m / S_;
#pragma unroll
        for (int j = 0; j < 4; ++j) {
            const int col = 4 * lane + 256 * j;
            const float4 gg = *(const float4*)(g + col);
            float4 o; o.x = v[j].x * rstd * gg.x; o.y = v[j].y * rstd * gg.y; o.z = v[j].z * rstd * gg.z; o.w = v[j].w * rstd * gg.w;
            if (mode == 2) { *(float4*)(outf + (size_t)m * D_ + col) = o; }
            else {
                const float4 sc = *(const float4*)(scale + (size_t)b * 6144 + col), sh = *(const float4*)(shift + (size_t)b * 6144 + col);
                o.x = o.x * (1.f + sc.x) + sh.x; o.y = o.y * (1.f + sc.y) + sh.y; o.z = o.z * (1.f + sc.z) + sh.z; o.w = o.w * (1.f + sc.w) + sh.w;
                uint2 w; w.x = (unsigned)f2bf(o.x) | ((unsigned)f2bf(o.y) << 16); w.y = (unsigned)f2bf(o.z) | ((unsigned)f2bf(o.w) << 16);
                *(uint2*)(hb + (size_t)m * D_ + col) = w;
            }
        }
    }
}
__global__ void __launch_bounds__(512) k_mixnorm(bf16* mix, const float* ga, const float* gb) {
    const int gw = blockIdx.x * 8 + (threadIdx.x >> 6), ngw = gridDim.x * 8, lane = threadIdx.x & 63;
    for (int m = gw; m < T_; m += ngw) {
        bf16* r = mix + (size_t)m * D_;
        float va[6], vb[6]; float sa = 0.f, sb = 0.f;
#pragma unroll
        for (int j = 0; j < 6; ++j) { va[j] = bf2f(r[lane + 64 * j]); vb[j] = bf2f(r[384 + lane + 64 * j]); sa += va[j] * va[j]; sb += vb[j] * vb[j]; }
        const float ra = rsqrtf(wave_sum(sa) * (1.f / 384.f) + EPS), rb = rsqrtf(wave_sum(sb) * (1.f / 384.f) + EPS);
#pragma unroll
        for (int j = 0; j < 6; ++j) { r[lane + 64 * j] = f2bf(va[j] * ra * ga[lane + 64 * j]); r[384 + lane + 64 * j] = f2bf(vb[j] * rb * gb[lane + 64 * j]); }
    }
}
__global__ void __launch_bounds__(512) k_mscan(float* CT, float* NL, const float* ML, const float* BL, float* MP) {
    for (int item = blockIdx.x; item < 32 * 9; item += gridDim.x) {
        const int bh = item / 9, part = item % 9, tid = threadIdx.x;
        if (part == 8 && tid >= 64) continue;
        float* base; size_t stride;
        if (part < 8) { base = CT + (size_t)bh * 32 * 4096 + part * 512 + tid; stride = 4096; } else { base = NL + (size_t)bh * 32 * 64 + tid; stride = 64; }
        float Cv = 0.f, m = 0.f;
        for (int c = 0; c < 32; ++c) {
            const float cl = base[(size_t)c * stride], ml = ML[bh * 32 + c], bl = BL[bh * 32 + c];
            base[(size_t)c * stride] = Cv;
            if (part == 8 && tid == 0) MP[bh * 32 + c] = m;
            const float mn = fmaxf(bl + m, ml);
            Cv = __expf(bl + m - mn) * Cv + __expf(ml - mn) * cl; m = mn;
        }
    }
}

enum { EPI_RAW = 0, EPI_RES = 1, EPI_GU = 2 };
struct GemmArgs { const bf16* A; int lda; const float* W; int ldw; int K; int N; int row0; int rows; const float* kscale;
                  float* raw; const float* xin; float* xout; const float* gate; bf16* act; };
template <int EPI> __global__ void __launch_bounds__(256) k_gemm_naive(GemmArgs a) {
    __shared__ float As[16][65], Bs[16][65], Bs2[16][65];
    const int tid = threadIdx.x, tx = tid & 15, ty = tid >> 4;
    const int n0 = blockIdx.x * 64, m0 = a.row0 + blockIdx.y * 64;
    float acc[4][4], acc2[4][4];
#pragma unroll
    for (int i = 0; i < 4; ++i)
#pragma unroll
        for (int j = 0; j < 4; ++j) { acc[i][j] = 0.f; acc2[i][j] = 0.f; }
    for (int k0 = 0; k0 < a.K; k0 += 16) {
        for (int i = tid; i < 1024; i += 256) { const int r = i >> 4, kk = i & 15; As[kk][r] = bf2f(a.A[(size_t)(m0 + r) * a.lda + k0 + kk]); }
        for (int i = tid; i < 1024; i += 256) { const int kk = i >> 6, c = i & 63; const int n = n0 + c;
            float w = (n < a.N) ? a.W[(size_t)(k0 + kk) * a.ldw + n] : 0.f; if (a.kscale) w *= a.kscale[k0 + kk]; Bs[kk][c] = w;
            if (EPI == EPI_GU) Bs2[kk][c] = (n < a.N) ? a.W[(size_t)(k0 + kk) * a.ldw + a.N + n] : 0.f; }
        __syncthreads();
#pragma unroll
        for (int kk = 0; kk < 16; ++kk) {
            float av[4], bv[4], bv2[4];
#pragma unroll
            for (int i = 0; i < 4; ++i) { av[i] = As[kk][ty * 4 + i]; bv[i] = Bs[kk][tx * 4 + i]; if (EPI == EPI_GU) bv2[i] = Bs2[kk][tx * 4 + i]; }
#pragma unroll
            for (int i = 0; i < 4; ++i)
#pragma unroll
                for (int j = 0; j < 4; ++j) { acc[i][j] += av[i] * bv[j]; if (EPI == EPI_GU) acc2[i][j] += av[i] * bv2[j]; }
        }
        __syncthreads();
    }
#pragma unroll
    for (int i = 0; i < 4; ++i)
#pragma unroll
        for (int j = 0; j < 4; ++j) {
            const int row = m0 + ty * 4 + i, col = n0 + tx * 4 + j;
            if (col >= a.N) continue;
            if (EPI == EPI_RAW) a.raw[(size_t)(row - a.row0) * a.N + col] = acc[i][j];
            else if (EPI == EPI_RES) { const int b = row / S_; a.xout[(size_t)row * D_ + col] = a.xin[(size_t)row * D_ + col] + a.gate[(size_t)b * 6144 + col] * acc[i][j]; }
            else { a.act[(size_t)row * FF + col] = f2bf(siluf_(acc[i][j]) * acc2[i][j]); }
        }
}
struct PostIn { const float* raw; int row0; int rows; const float *cosP, *sinP, *cosM, *sinM, *big, *bfg; bf16 *nsa, *kvl, *ql, *cm, *km; float* gm; };
__global__ void k_post_in(PostIn p) {
    const long idx = (long)blockIdx.x * blockDim.x + threadIdx.x;
    if (idx >= (long)p.rows * DIN) return;
    const int lr = (int)(idx / DIN), c = (int)(idx % DIN), row = p.row0 + lr;
    const float* r = p.raw + (size_t)lr * DIN;
    const float v = r[c];
    if (c < 1152) {
        float val = v;
        const int seg = (c < 384) ? -1 : (c - 384) / 128;
        const bool rope = (c < 384) || seg == 0 || seg == 2 || seg == 4;
        const int d = c & 63;
        if (rope && d < 16) { const int i = d & 7, hb = c - d; const float x1 = r[hb + i], x2 = r[hb + 8 + i], cs = p.cosP[row * 8 + i], sn = p.sinP[row * 8 + i];
            val = (d < 8) ? x1 * cs - x2 * sn : x1 * sn + x2 * cs; }
        if (c < 384) val *= QSCALE;
        p.nsa[(size_t)row * 1152 + c] = f2bf(val);
    } else if (c < 1170) p.gm[(size_t)row * 32 + (c - 1152)] = sigmoidf_(v);
    else if (c < 1426) p.ql[(size_t)row * 256 + (c - 1170)] = f2bf(v);
    else if (c < 1554) p.kvl[(size_t)row * 128 + (c - 1426)] = f2bf(v);
    else if (c < 1586) { const int d = c - 1554, i = d & 15; const float x1 = r[1554 + i], x2 = r[1570 + i], cs = p.cosM[row * 16 + i], sn = p.sinM[row * 16 + i];
        const bf16 o = f2bf((d < 16) ? x1 * cs - x2 * sn : x1 * sn + x2 * cs);
        for (int h = 0; h < 6; ++h) p.km[(size_t)row * 576 + h * 96 + 64 + d] = o; }
    else if (c < 2354) p.cm[(size_t)row * 768 + (c - 1586)] = f2bf(v);
    else if (c < 2358) p.gm[(size_t)row * 32 + 18 + (c - 2354)] = v + p.big[c - 2354];
    else { const float z = v + p.bfg[c - 2358]; p.gm[(size_t)row * 32 + 22 + (c - 2358)] = fminf(z, 0.f) - log1pf(__expf(-fabsf(z))); }
}
__global__ void __launch_bounds__(512) k_ssq(const bf16* ql, const bf16* kvl, float* sq, float* skv) {
    const int gw = blockIdx.x * 8 + (threadIdx.x >> 6), ngw = gridDim.x * 8, lane = threadIdx.x & 63;
    for (int m = gw; m < T_; m += ngw) {
        float a = 0.f, b = 0.f;
        for (int j = 0; j < 4; ++j) { const float v = bf2f(ql[(size_t)m * 256 + lane + 64 * j]); a += v * v; }
        for (int j = 0; j < 2; ++j) { const float v = bf2f(kvl[(size_t)m * 128 + lane + 64 * j]); b += v * v; }
        a = wave_sum(a); b = wave_sum(b);
        if (lane == 0) { sq[m] = a; skv[m] = b; }
    }
}
__global__ void k_post_uq(const float* raw, int row0, int rows, const float* ssq, const float* cosM, const float* sinM, bf16* qm) {
    const long idx = (long)blockIdx.x * blockDim.x + threadIdx.x;
    if (idx >= (long)rows * 576) return;
    const int lr = (int)(idx / 576), c = (int)(idx % 576), row = row0 + lr;
    const float* r = raw + (size_t)lr * 576;
    const float rstd = rsqrtf(ssq[row] * (1.f / 256.f) + EPS);
    const int h = c / 96, d = c % 96;
    float val = r[c] * rstd;
    if (d >= 64) { const int dd = d - 64, i = dd & 15; const float x1 = r[h * 96 + 64 + i] * rstd, x2 = r[h * 96 + 80 + i] * rstd, cs = cosM[row * 16 + i], sn = sinM[row * 16 + i];
        val = (dd < 16) ? x1 * cs - x2 * sn : x1 * sn + x2 * cs; }
    qm[(size_t)row * 576 + c] = f2bf(val * MSCALE);
}
__global__ void k_post_ukv(const float* raw, int row0, int rows, const float* ssq, bf16* km, bf16* vm) {
    const long idx = (long)blockIdx.x * blockDim.x + threadIdx.x;
    if (idx >= (long)rows * 768) return;
    const int lr = (int)(idx / 768), c = (int)(idx % 768), row = row0 + lr;
    const float rstd = rsqrtf(ssq[row] * (1.f / 128.f) + EPS);
    const float val = raw[(size_t)lr * 768 + c] * rstd;
    const int h = c / 128, w = c % 128;
    if (w < 64) km[(size_t)row * 576 + h * 96 + w] = f2bf(val); else vm[(size_t)row * 384 + h * 64 + (w - 64)] = f2bf(val);
}
__global__ void k_compress(const bf16* nsa, const float* cmp_pos, const float* wk, const float* wv, bf16* kcv) {
    const int idx = blockIdx.x * blockDim.x + threadIdx.x;
    if (idx >= 2 * 8 * 2 * 128 * 64) return;
    const int e = idx & 63, n = (idx >> 6) & 127, g = (idx >> 13) & 1, b = (idx >> 14) & 7, kv = idx >> 17;
    float acc = 0.f;
    if (n < 127) {
        const float* w = kv ? wv : wk; const int col = (kv ? 512 : 384) + g * 64;
        for (int l = 0; l < 32; ++l) { const bf16* tr = nsa + (size_t)(b * S_ + 16 * n + l) * 1152 + col;
            for (int d = 0; d < 64; ++d) acc += (bf2f(tr[d]) + cmp_pos[l * 64 + d]) * w[(size_t)(l * 64 + d) * 64 + e]; }
    }
    kcv[(size_t)kv * (8 * 2 * 128 * 64) + ((size_t)(b * 2 + g) * 128 + n) * 64 + e] = f2bf(acc);
}
__global__ void __launch_bounds__(64) k_cmp_sel(const bf16* nsa, const bf16* kcv, bf16* ocmp, unsigned* sel) {
    __shared__ float P[64][129], SC[64][129];
    const int tid = threadIdx.x, tile = blockIdx.x & 31, g = (blockIdx.x >> 5) & 1, b = blockIdx.x >> 6;
    const int t = tile * 64 + tid, row = b * S_ + t;
    const bf16* kc = kcv + (size_t)(b * 2 + g) * 128 * 64; const bf16* vc = kc + (size_t)8 * 2 * 128 * 64;
    int nvis = (t >= 31) ? ((t - 31) / 16 + 1) : 0; if (nvis > 127) nvis = 127;
    for (int n = 0; n < 128; ++n) P[tid][n] = 0.f;
    for (int r = 0; r < 3; ++r) {
        const int h = 3 * g + r;
        float q[64];
#pragma unroll
        for (int d = 0; d < 64; ++d) q[d] = bf2f(nsa[(size_t)row * 1152 + h * 64 + d]);
        float m = -1e30f;
        for (int n = 0; n < nvis; ++n) { float s = 0.f;
#pragma unroll
            for (int d = 0; d < 64; ++d) s += q[d] * bf2f(kc[n * 64 + d]);
            SC[tid][n] = s; m = fmaxf(m, s); }
        float l = 0.f;
        for (int n = 0; n < nvis; ++n) { const float p = exp2f(SC[tid][n] - m); SC[tid][n] = p; l += p; }
        const float il = (nvis > 0) ? 1.f / l : 0.f;
        float o[64];
#pragma unroll
        for (int d = 0; d < 64; ++d) o[d] = 0.f;
        for (int n = 0; n < nvis; ++n) { const float p = SC[tid][n] * il; P[tid][n] += p;
#pragma unroll
            for (int d = 0; d < 64; ++d) o[d] += p * bf2f(vc[n * 64 + d]); }
#pragma unroll
        for (int d = 0; d < 64; ++d) ocmp[(size_t)row * 384 + h * 64 + d] = f2bf(o[d]);
    }
    const int cur = t >> 6;
    for (int j = 0; j < 32; ++j) {
        float v = 0.f;
        for (int n = 4 * j - 1; n <= 4 * j + 3; ++n) if (n >= 0 && n < 127) v += P[tid][n];
        if (j == 0 || j == cur || j == cur - 1) v = INFINITY;
        if (j * 64 > t) v = -INFINITY;
        SC[tid][j] = v;
    }
    unsigned mask = 0;
    for (int j = 0; j < 32; ++j) { const float v = SC[tid][j]; int rank = 0;
        for (int k = 0; k < 32; ++k) { const float u = SC[tid][k]; rank += (u > v || (u == v && k < j)) ? 1 : 0; }
        if (rank < 16) mask |= 1u << j; }
    sel[(size_t)(b * 2 + g) * S_ + t] = mask;
}
template <int DQK, int MODE> __global__ void __launch_bounds__(64) k_attn_naive(const bf16* Q, int ldq, const bf16* K, int ldk, const bf16* V, int ldv,
        const unsigned* sel, const bf16* ocmp, const bf16* oslc_in, const float* gm, bf16* out) {
    const int t = blockIdx.x * 64 + threadIdx.x, h = blockIdx.y, b = blockIdx.z, row = b * S_ + t;
    const int g = (MODE == 2) ? h : h / 3;
    float q[DQK];
#pragma unroll
    for (int d = 0; d < DQK; ++d) q[d] = bf2f(Q[(size_t)row * ldq + h * DQK + d]);
    float o[64];
#pragma unroll
    for (int d = 0; d < 64; ++d) o[d] = 0.f;
    float m = -1e30f, l = 0.f;
    unsigned sm = 0xffffffffu; if (MODE == 0) sm = sel[(size_t)(b * 2 + g) * S_ + t];
    int j0 = 0; if (MODE == 1) j0 = (t - 511 > 0) ? t - 511 : 0;
    for (int j = j0; j <= t; ++j) {
        if (MODE == 0 && !((sm >> (j >> 6)) & 1u)) { j |= 63; continue; }
        const bf16* kr = K + (size_t)(b * S_ + j) * ldk + g * DQK;
        float s = 0.f;
#pragma unroll
        for (int d = 0; d < DQK; ++d) s += q[d] * bf2f(kr[d]);
        if (s > m) { const float f = exp2f(m - s); l *= f;
#pragma unroll
            for (int d = 0; d < 64; ++d) o[d] *= f;
            m = s; }
        const float p = exp2f(s - m); l += p;
        const bf16* vr = V + (size_t)(b * S_ + j) * ldv + g * 64;
#pragma unroll
        for (int d = 0; d < 64; ++d) o[d] += p * bf2f(vr[d]);
    }
    const float il = 1.f / l;
    if (MODE == 0) {
#pragma unroll
        for (int d = 0; d < 64; ++d) out[(size_t)row * 384 + h * 64 + d] = f2bf(o[d] * il);
    } else if (MODE == 1) {
        const float g0 = gm[(size_t)row * 32 + h * 3], g1 = gm[(size_t)row * 32 + h * 3 + 1], g2 = gm[(size_t)row * 32 + h * 3 + 2];
#pragma unroll
        for (int d = 0; d < 64; ++d) out[(size_t)row * D_ + h * 64 + d] =
            f2bf(g0 * bf2f(ocmp[(size_t)row * 384 + h * 64 + d]) + g1 * bf2f(oslc_in[(size_t)row * 384 + h * 64 + d]) + g2 * o[d] * il);
    } else {
#pragma unroll
        for (int d = 0; d < 64; ++d) out[(size_t)row * D_ + 384 + h * 64 + d] = f2bf(o[d] * il);
    }
}
__global__ void k_mconv(const bf16* cm, const float* cw, const float* cb, bf16* xc) {
    const int idx = blockIdx.x * blockDim.x + threadIdx.x;
    if (idx >= T_ * 256) return;
    const int row = idx >> 8, ch = idx & 255, s = row % S_;
    float a = cb[ch];
    for (int j = 0; j < 4; ++j) { const int ss = s - 3 + j; if (ss >= 0) a += cw[j * 256 + ch] * bf2f(cm[(size_t)(row - 3 + j) * 768 + ch]); }
    xc[idx] = f2bf(siluf_(a));
}
__global__ void k_mqk(const bf16* xc, const float* wq, const float* wk, bf16* mq, bf16* mk) {
    const int idx = blockIdx.x * blockDim.x + threadIdx.x;
    if (idx >= T_ * 256) return;
    const int row = idx >> 8, h = (idx >> 6) & 3, e = idx & 63;
    float aq = 0.f, ak = 0.f;
    for (int d = 0; d < 64; ++d) { const float x = bf2f(xc[(size_t)row * 256 + h * 64 + d]); aq += x * wq[(h * 64 + d) * 64 + e]; ak += x * wk[(h * 64 + d) * 64 + e]; }
    mq[idx] = f2bf(aq * 0.125f); mk[idx] = f2bf(ak);
}
__global__ void __launch_bounds__(64) k_mlocal(const bf16* mk, const bf16* cm, const float* gm, float* CT, float* NL, float* ML, float* BL) {
    __shared__ float w[64], bs[64];
    const int chunk = blockIdx.x, c = chunk & 31, h = (chunk >> 5) & 3, b = chunk >> 7, d = threadIdx.x;
    const int row0 = b * S_ + c * 64;
    if (d == 0) { float acc = 0.f; for (int l = 0; l < 64; ++l) { acc += gm[(size_t)(row0 + l) * 32 + 22 + h]; bs[l] = acc; } }
    __syncthreads();
    const float bL = bs[63];
    float a = bL - bs[d] + gm[(size_t)(row0 + d) * 32 + 18 + h];
    float mx = a;
#pragma unroll
    for (int o = 1; o < 64; o <<= 1) mx = fmaxf(mx, __shfl_xor(mx, o));
    w[d] = __expf(a - mx);
    __syncthreads();
    float C[64]; float n = 0.f;
#pragma unroll
    for (int e = 0; e < 64; ++e) C[e] = 0.f;
    for (int l = 0; l < 64; ++l) {
        const float kk = bf2f(mk[(size_t)(row0 + l) * 256 + h * 64 + d]) * w[l]; n += kk;
        const bf16* vr = cm + (size_t)(row0 + l) * 768 + 256 + h * 64;
#pragma unroll
        for (int e = 0; e < 64; ++e) C[e] += kk * bf2f(vr[e]);
    }
#pragma unroll
    for (int e = 0; e < 64; ++e) CT[(size_t)chunk * 4096 + e * 64 + d] = C[e];
    NL[chunk * 64 + d] = n;
    if (d == 0) { ML[chunk] = mx; BL[chunk] = bL; }
}
__global__ void __launch_bounds__(64) k_mout(const bf16* mq, const bf16* mk, const bf16* cm, const bf16* xc, const float* gm, const float* CT, const float* NL, const float* MP,
                                             const float* gmh, const float* skip, bf16* mix) {
    __shared__ float bs[64], us[64], Ks[64][65], Vs[64][65], Cs[64][65], Qs[64][65], ns[64];
    const int chunk = blockIdx.x, c = chunk & 31, h = (chunk >> 5) & 3, b = chunk >> 7, l = threadIdx.x;
    const int row0 = b * S_ + c * 64, row = row0 + l;
    if (l == 0) { float acc = 0.f; for (int i = 0; i < 64; ++i) { acc += gm[(size_t)(row0 + i) * 32 + 22 + h]; bs[i] = acc; } }
    for (int d = 0; d < 64; ++d) { Ks[l][d] = bf2f(mk[(size_t)row * 256 + h * 64 + d]); Vs[l][d] = bf2f(cm[(size_t)row * 768 + 256 + h * 64 + d]); Cs[l][d] = CT[(size_t)chunk * 4096 + l * 64 + d]; }
    ns[l] = NL[chunk * 64 + l];
    __syncthreads();
    us[l] = gm[(size_t)row * 32 + 18 + h] - bs[l];
    __syncthreads();
    const float mprev = MP[chunk];
    float cu = -INFINITY; for (int s = 0; s <= l; ++s) cu = fmaxf(cu, us[s]);
    const float mt = bs[l] + fmaxf(mprev, cu), inter = __expf(bs[l] + mprev - mt);
    for (int d = 0; d < 64; ++d) Qs[l][d] = bf2f(mq[(size_t)row * 256 + h * 64 + d]);
    float num[64]; float qn = 0.f;
#pragma unroll
    for (int e = 0; e < 64; ++e) num[e] = 0.f;
    for (int d = 0; d < 64; ++d) { const float qd = Qs[l][d]; qn += qd * ns[d];
#pragma unroll
        for (int e = 0; e < 64; ++e) num[e] += qd * Cs[e][d]; }
#pragma unroll
    for (int e = 0; e < 64; ++e) num[e] *= inter;
    float den = inter * qn;
    for (int s = 0; s < 64; ++s) {
        if (s <= l) { float sd = 0.f;
            for (int d = 0; d < 64; ++d) sd += Qs[l][d] * Ks[s][d];
            const float sw = sd * __expf(bs[l] + us[s] - mt); den += sw;
#pragma unroll
            for (int e = 0; e < 64; ++e) num[e] += sw * Vs[s][e]; }
    }
    const float dn = 1.f / fmaxf(fabsf(den), __expf(-mt));
    float mu = 0.f;
#pragma unroll
    for (int e = 0; e < 64; ++e) { num[e] = num[e] * dn * sigmoidf_(bf2f(cm[(size_t)row * 768 + 512 + h * 64 + e])); mu += num[e]; }
    mu *= (1.f / 64.f); float var = 0.f;
#pragma unroll
    for (int e = 0; e < 64; ++e) { const float dlt = num[e] - mu; var += dlt * dlt; }
    const float rs = rsqrtf(var * (1.f / 64.f) + EPS);
#pragma unroll
    for (int e = 0; e < 64; ++e) mix[(size_t)row * D_ + 768 + h * 64 + e] = f2bf((num[e] - mu) * rs * gmh[h * 64 + e] + skip[h * 64 + e] * bf2f(xc[(size_t)row * 256 + h * 64 + e]));
}


__device__ __forceinline__ int fresh_lane() { int l; asm volatile("v_mbcnt_lo_u32_b32 %0, -1, 0\n\tv_mbcnt_hi_u32_b32 %0, -1, %0" : "=&v"(l)); return l; }
namespace pg8 {
#define PG8_LAS __attribute__((address_space(3)))
typedef unsigned short bf16_t;
typedef short bf16x8 __attribute__((ext_vector_type(8)));
typedef float f32x4 __attribute__((ext_vector_type(4)));
typedef unsigned u32x4 __attribute__((ext_vector_type(4)));
constexpr int BM = 256, BK = 64, HALF = 128, HTB = HALF * BK * 2  , STAGE_BYTES = 8 * HTB, NXCD = 8, WGM = 8;

__host__ __device__ __forceinline__ int lds_byte(int r, int c) { const int st = (r >> 4) * 2 + (c >> 5), rr = r & 15, cc = c & 31, ob = rr * 64 + cc * 2; return st * 1024 + (ob ^ (((ob >> 9) & 1) << 5)); }
__host__ __device__ __forceinline__ void stage_rc(int b, int& R, int& C) { const int st = b / 1024, sb = b % 1024, swz = sb ^ (((sb >> 9) & 1) << 5); R = (st >> 1) * 16 + swz / 64; C = (st & 1) * 32 + (swz % 64) / 2; }
__host__ __device__ __forceinline__ int perm32(int rho) { const int n = rho >> 4, i = rho & 15; return 8 * (i >> 2) + 4 * n + (i & 3); }

struct Unit { int pm, pn; };
struct Gemm { const bf16_t* A; const bf16_t* Bt; int M, N, K; };

struct StaticOrder {
    int nM, nN, nwg, G, c;
    __host__ __device__ void init(int M, int N, int G_, int c_) { nM = M / BM; nN = N / BM; nwg = nM * nN; G = G_; c = c_; }
    __host__ __device__ bool next(int i, Unit& u) const {
        const long L = (long)i * G + c; if (L >= nwg) return false;
        int wgid = (int)L; { const int q = nwg / NXCD, r = nwg % NXCD, xcd = wgid % NXCD, off = wgid / NXCD; wgid = (xcd < r ? xcd * (q + 1) : r * (q + 1) + (xcd - r) * q) + off; }
        const int nig = WGM * nN, gid = wgid / nig, fm = gid * WGM, gsz = (nM - fm) < WGM ? (nM - fm) : WGM;
        u.pm = fm + ((wgid % nig) % gsz); u.pn = (wgid % nig) / gsz; return true;
    }
    __device__ __forceinline__ void a_ready(const Unit&) const {}
    __device__ __forceinline__ void done(const Unit&) const {}
};

__device__ __forceinline__ unsigned cvt_pk_bf16(float lo, float hi) { unsigned r; asm volatile("v_cvt_pk_bf16_f32 %0, %1, %2" : "=v"(r) : "v"(lo), "v"(hi)); return r; }
typedef float f32x2 __attribute__((ext_vector_type(2)));

typedef unsigned u32x4 __attribute__((ext_vector_type(4)));
typedef unsigned u32x2 __attribute__((ext_vector_type(2)));
struct EpiIn {
    static constexpr bool PERM = true, AFTER_DRAIN = false;
    unsigned char* ws; const float *big, *bfg;
#define EPI_ROWS(...) _Pragma("unroll") for (int ai = 0; ai < 2; ++ai) _Pragma("unroll") for (int m = 0; m < 4; ++m) { \
        const int row = u.pm * BM + ai * HALF + wr * 64 + m * 16 + fr; float v[8]; \
        _Pragma("unroll") for (int i = 0; i < 4; ++i) { v[i] = acc[ai][bj][m][0][i]; v[4 + i] = acc[ai][bj][m][1][i]; } \
        asm volatile("" : "+v"(v[0]), "+v"(v[1]), "+v"(v[2]), "+v"(v[3]), "+v"(v[4]), "+v"(v[5]), "+v"(v[6]), "+v"(v[7])); \
        __VA_ARGS__ asm volatile("" ::: "memory"); }
#define EPI_PACK(w) u32x4 w; w.x = cvt_pk_bf16(v[0], v[1]); w.y = cvt_pk_bf16(v[2], v[3]); w.z = cvt_pk_bf16(v[4], v[5]); w.w = cvt_pk_bf16(v[6], v[7]);
    __device__ __forceinline__ void operator()(const f32x4 (&acc)[2][2][4][2], const Unit& u, int wr, int wc, int fr, int fq) const {
        half<0>(acc, u, wr, wc, fr, fq); half<1>(acc, u, wr, wc, fr, fq);
    }
    template <int bj> __device__ __forceinline__ void half(const f32x4 (&acc)[2][2][4][2], const Unit& u, int wr, int wc, int fr, int fq) const {
        {
            const int hb = 2 * u.pn + bj;
            int cb = 32 * wc + 8 * fq; asm volatile("" : "+v"(cb), "+v"(fr));
            if (hb <= 8) {
                bf16_t* nsa = (bf16_t*)(ws + WS_NSA) + hb * 128 + cb;
                const bool rope_hb = (hb <= 3) || hb == 5 || hb == 7;
                if (rope_hb) {
                    const float* cosP = (const float*)(ws + WS_COSP); const float* sinP = (const float*)(ws + WS_SINP);
                    const bool mine = ((wc & 1) == 0) && fq < 2; const float sg = (fq == 0) ? -1.f : 1.f; const float sc = (hb < 3) ? QSCALE : 1.f;
                    EPI_ROWS({
                        float pv[8];
                        _Pragma("unroll") for (int i = 0; i < 8; ++i) pv[i] = __shfl_xor(v[i], 16);
                        if (mine) {
                            const f32x4 c0 = *(const f32x4*)(cosP + row * 8), c1 = *(const f32x4*)(cosP + row * 8 + 4), s0 = *(const f32x4*)(sinP + row * 8), s1 = *(const f32x4*)(sinP + row * 8 + 4);
                            _Pragma("unroll") for (int i = 0; i < 4; ++i) { v[i] = v[i] * c0[i] + sg * pv[i] * s0[i]; v[4 + i] = v[4 + i] * c1[i] + sg * pv[4 + i] * s1[i]; }
                        }
                        _Pragma("unroll") for (int i = 0; i < 8; ++i) v[i] *= sc;
                        EPI_PACK(w) *(u32x4*)(nsa + (size_t)row * 1152) = w;
                    })
                } else {
                    EPI_ROWS({ EPI_PACK(w) *(u32x4*)(nsa + (size_t)row * 1152) = w; })
                }
            } else if (hb <= 11) {
                bf16_t* dst = (hb == 9) ? (bf16_t*)(ws + WS_KVL) + cb : (bf16_t*)(ws + WS_QL) + (hb - 10) * 128 + cb;
                const int ld = (hb == 9) ? 128 : 256;
                EPI_ROWS({ EPI_PACK(w) *(u32x4*)(dst + (size_t)row * ld) = w; })
            } else if (hb <= 17) {
                bf16_t* cm = (bf16_t*)(ws + WS_CM) + (hb - 12) * 128 + cb;
                EPI_ROWS({ EPI_PACK(w) *(u32x4*)(cm + (size_t)row * 768) = w; })
            } else if (hb == 18) {
                float* mr = (float*)(ws + WS_MISCRAW) + cb;
                if (wc < 2) { EPI_ROWS({ *(f32x4*)(mr + (size_t)row * 64) = (f32x4){v[0], v[1], v[2], v[3]}; *(f32x4*)(mr + (size_t)row * 64 + 4) = (f32x4){v[4], v[5], v[6], v[7]}; }) }
            }
        }
    }
#undef EPI_ROWS
#undef EPI_PACK
};
struct EpiUKV {
    static constexpr bool PERM = true, AFTER_DRAIN = false;
    bf16_t* kvm;
    __device__ __forceinline__ void operator()(const f32x4 (&acc)[2][2][4][2], const Unit& u, int wr, int wc, int fr, int fq) const {
        asm volatile("" : "+v"(fq), "+v"(fr));
        const int col0 = u.pn * BM + wc * 32 + 8 * fq;
#pragma unroll
        for (int ai = 0; ai < 2; ++ai)
#pragma unroll
            for (int m = 0; m < 4; ++m) { bf16_t* rowp = kvm + (size_t)(u.pm * BM + ai * HALF + wr * 64 + m * 16 + fr) * 768 + col0;
#pragma unroll
                for (int bj = 0; bj < 2; ++bj) { const f32x4 a = acc[ai][bj][m][0], b = acc[ai][bj][m][1];
                    u32x4 w; w.x = cvt_pk_bf16(a[0], a[1]); w.y = cvt_pk_bf16(a[2], a[3]); w.z = cvt_pk_bf16(b[0], b[1]); w.w = cvt_pk_bf16(b[2], b[3]);
                    *(u32x4*)(rowp + bj * HALF) = w; } }
    }
};
struct EpiRes {
    static constexpr bool PERM = false, AFTER_DRAIN = false;
    const float* xin; float* xout; const float* gate;
    __device__ __forceinline__ void operator()(const f32x4 (&acc)[2][2][4][2], const Unit& u, int wr, int wc, int fr, int fq) const {
        asm volatile("" : "+v"(fq), "+v"(fr));
        const int b = (u.pm * BM) / S_; const int col0 = u.pn * BM + wc * 32 + 4 * fq;
        f32x4 gv[2][2];
#pragma unroll
        for (int bj = 0; bj < 2; ++bj)
#pragma unroll
            for (int n = 0; n < 2; ++n) gv[bj][n] = *(const f32x4*)(gate + (size_t)b * 6144 + col0 + bj * HALF + n * 16);
#pragma unroll
        for (int ai = 0; ai < 2; ++ai)
#pragma unroll
            for (int m = 0; m < 4; ++m) { const size_t off = (size_t)(u.pm * BM + ai * HALF + wr * 64 + m * 16 + fr) * D_ + col0;
#pragma unroll
                for (int bj = 0; bj < 2; ++bj)
#pragma unroll
                    for (int n = 0; n < 2; ++n) { const f32x4 xi = *(const f32x4*)(xin + off + bj * HALF + n * 16); *(f32x4*)(xout + off + bj * HALF + n * 16) = xi + gv[bj][n] * acc[ai][bj][m][n]; } }
    }
};
struct EpiGU {
    static constexpr bool PERM = true, AFTER_DRAIN = false;
    bf16_t* act;
    __device__ __forceinline__ void operator()(const f32x4 (&acc)[2][2][4][2], const Unit& u, int wr, int wc, int fr, int fq) const {
        asm volatile("" : "+v"(fq), "+v"(fr));
        const int col0 = u.pn * HALF + wc * 32 + 8 * fq;
#pragma unroll
        for (int ai = 0; ai < 2; ++ai)
#pragma unroll
            for (int m = 0; m < 4; ++m) { const int row = u.pm * BM + ai * HALF + wr * 64 + m * 16 + fr; float o[8];
#pragma unroll
                for (int n = 0; n < 2; ++n)
#pragma unroll
                    for (int i = 0; i < 4; ++i) { const float g = acc[ai][0][m][n][i], up = acc[ai][1][m][n][i]; o[4 * n + i] = g / (1.f + __expf(-g)) * up; }
                u32x4 w; w.x = cvt_pk_bf16(o[0], o[1]); w.y = cvt_pk_bf16(o[2], o[3]); w.z = cvt_pk_bf16(o[4], o[5]); w.w = cvt_pk_bf16(o[6], o[7]);
                *(u32x4*)(act + (size_t)row * FF + col0) = w; }
    }
};
template <class Epi, class Sched, bool ALIGN_EPI = false, bool SP2 = false>
__device__ __forceinline__ void gemm_phase(PG8_LAS unsigned char* lds, const Gemm g, const Sched& S, const Epi& E, int wid_in) {
    const int wid = __builtin_amdgcn_readfirstlane(wid_in), lane = fresh_lane(), tid = wid * 64 + lane, wr = wid >> 2, wc = wid & 3;
    const int K = g.K, nt = K / BK;
    unsigned voffA[2], voffB[2];
#pragma unroll
    for (int i = 0; i < 2; ++i) { int R, C; stage_rc(tid * 16 + i * 8192, R, C); const int Rb = Epi::PERM ? ((R & ~31) + perm32(R & 31)) : R;
        voffA[i] = (unsigned)(R * K + C) * 2u; voffB[i] = (unsigned)(Rb * K + C) * 2u; }
    const size_t kstep = (size_t)(BK * 2);
    const size_t hstep = (size_t)HALF * K * 2;
    const size_t tstep = 2 * hstep;
    const unsigned ldsw = (unsigned)wid * 1024u;
    const int aoff = lds_byte(wr * 64 + (lane & 15), (lane >> 4) * 8), boff = lds_byte(wc * 32 + (lane & 15), (lane >> 4) * 8);
#define PG8_SA(b, h) (((b) * 2 + (h)) * HTB)
#define PG8_SB(b, h) ((4 + (b) * 2 + (h)) * HTB)
#define PG8_STAGE(bufoff, gbase, voff) do { _Pragma("unroll") for (int _i = 0; _i < 2; ++_i) \
        __builtin_amdgcn_global_load_lds((const unsigned*)((const char*)(gbase) + (voff)[_i]), (PG8_LAS unsigned*)(lds + (bufoff) + ldsw + _i * 8192), 16, 0, 0); } while (0)
#define PG8_LDA(dst, b, h) do { _Pragma("unroll") for (int m = 0; m < 4; ++m) _Pragma("unroll") for (int k = 0; k < 2; ++k) dst[m][k] = *(const PG8_LAS bf16x8*)(lds + PG8_SA(b, h) + aoff + m * 2048 + k * 1024); } while (0)
#define PG8_LDB(dst, b, h) do { _Pragma("unroll") for (int n = 0; n < 2; ++n) _Pragma("unroll") for (int k = 0; k < 2; ++k) dst[n][k] = *(const PG8_LAS bf16x8*)(lds + PG8_SB(b, h) + boff + n * 2048 + k * 1024); } while (0)
#define PG8_MMA(ai, bj, At, Bt) do { __builtin_amdgcn_s_setprio(1); _Pragma("unroll") for (int m = 0; m < 4; ++m) _Pragma("unroll") for (int n = 0; n < 2; ++n) _Pragma("unroll") for (int k = 0; k < 2; ++k) \
        acc[ai][bj][m][n] = __builtin_amdgcn_mfma_f32_16x16x32_bf16(Bt[n][k], At[m][k], acc[ai][bj][m][n], 0, 0, 0); __builtin_amdgcn_s_setprio(0); } while (0)
#define PG8_WAIT_V(n) asm volatile("s_waitcnt vmcnt(" #n ")" ::: "memory")
#define PG8_WAIT_L(n) asm volatile("s_waitcnt lgkmcnt(" #n ")" ::: "memory")
#define PG8_BAR __builtin_amdgcn_s_barrier()
#define PG8_SCHED __builtin_amdgcn_sched_barrier(0)
    Unit cur, nxt; int ui = 0;
    if (!S.next(0, cur)) return;
    f32x4 acc[2][2][4][2];
#pragma unroll
    for (int a = 0; a < 2; ++a)
#pragma unroll
        for (int b = 0; b < 2; ++b)
#pragma unroll
            for (int m = 0; m < 4; ++m)
#pragma unroll
                for (int n = 0; n < 2; ++n) acc[a][b][m][n] = (f32x4){0.f, 0.f, 0.f, 0.f};
    bf16x8 At[4][2], B0[2][2], B1[2][2];
    const char* cA = (const char*)g.A + (size_t)cur.pm * tstep; const char* cB = (const char*)g.Bt + (size_t)cur.pn * tstep;
    S.a_ready(cur);
    if constexpr (SP2) {
        PG8_STAGE(PG8_SB(0, 0), cB, voffB); PG8_STAGE(PG8_SB(0, 1), cB + hstep, voffB); PG8_STAGE(PG8_SA(0, 0), cA, voffA); PG8_STAGE(PG8_SA(0, 1), cA + hstep, voffA);
        if (wr == 1) PG8_BAR;
        PG8_WAIT_V(2); PG8_BAR;
        PG8_STAGE(PG8_SB(1, 0), cB + kstep, voffB); PG8_STAGE(PG8_SA(1, 0), cA + kstep, voffA); PG8_STAGE(PG8_SB(1, 1), cB + hstep + kstep, voffB);
        PG8_WAIT_V(6); PG8_BAR;
    } else {
        PG8_STAGE(PG8_SB(0, 0), cB, voffB); PG8_STAGE(PG8_SA(0, 0), cA, voffA); PG8_STAGE(PG8_SB(0, 1), cB + hstep, voffB); PG8_STAGE(PG8_SA(0, 1), cA + hstep, voffA);
        if (wr == 1) PG8_BAR;
        PG8_WAIT_V(4); PG8_BAR;
        PG8_STAGE(PG8_SB(1, 0), cB + kstep, voffB); PG8_STAGE(PG8_SA(1, 0), cA + kstep, voffA); PG8_STAGE(PG8_SB(1, 1), cB + hstep + kstep, voffB);
        PG8_WAIT_V(6); PG8_BAR;
    }
    for (;;) {
        const bool has_next = S.next(ui + 1, nxt);
        const char* nA = has_next ? (const char*)g.A + (size_t)nxt.pm * tstep : cA; const char* nB = has_next ? (const char*)g.Bt + (size_t)nxt.pn * tstep : cB;
        for (int t = 0; t < nt; t += 2) {
            const bool last = (t == nt - 2);
            const char* a1 = cA + (size_t)(t + 1) * kstep;
            const char* a2 = last ? nA : cA + (size_t)(t + 2) * kstep; const char* b2 = last ? nB : cB + (size_t)(t + 2) * kstep;
            const char* a3 = a2 + kstep; const char* b3 = b2 + kstep;
            if (last && has_next) S.a_ready(nxt);
            if constexpr (SP2) {
            PG8_LDB(B0, 0, 0); PG8_LDB(B1, 0, 1); PG8_SCHED; PG8_LDA(At, 0, 0); PG8_STAGE(PG8_SA(1, 1), a1 + hstep, voffA);
            PG8_WAIT_V(8); PG8_WAIT_L(0); PG8_BAR; PG8_MMA(0, 0, At, B0); PG8_MMA(0, 1, At, B1); PG8_BAR; PG8_SCHED;
            PG8_LDA(At, 0, 1); PG8_STAGE(PG8_SB(0, 0), b2, voffB); PG8_STAGE(PG8_SB(0, 1), b2 + hstep, voffB); PG8_STAGE(PG8_SA(0, 0), a2, voffA);
            PG8_WAIT_V(8); PG8_WAIT_L(0); PG8_BAR; PG8_MMA(1, 0, At, B0); PG8_MMA(1, 1, At, B1); PG8_BAR; PG8_SCHED;
            PG8_LDB(B0, 1, 0); PG8_LDB(B1, 1, 1); PG8_SCHED; PG8_LDA(At, 1, 0); PG8_STAGE(PG8_SA(0, 1), a2 + hstep, voffA);
            PG8_WAIT_V(8); PG8_WAIT_L(0); PG8_BAR; PG8_MMA(0, 0, At, B0); PG8_MMA(0, 1, At, B1); PG8_BAR; PG8_SCHED;
            PG8_LDA(At, 1, 1); PG8_STAGE(PG8_SB(1, 0), b3, voffB); PG8_STAGE(PG8_SB(1, 1), b3 + hstep, voffB); PG8_STAGE(PG8_SA(1, 0), a3, voffA);
            PG8_WAIT_V(8); PG8_WAIT_L(0); PG8_BAR; PG8_MMA(1, 0, At, B0); PG8_MMA(1, 1, At, B1); PG8_BAR; PG8_SCHED;
            } else {
            PG8_LDB(B0, 0, 0); PG8_SCHED; PG8_LDA(At, 0, 0); PG8_STAGE(PG8_SA(1, 1), a1 + hstep, voffA);
            PG8_WAIT_L(8); PG8_BAR; PG8_WAIT_L(0); PG8_MMA(0, 0, At, B0); PG8_BAR; PG8_SCHED;
            PG8_LDB(B1, 0, 1); PG8_STAGE(PG8_SB(0, 0), b2, voffB);
            PG8_BAR; PG8_WAIT_L(0); PG8_MMA(0, 1, At, B1); PG8_BAR;
            PG8_LDA(At, 0, 1); PG8_STAGE(PG8_SA(0, 0), a2, voffA);
            PG8_BAR; PG8_WAIT_L(0); PG8_MMA(1, 0, At, B0); PG8_BAR; PG8_SCHED;
            PG8_STAGE(PG8_SB(0, 1), b2 + hstep, voffB);
            PG8_WAIT_V(6); PG8_BAR; PG8_MMA(1, 1, At, B1); PG8_BAR;
            PG8_LDB(B0, 1, 0); PG8_SCHED; PG8_LDA(At, 1, 0); PG8_STAGE(PG8_SA(0, 1), a2 + hstep, voffA);
            PG8_WAIT_L(8); PG8_BAR; PG8_WAIT_L(0); PG8_MMA(0, 0, At, B0); PG8_BAR; PG8_SCHED;
            PG8_LDB(B1, 1, 1); PG8_STAGE(PG8_SB(1, 0), b3, voffB);
            PG8_BAR; PG8_WAIT_L(0); PG8_MMA(0, 1, At, B1); PG8_BAR;
            PG8_LDA(At, 1, 1); PG8_STAGE(PG8_SA(1, 0), a3, voffA);
            PG8_BAR; PG8_WAIT_L(0); PG8_MMA(1, 0, At, B0); PG8_BAR; PG8_SCHED;
            PG8_STAGE(PG8_SB(1, 1), b3 + hstep, voffB);
            PG8_WAIT_V(6); PG8_BAR; PG8_MMA(1, 1, At, B1); PG8_BAR;
            }
        }
        if constexpr (ALIGN_EPI) { if (wr == 0) PG8_BAR; }
        if constexpr (!Epi::AFTER_DRAIN) { const int ln = fresh_lane(); E(acc, cur, wr, wc, ln & 15, ln >> 4); S.done(cur); }
        if (!has_next) break;
#pragma unroll
        for (int a = 0; a < 2; ++a)
#pragma unroll
            for (int b = 0; b < 2; ++b)
#pragma unroll
                for (int m = 0; m < 4; ++m)
#pragma unroll
                    for (int n = 0; n < 2; ++n) acc[a][b][m][n] = (f32x4){0.f, 0.f, 0.f, 0.f};
        cur = nxt; cA = nA; cB = nB; ++ui;
        if constexpr (ALIGN_EPI) { if (wr == 1) PG8_BAR; }
    }
    PG8_WAIT_V(0);
    if constexpr (!ALIGN_EPI) { if (wr == 0) PG8_BAR; }
    PG8_BAR;
    if constexpr (Epi::AFTER_DRAIN) { const int ln = fresh_lane(); E.fused(acc, cur, wr, wc, ln & 15, ln >> 4, lds, wid, ln); S.done(cur); }
#undef PG8_SA
#undef PG8_SB
#undef PG8_STAGE
#undef PG8_LDA
#undef PG8_LDB
#undef PG8_MMA
#undef PG8_WAIT_V
#undef PG8_WAIT_L
#undef PG8_BAR
#undef PG8_SCHED
}
}

#define GAS __attribute__((address_space(1)))
#define LAS __attribute__((address_space(3)))
typedef float f32x4 __attribute__((ext_vector_type(4)));
typedef unsigned v4u __attribute__((ext_vector_type(4)));
typedef GAS unsigned gu32;
#define XB_TMO      128
#define XB_XCNT(j)  (256  + 64 * (j))
#define XB_XSUB(j)  (1280 + 64 * (j))
#define XB_XGEN(j)  (2304 + 64 * (j))
#define XB_TOP      3328
#define XB_TOPGEN   3392
#define XCD_BAR_WORDS 3456
#define XB_SPIN_CAP (1u << 18)

__device__ __forceinline__ unsigned xb_ld(unsigned* p)              { return __hip_atomic_load(p, __ATOMIC_RELAXED, __HIP_MEMORY_SCOPE_AGENT); }
__device__ __forceinline__ unsigned xb_add(unsigned* p, unsigned v) { return __hip_atomic_fetch_add(p, v, __ATOMIC_RELAXED, __HIP_MEMORY_SCOPE_AGENT); }
__device__ __forceinline__ unsigned xb_xcc_id() { return (unsigned)__builtin_amdgcn_s_getreg((3 << 11) | 20) & 0xFu; }
#define XB_SPIN(cond, bar) do { unsigned _sp = 0; while (cond) { __builtin_amdgcn_s_sleep(1); \
    if ((++_sp & 255u) == 0u) { if (xb_ld(&(bar)[XB_TMO])) break; if (_sp > XB_SPIN_CAP) { atomicAdd(&(bar)[XB_TMO], 1u); break; } } } } while (0)

struct XcdBarrier {
    unsigned* bar; unsigned x;
    volatile LAS unsigned* st;
};

__device__ __forceinline__ XcdBarrier xcd_barrier_post(unsigned* bar, volatile LAS unsigned* st, int tid) {
    XcdBarrier b; b.bar = bar; b.x = xb_xcc_id(); b.st = st;
    if (tid == 0) (void)xb_add(&bar[XB_XCNT(b.x)], 1u);
    return b;
}
__device__ __forceinline__ void xcd_barrier_complete(unsigned* bar, unsigned x, unsigned& nloc, unsigned& nx) {
    const unsigned G = gridDim.x * gridDim.y * gridDim.z;
    unsigned sum, cnt, mine, sp = 0u;
    for (;;) {
        sum = 0u; cnt = 0u; mine = 0u;
#pragma unroll
        for (unsigned j = 0; j < 16; ++j) { const unsigned c = xb_ld(&bar[XB_XCNT(j)]); sum += c; cnt += (c > 0u) ? 1u : 0u; mine = (j == x) ? c : mine; }
        if (sum == G) break;
        __builtin_amdgcn_s_sleep(1);
        if ((++sp & 255u) == 0u) { if (xb_ld(&bar[XB_TMO])) break; if (sp > XB_SPIN_CAP) { atomicAdd(&bar[XB_TMO], 1u); break; } }
    }
    nloc = mine > 0u ? mine : 1u; nx = cnt > 0u ? cnt : 1u;
}

__device__ __forceinline__ void xcd_barrier(const XcdBarrier& b, int tid) {
    asm volatile("s_waitcnt vmcnt(0)" ::: "memory");
    __syncthreads();
    if (tid == 0) {
        unsigned* bar = b.bar;
        __builtin_amdgcn_s_waitcnt(0);
        unsigned nloc = b.st[0], nx = b.st[1];
        if (nloc == 0u) { xcd_barrier_complete(bar, b.x, nloc, nx); b.st[0] = nloc; b.st[1] = nx; }
        const unsigned old = xb_add(&bar[XB_XSUB(b.x)], 1u);
        const unsigned gen = old / nloc;
        if (old + 1u == (gen + 1u) * nloc) {
            __builtin_amdgcn_fence(__ATOMIC_RELEASE, "agent");
            asm volatile("s_waitcnt vmcnt(0)" ::: "memory");
            const unsigned og = xb_add(&bar[XB_TOP], 1u);
            const unsigned tg = og / nx;
            if (og + 1u == (tg + 1u) * nx) xb_add(&bar[XB_TOPGEN], 1u);
            else XB_SPIN(xb_ld(&bar[XB_TOPGEN]) == tg, bar);
            __builtin_amdgcn_fence(__ATOMIC_ACQUIRE, "agent");
            xb_add(&bar[XB_XGEN(b.x)], 1u);
            asm volatile("s_waitcnt vmcnt(0)" ::: "memory");
        } else {
            XB_SPIN(xb_ld(&bar[XB_XGEN(b.x)]) == gen, bar);
            __builtin_amdgcn_fence(__ATOMIC_ACQUIRE, "agent");
            asm volatile("s_waitcnt vmcnt(0)" ::: "memory");
        }
    }
    __syncthreads();
}

constexpr int NTHR = 512, NWAVES = 8;
constexpr int RING_BYTES = 131072, MISC_OFF = RING_BYTES + 320, LDS_BYTES = 147456;
constexpr int CW_BAR = 4096;
constexpr size_t CTL_ZERO_BYTES = 64 * 1024;
constexpr size_t WT_IN = WS_WT, WT_OUT = WT_IN + (size_t)2560 * 1024 * 2, WT_GU = WT_OUT + (size_t)1024 * 1024 * 2, WT_DOWN = WT_GU + (size_t)5632 * 1024 * 2,
                 WT_UQ = WT_DOWN + (size_t)1024 * 2816 * 2, WT_UKV = WT_UQ + (size_t)768 * 256 * 2, WT_CK = WT_UKV + (size_t)768 * 128 * 2, WT_CV = WT_CK + (size_t)64 * 2048 * 2,
                 WT_QM = WT_CV + (size_t)64 * 2048 * 2, WT_KM = WT_QM + 4 * 64 * 64 * 2, WT_END = WT_KM + 4 * 64 * 64 * 2;
static_assert(WT_END <= WS_HB, "weights");
constexpr int NPH = 24, PPL = 11;
constexpr int REP_MASK = 0;
#ifndef PHM
#define PHM 0xffff
#endif
struct MP { const float* in[N_IN]; float* out; unsigned char* ws; int ph_lo, ph_hi, coop, pad; };

struct MPK {
    const __attribute__((address_space(4))) MP* k;
    struct InArr { const __attribute__((address_space(4))) MP* k; __device__ __forceinline__ const float* operator[](int i) const { return k->in[i]; } };
    __device__ __forceinline__ InArr in_() const { return InArr{k}; }
};
#define PIN(i) (p.k->in[i])
__device__ __forceinline__ unsigned pk2(float lo, float hi) { return (unsigned)f2bf(lo) | ((unsigned)f2bf(hi) << 16); }
struct MapId { int n; __device__ __forceinline__ int operator()(int c) const { return c < n ? c : -1; } };
struct MapIn { __device__ __forceinline__ int operator()(int c) const {
    if (c < 1152) return c; if (c < 1280) return 1426 + (c - 1152); if (c < 1536) return 1170 + (c - 1280); if (c < 2304) return 1586 + (c - 1536);
    if (c < 2336) return 1554 + (c - 2304); if (c < 2354) return 1152 + (c - 2336); if (c < 2362) return c; return -1; } };
struct MapGU { __device__ __forceinline__ int operator()(int c) const { const int t = c >> 8, w = c & 255; return (w < 128) ? t * 128 + w : FF + t * 128 + (w - 128); } };
template <class Map> __device__ __forceinline__ void transpose_item(const float* W, int K, int ldw, const Map& map, const float* kscale, bf16* WT, LAS float* scr, int item, int nblk, int lane) {
    const int kb = item / nblk, nb = item % nblk, k0 = 64 * kb, n0 = 32 * nb;
    const int sc = map(n0 + (lane & 31));
#pragma unroll 8
    for (int i = 0; i < 32; ++i) { const int kk = 2 * i + (lane >> 5); float v = (sc >= 0) ? W[(size_t)(k0 + kk) * ldw + sc] : 0.f; if (kscale) v *= kscale[k0 + kk]; scr[kk * 33 + (lane & 31)] = v; }
    asm volatile("s_waitcnt lgkmcnt(0)" ::: "memory");
    const int c = lane & 7;
#pragma unroll
    for (int j = 0; j < 4; ++j) { const int n = (lane >> 3) + 8 * j; const LAS float* s = scr + (8 * c) * 33 + n;
        v4u o; o.x = pk2(s[0 * 33], s[1 * 33]); o.y = pk2(s[2 * 33], s[3 * 33]); o.z = pk2(s[4 * 33], s[5 * 33]); o.w = pk2(s[6 * 33], s[7 * 33]);
        *(v4u*)(WT + (size_t)(n0 + n) * K + k0 + 8 * c) = o; }
    asm volatile("s_waitcnt lgkmcnt(0)" ::: "memory");
}
__device__ __forceinline__ void norm_rows(const float* x, const float* g, const float* shift, const float* scale, bf16* hb, float* outf, int mode, int gw, int ngw, int lane) {
    for (int m = gw; m < T_; m += ngw) {
        const float4* xr = (const float4*)(x + (size_t)m * D_) + lane;
        float4 v[4]; float s = 0.f;
#pragma unroll
        for (int j = 0; j < 4; ++j) { v[j] = xr[64 * j]; s += v[j].x * v[j].x + v[j].y * v[j].y + v[j].z * v[j].z + v[j].w * v[j].w; }
        const float rstd = rsqrtf(wave_sum(s) * (1.f / D_) + EPS);
        const int b = m / S_;
#pragma unroll
        for (int j = 0; j < 4; ++j) {
            const int col = 4 * lane + 256 * j;
            const float4 gg = *(const float4*)(g + col);
            float4 o; o.x = v[j].x * rstd * gg.x; o.y = v[j].y * rstd * gg.y; o.z = v[j].z * rstd * gg.z; o.w = v[j].w * rstd * gg.w;
            if (mode == 2) { *(float4*)(outf + (size_t)m * D_ + col) = o; }
            else {
                const float4 sc = *(const float4*)(scale + (size_t)b * 6144 + col), sh = *(const float4*)(shift + (size_t)b * 6144 + col);
                o.x = o.x * (1.f + sc.x) + sh.x; o.y = o.y * (1.f + sc.y) + sh.y; o.z = o.z * (1.f + sc.z) + sh.z; o.w = o.w * (1.f + sc.w) + sh.w;
                uint2 w; w.x = pk2(o.x, o.y); w.y = pk2(o.z, o.w);
                *(uint2*)(hb + (size_t)m * D_ + col) = w;
            }
        }
    }
}
__device__ __forceinline__ void ph_p0(const MPK& p, LAS unsigned char* lds, int tid) {
    const int wave = tid >> 6, lane = tid & 63;
    LAS float* ca = (LAS float*)lds; LAS float* red = ca + 8192;
    unsigned char* ws = p.k->ws; float* mod = (float*)(ws + WS_MOD);
    const float* c = PIN(I_C);
    for (int i = tid; i < 8192; i += NTHR) ca[i] = siluf_(c[i]);
    __syncthreads();
    for (int item = blockIdx.x; item < 192; item += gridDim.x) {
        const int l = item / 96, j = (item % 96) * 64 + lane;
        const float* w = PIN(I_WADA) + (size_t)l * 1024 * 6144 + j;
        float acc[8];
#pragma unroll
        for (int b = 0; b < 8; ++b) acc[b] = 0.f;
#pragma unroll 4
        for (int k = wave * 128; k < wave * 128 + 128; ++k) {
            const float wv = w[(size_t)k * 6144];
#pragma unroll
            for (int b = 0; b < 8; ++b) acc[b] += ca[b * 1024 + k] * wv;
        }
#pragma unroll
        for (int b = 0; b < 8; ++b) red[(wave * 8 + b) * 64 + lane] = acc[b];
        __syncthreads();
        { const int b = wave; float s = 0.f;
#pragma unroll
          for (int w8 = 0; w8 < 8; ++w8) s += red[(w8 * 8 + b) * 64 + lane];
          mod[((size_t)l * 8 + b) * 6144 + j] = s + PIN(I_BADA)[l * 6144 + j]; }
        __syncthreads();
    }
    const int* pos = (const int*)PIN(I_POS);
    float *cosP = (float*)(ws + WS_COSP), *sinP = (float*)(ws + WS_SINP), *cosM = (float*)(ws + WS_COSM), *sinM = (float*)(ws + WS_SINM);
    for (int i = blockIdx.x * NTHR + tid; i < T_ * 24; i += gridDim.x * NTHR) {
        const int m = i / 24, f = i % 24;
        double inv; if (f < 8) inv = pow(500000.0, -(double)(2 * f) / 16.0); else inv = pow(500000.0, -(double)(2 * (f - 8)) / 32.0);
        const float ang = (float)pos[m] * (float)inv;
        const double a = (double)ang, kq = rint(a * 0.15915494309189535), r = a - kq * 6.283185307179586476925;
        const float cs = (float)cos(r), sn = (float)sin(r);
        if (f < 8) { cosP[m * 8 + f] = cs; sinP[m * 8 + f] = sn; } else { cosM[m * 16 + f - 8] = cs; sinM[m * 16 + f - 8] = sn; }
    }
}
__device__ __forceinline__ void ph_prep(const MPK& p, int l, LAS unsigned char* lds, int tid) {
    const int wave = tid >> 6, lane = tid & 63;
    const int gw = blockIdx.x * NWAVES + wave, ngw = gridDim.x * NWAVES;
    unsigned char* ws = p.k->ws;
    LAS float* scr = (LAS float*)(lds + wave * 16384);
    constexpr int I0 = 16 * 80, I1 = 16 * 32, I2 = 16 * 176, I3 = 44 * 32, I4 = 4 * 24, I5 = 2 * 24, I6 = 32 * 2, I7 = 32 * 2, I8 = 8, I9 = 8;
    constexpr int NIT = I0 + I1 + I2 + I3 + I4 + I5 + I6 + I7 + I8 + I9;
    for (int it = gw; it < NIT; it += ngw) {
        int r = it;
        if (r < I0) { transpose_item(PIN(I_WIN) + (size_t)l * D_ * DIN, D_, DIN, MapIn{}, nullptr, (bf16*)(ws + WT_IN), scr, r, 80, lane); continue; } r -= I0;
        if (r < I1) { transpose_item(PIN(I_WOUT) + (size_t)l * D_ * D_, D_, D_, MapId{D_}, nullptr, (bf16*)(ws + WT_OUT), scr, r, 32, lane); continue; } r -= I1;
        if (r < I2) { transpose_item(PIN(I_WGU) + (size_t)l * D_ * 2 * FF, D_, 2 * FF, MapGU{}, nullptr, (bf16*)(ws + WT_GU), scr, r, 176, lane); continue; } r -= I2;
        if (r < I3) { transpose_item(PIN(I_WDOWN) + (size_t)l * FF * D_, FF, D_, MapId{D_}, nullptr, (bf16*)(ws + WT_DOWN), scr, r, 32, lane); continue; } r -= I3;
        if (r < I4) { transpose_item(PIN(I_WUQ) + (size_t)l * 256 * 576, 256, 576, MapId{576}, PIN(I_GQL) + l * 256, (bf16*)(ws + WT_UQ), scr, r, 24, lane); continue; } r -= I4;
        if (r < I5) { transpose_item(PIN(I_WUKV) + (size_t)l * 128 * 768, 128, 768, MapId{768}, PIN(I_GKVL) + l * 128, (bf16*)(ws + WT_UKV), scr, r, 24, lane); continue; } r -= I5;
        if (r < I6) { transpose_item(PIN(I_WCK) + (size_t)l * 2048 * 64, 2048, 64, MapId{64}, nullptr, (bf16*)(ws + WT_CK), scr, r, 2, lane); continue; } r -= I6;
        if (r < I7) { transpose_item(PIN(I_WCV) + (size_t)l * 2048 * 64, 2048, 64, MapId{64}, nullptr, (bf16*)(ws + WT_CV), scr, r, 2, lane); continue; } r -= I7;
        if (r < I8) { const int h = r >> 1; transpose_item(PIN(I_WQM) + (size_t)l * 16384 + h * 4096, 64, 64, MapId{64}, nullptr, (bf16*)(ws + WT_QM) + h * 4096, scr, r & 1, 2, lane); continue; } r -= I8;
        { const int h = r >> 1; transpose_item(PIN(I_WKM) + (size_t)l * 16384 + h * 4096, 64, 64, MapId{64}, nullptr, (bf16*)(ws + WT_KM) + h * 4096, scr, r & 1, 2, lane); }
    }
    const float* xin = (l == 0) ? PIN(I_X) : p.k->out;
    const float* modl = (const float*)(ws + WS_MOD) + (size_t)l * 8 * 6144;
    norm_rows(xin, PIN(I_GN1) + l * D_, modl + 0, modl + 1024, (bf16*)(ws + WS_HB), nullptr, 0, gw, ngw, lane);
}
__device__ __forceinline__ void ph_mixnorm(const MPK& p, int l, int tid) {
    const int gw = blockIdx.x * NWAVES + (tid >> 6), ngw = gridDim.x * NWAVES, lane = tid & 63;
    bf16* mix = (bf16*)(p.k->ws + WS_HB); const float* ga = PIN(I_GOA) + l * 384; const float* gb = PIN(I_GOB) + l * 384;
    for (int m = gw; m < T_; m += ngw) {
        bf16* r = mix + (size_t)m * D_;
        float va[6], vb[6]; float sa = 0.f, sb = 0.f;
#pragma unroll
        for (int j = 0; j < 6; ++j) { va[j] = bf2f(r[lane + 64 * j]); vb[j] = bf2f(r[384 + lane + 64 * j]); sa += va[j] * va[j]; sb += vb[j] * vb[j]; }
        const float ra = rsqrtf(wave_sum(sa) * (1.f / 384.f) + EPS), rb = rsqrtf(wave_sum(sb) * (1.f / 384.f) + EPS);
#pragma unroll
        for (int j = 0; j < 6; ++j) { r[lane + 64 * j] = f2bf(va[j] * ra * ga[lane + 64 * j]); r[384 + lane + 64 * j] = f2bf(vb[j] * rb * gb[lane + 64 * j]); }
    }
}


typedef short bf16x8 __attribute__((ext_vector_type(8)));
typedef short s16x4 __attribute__((ext_vector_type(4)));
typedef float f32x16 __attribute__((ext_vector_type(16)));
typedef unsigned u32x2v __attribute__((ext_vector_type(2)));
constexpr int AT_BUF = 20480, AT_K32 = 8192, AT_V = 12288;
__device__ __forceinline__ unsigned cvtpk(float lo, float hi) { unsigned r; asm volatile("v_cvt_pk_bf16_f32 %0, %1, %2" : "=v"(r) : "v"(lo), "v"(hi)); return r; }
__device__ __forceinline__ int crow(int r, int hi) { return (r & 3) + 8 * (r >> 2) + 4 * hi; }
__device__ __forceinline__ s16x4 vtr(LAS const unsigned char* p) { return __builtin_bit_cast(s16x4, __builtin_amdgcn_ds_read_tr16_b64_v4i16((LAS s16x4*)p)); }
enum { AM_CAUSAL = 0, AM_WINDOW = 1, AM_SLC = 2 };
struct AttnState { float m, l; f32x16 o[2]; };
template <int NC> struct TileRegs { v4u k; v4u k2; v4u v; };
template <int NC> __device__ __forceinline__ void at_load(TileRegs<NC>& r, const bf16* Kg, int ldk, const bf16* Vg, int ldv, const bf16* K2g, int ldk2, int tile, int tid) {
    const int key = tid >> 3, c = tid & 7;
    r.k = *(const v4u*)(Kg + (size_t)(tile * 64 + key) * ldk + 8 * c);
    r.v = *(const v4u*)(Vg + (size_t)(tile * 64 + key) * ldv + 8 * c);
    if (NC == 6) { if (tid < 256) r.k2 = *(const v4u*)(K2g + (size_t)(tile * 64 + (tid >> 2)) * ldk2 + 8 * (tid & 3)); }
}
template <int NC> __device__ __forceinline__ void at_store(const TileRegs<NC>& r, LAS unsigned char* buf, int tid) {
    const int key = tid >> 3, c = tid & 7;
    *(LAS v4u*)(buf + key * 128 + 16 * (c ^ ((key >> 1) & 7))) = r.k;
    *(LAS v4u*)(buf + AT_V + (c >> 2) * 4096 + key * 64 + (c & 3) * 16) = r.v;
    if (NC == 6) { if (tid < 256) { const int k2 = tid >> 2, c2 = tid & 3; *(LAS v4u*)(buf + AT_K32 + k2 * 64 + 16 * (c2 ^ ((k2 >> 2) & 3))) = r.k2; } }
}
template <int NC, int MODE> __device__ __forceinline__ void at_tile(AttnState& st, LAS const unsigned char* buf, const bf16x8 (&qf)[NC], int kpos0, int qpos, bool need_mask, bool sel_ok, int lane) {
    const int r32 = lane & 31, hi = lane >> 5;
    f32x16 p0 = {}, p1 = {};
#pragma unroll
    for (int cc = 0; cc < NC; ++cc) {
        bf16x8 k0, k1;
        if (cc < 4) { const int k0r = r32, k1r = 32 + r32;
            k0 = *(LAS const bf16x8*)(buf + k0r * 128 + 16 * ((2 * cc + hi) ^ ((k0r >> 1) & 7)));
            k1 = *(LAS const bf16x8*)(buf + k1r * 128 + 16 * ((2 * cc + hi) ^ ((k1r >> 1) & 7))); }
        else { const int k0r = r32, k1r = 32 + r32, c2 = 2 * (cc - 4) + hi;
            k0 = *(LAS const bf16x8*)(buf + AT_K32 + k0r * 64 + 16 * (c2 ^ ((k0r >> 2) & 3)));
            k1 = *(LAS const bf16x8*)(buf + AT_K32 + k1r * 64 + 16 * (c2 ^ ((k1r >> 2) & 3))); }
        p0 = __builtin_amdgcn_mfma_f32_32x32x16_bf16(k0, qf[cc], p0, 0, 0, 0);
        p1 = __builtin_amdgcn_mfma_f32_32x32x16_bf16(k1, qf[cc], p1, 0, 0, 0);
    }
    if (need_mask) {
        const float selterm = (MODE == AM_SLC && !sel_ok) ? -INFINITY : INFINITY;
        const int dbase = qpos - kpos0 - 4 * hi;
#pragma unroll
        for (int r = 0; r < 16; ++r) {
            const int d0 = dbase - ((r & 3) + 8 * (r >> 2)), d1 = d0 - 32;
            float l0 = ((float)d0 + 0.5f) * INFINITY, l1 = ((float)d1 + 0.5f) * INFINITY;
            if (MODE == AM_WINDOW) { l0 = fminf(l0, ((float)(511 - d0) + 0.5f) * INFINITY); l1 = fminf(l1, ((float)(511 - d1) + 0.5f) * INFINITY); }
            if (MODE == AM_SLC) { l0 = fminf(l0, selterm); l1 = fminf(l1, selterm); }
            p0[r] = fminf(p0[r], l0); p1[r] = fminf(p1[r], l1);
        }
    }
    float mx = fmaxf(p0[0], p1[0]);
#pragma unroll
    for (int r = 1; r < 16; ++r) mx = fmaxf(mx, fmaxf(p0[r], p1[r]));
    mx = fmaxf(mx, __shfl_xor(mx, 32));
    const float mn = fmaxf(st.m, mx), alpha = exp2f(st.m - mn);
    st.m = mn;
    float sum = 0.f;
#pragma unroll
    for (int r = 0; r < 16; ++r) { p0[r] = exp2f(p0[r] - mn); p1[r] = exp2f(p1[r] - mn); sum += p0[r] + p1[r]; }
    st.l = st.l * alpha + sum;
#pragma unroll
    for (int r = 0; r < 16; ++r) { st.o[0][r] *= alpha; st.o[1][r] *= alpha; }
    bf16x8 pf[4];
#pragma unroll
    for (int s2 = 0; s2 < 2; ++s2) {
        v4u a, b;
        a.x = cvtpk(p0[8 * s2 + 0], p0[8 * s2 + 1]); a.y = cvtpk(p0[8 * s2 + 2], p0[8 * s2 + 3]); a.z = cvtpk(p0[8 * s2 + 4], p0[8 * s2 + 5]); a.w = cvtpk(p0[8 * s2 + 6], p0[8 * s2 + 7]);
        b.x = cvtpk(p1[8 * s2 + 0], p1[8 * s2 + 1]); b.y = cvtpk(p1[8 * s2 + 2], p1[8 * s2 + 3]); b.z = cvtpk(p1[8 * s2 + 4], p1[8 * s2 + 5]); b.w = cvtpk(p1[8 * s2 + 6], p1[8 * s2 + 7]);
        pf[s2] = __builtin_bit_cast(bf16x8, a); pf[2 + s2] = __builtin_bit_cast(bf16x8, b);
    }
    LAS const unsigned char* vb = buf + AT_V + (4 * hi + ((lane & 15) >> 2)) * 64 + ((lane >> 4) & 1) * 32 + (lane & 3) * 8;
#pragma unroll
    for (int dh = 0; dh < 2; ++dh)
#pragma unroll
        for (int s4 = 0; s4 < 4; ++s4) {
            const s16x4 lo = vtr(vb + dh * 4096 + s4 * 1024), hh = vtr(vb + dh * 4096 + s4 * 1024 + 512);
            const bf16x8 vf = {lo[0], lo[1], lo[2], lo[3], hh[0], hh[1], hh[2], hh[3]};
            st.o[dh] = __builtin_amdgcn_mfma_f32_32x32x16_bf16(vf, pf[s4], st.o[dh], 0, 0, 0);
        }
}
template <int NC, int MODE> __device__ __forceinline__ void at_stream(AttnState& st, LAS unsigned char* lds, const bf16* Kg, int ldk, const bf16* Vg, int ldv, const bf16* K2g, int ldk2, int t0, int t1,
                                                                       const bf16x8 (&qf)[NC], int qpos, int qw0, unsigned selbits, int tid) {
    const int lane = tid & 63;
    TileRegs<NC> tr;
    at_load<NC>(tr, Kg, ldk, Vg, ldv, K2g, ldk2, t0, tid);
    at_store<NC>(tr, lds, tid);
    __syncthreads();
    for (int t = t0; t < t1; ++t) {
        LAS unsigned char* cur = lds + ((t - t0) & 1) * AT_BUF;
        LAS unsigned char* nxt = lds + (((t - t0) & 1) ^ 1) * AT_BUF;
        const bool more = (t + 1 < t1);
        if (more) at_load<NC>(tr, Kg, ldk, Vg, ldv, K2g, ldk2, t + 1, tid);
        const int k0 = t * 64;
        bool skip = k0 > qw0 + 31, need_mask = (k0 + 63 > qw0);
        if (MODE == AM_WINDOW) { skip = skip || (k0 + 63 < qw0 - 511); need_mask = need_mask || (k0 < qw0 + 31 - 511); }
        bool sel_ok = true;
        if (MODE == AM_SLC) { sel_ok = (selbits >> t) & 1u; const unsigned long long bal = __ballot(sel_ok); skip = skip || (bal == 0ull); need_mask = need_mask || (bal != ~0ull); }
        if (!skip) at_tile<NC, MODE>(st, cur, qf, k0, qpos, need_mask, sel_ok, lane);
        if (more) at_store<NC>(tr, nxt, tid);
        __syncthreads();
    }
}
__device__ __forceinline__ int next_item(unsigned* ctr, LAS unsigned char* lds, int wave_u) {
    const int tid = wave_u * 64 + fresh_lane();
    LAS int* slot = (LAS int*)(lds + RING_BYTES + 64);
    if (tid == 0) *slot = (int)atomicAdd(ctr, 1u);
    __syncthreads();
    const int v = *slot;
    __syncthreads();
    return v;
}
__device__ __forceinline__ void mla_unit(unsigned char* ws, LAS unsigned char* lds, int b, int h, int qt, int wave_u) {
    const int tid = wave_u * 64 + fresh_lane();
    const int lane = tid & 63, wave = tid >> 6, r32 = lane & 31, hi = lane >> 5;
    const int qw0 = qt * 256 + wave * 32, qpos = qw0 + r32; const size_t row = (size_t)b * S_ + qpos;
    bf16x8 qf[6];
    {
        const bf16* ql = (const bf16*)(ws + WS_QL) + row * 256 + 8 * hi;
        const int sw = (r32 & 0x13) | ((r32 & 4) << 1) | ((r32 & 8) >> 1);
        const bf16* wt = (const bf16*)(ws + WT_UQ) + (size_t)(h * 96 + sw) * 256 + 8 * hi;
        f32x16 qa[3] = {f32x16{}, f32x16{}, f32x16{}};
#pragma unroll 4
        for (int ks = 0; ks < 16; ++ks) {
            const bf16x8 bq = *(const bf16x8*)(ql + 16 * ks);
#pragma unroll
            for (int blk = 0; blk < 3; ++blk) { const bf16x8 aw = *(const bf16x8*)(wt + (size_t)blk * 32 * 256 + 16 * ks); qa[blk] = __builtin_amdgcn_mfma_f32_32x32x16_bf16(aw, bq, qa[blk], 0, 0, 0); }
        }
        float msc = MSCALE; asm volatile("" : "+v"(msc));
        const float rs = rsqrtf(((const float*)(ws + WS_SSQL))[row] * (1.f / 256.f) + EPS) * msc;
        const float* cm_ = (const float*)(ws + WS_COSM) + row * 16 + 8 * hi; const float* sm_ = (const float*)(ws + WS_SINM) + row * 16 + 8 * hi;
#pragma unroll
        for (int r = 0; r < 8; ++r) { const float x1 = qa[2][r], x2 = qa[2][r + 8], cs = cm_[r], sn = sm_[r]; qa[2][r] = x1 * cs - x2 * sn; qa[2][r + 8] = x1 * sn + x2 * cs; }
#pragma unroll
        for (int blk = 0; blk < 3; ++blk)
#pragma unroll
            for (int a2 = 0; a2 < 2; ++a2) { v4u w; w.x = cvtpk(qa[blk][8 * a2 + 0] * rs, qa[blk][8 * a2 + 1] * rs); w.y = cvtpk(qa[blk][8 * a2 + 2] * rs, qa[blk][8 * a2 + 3] * rs);
                w.z = cvtpk(qa[blk][8 * a2 + 4] * rs, qa[blk][8 * a2 + 5] * rs); w.w = cvtpk(qa[blk][8 * a2 + 6] * rs, qa[blk][8 * a2 + 7] * rs); qf[2 * blk + a2] = __builtin_bit_cast(bf16x8, w); }
    }
    AttnState st; st.m = -1e30f; st.l = 0.f; st.o[0] = f32x16{}; st.o[1] = f32x16{};
    const bf16* kvb = (const bf16*)(ws + WS_KVM) + (size_t)b * S_ * 768 + h * 128;
    at_stream<6, AM_CAUSAL>(st, lds, kvb, 768, kvb + 64, 768, (const bf16*)(ws + WS_KR) + (size_t)b * S_ * 32, 32, 0, 4 * qt + 4, qf, qpos, qw0, 0u, tid);
    const float lt = st.l + __shfl_xor(st.l, 32), il = 1.f / lt;
    bf16* op = (bf16*)(ws + WS_HB) + row * D_ + 384 + h * 64 + 4 * hi;
#pragma unroll
    for (int dh = 0; dh < 2; ++dh)
#pragma unroll
        for (int g4 = 0; g4 < 4; ++g4) { u32x2v w; w.x = cvtpk(st.o[dh][4 * g4] * il, st.o[dh][4 * g4 + 1] * il); w.y = cvtpk(st.o[dh][4 * g4 + 2] * il, st.o[dh][4 * g4 + 3] * il);
            *(u32x2v*)(op + dh * 32 + 8 * g4) = w; }
}
__device__ __forceinline__ void nsa_unit(unsigned char* ws, LAS unsigned char* lds, int b, int h, int qt, int wave_u) {
    const int tid = wave_u * 64 + fresh_lane();
    const int lane = tid & 63, wave = tid >> 6, r32 = lane & 31, hi = lane >> 5, g = h / 3;
    const int qw0 = qt * 256 + wave * 32, qpos = qw0 + r32; const size_t row = (size_t)b * S_ + qpos;
    const bf16* nsa = (const bf16*)(ws + WS_NSA);
    const bf16* qp = nsa + row * 1152 + h * 64 + 8 * hi;
    bf16x8 qf[4];
#pragma unroll
    for (int cc = 0; cc < 4; ++cc) qf[cc] = *(const bf16x8*)(qp + 16 * cc);
    const unsigned selbits = ((const unsigned*)(ws + WS_SEL))[(size_t)(b * 2 + g) * S_ + qpos];
    const float* gm = (const float*)(ws + WS_GM) + row * 32 + h * 3;
    const float g0 = gm[0], g1 = gm[1], g2 = gm[2];
    const bf16* kb = nsa + (size_t)b * S_ * 1152 + g * 64;
    f32x16 comb[2];
    { AttnState st; st.m = -1e30f; st.l = 0.f; st.o[0] = f32x16{}; st.o[1] = f32x16{};
      at_stream<4, AM_SLC>(st, lds, kb + 640, 1152, kb + 768, 1152, nullptr, 0, 0, 4 * qt + 4, qf, qpos, qw0, selbits, tid);
      const float lt = st.l + __shfl_xor(st.l, 32), f = g1 / lt;
#pragma unroll
      for (int r = 0; r < 16; ++r) { comb[0][r] = st.o[0][r] * f; comb[1][r] = st.o[1][r] * f; } }
    { AttnState st; st.m = -1e30f; st.l = 0.f; st.o[0] = f32x16{}; st.o[1] = f32x16{};
      const int t0 = (4 * qt - 8 > 0) ? 4 * qt - 8 : 0;
      at_stream<4, AM_WINDOW>(st, lds, kb + 896, 1152, kb + 1024, 1152, nullptr, 0, t0, 4 * qt + 4, qf, qpos, qw0, 0u, tid);
      const float lt = st.l + __shfl_xor(st.l, 32), f = g2 / lt;
#pragma unroll
      for (int r = 0; r < 16; ++r) { comb[0][r] += st.o[0][r] * f; comb[1][r] += st.o[1][r] * f; } }
    const bf16* oc = (const bf16*)(ws + WS_OCMP) + row * 384 + h * 64 + 4 * hi;
    bf16* op = (bf16*)(ws + WS_HB) + row * D_ + h * 64 + 4 * hi;
#pragma unroll
    for (int dh = 0; dh < 2; ++dh)
#pragma unroll
        for (int g4 = 0; g4 < 4; ++g4) {
            const u32x2v c = *(const u32x2v*)(oc + dh * 32 + 8 * g4);
            const float c0 = __uint_as_float(c.x << 16), c1 = __uint_as_float(c.x & 0xffff0000u), c2 = __uint_as_float(c.y << 16), c3 = __uint_as_float(c.y & 0xffff0000u);
            u32x2v w; w.x = cvtpk(comb[dh][4 * g4] + g0 * c0, comb[dh][4 * g4 + 1] + g0 * c1); w.y = cvtpk(comb[dh][4 * g4 + 2] + g0 * c2, comb[dh][4 * g4 + 3] + g0 * c3);
            *(u32x2v*)(op + dh * 32 + 8 * g4) = w; }
}
__device__ __forceinline__ void cmp_unit(unsigned char* ws, LAS unsigned char* lds, int b, int g, int qt, int wave_u) {
    const int tid = wave_u * 64 + fresh_lane();
    const int lane = tid & 63, wave = tid >> 6, r32 = lane & 31, hi = lane >> 5;
    const int qpos = qt * 256 + wave * 32 + r32; const size_t row = (size_t)b * S_ + qpos;
    const bf16* kc = (const bf16*)(ws + WS_KCV) + (size_t)(b * 2 + g) * 128 * 64; const bf16* vc = kc + (size_t)8 * 2 * 128 * 64;
    { TileRegs<4> tr; at_load<4>(tr, kc, 64, vc, 64, nullptr, 0, 0, tid); at_store<4>(tr, lds, tid); at_load<4>(tr, kc, 64, vc, 64, nullptr, 0, 1, tid); at_store<4>(tr, lds + AT_BUF, tid); }
    __syncthreads();
    int nvis = (qpos >= 31) ? ((qpos - 31) >> 4) + 1 : 0; if (nvis > 127) nvis = 127;
    LAS float* IG = (LAS float*)(lds + 2 * AT_BUF) + wave * (32 * 33) + r32 * 33;
    LAS float* IL = IG + 8 * 32 * 33;
    const bf16* nsa = (const bf16*)(ws + WS_NSA);
    LAS const unsigned char* vb = lds + AT_V + (4 * hi + ((lane & 15) >> 2)) * 64 + ((lane >> 4) & 1) * 32 + (lane & 3) * 8;
    for (int r3 = 0; r3 < 3; ++r3) {
        const int h = 3 * g + r3;
        const bf16* qp = nsa + row * 1152 + h * 64 + 8 * hi;
        bf16x8 qf[4];
#pragma unroll
        for (int cc = 0; cc < 4; ++cc) qf[cc] = *(const bf16x8*)(qp + 16 * cc);
        f32x16 p[4];
#pragma unroll
        for (int tb = 0; tb < 4; ++tb) {
            LAS const unsigned char* buf = lds + (tb >> 1) * AT_BUF; const int kr = (tb & 1) * 32 + r32;
            p[tb] = f32x16{};
#pragma unroll
            for (int cc = 0; cc < 4; ++cc) { const bf16x8 kf = *(LAS const bf16x8*)(buf + kr * 128 + 16 * ((2 * cc + hi) ^ ((kr >> 1) & 7)));
                p[tb] = __builtin_amdgcn_mfma_f32_32x32x16_bf16(kf, qf[cc], p[tb], 0, 0, 0); }
        }
        float mx = -1e30f;
#pragma unroll
        for (int tb = 0; tb < 4; ++tb)
#pragma unroll
            for (int r = 0; r < 16; ++r) { const int n = 32 * tb + crow(r, hi); p[tb][r] = fminf(p[tb][r], ((float)(nvis - n) - 0.5f) * INFINITY); mx = fmaxf(mx, p[tb][r]); }
        mx = fmaxf(mx, __shfl_xor(mx, 32));
        float sum = 0.f;
#pragma unroll
        for (int tb = 0; tb < 4; ++tb)
#pragma unroll
            for (int r = 0; r < 16; ++r) { p[tb][r] = exp2f(p[tb][r] - mx); sum += p[tb][r]; }
        sum += __shfl_xor(sum, 32);
        const float il = (nvis > 0) ? 1.f / sum : 0.f;
#pragma unroll
        for (int tb = 0; tb < 4; ++tb)
#pragma unroll
            for (int k = 0; k < 4; ++k) { const float a0 = p[tb][4 * k] * il, a1 = p[tb][4 * k + 1] * il, a2 = p[tb][4 * k + 2] * il, a3 = p[tb][4 * k + 3] * il;
                const int j = 2 * (4 * tb + k) + hi;
                const float gs = (a0 + a1) + (a2 + a3);
                if (r3 == 0) { IG[j] = gs; IL[j + 1] = a3; } else { IG[j] += gs; IL[j + 1] += a3; } }
        f32x16 o[2] = {f32x16{}, f32x16{}};
#pragma unroll
        for (int tb = 0; tb < 4; ++tb)
#pragma unroll
            for (int s2 = 0; s2 < 2; ++s2) {
                v4u a; a.x = cvtpk(p[tb][8 * s2 + 0], p[tb][8 * s2 + 1]); a.y = cvtpk(p[tb][8 * s2 + 2], p[tb][8 * s2 + 3]); a.z = cvtpk(p[tb][8 * s2 + 4], p[tb][8 * s2 + 5]); a.w = cvtpk(p[tb][8 * s2 + 6], p[tb][8 * s2 + 7]);
                const bf16x8 pf = __builtin_bit_cast(bf16x8, a);
                LAS const unsigned char* vbb = vb + (tb >> 1) * AT_BUF + ((tb & 1) * 2 + s2) * 1024;
#pragma unroll
                for (int dh = 0; dh < 2; ++dh) { const s16x4 lo = vtr(vbb + dh * 4096), hh = vtr(vbb + dh * 4096 + 512);
                    const bf16x8 vf = {lo[0], lo[1], lo[2], lo[3], hh[0], hh[1], hh[2], hh[3]};
                    o[dh] = __builtin_amdgcn_mfma_f32_32x32x16_bf16(vf, pf, o[dh], 0, 0, 0); }
                asm volatile("" ::: "memory");
            }
        bf16* op = (bf16*)(ws + WS_OCMP) + row * 384 + h * 64 + 4 * hi;
#pragma unroll
        for (int dh = 0; dh < 2; ++dh)
#pragma unroll
            for (int g4 = 0; g4 < 4; ++g4) { u32x2v w; w.x = cvtpk(o[dh][4 * g4] * il, o[dh][4 * g4 + 1] * il); w.y = cvtpk(o[dh][4 * g4 + 2] * il, o[dh][4 * g4 + 3] * il);
                *(u32x2v*)(op + dh * 32 + 8 * g4) = w; }
    }
    const int cur = qpos >> 6;
    LAS float* imp = IG;
#pragma unroll 1
    for (int jj = 0; jj < 16; ++jj) {
        const int j = 16 * hi + jj;
        float v = IG[j] + (j > 0 ? IL[j] : 0.f);
        if (j == 0 || j == cur || j == cur - 1) v = INFINITY;
        if (j * 64 > qpos) v = -INFINITY;
        IL[j] = v;
    }
#pragma unroll 1
    for (int jj = 0; jj < 16; ++jj) { const int j = 16 * hi + jj; imp[j] = IL[j]; }
    unsigned mask = 0;
#pragma unroll 1
    for (int jj = 0; jj < 16; ++jj) {
        const int j = 16 * hi + jj; const float v = imp[j]; int rank = 0;
#pragma unroll 4
        for (int k = 0; k < 32; ++k) { const float u2 = imp[k]; rank += (u2 > v || (u2 == v && k < j)) ? 1 : 0; }
        if (rank < 16) mask |= 1u << j;
    }
    mask |= (unsigned)__shfl_xor((int)mask, 32);
    if (hi == 0) ((unsigned*)(ws + WS_SEL))[(size_t)(b * 2 + g) * S_ + qpos] = mask;
    __syncthreads();
}
__device__ __forceinline__ void lora_rows(unsigned char* ws, int tid) {
    const int gw = blockIdx.x * NWAVES + (tid >> 6), ngw = gridDim.x * NWAVES, lane = tid & 63;
    bf16* kvl = (bf16*)(ws + WS_KVL); const bf16* ql = (const bf16*)(ws + WS_QL); float* ssql = (float*)(ws + WS_SSQL);
    for (int m = gw; m < T_; m += ngw) {
        const unsigned kv = *(const unsigned*)(kvl + (size_t)m * 128 + 2 * lane);
        const float k0 = __uint_as_float(kv << 16), k1 = __uint_as_float(kv & 0xffff0000u);
        const uint2 qv = *(const uint2*)(ql + (size_t)m * 256 + 4 * lane);
        const float q0 = __uint_as_float(qv.x << 16), q1 = __uint_as_float(qv.x & 0xffff0000u), q2 = __uint_as_float(qv.y << 16), q3 = __uint_as_float(qv.y & 0xffff0000u);
        const float sk = wave_sum(k0 * k0 + k1 * k1), sq = wave_sum((q0 * q0 + q1 * q1) + (q2 * q2 + q3 * q3));
        const float rk = rsqrtf(sk * (1.f / 128.f) + EPS);
        *(unsigned*)(kvl + (size_t)m * 128 + 2 * lane) = pk2(k0 * rk, k1 * rk);
        if (lane == 0) ssql[m] = sq;
    }
}
__device__ __forceinline__ void post_misc(unsigned char* ws, const float* big, const float* bfg, int tid) {
    const float* mr = (const float*)(ws + WS_MISCRAW); const float* cosM = (const float*)(ws + WS_COSM); const float* sinM = (const float*)(ws + WS_SINM);
    bf16* kr = (bf16*)(ws + WS_KR); float* gm = (float*)(ws + WS_GM);
    for (int idx = blockIdx.x * NTHR + tid; idx < T_ * 64; idx += gridDim.x * NTHR) {
        const int row = idx >> 6, c = idx & 63; const float* r = mr + (size_t)row * 64; const float v = r[c];
        if (c < 32) { const int i = c & 15; const float x1 = r[i], x2 = r[16 + i], cs = cosM[row * 16 + i], sn = sinM[row * 16 + i];
            kr[(size_t)row * 32 + c] = f2bf((c < 16) ? x1 * cs - x2 * sn : x1 * sn + x2 * cs); }
        else if (c < 50) gm[(size_t)row * 32 + (c - 32)] = 1.f / (1.f + __expf(-v));
        else if (c < 54) gm[(size_t)row * 32 + 18 + (c - 50)] = v + big[c - 50];
        else if (c < 58) { const float z = v + bfg[c - 54]; gm[(size_t)row * 32 + 22 + (c - 54)] = fminf(z, 0.f) - __logf(1.f + __expf(-fabsf(z))); }
    }
}

typedef float f32x4v __attribute__((ext_vector_type(4)));
__device__ __forceinline__ void compress_item(unsigned char* ws, LAS unsigned char* lds, const float* cmp_pos, int item, int wave_u) {
    const int lane = fresh_lane(), tid = wave_u * 64 + lane;
    const int nb = item & 7, g = (item >> 3) & 1, b = (item >> 4) & 7, kv = item >> 7;
    const bf16* tok = (const bf16*)(ws + WS_NSA) + (size_t)b * S_ * 1152 + (kv ? 512 : 384) + g * 64;
    const bf16* wt = (const bf16*)(ws + (kv ? WT_CV : WT_CK));
    const int nrow = nb * 16 + (lane & 15), kq = lane >> 4;
    f32x4v acc[4] = {f32x4v{}, f32x4v{}, f32x4v{}, f32x4v{}};
#pragma unroll 2
    for (int ks = 0; ks < 8; ++ks) {
        const int k = wave_u * 256 + ks * 32 + kq * 8, l = k >> 6, d = k & 63;
        int trow = 16 * nrow + l; trow = trow < S_ ? trow : S_ - 1;
        const v4u t4 = *(const v4u*)(tok + (size_t)trow * 1152 + d);
        const f32x4v p0 = *(const f32x4v*)(cmp_pos + k), p1 = *(const f32x4v*)(cmp_pos + k + 4);
        v4u a4;
        a4.x = cvtpk(__uint_as_float(t4.x << 16) + p0[0], __uint_as_float(t4.x & 0xffff0000u) + p0[1]); a4.y = cvtpk(__uint_as_float(t4.y << 16) + p0[2], __uint_as_float(t4.y & 0xffff0000u) + p0[3]);
        a4.z = cvtpk(__uint_as_float(t4.z << 16) + p1[0], __uint_as_float(t4.z & 0xffff0000u) + p1[1]); a4.w = cvtpk(__uint_as_float(t4.w << 16) + p1[2], __uint_as_float(t4.w & 0xffff0000u) + p1[3]);
        const bf16x8 af = __builtin_bit_cast(bf16x8, a4);
#pragma unroll
        for (int cb = 0; cb < 4; ++cb) { const bf16x8 bfr = *(const bf16x8*)(wt + (size_t)(cb * 16 + (lane & 15)) * 2048 + k);
            acc[cb] = __builtin_amdgcn_mfma_f32_16x16x32_bf16(af, bfr, acc[cb], 0, 0, 0); }
    }
    LAS float* red = (LAS float*)lds + wave_u * 1024;
#pragma unroll
    for (int cb = 0; cb < 4; ++cb)
#pragma unroll
        for (int r = 0; r < 4; ++r) red[(4 * (lane >> 4) + r) * 64 + cb * 16 + (lane & 15)] = acc[cb][r];
    __syncthreads();
    bf16* out = (bf16*)(ws + WS_KCV) + (size_t)kv * (8 * 2 * 128 * 64) + ((size_t)(b * 2 + g) * 128 + nb * 16) * 64;
    for (int o = tid; o < 1024; o += NTHR) { float sum = 0.f;
#pragma unroll
        for (int w8 = 0; w8 < 8; ++w8) sum += ((LAS float*)lds)[w8 * 1024 + o];
        out[o] = f2bf(sum); }
    __syncthreads();
}
__device__ __forceinline__ f32x4v mm16(const LAS bf16* A, int lda, int arow0, const LAS bf16* Bt, int ldb, int bcol0, int K, int lane, f32x4v acc) {
    const LAS bf16* ap = A + (arow0 + (lane & 15)) * lda + 8 * (lane >> 4); const LAS bf16* bp = Bt + (bcol0 + (lane & 15)) * ldb + 8 * (lane >> 4);
    for (int k = 0; k < K; k += 32) acc = __builtin_amdgcn_mfma_f32_16x16x32_bf16(*(const LAS bf16x8*)(ap + k), *(const LAS bf16x8*)(bp + k), acc, 0, 0, 0);
    return acc;
}
constexpr int ML_LD = 72;
__device__ __forceinline__ void mlocal_item(unsigned char* ws, LAS unsigned char* lds, const float* convw, const float* convb, const float* big, const float* bfg, int chunk, int wave_u) {
    const int lane = fresh_lane(), tid = wave_u * 64 + lane;
    const int c = chunk & 31, h = (chunk >> 5) & 3, b = chunk >> 7, row0 = b * S_ + c * 64;
    LAS bf16* XS = (LAS bf16*)lds;
    LAS bf16* WQ = XS + 64 * ML_LD;
    LAS bf16* WK = WQ + 64 * ML_LD;
    LAS bf16* VT = WK + 64 * ML_LD;
    LAS bf16* WKT = VT + 64 * ML_LD;
    LAS float* wl = (LAS float*)(WKT + 64 * ML_LD);
    const bf16* cm = (const bf16*)(ws + WS_CM);
    {
        const int l = tid >> 3, ch0 = (tid & 7) * 8, row = row0 + l, s = c * 64 + l;
        float a[8];
#pragma unroll
        for (int i = 0; i < 8; ++i) a[i] = convb[h * 64 + ch0 + i];
#pragma unroll
        for (int j = 0; j < 4; ++j) { if (s - 3 + j >= 0) { const v4u x4 = *(const v4u*)(cm + (size_t)(row - 3 + j) * 768 + h * 64 + ch0);
            const float* cw = convw + j * 256 + h * 64 + ch0;
            a[0] += cw[0] * __uint_as_float(x4.x << 16); a[1] += cw[1] * __uint_as_float(x4.x & 0xffff0000u); a[2] += cw[2] * __uint_as_float(x4.y << 16); a[3] += cw[3] * __uint_as_float(x4.y & 0xffff0000u);
            a[4] += cw[4] * __uint_as_float(x4.z << 16); a[5] += cw[5] * __uint_as_float(x4.z & 0xffff0000u); a[6] += cw[6] * __uint_as_float(x4.w << 16); a[7] += cw[7] * __uint_as_float(x4.w & 0xffff0000u); } }
        v4u o4; float r[8];
#pragma unroll
        for (int i = 0; i < 8; ++i) r[i] = a[i] / (1.f + __expf(-a[i]));
        o4.x = cvtpk(r[0], r[1]); o4.y = cvtpk(r[2], r[3]); o4.z = cvtpk(r[4], r[5]); o4.w = cvtpk(r[6], r[7]);
        *(v4u*)((bf16*)(ws + WS_XC) + (size_t)row * 256 + h * 64 + ch0) = o4;
        *(LAS v4u*)(XS + l * ML_LD + ch0) = o4;
        const v4u v4 = *(const v4u*)(cm + (size_t)row * 768 + 256 + h * 64 + ch0);
        VT[(ch0 + 0) * ML_LD + l] = (bf16)(v4.x & 0xffffu); VT[(ch0 + 1) * ML_LD + l] = (bf16)(v4.x >> 16); VT[(ch0 + 2) * ML_LD + l] = (bf16)(v4.y & 0xffffu); VT[(ch0 + 3) * ML_LD + l] = (bf16)(v4.y >> 16);
        VT[(ch0 + 4) * ML_LD + l] = (bf16)(v4.z & 0xffffu); VT[(ch0 + 5) * ML_LD + l] = (bf16)(v4.z >> 16); VT[(ch0 + 6) * ML_LD + l] = (bf16)(v4.w & 0xffffu); VT[(ch0 + 7) * ML_LD + l] = (bf16)(v4.w >> 16);
        const int e = tid >> 3, d0 = (tid & 7) * 8;
        *(LAS v4u*)(WQ + e * ML_LD + d0) = *(const v4u*)((const bf16*)(ws + WT_QM) + h * 4096 + e * 64 + d0);
        *(LAS v4u*)(WK + e * ML_LD + d0) = *(const v4u*)((const bf16*)(ws + WT_KM) + h * 4096 + e * 64 + d0);
    }
    if (wave_u == 0) {
        const float* mr = (const float*)(ws + WS_MISCRAW) + (size_t)(row0 + lane) * 64;
        const float z = mr[54 + h] + bfg[h]; float lf = fminf(z, 0.f) - __logf(1.f + __expf(-fabsf(z)));
        const float ig = mr[50 + h] + big[h];
#pragma unroll
        for (int o = 1; o < 64; o <<= 1) { const float t = __shfl_up(lf, o); if (lane >= o) lf += t; }
        const float bL = __shfl(lf, 63);
        const float a = bL - lf + ig; float mx = a;
#pragma unroll
        for (int o = 1; o < 64; o <<= 1) mx = fmaxf(mx, __shfl_xor(mx, o));
        wl[lane] = __expf(a - mx);
        if (lane == 0) { ((float*)(ws + WS_ML))[chunk] = mx; ((float*)(ws + WS_BL))[chunk] = bL; }
    }
    __syncthreads();
    {
        const int lb = wave_u & 3; const bool isk = wave_u >= 4;
        const LAS bf16* Wt = isk ? WK : WQ;
        bf16* og = (bf16*)(ws + (isk ? WS_MK : WS_MQ)) + (size_t)(row0 + 16 * lb + 4 * (lane >> 4)) * 256 + h * 64 + (lane & 15);
        float w4[4];
#pragma unroll
        for (int r = 0; r < 4; ++r) w4[r] = wl[16 * lb + 4 * (lane >> 4) + r];
#pragma unroll
        for (int eb = 0; eb < 4; ++eb) {
            f32x4v acc = mm16(XS, ML_LD, 16 * lb, Wt, ML_LD, 16 * eb, 64, lane, f32x4v{});
            if (!isk) {
#pragma unroll
                for (int r = 0; r < 4; ++r) og[(size_t)r * 256 + 16 * eb] = f2bf(acc[r] * 0.125f);
            } else {
                bf16 kb[4];
#pragma unroll
                for (int r = 0; r < 4; ++r) { kb[r] = f2bf(acc[r]); og[(size_t)r * 256 + 16 * eb] = kb[r]; }
                u32x2v w2; w2.x = cvtpk(bf2f(kb[0]) * w4[0], bf2f(kb[1]) * w4[1]); w2.y = cvtpk(bf2f(kb[2]) * w4[2], bf2f(kb[3]) * w4[3]);
                *(LAS u32x2v*)(WKT + (16 * eb + (lane & 15)) * ML_LD + 16 * lb + 4 * (lane >> 4)) = w2;
            }
        }
    }
    __syncthreads();
    {
        float* ct = (float*)(ws + WS_CT) + (size_t)chunk * 4096;
#pragma unroll
        for (int i = 0; i < 2; ++i) { const int blk = wave_u * 2 + i, eb = blk >> 2, db = blk & 3;
            const f32x4v acc = mm16(VT, ML_LD, 16 * eb, WKT, ML_LD, 16 * db, 64, lane, f32x4v{});
#pragma unroll
            for (int r = 0; r < 4; ++r) ct[(16 * eb + 4 * (lane >> 4) + r) * 64 + 16 * db + (lane & 15)] = acc[r]; }
        if (tid < 64) { float n = 0.f; const LAS bf16* wr_ = WKT + tid * ML_LD;
            for (int l = 0; l < 64; ++l) n += bf2f(wr_[l]);
            ((float*)(ws + WS_NL))[chunk * 64 + tid] = n; }
    }
    __syncthreads();
}
__device__ __forceinline__ void mscan_item(unsigned char* ws, int item, int wave_u) {
    const int tid = wave_u * 64 + fresh_lane();
    const int bh = item / 9, part = item % 9;
    if (part == 8 && tid >= 64) return;
    float* base; size_t stride;
    if (part < 8) { base = (float*)(ws + WS_CT) + (size_t)bh * 32 * 4096 + part * 512 + tid; stride = 4096; } else { base = (float*)(ws + WS_NL) + (size_t)bh * 32 * 64 + tid; stride = 64; }
    const float* ML = (const float*)(ws + WS_ML); const float* BL = (const float*)(ws + WS_BL); float* MPv = (float*)(ws + WS_MP);
    float Cv = 0.f, m = 0.f;
    for (int c = 0; c < 32; ++c) {
        const float cl = base[(size_t)c * stride], ml = ML[bh * 32 + c], bl = BL[bh * 32 + c];
        base[(size_t)c * stride] = Cv;
        if (part == 8 && tid == 0) MPv[bh * 32 + c] = m;
        const float mn = fmaxf(bl + m, ml);
        Cv = __expf(bl + m - mn) * Cv + __expf(ml - mn) * cl; m = mn;
    }
}
__device__ __forceinline__ void mout_item(unsigned char* ws, LAS unsigned char* lds, const float* gmh, const float* skip, int chunk, int wave_u) {
    const int lane = fresh_lane(), tid = wave_u * 64 + lane;
    const int c = chunk & 31, h = (chunk >> 5) & 3, b = chunk >> 7, row0 = b * S_ + c * 64;
    LAS bf16* QS = (LAS bf16*)lds;
    LAS bf16* KS = QS + 64 * ML_LD;
    LAS bf16* VT = KS + 64 * ML_LD;
    LAS bf16* CP = VT + 64 * ML_LD;
    LAS bf16* SW = CP + 64 * ML_LD;
    LAS float* HS = (LAS float*)(SW + 64 * ML_LD);
    LAS float* bs = HS + 64 * 65; LAS float* us = bs + 64; LAS float* ns = us + 64; LAS float* mts = ns + 64; LAS float* ints = mts + 64; LAS float* dinv = ints + 64;
    const float* gm = (const float*)(ws + WS_GM);
    {
        const int l = tid >> 3, c0 = (tid & 7) * 8, row = row0 + l;
        *(LAS v4u*)(QS + l * ML_LD + c0) = *(const v4u*)((const bf16*)(ws + WS_MQ) + (size_t)row * 256 + h * 64 + c0);
        *(LAS v4u*)(KS + l * ML_LD + c0) = *(const v4u*)((const bf16*)(ws + WS_MK) + (size_t)row * 256 + h * 64 + c0);
        const v4u v4 = *(const v4u*)((const bf16*)(ws + WS_CM) + (size_t)row * 768 + 256 + h * 64 + c0);
        VT[(c0 + 0) * ML_LD + l] = (bf16)(v4.x & 0xffffu); VT[(c0 + 1) * ML_LD + l] = (bf16)(v4.x >> 16); VT[(c0 + 2) * ML_LD + l] = (bf16)(v4.y & 0xffffu); VT[(c0 + 3) * ML_LD + l] = (bf16)(v4.y >> 16);
        VT[(c0 + 4) * ML_LD + l] = (bf16)(v4.z & 0xffffu); VT[(c0 + 5) * ML_LD + l] = (bf16)(v4.z >> 16); VT[(c0 + 6) * ML_LD + l] = (bf16)(v4.w & 0xffffu); VT[(c0 + 7) * ML_LD + l] = (bf16)(v4.w >> 16);
        const float* ct = (const float*)(ws + WS_CT) + (size_t)chunk * 4096 + l * 64 + c0;
        const f32x4v c0v = *(const f32x4v*)ct, c1v = *(const f32x4v*)(ct + 4);
        v4u cw; cw.x = cvtpk(c0v[0], c0v[1]); cw.y = cvtpk(c0v[2], c0v[3]); cw.z = cvtpk(c1v[0], c1v[1]); cw.w = cvtpk(c1v[2], c1v[3]);
        *(LAS v4u*)(CP + l * ML_LD + c0) = cw;
    }
    if (wave_u == 0) {
        const float ig = gm[(size_t)(row0 + lane) * 32 + 18 + h]; float lf = gm[(size_t)(row0 + lane) * 32 + 22 + h];
#pragma unroll
        for (int o = 1; o < 64; o <<= 1) { const float t = __shfl_up(lf, o); if (lane >= o) lf += t; }
        const float u = ig - lf; float cu = u;
#pragma unroll
        for (int o = 1; o < 64; o <<= 1) { const float t = __shfl_up(cu, o); if (lane >= o) cu = fmaxf(cu, t); }
        const float mprev = ((const float*)(ws + WS_MP))[chunk];
        const float mt = lf + fmaxf(mprev, cu);
        bs[lane] = lf; us[lane] = u; mts[lane] = mt; ints[lane] = __expf(lf + mprev - mt); ns[lane] = ((const float*)(ws + WS_NL))[chunk * 64 + lane];
    }
    __syncthreads();
    {
#pragma unroll
        for (int i = 0; i < 2; ++i) { const int blk = wave_u * 2 + i, lb = blk >> 2, sb = blk & 3;
            f32x4v acc = f32x4v{};
            if (sb <= lb) acc = mm16(QS, ML_LD, 16 * lb, KS, ML_LD, 16 * sb, 64, lane, acc);
            const int sidx = 16 * sb + (lane & 15); const float usv = us[sidx];
#pragma unroll
            for (int r = 0; r < 4; ++r) { const int l = 16 * lb + 4 * (lane >> 4) + r;
                const float v = (sidx <= l) ? acc[r] * __expf(bs[l] + usv - mts[l]) : 0.f;
                SW[l * ML_LD + sidx] = f2bf(v); } }
    }
    __syncthreads();
    if (tid < 64) {
        const int l = tid; float qn = 0.f, ssum = 0.f;
        for (int d = 0; d < 64; ++d) { qn += bf2f(QS[l * ML_LD + d]) * ns[d]; ssum += bf2f(SW[l * ML_LD + d]); }
        const float den = ints[l] * qn + ssum;
        dinv[l] = 1.f / fmaxf(fabsf(den), __expf(-mts[l]));
    }
    f32x4v hq[2], hs2[2];
#pragma unroll
    for (int i = 0; i < 2; ++i) { const int blk = wave_u * 2 + i, lb = blk >> 2, eb = blk & 3;
        hq[i] = mm16(QS, ML_LD, 16 * lb, CP, ML_LD, 16 * eb, 64, lane, f32x4v{});
        hs2[i] = mm16(SW, ML_LD, 16 * lb, VT, ML_LD, 16 * eb, 16 * lb + 16 <= 32 ? 32 : 64, lane, f32x4v{}); }
    __syncthreads();
#pragma unroll
    for (int i = 0; i < 2; ++i) { const int blk = wave_u * 2 + i, lb = blk >> 2, eb = blk & 3; const int e = 16 * eb + (lane & 15);
#pragma unroll
        for (int r = 0; r < 4; ++r) { const int l = 16 * lb + 4 * (lane >> 4) + r;
            const float og = bf2f(((const bf16*)(ws + WS_CM))[(size_t)(row0 + l) * 768 + 512 + h * 64 + e]);
            HS[l * 65 + e] = (ints[l] * hq[i][r] + hs2[i][r]) * dinv[l] / (1.f + __expf(-og)); } }
    __syncthreads();
    {
        const int l = tid >> 3, e0 = (tid & 7) * 8, row = row0 + l;
        float v[8]; float mu = 0.f;
#pragma unroll
        for (int i = 0; i < 8; ++i) { v[i] = HS[l * 65 + e0 + i]; mu += v[i]; }
        mu += __shfl_xor(mu, 1); mu += __shfl_xor(mu, 2); mu += __shfl_xor(mu, 4); mu *= (1.f / 64.f);
        float var = 0.f;
#pragma unroll
        for (int i = 0; i < 8; ++i) { const float dl = v[i] - mu; var += dl * dl; }
        var += __shfl_xor(var, 1); var += __shfl_xor(var, 2); var += __shfl_xor(var, 4);
        const float rs = rsqrtf(var * (1.f / 64.f) + EPS);
        const v4u x4 = *(const v4u*)((const bf16*)(ws + WS_XC) + (size_t)row * 256 + h * 64 + e0);
        float xv[8]; xv[0] = __uint_as_float(x4.x << 16); xv[1] = __uint_as_float(x4.x & 0xffff0000u); xv[2] = __uint_as_float(x4.y << 16); xv[3] = __uint_as_float(x4.y & 0xffff0000u);
        xv[4] = __uint_as_float(x4.z << 16); xv[5] = __uint_as_float(x4.z & 0xffff0000u); xv[6] = __uint_as_float(x4.w << 16); xv[7] = __uint_as_float(x4.w & 0xffff0000u);
        float r[8];
#pragma unroll
        for (int i = 0; i < 8; ++i) r[i] = (v[i] - mu) * rs * gmh[h * 64 + e0 + i] + skip[h * 64 + e0 + i] * xv[i];
        v4u w4; w4.x = cvtpk(r[0], r[1]); w4.y = cvtpk(r[2], r[3]); w4.z = cvtpk(r[4], r[5]); w4.w = cvtpk(r[6], r[7]);
        *(v4u*)((bf16*)(ws + WS_HB) + (size_t)row * D_ + 768 + h * 64 + e0) = w4;
    }
    __syncthreads();
}

__global__ void __launch_bounds__(NTHR, 2) mega(MP p_unused) {
    extern __shared__ __attribute__((aligned(16))) unsigned char lds_raw[];
    LAS unsigned char* lds = (LAS unsigned char*)lds_raw;
    const int wave0 = __builtin_amdgcn_readfirstlane((int)threadIdx.x >> 6);
    const int tid0 = wave0 * 64 + fresh_lane();
    volatile LAS unsigned* MISC = (volatile LAS unsigned*)(lds + MISC_OFF);
    for (int u = tid0; u < (LDS_BYTES - RING_BYTES) / 4; u += NTHR) ((LAS unsigned*)(lds + RING_BYTES))[u] = 0u;
    __syncthreads();
    typedef const __attribute__((address_space(4))) MP* kmp_t;
    kmp_t kp0 = (kmp_t)__builtin_amdgcn_kernarg_segment_ptr();
    unsigned char* ws0 = kp0->ws; const int coop = kp0->coop, ph_lo = kp0->ph_lo, ph_hi = kp0->ph_hi;
    XcdBarrier bar; bar.bar = (unsigned*)(ws0 + WS_CTL) + CW_BAR; bar.x = 0; bar.st = nullptr;
    if (coop) bar = xcd_barrier_post((unsigned*)(ws0 + WS_CTL) + CW_BAR, MISC + 8, tid0);
    if (coop == 2) cooperative_groups::this_grid().sync();
    int ph = ph_lo;
    if (ph == 0) {
        const MPK p{kp0}; ph_p0(p, lds, wave0 * 64 + fresh_lane()); ph = 1;
        if (ph < ph_hi) xcd_barrier(bar, wave0 * 64 + fresh_lane());
    }
    bool second = false;
    for (; ph < ph_hi; ++ph) {
        kmp_t kp = kp0; asm volatile("" : "+s"(kp));
        const MPK p{kp}; unsigned char* ws = kp->ws;
#define TID_ (wave0 * 64 + fresh_lane())
#define GW_ (blockIdx.x * NWAVES + wave0)
#define NGW_ (gridDim.x * NWAVES)
        const int l = (ph - 1) / PPL, ty = (ph == 0) ? -1 : (ph == NPH - 1) ? -2 : (ph - 1) % PPL;
        const float* modl = (const float*)(ws + WS_MOD) + (size_t)l * 8 * 6144;
        if (ty == -2) norm_rows(p.k->out, PIN(I_GFIN), nullptr, nullptr, nullptr, p.k->out, 2, GW_, NGW_, fresh_lane());
        else if (ty == 0 && (PHM & 2)) ph_prep(p, l, lds, TID_);
        else if (ty == 1 && (PHM & 4)) {
            pg8::Gemm g{(const bf16*)(ws + WS_HB), (const bf16*)(ws + WT_IN), T_, 2560, D_}; pg8::StaticOrder S; S.init(T_, 2560, gridDim.x, blockIdx.x);
            pg8::EpiIn E{ws, PIN(I_BIG) + l * 4, PIN(I_BFG) + l * 4};
            pg8::gemm_phase<pg8::EpiIn, pg8::StaticOrder, true, true>(lds, g, S, E, wave0);
        }
        else if (ty == 2 && (PHM & 64)) {
            lora_rows(ws, TID_);
            post_misc(ws, PIN(I_BIG) + l * 4, PIN(I_BFG) + l * 4, TID_);
            unsigned* ctr = (unsigned*)(ws + WS_CTL) + 64 * (1 + ph) + (second ? 32 : 0);
            for (;;) { const int it = next_item(ctr, lds, wave0); if (it >= 1024 + 256) break;
                if (second && (REP_MASK & (1 << 18)) && it >= 1024) continue; if (second && (REP_MASK & (1 << 19)) && it < 1024) continue;
                if (it < 1024) mlocal_item(ws, lds, PIN(I_CONVW) + l * 1024, PIN(I_CONVB) + l * 256, PIN(I_BIG) + l * 4, PIN(I_BFG) + l * 4, it, wave0);
                else compress_item(ws, lds, PIN(I_CMPPOS) + l * 2048, it - 1024, wave0); }
        }
        else if (ty == 3 && (PHM & 64)) {
            pg8::Gemm g{(const bf16*)(ws + WS_KVL), (const bf16*)(ws + WT_UKV), T_, 768, 128}; pg8::StaticOrder S; S.init(T_, 768, gridDim.x, blockIdx.x);
            pg8::EpiUKV E{(bf16*)(ws + WS_KVM)}; pg8::gemm_phase<pg8::EpiUKV, pg8::StaticOrder, true, true>(lds, g, S, E, wave0);
        }
        else if (ty == 4 && (PHM & 128)) {
            unsigned* ctr = (unsigned*)(ws + WS_CTL) + 64 * (1 + ph) + (second ? 32 : 0);
            for (;;) { const int it = next_item(ctr, lds, wave0); if (it >= 384 + 128 + (second ? 0 : 288)) break;
                if (second && (REP_MASK & (1 << 20)) && it >= 384) continue; if (second && (REP_MASK & (1 << 21)) && it < 384) continue;
                if (it < 384) mla_unit(ws, lds, (it % 48) / 6, (it % 48) % 6, 7 - it / 48, wave0);
                else if (it < 512) { const int u = it - 384; cmp_unit(ws, lds, u >> 4, (u >> 3) & 1, u & 7, wave0); }
                else mscan_item(ws, it - 512, wave0); }
        }
        else if (ty == 5 && (PHM & 256)) {
            unsigned* ctr = (unsigned*)(ws + WS_CTL) + 64 * (1 + ph) + (second ? 32 : 0);
            for (;;) { const int u = next_item(ctr, lds, wave0); if (u >= 384 + 1024) break;
                if (second && (REP_MASK & (1 << 16)) && u >= 384) continue; if (second && (REP_MASK & (1 << 17)) && u < 384) continue;
                if (u < 384) nsa_unit(ws, lds, (u % 48) / 6, (u % 48) % 6, 7 - u / 48, wave0);
                else mout_item(ws, lds, PIN(I_GMH) + l * 256, PIN(I_SKIP) + l * 256, u - 384, wave0); }
        }
        else if (ty == 6) ph_mixnorm(p, l, TID_);
        else if (ty == 7 && (PHM & 8)) {
            pg8::Gemm g{(const bf16*)(ws + WS_HB), (const bf16*)(ws + WT_OUT), T_, D_, D_}; pg8::StaticOrder S; S.init(T_, D_, gridDim.x, blockIdx.x);
            pg8::EpiRes E{(l == 0) ? PIN(I_X) : p.k->out, p.k->out, modl + 2048};
            pg8::gemm_phase<pg8::EpiRes, pg8::StaticOrder, true, true>(lds, g, S, E, wave0);
        }
        else if (ty == 8) norm_rows(p.k->out, PIN(I_GN2) + l * D_, modl + 3072, modl + 4096, (bf16*)(ws + WS_HB), nullptr, 1, GW_, NGW_, fresh_lane());
        else if (ty == 9 && (PHM & 16)) {
            pg8::Gemm g{(const bf16*)(ws + WS_HB), (const bf16*)(ws + WT_GU), T_, 2 * FF, D_}; pg8::StaticOrder S; S.init(T_, 2 * FF, gridDim.x, blockIdx.x);
            pg8::EpiGU E{(bf16*)(ws + WS_ACT)};
            pg8::gemm_phase<pg8::EpiGU, pg8::StaticOrder, true, true>(lds, g, S, E, wave0);
        }
        else if (ty == 10 && (PHM & 32)) {
            pg8::Gemm g{(const bf16*)(ws + WS_ACT), (const bf16*)(ws + WT_DOWN), T_, D_, FF}; pg8::StaticOrder S; S.init(T_, D_, gridDim.x, blockIdx.x);
            pg8::EpiRes E{p.k->out, p.k->out, modl + 5120};
            pg8::gemm_phase<pg8::EpiRes, pg8::StaticOrder, true, true>(lds, g, S, E, wave0);
        }
        if (REP_MASK != 0 && ty >= 0 && ((REP_MASK >> ty) & 1) && !second) { second = true; --ph; } else second = false;
        if (ph + 1 < ph_hi) xcd_barrier(bar, wave0 * 64 + fresh_lane());
    }
}

__global__ void k_post_misc(const float* mr, const float* cosM, const float* sinM, const float* big, const float* bfg, bf16* km, float* gm) {
    const int idx = blockIdx.x * blockDim.x + threadIdx.x;
    if (idx >= T_ * 64) return;
    const int row = idx >> 6, c = idx & 63; const float* r = mr + (size_t)row * 64; const float v = r[c];
    if (c < 32) { const int i = c & 15; const float x1 = r[i], x2 = r[16 + i], cs = cosM[row * 16 + i], sn = sinM[row * 16 + i];
        const bf16 o = f2bf((c < 16) ? x1 * cs - x2 * sn : x1 * sn + x2 * cs);
        for (int h = 0; h < 6; ++h) km[(size_t)row * 576 + h * 96 + 64 + c] = o; }
    else if (c < 50) gm[(size_t)row * 32 + (c - 32)] = sigmoidf_(v);
    else if (c < 54) gm[(size_t)row * 32 + 18 + (c - 50)] = v + big[c - 50];
    else if (c < 58) { const float z = v + bfg[c - 54]; gm[(size_t)row * 32 + 22 + (c - 54)] = fminf(z, 0.f) - log1pf(__expf(-fabsf(z))); }
}
static void run_mega(const MP& base, int lo, int hi, hipStream_t stream) {
    for (int ph = lo; ph < hi; ++ph) { MP a = base; a.ph_lo = ph; a.ph_hi = ph + 1; a.coop = 0; hipLaunchKernelGGL(mega, dim3(256), dim3(NTHR), LDS_BYTES, stream, a); }
}
extern "C" void kernel_launch(void* const* d_in, const int* in_sizes, int n_in, void* d_out, int out_size, void* d_ws, size_t ws_size, hipStream_t stream) {
    if (n_in != N_IN || ws_size < WS_END) { fprintf(stderr, "kernel_launch: unexpected n_in %d / ws %zu\n", n_in, ws_size); return; }
    static int inited = 0;
    if (!inited) { if (hipFuncSetAttribute((const void*)mega, hipFuncAttributeMaxDynamicSharedMemorySize, LDS_BYTES) != hipSuccess) fprintf(stderr, "hipFuncSetAttribute failed\n"); inited = 1; }
    unsigned char* ws = (unsigned char*)d_ws;
    MP base{}; for (int i = 0; i < N_IN; ++i) base.in[i] = (const float*)d_in[i]; base.out = (float*)d_out; base.ws = ws;
    (void)hipMemsetAsync(ws + WS_CTL, 0, CTL_ZERO_BYTES, stream);
#if defined(MK_MULTI_LAUNCH)
    run_mega(base, 0, NPH, stream);
#else
    static int grid = 0;
    if (!grid) {
        int dev = 0, cus = 0, per_cu = 0;
        (void)hipGetDevice(&dev); (void)hipDeviceGetAttribute(&cus, hipDeviceAttributeMultiprocessorCount, dev);
        if (hipOccupancyMaxActiveBlocksPerMultiprocessor(&per_cu, (const void*)mega, NTHR, LDS_BYTES) != hipSuccess || per_cu < 1) { fprintf(stderr, "kernel_launch: occupancy query says %d blocks per CU\n", per_cu); per_cu = 1; }
        (void)hipGetLastError();
        grid = cus;
    }
    MP a = base; a.ph_lo = 0; a.ph_hi = NPH; a.coop = 1;
    void* args[] = {&a};
    const hipError_t e = hipLaunchCooperativeKernel((const void*)mega, dim3(grid), dim3(NTHR), args, LDS_BYTES, stream);
    if (e != hipSuccess) fprintf(stderr, "kernel_launch: cooperative launch failed: %s (grid %d)\n", hipGetErrorString(e), grid);
#endif
}
```

```cpp
#include <hip/hip_runtime.h>
#include <cstdint>
#include <cstdio>
#include <hip/hip_cooperative_groups.h>

constexpr int B_ = 8, S_ = 2048, T_ = B_ * S_, D_ = 1024, DIN = 2362, FF = 2816, DEPTH = 2;
constexpr float EPS = 1e-6f;
constexpr float LOG2E = 1.4426950408889634f;
constexpr float QSCALE = 0.125f * LOG2E;
constexpr float MSCALE = 0.10206207261596577f * LOG2E;
enum { I_X = 0, I_C, I_POS, I_GN1, I_GN2, I_WADA, I_BADA, I_WIN, I_CMPPOS, I_WCK, I_WCV, I_GOA, I_GQL, I_WUQ, I_GKVL, I_WUKV, I_GOB,
       I_CONVW, I_CONVB, I_WQM, I_WKM, I_BIG, I_BFG, I_GMH, I_SKIP, I_WOUT, I_WGU, I_WDOWN, I_GFIN, N_IN };

constexpr size_t MiB = 1u << 20;
constexpr size_t WS_CTL = 0;
constexpr size_t WS_MOD = 1 * MiB;
constexpr size_t WS_COSP = WS_MOD + 512 * 1024;
constexpr size_t WS_SINP = WS_COSP + 512 * 1024;
constexpr size_t WS_COSM = WS_SINP + 512 * 1024;
constexpr size_t WS_SINM = WS_COSM + 1 * MiB;
constexpr size_t WS_SSQL = WS_SINM + 1 * MiB;
constexpr size_t WS_SSKV = WS_SSQL + 64 * 1024;
constexpr size_t WS_ML = WS_SSKV + 64 * 1024;
constexpr size_t WS_BL = WS_ML + 4096;
constexpr size_t WS_MP = WS_BL + 4096;
constexpr size_t WS_NL = WS_MP + 4096;
constexpr size_t WS_WT = 8 * MiB;
constexpr size_t WS_RAW = WS_WT;
constexpr size_t WS_HB = 34 * MiB;
constexpr size_t WS_NSA = 66 * MiB;
constexpr size_t WS_KVL = 102 * MiB;
constexpr size_t WS_QL = 106 * MiB;
constexpr size_t WS_CM = 114 * MiB;
constexpr size_t WS_GM = 138 * MiB;
constexpr size_t WS_KM = 140 * MiB;
constexpr size_t WS_QM = 158 * MiB;
constexpr size_t WS_VM = 176 * MiB;
constexpr size_t WS_KCV = 188 * MiB;
constexpr size_t WS_OCMP = 189 * MiB;
constexpr size_t WS_SEL = 201 * MiB;
constexpr size_t WS_XC = 202 * MiB;
constexpr size_t WS_MQ = 210 * MiB;
constexpr size_t WS_MK = 218 * MiB;
constexpr size_t WS_CT = 226 * MiB;
constexpr size_t WS_MISCRAW = 242 * MiB;
constexpr size_t WS_KVM = 140 * MiB;
constexpr size_t WS_KR = 246 * MiB;
constexpr size_t WS_OSLC = 164 * MiB;
constexpr size_t WS_OWIN = 176 * MiB;
constexpr size_t WS_ACT = 66 * MiB;
constexpr size_t WS_END = 256 * MiB;
static_assert(WS_NL + 1024 * 64 * 4 <= WS_WT, "tab");
static_assert(WS_ACT + (size_t)T_ * FF * 2 <= WS_KCV, "act overlay");

typedef unsigned short bf16;
__device__ __forceinline__ float bf2f(bf16 v) { return __uint_as_float(((unsigned)v) << 16); }
__device__ __forceinline__ bf16 f2bf(float f) { unsigned u = __float_as_uint(f); return (bf16)((u + 0x7fffu + ((u >> 16) & 1u)) >> 16); }
__device__ __forceinline__ float sigmoidf_(float x) { return 1.f / (1.f + __expf(-x)); }
__device__ __forceinline__ float siluf_(float x) { return x / (1.f + __expf(-x)); }
__device__ __forceinline__ float wave_sum(float v) {
#pragma unroll
    for (int o = 1; o < 64; o <<= 1) v += __shfl_xor(v, o);
    return v;
}

__global__ void __launch_bounds__(512) k_ada(const float* c, const float* w_ada, const float* b_ada, float* mod) {
    __shared__ float ca[8 * 1024];
    __shared__ float red[8 * 8 * 64];
    const int tid = threadIdx.x, wave = tid >> 6, lane = tid & 63;
    for (int i = tid; i < 8192; i += 512) ca[i] = siluf_(c[i]);
    __syncthreads();
    for (int item = blockIdx.x; item < 192; item += gridDim.x) {
        const int l = item / 96, j = (item % 96) * 64 + lane;
        const float* w = w_ada + (size_t)l * 1024 * 6144 + j;
        float acc[8];
#pragma unroll
        for (int b = 0; b < 8; ++b) acc[b] = 0.f;
        for (int k = wave * 128; k < wave * 128 + 128; ++k) {
            const float wv = w[(size_t)k * 6144];
#pragma unroll
            for (int b = 0; b < 8; ++b) acc[b] += ca[b * 1024 + k] * wv;
        }
#pragma unroll
        for (int b = 0; b < 8; ++b) red[(wave * 8 + b) * 64 + lane] = acc[b];
        __syncthreads();
        {
            const int b = tid >> 6; float s = 0.f;
#pragma unroll
            for (int w8 = 0; w8 < 8; ++w8) s += red[(w8 * 8 + b) * 64 + lane];
            mod[((size_t)l * 8 + b) * 6144 + j] = s + b_ada[l * 6144 + j];
        }
        __syncthreads();
    }
}
__global__ void k_rope(const int* pos, float* cosP, float* sinP, float* cosM, float* sinM) {
    const int i = blockIdx.x * blockDim.x + threadIdx.x;
    if (i >= T_ * 24) return;
    const int m = i / 24, f = i % 24;
    double inv; if (f < 8) inv = pow(500000.0, -(double)(2 * f) / 16.0); else inv = pow(500000.0, -(double)(2 * (f - 8)) / 32.0);
    const float ang = (float)pos[m] * (float)inv;
    const double a = (double)ang, kq = rint(a * 0.15915494309189535), r = a - kq * 6.283185307179586476925;
    const float cs = (float)cos(r), sn = (float)sin(r);
    if (f < 8) { cosP[m * 8 + f] = cs; sinP[m * 8 + f] = sn; } else { cosM[m * 16 + f - 8] = cs; sinM[m * 16 + f - 8] = sn; }
}
__global__ void __launch_bounds__(512) k_norm(const float* x, const float* g, const float* shift, const float* scale, bf16* hb, float* outf, int mode) {
    const int gw = blockIdx.x * 8 + (threadIdx.x >> 6), ngw = gridDim.x * 8, lane = threadIdx.x & 63;
    for (int m = gw; m < T_; m += ngw) {
        const float4* xr = (const float4*)(x + (size_t)m * D_) + lane;
        float4 v[4]; float s = 0.f;
#pragma unroll
        for (int j = 0; j < 4; ++j) { v[j] = xr[64 * j]; s += v[j].x * v[j].x + v[j].y * v[j].y + v[j].z * v[j].z + v[j].w * v[j].w; }
        const float rstd = rsqrtf(wave_sum(s) * (1.f / D_) + EPS);
        const int b = m / S_;
#pragma unroll
        for (int j = 0; j < 4; ++j) {
            const int col = 4 * lane + 256 * j;
            const float4 gg = *(const float4*)(g + col);
            float4 o; o.x = v[j].x * rstd * gg.x; o.y = v[j].y * rstd * gg.y; o.z = v[j].z * rstd * gg.z; o.w = v[j].w * rstd * gg.w;
            if (mode == 2) { *(float4*)(outf + (size_t)m * D_ + col) = o; }
            else {
                const float4 sc = *(const float4*)(scale + (size_t)b * 6144 + col), sh = *(const float4*)(shift + (size_t)b * 6144 + col);
                o.x = o.x * (1.f + sc.x) + sh.x; o.y = o.y * (1.f + sc.y) + sh.y; o.z = o.z * (1.f + sc.z) + sh.z; o.w = o.w * (1.f + sc.w) + sh.w;
                uint2 w; w.x = (unsigned)f2bf(o.x) | ((unsigned)f2bf(o.y) << 16); w.y = (unsigned)f2bf(o.z) | ((unsigned)f2bf(o.w) << 16);
                *(uint2*)(hb + (size_t)m * D_ + col) = w;
            }
        }
    }
}
__global__ void __launch_bounds__(512) k_mixnorm(bf16* mix, const float* ga, const float* gb) {
    const int gw = blockIdx.x * 8 + (threadIdx.x >> 6), ngw = gridDim.x * 8, lane = threadIdx.x & 63;
    for (int m = gw; m < T_; m += ngw) {
        bf16* r = mix + (size_t)m * D_;
        float va[6], vb[6]; float sa = 0.f, sb = 0.f;
#pragma unroll
        for (int j = 0; j < 6; ++j) { va[j] = bf2f(r[lane + 64 * j]); vb[j] = bf2f(r[384 + lane + 64 * j]); sa += va[j] * va[j]; sb += vb[j] * vb[j]; }
        const float ra = rsqrtf(wave_sum(sa) * (1.f / 384.f) + EPS), rb = rsqrtf(wave_sum(sb) * (1.f / 384.f) + EPS);
#pragma unroll
        for (int j = 0; j < 6; ++j) { r[lane + 64 * j] = f2bf(va[j] * ra * ga[lane + 64 * j]); r[384 + lane + 64 * j] = f2bf(vb[j] * rb * gb[lane + 64 * j]); }
    }
}
__global__ void __launch_bounds__(512) k_mscan(float* CT, float* NL, const float* ML, const float* BL, float* MP) {
    for (int item = blockIdx.x; item < 32 * 9; item += gridDim.x) {
        const int bh = item / 9, part = item % 9, tid = threadIdx.x;
        if (part == 8 && tid >= 64) continue;
        float* base; size_t stride;
        if (part < 8) { base = CT + (size_t)bh * 32 * 4096 + part * 512 + tid; stride = 4096; } else { base = NL + (size_t)bh * 32 * 64 + tid; stride = 64; }
        float Cv = 0.f, m = 0.f;
        for (int c = 0; c < 32; ++c) {
            const float cl = base[(size_t)c * stride], ml = ML[bh * 32 + c], bl = BL[bh * 32 + c];
            base[(size_t)c * stride] = Cv;
            if (part == 8 && tid == 0) MP[bh * 32 + c] = m;
            const float mn = fmaxf(bl + m, ml);
            Cv = __expf(bl + m - mn) * Cv + __expf(ml - mn) * cl; m = mn;
        }
    }
}

enum { EPI_RAW = 0, EPI_RES = 1, EPI_GU = 2 };
struct GemmArgs { const bf16* A; int lda; const float* W; int ldw; int K; int N; int row0; int rows; const float* kscale;
                  float* raw; const float* xin; float* xout; const float* gate; bf16* act; };
template <int EPI> __global__ void __launch_bounds__(256) k_gemm_naive(GemmArgs a) {
    __shared__ float As[16][65], Bs[16][65], Bs2[16][65];
    const int tid = threadIdx.x, tx = tid & 15, ty = tid >> 4;
    const int n0 = blockIdx.x * 64, m0 = a.row0 + blockIdx.y * 64;
    float acc[4][4], acc2[4][4];
#pragma unroll
    for (int i = 0; i < 4; ++i)
#pragma unroll
        for (int j = 0; j < 4; ++j) { acc[i][j] = 0.f; acc2[i][j] = 0.f; }
    for (int k0 = 0; k0 < a.K; k0 += 16) {
        for (int i = tid; i < 1024; i += 256) { const int r = i >> 4, kk = i & 15; As[kk][r] = bf2f(a.A[(size_t)(m0 + r) * a.lda + k0 + kk]); }
        for (int i = tid; i < 1024; i += 256) { const int kk = i >> 6, c = i & 63; const int n = n0 + c;
            float w = (n < a.N) ? a.W[(size_t)(k0 + kk) * a.ldw + n] : 0.f; if (a.kscale) w *= a.kscale[k0 + kk]; Bs[kk][c] = w;
            if (EPI == EPI_GU) Bs2[kk][c] = (n < a.N) ? a.W[(size_t)(k0 + kk) * a.ldw + a.N + n] : 0.f; }
        __syncthreads();
#pragma unroll
        for (int kk = 0; kk < 16; ++kk) {
            float av[4], bv[4], bv2[4];
#pragma unroll
            for (int i = 0; i < 4; ++i) { av[i] = As[kk][ty * 4 + i]; bv[i] = Bs[kk][tx * 4 + i]; if (EPI == EPI_GU) bv2[i] = Bs2[kk][tx * 4 + i]; }
#pragma unroll
            for (int i = 0; i < 4; ++i)
#pragma unroll
                for (int j = 0; j < 4; ++j) { acc[i][j] += av[i] * bv[j]; if (EPI == EPI_GU) acc2[i][j] += av[i] * bv2[j]; }
        }
        __syncthreads();
    }
#pragma unroll
    for (int i = 0; i < 4; ++i)
#pragma unroll
        for (int j = 0; j < 4; ++j) {
            const int row = m0 + ty * 4 + i, col = n0 + tx * 4 + j;
            if (col >= a.N) continue;
            if (EPI == EPI_RAW) a.raw[(size_t)(row - a.row0) * a.N + col] = acc[i][j];
            else if (EPI == EPI_RES) { const int b = row / S_; a.xout[(size_t)row * D_ + col] = a.xin[(size_t)row * D_ + col] + a.gate[(size_t)b * 6144 + col] * acc[i][j]; }
            else { a.act[(size_t)row * FF + col] = f2bf(siluf_(acc[i][j]) * acc2[i][j]); }
        }
}
struct PostIn { const float* raw; int row0; int rows; const float *cosP, *sinP, *cosM, *sinM, *big, *bfg; bf16 *nsa, *kvl, *ql, *cm, *km; float* gm; };
__global__ void k_post_in(PostIn p) {
    const long idx = (long)blockIdx.x * blockDim.x + threadIdx.x;
    if (idx >= (long)p.rows * DIN) return;
    const int lr = (int)(idx / DIN), c = (int)(idx % DIN), row = p.row0 + lr;
    const float* r = p.raw + (size_t)lr * DIN;
    const float v = r[c];
    if (c < 1152) {
        float val = v;
        const int seg = (c < 384) ? -1 : (c - 384) / 128;
        const bool rope = (c < 384) || seg == 0 || seg == 2 || seg == 4;
        const int d = c & 63;
        if (rope && d < 16) { const int i = d & 7, hb = c - d; const float x1 = r[hb + i], x2 = r[hb + 8 + i], cs = p.cosP[row * 8 + i], sn = p.sinP[row * 8 + i];
            val = (d < 8) ? x1 * cs - x2 * sn : x1 * sn + x2 * cs; }
        if (c < 384) val *= QSCALE;
        p.nsa[(size_t)row * 1152 + c] = f2bf(val);
    } else if (c < 1170) p.gm[(size_t)row * 32 + (c - 1152)] = sigmoidf_(v);
    else if (c < 1426) p.ql[(size_t)row * 256 + (c - 1170)] = f2bf(v);
    else if (c < 1554) p.kvl[(size_t)row * 128 + (c - 1426)] = f2bf(v);
    else if (c < 1586) { const int d = c - 1554, i = d & 15; const float x1 = r[1554 + i], x2 = r[1570 + i], cs = p.cosM[row * 16 + i], sn = p.sinM[row * 16 + i];
        const bf16 o = f2bf((d < 16) ? x1 * cs - x2 * sn : x1 * sn + x2 * cs);
        for (int h = 0; h < 6; ++h) p.km[(size_t)row * 576 + h * 96 + 64 + d] = o; }
    else if (c < 2354) p.cm[(size_t)row * 768 + (c - 1586)] = f2bf(v);
    else if (c < 2358) p.gm[(size_t)row * 32 + 18 + (c - 2354)] = v + p.big[c - 2354];
    else { const float z = v + p.bfg[c - 2358]; p.gm[(size_t)row * 32 + 22 + (c - 2358)] = fminf(z, 0.f) - log1pf(__expf(-fabsf(z))); }
}
__global__ void __launch_bounds__(512) k_ssq(const bf16* ql, const bf16* kvl, float* sq, float* skv) {
    const int gw = blockIdx.x * 8 + (threadIdx.x >> 6), ngw = gridDim.x * 8, lane = threadIdx.x & 63;
    for (int m = gw; m < T_; m += ngw) {
        float a = 0.f, b = 0.f;
        for (int j = 0; j < 4; ++j) { const float v = bf2f(ql[(size_t)m * 256 + lane + 64 * j]); a += v * v; }
        for (int j = 0; j < 2; ++j) { const float v = bf2f(kvl[(size_t)m * 128 + lane + 64 * j]); b += v * v; }
        a = wave_sum(a); b = wave_sum(b);
        if (lane == 0) { sq[m] = a; skv[m] = b; }
    }
}
__global__ void k_post_uq(const float* raw, int row0, int rows, const float* ssq, const float* cosM, const float* sinM, bf16* qm) {
    const long idx = (long)blockIdx.x * blockDim.x + threadIdx.x;
    if (idx >= (long)rows * 576) return;
    const int lr = (int)(idx / 576), c = (int)(idx % 576), row = row0 + lr;
    const float* r = raw + (size_t)lr * 576;
    const float rstd = rsqrtf(ssq[row] * (1.f / 256.f) + EPS);
    const int h = c / 96, d = c % 96;
    float val = r[c] * rstd;
    if (d >= 64) { const int dd = d - 64, i = dd & 15; const float x1 = r[h * 96 + 64 + i] * rstd, x2 = r[h * 96 + 80 + i] * rstd, cs = cosM[row * 16 + i], sn = sinM[row * 16 + i];
        val = (dd < 16) ? x1 * cs - x2 * sn : x1 * sn + x2 * cs; }
    qm[(size_t)row * 576 + c] = f2bf(val * MSCALE);
}
__global__ void k_post_ukv(const float* raw, int row0, int rows, const float* ssq, bf16* km, bf16* vm) {
    const long idx = (long)blockIdx.x * blockDim.x + threadIdx.x;
    if (idx >= (long)rows * 768) return;
    const int lr = (int)(idx / 768), c = (int)(idx % 768), row = row0 + lr;
    const float rstd = rsqrtf(ssq[row] * (1.f / 128.f) + EPS);
    const float val = raw[(size_t)lr * 768 + c] * rstd;
    const int h = c / 128, w = c % 128;
    if (w < 64) km[(size_t)row * 576 + h * 96 + w] = f2bf(val); else vm[(size_t)row * 384 + h * 64 + (w - 64)] = f2bf(val);
}
__global__ void k_compress(const bf16* nsa, const float* cmp_pos, const float* wk, const float* wv, bf16* kcv) {
    const int idx = blockIdx.x * blockDim.x + threadIdx.x;
    if (idx >= 2 * 8 * 2 * 128 * 64) return;
    const int e = idx & 63, n = (idx >> 6) & 127, g = (idx >> 13) & 1, b = (idx >> 14) & 7, kv = idx >> 17;
    float acc = 0.f;
    if (n < 127) {
        const float* w = kv ? wv : wk; const int col = (kv ? 512 : 384) + g * 64;
        for (int l = 0; l < 32; ++l) { const bf16* tr = nsa + (size_t)(b * S_ + 16 * n + l) * 1152 + col;
            for (int d = 0; d < 64; ++d) acc += (bf2f(tr[d]) + cmp_pos[l * 64 + d]) * w[(size_t)(l * 64 + d) * 64 + e]; }
    }
    kcv[(size_t)kv * (8 * 2 * 128 * 64) + ((size_t)(b * 2 + g) * 128 + n) * 64 + e] = f2bf(acc);
}
__global__ void __launch_bounds__(64) k_cmp_sel(const bf16* nsa, const bf16* kcv, bf16* ocmp, unsigned* sel) {
    __shared__ float P[64][129], SC[64][129];
    const int tid = threadIdx.x, tile = blockIdx.x & 31, g = (blockIdx.x >> 5) & 1, b = blockIdx.x >> 6;
    const int t = tile * 64 + tid, row = b * S_ + t;
    const bf16* kc = kcv + (size_t)(b * 2 + g) * 128 * 64; const bf16* vc = kc + (size_t)8 * 2 * 128 * 64;
    int nvis = (t >= 31) ? ((t - 31) / 16 + 1) : 0; if (nvis > 127) nvis = 127;
    for (int n = 0; n < 128; ++n) P[tid][n] = 0.f;
    for (int r = 0; r < 3; ++r) {
        const int h = 3 * g + r;
        float q[64];
#pragma unroll
        for (int d = 0; d < 64; ++d) q[d] = bf2f(nsa[(size_t)row * 1152 + h * 64 + d]);
        float m = -1e30f;
        for (int n = 0; n < nvis; ++n) { float s = 0.f;
#pragma unroll
            for (int d = 0; d < 64; ++d) s += q[d] * bf2f(kc[n * 64 + d]);
            SC[tid][n] = s; m = fmaxf(m, s); }
        float l = 0.f;
        for (int n = 0; n < nvis; ++n) { const float p = exp2f(SC[tid][n] - m); SC[tid][n] = p; l += p; }
        const float il = (nvis > 0) ? 1.f / l : 0.f;
        float o[64];
#pragma unroll
        for (int d = 0; d < 64; ++d) o[d] = 0.f;
        for (int n = 0; n < nvis; ++n) { const float p = SC[tid][n] * il; P[tid][n] += p;
#pragma unroll
            for (int d = 0; d < 64; ++d) o[d] += p * bf2f(vc[n * 64 + d]); }
#pragma unroll
        for (int d = 0; d < 64; ++d) ocmp[(size_t)row * 384 + h * 64 + d] = f2bf(o[d]);
    }
    const int cur = t >> 6;
    for (int j = 0; j < 32; ++j) {
        float v = 0.f;
        for (int n = 4 * j - 1; n <= 4 * j + 3; ++n) if (n >= 0 && n < 127) v += P[tid][n];
        if (j == 0 || j == cur || j == cur - 1) v = INFINITY;
        if (j * 64 > t) v = -INFINITY;
        SC[tid][j] = v;
    }
    unsigned mask = 0;
    for (int j = 0; j < 32; ++j) { const float v = SC[tid][j]; int rank = 0;
        for (int k = 0; k < 32; ++k) { const float u = SC[tid][k]; rank += (u > v || (u == v && k < j)) ? 1 : 0; }
        if (rank < 16) mask |= 1u << j; }
    sel[(size_t)(b * 2 + g) * S_ + t] = mask;
}
template <int DQK, int MODE> __global__ void __launch_bounds__(64) k_attn_naive(const bf16* Q, int ldq, const bf16* K, int ldk, const bf16* V, int ldv,
        const unsigned* sel, const bf16* ocmp, const bf16* oslc_in, const float* gm, bf16* out) {
    const int t = blockIdx.x * 64 + threadIdx.x, h = blockIdx.y, b = blockIdx.z, row = b * S_ + t;
    const int g = (MODE == 2) ? h : h / 3;
    float q[DQK];
#pragma unroll
    for (int d = 0; d < DQK; ++d) q[d] = bf2f(Q[(size_t)row * ldq + h * DQK + d]);
    float o[64];
#pragma unroll
    for (int d = 0; d < 64; ++d) o[d] = 0.f;
    float m = -1e30f, l = 0.f;
    unsigned sm = 0xffffffffu; if (MODE == 0) sm = sel[(size_t)(b * 2 + g) * S_ + t];
    int j0 = 0; if (MODE == 1) j0 = (t - 511 > 0) ? t - 511 : 0;
    for (int j = j0; j <= t; ++j) {
        if (MODE == 0 && !((sm >> (j >> 6)) & 1u)) { j |= 63; continue; }
        const bf16* kr = K + (size_t)(b * S_ + j) * ldk + g * DQK;
        float s = 0.f;
#pragma unroll
        for (int d = 0; d < DQK; ++d) s += q[d] * bf2f(kr[d]);
        if (s > m) { const float f = exp2f(m - s); l *= f;
#pragma unroll
            for (int d = 0; d < 64; ++d) o[d] *= f;
            m = s; }
        const float p = exp2f(s - m); l += p;
        const bf16* vr = V + (size_t)(b * S_ + j) * ldv + g * 64;
#pragma unroll
        for (int d = 0; d < 64; ++d) o[d] += p * bf2f(vr[d]);
    }
    const float il = 1.f / l;
    if (MODE == 0) {
#pragma unroll
        for (int d = 0; d < 64; ++d) out[(size_t)row * 384 + h * 64 + d] = f2bf(o[d] * il);
    } else if (MODE == 1) {
        const float g0 = gm[(size_t)row * 32 + h * 3], g1 = gm[(size_t)row * 32 + h * 3 + 1], g2 = gm[(size_t)row * 32 + h * 3 + 2];
#pragma unroll
        for (int d = 0; d < 64; ++d) out[(size_t)row * D_ + h * 64 + d] =
            f2bf(g0 * bf2f(ocmp[(size_t)row * 384 + h * 64 + d]) + g1 * bf2f(oslc_in[(size_t)row * 384 + h * 64 + d]) + g2 * o[d] * il);
    } else {
#pragma unroll
        for (int d = 0; d < 64; ++d) out[(size_t)row * D_ + 384 + h * 64 + d] = f2bf(o[d] * il);
    }
}
__global__ void k_mconv(const bf16* cm, const float* cw, const float* cb, bf16* xc) {
    const int idx = blockIdx.x * blockDim.x + threadIdx.x;
    if (idx >= T_ * 256) return;
    const int row = idx >> 8, ch = idx & 255, s = row % S_;
    float a = cb[ch];
    for (int j = 0; j < 4; ++j) { const int ss = s - 3 + j; if (ss >= 0) a += cw[j * 256 + ch] * bf2f(cm[(size_t)(row - 3 + j) * 768 + ch]); }
    xc[idx] = f2bf(siluf_(a));
}
__global__ void k_mqk(const bf16* xc, const float* wq, const float* wk, bf16* mq, bf16* mk) {
    const int idx = blockIdx.x * blockDim.x + threadIdx.x;
    if (idx >= T_ * 256) return;
    const int row = idx >> 8, h = (idx >> 6) & 3, e = idx & 63;
    float aq = 0.f, ak = 0.f;
    for (int d = 0; d < 64; ++d) { const float x = bf2f(xc[(size_t)row * 256 + h * 64 + d]); aq += x * wq[(h * 64 + d) * 64 + e]; ak += x * wk[(h * 64 + d) * 64 + e]; }
    mq[idx] = f2bf(aq * 0.125f); mk[idx] = f2bf(ak);
}
__global__ void __launch_bounds__(64) k_mlocal(const bf16* mk, const bf16* cm, const float* gm, float* CT, float* NL, float* ML, float* BL) {
    __shared__ float w[64], bs[64];
    const int chunk = blockIdx.x, c = chunk & 31, h = (chunk >> 5) & 3, b = chunk >> 7, d = threadIdx.x;
    const int row0 = b * S_ + c * 64;
    if (d == 0) { float acc = 0.f; for (int l = 0; l < 64; ++l) { acc += gm[(size_t)(row0 + l) * 32 + 22 + h]; bs[l] = acc; } }
    __syncthreads();
    const float bL = bs[63];
    float a = bL - bs[d] + gm[(size_t)(row0 + d) * 32 + 18 + h];
    float mx = a;
#pragma unroll
    for (int o = 1; o < 64; o <<= 1) mx = fmaxf(mx, __shfl_xor(mx, o));
    w[d] = __expf(a - mx);
    __syncthreads();
    float C[64]; float n = 0.f;
#pragma unroll
    for (int e = 0; e < 64; ++e) C[e] = 0.f;
    for (int l = 0; l < 64; ++l) {
        const float kk = bf2f(mk[(size_t)(row0 + l) * 256 + h * 64 + d]) * w[l]; n += kk;
        const bf16* vr = cm + (size_t)(row0 + l) * 768 + 256 + h * 64;
#pragma unroll
        for (int e = 0; e < 64; ++e) C[e] += kk * bf2f(vr[e]);
    }
#pragma unroll
    for (int e = 0; e < 64; ++e) CT[(size_t)chunk * 4096 + e * 64 + d] = C[e];
    NL[chunk * 64 + d] = n;
    if (d == 0) { ML[chunk] = mx; BL[chunk] = bL; }
}
__global__ void __launch_bounds__(64) k_mout(const bf16* mq, const bf16* mk, const bf16* cm, const bf16* xc, const float* gm, const float* CT, const float* NL, const float* MP,
                                             const float* gmh, const float* skip, bf16* mix) {
    __shared__ float bs[64], us[64], Ks[64][65], Vs[64][65], Cs[64][65], Qs[64][65], ns[64];
    const int chunk = blockIdx.x, c = chunk & 31, h = (chunk >> 5) & 3, b = chunk >> 7, l = threadIdx.x;
    const int row0 = b * S_ + c * 64, row = row0 + l;
    if (l == 0) { float acc = 0.f; for (int i = 0; i < 64; ++i) { acc += gm[(size_t)(row0 + i) * 32 + 22 + h]; bs[i] = acc; } }
    for (int d = 0; d < 64; ++d) { Ks[l][d] = bf2f(mk[(size_t)row * 256 + h * 64 + d]); Vs[l][d] = bf2f(cm[(size_t)row * 768 + 256 + h * 64 + d]); Cs[l][d] = CT[(size_t)chunk * 4096 + l * 64 + d]; }
    ns[l] = NL[chunk * 64 + l];
    __syncthreads();
    us[l] = gm[(size_t)row * 32 + 18 + h] - bs[l];
    __syncthreads();
    const float mprev = MP[chunk];
    float cu = -INFINITY; for (int s = 0; s <= l; ++s) cu = fmaxf(cu, us[s]);
    const float mt = bs[l] + fmaxf(mprev, cu), inter = __expf(bs[l] + mprev - mt);
    for (int d = 0; d < 64; ++d) Qs[l][d] = bf2f(mq[(size_t)row * 256 + h * 64 + d]);
    float num[64]; float qn = 0.f;
#pragma unroll
    for (int e = 0; e < 64; ++e) num[e] = 0.f;
    for (int d = 0; d < 64; ++d) { const float qd = Qs[l][d]; qn += qd * ns[d];
#pragma unroll
        for (int e = 0; e < 64; ++e) num[e] += qd * Cs[e][d]; }
#pragma unroll
    for (int e = 0; e < 64; ++e) num[e] *= inter;
    float den = inter * qn;
    for (int s = 0; s < 64; ++s) {
        if (s <= l) { float sd = 0.f;
            for (int d = 0; d < 64; ++d) sd += Qs[l][d] * Ks[s][d];
            const float sw = sd * __expf(bs[l] + us[s] - mt); den += sw;
#pragma unroll
            for (int e = 0; e < 64; ++e) num[e] += sw * Vs[s][e]; }
    }
    const float dn = 1.f / fmaxf(fabsf(den), __expf(-mt));
    float mu = 0.f;
#pragma unroll
    for (int e = 0; e < 64; ++e) { num[e] = num[e] * dn * sigmoidf_(bf2f(cm[(size_t)row * 768 + 512 + h * 64 + e])); mu += num[e]; }
    mu *= (1.f / 64.f); float var = 0.f;
#pragma unroll
    for (int e = 0; e < 64; ++e) { const float dlt = num[e] - mu; var += dlt * dlt; }
    const float rs = rsqrtf(var * (1.f / 64.f) + EPS);
#pragma unroll
    for (int e = 0; e < 64; ++e) mix[(size_t)row * D_ + 768 + h * 64 + e] = f2bf((num[e] - mu) * rs * gmh[h * 64 + e] + skip[h * 64 + e] * bf2f(xc[(size_t)row * 256 + h * 64 + e]));
}


__device__ __forceinline__ int fresh_lane() { int l; asm volatile("v_mbcnt_lo_u32_b32 %0, -1, 0\n\tv_mbcnt_hi_u32_b32 %0, -1, %0" : "=&v"(l)); return l; }
template <int M> __device__ __forceinline__ float sxf(float v) { static_assert(M >= 1 && M < 32, "swizzle xor mask"); return __int_as_float(__builtin_amdgcn_ds_swizzle(__float_as_int(v), (M << 10) | 0x1f)); }
__device__ __forceinline__ float red32_max(float v) { auto r = __builtin_amdgcn_permlane32_swap(__float_as_uint(v), __float_as_uint(v), false, false); return fmaxf(__uint_as_float(r[0]), __uint_as_float(r[1])); }
__device__ __forceinline__ float red32_sum(float v) { auto r = __builtin_amdgcn_permlane32_swap(__float_as_uint(v), __float_as_uint(v), false, false); return __uint_as_float(r[0]) + __uint_as_float(r[1]); }
__device__ __forceinline__ unsigned red32_or(unsigned v) { auto r = __builtin_amdgcn_permlane32_swap(v, v, false, false); return r[0] | r[1]; }
__device__ __forceinline__ float bperm(float v, int src_lane) { return __int_as_float(__builtin_amdgcn_ds_bpermute(src_lane << 2, __float_as_int(v))); }
__device__ __forceinline__ float wave_sum2(float v) { v += sxf<1>(v); v += sxf<2>(v); v += sxf<4>(v); v += sxf<8>(v); v += sxf<16>(v); return red32_sum(v); }
__device__ __forceinline__ float wave_max2(float v) { v = fmaxf(v, sxf<1>(v)); v = fmaxf(v, sxf<2>(v)); v = fmaxf(v, sxf<4>(v)); v = fmaxf(v, sxf<8>(v)); v = fmaxf(v, sxf<16>(v)); return red32_max(v); }
namespace pg8 {
#define PG8_LAS __attribute__((address_space(3)))
typedef unsigned short bf16_t;
typedef short bf16x8 __attribute__((ext_vector_type(8)));
typedef float f32x4 __attribute__((ext_vector_type(4)));
typedef unsigned u32x4 __attribute__((ext_vector_type(4)));
constexpr int BM = 256, BK = 64, HALF = 128, HTB = HALF * BK * 2  , STAGE_BYTES = 8 * HTB, NXCD = 8, WGM = 8;

__host__ __device__ __forceinline__ int lds_byte(int r, int c) { const int st = (r >> 4) * 2 + (c >> 5), rr = r & 15, cc = c & 31, ob = rr * 64 + cc * 2; return st * 1024 + (ob ^ (((ob >> 9) & 1) << 5)); }
__host__ __device__ __forceinline__ void stage_rc(int b, int& R, int& C) { const int st = b / 1024, sb = b % 1024, swz = sb ^ (((sb >> 9) & 1) << 5); R = (st >> 1) * 16 + swz / 64; C = (st & 1) * 32 + (swz % 64) / 2; }
__host__ __device__ __forceinline__ int perm32(int rho) { const int n = rho >> 4, i = rho & 15; return 8 * (i >> 2) + 4 * n + (i & 3); }

struct Unit { int pm, pn; };
struct Gemm { const bf16_t* A; const bf16_t* Bt; int M, N, K; };

struct StaticOrder {
    int nM, nN, nwg, G, c;
    __host__ __device__ void init(int M, int N, int G_, int c_) { nM = M / BM; nN = N / BM; nwg = nM * nN; G = G_; c = c_; }
    __host__ __device__ bool next(int i, Unit& u) const {
        const long L = (long)i * G + c; if (L >= nwg) return false;
        int wgid = (int)L; { const int q = nwg / NXCD, r = nwg % NXCD, xcd = wgid % NXCD, off = wgid / NXCD; wgid = (xcd < r ? xcd * (q + 1) : r * (q + 1) + (xcd - r) * q) + off; }
        const int nig = WGM * nN, gid = wgid / nig, fm = gid * WGM, gsz = (nM - fm) < WGM ? (nM - fm) : WGM;
        u.pm = fm + ((wgid % nig) % gsz); u.pn = (wgid % nig) / gsz; return true;
    }
    __device__ __forceinline__ void a_ready(const Unit&) const {}
    __device__ __forceinline__ void done(const Unit&) const {}
};

__device__ __forceinline__ unsigned cvt_pk_bf16(float lo, float hi) { unsigned r; asm volatile("v_cvt_pk_bf16_f32 %0, %1, %2" : "=v"(r) : "v"(lo), "v"(hi)); return r; }
typedef float f32x2 __attribute__((ext_vector_type(2)));

typedef unsigned u32x4 __attribute__((ext_vector_type(4)));
typedef unsigned u32x2 __attribute__((ext_vector_type(2)));
struct EpiIn {
    static constexpr bool PERM = true, AFTER_DRAIN = false;
    unsigned char* ws; const float *big, *bfg;
#define EPI_ROWS(...) _Pragma("unroll") for (int ai = 0; ai < 2; ++ai) _Pragma("unroll") for (int m = 0; m < 4; ++m) { \
        const int row = u.pm * BM + ai * HALF + wr * 64 + m * 16 + fr; float v[8]; \
        _Pragma("unroll") for (int i = 0; i < 4; ++i) { v[i] = acc[ai][bj][m][0][i]; v[4 + i] = acc[ai][bj][m][1][i]; } \
        asm volatile("" : "+v"(v[0]), "+v"(v[1]), "+v"(v[2]), "+v"(v[3]), "+v"(v[4]), "+v"(v[5]), "+v"(v[6]), "+v"(v[7])); \
        __VA_ARGS__ asm volatile("" ::: "memory"); }
#define EPI_PACK(w) u32x4 w; w.x = cvt_pk_bf16(v[0], v[1]); w.y = cvt_pk_bf16(v[2], v[3]); w.z = cvt_pk_bf16(v[4], v[5]); w.w = cvt_pk_bf16(v[6], v[7]);
    __device__ __forceinline__ void operator()(const f32x4 (&acc)[2][2][4][2], const Unit& u, int wr, int wc, int fr, int fq) const {
        half<0>(acc, u, wr, wc, fr, fq); half<1>(acc, u, wr, wc, fr, fq);
    }
    template <int bj> __device__ __forceinline__ void half(const f32x4 (&acc)[2][2][4][2], const Unit& u, int wr, int wc, int fr, int fq) const {
        {
            const int hb = 2 * u.pn + bj;
            int cb = 32 * wc + 8 * fq; asm volatile("" : "+v"(cb), "+v"(fr));
            if (hb <= 8) {
                bf16_t* nsa = (bf16_t*)(ws + WS_NSA) + hb * 128 + cb;
                const bool rope_hb = (hb <= 3) || hb == 5 || hb == 7;
                if (rope_hb) {
                    const float* cosP = (const float*)(ws + WS_COSP); const float* sinP = (const float*)(ws + WS_SINP);
                    const bool mine = ((wc & 1) == 0) && fq < 2; const float sg = (fq == 0) ? -1.f : 1.f; const float sc = (hb < 3) ? QSCALE : 1.f;
                    EPI_ROWS({
                        float pv[8];
                        _Pragma("unroll") for (int i = 0; i < 8; ++i) pv[i] = sxf<16>(v[i]);
                        if (mine) {
                            const f32x4 c0 = *(const f32x4*)(cosP + row * 8), c1 = *(const f32x4*)(cosP + row * 8 + 4), s0 = *(const f32x4*)(sinP + row * 8), s1 = *(const f32x4*)(sinP + row * 8 + 4);
                            _Pragma("unroll") for (int i = 0; i < 4; ++i) { v[i] = v[i] * c0[i] + sg * pv[i] * s0[i]; v[4 + i] = v[4 + i] * c1[i] + sg * pv[4 + i] * s1[i]; }
                        }
                        _Pragma("unroll") for (int i = 0; i < 8; ++i) v[i] *= sc;
                        EPI_PACK(w) *(u32x4*)(nsa + (size_t)row * 1152) = w;
                    })
                } else {
                    EPI_ROWS({ EPI_PACK(w) *(u32x4*)(nsa + (size_t)row * 1152) = w; })
                }
            } else if (hb <= 11) {
                bf16_t* dst = (hb == 9) ? (bf16_t*)(ws + WS_KVL) + cb : (bf16_t*)(ws + WS_QL) + (hb - 10) * 128 + cb;
                const int ld = (hb == 9) ? 128 : 256;
                EPI_ROWS({ EPI_PACK(w) *(u32x4*)(dst + (size_t)row * ld) = w; })
            } else if (hb <= 17) {
                bf16_t* cm = (bf16_t*)(ws + WS_CM) + (hb - 12) * 128 + cb;
                EPI_ROWS({ EPI_PACK(w) *(u32x4*)(cm + (size_t)row * 768) = w; })
            } else if (hb == 18) {
                float* mr = (float*)(ws + WS_MISCRAW) + cb;
                if (wc < 2) { EPI_ROWS({ *(f32x4*)(mr + (size_t)row * 64) = (f32x4){v[0], v[1], v[2], v[3]}; *(f32x4*)(mr + (size_t)row * 64 + 4) = (f32x4){v[4], v[5], v[6], v[7]}; }) }
            }
        }
    }
#undef EPI_ROWS
#undef EPI_PACK
};
struct EpiUKV {
    static constexpr bool PERM = true, AFTER_DRAIN = false;
    bf16_t* kvm;
    __device__ __forceinline__ void operator()(const f32x4 (&acc)[2][2][4][2], const Unit& u, int wr, int wc, int fr, int fq) const {
        asm volatile("" : "+v"(fq), "+v"(fr));
        const int col0 = u.pn * BM + wc * 32 + 8 * fq;
#pragma unroll
        for (int ai = 0; ai < 2; ++ai)
#pragma unroll
            for (int m = 0; m < 4; ++m) { bf16_t* rowp = kvm + (size_t)(u.pm * BM + ai * HALF + wr * 64 + m * 16 + fr) * 768 + col0;
#pragma unroll
                for (int bj = 0; bj < 2; ++bj) { const f32x4 a = acc[ai][bj][m][0], b = acc[ai][bj][m][1];
                    u32x4 w; w.x = cvt_pk_bf16(a[0], a[1]); w.y = cvt_pk_bf16(a[2], a[3]); w.z = cvt_pk_bf16(b[0], b[1]); w.w = cvt_pk_bf16(b[2], b[3]);
                    *(u32x4*)(rowp + bj * HALF) = w; } }
    }
};
struct EpiRes {
    static constexpr bool PERM = false, AFTER_DRAIN = false;
    const float* xin; float* xout; const float* gate;
    __device__ __forceinline__ void operator()(const f32x4 (&acc)[2][2][4][2], const Unit& u, int wr, int wc, int fr, int fq) const {
        asm volatile("" : "+v"(fq), "+v"(fr));
        const int b = (u.pm * BM) / S_; const int col0 = u.pn * BM + wc * 32 + 4 * fq;
        f32x4 gv[2][2];
#pragma unroll
        for (int bj = 0; bj < 2; ++bj)
#pragma unroll
            for (int n = 0; n < 2; ++n) gv[bj][n] = *(const f32x4*)(gate + (size_t)b * 6144 + col0 + bj * HALF + n * 16);
#pragma unroll
        for (int ai = 0; ai < 2; ++ai)
#pragma unroll
            for (int m = 0; m < 4; ++m) { const size_t off = (size_t)(u.pm * BM + ai * HALF + wr * 64 + m * 16 + fr) * D_ + col0;
#pragma unroll
                for (int bj = 0; bj < 2; ++bj)
#pragma unroll
                    for (int n = 0; n < 2; ++n) { const f32x4 xi = *(const f32x4*)(xin + off + bj * HALF + n * 16); *(f32x4*)(xout + off + bj * HALF + n * 16) = xi + gv[bj][n] * acc[ai][bj][m][n]; } }
    }
};
struct EpiGU {
    static constexpr bool PERM = true, AFTER_DRAIN = false;
    bf16_t* act;
    __device__ __forceinline__ void operator()(const f32x4 (&acc)[2][2][4][2], const Unit& u, int wr, int wc, int fr, int fq) const {
        asm volatile("" : "+v"(fq), "+v"(fr));
        const int col0 = u.pn * HALF + wc * 32 + 8 * fq;
#pragma unroll
        for (int ai = 0; ai < 2; ++ai)
#pragma unroll
            for (int m = 0; m < 4; ++m) { const int row = u.pm * BM + ai * HALF + wr * 64 + m * 16 + fr; float o[8];
#pragma unroll
                for (int n = 0; n < 2; ++n)
#pragma unroll
                    for (int i = 0; i < 4; ++i) { const float g = acc[ai][0][m][n][i], up = acc[ai][1][m][n][i]; o[4 * n + i] = g / (1.f + __expf(-g)) * up; }
                u32x4 w; w.x = cvt_pk_bf16(o[0], o[1]); w.y = cvt_pk_bf16(o[2], o[3]); w.z = cvt_pk_bf16(o[4], o[5]); w.w = cvt_pk_bf16(o[6], o[7]);
                *(u32x4*)(act + (size_t)row * FF + col0) = w; }
    }
};
template <class Epi, class Sched, bool ALIGN_EPI = false, bool SP2 = false>
__device__ __forceinline__ void gemm_phase(PG8_LAS unsigned char* lds, const Gemm g, const Sched& S, const Epi& E, int wid_in) {
    const int wid = __builtin_amdgcn_readfirstlane(wid_in), lane = fresh_lane(), tid = wid * 64 + lane, wr = wid >> 2, wc = wid & 3;
    const int K = g.K, nt = K / BK;
    unsigned voffA[2], voffB[2];
#pragma unroll
    for (int i = 0; i < 2; ++i) { int R, C; stage_rc(tid * 16 + i * 8192, R, C); const int Rb = Epi::PERM ? ((R & ~31) + perm32(R & 31)) : R;
        voffA[i] = (unsigned)(R * K + C) * 2u; voffB[i] = (unsigned)(Rb * K + C) * 2u; }
    const size_t kstep = (size_t)(BK * 2);
    const size_t hstep = (size_t)HALF * K * 2;
    const size_t tstep = 2 * hstep;
    const unsigned ldsw = (unsigned)wid * 1024u;
    const int aoff = lds_byte(wr * 64 + (lane & 15), (lane >> 4) * 8), boff = lds_byte(wc * 32 + (lane & 15), (lane >> 4) * 8);
#define PG8_SA(b, h) (((b) * 2 + (h)) * HTB)
#define PG8_SB(b, h) ((4 + (b) * 2 + (h)) * HTB)
#define PG8_STAGE(bufoff, gbase, voff) do { _Pragma("unroll") for (int _i = 0; _i < 2; ++_i) \
        __builtin_amdgcn_global_load_lds((const unsigned*)((const char*)(gbase) + (voff)[_i]), (PG8_LAS unsigned*)(lds + (bufoff) + ldsw + _i * 8192), 16, 0, 0); } while (0)
#define PG8_LDA(dst, b, h) do { _Pragma("unroll") for (int m = 0; m < 4; ++m) _Pragma("unroll") for (int k = 0; k < 2; ++k) dst[m][k] = *(const PG8_LAS bf16x8*)(lds + PG8_SA(b, h) + aoff + m * 2048 + k * 1024); } while (0)
#define PG8_LDB(dst, b, h) do { _Pragma("unroll") for (int n = 0; n < 2; ++n) _Pragma("unroll") for (int k = 0; k < 2; ++k) dst[n][k] = *(const PG8_LAS bf16x8*)(lds + PG8_SB(b, h) + boff + n * 2048 + k * 1024); } while (0)
#define PG8_MMA(ai, bj, At, Bt) do { __builtin_amdgcn_s_setprio(1); _Pragma("unroll") for (int m = 0; m < 4; ++m) _Pragma("unroll") for (int n = 0; n < 2; ++n) _Pragma("unroll") for (int k = 0; k < 2; ++k) \
        acc[ai][bj][m][n] = __builtin_amdgcn_mfma_f32_16x16x32_bf16(Bt[n][k], At[m][k], acc[ai][bj][m][n], 0, 0, 0); __builtin_amdgcn_s_setprio(0); } while (0)
#define PG8_WAIT_V(n) asm volatile("s_waitcnt vmcnt(" #n ")" ::: "memory")
#define PG8_WAIT_L(n) asm volatile("s_waitcnt lgkmcnt(" #n ")" ::: "memory")
#define PG8_BAR __builtin_amdgcn_s_barrier()
#define PG8_SCHED __builtin_amdgcn_sched_barrier(0)
    Unit cur, nxt; int ui = 0;
    if (!S.next(0, cur)) return;
    f32x4 acc[2][2][4][2];
#pragma unroll
    for (int a = 0; a < 2; ++a)
#pragma unroll
        for (int b = 0; b < 2; ++b)
#pragma unroll
            for (int m = 0; m < 4; ++m)
#pragma unroll
                for (int n = 0; n < 2; ++n) acc[a][b][m][n] = (f32x4){0.f, 0.f, 0.f, 0.f};
    bf16x8 At[4][2], B0[2][2], B1[2][2];
    const char* cA = (const char*)g.A + (size_t)cur.pm * tstep; const char* cB = (const char*)g.Bt + (size_t)cur.pn * tstep;
    S.a_ready(cur);
    if constexpr (SP2) {
        PG8_STAGE(PG8_SB(0, 0), cB, voffB); PG8_STAGE(PG8_SB(0, 1), cB + hstep, voffB); PG8_STAGE(PG8_SA(0, 0), cA, voffA); PG8_STAGE(PG8_SA(0, 1), cA + hstep, voffA);
        if (wr == 1) PG8_BAR;
        PG8_WAIT_V(2); PG8_BAR;
        PG8_STAGE(PG8_SB(1, 0), cB + kstep, voffB); PG8_STAGE(PG8_SA(1, 0), cA + kstep, voffA); PG8_STAGE(PG8_SB(1, 1), cB + hstep + kstep, voffB);
        PG8_WAIT_V(6); PG8_BAR;
    } else {
        PG8_STAGE(PG8_SB(0, 0), cB, voffB); PG8_STAGE(PG8_SA(0, 0), cA, voffA); PG8_STAGE(PG8_SB(0, 1), cB + hstep, voffB); PG8_STAGE(PG8_SA(0, 1), cA + hstep, voffA);
        if (wr == 1) PG8_BAR;
        PG8_WAIT_V(4); PG8_BAR;
        PG8_STAGE(PG8_SB(1, 0), cB + kstep, voffB); PG8_STAGE(PG8_SA(1, 0), cA + kstep, voffA); PG8_STAGE(PG8_SB(1, 1), cB + hstep + kstep, voffB);
        PG8_WAIT_V(6); PG8_BAR;
    }
    for (;;) {
        const bool has_next = S.next(ui + 1, nxt);
        const char* nA = has_next ? (const char*)g.A + (size_t)nxt.pm * tstep : cA; const char* nB = has_next ? (const char*)g.Bt + (size_t)nxt.pn * tstep : cB;
        for (int t = 0; t < nt; t += 2) {
            const bool last = (t == nt - 2);
            const char* a1 = cA + (size_t)(t + 1) * kstep;
            const char* a2 = last ? nA : cA + (size_t)(t + 2) * kstep; const char* b2 = last ? nB : cB + (size_t)(t + 2) * kstep;
            const char* a3 = a2 + kstep; const char* b3 = b2 + kstep;
            if (last && has_next) S.a_ready(nxt);
            if constexpr (SP2) {
            PG8_LDB(B0, 0, 0); PG8_LDB(B1, 0, 1); PG8_SCHED; PG8_LDA(At, 0, 0); PG8_STAGE(PG8_SA(1, 1), a1 + hstep, voffA);
            PG8_WAIT_V(8); PG8_WAIT_L(0); PG8_BAR; PG8_MMA(0, 0, At, B0); PG8_MMA(0, 1, At, B1); PG8_BAR; PG8_SCHED;
            PG8_LDA(At, 0, 1); PG8_STAGE(PG8_SB(0, 0), b2, voffB); PG8_STAGE(PG8_SB(0, 1), b2 + hstep, voffB); PG8_STAGE(PG8_SA(0, 0), a2, voffA);
            PG8_WAIT_V(8); PG8_WAIT_L(0); PG8_BAR; PG8_MMA(1, 0, At, B0); PG8_MMA(1, 1, At, B1); PG8_BAR; PG8_SCHED;
            PG8_LDB(B0, 1, 0); PG8_LDB(B1, 1, 1); PG8_SCHED; PG8_LDA(At, 1, 0); PG8_STAGE(PG8_SA(0, 1), a2 + hstep, voffA);
            PG8_WAIT_V(8); PG8_WAIT_L(0); PG8_BAR; PG8_MMA(0, 0, At, B0); PG8_MMA(0, 1, At, B1); PG8_BAR; PG8_SCHED;
            PG8_LDA(At, 1, 1); PG8_STAGE(PG8_SB(1, 0), b3, voffB); PG8_STAGE(PG8_SB(1, 1), b3 + hstep, voffB); PG8_STAGE(PG8_SA(1, 0), a3, voffA);
            PG8_WAIT_V(8); PG8_WAIT_L(0); PG8_BAR; PG8_MMA(1, 0, At, B0); PG8_MMA(1, 1, At, B1); PG8_BAR; PG8_SCHED;
            } else {
            PG8_LDB(B0, 0, 0); PG8_SCHED; PG8_LDA(At, 0, 0); PG8_STAGE(PG8_SA(1, 1), a1 + hstep, voffA);
            PG8_WAIT_L(8); PG8_BAR; PG8_WAIT_L(0); PG8_MMA(0, 0, At, B0); PG8_BAR; PG8_SCHED;
            PG8_LDB(B1, 0, 1); PG8_STAGE(PG8_SB(0, 0), b2, voffB);
            PG8_BAR; PG8_WAIT_L(0); PG8_MMA(0, 1, At, B1); PG8_BAR;
            PG8_LDA(At, 0, 1); PG8_STAGE(PG8_SA(0, 0), a2, voffA);
            PG8_BAR; PG8_WAIT_L(0); PG8_MMA(1, 0, At, B0); PG8_BAR; PG8_SCHED;
            PG8_STAGE(PG8_SB(0, 1), b2 + hstep, voffB);
            PG8_WAIT_V(6); PG8_BAR; PG8_MMA(1, 1, At, B1); PG8_BAR;
            PG8_LDB(B0, 1, 0); PG8_SCHED; PG8_LDA(At, 1, 0); PG8_STAGE(PG8_SA(0, 1), a2 + hstep, voffA);
            PG8_WAIT_L(8); PG8_BAR; PG8_WAIT_L(0); PG8_MMA(0, 0, At, B0); PG8_BAR; PG8_SCHED;
            PG8_LDB(B1, 1, 1); PG8_STAGE(PG8_SB(1, 0), b3, voffB);
            PG8_BAR; PG8_WAIT_L(0); PG8_MMA(0, 1, At, B1); PG8_BAR;
            PG8_LDA(At, 1, 1); PG8_STAGE(PG8_SA(1, 0), a3, voffA);
            PG8_BAR; PG8_WAIT_L(0); PG8_MMA(1, 0, At, B0); PG8_BAR; PG8_SCHED;
            PG8_STAGE(PG8_SB(1, 1), b3 + hstep, voffB);
            PG8_WAIT_V(6); PG8_BAR; PG8_MMA(1, 1, At, B1); PG8_BAR;
            }
        }
        if constexpr (ALIGN_EPI) { if (wr == 0) PG8_BAR; }
        if constexpr (!Epi::AFTER_DRAIN) { const int ln = fresh_lane(); E(acc, cur, wr, wc, ln & 15, ln >> 4); S.done(cur); }
        if (!has_next) break;
#pragma unroll
        for (int a = 0; a < 2; ++a)
#pragma unroll
            for (int b = 0; b < 2; ++b)
#pragma unroll
                for (int m = 0; m < 4; ++m)
#pragma unroll
                    for (int n = 0; n < 2; ++n) acc[a][b][m][n] = (f32x4){0.f, 0.f, 0.f, 0.f};
        cur = nxt; cA = nA; cB = nB; ++ui;
        if constexpr (ALIGN_EPI) { if (wr == 1) PG8_BAR; }
    }
    PG8_WAIT_V(0);
    if constexpr (!ALIGN_EPI) { if (wr == 0) PG8_BAR; }
    PG8_BAR;
    if constexpr (Epi::AFTER_DRAIN) { const int ln = fresh_lane(); E.fused(acc, cur, wr, wc, ln & 15, ln >> 4, lds, wid, ln); S.done(cur); }
#undef PG8_SA
#undef PG8_SB
#undef PG8_STAGE
#undef PG8_LDA
#undef PG8_LDB
#undef PG8_MMA
#undef PG8_WAIT_V
#undef PG8_WAIT_L
#undef PG8_BAR
#undef PG8_SCHED
}
}

#define GAS __attribute__((address_space(1)))
#define LAS __attribute__((address_space(3)))
typedef float f32x4 __attribute__((ext_vector_type(4)));
typedef unsigned v4u __attribute__((ext_vector_type(4)));
typedef GAS unsigned gu32;
#define XB_TMO      128
#define XB_XCNT(j)  (256  + 64 * (j))
#define XB_XSUB(j)  (1280 + 64 * (j))
#define XB_XGEN(j)  (2304 + 64 * (j))
#define XB_TOP      3328
#define XB_TOPGEN   3392
#define XCD_BAR_WORDS 3456
#define XB_SPIN_CAP (1u << 18)

__device__ __forceinline__ unsigned xb_ld(unsigned* p)              { return __hip_atomic_load(p, __ATOMIC_RELAXED, __HIP_MEMORY_SCOPE_AGENT); }
__device__ __forceinline__ unsigned xb_add(unsigned* p, unsigned v) { return __hip_atomic_fetch_add(p, v, __ATOMIC_RELAXED, __HIP_MEMORY_SCOPE_AGENT); }
__device__ __forceinline__ unsigned xb_xcc_id() { return (unsigned)__builtin_amdgcn_s_getreg((3 << 11) | 20) & 0xFu; }
#define XB_SPIN(cond, bar) do { unsigned _sp = 0; while (cond) { __builtin_amdgcn_s_sleep(1); \
    if ((++_sp & 255u) == 0u) { if (xb_ld(&(bar)[XB_TMO])) break; if (_sp > XB_SPIN_CAP) { atomicAdd(&(bar)[XB_TMO], 1u); break; } } } } while (0)

struct XcdBarrier {
    unsigned* bar; unsigned x;
    volatile LAS unsigned* st;
};

__device__ __forceinline__ XcdBarrier xcd_barrier_post(unsigned* bar, volatile LAS unsigned* st, int tid) {
    XcdBarrier b; b.bar = bar; b.x = xb_xcc_id(); b.st = st;
    if (tid == 0) (void)xb_add(&bar[XB_XCNT(b.x)], 1u);
    return b;
}
__device__ __forceinline__ void xcd_barrier_complete(unsigned* bar, unsigned x, unsigned& nloc, unsigned& nx) {
    const unsigned G = gridDim.x * gridDim.y * gridDim.z;
    unsigned sum, cnt, mine, sp = 0u;
    for (;;) {
        sum = 0u; cnt = 0u; mine = 0u;
#pragma unroll
        for (unsigned j = 0; j < 16; ++j) { const unsigned c = xb_ld(&bar[XB_XCNT(j)]); sum += c; cnt += (c > 0u) ? 1u : 0u; mine = (j == x) ? c : mine; }
        if (sum == G) break;
        __builtin_amdgcn_s_sleep(1);
        if ((++sp & 255u) == 0u) { if (xb_ld(&bar[XB_TMO])) break; if (sp > XB_SPIN_CAP) { atomicAdd(&bar[XB_TMO], 1u); break; } }
    }
    nloc = mine > 0u ? mine : 1u; nx = cnt > 0u ? cnt : 1u;
}

__device__ __forceinline__ void xcd_barrier(const XcdBarrier& b, int tid) {
    asm volatile("s_waitcnt vmcnt(0)" ::: "memory");
    __syncthreads();
    if (tid == 0) {
        unsigned* bar = b.bar;
        __builtin_amdgcn_s_waitcnt(0);
        unsigned nloc = b.st[0], nx = b.st[1];
        if (nloc == 0u) { xcd_barrier_complete(bar, b.x, nloc, nx); b.st[0] = nloc; b.st[1] = nx; }
        const unsigned old = xb_add(&bar[XB_XSUB(b.x)], 1u);
        const unsigned gen = old / nloc;
        if (old + 1u == (gen + 1u) * nloc) {
            __builtin_amdgcn_fence(__ATOMIC_RELEASE, "agent");
            asm volatile("s_waitcnt vmcnt(0)" ::: "memory");
            const unsigned og = xb_add(&bar[XB_TOP], 1u);
            const unsigned tg = og / nx;
            if (og + 1u == (tg + 1u) * nx) xb_add(&bar[XB_TOPGEN], 1u);
            else XB_SPIN(xb_ld(&bar[XB_TOPGEN]) == tg, bar);
            __builtin_amdgcn_fence(__ATOMIC_ACQUIRE, "agent");
            xb_add(&bar[XB_XGEN(b.x)], 1u);
            asm volatile("s_waitcnt vmcnt(0)" ::: "memory");
        } else {
            XB_SPIN(xb_ld(&bar[XB_XGEN(b.x)]) == gen, bar);
            __builtin_amdgcn_fence(__ATOMIC_ACQUIRE, "agent");
            asm volatile("s_waitcnt vmcnt(0)" ::: "memory");
        }
    }
    __syncthreads();
}

constexpr int NTHR = 512, NWAVES = 8;
constexpr int RING_BYTES = 131072, MISC_OFF = RING_BYTES + 320, LDS_BYTES = 147456;
constexpr int CW_BAR = 4096;
constexpr size_t CTL_ZERO_BYTES = 64 * 1024;
constexpr size_t WT_IN = WS_WT, WT_OUT = WT_IN + (size_t)2560 * 1024 * 2, WT_GU = WT_OUT + (size_t)1024 * 1024 * 2, WT_DOWN = WT_GU + (size_t)5632 * 1024 * 2,
                 WT_UQ = WT_DOWN + (size_t)1024 * 2816 * 2, WT_UKV = WT_UQ + (size_t)768 * 256 * 2, WT_CK = WT_UKV + (size_t)768 * 128 * 2, WT_CV = WT_CK + (size_t)64 * 2048 * 2,
                 WT_QM = WT_CV + (size_t)64 * 2048 * 2, WT_KM = WT_QM + 4 * 64 * 64 * 2, WT_END = WT_KM + 4 * 64 * 64 * 2;
static_assert(WT_END <= WS_HB, "weights");
constexpr int NPH = 24, PPL = 11;
constexpr int PROBE_SEL = 0;
constexpr int REP_MASK = 0;
#ifndef PHM
#define PHM 0xffff
#endif
struct MP { const float* in[N_IN]; float* out; unsigned char* ws; int ph_lo, ph_hi, coop, pad; };

struct MPK {
    const __attribute__((address_space(4))) MP* k;
    struct InArr { const __attribute__((address_space(4))) MP* k; __device__ __forceinline__ const float* operator[](int i) const { return k->in[i]; } };
    __device__ __forceinline__ InArr in_() const { return InArr{k}; }
};
#define PIN(i) (p.k->in[i])
__device__ __forceinline__ unsigned pk2(float lo, float hi) { return (unsigned)f2bf(lo) | ((unsigned)f2bf(hi) << 16); }
struct MapId { int n; __device__ __forceinline__ int operator()(int c) const { return c < n ? c : -1; } };
struct MapIn { __device__ __forceinline__ int operator()(int c) const {
    if (c < 1152) return c; if (c < 1280) return 1426 + (c - 1152); if (c < 1536) return 1170 + (c - 1280); if (c < 2304) return 1586 + (c - 1536);
    if (c < 2336) return 1554 + (c - 2304); if (c < 2354) return 1152 + (c - 2336); if (c < 2362) return c; return -1; } };
struct MapGU { __device__ __forceinline__ int operator()(int c) const { const int t = c >> 8, w = c & 255; return (w < 128) ? t * 128 + w : FF + t * 128 + (w - 128); } };
template <class Map> __device__ __forceinline__ void transpose_item(const float* W, int K, int ldw, const Map& map, const float* kscale, bf16* WT, LAS float* scr, int item, int nblk, int lane) {
    const int kb = item / nblk, nb = item % nblk, k0 = 64 * kb, n0 = 32 * nb;
    const int sc = map(n0 + (lane & 31));
#pragma unroll 8
    for (int i = 0; i < 32; ++i) { const int kk = 2 * i + (lane >> 5); float v = (sc >= 0) ? W[(size_t)(k0 + kk) * ldw + sc] : 0.f; if (kscale) v *= kscale[k0 + kk]; scr[kk * 33 + (lane & 31)] = v; }
    asm volatile("s_waitcnt lgkmcnt(0)" ::: "memory");
    const int c = lane & 7;
#pragma unroll
    for (int j = 0; j < 4; ++j) { const int n = (lane >> 3) + 8 * j; const LAS float* s = scr + (8 * c) * 33 + n;
        v4u o; o.x = pk2(s[0 * 33], s[1 * 33]); o.y = pk2(s[2 * 33], s[3 * 33]); o.z = pk2(s[4 * 33], s[5 * 33]); o.w = pk2(s[6 * 33], s[7 * 33]);
        *(v4u*)(WT + (size_t)(n0 + n) * K + k0 + 8 * c) = o; }
    asm volatile("s_waitcnt lgkmcnt(0)" ::: "memory");
}
__device__ __forceinline__ void norm_rows(const float* x, const float* g, const float* shift, const float* scale, bf16* hb, float* outf, int mode, int gw, int ngw, int lane) {
    for (int m = gw; m < T_; m += ngw) {
        const float4* xr = (const float4*)(x + (size_t)m * D_) + lane;
        float4 v[4]; float s = 0.f;
#pragma unroll
        for (int j = 0; j < 4; ++j) { v[j] = xr[64 * j]; s += v[j].x * v[j].x + v[j].y * v[j].y + v[j].z * v[j].z + v[j].w * v[j].w; }
        const float rstd = rsqrtf(wave_sum2(s) * (1.f / D_) + EPS);
        const int b = m / S_;
#pragma unroll
        for (int j = 0; j < 4; ++j) {
            const int col = 4 * lane + 256 * j;
            const float4 gg = *(const float4*)(g + col);
            float4 o; o.x = v[j].x * rstd * gg.x; o.y = v[j].y * rstd * gg.y; o.z = v[j].z * rstd * gg.z; o.w = v[j].w * rstd * gg.w;
            if (mode == 2) { *(float4*)(outf + (size_t)m * D_ + col) = o; }
            else {
                const float4 sc = *(const float4*)(scale + (size_t)b * 6144 + col), sh = *(const float4*)(shift + (size_t)b * 6144 + col);
                o.x = o.x * (1.f + sc.x) + sh.x; o.y = o.y * (1.f + sc.y) + sh.y; o.z = o.z * (1.f + sc.z) + sh.z; o.w = o.w * (1.f + sc.w) + sh.w;
                uint2 w; w.x = pk2(o.x, o.y); w.y = pk2(o.z, o.w);
                *(uint2*)(hb + (size_t)m * D_ + col) = w;
            }
        }
    }
}
__device__ __forceinline__ void ph_p0(const MPK& p, LAS unsigned char* lds, int tid) {
    const int wave = tid >> 6, lane = tid & 63;
    LAS float* ca = (LAS float*)lds; LAS float* red = ca + 8192;
    unsigned char* ws = p.k->ws; float* mod = (float*)(ws + WS_MOD);
    const float* c = PIN(I_C);
    for (int i = tid; i < 8192; i += NTHR) ca[i] = siluf_(c[i]);
    __syncthreads();
    for (int item = blockIdx.x; item < 192; item += gridDim.x) {
        const int l = item / 96, j = (item % 96) * 64 + lane;
        const float* w = PIN(I_WADA) + (size_t)l * 1024 * 6144 + j;
        float acc[8];
#pragma unroll
        for (int b = 0; b < 8; ++b) acc[b] = 0.f;
#pragma unroll 4
        for (int k = wave * 128; k < wave * 128 + 128; ++k) {
            const float wv = w[(size_t)k * 6144];
#pragma unroll
            for (int b = 0; b < 8; ++b) acc[b] += ca[b * 1024 + k] * wv;
        }
#pragma unroll
        for (int b = 0; b < 8; ++b) red[(wave * 8 + b) * 64 + lane] = acc[b];
        __syncthreads();
        { const int b = wave; float s = 0.f;
#pragma unroll
          for (int w8 = 0; w8 < 8; ++w8) s += red[(w8 * 8 + b) * 64 + lane];
          mod[((size_t)l * 8 + b) * 6144 + j] = s + PIN(I_BADA)[l * 6144 + j]; }
        __syncthreads();
    }
    const int* pos = (const int*)PIN(I_POS);
    float *cosP = (float*)(ws + WS_COSP), *sinP = (float*)(ws + WS_SINP), *cosM = (float*)(ws + WS_COSM), *sinM = (float*)(ws + WS_SINM);
    for (int i = blockIdx.x * NTHR + tid; i < T_ * 24; i += gridDim.x * NTHR) {
        const int m = i / 24, f = i % 24;
        double inv; if (f < 8) inv = pow(500000.0, -(double)(2 * f) / 16.0); else inv = pow(500000.0, -(double)(2 * (f - 8)) / 32.0);
        const float ang = (float)pos[m] * (float)inv;
        const double a = (double)ang, kq = rint(a * 0.15915494309189535), r = a - kq * 6.283185307179586476925;
        const float cs = (float)cos(r), sn = (float)sin(r);
        if (f < 8) { cosP[m * 8 + f] = cs; sinP[m * 8 + f] = sn; } else { cosM[m * 16 + f - 8] = cs; sinM[m * 16 + f - 8] = sn; }
    }
}
__device__ __forceinline__ void ph_prep(const MPK& p, int l, LAS unsigned char* lds, int tid) {
    const int wave = tid >> 6, lane = tid & 63;
    const int gw = blockIdx.x * NWAVES + wave, ngw = gridDim.x * NWAVES;
    unsigned char* ws = p.k->ws;
    LAS float* scr = (LAS float*)(lds + wave * 16384);
    constexpr int I0 = 16 * 80, I1 = 16 * 32, I2 = 16 * 176, I3 = 44 * 32, I4 = 4 * 24, I5 = 2 * 24, I6 = 32 * 2, I7 = 32 * 2, I8 = 8, I9 = 8;
    constexpr int NIT = I0 + I1 + I2 + I3 + I4 + I5 + I6 + I7 + I8 + I9;
    for (int it = gw; it < NIT; it += ngw) {
        int r = it;
        if (r < I0) { transpose_item(PIN(I_WIN) + (size_t)l * D_ * DIN, D_, DIN, MapIn{}, nullptr, (bf16*)(ws + WT_IN), scr, r, 80, lane); continue; } r -= I0;
        if (r < I1) { transpose_item(PIN(I_WOUT) + (size_t)l * D_ * D_, D_, D_, MapId{D_}, nullptr, (bf16*)(ws + WT_OUT), scr, r, 32, lane); continue; } r -= I1;
        if (r < I2) { transpose_item(PIN(I_WGU) + (size_t)l * D_ * 2 * FF, D_, 2 * FF, MapGU{}, nullptr, (bf16*)(ws + WT_GU), scr, r, 176, lane); continue; } r -= I2;
        if (r < I3) { transpose_item(PIN(I_WDOWN) + (size_t)l * FF * D_, FF, D_, MapId{D_}, nullptr, (bf16*)(ws + WT_DOWN), scr, r, 32, lane); continue; } r -= I3;
        if (r < I4) { transpose_item(PIN(I_WUQ) + (size_t)l * 256 * 576, 256, 576, MapId{576}, PIN(I_GQL) + l * 256, (bf16*)(ws + WT_UQ), scr, r, 24, lane); continue; } r -= I4;
        if (r < I5) { transpose_item(PIN(I_WUKV) + (size_t)l * 128 * 768, 128, 768, MapId{768}, PIN(I_GKVL) + l * 128, (bf16*)(ws + WT_UKV), scr, r, 24, lane); continue; } r -= I5;
        if (r < I6) { transpose_item(PIN(I_WCK) + (size_t)l * 2048 * 64, 2048, 64, MapId{64}, nullptr, (bf16*)(ws + WT_CK), scr, r, 2, lane); continue; } r -= I6;
        if (r < I7) { transpose_item(PIN(I_WCV) + (size_t)l * 2048 * 64, 2048, 64, MapId{64}, nullptr, (bf16*)(ws + WT_CV), scr, r, 2, lane); continue; } r -= I7;
        if (r < I8) { const int h = r >> 1; transpose_item(PIN(I_WQM) + (size_t)l * 16384 + h * 4096, 64, 64, MapId{64}, nullptr, (bf16*)(ws + WT_QM) + h * 4096, scr, r & 1, 2, lane); continue; } r -= I8;
        { const int h = r >> 1; transpose_item(PIN(I_WKM) + (size_t)l * 16384 + h * 4096, 64, 64, MapId{64}, nullptr, (bf16*)(ws + WT_KM) + h * 4096, scr, r & 1, 2, lane); }
    }
    const float* xin = (l == 0) ? PIN(I_X) : p.k->out;
    const float* modl = (const float*)(ws + WS_MOD) + (size_t)l * 8 * 6144;
    norm_rows(xin, PIN(I_GN1) + l * D_, modl + 0, modl + 1024, (bf16*)(ws + WS_HB), nullptr, 0, gw, ngw, lane);
}
__device__ __forceinline__ void ph_mixnorm(const MPK& p, int l, int tid) {
    const int gw = blockIdx.x * NWAVES + (tid >> 6), ngw = gridDim.x * NWAVES, lane = tid & 63;
    unsigned char* ws = p.k->ws;
    bf16* mix = (bf16*)(ws + WS_HB); const float* ga = PIN(I_GOA) + l * 384; const float* gb = PIN(I_GOB) + l * 384;
    const bf16 *oc = (const bf16*)(ws + WS_OCMP), *os = (const bf16*)(ws + WS_OSLC), *ow = (const bf16*)(ws + WS_OWIN); const float* gm = (const float*)(ws + WS_GM);
#define UNPK8(dst, src) dst[0] = __uint_as_float(src.x << 16); dst[1] = __uint_as_float(src.x & 0xffff0000u); dst[2] = __uint_as_float(src.y << 16); dst[3] = __uint_as_float(src.y & 0xffff0000u); \
    dst[4] = __uint_as_float(src.z << 16); dst[5] = __uint_as_float(src.z & 0xffff0000u); dst[6] = __uint_as_float(src.w << 16); dst[7] = __uint_as_float(src.w & 0xffff0000u);
    for (int m = gw; m < T_; m += ngw) {
        bf16* r = mix + (size_t)m * D_;
        float v0[8], v1[8]; float sa = 0.f, sb = 0.f;
        if (lane < 48) {
            const size_t o = (size_t)m * 384 + lane * 8; const float* g3 = gm + (size_t)m * 32 + 3 * (lane >> 3);
            const float g0 = g3[0], g1 = g3[1], g2 = g3[2];
            const v4u c4 = *(const v4u*)(oc + o), s4 = *(const v4u*)(os + o), w4 = *(const v4u*)(ow + o);
            float c8[8], s8[8], w8[8]; UNPK8(c8, c4) UNPK8(s8, s4) UNPK8(w8, w4)
#pragma unroll
            for (int i = 0; i < 8; ++i) { v0[i] = g0 * c8[i] + g1 * s8[i] + g2 * w8[i]; sa += v0[i] * v0[i]; }
        } else {
            const v4u y4 = *(const v4u*)(r + 384 + (lane - 48) * 8); UNPK8(v0, y4)
#pragma unroll
            for (int i = 0; i < 8; ++i) sb += v0[i] * v0[i];
        }
        if (lane < 32) { const v4u y4 = *(const v4u*)(r + 384 + (16 + lane) * 8); UNPK8(v1, y4)
#pragma unroll
            for (int i = 0; i < 8; ++i) sb += v1[i] * v1[i]; }
        const float ra = rsqrtf(wave_sum2(sa) * (1.f / 384.f) + EPS), rb = rsqrtf(wave_sum2(sb) * (1.f / 384.f) + EPS);
        {
            const int col = (lane < 48) ? lane * 8 : 384 + (lane - 48) * 8; const float* gg = (lane < 48) ? ga + lane * 8 : gb + (lane - 48) * 8; const float rr = (lane < 48) ? ra : rb;
            const float4 g0 = *(const float4*)gg, g1 = *(const float4*)(gg + 4);
            v4u w; w.x = pk2(v0[0] * rr * g0.x, v0[1] * rr * g0.y); w.y = pk2(v0[2] * rr * g0.z, v0[3] * rr * g0.w); w.z = pk2(v0[4] * rr * g1.x, v0[5] * rr * g1.y); w.w = pk2(v0[6] * rr * g1.z, v0[7] * rr * g1.w);
            *(v4u*)(r + col) = w;
        }
        if (lane < 32) { const float* gg = gb + (16 + lane) * 8; const float4 g0 = *(const float4*)gg, g1 = *(const float4*)(gg + 4);
            v4u w; w.x = pk2(v1[0] * rb * g0.x, v1[1] * rb * g0.y); w.y = pk2(v1[2] * rb * g0.z, v1[3] * rb * g0.w); w.z = pk2(v1[4] * rb * g1.x, v1[5] * rb * g1.y); w.w = pk2(v1[6] * rb * g1.z, v1[7] * rb * g1.w);
            *(v4u*)(r + 384 + (16 + lane) * 8) = w; }
    }
#undef UNPK8
}


typedef short bf16x8 __attribute__((ext_vector_type(8)));
typedef short s16x4 __attribute__((ext_vector_type(4)));
typedef float f32x16 __attribute__((ext_vector_type(16)));
typedef unsigned u32x2v __attribute__((ext_vector_type(2)));
constexpr int AT_BUF = 20480, AT_K32 = 8192, AT_V = 12288;
__device__ __forceinline__ unsigned cvtpk(float lo, float hi) { unsigned r; asm volatile("v_cvt_pk_bf16_f32 %0, %1, %2" : "=v"(r) : "v"(lo), "v"(hi)); return r; }
__device__ __forceinline__ float max3f(float a, float b, float c) { float r; asm("v_max3_f32 %0, %1, %2, %3" : "=v"(r) : "v"(a), "v"(b), "v"(c)); return r; }
__device__ __forceinline__ int crow(int r, int hi) { return (r & 3) + 8 * (r >> 2) + 4 * hi; }
__device__ __forceinline__ s16x4 vtr(LAS const unsigned char* p) { return __builtin_bit_cast(s16x4, __builtin_amdgcn_ds_read_tr16_b64_v4i16((LAS s16x4*)p)); }
enum { AM_CAUSAL = 0, AM_WINDOW = 1, AM_SLC = 2 };
struct AttnState { float m, l; f32x16 o[2]; long long twait; };
template <int NC> struct TileRegs { v4u k; v4u k2; v4u v; };
template <int NC> __device__ __forceinline__ void at_load(TileRegs<NC>& r, const bf16* Kg, int ldk, const bf16* Vg, int ldv, const bf16* K2g, int ldk2, int tile, int tid) {
    const int key = tid >> 3, c = tid & 7;
    r.k = *(const v4u*)(Kg + (size_t)(tile * 64 + key) * ldk + 8 * c);
    r.v = *(const v4u*)(Vg + (size_t)(tile * 64 + key) * ldv + 8 * c);
    if (NC == 6) { if (tid < 256) r.k2 = *(const v4u*)(K2g + (size_t)(tile * 64 + (tid >> 2)) * ldk2 + 8 * (tid & 3)); }
}
template <int NC> __device__ __forceinline__ void at_store(const TileRegs<NC>& r, LAS unsigned char* buf, int tid) {
    const int key = tid >> 3, c = tid & 7;
    *(LAS v4u*)(buf + key * 128 + 16 * (c ^ ((key >> 1) & 7))) = r.k;
    *(LAS v4u*)(buf + AT_V + (c >> 2) * 4096 + key * 64 + (c & 3) * 16) = r.v;
    if (NC == 6) { if (tid < 256) { const int k2 = tid >> 2, c2 = tid & 3; *(LAS v4u*)(buf + AT_K32 + k2 * 64 + 16 * (c2 ^ ((k2 >> 2) & 3))) = r.k2; } }
}
template <int NC> __device__ __forceinline__ void qk_tile(f32x16& p0, f32x16& p1, LAS const unsigned char* buf, const bf16x8 (&qf)[NC], int lane) {
    const int r32 = lane & 31, hi = lane >> 5;
    p0 = f32x16{}; p1 = f32x16{};
#pragma unroll
    for (int cc = 0; cc < NC; ++cc) {
        bf16x8 k0, k1;
        if (cc < 4) { const int k0r = r32, k1r = 32 + r32;
            k0 = *(LAS const bf16x8*)(buf + k0r * 128 + 16 * ((2 * cc + hi) ^ ((k0r >> 1) & 7)));
            k1 = *(LAS const bf16x8*)(buf + k1r * 128 + 16 * ((2 * cc + hi) ^ ((k1r >> 1) & 7))); }
        else { const int k0r = r32, k1r = 32 + r32, c2 = 2 * (cc - 4) + hi;
            k0 = *(LAS const bf16x8*)(buf + AT_K32 + k0r * 64 + 16 * (c2 ^ ((k0r >> 2) & 3)));
            k1 = *(LAS const bf16x8*)(buf + AT_K32 + k1r * 64 + 16 * (c2 ^ ((k1r >> 2) & 3))); }
        p0 = __builtin_amdgcn_mfma_f32_32x32x16_bf16(k0, qf[cc], p0, 0, 0, 0);
        p1 = __builtin_amdgcn_mfma_f32_32x32x16_bf16(k1, qf[cc], p1, 0, 0, 0);
    }
}
template <int MODE> __device__ __forceinline__ void softmax_tile(AttnState& st, f32x16& p0, f32x16& p1, bf16x8 (&pf)[4], int kpos0, int qpos, bool need_mask, bool sel_ok, int lane) {
    const int hi = lane >> 5;
    if (need_mask) {
        const int qw0m = __builtin_amdgcn_readfirstlane(qpos) & ~31;
        const bool diag = (kpos0 + 63 > qw0m), old = (MODE == AM_WINDOW) && (kpos0 < qw0m + 31 - 511);
        if (diag || old) {
            const float selterm = (MODE == AM_SLC && !sel_ok) ? -INFINITY : INFINITY;
            const int dbase = qpos - kpos0 - 4 * hi;
#pragma unroll
            for (int r = 0; r < 16; ++r) {
                const int d0 = dbase - ((r & 3) + 8 * (r >> 2)), d1 = d0 - 32;
                float l0 = ((float)d0 + 0.5f) * INFINITY, l1 = ((float)d1 + 0.5f) * INFINITY;
                if (MODE == AM_WINDOW) { l0 = fminf(l0, ((float)(511 - d0) + 0.5f) * INFINITY); l1 = fminf(l1, ((float)(511 - d1) + 0.5f) * INFINITY); }
                if (MODE == AM_SLC) { l0 = fminf(l0, selterm); l1 = fminf(l1, selterm); }
                p0[r] = fminf(p0[r], l0); p1[r] = fminf(p1[r], l1);
            }
        } else if (MODE == AM_SLC) {
            const float selterm = sel_ok ? INFINITY : -INFINITY;
#pragma unroll
            for (int r = 0; r < 16; ++r) { p0[r] = fminf(p0[r], selterm); p1[r] = fminf(p1[r], selterm); }
        }
    }
    float mx = max3f(p0[0], p1[0], p0[1]), mx2 = max3f(p1[1], p0[2], p1[2]);
#pragma unroll
    for (int r = 3; r < 15; r += 2) { mx = max3f(mx, p0[r], p1[r]); mx2 = max3f(mx2, p0[r + 1], p1[r + 1]); }
    mx = max3f(mx, p0[15], p1[15]); mx = max3f(mx, mx2, mx2);
    mx = red32_max(mx);
    if (__any(mx > st.m)) {
        const float mn = fmaxf(st.m, mx), alpha = __builtin_amdgcn_exp2f(st.m - mn);
        st.m = mn; st.l *= alpha;
#pragma unroll
        for (int r = 0; r < 16; ++r) { st.o[0][r] *= alpha; st.o[1][r] *= alpha; }
    }
    const float mn = st.m;
    float sum = 0.f;
#pragma unroll
    for (int r = 0; r < 16; ++r) { p0[r] = __builtin_amdgcn_exp2f(p0[r] - mn); p1[r] = __builtin_amdgcn_exp2f(p1[r] - mn); sum += p0[r] + p1[r]; }
    st.l += sum;
#pragma unroll
    for (int s2 = 0; s2 < 2; ++s2) {
        v4u a, b;
        a.x = cvtpk(p0[8 * s2 + 0], p0[8 * s2 + 1]); a.y = cvtpk(p0[8 * s2 + 2], p0[8 * s2 + 3]); a.z = cvtpk(p0[8 * s2 + 4], p0[8 * s2 + 5]); a.w = cvtpk(p0[8 * s2 + 6], p0[8 * s2 + 7]);
        b.x = cvtpk(p1[8 * s2 + 0], p1[8 * s2 + 1]); b.y = cvtpk(p1[8 * s2 + 2], p1[8 * s2 + 3]); b.z = cvtpk(p1[8 * s2 + 4], p1[8 * s2 + 5]); b.w = cvtpk(p1[8 * s2 + 6], p1[8 * s2 + 7]);
        pf[s2] = __builtin_bit_cast(bf16x8, a); pf[2 + s2] = __builtin_bit_cast(bf16x8, b);
    }
}
__device__ __forceinline__ void pv_tile(AttnState& st, LAS const unsigned char* buf, const bf16x8 (&pf)[4], int lane) {
    const int hi = lane >> 5;
    const unsigned vb = (unsigned)(uintptr_t)(buf + AT_V + (4 * hi + ((lane & 15) >> 2)) * 64 + ((lane >> 4) & 1) * 32 + (lane & 3) * 8);
#pragma unroll
    for (int dh = 0; dh < 2; ++dh) {
        s16x4 lo[4], hh[4];
#pragma unroll
        for (int s4 = 0; s4 < 4; ++s4) {
            asm volatile("ds_read_b64_tr_b16 %0, %1 offset:%c2" : "=&v"(lo[s4]) : "v"(vb), "i"(dh * 4096 + s4 * 1024) : "memory");
            asm volatile("ds_read_b64_tr_b16 %0, %1 offset:%c2" : "=&v"(hh[s4]) : "v"(vb), "i"(dh * 4096 + s4 * 1024 + 512) : "memory");
        }
        asm volatile("s_waitcnt lgkmcnt(0)" : "+v"(lo[0]), "+v"(lo[1]), "+v"(lo[2]), "+v"(lo[3]), "+v"(hh[0]), "+v"(hh[1]), "+v"(hh[2]), "+v"(hh[3]) :: "memory");
#pragma unroll
        for (int s4 = 0; s4 < 4; ++s4) {
            const bf16x8 vf = {lo[s4][0], lo[s4][1], lo[s4][2], lo[s4][3], hh[s4][0], hh[s4][1], hh[s4][2], hh[s4][3]};
            st.o[dh] = __builtin_amdgcn_mfma_f32_32x32x16_bf16(vf, pf[s4], st.o[dh], 0, 0, 0);
        }
    }
}
struct TileFlags { bool skip, need_mask, sel_ok; };
template <int MODE> __device__ __forceinline__ TileFlags tile_flags(int t, int qw0, unsigned selbits) {
    const int k0 = t * 64; TileFlags f;
    f.skip = k0 > qw0 + 31; f.need_mask = (k0 + 63 > qw0); f.sel_ok = true;
    if (MODE == AM_WINDOW) { f.skip = f.skip || (k0 + 63 < qw0 - 511); f.need_mask = f.need_mask || (k0 < qw0 + 31 - 511); }
    if (MODE == AM_SLC) { f.sel_ok = (selbits >> t) & 1u; const unsigned long long bal = __ballot(f.sel_ok); f.skip = f.skip || (bal == 0ull); f.need_mask = f.need_mask || (bal != ~0ull); }
    return f;
}
struct DmaOff { unsigned k, v, k2; };
template <int NC> __device__ __forceinline__ DmaOff at_dma_off(int ldk, int ldv, int ldk2, int wave, int lane) {
    const int L = wave * 64 + lane; DmaOff o;
    { const int key = L >> 3, c = (L & 7) ^ ((key >> 1) & 7); o.k = (unsigned)(key * ldk + 8 * c) * 2u; }
    { const int key = (L >> 2) & 63, c = (L >> 8) * 4 + (L & 3); o.v = (unsigned)(key * ldv + 8 * c) * 2u; }
    { const int key = (L >> 2) & 63, c2 = (L & 3) ^ ((key >> 2) & 3); o.k2 = (unsigned)(key * ldk2 + 8 * c2) * 2u; }
    return o;
}
template <int NC> __device__ __forceinline__ void at_dma(const DmaOff& o, const bf16* Kg, int ldk, const bf16* Vg, int ldv, const bf16* K2g, int ldk2, int tile, LAS unsigned char* slot, int wave) {
    __builtin_amdgcn_global_load_lds((const unsigned*)((const char*)(Kg + (size_t)tile * 64 * ldk) + o.k), (LAS unsigned*)(slot + wave * 1024), 16, 0, 0);
    __builtin_amdgcn_global_load_lds((const unsigned*)((const char*)(Vg + (size_t)tile * 64 * ldv) + o.v), (LAS unsigned*)(slot + AT_V + wave * 1024), 16, 0, 0);
    if (NC == 6) { if (wave < 4) __builtin_amdgcn_global_load_lds((const unsigned*)((const char*)(K2g + (size_t)tile * 64 * ldk2) + o.k2), (LAS unsigned*)(slot + AT_K32 + wave * 1024), 16, 0, 0); }
}
__device__ __forceinline__ void at_wait_bar(int keep) {
    if (keep == 0) asm volatile("s_waitcnt vmcnt(0) lgkmcnt(0)" ::: "memory");
    else if (keep == 2) asm volatile("s_waitcnt vmcnt(2) lgkmcnt(0)" ::: "memory");
    else asm volatile("s_waitcnt vmcnt(3) lgkmcnt(0)" ::: "memory");
    __builtin_amdgcn_s_barrier();
    asm volatile("" ::: "memory");
}
template <int NC, int MODE> __device__ __forceinline__ void at_stream(AttnState& st, LAS unsigned char* lds, const bf16* Kg, int ldk, const bf16* Vg, int ldv, const bf16* K2g, int ldk2, int t0, int t1,
                                                                       const bf16x8 (&qf)[NC], int qpos, int qw0, unsigned selbits, int tid) {
    const int lane = tid & 63, wave = __builtin_amdgcn_readfirstlane(tid >> 6), nt = t1 - t0;
    const int nper = (NC == 6 && wave < 4) ? 3 : 2;
    const DmaOff dof = at_dma_off<NC>(ldk, ldv, ldk2, wave, lane);
    at_dma<NC>(dof, Kg, ldk, Vg, ldv, K2g, ldk2, t0, lds, wave);
    if (nt > 1) at_dma<NC>(dof, Kg, ldk, Vg, ldv, K2g, ldk2, t0 + 1, lds + AT_BUF, wave);
    at_wait_bar(nt > 1 ? nper : 0);
    int s0 = 0, s1 = AT_BUF, s2 = 2 * AT_BUF;
    for (int i = 0; i < nt; ++i) {
        const int t = t0 + i; const bool has_2 = (i + 2 < nt);
        if (has_2) at_dma<NC>(dof, Kg, ldk, Vg, ldv, K2g, ldk2, t + 2, lds + s2, wave);
        const TileFlags f = tile_flags<MODE>(t, qw0, selbits);
        if (!f.skip) {
            f32x16 p0, p1; bf16x8 pf[4];
            qk_tile<NC>(p0, p1, lds + s0, qf, lane);
            softmax_tile<MODE>(st, p0, p1, pf, t * 64, qpos, f.need_mask, f.sel_ok, lane);
            pv_tile(st, lds + s0, pf, lane);
        }
        { const long long tw0 = (PROBE_SEL != 0) ? (long long)__builtin_amdgcn_s_memtime() : 0ll;
          at_wait_bar(has_2 ? nper : 0);
          if (PROBE_SEL != 0) st.twait += (long long)__builtin_amdgcn_s_memtime() - tw0; }
        const int tmp = s0; s0 = s1; s1 = s2; s2 = tmp;
    }
}
__device__ __forceinline__ int next_item_q(unsigned* ctrs, LAS unsigned char* lds, int wave_u, int count, int q0, int& kstart) {
    const int tid = wave_u * 64 + fresh_lane();
    LAS int* slot = (LAS int*)(lds + RING_BYTES + 64);
    if (tid == 0) {
        int r = -1, k = kstart;
        for (; k < 8; ++k) { const int q = (q0 + k) & 7; const unsigned v = atomicAdd(ctrs + q * 16, 1u); if (v < (unsigned)count) { r = (q << 16) | (int)v; break; } }
        slot[0] = r; slot[1] = k;
    }
    __syncthreads();
    const int v = slot[0]; kstart = slot[1];
    __syncthreads();
    return v;
}
__device__ __forceinline__ void mla_unit(unsigned char* ws, LAS unsigned char* lds, int b, int h, int qt, int wave_u) {
    const int tid = wave_u * 64 + fresh_lane();
    const int lane = tid & 63, wave = tid >> 6, r32 = lane & 31, hi = lane >> 5;
    const int qw0 = qt * 256 + wave * 32, qpos = qw0 + r32; const size_t row = (size_t)b * S_ + qpos;
    const long long tq0 = (PROBE_SEL != 0) ? (long long)__builtin_amdgcn_s_memtime() : 0ll;
    bf16x8 qf[6];
    {
        const bf16* ql = (const bf16*)(ws + WS_QL) + row * 256 + 8 * hi;
        const int sw = (r32 & 0x13) | ((r32 & 4) << 1) | ((r32 & 8) >> 1);
        const bf16* wt = (const bf16*)(ws + WT_UQ) + (size_t)(h * 96 + sw) * 256 + 8 * hi;
        f32x16 qa[3] = {f32x16{}, f32x16{}, f32x16{}};
#pragma unroll 4
        for (int ks = 0; ks < 16; ++ks) {
            const bf16x8 bq = *(const bf16x8*)(ql + 16 * ks);
#pragma unroll
            for (int blk = 0; blk < 3; ++blk) { const bf16x8 aw = *(const bf16x8*)(wt + (size_t)blk * 32 * 256 + 16 * ks); qa[blk] = __builtin_amdgcn_mfma_f32_32x32x16_bf16(aw, bq, qa[blk], 0, 0, 0); }
        }
        float msc = MSCALE; asm volatile("" : "+v"(msc));
        const float rs = rsqrtf(((const float*)(ws + WS_SSQL))[row] * (1.f / 256.f) + EPS) * msc;
        const float* cm_ = (const float*)(ws + WS_COSM) + row * 16 + 8 * hi; const float* sm_ = (const float*)(ws + WS_SINM) + row * 16 + 8 * hi;
#pragma unroll
        for (int r = 0; r < 8; ++r) { const float x1 = qa[2][r], x2 = qa[2][r + 8], cs = cm_[r], sn = sm_[r]; qa[2][r] = x1 * cs - x2 * sn; qa[2][r + 8] = x1 * sn + x2 * cs; }
#pragma unroll
        for (int blk = 0; blk < 3; ++blk)
#pragma unroll
            for (int a2 = 0; a2 < 2; ++a2) { v4u w; w.x = cvtpk(qa[blk][8 * a2 + 0] * rs, qa[blk][8 * a2 + 1] * rs); w.y = cvtpk(qa[blk][8 * a2 + 2] * rs, qa[blk][8 * a2 + 3] * rs);
                w.z = cvtpk(qa[blk][8 * a2 + 4] * rs, qa[blk][8 * a2 + 5] * rs); w.w = cvtpk(qa[blk][8 * a2 + 6] * rs, qa[blk][8 * a2 + 7] * rs); qf[2 * blk + a2] = __builtin_bit_cast(bf16x8, w); }
    }
    const long long tq1 = (PROBE_SEL != 0) ? (long long)__builtin_amdgcn_s_memtime() : 0ll;
    AttnState st; st.m = -1e30f; st.l = 0.f; st.o[0] = f32x16{}; st.o[1] = f32x16{}; st.twait = 0;
    const bf16* kvb = (const bf16*)(ws + WS_KVM) + (size_t)b * S_ * 768 + h * 128;
    at_stream<6, AM_CAUSAL>(st, lds, kvb, 768, kvb + 64, 768, (const bf16*)(ws + WS_KR) + (size_t)b * S_ * 32, 32, 0, 4 * qt + 4, qf, qpos, qw0, 0u, tid);
    if (PROBE_SEL >= 1 && PROBE_SEL <= 3 && b == 0 && h == 0 && qt == 7 && tid == 0) { const long long tq2 = (long long)__builtin_amdgcn_s_memtime();
        ((float*)(ws + WS_CTL))[100] = (PROBE_SEL == 1) ? (float)(tq2 - tq1) : (PROBE_SEL == 2) ? (float)st.twait : (float)(tq1 - tq0); }
    const float lt = red32_sum(st.l), il = 1.f / lt;
    bf16* op = (bf16*)(ws + WS_HB) + row * D_ + 384 + h * 64 + 4 * hi;
#pragma unroll
    for (int dh = 0; dh < 2; ++dh)
#pragma unroll
        for (int g4 = 0; g4 < 4; ++g4) { u32x2v w; w.x = cvtpk(st.o[dh][4 * g4] * il, st.o[dh][4 * g4 + 1] * il); w.y = cvtpk(st.o[dh][4 * g4 + 2] * il, st.o[dh][4 * g4 + 3] * il);
            *(u32x2v*)(op + dh * 32 + 8 * g4) = w; }
}
template <int MODE> __device__ __forceinline__ void nsa_branch_unit(unsigned char* ws, LAS unsigned char* lds, int b, int h, int qt, int wave_u) {
    const int tid = wave_u * 64 + fresh_lane();
    const int lane = tid & 63, wave = tid >> 6, r32 = lane & 31, hi = lane >> 5, g = h / 3;
    const int qw0 = qt * 256 + wave * 32, qpos = qw0 + r32; const size_t row = (size_t)b * S_ + qpos;
    const bf16* nsa = (const bf16*)(ws + WS_NSA);
    const bf16* qp = nsa + row * 1152 + h * 64 + 8 * hi;
    bf16x8 qf[4];
#pragma unroll
    for (int cc = 0; cc < 4; ++cc) qf[cc] = *(const bf16x8*)(qp + 16 * cc);
    unsigned selbits = 0u; if (MODE == AM_SLC) selbits = ((const unsigned*)(ws + WS_SEL))[(size_t)(b * 2 + g) * S_ + qpos];
    const bf16* kb = nsa + (size_t)b * S_ * 1152 + g * 64 + (MODE == AM_SLC ? 640 : 896);
    AttnState st; st.m = -1e30f; st.l = 0.f; st.o[0] = f32x16{}; st.o[1] = f32x16{}; st.twait = 0;
    const long long tn0 = (PROBE_SEL != 0) ? (long long)__builtin_amdgcn_s_memtime() : 0ll;
    const int t0 = (MODE == AM_SLC) ? 0 : ((4 * qt - 8 > 0) ? 4 * qt - 8 : 0);
    at_stream<4, MODE>(st, lds, kb, 1152, kb + 128, 1152, nullptr, 0, t0, 4 * qt + 4, qf, qpos, qw0, selbits, tid);
    if (PROBE_SEL >= 4 && PROBE_SEL <= 5 && MODE == AM_SLC && b == 0 && h == 0 && qt == 7 && tid == 0) { const long long tn1 = (long long)__builtin_amdgcn_s_memtime();
        ((float*)(ws + WS_CTL))[100] = (PROBE_SEL == 4) ? (float)(tn1 - tn0) : (float)st.twait; }
    const float lt = red32_sum(st.l), il = 1.f / lt;
    bf16* op = (bf16*)(ws + (MODE == AM_SLC ? WS_OSLC : WS_OWIN)) + row * 384 + h * 64 + 4 * hi;
#pragma unroll
    for (int dh = 0; dh < 2; ++dh)
#pragma unroll
        for (int g4 = 0; g4 < 4; ++g4) { u32x2v w; w.x = cvtpk(st.o[dh][4 * g4] * il, st.o[dh][4 * g4 + 1] * il); w.y = cvtpk(st.o[dh][4 * g4 + 2] * il, st.o[dh][4 * g4 + 3] * il);
            *(u32x2v*)(op + dh * 32 + 8 * g4) = w; }
}
__device__ __forceinline__ void cmp_unit(unsigned char* ws, LAS unsigned char* lds, int b, int g, int qt, int wave_u) {
    const int tid = wave_u * 64 + fresh_lane();
    const int lane = tid & 63, wave = tid >> 6, r32 = lane & 31, hi = lane >> 5;
    const int qpos = qt * 256 + wave * 32 + r32; const size_t row = (size_t)b * S_ + qpos;
    const bf16* kc = (const bf16*)(ws + WS_KCV) + (size_t)(b * 2 + g) * 128 * 64; const bf16* vc = kc + (size_t)8 * 2 * 128 * 64;
    { TileRegs<4> tr; at_load<4>(tr, kc, 64, vc, 64, nullptr, 0, 0, tid); at_store<4>(tr, lds, tid); at_load<4>(tr, kc, 64, vc, 64, nullptr, 0, 1, tid); at_store<4>(tr, lds + AT_BUF, tid); }
    __syncthreads();
    int nvis = (qpos >= 31) ? ((qpos - 31) >> 4) + 1 : 0; if (nvis > 127) nvis = 127;
    LAS float* IG = (LAS float*)(lds + 2 * AT_BUF) + wave * (32 * 33) + r32 * 33;
    LAS float* IL = IG + 8 * 32 * 33;
    const bf16* nsa = (const bf16*)(ws + WS_NSA);
    LAS const unsigned char* vb = lds + AT_V + (4 * hi + ((lane & 15) >> 2)) * 64 + ((lane >> 4) & 1) * 32 + (lane & 3) * 8;
    for (int r3 = 0; r3 < 3; ++r3) {
        const int h = 3 * g + r3;
        const bf16* qp = nsa + row * 1152 + h * 64 + 8 * hi;
        bf16x8 qf[4];
#pragma unroll
        for (int cc = 0; cc < 4; ++cc) qf[cc] = *(const bf16x8*)(qp + 16 * cc);
        f32x16 p[4];
#pragma unroll
        for (int tb = 0; tb < 4; ++tb) {
            LAS const unsigned char* buf = lds + (tb >> 1) * AT_BUF; const int kr = (tb & 1) * 32 + r32;
            p[tb] = f32x16{};
#pragma unroll
            for (int cc = 0; cc < 4; ++cc) { const bf16x8 kf = *(LAS const bf16x8*)(buf + kr * 128 + 16 * ((2 * cc + hi) ^ ((kr >> 1) & 7)));
                p[tb] = __builtin_amdgcn_mfma_f32_32x32x16_bf16(kf, qf[cc], p[tb], 0, 0, 0); }
        }
        float mx = -1e30f;
#pragma unroll
        for (int tb = 0; tb < 4; ++tb)
#pragma unroll
            for (int r = 0; r < 16; ++r) { const int n = 32 * tb + crow(r, hi); p[tb][r] = fminf(p[tb][r], ((float)(nvis - n) - 0.5f) * INFINITY); mx = fmaxf(mx, p[tb][r]); }
        mx = red32_max(mx);
        float sum = 0.f;
#pragma unroll
        for (int tb = 0; tb < 4; ++tb)
#pragma unroll
            for (int r = 0; r < 16; ++r) { p[tb][r] = __builtin_amdgcn_exp2f(p[tb][r] - mx); sum += p[tb][r]; }
        sum = red32_sum(sum);
        const float il = (nvis > 0) ? 1.f / sum : 0.f;
#pragma unroll
        for (int tb = 0; tb < 4; ++tb)
#pragma unroll
            for (int k = 0; k < 4; ++k) { const float a0 = p[tb][4 * k] * il, a1 = p[tb][4 * k + 1] * il, a2 = p[tb][4 * k + 2] * il, a3 = p[tb][4 * k + 3] * il;
                const int j = 2 * (4 * tb + k) + hi;
                const float gs = (a0 + a1) + (a2 + a3);
                if (r3 == 0) { IG[j] = gs; IL[j + 1] = a3; } else { IG[j] += gs; IL[j + 1] += a3; } }
        f32x16 o[2] = {f32x16{}, f32x16{}};
#pragma unroll
        for (int tb = 0; tb < 4; ++tb)
#pragma unroll
            for (int s2 = 0; s2 < 2; ++s2) {
                v4u a; a.x = cvtpk(p[tb][8 * s2 + 0], p[tb][8 * s2 + 1]); a.y = cvtpk(p[tb][8 * s2 + 2], p[tb][8 * s2 + 3]); a.z = cvtpk(p[tb][8 * s2 + 4], p[tb][8 * s2 + 5]); a.w = cvtpk(p[tb][8 * s2 + 6], p[tb][8 * s2 + 7]);
                const bf16x8 pf = __builtin_bit_cast(bf16x8, a);
                LAS const unsigned char* vbb = vb + (tb >> 1) * AT_BUF + ((tb & 1) * 2 + s2) * 1024;
#pragma unroll
                for (int dh = 0; dh < 2; ++dh) { const s16x4 lo = vtr(vbb + dh * 4096), hh = vtr(vbb + dh * 4096 + 512);
                    const bf16x8 vf = {lo[0], lo[1], lo[2], lo[3], hh[0], hh[1], hh[2], hh[3]};
                    o[dh] = __builtin_amdgcn_mfma_f32_32x32x16_bf16(vf, pf, o[dh], 0, 0, 0); }
                asm volatile("" ::: "memory");
            }
        bf16* op = (bf16*)(ws + WS_OCMP) + row * 384 + h * 64 + 4 * hi;
#pragma unroll
        for (int dh = 0; dh < 2; ++dh)
#pragma unroll
            for (int g4 = 0; g4 < 4; ++g4) { u32x2v w; w.x = cvtpk(o[dh][4 * g4] * il, o[dh][4 * g4 + 1] * il); w.y = cvtpk(o[dh][4 * g4 + 2] * il, o[dh][4 * g4 + 3] * il);
                *(u32x2v*)(op + dh * 32 + 8 * g4) = w; }
    }
    const int cur = qpos >> 6;
    LAS float* imp = IG;
#pragma unroll 1
    for (int jj = 0; jj < 16; ++jj) {
        const int j = 16 * hi + jj;
        float v = IG[j] + (j > 0 ? IL[j] : 0.f);
        if (j == 0 || j == cur || j == cur - 1) v = INFINITY;
        if (j * 64 > qpos) v = -INFINITY;
        IL[j] = v;
    }
#pragma unroll 1
    for (int jj = 0; jj < 16; ++jj) { const int j = 16 * hi + jj; imp[j] = IL[j]; }
    unsigned mask = 0;
#pragma unroll 1
    for (int jj = 0; jj < 16; ++jj) {
        const int j = 16 * hi + jj; const float v = imp[j]; int rank = 0;
#pragma unroll 4
        for (int k = 0; k < 32; ++k) { const float u2 = imp[k]; rank += (u2 > v || (u2 == v && k < j)) ? 1 : 0; }
        if (rank < 16) mask |= 1u << j;
    }
    mask = red32_or(mask);
    if (hi == 0) ((unsigned*)(ws + WS_SEL))[(size_t)(b * 2 + g) * S_ + qpos] = mask;
    __syncthreads();
}
__device__ __forceinline__ void lora_rows(unsigned char* ws, int tid) {
    const int gw = blockIdx.x * NWAVES + (tid >> 6), ngw = gridDim.x * NWAVES, lane = tid & 63;
    bf16* kvl = (bf16*)(ws + WS_KVL); const bf16* ql = (const bf16*)(ws + WS_QL); float* ssql = (float*)(ws + WS_SSQL);
    for (int m = gw; m < T_; m += ngw) {
        const unsigned kv = *(const unsigned*)(kvl + (size_t)m * 128 + 2 * lane);
        const float k0 = __uint_as_float(kv << 16), k1 = __uint_as_float(kv & 0xffff0000u);
        const uint2 qv = *(const uint2*)(ql + (size_t)m * 256 + 4 * lane);
        const float q0 = __uint_as_float(qv.x << 16), q1 = __uint_as_float(qv.x & 0xffff0000u), q2 = __uint_as_float(qv.y << 16), q3 = __uint_as_float(qv.y & 0xffff0000u);
        const float sk = wave_sum2(k0 * k0 + k1 * k1), sq = wave_sum2((q0 * q0 + q1 * q1) + (q2 * q2 + q3 * q3));
        const float rk = rsqrtf(sk * (1.f / 128.f) + EPS);
        *(unsigned*)(kvl + (size_t)m * 128 + 2 * lane) = pk2(k0 * rk, k1 * rk);
        if (lane == 0) ssql[m] = sq;
    }
}
__device__ __forceinline__ void post_misc(unsigned char* ws, const float* big, const float* bfg, int tid) {
    const float* mr = (const float*)(ws + WS_MISCRAW); const float* cosM = (const float*)(ws + WS_COSM); const float* sinM = (const float*)(ws + WS_SINM);
    bf16* kr = (bf16*)(ws + WS_KR); float* gm = (float*)(ws + WS_GM);
    for (int idx = blockIdx.x * NTHR + tid; idx < T_ * 64; idx += gridDim.x * NTHR) {
        const int row = idx >> 6, c = idx & 63; const float* r = mr + (size_t)row * 64; const float v = r[c];
        if (c < 32) { const int i = c & 15; const float x1 = r[i], x2 = r[16 + i], cs = cosM[row * 16 + i], sn = sinM[row * 16 + i];
            kr[(size_t)row * 32 + c] = f2bf((c < 16) ? x1 * cs - x2 * sn : x1 * sn + x2 * cs); }
        else if (c < 50) gm[(size_t)row * 32 + (c - 32)] = 1.f / (1.f + __expf(-v));
        else if (c < 54) gm[(size_t)row * 32 + 18 + (c - 50)] = v + big[c - 50];
        else if (c < 58) { const float z = v + bfg[c - 54]; gm[(size_t)row * 32 + 22 + (c - 54)] = fminf(z, 0.f) - __logf(1.f + __expf(-fabsf(z))); }
    }
}

typedef float f32x4v __attribute__((ext_vector_type(4)));
__device__ __forceinline__ void compress_item(unsigned char* ws, LAS unsigned char* lds, const float* cmp_pos, int item, int wave_u) {
    const int lane = fresh_lane(), tid = wave_u * 64 + lane;
    const int nb = item & 7, g = (item >> 3) & 1, b = (item >> 4) & 7, kv = item >> 7;
    const bf16* tok = (const bf16*)(ws + WS_NSA) + (size_t)b * S_ * 1152 + (kv ? 512 : 384) + g * 64;
    const bf16* wt = (const bf16*)(ws + (kv ? WT_CV : WT_CK));
    const int nrow = nb * 16 + (lane & 15), kq = lane >> 4;
    f32x4v acc[4] = {f32x4v{}, f32x4v{}, f32x4v{}, f32x4v{}};
#pragma unroll 4
    for (int ks = 0; ks < 8; ++ks) {
        const int k = wave_u * 256 + ks * 32 + kq * 8, l = k >> 6, d = k & 63;
        int trow = 16 * nrow + l; trow = trow < S_ ? trow : S_ - 1;
        const v4u t4 = *(const v4u*)(tok + (size_t)trow * 1152 + d);
        const f32x4v p0 = *(const f32x4v*)(cmp_pos + k), p1 = *(const f32x4v*)(cmp_pos + k + 4);
        v4u a4;
        a4.x = cvtpk(__uint_as_float(t4.x << 16) + p0[0], __uint_as_float(t4.x & 0xffff0000u) + p0[1]); a4.y = cvtpk(__uint_as_float(t4.y << 16) + p0[2], __uint_as_float(t4.y & 0xffff0000u) + p0[3]);
        a4.z = cvtpk(__uint_as_float(t4.z << 16) + p1[0], __uint_as_float(t4.z & 0xffff0000u) + p1[1]); a4.w = cvtpk(__uint_as_float(t4.w << 16) + p1[2], __uint_as_float(t4.w & 0xffff0000u) + p1[3]);
        const bf16x8 af = __builtin_bit_cast(bf16x8, a4);
#pragma unroll
        for (int cb = 0; cb < 4; ++cb) { const bf16x8 bfr = *(const bf16x8*)(wt + (size_t)(cb * 16 + (lane & 15)) * 2048 + k);
            acc[cb] = __builtin_amdgcn_mfma_f32_16x16x32_bf16(af, bfr, acc[cb], 0, 0, 0); }
    }
    LAS float* red = (LAS float*)lds + wave_u * 1024;
#pragma unroll
    for (int cb = 0; cb < 4; ++cb)
#pragma unroll
        for (int r = 0; r < 4; ++r) red[(4 * (lane >> 4) + r) * 64 + cb * 16 + (lane & 15)] = acc[cb][r];
    __syncthreads();
    bf16* out = (bf16*)(ws + WS_KCV) + (size_t)kv * (8 * 2 * 128 * 64) + ((size_t)(b * 2 + g) * 128 + nb * 16) * 64;
    for (int o = tid; o < 1024; o += NTHR) { float sum = 0.f;
#pragma unroll
        for (int w8 = 0; w8 < 8; ++w8) sum += ((LAS float*)lds)[w8 * 1024 + o];
        out[o] = f2bf(sum); }
    __syncthreads();
}
__device__ __forceinline__ f32x4v mm16(const LAS bf16* A, int lda, int arow0, const LAS bf16* Bt, int ldb, int bcol0, int K, int lane, f32x4v acc) {
    const LAS bf16* ap = A + (arow0 + (lane & 15)) * lda + 8 * (lane >> 4); const LAS bf16* bp = Bt + (bcol0 + (lane & 15)) * ldb + 8 * (lane >> 4);
    for (int k = 0; k < K; k += 32) acc = __builtin_amdgcn_mfma_f32_16x16x32_bf16(*(const LAS bf16x8*)(ap + k), *(const LAS bf16x8*)(bp + k), acc, 0, 0, 0);
    return acc;
}
constexpr int ML_LD = 72;
__device__ __forceinline__ void mlocal_item(unsigned char* ws, LAS unsigned char* lds, const float* convw, const float* convb, const float* big, const float* bfg, int chunk, int wave_u) {
    const int lane = fresh_lane(), tid = wave_u * 64 + lane;
    const int c = chunk & 31, h = (chunk >> 5) & 3, b = chunk >> 7, row0 = b * S_ + c * 64;
    LAS bf16* XS = (LAS bf16*)lds;
    LAS bf16* WQ = XS + 64 * ML_LD;
    LAS bf16* WK = WQ + 64 * ML_LD;
    LAS bf16* VT = WK + 64 * ML_LD;
    LAS bf16* WKT = VT + 64 * ML_LD;
    LAS float* wl = (LAS float*)(WKT + 64 * ML_LD);
    const bf16* cm = (const bf16*)(ws + WS_CM);
    {
        const int l = tid >> 3, ch0 = (tid & 7) * 8, row = row0 + l, s = c * 64 + l;
        float a[8];
#pragma unroll
        for (int i = 0; i < 8; ++i) a[i] = convb[h * 64 + ch0 + i];
#pragma unroll
        for (int j = 0; j < 4; ++j) { if (s - 3 + j >= 0) { const v4u x4 = *(const v4u*)(cm + (size_t)(row - 3 + j) * 768 + h * 64 + ch0);
            const float* cw = convw + j * 256 + h * 64 + ch0;
            a[0] += cw[0] * __uint_as_float(x4.x << 16); a[1] += cw[1] * __uint_as_float(x4.x & 0xffff0000u); a[2] += cw[2] * __uint_as_float(x4.y << 16); a[3] += cw[3] * __uint_as_float(x4.y & 0xffff0000u);
            a[4] += cw[4] * __uint_as_float(x4.z << 16); a[5] += cw[5] * __uint_as_float(x4.z & 0xffff0000u); a[6] += cw[6] * __uint_as_float(x4.w << 16); a[7] += cw[7] * __uint_as_float(x4.w & 0xffff0000u); } }
        v4u o4; float r[8];
#pragma unroll
        for (int i = 0; i < 8; ++i) r[i] = a[i] / (1.f + __expf(-a[i]));
        o4.x = cvtpk(r[0], r[1]); o4.y = cvtpk(r[2], r[3]); o4.z = cvtpk(r[4], r[5]); o4.w = cvtpk(r[6], r[7]);
        *(v4u*)((bf16*)(ws + WS_XC) + (size_t)row * 256 + h * 64 + ch0) = o4;
        *(LAS v4u*)(XS + l * ML_LD + ch0) = o4;
        const v4u v4 = *(const v4u*)(cm + (size_t)row * 768 + 256 + h * 64 + ch0);
        VT[(ch0 + 0) * ML_LD + l] = (bf16)(v4.x & 0xffffu); VT[(ch0 + 1) * ML_LD + l] = (bf16)(v4.x >> 16); VT[(ch0 + 2) * ML_LD + l] = (bf16)(v4.y & 0xffffu); VT[(ch0 + 3) * ML_LD + l] = (bf16)(v4.y >> 16);
        VT[(ch0 + 4) * ML_LD + l] = (bf16)(v4.z & 0xffffu); VT[(ch0 + 5) * ML_LD + l] = (bf16)(v4.z >> 16); VT[(ch0 + 6) * ML_LD + l] = (bf16)(v4.w & 0xffffu); VT[(ch0 + 7) * ML_LD + l] = (bf16)(v4.w >> 16);
        const int e = tid >> 3, d0 = (tid & 7) * 8;
        *(LAS v4u*)(WQ + e * ML_LD + d0) = *(const v4u*)((const bf16*)(ws + WT_QM) + h * 4096 + e * 64 + d0);
        *(LAS v4u*)(WK + e * ML_LD + d0) = *(const v4u*)((const bf16*)(ws + WT_KM) + h * 4096 + e * 64 + d0);
    }
    if (wave_u == 0) {
        const float* mr = (const float*)(ws + WS_MISCRAW) + (size_t)(row0 + lane) * 64;
        const float z = mr[54 + h] + bfg[h]; float lf = fminf(z, 0.f) - __logf(1.f + __expf(-fabsf(z)));
        const float ig = mr[50 + h] + big[h];
#pragma unroll
        for (int o = 1; o < 64; o <<= 1) { const float t = bperm(lf, lane - o); if (lane >= o) lf += t; }
        const float bL = __int_as_float(__builtin_amdgcn_readlane(__float_as_int(lf), 63));
        const float a = bL - lf + ig; const float mx = wave_max2(a);
        wl[lane] = __expf(a - mx);
        if (lane == 0) { ((float*)(ws + WS_ML))[chunk] = mx; ((float*)(ws + WS_BL))[chunk] = bL; }
    }
    __syncthreads();
    {
        const int lb = wave_u & 3; const bool isk = wave_u >= 4;
        const LAS bf16* Wt = isk ? WK : WQ;
        bf16* og = (bf16*)(ws + (isk ? WS_MK : WS_MQ)) + (size_t)(row0 + 16 * lb + 4 * (lane >> 4)) * 256 + h * 64 + (lane & 15);
        float w4[4];
#pragma unroll
        for (int r = 0; r < 4; ++r) w4[r] = wl[16 * lb + 4 * (lane >> 4) + r];
#pragma unroll
        for (int eb = 0; eb < 4; ++eb) {
            f32x4v acc = mm16(XS, ML_LD, 16 * lb, Wt, ML_LD, 16 * eb, 64, lane, f32x4v{});
            if (!isk) {
#pragma unroll
                for (int r = 0; r < 4; ++r) og[(size_t)r * 256 + 16 * eb] = f2bf(acc[r] * 0.125f);
            } else {
                bf16 kb[4];
#pragma unroll
                for (int r = 0; r < 4; ++r) { kb[r] = f2bf(acc[r]); og[(size_t)r * 256 + 16 * eb] = kb[r]; }
                u32x2v w2; w2.x = cvtpk(bf2f(kb[0]) * w4[0], bf2f(kb[1]) * w4[1]); w2.y = cvtpk(bf2f(kb[2]) * w4[2], bf2f(kb[3]) * w4[3]);
                *(LAS u32x2v*)(WKT + (16 * eb + (lane & 15)) * ML_LD + 16 * lb + 4 * (lane >> 4)) = w2;
            }
        }
    }
    __syncthreads();
    {
        float* ct = (float*)(ws + WS_CT) + (size_t)chunk * 4096;
#pragma unroll
        for (int i = 0; i < 2; ++i) { const int blk = wave_u * 2 + i, eb = blk >> 2, db = blk & 3;
            const f32x4v acc = mm16(VT, ML_LD, 16 * eb, WKT, ML_LD, 16 * db, 64, lane, f32x4v{});
#pragma unroll
            for (int r = 0; r < 4; ++r) ct[(16 * eb + 4 * (lane >> 4) + r) * 64 + 16 * db + (lane & 15)] = acc[r]; }
        if (tid < 64) { float n = 0.f; const LAS bf16* wr_ = WKT + tid * ML_LD;
            for (int l = 0; l < 64; ++l) n += bf2f(wr_[l]);
            ((float*)(ws + WS_NL))[chunk * 64 + tid] = n; }
    }
    __syncthreads();
}
__device__ __forceinline__ void mscan_item(unsigned char* ws, int item, int wave_u) {
    const int tid = wave_u * 64 + fresh_lane();
    const int bh = item / 9, part = item % 9;
    if (part == 8 && tid >= 64) return;
    float* base; size_t stride;
    if (part < 8) { base = (float*)(ws + WS_CT) + (size_t)bh * 32 * 4096 + part * 512 + tid; stride = 4096; } else { base = (float*)(ws + WS_NL) + (size_t)bh * 32 * 64 + tid; stride = 64; }
    const float* ML = (const float*)(ws + WS_ML); const float* BL = (const float*)(ws + WS_BL); float* MPv = (float*)(ws + WS_MP);
    float Cv = 0.f, m = 0.f;
    for (int c = 0; c < 32; ++c) {
        const float cl = base[(size_t)c * stride], ml = ML[bh * 32 + c], bl = BL[bh * 32 + c];
        base[(size_t)c * stride] = Cv;
        if (part == 8 && tid == 0) MPv[bh * 32 + c] = m;
        const float mn = fmaxf(bl + m, ml);
        Cv = __expf(bl + m - mn) * Cv + __expf(ml - mn) * cl; m = mn;
    }
}
__device__ __forceinline__ void mout_item(unsigned char* ws, LAS unsigned char* lds, const float* gmh, const float* skip, int chunk, int wave_u) {
    const int lane = fresh_lane(), tid = wave_u * 64 + lane;
    const int c = chunk & 31, h = (chunk >> 5) & 3, b = chunk >> 7, row0 = b * S_ + c * 64;
    LAS bf16* QS = (LAS bf16*)lds;
    LAS bf16* KS = QS + 64 * ML_LD;
    LAS bf16* VT = KS + 64 * ML_LD;
    LAS bf16* CP = VT + 64 * ML_LD;
    LAS bf16* SW = CP + 64 * ML_LD;
    LAS float* HS = (LAS float*)(SW + 64 * ML_LD);
    LAS float* bs = HS + 64 * 65; LAS float* us = bs + 64; LAS float* ns = us + 64; LAS float* mts = ns + 64; LAS float* ints = mts + 64; LAS float* dinv = ints + 64;
    const float* gm = (const float*)(ws + WS_GM);
    {
        const int l = tid >> 3, c0 = (tid & 7) * 8, row = row0 + l;
        *(LAS v4u*)(QS + l * ML_LD + c0) = *(const v4u*)((const bf16*)(ws + WS_MQ) + (size_t)row * 256 + h * 64 + c0);
        *(LAS v4u*)(KS + l * ML_LD + c0) = *(const v4u*)((const bf16*)(ws + WS_MK) + (size_t)row * 256 + h * 64 + c0);
        const v4u v4 = *(const v4u*)((const bf16*)(ws + WS_CM) + (size_t)row * 768 + 256 + h * 64 + c0);
        VT[(c0 + 0) * ML_LD + l] = (bf16)(v4.x & 0xffffu); VT[(c0 + 1) * ML_LD + l] = (bf16)(v4.x >> 16); VT[(c0 + 2) * ML_LD + l] = (bf16)(v4.y & 0xffffu); VT[(c0 + 3) * ML_LD + l] = (bf16)(v4.y >> 16);
        VT[(c0 + 4) * ML_LD + l] = (bf16)(v4.z & 0xffffu); VT[(c0 + 5) * ML_LD + l] = (bf16)(v4.z >> 16); VT[(c0 + 6) * ML_LD + l] = (bf16)(v4.w & 0xffffu); VT[(c0 + 7) * ML_LD + l] = (bf16)(v4.w >> 16);
        const float* ct = (const float*)(ws + WS_CT) + (size_t)chunk * 4096 + l * 64 + c0;
        const f32x4v c0v = *(const f32x4v*)ct, c1v = *(const f32x4v*)(ct + 4);
        v4u cw; cw.x = cvtpk(c0v[0], c0v[1]); cw.y = cvtpk(c0v[2], c0v[3]); cw.z = cvtpk(c1v[0], c1v[1]); cw.w = cvtpk(c1v[2], c1v[3]);
        *(LAS v4u*)(CP + l * ML_LD + c0) = cw;
    }
    if (wave_u == 0) {
        const float ig = gm[(size_t)(row0 + lane) * 32 + 18 + h]; float lf = gm[(size_t)(row0 + lane) * 32 + 22 + h];
#pragma unroll
        for (int o = 1; o < 64; o <<= 1) { const float t = bperm(lf, lane - o); if (lane >= o) lf += t; }
        const float u = ig - lf; float cu = u;
#pragma unroll
        for (int o = 1; o < 64; o <<= 1) { const float t = bperm(cu, lane - o); if (lane >= o) cu = fmaxf(cu, t); }
        const float mprev = ((const float*)(ws + WS_MP))[chunk];
        const float mt = lf + fmaxf(mprev, cu);
        bs[lane] = lf; us[lane] = u; mts[lane] = mt; ints[lane] = __expf(lf + mprev - mt); ns[lane] = ((const float*)(ws + WS_NL))[chunk * 64 + lane];
    }
    __syncthreads();
    {
#pragma unroll
        for (int i = 0; i < 2; ++i) { const int blk = wave_u * 2 + i, lb = blk >> 2, sb = blk & 3;
            f32x4v acc = f32x4v{};
            if (sb <= lb) acc = mm16(QS, ML_LD, 16 * lb, KS, ML_LD, 16 * sb, 64, lane, acc);
            const int sidx = 16 * sb + (lane & 15); const float usv = us[sidx];
#pragma unroll
            for (int r = 0; r < 4; ++r) { const int l = 16 * lb + 4 * (lane >> 4) + r;
                const float v = (sidx <= l) ? acc[r] * __expf(bs[l] + usv - mts[l]) : 0.f;
                SW[l * ML_LD + sidx] = f2bf(v); } }
    }
    __syncthreads();
    if (tid < 64) {
        const int l = tid; float qn = 0.f, ssum = 0.f;
        for (int d = 0; d < 64; ++d) { qn += bf2f(QS[l * ML_LD + d]) * ns[d]; ssum += bf2f(SW[l * ML_LD + d]); }
        const float den = ints[l] * qn + ssum;
        dinv[l] = 1.f / fmaxf(fabsf(den), __expf(-mts[l]));
    }
    f32x4v hq[2], hs2[2];
#pragma unroll
    for (int i = 0; i < 2; ++i) { const int blk = wave_u * 2 + i, lb = blk >> 2, eb = blk & 3;
        hq[i] = mm16(QS, ML_LD, 16 * lb, CP, ML_LD, 16 * eb, 64, lane, f32x4v{});
        hs2[i] = mm16(SW, ML_LD, 16 * lb, VT, ML_LD, 16 * eb, 16 * lb + 16 <= 32 ? 32 : 64, lane, f32x4v{}); }
    __syncthreads();
#pragma unroll
    for (int i = 0; i < 2; ++i) { const int blk = wave_u * 2 + i, lb = blk >> 2, eb = blk & 3; const int e = 16 * eb + (lane & 15);
#pragma unroll
        for (int r = 0; r < 4; ++r) { const int l = 16 * lb + 4 * (lane >> 4) + r;
            const float og = bf2f(((const bf16*)(ws + WS_CM))[(size_t)(row0 + l) * 768 + 512 + h * 64 + e]);
            HS[l * 65 + e] = (ints[l] * hq[i][r] + hs2[i][r]) * dinv[l] / (1.f + __expf(-og)); } }
    __syncthreads();
    {
        const int l = tid >> 3, e0 = (tid & 7) * 8, row = row0 + l;
        float v[8]; float mu = 0.f;
#pragma unroll
        for (int i = 0; i < 8; ++i) { v[i] = HS[l * 65 + e0 + i]; mu += v[i]; }
        mu += sxf<1>(mu); mu += sxf<2>(mu); mu += sxf<4>(mu); mu *= (1.f / 64.f);
        float var = 0.f;
#pragma unroll
        for (int i = 0; i < 8; ++i) { const float dl = v[i] - mu; var += dl * dl; }
        var += sxf<1>(var); var += sxf<2>(var); var += sxf<4>(var);
        const float rs = rsqrtf(var * (1.f / 64.f) + EPS);
        const v4u x4 = *(const v4u*)((const bf16*)(ws + WS_XC) + (size_t)row * 256 + h * 64 + e0);
        float xv[8]; xv[0] = __uint_as_float(x4.x << 16); xv[1] = __uint_as_float(x4.x & 0xffff0000u); xv[2] = __uint_as_float(x4.y << 16); xv[3] = __uint_as_float(x4.y & 0xffff0000u);
        xv[4] = __uint_as_float(x4.z << 16); xv[5] = __uint_as_float(x4.z & 0xffff0000u); xv[6] = __uint_as_float(x4.w << 16); xv[7] = __uint_as_float(x4.w & 0xffff0000u);
        float r[8];
#pragma unroll
        for (int i = 0; i < 8; ++i) r[i] = (v[i] - mu) * rs * gmh[h * 64 + e0 + i] + skip[h * 64 + e0 + i] * xv[i];
        v4u w4; w4.x = cvtpk(r[0], r[1]); w4.y = cvtpk(r[2], r[3]); w4.z = cvtpk(r[4], r[5]); w4.w = cvtpk(r[6], r[7]);
        *(v4u*)((bf16*)(ws + WS_HB) + (size_t)row * D_ + 768 + h * 64 + e0) = w4;
    }
    __syncthreads();
}

__global__ void __launch_bounds__(NTHR, 2) mega(MP p_unused) {
    extern __shared__ __attribute__((aligned(16))) unsigned char lds_raw[];
    LAS unsigned char* lds = (LAS unsigned char*)lds_raw;
    const int wave0 = __builtin_amdgcn_readfirstlane((int)threadIdx.x >> 6);
    const int tid0 = wave0 * 64 + fresh_lane();
    const int xcc = (int)(__builtin_amdgcn_s_getreg((3 << 11) | 20) & 7u);
    volatile LAS unsigned* MISC = (volatile LAS unsigned*)(lds + MISC_OFF);
    for (int u = tid0; u < (LDS_BYTES - RING_BYTES) / 4; u += NTHR) ((LAS unsigned*)(lds + RING_BYTES))[u] = 0u;
    __syncthreads();
    typedef const __attribute__((address_space(4))) MP* kmp_t;
    kmp_t kp0 = (kmp_t)__builtin_amdgcn_kernarg_segment_ptr();
    unsigned char* ws0 = kp0->ws; const int coop = kp0->coop, ph_lo = kp0->ph_lo, ph_hi = kp0->ph_hi;
    XcdBarrier bar; bar.bar = (unsigned*)(ws0 + WS_CTL) + CW_BAR; bar.x = 0; bar.st = nullptr;
    if (coop) bar = xcd_barrier_post((unsigned*)(ws0 + WS_CTL) + CW_BAR, MISC + 8, tid0);
    if (coop == 2) cooperative_groups::this_grid().sync();
    int ph = ph_lo;
    if (ph == 0) {
        const MPK p{kp0}; ph_p0(p, lds, wave0 * 64 + fresh_lane()); ph = 1;
        if (ph < ph_hi) xcd_barrier(bar, wave0 * 64 + fresh_lane());
    }
    bool second = false;
    for (; ph < ph_hi; ++ph) {
        kmp_t kp = kp0; asm volatile("" : "+s"(kp));
        const MPK p{kp}; unsigned char* ws = kp->ws;
#define TID_ (wave0 * 64 + fresh_lane())
#define GW_ (blockIdx.x * NWAVES + wave0)
#define NGW_ (gridDim.x * NWAVES)
        const int l = (ph - 1) / PPL, ty = (ph == 0) ? -1 : (ph == NPH - 1) ? -2 : (ph - 1) % PPL;
        const float* modl = (const float*)(ws + WS_MOD) + (size_t)l * 8 * 6144;
        if (ty == -2) { norm_rows(p.k->out, PIN(I_GFIN), nullptr, nullptr, nullptr, p.k->out, 2, GW_, NGW_, fresh_lane());
            if (PROBE_SEL != 0 && blockIdx.x == 0 && TID_ == 0) { asm volatile("s_waitcnt vmcnt(0)" ::: "memory"); p.k->out[0] = ((const float*)(ws + WS_CTL))[100] * 0.001f; } }
        else if (ty == 0 && (PHM & 2)) ph_prep(p, l, lds, TID_);
        else if (ty == 1 && (PHM & 4)) {
            pg8::Gemm g{(const bf16*)(ws + WS_HB), (const bf16*)(ws + WT_IN), T_, 2560, D_}; pg8::StaticOrder S; S.init(T_, 2560, gridDim.x, blockIdx.x);
            pg8::EpiIn E{ws, PIN(I_BIG) + l * 4, PIN(I_BFG) + l * 4};
            pg8::gemm_phase<pg8::EpiIn, pg8::StaticOrder, true, true>(lds, g, S, E, wave0);
        }
        else if (ty == 2 && (PHM & 64)) {
            lora_rows(ws, TID_);
            post_misc(ws, PIN(I_BIG) + l * 4, PIN(I_BFG) + l * 4, TID_);
            unsigned* ctrs = (unsigned*)(ws + WS_CTL) + 8192 + ph * 256 + (second ? 128 : 0); int ks = 0;
            for (;;) { const int it = next_item_q(ctrs, lds, wave0, 160, xcc, ks); if (it < 0) break; const int b = it >> 16, j = it & 0xffff;
                if (second && (REP_MASK & (1 << 18)) && j >= 128) continue; if (second && (REP_MASK & (1 << 19)) && j < 128) continue;
                if (j < 128) mlocal_item(ws, lds, PIN(I_CONVW) + l * 1024, PIN(I_CONVB) + l * 256, PIN(I_BIG) + l * 4, PIN(I_BFG) + l * 4, b * 128 + j, wave0);
                else { const int k = j - 128; compress_item(ws, lds, PIN(I_CMPPOS) + l * 2048, ((k >> 4) << 7) | (b << 4) | (k & 15), wave0); } }
        }
        else if (ty == 3 && (PHM & 64)) {
            pg8::Gemm g{(const bf16*)(ws + WS_KVL), (const bf16*)(ws + WT_UKV), T_, 768, 128}; pg8::StaticOrder S; S.init(T_, 768, gridDim.x, blockIdx.x);
            pg8::EpiUKV E{(bf16*)(ws + WS_KVM)}; pg8::gemm_phase<pg8::EpiUKV, pg8::StaticOrder, true, true>(lds, g, S, E, wave0);
        }
        else if (ty == 4 && (PHM & 128)) {
            unsigned* ctrs = (unsigned*)(ws + WS_CTL) + 8192 + ph * 256 + (second ? 128 : 0); int ks = 0;
            for (;;) { const int it = next_item_q(ctrs, lds, wave0, second ? 64 : 100, xcc, ks); if (it < 0) break; const int b = it >> 16, j = it & 0xffff;
                if (second && (REP_MASK & (1 << 20)) && j >= 48) continue; if (second && (REP_MASK & (1 << 21)) && j < 48) continue;
                if (j < 48) mla_unit(ws, lds, b, j % 6, 7 - j / 6, wave0);
                else if (j < 64) cmp_unit(ws, lds, b, (j - 48) >> 3, (j - 48) & 7, wave0);
                else mscan_item(ws, b * 36 + (j - 64), wave0); }
        }
        else if (ty == 5 && (PHM & 256)) {
            unsigned* ctrs = (unsigned*)(ws + WS_CTL) + 8192 + ph * 256 + (second ? 128 : 0); int ks = 0;
            for (;;) { const int it = next_item_q(ctrs, lds, wave0, 224, xcc, ks); if (it < 0) break; const int b = it >> 16, j = it & 0xffff;
                if (second && (REP_MASK & (1 << 16)) && j >= 96) continue; if (second && (REP_MASK & (1 << 17)) && j < 96) continue;
                if (j < 48) nsa_branch_unit<AM_SLC>(ws, lds, b, j % 6, 7 - j / 6, wave0);
                else if (j < 96) nsa_branch_unit<AM_WINDOW>(ws, lds, b, (j - 48) % 6, 7 - (j - 48) / 6, wave0);
                else mout_item(ws, lds, PIN(I_GMH) + l * 256, PIN(I_SKIP) + l * 256, b * 128 + (j - 96), wave0); }
        }
        else if (ty == 6) ph_mixnorm(p, l, TID_);
        else if (ty == 7 && (PHM & 8)) {
            pg8::Gemm g{(const bf16*)(ws + WS_HB), (const bf16*)(ws + WT_OUT), T_, D_, D_}; pg8::StaticOrder S; S.init(T_, D_, gridDim.x, blockIdx.x);
            pg8::EpiRes E{(l == 0) ? PIN(I_X) : p.k->out, p.k->out, modl + 2048};
            pg8::gemm_phase<pg8::EpiRes, pg8::StaticOrder, true, true>(lds, g, S, E, wave0);
        }
        else if (ty == 8) norm_rows(p.k->out, PIN(I_GN2) + l * D_, modl + 3072, modl + 4096, (bf16*)(ws + WS_HB), nullptr, 1, GW_, NGW_, fresh_lane());
        else if (ty == 9 && (PHM & 16)) {
            pg8::Gemm g{(const bf16*)(ws + WS_HB), (const bf16*)(ws + WT_GU), T_, 2 * FF, D_}; pg8::StaticOrder S; S.init(T_, 2 * FF, gridDim.x, blockIdx.x);
            pg8::EpiGU E{(bf16*)(ws + WS_ACT)};
            pg8::gemm_phase<pg8::EpiGU, pg8::StaticOrder, true, true>(lds, g, S, E, wave0);
        }
        else if (ty == 10 && (PHM & 32)) {
            pg8::Gemm g{(const bf16*)(ws + WS_ACT), (const bf16*)(ws + WT_DOWN), T_, D_, FF}; pg8::StaticOrder S; S.init(T_, D_, gridDim.x, blockIdx.x);
            pg8::EpiRes E{p.k->out, p.k->out, modl + 5120};
            pg8::gemm_phase<pg8::EpiRes, pg8::StaticOrder, true, true>(lds, g, S, E, wave0);
        }
        if (REP_MASK != 0 && ty >= 0 && ((REP_MASK >> ty) & 1) && !second) { second = true; --ph; } else second = false;
        if (ph + 1 < ph_hi) xcd_barrier(bar, wave0 * 64 + fresh_lane());
    }
}

__global__ void k_post_misc(const float* mr, const float* cosM, const float* sinM, const float* big, const float* bfg, bf16* km, float* gm) {
    const int idx = blockIdx.x * blockDim.x + threadIdx.x;
    if (idx >= T_ * 64) return;
    const int row = idx >> 6, c = idx & 63; const float* r = mr + (size_t)row * 64; const float v = r[c];
    if (c < 32) { const int i = c & 15; const float x1 = r[i], x2 = r[16 + i], cs = cosM[row * 16 + i], sn = sinM[row * 16 + i];
        const bf16 o = f2bf((c < 16) ? x1 * cs - x2 * sn : x1 * sn + x2 * cs);
        for (int h = 0; h < 6; ++h) km[(size_t)row * 576 + h * 96 + 64 + c] = o; }
    else if (c < 50) gm[(size_t)row * 32 + (c - 32)] = sigmoidf_(v);
    else if (c < 54) gm[(size_t)row * 32 + 18 + (c - 50)] = v + big[c - 50];
    else if (c < 58) { const float z = v + bfg[c - 54]; gm[(size_t)row * 32 + 22 + (c - 54)] = fminf(z, 0.f) - log1pf(__expf(-fabsf(z))); }
}
static void run_mega(const MP& base, int lo, int hi, hipStream_t stream) {
    for (int ph = lo; ph < hi; ++ph) { MP a = base; a.ph_lo = ph; a.ph_hi = ph + 1; a.coop = 0; hipLaunchKernelGGL(mega, dim3(256), dim3(NTHR), LDS_BYTES, stream, a); }
}
extern "C" void kernel_launch(void* const* d_in, const int* in_sizes, int n_in, void* d_out, int out_size, void* d_ws, size_t ws_size, hipStream_t stream) {
    if (n_in != N_IN || ws_size < WS_END) { fprintf(stderr, "kernel_launch: unexpected n_in %d / ws %zu\n", n_in, ws_size); return; }
    static int inited = 0;
    if (!inited) { if (hipFuncSetAttribute((const void*)mega, hipFuncAttributeMaxDynamicSharedMemorySize, LDS_BYTES) != hipSuccess) fprintf(stderr, "hipFuncSetAttribute failed\n"); inited = 1; }
    unsigned char* ws = (unsigned char*)d_ws;
    MP base{}; for (int i = 0; i < N_IN; ++i) base.in[i] = (const float*)d_in[i]; base.out = (float*)d_out; base.ws = ws;
    (void)hipMemsetAsync(ws + WS_CTL, 0, CTL_ZERO_BYTES, stream);
#if defined(MK_MULTI_LAUNCH)
    run_mega(base, 0, NPH, stream);
#else
    static int grid = 0;
    if (!grid) {
        int dev = 0, cus = 0, per_cu = 0;
        (void)hipGetDevice(&dev); (void)hipDeviceGetAttribute(&cus, hipDeviceAttributeMultiprocessorCount, dev);
        if (hipOccupancyMaxActiveBlocksPerMultiprocessor(&per_cu, (const void*)mega, NTHR, LDS_BYTES) != hipSuccess || per_cu < 1) { fprintf(stderr, "kernel_launch: occupancy query says %d blocks per CU\n", per_cu); per_cu = 1; }
        (void)hipGetLastError();
        grid = cus;
    }
    MP a = base; a.ph_lo = 0; a.ph_hi = NPH; a.coop = 1;
    void* args[] = {&a};
    const hipError_t e = hipLaunchCooperativeKernel((const void*)mega, dim3(grid), dim3(NTHR), args, LDS_BYTES, stream);
    if (e != hipSuccess) fprintf(stderr, "kernel_launch: cooperative launch failed: %s (grid %d)\n", hipGetErrorString(e), grid);
#endif
}
```

```cpp
#include <hip/hip_runtime.h>
#include <cstdint>
#include <cstdio>
#include <hip/hip_cooperative_groups.h>

constexpr int B_ = 8, S_ = 2048, T_ = B_ * S_, D_ = 1024, DIN = 2362, FF = 2816, DEPTH = 2;
constexpr float EPS = 1e-6f;
constexpr float LOG2E = 1.4426950408889634f;
constexpr float QSCALE = 0.125f * LOG2E;
constexpr float MSCALE = 0.10206207261596577f * LOG2E;
enum { I_X = 0, I_C, I_POS, I_GN1, I_GN2, I_WADA, I_BADA, I_WIN, I_CMPPOS, I_WCK, I_WCV, I_GOA, I_GQL, I_WUQ, I_GKVL, I_WUKV, I_GOB,
       I_CONVW, I_CONVB, I_WQM, I_WKM, I_BIG, I_BFG, I_GMH, I_SKIP, I_WOUT, I_WGU, I_WDOWN, I_GFIN, N_IN };

constexpr size_t MiB = 1u << 20;
constexpr size_t WS_CTL = 0;
constexpr size_t WS_MOD = 1 * MiB;
constexpr size_t WS_COSP = WS_MOD + 512 * 1024;
constexpr size_t WS_SINP = WS_COSP + 512 * 1024;
constexpr size_t WS_COSM = WS_SINP + 512 * 1024;
constexpr size_t WS_SINM = WS_COSM + 1 * MiB;
constexpr size_t WS_SSQL = WS_SINM + 1 * MiB;
constexpr size_t WS_SSKV = WS_SSQL + 64 * 1024;
constexpr size_t WS_ML = WS_SSKV + 64 * 1024;
constexpr size_t WS_BL = WS_ML + 4096;
constexpr size_t WS_MP = WS_BL + 4096;
constexpr size_t WS_NL = WS_MP + 4096;
constexpr size_t WS_WT = 8 * MiB;
constexpr size_t WS_RAW = WS_WT;
constexpr size_t WS_HB = 34 * MiB;
constexpr size_t WS_NSA = 66 * MiB;
constexpr size_t WS_KVL = 102 * MiB;
constexpr size_t WS_QL = 106 * MiB;
constexpr size_t WS_CM = 114 * MiB;
constexpr size_t WS_GM = 138 * MiB;
constexpr size_t WS_KM = 140 * MiB;
constexpr size_t WS_QM = 158 * MiB;
constexpr size_t WS_VM = 176 * MiB;
constexpr size_t WS_KCV = 188 * MiB;
constexpr size_t WS_OCMP = 189 * MiB;
constexpr size_t WS_SEL = 201 * MiB;
constexpr size_t WS_XC = 202 * MiB;
constexpr size_t WS_MQ = 210 * MiB;
constexpr size_t WS_MK = 218 * MiB;
constexpr size_t WS_CT = 226 * MiB;
constexpr size_t WS_MISCRAW = 242 * MiB;
constexpr size_t WS_KVM = 140 * MiB;
constexpr size_t WS_KR = 246 * MiB;
constexpr size_t WS_OSLC = 164 * MiB;
constexpr size_t WS_OWIN = 176 * MiB;
constexpr size_t WS_ACT = 66 * MiB;
constexpr size_t WS_END = 256 * MiB;
static_assert(WS_NL + 1024 * 64 * 4 <= WS_WT, "tab");
static_assert(WS_ACT + (size_t)T_ * FF * 2 <= WS_KCV, "act overlay");

typedef unsigned short bf16;
__device__ __forceinline__ float bf2f(bf16 v) { return __uint_as_float(((unsigned)v) << 16); }
__device__ __forceinline__ bf16 f2bf(float f) { unsigned u = __float_as_uint(f); return (bf16)((u + 0x7fffu + ((u >> 16) & 1u)) >> 16); }
__device__ __forceinline__ float sigmoidf_(float x) { return 1.f / (1.f + __expf(-x)); }
__device__ __forceinline__ float siluf_(float x) { return x / (1.f + __expf(-x)); }
__device__ __forceinline__ float wave_sum(float v) {
#pragma unroll
    for (int o = 1; o < 64; o <<= 1) v += __shfl_xor(v, o);
    return v;
}

__global__ void __launch_bounds__(512) k_ada(const float* c, const float* w_ada, const float* b_ada, float* mod) {
    __shared__ float ca[8 * 1024];
    __shared__ float red[8 * 8 * 64];
    const int tid = threadIdx.x, wave = tid >> 6, lane = tid & 63;
    for (int i = tid; i < 8192; i += 512) ca[i] = siluf_(c[i]);
    __syncthreads();
    for (int item = blockIdx.x; item < 192; item += gridDim.x) {
        const int l = item / 96, j = (item % 96) * 64 + lane;
        const float* w = w_ada + (size_t)l * 1024 * 6144 + j;
        float acc[8];
#pragma unroll
        for (int b = 0; b < 8; ++b) acc[b] = 0.f;
        for (int k = wave * 128; k < wave * 128 + 128; ++k) {
            const float wv = w[(size_t)k * 6144];
#pragma unroll
            for (int b = 0; b < 8; ++b) acc[b] += ca[b * 1024 + k] * wv;
        }
#pragma unroll
        for (int b = 0; b < 8; ++b) red[(wave * 8 + b) * 64 + lane] = acc[b];
        __syncthreads();
        {
            const int b = tid >> 6; float s = 0.f;
#pragma unroll
            for (int w8 = 0; w8 < 8; ++w8) s += red[(w8 * 8 + b) * 64 + lane];
            mod[((size_t)l * 8 + b) * 6144 + j] = s + b_ada[l * 6144 + j];
        }
        __syncthreads();
    }
}
__global__ void k_rope(const int* pos, float* cosP, float* sinP, float* cosM, float* sinM) {
    const int i = blockIdx.x * blockDim.x + threadIdx.x;
    if (i >= T_ * 24) return;
    const int m = i / 24, f = i % 24;
    double inv; if (f < 8) inv = pow(500000.0, -(double)(2 * f) / 16.0); else inv = pow(500000.0, -(double)(2 * (f - 8)) / 32.0);
    const float ang = (float)pos[m] * (float)inv;
    const double a = (double)ang, kq = rint(a * 0.15915494309189535), r = a - kq * 6.283185307179586476925;
    const float cs = (float)cos(r), sn = (float)sin(r);
    if (f < 8) { cosP[m * 8 + f] = cs; sinP[m * 8 + f] = sn; } else { cosM[m * 16 + f - 8] = cs; sinM[m * 16 + f - 8] = sn; }
}
__global__ void __launch_bounds__(512) k_norm(const float* x, const float* g, const float* shift, const float* scale, bf16* hb, float* outf, int mode) {
    const int gw = blockIdx.x * 8 + (threadIdx.x >> 6), ngw = gridDim.x * 8, lane = threadIdx.x & 63;
    for (int m = gw; m < T_; m += ngw) {
        const float4* xr = (const float4*)(x + (size_t)m * D_) + lane;
        float4 v[4]; float s = 0.f;
#pragma unroll
        for (int j = 0; j < 4; ++j) { v[j] = xr[64 * j]; s += v[j].x * v[j].x + v[j].y * v[j].y + v[j].z * v[j].z + v[j].w * v[j].w; }
        const float rstd = rsqrtf(wave_sum(s) * (1.f / D_) + EPS);
        const int b = m / S_;
#pragma unroll
        for (int j = 0; j < 4; ++j) {
            const int col = 4 * lane + 256 * j;
            const float4 gg = *(const float4*)(g + col);
            float4 o; o.x = v[j].x * rstd * gg.x; o.y = v[j].y * rstd * gg.y; o.z = v[j].z * rstd * gg.z; o.w = v[j].w * rstd * gg.w;
            if (mode == 2) { *(float4*)(outf + (size_t)m * D_ + col) = o; }
            else {
                const float4 sc = *(const float4*)(scale + (size_t)b * 6144 + col), sh = *(const float4*)(shift + (size_t)b * 6144 + col);
                o.x = o.x * (1.f + sc.x) + sh.x; o.y = o.y * (1.f + sc.y) + sh.y; o.z = o.z * (1.f + sc.z) + sh.z; o.w = o.w * (1.f + sc.w) + sh.w;
                uint2 w; w.x = (unsigned)f2bf(o.x) | ((unsigned)f2bf(o.y) << 16); w.y = (unsigned)f2bf(o.z) | ((unsigned)f2bf(o.w) << 16);
                *(uint2*)(hb + (size_t)m * D_ + col) = w;
            }
        }
    }
}
__global__ void __launch_bounds__(512) k_mixnorm(bf16* mix, const float* ga, const float* gb) {
    const int gw = blockIdx.x * 8 + (threadIdx.x >> 6), ngw = gridDim.x * 8, lane = threadIdx.x & 63;
    for (int m = gw; m < T_; m += ngw) {
        bf16* r = mix + (size_t)m * D_;
        float va[6], vb[6]; float sa = 0.f, sb = 0.f;
#pragma unroll
        for (int j = 0; j < 6; ++j) { va[j] = bf2f(r[lane + 64 * j]); vb[j] = bf2f(r[384 + lane + 64 * j]); sa += va[j] * va[j]; sb += vb[j] * vb[j]; }
        const float ra = rsqrtf(wave_sum(sa) * (1.f / 384.f) + EPS), rb = rsqrtf(wave_sum(sb) * (1.f / 384.f) + EPS);
#pragma unroll
        for (int j = 0; j < 6; ++j) { r[lane + 64 * j] = f2bf(va[j] * ra * ga[lane + 64 * j]); r[384 + lane + 64 * j] = f2bf(vb[j] * rb * gb[lane + 64 * j]); }
    }
}
__global__ void __launch_bounds__(512) k_mscan(float* CT, float* NL, const float* ML, const float* BL, float* MP) {
    for (int item = blockIdx.x; item < 32 * 9; item += gridDim.x) {
        const int bh = item / 9, part = item % 9, tid = threadIdx.x;
        if (part == 8 && tid >= 64) continue;
        float* base; size_t stride;
        if (part < 8) { base = CT + (size_t)bh * 32 * 4096 + part * 512 + tid; stride = 4096; } else { base = NL + (size_t)bh * 32 * 64 + tid; stride = 64; }
        float Cv = 0.f, m = 0.f;
        for (int c = 0; c < 32; ++c) {
            const float cl = base[(size_t)c * stride], ml = ML[bh * 32 + c], bl = BL[bh * 32 + c];
            base[(size_t)c * stride] = Cv;
            if (part == 8 && tid == 0) MP[bh * 32 + c] = m;
            const float mn = fmaxf(bl + m, ml);
            Cv = __expf(bl + m - mn) * Cv + __expf(ml - mn) * cl; m = mn;
        }
    }
}

enum { EPI_RAW = 0, EPI_RES = 1, EPI_GU = 2 };
struct GemmArgs { const bf16* A; int lda; const float* W; int ldw; int K; int N; int row0; int rows; const float* kscale;
                  float* raw; const float* xin; float* xout; const float* gate; bf16* act; };
template <int EPI> __global__ void __launch_bounds__(256) k_gemm_naive(GemmArgs a) {
    __shared__ float As[16][65], Bs[16][65], Bs2[16][65];
    const int tid = threadIdx.x, tx = tid & 15, ty = tid >> 4;
    const int n0 = blockIdx.x * 64, m0 = a.row0 + blockIdx.y * 64;
    float acc[4][4], acc2[4][4];
#pragma unroll
    for (int i = 0; i < 4; ++i)
#pragma unroll
        for (int j = 0; j < 4; ++j) { acc[i][j] = 0.f; acc2[i][j] = 0.f; }
    for (int k0 = 0; k0 < a.K; k0 += 16) {
        for (int i = tid; i < 1024; i += 256) { const int r = i >> 4, kk = i & 15; As[kk][r] = bf2f(a.A[(size_t)(m0 + r) * a.lda + k0 + kk]); }
        for (int i = tid; i < 1024; i += 256) { const int kk = i >> 6, c = i & 63; const int n = n0 + c;
            float w = (n < a.N) ? a.W[(size_t)(k0 + kk) * a.ldw + n] : 0.f; if (a.kscale) w *= a.kscale[k0 + kk]; Bs[kk][c] = w;
            if (EPI == EPI_GU) Bs2[kk][c] = (n < a.N) ? a.W[(size_t)(k0 + kk) * a.ldw + a.N + n] : 0.f; }
        __syncthreads();
#pragma unroll
        for (int kk = 0; kk < 16; ++kk) {
            float av[4], bv[4], bv2[4];
#pragma unroll
            for (int i = 0; i < 4; ++i) { av[i] = As[kk][ty * 4 + i]; bv[i] = Bs[kk][tx * 4 + i]; if (EPI == EPI_GU) bv2[i] = Bs2[kk][tx * 4 + i]; }
#pragma unroll
            for (int i = 0; i < 4; ++i)
#pragma unroll
                for (int j = 0; j < 4; ++j) { acc[i][j] += av[i] * bv[j]; if (EPI == EPI_GU) acc2[i][j] += av[i] * bv2[j]; }
        }
        __syncthreads();
    }
#pragma unroll
    for (int i = 0; i < 4; ++i)
#pragma unroll
        for (int j = 0; j < 4; ++j) {
            const int row = m0 + ty * 4 + i, col = n0 + tx * 4 + j;
            if (col >= a.N) continue;
            if (EPI == EPI_RAW) a.raw[(size_t)(row - a.row0) * a.N + col] = acc[i][j];
            else if (EPI == EPI_RES) { const int b = row / S_; a.xout[(size_t)row * D_ + col] = a.xin[(size_t)row * D_ + col] + a.gate[(size_t)b * 6144 + col] * acc[i][j]; }
            else { a.act[(size_t)row * FF + col] = f2bf(siluf_(acc[i][j]) * acc2[i][j]); }
        }
}
struct PostIn { const float* raw; int row0; int rows; const float *cosP, *sinP, *cosM, *sinM, *big, *bfg; bf16 *nsa, *kvl, *ql, *cm, *km; float* gm; };
__global__ void k_post_in(PostIn p) {
    const long idx = (long)blockIdx.x * blockDim.x + threadIdx.x;
    if (idx >= (long)p.rows * DIN) return;
    const int lr = (int)(idx / DIN), c = (int)(idx % DIN), row = p.row0 + lr;
    const float* r = p.raw + (size_t)lr * DIN;
    const float v = r[c];
    if (c < 1152) {
        float val = v;
        const int seg = (c < 384) ? -1 : (c - 384) / 128;
        const bool rope = (c < 384) || seg == 0 || seg == 2 || seg == 4;
        const int d = c & 63;
        if (rope && d < 16) { const int i = d & 7, hb = c - d; const float x1 = r[hb + i], x2 = r[hb + 8 + i], cs = p.cosP[row * 8 + i], sn = p.sinP[row * 8 + i];
            val = (d < 8) ? x1 * cs - x2 * sn : x1 * sn + x2 * cs; }
        if (c < 384) val *= QSCALE;
        p.nsa[(size_t)row * 1152 + c] = f2bf(val);
    } else if (c < 1170) p.gm[(size_t)row * 32 + (c - 1152)] = sigmoidf_(v);
    else if (c < 1426) p.ql[(size_t)row * 256 + (c - 1170)] = f2bf(v);
    else if (c < 1554) p.kvl[(size_t)row * 128 + (c - 1426)] = f2bf(v);
    else if (c < 1586) { const int d = c - 1554, i = d & 15; const float x1 = r[1554 + i], x2 = r[1570 + i], cs = p.cosM[row * 16 + i], sn = p.sinM[row * 16 + i];
        const bf16 o = f2bf((d < 16) ? x1 * cs - x2 * sn : x1 * sn + x2 * cs);
        for (int h = 0; h < 6; ++h) p.km[(size_t)row * 576 + h * 96 + 64 + d] = o; }
    else if (c < 2354) p.cm[(size_t)row * 768 + (c - 1586)] = f2bf(v);
    else if (c < 2358) p.gm[(size_t)row * 32 + 18 + (c - 2354)] = v + p.big[c - 2354];
    else { const float z = v + p.bfg[c - 2358]; p.gm[(size_t)row * 32 + 22 + (c - 2358)] = fminf(z, 0.f) - log1pf(__expf(-fabsf(z))); }
}
__global__ void __launch_bounds__(512) k_ssq(const bf16* ql, const bf16* kvl, float* sq, float* skv) {
    const int gw = blockIdx.x * 8 + (threadIdx.x >> 6), ngw = gridDim.x * 8, lane = threadIdx.x & 63;
    for (int m = gw; m < T_; m += ngw) {
        float a = 0.f, b = 0.f;
        for (int j = 0; j < 4; ++j) { const float v = bf2f(ql[(size_t)m * 256 + lane + 64 * j]); a += v * v; }
        for (int j = 0; j < 2; ++j) { const float v = bf2f(kvl[(size_t)m * 128 + lane + 64 * j]); b += v * v; }
        a = wave_sum(a); b = wave_sum(b);
        if (lane == 0) { sq[m] = a; skv[m] = b; }
    }
}
__global__ void k_post_uq(const float* raw, int row0, int rows, const float* ssq, const float* cosM, const float* sinM, bf16* qm) {
    const long idx = (long)blockIdx.x * blockDim.x + threadIdx.x;
    if (idx >= (long)rows * 576) return;
    const int lr = (int)(idx / 576), c = (int)(idx % 576), row = row0 + lr;
    const float* r = raw + (size_t)lr * 576;
    const float rstd = rsqrtf(ssq[row] * (1.f / 256.f) + EPS);
    const int h = c / 96, d = c % 96;
    float val = r[c] * rstd;
    if (d >= 64) { const int dd = d - 64, i = dd & 15; const float x1 = r[h * 96 + 64 + i] * rstd, x2 = r[h * 96 + 80 + i] * rstd, cs = cosM[row * 16 + i], sn = sinM[row * 16 + i];
        val = (dd < 16) ? x1 * cs - x2 * sn : x1 * sn + x2 * cs; }
    qm[(size_t)row * 576 + c] = f2bf(val * MSCALE);
}
__global__ void k_post_ukv(const float* raw, int row0, int rows, const float* ssq, bf16* km, bf16* vm) {
    const long idx = (long)blockIdx.x * blockDim.x + threadIdx.x;
    if (idx >= (long)rows * 768) return;
    const int lr = (int)(idx / 768), c = (int)(idx % 768), row = row0 + lr;
    const float rstd = rsqrtf(ssq[row] * (1.f / 128.f) + EPS);
    const float val = raw[(size_t)lr * 768 + c] * rstd;
    const int h = c / 128, w = c % 128;
    if (w < 64) km[(size_t)row * 576 + h * 96 + w] = f2bf(val); else vm[(size_t)row * 384 + h * 64 + (w - 64)] = f2bf(val);
}
__global__ void k_compress(const bf16* nsa, const float* cmp_pos, const float* wk, const float* wv, bf16* kcv) {
    const int idx = blockIdx.x * blockDim.x + threadIdx.x;
    if (idx >= 2 * 8 * 2 * 128 * 64) return;
    const int e = idx & 63, n = (idx >> 6) & 127, g = (idx >> 13) & 1, b = (idx >> 14) & 7, kv = idx >> 17;
    float acc = 0.f;
    if (n < 127) {
        const float* w = kv ? wv : wk; const int col = (kv ? 512 : 384) + g * 64;
        for (int l = 0; l < 32; ++l) { const bf16* tr = nsa + (size_t)(b * S_ + 16 * n + l) * 1152 + col;
            for (int d = 0; d < 64; ++d) acc += (bf2f(tr[d]) + cmp_pos[l * 64 + d]) * w[(size_t)(l * 64 + d) * 64 + e]; }
    }
    kcv[(size_t)kv * (8 * 2 * 128 * 64) + ((size_t)(b * 2 + g) * 128 + n) * 64 + e] = f2bf(acc);
}
__global__ void __launch_bounds__(64) k_cmp_sel(const bf16* nsa, const bf16* kcv, bf16* ocmp, unsigned* sel) {
    __shared__ float P[64][129], SC[64][129];
    const int tid = threadIdx.x, tile = blockIdx.x & 31, g = (blockIdx.x >> 5) & 1, b = blockIdx.x >> 6;
    const int t = tile * 64 + tid, row = b * S_ + t;
    const bf16* kc = kcv + (size_t)(b * 2 + g) * 128 * 64; const bf16* vc = kc + (size_t)8 * 2 * 128 * 64;
    int nvis = (t >= 31) ? ((t - 31) / 16 + 1) : 0; if (nvis > 127) nvis = 127;
    for (int n = 0; n < 128; ++n) P[tid][n] = 0.f;
    for (int r = 0; r < 3; ++r) {
        const int h = 3 * g + r;
        float q[64];
#pragma unroll
        for (int d = 0; d < 64; ++d) q[d] = bf2f(nsa[(size_t)row * 1152 + h * 64 + d]);
        float m = -1e30f;
        for (int n = 0; n < nvis; ++n) { float s = 0.f;
#pragma unroll
            for (int d = 0; d < 64; ++d) s += q[d] * bf2f(kc[n * 64 + d]);
            SC[tid][n] = s; m = fmaxf(m, s); }
        float l = 0.f;
        for (int n = 0; n < nvis; ++n) { const float p = exp2f(SC[tid][n] - m); SC[tid][n] = p; l += p; }
        const float il = (nvis > 0) ? 1.f / l : 0.f;
        float o[64];
#pragma unroll
        for (int d = 0; d < 64; ++d) o[d] = 0.f;
        for (int n = 0; n < nvis; ++n) { const float p = SC[tid][n] * il; P[tid][n] += p;
#pragma unroll
            for (int d = 0; d < 64; ++d) o[d] += p * bf2f(vc[n * 64 + d]); }
#pragma unroll
        for (int d = 0; d < 64; ++d) ocmp[(size_t)row * 384 + h * 64 + d] = f2bf(o[d]);
    }
    const int cur = t >> 6;
    for (int j = 0; j < 32; ++j) {
        float v = 0.f;
        for (int n = 4 * j - 1; n <= 4 * j + 3; ++n) if (n >= 0 && n < 127) v += P[tid][n];
        if (j == 0 || j == cur || j == cur - 1) v = INFINITY;
        if (j * 64 > t) v = -INFINITY;
        SC[tid][j] = v;
    }
    unsigned mask = 0;
    for (int j = 0; j < 32; ++j) { const float v = SC[tid][j]; int rank = 0;
        for (int k = 0; k < 32; ++k) { const float u = SC[tid][k]; rank += (u > v || (u == v && k < j)) ? 1 : 0; }
        if (rank < 16) mask |= 1u << j; }
    sel[(size_t)(b * 2 + g) * S_ + t] = mask;
}
template <int DQK, int MODE> __global__ void __launch_bounds__(64) k_attn_naive(const bf16* Q, int ldq, const bf16* K, int ldk, const bf16* V, int ldv,
        const unsigned* sel, const bf16* ocmp, const bf16* oslc_in, const float* gm, bf16* out) {
    const int t = blockIdx.x * 64 + threadIdx.x, h = blockIdx.y, b = blockIdx.z, row = b * S_ + t;
    const int g = (MODE == 2) ? h : h / 3;
    float q[DQK];
#pragma unroll
    for (int d = 0; d < DQK; ++d) q[d] = bf2f(Q[(size_t)row * ldq + h * DQK + d]);
    float o[64];
#pragma unroll
    for (int d = 0; d < 64; ++d) o[d] = 0.f;
    float m = -1e30f, l = 0.f;
    unsigned sm = 0xffffffffu; if (MODE == 0) sm = sel[(size_t)(b * 2 + g) * S_ + t];
    int j0 = 0; if (MODE == 1) j0 = (t - 511 > 0) ? t - 511 : 0;
    for (int j = j0; j <= t; ++j) {
        if (MODE == 0 && !((sm >> (j >> 6)) & 1u)) { j |= 63; continue; }
        const bf16* kr = K + (size_t)(b * S_ + j) * ldk + g * DQK;
        float s = 0.f;
#pragma unroll
        for (int d = 0; d < DQK; ++d) s += q[d] * bf2f(kr[d]);
        if (s > m) { const float f = exp2f(m - s); l *= f;
#pragma unroll
            for (int d = 0; d < 64; ++d) o[d] *= f;
            m = s; }
        const float p = exp2f(s - m); l += p;
        const bf16* vr = V + (size_t)(b * S_ + j) * ldv + g * 64;
#pragma unroll
        for (int d = 0; d < 64; ++d) o[d] += p * bf2f(vr[d]);
    }
    const float il = 1.f / l;
    if (MODE == 0) {
#pragma unroll
        for (int d = 0; d < 64; ++d) out[(size_t)row * 384 + h * 64 + d] = f2bf(o[d] * il);
    } else if (MODE == 1) {
        const float g0 = gm[(size_t)row * 32 + h * 3], g1 = gm[(size_t)row * 32 + h * 3 + 1], g2 = gm[(size_t)row * 32 + h * 3 + 2];
#pragma unroll
        for (int d = 0; d < 64; ++d) out[(size_t)row * D_ + h * 64 + d] =
            f2bf(g0 * bf2f(ocmp[(size_t)row * 384 + h * 64 + d]) + g1 * bf2f(oslc_in[(size_t)row * 384 + h * 64 + d]) + g2 * o[d] * il);
    } else {
#pragma unroll
        for (int d = 0; d < 64; ++d) out[(size_t)row * D_ + 384 + h * 64 + d] = f2bf(o[d] * il);
    }
}
__global__ void k_mconv(const bf16* cm, const float* cw, const float* cb, bf16* xc) {
    const int idx = blockIdx.x * blockDim.x + threadIdx.x;
    if (idx >= T_ * 256) return;
    const int row = idx >> 8, ch = idx & 255, s = row % S_;
    float a = cb[ch];
    for (int j = 0; j < 4; ++j) { const int ss = s - 3 + j; if (ss >= 0) a += cw[j * 256 + ch] * bf2f(cm[(size_t)(row - 3 + j) * 768 + ch]); }
    xc[idx] = f2bf(siluf_(a));
}
__global__ void k_mqk(const bf16* xc, const float* wq, const float* wk, bf16* mq, bf16* mk) {
    const int idx = blockIdx.x * blockDim.x + threadIdx.x;
    if (idx >= T_ * 256) return;
    const int row = idx >> 8, h = (idx >> 6) & 3, e = idx & 63;
    float aq = 0.f, ak = 0.f;
    for (int d = 0; d < 64; ++d) { const float x = bf2f(xc[(size_t)row * 256 + h * 64 + d]); aq += x * wq[(h * 64 + d) * 64 + e]; ak += x * wk[(h * 64 + d) * 64 + e]; }
    mq[idx] = f2bf(aq * 0.125f); mk[idx] = f2bf(ak);
}
__global__ void __launch_bounds__(64) k_mlocal(const bf16* mk, const bf16* cm, const float* gm, float* CT, float* NL, float* ML, float* BL) {
    __shared__ float w[64], bs[64];
    const int chunk = blockIdx.x, c = chunk & 31, h = (chunk >> 5) & 3, b = chunk >> 7, d = threadIdx.x;
    const int row0 = b * S_ + c * 64;
    if (d == 0) { float acc = 0.f; for (int l = 0; l < 64; ++l) { acc += gm[(size_t)(row0 + l) * 32 + 22 + h]; bs[l] = acc; } }
    __syncthreads();
    const float bL = bs[63];
    float a = bL - bs[d] + gm[(size_t)(row0 + d) * 32 + 18 + h];
    float mx = a;
#pragma unroll
    for (int o = 1; o < 64; o <<= 1) mx = fmaxf(mx, __shfl_xor(mx, o));
    w[d] = __expf(a - mx);
    __syncthreads();
    float C[64]; float n = 0.f;
#pragma unroll
    for (int e = 0; e < 64; ++e) C[e] = 0.f;
    for (int l = 0; l < 64; ++l) {
        const float kk = bf2f(mk[(size_t)(row0 + l) * 256 + h * 64 + d]) * w[l]; n += kk;
        const bf16* vr = cm + (size_t)(row0 + l) * 768 + 256 + h * 64;
#pragma unroll
        for (int e = 0; e < 64; ++e) C[e] += kk * bf2f(vr[e]);
    }
#pragma unroll
    for (int e = 0; e < 64; ++e) CT[(size_t)chunk * 4096 + e * 64 + d] = C[e];
    NL[chunk * 64 + d] = n;
    if (d == 0) { ML[chunk] = mx; BL[chunk] = bL; }
}
__global__ void __launch_bounds__(64) k_mout(const bf16* mq, const bf16* mk, const bf16* cm, const bf16* xc, const float* gm, const float* CT, const float* NL, const float* MP,
                                             const float* gmh, const float* skip, bf16* mix) {
    __shared__ float bs[64], us[64], Ks[64][65], Vs[64][65], Cs[64][65], Qs[64][65], ns[64];
    const int chunk = blockIdx.x, c = chunk & 31, h = (chunk >> 5) & 3, b = chunk >> 7, l = threadIdx.x;
    const int row0 = b * S_ + c * 64, row = row0 + l;
    if (l == 0) { float acc = 0.f; for (int i = 0; i < 64; ++i) { acc += gm[(size_t)(row0 + i) * 32 + 22 + h]; bs[i] = acc; } }
    for (int d = 0; d < 64; ++d) { Ks[l][d] = bf2f(mk[(size_t)row * 256 + h * 64 + d]); Vs[l][d] = bf2f(cm[(size_t)row * 768 + 256 + h * 64 + d]); Cs[l][d] = CT[(size_t)chunk * 4096 + l * 64 + d]; }
    ns[l] = NL[chunk * 64 + l];
    __syncthreads();
    us[l] = gm[(size_t)row * 32 + 18 + h] - bs[l];
    __syncthreads();
    const float mprev = MP[chunk];
    float cu = -INFINITY; for (int s = 0; s <= l; ++s) cu = fmaxf(cu, us[s]);
    const float mt = bs[l] + fmaxf(mprev, cu), inter = __expf(bs[l] + mprev - mt);
    for (int d = 0; d < 64; ++d) Qs[l][d] = bf2f(mq[(size_t)row * 256 + h * 64 + d]);
    float num[64]; float qn = 0.f;
#pragma unroll
    for (int e = 0; e < 64; ++e) num[e] = 0.f;
    for (int d = 0; d < 64; ++d) { const float qd = Qs[l][d]; qn += qd * ns[d];
#pragma unroll
        for (int e = 0; e < 64; ++e) num[e] += qd * Cs[e][d]; }
#pragma unroll
    for (int e = 0; e < 64; ++e) num[e] *= inter;
    float den = inter * qn;
    for (int s = 0; s < 64; ++s) {
        if (s <= l) { float sd = 0.f;
            for (int d = 0; d < 64; ++d) sd += Qs[l][d] * Ks[s][d];
            const float sw = sd * __expf(bs[l] + us[s] - mt); den += sw;
#pragma unroll
            for (int e = 0; e < 64; ++e) num[e] += sw * Vs[s][e]; }
    }
    const float dn = 1.f / fmaxf(fabsf(den), __expf(-mt));
    float mu = 0.f;
#pragma unroll
    for (int e = 0; e < 64; ++e) { num[e] = num[e] * dn * sigmoidf_(bf2f(cm[(size_t)row * 768 + 512 + h * 64 + e])); mu += num[e]; }
    mu *= (1.f / 64.f); float var = 0.f;
#pragma unroll
    for (int e = 0; e < 64; ++e) { const float dlt = num[e] - mu; var += dlt * dlt; }
    const float rs = rsqrtf(var * (1.f / 64.f) + EPS);
#pragma unroll
    for (int e = 0; e < 64; ++e) mix[(size_t)row * D_ + 768 + h * 64 + e] = f2bf((num[e] - mu) * rs * gmh[h * 64 + e] + skip[h * 64 + e] * bf2f(xc[(size_t)row * 256 + h * 64 + e]));
}


__device__ __forceinline__ int fresh_lane() { int l; asm volatile("v_mbcnt_lo_u32_b32 %0, -1, 0\n\tv_mbcnt_hi_u32_b32 %0, -1, %0" : "=&v"(l)); return l; }
template <int M> __device__ __forceinline__ float sxf(float v) { static_assert(M >= 1 && M < 32, "swizzle xor mask"); return __int_as_float(__builtin_amdgcn_ds_swizzle(__float_as_int(v), (M << 10) | 0x1f)); }
__device__ __forceinline__ float red32_max(float v) { auto r = __builtin_amdgcn_permlane32_swap(__float_as_uint(v), __float_as_uint(v), false, false); return fmaxf(__uint_as_float(r[0]), __uint_as_float(r[1])); }
__device__ __forceinline__ float red32_sum(float v) { auto r = __builtin_amdgcn_permlane32_swap(__float_as_uint(v), __float_as_uint(v), false, false); return __uint_as_float(r[0]) + __uint_as_float(r[1]); }
__device__ __forceinline__ unsigned red32_or(unsigned v) { auto r = __builtin_amdgcn_permlane32_swap(v, v, false, false); return r[0] | r[1]; }
__device__ __forceinline__ float bperm(float v, int src_lane) { return __int_as_float(__builtin_amdgcn_ds_bpermute(src_lane << 2, __float_as_int(v))); }
__device__ __forceinline__ float wave_sum2(float v) { v += sxf<1>(v); v += sxf<2>(v); v += sxf<4>(v); v += sxf<8>(v); v += sxf<16>(v); return red32_sum(v); }
__device__ __forceinline__ float wave_max2(float v) { v = fmaxf(v, sxf<1>(v)); v = fmaxf(v, sxf<2>(v)); v = fmaxf(v, sxf<4>(v)); v = fmaxf(v, sxf<8>(v)); v = fmaxf(v, sxf<16>(v)); return red32_max(v); }
namespace pg8 {
#define PG8_LAS __attribute__((address_space(3)))
typedef unsigned short bf16_t;
typedef short bf16x8 __attribute__((ext_vector_type(8)));
typedef float f32x4 __attribute__((ext_vector_type(4)));
typedef unsigned u32x4 __attribute__((ext_vector_type(4)));
constexpr int BM = 256, BK = 64, HALF = 128, HTB = HALF * BK * 2  , STAGE_BYTES = 8 * HTB, NXCD = 8, WGM = 8;

__host__ __device__ __forceinline__ int lds_byte(int r, int c) { const int st = (r >> 4) * 2 + (c >> 5), rr = r & 15, cc = c & 31, ob = rr * 64 + cc * 2; return st * 1024 + (ob ^ (((ob >> 9) & 1) << 5)); }
__host__ __device__ __forceinline__ void stage_rc(int b, int& R, int& C) { const int st = b / 1024, sb = b % 1024, swz = sb ^ (((sb >> 9) & 1) << 5); R = (st >> 1) * 16 + swz / 64; C = (st & 1) * 32 + (swz % 64) / 2; }
__host__ __device__ __forceinline__ int perm32(int rho) { const int n = rho >> 4, i = rho & 15; return 8 * (i >> 2) + 4 * n + (i & 3); }

struct Unit { int pm, pn; };
struct Gemm { const bf16_t* A; const bf16_t* Bt; int M, N, K; };

struct StaticOrder {
    int nM, nN, nwg, G, c;
    __host__ __device__ void init(int M, int N, int G_, int c_) { nM = M / BM; nN = N / BM; nwg = nM * nN; G = G_; c = c_; }
    __host__ __device__ bool next(int i, Unit& u) const {
        const long L = (long)i * G + c; if (L >= nwg) return false;
        int wgid = (int)L; { const int q = nwg / NXCD, r = nwg % NXCD, xcd = wgid % NXCD, off = wgid / NXCD; wgid = (xcd < r ? xcd * (q + 1) : r * (q + 1) + (xcd - r) * q) + off; }
        const int nig = WGM * nN, gid = wgid / nig, fm = gid * WGM, gsz = (nM - fm) < WGM ? (nM - fm) : WGM;
        u.pm = fm + ((wgid % nig) % gsz); u.pn = (wgid % nig) / gsz; return true;
    }
    __device__ __forceinline__ void a_ready(const Unit&) const {}
    __device__ __forceinline__ void done(const Unit&) const {}
};

__device__ __forceinline__ unsigned cvt_pk_bf16(float lo, float hi) { unsigned r; asm volatile("v_cvt_pk_bf16_f32 %0, %1, %2" : "=v"(r) : "v"(lo), "v"(hi)); return r; }
typedef float f32x2 __attribute__((ext_vector_type(2)));

typedef unsigned u32x4 __attribute__((ext_vector_type(4)));
typedef unsigned u32x2 __attribute__((ext_vector_type(2)));
struct EpiIn {
    static constexpr bool PERM = true, AFTER_DRAIN = false;
    unsigned char* ws; const float *big, *bfg;
#define EPI_ROWS(...) _Pragma("unroll") for (int ai = 0; ai < 2; ++ai) _Pragma("unroll") for (int m = 0; m < 4; ++m) { \
        const int row = u.pm * BM + ai * HALF + wr * 64 + m * 16 + fr; float v[8]; \
        _Pragma("unroll") for (int i = 0; i < 4; ++i) { v[i] = acc[ai][bj][m][0][i]; v[4 + i] = acc[ai][bj][m][1][i]; } \
        asm volatile("" : "+v"(v[0]), "+v"(v[1]), "+v"(v[2]), "+v"(v[3]), "+v"(v[4]), "+v"(v[5]), "+v"(v[6]), "+v"(v[7])); \
        __VA_ARGS__ asm volatile("" ::: "memory"); }
#define EPI_PACK(w) u32x4 w; w.x = cvt_pk_bf16(v[0], v[1]); w.y = cvt_pk_bf16(v[2], v[3]); w.z = cvt_pk_bf16(v[4], v[5]); w.w = cvt_pk_bf16(v[6], v[7]);
    __device__ __forceinline__ void operator()(const f32x4 (&acc)[2][2][4][2], const Unit& u, int wr, int wc, int fr, int fq) const {
        half<0>(acc, u, wr, wc, fr, fq); half<1>(acc, u, wr, wc, fr, fq);
    }
    template <int bj> __device__ __forceinline__ void half(const f32x4 (&acc)[2][2][4][2], const Unit& u, int wr, int wc, int fr, int fq) const {
        {
            const int hb = 2 * u.pn + bj;
            int cb = 32 * wc + 8 * fq; asm volatile("" : "+v"(cb), "+v"(fr));
            if (hb <= 8) {
                bf16_t* nsa = (bf16_t*)(ws + WS_NSA) + hb * 128 + cb;
                const bool rope_hb = (hb <= 3) || hb == 5 || hb == 7;
                if (rope_hb) {
                    const float* cosP = (const float*)(ws + WS_COSP); const float* sinP = (const float*)(ws + WS_SINP);
                    const bool mine = ((wc & 1) == 0) && fq < 2; const float sg = (fq == 0) ? -1.f : 1.f; const float sc = (hb < 3) ? QSCALE : 1.f;
                    EPI_ROWS({
                        float pv[8];
                        _Pragma("unroll") for (int i = 0; i < 8; ++i) pv[i] = sxf<16>(v[i]);
                        if (mine) {
                            const f32x4 c0 = *(const f32x4*)(cosP + row * 8), c1 = *(const f32x4*)(cosP + row * 8 + 4), s0 = *(const f32x4*)(sinP + row * 8), s1 = *(const f32x4*)(sinP + row * 8 + 4);
                            _Pragma("unroll") for (int i = 0; i < 4; ++i) { v[i] = v[i] * c0[i] + sg * pv[i] * s0[i]; v[4 + i] = v[4 + i] * c1[i] + sg * pv[4 + i] * s1[i]; }
                        }
                        _Pragma("unroll") for (int i = 0; i < 8; ++i) v[i] *= sc;
                        EPI_PACK(w) *(u32x4*)(nsa + (size_t)row * 1152) = w;
                    })
                } else {
                    EPI_ROWS({ EPI_PACK(w) *(u32x4*)(nsa + (size_t)row * 1152) = w; })
                }
            } else if (hb <= 11) {
                bf16_t* dst = (hb == 9) ? (bf16_t*)(ws + WS_KVL) + cb : (bf16_t*)(ws + WS_QL) + (hb - 10) * 128 + cb;
                const int ld = (hb == 9) ? 128 : 256;
                float* ssq = (hb == 9) ? (float*)(ws + WS_SSKV) : (float*)(ws + WS_SSQL);
                EPI_ROWS({ EPI_PACK(w) *(u32x4*)(dst + (size_t)row * ld) = w;
                    float sq = 0.f;
                    _Pragma("unroll") for (int i = 0; i < 8; ++i) sq += v[i] * v[i];
                    sq += sxf<16>(sq); sq = red32_sum(sq);
                    if (fq == 0) atomicAdd(ssq + row, sq); })
            } else if (hb <= 17) {
                bf16_t* cm = (bf16_t*)(ws + WS_CM) + (hb - 12) * 128 + cb;
                EPI_ROWS({ EPI_PACK(w) *(u32x4*)(cm + (size_t)row * 768) = w; })
            } else if (hb == 18) {
                float* mr = (float*)(ws + WS_MISCRAW) + cb;
                if (wc < 2) { EPI_ROWS({ *(f32x4*)(mr + (size_t)row * 64) = (f32x4){v[0], v[1], v[2], v[3]}; *(f32x4*)(mr + (size_t)row * 64 + 4) = (f32x4){v[4], v[5], v[6], v[7]}; }) }
            }
        }
    }
#undef EPI_ROWS
#undef EPI_PACK
};
struct EpiUKV {
    static constexpr bool PERM = true, AFTER_DRAIN = false;
    bf16_t* kvm; const float* sskv;
    __device__ __forceinline__ void operator()(const f32x4 (&acc)[2][2][4][2], const Unit& u, int wr, int wc, int fr, int fq) const {
        asm volatile("" : "+v"(fq), "+v"(fr));
        const int col0 = u.pn * BM + wc * 32 + 8 * fq;
#pragma unroll
        for (int ai = 0; ai < 2; ++ai)
#pragma unroll
            for (int m = 0; m < 4; ++m) { const int row = u.pm * BM + ai * HALF + wr * 64 + m * 16 + fr; bf16_t* rowp = kvm + (size_t)row * 768 + col0;
                const float rs = rsqrtf(sskv[row] * (1.f / 128.f) + EPS);
#pragma unroll
                for (int bj = 0; bj < 2; ++bj) { const f32x4 a = acc[ai][bj][m][0] * rs, b = acc[ai][bj][m][1] * rs;
                    u32x4 w; w.x = cvt_pk_bf16(a[0], a[1]); w.y = cvt_pk_bf16(a[2], a[3]); w.z = cvt_pk_bf16(b[0], b[1]); w.w = cvt_pk_bf16(b[2], b[3]);
                    *(u32x4*)(rowp + bj * HALF) = w; }
                asm volatile("" ::: "memory"); }
    }
};
struct EpiPlain {
    static constexpr bool PERM = true, AFTER_DRAIN = false;
    bf16_t* out; int ld;
    __device__ __forceinline__ void operator()(const f32x4 (&acc)[2][2][4][2], const Unit& u, int wr, int wc, int fr, int fq) const {
        asm volatile("" : "+v"(fq), "+v"(fr));
        const int col0 = u.pn * BM + wc * 32 + 8 * fq;
#pragma unroll
        for (int ai = 0; ai < 2; ++ai)
#pragma unroll
            for (int m = 0; m < 4; ++m) { bf16_t* rowp = out + (size_t)(u.pm * BM + ai * HALF + wr * 64 + m * 16 + fr) * ld + col0;
#pragma unroll
                for (int bj = 0; bj < 2; ++bj) { const f32x4 a = acc[ai][bj][m][0], b = acc[ai][bj][m][1];
                    u32x4 w; w.x = cvt_pk_bf16(a[0], a[1]); w.y = cvt_pk_bf16(a[2], a[3]); w.z = cvt_pk_bf16(b[0], b[1]); w.w = cvt_pk_bf16(b[2], b[3]);
                    *(u32x4*)(rowp + bj * HALF) = w; } }
    }
};
struct EpiRes {
    static constexpr bool PERM = false, AFTER_DRAIN = false;
    const float* xin; float* xout; const float* gate;
    __device__ __forceinline__ void operator()(const f32x4 (&acc)[2][2][4][2], const Unit& u, int wr, int wc, int fr, int fq) const {
        asm volatile("" : "+v"(fq), "+v"(fr));
        const int b = (u.pm * BM) / S_; const int col0 = u.pn * BM + wc * 32 + 4 * fq;
        f32x4 gv[2][2];
#pragma unroll
        for (int bj = 0; bj < 2; ++bj)
#pragma unroll
            for (int n = 0; n < 2; ++n) gv[bj][n] = *(const f32x4*)(gate + (size_t)b * 6144 + col0 + bj * HALF + n * 16);
#pragma unroll
        for (int ai = 0; ai < 2; ++ai)
#pragma unroll
            for (int m = 0; m < 4; ++m) { const size_t off = (size_t)(u.pm * BM + ai * HALF + wr * 64 + m * 16 + fr) * D_ + col0;
#pragma unroll
                for (int bj = 0; bj < 2; ++bj)
#pragma unroll
                    for (int n = 0; n < 2; ++n) { const f32x4 xi = *(const f32x4*)(xin + off + bj * HALF + n * 16); *(f32x4*)(xout + off + bj * HALF + n * 16) = xi + gv[bj][n] * acc[ai][bj][m][n]; } }
    }
};
struct EpiGU {
    static constexpr bool PERM = true, AFTER_DRAIN = false;
    bf16_t* act;
    __device__ __forceinline__ void operator()(const f32x4 (&acc)[2][2][4][2], const Unit& u, int wr, int wc, int fr, int fq) const {
        asm volatile("" : "+v"(fq), "+v"(fr));
        const int col0 = u.pn * HALF + wc * 32 + 8 * fq;
#pragma unroll
        for (int ai = 0; ai < 2; ++ai)
#pragma unroll
            for (int m = 0; m < 4; ++m) { const int row = u.pm * BM + ai * HALF + wr * 64 + m * 16 + fr; float o[8];
#pragma unroll
                for (int n = 0; n < 2; ++n)
#pragma unroll
                    for (int i = 0; i < 4; ++i) { const float g = acc[ai][0][m][n][i], up = acc[ai][1][m][n][i]; o[4 * n + i] = g / (1.f + __expf(-g)) * up; }
                u32x4 w; w.x = cvt_pk_bf16(o[0], o[1]); w.y = cvt_pk_bf16(o[2], o[3]); w.z = cvt_pk_bf16(o[4], o[5]); w.w = cvt_pk_bf16(o[6], o[7]);
                *(u32x4*)(act + (size_t)row * FF + col0) = w; }
    }
};
template <class Epi, class Sched, bool ALIGN_EPI = false, bool SP2 = false>
__device__ __forceinline__ void gemm_phase(PG8_LAS unsigned char* lds, const Gemm g, const Sched& S, const Epi& E, int wid_in) {
    const int wid = __builtin_amdgcn_readfirstlane(wid_in), lane = fresh_lane(), tid = wid * 64 + lane, wr = wid >> 2, wc = wid & 3;
    const int K = g.K, nt = K / BK;
    unsigned voffA[2], voffB[2];
#pragma unroll
    for (int i = 0; i < 2; ++i) { int R, C; stage_rc(tid * 16 + i * 8192, R, C); const int Rb = Epi::PERM ? ((R & ~31) + perm32(R & 31)) : R;
        voffA[i] = (unsigned)(R * K + C) * 2u; voffB[i] = (unsigned)(Rb * K + C) * 2u; }
    const size_t kstep = (size_t)(BK * 2);
    const size_t hstep = (size_t)HALF * K * 2;
    const size_t tstep = 2 * hstep;
    const unsigned ldsw = (unsigned)wid * 1024u;
    const int aoff = lds_byte(wr * 64 + (lane & 15), (lane >> 4) * 8), boff = lds_byte(wc * 32 + (lane & 15), (lane >> 4) * 8);
#define PG8_SA(b, h) (((b) * 2 + (h)) * HTB)
#define PG8_SB(b, h) ((4 + (b) * 2 + (h)) * HTB)
#define PG8_STAGE(bufoff, gbase, voff) do { _Pragma("unroll") for (int _i = 0; _i < 2; ++_i) \
        __builtin_amdgcn_global_load_lds((const unsigned*)((const char*)(gbase) + (voff)[_i]), (PG8_LAS unsigned*)(lds + (bufoff) + ldsw + _i * 8192), 16, 0, 0); } while (0)
#define PG8_LDA(dst, b, h) do { _Pragma("unroll") for (int m = 0; m < 4; ++m) _Pragma("unroll") for (int k = 0; k < 2; ++k) dst[m][k] = *(const PG8_LAS bf16x8*)(lds + PG8_SA(b, h) + aoff + m * 2048 + k * 1024); } while (0)
#define PG8_LDB(dst, b, h) do { _Pragma("unroll") for (int n = 0; n < 2; ++n) _Pragma("unroll") for (int k = 0; k < 2; ++k) dst[n][k] = *(const PG8_LAS bf16x8*)(lds + PG8_SB(b, h) + boff + n * 2048 + k * 1024); } while (0)
#define PG8_MMA(ai, bj, At, Bt) do { __builtin_amdgcn_s_setprio(1); _Pragma("unroll") for (int m = 0; m < 4; ++m) _Pragma("unroll") for (int n = 0; n < 2; ++n) _Pragma("unroll") for (int k = 0; k < 2; ++k) \
        acc[ai][bj][m][n] = __builtin_amdgcn_mfma_f32_16x16x32_bf16(Bt[n][k], At[m][k], acc[ai][bj][m][n], 0, 0, 0); __builtin_amdgcn_s_setprio(0); } while (0)
#define PG8_WAIT_V(n) asm volatile("s_waitcnt vmcnt(" #n ")" ::: "memory")
#define PG8_WAIT_L(n) asm volatile("s_waitcnt lgkmcnt(" #n ")" ::: "memory")
#define PG8_BAR __builtin_amdgcn_s_barrier()
#define PG8_SCHED __builtin_amdgcn_sched_barrier(0)
    Unit cur, nxt; int ui = 0;
    if (!S.next(0, cur)) return;
    f32x4 acc[2][2][4][2];
#pragma unroll
    for (int a = 0; a < 2; ++a)
#pragma unroll
        for (int b = 0; b < 2; ++b)
#pragma unroll
            for (int m = 0; m < 4; ++m)
#pragma unroll
                for (int n = 0; n < 2; ++n) acc[a][b][m][n] = (f32x4){0.f, 0.f, 0.f, 0.f};
    bf16x8 At[4][2], B0[2][2], B1[2][2];
    const char* cA = (const char*)g.A + (size_t)cur.pm * tstep; const char* cB = (const char*)g.Bt + (size_t)cur.pn * tstep;
    S.a_ready(cur);
    if constexpr (SP2) {
        PG8_STAGE(PG8_SB(0, 0), cB, voffB); PG8_STAGE(PG8_SB(0, 1), cB + hstep, voffB); PG8_STAGE(PG8_SA(0, 0), cA, voffA); PG8_STAGE(PG8_SA(0, 1), cA + hstep, voffA);
        if (wr == 1) PG8_BAR;
        PG8_WAIT_V(2); PG8_BAR;
        PG8_STAGE(PG8_SB(1, 0), cB + kstep, voffB); PG8_STAGE(PG8_SA(1, 0), cA + kstep, voffA); PG8_STAGE(PG8_SB(1, 1), cB + hstep + kstep, voffB);
        PG8_WAIT_V(6); PG8_BAR;
    } else {
        PG8_STAGE(PG8_SB(0, 0), cB, voffB); PG8_STAGE(PG8_SA(0, 0), cA, voffA); PG8_STAGE(PG8_SB(0, 1), cB + hstep, voffB); PG8_STAGE(PG8_SA(0, 1), cA + hstep, voffA);
        if (wr == 1) PG8_BAR;
        PG8_WAIT_V(4); PG8_BAR;
        PG8_STAGE(PG8_SB(1, 0), cB + kstep, voffB); PG8_STAGE(PG8_SA(1, 0), cA + kstep, voffA); PG8_STAGE(PG8_SB(1, 1), cB + hstep + kstep, voffB);
        PG8_WAIT_V(6); PG8_BAR;
    }
    for (;;) {
        const bool has_next = S.next(ui + 1, nxt);
        const char* nA = has_next ? (const char*)g.A + (size_t)nxt.pm * tstep : cA; const char* nB = has_next ? (const char*)g.Bt + (size_t)nxt.pn * tstep : cB;
        for (int t = 0; t < nt; t += 2) {
            const bool last = (t == nt - 2);
            const char* a1 = cA + (size_t)(t + 1) * kstep;
            const char* a2 = last ? nA : cA + (size_t)(t + 2) * kstep; const char* b2 = last ? nB : cB + (size_t)(t + 2) * kstep;
            const char* a3 = a2 + kstep; const char* b3 = b2 + kstep;
            if (last && has_next) S.a_ready(nxt);
            if constexpr (SP2) {
            PG8_LDB(B0, 0, 0); PG8_LDB(B1, 0, 1); PG8_SCHED; PG8_LDA(At, 0, 0); PG8_STAGE(PG8_SA(1, 1), a1 + hstep, voffA);
            PG8_WAIT_V(8); PG8_WAIT_L(0); PG8_BAR; PG8_MMA(0, 0, At, B0); PG8_MMA(0, 1, At, B1); PG8_BAR; PG8_SCHED;
            PG8_LDA(At, 0, 1); PG8_STAGE(PG8_SB(0, 0), b2, voffB); PG8_STAGE(PG8_SB(0, 1), b2 + hstep, voffB); PG8_STAGE(PG8_SA(0, 0), a2, voffA);
            PG8_WAIT_V(8); PG8_WAIT_L(0); PG8_BAR; PG8_MMA(1, 0, At, B0); PG8_MMA(1, 1, At, B1); PG8_BAR; PG8_SCHED;
            PG8_LDB(B0, 1, 0); PG8_LDB(B1, 1, 1); PG8_SCHED; PG8_LDA(At, 1, 0); PG8_STAGE(PG8_SA(0, 1), a2 + hstep, voffA);
            PG8_WAIT_V(8); PG8_WAIT_L(0); PG8_BAR; PG8_MMA(0, 0, At, B0); PG8_MMA(0, 1, At, B1); PG8_BAR; PG8_SCHED;
            PG8_LDA(At, 1, 1); PG8_STAGE(PG8_SB(1, 0), b3, voffB); PG8_STAGE(PG8_SB(1, 1), b3 + hstep, voffB); PG8_STAGE(PG8_SA(1, 0), a3, voffA);
            PG8_WAIT_V(8); PG8_WAIT_L(0); PG8_BAR; PG8_MMA(1, 0, At, B0); PG8_MMA(1, 1, At, B1); PG8_BAR; PG8_SCHED;
            } else {
            PG8_LDB(B0, 0, 0); PG8_SCHED; PG8_LDA(At, 0, 0); PG8_STAGE(PG8_SA(1, 1), a1 + hstep, voffA);
            PG8_WAIT_L(8); PG8_BAR; PG8_WAIT_L(0); PG8_MMA(0, 0, At, B0); PG8_BAR; PG8_SCHED;
            PG8_LDB(B1, 0, 1); PG8_STAGE(PG8_SB(0, 0), b2, voffB);
            PG8_BAR; PG8_WAIT_L(0); PG8_MMA(0, 1, At, B1); PG8_BAR;
            PG8_LDA(At, 0, 1); PG8_STAGE(PG8_SA(0, 0), a2, voffA);
            PG8_BAR; PG8_WAIT_L(0); PG8_MMA(1, 0, At, B0); PG8_BAR; PG8_SCHED;
            PG8_STAGE(PG8_SB(0, 1), b2 + hstep, voffB);
            PG8_WAIT_V(6); PG8_BAR; PG8_MMA(1, 1, At, B1); PG8_BAR;
            PG8_LDB(B0, 1, 0); PG8_SCHED; PG8_LDA(At, 1, 0); PG8_STAGE(PG8_SA(0, 1), a2 + hstep, voffA);
            PG8_WAIT_L(8); PG8_BAR; PG8_WAIT_L(0); PG8_MMA(0, 0, At, B0); PG8_BAR; PG8_SCHED;
            PG8_LDB(B1, 1, 1); PG8_STAGE(PG8_SB(1, 0), b3, voffB);
            PG8_BAR; PG8_WAIT_L(0); PG8_MMA(0, 1, At, B1); PG8_BAR;
            PG8_LDA(At, 1, 1); PG8_STAGE(PG8_SA(1, 0), a3, voffA);
            PG8_BAR; PG8_WAIT_L(0); PG8_MMA(1, 0, At, B0); PG8_BAR; PG8_SCHED;
            PG8_STAGE(PG8_SB(1, 1), b3 + hstep, voffB);
            PG8_WAIT_V(6); PG8_BAR; PG8_MMA(1, 1, At, B1); PG8_BAR;
            }
        }
        if constexpr (ALIGN_EPI) { if (wr == 0) PG8_BAR; }
        if constexpr (!Epi::AFTER_DRAIN) { const int ln = fresh_lane(); E(acc, cur, wr, wc, ln & 15, ln >> 4); S.done(cur); }
        if (!has_next) break;
#pragma unroll
        for (int a = 0; a < 2; ++a)
#pragma unroll
            for (int b = 0; b < 2; ++b)
#pragma unroll
                for (int m = 0; m < 4; ++m)
#pragma unroll
                    for (int n = 0; n < 2; ++n) acc[a][b][m][n] = (f32x4){0.f, 0.f, 0.f, 0.f};
        cur = nxt; cA = nA; cB = nB; ++ui;
        if constexpr (ALIGN_EPI) { if (wr == 1) PG8_BAR; }
    }
    PG8_WAIT_V(0);
    if constexpr (!ALIGN_EPI) { if (wr == 0) PG8_BAR; }
    PG8_BAR;
    if constexpr (Epi::AFTER_DRAIN) { const int ln = fresh_lane(); E.fused(acc, cur, wr, wc, ln & 15, ln >> 4, lds, wid, ln); S.done(cur); }
#undef PG8_SA
#undef PG8_SB
#undef PG8_STAGE
#undef PG8_LDA
#undef PG8_LDB
#undef PG8_MMA
#undef PG8_WAIT_V
#undef PG8_WAIT_L
#undef PG8_BAR
#undef PG8_SCHED
}
}

#define GAS __attribute__((address_space(1)))
#define LAS __attribute__((address_space(3)))
typedef float f32x4 __attribute__((ext_vector_type(4)));
typedef unsigned v4u __attribute__((ext_vector_type(4)));
typedef GAS unsigned gu32;
#define XB_TMO      128
#define XB_XCNT(j)  (256  + 64 * (j))
#define XB_XSUB(j)  (1280 + 64 * (j))
#define XB_XGEN(j)  (2304 + 64 * (j))
#define XB_TOP      3328
#define XB_TOPGEN   3392
#define XCD_BAR_WORDS 3456
#define XB_SPIN_CAP (1u << 18)

__device__ __forceinline__ unsigned xb_ld(unsigned* p)              { return __hip_atomic_load(p, __ATOMIC_RELAXED, __HIP_MEMORY_SCOPE_AGENT); }
__device__ __forceinline__ unsigned xb_add(unsigned* p, unsigned v) { return __hip_atomic_fetch_add(p, v, __ATOMIC_RELAXED, __HIP_MEMORY_SCOPE_AGENT); }
__device__ __forceinline__ unsigned xb_xcc_id() { return (unsigned)__builtin_amdgcn_s_getreg((3 << 11) | 20) & 0xFu; }
#define XB_SPIN(cond, bar) do { unsigned _sp = 0; while (cond) { __builtin_amdgcn_s_sleep(1); \
    if ((++_sp & 255u) == 0u) { if (xb_ld(&(bar)[XB_TMO])) break; if (_sp > XB_SPIN_CAP) { atomicAdd(&(bar)[XB_TMO], 1u); break; } } } } while (0)

struct XcdBarrier {
    unsigned* bar; unsigned x;
    volatile LAS unsigned* st;
};

__device__ __forceinline__ XcdBarrier xcd_barrier_post(unsigned* bar, volatile LAS unsigned* st, int tid) {
    XcdBarrier b; b.bar = bar; b.x = xb_xcc_id(); b.st = st;
    if (tid == 0) (void)xb_add(&bar[XB_XCNT(b.x)], 1u);
    return b;
}
__device__ __forceinline__ void xcd_barrier_complete(unsigned* bar, unsigned x, unsigned& nloc, unsigned& nx) {
    const unsigned G = gridDim.x * gridDim.y * gridDim.z;
    unsigned sum, cnt, mine, sp = 0u;
    for (;;) {
        sum = 0u; cnt = 0u; mine = 0u;
#pragma unroll
        for (unsigned j = 0; j < 16; ++j) { const unsigned c = xb_ld(&bar[XB_XCNT(j)]); sum += c; cnt += (c > 0u) ? 1u : 0u; mine = (j == x) ? c : mine; }
        if (sum == G) break;
        __builtin_amdgcn_s_sleep(1);
        if ((++sp & 255u) == 0u) { if (xb_ld(&bar[XB_TMO])) break; if (sp > XB_SPIN_CAP) { atomicAdd(&bar[XB_TMO], 1u); break; } }
    }
    nloc = mine > 0u ? mine : 1u; nx = cnt > 0u ? cnt : 1u;
}

__device__ __forceinline__ void xcd_barrier(const XcdBarrier& b, int tid) {
    asm volatile("s_waitcnt vmcnt(0)" ::: "memory");
    __syncthreads();
    if (tid == 0) {
        unsigned* bar = b.bar;
        __builtin_amdgcn_s_waitcnt(0);
        unsigned nloc = b.st[0], nx = b.st[1];
        if (nloc == 0u) { xcd_barrier_complete(bar, b.x, nloc, nx); b.st[0] = nloc; b.st[1] = nx; }
        const unsigned old = xb_add(&bar[XB_XSUB(b.x)], 1u);
        const unsigned gen = old / nloc;
        if (old + 1u == (gen + 1u) * nloc) {
            __builtin_amdgcn_fence(__ATOMIC_RELEASE, "agent");
            asm volatile("s_waitcnt vmcnt(0)" ::: "memory");
            const unsigned og = xb_add(&bar[XB_TOP], 1u);
            const unsigned tg = og / nx;
            if (og + 1u == (tg + 1u) * nx) xb_add(&bar[XB_TOPGEN], 1u);
            else XB_SPIN(xb_ld(&bar[XB_TOPGEN]) == tg, bar);
            __builtin_amdgcn_fence(__ATOMIC_ACQUIRE, "agent");
            xb_add(&bar[XB_XGEN(b.x)], 1u);
            asm volatile("s_waitcnt vmcnt(0)" ::: "memory");
        } else {
            XB_SPIN(xb_ld(&bar[XB_XGEN(b.x)]) == gen, bar);
            __builtin_amdgcn_fence(__ATOMIC_ACQUIRE, "agent");
            asm volatile("s_waitcnt vmcnt(0)" ::: "memory");
        }
    }
    __syncthreads();
}

constexpr int NTHR = 512, NWAVES = 8;
constexpr int RING_BYTES = 131072, MISC_OFF = RING_BYTES + 320, LDS_BYTES = 147456;
constexpr int CW_BAR = 4096;
constexpr size_t CTL_ZERO_BYTES = 64 * 1024;
constexpr size_t WT_IN = WS_WT, WT_OUT = WT_IN + (size_t)2560 * 1024 * 2, WT_GU = WT_OUT + (size_t)1024 * 1024 * 2, WT_DOWN = WT_GU + (size_t)5632 * 1024 * 2,
                 WT_UQ = WT_DOWN + (size_t)1024 * 2816 * 2, WT_UKV = WT_UQ + (size_t)768 * 256 * 2, WT_CK = WT_UKV + (size_t)768 * 128 * 2, WT_CV = WT_CK + (size_t)64 * 2048 * 2,
                 WT_QM = WT_CV + (size_t)64 * 2048 * 2, WT_KM = WT_QM + 4 * 64 * 64 * 2, WT_END = WT_KM + 4 * 64 * 64 * 2;
static_assert(WT_END <= WS_HB, "weights");
constexpr int NPH = 22, PPL = 10;
constexpr int PROBE_SEL = 0;
constexpr int REP_MASK = 0;
#ifndef PHM
#define PHM 0xffff
#endif
struct MP { const float* in[N_IN]; float* out; unsigned char* ws; int ph_lo, ph_hi, coop, pad; };

struct MPK {
    const __attribute__((address_space(4))) MP* k;
    struct InArr { const __attribute__((address_space(4))) MP* k; __device__ __forceinline__ const float* operator[](int i) const { return k->in[i]; } };
    __device__ __forceinline__ InArr in_() const { return InArr{k}; }
};
#define PIN(i) (p.k->in[i])
__device__ __forceinline__ unsigned pk2(float lo, float hi) { return (unsigned)f2bf(lo) | ((unsigned)f2bf(hi) << 16); }
struct MapId { int n; __device__ __forceinline__ int operator()(int c) const { return c < n ? c : -1; } };
struct MapIn { __device__ __forceinline__ int operator()(int c) const {
    if (c < 1152) return c; if (c < 1280) return 1426 + (c - 1152); if (c < 1536) return 1170 + (c - 1280); if (c < 2304) return 1586 + (c - 1536);
    if (c < 2336) return 1554 + (c - 2304); if (c < 2354) return 1152 + (c - 2336); if (c < 2362) return c; return -1; } };
struct MapGU { __device__ __forceinline__ int operator()(int c) const { const int t = c >> 8, w = c & 255; return (w < 128) ? t * 128 + w : FF + t * 128 + (w - 128); } };
template <class Map> __device__ __forceinline__ void transpose_item(const float* W, int K, int ldw, const Map& map, const float* kscale, bf16* WT, LAS float* scr, int item, int nblk, int lane) {
    const int kb = item / nblk, nb = item % nblk, k0 = 64 * kb, n0 = 32 * nb;
    const int np = 2 * (lane & 15);
    const int sc = map(n0 + np);
#pragma unroll 8
    for (int i = 0; i < 16; ++i) { const int kk = 4 * i + (lane >> 4); float2 v = (sc >= 0) ? *(const float2*)(W + (size_t)(k0 + kk) * ldw + sc) : make_float2(0.f, 0.f);
        if (kscale) { const float ksc = kscale[k0 + kk]; v.x *= ksc; v.y *= ksc; } scr[kk * 33 + np] = v.x; scr[kk * 33 + np + 1] = v.y; }
    asm volatile("s_waitcnt lgkmcnt(0)" ::: "memory");
    const int c = lane & 7;
#pragma unroll
    for (int j = 0; j < 4; ++j) { const int n = (lane >> 3) + 8 * j; const LAS float* s = scr + (8 * c) * 33 + n;
        v4u o; o.x = pk2(s[0 * 33], s[1 * 33]); o.y = pk2(s[2 * 33], s[3 * 33]); o.z = pk2(s[4 * 33], s[5 * 33]); o.w = pk2(s[6 * 33], s[7 * 33]);
        *(v4u*)(WT + (size_t)(n0 + n) * K + k0 + 8 * c) = o; }
    asm volatile("s_waitcnt lgkmcnt(0)" ::: "memory");
}
__device__ __forceinline__ void norm_row_finish(const float4 (&v)[4], float ssq, const float* g, const float* shift, const float* scale, bf16* hb, float* outf, int mode, int m, int lane) {
    const float rstd = rsqrtf(ssq * (1.f / D_) + EPS);
    const int b = m / S_;
#pragma unroll
    for (int j = 0; j < 4; ++j) {
        const int col = 4 * lane + 256 * j;
        const float4 gg = *(const float4*)(g + col);
        float4 o; o.x = v[j].x * rstd * gg.x; o.y = v[j].y * rstd * gg.y; o.z = v[j].z * rstd * gg.z; o.w = v[j].w * rstd * gg.w;
        if (mode == 2) { *(float4*)(outf + (size_t)m * D_ + col) = o; }
        else {
            const float4 sc = *(const float4*)(scale + (size_t)b * 6144 + col), sh = *(const float4*)(shift + (size_t)b * 6144 + col);
            o.x = o.x * (1.f + sc.x) + sh.x; o.y = o.y * (1.f + sc.y) + sh.y; o.z = o.z * (1.f + sc.z) + sh.z; o.w = o.w * (1.f + sc.w) + sh.w;
            uint2 w; w.x = pk2(o.x, o.y); w.y = pk2(o.z, o.w);
            *(uint2*)(hb + (size_t)m * D_ + col) = w;
        }
    }
}
__device__ __forceinline__ void norm_rows(const float* x, const float* g, const float* shift, const float* scale, bf16* hb, float* outf, int mode, int gw, int ngw, int lane) {
    for (int m = gw; m < T_; m += 2 * ngw) {
        const int m2 = m + ngw;
        const float4* xr = (const float4*)(x + (size_t)m * D_) + lane; const float4* xr2 = (const float4*)(x + (size_t)m2 * D_) + lane;
        float4 v[4], w[4]; float s = 0.f, s2 = 0.f;
#pragma unroll
        for (int j = 0; j < 4; ++j) { v[j] = xr[64 * j]; w[j] = xr2[64 * j]; }
#pragma unroll
        for (int j = 0; j < 4; ++j) { s += v[j].x * v[j].x + v[j].y * v[j].y + v[j].z * v[j].z + v[j].w * v[j].w; s2 += w[j].x * w[j].x + w[j].y * w[j].y + w[j].z * w[j].z + w[j].w * w[j].w; }
        norm_row_finish(v, wave_sum2(s), g, shift, scale, hb, outf, mode, m, lane);
        norm_row_finish(w, wave_sum2(s2), g, shift, scale, hb, outf, mode, m2, lane);
    }
}
__device__ __forceinline__ void ph_p0(const MPK& p, LAS unsigned char* lds, int tid) {
    const int wave = tid >> 6, lane = tid & 63;
    LAS float* ca = (LAS float*)lds; LAS float* red = ca + 8192;
    unsigned char* ws = p.k->ws; float* mod = (float*)(ws + WS_MOD);
    const float* c = PIN(I_C);
    for (int i = tid; i < 8192; i += NTHR) ca[i] = siluf_(c[i]);
    __syncthreads();
    for (int item = blockIdx.x; item < 192; item += gridDim.x) {
        const int l = item / 96, j = (item % 96) * 64 + lane;
        const float* w = PIN(I_WADA) + (size_t)l * 1024 * 6144 + j;
        float acc[8];
#pragma unroll
        for (int b = 0; b < 8; ++b) acc[b] = 0.f;
#pragma unroll 4
        for (int k = wave * 128; k < wave * 128 + 128; ++k) {
            const float wv = w[(size_t)k * 6144];
#pragma unroll
            for (int b = 0; b < 8; ++b) acc[b] += ca[b * 1024 + k] * wv;
        }
#pragma unroll
        for (int b = 0; b < 8; ++b) red[(wave * 8 + b) * 64 + lane] = acc[b];
        __syncthreads();
        { const int b = wave; float s = 0.f;
#pragma unroll
          for (int w8 = 0; w8 < 8; ++w8) s += red[(w8 * 8 + b) * 64 + lane];
          mod[((size_t)l * 8 + b) * 6144 + j] = s + PIN(I_BADA)[l * 6144 + j]; }
        __syncthreads();
    }
    const int* pos = (const int*)PIN(I_POS);
    float *cosP = (float*)(ws + WS_COSP), *sinP = (float*)(ws + WS_SINP), *cosM = (float*)(ws + WS_COSM), *sinM = (float*)(ws + WS_SINM);
    for (int i = blockIdx.x * NTHR + tid; i < T_ * 24; i += gridDim.x * NTHR) {
        const int m = i / 24, f = i % 24;
        double inv; if (f < 8) inv = pow(500000.0, -(double)(2 * f) / 16.0); else inv = pow(500000.0, -(double)(2 * (f - 8)) / 32.0);
        const float ang = (float)pos[m] * (float)inv;
        const double a = (double)ang, kq = rint(a * 0.15915494309189535), r = a - kq * 6.283185307179586476925;
        const float cs = (float)cos(r), sn = (float)sin(r);
        if (f < 8) { cosP[m * 8 + f] = cs; sinP[m * 8 + f] = sn; } else { cosM[m * 16 + f - 8] = cs; sinM[m * 16 + f - 8] = sn; }
    }
}
__device__ __forceinline__ void ph_prep(const MPK& p, int l, LAS unsigned char* lds, int tid) {
    const int wave = tid >> 6, lane = tid & 63;
    const int gw = blockIdx.x * NWAVES + wave, ngw = gridDim.x * NWAVES;
    unsigned char* ws = p.k->ws;
    LAS float* scr = (LAS float*)(lds + wave * 8704);
    for (int i = blockIdx.x * NTHR + tid; i < 2 * T_; i += gridDim.x * NTHR) ((float*)(ws + WS_SSQL))[i] = 0.f;
    constexpr int I0 = 16 * 80, I4 = 4 * 24, I5 = 2 * 24, I6 = 32 * 2, I7 = 32 * 2, I8 = 8, I9 = 8;
    constexpr int NIT = I0 + I4 + I5 + I6 + I7 + I8 + I9;
    for (int it = gw; it < NIT; it += ngw) {
        int r = it;
        if (r < I0) { transpose_item(PIN(I_WIN) + (size_t)l * D_ * DIN, D_, DIN, MapIn{}, nullptr, (bf16*)(ws + WT_IN), scr, r, 80, lane); continue; } r -= I0;
        if (r < I4) { transpose_item(PIN(I_WUQ) + (size_t)l * 256 * 576, 256, 576, MapId{576}, PIN(I_GQL) + l * 256, (bf16*)(ws + WT_UQ), scr, r, 24, lane); continue; } r -= I4;
        if (r < I5) { transpose_item(PIN(I_WUKV) + (size_t)l * 128 * 768, 128, 768, MapId{768}, PIN(I_GKVL) + l * 128, (bf16*)(ws + WT_UKV), scr, r, 24, lane); continue; } r -= I5;
        if (r < I6) { transpose_item(PIN(I_WCK) + (size_t)l * 2048 * 64, 2048, 64, MapId{64}, nullptr, (bf16*)(ws + WT_CK), scr, r, 2, lane); continue; } r -= I6;
        if (r < I7) { transpose_item(PIN(I_WCV) + (size_t)l * 2048 * 64, 2048, 64, MapId{64}, nullptr, (bf16*)(ws + WT_CV), scr, r, 2, lane); continue; } r -= I7;
        if (r < I8) { const int h = r >> 1; transpose_item(PIN(I_WQM) + (size_t)l * 16384 + h * 4096, 64, 64, MapId{64}, nullptr, (bf16*)(ws + WT_QM) + h * 4096, scr, r & 1, 2, lane); continue; } r -= I8;
        { const int h = r >> 1; transpose_item(PIN(I_WKM) + (size_t)l * 16384 + h * 4096, 64, 64, MapId{64}, nullptr, (bf16*)(ws + WT_KM) + h * 4096, scr, r & 1, 2, lane); }
    }
    const float* xin = (l == 0) ? PIN(I_X) : p.k->out;
    const float* modl = (const float*)(ws + WS_MOD) + (size_t)l * 8 * 6144;
    norm_rows(xin, PIN(I_GN1) + l * D_, modl + 0, modl + 1024, (bf16*)(ws + WS_HB), nullptr, 0, gw, ngw, lane);
}
__device__ __forceinline__ void late_transposes(const MPK& p, int l, LAS unsigned char* lds, int tid, int first) {
    const int wave = tid >> 6, lane = tid & 63;
    if ((int)blockIdx.x < first) return;
    const int gw = ((int)blockIdx.x - first) * NWAVES + wave, ngw = ((int)gridDim.x - first) * NWAVES;
    unsigned char* ws = p.k->ws;
    LAS float* scr = (LAS float*)(lds + wave * 8704);
    constexpr int I1 = 16 * 32, I2 = 16 * 176, I3 = 44 * 32;
    for (int it = gw; it < I1 + I2 + I3; it += ngw) {
        int r = it;
        if (r < I1) { transpose_item(PIN(I_WOUT) + (size_t)l * D_ * D_, D_, D_, MapId{D_}, nullptr, (bf16*)(ws + WT_OUT), scr, r, 32, lane); continue; } r -= I1;
        if (r < I2) { transpose_item(PIN(I_WGU) + (size_t)l * D_ * 2 * FF, D_, 2 * FF, MapGU{}, nullptr, (bf16*)(ws + WT_GU), scr, r, 176, lane); continue; } r -= I2;
        transpose_item(PIN(I_WDOWN) + (size_t)l * FF * D_, FF, D_, MapId{D_}, nullptr, (bf16*)(ws + WT_DOWN), scr, r, 32, lane);
    }
}
__device__ __forceinline__ void ph_mixnorm(const MPK& p, int l, int tid) {
    const int gw = blockIdx.x * NWAVES + (tid >> 6), ngw = gridDim.x * NWAVES, lane = tid & 63;
    unsigned char* ws = p.k->ws;
    bf16* mix = (bf16*)(ws + WS_HB); const float* ga = PIN(I_GOA) + l * 384; const float* gb = PIN(I_GOB) + l * 384;
    const bf16 *oc = (const bf16*)(ws + WS_OCMP), *os = (const bf16*)(ws + WS_OSLC), *ow = (const bf16*)(ws + WS_OWIN); const float* gm = (const float*)(ws + WS_GM);
#define UNPK8(dst, src) dst[0] = __uint_as_float(src.x << 16); dst[1] = __uint_as_float(src.x & 0xffff0000u); dst[2] = __uint_as_float(src.y << 16); dst[3] = __uint_as_float(src.y & 0xffff0000u); \
    dst[4] = __uint_as_float(src.z << 16); dst[5] = __uint_as_float(src.z & 0xffff0000u); dst[6] = __uint_as_float(src.w << 16); dst[7] = __uint_as_float(src.w & 0xffff0000u);
    for (int m = gw; m < T_; m += ngw) {
        bf16* r = mix + (size_t)m * D_;
        float v0[8], v1[8]; float sa = 0.f, sb = 0.f;
        if (lane < 48) {
            const size_t o = (size_t)m * 384 + lane * 8; const float* g3 = gm + (size_t)m * 32 + 3 * (lane >> 3);
            const float g0 = g3[0], g1 = g3[1], g2 = g3[2];
            const v4u c4 = *(const v4u*)(oc + o), s4 = *(const v4u*)(os + o), w4 = *(const v4u*)(ow + o);
            float c8[8], s8[8], w8[8]; UNPK8(c8, c4) UNPK8(s8, s4) UNPK8(w8, w4)
#pragma unroll
            for (int i = 0; i < 8; ++i) { v0[i] = g0 * c8[i] + g1 * s8[i] + g2 * w8[i]; sa += v0[i] * v0[i]; }
        } else {
            const v4u y4 = *(const v4u*)(r + 384 + (lane - 48) * 8); UNPK8(v0, y4)
#pragma unroll
            for (int i = 0; i < 8; ++i) sb += v0[i] * v0[i];
        }
        if (lane < 32) { const v4u y4 = *(const v4u*)(r + 384 + (16 + lane) * 8); UNPK8(v1, y4)
#pragma unroll
            for (int i = 0; i < 8; ++i) sb += v1[i] * v1[i]; }
        const float ra = rsqrtf(wave_sum2(sa) * (1.f / 384.f) + EPS), rb = rsqrtf(wave_sum2(sb) * (1.f / 384.f) + EPS);
        {
            const int col = (lane < 48) ? lane * 8 : 384 + (lane - 48) * 8; const float* gg = (lane < 48) ? ga + lane * 8 : gb + (lane - 48) * 8; const float rr = (lane < 48) ? ra : rb;
            const float4 g0 = *(const float4*)gg, g1 = *(const float4*)(gg + 4);
            v4u w; w.x = pk2(v0[0] * rr * g0.x, v0[1] * rr * g0.y); w.y = pk2(v0[2] * rr * g0.z, v0[3] * rr * g0.w); w.z = pk2(v0[4] * rr * g1.x, v0[5] * rr * g1.y); w.w = pk2(v0[6] * rr * g1.z, v0[7] * rr * g1.w);
            *(v4u*)(r + col) = w;
        }
        if (lane < 32) { const float* gg = gb + (16 + lane) * 8; const float4 g0 = *(const float4*)gg, g1 = *(const float4*)(gg + 4);
            v4u w; w.x = pk2(v1[0] * rb * g0.x, v1[1] * rb * g0.y); w.y = pk2(v1[2] * rb * g0.z, v1[3] * rb * g0.w); w.z = pk2(v1[4] * rb * g1.x, v1[5] * rb * g1.y); w.w = pk2(v1[6] * rb * g1.z, v1[7] * rb * g1.w);
            *(v4u*)(r + 384 + (16 + lane) * 8) = w; }
    }
#undef UNPK8
}


typedef short bf16x8 __attribute__((ext_vector_type(8)));
typedef short s16x4 __attribute__((ext_vector_type(4)));
typedef float f32x16 __attribute__((ext_vector_type(16)));
typedef unsigned u32x2v __attribute__((ext_vector_type(2)));
constexpr int AT_BUF = 20480, AT_K32 = 8192, AT_V = 12288;
__device__ __forceinline__ unsigned cvtpk(float lo, float hi) { unsigned r; asm volatile("v_cvt_pk_bf16_f32 %0, %1, %2" : "=v"(r) : "v"(lo), "v"(hi)); return r; }
__device__ __forceinline__ float max3f(float a, float b, float c) { float r; asm("v_max3_f32 %0, %1, %2, %3" : "=v"(r) : "v"(a), "v"(b), "v"(c)); return r; }
__device__ __forceinline__ int crow(int r, int hi) { return (r & 3) + 8 * (r >> 2) + 4 * hi; }
__device__ __forceinline__ s16x4 vtr(LAS const unsigned char* p) { return __builtin_bit_cast(s16x4, __builtin_amdgcn_ds_read_tr16_b64_v4i16((LAS s16x4*)p)); }
enum { AM_CAUSAL = 0, AM_WINDOW = 1, AM_SLC = 2 };
struct AttnState { float m, l; f32x16 o[2]; f32x16 negm; bool started; long long twait; };
template <int NC> struct TileRegs { v4u k; v4u k2; v4u v; };
template <int NC> __device__ __forceinline__ void at_load(TileRegs<NC>& r, const bf16* Kg, int ldk, const bf16* Vg, int ldv, const bf16* K2g, int ldk2, int tile, int tid) {
    const int key = tid >> 3, c = tid & 7;
    r.k = *(const v4u*)(Kg + (size_t)(tile * 64 + key) * ldk + 8 * c);
    r.v = *(const v4u*)(Vg + (size_t)(tile * 64 + key) * ldv + 8 * c);
    if (NC == 6) { if (tid < 256) r.k2 = *(const v4u*)(K2g + (size_t)(tile * 64 + (tid >> 2)) * ldk2 + 8 * (tid & 3)); }
}
template <int NC> __device__ __forceinline__ void at_store(const TileRegs<NC>& r, LAS unsigned char* buf, int tid) {
    const int key = tid >> 3, c = tid & 7;
    *(LAS v4u*)(buf + key * 128 + 16 * (c ^ ((key >> 1) & 7))) = r.k;
    *(LAS v4u*)(buf + AT_V + (c >> 2) * 4096 + key * 64 + (c & 3) * 16) = r.v;
    if (NC == 6) { if (tid < 256) { const int k2 = tid >> 2, c2 = tid & 3; *(LAS v4u*)(buf + AT_K32 + k2 * 64 + 16 * (c2 ^ ((k2 >> 2) & 3))) = r.k2; } }
}
template <int NC> __device__ __forceinline__ void qk_tile(f32x16& p0, f32x16& p1, LAS const unsigned char* buf, const bf16x8 (&qf)[NC], const f32x16& negm, int lane) {
    const int r32 = lane & 31, hi = lane >> 5;
    p0 = negm; p1 = negm;
#pragma unroll
    for (int cc = 0; cc < NC; ++cc) {
        bf16x8 k0, k1;
        if (cc < 4) { const int k0r = r32, k1r = 32 + r32;
            k0 = *(LAS const bf16x8*)(buf + k0r * 128 + 16 * ((2 * cc + hi) ^ ((k0r >> 1) & 7)));
            k1 = *(LAS const bf16x8*)(buf + k1r * 128 + 16 * ((2 * cc + hi) ^ ((k1r >> 1) & 7))); }
        else { const int k0r = r32, k1r = 32 + r32, c2 = 2 * (cc - 4) + hi;
            k0 = *(LAS const bf16x8*)(buf + AT_K32 + k0r * 64 + 16 * (c2 ^ ((k0r >> 2) & 3)));
            k1 = *(LAS const bf16x8*)(buf + AT_K32 + k1r * 64 + 16 * (c2 ^ ((k1r >> 2) & 3))); }
        p0 = __builtin_amdgcn_mfma_f32_32x32x16_bf16(k0, qf[cc], p0, 0, 0, 0);
        p1 = __builtin_amdgcn_mfma_f32_32x32x16_bf16(k1, qf[cc], p1, 0, 0, 0);
    }
}
template <int MODE> __device__ __forceinline__ void softmax_tile(AttnState& st, f32x16& p0, f32x16& p1, bf16x8 (&pf)[4], int kpos0, int qpos, bool need_mask, bool sel_ok, int lane) {
    const int hi = lane >> 5;
    if (need_mask) {
        const int qw0m = __builtin_amdgcn_readfirstlane(qpos) & ~31;
        const bool diag = (kpos0 + 63 > qw0m), old = (MODE == AM_WINDOW) && (kpos0 < qw0m + 31 - 511);
        if (diag || old) {
            const float selterm = (MODE == AM_SLC && !sel_ok) ? -INFINITY : INFINITY;
            const int dbase = qpos - kpos0 - 4 * hi;
#pragma unroll
            for (int r = 0; r < 16; ++r) {
                const int d0 = dbase - ((r & 3) + 8 * (r >> 2)), d1 = d0 - 32;
                float l0 = ((float)d0 + 0.5f) * INFINITY, l1 = ((float)d1 + 0.5f) * INFINITY;
                if (MODE == AM_WINDOW) { l0 = fminf(l0, ((float)(511 - d0) + 0.5f) * INFINITY); l1 = fminf(l1, ((float)(511 - d1) + 0.5f) * INFINITY); }
                if (MODE == AM_SLC) { l0 = fminf(l0, selterm); l1 = fminf(l1, selterm); }
                p0[r] = fminf(p0[r], l0); p1[r] = fminf(p1[r], l1);
            }
        } else if (MODE == AM_SLC) {
            const float selterm = sel_ok ? INFINITY : -INFINITY;
#pragma unroll
            for (int r = 0; r < 16; ++r) { p0[r] = fminf(p0[r], selterm); p1[r] = fminf(p1[r], selterm); }
        }
    }
    float mx = max3f(p0[0], p1[0], p0[1]), mx2 = max3f(p1[1], p0[2], p1[2]);
#pragma unroll
    for (int r = 3; r < 15; r += 2) { mx = max3f(mx, p0[r], p1[r]); mx2 = max3f(mx2, p0[r + 1], p1[r + 1]); }
    mx = max3f(mx, p0[15], p1[15]); mx = max3f(mx, mx2, mx2);
    mx = red32_max(mx);
    if (!st.started || __any(mx > 0.f)) {
        float dl = st.started ? fmaxf(mx, 0.f) : mx;
        dl = (dl > -1e30f) ? dl : 0.f;
        st.started = true;
        const float alpha = __builtin_amdgcn_exp2f(-dl);
        st.m += dl; st.l *= alpha;
#pragma unroll
        for (int r = 0; r < 16; ++r) { st.o[0][r] *= alpha; st.o[1][r] *= alpha; p0[r] -= dl; p1[r] -= dl; st.negm[r] = -st.m; }
    }
    float sum = 0.f;
#pragma unroll
    for (int r = 0; r < 16; ++r) { p0[r] = __builtin_amdgcn_exp2f(p0[r]); p1[r] = __builtin_amdgcn_exp2f(p1[r]); sum += p0[r] + p1[r]; }
    st.l += sum;
#pragma unroll
    for (int s2 = 0; s2 < 2; ++s2) {
        v4u a, b;
        a.x = cvtpk(p0[8 * s2 + 0], p0[8 * s2 + 1]); a.y = cvtpk(p0[8 * s2 + 2], p0[8 * s2 + 3]); a.z = cvtpk(p0[8 * s2 + 4], p0[8 * s2 + 5]); a.w = cvtpk(p0[8 * s2 + 6], p0[8 * s2 + 7]);
        b.x = cvtpk(p1[8 * s2 + 0], p1[8 * s2 + 1]); b.y = cvtpk(p1[8 * s2 + 2], p1[8 * s2 + 3]); b.z = cvtpk(p1[8 * s2 + 4], p1[8 * s2 + 5]); b.w = cvtpk(p1[8 * s2 + 6], p1[8 * s2 + 7]);
        pf[s2] = __builtin_bit_cast(bf16x8, a); pf[2 + s2] = __builtin_bit_cast(bf16x8, b);
    }
}
__device__ __forceinline__ void pv_tile(AttnState& st, LAS const unsigned char* buf, const bf16x8 (&pf)[4], int lane) {
    const int hi = lane >> 5;
    const unsigned vb = (unsigned)(uintptr_t)(buf + AT_V + (4 * hi + ((lane & 15) >> 2)) * 64 + ((lane >> 4) & 1) * 32 + (lane & 3) * 8);
#pragma unroll
    for (int dh = 0; dh < 2; ++dh) {
        s16x4 lo[4], hh[4];
#pragma unroll
        for (int s4 = 0; s4 < 4; ++s4) {
            asm volatile("ds_read_b64_tr_b16 %0, %1 offset:%c2" : "=&v"(lo[s4]) : "v"(vb), "i"(dh * 4096 + s4 * 1024) : "memory");
            asm volatile("ds_read_b64_tr_b16 %0, %1 offset:%c2" : "=&v"(hh[s4]) : "v"(vb), "i"(dh * 4096 + s4 * 1024 + 512) : "memory");
        }
        asm volatile("s_waitcnt lgkmcnt(0)" : "+v"(lo[0]), "+v"(lo[1]), "+v"(lo[2]), "+v"(lo[3]), "+v"(hh[0]), "+v"(hh[1]), "+v"(hh[2]), "+v"(hh[3]) :: "memory");
#pragma unroll
        for (int s4 = 0; s4 < 4; ++s4) {
            const bf16x8 vf = {lo[s4][0], lo[s4][1], lo[s4][2], lo[s4][3], hh[s4][0], hh[s4][1], hh[s4][2], hh[s4][3]};
            st.o[dh] = __builtin_amdgcn_mfma_f32_32x32x16_bf16(vf, pf[s4], st.o[dh], 0, 0, 0);
        }
    }
}
struct TileFlags { bool skip, need_mask, sel_ok; };
template <int MODE> __device__ __forceinline__ TileFlags tile_flags(int t, int qw0, unsigned selbits) {
    const int k0 = t * 64; TileFlags f;
    f.skip = k0 > qw0 + 31; f.need_mask = (k0 + 63 > qw0); f.sel_ok = true;
    if (MODE == AM_WINDOW) { f.skip = f.skip || (k0 + 63 < qw0 - 511); f.need_mask = f.need_mask || (k0 < qw0 + 31 - 511); }
    if (MODE == AM_SLC) { f.sel_ok = (selbits >> t) & 1u; const unsigned long long bal = __ballot(f.sel_ok); f.skip = f.skip || (bal == 0ull); f.need_mask = f.need_mask || (bal != ~0ull); }
    return f;
}
struct DmaOff { unsigned k, v, k2; };
template <int NC> __device__ __forceinline__ DmaOff at_dma_off(int ldk, int ldv, int ldk2, int wave, int lane) {
    const int L = wave * 64 + lane; DmaOff o;
    { const int key = L >> 3, c = (L & 7) ^ ((key >> 1) & 7); o.k = (unsigned)(key * ldk + 8 * c) * 2u; }
    { const int key = (L >> 2) & 63, c = (L >> 8) * 4 + (L & 3); o.v = (unsigned)(key * ldv + 8 * c) * 2u; }
    { const int key = (L >> 2) & 63, c2 = (L & 3) ^ ((key >> 2) & 3); o.k2 = (unsigned)(key * ldk2 + 8 * c2) * 2u; }
    return o;
}
template <int NC> __device__ __forceinline__ void at_dma(const DmaOff& o, const bf16* Kg, int ldk, const bf16* Vg, int ldv, const bf16* K2g, int ldk2, int tile, LAS unsigned char* slot, int wave) {
    __builtin_amdgcn_global_load_lds((const unsigned*)((const char*)(Kg + (size_t)tile * 64 * ldk) + o.k), (LAS unsigned*)(slot + wave * 1024), 16, 0, 0);
    __builtin_amdgcn_global_load_lds((const unsigned*)((const char*)(Vg + (size_t)tile * 64 * ldv) + o.v), (LAS unsigned*)(slot + AT_V + wave * 1024), 16, 0, 0);
    if (NC == 6) { if (wave < 4) __builtin_amdgcn_global_load_lds((const unsigned*)((const char*)(K2g + (size_t)tile * 64 * ldk2) + o.k2), (LAS unsigned*)(slot + AT_K32 + wave * 1024), 16, 0, 0); }
}
__device__ __forceinline__ void at_wait_bar(int keep) {
    if (keep == 0) asm volatile("s_waitcnt vmcnt(0) lgkmcnt(0)" ::: "memory");
    else if (keep == 2) asm volatile("s_waitcnt vmcnt(2) lgkmcnt(0)" ::: "memory");
    else asm volatile("s_waitcnt vmcnt(3) lgkmcnt(0)" ::: "memory");
    __builtin_amdgcn_s_barrier();
    asm volatile("" ::: "memory");
}
template <int NC, int MODE> __device__ __forceinline__ void at_stream(AttnState& st, LAS unsigned char* lds, const bf16* Kg, int ldk, const bf16* Vg, int ldv, const bf16* K2g, int ldk2, int t0, int t1,
                                                                       const bf16x8 (&qf)[NC], int qpos, int qw0, unsigned selbits, int tid) {
    const int lane = tid & 63, wave = __builtin_amdgcn_readfirstlane(tid >> 6), nt = t1 - t0;
    const int nper = (NC == 6 && wave < 4) ? 3 : 2;
    const DmaOff dof = at_dma_off<NC>(ldk, ldv, ldk2, wave, lane);
    at_dma<NC>(dof, Kg, ldk, Vg, ldv, K2g, ldk2, t0, lds, wave);
    if (nt > 1) at_dma<NC>(dof, Kg, ldk, Vg, ldv, K2g, ldk2, t0 + 1, lds + AT_BUF, wave);
    at_wait_bar(nt > 1 ? nper : 0);
    int s0 = 0, s1 = AT_BUF, s2 = 2 * AT_BUF;
    for (int i = 0; i < nt; ++i) {
        const int t = t0 + i; const bool has_2 = (i + 2 < nt);
        if (has_2) at_dma<NC>(dof, Kg, ldk, Vg, ldv, K2g, ldk2, t + 2, lds + s2, wave);
        const TileFlags f = tile_flags<MODE>(t, qw0, selbits);
        if (!f.skip) {
            f32x16 p0, p1; bf16x8 pf[4];
            qk_tile<NC>(p0, p1, lds + s0, qf, st.negm, lane);
            softmax_tile<MODE>(st, p0, p1, pf, t * 64, qpos, f.need_mask, f.sel_ok, lane);
            pv_tile(st, lds + s0, pf, lane);
        }
        { const long long tw0 = (PROBE_SEL != 0) ? (long long)__builtin_amdgcn_s_memtime() : 0ll;
          at_wait_bar(has_2 ? nper : 0);
          if (PROBE_SEL != 0) st.twait += (long long)__builtin_amdgcn_s_memtime() - tw0; }
        const int tmp = s0; s0 = s1; s1 = s2; s2 = tmp;
    }
}
__device__ __forceinline__ int next_item_q(unsigned* ctrs, LAS unsigned char* lds, int wave_u, int count, int q0, int& kstart) {
    const int tid = wave_u * 64 + fresh_lane();
    LAS int* slot = (LAS int*)(lds + RING_BYTES + 64);
    if (tid == 0) {
        int r = -1, k = kstart;
        for (; k < 8; ++k) { const int q = (q0 + k) & 7; const unsigned v = atomicAdd(ctrs + q * 16, 1u); if (v < (unsigned)count) { r = (q << 16) | (int)v; break; } }
        slot[0] = r; slot[1] = k;
    }
    __syncthreads();
    const int v = slot[0]; kstart = slot[1];
    __syncthreads();
    return v;
}
__device__ __forceinline__ void mla_unit(unsigned char* ws, LAS unsigned char* lds, int b, int h, int qt, int wave_u) {
    const int tid = wave_u * 64 + fresh_lane();
    const int lane = tid & 63, wave = tid >> 6, r32 = lane & 31, hi = lane >> 5;
    const int qw0 = qt * 256 + wave * 32, qpos = qw0 + r32; const size_t row = (size_t)b * S_ + qpos;
    const long long tq0 = (PROBE_SEL != 0) ? (long long)__builtin_amdgcn_s_memtime() : 0ll;
    bf16x8 qf[6];
    {
        const bf16* qp = (const bf16*)(ws + WS_OSLC) + row * 768 + h * 96 + 8 * hi;
        v4u raw[6];
#pragma unroll
        for (int cc = 0; cc < 6; ++cc) raw[cc] = *(const v4u*)(qp + 16 * cc);
        float msc = MSCALE; asm volatile("" : "+v"(msc));
        const float rs = rsqrtf(((const float*)(ws + WS_SSQL))[row] * (1.f / 256.f) + EPS) * msc;
        const float* cm_ = (const float*)(ws + WS_COSM) + row * 16 + 8 * hi; const float* sm_ = (const float*)(ws + WS_SINM) + row * 16 + 8 * hi;
#define UNPKQ(dst, src) dst[0] = __uint_as_float(src.x << 16); dst[1] = __uint_as_float(src.x & 0xffff0000u); dst[2] = __uint_as_float(src.y << 16); dst[3] = __uint_as_float(src.y & 0xffff0000u); \
        dst[4] = __uint_as_float(src.z << 16); dst[5] = __uint_as_float(src.z & 0xffff0000u); dst[6] = __uint_as_float(src.w << 16); dst[7] = __uint_as_float(src.w & 0xffff0000u);
#pragma unroll
        for (int cc = 0; cc < 4; ++cc) { float f[8]; UNPKQ(f, raw[cc])
            v4u w; w.x = cvtpk(f[0] * rs, f[1] * rs); w.y = cvtpk(f[2] * rs, f[3] * rs); w.z = cvtpk(f[4] * rs, f[5] * rs); w.w = cvtpk(f[6] * rs, f[7] * rs); qf[cc] = __builtin_bit_cast(bf16x8, w); }
        { float x1[8], x2[8], o1[8], o2[8]; UNPKQ(x1, raw[4]) UNPKQ(x2, raw[5])
#pragma unroll
          for (int j = 0; j < 8; ++j) { const float cs = cm_[j] * rs, sn = sm_[j] * rs; o1[j] = x1[j] * cs - x2[j] * sn; o2[j] = x1[j] * sn + x2[j] * cs; }
          v4u w; w.x = cvtpk(o1[0], o1[1]); w.y = cvtpk(o1[2], o1[3]); w.z = cvtpk(o1[4], o1[5]); w.w = cvtpk(o1[6], o1[7]); qf[4] = __builtin_bit_cast(bf16x8, w);
          w.x = cvtpk(o2[0], o2[1]); w.y = cvtpk(o2[2], o2[3]); w.z = cvtpk(o2[4], o2[5]); w.w = cvtpk(o2[6], o2[7]); qf[5] = __builtin_bit_cast(bf16x8, w); }
#undef UNPKQ
    }
    const long long tq1 = (PROBE_SEL != 0) ? (long long)__builtin_amdgcn_s_memtime() : 0ll;
    AttnState st; st.m = 0.f; st.l = 0.f; st.o[0] = f32x16{}; st.o[1] = f32x16{}; st.negm = f32x16{}; st.started = false; st.twait = 0;
    const bf16* kvb = (const bf16*)(ws + WS_KVM) + (size_t)b * S_ * 768 + h * 128;
    at_stream<6, AM_CAUSAL>(st, lds, kvb, 768, kvb + 64, 768, (const bf16*)(ws + WS_KR) + (size_t)b * S_ * 32, 32, 0, 4 * qt + 4, qf, qpos, qw0, 0u, tid);
    if (PROBE_SEL >= 1 && PROBE_SEL <= 3 && b == 0 && h == 0 && qt == 7 && tid == 0) { const long long tq2 = (long long)__builtin_amdgcn_s_memtime();
        ((float*)(ws + WS_CTL))[100] = (PROBE_SEL == 1) ? (float)(tq2 - tq1) : (PROBE_SEL == 2) ? (float)st.twait : (float)(tq1 - tq0); }
    const float lt = red32_sum(st.l), il = 1.f / lt;
    bf16* op = (bf16*)(ws + WS_HB) + row * D_ + 384 + h * 64 + 4 * hi;
#pragma unroll
    for (int dh = 0; dh < 2; ++dh)
#pragma unroll
        for (int g4 = 0; g4 < 4; ++g4) { u32x2v w; w.x = cvtpk(st.o[dh][4 * g4] * il, st.o[dh][4 * g4 + 1] * il); w.y = cvtpk(st.o[dh][4 * g4 + 2] * il, st.o[dh][4 * g4 + 3] * il);
            *(u32x2v*)(op + dh * 32 + 8 * g4) = w; }
}
template <int MODE> __device__ __forceinline__ void nsa_branch_unit(unsigned char* ws, LAS unsigned char* lds, int b, int h, int qt, int wave_u) {
    const int tid = wave_u * 64 + fresh_lane();
    const int lane = tid & 63, wave = tid >> 6, r32 = lane & 31, hi = lane >> 5, g = h / 3;
    const int qw0 = qt * 256 + wave * 32, qpos = qw0 + r32; const size_t row = (size_t)b * S_ + qpos;
    const bf16* nsa = (const bf16*)(ws + WS_NSA);
    const bf16* qp = nsa + row * 1152 + h * 64 + 8 * hi;
    bf16x8 qf[4];
#pragma unroll
    for (int cc = 0; cc < 4; ++cc) qf[cc] = *(const bf16x8*)(qp + 16 * cc);
    unsigned selbits = 0u; if (MODE == AM_SLC) selbits = ((const unsigned*)(ws + WS_SEL))[(size_t)(b * 2 + g) * S_ + qpos];
    const bf16* kb = nsa + (size_t)b * S_ * 1152 + g * 64 + (MODE == AM_SLC ? 640 : 896);
    AttnState st; st.m = 0.f; st.l = 0.f; st.o[0] = f32x16{}; st.o[1] = f32x16{}; st.negm = f32x16{}; st.started = false; st.twait = 0;
    const long long tn0 = (PROBE_SEL != 0) ? (long long)__builtin_amdgcn_s_memtime() : 0ll;
    const int t0 = (MODE == AM_SLC) ? 0 : ((4 * qt - 8 > 0) ? 4 * qt - 8 : 0);
    at_stream<4, MODE>(st, lds, kb, 1152, kb + 128, 1152, nullptr, 0, t0, 4 * qt + 4, qf, qpos, qw0, selbits, tid);
    if (PROBE_SEL >= 4 && PROBE_SEL <= 5 && MODE == AM_SLC && b == 0 && h == 0 && qt == 7 && tid == 0) { const long long tn1 = (long long)__builtin_amdgcn_s_memtime();
        ((float*)(ws + WS_CTL))[100] = (PROBE_SEL == 4) ? (float)(tn1 - tn0) : (float)st.twait; }
    const float lt = red32_sum(st.l), il = 1.f / lt;
    bf16* op = (bf16*)(ws + (MODE == AM_SLC ? WS_OSLC : WS_OWIN)) + row * 384 + h * 64 + 4 * hi;
#pragma unroll
    for (int dh = 0; dh < 2; ++dh)
#pragma unroll
        for (int g4 = 0; g4 < 4; ++g4) { u32x2v w; w.x = cvtpk(st.o[dh][4 * g4] * il, st.o[dh][4 * g4 + 1] * il); w.y = cvtpk(st.o[dh][4 * g4 + 2] * il, st.o[dh][4 * g4 + 3] * il);
            *(u32x2v*)(op + dh * 32 + 8 * g4) = w; }
}
__device__ __forceinline__ void cmp_unit(unsigned char* ws, LAS unsigned char* lds, int b, int g, int qt, int wave_u) {
    const int tid = wave_u * 64 + fresh_lane();
    const int lane = tid & 63, wave = tid >> 6, r32 = lane & 31, hi = lane >> 5;
    const int qpos = qt * 256 + wave * 32 + r32; const size_t row = (size_t)b * S_ + qpos;
    const bf16* kc = (const bf16*)(ws + WS_KCV) + (size_t)(b * 2 + g) * 128 * 64; const bf16* vc = kc + (size_t)8 * 2 * 128 * 64;
    { TileRegs<4> tr; at_load<4>(tr, kc, 64, vc, 64, nullptr, 0, 0, tid); at_store<4>(tr, lds, tid); at_load<4>(tr, kc, 64, vc, 64, nullptr, 0, 1, tid); at_store<4>(tr, lds + AT_BUF, tid); }
    __syncthreads();
    int nvis = (qpos >= 31) ? ((qpos - 31) >> 4) + 1 : 0; if (nvis > 127) nvis = 127;
    LAS float* IG = (LAS float*)(lds + 2 * AT_BUF) + wave * (32 * 33) + r32 * 33;
    LAS float* IL = IG + 8 * 32 * 33;
    const bf16* nsa = (const bf16*)(ws + WS_NSA);
    LAS const unsigned char* vb = lds + AT_V + (4 * hi + ((lane & 15) >> 2)) * 64 + ((lane >> 4) & 1) * 32 + (lane & 3) * 8;
    for (int r3 = 0; r3 < 3; ++r3) {
        const int h = 3 * g + r3;
        const bf16* qp = nsa + row * 1152 + h * 64 + 8 * hi;
        bf16x8 qf[4];
#pragma unroll
        for (int cc = 0; cc < 4; ++cc) qf[cc] = *(const bf16x8*)(qp + 16 * cc);
        f32x16 p[4];
#pragma unroll
        for (int tb = 0; tb < 4; ++tb) {
            LAS const unsigned char* buf = lds + (tb >> 1) * AT_BUF; const int kr = (tb & 1) * 32 + r32;
            p[tb] = f32x16{};
#pragma unroll
            for (int cc = 0; cc < 4; ++cc) { const bf16x8 kf = *(LAS const bf16x8*)(buf + kr * 128 + 16 * ((2 * cc + hi) ^ ((kr >> 1) & 7)));
                p[tb] = __builtin_amdgcn_mfma_f32_32x32x16_bf16(kf, qf[cc], p[tb], 0, 0, 0); }
        }
        float mx = -1e30f;
#pragma unroll
        for (int tb = 0; tb < 4; ++tb)
#pragma unroll
            for (int r = 0; r < 16; ++r) { const int n = 32 * tb + crow(r, hi); p[tb][r] = fminf(p[tb][r], ((float)(nvis - n) - 0.5f) * INFINITY); mx = fmaxf(mx, p[tb][r]); }
        mx = red32_max(mx);
        float sum = 0.f;
#pragma unroll
        for (int tb = 0; tb < 4; ++tb)
#pragma unroll
            for (int r = 0; r < 16; ++r) { p[tb][r] = __builtin_amdgcn_exp2f(p[tb][r] - mx); sum += p[tb][r]; }
        sum = red32_sum(sum);
        const float il = (nvis > 0) ? 1.f / sum : 0.f;
#pragma unroll
        for (int tb = 0; tb < 4; ++tb)
#pragma unroll
            for (int k = 0; k < 4; ++k) { const float a0 = p[tb][4 * k] * il, a1 = p[tb][4 * k + 1] * il, a2 = p[tb][4 * k + 2] * il, a3 = p[tb][4 * k + 3] * il;
                const int j = 2 * (4 * tb + k) + hi;
                const float gs = (a0 + a1) + (a2 + a3);
                if (r3 == 0) { IG[j] = gs; IL[j + 1] = a3; } else { IG[j] += gs; IL[j + 1] += a3; } }
        f32x16 o[2] = {f32x16{}, f32x16{}};
#pragma unroll
        for (int tb = 0; tb < 4; ++tb)
#pragma unroll
            for (int s2 = 0; s2 < 2; ++s2) {
                v4u a; a.x = cvtpk(p[tb][8 * s2 + 0], p[tb][8 * s2 + 1]); a.y = cvtpk(p[tb][8 * s2 + 2], p[tb][8 * s2 + 3]); a.z = cvtpk(p[tb][8 * s2 + 4], p[tb][8 * s2 + 5]); a.w = cvtpk(p[tb][8 * s2 + 6], p[tb][8 * s2 + 7]);
                const bf16x8 pf = __builtin_bit_cast(bf16x8, a);
                LAS const unsigned char* vbb = vb + (tb >> 1) * AT_BUF + ((tb & 1) * 2 + s2) * 1024;
#pragma unroll
                for (int dh = 0; dh < 2; ++dh) { const s16x4 lo = vtr(vbb + dh * 4096), hh = vtr(vbb + dh * 4096 + 512);
                    const bf16x8 vf = {lo[0], lo[1], lo[2], lo[3], hh[0], hh[1], hh[2], hh[3]};
                    o[dh] = __builtin_amdgcn_mfma_f32_32x32x16_bf16(vf, pf, o[dh], 0, 0, 0); }
                asm volatile("" ::: "memory");
            }
        bf16* op = (bf16*)(ws + WS_OCMP) + row * 384 + h * 64 + 4 * hi;
#pragma unroll
        for (int dh = 0; dh < 2; ++dh)
#pragma unroll
            for (int g4 = 0; g4 < 4; ++g4) { u32x2v w; w.x = cvtpk(o[dh][4 * g4] * il, o[dh][4 * g4 + 1] * il); w.y = cvtpk(o[dh][4 * g4 + 2] * il, o[dh][4 * g4 + 3] * il);
                *(u32x2v*)(op + dh * 32 + 8 * g4) = w; }
    }
    const int cur = qpos >> 6;
    LAS float* imp = IG;
#pragma unroll 1
    for (int jj = 0; jj < 16; ++jj) {
        const int j = 16 * hi + jj;
        float v = IG[j] + (j > 0 ? IL[j] : 0.f);
        if (j == 0 || j == cur || j == cur - 1) v = INFINITY;
        if (j * 64 > qpos) v = -INFINITY;
        IL[j] = v;
    }
#pragma unroll 1
    for (int jj = 0; jj < 16; ++jj) { const int j = 16 * hi + jj; imp[j] = IL[j]; }
    unsigned mask = 0;
#pragma unroll 1
    for (int jj = 0; jj < 16; ++jj) {
        const int j = 16 * hi + jj; const float v = imp[j]; int rank = 0;
#pragma unroll 4
        for (int k = 0; k < 32; ++k) { const float u2 = imp[k]; rank += (u2 > v || (u2 == v && k < j)) ? 1 : 0; }
        if (rank < 16) mask |= 1u << j;
    }
    mask = red32_or(mask);
    if (hi == 0) ((unsigned*)(ws + WS_SEL))[(size_t)(b * 2 + g) * S_ + qpos] = mask;
    __syncthreads();
}
__device__ __forceinline__ void lora_rows(unsigned char* ws, int tid) {
    const int gw = blockIdx.x * NWAVES + (tid >> 6), ngw = gridDim.x * NWAVES, lane = tid & 63;
    bf16* kvl = (bf16*)(ws + WS_KVL); const bf16* ql = (const bf16*)(ws + WS_QL); float* ssql = (float*)(ws + WS_SSQL);
    for (int m = gw; m < T_; m += ngw) {
        const unsigned kv = *(const unsigned*)(kvl + (size_t)m * 128 + 2 * lane);
        const float k0 = __uint_as_float(kv << 16), k1 = __uint_as_float(kv & 0xffff0000u);
        const uint2 qv = *(const uint2*)(ql + (size_t)m * 256 + 4 * lane);
        const float q0 = __uint_as_float(qv.x << 16), q1 = __uint_as_float(qv.x & 0xffff0000u), q2 = __uint_as_float(qv.y << 16), q3 = __uint_as_float(qv.y & 0xffff0000u);
        const float sk = wave_sum2(k0 * k0 + k1 * k1), sq = wave_sum2((q0 * q0 + q1 * q1) + (q2 * q2 + q3 * q3));
        const float rk = rsqrtf(sk * (1.f / 128.f) + EPS);
        *(unsigned*)(kvl + (size_t)m * 128 + 2 * lane) = pk2(k0 * rk, k1 * rk);
        if (lane == 0) ssql[m] = sq;
    }
}
__device__ __forceinline__ void post_misc(unsigned char* ws, const float* big, const float* bfg, int tid) {
    const float* mr = (const float*)(ws + WS_MISCRAW); const float* cosM = (const float*)(ws + WS_COSM); const float* sinM = (const float*)(ws + WS_SINM);
    bf16* kr = (bf16*)(ws + WS_KR); float* gm = (float*)(ws + WS_GM);
    for (int idx = blockIdx.x * NTHR + tid; idx < T_ * 64; idx += gridDim.x * NTHR) {
        const int row = idx >> 6, c = idx & 63; const float* r = mr + (size_t)row * 64; const float v = r[c];
        if (c < 32) { const int i = c & 15; const float x1 = r[i], x2 = r[16 + i], cs = cosM[row * 16 + i], sn = sinM[row * 16 + i];
            kr[(size_t)row * 32 + c] = f2bf((c < 16) ? x1 * cs - x2 * sn : x1 * sn + x2 * cs); }
        else if (c < 50) gm[(size_t)row * 32 + (c - 32)] = 1.f / (1.f + __expf(-v));
        else if (c < 54) gm[(size_t)row * 32 + 18 + (c - 50)] = v + big[c - 50];
        else if (c < 58) { const float z = v + bfg[c - 54]; gm[(size_t)row * 32 + 22 + (c - 54)] = fminf(z, 0.f) - __logf(1.f + __expf(-fabsf(z))); }
    }
}

typedef float f32x4v __attribute__((ext_vector_type(4)));
__device__ __forceinline__ void compress_item(unsigned char* ws, LAS unsigned char* lds, const float* cmp_pos, int item, int wave_u) {
    const int lane = fresh_lane(), tid = wave_u * 64 + lane;
    const int nb = item & 7, g = (item >> 3) & 1, b = (item >> 4) & 7, kv = item >> 7;
    const bf16* tok = (const bf16*)(ws + WS_NSA) + (size_t)b * S_ * 1152 + (kv ? 512 : 384) + g * 64;
    const bf16* wt = (const bf16*)(ws + (kv ? WT_CV : WT_CK));
    const int nrow = nb * 16 + (lane & 15), kq = lane >> 4;
    f32x4v acc[4] = {f32x4v{}, f32x4v{}, f32x4v{}, f32x4v{}};
#pragma unroll 4
    for (int ks = 0; ks < 8; ++ks) {
        const int k = wave_u * 256 + ks * 32 + kq * 8, l = k >> 6, d = k & 63;
        int trow = 16 * nrow + l; trow = trow < S_ ? trow : S_ - 1;
        const v4u t4 = *(const v4u*)(tok + (size_t)trow * 1152 + d);
        const f32x4v p0 = *(const f32x4v*)(cmp_pos + k), p1 = *(const f32x4v*)(cmp_pos + k + 4);
        v4u a4;
        a4.x = cvtpk(__uint_as_float(t4.x << 16) + p0[0], __uint_as_float(t4.x & 0xffff0000u) + p0[1]); a4.y = cvtpk(__uint_as_float(t4.y << 16) + p0[2], __uint_as_float(t4.y & 0xffff0000u) + p0[3]);
        a4.z = cvtpk(__uint_as_float(t4.z << 16) + p1[0], __uint_as_float(t4.z & 0xffff0000u) + p1[1]); a4.w = cvtpk(__uint_as_float(t4.w << 16) + p1[2], __uint_as_float(t4.w & 0xffff0000u) + p1[3]);
        const bf16x8 af = __builtin_bit_cast(bf16x8, a4);
#pragma unroll
        for (int cb = 0; cb < 4; ++cb) { const bf16x8 bfr = *(const bf16x8*)(wt + (size_t)(cb * 16 + (lane & 15)) * 2048 + k);
            acc[cb] = __builtin_amdgcn_mfma_f32_16x16x32_bf16(af, bfr, acc[cb], 0, 0, 0); }
    }
    LAS float* red = (LAS float*)lds + wave_u * 1024;
#pragma unroll
    for (int cb = 0; cb < 4; ++cb)
#pragma unroll
        for (int r = 0; r < 4; ++r) red[(4 * (lane >> 4) + r) * 64 + cb * 16 + (lane & 15)] = acc[cb][r];
    __syncthreads();
    bf16* out = (bf16*)(ws + WS_KCV) + (size_t)kv * (8 * 2 * 128 * 64) + ((size_t)(b * 2 + g) * 128 + nb * 16) * 64;
    for (int o = tid; o < 1024; o += NTHR) { float sum = 0.f;
#pragma unroll
        for (int w8 = 0; w8 < 8; ++w8) sum += ((LAS float*)lds)[w8 * 1024 + o];
        out[o] = f2bf(sum); }
    __syncthreads();
}
__device__ __forceinline__ f32x4v mm16(const LAS bf16* A, int lda, int arow0, const LAS bf16* Bt, int ldb, int bcol0, int K, int lane, f32x4v acc) {
    const LAS bf16* ap = A + (arow0 + (lane & 15)) * lda + 8 * (lane >> 4); const LAS bf16* bp = Bt + (bcol0 + (lane & 15)) * ldb + 8 * (lane >> 4);
    for (int k = 0; k < K; k += 32) acc = __builtin_amdgcn_mfma_f32_16x16x32_bf16(*(const LAS bf16x8*)(ap + k), *(const LAS bf16x8*)(bp + k), acc, 0, 0, 0);
    return acc;
}
constexpr int ML_LD = 72;
__device__ __forceinline__ void mlocal_item(unsigned char* ws, LAS unsigned char* lds, const float* convw, const float* convb, const float* big, const float* bfg, int chunk, int wave_u) {
    const int lane = fresh_lane(), tid = wave_u * 64 + lane;
    const int c = chunk & 31, h = (chunk >> 5) & 3, b = chunk >> 7, row0 = b * S_ + c * 64;
    LAS bf16* XS = (LAS bf16*)lds;
    LAS bf16* WQ = XS + 64 * ML_LD;
    LAS bf16* WK = WQ + 64 * ML_LD;
    LAS bf16* VT = WK + 64 * ML_LD;
    LAS bf16* WKT = VT + 64 * ML_LD;
    LAS float* wl = (LAS float*)(WKT + 64 * ML_LD);
    const bf16* cm = (const bf16*)(ws + WS_CM);
    {
        const int l = tid >> 3, ch0 = (tid & 7) * 8, row = row0 + l, s = c * 64 + l;
        float a[8];
#pragma unroll
        for (int i = 0; i < 8; ++i) a[i] = convb[h * 64 + ch0 + i];
#pragma unroll
        for (int j = 0; j < 4; ++j) { if (s - 3 + j >= 0) { const v4u x4 = *(const v4u*)(cm + (size_t)(row - 3 + j) * 768 + h * 64 + ch0);
            const float* cw = convw + j * 256 + h * 64 + ch0;
            a[0] += cw[0] * __uint_as_float(x4.x << 16); a[1] += cw[1] * __uint_as_float(x4.x & 0xffff0000u); a[2] += cw[2] * __uint_as_float(x4.y << 16); a[3] += cw[3] * __uint_as_float(x4.y & 0xffff0000u);
            a[4] += cw[4] * __uint_as_float(x4.z << 16); a[5] += cw[5] * __uint_as_float(x4.z & 0xffff0000u); a[6] += cw[6] * __uint_as_float(x4.w << 16); a[7] += cw[7] * __uint_as_float(x4.w & 0xffff0000u); } }
        v4u o4; float r[8];
#pragma unroll
        for (int i = 0; i < 8; ++i) r[i] = a[i] / (1.f + __expf(-a[i]));
        o4.x = cvtpk(r[0], r[1]); o4.y = cvtpk(r[2], r[3]); o4.z = cvtpk(r[4], r[5]); o4.w = cvtpk(r[6], r[7]);
        *(v4u*)((bf16*)(ws + WS_XC) + (size_t)row * 256 + h * 64 + ch0) = o4;
        *(LAS v4u*)(XS + l * ML_LD + ch0) = o4;
        const v4u v4 = *(const v4u*)(cm + (size_t)row * 768 + 256 + h * 64 + ch0);
        VT[(ch0 + 0) * ML_LD + l] = (bf16)(v4.x & 0xffffu); VT[(ch0 + 1) * ML_LD + l] = (bf16)(v4.x >> 16); VT[(ch0 + 2) * ML_LD + l] = (bf16)(v4.y & 0xffffu); VT[(ch0 + 3) * ML_LD + l] = (bf16)(v4.y >> 16);
        VT[(ch0 + 4) * ML_LD + l] = (bf16)(v4.z & 0xffffu); VT[(ch0 + 5) * ML_LD + l] = (bf16)(v4.z >> 16); VT[(ch0 + 6) * ML_LD + l] = (bf16)(v4.w & 0xffffu); VT[(ch0 + 7) * ML_LD + l] = (bf16)(v4.w >> 16);
        const int e = tid >> 3, d0 = (tid & 7) * 8;
        *(LAS v4u*)(WQ + e * ML_LD + d0) = *(const v4u*)((const bf16*)(ws + WT_QM) + h * 4096 + e * 64 + d0);
        *(LAS v4u*)(WK + e * ML_LD + d0) = *(const v4u*)((const bf16*)(ws + WT_KM) + h * 4096 + e * 64 + d0);
    }
    if (wave_u == 0) {
        const float* mr = (const float*)(ws + WS_MISCRAW) + (size_t)(row0 + lane) * 64;
        const float z = mr[54 + h] + bfg[h]; float lf = fminf(z, 0.f) - __logf(1.f + __expf(-fabsf(z)));
        const float ig = mr[50 + h] + big[h];
#pragma unroll
        for (int o = 1; o < 64; o <<= 1) { const float t = bperm(lf, lane - o); if (lane >= o) lf += t; }
        const float bL = __int_as_float(__builtin_amdgcn_readlane(__float_as_int(lf), 63));
        const float a = bL - lf + ig; const float mx = wave_max2(a);
        wl[lane] = __expf(a - mx);
        if (lane == 0) { ((float*)(ws + WS_ML))[chunk] = mx; ((float*)(ws + WS_BL))[chunk] = bL; }
    }
    __syncthreads();
    {
        const int lb = wave_u & 3; const bool isk = wave_u >= 4;
        const LAS bf16* Wt = isk ? WK : WQ;
        bf16* og = (bf16*)(ws + (isk ? WS_MK : WS_MQ)) + (size_t)(row0 + 16 * lb + 4 * (lane >> 4)) * 256 + h * 64 + (lane & 15);
        float w4[4];
#pragma unroll
        for (int r = 0; r < 4; ++r) w4[r] = wl[16 * lb + 4 * (lane >> 4) + r];
#pragma unroll
        for (int eb = 0; eb < 4; ++eb) {
            f32x4v acc = mm16(XS, ML_LD, 16 * lb, Wt, ML_LD, 16 * eb, 64, lane, f32x4v{});
            if (!isk) {
#pragma unroll
                for (int r = 0; r < 4; ++r) og[(size_t)r * 256 + 16 * eb] = f2bf(acc[r] * 0.125f);
            } else {
                bf16 kb[4];
#pragma unroll
                for (int r = 0; r < 4; ++r) { kb[r] = f2bf(acc[r]); og[(size_t)r * 256 + 16 * eb] = kb[r]; }
                u32x2v w2; w2.x = cvtpk(bf2f(kb[0]) * w4[0], bf2f(kb[1]) * w4[1]); w2.y = cvtpk(bf2f(kb[2]) * w4[2], bf2f(kb[3]) * w4[3]);
                *(LAS u32x2v*)(WKT + (16 * eb + (lane & 15)) * ML_LD + 16 * lb + 4 * (lane >> 4)) = w2;
            }
        }
    }
    __syncthreads();
    {
        float* ct = (float*)(ws + WS_CT) + (size_t)chunk * 4096;
#pragma unroll
        for (int i = 0; i < 2; ++i) { const int blk = wave_u * 2 + i, eb = blk >> 2, db = blk & 3;
            const f32x4v acc = mm16(VT, ML_LD, 16 * eb, WKT, ML_LD, 16 * db, 64, lane, f32x4v{});
#pragma unroll
            for (int r = 0; r < 4; ++r) ct[(16 * eb + 4 * (lane >> 4) + r) * 64 + 16 * db + (lane & 15)] = acc[r]; }
        if (tid < 64) { float n = 0.f; const LAS bf16* wr_ = WKT + tid * ML_LD;
            for (int l = 0; l < 64; ++l) n += bf2f(wr_[l]);
            ((float*)(ws + WS_NL))[chunk * 64 + tid] = n; }
    }
    __syncthreads();
}
__device__ __forceinline__ void mscan_item(unsigned char* ws, int item, int wave_u) {
    const int tid = wave_u * 64 + fresh_lane();
    const int bh = item / 9, part = item % 9;
    if (part == 8 && tid >= 64) return;
    float* base; size_t stride;
    if (part < 8) { base = (float*)(ws + WS_CT) + (size_t)bh * 32 * 4096 + part * 512 + tid; stride = 4096; } else { base = (float*)(ws + WS_NL) + (size_t)bh * 32 * 64 + tid; stride = 64; }
    const float* ML = (const float*)(ws + WS_ML); const float* BL = (const float*)(ws + WS_BL); float* MPv = (float*)(ws + WS_MP);
    float Cv = 0.f, m = 0.f;
    for (int c = 0; c < 32; ++c) {
        const float cl = base[(size_t)c * stride], ml = ML[bh * 32 + c], bl = BL[bh * 32 + c];
        base[(size_t)c * stride] = Cv;
        if (part == 8 && tid == 0) MPv[bh * 32 + c] = m;
        const float mn = fmaxf(bl + m, ml);
        Cv = __expf(bl + m - mn) * Cv + __expf(ml - mn) * cl; m = mn;
    }
}
__device__ __forceinline__ void mout_item(unsigned char* ws, LAS unsigned char* lds, const float* gmh, const float* skip, int chunk, int wave_u) {
    const int lane = fresh_lane(), tid = wave_u * 64 + lane;
    const int c = chunk & 31, h = (chunk >> 5) & 3, b = chunk >> 7, row0 = b * S_ + c * 64;
    LAS bf16* QS = (LAS bf16*)lds;
    LAS bf16* KS = QS + 64 * ML_LD;
    LAS bf16* VT = KS + 64 * ML_LD;
    LAS bf16* CP = VT + 64 * ML_LD;
    LAS bf16* SW = CP + 64 * ML_LD;
    LAS float* HS = (LAS float*)(SW + 64 * ML_LD);
    LAS float* bs = HS + 64 * 65; LAS float* us = bs + 64; LAS float* ns = us + 64; LAS float* mts = ns + 64; LAS float* ints = mts + 64; LAS float* dinv = ints + 64;
    const float* gm = (const float*)(ws + WS_GM);
    {
        const int l = tid >> 3, c0 = (tid & 7) * 8, row = row0 + l;
        *(LAS v4u*)(QS + l * ML_LD + c0) = *(const v4u*)((const bf16*)(ws + WS_MQ) + (size_t)row * 256 + h * 64 + c0);
        *(LAS v4u*)(KS + l * ML_LD + c0) = *(const v4u*)((const bf16*)(ws + WS_MK) + (size_t)row * 256 + h * 64 + c0);
        const v4u v4 = *(const v4u*)((const bf16*)(ws + WS_CM) + (size_t)row * 768 + 256 + h * 64 + c0);
        VT[(c0 + 0) * ML_LD + l] = (bf16)(v4.x & 0xffffu); VT[(c0 + 1) * ML_LD + l] = (bf16)(v4.x >> 16); VT[(c0 + 2) * ML_LD + l] = (bf16)(v4.y & 0xffffu); VT[(c0 + 3) * ML_LD + l] = (bf16)(v4.y >> 16);
        VT[(c0 + 4) * ML_LD + l] = (bf16)(v4.z & 0xffffu); VT[(c0 + 5) * ML_LD + l] = (bf16)(v4.z >> 16); VT[(c0 + 6) * ML_LD + l] = (bf16)(v4.w & 0xffffu); VT[(c0 + 7) * ML_LD + l] = (bf16)(v4.w >> 16);
        const float* ct = (const float*)(ws + WS_CT) + (size_t)chunk * 4096 + l * 64 + c0;
        const f32x4v c0v = *(const f32x4v*)ct, c1v = *(const f32x4v*)(ct + 4);
        v4u cw; cw.x = cvtpk(c0v[0], c0v[1]); cw.y = cvtpk(c0v[2], c0v[3]); cw.z = cvtpk(c1v[0], c1v[1]); cw.w = cvtpk(c1v[2], c1v[3]);
        *(LAS v4u*)(CP + l * ML_LD + c0) = cw;
    }
    if (wave_u == 0) {
        const float ig = gm[(size_t)(row0 + lane) * 32 + 18 + h]; float lf = gm[(size_t)(row0 + lane) * 32 + 22 + h];
#pragma unroll
        for (int o = 1; o < 64; o <<= 1) { const float t = bperm(lf, lane - o); if (lane >= o) lf += t; }
        const float u = ig - lf; float cu = u;
#pragma unroll
        for (int o = 1; o < 64; o <<= 1) { const float t = bperm(cu, lane - o); if (lane >= o) cu = fmaxf(cu, t); }
        const float mprev = ((const float*)(ws + WS_MP))[chunk];
        const float mt = lf + fmaxf(mprev, cu);
        bs[lane] = lf; us[lane] = u; mts[lane] = mt; ints[lane] = __expf(lf + mprev - mt); ns[lane] = ((const float*)(ws + WS_NL))[chunk * 64 + lane];
    }
    __syncthreads();
    {
#pragma unroll
        for (int i = 0; i < 2; ++i) { const int blk = wave_u * 2 + i, lb = blk >> 2, sb = blk & 3;
            f32x4v acc = f32x4v{};
            if (sb <= lb) acc = mm16(QS, ML_LD, 16 * lb, KS, ML_LD, 16 * sb, 64, lane, acc);
            const int sidx = 16 * sb + (lane & 15); const float usv = us[sidx];
#pragma unroll
            for (int r = 0; r < 4; ++r) { const int l = 16 * lb + 4 * (lane >> 4) + r;
                const float v = (sidx <= l) ? acc[r] * __expf(bs[l] + usv - mts[l]) : 0.f;
                SW[l * ML_LD + sidx] = f2bf(v); } }
    }
    __syncthreads();
    if (tid < 64) {
        const int l = tid; float qn = 0.f, ssum = 0.f;
        for (int d = 0; d < 64; ++d) { qn += bf2f(QS[l * ML_LD + d]) * ns[d]; ssum += bf2f(SW[l * ML_LD + d]); }
        const float den = ints[l] * qn + ssum;
        dinv[l] = 1.f / fmaxf(fabsf(den), __expf(-mts[l]));
    }
    f32x4v hq[2], hs2[2];
#pragma unroll
    for (int i = 0; i < 2; ++i) { const int blk = wave_u * 2 + i, lb = blk >> 2, eb = blk & 3;
        hq[i] = mm16(QS, ML_LD, 16 * lb, CP, ML_LD, 16 * eb, 64, lane, f32x4v{});
        hs2[i] = mm16(SW, ML_LD, 16 * lb, VT, ML_LD, 16 * eb, 16 * lb + 16 <= 32 ? 32 : 64, lane, f32x4v{}); }
    __syncthreads();
#pragma unroll
    for (int i = 0; i < 2; ++i) { const int blk = wave_u * 2 + i, lb = blk >> 2, eb = blk & 3; const int e = 16 * eb + (lane & 15);
#pragma unroll
        for (int r = 0; r < 4; ++r) { const int l = 16 * lb + 4 * (lane >> 4) + r;
            const float og = bf2f(((const bf16*)(ws + WS_CM))[(size_t)(row0 + l) * 768 + 512 + h * 64 + e]);
            HS[l * 65 + e] = (ints[l] * hq[i][r] + hs2[i][r]) * dinv[l] / (1.f + __expf(-og)); } }
    __syncthreads();
    {
        const int l = tid >> 3, e0 = (tid & 7) * 8, row = row0 + l;
        float v[8]; float mu = 0.f;
#pragma unroll
        for (int i = 0; i < 8; ++i) { v[i] = HS[l * 65 + e0 + i]; mu += v[i]; }
        mu += sxf<1>(mu); mu += sxf<2>(mu); mu += sxf<4>(mu); mu *= (1.f / 64.f);
        float var = 0.f;
#pragma unroll
        for (int i = 0; i < 8; ++i) { const float dl = v[i] - mu; var += dl * dl; }
        var += sxf<1>(var); var += sxf<2>(var); var += sxf<4>(var);
        const float rs = rsqrtf(var * (1.f / 64.f) + EPS);
        const v4u x4 = *(const v4u*)((const bf16*)(ws + WS_XC) + (size_t)row * 256 + h * 64 + e0);
        float xv[8]; xv[0] = __uint_as_float(x4.x << 16); xv[1] = __uint_as_float(x4.x & 0xffff0000u); xv[2] = __uint_as_float(x4.y << 16); xv[3] = __uint_as_float(x4.y & 0xffff0000u);
        xv[4] = __uint_as_float(x4.z << 16); xv[5] = __uint_as_float(x4.z & 0xffff0000u); xv[6] = __uint_as_float(x4.w << 16); xv[7] = __uint_as_float(x4.w & 0xffff0000u);
        float r[8];
#pragma unroll
        for (int i = 0; i < 8; ++i) r[i] = (v[i] - mu) * rs * gmh[h * 64 + e0 + i] + skip[h * 64 + e0 + i] * xv[i];
        v4u w4; w4.x = cvtpk(r[0], r[1]); w4.y = cvtpk(r[2], r[3]); w4.z = cvtpk(r[4], r[5]); w4.w = cvtpk(r[6], r[7]);
        *(v4u*)((bf16*)(ws + WS_HB) + (size_t)row * D_ + 768 + h * 64 + e0) = w4;
    }
    __syncthreads();
}

__global__ void __launch_bounds__(NTHR, 2) mega(MP p_unused) {
    extern __shared__ __attribute__((aligned(16))) unsigned char lds_raw[];
    LAS unsigned char* lds = (LAS unsigned char*)lds_raw;
    const int wave0 = __builtin_amdgcn_readfirstlane((int)threadIdx.x >> 6);
    const int tid0 = wave0 * 64 + fresh_lane();
    const int xcc = (int)(__builtin_amdgcn_s_getreg((3 << 11) | 20) & 7u);
    volatile LAS unsigned* MISC = (volatile LAS unsigned*)(lds + MISC_OFF);
    for (int u = tid0; u < (LDS_BYTES - RING_BYTES) / 4; u += NTHR) ((LAS unsigned*)(lds + RING_BYTES))[u] = 0u;
    __syncthreads();
    typedef const __attribute__((address_space(4))) MP* kmp_t;
    kmp_t kp0 = (kmp_t)__builtin_amdgcn_kernarg_segment_ptr();
    unsigned char* ws0 = kp0->ws; const int coop = kp0->coop, ph_lo = kp0->ph_lo, ph_hi = kp0->ph_hi;
    XcdBarrier bar; bar.bar = (unsigned*)(ws0 + WS_CTL) + CW_BAR; bar.x = 0; bar.st = nullptr;
    if (coop) bar = xcd_barrier_post((unsigned*)(ws0 + WS_CTL) + CW_BAR, MISC + 8, tid0);
    if (coop == 2) cooperative_groups::this_grid().sync();
    int ph = ph_lo;
    if (ph == 0) {
        const MPK p{kp0}; ph_p0(p, lds, wave0 * 64 + fresh_lane()); ph = 1;
        if (ph < ph_hi) xcd_barrier(bar, wave0 * 64 + fresh_lane());
    }
    bool second = false;
    for (; ph < ph_hi; ++ph) {
        kmp_t kp = kp0; asm volatile("" : "+s"(kp));
        const MPK p{kp}; unsigned char* ws = kp->ws;
#define TID_ (wave0 * 64 + fresh_lane())
#define GW_ (blockIdx.x * NWAVES + wave0)
#define NGW_ (gridDim.x * NWAVES)
        const int l = (ph - 1) / PPL, ty = (ph == 0) ? -1 : (ph == NPH - 1) ? -2 : (ph - 1) % PPL;
        const float* modl = (const float*)(ws + WS_MOD) + (size_t)l * 8 * 6144;
        if (ty == -2) { norm_rows(p.k->out, PIN(I_GFIN), nullptr, nullptr, nullptr, p.k->out, 2, GW_, NGW_, fresh_lane());
            if (PROBE_SEL != 0 && blockIdx.x == 0 && TID_ == 0) { asm volatile("s_waitcnt vmcnt(0)" ::: "memory"); p.k->out[0] = ((const float*)(ws + WS_CTL))[100] * 0.001f; } }
        else if (ty == 0 && (PHM & 2)) ph_prep(p, l, lds, TID_);
        else if (ty == 1 && (PHM & 4)) {
            pg8::Gemm g{(const bf16*)(ws + WS_HB), (const bf16*)(ws + WT_IN), T_, 2560, D_}; pg8::StaticOrder S; S.init(T_, 2560, gridDim.x, blockIdx.x);
            pg8::EpiIn E{ws, PIN(I_BIG) + l * 4, PIN(I_BFG) + l * 4};
            pg8::gemm_phase<pg8::EpiIn, pg8::StaticOrder, true, true>(lds, g, S, E, wave0);
            late_transposes(p, l, lds, TID_, 640 % (int)gridDim.x);
        }
        else if (ty == 2 && (PHM & 64)) {
            { pg8::Gemm g{(const bf16*)(ws + WS_KVL), (const bf16*)(ws + WT_UKV), T_, 768, 128}; pg8::StaticOrder S; S.init(T_, 768, gridDim.x, blockIdx.x);
              pg8::EpiUKV E{(bf16*)(ws + WS_KVM), (const float*)(ws + WS_SSKV)}; pg8::gemm_phase<pg8::EpiUKV, pg8::StaticOrder, true, true>(lds, g, S, E, wave0); }
            { pg8::Gemm g{(const bf16*)(ws + WS_QL), (const bf16*)(ws + WT_UQ), T_, 768, 256}; pg8::StaticOrder S; S.init(T_, 768, gridDim.x, blockIdx.x);
              pg8::EpiPlain E{(bf16*)(ws + WS_OSLC), 768}; pg8::gemm_phase<pg8::EpiPlain, pg8::StaticOrder, true, true>(lds, g, S, E, wave0); }
            post_misc(ws, PIN(I_BIG) + l * 4, PIN(I_BFG) + l * 4, TID_);
            unsigned* ctrs = (unsigned*)(ws + WS_CTL) + 8192 + ph * 256 + (second ? 128 : 0); int ks = 0;
            for (;;) { const int it = next_item_q(ctrs, lds, wave0, 160, xcc, ks); if (it < 0) break; const int b = it >> 16, j = it & 0xffff;
                if (second && (REP_MASK & (1 << 18)) && j >= 128) continue; if (second && (REP_MASK & (1 << 19)) && j < 128) continue;
                if (j < 128) mlocal_item(ws, lds, PIN(I_CONVW) + l * 1024, PIN(I_CONVB) + l * 256, PIN(I_BIG) + l * 4, PIN(I_BFG) + l * 4, b * 128 + j, wave0);
                else { const int k = j - 128; compress_item(ws, lds, PIN(I_CMPPOS) + l * 2048, ((k >> 4) << 7) | (b << 4) | (k & 15), wave0); } }
        }
        else if (ty == 3 && (PHM & 128)) {
            unsigned* ctrs = (unsigned*)(ws + WS_CTL) + 8192 + ph * 256 + (second ? 128 : 0); int ks = 0;
            for (;;) { const int it = next_item_q(ctrs, lds, wave0, second ? 64 : 100, xcc, ks); if (it < 0) break; const int b = it >> 16, j = it & 0xffff;
                if (second && (REP_MASK & (1 << 20)) && j >= 48) continue; if (second && (REP_MASK & (1 << 21)) && j < 48) continue;
                if (j < 48) mla_unit(ws, lds, b, j % 6, 7 - j / 6, wave0);
                else if (j < 64) cmp_unit(ws, lds, b, (j - 48) >> 3, (j - 48) & 7, wave0);
                else mscan_item(ws, b * 36 + (j - 64), wave0); }
        }
        else if (ty == 4 && (PHM & 256)) {
            unsigned* ctrs = (unsigned*)(ws + WS_CTL) + 8192 + ph * 256 + (second ? 128 : 0); int ks = 0;
            for (;;) { const int it = next_item_q(ctrs, lds, wave0, 224, xcc, ks); if (it < 0) break; const int b = it >> 16, j = it & 0xffff;
                if (second && (REP_MASK & (1 << 16)) && j >= 96) continue; if (second && (REP_MASK & (1 << 17)) && j < 96) continue;
                if (j < 48) nsa_branch_unit<AM_SLC>(ws, lds, b, j % 6, 7 - j / 6, wave0);
                else if (j < 96) nsa_branch_unit<AM_WINDOW>(ws, lds, b, (j - 48) % 6, 7 - (j - 48) / 6, wave0);
                else mout_item(ws, lds, PIN(I_GMH) + l * 256, PIN(I_SKIP) + l * 256, b * 128 + (j - 96), wave0); }
        }
        else if (ty == 5) ph_mixnorm(p, l, TID_);
        else if (ty == 6 && (PHM & 8)) {
            pg8::Gemm g{(const bf16*)(ws + WS_HB), (const bf16*)(ws + WT_OUT), T_, D_, D_}; pg8::StaticOrder S; S.init(T_, D_, gridDim.x, blockIdx.x);
            pg8::EpiRes E{(l == 0) ? PIN(I_X) : p.k->out, p.k->out, modl + 2048};
            pg8::gemm_phase<pg8::EpiRes, pg8::StaticOrder, true, true>(lds, g, S, E, wave0);
        }
        else if (ty == 7) norm_rows(p.k->out, PIN(I_GN2) + l * D_, modl + 3072, modl + 4096, (bf16*)(ws + WS_HB), nullptr, 1, GW_, NGW_, fresh_lane());
        else if (ty == 8 && (PHM & 16)) {
            pg8::Gemm g{(const bf16*)(ws + WS_HB), (const bf16*)(ws + WT_GU), T_, 2 * FF, D_}; pg8::StaticOrder S; S.init(T_, 2 * FF, gridDim.x, blockIdx.x);
            pg8::EpiGU E{(bf16*)(ws + WS_ACT)};
            pg8::gemm_phase<pg8::EpiGU, pg8::StaticOrder, true, true>(lds, g, S, E, wave0);
        }
        else if (ty == 9 && (PHM & 32)) {
            pg8::Gemm g{(const bf16*)(ws + WS_ACT), (const bf16*)(ws + WT_DOWN), T_, D_, FF}; pg8::StaticOrder S; S.init(T_, D_, gridDim.x, blockIdx.x);
            pg8::EpiRes E{p.k->out, p.k->out, modl + 5120};
            pg8::gemm_phase<pg8::EpiRes, pg8::StaticOrder, true, true>(lds, g, S, E, wave0);
        }
        if (REP_MASK != 0 && ty >= 0 && ((REP_MASK >> ty) & 1) && !second) { second = true; --ph; } else second = false;
        if (ph + 1 < ph_hi) xcd_barrier(bar, wave0 * 64 + fresh_lane());
    }
}

__global__ void k_post_misc(const float* mr, const float* cosM, const float* sinM, const float* big, const float* bfg, bf16* km, float* gm) {
    const int idx = blockIdx.x * blockDim.x + threadIdx.x;
    if (idx >= T_ * 64) return;
    const int row = idx >> 6, c = idx & 63; const float* r = mr + (size_t)row * 64; const float v = r[c];
    if (c < 32) { const int i = c & 15; const float x1 = r[i], x2 = r[16 + i], cs = cosM[row * 16 + i], sn = sinM[row * 16 + i];
        const bf16 o = f2bf((c < 16) ? x1 * cs - x2 * sn : x1 * sn + x2 * cs);
        for (int h = 0; h < 6; ++h) km[(size_t)row * 576 + h * 96 + 64 + c] = o; }
    else if (c < 50) gm[(size_t)row * 32 + (c - 32)] = sigmoidf_(v);
    else if (c < 54) gm[(size_t)row * 32 + 18 + (c - 50)] = v + big[c - 50];
    else if (c < 58) { const float z = v + bfg[c - 54]; gm[(size_t)row * 32 + 22 + (c - 54)] = fminf(z, 0.f) - log1pf(__expf(-fabsf(z))); }
}
static void run_mega(const MP& base, int lo, int hi, hipStream_t stream) {
    for (int ph = lo; ph < hi; ++ph) { MP a = base; a.ph_lo = ph; a.ph_hi = ph + 1; a.coop = 0; hipLaunchKernelGGL(mega, dim3(256), dim3(NTHR), LDS_BYTES, stream, a); }
}
extern "C" void kernel_launch(void* const* d_in, const int* in_sizes, int n_in, void* d_out, int out_size, void* d_ws, size_t ws_size, hipStream_t stream) {
    if (n_in != N_IN || ws_size < WS_END) { fprintf(stderr, "kernel_launch: unexpected n_in %d / ws %zu\n", n_in, ws_size); return; }
    static int inited = 0;
    if (!inited) { if (hipFuncSetAttribute((const void*)mega, hipFuncAttributeMaxDynamicSharedMemorySize, LDS_BYTES) != hipSuccess) fprintf(stderr, "hipFuncSetAttribute failed\n"); inited = 1; }
    unsigned char* ws = (unsigned char*)d_ws;
    MP base{}; for (int i = 0; i < N_IN; ++i) base.in[i] = (const float*)d_in[i]; base.out = (float*)d_out; base.ws = ws;
    (void)hipMemsetAsync(ws + WS_CTL, 0, CTL_ZERO_BYTES, stream);
#if defined(MK_MULTI_LAUNCH)
    run_mega(base, 0, NPH, stream);
#else
    static int grid = 0;
    if (!grid) {
        int dev = 0, cus = 0, per_cu = 0;
        (void)hipGetDevice(&dev); (void)hipDeviceGetAttribute(&cus, hipDeviceAttributeMultiprocessorCount, dev);
        if (hipOccupancyMaxActiveBlocksPerMultiprocessor(&per_cu, (const void*)mega, NTHR, LDS_BYTES) != hipSuccess || per_cu < 1) { fprintf(stderr, "kernel_launch: occupancy query says %d blocks per CU\n", per_cu); per_cu = 1; }
        (void)hipGetLastError();
        grid = cus;
    }
    MP a = base; a.ph_lo = 0; a.ph_hi = NPH; a.coop = 1;
    void* args[] = {&a};
    const hipError_t e = hipLaunchCooperativeKernel((const void*)mega, dim3(grid), dim3(NTHR), args, LDS_BYTES, stream);
    if (e != hipSuccess) fprintf(stderr, "kernel_launch: cooperative launch failed: %s (grid %d)\n", hipGetErrorString(e), grid);
#endif
}
```

```cpp
#include <hip/hip_runtime.h>
#include <cstdint>
#include <cstdio>
#include <hip/hip_cooperative_groups.h>

constexpr int B_ = 8, S_ = 2048, T_ = B_ * S_, D_ = 1024, DIN = 2362, FF = 2816, DEPTH = 2;
constexpr float EPS = 1e-6f;
constexpr float LOG2E = 1.4426950408889634f;
constexpr float QSCALE = 0.125f * LOG2E;
constexpr float MSCALE = 0.10206207261596577f * LOG2E;
enum { I_X = 0, I_C, I_POS, I_GN1, I_GN2, I_WADA, I_BADA, I_WIN, I_CMPPOS, I_WCK, I_WCV, I_GOA, I_GQL, I_WUQ, I_GKVL, I_WUKV, I_GOB,
       I_CONVW, I_CONVB, I_WQM, I_WKM, I_BIG, I_BFG, I_GMH, I_SKIP, I_WOUT, I_WGU, I_WDOWN, I_GFIN, N_IN };

constexpr size_t MiB = 1u << 20;
constexpr size_t WS_CTL = 0;
constexpr size_t WS_MOD = 1 * MiB;
constexpr size_t WS_COSP = WS_MOD + 512 * 1024;
constexpr size_t WS_SINP = WS_COSP + 512 * 1024;
constexpr size_t WS_COSM = WS_SINP + 512 * 1024;
constexpr size_t WS_SINM = WS_COSM + 1 * MiB;
constexpr size_t WS_SSQL = WS_SINM + 1 * MiB;
constexpr size_t WS_SSKV = WS_SSQL + 64 * 1024;
constexpr size_t WS_ML = WS_SSKV + 64 * 1024;
constexpr size_t WS_BL = WS_ML + 4096;
constexpr size_t WS_MP = WS_BL + 4096;
constexpr size_t WS_NL = WS_MP + 4096;
constexpr size_t WS_WT = 8 * MiB;
constexpr size_t WS_RAW = WS_WT;
constexpr size_t WS_HB = 34 * MiB;
constexpr size_t WS_NSA = 66 * MiB;
constexpr size_t WS_KVL = 102 * MiB;
constexpr size_t WS_QL = 106 * MiB;
constexpr size_t WS_CM = 114 * MiB;
constexpr size_t WS_GM = 138 * MiB;
constexpr size_t WS_KM = 140 * MiB;
constexpr size_t WS_QM = 158 * MiB;
constexpr size_t WS_VM = 176 * MiB;
constexpr size_t WS_KCV = 188 * MiB;
constexpr size_t WS_OCMP = 189 * MiB;
constexpr size_t WS_SEL = 201 * MiB;
constexpr size_t WS_XC = 202 * MiB;
constexpr size_t WS_MQ = 210 * MiB;
constexpr size_t WS_MK = 218 * MiB;
constexpr size_t WS_CT = 226 * MiB;
constexpr size_t WS_MISCRAW = 242 * MiB;
constexpr size_t WS_KVM = 140 * MiB;
constexpr size_t WS_KR = 246 * MiB;
constexpr size_t WS_OSLC = 164 * MiB;
constexpr size_t WS_OWIN = 176 * MiB;
constexpr size_t WS_ACT = 66 * MiB;
constexpr size_t WS_END = 256 * MiB;
static_assert(WS_NL + 1024 * 64 * 4 <= WS_WT, "tab");
static_assert(WS_ACT + (size_t)T_ * FF * 2 <= WS_KCV, "act overlay");

typedef unsigned short bf16;
__device__ __forceinline__ float bf2f(bf16 v) { return __uint_as_float(((unsigned)v) << 16); }
__device__ __forceinline__ bf16 f2bf(float f) { unsigned u = __float_as_uint(f); return (bf16)((u + 0x7fffu + ((u >> 16) & 1u)) >> 16); }
__device__ __forceinline__ float sigmoidf_(float x) { return 1.f / (1.f + __expf(-x)); }
__device__ __forceinline__ float siluf_(float x) { return x / (1.f + __expf(-x)); }
__device__ __forceinline__ float wave_sum(float v) {
#pragma unroll
    for (int o = 1; o < 64; o <<= 1) v += __shfl_xor(v, o);
    return v;
}

__device__ __forceinline__ int fresh_lane() { int l; asm volatile("v_mbcnt_lo_u32_b32 %0, -1, 0\n\tv_mbcnt_hi_u32_b32 %0, -1, %0" : "=&v"(l)); return l; }
template <int M> __device__ __forceinline__ float sxf(float v) { static_assert(M >= 1 && M < 32, "swizzle xor mask"); return __int_as_float(__builtin_amdgcn_ds_swizzle(__float_as_int(v), (M << 10) | 0x1f)); }
__device__ __forceinline__ float red32_max(float v) { auto r = __builtin_amdgcn_permlane32_swap(__float_as_uint(v), __float_as_uint(v), false, false); return fmaxf(__uint_as_float(r[0]), __uint_as_float(r[1])); }
__device__ __forceinline__ float red32_sum(float v) { auto r = __builtin_amdgcn_permlane32_swap(__float_as_uint(v), __float_as_uint(v), false, false); return __uint_as_float(r[0]) + __uint_as_float(r[1]); }
__device__ __forceinline__ unsigned red32_or(unsigned v) { auto r = __builtin_amdgcn_permlane32_swap(v, v, false, false); return r[0] | r[1]; }
__device__ __forceinline__ float bperm(float v, int src_lane) { return __int_as_float(__builtin_amdgcn_ds_bpermute(src_lane << 2, __float_as_int(v))); }
__device__ __forceinline__ float wave_sum2(float v) { v += sxf<1>(v); v += sxf<2>(v); v += sxf<4>(v); v += sxf<8>(v); v += sxf<16>(v); return red32_sum(v); }
__device__ __forceinline__ float wave_max2(float v) { v = fmaxf(v, sxf<1>(v)); v = fmaxf(v, sxf<2>(v)); v = fmaxf(v, sxf<4>(v)); v = fmaxf(v, sxf<8>(v)); v = fmaxf(v, sxf<16>(v)); return red32_max(v); }
namespace pg8 {
#define PG8_LAS __attribute__((address_space(3)))
typedef unsigned short bf16_t;
typedef short bf16x8 __attribute__((ext_vector_type(8)));
typedef float f32x4 __attribute__((ext_vector_type(4)));
typedef unsigned u32x4 __attribute__((ext_vector_type(4)));
constexpr int BM = 256, BK = 64, HALF = 128, HTB = HALF * BK * 2  , STAGE_BYTES = 8 * HTB, NXCD = 8, WGM = 8;

__host__ __device__ __forceinline__ int lds_byte(int r, int c) { const int st = (r >> 4) * 2 + (c >> 5), rr = r & 15, cc = c & 31, ob = rr * 64 + cc * 2; return st * 1024 + (ob ^ (((ob >> 9) & 1) << 5)); }
__host__ __device__ __forceinline__ void stage_rc(int b, int& R, int& C) { const int st = b / 1024, sb = b % 1024, swz = sb ^ (((sb >> 9) & 1) << 5); R = (st >> 1) * 16 + swz / 64; C = (st & 1) * 32 + (swz % 64) / 2; }
__host__ __device__ __forceinline__ int perm32(int rho) { const int n = rho >> 4, i = rho & 15; return 8 * (i >> 2) + 4 * n + (i & 3); }

struct Unit { int pm, pn; };
struct Gemm { const bf16_t* A; const bf16_t* Bt; int M, N, K; };

struct StaticOrder {
    int nM, nN, nwg, G, c;
    __host__ __device__ void init(int M, int N, int G_, int c_) { nM = M / BM; nN = N / BM; nwg = nM * nN; G = G_; c = c_; }
    __host__ __device__ bool next(int i, Unit& u) const {
        const long L = (long)i * G + c; if (L >= nwg) return false;
        int wgid = (int)L; { const int q = nwg / NXCD, r = nwg % NXCD, xcd = wgid % NXCD, off = wgid / NXCD; wgid = (xcd < r ? xcd * (q + 1) : r * (q + 1) + (xcd - r) * q) + off; }
        const int nig = WGM * nN, gid = wgid / nig, fm = gid * WGM, gsz = (nM - fm) < WGM ? (nM - fm) : WGM;
        u.pm = fm + ((wgid % nig) % gsz); u.pn = (wgid % nig) / gsz; return true;
    }
    __device__ __forceinline__ void a_ready(const Unit&) const {}
    __device__ __forceinline__ void done(const Unit&) const {}
};

__device__ __forceinline__ unsigned cvt_pk_bf16(float lo, float hi) { unsigned r; asm volatile("v_cvt_pk_bf16_f32 %0, %1, %2" : "=v"(r) : "v"(lo), "v"(hi)); return r; }
typedef float f32x2 __attribute__((ext_vector_type(2)));

typedef unsigned u32x4 __attribute__((ext_vector_type(4)));
typedef unsigned u32x2 __attribute__((ext_vector_type(2)));
struct EpiIn {
    static constexpr bool PERM = true, AFTER_DRAIN = false;
    unsigned char* ws; const float *big, *bfg;
#define EPI_ROWS(...) _Pragma("unroll") for (int ai = 0; ai < 2; ++ai) _Pragma("unroll") for (int m = 0; m < 4; ++m) { \
        const int row = u.pm * BM + ai * HALF + wr * 64 + m * 16 + fr; float v[8]; \
        _Pragma("unroll") for (int i = 0; i < 4; ++i) { v[i] = acc[ai][bj][m][0][i]; v[4 + i] = acc[ai][bj][m][1][i]; } \
        asm volatile("" : "+v"(v[0]), "+v"(v[1]), "+v"(v[2]), "+v"(v[3]), "+v"(v[4]), "+v"(v[5]), "+v"(v[6]), "+v"(v[7])); \
        __VA_ARGS__ asm volatile("" ::: "memory"); }
#define EPI_PACK(w) u32x4 w; w.x = cvt_pk_bf16(v[0], v[1]); w.y = cvt_pk_bf16(v[2], v[3]); w.z = cvt_pk_bf16(v[4], v[5]); w.w = cvt_pk_bf16(v[6], v[7]);
    __device__ __forceinline__ void operator()(const f32x4 (&acc)[2][2][4][2], const Unit& u, int wr, int wc, int fr, int fq) const {
        half<0>(acc, u, wr, wc, fr, fq); half<1>(acc, u, wr, wc, fr, fq);
    }
    template <int bj> __device__ __forceinline__ void half(const f32x4 (&acc)[2][2][4][2], const Unit& u, int wr, int wc, int fr, int fq) const {
        {
            const int hb = 2 * u.pn + bj;
            int cb = 32 * wc + 8 * fq; asm volatile("" : "+v"(cb), "+v"(fr));
            if (hb <= 8) {
                bf16_t* nsa = (bf16_t*)(ws + WS_NSA) + hb * 128 + cb;
                const bool rope_hb = (hb <= 3) || hb == 5 || hb == 7;
                if (rope_hb) {
                    const float* cosP = (const float*)(ws + WS_COSP); const float* sinP = (const float*)(ws + WS_SINP);
                    const bool mine = ((wc & 1) == 0) && fq < 2; const float sg = (fq == 0) ? -1.f : 1.f; const float sc = (hb < 3) ? QSCALE : 1.f;
                    EPI_ROWS({
                        float pv[8];
                        _Pragma("unroll") for (int i = 0; i < 8; ++i) pv[i] = sxf<16>(v[i]);
                        if (mine) {
                            const f32x4 c0 = *(const f32x4*)(cosP + row * 8), c1 = *(const f32x4*)(cosP + row * 8 + 4), s0 = *(const f32x4*)(sinP + row * 8), s1 = *(const f32x4*)(sinP + row * 8 + 4);
                            _Pragma("unroll") for (int i = 0; i < 4; ++i) { v[i] = v[i] * c0[i] + sg * pv[i] * s0[i]; v[4 + i] = v[4 + i] * c1[i] + sg * pv[4 + i] * s1[i]; }
                        }
                        _Pragma("unroll") for (int i = 0; i < 8; ++i) v[i] *= sc;
                        EPI_PACK(w) *(u32x4*)(nsa + (size_t)row * 1152) = w;
                    })
                } else {
                    EPI_ROWS({ EPI_PACK(w) *(u32x4*)(nsa + (size_t)row * 1152) = w; })
                }
            } else if (hb <= 11) {
                bf16_t* dst = (hb == 9) ? (bf16_t*)(ws + WS_KVL) + cb : (bf16_t*)(ws + WS_QL) + (hb - 10) * 128 + cb;
                const int ld = (hb == 9) ? 128 : 256;
                float* ssq = (hb == 9) ? (float*)(ws + WS_SSKV) : (float*)(ws + WS_SSQL);
                EPI_ROWS({ EPI_PACK(w) *(u32x4*)(dst + (size_t)row * ld) = w;
                    float sq = 0.f;
                    _Pragma("unroll") for (int i = 0; i < 8; ++i) sq += v[i] * v[i];
                    sq += sxf<16>(sq); sq = red32_sum(sq);
                    if (fq == 0) atomicAdd(ssq + row, sq); })
            } else if (hb <= 17) {
                bf16_t* cm = (bf16_t*)(ws + WS_CM) + (hb - 12) * 128 + cb;
                EPI_ROWS({ EPI_PACK(w) *(u32x4*)(cm + (size_t)row * 768) = w; })
            } else if (hb == 18) {
                float* mr = (float*)(ws + WS_MISCRAW) + cb;
                if (wc < 2) { EPI_ROWS({ *(f32x4*)(mr + (size_t)row * 64) = (f32x4){v[0], v[1], v[2], v[3]}; *(f32x4*)(mr + (size_t)row * 64 + 4) = (f32x4){v[4], v[5], v[6], v[7]}; }) }
            }
        }
    }
#undef EPI_ROWS
#undef EPI_PACK
};
struct EpiUKV {
    static constexpr bool PERM = true, AFTER_DRAIN = false;
    bf16_t* kvm; const float* sskv;
    __device__ __forceinline__ void operator()(const f32x4 (&acc)[2][2][4][2], const Unit& u, int wr, int wc, int fr, int fq) const {
        asm volatile("" : "+v"(fq), "+v"(fr));
        const int col0 = u.pn * BM + wc * 32 + 8 * fq;
#pragma unroll
        for (int ai = 0; ai < 2; ++ai)
#pragma unroll
            for (int m = 0; m < 4; ++m) { const int row = u.pm * BM + ai * HALF + wr * 64 + m * 16 + fr; bf16_t* rowp = kvm + (size_t)row * 768 + col0;
                const float rs = rsqrtf(sskv[row] * (1.f / 128.f) + EPS);
#pragma unroll
                for (int bj = 0; bj < 2; ++bj) { const f32x4 a = acc[ai][bj][m][0] * rs, b = acc[ai][bj][m][1] * rs;
                    u32x4 w; w.x = cvt_pk_bf16(a[0], a[1]); w.y = cvt_pk_bf16(a[2], a[3]); w.z = cvt_pk_bf16(b[0], b[1]); w.w = cvt_pk_bf16(b[2], b[3]);
                    *(u32x4*)(rowp + bj * HALF) = w; }
                asm volatile("" ::: "memory"); }
    }
};
struct EpiPlain {
    static constexpr bool PERM = true, AFTER_DRAIN = false;
    bf16_t* out; int ld;
    __device__ __forceinline__ void operator()(const f32x4 (&acc)[2][2][4][2], const Unit& u, int wr, int wc, int fr, int fq) const {
        asm volatile("" : "+v"(fq), "+v"(fr));
        const int col0 = u.pn * BM + wc * 32 + 8 * fq;
#pragma unroll
        for (int ai = 0; ai < 2; ++ai)
#pragma unroll
            for (int m = 0; m < 4; ++m) { bf16_t* rowp = out + (size_t)(u.pm * BM + ai * HALF + wr * 64 + m * 16 + fr) * ld + col0;
#pragma unroll
                for (int bj = 0; bj < 2; ++bj) { const f32x4 a = acc[ai][bj][m][0], b = acc[ai][bj][m][1];
                    u32x4 w; w.x = cvt_pk_bf16(a[0], a[1]); w.y = cvt_pk_bf16(a[2], a[3]); w.z = cvt_pk_bf16(b[0], b[1]); w.w = cvt_pk_bf16(b[2], b[3]);
                    *(u32x4*)(rowp + bj * HALF) = w; } }
    }
};
struct EpiRes {
    static constexpr bool PERM = false, AFTER_DRAIN = false;
    const float* xin; float* xout; const float* gate;
    __device__ __forceinline__ void operator()(const f32x4 (&acc)[2][2][4][2], const Unit& u, int wr, int wc, int fr, int fq) const {
        asm volatile("" : "+v"(fq), "+v"(fr));
        const int b = (u.pm * BM) / S_; const int col0 = u.pn * BM + wc * 32 + 4 * fq;
        f32x4 gv[2][2];
#pragma unroll
        for (int bj = 0; bj < 2; ++bj)
#pragma unroll
            for (int n = 0; n < 2; ++n) gv[bj][n] = *(const f32x4*)(gate + (size_t)b * 6144 + col0 + bj * HALF + n * 16);
#pragma unroll
        for (int ai = 0; ai < 2; ++ai)
#pragma unroll
            for (int m = 0; m < 4; ++m) { const size_t off = (size_t)(u.pm * BM + ai * HALF + wr * 64 + m * 16 + fr) * D_ + col0;
#pragma unroll
                for (int bj = 0; bj < 2; ++bj)
#pragma unroll
                    for (int n = 0; n < 2; ++n) { const f32x4 xi = *(const f32x4*)(xin + off + bj * HALF + n * 16); *(f32x4*)(xout + off + bj * HALF + n * 16) = xi + gv[bj][n] * acc[ai][bj][m][n]; } }
    }
};
struct EpiGU {
    static constexpr bool PERM = true, AFTER_DRAIN = false;
    bf16_t* act;
    __device__ __forceinline__ void operator()(const f32x4 (&acc)[2][2][4][2], const Unit& u, int wr, int wc, int fr, int fq) const {
        asm volatile("" : "+v"(fq), "+v"(fr));
        const int col0 = u.pn * HALF + wc * 32 + 8 * fq;
#pragma unroll
        for (int ai = 0; ai < 2; ++ai)
#pragma unroll
            for (int m = 0; m < 4; ++m) { const int row = u.pm * BM + ai * HALF + wr * 64 + m * 16 + fr; float o[8];
#pragma unroll
                for (int n = 0; n < 2; ++n)
#pragma unroll
                    for (int i = 0; i < 4; ++i) { const float g = acc[ai][0][m][n][i], up = acc[ai][1][m][n][i]; o[4 * n + i] = g / (1.f + __expf(-g)) * up; }
                u32x4 w; w.x = cvt_pk_bf16(o[0], o[1]); w.y = cvt_pk_bf16(o[2], o[3]); w.z = cvt_pk_bf16(o[4], o[5]); w.w = cvt_pk_bf16(o[6], o[7]);
                *(u32x4*)(act + (size_t)row * FF + col0) = w; }
    }
};
template <class Epi, class Sched, bool ALIGN_EPI = false, bool SP2 = false>
__device__ __forceinline__ void gemm_phase(PG8_LAS unsigned char* lds, const Gemm g, const Sched& S, const Epi& E, int wid_in) {
    const int wid = __builtin_amdgcn_readfirstlane(wid_in), lane = fresh_lane(), tid = wid * 64 + lane, wr = wid >> 2, wc = wid & 3;
    const int K = g.K, nt = K / BK;
    unsigned voffA[2], voffB[2];
#pragma unroll
    for (int i = 0; i < 2; ++i) { int R, C; stage_rc(tid * 16 + i * 8192, R, C); const int Rb = Epi::PERM ? ((R & ~31) + perm32(R & 31)) : R;
        voffA[i] = (unsigned)(R * K + C) * 2u; voffB[i] = (unsigned)(Rb * K + C) * 2u; }
    const size_t kstep = (size_t)(BK * 2);
    const size_t hstep = (size_t)HALF * K * 2;
    const size_t tstep = 2 * hstep;
    const unsigned ldsw = (unsigned)wid * 1024u;
    const int aoff = lds_byte(wr * 64 + (lane & 15), (lane >> 4) * 8), boff = lds_byte(wc * 32 + (lane & 15), (lane >> 4) * 8);
#define PG8_SA(b, h) (((b) * 2 + (h)) * HTB)
#define PG8_SB(b, h) ((4 + (b) * 2 + (h)) * HTB)
#define PG8_STAGE(bufoff, gbase, voff) do { _Pragma("unroll") for (int _i = 0; _i < 2; ++_i) \
        __builtin_amdgcn_global_load_lds((const unsigned*)((const char*)(gbase) + (voff)[_i]), (PG8_LAS unsigned*)(lds + (bufoff) + ldsw + _i * 8192), 16, 0, 0); } while (0)
#define PG8_LDA(dst, b, h) do { _Pragma("unroll") for (int m = 0; m < 4; ++m) _Pragma("unroll") for (int k = 0; k < 2; ++k) dst[m][k] = *(const PG8_LAS bf16x8*)(lds + PG8_SA(b, h) + aoff + m * 2048 + k * 1024); } while (0)
#define PG8_LDB(dst, b, h) do { _Pragma("unroll") for (int n = 0; n < 2; ++n) _Pragma("unroll") for (int k = 0; k < 2; ++k) dst[n][k] = *(const PG8_LAS bf16x8*)(lds + PG8_SB(b, h) + boff + n * 2048 + k * 1024); } while (0)
#define PG8_MMA(ai, bj, At, Bt) do { __builtin_amdgcn_s_setprio(1); _Pragma("unroll") for (int m = 0; m < 4; ++m) _Pragma("unroll") for (int n = 0; n < 2; ++n) _Pragma("unroll") for (int k = 0; k < 2; ++k) \
        acc[ai][bj][m][n] = __builtin_amdgcn_mfma_f32_16x16x32_bf16(Bt[n][k], At[m][k], acc[ai][bj][m][n], 0, 0, 0); __builtin_amdgcn_s_setprio(0); } while (0)
#define PG8_WAIT_V(n) asm volatile("s_waitcnt vmcnt(" #n ")" ::: "memory")
#define PG8_WAIT_L(n) asm volatile("s_waitcnt lgkmcnt(" #n ")" ::: "memory")
#define PG8_BAR __builtin_amdgcn_s_barrier()
#define PG8_SCHED __builtin_amdgcn_sched_barrier(0)
    Unit cur, nxt; int ui = 0;
    if (!S.next(0, cur)) return;
    f32x4 acc[2][2][4][2];
#pragma unroll
    for (int a = 0; a < 2; ++a)
#pragma unroll
        for (int b = 0; b < 2; ++b)
#pragma unroll
            for (int m = 0; m < 4; ++m)
#pragma unroll
                for (int n = 0; n < 2; ++n) acc[a][b][m][n] = (f32x4){0.f, 0.f, 0.f, 0.f};
    bf16x8 At[4][2], B0[2][2], B1[2][2];
    const char* cA = (const char*)g.A + (size_t)cur.pm * tstep; const char* cB = (const char*)g.Bt + (size_t)cur.pn * tstep;
    S.a_ready(cur);
    if constexpr (SP2) {
        PG8_STAGE(PG8_SB(0, 0), cB, voffB); PG8_STAGE(PG8_SB(0, 1), cB + hstep, voffB); PG8_STAGE(PG8_SA(0, 0), cA, voffA); PG8_STAGE(PG8_SA(0, 1), cA + hstep, voffA);
        if (wr == 1) PG8_BAR;
        PG8_WAIT_V(2); PG8_BAR;
        PG8_STAGE(PG8_SB(1, 0), cB + kstep, voffB); PG8_STAGE(PG8_SA(1, 0), cA + kstep, voffA); PG8_STAGE(PG8_SB(1, 1), cB + hstep + kstep, voffB);
        PG8_WAIT_V(6); PG8_BAR;
    } else {
        PG8_STAGE(PG8_SB(0, 0), cB, voffB); PG8_STAGE(PG8_SA(0, 0), cA, voffA); PG8_STAGE(PG8_SB(0, 1), cB + hstep, voffB); PG8_STAGE(PG8_SA(0, 1), cA + hstep, voffA);
        if (wr == 1) PG8_BAR;
        PG8_WAIT_V(4); PG8_BAR;
        PG8_STAGE(PG8_SB(1, 0), cB + kstep, voffB); PG8_STAGE(PG8_SA(1, 0), cA + kstep, voffA); PG8_STAGE(PG8_SB(1, 1), cB + hstep + kstep, voffB);
        PG8_WAIT_V(6); PG8_BAR;
    }
    for (;;) {
        const bool has_next = S.next(ui + 1, nxt);
        const char* nA = has_next ? (const char*)g.A + (size_t)nxt.pm * tstep : cA; const char* nB = has_next ? (const char*)g.Bt + (size_t)nxt.pn * tstep : cB;
        for (int t = 0; t < nt; t += 2) {
            const bool last = (t == nt - 2);
            const char* a1 = cA + (size_t)(t + 1) * kstep;
            const char* a2 = last ? nA : cA + (size_t)(t + 2) * kstep; const char* b2 = last ? nB : cB + (size_t)(t + 2) * kstep;
            const char* a3 = a2 + kstep; const char* b3 = b2 + kstep;
            if (last && has_next) S.a_ready(nxt);
            if constexpr (SP2) {
            PG8_LDB(B0, 0, 0); PG8_LDB(B1, 0, 1); PG8_SCHED; PG8_LDA(At, 0, 0); PG8_STAGE(PG8_SA(1, 1), a1 + hstep, voffA);
            PG8_WAIT_V(8); PG8_WAIT_L(0); PG8_BAR; PG8_MMA(0, 0, At, B0); PG8_MMA(0, 1, At, B1); PG8_BAR; PG8_SCHED;
            PG8_LDA(At, 0, 1); PG8_STAGE(PG8_SB(0, 0), b2, voffB); PG8_STAGE(PG8_SB(0, 1), b2 + hstep, voffB); PG8_STAGE(PG8_SA(0, 0), a2, voffA);
            PG8_WAIT_V(8); PG8_WAIT_L(0); PG8_BAR; PG8_MMA(1, 0, At, B0); PG8_MMA(1, 1, At, B1); PG8_BAR; PG8_SCHED;
            PG8_LDB(B0, 1, 0); PG8_LDB(B1, 1, 1); PG8_SCHED; PG8_LDA(At, 1, 0); PG8_STAGE(PG8_SA(0, 1), a2 + hstep, voffA);
            PG8_WAIT_V(8); PG8_WAIT_L(0); PG8_BAR; PG8_MMA(0, 0, At, B0); PG8_MMA(0, 1, At, B1); PG8_BAR; PG8_SCHED;
            PG8_LDA(At, 1, 1); PG8_STAGE(PG8_SB(1, 0), b3, voffB); PG8_STAGE(PG8_SB(1, 1), b3 + hstep, voffB); PG8_STAGE(PG8_SA(1, 0), a3, voffA);
            PG8_WAIT_V(8); PG8_WAIT_L(0); PG8_BAR; PG8_MMA(1, 0, At, B0); PG8_MMA(1, 1, At, B1); PG8_BAR; PG8_SCHED;
            } else {
            PG8_LDB(B0, 0, 0); PG8_SCHED; PG8_LDA(At, 0, 0); PG8_STAGE(PG8_SA(1, 1), a1 + hstep, voffA);
            PG8_WAIT_L(8); PG8_BAR; PG8_WAIT_L(0); PG8_MMA(0, 0, At, B0); PG8_BAR; PG8_SCHED;
            PG8_LDB(B1, 0, 1); PG8_STAGE(PG8_SB(0, 0), b2, voffB);
            PG8_BAR; PG8_WAIT_L(0); PG8_MMA(0, 1, At, B1); PG8_BAR;
            PG8_LDA(At, 0, 1); PG8_STAGE(PG8_SA(0, 0), a2, voffA);
            PG8_BAR; PG8_WAIT_L(0); PG8_MMA(1, 0, At, B0); PG8_BAR; PG8_SCHED;
            PG8_STAGE(PG8_SB(0, 1), b2 + hstep, voffB);
            PG8_WAIT_V(6); PG8_BAR; PG8_MMA(1, 1, At, B1); PG8_BAR;
            PG8_LDB(B0, 1, 0); PG8_SCHED; PG8_LDA(At, 1, 0); PG8_STAGE(PG8_SA(0, 1), a2 + hstep, voffA);
            PG8_WAIT_L(8); PG8_BAR; PG8_WAIT_L(0); PG8_MMA(0, 0, At, B0); PG8_BAR; PG8_SCHED;
            PG8_LDB(B1, 1, 1); PG8_STAGE(PG8_SB(1, 0), b3, voffB);
            PG8_BAR; PG8_WAIT_L(0); PG8_MMA(0, 1, At, B1); PG8_BAR;
            PG8_LDA(At, 1, 1); PG8_STAGE(PG8_SA(1, 0), a3, voffA);
            PG8_BAR; PG8_WAIT_L(0); PG8_MMA(1, 0, At, B0); PG8_BAR; PG8_SCHED;
            PG8_STAGE(PG8_SB(1, 1), b3 + hstep, voffB);
            PG8_WAIT_V(6); PG8_BAR; PG8_MMA(1, 1, At, B1); PG8_BAR;
            }
        }
        if constexpr (ALIGN_EPI) { if (wr == 0) PG8_BAR; }
        if constexpr (!Epi::AFTER_DRAIN) { const int ln = fresh_lane(); E(acc, cur, wr, wc, ln & 15, ln >> 4); S.done(cur); }
        if (!has_next) break;
#pragma unroll
        for (int a = 0; a < 2; ++a)
#pragma unroll
            for (int b = 0; b < 2; ++b)
#pragma unroll
                for (int m = 0; m < 4; ++m)
#pragma unroll
                    for (int n = 0; n < 2; ++n) acc[a][b][m][n] = (f32x4){0.f, 0.f, 0.f, 0.f};
        cur = nxt; cA = nA; cB = nB; ++ui;
        if constexpr (ALIGN_EPI) { if (wr == 1) PG8_BAR; }
    }
    PG8_WAIT_V(0);
    if constexpr (!ALIGN_EPI) { if (wr == 0) PG8_BAR; }
    PG8_BAR;
    if constexpr (Epi::AFTER_DRAIN) { const int ln = fresh_lane(); E.fused(acc, cur, wr, wc, ln & 15, ln >> 4, lds, wid, ln); S.done(cur); }
#undef PG8_SA
#undef PG8_SB
#undef PG8_STAGE
#undef PG8_LDA
#undef PG8_LDB
#undef PG8_MMA
#undef PG8_WAIT_V
#undef PG8_WAIT_L
#undef PG8_BAR
#undef PG8_SCHED
}
}

#define GAS __attribute__((address_space(1)))
#define LAS __attribute__((address_space(3)))
typedef float f32x4 __attribute__((ext_vector_type(4)));
typedef unsigned v4u __attribute__((ext_vector_type(4)));
typedef GAS unsigned gu32;
#define XB_TMO      128
#define XB_XCNT(j)  (256  + 64 * (j))
#define XB_XSUB(j)  (1280 + 64 * (j))
#define XB_XGEN(j)  (2304 + 64 * (j))
#define XB_TOP      3328
#define XB_TOPGEN   3392
#define XCD_BAR_WORDS 3456
#define XB_SPIN_CAP (1u << 18)

__device__ __forceinline__ unsigned xb_ld(unsigned* p)              { return __hip_atomic_load(p, __ATOMIC_RELAXED, __HIP_MEMORY_SCOPE_AGENT); }
__device__ __forceinline__ unsigned xb_add(unsigned* p, unsigned v) { return __hip_atomic_fetch_add(p, v, __ATOMIC_RELAXED, __HIP_MEMORY_SCOPE_AGENT); }
__device__ __forceinline__ unsigned xb_xcc_id() { return (unsigned)__builtin_amdgcn_s_getreg((3 << 11) | 20) & 0xFu; }
#define XB_SPIN(cond, bar) do { unsigned _sp = 0; while (cond) { __builtin_amdgcn_s_sleep(1); \
    if ((++_sp & 255u) == 0u) { if (xb_ld(&(bar)[XB_TMO])) break; if (_sp > XB_SPIN_CAP) { atomicAdd(&(bar)[XB_TMO], 1u); break; } } } } while (0)

struct XcdBarrier {
    unsigned* bar; unsigned x;
    volatile LAS unsigned* st;
};

__device__ __forceinline__ XcdBarrier xcd_barrier_post(unsigned* bar, volatile LAS unsigned* st, int tid) {
    XcdBarrier b; b.bar = bar; b.x = xb_xcc_id(); b.st = st;
    if (tid == 0) (void)xb_add(&bar[XB_XCNT(b.x)], 1u);
    return b;
}
__device__ __forceinline__ void xcd_barrier_complete(unsigned* bar, unsigned x, unsigned& nloc, unsigned& nx) {
    const unsigned G = gridDim.x * gridDim.y * gridDim.z;
    unsigned sum, cnt, mine, sp = 0u;
    for (;;) {
        sum = 0u; cnt = 0u; mine = 0u;
#pragma unroll
        for (unsigned j = 0; j < 16; ++j) { const unsigned c = xb_ld(&bar[XB_XCNT(j)]); sum += c; cnt += (c > 0u) ? 1u : 0u; mine = (j == x) ? c : mine; }
        if (sum == G) break;
        __builtin_amdgcn_s_sleep(1);
        if ((++sp & 255u) == 0u) { if (xb_ld(&bar[XB_TMO])) break; if (sp > XB_SPIN_CAP) { atomicAdd(&bar[XB_TMO], 1u); break; } }
    }
    nloc = mine > 0u ? mine : 1u; nx = cnt > 0u ? cnt : 1u;
}

__device__ __forceinline__ void xcd_barrier(const XcdBarrier& b, int tid) {
    asm volatile("s_waitcnt vmcnt(0)" ::: "memory");
    __syncthreads();
    if (tid == 0) {
        unsigned* bar = b.bar;
        __builtin_amdgcn_s_waitcnt(0);
        unsigned nloc = b.st[0], nx = b.st[1];
        if (nloc == 0u) { xcd_barrier_complete(bar, b.x, nloc, nx); b.st[0] = nloc; b.st[1] = nx; }
        const unsigned old = xb_add(&bar[XB_XSUB(b.x)], 1u);
        const unsigned gen = old / nloc;
        if (old + 1u == (gen + 1u) * nloc) {
            __builtin_amdgcn_fence(__ATOMIC_RELEASE, "agent");
            asm volatile("s_waitcnt vmcnt(0)" ::: "memory");
            const unsigned og = xb_add(&bar[XB_TOP], 1u);
            const unsigned tg = og / nx;
            if (og + 1u == (tg + 1u) * nx) xb_add(&bar[XB_TOPGEN], 1u);
            else XB_SPIN(xb_ld(&bar[XB_TOPGEN]) == tg, bar);
            __builtin_amdgcn_fence(__ATOMIC_ACQUIRE, "agent");
            xb_add(&bar[XB_XGEN(b.x)], 1u);
            asm volatile("s_waitcnt vmcnt(0)" ::: "memory");
        } else {
            XB_SPIN(xb_ld(&bar[XB_XGEN(b.x)]) == gen, bar);
            __builtin_amdgcn_fence(__ATOMIC_ACQUIRE, "agent");
            asm volatile("s_waitcnt vmcnt(0)" ::: "memory");
        }
    }
    __syncthreads();
}

constexpr int NTHR = 512, NWAVES = 8;
constexpr int RING_BYTES = 131072, MISC_OFF = RING_BYTES + 320, LDS_BYTES = 147456;
constexpr int CW_BAR = 4096;
constexpr size_t CTL_ZERO_BYTES = 64 * 1024;
constexpr size_t WT_IN = WS_WT, WT_OUT = WT_IN + (size_t)2560 * 1024 * 2, WT_GU = WT_OUT + (size_t)1024 * 1024 * 2, WT_DOWN = WT_GU + (size_t)5632 * 1024 * 2,
                 WT_UQ = WT_DOWN + (size_t)1024 * 2816 * 2, WT_UKV = WT_UQ + (size_t)768 * 256 * 2, WT_CK = WT_UKV + (size_t)768 * 128 * 2, WT_CV = WT_CK + (size_t)64 * 2048 * 2,
                 WT_QM = WT_CV + (size_t)64 * 2048 * 2, WT_KM = WT_QM + 4 * 64 * 64 * 2, WT_END = WT_KM + 4 * 64 * 64 * 2;
static_assert(WT_END <= WS_HB, "weights");
constexpr int NPH = 22, PPL = 10;
constexpr int PROBE_SEL = 0;
constexpr int REP_MASK = 0;
#ifndef PHM
#define PHM 0xffff
#endif
struct MP { const float* in[N_IN]; float* out; unsigned char* ws; int ph_lo, ph_hi, coop, pad; };

struct MPK {
    const __attribute__((address_space(4))) MP* k;
    struct InArr { const __attribute__((address_space(4))) MP* k; __device__ __forceinline__ const float* operator[](int i) const { return k->in[i]; } };
    __device__ __forceinline__ InArr in_() const { return InArr{k}; }
};
#define PIN(i) (p.k->in[i])
__device__ __forceinline__ unsigned pk2(float lo, float hi) { return (unsigned)f2bf(lo) | ((unsigned)f2bf(hi) << 16); }
struct MapId { int n; __device__ __forceinline__ int operator()(int c) const { return c < n ? c : -1; } };
struct MapIn { __device__ __forceinline__ int operator()(int c) const {
    if (c < 1152) return c; if (c < 1280) return 1426 + (c - 1152); if (c < 1536) return 1170 + (c - 1280); if (c < 2304) return 1586 + (c - 1536);
    if (c < 2336) return 1554 + (c - 2304); if (c < 2354) return 1152 + (c - 2336); if (c < 2362) return c; return -1; } };
struct MapGU { __device__ __forceinline__ int operator()(int c) const { const int t = c >> 8, w = c & 255; return (w < 128) ? t * 128 + w : FF + t * 128 + (w - 128); } };
template <class Map> __device__ __forceinline__ void transpose_item(const float* W, int K, int ldw, const Map& map, const float* kscale, bf16* WT, LAS float* scr, int item, int nblk, int lane) {
    const int kb = item / nblk, nb = item % nblk, k0 = 64 * kb, n0 = 32 * nb;
    const int np = 2 * (lane & 15);
    const int sc = map(n0 + np);
#pragma unroll 8
    for (int i = 0; i < 16; ++i) { const int kk = 4 * i + (lane >> 4); float2 v = (sc >= 0) ? *(const float2*)(W + (size_t)(k0 + kk) * ldw + sc) : make_float2(0.f, 0.f);
        if (kscale) { const float ksc = kscale[k0 + kk]; v.x *= ksc; v.y *= ksc; } scr[kk * 33 + np] = v.x; scr[kk * 33 + np + 1] = v.y; }
    asm volatile("s_waitcnt lgkmcnt(0)" ::: "memory");
    const int c = lane & 7;
#pragma unroll
    for (int j = 0; j < 4; ++j) { const int n = (lane >> 3) + 8 * j; const LAS float* s = scr + (8 * c) * 33 + n;
        v4u o; o.x = pk2(s[0 * 33], s[1 * 33]); o.y = pk2(s[2 * 33], s[3 * 33]); o.z = pk2(s[4 * 33], s[5 * 33]); o.w = pk2(s[6 * 33], s[7 * 33]);
        *(v4u*)(WT + (size_t)(n0 + n) * K + k0 + 8 * c) = o; }
    asm volatile("s_waitcnt lgkmcnt(0)" ::: "memory");
}
__device__ __forceinline__ void norm_row_finish(const float4 (&v)[4], float ssq, const float* g, const float* shift, const float* scale, bf16* hb, float* outf, int mode, int m, int lane) {
    const float rstd = rsqrtf(ssq * (1.f / D_) + EPS);
    const int b = m / S_;
#pragma unroll
    for (int j = 0; j < 4; ++j) {
        const int col = 4 * lane + 256 * j;
        const float4 gg = *(const float4*)(g + col);
        float4 o; o.x = v[j].x * rstd * gg.x; o.y = v[j].y * rstd * gg.y; o.z = v[j].z * rstd * gg.z; o.w = v[j].w * rstd * gg.w;
        if (mode == 2) { *(float4*)(outf + (size_t)m * D_ + col) = o; }
        else {
            const float4 sc = *(const float4*)(scale + (size_t)b * 6144 + col), sh = *(const float4*)(shift + (size_t)b * 6144 + col);
            o.x = o.x * (1.f + sc.x) + sh.x; o.y = o.y * (1.f + sc.y) + sh.y; o.z = o.z * (1.f + sc.z) + sh.z; o.w = o.w * (1.f + sc.w) + sh.w;
            uint2 w; w.x = pk2(o.x, o.y); w.y = pk2(o.z, o.w);
            *(uint2*)(hb + (size_t)m * D_ + col) = w;
        }
    }
}
__device__ __forceinline__ void norm_rows(const float* x, const float* g, const float* shift, const float* scale, bf16* hb, float* outf, int mode, int gw, int ngw, int lane) {
    for (int m = gw; m < T_; m += 2 * ngw) {
        const int m2 = m + ngw;
        const float4* xr = (const float4*)(x + (size_t)m * D_) + lane; const float4* xr2 = (const float4*)(x + (size_t)m2 * D_) + lane;
        float4 v[4], w[4]; float s = 0.f, s2 = 0.f;
#pragma unroll
        for (int j = 0; j < 4; ++j) { v[j] = xr[64 * j]; w[j] = xr2[64 * j]; }
#pragma unroll
        for (int j = 0; j < 4; ++j) { s += v[j].x * v[j].x + v[j].y * v[j].y + v[j].z * v[j].z + v[j].w * v[j].w; s2 += w[j].x * w[j].x + w[j].y * w[j].y + w[j].z * w[j].z + w[j].w * w[j].w; }
        norm_row_finish(v, wave_sum2(s), g, shift, scale, hb, outf, mode, m, lane);
        norm_row_finish(w, wave_sum2(s2), g, shift, scale, hb, outf, mode, m2, lane);
    }
}
__device__ __forceinline__ void ph_p0(const MPK& p, LAS unsigned char* lds, int tid) {
    const int wave = tid >> 6, lane = tid & 63;
    LAS float* ca = (LAS float*)lds; LAS float* red = ca + 8192;
    unsigned char* ws = p.k->ws; float* mod = (float*)(ws + WS_MOD);
    const float* c = PIN(I_C);
    for (int i = tid; i < 8192; i += NTHR) ca[i] = siluf_(c[i]);
    __syncthreads();
    for (int item = blockIdx.x; item < 192; item += gridDim.x) {
        const int l = item / 96, j = (item % 96) * 64 + lane;
        const float* w = PIN(I_WADA) + (size_t)l * 1024 * 6144 + j;
        float acc[8];
#pragma unroll
        for (int b = 0; b < 8; ++b) acc[b] = 0.f;
#pragma unroll 4
        for (int k = wave * 128; k < wave * 128 + 128; ++k) {
            const float wv = w[(size_t)k * 6144];
#pragma unroll
            for (int b = 0; b < 8; ++b) acc[b] += ca[b * 1024 + k] * wv;
        }
#pragma unroll
        for (int b = 0; b < 8; ++b) red[(wave * 8 + b) * 64 + lane] = acc[b];
        __syncthreads();
        { const int b = wave; float s = 0.f;
#pragma unroll
          for (int w8 = 0; w8 < 8; ++w8) s += red[(w8 * 8 + b) * 64 + lane];
          mod[((size_t)l * 8 + b) * 6144 + j] = s + PIN(I_BADA)[l * 6144 + j]; }
        __syncthreads();
    }
    const int* pos = (const int*)PIN(I_POS);
    float *cosP = (float*)(ws + WS_COSP), *sinP = (float*)(ws + WS_SINP), *cosM = (float*)(ws + WS_COSM), *sinM = (float*)(ws + WS_SINM);
    for (int i = blockIdx.x * NTHR + tid; i < T_ * 24; i += gridDim.x * NTHR) {
        const int m = i / 24, f = i % 24;
        double inv; if (f < 8) inv = pow(500000.0, -(double)(2 * f) / 16.0); else inv = pow(500000.0, -(double)(2 * (f - 8)) / 32.0);
        const float ang = (float)pos[m] * (float)inv;
        const double a = (double)ang, kq = rint(a * 0.15915494309189535), r = a - kq * 6.283185307179586476925;
        const float cs = (float)cos(r), sn = (float)sin(r);
        if (f < 8) { cosP[m * 8 + f] = cs; sinP[m * 8 + f] = sn; } else { cosM[m * 16 + f - 8] = cs; sinM[m * 16 + f - 8] = sn; }
    }
}
__device__ __forceinline__ void ph_prep(const MPK& p, int l, LAS unsigned char* lds, int tid) {
    const int wave = tid >> 6, lane = tid & 63;
    const int gw = blockIdx.x * NWAVES + wave, ngw = gridDim.x * NWAVES;
    unsigned char* ws = p.k->ws;
    LAS float* scr = (LAS float*)(lds + wave * 8704);
    for (int i = blockIdx.x * NTHR + tid; i < 2 * T_; i += gridDim.x * NTHR) ((float*)(ws + WS_SSQL))[i] = 0.f;
    constexpr int I0 = 16 * 80, I4 = 4 * 24, I5 = 2 * 24, I6 = 32 * 2, I7 = 32 * 2, I8 = 8, I9 = 8;
    constexpr int NIT = I0 + I4 + I5 + I6 + I7 + I8 + I9;
    for (int it = gw; it < NIT; it += ngw) {
        int r = it;
        if (r < I0) { transpose_item(PIN(I_WIN) + (size_t)l * D_ * DIN, D_, DIN, MapIn{}, nullptr, (bf16*)(ws + WT_IN), scr, r, 80, lane); continue; } r -= I0;
        if (r < I4) { transpose_item(PIN(I_WUQ) + (size_t)l * 256 * 576, 256, 576, MapId{576}, PIN(I_GQL) + l * 256, (bf16*)(ws + WT_UQ), scr, r, 24, lane); continue; } r -= I4;
        if (r < I5) { transpose_item(PIN(I_WUKV) + (size_t)l * 128 * 768, 128, 768, MapId{768}, PIN(I_GKVL) + l * 128, (bf16*)(ws + WT_UKV), scr, r, 24, lane); continue; } r -= I5;
        if (r < I6) { transpose_item(PIN(I_WCK) + (size_t)l * 2048 * 64, 2048, 64, MapId{64}, nullptr, (bf16*)(ws + WT_CK), scr, r, 2, lane); continue; } r -= I6;
        if (r < I7) { transpose_item(PIN(I_WCV) + (size_t)l * 2048 * 64, 2048, 64, MapId{64}, nullptr, (bf16*)(ws + WT_CV), scr, r, 2, lane); continue; } r -= I7;
        if (r < I8) { const int h = r >> 1; transpose_item(PIN(I_WQM) + (size_t)l * 16384 + h * 4096, 64, 64, MapId{64}, nullptr, (bf16*)(ws + WT_QM) + h * 4096, scr, r & 1, 2, lane); continue; } r -= I8;
        { const int h = r >> 1; transpose_item(PIN(I_WKM) + (size_t)l * 16384 + h * 4096, 64, 64, MapId{64}, nullptr, (bf16*)(ws + WT_KM) + h * 4096, scr, r & 1, 2, lane); }
    }
    const float* xin = (l == 0) ? PIN(I_X) : p.k->out;
    const float* modl = (const float*)(ws + WS_MOD) + (size_t)l * 8 * 6144;
    norm_rows(xin, PIN(I_GN1) + l * D_, modl + 0, modl + 1024, (bf16*)(ws + WS_HB), nullptr, 0, gw, ngw, lane);
}
__device__ __forceinline__ void late_transposes(const MPK& p, int l, LAS unsigned char* lds, int tid, int first) {
    const int wave = tid >> 6, lane = tid & 63;
    if ((int)blockIdx.x < first) return;
    const int gw = ((int)blockIdx.x - first) * NWAVES + wave, ngw = ((int)gridDim.x - first) * NWAVES;
    unsigned char* ws = p.k->ws;
    LAS float* scr = (LAS float*)(lds + wave * 8704);
    constexpr int I1 = 16 * 32, I2 = 16 * 176, I3 = 44 * 32;
    for (int it = gw; it < I1 + I2 + I3; it += ngw) {
        int r = it;
        if (r < I1) { transpose_item(PIN(I_WOUT) + (size_t)l * D_ * D_, D_, D_, MapId{D_}, nullptr, (bf16*)(ws + WT_OUT), scr, r, 32, lane); continue; } r -= I1;
        if (r < I2) { transpose_item(PIN(I_WGU) + (size_t)l * D_ * 2 * FF, D_, 2 * FF, MapGU{}, nullptr, (bf16*)(ws + WT_GU), scr, r, 176, lane); continue; } r -= I2;
        transpose_item(PIN(I_WDOWN) + (size_t)l * FF * D_, FF, D_, MapId{D_}, nullptr, (bf16*)(ws + WT_DOWN), scr, r, 32, lane);
    }
}
__device__ __forceinline__ void ph_mixnorm(const MPK& p, int l, int tid) {
    const int gw = blockIdx.x * NWAVES + (tid >> 6), ngw = gridDim.x * NWAVES, lane = tid & 63;
    unsigned char* ws = p.k->ws;
    bf16* mix = (bf16*)(ws + WS_HB); const float* ga = PIN(I_GOA) + l * 384; const float* gb = PIN(I_GOB) + l * 384;
    const bf16 *oc = (const bf16*)(ws + WS_OCMP), *os = (const bf16*)(ws + WS_OSLC), *ow = (const bf16*)(ws + WS_OWIN); const float* gm = (const float*)(ws + WS_GM);
#define UNPK8(dst, src) dst[0] = __uint_as_float(src.x << 16); dst[1] = __uint_as_float(src.x & 0xffff0000u); dst[2] = __uint_as_float(src.y << 16); dst[3] = __uint_as_float(src.y & 0xffff0000u); \
    dst[4] = __uint_as_float(src.z << 16); dst[5] = __uint_as_float(src.z & 0xffff0000u); dst[6] = __uint_as_float(src.w << 16); dst[7] = __uint_as_float(src.w & 0xffff0000u);
    for (int m = gw; m < T_; m += ngw) {
        bf16* r = mix + (size_t)m * D_;
        float v0[8], v1[8]; float sa = 0.f, sb = 0.f;
        if (lane < 48) {
            const size_t o = (size_t)m * 384 + lane * 8; const float* g3 = gm + (size_t)m * 32 + 3 * (lane >> 3);
            const float g0 = g3[0], g1 = g3[1], g2 = g3[2];
            const v4u c4 = *(const v4u*)(oc + o), s4 = *(const v4u*)(os + o), w4 = *(const v4u*)(ow + o);
            float c8[8], s8[8], w8[8]; UNPK8(c8, c4) UNPK8(s8, s4) UNPK8(w8, w4)
#pragma unroll
            for (int i = 0; i < 8; ++i) { v0[i] = g0 * c8[i] + g1 * s8[i] + g2 * w8[i]; sa += v0[i] * v0[i]; }
        } else {
            const v4u y4 = *(const v4u*)(r + 384 + (lane - 48) * 8); UNPK8(v0, y4)
#pragma unroll
            for (int i = 0; i < 8; ++i) sb += v0[i] * v0[i];
        }
        if (lane < 32) { const v4u y4 = *(const v4u*)(r + 384 + (16 + lane) * 8); UNPK8(v1, y4)
#pragma unroll
            for (int i = 0; i < 8; ++i) sb += v1[i] * v1[i]; }
        const float ra = rsqrtf(wave_sum2(sa) * (1.f / 384.f) + EPS), rb = rsqrtf(wave_sum2(sb) * (1.f / 384.f) + EPS);
        {
            const int col = (lane < 48) ? lane * 8 : 384 + (lane - 48) * 8; const float* gg = (lane < 48) ? ga + lane * 8 : gb + (lane - 48) * 8; const float rr = (lane < 48) ? ra : rb;
            const float4 g0 = *(const float4*)gg, g1 = *(const float4*)(gg + 4);
            v4u w; w.x = pk2(v0[0] * rr * g0.x, v0[1] * rr * g0.y); w.y = pk2(v0[2] * rr * g0.z, v0[3] * rr * g0.w); w.z = pk2(v0[4] * rr * g1.x, v0[5] * rr * g1.y); w.w = pk2(v0[6] * rr * g1.z, v0[7] * rr * g1.w);
            *(v4u*)(r + col) = w;
        }
        if (lane < 32) { const float* gg = gb + (16 + lane) * 8; const float4 g0 = *(const float4*)gg, g1 = *(const float4*)(gg + 4);
            v4u w; w.x = pk2(v1[0] * rb * g0.x, v1[1] * rb * g0.y); w.y = pk2(v1[2] * rb * g0.z, v1[3] * rb * g0.w); w.z = pk2(v1[4] * rb * g1.x, v1[5] * rb * g1.y); w.w = pk2(v1[6] * rb * g1.z, v1[7] * rb * g1.w);
            *(v4u*)(r + 384 + (16 + lane) * 8) = w; }
    }
#undef UNPK8
}


typedef short bf16x8 __attribute__((ext_vector_type(8)));
typedef short s16x4 __attribute__((ext_vector_type(4)));
typedef float f32x16 __attribute__((ext_vector_type(16)));
typedef unsigned u32x2v __attribute__((ext_vector_type(2)));
constexpr int AT_BUF = 20480, AT_K32 = 8192, AT_V = 12288;
__device__ __forceinline__ unsigned cvtpk(float lo, float hi) { unsigned r; asm volatile("v_cvt_pk_bf16_f32 %0, %1, %2" : "=v"(r) : "v"(lo), "v"(hi)); return r; }
__device__ __forceinline__ float max3f(float a, float b, float c) { float r; asm("v_max3_f32 %0, %1, %2, %3" : "=v"(r) : "v"(a), "v"(b), "v"(c)); return r; }
__device__ __forceinline__ int crow(int r, int hi) { return (r & 3) + 8 * (r >> 2) + 4 * hi; }
__device__ __forceinline__ s16x4 vtr(LAS const unsigned char* p) { return __builtin_bit_cast(s16x4, __builtin_amdgcn_ds_read_tr16_b64_v4i16((LAS s16x4*)p)); }
enum { AM_CAUSAL = 0, AM_WINDOW = 1, AM_SLC = 2 };
struct AttnState { float m, l; f32x16 o[2]; f32x16 negm; bool started; long long twait; };
template <int NC> struct TileRegs { v4u k; v4u k2; v4u v; };
template <int NC> __device__ __forceinline__ void at_load(TileRegs<NC>& r, const bf16* Kg, int ldk, const bf16* Vg, int ldv, const bf16* K2g, int ldk2, int tile, int tid) {
    const int key = tid >> 3, c = tid & 7;
    r.k = *(const v4u*)(Kg + (size_t)(tile * 64 + key) * ldk + 8 * c);
    r.v = *(const v4u*)(Vg + (size_t)(tile * 64 + key) * ldv + 8 * c);
    if (NC == 6) { if (tid < 256) r.k2 = *(const v4u*)(K2g + (size_t)(tile * 64 + (tid >> 2)) * ldk2 + 8 * (tid & 3)); }
}
template <int NC> __device__ __forceinline__ void at_store(const TileRegs<NC>& r, LAS unsigned char* buf, int tid) {
    const int key = tid >> 3, c = tid & 7;
    *(LAS v4u*)(buf + key * 128 + 16 * (c ^ ((key >> 1) & 7))) = r.k;
    *(LAS v4u*)(buf + AT_V + (c >> 2) * 4096 + key * 64 + (c & 3) * 16) = r.v;
    if (NC == 6) { if (tid < 256) { const int k2 = tid >> 2, c2 = tid & 3; *(LAS v4u*)(buf + AT_K32 + k2 * 64 + 16 * (c2 ^ ((k2 >> 2) & 3))) = r.k2; } }
}
template <int NC> __device__ __forceinline__ void qk_tile(f32x16& p0, f32x16& p1, LAS const unsigned char* buf, const bf16x8 (&qf)[NC], const f32x16& negm, int lane) {
    const int r32 = lane & 31, hi = lane >> 5;
    p0 = negm; p1 = negm;
#pragma unroll
    for (int cc = 0; cc < NC; ++cc) {
        bf16x8 k0, k1;
        if (cc < 4) { const int k0r = r32, k1r = 32 + r32;
            k0 = *(LAS const bf16x8*)(buf + k0r * 128 + 16 * ((2 * cc + hi) ^ ((k0r >> 1) & 7)));
            k1 = *(LAS const bf16x8*)(buf + k1r * 128 + 16 * ((2 * cc + hi) ^ ((k1r >> 1) & 7))); }
        else { const int k0r = r32, k1r = 32 + r32, c2 = 2 * (cc - 4) + hi;
            k0 = *(LAS const bf16x8*)(buf + AT_K32 + k0r * 64 + 16 * (c2 ^ ((k0r >> 2) & 3)));
            k1 = *(LAS const bf16x8*)(buf + AT_K32 + k1r * 64 + 16 * (c2 ^ ((k1r >> 2) & 3))); }
        p0 = __builtin_amdgcn_mfma_f32_32x32x16_bf16(k0, qf[cc], p0, 0, 0, 0);
        p1 = __builtin_amdgcn_mfma_f32_32x32x16_bf16(k1, qf[cc], p1, 0, 0, 0);
    }
}
template <int MODE> __device__ __forceinline__ void softmax_tile(AttnState& st, f32x16& p0, f32x16& p1, bf16x8 (&pf)[4], int kpos0, int qpos, bool need_mask, bool sel_ok, int lane) {
    const int hi = lane >> 5;
    if (need_mask) {
        const int qw0m = __builtin_amdgcn_readfirstlane(qpos) & ~31;
        const bool diag = (kpos0 + 63 > qw0m), old = (MODE == AM_WINDOW) && (kpos0 < qw0m + 31 - 511);
        if (diag || old) {
            const float selterm = (MODE == AM_SLC && !sel_ok) ? -INFINITY : INFINITY;
            const int dbase = qpos - kpos0 - 4 * hi;
#pragma unroll
            for (int r = 0; r < 16; ++r) {
                const int d0 = dbase - ((r & 3) + 8 * (r >> 2)), d1 = d0 - 32;
                float l0 = ((float)d0 + 0.5f) * INFINITY, l1 = ((float)d1 + 0.5f) * INFINITY;
                if (MODE == AM_WINDOW) { l0 = fminf(l0, ((float)(511 - d0) + 0.5f) * INFINITY); l1 = fminf(l1, ((float)(511 - d1) + 0.5f) * INFINITY); }
                if (MODE == AM_SLC) { l0 = fminf(l0, selterm); l1 = fminf(l1, selterm); }
                p0[r] = fminf(p0[r], l0); p1[r] = fminf(p1[r], l1);
            }
        } else if (MODE == AM_SLC) {
            const float selterm = sel_ok ? INFINITY : -INFINITY;
#pragma unroll
            for (int r = 0; r < 16; ++r) { p0[r] = fminf(p0[r], selterm); p1[r] = fminf(p1[r], selterm); }
        }
    }
    float mx = max3f(p0[0], p1[0], p0[1]), mx2 = max3f(p1[1], p0[2], p1[2]);
#pragma unroll
    for (int r = 3; r < 15; r += 2) { mx = max3f(mx, p0[r], p1[r]); mx2 = max3f(mx2, p0[r + 1], p1[r + 1]); }
    mx = max3f(mx, p0[15], p1[15]); mx = max3f(mx, mx2, mx2);
    mx = red32_max(mx);
    if (!st.started || __any(mx > 0.f)) {
        float dl = st.started ? fmaxf(mx, 0.f) : mx;
        dl = (dl > -1e30f) ? dl : 0.f;
        st.started = true;
        const float alpha = __builtin_amdgcn_exp2f(-dl);
        st.m += dl; st.l *= alpha;
#pragma unroll
        for (int r = 0; r < 16; ++r) { st.o[0][r] *= alpha; st.o[1][r] *= alpha; p0[r] -= dl; p1[r] -= dl; st.negm[r] = -st.m; }
    }
    float sum = 0.f;
#pragma unroll
    for (int r = 0; r < 16; ++r) { p0[r] = __builtin_amdgcn_exp2f(p0[r]); p1[r] = __builtin_amdgcn_exp2f(p1[r]); sum += p0[r] + p1[r]; }
    st.l += sum;
#pragma unroll
    for (int s2 = 0; s2 < 2; ++s2) {
        v4u a, b;
        a.x = cvtpk(p0[8 * s2 + 0], p0[8 * s2 + 1]); a.y = cvtpk(p0[8 * s2 + 2], p0[8 * s2 + 3]); a.z = cvtpk(p0[8 * s2 + 4], p0[8 * s2 + 5]); a.w = cvtpk(p0[8 * s2 + 6], p0[8 * s2 + 7]);
        b.x = cvtpk(p1[8 * s2 + 0], p1[8 * s2 + 1]); b.y = cvtpk(p1[8 * s2 + 2], p1[8 * s2 + 3]); b.z = cvtpk(p1[8 * s2 + 4], p1[8 * s2 + 5]); b.w = cvtpk(p1[8 * s2 + 6], p1[8 * s2 + 7]);
        pf[s2] = __builtin_bit_cast(bf16x8, a); pf[2 + s2] = __builtin_bit_cast(bf16x8, b);
    }
}
__device__ __forceinline__ void pv_tile(AttnState& st, LAS const unsigned char* buf, const bf16x8 (&pf)[4], int lane) {
    const int hi = lane >> 5;
    const unsigned vb = (unsigned)(uintptr_t)(buf + AT_V + (4 * hi + ((lane & 15) >> 2)) * 64 + ((lane >> 4) & 1) * 32 + (lane & 3) * 8);
#pragma unroll
    for (int dh = 0; dh < 2; ++dh) {
        s16x4 lo[4], hh[4];
#pragma unroll
        for (int s4 = 0; s4 < 4; ++s4) {
            asm volatile("ds_read_b64_tr_b16 %0, %1 offset:%c2" : "=&v"(lo[s4]) : "v"(vb), "i"(dh * 4096 + s4 * 1024) : "memory");
            asm volatile("ds_read_b64_tr_b16 %0, %1 offset:%c2" : "=&v"(hh[s4]) : "v"(vb), "i"(dh * 4096 + s4 * 1024 + 512) : "memory");
        }
        asm volatile("s_waitcnt lgkmcnt(0)" : "+v"(lo[0]), "+v"(lo[1]), "+v"(lo[2]), "+v"(lo[3]), "+v"(hh[0]), "+v"(hh[1]), "+v"(hh[2]), "+v"(hh[3]) :: "memory");
#pragma unroll
        for (int s4 = 0; s4 < 4; ++s4) {
            const bf16x8 vf = {lo[s4][0], lo[s4][1], lo[s4][2], lo[s4][3], hh[s4][0], hh[s4][1], hh[s4][2], hh[s4][3]};
            st.o[dh] = __builtin_amdgcn_mfma_f32_32x32x16_bf16(vf, pf[s4], st.o[dh], 0, 0, 0);
        }
    }
}
struct TileFlags { bool skip, need_mask, sel_ok; };
template <int MODE> __device__ __forceinline__ TileFlags tile_flags(int t, int qw0, unsigned selbits) {
    const int k0 = t * 64; TileFlags f;
    f.skip = k0 > qw0 + 31; f.need_mask = (k0 + 63 > qw0); f.sel_ok = true;
    if (MODE == AM_WINDOW) { f.skip = f.skip || (k0 + 63 < qw0 - 511); f.need_mask = f.need_mask || (k0 < qw0 + 31 - 511); }
    if (MODE == AM_SLC) { f.sel_ok = (selbits >> t) & 1u; const unsigned long long bal = __ballot(f.sel_ok); f.skip = f.skip || (bal == 0ull); f.need_mask = f.need_mask || (bal != ~0ull); }
    return f;
}
struct DmaOff { unsigned k, v, k2; };
template <int NC> __device__ __forceinline__ DmaOff at_dma_off(int ldk, int ldv, int ldk2, int wave, int lane) {
    const int L = wave * 64 + lane; DmaOff o;
    { const int key = L >> 3, c = (L & 7) ^ ((key >> 1) & 7); o.k = (unsigned)(key * ldk + 8 * c) * 2u; }
    { const int key = (L >> 2) & 63, c = (L >> 8) * 4 + (L & 3); o.v = (unsigned)(key * ldv + 8 * c) * 2u; }
    { const int key = (L >> 2) & 63, c2 = (L & 3) ^ ((key >> 2) & 3); o.k2 = (unsigned)(key * ldk2 + 8 * c2) * 2u; }
    return o;
}
template <int NC> __device__ __forceinline__ void at_dma(const DmaOff& o, const bf16* Kg, int ldk, const bf16* Vg, int ldv, const bf16* K2g, int ldk2, int tile, LAS unsigned char* slot, int wave) {
    __builtin_amdgcn_global_load_lds((const unsigned*)((const char*)(Kg + (size_t)tile * 64 * ldk) + o.k), (LAS unsigned*)(slot + wave * 1024), 16, 0, 0);
    __builtin_amdgcn_global_load_lds((const unsigned*)((const char*)(Vg + (size_t)tile * 64 * ldv) + o.v), (LAS unsigned*)(slot + AT_V + wave * 1024), 16, 0, 0);
    if (NC == 6) { if (wave < 4) __builtin_amdgcn_global_load_lds((const unsigned*)((const char*)(K2g + (size_t)tile * 64 * ldk2) + o.k2), (LAS unsigned*)(slot + AT_K32 + wave * 1024), 16, 0, 0); }
}
__device__ __forceinline__ void at_wait_bar(int keep) {
    if (keep == 0) asm volatile("s_waitcnt vmcnt(0) lgkmcnt(0)" ::: "memory");
    else if (keep == 2) asm volatile("s_waitcnt vmcnt(2) lgkmcnt(0)" ::: "memory");
    else asm volatile("s_waitcnt vmcnt(3) lgkmcnt(0)" ::: "memory");
    __builtin_amdgcn_s_barrier();
    asm volatile("" ::: "memory");
}
template <int NC, int MODE> __device__ __forceinline__ void at_stream(AttnState& st, LAS unsigned char* lds, const bf16* Kg, int ldk, const bf16* Vg, int ldv, const bf16* K2g, int ldk2, int t0, int t1,
                                                                       const bf16x8 (&qf)[NC], int qpos, int qw0, unsigned selbits, int tid) {
    const int lane = tid & 63, wave = __builtin_amdgcn_readfirstlane(tid >> 6), nt = t1 - t0;
    const int nper = (NC == 6 && wave < 4) ? 3 : 2;
    const DmaOff dof = at_dma_off<NC>(ldk, ldv, ldk2, wave, lane);
    at_dma<NC>(dof, Kg, ldk, Vg, ldv, K2g, ldk2, t0, lds, wave);
    if (nt > 1) at_dma<NC>(dof, Kg, ldk, Vg, ldv, K2g, ldk2, t0 + 1, lds + AT_BUF, wave);
    at_wait_bar(nt > 1 ? nper : 0);
    int s0 = 0, s1 = AT_BUF, s2 = 2 * AT_BUF;
    for (int i = 0; i < nt; ++i) {
        const int t = t0 + i; const bool has_2 = (i + 2 < nt);
        if (has_2) at_dma<NC>(dof, Kg, ldk, Vg, ldv, K2g, ldk2, t + 2, lds + s2, wave);
        const TileFlags f = tile_flags<MODE>(t, qw0, selbits);
        if (!f.skip) {
            f32x16 p0, p1; bf16x8 pf[4];
            qk_tile<NC>(p0, p1, lds + s0, qf, st.negm, lane);
            softmax_tile<MODE>(st, p0, p1, pf, t * 64, qpos, f.need_mask, f.sel_ok, lane);
            pv_tile(st, lds + s0, pf, lane);
        }
        { const long long tw0 = (PROBE_SEL != 0) ? (long long)__builtin_amdgcn_s_memtime() : 0ll;
          at_wait_bar(has_2 ? nper : 0);
          if (PROBE_SEL != 0) st.twait += (long long)__builtin_amdgcn_s_memtime() - tw0; }
        const int tmp = s0; s0 = s1; s1 = s2; s2 = tmp;
    }
}
__device__ __forceinline__ int next_item_q(unsigned* ctrs, LAS unsigned char* lds, int wave_u, int count, int q0, int& kstart) {
    const int tid = wave_u * 64 + fresh_lane();
    LAS int* slot = (LAS int*)(lds + RING_BYTES + 64);
    if (tid == 0) {
        int r = -1, k = kstart;
        for (; k < 8; ++k) { const int q = (q0 + k) & 7; const unsigned v = atomicAdd(ctrs + q * 16, 1u); if (v < (unsigned)count) { r = (q << 16) | (int)v; break; } }
        slot[0] = r; slot[1] = k;
    }
    __syncthreads();
    const int v = slot[0]; kstart = slot[1];
    __syncthreads();
    return v;
}
__device__ __forceinline__ void mla_unit(unsigned char* ws, LAS unsigned char* lds, int b, int h, int qt, int wave_u) {
    const int tid = wave_u * 64 + fresh_lane();
    const int lane = tid & 63, wave = tid >> 6, r32 = lane & 31, hi = lane >> 5;
    const int qw0 = qt * 256 + wave * 32, qpos = qw0 + r32; const size_t row = (size_t)b * S_ + qpos;
    const long long tq0 = (PROBE_SEL != 0) ? (long long)__builtin_amdgcn_s_memtime() : 0ll;
    bf16x8 qf[6];
    {
        const bf16* qp = (const bf16*)(ws + WS_OSLC) + row * 768 + h * 96 + 8 * hi;
        v4u raw[6];
#pragma unroll
        for (int cc = 0; cc < 6; ++cc) raw[cc] = *(const v4u*)(qp + 16 * cc);
        float msc = MSCALE; asm volatile("" : "+v"(msc));
        const float rs = rsqrtf(((const float*)(ws + WS_SSQL))[row] * (1.f / 256.f) + EPS) * msc;
        const float* cm_ = (const float*)(ws + WS_COSM) + row * 16 + 8 * hi; const float* sm_ = (const float*)(ws + WS_SINM) + row * 16 + 8 * hi;
#define UNPKQ(dst, src) dst[0] = __uint_as_float(src.x << 16); dst[1] = __uint_as_float(src.x & 0xffff0000u); dst[2] = __uint_as_float(src.y << 16); dst[3] = __uint_as_float(src.y & 0xffff0000u); \
        dst[4] = __uint_as_float(src.z << 16); dst[5] = __uint_as_float(src.z & 0xffff0000u); dst[6] = __uint_as_float(src.w << 16); dst[7] = __uint_as_float(src.w & 0xffff0000u);
#pragma unroll
        for (int cc = 0; cc < 4; ++cc) { float f[8]; UNPKQ(f, raw[cc])
            v4u w; w.x = cvtpk(f[0] * rs, f[1] * rs); w.y = cvtpk(f[2] * rs, f[3] * rs); w.z = cvtpk(f[4] * rs, f[5] * rs); w.w = cvtpk(f[6] * rs, f[7] * rs); qf[cc] = __builtin_bit_cast(bf16x8, w); }
        { float x1[8], x2[8], o1[8], o2[8]; UNPKQ(x1, raw[4]) UNPKQ(x2, raw[5])
#pragma unroll
          for (int j = 0; j < 8; ++j) { const float cs = cm_[j] * rs, sn = sm_[j] * rs; o1[j] = x1[j] * cs - x2[j] * sn; o2[j] = x1[j] * sn + x2[j] * cs; }
          v4u w; w.x = cvtpk(o1[0], o1[1]); w.y = cvtpk(o1[2], o1[3]); w.z = cvtpk(o1[4], o1[5]); w.w = cvtpk(o1[6], o1[7]); qf[4] = __builtin_bit_cast(bf16x8, w);
          w.x = cvtpk(o2[0], o2[1]); w.y = cvtpk(o2[2], o2[3]); w.z = cvtpk(o2[4], o2[5]); w.w = cvtpk(o2[6], o2[7]); qf[5] = __builtin_bit_cast(bf16x8, w); }
#undef UNPKQ
    }
    const long long tq1 = (PROBE_SEL != 0) ? (long long)__builtin_amdgcn_s_memtime() : 0ll;
    AttnState st; st.m = 0.f; st.l = 0.f; st.o[0] = f32x16{}; st.o[1] = f32x16{}; st.negm = f32x16{}; st.started = false; st.twait = 0;
    const bf16* kvb = (const bf16*)(ws + WS_KVM) + (size_t)b * S_ * 768 + h * 128;
    at_stream<6, AM_CAUSAL>(st, lds, kvb, 768, kvb + 64, 768, (const bf16*)(ws + WS_KR) + (size_t)b * S_ * 32, 32, 0, 4 * qt + 4, qf, qpos, qw0, 0u, tid);
    if (PROBE_SEL >= 1 && PROBE_SEL <= 3 && b == 0 && h == 0 && qt == 7 && tid == 0) { const long long tq2 = (long long)__builtin_amdgcn_s_memtime();
        ((float*)(ws + WS_CTL))[100] = (PROBE_SEL == 1) ? (float)(tq2 - tq1) : (PROBE_SEL == 2) ? (float)st.twait : (float)(tq1 - tq0); }
    const float lt = red32_sum(st.l), il = 1.f / lt;
    bf16* op = (bf16*)(ws + WS_HB) + row * D_ + 384 + h * 64 + 4 * hi;
#pragma unroll
    for (int dh = 0; dh < 2; ++dh)
#pragma unroll
        for (int g4 = 0; g4 < 4; ++g4) { u32x2v w; w.x = cvtpk(st.o[dh][4 * g4] * il, st.o[dh][4 * g4 + 1] * il); w.y = cvtpk(st.o[dh][4 * g4 + 2] * il, st.o[dh][4 * g4 + 3] * il);
            *(u32x2v*)(op + dh * 32 + 8 * g4) = w; }
}
template <int MODE> __device__ __forceinline__ void nsa_branch_unit(unsigned char* ws, LAS unsigned char* lds, int b, int h, int qt, int wave_u) {
    const int tid = wave_u * 64 + fresh_lane();
    const int lane = tid & 63, wave = tid >> 6, r32 = lane & 31, hi = lane >> 5, g = h / 3;
    const int qw0 = qt * 256 + wave * 32, qpos = qw0 + r32; const size_t row = (size_t)b * S_ + qpos;
    const bf16* nsa = (const bf16*)(ws + WS_NSA);
    const bf16* qp = nsa + row * 1152 + h * 64 + 8 * hi;
    bf16x8 qf[4];
#pragma unroll
    for (int cc = 0; cc < 4; ++cc) qf[cc] = *(const bf16x8*)(qp + 16 * cc);
    unsigned selbits = 0u; if (MODE == AM_SLC) selbits = ((const unsigned*)(ws + WS_SEL))[(size_t)(b * 2 + g) * S_ + qpos];
    const bf16* kb = nsa + (size_t)b * S_ * 1152 + g * 64 + (MODE == AM_SLC ? 640 : 896);
    AttnState st; st.m = 0.f; st.l = 0.f; st.o[0] = f32x16{}; st.o[1] = f32x16{}; st.negm = f32x16{}; st.started = false; st.twait = 0;
    const long long tn0 = (PROBE_SEL != 0) ? (long long)__builtin_amdgcn_s_memtime() : 0ll;
    const int t0 = (MODE == AM_SLC) ? 0 : ((4 * qt - 8 > 0) ? 4 * qt - 8 : 0);
    at_stream<4, MODE>(st, lds, kb, 1152, kb + 128, 1152, nullptr, 0, t0, 4 * qt + 4, qf, qpos, qw0, selbits, tid);
    if (PROBE_SEL >= 4 && PROBE_SEL <= 5 && MODE == AM_SLC && b == 0 && h == 0 && qt == 7 && tid == 0) { const long long tn1 = (long long)__builtin_amdgcn_s_memtime();
        ((float*)(ws + WS_CTL))[100] = (PROBE_SEL == 4) ? (float)(tn1 - tn0) : (float)st.twait; }
    const float lt = red32_sum(st.l), il = 1.f / lt;
    bf16* op = (bf16*)(ws + (MODE == AM_SLC ? WS_OSLC : WS_OWIN)) + row * 384 + h * 64 + 4 * hi;
#pragma unroll
    for (int dh = 0; dh < 2; ++dh)
#pragma unroll
        for (int g4 = 0; g4 < 4; ++g4) { u32x2v w; w.x = cvtpk(st.o[dh][4 * g4] * il, st.o[dh][4 * g4 + 1] * il); w.y = cvtpk(st.o[dh][4 * g4 + 2] * il, st.o[dh][4 * g4 + 3] * il);
            *(u32x2v*)(op + dh * 32 + 8 * g4) = w; }
}
__device__ __forceinline__ void cmp_unit(unsigned char* ws, LAS unsigned char* lds, int b, int g, int qt, int wave_u) {
    const int tid = wave_u * 64 + fresh_lane();
    const int lane = tid & 63, wave = tid >> 6, r32 = lane & 31, hi = lane >> 5;
    const int qpos = qt * 256 + wave * 32 + r32; const size_t row = (size_t)b * S_ + qpos;
    const bf16* kc = (const bf16*)(ws + WS_KCV) + (size_t)(b * 2 + g) * 128 * 64; const bf16* vc = kc + (size_t)8 * 2 * 128 * 64;
    { TileRegs<4> tr; at_load<4>(tr, kc, 64, vc, 64, nullptr, 0, 0, tid); at_store<4>(tr, lds, tid); at_load<4>(tr, kc, 64, vc, 64, nullptr, 0, 1, tid); at_store<4>(tr, lds + AT_BUF, tid); }
    __syncthreads();
    int nvis = (qpos >= 31) ? ((qpos - 31) >> 4) + 1 : 0; if (nvis > 127) nvis = 127;
    LAS float* IG = (LAS float*)(lds + 2 * AT_BUF) + wave * (32 * 33) + r32 * 33;
    LAS float* IL = IG + 8 * 32 * 33;
    const bf16* nsa = (const bf16*)(ws + WS_NSA);
    LAS const unsigned char* vb = lds + AT_V + (4 * hi + ((lane & 15) >> 2)) * 64 + ((lane >> 4) & 1) * 32 + (lane & 3) * 8;
    for (int r3 = 0; r3 < 3; ++r3) {
        const int h = 3 * g + r3;
        const bf16* qp = nsa + row * 1152 + h * 64 + 8 * hi;
        bf16x8 qf[4];
#pragma unroll
        for (int cc = 0; cc < 4; ++cc) qf[cc] = *(const bf16x8*)(qp + 16 * cc);
        f32x16 p[4];
#pragma unroll
        for (int tb = 0; tb < 4; ++tb) {
            LAS const unsigned char* buf = lds + (tb >> 1) * AT_BUF; const int kr = (tb & 1) * 32 + r32;
            p[tb] = f32x16{};
#pragma unroll
            for (int cc = 0; cc < 4; ++cc) { const bf16x8 kf = *(LAS const bf16x8*)(buf + kr * 128 + 16 * ((2 * cc + hi) ^ ((kr >> 1) & 7)));
                p[tb] = __builtin_amdgcn_mfma_f32_32x32x16_bf16(kf, qf[cc], p[tb], 0, 0, 0); }
        }
        float mx = -1e30f;
#pragma unroll
        for (int tb = 0; tb < 4; ++tb)
#pragma unroll
            for (int r = 0; r < 16; ++r) { const int n = 32 * tb + crow(r, hi); p[tb][r] = fminf(p[tb][r], ((float)(nvis - n) - 0.5f) * INFINITY); mx = fmaxf(mx, p[tb][r]); }
        mx = red32_max(mx);
        float sum = 0.f;
#pragma unroll
        for (int tb = 0; tb < 4; ++tb)
#pragma unroll
            for (int r = 0; r < 16; ++r) { p[tb][r] = __builtin_amdgcn_exp2f(p[tb][r] - mx); sum += p[tb][r]; }
        sum = red32_sum(sum);
        const float il = (nvis > 0) ? 1.f / sum : 0.f;
#pragma unroll
        for (int tb = 0; tb < 4; ++tb)
#pragma unroll
            for (int k = 0; k < 4; ++k) { const float a0 = p[tb][4 * k] * il, a1 = p[tb][4 * k + 1] * il, a2 = p[tb][4 * k + 2] * il, a3 = p[tb][4 * k + 3] * il;
                const int j = 2 * (4 * tb + k) + hi;
                const float gs = (a0 + a1) + (a2 + a3);
                if (r3 == 0) { IG[j] = gs; IL[j + 1] = a3; } else { IG[j] += gs; IL[j + 1] += a3; } }
        f32x16 o[2] = {f32x16{}, f32x16{}};
#pragma unroll
        for (int tb = 0; tb < 4; ++tb)
#pragma unroll
            for (int s2 = 0; s2 < 2; ++s2) {
                v4u a; a.x = cvtpk(p[tb][8 * s2 + 0], p[tb][8 * s2 + 1]); a.y = cvtpk(p[tb][8 * s2 + 2], p[tb][8 * s2 + 3]); a.z = cvtpk(p[tb][8 * s2 + 4], p[tb][8 * s2 + 5]); a.w = cvtpk(p[tb][8 * s2 + 6], p[tb][8 * s2 + 7]);
                const bf16x8 pf = __builtin_bit_cast(bf16x8, a);
                LAS const unsigned char* vbb = vb + (tb >> 1) * AT_BUF + ((tb & 1) * 2 + s2) * 1024;
#pragma unroll
                for (int dh = 0; dh < 2; ++dh) { const s16x4 lo = vtr(vbb + dh * 4096), hh = vtr(vbb + dh * 4096 + 512);
                    const bf16x8 vf = {lo[0], lo[1], lo[2], lo[3], hh[0], hh[1], hh[2], hh[3]};
                    o[dh] = __builtin_amdgcn_mfma_f32_32x32x16_bf16(vf, pf, o[dh], 0, 0, 0); }
                asm volatile("" ::: "memory");
            }
        bf16* op = (bf16*)(ws + WS_OCMP) + row * 384 + h * 64 + 4 * hi;
#pragma unroll
        for (int dh = 0; dh < 2; ++dh)
#pragma unroll
            for (int g4 = 0; g4 < 4; ++g4) { u32x2v w; w.x = cvtpk(o[dh][4 * g4] * il, o[dh][4 * g4 + 1] * il); w.y = cvtpk(o[dh][4 * g4 + 2] * il, o[dh][4 * g4 + 3] * il);
                *(u32x2v*)(op + dh * 32 + 8 * g4) = w; }
    }
    const int cur = qpos >> 6;
    LAS float* imp = IG;
#pragma unroll 1
    for (int jj = 0; jj < 16; ++jj) {
        const int j = 16 * hi + jj;
        float v = IG[j] + (j > 0 ? IL[j] : 0.f);
        if (j == 0 || j == cur || j == cur - 1) v = INFINITY;
        if (j * 64 > qpos) v = -INFINITY;
        IL[j] = v;
    }
#pragma unroll 1
    for (int jj = 0; jj < 16; ++jj) { const int j = 16 * hi + jj; imp[j] = IL[j]; }
    unsigned mask = 0;
#pragma unroll 1
    for (int jj = 0; jj < 16; ++jj) {
        const int j = 16 * hi + jj; const float v = imp[j]; int rank = 0;
#pragma unroll 4
        for (int k = 0; k < 32; ++k) { const float u2 = imp[k]; rank += (u2 > v || (u2 == v && k < j)) ? 1 : 0; }
        if (rank < 16) mask |= 1u << j;
    }
    mask = red32_or(mask);
    if (hi == 0) ((unsigned*)(ws + WS_SEL))[(size_t)(b * 2 + g) * S_ + qpos] = mask;
    __syncthreads();
}
__device__ __forceinline__ void lora_rows(unsigned char* ws, int tid) {
    const int gw = blockIdx.x * NWAVES + (tid >> 6), ngw = gridDim.x * NWAVES, lane = tid & 63;
    bf16* kvl = (bf16*)(ws + WS_KVL); const bf16* ql = (const bf16*)(ws + WS_QL); float* ssql = (float*)(ws + WS_SSQL);
    for (int m = gw; m < T_; m += ngw) {
        const unsigned kv = *(const unsigned*)(kvl + (size_t)m * 128 + 2 * lane);
        const float k0 = __uint_as_float(kv << 16), k1 = __uint_as_float(kv & 0xffff0000u);
        const uint2 qv = *(const uint2*)(ql + (size_t)m * 256 + 4 * lane);
        const float q0 = __uint_as_float(qv.x << 16), q1 = __uint_as_float(qv.x & 0xffff0000u), q2 = __uint_as_float(qv.y << 16), q3 = __uint_as_float(qv.y & 0xffff0000u);
        const float sk = wave_sum2(k0 * k0 + k1 * k1), sq = wave_sum2((q0 * q0 + q1 * q1) + (q2 * q2 + q3 * q3));
        const float rk = rsqrtf(sk * (1.f / 128.f) + EPS);
        *(unsigned*)(kvl + (size_t)m * 128 + 2 * lane) = pk2(k0 * rk, k1 * rk);
        if (lane == 0) ssql[m] = sq;
    }
}
__device__ __forceinline__ void post_misc(unsigned char* ws, const float* big, const float* bfg, int tid) {
    const float* mr = (const float*)(ws + WS_MISCRAW); const float* cosM = (const float*)(ws + WS_COSM); const float* sinM = (const float*)(ws + WS_SINM);
    bf16* kr = (bf16*)(ws + WS_KR); float* gm = (float*)(ws + WS_GM);
    for (int idx = blockIdx.x * NTHR + tid; idx < T_ * 64; idx += gridDim.x * NTHR) {
        const int row = idx >> 6, c = idx & 63; const float* r = mr + (size_t)row * 64; const float v = r[c];
        if (c < 32) { const int i = c & 15; const float x1 = r[i], x2 = r[16 + i], cs = cosM[row * 16 + i], sn = sinM[row * 16 + i];
            kr[(size_t)row * 32 + c] = f2bf((c < 16) ? x1 * cs - x2 * sn : x1 * sn + x2 * cs); }
        else if (c < 50) gm[(size_t)row * 32 + (c - 32)] = 1.f / (1.f + __expf(-v));
        else if (c < 54) gm[(size_t)row * 32 + 18 + (c - 50)] = v + big[c - 50];
        else if (c < 58) { const float z = v + bfg[c - 54]; gm[(size_t)row * 32 + 22 + (c - 54)] = fminf(z, 0.f) - __logf(1.f + __expf(-fabsf(z))); }
    }
}

typedef float f32x4v __attribute__((ext_vector_type(4)));
__device__ __forceinline__ void compress_item(unsigned char* ws, LAS unsigned char* lds, const float* cmp_pos, int item, int wave_u) {
    const int lane = fresh_lane(), tid = wave_u * 64 + lane;
    const int nb = item & 7, g = (item >> 3) & 1, b = (item >> 4) & 7, kv = item >> 7;
    const bf16* tok = (const bf16*)(ws + WS_NSA) + (size_t)b * S_ * 1152 + (kv ? 512 : 384) + g * 64;
    const bf16* wt = (const bf16*)(ws + (kv ? WT_CV : WT_CK));
    const int nrow = nb * 16 + (lane & 15), kq = lane >> 4;
    f32x4v acc[4] = {f32x4v{}, f32x4v{}, f32x4v{}, f32x4v{}};
#pragma unroll 4
    for (int ks = 0; ks < 8; ++ks) {
        const int k = wave_u * 256 + ks * 32 + kq * 8, l = k >> 6, d = k & 63;
        int trow = 16 * nrow + l; trow = trow < S_ ? trow : S_ - 1;
        const v4u t4 = *(const v4u*)(tok + (size_t)trow * 1152 + d);
        const f32x4v p0 = *(const f32x4v*)(cmp_pos + k), p1 = *(const f32x4v*)(cmp_pos + k + 4);
        v4u a4;
        a4.x = cvtpk(__uint_as_float(t4.x << 16) + p0[0], __uint_as_float(t4.x & 0xffff0000u) + p0[1]); a4.y = cvtpk(__uint_as_float(t4.y << 16) + p0[2], __uint_as_float(t4.y & 0xffff0000u) + p0[3]);
        a4.z = cvtpk(__uint_as_float(t4.z << 16) + p1[0], __uint_as_float(t4.z & 0xffff0000u) + p1[1]); a4.w = cvtpk(__uint_as_float(t4.w << 16) + p1[2], __uint_as_float(t4.w & 0xffff0000u) + p1[3]);
        const bf16x8 af = __builtin_bit_cast(bf16x8, a4);
#pragma unroll
        for (int cb = 0; cb < 4; ++cb) { const bf16x8 bfr = *(const bf16x8*)(wt + (size_t)(cb * 16 + (lane & 15)) * 2048 + k);
            acc[cb] = __builtin_amdgcn_mfma_f32_16x16x32_bf16(af, bfr, acc[cb], 0, 0, 0); }
    }
    LAS float* red = (LAS float*)lds + wave_u * 1024;
#pragma unroll
    for (int cb = 0; cb < 4; ++cb)
#pragma unroll
        for (int r = 0; r < 4; ++r) red[(4 * (lane >> 4) + r) * 64 + cb * 16 + (lane & 15)] = acc[cb][r];
    __syncthreads();
    bf16* out = (bf16*)(ws + WS_KCV) + (size_t)kv * (8 * 2 * 128 * 64) + ((size_t)(b * 2 + g) * 128 + nb * 16) * 64;
    for (int o = tid; o < 1024; o += NTHR) { float sum = 0.f;
#pragma unroll
        for (int w8 = 0; w8 < 8; ++w8) sum += ((LAS float*)lds)[w8 * 1024 + o];
        out[o] = f2bf(sum); }
    __syncthreads();
}
__device__ __forceinline__ f32x4v mm16(const LAS bf16* A, int lda, int arow0, const LAS bf16* Bt, int ldb, int bcol0, int K, int lane, f32x4v acc) {
    const LAS bf16* ap = A + (arow0 + (lane & 15)) * lda + 8 * (lane >> 4); const LAS bf16* bp = Bt + (bcol0 + (lane & 15)) * ldb + 8 * (lane >> 4);
    for (int k = 0; k < K; k += 32) acc = __builtin_amdgcn_mfma_f32_16x16x32_bf16(*(const LAS bf16x8*)(ap + k), *(const LAS bf16x8*)(bp + k), acc, 0, 0, 0);
    return acc;
}
constexpr int ML_LD = 72;
__device__ __forceinline__ void mlocal_item(unsigned char* ws, LAS unsigned char* lds, const float* convw, const float* convb, const float* big, const float* bfg, int chunk, int wave_u) {
    const int lane = fresh_lane(), tid = wave_u * 64 + lane;
    const int c = chunk & 31, h = (chunk >> 5) & 3, b = chunk >> 7, row0 = b * S_ + c * 64;
    LAS bf16* XS = (LAS bf16*)lds;
    LAS bf16* WQ = XS + 64 * ML_LD;
    LAS bf16* WK = WQ + 64 * ML_LD;
    LAS bf16* VT = WK + 64 * ML_LD;
    LAS bf16* WKT = VT + 64 * ML_LD;
    LAS float* wl = (LAS float*)(WKT + 64 * ML_LD);
    const bf16* cm = (const bf16*)(ws + WS_CM);
    {
        const int l = tid >> 3, ch0 = (tid & 7) * 8, row = row0 + l, s = c * 64 + l;
        float a[8];
#pragma unroll
        for (int i = 0; i < 8; ++i) a[i] = convb[h * 64 + ch0 + i];
#pragma unroll
        for (int j = 0; j < 4; ++j) { if (s - 3 + j >= 0) { const v4u x4 = *(const v4u*)(cm + (size_t)(row - 3 + j) * 768 + h * 64 + ch0);
            const float* cw = convw + j * 256 + h * 64 + ch0;
            a[0] += cw[0] * __uint_as_float(x4.x << 16); a[1] += cw[1] * __uint_as_float(x4.x & 0xffff0000u); a[2] += cw[2] * __uint_as_float(x4.y << 16); a[3] += cw[3] * __uint_as_float(x4.y & 0xffff0000u);
            a[4] += cw[4] * __uint_as_float(x4.z << 16); a[5] += cw[5] * __uint_as_float(x4.z & 0xffff0000u); a[6] += cw[6] * __uint_as_float(x4.w << 16); a[7] += cw[7] * __uint_as_float(x4.w & 0xffff0000u); } }
        v4u o4; float r[8];
#pragma unroll
        for (int i = 0; i < 8; ++i) r[i] = a[i] / (1.f + __expf(-a[i]));
        o4.x = cvtpk(r[0], r[1]); o4.y = cvtpk(r[2], r[3]); o4.z = cvtpk(r[4], r[5]); o4.w = cvtpk(r[6], r[7]);
        *(v4u*)((bf16*)(ws + WS_XC) + (size_t)row * 256 + h * 64 + ch0) = o4;
        *(LAS v4u*)(XS + l * ML_LD + ch0) = o4;
        const v4u v4 = *(const v4u*)(cm + (size_t)row * 768 + 256 + h * 64 + ch0);
        VT[(ch0 + 0) * ML_LD + l] = (bf16)(v4.x & 0xffffu); VT[(ch0 + 1) * ML_LD + l] = (bf16)(v4.x >> 16); VT[(ch0 + 2) * ML_LD + l] = (bf16)(v4.y & 0xffffu); VT[(ch0 + 3) * ML_LD + l] = (bf16)(v4.y >> 16);
        VT[(ch0 + 4) * ML_LD + l] = (bf16)(v4.z & 0xffffu); VT[(ch0 + 5) * ML_LD + l] = (bf16)(v4.z >> 16); VT[(ch0 + 6) * ML_LD + l] = (bf16)(v4.w & 0xffffu); VT[(ch0 + 7) * ML_LD + l] = (bf16)(v4.w >> 16);
        const int e = tid >> 3, d0 = (tid & 7) * 8;
        *(LAS v4u*)(WQ + e * ML_LD + d0) = *(const v4u*)((const bf16*)(ws + WT_QM) + h * 4096 + e * 64 + d0);
        *(LAS v4u*)(WK + e * ML_LD + d0) = *(const v4u*)((const bf16*)(ws + WT_KM) + h * 4096 + e * 64 + d0);
    }
    if (wave_u == 0) {
        const float* mr = (const float*)(ws + WS_MISCRAW) + (size_t)(row0 + lane) * 64;
        const float z = mr[54 + h] + bfg[h]; float lf = fminf(z, 0.f) - __logf(1.f + __expf(-fabsf(z)));
        const float ig = mr[50 + h] + big[h];
#pragma unroll
        for (int o = 1; o < 64; o <<= 1) { const float t = bperm(lf, lane - o); if (lane >= o) lf += t; }
        const float bL = __int_as_float(__builtin_amdgcn_readlane(__float_as_int(lf), 63));
        const float a = bL - lf + ig; const float mx = wave_max2(a);
        wl[lane] = __expf(a - mx);
        if (lane == 0) { ((float*)(ws + WS_ML))[chunk] = mx; ((float*)(ws + WS_BL))[chunk] = bL; }
    }
    __syncthreads();
    {
        const int lb = wave_u & 3; const bool isk = wave_u >= 4;
        const LAS bf16* Wt = isk ? WK : WQ;
        bf16* og = (bf16*)(ws + (isk ? WS_MK : WS_MQ)) + (size_t)(row0 + 16 * lb + 4 * (lane >> 4)) * 256 + h * 64 + (lane & 15);
        float w4[4];
#pragma unroll
        for (int r = 0; r < 4; ++r) w4[r] = wl[16 * lb + 4 * (lane >> 4) + r];
#pragma unroll
        for (int eb = 0; eb < 4; ++eb) {
            f32x4v acc = mm16(XS, ML_LD, 16 * lb, Wt, ML_LD, 16 * eb, 64, lane, f32x4v{});
            if (!isk) {
#pragma unroll
                for (int r = 0; r < 4; ++r) og[(size_t)r * 256 + 16 * eb] = f2bf(acc[r] * 0.125f);
            } else {
                bf16 kb[4];
#pragma unroll
                for (int r = 0; r < 4; ++r) { kb[r] = f2bf(acc[r]); og[(size_t)r * 256 + 16 * eb] = kb[r]; }
                u32x2v w2; w2.x = cvtpk(bf2f(kb[0]) * w4[0], bf2f(kb[1]) * w4[1]); w2.y = cvtpk(bf2f(kb[2]) * w4[2], bf2f(kb[3]) * w4[3]);
                *(LAS u32x2v*)(WKT + (16 * eb + (lane & 15)) * ML_LD + 16 * lb + 4 * (lane >> 4)) = w2;
            }
        }
    }
    __syncthreads();
    {
        float* ct = (float*)(ws + WS_CT) + (size_t)chunk * 4096;
#pragma unroll
        for (int i = 0; i < 2; ++i) { const int blk = wave_u * 2 + i, eb = blk >> 2, db = blk & 3;
            const f32x4v acc = mm16(VT, ML_LD, 16 * eb, WKT, ML_LD, 16 * db, 64, lane, f32x4v{});
#pragma unroll
            for (int r = 0; r < 4; ++r) ct[(16 * eb + 4 * (lane >> 4) + r) * 64 + 16 * db + (lane & 15)] = acc[r]; }
        if (tid < 64) { float n = 0.f; const LAS bf16* wr_ = WKT + tid * ML_LD;
            for (int l = 0; l < 64; ++l) n += bf2f(wr_[l]);
            ((float*)(ws + WS_NL))[chunk * 64 + tid] = n; }
    }
    __syncthreads();
}
__device__ __forceinline__ void mscan_item(unsigned char* ws, int item, int wave_u) {
    const int tid = wave_u * 64 + fresh_lane();
    const int bh = item / 9, part = item % 9;
    if (part == 8 && tid >= 64) return;
    float* base; size_t stride;
    if (part < 8) { base = (float*)(ws + WS_CT) + (size_t)bh * 32 * 4096 + part * 512 + tid; stride = 4096; } else { base = (float*)(ws + WS_NL) + (size_t)bh * 32 * 64 + tid; stride = 64; }
    const float* ML = (const float*)(ws + WS_ML); const float* BL = (const float*)(ws + WS_BL); float* MPv = (float*)(ws + WS_MP);
    float Cv = 0.f, m = 0.f;
    for (int c = 0; c < 32; ++c) {
        const float cl = base[(size_t)c * stride], ml = ML[bh * 32 + c], bl = BL[bh * 32 + c];
        base[(size_t)c * stride] = Cv;
        if (part == 8 && tid == 0) MPv[bh * 32 + c] = m;
        const float mn = fmaxf(bl + m, ml);
        Cv = __expf(bl + m - mn) * Cv + __expf(ml - mn) * cl; m = mn;
    }
}
__device__ __forceinline__ void mout_item(unsigned char* ws, LAS unsigned char* lds, const float* gmh, const float* skip, int chunk, int wave_u) {
    const int lane = fresh_lane(), tid = wave_u * 64 + lane;
    const int c = chunk & 31, h = (chunk >> 5) & 3, b = chunk >> 7, row0 = b * S_ + c * 64;
    LAS bf16* QS = (LAS bf16*)lds;
    LAS bf16* KS = QS + 64 * ML_LD;
    LAS bf16* VT = KS + 64 * ML_LD;
    LAS bf16* CP = VT + 64 * ML_LD;
    LAS bf16* SW = CP + 64 * ML_LD;
    LAS float* HS = (LAS float*)(SW + 64 * ML_LD);
    LAS float* bs = HS + 64 * 65; LAS float* us = bs + 64; LAS float* ns = us + 64; LAS float* mts = ns + 64; LAS float* ints = mts + 64; LAS float* dinv = ints + 64;
    const float* gm = (const float*)(ws + WS_GM);
    {
        const int l = tid >> 3, c0 = (tid & 7) * 8, row = row0 + l;
        *(LAS v4u*)(QS + l * ML_LD + c0) = *(const v4u*)((const bf16*)(ws + WS_MQ) + (size_t)row * 256 + h * 64 + c0);
        *(LAS v4u*)(KS + l * ML_LD + c0) = *(const v4u*)((const bf16*)(ws + WS_MK) + (size_t)row * 256 + h * 64 + c0);
        const v4u v4 = *(const v4u*)((const bf16*)(ws + WS_CM) + (size_t)row * 768 + 256 + h * 64 + c0);
        VT[(c0 + 0) * ML_LD + l] = (bf16)(v4.x & 0xffffu); VT[(c0 + 1) * ML_LD + l] = (bf16)(v4.x >> 16); VT[(c0 + 2) * ML_LD + l] = (bf16)(v4.y & 0xffffu); VT[(c0 + 3) * ML_LD + l] = (bf16)(v4.y >> 16);
        VT[(c0 + 4) * ML_LD + l] = (bf16)(v4.z & 0xffffu); VT[(c0 + 5) * ML_LD + l] = (bf16)(v4.z >> 16); VT[(c0 + 6) * ML_LD + l] = (bf16)(v4.w & 0xffffu); VT[(c0 + 7) * ML_LD + l] = (bf16)(v4.w >> 16);
        const float* ct = (const float*)(ws + WS_CT) + (size_t)chunk * 4096 + l * 64 + c0;
        const f32x4v c0v = *(const f32x4v*)ct, c1v = *(const f32x4v*)(ct + 4);
        v4u cw; cw.x = cvtpk(c0v[0], c0v[1]); cw.y = cvtpk(c0v[2], c0v[3]); cw.z = cvtpk(c1v[0], c1v[1]); cw.w = cvtpk(c1v[2], c1v[3]);
        *(LAS v4u*)(CP + l * ML_LD + c0) = cw;
    }
    if (wave_u == 0) {
        const float ig = gm[(size_t)(row0 + lane) * 32 + 18 + h]; float lf = gm[(size_t)(row0 + lane) * 32 + 22 + h];
#pragma unroll
        for (int o = 1; o < 64; o <<= 1) { const float t = bperm(lf, lane - o); if (lane >= o) lf += t; }
        const float u = ig - lf; float cu = u;
#pragma unroll
        for (int o = 1; o < 64; o <<= 1) { const float t = bperm(cu, lane - o); if (lane >= o) cu = fmaxf(cu, t); }
        const float mprev = ((const float*)(ws + WS_MP))[chunk];
        const float mt = lf + fmaxf(mprev, cu);
        bs[lane] = lf; us[lane] = u; mts[lane] = mt; ints[lane] = __expf(lf + mprev - mt); ns[lane] = ((const float*)(ws + WS_NL))[chunk * 64 + lane];
    }
    __syncthreads();
    {
#pragma unroll
        for (int i = 0; i < 2; ++i) { const int blk = wave_u * 2 + i, lb = blk >> 2, sb = blk & 3;
            f32x4v acc = f32x4v{};
            if (sb <= lb) acc = mm16(QS, ML_LD, 16 * lb, KS, ML_LD, 16 * sb, 64, lane, acc);
            const int sidx = 16 * sb + (lane & 15); const float usv = us[sidx];
#pragma unroll
            for (int r = 0; r < 4; ++r) { const int l = 16 * lb + 4 * (lane >> 4) + r;
                const float v = (sidx <= l) ? acc[r] * __expf(bs[l] + usv - mts[l]) : 0.f;
                SW[l * ML_LD + sidx] = f2bf(v); } }
    }
    __syncthreads();
    if (tid < 64) {
        const int l = tid; float qn = 0.f, ssum = 0.f;
        for (int d = 0; d < 64; ++d) { qn += bf2f(QS[l * ML_LD + d]) * ns[d]; ssum += bf2f(SW[l * ML_LD + d]); }
        const float den = ints[l] * qn + ssum;
        dinv[l] = 1.f / fmaxf(fabsf(den), __expf(-mts[l]));
    }
    f32x4v hq[2], hs2[2];
#pragma unroll
    for (int i = 0; i < 2; ++i) { const int blk = wave_u * 2 + i, lb = blk >> 2, eb = blk & 3;
        hq[i] = mm16(QS, ML_LD, 16 * lb, CP, ML_LD, 16 * eb, 64, lane, f32x4v{});
        hs2[i] = mm16(SW, ML_LD, 16 * lb, VT, ML_LD, 16 * eb, 16 * lb + 16 <= 32 ? 32 : 64, lane, f32x4v{}); }
    __syncthreads();
#pragma unroll
    for (int i = 0; i < 2; ++i) { const int blk = wave_u * 2 + i, lb = blk >> 2, eb = blk & 3; const int e = 16 * eb + (lane & 15);
#pragma unroll
        for (int r = 0; r < 4; ++r) { const int l = 16 * lb + 4 * (lane >> 4) + r;
            const float og = bf2f(((const bf16*)(ws + WS_CM))[(size_t)(row0 + l) * 768 + 512 + h * 64 + e]);
            HS[l * 65 + e] = (ints[l] * hq[i][r] + hs2[i][r]) * dinv[l] / (1.f + __expf(-og)); } }
    __syncthreads();
    {
        const int l = tid >> 3, e0 = (tid & 7) * 8, row = row0 + l;
        float v[8]; float mu = 0.f;
#pragma unroll
        for (int i = 0; i < 8; ++i) { v[i] = HS[l * 65 + e0 + i]; mu += v[i]; }
        mu += sxf<1>(mu); mu += sxf<2>(mu); mu += sxf<4>(mu); mu *= (1.f / 64.f);
        float var = 0.f;
#pragma unroll
        for (int i = 0; i < 8; ++i) { const float dl = v[i] - mu; var += dl * dl; }
        var += sxf<1>(var); var += sxf<2>(var); var += sxf<4>(var);
        const float rs = rsqrtf(var * (1.f / 64.f) + EPS);
        const v4u x4 = *(const v4u*)((const bf16*)(ws + WS_XC) + (size_t)row * 256 + h * 64 + e0);
        float xv[8]; xv[0] = __uint_as_float(x4.x << 16); xv[1] = __uint_as_float(x4.x & 0xffff0000u); xv[2] = __uint_as_float(x4.y << 16); xv[3] = __uint_as_float(x4.y & 0xffff0000u);
        xv[4] = __uint_as_float(x4.z << 16); xv[5] = __uint_as_float(x4.z & 0xffff0000u); xv[6] = __uint_as_float(x4.w << 16); xv[7] = __uint_as_float(x4.w & 0xffff0000u);
        float r[8];
#pragma unroll
        for (int i = 0; i < 8; ++i) r[i] = (v[i] - mu) * rs * gmh[h * 64 + e0 + i] + skip[h * 64 + e0 + i] * xv[i];
        v4u w4; w4.x = cvtpk(r[0], r[1]); w4.y = cvtpk(r[2], r[3]); w4.z = cvtpk(r[4], r[5]); w4.w = cvtpk(r[6], r[7]);
        *(v4u*)((bf16*)(ws + WS_HB) + (size_t)row * D_ + 768 + h * 64 + e0) = w4;
    }
    __syncthreads();
}

__global__ void __launch_bounds__(NTHR, 2) mega(MP p_unused) {
    extern __shared__ __attribute__((aligned(16))) unsigned char lds_raw[];
    LAS unsigned char* lds = (LAS unsigned char*)lds_raw;
    const int wave0 = __builtin_amdgcn_readfirstlane((int)threadIdx.x >> 6);
    const int tid0 = wave0 * 64 + fresh_lane();
    const int xcc = (int)(__builtin_amdgcn_s_getreg((3 << 11) | 20) & 7u);
    volatile LAS unsigned* MISC = (volatile LAS unsigned*)(lds + MISC_OFF);
    for (int u = tid0; u < (LDS_BYTES - RING_BYTES) / 4; u += NTHR) ((LAS unsigned*)(lds + RING_BYTES))[u] = 0u;
    __syncthreads();
    typedef const __attribute__((address_space(4))) MP* kmp_t;
    kmp_t kp0 = (kmp_t)__builtin_amdgcn_kernarg_segment_ptr();
    unsigned char* ws0 = kp0->ws; const int coop = kp0->coop, ph_lo = kp0->ph_lo, ph_hi = kp0->ph_hi;
    XcdBarrier bar; bar.bar = (unsigned*)(ws0 + WS_CTL) + CW_BAR; bar.x = 0; bar.st = nullptr;
    if (coop) bar = xcd_barrier_post((unsigned*)(ws0 + WS_CTL) + CW_BAR, MISC + 8, tid0);
    if (coop == 2) cooperative_groups::this_grid().sync();
    int ph = ph_lo;
    if (ph == 0) {
        const MPK p{kp0}; ph_p0(p, lds, wave0 * 64 + fresh_lane()); ph = 1;
        if (ph < ph_hi) xcd_barrier(bar, wave0 * 64 + fresh_lane());
    }
    bool second = false;
    for (; ph < ph_hi; ++ph) {
        kmp_t kp = kp0; asm volatile("" : "+s"(kp));
        const MPK p{kp}; unsigned char* ws = kp->ws;
#define TID_ (wave0 * 64 + fresh_lane())
#define GW_ (blockIdx.x * NWAVES + wave0)
#define NGW_ (gridDim.x * NWAVES)
        const int l = (ph - 1) / PPL, ty = (ph == 0) ? -1 : (ph == NPH - 1) ? -2 : (ph - 1) % PPL;
        const float* modl = (const float*)(ws + WS_MOD) + (size_t)l * 8 * 6144;
        if (ty == -2) { norm_rows(p.k->out, PIN(I_GFIN), nullptr, nullptr, nullptr, p.k->out, 2, GW_, NGW_, fresh_lane());
            if (PROBE_SEL != 0 && blockIdx.x == 0 && TID_ == 0) { asm volatile("s_waitcnt vmcnt(0)" ::: "memory"); p.k->out[0] = ((const float*)(ws + WS_CTL))[100] * 0.001f; } }
        else if (ty == 0 && (PHM & 2)) ph_prep(p, l, lds, TID_);
        else if (ty == 1 && (PHM & 4)) {
            pg8::Gemm g{(const bf16*)(ws + WS_HB), (const bf16*)(ws + WT_IN), T_, 2560, D_}; pg8::StaticOrder S; S.init(T_, 2560, gridDim.x, blockIdx.x);
            pg8::EpiIn E{ws, PIN(I_BIG) + l * 4, PIN(I_BFG) + l * 4};
            pg8::gemm_phase<pg8::EpiIn, pg8::StaticOrder, true, true>(lds, g, S, E, wave0);
            late_transposes(p, l, lds, TID_, 640 % (int)gridDim.x);
        }
        else if (ty == 2 && (PHM & 64)) {
            { pg8::Gemm g{(const bf16*)(ws + WS_KVL), (const bf16*)(ws + WT_UKV), T_, 768, 128}; pg8::StaticOrder S; S.init(T_, 768, gridDim.x, blockIdx.x);
              pg8::EpiUKV E{(bf16*)(ws + WS_KVM), (const float*)(ws + WS_SSKV)}; pg8::gemm_phase<pg8::EpiUKV, pg8::StaticOrder, true, true>(lds, g, S, E, wave0); }
            { pg8::Gemm g{(const bf16*)(ws + WS_QL), (const bf16*)(ws + WT_UQ), T_, 768, 256}; pg8::StaticOrder S; S.init(T_, 768, gridDim.x, blockIdx.x);
              pg8::EpiPlain E{(bf16*)(ws + WS_OSLC), 768}; pg8::gemm_phase<pg8::EpiPlain, pg8::StaticOrder, true, true>(lds, g, S, E, wave0); }
            post_misc(ws, PIN(I_BIG) + l * 4, PIN(I_BFG) + l * 4, TID_);
            unsigned* ctrs = (unsigned*)(ws + WS_CTL) + 8192 + ph * 256 + (second ? 128 : 0); int ks = 0;
            for (;;) { const int it = next_item_q(ctrs, lds, wave0, 160, xcc, ks); if (it < 0) break; const int b = it >> 16, j = it & 0xffff;
                if (second && (REP_MASK & (1 << 18)) && j >= 128) continue; if (second && (REP_MASK & (1 << 19)) && j < 128) continue;
                if (j < 128) mlocal_item(ws, lds, PIN(I_CONVW) + l * 1024, PIN(I_CONVB) + l * 256, PIN(I_BIG) + l * 4, PIN(I_BFG) + l * 4, b * 128 + j, wave0);
                else { const int k = j - 128; compress_item(ws, lds, PIN(I_CMPPOS) + l * 2048, ((k >> 4) << 7) | (b << 4) | (k & 15), wave0); } }
        }
        else if (ty == 3 && (PHM & 128)) {
            unsigned* ctrs = (unsigned*)(ws + WS_CTL) + 8192 + ph * 256 + (second ? 128 : 0); int ks = 0;
            for (;;) { const int it = next_item_q(ctrs, lds, wave0, second ? 64 : 100, xcc, ks); if (it < 0) break; const int b = it >> 16, j = it & 0xffff;
                if (second && (REP_MASK & (1 << 20)) && j >= 48) continue; if (second && (REP_MASK & (1 << 21)) && j < 48) continue;
                if (j < 18) mla_unit(ws, lds, b, j % 6, 7 - j / 6, wave0);
                else if (j < 34) cmp_unit(ws, lds, b, (j - 18) >> 3, 7 - ((j - 18) & 7), wave0);
                else if (j < 64) { const int u = j - 16; mla_unit(ws, lds, b, u % 6, 7 - u / 6, wave0); }
                else mscan_item(ws, b * 36 + (j - 64), wave0); }
        }
        else if (ty == 4 && (PHM & 256)) {
            unsigned* ctrs = (unsigned*)(ws + WS_CTL) + 8192 + ph * 256 + (second ? 128 : 0); int ks = 0;
            for (;;) { const int it = next_item_q(ctrs, lds, wave0, 224, xcc, ks); if (it < 0) break; const int b = it >> 16, j = it & 0xffff;
                if (second && (REP_MASK & (1 << 16)) && j >= 96) continue; if (second && (REP_MASK & (1 << 17)) && j < 96) continue;
                if (j < 36) nsa_branch_unit<AM_SLC>(ws, lds, b, j % 6, 7 - j / 6, wave0);
                else if (j < 84) nsa_branch_unit<AM_WINDOW>(ws, lds, b, (j - 36) % 6, 7 - (j - 36) / 6, wave0);
                else if (j < 96) { const int u = j - 48; nsa_branch_unit<AM_SLC>(ws, lds, b, u % 6, 7 - u / 6, wave0); }
                else mout_item(ws, lds, PIN(I_GMH) + l * 256, PIN(I_SKIP) + l * 256, b * 128 + (j - 96), wave0); }
        }
        else if (ty == 5) ph_mixnorm(p, l, TID_);
        else if (ty == 6 && (PHM & 8)) {
            pg8::Gemm g{(const bf16*)(ws + WS_HB), (const bf16*)(ws + WT_OUT), T_, D_, D_}; pg8::StaticOrder S; S.init(T_, D_, gridDim.x, blockIdx.x);
            pg8::EpiRes E{(l == 0) ? PIN(I_X) : p.k->out, p.k->out, modl + 2048};
            pg8::gemm_phase<pg8::EpiRes, pg8::StaticOrder, true, true>(lds, g, S, E, wave0);
        }
        else if (ty == 7) norm_rows(p.k->out, PIN(I_GN2) + l * D_, modl + 3072, modl + 4096, (bf16*)(ws + WS_HB), nullptr, 1, GW_, NGW_, fresh_lane());
        else if (ty == 8 && (PHM & 16)) {
            pg8::Gemm g{(const bf16*)(ws + WS_HB), (const bf16*)(ws + WT_GU), T_, 2 * FF, D_}; pg8::StaticOrder S; S.init(T_, 2 * FF, gridDim.x, blockIdx.x);
            pg8::EpiGU E{(bf16*)(ws + WS_ACT)};
            pg8::gemm_phase<pg8::EpiGU, pg8::StaticOrder, true, true>(lds, g, S, E, wave0);
        }
        else if (ty == 9 && (PHM & 32)) {
            pg8::Gemm g{(const bf16*)(ws + WS_ACT), (const bf16*)(ws + WT_DOWN), T_, D_, FF}; pg8::StaticOrder S; S.init(T_, D_, gridDim.x, blockIdx.x);
            pg8::EpiRes E{p.k->out, p.k->out, modl + 5120};
            pg8::gemm_phase<pg8::EpiRes, pg8::StaticOrder, true, true>(lds, g, S, E, wave0);
        }
        if (REP_MASK != 0 && ty >= 0 && ((REP_MASK >> ty) & 1) && !second) { second = true; --ph; } else second = false;
        if (ph + 1 < ph_hi) xcd_barrier(bar, wave0 * 64 + fresh_lane());
    }
}

extern "C" void kernel_launch(void* const* d_in, const int* in_sizes, int n_in, void* d_out, int out_size, void* d_ws, size_t ws_size, hipStream_t stream) {
    if (n_in != N_IN || ws_size < WS_END) { fprintf(stderr, "kernel_launch: unexpected n_in %d / ws %zu\n", n_in, ws_size); return; }
    static int inited = 0;
    if (!inited) { if (hipFuncSetAttribute((const void*)mega, hipFuncAttributeMaxDynamicSharedMemorySize, LDS_BYTES) != hipSuccess) fprintf(stderr, "hipFuncSetAttribute failed\n"); inited = 1; }
    unsigned char* ws = (unsigned char*)d_ws;
    MP base{}; for (int i = 0; i < N_IN; ++i) base.in[i] = (const float*)d_in[i]; base.out = (float*)d_out; base.ws = ws;
    (void)hipMemsetAsync(ws + WS_CTL, 0, CTL_ZERO_BYTES, stream);
    static int grid = 0;
    if (!grid) {
        int dev = 0, cus = 0, per_cu = 0;
        (void)hipGetDevice(&dev); (void)hipDeviceGetAttribute(&cus, hipDeviceAttributeMultiprocessorCount, dev);
        if (hipOccupancyMaxActiveBlocksPerMultiprocessor(&per_cu, (const void*)mega, NTHR, LDS_BYTES) != hipSuccess || per_cu < 1) { fprintf(stderr, "kernel_launch: occupancy query says %d blocks per CU\n", per_cu); per_cu = 1; }
        (void)hipGetLastError();
        grid = cus;
    }
    MP a = base; a.ph_lo = 0; a.ph_hi = NPH; a.coop = 1;
    void* args[] = {&a};
    const hipError_t e = hipLaunchCooperativeKernel((const void*)mega, dim3(grid), dim3(NTHR), args, LDS_BYTES, stream);
    if (e != hipSuccess) fprintf(stderr, "kernel_launch: cooperative launch failed: %s (grid %d)\n", hipGetErrorString(e), grid);
}
```

```cpp
#include <hip/hip_runtime.h>
#include <cstdint>
#include <cstdio>
#include <hip/hip_cooperative_groups.h>

constexpr int B_ = 8, S_ = 2048, T_ = B_ * S_, D_ = 1024, DIN = 2362, FF = 2816, DEPTH = 2;
constexpr float EPS = 1e-6f;
constexpr float LOG2E = 1.4426950408889634f;
constexpr float QSCALE = 0.125f * LOG2E;
constexpr float MSCALE = 0.10206207261596577f * LOG2E;
enum { I_X = 0, I_C, I_POS, I_GN1, I_GN2, I_WADA, I_BADA, I_WIN, I_CMPPOS, I_WCK, I_WCV, I_GOA, I_GQL, I_WUQ, I_GKVL, I_WUKV, I_GOB,
       I_CONVW, I_CONVB, I_WQM, I_WKM, I_BIG, I_BFG, I_GMH, I_SKIP, I_WOUT, I_WGU, I_WDOWN, I_GFIN, N_IN };

constexpr size_t MiB = 1u << 20;
constexpr size_t WS_CTL = 0;
constexpr size_t WS_MOD = 1 * MiB;
constexpr size_t WS_COSP = WS_MOD + 512 * 1024;
constexpr size_t WS_SINP = WS_COSP + 512 * 1024;
constexpr size_t WS_COSM = WS_SINP + 512 * 1024;
constexpr size_t WS_SINM = WS_COSM + 1 * MiB;
constexpr size_t WS_SSQL = WS_SINM + 1 * MiB;
constexpr size_t WS_SSKV = WS_SSQL + 64 * 1024;
constexpr size_t WS_ML = WS_SSKV + 64 * 1024;
constexpr size_t WS_BL = WS_ML + 4096;
constexpr size_t WS_MP = WS_BL + 4096;
constexpr size_t WS_NL = WS_MP + 4096;
constexpr size_t WS_WT = 8 * MiB;
constexpr size_t WS_RAW = WS_WT;
constexpr size_t WS_HB = 34 * MiB;
constexpr size_t WS_NSA = 66 * MiB;
constexpr size_t WS_KVL = 102 * MiB;
constexpr size_t WS_QL = 106 * MiB;
constexpr size_t WS_CM = 114 * MiB;
constexpr size_t WS_GM = 138 * MiB;
constexpr size_t WS_KM = 140 * MiB;
constexpr size_t WS_QM = 158 * MiB;
constexpr size_t WS_VM = 176 * MiB;
constexpr size_t WS_KCV = 188 * MiB;
constexpr size_t WS_OCMP = 189 * MiB;
constexpr size_t WS_SEL = 201 * MiB;
constexpr size_t WS_XC = 202 * MiB;
constexpr size_t WS_MQ = 210 * MiB;
constexpr size_t WS_MK = 218 * MiB;
constexpr size_t WS_CT = 226 * MiB;
constexpr size_t WS_MISCRAW = 242 * MiB;
constexpr size_t WS_KVM = 140 * MiB;
constexpr size_t WS_KR = 246 * MiB;
constexpr size_t WS_OSLC = 164 * MiB;
constexpr size_t WS_OWIN = 176 * MiB;
constexpr size_t WS_ACT = 66 * MiB;
constexpr size_t WS_END = 256 * MiB;
static_assert(WS_NL + 1024 * 64 * 4 <= WS_WT, "tab");
static_assert(WS_ACT + (size_t)T_ * FF * 2 <= WS_KCV, "act overlay");

typedef unsigned short bf16;
__device__ __forceinline__ float bf2f(bf16 v) { return __uint_as_float(((unsigned)v) << 16); }
__device__ __forceinline__ bf16 f2bf(float f) { unsigned u = __float_as_uint(f); return (bf16)((u + 0x7fffu + ((u >> 16) & 1u)) >> 16); }
__device__ __forceinline__ float sigmoidf_(float x) { return 1.f / (1.f + __expf(-x)); }
__device__ __forceinline__ float siluf_(float x) { return x / (1.f + __expf(-x)); }
__device__ __forceinline__ float wave_sum(float v) {
#pragma unroll
    for (int o = 1; o < 64; o <<= 1) v += __shfl_xor(v, o);
    return v;
}

__device__ __forceinline__ int fresh_lane() { int l; asm volatile("v_mbcnt_lo_u32_b32 %0, -1, 0\n\tv_mbcnt_hi_u32_b32 %0, -1, %0" : "=&v"(l)); return l; }
template <int M> __device__ __forceinline__ float sxf(float v) { static_assert(M >= 1 && M < 32, "swizzle xor mask"); return __int_as_float(__builtin_amdgcn_ds_swizzle(__float_as_int(v), (M << 10) | 0x1f)); }
__device__ __forceinline__ float red32_max(float v) { auto r = __builtin_amdgcn_permlane32_swap(__float_as_uint(v), __float_as_uint(v), false, false); return fmaxf(__uint_as_float(r[0]), __uint_as_float(r[1])); }
__device__ __forceinline__ float red32_sum(float v) { auto r = __builtin_amdgcn_permlane32_swap(__float_as_uint(v), __float_as_uint(v), false, false); return __uint_as_float(r[0]) + __uint_as_float(r[1]); }
__device__ __forceinline__ unsigned red32_or(unsigned v) { auto r = __builtin_amdgcn_permlane32_swap(v, v, false, false); return r[0] | r[1]; }
__device__ __forceinline__ float bperm(float v, int src_lane) { return __int_as_float(__builtin_amdgcn_ds_bpermute(src_lane << 2, __float_as_int(v))); }
__device__ __forceinline__ float wave_sum2(float v) { v += sxf<1>(v); v += sxf<2>(v); v += sxf<4>(v); v += sxf<8>(v); v += sxf<16>(v); return red32_sum(v); }
__device__ __forceinline__ float wave_max2(float v) { v = fmaxf(v, sxf<1>(v)); v = fmaxf(v, sxf<2>(v)); v = fmaxf(v, sxf<4>(v)); v = fmaxf(v, sxf<8>(v)); v = fmaxf(v, sxf<16>(v)); return red32_max(v); }
namespace pg8 {
#define PG8_LAS __attribute__((address_space(3)))
typedef unsigned short bf16_t;
typedef short bf16x8 __attribute__((ext_vector_type(8)));
typedef float f32x4 __attribute__((ext_vector_type(4)));
typedef unsigned u32x4 __attribute__((ext_vector_type(4)));
constexpr int BM = 256, BK = 64, HALF = 128, HTB = HALF * BK * 2  , STAGE_BYTES = 8 * HTB, NXCD = 8, WGM = 8;

__host__ __device__ __forceinline__ int lds_byte(int r, int c) { const int st = (r >> 4) * 2 + (c >> 5), rr = r & 15, cc = c & 31, ob = rr * 64 + cc * 2; return st * 1024 + (ob ^ (((ob >> 9) & 1) << 5)); }
__host__ __device__ __forceinline__ void stage_rc(int b, int& R, int& C) { const int st = b / 1024, sb = b % 1024, swz = sb ^ (((sb >> 9) & 1) << 5); R = (st >> 1) * 16 + swz / 64; C = (st & 1) * 32 + (swz % 64) / 2; }
__host__ __device__ __forceinline__ int perm32(int rho) { const int n = rho >> 4, i = rho & 15; return 8 * (i >> 2) + 4 * n + (i & 3); }

struct Unit { int pm, pn; };
struct Gemm { const bf16_t* A; const bf16_t* Bt; int M, N, K; };

struct StaticOrder {
    int nM, nN, nwg, G, c;
    __host__ __device__ void init(int M, int N, int G_, int c_) { nM = M / BM; nN = N / BM; nwg = nM * nN; G = G_; c = c_; }
    __host__ __device__ bool next(int i, Unit& u) const {
        const long L = (long)i * G + c; if (L >= nwg) return false;
        int wgid = (int)L; { const int q = nwg / NXCD, r = nwg % NXCD, xcd = wgid % NXCD, off = wgid / NXCD; wgid = (xcd < r ? xcd * (q + 1) : r * (q + 1) + (xcd - r) * q) + off; }
        const int nig = WGM * nN, gid = wgid / nig, fm = gid * WGM, gsz = (nM - fm) < WGM ? (nM - fm) : WGM;
        u.pm = fm + ((wgid % nig) % gsz); u.pn = (wgid % nig) / gsz; return true;
    }
    __device__ __forceinline__ void a_ready(const Unit&) const {}
    __device__ __forceinline__ void done(const Unit&) const {}
};

__device__ __forceinline__ unsigned cvt_pk_bf16(float lo, float hi) { unsigned r; asm volatile("v_cvt_pk_bf16_f32 %0, %1, %2" : "=v"(r) : "v"(lo), "v"(hi)); return r; }
typedef float f32x2 __attribute__((ext_vector_type(2)));

typedef unsigned u32x4 __attribute__((ext_vector_type(4)));
typedef unsigned u32x2 __attribute__((ext_vector_type(2)));
struct EpiIn {
    static constexpr bool PERM = true, AFTER_DRAIN = false;
    unsigned char* ws; const float *big, *bfg;
#define EPI_ROWS(...) _Pragma("unroll") for (int ai = 0; ai < 2; ++ai) _Pragma("unroll") for (int m = 0; m < 4; ++m) { \
        const int row = u.pm * BM + ai * HALF + wr * 64 + m * 16 + fr; float v[8]; \
        _Pragma("unroll") for (int i = 0; i < 4; ++i) { v[i] = acc[ai][bj][m][0][i]; v[4 + i] = acc[ai][bj][m][1][i]; } \
        asm volatile("" : "+v"(v[0]), "+v"(v[1]), "+v"(v[2]), "+v"(v[3]), "+v"(v[4]), "+v"(v[5]), "+v"(v[6]), "+v"(v[7])); \
        __VA_ARGS__ asm volatile("" ::: "memory"); }
#define EPI_PACK(w) u32x4 w; w.x = cvt_pk_bf16(v[0], v[1]); w.y = cvt_pk_bf16(v[2], v[3]); w.z = cvt_pk_bf16(v[4], v[5]); w.w = cvt_pk_bf16(v[6], v[7]);
    __device__ __forceinline__ void operator()(const f32x4 (&acc)[2][2][4][2], const Unit& u, int wr, int wc, int fr, int fq) const {
        half<0>(acc, u, wr, wc, fr, fq); half<1>(acc, u, wr, wc, fr, fq);
    }
    template <int bj> __device__ __forceinline__ void half(const f32x4 (&acc)[2][2][4][2], const Unit& u, int wr, int wc, int fr, int fq) const {
        {
            const int hb = 2 * u.pn + bj;
            int cb = 32 * wc + 8 * fq; asm volatile("" : "+v"(cb), "+v"(fr));
            if (hb <= 8) {
                bf16_t* nsa = (bf16_t*)(ws + WS_NSA) + hb * 128 + cb;
                const bool rope_hb = (hb <= 3) || hb == 5 || hb == 7;
                if (rope_hb) {
                    const float* cosP = (const float*)(ws + WS_COSP); const float* sinP = (const float*)(ws + WS_SINP);
                    const bool mine = ((wc & 1) == 0) && fq < 2; const float sg = (fq == 0) ? -1.f : 1.f; const float sc = (hb < 3) ? QSCALE : 1.f;
                    EPI_ROWS({
                        float pv[8];
                        _Pragma("unroll") for (int i = 0; i < 8; ++i) pv[i] = sxf<16>(v[i]);
                        if (mine) {
                            const f32x4 c0 = *(const f32x4*)(cosP + row * 8), c1 = *(const f32x4*)(cosP + row * 8 + 4), s0 = *(const f32x4*)(sinP + row * 8), s1 = *(const f32x4*)(sinP + row * 8 + 4);
                            _Pragma("unroll") for (int i = 0; i < 4; ++i) { v[i] = v[i] * c0[i] + sg * pv[i] * s0[i]; v[4 + i] = v[4 + i] * c1[i] + sg * pv[4 + i] * s1[i]; }
                        }
                        _Pragma("unroll") for (int i = 0; i < 8; ++i) v[i] *= sc;
                        EPI_PACK(w) *(u32x4*)(nsa + (size_t)row * 1152) = w;
                    })
                } else {
                    EPI_ROWS({ EPI_PACK(w) *(u32x4*)(nsa + (size_t)row * 1152) = w; })
                }
            } else if (hb <= 11) {
                bf16_t* dst = (hb == 9) ? (bf16_t*)(ws + WS_KVL) + cb : (bf16_t*)(ws + WS_QL) + (hb - 10) * 128 + cb;
                const int ld = (hb == 9) ? 128 : 256;
                float* ssq = (hb == 9) ? (float*)(ws + WS_SSKV) : (float*)(ws + WS_SSQL);
                EPI_ROWS({ EPI_PACK(w) *(u32x4*)(dst + (size_t)row * ld) = w;
                    float sq = 0.f;
                    _Pragma("unroll") for (int i = 0; i < 8; ++i) sq += v[i] * v[i];
                    sq += sxf<16>(sq); sq = red32_sum(sq);
                    if (fq == 0) atomicAdd(ssq + row, sq); })
            } else if (hb <= 17) {
                bf16_t* cm = (bf16_t*)(ws + WS_CM) + (hb - 12) * 128 + cb;
                EPI_ROWS({ EPI_PACK(w) *(u32x4*)(cm + (size_t)row * 768) = w; })
            } else if (hb == 18) {
                float* mr = (float*)(ws + WS_MISCRAW) + cb;
                if (wc < 2) { EPI_ROWS({ *(f32x4*)(mr + (size_t)row * 64) = (f32x4){v[0], v[1], v[2], v[3]}; *(f32x4*)(mr + (size_t)row * 64 + 4) = (f32x4){v[4], v[5], v[6], v[7]}; }) }
            }
        }
    }
#undef EPI_ROWS
#undef EPI_PACK
};
struct EpiUKV {
    static constexpr bool PERM = true, AFTER_DRAIN = false;
    bf16_t* kvm; const float* sskv;
    __device__ __forceinline__ void operator()(const f32x4 (&acc)[2][2][4][2], const Unit& u, int wr, int wc, int fr, int fq) const {
        asm volatile("" : "+v"(fq), "+v"(fr));
        const int col0 = u.pn * BM + wc * 32 + 8 * fq;
#pragma unroll
        for (int ai = 0; ai < 2; ++ai)
#pragma unroll
            for (int m = 0; m < 4; ++m) { const int row = u.pm * BM + ai * HALF + wr * 64 + m * 16 + fr; bf16_t* rowp = kvm + (size_t)row * 768 + col0;
                const float rs = rsqrtf(sskv[row] * (1.f / 128.f) + EPS);
#pragma unroll
                for (int bj = 0; bj < 2; ++bj) { const f32x4 a = acc[ai][bj][m][0] * rs, b = acc[ai][bj][m][1] * rs;
                    u32x4 w; w.x = cvt_pk_bf16(a[0], a[1]); w.y = cvt_pk_bf16(a[2], a[3]); w.z = cvt_pk_bf16(b[0], b[1]); w.w = cvt_pk_bf16(b[2], b[3]);
                    *(u32x4*)(rowp + bj * HALF) = w; }
                asm volatile("" ::: "memory"); }
    }
};
struct EpiPlain {
    static constexpr bool PERM = true, AFTER_DRAIN = false;
    bf16_t* out; int ld;
    __device__ __forceinline__ void operator()(const f32x4 (&acc)[2][2][4][2], const Unit& u, int wr, int wc, int fr, int fq) const {
        asm volatile("" : "+v"(fq), "+v"(fr));
        const int col0 = u.pn * BM + wc * 32 + 8 * fq;
#pragma unroll
        for (int ai = 0; ai < 2; ++ai)
#pragma unroll
            for (int m = 0; m < 4; ++m) { bf16_t* rowp = out + (size_t)(u.pm * BM + ai * HALF + wr * 64 + m * 16 + fr) * ld + col0;
#pragma unroll
                for (int bj = 0; bj < 2; ++bj) { const f32x4 a = acc[ai][bj][m][0], b = acc[ai][bj][m][1];
                    u32x4 w; w.x = cvt_pk_bf16(a[0], a[1]); w.y = cvt_pk_bf16(a[2], a[3]); w.z = cvt_pk_bf16(b[0], b[1]); w.w = cvt_pk_bf16(b[2], b[3]);
                    *(u32x4*)(rowp + bj * HALF) = w; } }
    }
};
struct EpiRes {
    static constexpr bool PERM = false, AFTER_DRAIN = false;
    const float* xin; float* xout; const float* gate;
    __device__ __forceinline__ void operator()(const f32x4 (&acc)[2][2][4][2], const Unit& u, int wr, int wc, int fr, int fq) const {
        asm volatile("" : "+v"(fq), "+v"(fr));
        const int b = (u.pm * BM) / S_; const int col0 = u.pn * BM + wc * 32 + 4 * fq;
        f32x4 gv[2][2];
#pragma unroll
        for (int bj = 0; bj < 2; ++bj)
#pragma unroll
            for (int n = 0; n < 2; ++n) gv[bj][n] = *(const f32x4*)(gate + (size_t)b * 6144 + col0 + bj * HALF + n * 16);
#pragma unroll
        for (int ai = 0; ai < 2; ++ai)
#pragma unroll
            for (int m = 0; m < 4; ++m) { const size_t off = (size_t)(u.pm * BM + ai * HALF + wr * 64 + m * 16 + fr) * D_ + col0;
#pragma unroll
                for (int bj = 0; bj < 2; ++bj)
#pragma unroll
                    for (int n = 0; n < 2; ++n) { const f32x4 xi = *(const f32x4*)(xin + off + bj * HALF + n * 16); *(f32x4*)(xout + off + bj * HALF + n * 16) = xi + gv[bj][n] * acc[ai][bj][m][n]; } }
    }
};
struct EpiGU {
    static constexpr bool PERM = true, AFTER_DRAIN = false;
    bf16_t* act;
    __device__ __forceinline__ void operator()(const f32x4 (&acc)[2][2][4][2], const Unit& u, int wr, int wc, int fr, int fq) const {
        asm volatile("" : "+v"(fq), "+v"(fr));
        const int col0 = u.pn * HALF + wc * 32 + 8 * fq;
#pragma unroll
        for (int ai = 0; ai < 2; ++ai)
#pragma unroll
            for (int m = 0; m < 4; ++m) { const int row = u.pm * BM + ai * HALF + wr * 64 + m * 16 + fr; float o[8];
#pragma unroll
                for (int n = 0; n < 2; ++n)
#pragma unroll
                    for (int i = 0; i < 4; ++i) { const float g = acc[ai][0][m][n][i], up = acc[ai][1][m][n][i]; o[4 * n + i] = g / (1.f + __expf(-g)) * up; }
                u32x4 w; w.x = cvt_pk_bf16(o[0], o[1]); w.y = cvt_pk_bf16(o[2], o[3]); w.z = cvt_pk_bf16(o[4], o[5]); w.w = cvt_pk_bf16(o[6], o[7]);
                *(u32x4*)(act + (size_t)row * FF + col0) = w; }
    }
};
template <class Epi, class Sched, bool ALIGN_EPI = false, bool SP2 = false>
__device__ __forceinline__ void gemm_phase(PG8_LAS unsigned char* lds, const Gemm g, const Sched& S, const Epi& E, int wid_in) {
    const int wid = __builtin_amdgcn_readfirstlane(wid_in), lane = fresh_lane(), tid = wid * 64 + lane, wr = wid >> 2, wc = wid & 3;
    const int K = g.K, nt = K / BK;
    unsigned voffA[2], voffB[2];
#pragma unroll
    for (int i = 0; i < 2; ++i) { int R, C; stage_rc(tid * 16 + i * 8192, R, C); const int Rb = Epi::PERM ? ((R & ~31) + perm32(R & 31)) : R;
        voffA[i] = (unsigned)(R * K + C) * 2u; voffB[i] = (unsigned)(Rb * K + C) * 2u; }
    const size_t kstep = (size_t)(BK * 2);
    const size_t hstep = (size_t)HALF * K * 2;
    const size_t tstep = 2 * hstep;
    const unsigned ldsw = (unsigned)wid * 1024u;
    const int aoff = lds_byte(wr * 64 + (lane & 15), (lane >> 4) * 8), boff = lds_byte(wc * 32 + (lane & 15), (lane >> 4) * 8);
#define PG8_SA(b, h) (((b) * 2 + (h)) * HTB)
#define PG8_SB(b, h) ((4 + (b) * 2 + (h)) * HTB)
#define PG8_STAGE(bufoff, gbase, voff) do { _Pragma("unroll") for (int _i = 0; _i < 2; ++_i) \
        __builtin_amdgcn_global_load_lds((const unsigned*)((const char*)(gbase) + (voff)[_i]), (PG8_LAS unsigned*)(lds + (bufoff) + ldsw + _i * 8192), 16, 0, 0); } while (0)
#define PG8_LDA(dst, b, h) do { _Pragma("unroll") for (int m = 0; m < 4; ++m) _Pragma("unroll") for (int k = 0; k < 2; ++k) dst[m][k] = *(const PG8_LAS bf16x8*)(lds + PG8_SA(b, h) + aoff + m * 2048 + k * 1024); } while (0)
#define PG8_LDB(dst, b, h) do { _Pragma("unroll") for (int n = 0; n < 2; ++n) _Pragma("unroll") for (int k = 0; k < 2; ++k) dst[n][k] = *(const PG8_LAS bf16x8*)(lds + PG8_SB(b, h) + boff + n * 2048 + k * 1024); } while (0)
#define PG8_MMA(ai, bj, At, Bt) do { __builtin_amdgcn_s_setprio(1); _Pragma("unroll") for (int m = 0; m < 4; ++m) _Pragma("unroll") for (int n = 0; n < 2; ++n) _Pragma("unroll") for (int k = 0; k < 2; ++k) \
        acc[ai][bj][m][n] = __builtin_amdgcn_mfma_f32_16x16x32_bf16(Bt[n][k], At[m][k], acc[ai][bj][m][n], 0, 0, 0); __builtin_amdgcn_s_setprio(0); } while (0)
#define PG8_WAIT_V(n) asm volatile("s_waitcnt vmcnt(" #n ")" ::: "memory")
#define PG8_WAIT_L(n) asm volatile("s_waitcnt lgkmcnt(" #n ")" ::: "memory")
#define PG8_BAR __builtin_amdgcn_s_barrier()
#define PG8_SCHED __builtin_amdgcn_sched_barrier(0)
    Unit cur, nxt; int ui = 0;
    if (!S.next(0, cur)) return;
    f32x4 acc[2][2][4][2];
#pragma unroll
    for (int a = 0; a < 2; ++a)
#pragma unroll
        for (int b = 0; b < 2; ++b)
#pragma unroll
            for (int m = 0; m < 4; ++m)
#pragma unroll
                for (int n = 0; n < 2; ++n) acc[a][b][m][n] = (f32x4){0.f, 0.f, 0.f, 0.f};
    bf16x8 At[4][2], B0[2][2], B1[2][2];
    const char* cA = (const char*)g.A + (size_t)cur.pm * tstep; const char* cB = (const char*)g.Bt + (size_t)cur.pn * tstep;
    S.a_ready(cur);
    if constexpr (SP2) {
        PG8_STAGE(PG8_SB(0, 0), cB, voffB); PG8_STAGE(PG8_SB(0, 1), cB + hstep, voffB); PG8_STAGE(PG8_SA(0, 0), cA, voffA); PG8_STAGE(PG8_SA(0, 1), cA + hstep, voffA);
        if (wr == 1) PG8_BAR;
        PG8_WAIT_V(2); PG8_BAR;
        PG8_STAGE(PG8_SB(1, 0), cB + kstep, voffB); PG8_STAGE(PG8_SA(1, 0), cA + kstep, voffA); PG8_STAGE(PG8_SB(1, 1), cB + hstep + kstep, voffB);
        PG8_WAIT_V(6); PG8_BAR;
    } else {
        PG8_STAGE(PG8_SB(0, 0), cB, voffB); PG8_STAGE(PG8_SA(0, 0), cA, voffA); PG8_STAGE(PG8_SB(0, 1), cB + hstep, voffB); PG8_STAGE(PG8_SA(0, 1), cA + hstep, voffA);
        if (wr == 1) PG8_BAR;
        PG8_WAIT_V(4); PG8_BAR;
        PG8_STAGE(PG8_SB(1, 0), cB + kstep, voffB); PG8_STAGE(PG8_SA(1, 0), cA + kstep, voffA); PG8_STAGE(PG8_SB(1, 1), cB + hstep + kstep, voffB);
        PG8_WAIT_V(6); PG8_BAR;
    }
    for (;;) {
        const bool has_next = S.next(ui + 1, nxt);
        const char* nA = has_next ? (const char*)g.A + (size_t)nxt.pm * tstep : cA; const char* nB = has_next ? (const char*)g.Bt + (size_t)nxt.pn * tstep : cB;
        for (int t = 0; t < nt; t += 2) {
            const bool last = (t == nt - 2);
            const char* a1 = cA + (size_t)(t + 1) * kstep;
            const char* a2 = last ? nA : cA + (size_t)(t + 2) * kstep; const char* b2 = last ? nB : cB + (size_t)(t + 2) * kstep;
            const char* a3 = a2 + kstep; const char* b3 = b2 + kstep;
            if (last && has_next) S.a_ready(nxt);
            if constexpr (SP2) {
            PG8_LDB(B0, 0, 0); PG8_LDB(B1, 0, 1); PG8_SCHED; PG8_LDA(At, 0, 0); PG8_STAGE(PG8_SA(1, 1), a1 + hstep, voffA);
            PG8_WAIT_V(8); PG8_WAIT_L(0); PG8_BAR; PG8_MMA(0, 0, At, B0); PG8_MMA(0, 1, At, B1); PG8_BAR; PG8_SCHED;
            PG8_LDA(At, 0, 1); PG8_STAGE(PG8_SB(0, 0), b2, voffB); PG8_STAGE(PG8_SB(0, 1), b2 + hstep, voffB); PG8_STAGE(PG8_SA(0, 0), a2, voffA);
            PG8_WAIT_V(8); PG8_WAIT_L(0); PG8_BAR; PG8_MMA(1, 0, At, B0); PG8_MMA(1, 1, At, B1); PG8_BAR; PG8_SCHED;
            PG8_LDB(B0, 1, 0); PG8_LDB(B1, 1, 1); PG8_SCHED; PG8_LDA(At, 1, 0); PG8_STAGE(PG8_SA(0, 1), a2 + hstep, voffA);
            PG8_WAIT_V(8); PG8_WAIT_L(0); PG8_BAR; PG8_MMA(0, 0, At, B0); PG8_MMA(0, 1, At, B1); PG8_BAR; PG8_SCHED;
            PG8_LDA(At, 1, 1); PG8_STAGE(PG8_SB(1, 0), b3, voffB); PG8_STAGE(PG8_SB(1, 1), b3 + hstep, voffB); PG8_STAGE(PG8_SA(1, 0), a3, voffA);
            PG8_WAIT_V(8); PG8_WAIT_L(0); PG8_BAR; PG8_MMA(1, 0, At, B0); PG8_MMA(1, 1, At, B1); PG8_BAR; PG8_SCHED;
            } else {
            PG8_LDB(B0, 0, 0); PG8_SCHED; PG8_LDA(At, 0, 0); PG8_STAGE(PG8_SA(1, 1), a1 + hstep, voffA);
            PG8_WAIT_L(8); PG8_BAR; PG8_WAIT_L(0); PG8_MMA(0, 0, At, B0); PG8_BAR; PG8_SCHED;
            PG8_LDB(B1, 0, 1); PG8_STAGE(PG8_SB(0, 0), b2, voffB);
            PG8_BAR; PG8_WAIT_L(0); PG8_MMA(0, 1, At, B1); PG8_BAR;
            PG8_LDA(At, 0, 1); PG8_STAGE(PG8_SA(0, 0), a2, voffA);
            PG8_BAR; PG8_WAIT_L(0); PG8_MMA(1, 0, At, B0); PG8_BAR; PG8_SCHED;
            PG8_STAGE(PG8_SB(0, 1), b2 + hstep, voffB);
            PG8_WAIT_V(6); PG8_BAR; PG8_MMA(1, 1, At, B1); PG8_BAR;
            PG8_LDB(B0, 1, 0); PG8_SCHED; PG8_LDA(At, 1, 0); PG8_STAGE(PG8_SA(0, 1), a2 + hstep, voffA);
            PG8_WAIT_L(8); PG8_BAR; PG8_WAIT_L(0); PG8_MMA(0, 0, At, B0); PG8_BAR; PG8_SCHED;
            PG8_LDB(B1, 1, 1); PG8_STAGE(PG8_SB(1, 0), b3, voffB);
            PG8_BAR; PG8_WAIT_L(0); PG8_MMA(0, 1, At, B1); PG8_BAR;
            PG8_LDA(At, 1, 1); PG8_STAGE(PG8_SA(1, 0), a3, voffA);
            PG8_BAR; PG8_WAIT_L(0); PG8_MMA(1, 0, At, B0); PG8_BAR; PG8_SCHED;
            PG8_STAGE(PG8_SB(1, 1), b3 + hstep, voffB);
            PG8_WAIT_V(6); PG8_BAR; PG8_MMA(1, 1, At, B1); PG8_BAR;
            }
        }
        if constexpr (ALIGN_EPI) { if (wr == 0) PG8_BAR; }
        if constexpr (!Epi::AFTER_DRAIN) { const int ln = fresh_lane(); E(acc, cur, wr, wc, ln & 15, ln >> 4); S.done(cur); }
        if (!has_next) break;
#pragma unroll
        for (int a = 0; a < 2; ++a)
#pragma unroll
            for (int b = 0; b < 2; ++b)
#pragma unroll
                for (int m = 0; m < 4; ++m)
#pragma unroll
                    for (int n = 0; n < 2; ++n) acc[a][b][m][n] = (f32x4){0.f, 0.f, 0.f, 0.f};
        cur = nxt; cA = nA; cB = nB; ++ui;
        if constexpr (ALIGN_EPI) { if (wr == 1) PG8_BAR; }
    }
    PG8_WAIT_V(0);
    if constexpr (!ALIGN_EPI) { if (wr == 0) PG8_BAR; }
    PG8_BAR;
    if constexpr (Epi::AFTER_DRAIN) { const int ln = fresh_lane(); E.fused(acc, cur, wr, wc, ln & 15, ln >> 4, lds, wid, ln); S.done(cur); }
#undef PG8_SA
#undef PG8_SB
#undef PG8_STAGE
#undef PG8_LDA
#undef PG8_LDB
#undef PG8_MMA
#undef PG8_WAIT_V
#undef PG8_WAIT_L
#undef PG8_BAR
#undef PG8_SCHED
}
}

#define GAS __attribute__((address_space(1)))
#define LAS __attribute__((address_space(3)))
typedef float f32x4 __attribute__((ext_vector_type(4)));
typedef unsigned v4u __attribute__((ext_vector_type(4)));
typedef GAS unsigned gu32;
#define XB_TMO      128
#define XB_XCNT(j)  (256  + 64 * (j))
#define XB_XSUB(j)  (1280 + 64 * (j))
#define XB_XGEN(j)  (2304 + 64 * (j))
#define XB_TOP      3328
#define XB_TOPGEN   3392
#define XCD_BAR_WORDS 3456
#define XB_SPIN_CAP (1u << 18)

__device__ __forceinline__ unsigned xb_ld(unsigned* p)              { return __hip_atomic_load(p, __ATOMIC_RELAXED, __HIP_MEMORY_SCOPE_AGENT); }
__device__ __forceinline__ unsigned xb_add(unsigned* p, unsigned v) { return __hip_atomic_fetch_add(p, v, __ATOMIC_RELAXED, __HIP_MEMORY_SCOPE_AGENT); }
__device__ __forceinline__ unsigned xb_xcc_id() { return (unsigned)__builtin_amdgcn_s_getreg((3 << 11) | 20) & 0xFu; }
#define XB_SPIN(cond, bar) do { unsigned _sp = 0; while (cond) { __builtin_amdgcn_s_sleep(1); \
    if ((++_sp & 255u) == 0u) { if (xb_ld(&(bar)[XB_TMO])) break; if (_sp > XB_SPIN_CAP) { atomicAdd(&(bar)[XB_TMO], 1u); break; } } } } while (0)

struct XcdBarrier {
    unsigned* bar; unsigned x;
    volatile LAS unsigned* st;
};

__device__ __forceinline__ XcdBarrier xcd_barrier_post(unsigned* bar, volatile LAS unsigned* st, int tid) {
    XcdBarrier b; b.bar = bar; b.x = xb_xcc_id(); b.st = st;
    if (tid == 0) (void)xb_add(&bar[XB_XCNT(b.x)], 1u);
    return b;
}
__device__ __forceinline__ void xcd_barrier_complete(unsigned* bar, unsigned x, unsigned& nloc, unsigned& nx) {
    const unsigned G = gridDim.x * gridDim.y * gridDim.z;
    unsigned sum, cnt, mine, sp = 0u;
    for (;;) {
        sum = 0u; cnt = 0u; mine = 0u;
#pragma unroll
        for (unsigned j = 0; j < 16; ++j) { const unsigned c = xb_ld(&bar[XB_XCNT(j)]); sum += c; cnt += (c > 0u) ? 1u : 0u; mine = (j == x) ? c : mine; }
        if (sum == G) break;
        __builtin_amdgcn_s_sleep(1);
        if ((++sp & 255u) == 0u) { if (xb_ld(&bar[XB_TMO])) break; if (sp > XB_SPIN_CAP) { atomicAdd(&bar[XB_TMO], 1u); break; } }
    }
    nloc = mine > 0u ? mine : 1u; nx = cnt > 0u ? cnt : 1u;
}

__device__ __forceinline__ void xcd_barrier(const XcdBarrier& b, int tid) {
    asm volatile("s_waitcnt vmcnt(0)" ::: "memory");
    __syncthreads();
    if (tid == 0) {
        unsigned* bar = b.bar;
        __builtin_amdgcn_s_waitcnt(0);
        unsigned nloc = b.st[0], nx = b.st[1];
        if (nloc == 0u) { xcd_barrier_complete(bar, b.x, nloc, nx); b.st[0] = nloc; b.st[1] = nx; }
        const unsigned old = xb_add(&bar[XB_XSUB(b.x)], 1u);
        const unsigned gen = old / nloc;
        if (old + 1u == (gen + 1u) * nloc) {
            __builtin_amdgcn_fence(__ATOMIC_RELEASE, "agent");
            asm volatile("s_waitcnt vmcnt(0)" ::: "memory");
            const unsigned og = xb_add(&bar[XB_TOP], 1u);
            const unsigned tg = og / nx;
            if (og + 1u == (tg + 1u) * nx) xb_add(&bar[XB_TOPGEN], 1u);
            else XB_SPIN(xb_ld(&bar[XB_TOPGEN]) == tg, bar);
            __builtin_amdgcn_fence(__ATOMIC_ACQUIRE, "agent");
            xb_add(&bar[XB_XGEN(b.x)], 1u);
            asm volatile("s_waitcnt vmcnt(0)" ::: "memory");
        } else {
            XB_SPIN(xb_ld(&bar[XB_XGEN(b.x)]) == gen, bar);
            __builtin_amdgcn_fence(__ATOMIC_ACQUIRE, "agent");
            asm volatile("s_waitcnt vmcnt(0)" ::: "memory");
        }
    }
    __syncthreads();
}

constexpr int NTHR = 512, NWAVES = 8;
constexpr int RING_BYTES = 131072, MISC_OFF = RING_BYTES + 320, LDS_BYTES = 147456;
constexpr int CW_BAR = 4096;
constexpr size_t CTL_ZERO_BYTES = 64 * 1024;
constexpr size_t WT_IN = WS_WT, WT_OUT = WT_IN + (size_t)2560 * 1024 * 2, WT_GU = WT_OUT + (size_t)1024 * 1024 * 2, WT_DOWN = WT_GU + (size_t)5632 * 1024 * 2,
                 WT_UQ = WT_DOWN + (size_t)1024 * 2816 * 2, WT_UKV = WT_UQ + (size_t)768 * 256 * 2, WT_CK = WT_UKV + (size_t)768 * 128 * 2, WT_CV = WT_CK + (size_t)64 * 2048 * 2,
                 WT_QM = WT_CV + (size_t)64 * 2048 * 2, WT_KM = WT_QM + 4 * 64 * 64 * 2, WT_END = WT_KM + 4 * 64 * 64 * 2;
static_assert(WT_END <= WS_HB, "weights");
constexpr int NPH = 22, PPL = 10;
constexpr int PROBE_SEL = 0;
constexpr int REP_MASK = 0;
#ifndef PHM
#define PHM 0xffff
#endif
struct MP { const float* in[N_IN]; float* out; unsigned char* ws; int ph_lo, ph_hi, coop, pad; };

struct MPK {
    const __attribute__((address_space(4))) MP* k;
    struct InArr { const __attribute__((address_space(4))) MP* k; __device__ __forceinline__ const float* operator[](int i) const { return k->in[i]; } };
    __device__ __forceinline__ InArr in_() const { return InArr{k}; }
};
#define PIN(i) (p.k->in[i])
__device__ __forceinline__ unsigned pk2(float lo, float hi) { return (unsigned)f2bf(lo) | ((unsigned)f2bf(hi) << 16); }
struct MapId { int n; __device__ __forceinline__ int operator()(int c) const { return c < n ? c : -1; } };
struct MapIn { __device__ __forceinline__ int operator()(int c) const {
    if (c < 1152) return c; if (c < 1280) return 1426 + (c - 1152); if (c < 1536) return 1170 + (c - 1280); if (c < 2304) return 1586 + (c - 1536);
    if (c < 2336) return 1554 + (c - 2304); if (c < 2354) return 1152 + (c - 2336); if (c < 2362) return c; return -1; } };
struct MapGU { __device__ __forceinline__ int operator()(int c) const { const int t = c >> 8, w = c & 255; return (w < 128) ? t * 128 + w : FF + t * 128 + (w - 128); } };
template <class Map> __device__ __forceinline__ void transpose_item(const float* W, int K, int ldw, const Map& map, const float* kscale, bf16* WT, LAS float* scr, int item, int nblk, int lane) {
    const int kb = item / nblk, nb = item % nblk, k0 = 64 * kb, n0 = 32 * nb;
    const int np = 2 * (lane & 15);
    const int sc = map(n0 + np);
#pragma unroll 8
    for (int i = 0; i < 16; ++i) { const int kk = 4 * i + (lane >> 4); float2 v = (sc >= 0) ? *(const float2*)(W + (size_t)(k0 + kk) * ldw + sc) : make_float2(0.f, 0.f);
        if (kscale) { const float ksc = kscale[k0 + kk]; v.x *= ksc; v.y *= ksc; } scr[kk * 33 + np] = v.x; scr[kk * 33 + np + 1] = v.y; }
    asm volatile("s_waitcnt lgkmcnt(0)" ::: "memory");
    const int c = lane & 7;
#pragma unroll
    for (int j = 0; j < 4; ++j) { const int n = (lane >> 3) + 8 * j; const LAS float* s = scr + (8 * c) * 33 + n;
        v4u o; o.x = pk2(s[0 * 33], s[1 * 33]); o.y = pk2(s[2 * 33], s[3 * 33]); o.z = pk2(s[4 * 33], s[5 * 33]); o.w = pk2(s[6 * 33], s[7 * 33]);
        *(v4u*)(WT + (size_t)(n0 + n) * K + k0 + 8 * c) = o; }
    asm volatile("s_waitcnt lgkmcnt(0)" ::: "memory");
}
__device__ __forceinline__ void norm_row_finish(const float4 (&v)[4], float ssq, const float* g, const float* shift, const float* scale, bf16* hb, float* outf, int mode, int m, int lane) {
    const float rstd = rsqrtf(ssq * (1.f / D_) + EPS);
    const int b = m / S_;
#pragma unroll
    for (int j = 0; j < 4; ++j) {
        const int col = 4 * lane + 256 * j;
        const float4 gg = *(const float4*)(g + col);
        float4 o; o.x = v[j].x * rstd * gg.x; o.y = v[j].y * rstd * gg.y; o.z = v[j].z * rstd * gg.z; o.w = v[j].w * rstd * gg.w;
        if (mode == 2) { *(float4*)(outf + (size_t)m * D_ + col) = o; }
        else {
            const float4 sc = *(const float4*)(scale + (size_t)b * 6144 + col), sh = *(const float4*)(shift + (size_t)b * 6144 + col);
            o.x = o.x * (1.f + sc.x) + sh.x; o.y = o.y * (1.f + sc.y) + sh.y; o.z = o.z * (1.f + sc.z) + sh.z; o.w = o.w * (1.f + sc.w) + sh.w;
            uint2 w; w.x = pk2(o.x, o.y); w.y = pk2(o.z, o.w);
            *(uint2*)(hb + (size_t)m * D_ + col) = w;
        }
    }
}
__device__ __forceinline__ void norm_rows(const float* x, const float* g, const float* shift, const float* scale, bf16* hb, float* outf, int mode, int gw, int ngw, int lane) {
    for (int m = gw; m < T_; m += 2 * ngw) {
        const int m2 = m + ngw;
        const float4* xr = (const float4*)(x + (size_t)m * D_) + lane; const float4* xr2 = (const float4*)(x + (size_t)m2 * D_) + lane;
        float4 v[4], w[4]; float s = 0.f, s2 = 0.f;
#pragma unroll
        for (int j = 0; j < 4; ++j) { v[j] = xr[64 * j]; w[j] = xr2[64 * j]; }
#pragma unroll
        for (int j = 0; j < 4; ++j) { s += v[j].x * v[j].x + v[j].y * v[j].y + v[j].z * v[j].z + v[j].w * v[j].w; s2 += w[j].x * w[j].x + w[j].y * w[j].y + w[j].z * w[j].z + w[j].w * w[j].w; }
        norm_row_finish(v, wave_sum2(s), g, shift, scale, hb, outf, mode, m, lane);
        norm_row_finish(w, wave_sum2(s2), g, shift, scale, hb, outf, mode, m2, lane);
    }
}
__device__ __forceinline__ void ph_p0(const MPK& p, LAS unsigned char* lds, int tid) {
    const int wave = tid >> 6, lane = tid & 63;
    LAS float* ca = (LAS float*)lds; LAS float* red = ca + 8192;
    unsigned char* ws = p.k->ws; float* mod = (float*)(ws + WS_MOD);
    const float* c = PIN(I_C);
    for (int i = tid; i < 8192; i += NTHR) ca[i] = siluf_(c[i]);
    __syncthreads();
    for (int item = blockIdx.x; item < 192; item += gridDim.x) {
        const int l = item / 96, j = (item % 96) * 64 + lane;
        const float* w = PIN(I_WADA) + (size_t)l * 1024 * 6144 + j;
        float acc[8];
#pragma unroll
        for (int b = 0; b < 8; ++b) acc[b] = 0.f;
#pragma unroll 4
        for (int k = wave * 128; k < wave * 128 + 128; ++k) {
            const float wv = w[(size_t)k * 6144];
#pragma unroll
            for (int b = 0; b < 8; ++b) acc[b] += ca[b * 1024 + k] * wv;
        }
#pragma unroll
        for (int b = 0; b < 8; ++b) red[(wave * 8 + b) * 64 + lane] = acc[b];
        __syncthreads();
        { const int b = wave; float s = 0.f;
#pragma unroll
          for (int w8 = 0; w8 < 8; ++w8) s += red[(w8 * 8 + b) * 64 + lane];
          mod[((size_t)l * 8 + b) * 6144 + j] = s + PIN(I_BADA)[l * 6144 + j]; }
        __syncthreads();
    }
    const int* pos = (const int*)PIN(I_POS);
    float *cosP = (float*)(ws + WS_COSP), *sinP = (float*)(ws + WS_SINP), *cosM = (float*)(ws + WS_COSM), *sinM = (float*)(ws + WS_SINM);
    for (int i = blockIdx.x * NTHR + tid; i < T_ * 24; i += gridDim.x * NTHR) {
        const int m = i / 24, f = i % 24;
        double inv; if (f < 8) inv = pow(500000.0, -(double)(2 * f) / 16.0); else inv = pow(500000.0, -(double)(2 * (f - 8)) / 32.0);
        const float ang = (float)pos[m] * (float)inv;
        const double a = (double)ang, kq = rint(a * 0.15915494309189535), r = a - kq * 6.283185307179586476925;
        const float cs = (float)cos(r), sn = (float)sin(r);
        if (f < 8) { cosP[m * 8 + f] = cs; sinP[m * 8 + f] = sn; } else { cosM[m * 16 + f - 8] = cs; sinM[m * 16 + f - 8] = sn; }
    }
}
__device__ __forceinline__ void ph_prep(const MPK& p, int l, LAS unsigned char* lds, int tid) {
    const int wave = tid >> 6, lane = tid & 63;
    const int gw = blockIdx.x * NWAVES + wave, ngw = gridDim.x * NWAVES;
    unsigned char* ws = p.k->ws;
    LAS float* scr = (LAS float*)(lds + wave * 8704);
    for (int i = blockIdx.x * NTHR + tid; i < 2 * T_; i += gridDim.x * NTHR) ((float*)(ws + WS_SSQL))[i] = 0.f;
    constexpr int I0 = 16 * 80, I4 = 4 * 24, I5 = 2 * 24, I6 = 32 * 2, I7 = 32 * 2, I8 = 8, I9 = 8;
    constexpr int NIT = I0 + I4 + I5 + I6 + I7 + I8 + I9;
    for (int it = gw; it < NIT; it += ngw) {
        int r = it;
        if (r < I0) { transpose_item(PIN(I_WIN) + (size_t)l * D_ * DIN, D_, DIN, MapIn{}, nullptr, (bf16*)(ws + WT_IN), scr, r, 80, lane); continue; } r -= I0;
        if (r < I4) { transpose_item(PIN(I_WUQ) + (size_t)l * 256 * 576, 256, 576, MapId{576}, PIN(I_GQL) + l * 256, (bf16*)(ws + WT_UQ), scr, r, 24, lane); continue; } r -= I4;
        if (r < I5) { transpose_item(PIN(I_WUKV) + (size_t)l * 128 * 768, 128, 768, MapId{768}, PIN(I_GKVL) + l * 128, (bf16*)(ws + WT_UKV), scr, r, 24, lane); continue; } r -= I5;
        if (r < I6) { transpose_item(PIN(I_WCK) + (size_t)l * 2048 * 64, 2048, 64, MapId{64}, nullptr, (bf16*)(ws + WT_CK), scr, r, 2, lane); continue; } r -= I6;
        if (r < I7) { transpose_item(PIN(I_WCV) + (size_t)l * 2048 * 64, 2048, 64, MapId{64}, nullptr, (bf16*)(ws + WT_CV), scr, r, 2, lane); continue; } r -= I7;
        if (r < I8) { const int h = r >> 1; transpose_item(PIN(I_WQM) + (size_t)l * 16384 + h * 4096, 64, 64, MapId{64}, nullptr, (bf16*)(ws + WT_QM) + h * 4096, scr, r & 1, 2, lane); continue; } r -= I8;
        { const int h = r >> 1; transpose_item(PIN(I_WKM) + (size_t)l * 16384 + h * 4096, 64, 64, MapId{64}, nullptr, (bf16*)(ws + WT_KM) + h * 4096, scr, r & 1, 2, lane); }
    }
    const float* xin = (l == 0) ? PIN(I_X) : p.k->out;
    const float* modl = (const float*)(ws + WS_MOD) + (size_t)l * 8 * 6144;
    norm_rows(xin, PIN(I_GN1) + l * D_, modl + 0, modl + 1024, (bf16*)(ws + WS_HB), nullptr, 0, gw, ngw, lane);
}
__device__ __forceinline__ void late_transposes(const MPK& p, int l, LAS unsigned char* lds, int tid, int first) {
    const int wave = tid >> 6, lane = tid & 63;
    if ((int)blockIdx.x < first) return;
    const int gw = ((int)blockIdx.x - first) * NWAVES + wave, ngw = ((int)gridDim.x - first) * NWAVES;
    unsigned char* ws = p.k->ws;
    LAS float* scr = (LAS float*)(lds + wave * 8704);
    constexpr int I1 = 16 * 32, I2 = 16 * 176, I3 = 44 * 32;
    for (int it = gw; it < I1 + I2 + I3; it += ngw) {
        int r = it;
        if (r < I1) { transpose_item(PIN(I_WOUT) + (size_t)l * D_ * D_, D_, D_, MapId{D_}, nullptr, (bf16*)(ws + WT_OUT), scr, r, 32, lane); continue; } r -= I1;
        if (r < I2) { transpose_item(PIN(I_WGU) + (size_t)l * D_ * 2 * FF, D_, 2 * FF, MapGU{}, nullptr, (bf16*)(ws + WT_GU), scr, r, 176, lane); continue; } r -= I2;
        transpose_item(PIN(I_WDOWN) + (size_t)l * FF * D_, FF, D_, MapId{D_}, nullptr, (bf16*)(ws + WT_DOWN), scr, r, 32, lane);
    }
}
__device__ __forceinline__ void ph_mixnorm(const MPK& p, int l, int tid) {
    const int gw = blockIdx.x * NWAVES + (tid >> 6), ngw = gridDim.x * NWAVES, lane = tid & 63;
    unsigned char* ws = p.k->ws;
    bf16* mix = (bf16*)(ws + WS_HB); const float* ga = PIN(I_GOA) + l * 384; const float* gb = PIN(I_GOB) + l * 384;
    const bf16 *oc = (const bf16*)(ws + WS_OCMP), *os = (const bf16*)(ws + WS_OSLC), *ow = (const bf16*)(ws + WS_OWIN); const float* gm = (const float*)(ws + WS_GM);
#define UNPK8(dst, src) dst[0] = __uint_as_float(src.x << 16); dst[1] = __uint_as_float(src.x & 0xffff0000u); dst[2] = __uint_as_float(src.y << 16); dst[3] = __uint_as_float(src.y & 0xffff0000u); \
    dst[4] = __uint_as_float(src.z << 16); dst[5] = __uint_as_float(src.z & 0xffff0000u); dst[6] = __uint_as_float(src.w << 16); dst[7] = __uint_as_float(src.w & 0xffff0000u);
    for (int m = gw; m < T_; m += ngw) {
        bf16* r = mix + (size_t)m * D_;
        float v0[8], v1[8]; float sa = 0.f, sb = 0.f;
        if (lane < 48) {
            const size_t o = (size_t)m * 384 + lane * 8; const float* g3 = gm + (size_t)m * 32 + 3 * (lane >> 3);
            const float g0 = g3[0], g1 = g3[1], g2 = g3[2];
            const v4u c4 = *(const v4u*)(oc + o), s4 = *(const v4u*)(os + o), w4 = *(const v4u*)(ow + o);
            float c8[8], s8[8], w8[8]; UNPK8(c8, c4) UNPK8(s8, s4) UNPK8(w8, w4)
#pragma unroll
            for (int i = 0; i < 8; ++i) { v0[i] = g0 * c8[i] + g1 * s8[i] + g2 * w8[i]; sa += v0[i] * v0[i]; }
        } else {
            const v4u y4 = *(const v4u*)(r + 384 + (lane - 48) * 8); UNPK8(v0, y4)
#pragma unroll
            for (int i = 0; i < 8; ++i) sb += v0[i] * v0[i];
        }
        if (lane < 32) { const v4u y4 = *(const v4u*)(r + 384 + (16 + lane) * 8); UNPK8(v1, y4)
#pragma unroll
            for (int i = 0; i < 8; ++i) sb += v1[i] * v1[i]; }
        const float ra = rsqrtf(wave_sum2(sa) * (1.f / 384.f) + EPS), rb = rsqrtf(wave_sum2(sb) * (1.f / 384.f) + EPS);
        {
            const int col = (lane < 48) ? lane * 8 : 384 + (lane - 48) * 8; const float* gg = (lane < 48) ? ga + lane * 8 : gb + (lane - 48) * 8; const float rr = (lane < 48) ? ra : rb;
            const float4 g0 = *(const float4*)gg, g1 = *(const float4*)(gg + 4);
            v4u w; w.x = pk2(v0[0] * rr * g0.x, v0[1] * rr * g0.y); w.y = pk2(v0[2] * rr * g0.z, v0[3] * rr * g0.w); w.z = pk2(v0[4] * rr * g1.x, v0[5] * rr * g1.y); w.w = pk2(v0[6] * rr * g1.z, v0[7] * rr * g1.w);
            *(v4u*)(r + col) = w;
        }
        if (lane < 32) { const float* gg = gb + (16 + lane) * 8; const float4 g0 = *(const float4*)gg, g1 = *(const float4*)(gg + 4);
            v4u w; w.x = pk2(v1[0] * rb * g0.x, v1[1] * rb * g0.y); w.y = pk2(v1[2] * rb * g0.z, v1[3] * rb * g0.w); w.z = pk2(v1[4] * rb * g1.x, v1[5] * rb * g1.y); w.w = pk2(v1[6] * rb * g1.z, v1[7] * rb * g1.w);
            *(v4u*)(r + 384 + (16 + lane) * 8) = w; }
    }
#undef UNPK8
}


typedef short bf16x8 __attribute__((ext_vector_type(8)));
typedef short s16x4 __attribute__((ext_vector_type(4)));
typedef float f32x16 __attribute__((ext_vector_type(16)));
typedef unsigned u32x2v __attribute__((ext_vector_type(2)));
constexpr int AT_BUF = 20480, AT_K32 = 8192, AT_V = 12288;
__device__ __forceinline__ unsigned cvtpk(float lo, float hi) { unsigned r; asm volatile("v_cvt_pk_bf16_f32 %0, %1, %2" : "=v"(r) : "v"(lo), "v"(hi)); return r; }
__device__ __forceinline__ float max3f(float a, float b, float c) { float r; asm("v_max3_f32 %0, %1, %2, %3" : "=v"(r) : "v"(a), "v"(b), "v"(c)); return r; }
__device__ __forceinline__ int crow(int r, int hi) { return (r & 3) + 8 * (r >> 2) + 4 * hi; }
__device__ __forceinline__ s16x4 vtr(LAS const unsigned char* p) { return __builtin_bit_cast(s16x4, __builtin_amdgcn_ds_read_tr16_b64_v4i16((LAS s16x4*)p)); }
enum { AM_CAUSAL = 0, AM_WINDOW = 1, AM_SLC = 2 };
struct AttnState { float m, l; f32x16 o[2]; f32x16 negm; bool started; long long twait; };
template <int NC> struct TileRegs { v4u k; v4u k2; v4u v; };
template <int NC> __device__ __forceinline__ void at_load(TileRegs<NC>& r, const bf16* Kg, int ldk, const bf16* Vg, int ldv, const bf16* K2g, int ldk2, int tile, int tid) {
    const int key = tid >> 3, c = tid & 7;
    r.k = *(const v4u*)(Kg + (size_t)(tile * 64 + key) * ldk + 8 * c);
    r.v = *(const v4u*)(Vg + (size_t)(tile * 64 + key) * ldv + 8 * c);
    if (NC == 6) { if (tid < 256) r.k2 = *(const v4u*)(K2g + (size_t)(tile * 64 + (tid >> 2)) * ldk2 + 8 * (tid & 3)); }
}
template <int NC> __device__ __forceinline__ void at_store(const TileRegs<NC>& r, LAS unsigned char* buf, int tid) {
    const int key = tid >> 3, c = tid & 7;
    *(LAS v4u*)(buf + key * 128 + 16 * (c ^ ((key >> 1) & 7))) = r.k;
    *(LAS v4u*)(buf + AT_V + (c >> 2) * 4096 + key * 64 + (c & 3) * 16) = r.v;
    if (NC == 6) { if (tid < 256) { const int k2 = tid >> 2, c2 = tid & 3; *(LAS v4u*)(buf + AT_K32 + k2 * 64 + 16 * (c2 ^ ((k2 >> 2) & 3))) = r.k2; } }
}
template <int NC> __device__ __forceinline__ void qk_tile(f32x16& p0, f32x16& p1, LAS const unsigned char* buf, const bf16x8 (&qf)[NC], const f32x16& negm, int lane) {
    const int r32 = lane & 31, hi = lane >> 5;
    p0 = negm; p1 = negm;
#pragma unroll
    for (int cc = 0; cc < NC; ++cc) {
        bf16x8 k0, k1;
        if (cc < 4) { const int k0r = r32, k1r = 32 + r32;
            k0 = *(LAS const bf16x8*)(buf + k0r * 128 + 16 * ((2 * cc + hi) ^ ((k0r >> 1) & 7)));
            k1 = *(LAS const bf16x8*)(buf + k1r * 128 + 16 * ((2 * cc + hi) ^ ((k1r >> 1) & 7))); }
        else { const int k0r = r32, k1r = 32 + r32, c2 = 2 * (cc - 4) + hi;
            k0 = *(LAS const bf16x8*)(buf + AT_K32 + k0r * 64 + 16 * (c2 ^ ((k0r >> 2) & 3)));
            k1 = *(LAS const bf16x8*)(buf + AT_K32 + k1r * 64 + 16 * (c2 ^ ((k1r >> 2) & 3))); }
        p0 = __builtin_amdgcn_mfma_f32_32x32x16_bf16(k0, qf[cc], p0, 0, 0, 0);
        p1 = __builtin_amdgcn_mfma_f32_32x32x16_bf16(k1, qf[cc], p1, 0, 0, 0);
    }
}
template <int MODE> __device__ __forceinline__ void softmax_tile(AttnState& st, f32x16& p0, f32x16& p1, bf16x8 (&pf)[4], int kpos0, int qpos, bool need_mask, bool sel_ok, int lane) {
    const int hi = lane >> 5;
    if (need_mask) {
        const int qw0m = __builtin_amdgcn_readfirstlane(qpos) & ~31;
        const bool diag = (kpos0 + 63 > qw0m), old = (MODE == AM_WINDOW) && (kpos0 < qw0m + 31 - 511);
        if (diag || old) {
            const float selterm = (MODE == AM_SLC && !sel_ok) ? -INFINITY : INFINITY;
            const int dbase = qpos - kpos0 - 4 * hi;
#pragma unroll
            for (int r = 0; r < 16; ++r) {
                const int d0 = dbase - ((r & 3) + 8 * (r >> 2)), d1 = d0 - 32;
                float l0 = ((float)d0 + 0.5f) * INFINITY, l1 = ((float)d1 + 0.5f) * INFINITY;
                if (MODE == AM_WINDOW) { l0 = fminf(l0, ((float)(511 - d0) + 0.5f) * INFINITY); l1 = fminf(l1, ((float)(511 - d1) + 0.5f) * INFINITY); }
                if (MODE == AM_SLC) { l0 = fminf(l0, selterm); l1 = fminf(l1, selterm); }
                p0[r] = fminf(p0[r], l0); p1[r] = fminf(p1[r], l1);
            }
        } else if (MODE == AM_SLC) {
            const float selterm = sel_ok ? INFINITY : -INFINITY;
#pragma unroll
            for (int r = 0; r < 16; ++r) { p0[r] = fminf(p0[r], selterm); p1[r] = fminf(p1[r], selterm); }
        }
    }
    float mx = max3f(p0[0], p1[0], p0[1]), mx2 = max3f(p1[1], p0[2], p1[2]);
#pragma unroll
    for (int r = 3; r < 15; r += 2) { mx = max3f(mx, p0[r], p1[r]); mx2 = max3f(mx2, p0[r + 1], p1[r + 1]); }
    mx = max3f(mx, p0[15], p1[15]); mx = max3f(mx, mx2, mx2);
    mx = red32_max(mx);
    if (!st.started || __any(mx > 0.f)) {
        float dl = st.started ? fmaxf(mx, 0.f) : mx;
        dl = (dl > -1e30f) ? dl : 0.f;
        st.started = true;
        const float alpha = __builtin_amdgcn_exp2f(-dl);
        st.m += dl; st.l *= alpha;
#pragma unroll
        for (int r = 0; r < 16; ++r) { st.o[0][r] *= alpha; st.o[1][r] *= alpha; p0[r] -= dl; p1[r] -= dl; st.negm[r] = -st.m; }
    }
    float sum = 0.f;
#pragma unroll
    for (int r = 0; r < 16; ++r) { p0[r] = __builtin_amdgcn_exp2f(p0[r]); p1[r] = __builtin_amdgcn_exp2f(p1[r]); sum += p0[r] + p1[r]; }
    st.l += sum;
#pragma unroll
    for (int s2 = 0; s2 < 2; ++s2) {
        v4u a, b;
        a.x = cvtpk(p0[8 * s2 + 0], p0[8 * s2 + 1]); a.y = cvtpk(p0[8 * s2 + 2], p0[8 * s2 + 3]); a.z = cvtpk(p0[8 * s2 + 4], p0[8 * s2 + 5]); a.w = cvtpk(p0[8 * s2 + 6], p0[8 * s2 + 7]);
        b.x = cvtpk(p1[8 * s2 + 0], p1[8 * s2 + 1]); b.y = cvtpk(p1[8 * s2 + 2], p1[8 * s2 + 3]); b.z = cvtpk(p1[8 * s2 + 4], p1[8 * s2 + 5]); b.w = cvtpk(p1[8 * s2 + 6], p1[8 * s2 + 7]);
        pf[s2] = __builtin_bit_cast(bf16x8, a); pf[2 + s2] = __builtin_bit_cast(bf16x8, b);
    }
}
__device__ __forceinline__ void pv_tile(AttnState& st, LAS const unsigned char* buf, const bf16x8 (&pf)[4], int lane) {
    const int hi = lane >> 5;
    const unsigned vb = (unsigned)(uintptr_t)(buf + AT_V + (4 * hi + ((lane & 15) >> 2)) * 64 + ((lane >> 4) & 1) * 32 + (lane & 3) * 8);
#pragma unroll
    for (int dh = 0; dh < 2; ++dh) {
        s16x4 lo[4], hh[4];
#pragma unroll
        for (int s4 = 0; s4 < 4; ++s4) {
            asm volatile("ds_read_b64_tr_b16 %0, %1 offset:%c2" : "=&v"(lo[s4]) : "v"(vb), "i"(dh * 4096 + s4 * 1024) : "memory");
            asm volatile("ds_read_b64_tr_b16 %0, %1 offset:%c2" : "=&v"(hh[s4]) : "v"(vb), "i"(dh * 4096 + s4 * 1024 + 512) : "memory");
        }
        asm volatile("s_waitcnt lgkmcnt(0)" : "+v"(lo[0]), "+v"(lo[1]), "+v"(lo[2]), "+v"(lo[3]), "+v"(hh[0]), "+v"(hh[1]), "+v"(hh[2]), "+v"(hh[3]) :: "memory");
#pragma unroll
        for (int s4 = 0; s4 < 4; ++s4) {
            const bf16x8 vf = {lo[s4][0], lo[s4][1], lo[s4][2], lo[s4][3], hh[s4][0], hh[s4][1], hh[s4][2], hh[s4][3]};
            st.o[dh] = __builtin_amdgcn_mfma_f32_32x32x16_bf16(vf, pf[s4], st.o[dh], 0, 0, 0);
        }
    }
}
struct TileFlags { bool skip, need_mask, sel_ok; };
template <int MODE> __device__ __forceinline__ TileFlags tile_flags(int t, int qw0, unsigned selbits) {
    const int k0 = t * 64; TileFlags f;
    f.skip = k0 > qw0 + 31; f.need_mask = (k0 + 63 > qw0); f.sel_ok = true;
    if (MODE == AM_WINDOW) { f.skip = f.skip || (k0 + 63 < qw0 - 511); f.need_mask = f.need_mask || (k0 < qw0 + 31 - 511); }
    if (MODE == AM_SLC) { f.sel_ok = (selbits >> t) & 1u; const unsigned long long bal = __ballot(f.sel_ok); f.skip = f.skip || (bal == 0ull); f.need_mask = f.need_mask || (bal != ~0ull); }
    return f;
}
struct DmaOff { unsigned k, v, k2; };
template <int NC> __device__ __forceinline__ DmaOff at_dma_off(int ldk, int ldv, int ldk2, int wave, int lane) {
    const int L = wave * 64 + lane; DmaOff o;
    { const int key = L >> 3, c = (L & 7) ^ ((key >> 1) & 7); o.k = (unsigned)(key * ldk + 8 * c) * 2u; }
    { const int key = (L >> 2) & 63, c = (L >> 8) * 4 + (L & 3); o.v = (unsigned)(key * ldv + 8 * c) * 2u; }
    { const int key = (L >> 2) & 63, c2 = (L & 3) ^ ((key >> 2) & 3); o.k2 = (unsigned)(key * ldk2 + 8 * c2) * 2u; }
    return o;
}
template <int NC> __device__ __forceinline__ void at_dma(const DmaOff& o, const bf16* Kg, int ldk, const bf16* Vg, int ldv, const bf16* K2g, int ldk2, int tile, LAS unsigned char* slot, int wave) {
    __builtin_amdgcn_global_load_lds((const unsigned*)((const char*)(Kg + (size_t)tile * 64 * ldk) + o.k), (LAS unsigned*)(slot + wave * 1024), 16, 0, 0);
    __builtin_amdgcn_global_load_lds((const unsigned*)((const char*)(Vg + (size_t)tile * 64 * ldv) + o.v), (LAS unsigned*)(slot + AT_V + wave * 1024), 16, 0, 0);
    if (NC == 6) { if (wave < 4) __builtin_amdgcn_global_load_lds((const unsigned*)((const char*)(K2g + (size_t)tile * 64 * ldk2) + o.k2), (LAS unsigned*)(slot + AT_K32 + wave * 1024), 16, 0, 0); }
}
__device__ __forceinline__ void at_wait_bar(int keep) {
    if (keep == 0) asm volatile("s_waitcnt vmcnt(0) lgkmcnt(0)" ::: "memory");
    else if (keep == 4) asm volatile("s_waitcnt vmcnt(4) lgkmcnt(0)" ::: "memory");
    else asm volatile("s_waitcnt vmcnt(6) lgkmcnt(0)" ::: "memory");
    __builtin_amdgcn_s_barrier();
    asm volatile("" ::: "memory");
}
template <int NC, int MODE> __device__ __forceinline__ void at_stream(AttnState& st, LAS unsigned char* lds, const bf16* Kg, int ldk, const bf16* Vg, int ldv, const bf16* K2g, int ldk2, int t0, int t1,
                                                                       const bf16x8 (&qf)[NC], int qpos, int qw0, unsigned selbits, int tid) {
    const int lane = tid & 63, wave = __builtin_amdgcn_readfirstlane(tid >> 6), np = (t1 - t0) >> 1;
    const int nper2 = (NC == 6 && wave < 4) ? 6 : 4;
    const DmaOff dof = at_dma_off<NC>(ldk, ldv, ldk2, wave, lane);
    at_dma<NC>(dof, Kg, ldk, Vg, ldv, K2g, ldk2, t0, lds, wave); at_dma<NC>(dof, Kg, ldk, Vg, ldv, K2g, ldk2, t0 + 1, lds + AT_BUF, wave);
    if (np > 1) { at_dma<NC>(dof, Kg, ldk, Vg, ldv, K2g, ldk2, t0 + 2, lds + 2 * AT_BUF, wave); at_dma<NC>(dof, Kg, ldk, Vg, ldv, K2g, ldk2, t0 + 3, lds + 3 * AT_BUF, wave); }
    at_wait_bar(np > 1 ? nper2 : 0);
    int s0 = 0, s1 = 2 * AT_BUF, s2 = 4 * AT_BUF;
    for (int j = 0; j < np; ++j) {
        const int t = t0 + 2 * j; const bool has_2 = (j + 2 < np);
        if (has_2) { at_dma<NC>(dof, Kg, ldk, Vg, ldv, K2g, ldk2, t + 4, lds + s2, wave); at_dma<NC>(dof, Kg, ldk, Vg, ldv, K2g, ldk2, t + 5, lds + s2 + AT_BUF, wave); }
#pragma unroll
        for (int h2 = 0; h2 < 2; ++h2) {
            const TileFlags f = tile_flags<MODE>(t + h2, qw0, selbits);
            if (!f.skip) {
                f32x16 p0, p1; bf16x8 pf[4];
                qk_tile<NC>(p0, p1, lds + s0 + h2 * AT_BUF, qf, st.negm, lane);
                softmax_tile<MODE>(st, p0, p1, pf, (t + h2) * 64, qpos, f.need_mask, f.sel_ok, lane);
                pv_tile(st, lds + s0 + h2 * AT_BUF, pf, lane);
            }
        }
        at_wait_bar(has_2 ? nper2 : 0);
        const int tmp = s0; s0 = s1; s1 = s2; s2 = tmp;
    }
}
__device__ __forceinline__ int next_item_q(unsigned* ctrs, LAS unsigned char* lds, int wave_u, int count, int q0, int& kstart) {
    const int tid = wave_u * 64 + fresh_lane();
    LAS int* slot = (LAS int*)(lds + RING_BYTES + 64);
    if (tid == 0) {
        int r = -1, k = kstart;
        for (; k < 8; ++k) { const int q = (q0 + k) & 7; const unsigned v = atomicAdd(ctrs + q * 16, 1u); if (v < (unsigned)count) { r = (q << 16) | (int)v; break; } }
        slot[0] = r; slot[1] = k;
    }
    __syncthreads();
    const int v = slot[0]; kstart = slot[1];
    __syncthreads();
    return v;
}
__device__ __forceinline__ void mla_unit(unsigned char* ws, LAS unsigned char* lds, int b, int h, int qt, int wave_u) {
    const int tid = wave_u * 64 + fresh_lane();
    const int lane = tid & 63, wave = tid >> 6, r32 = lane & 31, hi = lane >> 5;
    const int qw0 = qt * 256 + wave * 32, qpos = qw0 + r32; const size_t row = (size_t)b * S_ + qpos;
    const long long tq0 = (PROBE_SEL != 0) ? (long long)__builtin_amdgcn_s_memtime() : 0ll;
    bf16x8 qf[6];
    {
        const bf16* qp = (const bf16*)(ws + WS_OSLC) + row * 768 + h * 96 + 8 * hi;
        v4u raw[6];
#pragma unroll
        for (int cc = 0; cc < 6; ++cc) raw[cc] = *(const v4u*)(qp + 16 * cc);
        float msc = MSCALE; asm volatile("" : "+v"(msc));
        const float rs = rsqrtf(((const float*)(ws + WS_SSQL))[row] * (1.f / 256.f) + EPS) * msc;
        const float* cm_ = (const float*)(ws + WS_COSM) + row * 16 + 8 * hi; const float* sm_ = (const float*)(ws + WS_SINM) + row * 16 + 8 * hi;
#define UNPKQ(dst, src) dst[0] = __uint_as_float(src.x << 16); dst[1] = __uint_as_float(src.x & 0xffff0000u); dst[2] = __uint_as_float(src.y << 16); dst[3] = __uint_as_float(src.y & 0xffff0000u); \
        dst[4] = __uint_as_float(src.z << 16); dst[5] = __uint_as_float(src.z & 0xffff0000u); dst[6] = __uint_as_float(src.w << 16); dst[7] = __uint_as_float(src.w & 0xffff0000u);
#pragma unroll
        for (int cc = 0; cc < 4; ++cc) { float f[8]; UNPKQ(f, raw[cc])
            v4u w; w.x = cvtpk(f[0] * rs, f[1] * rs); w.y = cvtpk(f[2] * rs, f[3] * rs); w.z = cvtpk(f[4] * rs, f[5] * rs); w.w = cvtpk(f[6] * rs, f[7] * rs); qf[cc] = __builtin_bit_cast(bf16x8, w); }
        { float x1[8], x2[8], o1[8], o2[8]; UNPKQ(x1, raw[4]) UNPKQ(x2, raw[5])
#pragma unroll
          for (int j = 0; j < 8; ++j) { const float cs = cm_[j] * rs, sn = sm_[j] * rs; o1[j] = x1[j] * cs - x2[j] * sn; o2[j] = x1[j] * sn + x2[j] * cs; }
          v4u w; w.x = cvtpk(o1[0], o1[1]); w.y = cvtpk(o1[2], o1[3]); w.z = cvtpk(o1[4], o1[5]); w.w = cvtpk(o1[6], o1[7]); qf[4] = __builtin_bit_cast(bf16x8, w);
          w.x = cvtpk(o2[0], o2[1]); w.y = cvtpk(o2[2], o2[3]); w.z = cvtpk(o2[4], o2[5]); w.w = cvtpk(o2[6], o2[7]); qf[5] = __builtin_bit_cast(bf16x8, w); }
#undef UNPKQ
    }
    const long long tq1 = (PROBE_SEL != 0) ? (long long)__builtin_amdgcn_s_memtime() : 0ll;
    AttnState st; st.m = 0.f; st.l = 0.f; st.o[0] = f32x16{}; st.o[1] = f32x16{}; st.negm = f32x16{}; st.started = false; st.twait = 0;
    const bf16* kvb = (const bf16*)(ws + WS_KVM) + (size_t)b * S_ * 768 + h * 128;
    at_stream<6, AM_CAUSAL>(st, lds, kvb, 768, kvb + 64, 768, (const bf16*)(ws + WS_KR) + (size_t)b * S_ * 32, 32, 0, 4 * qt + 4, qf, qpos, qw0, 0u, tid);
    if (PROBE_SEL >= 1 && PROBE_SEL <= 3 && b == 0 && h == 0 && qt == 7 && tid == 0) { const long long tq2 = (long long)__builtin_amdgcn_s_memtime();
        ((float*)(ws + WS_CTL))[100] = (PROBE_SEL == 1) ? (float)(tq2 - tq1) : (PROBE_SEL == 2) ? (float)st.twait : (float)(tq1 - tq0); }
    const float lt = red32_sum(st.l), il = 1.f / lt;
    bf16* op = (bf16*)(ws + WS_HB) + row * D_ + 384 + h * 64 + 4 * hi;
#pragma unroll
    for (int dh = 0; dh < 2; ++dh)
#pragma unroll
        for (int g4 = 0; g4 < 4; ++g4) { u32x2v w; w.x = cvtpk(st.o[dh][4 * g4] * il, st.o[dh][4 * g4 + 1] * il); w.y = cvtpk(st.o[dh][4 * g4 + 2] * il, st.o[dh][4 * g4 + 3] * il);
            *(u32x2v*)(op + dh * 32 + 8 * g4) = w; }
}
template <int MODE> __device__ __forceinline__ void nsa_branch_unit(unsigned char* ws, LAS unsigned char* lds, int b, int h, int qt, int wave_u) {
    const int tid = wave_u * 64 + fresh_lane();
    const int lane = tid & 63, wave = tid >> 6, r32 = lane & 31, hi = lane >> 5, g = h / 3;
    const int qw0 = qt * 256 + wave * 32, qpos = qw0 + r32; const size_t row = (size_t)b * S_ + qpos;
    const bf16* nsa = (const bf16*)(ws + WS_NSA);
    const bf16* qp = nsa + row * 1152 + h * 64 + 8 * hi;
    bf16x8 qf[4];
#pragma unroll
    for (int cc = 0; cc < 4; ++cc) qf[cc] = *(const bf16x8*)(qp + 16 * cc);
    unsigned selbits = 0u; if (MODE == AM_SLC) selbits = ((const unsigned*)(ws + WS_SEL))[(size_t)(b * 2 + g) * S_ + qpos];
    const bf16* kb = nsa + (size_t)b * S_ * 1152 + g * 64 + (MODE == AM_SLC ? 640 : 896);
    AttnState st; st.m = 0.f; st.l = 0.f; st.o[0] = f32x16{}; st.o[1] = f32x16{}; st.negm = f32x16{}; st.started = false; st.twait = 0;
    const long long tn0 = (PROBE_SEL != 0) ? (long long)__builtin_amdgcn_s_memtime() : 0ll;
    const int t0 = (MODE == AM_SLC) ? 0 : ((4 * qt - 8 > 0) ? 4 * qt - 8 : 0);
    at_stream<4, MODE>(st, lds, kb, 1152, kb + 128, 1152, nullptr, 0, t0, 4 * qt + 4, qf, qpos, qw0, selbits, tid);
    if (PROBE_SEL >= 4 && PROBE_SEL <= 5 && MODE == AM_SLC && b == 0 && h == 0 && qt == 7 && tid == 0) { const long long tn1 = (long long)__builtin_amdgcn_s_memtime();
        ((float*)(ws + WS_CTL))[100] = (PROBE_SEL == 4) ? (float)(tn1 - tn0) : (float)st.twait; }
    const float lt = red32_sum(st.l), il = 1.f / lt;
    bf16* op = (bf16*)(ws + (MODE == AM_SLC ? WS_OSLC : WS_OWIN)) + row * 384 + h * 64 + 4 * hi;
#pragma unroll
    for (int dh = 0; dh < 2; ++dh)
#pragma unroll
        for (int g4 = 0; g4 < 4; ++g4) { u32x2v w; w.x = cvtpk(st.o[dh][4 * g4] * il, st.o[dh][4 * g4 + 1] * il); w.y = cvtpk(st.o[dh][4 * g4 + 2] * il, st.o[dh][4 * g4 + 3] * il);
            *(u32x2v*)(op + dh * 32 + 8 * g4) = w; }
}
__device__ __forceinline__ void cmp_unit(unsigned char* ws, LAS unsigned char* lds, int b, int g, int qt, int wave_u) {
    const int tid = wave_u * 64 + fresh_lane();
    const int lane = tid & 63, wave = tid >> 6, r32 = lane & 31, hi = lane >> 5;
    const int qpos = qt * 256 + wave * 32 + r32; const size_t row = (size_t)b * S_ + qpos;
    const bf16* kc = (const bf16*)(ws + WS_KCV) + (size_t)(b * 2 + g) * 128 * 64; const bf16* vc = kc + (size_t)8 * 2 * 128 * 64;
    { TileRegs<4> tr; at_load<4>(tr, kc, 64, vc, 64, nullptr, 0, 0, tid); at_store<4>(tr, lds, tid); at_load<4>(tr, kc, 64, vc, 64, nullptr, 0, 1, tid); at_store<4>(tr, lds + AT_BUF, tid); }
    __syncthreads();
    int nvis = (qpos >= 31) ? ((qpos - 31) >> 4) + 1 : 0; if (nvis > 127) nvis = 127;
    LAS float* IG = (LAS float*)(lds + 2 * AT_BUF) + wave * (32 * 33) + r32 * 33;
    LAS float* IL = IG + 8 * 32 * 33;
    const bf16* nsa = (const bf16*)(ws + WS_NSA);
    LAS const unsigned char* vb = lds + AT_V + (4 * hi + ((lane & 15) >> 2)) * 64 + ((lane >> 4) & 1) * 32 + (lane & 3) * 8;
    for (int r3 = 0; r3 < 3; ++r3) {
        const int h = 3 * g + r3;
        const bf16* qp = nsa + row * 1152 + h * 64 + 8 * hi;
        bf16x8 qf[4];
#pragma unroll
        for (int cc = 0; cc < 4; ++cc) qf[cc] = *(const bf16x8*)(qp + 16 * cc);
        f32x16 p[4];
#pragma unroll
        for (int tb = 0; tb < 4; ++tb) {
            LAS const unsigned char* buf = lds + (tb >> 1) * AT_BUF; const int kr = (tb & 1) * 32 + r32;
            p[tb] = f32x16{};
#pragma unroll
            for (int cc = 0; cc < 4; ++cc) { const bf16x8 kf = *(LAS const bf16x8*)(buf + kr * 128 + 16 * ((2 * cc + hi) ^ ((kr >> 1) & 7)));
                p[tb] = __builtin_amdgcn_mfma_f32_32x32x16_bf16(kf, qf[cc], p[tb], 0, 0, 0); }
        }
        float mx = -1e30f;
#pragma unroll
        for (int tb = 0; tb < 4; ++tb)
#pragma unroll
            for (int r = 0; r < 16; ++r) { const int n = 32 * tb + crow(r, hi); p[tb][r] = fminf(p[tb][r], ((float)(nvis - n) - 0.5f) * INFINITY); mx = fmaxf(mx, p[tb][r]); }
        mx = red32_max(mx);
        float sum = 0.f;
#pragma unroll
        for (int tb = 0; tb < 4; ++tb)
#pragma unroll
            for (int r = 0; r < 16; ++r) { p[tb][r] = __builtin_amdgcn_exp2f(p[tb][r] - mx); sum += p[tb][r]; }
        sum = red32_sum(sum);
        const float il = (nvis > 0) ? 1.f / sum : 0.f;
#pragma unroll
        for (int tb = 0; tb < 4; ++tb)
#pragma unroll
            for (int k = 0; k < 4; ++k) { const float a0 = p[tb][4 * k] * il, a1 = p[tb][4 * k + 1] * il, a2 = p[tb][4 * k + 2] * il, a3 = p[tb][4 * k + 3] * il;
                const int j = 2 * (4 * tb + k) + hi;
                const float gs = (a0 + a1) + (a2 + a3);
                if (r3 == 0) { IG[j] = gs; IL[j + 1] = a3; } else { IG[j] += gs; IL[j + 1] += a3; } }
        f32x16 o[2] = {f32x16{}, f32x16{}};
#pragma unroll
        for (int tb = 0; tb < 4; ++tb)
#pragma unroll
            for (int s2 = 0; s2 < 2; ++s2) {
                v4u a; a.x = cvtpk(p[tb][8 * s2 + 0], p[tb][8 * s2 + 1]); a.y = cvtpk(p[tb][8 * s2 + 2], p[tb][8 * s2 + 3]); a.z = cvtpk(p[tb][8 * s2 + 4], p[tb][8 * s2 + 5]); a.w = cvtpk(p[tb][8 * s2 + 6], p[tb][8 * s2 + 7]);
                const bf16x8 pf = __builtin_bit_cast(bf16x8, a);
                LAS const unsigned char* vbb = vb + (tb >> 1) * AT_BUF + ((tb & 1) * 2 + s2) * 1024;
#pragma unroll
                for (int dh = 0; dh < 2; ++dh) { const s16x4 lo = vtr(vbb + dh * 4096), hh = vtr(vbb + dh * 4096 + 512);
                    const bf16x8 vf = {lo[0], lo[1], lo[2], lo[3], hh[0], hh[1], hh[2], hh[3]};
                    o[dh] = __builtin_amdgcn_mfma_f32_32x32x16_bf16(vf, pf, o[dh], 0, 0, 0); }
                asm volatile("" ::: "memory");
            }
        bf16* op = (bf16*)(ws + WS_OCMP) + row * 384 + h * 64 + 4 * hi;
#pragma unroll
        for (int dh = 0; dh < 2; ++dh)
#pragma unroll
            for (int g4 = 0; g4 < 4; ++g4) { u32x2v w; w.x = cvtpk(o[dh][4 * g4] * il, o[dh][4 * g4 + 1] * il); w.y = cvtpk(o[dh][4 * g4 + 2] * il, o[dh][4 * g4 + 3] * il);
                *(u32x2v*)(op + dh * 32 + 8 * g4) = w; }
    }
    const int cur = qpos >> 6;
    LAS float* imp = IG;
#pragma unroll 1
    for (int jj = 0; jj < 16; ++jj) {
        const int j = 16 * hi + jj;
        float v = IG[j] + (j > 0 ? IL[j] : 0.f);
        if (j == 0 || j == cur || j == cur - 1) v = INFINITY;
        if (j * 64 > qpos) v = -INFINITY;
        IL[j] = v;
    }
#pragma unroll 1
    for (int jj = 0; jj < 16; ++jj) { const int j = 16 * hi + jj; imp[j] = IL[j]; }
    unsigned mask = 0;
#pragma unroll 1
    for (int jj = 0; jj < 16; ++jj) {
        const int j = 16 * hi + jj; const float v = imp[j]; int rank = 0;
#pragma unroll 4
        for (int k = 0; k < 32; ++k) { const float u2 = imp[k]; rank += (u2 > v || (u2 == v && k < j)) ? 1 : 0; }
        if (rank < 16) mask |= 1u << j;
    }
    mask = red32_or(mask);
    if (hi == 0) ((unsigned*)(ws + WS_SEL))[(size_t)(b * 2 + g) * S_ + qpos] = mask;
    __syncthreads();
}
__device__ __forceinline__ void lora_rows(unsigned char* ws, int tid) {
    const int gw = blockIdx.x * NWAVES + (tid >> 6), ngw = gridDim.x * NWAVES, lane = tid & 63;
    bf16* kvl = (bf16*)(ws + WS_KVL); const bf16* ql = (const bf16*)(ws + WS_QL); float* ssql = (float*)(ws + WS_SSQL);
    for (int m = gw; m < T_; m += ngw) {
        const unsigned kv = *(const unsigned*)(kvl + (size_t)m * 128 + 2 * lane);
        const float k0 = __uint_as_float(kv << 16), k1 = __uint_as_float(kv & 0xffff0000u);
        const uint2 qv = *(const uint2*)(ql + (size_t)m * 256 + 4 * lane);
        const float q0 = __uint_as_float(qv.x << 16), q1 = __uint_as_float(qv.x & 0xffff0000u), q2 = __uint_as_float(qv.y << 16), q3 = __uint_as_float(qv.y & 0xffff0000u);
        const float sk = wave_sum2(k0 * k0 + k1 * k1), sq = wave_sum2((q0 * q0 + q1 * q1) + (q2 * q2 + q3 * q3));
        const float rk = rsqrtf(sk * (1.f / 128.f) + EPS);
        *(unsigned*)(kvl + (size_t)m * 128 + 2 * lane) = pk2(k0 * rk, k1 * rk);
        if (lane == 0) ssql[m] = sq;
    }
}
__device__ __forceinline__ void post_misc(unsigned char* ws, const float* big, const float* bfg, int tid) {
    const float* mr = (const float*)(ws + WS_MISCRAW); const float* cosM = (const float*)(ws + WS_COSM); const float* sinM = (const float*)(ws + WS_SINM);
    bf16* kr = (bf16*)(ws + WS_KR); float* gm = (float*)(ws + WS_GM);
    for (int idx = blockIdx.x * NTHR + tid; idx < T_ * 64; idx += gridDim.x * NTHR) {
        const int row = idx >> 6, c = idx & 63; const float* r = mr + (size_t)row * 64; const float v = r[c];
        if (c < 32) { const int i = c & 15; const float x1 = r[i], x2 = r[16 + i], cs = cosM[row * 16 + i], sn = sinM[row * 16 + i];
            kr[(size_t)row * 32 + c] = f2bf((c < 16) ? x1 * cs - x2 * sn : x1 * sn + x2 * cs); }
        else if (c < 50) gm[(size_t)row * 32 + (c - 32)] = 1.f / (1.f + __expf(-v));
        else if (c < 54) gm[(size_t)row * 32 + 18 + (c - 50)] = v + big[c - 50];
        else if (c < 58) { const float z = v + bfg[c - 54]; gm[(size_t)row * 32 + 22 + (c - 54)] = fminf(z, 0.f) - __logf(1.f + __expf(-fabsf(z))); }
    }
}

typedef float f32x4v __attribute__((ext_vector_type(4)));
__device__ __forceinline__ void compress_item(unsigned char* ws, LAS unsigned char* lds, const float* cmp_pos, int item, int wave_u) {
    const int lane = fresh_lane(), tid = wave_u * 64 + lane;
    const int nb = item & 7, g = (item >> 3) & 1, b = (item >> 4) & 7, kv = item >> 7;
    const bf16* tok = (const bf16*)(ws + WS_NSA) + (size_t)b * S_ * 1152 + (kv ? 512 : 384) + g * 64;
    const bf16* wt = (const bf16*)(ws + (kv ? WT_CV : WT_CK));
    const int nrow = nb * 16 + (lane & 15), kq = lane >> 4;
    f32x4v acc[4] = {f32x4v{}, f32x4v{}, f32x4v{}, f32x4v{}};
#pragma unroll 4
    for (int ks = 0; ks < 8; ++ks) {
        const int k = wave_u * 256 + ks * 32 + kq * 8, l = k >> 6, d = k & 63;
        int trow = 16 * nrow + l; trow = trow < S_ ? trow : S_ - 1;
        const v4u t4 = *(const v4u*)(tok + (size_t)trow * 1152 + d);
        const f32x4v p0 = *(const f32x4v*)(cmp_pos + k), p1 = *(const f32x4v*)(cmp_pos + k + 4);
        v4u a4;
        a4.x = cvtpk(__uint_as_float(t4.x << 16) + p0[0], __uint_as_float(t4.x & 0xffff0000u) + p0[1]); a4.y = cvtpk(__uint_as_float(t4.y << 16) + p0[2], __uint_as_float(t4.y & 0xffff0000u) + p0[3]);
        a4.z = cvtpk(__uint_as_float(t4.z << 16) + p1[0], __uint_as_float(t4.z & 0xffff0000u) + p1[1]); a4.w = cvtpk(__uint_as_float(t4.w << 16) + p1[2], __uint_as_float(t4.w & 0xffff0000u) + p1[3]);
        const bf16x8 af = __builtin_bit_cast(bf16x8, a4);
#pragma unroll
        for (int cb = 0; cb < 4; ++cb) { const bf16x8 bfr = *(const bf16x8*)(wt + (size_t)(cb * 16 + (lane & 15)) * 2048 + k);
            acc[cb] = __builtin_amdgcn_mfma_f32_16x16x32_bf16(af, bfr, acc[cb], 0, 0, 0); }
    }
    LAS float* red = (LAS float*)lds + wave_u * 1024;
#pragma unroll
    for (int cb = 0; cb < 4; ++cb)
#pragma unroll
        for (int r = 0; r < 4; ++r) red[(4 * (lane >> 4) + r) * 64 + cb * 16 + (lane & 15)] = acc[cb][r];
    __syncthreads();
    bf16* out = (bf16*)(ws + WS_KCV) + (size_t)kv * (8 * 2 * 128 * 64) + ((size_t)(b * 2 + g) * 128 + nb * 16) * 64;
    for (int o = tid; o < 1024; o += NTHR) { float sum = 0.f;
#pragma unroll
        for (int w8 = 0; w8 < 8; ++w8) sum += ((LAS float*)lds)[w8 * 1024 + o];
        out[o] = f2bf(sum); }
    __syncthreads();
}
__device__ __forceinline__ f32x4v mm16(const LAS bf16* A, int lda, int arow0, const LAS bf16* Bt, int ldb, int bcol0, int K, int lane, f32x4v acc) {
    const LAS bf16* ap = A + (arow0 + (lane & 15)) * lda + 8 * (lane >> 4); const LAS bf16* bp = Bt + (bcol0 + (lane & 15)) * ldb + 8 * (lane >> 4);
    for (int k = 0; k < K; k += 32) acc = __builtin_amdgcn_mfma_f32_16x16x32_bf16(*(const LAS bf16x8*)(ap + k), *(const LAS bf16x8*)(bp + k), acc, 0, 0, 0);
    return acc;
}
constexpr int ML_LD = 72;
__device__ __forceinline__ void mlocal_item(unsigned char* ws, LAS unsigned char* lds, const float* convw, const float* convb, const float* big, const float* bfg, int chunk, int wave_u) {
    const int lane = fresh_lane(), tid = wave_u * 64 + lane;
    const int c = chunk & 31, h = (chunk >> 5) & 3, b = chunk >> 7, row0 = b * S_ + c * 64;
    LAS bf16* XS = (LAS bf16*)lds;
    LAS bf16* WQ = XS + 64 * ML_LD;
    LAS bf16* WK = WQ + 64 * ML_LD;
    LAS bf16* VT = WK + 64 * ML_LD;
    LAS bf16* WKT = VT + 64 * ML_LD;
    LAS float* wl = (LAS float*)(WKT + 64 * ML_LD);
    const bf16* cm = (const bf16*)(ws + WS_CM);
    {
        const int l = tid >> 3, ch0 = (tid & 7) * 8, row = row0 + l, s = c * 64 + l;
        float a[8];
#pragma unroll
        for (int i = 0; i < 8; ++i) a[i] = convb[h * 64 + ch0 + i];
#pragma unroll
        for (int j = 0; j < 4; ++j) { if (s - 3 + j >= 0) { const v4u x4 = *(const v4u*)(cm + (size_t)(row - 3 + j) * 768 + h * 64 + ch0);
            const float* cw = convw + j * 256 + h * 64 + ch0;
            a[0] += cw[0] * __uint_as_float(x4.x << 16); a[1] += cw[1] * __uint_as_float(x4.x & 0xffff0000u); a[2] += cw[2] * __uint_as_float(x4.y << 16); a[3] += cw[3] * __uint_as_float(x4.y & 0xffff0000u);
            a[4] += cw[4] * __uint_as_float(x4.z << 16); a[5] += cw[5] * __uint_as_float(x4.z & 0xffff0000u); a[6] += cw[6] * __uint_as_float(x4.w << 16); a[7] += cw[7] * __uint_as_float(x4.w & 0xffff0000u); } }
        v4u o4; float r[8];
#pragma unroll
        for (int i = 0; i < 8; ++i) r[i] = a[i] / (1.f + __expf(-a[i]));
        o4.x = cvtpk(r[0], r[1]); o4.y = cvtpk(r[2], r[3]); o4.z = cvtpk(r[4], r[5]); o4.w = cvtpk(r[6], r[7]);
        *(v4u*)((bf16*)(ws + WS_XC) + (size_t)row * 256 + h * 64 + ch0) = o4;
        *(LAS v4u*)(XS + l * ML_LD + ch0) = o4;
        const v4u v4 = *(const v4u*)(cm + (size_t)row * 768 + 256 + h * 64 + ch0);
        VT[(ch0 + 0) * ML_LD + l] = (bf16)(v4.x & 0xffffu); VT[(ch0 + 1) * ML_LD + l] = (bf16)(v4.x >> 16); VT[(ch0 + 2) * ML_LD + l] = (bf16)(v4.y & 0xffffu); VT[(ch0 + 3) * ML_LD + l] = (bf16)(v4.y >> 16);
        VT[(ch0 + 4) * ML_LD + l] = (bf16)(v4.z & 0xffffu); VT[(ch0 + 5) * ML_LD + l] = (bf16)(v4.z >> 16); VT[(ch0 + 6) * ML_LD + l] = (bf16)(v4.w & 0xffffu); VT[(ch0 + 7) * ML_LD + l] = (bf16)(v4.w >> 16);
        const int e = tid >> 3, d0 = (tid & 7) * 8;
        *(LAS v4u*)(WQ + e * ML_LD + d0) = *(const v4u*)((const bf16*)(ws + WT_QM) + h * 4096 + e * 64 + d0);
        *(LAS v4u*)(WK + e * ML_LD + d0) = *(const v4u*)((const bf16*)(ws + WT_KM) + h * 4096 + e * 64 + d0);
    }
    if (wave_u == 0) {
        const float* mr = (const float*)(ws + WS_MISCRAW) + (size_t)(row0 + lane) * 64;
        const float z = mr[54 + h] + bfg[h]; float lf = fminf(z, 0.f) - __logf(1.f + __expf(-fabsf(z)));
        const float ig = mr[50 + h] + big[h];
#pragma unroll
        for (int o = 1; o < 64; o <<= 1) { const float t = bperm(lf, lane - o); if (lane >= o) lf += t; }
        const float bL = __int_as_float(__builtin_amdgcn_readlane(__float_as_int(lf), 63));
        const float a = bL - lf + ig; const float mx = wave_max2(a);
        wl[lane] = __expf(a - mx);
        if (lane == 0) { ((float*)(ws + WS_ML))[chunk] = mx; ((float*)(ws + WS_BL))[chunk] = bL; }
    }
    __syncthreads();
    {
        const int lb = wave_u & 3; const bool isk = wave_u >= 4;
        const LAS bf16* Wt = isk ? WK : WQ;
        bf16* og = (bf16*)(ws + (isk ? WS_MK : WS_MQ)) + (size_t)(row0 + 16 * lb + 4 * (lane >> 4)) * 256 + h * 64 + (lane & 15);
        float w4[4];
#pragma unroll
        for (int r = 0; r < 4; ++r) w4[r] = wl[16 * lb + 4 * (lane >> 4) + r];
#pragma unroll
        for (int eb = 0; eb < 4; ++eb) {
            f32x4v acc = mm16(XS, ML_LD, 16 * lb, Wt, ML_LD, 16 * eb, 64, lane, f32x4v{});
            if (!isk) {
#pragma unroll
                for (int r = 0; r < 4; ++r) og[(size_t)r * 256 + 16 * eb] = f2bf(acc[r] * 0.125f);
            } else {
                bf16 kb[4];
#pragma unroll
                for (int r = 0; r < 4; ++r) { kb[r] = f2bf(acc[r]); og[(size_t)r * 256 + 16 * eb] = kb[r]; }
                u32x2v w2; w2.x = cvtpk(bf2f(kb[0]) * w4[0], bf2f(kb[1]) * w4[1]); w2.y = cvtpk(bf2f(kb[2]) * w4[2], bf2f(kb[3]) * w4[3]);
                *(LAS u32x2v*)(WKT + (16 * eb + (lane & 15)) * ML_LD + 16 * lb + 4 * (lane >> 4)) = w2;
            }
        }
    }
    __syncthreads();
    {
        float* ct = (float*)(ws + WS_CT) + (size_t)chunk * 4096;
#pragma unroll
        for (int i = 0; i < 2; ++i) { const int blk = wave_u * 2 + i, eb = blk >> 2, db = blk & 3;
            const f32x4v acc = mm16(VT, ML_LD, 16 * eb, WKT, ML_LD, 16 * db, 64, lane, f32x4v{});
#pragma unroll
            for (int r = 0; r < 4; ++r) ct[(16 * eb + 4 * (lane >> 4) + r) * 64 + 16 * db + (lane & 15)] = acc[r]; }
        if (tid < 64) { float n = 0.f; const LAS bf16* wr_ = WKT + tid * ML_LD;
            for (int l = 0; l < 64; ++l) n += bf2f(wr_[l]);
            ((float*)(ws + WS_NL))[chunk * 64 + tid] = n; }
    }
    __syncthreads();
}
__device__ __forceinline__ void mscan_item(unsigned char* ws, int item, int wave_u) {
    const int tid = wave_u * 64 + fresh_lane();
    const int bh = item / 9, part = item % 9;
    if (part == 8 && tid >= 64) return;
    float* base; size_t stride;
    if (part < 8) { base = (float*)(ws + WS_CT) + (size_t)bh * 32 * 4096 + part * 512 + tid; stride = 4096; } else { base = (float*)(ws + WS_NL) + (size_t)bh * 32 * 64 + tid; stride = 64; }
    const float* ML = (const float*)(ws + WS_ML); const float* BL = (const float*)(ws + WS_BL); float* MPv = (float*)(ws + WS_MP);
    float Cv = 0.f, m = 0.f;
    for (int c = 0; c < 32; ++c) {
        const float cl = base[(size_t)c * stride], ml = ML[bh * 32 + c], bl = BL[bh * 32 + c];
        base[(size_t)c * stride] = Cv;
        if (part == 8 && tid == 0) MPv[bh * 32 + c] = m;
        const float mn = fmaxf(bl + m, ml);
        Cv = __expf(bl + m - mn) * Cv + __expf(ml - mn) * cl; m = mn;
    }
}
__device__ __forceinline__ void mout_item(unsigned char* ws, LAS unsigned char* lds, const float* gmh, const float* skip, int chunk, int wave_u) {
    const int lane = fresh_lane(), tid = wave_u * 64 + lane;
    const int c = chunk & 31, h = (chunk >> 5) & 3, b = chunk >> 7, row0 = b * S_ + c * 64;
    LAS bf16* QS = (LAS bf16*)lds;
    LAS bf16* KS = QS + 64 * ML_LD;
    LAS bf16* VT = KS + 64 * ML_LD;
    LAS bf16* CP = VT + 64 * ML_LD;
    LAS bf16* SW = CP + 64 * ML_LD;
    LAS float* HS = (LAS float*)(SW + 64 * ML_LD);
    LAS float* bs = HS + 64 * 65; LAS float* us = bs + 64; LAS float* ns = us + 64; LAS float* mts = ns + 64; LAS float* ints = mts + 64; LAS float* dinv = ints + 64;
    const float* gm = (const float*)(ws + WS_GM);
    {
        const int l = tid >> 3, c0 = (tid & 7) * 8, row = row0 + l;
        *(LAS v4u*)(QS + l * ML_LD + c0) = *(const v4u*)((const bf16*)(ws + WS_MQ) + (size_t)row * 256 + h * 64 + c0);
        *(LAS v4u*)(KS + l * ML_LD + c0) = *(const v4u*)((const bf16*)(ws + WS_MK) + (size_t)row * 256 + h * 64 + c0);
        const v4u v4 = *(const v4u*)((const bf16*)(ws + WS_CM) + (size_t)row * 768 + 256 + h * 64 + c0);
        VT[(c0 + 0) * ML_LD + l] = (bf16)(v4.x & 0xffffu); VT[(c0 + 1) * ML_LD + l] = (bf16)(v4.x >> 16); VT[(c0 + 2) * ML_LD + l] = (bf16)(v4.y & 0xffffu); VT[(c0 + 3) * ML_LD + l] = (bf16)(v4.y >> 16);
        VT[(c0 + 4) * ML_LD + l] = (bf16)(v4.z & 0xffffu); VT[(c0 + 5) * ML_LD + l] = (bf16)(v4.z >> 16); VT[(c0 + 6) * ML_LD + l] = (bf16)(v4.w & 0xffffu); VT[(c0 + 7) * ML_LD + l] = (bf16)(v4.w >> 16);
        const float* ct = (const float*)(ws + WS_CT) + (size_t)chunk * 4096 + l * 64 + c0;
        const f32x4v c0v = *(const f32x4v*)ct, c1v = *(const f32x4v*)(ct + 4);
        v4u cw; cw.x = cvtpk(c0v[0], c0v[1]); cw.y = cvtpk(c0v[2], c0v[3]); cw.z = cvtpk(c1v[0], c1v[1]); cw.w = cvtpk(c1v[2], c1v[3]);
        *(LAS v4u*)(CP + l * ML_LD + c0) = cw;
    }
    if (wave_u == 0) {
        const float ig = gm[(size_t)(row0 + lane) * 32 + 18 + h]; float lf = gm[(size_t)(row0 + lane) * 32 + 22 + h];
#pragma unroll
        for (int o = 1; o < 64; o <<= 1) { const float t = bperm(lf, lane - o); if (lane >= o) lf += t; }
        const float u = ig - lf; float cu = u;
#pragma unroll
        for (int o = 1; o < 64; o <<= 1) { const float t = bperm(cu, lane - o); if (lane >= o) cu = fmaxf(cu, t); }
        const float mprev = ((const float*)(ws + WS_MP))[chunk];
        const float mt = lf + fmaxf(mprev, cu);
        bs[lane] = lf; us[lane] = u; mts[lane] = mt; ints[lane] = __expf(lf + mprev - mt); ns[lane] = ((const float*)(ws + WS_NL))[chunk * 64 + lane];
    }
    __syncthreads();
    {
#pragma unroll
        for (int i = 0; i < 2; ++i) { const int blk = wave_u * 2 + i, lb = blk >> 2, sb = blk & 3;
            f32x4v acc = f32x4v{};
            if (sb <= lb) acc = mm16(QS, ML_LD, 16 * lb, KS, ML_LD, 16 * sb, 64, lane, acc);
            const int sidx = 16 * sb + (lane & 15); const float usv = us[sidx];
#pragma unroll
            for (int r = 0; r < 4; ++r) { const int l = 16 * lb + 4 * (lane >> 4) + r;
                const float v = (sidx <= l) ? acc[r] * __expf(bs[l] + usv - mts[l]) : 0.f;
                SW[l * ML_LD + sidx] = f2bf(v); } }
    }
    __syncthreads();
    if (tid < 64) {
        const int l = tid; float qn = 0.f, ssum = 0.f;
        for (int d = 0; d < 64; ++d) { qn += bf2f(QS[l * ML_LD + d]) * ns[d]; ssum += bf2f(SW[l * ML_LD + d]); }
        const float den = ints[l] * qn + ssum;
        dinv[l] = 1.f / fmaxf(fabsf(den), __expf(-mts[l]));
    }
    f32x4v hq[2], hs2[2];
#pragma unroll
    for (int i = 0; i < 2; ++i) { const int blk = wave_u * 2 + i, lb = blk >> 2, eb = blk & 3;
        hq[i] = mm16(QS, ML_LD, 16 * lb, CP, ML_LD, 16 * eb, 64, lane, f32x4v{});
        hs2[i] = mm16(SW, ML_LD, 16 * lb, VT, ML_LD, 16 * eb, 16 * lb + 16 <= 32 ? 32 : 64, lane, f32x4v{}); }
    __syncthreads();
#pragma unroll
    for (int i = 0; i < 2; ++i) { const int blk = wave_u * 2 + i, lb = blk >> 2, eb = blk & 3; const int e = 16 * eb + (lane & 15);
#pragma unroll
        for (int r = 0; r < 4; ++r) { const int l = 16 * lb + 4 * (lane >> 4) + r;
            const float og = bf2f(((const bf16*)(ws + WS_CM))[(size_t)(row0 + l) * 768 + 512 + h * 64 + e]);
            HS[l * 65 + e] = (ints[l] * hq[i][r] + hs2[i][r]) * dinv[l] / (1.f + __expf(-og)); } }
    __syncthreads();
    {
        const int l = tid >> 3, e0 = (tid & 7) * 8, row = row0 + l;
        float v[8]; float mu = 0.f;
#pragma unroll
        for (int i = 0; i < 8; ++i) { v[i] = HS[l * 65 + e0 + i]; mu += v[i]; }
        mu += sxf<1>(mu); mu += sxf<2>(mu); mu += sxf<4>(mu); mu *= (1.f / 64.f);
        float var = 0.f;
#pragma unroll
        for (int i = 0; i < 8; ++i) { const float dl = v[i] - mu; var += dl * dl; }
        var += sxf<1>(var); var += sxf<2>(var); var += sxf<4>(var);
        const float rs = rsqrtf(var * (1.f / 64.f) + EPS);
        const v4u x4 = *(const v4u*)((const bf16*)(ws + WS_XC) + (size_t)row * 256 + h * 64 + e0);
        float xv[8]; xv[0] = __uint_as_float(x4.x << 16); xv[1] = __uint_as_float(x4.x & 0xffff0000u); xv[2] = __uint_as_float(x4.y << 16); xv[3] = __uint_as_float(x4.y & 0xffff0000u);
        xv[4] = __uint_as_float(x4.z << 16); xv[5] = __uint_as_float(x4.z & 0xffff0000u); xv[6] = __uint_as_float(x4.w << 16); xv[7] = __uint_as_float(x4.w & 0xffff0000u);
        float r[8];
#pragma unroll
        for (int i = 0; i < 8; ++i) r[i] = (v[i] - mu) * rs * gmh[h * 64 + e0 + i] + skip[h * 64 + e0 + i] * xv[i];
        v4u w4; w4.x = cvtpk(r[0], r[1]); w4.y = cvtpk(r[2], r[3]); w4.z = cvtpk(r[4], r[5]); w4.w = cvtpk(r[6], r[7]);
        *(v4u*)((bf16*)(ws + WS_HB) + (size_t)row * D_ + 768 + h * 64 + e0) = w4;
    }
    __syncthreads();
}

__global__ void __launch_bounds__(NTHR, 2) mega(MP p_unused) {
    extern __shared__ __attribute__((aligned(16))) unsigned char lds_raw[];
    LAS unsigned char* lds = (LAS unsigned char*)lds_raw;
    const int wave0 = __builtin_amdgcn_readfirstlane((int)threadIdx.x >> 6);
    const int tid0 = wave0 * 64 + fresh_lane();
    const int xcc = (int)(__builtin_amdgcn_s_getreg((3 << 11) | 20) & 7u);
    volatile LAS unsigned* MISC = (volatile LAS unsigned*)(lds + MISC_OFF);
    for (int u = tid0; u < (LDS_BYTES - RING_BYTES) / 4; u += NTHR) ((LAS unsigned*)(lds + RING_BYTES))[u] = 0u;
    __syncthreads();
    typedef const __attribute__((address_space(4))) MP* kmp_t;
    kmp_t kp0 = (kmp_t)__builtin_amdgcn_kernarg_segment_ptr();
    unsigned char* ws0 = kp0->ws; const int coop = kp0->coop, ph_lo = kp0->ph_lo, ph_hi = kp0->ph_hi;
    XcdBarrier bar; bar.bar = (unsigned*)(ws0 + WS_CTL) + CW_BAR; bar.x = 0; bar.st = nullptr;
    if (coop) bar = xcd_barrier_post((unsigned*)(ws0 + WS_CTL) + CW_BAR, MISC + 8, tid0);
    if (coop == 2) cooperative_groups::this_grid().sync();
    int ph = ph_lo;
    if (ph == 0) {
        const MPK p{kp0}; ph_p0(p, lds, wave0 * 64 + fresh_lane()); ph = 1;
        if (ph < ph_hi) xcd_barrier(bar, wave0 * 64 + fresh_lane());
    }
    bool second = false;
    for (; ph < ph_hi; ++ph) {
        kmp_t kp = kp0; asm volatile("" : "+s"(kp));
        const MPK p{kp}; unsigned char* ws = kp->ws;
#define TID_ (wave0 * 64 + fresh_lane())
#define GW_ (blockIdx.x * NWAVES + wave0)
#define NGW_ (gridDim.x * NWAVES)
        const int l = (ph - 1) / PPL, ty = (ph == 0) ? -1 : (ph == NPH - 1) ? -2 : (ph - 1) % PPL;
        const float* modl = (const float*)(ws + WS_MOD) + (size_t)l * 8 * 6144;
        if (ty == -2) { norm_rows(p.k->out, PIN(I_GFIN), nullptr, nullptr, nullptr, p.k->out, 2, GW_, NGW_, fresh_lane());
            if (PROBE_SEL != 0 && blockIdx.x == 0 && TID_ == 0) { asm volatile("s_waitcnt vmcnt(0)" ::: "memory"); p.k->out[0] = ((const float*)(ws + WS_CTL))[100] * 0.001f; } }
        else if (ty == 0 && (PHM & 2)) ph_prep(p, l, lds, TID_);
        else if (ty == 1 && (PHM & 4)) {
            pg8::Gemm g{(const bf16*)(ws + WS_HB), (const bf16*)(ws + WT_IN), T_, 2560, D_}; pg8::StaticOrder S; S.init(T_, 2560, gridDim.x, blockIdx.x);
            pg8::EpiIn E{ws, PIN(I_BIG) + l * 4, PIN(I_BFG) + l * 4};
            pg8::gemm_phase<pg8::EpiIn, pg8::StaticOrder, true, true>(lds, g, S, E, wave0);
            late_transposes(p, l, lds, TID_, 640 % (int)gridDim.x);
        }
        else if (ty == 2 && (PHM & 64)) {
            { pg8::Gemm g{(const bf16*)(ws + WS_KVL), (const bf16*)(ws + WT_UKV), T_, 768, 128}; pg8::StaticOrder S; S.init(T_, 768, gridDim.x, blockIdx.x);
              pg8::EpiUKV E{(bf16*)(ws + WS_KVM), (const float*)(ws + WS_SSKV)}; pg8::gemm_phase<pg8::EpiUKV, pg8::StaticOrder, true, true>(lds, g, S, E, wave0); }
            { pg8::Gemm g{(const bf16*)(ws + WS_QL), (const bf16*)(ws + WT_UQ), T_, 768, 256}; pg8::StaticOrder S; S.init(T_, 768, gridDim.x, blockIdx.x);
              pg8::EpiPlain E{(bf16*)(ws + WS_OSLC), 768}; pg8::gemm_phase<pg8::EpiPlain, pg8::StaticOrder, true, true>(lds, g, S, E, wave0); }
            post_misc(ws, PIN(I_BIG) + l * 4, PIN(I_BFG) + l * 4, TID_);
            unsigned* ctrs = (unsigned*)(ws + WS_CTL) + 8192 + ph * 256 + (second ? 128 : 0); int ks = 0;
            for (;;) { const int it = next_item_q(ctrs, lds, wave0, 160, xcc, ks); if (it < 0) break; const int b = it >> 16, j = it & 0xffff;
                if (second && (REP_MASK & (1 << 18)) && j >= 128) continue; if (second && (REP_MASK & (1 << 19)) && j < 128) continue;
                if (j < 128) mlocal_item(ws, lds, PIN(I_CONVW) + l * 1024, PIN(I_CONVB) + l * 256, PIN(I_BIG) + l * 4, PIN(I_BFG) + l * 4, b * 128 + j, wave0);
                else { const int k = j - 128; compress_item(ws, lds, PIN(I_CMPPOS) + l * 2048, ((k >> 4) << 7) | (b << 4) | (k & 15), wave0); } }
        }
        else if (ty == 3 && (PHM & 128)) {
            unsigned* ctrs = (unsigned*)(ws + WS_CTL) + 8192 + ph * 256 + (second ? 128 : 0); int ks = 0;
            for (;;) { const int it = next_item_q(ctrs, lds, wave0, second ? 64 : 100, xcc, ks); if (it < 0) break; const int b = it >> 16, j = it & 0xffff;
                if (second && (REP_MASK & (1 << 20)) && j >= 48) continue; if (second && (REP_MASK & (1 << 21)) && j < 48) continue;
                if (j < 18) mla_unit(ws, lds, b, j % 6, 7 - j / 6, wave0);
                else if (j < 34) cmp_unit(ws, lds, b, (j - 18) >> 3, 7 - ((j - 18) & 7), wave0);
                else if (j < 64) { const int u = j - 16; mla_unit(ws, lds, b, u % 6, 7 - u / 6, wave0); }
                else mscan_item(ws, b * 36 + (j - 64), wave0); }
        }
        else if (ty == 4 && (PHM & 256)) {
            unsigned* ctrs = (unsigned*)(ws + WS_CTL) + 8192 + ph * 256 + (second ? 128 : 0); int ks = 0;
            for (;;) { const int it = next_item_q(ctrs, lds, wave0, 224, xcc, ks); if (it < 0) break; const int b = it >> 16, j = it & 0xffff;
                if (second && (REP_MASK & (1 << 16)) && j >= 96) continue; if (second && (REP_MASK & (1 << 17)) && j < 96) continue;
                if (j < 36) nsa_branch_unit<AM_SLC>(ws, lds, b, j % 6, 7 - j / 6, wave0);
                else if (j < 84) nsa_branch_unit<AM_WINDOW>(ws, lds, b, (j - 36) % 6, 7 - (j - 36) / 6, wave0);
                else if (j < 96) { const int u = j - 48; nsa_branch_unit<AM_SLC>(ws, lds, b, u % 6, 7 - u / 6, wave0); }
                else mout_item(ws, lds, PIN(I_GMH) + l * 256, PIN(I_SKIP) + l * 256, b * 128 + (j - 96), wave0); }
        }
        else if (ty == 5) ph_mixnorm(p, l, TID_);
        else if (ty == 6 && (PHM & 8)) {
            pg8::Gemm g{(const bf16*)(ws + WS_HB), (const bf16*)(ws + WT_OUT), T_, D_, D_}; pg8::StaticOrder S; S.init(T_, D_, gridDim.x, blockIdx.x);
            pg8::EpiRes E{(l == 0) ? PIN(I_X) : p.k->out, p.k->out, modl + 2048};
            pg8::gemm_phase<pg8::EpiRes, pg8::StaticOrder, true, true>(lds, g, S, E, wave0);
        }
        else if (ty == 7) norm_rows(p.k->out, PIN(I_GN2) + l * D_, modl + 3072, modl + 4096, (bf16*)(ws + WS_HB), nullptr, 1, GW_, NGW_, fresh_lane());
        else if (ty == 8 && (PHM & 16)) {
            pg8::Gemm g{(const bf16*)(ws + WS_HB), (const bf16*)(ws + WT_GU), T_, 2 * FF, D_}; pg8::StaticOrder S; S.init(T_, 2 * FF, gridDim.x, blockIdx.x);
            pg8::EpiGU E{(bf16*)(ws + WS_ACT)};
            pg8::gemm_phase<pg8::EpiGU, pg8::StaticOrder, true, true>(lds, g, S, E, wave0);
        }
        else if (ty == 9 && (PHM & 32)) {
            pg8::Gemm g{(const bf16*)(ws + WS_ACT), (const bf16*)(ws + WT_DOWN), T_, D_, FF}; pg8::StaticOrder S; S.init(T_, D_, gridDim.x, blockIdx.x);
            pg8::EpiRes E{p.k->out, p.k->out, modl + 5120};
            pg8::gemm_phase<pg8::EpiRes, pg8::StaticOrder, true, true>(lds, g, S, E, wave0);
        }
        if (REP_MASK != 0 && ty >= 0 && ((REP_MASK >> ty) & 1) && !second) { second = true; --ph; } else second = false;
        if (ph + 1 < ph_hi) xcd_barrier(bar, wave0 * 64 + fresh_lane());
    }
}

extern "C" void kernel_launch(void* const* d_in, const int* in_sizes, int n_in, void* d_out, int out_size, void* d_ws, size_t ws_size, hipStream_t stream) {
    if (n_in != N_IN || ws_size < WS_END) { fprintf(stderr, "kernel_launch: unexpected n_in %d / ws %zu\n", n_in, ws_size); return; }
    static int inited = 0;
    if (!inited) { if (hipFuncSetAttribute((const void*)mega, hipFuncAttributeMaxDynamicSharedMemorySize, LDS_BYTES) != hipSuccess) fprintf(stderr, "hipFuncSetAttribute failed\n"); inited = 1; }
    unsigned char* ws = (unsigned char*)d_ws;
    MP base{}; for (int i = 0; i < N_IN; ++i) base.in[i] = (const float*)d_in[i]; base.out = (float*)d_out; base.ws = ws;
    (void)hipMemsetAsync(ws + WS_CTL, 0, CTL_ZERO_BYTES, stream);
    static int grid = 0;
    if (!grid) {
        int dev = 0, cus = 0, per_cu = 0;
        (void)hipGetDevice(&dev); (void)hipDeviceGetAttribute(&cus, hipDeviceAttributeMultiprocessorCount, dev);
        if (hipOccupancyMaxActiveBlocksPerMultiprocessor(&per_cu, (const void*)mega, NTHR, LDS_BYTES) != hipSuccess || per_cu < 1) { fprintf(stderr, "kernel_launch: occupancy query says %d blocks per CU\n", per_cu); per_cu = 1; }
        (void)hipGetLastError();
        grid = cus;
    }
    MP a = base; a.ph_lo = 0; a.ph_hi = NPH; a.coop = 1;
    void* args[] = {&a};
    const hipError_t e = hipLaunchCooperativeKernel((const void*)mega, dim3(grid), dim3(NTHR), args, LDS_BYTES, stream);
    if (e != hipSuccess) fprintf(stderr, "kernel_launch: cooperative launch failed: %s (grid %d)\n", hipGetErrorString(e), grid);
}
```

```cpp
#include <hip/hip_runtime.h>
#include <cstdint>
#include <cstdio>
#include <hip/hip_cooperative_groups.h>

constexpr int B_ = 8, S_ = 2048, T_ = B_ * S_, D_ = 1024, DIN = 2362, FF = 2816, DEPTH = 2;
constexpr float EPS = 1e-6f;
constexpr float LOG2E = 1.4426950408889634f;
constexpr float QSCALE = 0.125f * LOG2E;
constexpr float MSCALE = 0.10206207261596577f * LOG2E;
enum { I_X = 0, I_C, I_POS, I_GN1, I_GN2, I_WADA, I_BADA, I_WIN, I_CMPPOS, I_WCK, I_WCV, I_GOA, I_GQL, I_WUQ, I_GKVL, I_WUKV, I_GOB,
       I_CONVW, I_CONVB, I_WQM, I_WKM, I_BIG, I_BFG, I_GMH, I_SKIP, I_WOUT, I_WGU, I_WDOWN, I_GFIN, N_IN };

constexpr size_t MiB = 1u << 20;
constexpr size_t WS_CTL = 0;
constexpr size_t WS_MOD = 1 * MiB;
constexpr size_t WS_COSP = WS_MOD + 512 * 1024;
constexpr size_t WS_SINP = WS_COSP + 512 * 1024;
constexpr size_t WS_COSM = WS_SINP + 512 * 1024;
constexpr size_t WS_SINM = WS_COSM + 1 * MiB;
constexpr size_t WS_SSQL = WS_SINM + 1 * MiB;
constexpr size_t WS_SSKV = WS_SSQL + 64 * 1024;
constexpr size_t WS_ML = WS_SSKV + 64 * 1024;
constexpr size_t WS_BL = WS_ML + 4096;
constexpr size_t WS_MP = WS_BL + 4096;
constexpr size_t WS_NL = WS_MP + 4096;
constexpr size_t WS_WT = 8 * MiB;
constexpr size_t WS_RAW = WS_WT;
constexpr size_t WS_HB = 34 * MiB;
constexpr size_t WS_NSA = 66 * MiB;
constexpr size_t WS_KVL = 102 * MiB;
constexpr size_t WS_QL = 106 * MiB;
constexpr size_t WS_CM = 114 * MiB;
constexpr size_t WS_GM = 138 * MiB;
constexpr size_t WS_KM = 140 * MiB;
constexpr size_t WS_QM = 158 * MiB;
constexpr size_t WS_VM = 176 * MiB;
constexpr size_t WS_KCV = 188 * MiB;
constexpr size_t WS_OCMP = 189 * MiB;
constexpr size_t WS_SEL = 201 * MiB;
constexpr size_t WS_XC = 202 * MiB;
constexpr size_t WS_MQ = 210 * MiB;
constexpr size_t WS_MK = 218 * MiB;
constexpr size_t WS_CT = 226 * MiB;
constexpr size_t WS_MISCRAW = 242 * MiB;
constexpr size_t WS_KVM = 140 * MiB;
constexpr size_t WS_KR = 246 * MiB;
constexpr size_t WS_OSLC = 164 * MiB;
constexpr size_t WS_OWIN = 176 * MiB;
constexpr size_t WS_ACT = 66 * MiB;
constexpr size_t WS_END = 256 * MiB;
static_assert(WS_NL + 1024 * 64 * 4 <= WS_WT, "tab");
static_assert(WS_ACT + (size_t)T_ * FF * 2 <= WS_KCV, "act overlay");

typedef unsigned short bf16;
__device__ __forceinline__ float bf2f(bf16 v) { return __uint_as_float(((unsigned)v) << 16); }
__device__ __forceinline__ bf16 f2bf(float f) { unsigned u = __float_as_uint(f); return (bf16)((u + 0x7fffu + ((u >> 16) & 1u)) >> 16); }
__device__ __forceinline__ float sigmoidf_(float x) { return 1.f / (1.f + __expf(-x)); }
__device__ __forceinline__ float siluf_(float x) { return x / (1.f + __expf(-x)); }
__device__ __forceinline__ float wave_sum(float v) {
#pragma unroll
    for (int o = 1; o < 64; o <<= 1) v += __shfl_xor(v, o);
    return v;
}

__device__ __forceinline__ int fresh_lane() { int l; asm volatile("v_mbcnt_lo_u32_b32 %0, -1, 0\n\tv_mbcnt_hi_u32_b32 %0, -1, %0" : "=&v"(l)); return l; }
template <int M> __device__ __forceinline__ float sxf(float v) { static_assert(M >= 1 && M < 32, "swizzle xor mask"); return __int_as_float(__builtin_amdgcn_ds_swizzle(__float_as_int(v), (M << 10) | 0x1f)); }
__device__ __forceinline__ float red32_max(float v) { auto r = __builtin_amdgcn_permlane32_swap(__float_as_uint(v), __float_as_uint(v), false, false); return fmaxf(__uint_as_float(r[0]), __uint_as_float(r[1])); }
__device__ __forceinline__ float red32_sum(float v) { auto r = __builtin_amdgcn_permlane32_swap(__float_as_uint(v), __float_as_uint(v), false, false); return __uint_as_float(r[0]) + __uint_as_float(r[1]); }
__device__ __forceinline__ unsigned red32_or(unsigned v) { auto r = __builtin_amdgcn_permlane32_swap(v, v, false, false); return r[0] | r[1]; }
__device__ __forceinline__ float bperm(float v, int src_lane) { return __int_as_float(__builtin_amdgcn_ds_bpermute(src_lane << 2, __float_as_int(v))); }
__device__ __forceinline__ float wave_sum2(float v) { v += sxf<1>(v); v += sxf<2>(v); v += sxf<4>(v); v += sxf<8>(v); v += sxf<16>(v); return red32_sum(v); }
__device__ __forceinline__ float wave_max2(float v) { v = fmaxf(v, sxf<1>(v)); v = fmaxf(v, sxf<2>(v)); v = fmaxf(v, sxf<4>(v)); v = fmaxf(v, sxf<8>(v)); v = fmaxf(v, sxf<16>(v)); return red32_max(v); }
namespace pg8 {
#define PG8_LAS __attribute__((address_space(3)))
typedef unsigned short bf16_t;
typedef short bf16x8 __attribute__((ext_vector_type(8)));
typedef float f32x4 __attribute__((ext_vector_type(4)));
typedef unsigned u32x4 __attribute__((ext_vector_type(4)));
constexpr int BM = 256, BK = 64, HALF = 128, HTB = HALF * BK * 2  , STAGE_BYTES = 8 * HTB, NXCD = 8, WGM = 8;

__host__ __device__ __forceinline__ int lds_byte(int r, int c) { const int st = (r >> 4) * 2 + (c >> 5), rr = r & 15, cc = c & 31, ob = rr * 64 + cc * 2; return st * 1024 + (ob ^ (((ob >> 9) & 1) << 5)); }
__host__ __device__ __forceinline__ void stage_rc(int b, int& R, int& C) { const int st = b / 1024, sb = b % 1024, swz = sb ^ (((sb >> 9) & 1) << 5); R = (st >> 1) * 16 + swz / 64; C = (st & 1) * 32 + (swz % 64) / 2; }
__host__ __device__ __forceinline__ int perm32(int rho) { const int n = rho >> 4, i = rho & 15; return 8 * (i >> 2) + 4 * n + (i & 3); }

struct Unit { int pm, pn; };
struct Gemm { const bf16_t* A; const bf16_t* Bt; int M, N, K; };

struct StaticOrder {
    int nM, nN, nwg, G, c;
    __host__ __device__ void init(int M, int N, int G_, int c_) { nM = M / BM; nN = N / BM; nwg = nM * nN; G = G_; c = c_; }
    __host__ __device__ bool next(int i, Unit& u) const {
        const long L = (long)i * G + c; if (L >= nwg) return false;
        int wgid = (int)L; { const int q = nwg / NXCD, r = nwg % NXCD, xcd = wgid % NXCD, off = wgid / NXCD; wgid = (xcd < r ? xcd * (q + 1) : r * (q + 1) + (xcd - r) * q) + off; }
        const int nig = WGM * nN, gid = wgid / nig, fm = gid * WGM, gsz = (nM - fm) < WGM ? (nM - fm) : WGM;
        u.pm = fm + ((wgid % nig) % gsz); u.pn = (wgid % nig) / gsz; return true;
    }
    __device__ __forceinline__ void a_ready(const Unit&) const {}
    __device__ __forceinline__ void done(const Unit&) const {}
};

__device__ __forceinline__ unsigned cvt_pk_bf16(float lo, float hi) { unsigned r; asm volatile("v_cvt_pk_bf16_f32 %0, %1, %2" : "=v"(r) : "v"(lo), "v"(hi)); return r; }
typedef float f32x2 __attribute__((ext_vector_type(2)));

typedef unsigned u32x4 __attribute__((ext_vector_type(4)));
typedef unsigned u32x2 __attribute__((ext_vector_type(2)));
struct EpiIn {
    static constexpr bool PERM = true, AFTER_DRAIN = false;
    unsigned char* ws; const float *big, *bfg;
#define EPI_ROWS(...) _Pragma("unroll") for (int ai = 0; ai < 2; ++ai) _Pragma("unroll") for (int m = 0; m < 4; ++m) { \
        const int row = u.pm * BM + ai * HALF + wr * 64 + m * 16 + fr; float v[8]; \
        _Pragma("unroll") for (int i = 0; i < 4; ++i) { v[i] = acc[ai][bj][m][0][i]; v[4 + i] = acc[ai][bj][m][1][i]; } \
        asm volatile("" : "+v"(v[0]), "+v"(v[1]), "+v"(v[2]), "+v"(v[3]), "+v"(v[4]), "+v"(v[5]), "+v"(v[6]), "+v"(v[7])); \
        __VA_ARGS__ asm volatile("" ::: "memory"); }
#define EPI_PACK(w) u32x4 w; w.x = cvt_pk_bf16(v[0], v[1]); w.y = cvt_pk_bf16(v[2], v[3]); w.z = cvt_pk_bf16(v[4], v[5]); w.w = cvt_pk_bf16(v[6], v[7]);
    __device__ __forceinline__ void operator()(const f32x4 (&acc)[2][2][4][2], const Unit& u, int wr, int wc, int fr, int fq) const {
        half<0>(acc, u, wr, wc, fr, fq); half<1>(acc, u, wr, wc, fr, fq);
    }
    template <int bj> __device__ __forceinline__ void half(const f32x4 (&acc)[2][2][4][2], const Unit& u, int wr, int wc, int fr, int fq) const {
        {
            const int hb = 2 * u.pn + bj;
            int cb = 32 * wc + 8 * fq; asm volatile("" : "+v"(cb), "+v"(fr));
            if (hb <= 8) {
                bf16_t* nsa = (bf16_t*)(ws + WS_NSA) + hb * 128 + cb;
                const bool rope_hb = (hb <= 3) || hb == 5 || hb == 7;
                if (rope_hb) {
                    const float* cosP = (const float*)(ws + WS_COSP); const float* sinP = (const float*)(ws + WS_SINP);
                    const bool mine = ((wc & 1) == 0) && fq < 2; const float sg = (fq == 0) ? -1.f : 1.f; const float sc = (hb < 3) ? QSCALE : 1.f;
                    EPI_ROWS({
                        float pv[8];
                        _Pragma("unroll") for (int i = 0; i < 8; ++i) pv[i] = sxf<16>(v[i]);
                        if (mine) {
                            const f32x4 c0 = *(const f32x4*)(cosP + row * 8), c1 = *(const f32x4*)(cosP + row * 8 + 4), s0 = *(const f32x4*)(sinP + row * 8), s1 = *(const f32x4*)(sinP + row * 8 + 4);
                            _Pragma("unroll") for (int i = 0; i < 4; ++i) { v[i] = v[i] * c0[i] + sg * pv[i] * s0[i]; v[4 + i] = v[4 + i] * c1[i] + sg * pv[4 + i] * s1[i]; }
                        }
                        _Pragma("unroll") for (int i = 0; i < 8; ++i) v[i] *= sc;
                        EPI_PACK(w) *(u32x4*)(nsa + (size_t)row * 1152) = w;
                    })
                } else {
                    EPI_ROWS({ EPI_PACK(w) *(u32x4*)(nsa + (size_t)row * 1152) = w; })
                }
            } else if (hb <= 11) {
                bf16_t* dst = (hb == 9) ? (bf16_t*)(ws + WS_KVL) + cb : (bf16_t*)(ws + WS_QL) + (hb - 10) * 128 + cb;
                const int ld = (hb == 9) ? 128 : 256;
                float* ssq = (hb == 9) ? (float*)(ws + WS_SSKV) : (float*)(ws + WS_SSQL);
                EPI_ROWS({ EPI_PACK(w) *(u32x4*)(dst + (size_t)row * ld) = w;
                    float sq = 0.f;
                    _Pragma("unroll") for (int i = 0; i < 8; ++i) sq += v[i] * v[i];
                    sq += sxf<16>(sq); sq = red32_sum(sq);
                    if (fq == 0) atomicAdd(ssq + row, sq); })
            } else if (hb <= 17) {
                bf16_t* cm = (bf16_t*)(ws + WS_CM) + (hb - 12) * 128 + cb;
                EPI_ROWS({ EPI_PACK(w) *(u32x4*)(cm + (size_t)row * 768) = w; })
            } else if (hb == 18) {
                float* mr = (float*)(ws + WS_MISCRAW) + cb;
                if (wc < 2) { EPI_ROWS({ *(f32x4*)(mr + (size_t)row * 64) = (f32x4){v[0], v[1], v[2], v[3]}; *(f32x4*)(mr + (size_t)row * 64 + 4) = (f32x4){v[4], v[5], v[6], v[7]}; }) }
            }
        }
    }
#undef EPI_ROWS
#undef EPI_PACK
};
struct EpiUKV {
    static constexpr bool PERM = true, AFTER_DRAIN = false;
    bf16_t* kvm; const float* sskv;
    __device__ __forceinline__ void operator()(const f32x4 (&acc)[2][2][4][2], const Unit& u, int wr, int wc, int fr, int fq) const {
        asm volatile("" : "+v"(fq), "+v"(fr));
        const int col0 = u.pn * BM + wc * 32 + 8 * fq;
#pragma unroll
        for (int ai = 0; ai < 2; ++ai)
#pragma unroll
            for (int m = 0; m < 4; ++m) { const int row = u.pm * BM + ai * HALF + wr * 64 + m * 16 + fr; bf16_t* rowp = kvm + (size_t)row * 768 + col0;
                const float rs = rsqrtf(sskv[row] * (1.f / 128.f) + EPS);
#pragma unroll
                for (int bj = 0; bj < 2; ++bj) { const f32x4 a = acc[ai][bj][m][0] * rs, b = acc[ai][bj][m][1] * rs;
                    u32x4 w; w.x = cvt_pk_bf16(a[0], a[1]); w.y = cvt_pk_bf16(a[2], a[3]); w.z = cvt_pk_bf16(b[0], b[1]); w.w = cvt_pk_bf16(b[2], b[3]);
                    *(u32x4*)(rowp + bj * HALF) = w; }
                asm volatile("" ::: "memory"); }
    }
};
struct EpiPlain {
    static constexpr bool PERM = true, AFTER_DRAIN = false;
    bf16_t* out; int ld;
    __device__ __forceinline__ void operator()(const f32x4 (&acc)[2][2][4][2], const Unit& u, int wr, int wc, int fr, int fq) const {
        asm volatile("" : "+v"(fq), "+v"(fr));
        const int col0 = u.pn * BM + wc * 32 + 8 * fq;
#pragma unroll
        for (int ai = 0; ai < 2; ++ai)
#pragma unroll
            for (int m = 0; m < 4; ++m) { bf16_t* rowp = out + (size_t)(u.pm * BM + ai * HALF + wr * 64 + m * 16 + fr) * ld + col0;
#pragma unroll
                for (int bj = 0; bj < 2; ++bj) { const f32x4 a = acc[ai][bj][m][0], b = acc[ai][bj][m][1];
                    u32x4 w; w.x = cvt_pk_bf16(a[0], a[1]); w.y = cvt_pk_bf16(a[2], a[3]); w.z = cvt_pk_bf16(b[0], b[1]); w.w = cvt_pk_bf16(b[2], b[3]);
                    *(u32x4*)(rowp + bj * HALF) = w; } }
    }
};
struct EpiRes {
    static constexpr bool PERM = false, AFTER_DRAIN = false;
    const float* xin; float* xout; const float* gate;
    __device__ __forceinline__ void operator()(const f32x4 (&acc)[2][2][4][2], const Unit& u, int wr, int wc, int fr, int fq) const {
        asm volatile("" : "+v"(fq), "+v"(fr));
        const int b = (u.pm * BM) / S_; const int col0 = u.pn * BM + wc * 32 + 4 * fq;
        f32x4 gv[2][2];
#pragma unroll
        for (int bj = 0; bj < 2; ++bj)
#pragma unroll
            for (int n = 0; n < 2; ++n) gv[bj][n] = *(const f32x4*)(gate + (size_t)b * 6144 + col0 + bj * HALF + n * 16);
#pragma unroll
        for (int ai = 0; ai < 2; ++ai)
#pragma unroll
            for (int m = 0; m < 4; ++m) { const size_t off = (size_t)(u.pm * BM + ai * HALF + wr * 64 + m * 16 + fr) * D_ + col0;
#pragma unroll
                for (int bj = 0; bj < 2; ++bj)
#pragma unroll
                    for (int n = 0; n < 2; ++n) { const f32x4 xi = *(const f32x4*)(xin + off + bj * HALF + n * 16); *(f32x4*)(xout + off + bj * HALF + n * 16) = xi + gv[bj][n] * acc[ai][bj][m][n]; } }
    }
};
struct EpiGU {
    static constexpr bool PERM = true, AFTER_DRAIN = false;
    bf16_t* act;
    __device__ __forceinline__ void operator()(const f32x4 (&acc)[2][2][4][2], const Unit& u, int wr, int wc, int fr, int fq) const {
        asm volatile("" : "+v"(fq), "+v"(fr));
        const int col0 = u.pn * HALF + wc * 32 + 8 * fq;
#pragma unroll
        for (int ai = 0; ai < 2; ++ai)
#pragma unroll
            for (int m = 0; m < 4; ++m) { const int row = u.pm * BM + ai * HALF + wr * 64 + m * 16 + fr; float o[8];
#pragma unroll
                for (int n = 0; n < 2; ++n)
#pragma unroll
                    for (int i = 0; i < 4; ++i) { const float g = acc[ai][0][m][n][i], up = acc[ai][1][m][n][i]; o[4 * n + i] = g / (1.f + __expf(-g)) * up; }
                u32x4 w; w.x = cvt_pk_bf16(o[0], o[1]); w.y = cvt_pk_bf16(o[2], o[3]); w.z = cvt_pk_bf16(o[4], o[5]); w.w = cvt_pk_bf16(o[6], o[7]);
                *(u32x4*)(act + (size_t)row * FF + col0) = w; }
    }
};
template <class Epi, class Sched, bool ALIGN_EPI = false, bool SP2 = false>
__device__ __forceinline__ void gemm_phase(PG8_LAS unsigned char* lds, const Gemm g, const Sched& S, const Epi& E, int wid_in) {
    const int wid = __builtin_amdgcn_readfirstlane(wid_in), lane = fresh_lane(), tid = wid * 64 + lane, wr = wid >> 2, wc = wid & 3;
    const int K = g.K, nt = K / BK;
    unsigned voffA[2], voffB[2];
#pragma unroll
    for (int i = 0; i < 2; ++i) { int R, C; stage_rc(tid * 16 + i * 8192, R, C); const int Rb = Epi::PERM ? ((R & ~31) + perm32(R & 31)) : R;
        voffA[i] = (unsigned)(R * K + C) * 2u; voffB[i] = (unsigned)(Rb * K + C) * 2u; }
    const size_t kstep = (size_t)(BK * 2);
    const size_t hstep = (size_t)HALF * K * 2;
    const size_t tstep = 2 * hstep;
    const unsigned ldsw = (unsigned)wid * 1024u;
    const int aoff = lds_byte(wr * 64 + (lane & 15), (lane >> 4) * 8), boff = lds_byte(wc * 32 + (lane & 15), (lane >> 4) * 8);
#define PG8_SA(b, h) (((b) * 2 + (h)) * HTB)
#define PG8_SB(b, h) ((4 + (b) * 2 + (h)) * HTB)
#define PG8_STAGE(bufoff, gbase, voff) do { _Pragma("unroll") for (int _i = 0; _i < 2; ++_i) \
        __builtin_amdgcn_global_load_lds((const unsigned*)((const char*)(gbase) + (voff)[_i]), (PG8_LAS unsigned*)(lds + (bufoff) + ldsw + _i * 8192), 16, 0, 0); } while (0)
#define PG8_LDA(dst, b, h) do { _Pragma("unroll") for (int m = 0; m < 4; ++m) _Pragma("unroll") for (int k = 0; k < 2; ++k) dst[m][k] = *(const PG8_LAS bf16x8*)(lds + PG8_SA(b, h) + aoff + m * 2048 + k * 1024); } while (0)
#define PG8_LDB(dst, b, h) do { _Pragma("unroll") for (int n = 0; n < 2; ++n) _Pragma("unroll") for (int k = 0; k < 2; ++k) dst[n][k] = *(const PG8_LAS bf16x8*)(lds + PG8_SB(b, h) + boff + n * 2048 + k * 1024); } while (0)
#define PG8_MMA(ai, bj, At, Bt) do { __builtin_amdgcn_s_setprio(1); _Pragma("unroll") for (int m = 0; m < 4; ++m) _Pragma("unroll") for (int n = 0; n < 2; ++n) _Pragma("unroll") for (int k = 0; k < 2; ++k) \
        acc[ai][bj][m][n] = __builtin_amdgcn_mfma_f32_16x16x32_bf16(Bt[n][k], At[m][k], acc[ai][bj][m][n], 0, 0, 0); __builtin_amdgcn_s_setprio(0); } while (0)
#define PG8_WAIT_V(n) asm volatile("s_waitcnt vmcnt(" #n ")" ::: "memory")
#define PG8_WAIT_L(n) asm volatile("s_waitcnt lgkmcnt(" #n ")" ::: "memory")
#define PG8_BAR __builtin_amdgcn_s_barrier()
#define PG8_SCHED __builtin_amdgcn_sched_barrier(0)
    Unit cur, nxt; int ui = 0;
    if (!S.next(0, cur)) return;
    f32x4 acc[2][2][4][2];
#pragma unroll
    for (int a = 0; a < 2; ++a)
#pragma unroll
        for (int b = 0; b < 2; ++b)
#pragma unroll
            for (int m = 0; m < 4; ++m)
#pragma unroll
                for (int n = 0; n < 2; ++n) acc[a][b][m][n] = (f32x4){0.f, 0.f, 0.f, 0.f};
    bf16x8 At[4][2], B0[2][2], B1[2][2];
    const char* cA = (const char*)g.A + (size_t)cur.pm * tstep; const char* cB = (const char*)g.Bt + (size_t)cur.pn * tstep;
    S.a_ready(cur);
    if constexpr (SP2) {
        PG8_STAGE(PG8_SB(0, 0), cB, voffB); PG8_STAGE(PG8_SB(0, 1), cB + hstep, voffB); PG8_STAGE(PG8_SA(0, 0), cA, voffA); PG8_STAGE(PG8_SA(0, 1), cA + hstep, voffA);
        if (wr == 1) PG8_BAR;
        PG8_WAIT_V(2); PG8_BAR;
        PG8_STAGE(PG8_SB(1, 0), cB + kstep, voffB); PG8_STAGE(PG8_SA(1, 0), cA + kstep, voffA); PG8_STAGE(PG8_SB(1, 1), cB + hstep + kstep, voffB);
        PG8_WAIT_V(6); PG8_BAR;
    } else {
        PG8_STAGE(PG8_SB(0, 0), cB, voffB); PG8_STAGE(PG8_SA(0, 0), cA, voffA); PG8_STAGE(PG8_SB(0, 1), cB + hstep, voffB); PG8_STAGE(PG8_SA(0, 1), cA + hstep, voffA);
        if (wr == 1) PG8_BAR;
        PG8_WAIT_V(4); PG8_BAR;
        PG8_STAGE(PG8_SB(1, 0), cB + kstep, voffB); PG8_STAGE(PG8_SA(1, 0), cA + kstep, voffA); PG8_STAGE(PG8_SB(1, 1), cB + hstep + kstep, voffB);
        PG8_WAIT_V(6); PG8_BAR;
    }
    for (;;) {
        const bool has_next = S.next(ui + 1, nxt);
        const char* nA = has_next ? (const char*)g.A + (size_t)nxt.pm * tstep : cA; const char* nB = has_next ? (const char*)g.Bt + (size_t)nxt.pn * tstep : cB;
        for (int t = 0; t < nt; t += 2) {
            const bool last = (t == nt - 2);
            const char* a1 = cA + (size_t)(t + 1) * kstep;
            const char* a2 = last ? nA : cA + (size_t)(t + 2) * kstep; const char* b2 = last ? nB : cB + (size_t)(t + 2) * kstep;
            const char* a3 = a2 + kstep; const char* b3 = b2 + kstep;
            if (last && has_next) S.a_ready(nxt);
            if constexpr (SP2) {
            PG8_LDB(B0, 0, 0); PG8_LDB(B1, 0, 1); PG8_SCHED; PG8_LDA(At, 0, 0); PG8_STAGE(PG8_SA(1, 1), a1 + hstep, voffA);
            PG8_WAIT_V(8); PG8_WAIT_L(0); PG8_BAR; PG8_MMA(0, 0, At, B0); PG8_MMA(0, 1, At, B1); PG8_BAR; PG8_SCHED;
            PG8_LDA(At, 0, 1); PG8_STAGE(PG8_SB(0, 0), b2, voffB); PG8_STAGE(PG8_SB(0, 1), b2 + hstep, voffB); PG8_STAGE(PG8_SA(0, 0), a2, voffA);
            PG8_WAIT_V(8); PG8_WAIT_L(0); PG8_BAR; PG8_MMA(1, 0, At, B0); PG8_MMA(1, 1, At, B1); PG8_BAR; PG8_SCHED;
            PG8_LDB(B0, 1, 0); PG8_LDB(B1, 1, 1); PG8_SCHED; PG8_LDA(At, 1, 0); PG8_STAGE(PG8_SA(0, 1), a2 + hstep, voffA);
            PG8_WAIT_V(8); PG8_WAIT_L(0); PG8_BAR; PG8_MMA(0, 0, At, B0); PG8_MMA(0, 1, At, B1); PG8_BAR; PG8_SCHED;
            PG8_LDA(At, 1, 1); PG8_STAGE(PG8_SB(1, 0), b3, voffB); PG8_STAGE(PG8_SB(1, 1), b3 + hstep, voffB); PG8_STAGE(PG8_SA(1, 0), a3, voffA);
            PG8_WAIT_V(8); PG8_WAIT_L(0); PG8_BAR; PG8_MMA(1, 0, At, B0); PG8_MMA(1, 1, At, B1); PG8_BAR; PG8_SCHED;
            } else {
            PG8_LDB(B0, 0, 0); PG8_SCHED; PG8_LDA(At, 0, 0); PG8_STAGE(PG8_SA(1, 1), a1 + hstep, voffA);
            PG8_WAIT_L(8); PG8_BAR; PG8_WAIT_L(0); PG8_MMA(0, 0, At, B0); PG8_BAR; PG8_SCHED;
            PG8_LDB(B1, 0, 1); PG8_STAGE(PG8_SB(0, 0), b2, voffB);
            PG8_BAR; PG8_WAIT_L(0); PG8_MMA(0, 1, At, B1); PG8_BAR;
            PG8_LDA(At, 0, 1); PG8_STAGE(PG8_SA(0, 0), a2, voffA);
            PG8_BAR; PG8_WAIT_L(0); PG8_MMA(1, 0, At, B0); PG8_BAR; PG8_SCHED;
            PG8_STAGE(PG8_SB(0, 1), b2 + hstep, voffB);
            PG8_WAIT_V(6); PG8_BAR; PG8_MMA(1, 1, At, B1); PG8_BAR;
            PG8_LDB(B0, 1, 0); PG8_SCHED; PG8_LDA(At, 1, 0); PG8_STAGE(PG8_SA(0, 1), a2 + hstep, voffA);
            PG8_WAIT_L(8); PG8_BAR; PG8_WAIT_L(0); PG8_MMA(0, 0, At, B0); PG8_BAR; PG8_SCHED;
            PG8_LDB(B1, 1, 1); PG8_STAGE(PG8_SB(1, 0), b3, voffB);
            PG8_BAR; PG8_WAIT_L(0); PG8_MMA(0, 1, At, B1); PG8_BAR;
            PG8_LDA(At, 1, 1); PG8_STAGE(PG8_SA(1, 0), a3, voffA);
            PG8_BAR; PG8_WAIT_L(0); PG8_MMA(1, 0, At, B0); PG8_BAR; PG8_SCHED;
            PG8_STAGE(PG8_SB(1, 1), b3 + hstep, voffB);
            PG8_WAIT_V(6); PG8_BAR; PG8_MMA(1, 1, At, B1); PG8_BAR;
            }
        }
        if constexpr (ALIGN_EPI) { if (wr == 0) PG8_BAR; }
        if constexpr (!Epi::AFTER_DRAIN) { const int ln = fresh_lane(); E(acc, cur, wr, wc, ln & 15, ln >> 4); S.done(cur); }
        if (!has_next) break;
#pragma unroll
        for (int a = 0; a < 2; ++a)
#pragma unroll
            for (int b = 0; b < 2; ++b)
#pragma unroll
                for (int m = 0; m < 4; ++m)
#pragma unroll
                    for (int n = 0; n < 2; ++n) acc[a][b][m][n] = (f32x4){0.f, 0.f, 0.f, 0.f};
        cur = nxt; cA = nA; cB = nB; ++ui;
        if constexpr (ALIGN_EPI) { if (wr == 1) PG8_BAR; }
    }
    PG8_WAIT_V(0);
    if constexpr (!ALIGN_EPI) { if (wr == 0) PG8_BAR; }
    PG8_BAR;
    if constexpr (Epi::AFTER_DRAIN) { const int ln = fresh_lane(); E.fused(acc, cur, wr, wc, ln & 15, ln >> 4, lds, wid, ln); S.done(cur); }
#undef PG8_SA
#undef PG8_SB
#undef PG8_STAGE
#undef PG8_LDA
#undef PG8_LDB
#undef PG8_MMA
#undef PG8_WAIT_V
#undef PG8_WAIT_L
#undef PG8_BAR
#undef PG8_SCHED
}
}

#define GAS __attribute__((address_space(1)))
#define LAS __attribute__((address_space(3)))
typedef float f32x4 __attribute__((ext_vector_type(4)));
typedef unsigned v4u __attribute__((ext_vector_type(4)));
typedef GAS unsigned gu32;
#define XB_TMO      128
#define XB_XCNT(j)  (256  + 64 * (j))
#define XB_XSUB(j)  (1280 + 64 * (j))
#define XB_XGEN(j)  (2304 + 64 * (j))
#define XB_TOP      3328
#define XB_TOPGEN   3392
#define XCD_BAR_WORDS 3456
#define XB_SPIN_CAP (1u << 18)

__device__ __forceinline__ unsigned xb_ld(unsigned* p)              { return __hip_atomic_load(p, __ATOMIC_RELAXED, __HIP_MEMORY_SCOPE_AGENT); }
__device__ __forceinline__ unsigned xb_add(unsigned* p, unsigned v) { return __hip_atomic_fetch_add(p, v, __ATOMIC_RELAXED, __HIP_MEMORY_SCOPE_AGENT); }
__device__ __forceinline__ unsigned xb_xcc_id() { return (unsigned)__builtin_amdgcn_s_getreg((3 << 11) | 20) & 0xFu; }
#define XB_SPIN(cond, bar) do { unsigned _sp = 0; while (cond) { __builtin_amdgcn_s_sleep(1); \
    if ((++_sp & 255u) == 0u) { if (xb_ld(&(bar)[XB_TMO])) break; if (_sp > XB_SPIN_CAP) { atomicAdd(&(bar)[XB_TMO], 1u); break; } } } } while (0)

struct XcdBarrier {
    unsigned* bar; unsigned x;
    volatile LAS unsigned* st;
};

__device__ __forceinline__ XcdBarrier xcd_barrier_post(unsigned* bar, volatile LAS unsigned* st, int tid) {
    XcdBarrier b; b.bar = bar; b.x = xb_xcc_id(); b.st = st;
    if (tid == 0) (void)xb_add(&bar[XB_XCNT(b.x)], 1u);
    return b;
}
__device__ __forceinline__ void xcd_barrier_complete(unsigned* bar, unsigned x, unsigned& nloc, unsigned& nx) {
    const unsigned G = gridDim.x * gridDim.y * gridDim.z;
    unsigned sum, cnt, mine, sp = 0u;
    for (;;) {
        sum = 0u; cnt = 0u; mine = 0u;
#pragma unroll
        for (unsigned j = 0; j < 16; ++j) { const unsigned c = xb_ld(&bar[XB_XCNT(j)]); sum += c; cnt += (c > 0u) ? 1u : 0u; mine = (j == x) ? c : mine; }
        if (sum == G) break;
        __builtin_amdgcn_s_sleep(1);
        if ((++sp & 255u) == 0u) { if (xb_ld(&bar[XB_TMO])) break; if (sp > XB_SPIN_CAP) { atomicAdd(&bar[XB_TMO], 1u); break; } }
    }
    nloc = mine > 0u ? mine : 1u; nx = cnt > 0u ? cnt : 1u;
}

__device__ __forceinline__ void xcd_barrier(const XcdBarrier& b, int tid) {
    asm volatile("s_waitcnt vmcnt(0)" ::: "memory");
    __syncthreads();
    if (tid == 0) {
        unsigned* bar = b.bar;
        __builtin_amdgcn_s_waitcnt(0);
        unsigned nloc = b.st[0], nx = b.st[1];
        if (nloc == 0u) { xcd_barrier_complete(bar, b.x, nloc, nx); b.st[0] = nloc; b.st[1] = nx; }
        const unsigned old = xb_add(&bar[XB_XSUB(b.x)], 1u);
        const unsigned gen = old / nloc;
        if (old + 1u == (gen + 1u) * nloc) {
            __builtin_amdgcn_fence(__ATOMIC_RELEASE, "agent");
            asm volatile("s_waitcnt vmcnt(0)" ::: "memory");
            const unsigned og = xb_add(&bar[XB_TOP], 1u);
            const unsigned tg = og / nx;
            if (og + 1u == (tg + 1u) * nx) xb_add(&bar[XB_TOPGEN], 1u);
            else XB_SPIN(xb_ld(&bar[XB_TOPGEN]) == tg, bar);
            __builtin_amdgcn_fence(__ATOMIC_ACQUIRE, "agent");
            xb_add(&bar[XB_XGEN(b.x)], 1u);
            asm volatile("s_waitcnt vmcnt(0)" ::: "memory");
        } else {
            XB_SPIN(xb_ld(&bar[XB_XGEN(b.x)]) == gen, bar);
            __builtin_amdgcn_fence(__ATOMIC_ACQUIRE, "agent");
            asm volatile("s_waitcnt vmcnt(0)" ::: "memory");
        }
    }
    __syncthreads();
}

constexpr int NTHR = 512, NWAVES = 8;
constexpr int RING_BYTES = 131072, MISC_OFF = RING_BYTES + 320, LDS_BYTES = 147456;
constexpr int CW_BAR = 4096;
constexpr size_t CTL_ZERO_BYTES = 64 * 1024;
constexpr size_t WT_IN = WS_WT, WT_OUT = WT_IN + (size_t)2560 * 1024 * 2, WT_GU = WT_OUT + (size_t)1024 * 1024 * 2, WT_DOWN = WT_GU + (size_t)5632 * 1024 * 2,
                 WT_UQ = WT_DOWN + (size_t)1024 * 2816 * 2, WT_UKV = WT_UQ + (size_t)768 * 256 * 2, WT_CK = WT_UKV + (size_t)768 * 128 * 2, WT_CV = WT_CK + (size_t)64 * 2048 * 2,
                 WT_QM = WT_CV + (size_t)64 * 2048 * 2, WT_KM = WT_QM + 4 * 64 * 64 * 2, WT_END = WT_KM + 4 * 64 * 64 * 2;
static_assert(WT_END <= WS_HB, "weights");
constexpr int NPH = 22, PPL = 10;
constexpr int PROBE_SEL = 0;
constexpr int REP_MASK = 0;
#ifndef PHM
#define PHM 0xffff
#endif
struct MP { const float* in[N_IN]; float* out; unsigned char* ws; int ph_lo, ph_hi, coop, pad; };

struct MPK {
    const __attribute__((address_space(4))) MP* k;
    struct InArr { const __attribute__((address_space(4))) MP* k; __device__ __forceinline__ const float* operator[](int i) const { return k->in[i]; } };
    __device__ __forceinline__ InArr in_() const { return InArr{k}; }
};
#define PIN(i) (p.k->in[i])
__device__ __forceinline__ unsigned pk2(float lo, float hi) { return (unsigned)f2bf(lo) | ((unsigned)f2bf(hi) << 16); }
struct MapId { int n; __device__ __forceinline__ int operator()(int c) const { return c < n ? c : -1; } };
struct MapIn { __device__ __forceinline__ int operator()(int c) const {
    if (c < 1152) return c; if (c < 1280) return 1426 + (c - 1152); if (c < 1536) return 1170 + (c - 1280); if (c < 2304) return 1586 + (c - 1536);
    if (c < 2336) return 1554 + (c - 2304); if (c < 2354) return 1152 + (c - 2336); if (c < 2362) return c; return -1; } };
struct MapGU { __device__ __forceinline__ int operator()(int c) const { const int t = c >> 8, w = c & 255; return (w < 128) ? t * 128 + w : FF + t * 128 + (w - 128); } };
template <class Map> __device__ __forceinline__ void transpose_item(const float* W, int K, int ldw, const Map& map, const float* kscale, bf16* WT, LAS float* scr, int item, int nblk, int lane) {
    const int kb = item / nblk, nb = item % nblk, k0 = 64 * kb, n0 = 32 * nb;
    const int np = 2 * (lane & 15);
    const int sc = map(n0 + np);
#pragma unroll 8
    for (int i = 0; i < 16; ++i) { const int kk = 4 * i + (lane >> 4); float2 v = (sc >= 0) ? *(const float2*)(W + (size_t)(k0 + kk) * ldw + sc) : make_float2(0.f, 0.f);
        if (kscale) { const float ksc = kscale[k0 + kk]; v.x *= ksc; v.y *= ksc; } scr[kk * 33 + np] = v.x; scr[kk * 33 + np + 1] = v.y; }
    asm volatile("s_waitcnt lgkmcnt(0)" ::: "memory");
    const int c = lane & 7;
#pragma unroll
    for (int j = 0; j < 4; ++j) { const int n = (lane >> 3) + 8 * j; const LAS float* s = scr + (8 * c) * 33 + n;
        v4u o; o.x = pk2(s[0 * 33], s[1 * 33]); o.y = pk2(s[2 * 33], s[3 * 33]); o.z = pk2(s[4 * 33], s[5 * 33]); o.w = pk2(s[6 * 33], s[7 * 33]);
        *(v4u*)(WT + (size_t)(n0 + n) * K + k0 + 8 * c) = o; }
    asm volatile("s_waitcnt lgkmcnt(0)" ::: "memory");
}
__device__ __forceinline__ void norm_row_finish(const float4 (&v)[4], float ssq, const float* g, const float* shift, const float* scale, bf16* hb, float* outf, int mode, int m, int lane) {
    const float rstd = rsqrtf(ssq * (1.f / D_) + EPS);
    const int b = m / S_;
#pragma unroll
    for (int j = 0; j < 4; ++j) {
        const int col = 4 * lane + 256 * j;
        const float4 gg = *(const float4*)(g + col);
        float4 o; o.x = v[j].x * rstd * gg.x; o.y = v[j].y * rstd * gg.y; o.z = v[j].z * rstd * gg.z; o.w = v[j].w * rstd * gg.w;
        if (mode == 2) { *(float4*)(outf + (size_t)m * D_ + col) = o; }
        else {
            const float4 sc = *(const float4*)(scale + (size_t)b * 6144 + col), sh = *(const float4*)(shift + (size_t)b * 6144 + col);
            o.x = o.x * (1.f + sc.x) + sh.x; o.y = o.y * (1.f + sc.y) + sh.y; o.z = o.z * (1.f + sc.z) + sh.z; o.w = o.w * (1.f + sc.w) + sh.w;
            uint2 w; w.x = pk2(o.x, o.y); w.y = pk2(o.z, o.w);
            *(uint2*)(hb + (size_t)m * D_ + col) = w;
        }
    }
}
__device__ __forceinline__ void norm_rows(const float* x, const float* g, const float* shift, const float* scale, bf16* hb, float* outf, int mode, int gw, int ngw, int lane) {
    for (int m = gw; m < T_; m += 2 * ngw) {
        const int m2 = m + ngw;
        const float4* xr = (const float4*)(x + (size_t)m * D_) + lane; const float4* xr2 = (const float4*)(x + (size_t)m2 * D_) + lane;
        float4 v[4], w[4]; float s = 0.f, s2 = 0.f;
#pragma unroll
        for (int j = 0; j < 4; ++j) { v[j] = xr[64 * j]; w[j] = xr2[64 * j]; }
#pragma unroll
        for (int j = 0; j < 4; ++j) { s += v[j].x * v[j].x + v[j].y * v[j].y + v[j].z * v[j].z + v[j].w * v[j].w; s2 += w[j].x * w[j].x + w[j].y * w[j].y + w[j].z * w[j].z + w[j].w * w[j].w; }
        norm_row_finish(v, wave_sum2(s), g, shift, scale, hb, outf, mode, m, lane);
        norm_row_finish(w, wave_sum2(s2), g, shift, scale, hb, outf, mode, m2, lane);
    }
}
__device__ __forceinline__ void ph_p0(const MPK& p, LAS unsigned char* lds, int tid) {
    const int wave = tid >> 6, lane = tid & 63;
    LAS float* ca = (LAS float*)lds; LAS float* red = ca + 8192;
    unsigned char* ws = p.k->ws; float* mod = (float*)(ws + WS_MOD);
    const float* c = PIN(I_C);
    for (int i = tid; i < 8192; i += NTHR) ca[i] = siluf_(c[i]);
    __syncthreads();
    for (int item = blockIdx.x; item < 192; item += gridDim.x) {
        const int l = item / 96, j = (item % 96) * 64 + lane;
        const float* w = PIN(I_WADA) + (size_t)l * 1024 * 6144 + j;
        float acc[8];
#pragma unroll
        for (int b = 0; b < 8; ++b) acc[b] = 0.f;
#pragma unroll 4
        for (int k = wave * 128; k < wave * 128 + 128; ++k) {
            const float wv = w[(size_t)k * 6144];
#pragma unroll
            for (int b = 0; b < 8; ++b) acc[b] += ca[b * 1024 + k] * wv;
        }
#pragma unroll
        for (int b = 0; b < 8; ++b) red[(wave * 8 + b) * 64 + lane] = acc[b];
        __syncthreads();
        { const int b = wave; float s = 0.f;
#pragma unroll
          for (int w8 = 0; w8 < 8; ++w8) s += red[(w8 * 8 + b) * 64 + lane];
          mod[((size_t)l * 8 + b) * 6144 + j] = s + PIN(I_BADA)[l * 6144 + j]; }
        __syncthreads();
    }
    const int* pos = (const int*)PIN(I_POS);
    float *cosP = (float*)(ws + WS_COSP), *sinP = (float*)(ws + WS_SINP), *cosM = (float*)(ws + WS_COSM), *sinM = (float*)(ws + WS_SINM);
    for (int i = blockIdx.x * NTHR + tid; i < T_ * 24; i += gridDim.x * NTHR) {
        const int m = i / 24, f = i % 24;
        double inv; if (f < 8) inv = pow(500000.0, -(double)(2 * f) / 16.0); else inv = pow(500000.0, -(double)(2 * (f - 8)) / 32.0);
        const float ang = (float)pos[m] * (float)inv;
        const double a = (double)ang, kq = rint(a * 0.15915494309189535), r = a - kq * 6.283185307179586476925;
        const float cs = (float)cos(r), sn = (float)sin(r);
        if (f < 8) { cosP[m * 8 + f] = cs; sinP[m * 8 + f] = sn; } else { cosM[m * 16 + f - 8] = cs; sinM[m * 16 + f - 8] = sn; }
    }
}
__device__ __forceinline__ void early_transposes(const MPK& p, int l, LAS unsigned char* lds, int tid, int first) {
    const int wave = tid >> 6, lane = tid & 63;
    if ((int)blockIdx.x < first) return;
    const int gw = ((int)blockIdx.x - first) * NWAVES + wave, ngw = ((int)gridDim.x - first) * NWAVES;
    unsigned char* ws = p.k->ws;
    LAS float* scr = (LAS float*)(lds + wave * 8704);
    constexpr int I0 = 16 * 80, I4 = 4 * 24, I5 = 2 * 24, I6 = 32 * 2, I7 = 32 * 2, I8 = 8, I9 = 8;
    constexpr int NIT = I0 + I4 + I5 + I6 + I7 + I8 + I9;
    for (int it = gw; it < NIT; it += ngw) {
        int r = it;
        if (r < I0) { transpose_item(PIN(I_WIN) + (size_t)l * D_ * DIN, D_, DIN, MapIn{}, nullptr, (bf16*)(ws + WT_IN), scr, r, 80, lane); continue; } r -= I0;
        if (r < I4) { transpose_item(PIN(I_WUQ) + (size_t)l * 256 * 576, 256, 576, MapId{576}, PIN(I_GQL) + l * 256, (bf16*)(ws + WT_UQ), scr, r, 24, lane); continue; } r -= I4;
        if (r < I5) { transpose_item(PIN(I_WUKV) + (size_t)l * 128 * 768, 128, 768, MapId{768}, PIN(I_GKVL) + l * 128, (bf16*)(ws + WT_UKV), scr, r, 24, lane); continue; } r -= I5;
        if (r < I6) { transpose_item(PIN(I_WCK) + (size_t)l * 2048 * 64, 2048, 64, MapId{64}, nullptr, (bf16*)(ws + WT_CK), scr, r, 2, lane); continue; } r -= I6;
        if (r < I7) { transpose_item(PIN(I_WCV) + (size_t)l * 2048 * 64, 2048, 64, MapId{64}, nullptr, (bf16*)(ws + WT_CV), scr, r, 2, lane); continue; } r -= I7;
        if (r < I8) { const int h = r >> 1; transpose_item(PIN(I_WQM) + (size_t)l * 16384 + h * 4096, 64, 64, MapId{64}, nullptr, (bf16*)(ws + WT_QM) + h * 4096, scr, r & 1, 2, lane); continue; } r -= I8;
        { const int h = r >> 1; transpose_item(PIN(I_WKM) + (size_t)l * 16384 + h * 4096, 64, 64, MapId{64}, nullptr, (bf16*)(ws + WT_KM) + h * 4096, scr, r & 1, 2, lane); }
    }
}
__device__ __forceinline__ void ph_prep(const MPK& p, int l, LAS unsigned char* lds, int tid) {
    const int wave = tid >> 6, lane = tid & 63;
    const int gw = blockIdx.x * NWAVES + wave, ngw = gridDim.x * NWAVES;
    unsigned char* ws = p.k->ws;
    LAS float* scr = (LAS float*)(lds + wave * 8704);
    for (int i = blockIdx.x * NTHR + tid; i < 2 * T_; i += gridDim.x * NTHR) ((float*)(ws + WS_SSQL))[i] = 0.f;
    if (l == 0) early_transposes(p, l, lds, tid, 0);
    const float* xin = (l == 0) ? PIN(I_X) : p.k->out;
    const float* modl = (const float*)(ws + WS_MOD) + (size_t)l * 8 * 6144;
    norm_rows(xin, PIN(I_GN1) + l * D_, modl + 0, modl + 1024, (bf16*)(ws + WS_HB), nullptr, 0, gw, ngw, lane);
}
__device__ __forceinline__ void late_transposes(const MPK& p, int l, LAS unsigned char* lds, int tid, int first) {
    const int wave = tid >> 6, lane = tid & 63;
    if ((int)blockIdx.x < first) return;
    const int gw = ((int)blockIdx.x - first) * NWAVES + wave, ngw = ((int)gridDim.x - first) * NWAVES;
    unsigned char* ws = p.k->ws;
    LAS float* scr = (LAS float*)(lds + wave * 8704);
    constexpr int I1 = 16 * 32, I2 = 16 * 176, I3 = 44 * 32;
    for (int it = gw; it < I1 + I2 + I3; it += ngw) {
        int r = it;
        if (r < I1) { transpose_item(PIN(I_WOUT) + (size_t)l * D_ * D_, D_, D_, MapId{D_}, nullptr, (bf16*)(ws + WT_OUT), scr, r, 32, lane); continue; } r -= I1;
        if (r < I2) { transpose_item(PIN(I_WGU) + (size_t)l * D_ * 2 * FF, D_, 2 * FF, MapGU{}, nullptr, (bf16*)(ws + WT_GU), scr, r, 176, lane); continue; } r -= I2;
        transpose_item(PIN(I_WDOWN) + (size_t)l * FF * D_, FF, D_, MapId{D_}, nullptr, (bf16*)(ws + WT_DOWN), scr, r, 32, lane);
    }
}
__device__ __forceinline__ void ph_mixnorm(const MPK& p, int l, int tid) {
    const int gw = blockIdx.x * NWAVES + (tid >> 6), ngw = gridDim.x * NWAVES, lane = tid & 63;
    unsigned char* ws = p.k->ws;
    bf16* mix = (bf16*)(ws + WS_HB); const float* ga = PIN(I_GOA) + l * 384; const float* gb = PIN(I_GOB) + l * 384;
    const bf16 *oc = (const bf16*)(ws + WS_OCMP), *os = (const bf16*)(ws + WS_OSLC), *ow = (const bf16*)(ws + WS_OWIN); const float* gm = (const float*)(ws + WS_GM);
#define UNPK8(dst, src) dst[0] = __uint_as_float(src.x << 16); dst[1] = __uint_as_float(src.x & 0xffff0000u); dst[2] = __uint_as_float(src.y << 16); dst[3] = __uint_as_float(src.y & 0xffff0000u); \
    dst[4] = __uint_as_float(src.z << 16); dst[5] = __uint_as_float(src.z & 0xffff0000u); dst[6] = __uint_as_float(src.w << 16); dst[7] = __uint_as_float(src.w & 0xffff0000u);
    for (int m = gw; m < T_; m += ngw) {
        bf16* r = mix + (size_t)m * D_;
        float v0[8], v1[8]; float sa = 0.f, sb = 0.f;
        if (lane < 48) {
            const size_t o = (size_t)m * 384 + lane * 8; const float* g3 = gm + (size_t)m * 32 + 3 * (lane >> 3);
            const float g0 = g3[0], g1 = g3[1], g2 = g3[2];
            const v4u c4 = *(const v4u*)(oc + o), s4 = *(const v4u*)(os + o), w4 = *(const v4u*)(ow + o);
            float c8[8], s8[8], w8[8]; UNPK8(c8, c4) UNPK8(s8, s4) UNPK8(w8, w4)
#pragma unroll
            for (int i = 0; i < 8; ++i) { v0[i] = g0 * c8[i] + g1 * s8[i] + g2 * w8[i]; sa += v0[i] * v0[i]; }
        } else {
            const v4u y4 = *(const v4u*)(r + 384 + (lane - 48) * 8); UNPK8(v0, y4)
#pragma unroll
            for (int i = 0; i < 8; ++i) sb += v0[i] * v0[i];
        }
        if (lane < 32) { const v4u y4 = *(const v4u*)(r + 384 + (16 + lane) * 8); UNPK8(v1, y4)
#pragma unroll
            for (int i = 0; i < 8; ++i) sb += v1[i] * v1[i]; }
        const float ra = rsqrtf(wave_sum2(sa) * (1.f / 384.f) + EPS), rb = rsqrtf(wave_sum2(sb) * (1.f / 384.f) + EPS);
        {
            const int col = (lane < 48) ? lane * 8 : 384 + (lane - 48) * 8; const float* gg = (lane < 48) ? ga + lane * 8 : gb + (lane - 48) * 8; const float rr = (lane < 48) ? ra : rb;
            const float4 g0 = *(const float4*)gg, g1 = *(const float4*)(gg + 4);
            v4u w; w.x = pk2(v0[0] * rr * g0.x, v0[1] * rr * g0.y); w.y = pk2(v0[2] * rr * g0.z, v0[3] * rr * g0.w); w.z = pk2(v0[4] * rr * g1.x, v0[5] * rr * g1.y); w.w = pk2(v0[6] * rr * g1.z, v0[7] * rr * g1.w);
            *(v4u*)(r + col) = w;
        }
        if (lane < 32) { const float* gg = gb + (16 + lane) * 8; const float4 g0 = *(const float4*)gg, g1 = *(const float4*)(gg + 4);
            v4u w; w.x = pk2(v1[0] * rb * g0.x, v1[1] * rb * g0.y); w.y = pk2(v1[2] * rb * g0.z, v1[3] * rb * g0.w); w.z = pk2(v1[4] * rb * g1.x, v1[5] * rb * g1.y); w.w = pk2(v1[6] * rb * g1.z, v1[7] * rb * g1.w);
            *(v4u*)(r + 384 + (16 + lane) * 8) = w; }
    }
#undef UNPK8
}


typedef short bf16x8 __attribute__((ext_vector_type(8)));
typedef short s16x4 __attribute__((ext_vector_type(4)));
typedef float f32x16 __attribute__((ext_vector_type(16)));
typedef unsigned u32x2v __attribute__((ext_vector_type(2)));
constexpr int AT_BUF = 20480, AT_K32 = 8192, AT_V = 12288;
__device__ __forceinline__ unsigned cvtpk(float lo, float hi) { unsigned r; asm volatile("v_cvt_pk_bf16_f32 %0, %1, %2" : "=v"(r) : "v"(lo), "v"(hi)); return r; }
__device__ __forceinline__ float max3f(float a, float b, float c) { float r; asm("v_max3_f32 %0, %1, %2, %3" : "=v"(r) : "v"(a), "v"(b), "v"(c)); return r; }
__device__ __forceinline__ int crow(int r, int hi) { return (r & 3) + 8 * (r >> 2) + 4 * hi; }
__device__ __forceinline__ s16x4 vtr(LAS const unsigned char* p) { return __builtin_bit_cast(s16x4, __builtin_amdgcn_ds_read_tr16_b64_v4i16((LAS s16x4*)p)); }
enum { AM_CAUSAL = 0, AM_WINDOW = 1, AM_SLC = 2 };
struct AttnState { float m, l; f32x16 o[2]; f32x16 negm; bool started; long long twait; };
template <int NC> struct TileRegs { v4u k; v4u k2; v4u v; };
template <int NC> __device__ __forceinline__ void at_load(TileRegs<NC>& r, const bf16* Kg, int ldk, const bf16* Vg, int ldv, const bf16* K2g, int ldk2, int tile, int tid) {
    const int key = tid >> 3, c = tid & 7;
    r.k = *(const v4u*)(Kg + (size_t)(tile * 64 + key) * ldk + 8 * c);
    r.v = *(const v4u*)(Vg + (size_t)(tile * 64 + key) * ldv + 8 * c);
    if (NC == 6) { if (tid < 256) r.k2 = *(const v4u*)(K2g + (size_t)(tile * 64 + (tid >> 2)) * ldk2 + 8 * (tid & 3)); }
}
template <int NC> __device__ __forceinline__ void at_store(const TileRegs<NC>& r, LAS unsigned char* buf, int tid) {
    const int key = tid >> 3, c = tid & 7;
    *(LAS v4u*)(buf + key * 128 + 16 * (c ^ ((key >> 1) & 7))) = r.k;
    *(LAS v4u*)(buf + AT_V + (c >> 2) * 4096 + key * 64 + (c & 3) * 16) = r.v;
    if (NC == 6) { if (tid < 256) { const int k2 = tid >> 2, c2 = tid & 3; *(LAS v4u*)(buf + AT_K32 + k2 * 64 + 16 * (c2 ^ ((k2 >> 2) & 3))) = r.k2; } }
}
template <int NC> __device__ __forceinline__ void qk_tile(f32x16& p0, f32x16& p1, LAS const unsigned char* buf, const bf16x8 (&qf)[NC], const f32x16& negm, int lane) {
    const int r32 = lane & 31, hi = lane >> 5;
    p0 = negm; p1 = negm;
#pragma unroll
    for (int cc = 0; cc < NC; ++cc) {
        bf16x8 k0, k1;
        if (cc < 4) { const int k0r = r32, k1r = 32 + r32;
            k0 = *(LAS const bf16x8*)(buf + k0r * 128 + 16 * ((2 * cc + hi) ^ ((k0r >> 1) & 7)));
            k1 = *(LAS const bf16x8*)(buf + k1r * 128 + 16 * ((2 * cc + hi) ^ ((k1r >> 1) & 7))); }
        else { const int k0r = r32, k1r = 32 + r32, c2 = 2 * (cc - 4) + hi;
            k0 = *(LAS const bf16x8*)(buf + AT_K32 + k0r * 64 + 16 * (c2 ^ ((k0r >> 2) & 3)));
            k1 = *(LAS const bf16x8*)(buf + AT_K32 + k1r * 64 + 16 * (c2 ^ ((k1r >> 2) & 3))); }
        p0 = __builtin_amdgcn_mfma_f32_32x32x16_bf16(k0, qf[cc], p0, 0, 0, 0);
        p1 = __builtin_amdgcn_mfma_f32_32x32x16_bf16(k1, qf[cc], p1, 0, 0, 0);
    }
}
template <int MODE> __device__ __forceinline__ void mask_tile(f32x16& p0, f32x16& p1, int kpos0, int qpos, bool need_mask, bool sel_ok, int lane) {
    const int hi = lane >> 5;
    if (need_mask) {
        const int qw0m = __builtin_amdgcn_readfirstlane(qpos) & ~31;
        const bool diag = (kpos0 + 63 > qw0m), old = (MODE == AM_WINDOW) && (kpos0 < qw0m + 31 - 511);
        if (diag || old) {
            const float selterm = (MODE == AM_SLC && !sel_ok) ? -INFINITY : INFINITY;
            const int dbase = qpos - kpos0 - 4 * hi;
#pragma unroll
            for (int r = 0; r < 16; ++r) {
                const int d0 = dbase - ((r & 3) + 8 * (r >> 2)), d1 = d0 - 32;
                float l0 = ((float)d0 + 0.5f) * INFINITY, l1 = ((float)d1 + 0.5f) * INFINITY;
                if (MODE == AM_WINDOW) { l0 = fminf(l0, ((float)(511 - d0) + 0.5f) * INFINITY); l1 = fminf(l1, ((float)(511 - d1) + 0.5f) * INFINITY); }
                if (MODE == AM_SLC) { l0 = fminf(l0, selterm); l1 = fminf(l1, selterm); }
                p0[r] = fminf(p0[r], l0); p1[r] = fminf(p1[r], l1);
            }
        } else if (MODE == AM_SLC) {
            const float selterm = sel_ok ? INFINITY : -INFINITY;
#pragma unroll
            for (int r = 0; r < 16; ++r) { p0[r] = fminf(p0[r], selterm); p1[r] = fminf(p1[r], selterm); }
        }
    }
}
template <int MODE> __device__ __forceinline__ void softmax_tile(AttnState& st, f32x16& p0, f32x16& p1, bf16x8 (&pf)[4], int kpos0, int qpos, bool need_mask, bool sel_ok, int lane) {
    mask_tile<MODE>(p0, p1, kpos0, qpos, need_mask, sel_ok, lane);
    float mx = max3f(p0[0], p1[0], p0[1]), mx2 = max3f(p1[1], p0[2], p1[2]);
#pragma unroll
    for (int r = 3; r < 15; r += 2) { mx = max3f(mx, p0[r], p1[r]); mx2 = max3f(mx2, p0[r + 1], p1[r + 1]); }
    mx = max3f(mx, p0[15], p1[15]); mx = max3f(mx, mx2, mx2);
    mx = red32_max(mx);
    if (!st.started || __any(mx > 0.f)) {
        float dl = st.started ? fmaxf(mx, 0.f) : mx;
        dl = (dl > -1e30f) ? dl : 0.f;
        st.started = true;
        const float alpha = __builtin_amdgcn_exp2f(-dl);
        st.m += dl; st.l *= alpha;
#pragma unroll
        for (int r = 0; r < 16; ++r) { st.o[0][r] *= alpha; st.o[1][r] *= alpha; p0[r] -= dl; p1[r] -= dl; st.negm[r] = -st.m; }
    }
    float sum = 0.f;
#pragma unroll
    for (int r = 0; r < 16; ++r) { p0[r] = __builtin_amdgcn_exp2f(p0[r]); p1[r] = __builtin_amdgcn_exp2f(p1[r]); sum += p0[r] + p1[r]; }
    st.l += sum;
#pragma unroll
    for (int s2 = 0; s2 < 2; ++s2) {
        v4u a, b;
        a.x = cvtpk(p0[8 * s2 + 0], p0[8 * s2 + 1]); a.y = cvtpk(p0[8 * s2 + 2], p0[8 * s2 + 3]); a.z = cvtpk(p0[8 * s2 + 4], p0[8 * s2 + 5]); a.w = cvtpk(p0[8 * s2 + 6], p0[8 * s2 + 7]);
        b.x = cvtpk(p1[8 * s2 + 0], p1[8 * s2 + 1]); b.y = cvtpk(p1[8 * s2 + 2], p1[8 * s2 + 3]); b.z = cvtpk(p1[8 * s2 + 4], p1[8 * s2 + 5]); b.w = cvtpk(p1[8 * s2 + 6], p1[8 * s2 + 7]);
        pf[s2] = __builtin_bit_cast(bf16x8, a); pf[2 + s2] = __builtin_bit_cast(bf16x8, b);
    }
}
struct TileFlags { bool skip, need_mask, sel_ok; };
__device__ __forceinline__ void pack_p(bf16x8 (&pf)[4], const f32x16& p0, const f32x16& p1) {
#pragma unroll
    for (int s2 = 0; s2 < 2; ++s2) {
        v4u a, b;
        a.x = cvtpk(p0[8 * s2 + 0], p0[8 * s2 + 1]); a.y = cvtpk(p0[8 * s2 + 2], p0[8 * s2 + 3]); a.z = cvtpk(p0[8 * s2 + 4], p0[8 * s2 + 5]); a.w = cvtpk(p0[8 * s2 + 6], p0[8 * s2 + 7]);
        b.x = cvtpk(p1[8 * s2 + 0], p1[8 * s2 + 1]); b.y = cvtpk(p1[8 * s2 + 2], p1[8 * s2 + 3]); b.z = cvtpk(p1[8 * s2 + 4], p1[8 * s2 + 5]); b.w = cvtpk(p1[8 * s2 + 6], p1[8 * s2 + 7]);
        pf[s2] = __builtin_bit_cast(bf16x8, a); pf[2 + s2] = __builtin_bit_cast(bf16x8, b);
    }
}
template <int MODE> __device__ __forceinline__ void softmax_pair(AttnState& st, f32x16& a0, f32x16& a1, f32x16& b0, f32x16& b1, int kpos0, int qpos, const TileFlags& fa, const TileFlags& fb, int lane) {
    mask_tile<MODE>(a0, a1, kpos0, qpos, fa.need_mask, fa.sel_ok, lane);
    mask_tile<MODE>(b0, b1, kpos0 + 64, qpos, fb.need_mask, fb.sel_ok, lane);
    float mx = max3f(a0[0], a1[0], b0[0]), mx2 = max3f(b1[0], a0[1], a1[1]);
#pragma unroll
    for (int r = 1; r < 16; ++r) { mx = max3f(mx, b0[r], b1[r]); if (r > 1) mx2 = max3f(mx2, a0[r], a1[r]); }
    mx = max3f(mx, mx2, mx2);
    mx = red32_max(mx);
    if (!st.started || __any(mx > 0.f)) {
        float dl = st.started ? fmaxf(mx, 0.f) : mx;
        dl = (dl > -1e30f) ? dl : 0.f;
        st.started = true;
        const float alpha = __builtin_amdgcn_exp2f(-dl);
        st.m += dl; st.l *= alpha;
#pragma unroll
        for (int r = 0; r < 16; ++r) { st.o[0][r] *= alpha; st.o[1][r] *= alpha; a0[r] -= dl; a1[r] -= dl; b0[r] -= dl; b1[r] -= dl; st.negm[r] = -st.m; }
    }
    float sum = 0.f;
#pragma unroll
    for (int r = 0; r < 16; ++r) { a0[r] = __builtin_amdgcn_exp2f(a0[r]); a1[r] = __builtin_amdgcn_exp2f(a1[r]); b0[r] = __builtin_amdgcn_exp2f(b0[r]); b1[r] = __builtin_amdgcn_exp2f(b1[r]); sum += (a0[r] + a1[r]) + (b0[r] + b1[r]); }
    st.l += sum;
}
__device__ __forceinline__ void pv_tile(AttnState& st, LAS const unsigned char* buf, const bf16x8 (&pf)[4], int lane) {
    const int hi = lane >> 5;
    const unsigned vb = (unsigned)(uintptr_t)(buf + AT_V + (4 * hi + ((lane & 15) >> 2)) * 64 + ((lane >> 4) & 1) * 32 + (lane & 3) * 8);
#pragma unroll
    for (int dh = 0; dh < 2; ++dh) {
        s16x4 lo[4], hh[4];
#pragma unroll
        for (int s4 = 0; s4 < 4; ++s4) {
            asm volatile("ds_read_b64_tr_b16 %0, %1 offset:%c2" : "=&v"(lo[s4]) : "v"(vb), "i"(dh * 4096 + s4 * 1024) : "memory");
            asm volatile("ds_read_b64_tr_b16 %0, %1 offset:%c2" : "=&v"(hh[s4]) : "v"(vb), "i"(dh * 4096 + s4 * 1024 + 512) : "memory");
        }
        asm volatile("s_waitcnt lgkmcnt(0)" : "+v"(lo[0]), "+v"(lo[1]), "+v"(lo[2]), "+v"(lo[3]), "+v"(hh[0]), "+v"(hh[1]), "+v"(hh[2]), "+v"(hh[3]) :: "memory");
#pragma unroll
        for (int s4 = 0; s4 < 4; ++s4) {
            const bf16x8 vf = {lo[s4][0], lo[s4][1], lo[s4][2], lo[s4][3], hh[s4][0], hh[s4][1], hh[s4][2], hh[s4][3]};
            st.o[dh] = __builtin_amdgcn_mfma_f32_32x32x16_bf16(vf, pf[s4], st.o[dh], 0, 0, 0);
        }
    }
}
template <int MODE> __device__ __forceinline__ TileFlags tile_flags(int t, int qw0, unsigned selbits) {
    const int k0 = t * 64; TileFlags f;
    f.skip = k0 > qw0 + 31; f.need_mask = (k0 + 63 > qw0); f.sel_ok = true;
    if (MODE == AM_WINDOW) { f.skip = f.skip || (k0 + 63 < qw0 - 511); f.need_mask = f.need_mask || (k0 < qw0 + 31 - 511); }
    if (MODE == AM_SLC) { f.sel_ok = (selbits >> t) & 1u; const unsigned long long bal = __ballot(f.sel_ok); f.skip = f.skip || (bal == 0ull); f.need_mask = f.need_mask || (bal != ~0ull); }
    return f;
}
struct DmaOff { unsigned k, v, k2; };
template <int NC> __device__ __forceinline__ DmaOff at_dma_off(int ldk, int ldv, int ldk2, int wave, int lane) {
    const int L = wave * 64 + lane; DmaOff o;
    { const int key = L >> 3, c = (L & 7) ^ ((key >> 1) & 7); o.k = (unsigned)(key * ldk + 8 * c) * 2u; }
    { const int key = (L >> 2) & 63, c = (L >> 8) * 4 + (L & 3); o.v = (unsigned)(key * ldv + 8 * c) * 2u; }
    { const int key = (L >> 2) & 63, c2 = (L & 3) ^ ((key >> 2) & 3); o.k2 = (unsigned)(key * ldk2 + 8 * c2) * 2u; }
    return o;
}
template <int NC> __device__ __forceinline__ void at_dma(const DmaOff& o, const bf16* Kg, int ldk, const bf16* Vg, int ldv, const bf16* K2g, int ldk2, int tile, LAS unsigned char* slot, int wave) {
    __builtin_amdgcn_global_load_lds((const unsigned*)((const char*)(Kg + (size_t)tile * 64 * ldk) + o.k), (LAS unsigned*)(slot + wave * 1024), 16, 0, 0);
    __builtin_amdgcn_global_load_lds((const unsigned*)((const char*)(Vg + (size_t)tile * 64 * ldv) + o.v), (LAS unsigned*)(slot + AT_V + wave * 1024), 16, 0, 0);
    if (NC == 6) { if (wave < 4) __builtin_amdgcn_global_load_lds((const unsigned*)((const char*)(K2g + (size_t)tile * 64 * ldk2) + o.k2), (LAS unsigned*)(slot + AT_K32 + wave * 1024), 16, 0, 0); }
}
__device__ __forceinline__ void at_wait_bar(int keep) {
    if (keep == 0) asm volatile("s_waitcnt vmcnt(0) lgkmcnt(0)" ::: "memory");
    else if (keep == 4) asm volatile("s_waitcnt vmcnt(4) lgkmcnt(0)" ::: "memory");
    else asm volatile("s_waitcnt vmcnt(6) lgkmcnt(0)" ::: "memory");
    __builtin_amdgcn_s_barrier();
    asm volatile("" ::: "memory");
}
template <int NC, int MODE> __device__ __forceinline__ void at_stream(AttnState& st, LAS unsigned char* lds, const bf16* Kg, int ldk, const bf16* Vg, int ldv, const bf16* K2g, int ldk2, int t0, int t1,
                                                                       const bf16x8 (&qf)[NC], int qpos, int qw0, unsigned selbits, int tid) {
    const int lane = tid & 63, wave = __builtin_amdgcn_readfirstlane(tid >> 6), np = (t1 - t0) >> 1;
    const int nper2 = (NC == 6 && wave < 4) ? 6 : 4;
    const DmaOff dof = at_dma_off<NC>(ldk, ldv, ldk2, wave, lane);
    at_dma<NC>(dof, Kg, ldk, Vg, ldv, K2g, ldk2, t0, lds, wave); at_dma<NC>(dof, Kg, ldk, Vg, ldv, K2g, ldk2, t0 + 1, lds + AT_BUF, wave);
    if (np > 1) { at_dma<NC>(dof, Kg, ldk, Vg, ldv, K2g, ldk2, t0 + 2, lds + 2 * AT_BUF, wave); at_dma<NC>(dof, Kg, ldk, Vg, ldv, K2g, ldk2, t0 + 3, lds + 3 * AT_BUF, wave); }
    at_wait_bar(np > 1 ? nper2 : 0);
    int s0 = 0, s1 = 2 * AT_BUF, s2 = 4 * AT_BUF;
    for (int j = 0; j < np; ++j) {
        const int t = t0 + 2 * j; const bool has_2 = (j + 2 < np);
        if (has_2) { at_dma<NC>(dof, Kg, ldk, Vg, ldv, K2g, ldk2, t + 4, lds + s2, wave); at_dma<NC>(dof, Kg, ldk, Vg, ldv, K2g, ldk2, t + 5, lds + s2 + AT_BUF, wave); }
        const TileFlags fa = tile_flags<MODE>(t, qw0, selbits), fb = tile_flags<MODE>(t + 1, qw0, selbits);
        if (!fa.skip && !fb.skip) {
            f32x16 a0, a1, b0, b1; bf16x8 pf[4];
            qk_tile<NC>(a0, a1, lds + s0, qf, st.negm, lane);
            qk_tile<NC>(b0, b1, lds + s0 + AT_BUF, qf, st.negm, lane);
            softmax_pair<MODE>(st, a0, a1, b0, b1, t * 64, qpos, fa, fb, lane);
            pack_p(pf, a0, a1); pv_tile(st, lds + s0, pf, lane);
            pack_p(pf, b0, b1); pv_tile(st, lds + s0 + AT_BUF, pf, lane);
        } else {
            if (!fa.skip) { f32x16 p0, p1; bf16x8 pf[4]; qk_tile<NC>(p0, p1, lds + s0, qf, st.negm, lane); softmax_tile<MODE>(st, p0, p1, pf, t * 64, qpos, fa.need_mask, fa.sel_ok, lane); pv_tile(st, lds + s0, pf, lane); }
            if (!fb.skip) { f32x16 p0, p1; bf16x8 pf[4]; qk_tile<NC>(p0, p1, lds + s0 + AT_BUF, qf, st.negm, lane); softmax_tile<MODE>(st, p0, p1, pf, (t + 1) * 64, qpos, fb.need_mask, fb.sel_ok, lane); pv_tile(st, lds + s0 + AT_BUF, pf, lane); }
        }
        at_wait_bar(has_2 ? nper2 : 0);
        const int tmp = s0; s0 = s1; s1 = s2; s2 = tmp;
    }
}
__device__ __forceinline__ int next_item_q(unsigned* ctrs, LAS unsigned char* lds, int wave_u, int count, int q0, int& kstart) {
    const int tid = wave_u * 64 + fresh_lane();
    LAS int* slot = (LAS int*)(lds + RING_BYTES + 64);
    if (tid == 0) {
        int r = -1, k = kstart;
        for (; k < 8; ++k) { const int q = (q0 + k) & 7; const unsigned v = atomicAdd(ctrs + q * 16, 1u); if (v < (unsigned)count) { r = (q << 16) | (int)v; break; } }
        slot[0] = r; slot[1] = k;
    }
    __syncthreads();
    const int v = slot[0]; kstart = slot[1];
    __syncthreads();
    return v;
}
__device__ __forceinline__ void mla_unit(unsigned char* ws, LAS unsigned char* lds, int b, int h, int qt, int wave_u) {
    const int tid = wave_u * 64 + fresh_lane();
    const int lane = tid & 63, wave = tid >> 6, r32 = lane & 31, hi = lane >> 5;
    const int qw0 = qt * 256 + wave * 32, qpos = qw0 + r32; const size_t row = (size_t)b * S_ + qpos;
    const long long tq0 = (PROBE_SEL != 0) ? (long long)__builtin_amdgcn_s_memtime() : 0ll;
    bf16x8 qf[6];
    {
        const bf16* qp = (const bf16*)(ws + WS_OSLC) + row * 768 + h * 96 + 8 * hi;
        v4u raw[6];
#pragma unroll
        for (int cc = 0; cc < 6; ++cc) raw[cc] = *(const v4u*)(qp + 16 * cc);
        float msc = MSCALE; asm volatile("" : "+v"(msc));
        const float rs = rsqrtf(((const float*)(ws + WS_SSQL))[row] * (1.f / 256.f) + EPS) * msc;
        const float* cm_ = (const float*)(ws + WS_COSM) + row * 16 + 8 * hi; const float* sm_ = (const float*)(ws + WS_SINM) + row * 16 + 8 * hi;
#define UNPKQ(dst, src) dst[0] = __uint_as_float(src.x << 16); dst[1] = __uint_as_float(src.x & 0xffff0000u); dst[2] = __uint_as_float(src.y << 16); dst[3] = __uint_as_float(src.y & 0xffff0000u); \
        dst[4] = __uint_as_float(src.z << 16); dst[5] = __uint_as_float(src.z & 0xffff0000u); dst[6] = __uint_as_float(src.w << 16); dst[7] = __uint_as_float(src.w & 0xffff0000u);
#pragma unroll
        for (int cc = 0; cc < 4; ++cc) { float f[8]; UNPKQ(f, raw[cc])
            v4u w; w.x = cvtpk(f[0] * rs, f[1] * rs); w.y = cvtpk(f[2] * rs, f[3] * rs); w.z = cvtpk(f[4] * rs, f[5] * rs); w.w = cvtpk(f[6] * rs, f[7] * rs); qf[cc] = __builtin_bit_cast(bf16x8, w); }
        { float x1[8], x2[8], o1[8], o2[8]; UNPKQ(x1, raw[4]) UNPKQ(x2, raw[5])
#pragma unroll
          for (int j = 0; j < 8; ++j) { const float cs = cm_[j] * rs, sn = sm_[j] * rs; o1[j] = x1[j] * cs - x2[j] * sn; o2[j] = x1[j] * sn + x2[j] * cs; }
          v4u w; w.x = cvtpk(o1[0], o1[1]); w.y = cvtpk(o1[2], o1[3]); w.z = cvtpk(o1[4], o1[5]); w.w = cvtpk(o1[6], o1[7]); qf[4] = __builtin_bit_cast(bf16x8, w);
          w.x = cvtpk(o2[0], o2[1]); w.y = cvtpk(o2[2], o2[3]); w.z = cvtpk(o2[4], o2[5]); w.w = cvtpk(o2[6], o2[7]); qf[5] = __builtin_bit_cast(bf16x8, w); }
#undef UNPKQ
    }
    const long long tq1 = (PROBE_SEL != 0) ? (long long)__builtin_amdgcn_s_memtime() : 0ll;
    AttnState st; st.m = 0.f; st.l = 0.f; st.o[0] = f32x16{}; st.o[1] = f32x16{}; st.negm = f32x16{}; st.started = false; st.twait = 0;
    const bf16* kvb = (const bf16*)(ws + WS_KVM) + (size_t)b * S_ * 768 + h * 128;
    at_stream<6, AM_CAUSAL>(st, lds, kvb, 768, kvb + 64, 768, (const bf16*)(ws + WS_KR) + (size_t)b * S_ * 32, 32, 0, 4 * qt + 4, qf, qpos, qw0, 0u, tid);
    if (PROBE_SEL >= 1 && PROBE_SEL <= 3 && b == 0 && h == 0 && qt == 7 && tid == 0) { const long long tq2 = (long long)__builtin_amdgcn_s_memtime();
        ((float*)(ws + WS_CTL))[100] = (PROBE_SEL == 1) ? (float)(tq2 - tq1) : (PROBE_SEL == 2) ? (float)st.twait : (float)(tq1 - tq0); }
    const float lt = red32_sum(st.l), il = 1.f / lt;
    bf16* op = (bf16*)(ws + WS_HB) + row * D_ + 384 + h * 64 + 4 * hi;
#pragma unroll
    for (int dh = 0; dh < 2; ++dh)
#pragma unroll
        for (int g4 = 0; g4 < 4; ++g4) { u32x2v w; w.x = cvtpk(st.o[dh][4 * g4] * il, st.o[dh][4 * g4 + 1] * il); w.y = cvtpk(st.o[dh][4 * g4 + 2] * il, st.o[dh][4 * g4 + 3] * il);
            *(u32x2v*)(op + dh * 32 + 8 * g4) = w; }
}
template <int MODE> __device__ __forceinline__ void nsa_branch_unit(unsigned char* ws, LAS unsigned char* lds, int b, int h, int qt, int wave_u) {
    const int tid = wave_u * 64 + fresh_lane();
    const int lane = tid & 63, wave = tid >> 6, r32 = lane & 31, hi = lane >> 5, g = h / 3;
    const int qw0 = qt * 256 + wave * 32, qpos = qw0 + r32; const size_t row = (size_t)b * S_ + qpos;
    const bf16* nsa = (const bf16*)(ws + WS_NSA);
    const bf16* qp = nsa + row * 1152 + h * 64 + 8 * hi;
    bf16x8 qf[4];
#pragma unroll
    for (int cc = 0; cc < 4; ++cc) qf[cc] = *(const bf16x8*)(qp + 16 * cc);
    unsigned selbits = 0u; if (MODE == AM_SLC) selbits = ((const unsigned*)(ws + WS_SEL))[(size_t)(b * 2 + g) * S_ + qpos];
    const bf16* kb = nsa + (size_t)b * S_ * 1152 + g * 64 + (MODE == AM_SLC ? 640 : 896);
    AttnState st; st.m = 0.f; st.l = 0.f; st.o[0] = f32x16{}; st.o[1] = f32x16{}; st.negm = f32x16{}; st.started = false; st.twait = 0;
    const long long tn0 = (PROBE_SEL != 0) ? (long long)__builtin_amdgcn_s_memtime() : 0ll;
    const int t0 = (MODE == AM_SLC) ? 0 : ((4 * qt - 8 > 0) ? 4 * qt - 8 : 0);
    at_stream<4, MODE>(st, lds, kb, 1152, kb + 128, 1152, nullptr, 0, t0, 4 * qt + 4, qf, qpos, qw0, selbits, tid);
    if (PROBE_SEL >= 4 && PROBE_SEL <= 5 && MODE == AM_SLC && b == 0 && h == 0 && qt == 7 && tid == 0) { const long long tn1 = (long long)__builtin_amdgcn_s_memtime();
        ((float*)(ws + WS_CTL))[100] = (PROBE_SEL == 4) ? (float)(tn1 - tn0) : (float)st.twait; }
    const float lt = red32_sum(st.l), il = 1.f / lt;
    bf16* op = (bf16*)(ws + (MODE == AM_SLC ? WS_OSLC : WS_OWIN)) + row * 384 + h * 64 + 4 * hi;
#pragma unroll
    for (int dh = 0; dh < 2; ++dh)
#pragma unroll
        for (int g4 = 0; g4 < 4; ++g4) { u32x2v w; w.x = cvtpk(st.o[dh][4 * g4] * il, st.o[dh][4 * g4 + 1] * il); w.y = cvtpk(st.o[dh][4 * g4 + 2] * il, st.o[dh][4 * g4 + 3] * il);
            *(u32x2v*)(op + dh * 32 + 8 * g4) = w; }
}
__device__ __forceinline__ void cmp_unit(unsigned char* ws, LAS unsigned char* lds, int b, int g, int qt, int wave_u) {
    const int tid = wave_u * 64 + fresh_lane();
    const int lane = tid & 63, wave = tid >> 6, r32 = lane & 31, hi = lane >> 5;
    const int qpos = qt * 256 + wave * 32 + r32; const size_t row = (size_t)b * S_ + qpos;
    const bf16* kc = (const bf16*)(ws + WS_KCV) + (size_t)(b * 2 + g) * 128 * 64; const bf16* vc = kc + (size_t)8 * 2 * 128 * 64;
    { TileRegs<4> tr; at_load<4>(tr, kc, 64, vc, 64, nullptr, 0, 0, tid); at_store<4>(tr, lds, tid); at_load<4>(tr, kc, 64, vc, 64, nullptr, 0, 1, tid); at_store<4>(tr, lds + AT_BUF, tid); }
    __syncthreads();
    int nvis = (qpos >= 31) ? ((qpos - 31) >> 4) + 1 : 0; if (nvis > 127) nvis = 127;
    LAS float* IG = (LAS float*)(lds + 2 * AT_BUF) + wave * (32 * 33) + r32 * 33;
    LAS float* IL = IG + 8 * 32 * 33;
    const bf16* nsa = (const bf16*)(ws + WS_NSA);
    LAS const unsigned char* vb = lds + AT_V + (4 * hi + ((lane & 15) >> 2)) * 64 + ((lane >> 4) & 1) * 32 + (lane & 3) * 8;
    for (int r3 = 0; r3 < 3; ++r3) {
        const int h = 3 * g + r3;
        const bf16* qp = nsa + row * 1152 + h * 64 + 8 * hi;
        bf16x8 qf[4];
#pragma unroll
        for (int cc = 0; cc < 4; ++cc) qf[cc] = *(const bf16x8*)(qp + 16 * cc);
        f32x16 p[4];
#pragma unroll
        for (int tb = 0; tb < 4; ++tb) {
            LAS const unsigned char* buf = lds + (tb >> 1) * AT_BUF; const int kr = (tb & 1) * 32 + r32;
            p[tb] = f32x16{};
#pragma unroll
            for (int cc = 0; cc < 4; ++cc) { const bf16x8 kf = *(LAS const bf16x8*)(buf + kr * 128 + 16 * ((2 * cc + hi) ^ ((kr >> 1) & 7)));
                p[tb] = __builtin_amdgcn_mfma_f32_32x32x16_bf16(kf, qf[cc], p[tb], 0, 0, 0); }
        }
        float mx = -1e30f;
#pragma unroll
        for (int tb = 0; tb < 4; ++tb)
#pragma unroll
            for (int r = 0; r < 16; ++r) { const int n = 32 * tb + crow(r, hi); p[tb][r] = fminf(p[tb][r], ((float)(nvis - n) - 0.5f) * INFINITY); mx = fmaxf(mx, p[tb][r]); }
        mx = red32_max(mx);
        float sum = 0.f;
#pragma unroll
        for (int tb = 0; tb < 4; ++tb)
#pragma unroll
            for (int r = 0; r < 16; ++r) { p[tb][r] = __builtin_amdgcn_exp2f(p[tb][r] - mx); sum += p[tb][r]; }
        sum = red32_sum(sum);
        const float il = (nvis > 0) ? 1.f / sum : 0.f;
#pragma unroll
        for (int tb = 0; tb < 4; ++tb)
#pragma unroll
            for (int k = 0; k < 4; ++k) { const float a0 = p[tb][4 * k] * il, a1 = p[tb][4 * k + 1] * il, a2 = p[tb][4 * k + 2] * il, a3 = p[tb][4 * k + 3] * il;
                const int j = 2 * (4 * tb + k) + hi;
                const float gs = (a0 + a1) + (a2 + a3);
                if (r3 == 0) { IG[j] = gs; IL[j + 1] = a3; } else { IG[j] += gs; IL[j + 1] += a3; } }
        f32x16 o[2] = {f32x16{}, f32x16{}};
#pragma unroll
        for (int tb = 0; tb < 4; ++tb)
#pragma unroll
            for (int s2 = 0; s2 < 2; ++s2) {
                v4u a; a.x = cvtpk(p[tb][8 * s2 + 0], p[tb][8 * s2 + 1]); a.y = cvtpk(p[tb][8 * s2 + 2], p[tb][8 * s2 + 3]); a.z = cvtpk(p[tb][8 * s2 + 4], p[tb][8 * s2 + 5]); a.w = cvtpk(p[tb][8 * s2 + 6], p[tb][8 * s2 + 7]);
                const bf16x8 pf = __builtin_bit_cast(bf16x8, a);
                LAS const unsigned char* vbb = vb + (tb >> 1) * AT_BUF + ((tb & 1) * 2 + s2) * 1024;
#pragma unroll
                for (int dh = 0; dh < 2; ++dh) { const s16x4 lo = vtr(vbb + dh * 4096), hh = vtr(vbb + dh * 4096 + 512);
                    const bf16x8 vf = {lo[0], lo[1], lo[2], lo[3], hh[0], hh[1], hh[2], hh[3]};
                    o[dh] = __builtin_amdgcn_mfma_f32_32x32x16_bf16(vf, pf, o[dh], 0, 0, 0); }
                asm volatile("" ::: "memory");
            }
        bf16* op = (bf16*)(ws + WS_OCMP) + row * 384 + h * 64 + 4 * hi;
#pragma unroll
        for (int dh = 0; dh < 2; ++dh)
#pragma unroll
            for (int g4 = 0; g4 < 4; ++g4) { u32x2v w; w.x = cvtpk(o[dh][4 * g4] * il, o[dh][4 * g4 + 1] * il); w.y = cvtpk(o[dh][4 * g4 + 2] * il, o[dh][4 * g4 + 3] * il);
                *(u32x2v*)(op + dh * 32 + 8 * g4) = w; }
    }
    const int cur = qpos >> 6;
    LAS float* imp = IG;
#pragma unroll 1
    for (int jj = 0; jj < 16; ++jj) {
        const int j = 16 * hi + jj;
        float v = IG[j] + (j > 0 ? IL[j] : 0.f);
        if (j == 0 || j == cur || j == cur - 1) v = INFINITY;
        if (j * 64 > qpos) v = -INFINITY;
        IL[j] = v;
    }
#pragma unroll 1
    for (int jj = 0; jj < 16; ++jj) { const int j = 16 * hi + jj; imp[j] = IL[j]; }
    unsigned mask = 0;
#pragma unroll 1
    for (int jj = 0; jj < 16; ++jj) {
        const int j = 16 * hi + jj; const float v = imp[j]; int rank = 0;
#pragma unroll 4
        for (int k = 0; k < 32; ++k) { const float u2 = imp[k]; rank += (u2 > v || (u2 == v && k < j)) ? 1 : 0; }
        if (rank < 16) mask |= 1u << j;
    }
    mask = red32_or(mask);
    if (hi == 0) ((unsigned*)(ws + WS_SEL))[(size_t)(b * 2 + g) * S_ + qpos] = mask;
    __syncthreads();
}
__device__ __forceinline__ void lora_rows(unsigned char* ws, int tid) {
    const int gw = blockIdx.x * NWAVES + (tid >> 6), ngw = gridDim.x * NWAVES, lane = tid & 63;
    bf16* kvl = (bf16*)(ws + WS_KVL); const bf16* ql = (const bf16*)(ws + WS_QL); float* ssql = (float*)(ws + WS_SSQL);
    for (int m = gw; m < T_; m += ngw) {
        const unsigned kv = *(const unsigned*)(kvl + (size_t)m * 128 + 2 * lane);
        const float k0 = __uint_as_float(kv << 16), k1 = __uint_as_float(kv & 0xffff0000u);
        const uint2 qv = *(const uint2*)(ql + (size_t)m * 256 + 4 * lane);
        const float q0 = __uint_as_float(qv.x << 16), q1 = __uint_as_float(qv.x & 0xffff0000u), q2 = __uint_as_float(qv.y << 16), q3 = __uint_as_float(qv.y & 0xffff0000u);
        const float sk = wave_sum2(k0 * k0 + k1 * k1), sq = wave_sum2((q0 * q0 + q1 * q1) + (q2 * q2 + q3 * q3));
        const float rk = rsqrtf(sk * (1.f / 128.f) + EPS);
        *(unsigned*)(kvl + (size_t)m * 128 + 2 * lane) = pk2(k0 * rk, k1 * rk);
        if (lane == 0) ssql[m] = sq;
    }
}
__device__ __forceinline__ void post_misc(unsigned char* ws, const float* big, const float* bfg, int tid) {
    const float* mr = (const float*)(ws + WS_MISCRAW); const float* cosM = (const float*)(ws + WS_COSM); const float* sinM = (const float*)(ws + WS_SINM);
    bf16* kr = (bf16*)(ws + WS_KR); float* gm = (float*)(ws + WS_GM);
    for (int idx = blockIdx.x * NTHR + tid; idx < T_ * 64; idx += gridDim.x * NTHR) {
        const int row = idx >> 6, c = idx & 63; const float* r = mr + (size_t)row * 64; const float v = r[c];
        if (c < 32) { const int i = c & 15; const float x1 = r[i], x2 = r[16 + i], cs = cosM[row * 16 + i], sn = sinM[row * 16 + i];
            kr[(size_t)row * 32 + c] = f2bf((c < 16) ? x1 * cs - x2 * sn : x1 * sn + x2 * cs); }
        else if (c < 50) gm[(size_t)row * 32 + (c - 32)] = 1.f / (1.f + __expf(-v));
        else if (c < 54) gm[(size_t)row * 32 + 18 + (c - 50)] = v + big[c - 50];
        else if (c < 58) { const float z = v + bfg[c - 54]; gm[(size_t)row * 32 + 22 + (c - 54)] = fminf(z, 0.f) - __logf(1.f + __expf(-fabsf(z))); }
    }
}

typedef float f32x4v __attribute__((ext_vector_type(4)));
__device__ __forceinline__ void compress_item(unsigned char* ws, LAS unsigned char* lds, const float* cmp_pos, int item, int wave_u) {
    const int lane = fresh_lane(), tid = wave_u * 64 + lane;
    const int nb = item & 7, g = (item >> 3) & 1, b = (item >> 4) & 7, kv = item >> 7;
    const bf16* tok = (const bf16*)(ws + WS_NSA) + (size_t)b * S_ * 1152 + (kv ? 512 : 384) + g * 64;
    const bf16* wt = (const bf16*)(ws + (kv ? WT_CV : WT_CK));
    const int nrow = nb * 16 + (lane & 15), kq = lane >> 4;
    f32x4v acc[4] = {f32x4v{}, f32x4v{}, f32x4v{}, f32x4v{}};
#pragma unroll 4
    for (int ks = 0; ks < 8; ++ks) {
        const int k = wave_u * 256 + ks * 32 + kq * 8, l = k >> 6, d = k & 63;
        int trow = 16 * nrow + l; trow = trow < S_ ? trow : S_ - 1;
        const v4u t4 = *(const v4u*)(tok + (size_t)trow * 1152 + d);
        const f32x4v p0 = *(const f32x4v*)(cmp_pos + k), p1 = *(const f32x4v*)(cmp_pos + k + 4);
        v4u a4;
        a4.x = cvtpk(__uint_as_float(t4.x << 16) + p0[0], __uint_as_float(t4.x & 0xffff0000u) + p0[1]); a4.y = cvtpk(__uint_as_float(t4.y << 16) + p0[2], __uint_as_float(t4.y & 0xffff0000u) + p0[3]);
        a4.z = cvtpk(__uint_as_float(t4.z << 16) + p1[0], __uint_as_float(t4.z & 0xffff0000u) + p1[1]); a4.w = cvtpk(__uint_as_float(t4.w << 16) + p1[2], __uint_as_float(t4.w & 0xffff0000u) + p1[3]);
        const bf16x8 af = __builtin_bit_cast(bf16x8, a4);
#pragma unroll
        for (int cb = 0; cb < 4; ++cb) { const bf16x8 bfr = *(const bf16x8*)(wt + (size_t)(cb * 16 + (lane & 15)) * 2048 + k);
            acc[cb] = __builtin_amdgcn_mfma_f32_16x16x32_bf16(af, bfr, acc[cb], 0, 0, 0); }
    }
    LAS float* red = (LAS float*)lds + wave_u * 1024;
#pragma unroll
    for (int cb = 0; cb < 4; ++cb)
#pragma unroll
        for (int r = 0; r < 4; ++r) red[(4 * (lane >> 4) + r) * 64 + cb * 16 + (lane & 15)] = acc[cb][r];
    __syncthreads();
    bf16* out = (bf16*)(ws + WS_KCV) + (size_t)kv * (8 * 2 * 128 * 64) + ((size_t)(b * 2 + g) * 128 + nb * 16) * 64;
    for (int o = tid; o < 1024; o += NTHR) { float sum = 0.f;
#pragma unroll
        for (int w8 = 0; w8 < 8; ++w8) sum += ((LAS float*)lds)[w8 * 1024 + o];
        out[o] = f2bf(sum); }
    __syncthreads();
}
__device__ __forceinline__ f32x4v mm16(const LAS bf16* A, int lda, int arow0, const LAS bf16* Bt, int ldb, int bcol0, int K, int lane, f32x4v acc) {
    const LAS bf16* ap = A + (arow0 + (lane & 15)) * lda + 8 * (lane >> 4); const LAS bf16* bp = Bt + (bcol0 + (lane & 15)) * ldb + 8 * (lane >> 4);
    for (int k = 0; k < K; k += 32) acc = __builtin_amdgcn_mfma_f32_16x16x32_bf16(*(const LAS bf16x8*)(ap + k), *(const LAS bf16x8*)(bp + k), acc, 0, 0, 0);
    return acc;
}
constexpr int ML_LD = 72;
__device__ __forceinline__ void mlocal_item(unsigned char* ws, LAS unsigned char* lds, const float* convw, const float* convb, const float* big, const float* bfg, int chunk, int wave_u) {
    const int lane = fresh_lane(), tid = wave_u * 64 + lane;
    const int c = chunk & 31, h = (chunk >> 5) & 3, b = chunk >> 7, row0 = b * S_ + c * 64;
    LAS bf16* XS = (LAS bf16*)lds;
    LAS bf16* WQ = XS + 64 * ML_LD;
    LAS bf16* WK = WQ + 64 * ML_LD;
    LAS bf16* VT = WK + 64 * ML_LD;
    LAS bf16* WKT = VT + 64 * ML_LD;
    LAS float* wl = (LAS float*)(WKT + 64 * ML_LD);
    const bf16* cm = (const bf16*)(ws + WS_CM);
    {
        const int l = tid >> 3, ch0 = (tid & 7) * 8, row = row0 + l, s = c * 64 + l;
        float a[8];
#pragma unroll
        for (int i = 0; i < 8; ++i) a[i] = convb[h * 64 + ch0 + i];
#pragma unroll
        for (int j = 0; j < 4; ++j) { if (s - 3 + j >= 0) { const v4u x4 = *(const v4u*)(cm + (size_t)(row - 3 + j) * 768 + h * 64 + ch0);
            const float* cw = convw + j * 256 + h * 64 + ch0;
            a[0] += cw[0] * __uint_as_float(x4.x << 16); a[1] += cw[1] * __uint_as_float(x4.x & 0xffff0000u); a[2] += cw[2] * __uint_as_float(x4.y << 16); a[3] += cw[3] * __uint_as_float(x4.y & 0xffff0000u);
            a[4] += cw[4] * __uint_as_float(x4.z << 16); a[5] += cw[5] * __uint_as_float(x4.z & 0xffff0000u); a[6] += cw[6] * __uint_as_float(x4.w << 16); a[7] += cw[7] * __uint_as_float(x4.w & 0xffff0000u); } }
        v4u o4; float r[8];
#pragma unroll
        for (int i = 0; i < 8; ++i) r[i] = a[i] / (1.f + __expf(-a[i]));
        o4.x = cvtpk(r[0], r[1]); o4.y = cvtpk(r[2], r[3]); o4.z = cvtpk(r[4], r[5]); o4.w = cvtpk(r[6], r[7]);
        *(v4u*)((bf16*)(ws + WS_XC) + (size_t)row * 256 + h * 64 + ch0) = o4;
        *(LAS v4u*)(XS + l * ML_LD + ch0) = o4;
        const v4u v4 = *(const v4u*)(cm + (size_t)row * 768 + 256 + h * 64 + ch0);
        VT[(ch0 + 0) * ML_LD + l] = (bf16)(v4.x & 0xffffu); VT[(ch0 + 1) * ML_LD + l] = (bf16)(v4.x >> 16); VT[(ch0 + 2) * ML_LD + l] = (bf16)(v4.y & 0xffffu); VT[(ch0 + 3) * ML_LD + l] = (bf16)(v4.y >> 16);
        VT[(ch0 + 4) * ML_LD + l] = (bf16)(v4.z & 0xffffu); VT[(ch0 + 5) * ML_LD + l] = (bf16)(v4.z >> 16); VT[(ch0 + 6) * ML_LD + l] = (bf16)(v4.w & 0xffffu); VT[(ch0 + 7) * ML_LD + l] = (bf16)(v4.w >> 16);
        const int e = tid >> 3, d0 = (tid & 7) * 8;
        *(LAS v4u*)(WQ + e * ML_LD + d0) = *(const v4u*)((const bf16*)(ws + WT_QM) + h * 4096 + e * 64 + d0);
        *(LAS v4u*)(WK + e * ML_LD + d0) = *(const v4u*)((const bf16*)(ws + WT_KM) + h * 4096 + e * 64 + d0);
    }
    if (wave_u == 0) {
        const float* mr = (const float*)(ws + WS_MISCRAW) + (size_t)(row0 + lane) * 64;
        const float z = mr[54 + h] + bfg[h]; float lf = fminf(z, 0.f) - __logf(1.f + __expf(-fabsf(z)));
        const float ig = mr[50 + h] + big[h];
#pragma unroll
        for (int o = 1; o < 64; o <<= 1) { const float t = bperm(lf, lane - o); if (lane >= o) lf += t; }
        const float bL = __int_as_float(__builtin_amdgcn_readlane(__float_as_int(lf), 63));
        const float a = bL - lf + ig; const float mx = wave_max2(a);
        wl[lane] = __expf(a - mx);
        if (lane == 0) { ((float*)(ws + WS_ML))[chunk] = mx; ((float*)(ws + WS_BL))[chunk] = bL; }
    }
    __syncthreads();
    {
        const int lb = wave_u & 3; const bool isk = wave_u >= 4;
        const LAS bf16* Wt = isk ? WK : WQ;
        bf16* og = (bf16*)(ws + (isk ? WS_MK : WS_MQ)) + (size_t)(row0 + 16 * lb + 4 * (lane >> 4)) * 256 + h * 64 + (lane & 15);
        float w4[4];
#pragma unroll
        for (int r = 0; r < 4; ++r) w4[r] = wl[16 * lb + 4 * (lane >> 4) + r];
#pragma unroll
        for (int eb = 0; eb < 4; ++eb) {
            f32x4v acc = mm16(XS, ML_LD, 16 * lb, Wt, ML_LD, 16 * eb, 64, lane, f32x4v{});
            if (!isk) {
#pragma unroll
                for (int r = 0; r < 4; ++r) og[(size_t)r * 256 + 16 * eb] = f2bf(acc[r] * 0.125f);
            } else {
                bf16 kb[4];
#pragma unroll
                for (int r = 0; r < 4; ++r) { kb[r] = f2bf(acc[r]); og[(size_t)r * 256 + 16 * eb] = kb[r]; }
                u32x2v w2; w2.x = cvtpk(bf2f(kb[0]) * w4[0], bf2f(kb[1]) * w4[1]); w2.y = cvtpk(bf2f(kb[2]) * w4[2], bf2f(kb[3]) * w4[3]);
                *(LAS u32x2v*)(WKT + (16 * eb + (lane & 15)) * ML_LD + 16 * lb + 4 * (lane >> 4)) = w2;
            }
        }
    }
    __syncthreads();
    {
        float* ct = (float*)(ws + WS_CT) + (size_t)chunk * 4096;
#pragma unroll
        for (int i = 0; i < 2; ++i) { const int blk = wave_u * 2 + i, eb = blk >> 2, db = blk & 3;
            const f32x4v acc = mm16(VT, ML_LD, 16 * eb, WKT, ML_LD, 16 * db, 64, lane, f32x4v{});
#pragma unroll
            for (int r = 0; r < 4; ++r) ct[(16 * eb + 4 * (lane >> 4) + r) * 64 + 16 * db + (lane & 15)] = acc[r]; }
        if (tid < 64) { float n = 0.f; const LAS bf16* wr_ = WKT + tid * ML_LD;
            for (int l = 0; l < 64; ++l) n += bf2f(wr_[l]);
            ((float*)(ws + WS_NL))[chunk * 64 + tid] = n; }
    }
    __syncthreads();
}
__device__ __forceinline__ void mscan_item(unsigned char* ws, int item, int wave_u) {
    const int tid = wave_u * 64 + fresh_lane();
    const int bh = item / 9, part = item % 9;
    if (part == 8 && tid >= 64) return;
    float* base; size_t stride;
    if (part < 8) { base = (float*)(ws + WS_CT) + (size_t)bh * 32 * 4096 + part * 512 + tid; stride = 4096; } else { base = (float*)(ws + WS_NL) + (size_t)bh * 32 * 64 + tid; stride = 64; }
    const float* ML = (const float*)(ws + WS_ML); const float* BL = (const float*)(ws + WS_BL); float* MPv = (float*)(ws + WS_MP);
    float Cv = 0.f, m = 0.f;
    for (int c = 0; c < 32; ++c) {
        const float cl = base[(size_t)c * stride], ml = ML[bh * 32 + c], bl = BL[bh * 32 + c];
        base[(size_t)c * stride] = Cv;
        if (part == 8 && tid == 0) MPv[bh * 32 + c] = m;
        const float mn = fmaxf(bl + m, ml);
        Cv = __expf(bl + m - mn) * Cv + __expf(ml - mn) * cl; m = mn;
    }
}
__device__ __forceinline__ void mout_item(unsigned char* ws, LAS unsigned char* lds, const float* gmh, const float* skip, int chunk, int wave_u) {
    const int lane = fresh_lane(), tid = wave_u * 64 + lane;
    const int c = chunk & 31, h = (chunk >> 5) & 3, b = chunk >> 7, row0 = b * S_ + c * 64;
    LAS bf16* QS = (LAS bf16*)lds;
    LAS bf16* KS = QS + 64 * ML_LD;
    LAS bf16* VT = KS + 64 * ML_LD;
    LAS bf16* CP = VT + 64 * ML_LD;
    LAS bf16* SW = CP + 64 * ML_LD;
    LAS float* HS = (LAS float*)(SW + 64 * ML_LD);
    LAS float* bs = HS + 64 * 65; LAS float* us = bs + 64; LAS float* ns = us + 64; LAS float* mts = ns + 64; LAS float* ints = mts + 64; LAS float* dinv = ints + 64;
    const float* gm = (const float*)(ws + WS_GM);
    {
        const int l = tid >> 3, c0 = (tid & 7) * 8, row = row0 + l;
        *(LAS v4u*)(QS + l * ML_LD + c0) = *(const v4u*)((const bf16*)(ws + WS_MQ) + (size_t)row * 256 + h * 64 + c0);
        *(LAS v4u*)(KS + l * ML_LD + c0) = *(const v4u*)((const bf16*)(ws + WS_MK) + (size_t)row * 256 + h * 64 + c0);
        const v4u v4 = *(const v4u*)((const bf16*)(ws + WS_CM) + (size_t)row * 768 + 256 + h * 64 + c0);
        VT[(c0 + 0) * ML_LD + l] = (bf16)(v4.x & 0xffffu); VT[(c0 + 1) * ML_LD + l] = (bf16)(v4.x >> 16); VT[(c0 + 2) * ML_LD + l] = (bf16)(v4.y & 0xffffu); VT[(c0 + 3) * ML_LD + l] = (bf16)(v4.y >> 16);
        VT[(c0 + 4) * ML_LD + l] = (bf16)(v4.z & 0xffffu); VT[(c0 + 5) * ML_LD + l] = (bf16)(v4.z >> 16); VT[(c0 + 6) * ML_LD + l] = (bf16)(v4.w & 0xffffu); VT[(c0 + 7) * ML_LD + l] = (bf16)(v4.w >> 16);
        const float* ct = (const float*)(ws + WS_CT) + (size_t)chunk * 4096 + l * 64 + c0;
        const f32x4v c0v = *(const f32x4v*)ct, c1v = *(const f32x4v*)(ct + 4);
        v4u cw; cw.x = cvtpk(c0v[0], c0v[1]); cw.y = cvtpk(c0v[2], c0v[3]); cw.z = cvtpk(c1v[0], c1v[1]); cw.w = cvtpk(c1v[2], c1v[3]);
        *(LAS v4u*)(CP + l * ML_LD + c0) = cw;
    }
    if (wave_u == 0) {
        const float ig = gm[(size_t)(row0 + lane) * 32 + 18 + h]; float lf = gm[(size_t)(row0 + lane) * 32 + 22 + h];
#pragma unroll
        for (int o = 1; o < 64; o <<= 1) { const float t = bperm(lf, lane - o); if (lane >= o) lf += t; }
        const float u = ig - lf; float cu = u;
#pragma unroll
        for (int o = 1; o < 64; o <<= 1) { const float t = bperm(cu, lane - o); if (lane >= o) cu = fmaxf(cu, t); }
        const float mprev = ((const float*)(ws + WS_MP))[chunk];
        const float mt = lf + fmaxf(mprev, cu);
        bs[lane] = lf; us[lane] = u; mts[lane] = mt; ints[lane] = __expf(lf + mprev - mt); ns[lane] = ((const float*)(ws + WS_NL))[chunk * 64 + lane];
    }
    __syncthreads();
    {
#pragma unroll
        for (int i = 0; i < 2; ++i) { const int blk = wave_u * 2 + i, lb = blk >> 2, sb = blk & 3;
            f32x4v acc = f32x4v{};
            if (sb <= lb) acc = mm16(QS, ML_LD, 16 * lb, KS, ML_LD, 16 * sb, 64, lane, acc);
            const int sidx = 16 * sb + (lane & 15); const float usv = us[sidx];
#pragma unroll
            for (int r = 0; r < 4; ++r) { const int l = 16 * lb + 4 * (lane >> 4) + r;
                const float v = (sidx <= l) ? acc[r] * __expf(bs[l] + usv - mts[l]) : 0.f;
                SW[l * ML_LD + sidx] = f2bf(v); } }
    }
    __syncthreads();
    if (tid < 64) {
        const int l = tid; float qn = 0.f, ssum = 0.f;
        for (int d = 0; d < 64; ++d) { qn += bf2f(QS[l * ML_LD + d]) * ns[d]; ssum += bf2f(SW[l * ML_LD + d]); }
        const float den = ints[l] * qn + ssum;
        dinv[l] = 1.f / fmaxf(fabsf(den), __expf(-mts[l]));
    }
    f32x4v hq[2], hs2[2];
#pragma unroll
    for (int i = 0; i < 2; ++i) { const int blk = wave_u * 2 + i, lb = blk >> 2, eb = blk & 3;
        hq[i] = mm16(QS, ML_LD, 16 * lb, CP, ML_LD, 16 * eb, 64, lane, f32x4v{});
        hs2[i] = mm16(SW, ML_LD, 16 * lb, VT, ML_LD, 16 * eb, 16 * lb + 16 <= 32 ? 32 : 64, lane, f32x4v{}); }
    __syncthreads();
#pragma unroll
    for (int i = 0; i < 2; ++i) { const int blk = wave_u * 2 + i, lb = blk >> 2, eb = blk & 3; const int e = 16 * eb + (lane & 15);
#pragma unroll
        for (int r = 0; r < 4; ++r) { const int l = 16 * lb + 4 * (lane >> 4) + r;
            const float og = bf2f(((const bf16*)(ws + WS_CM))[(size_t)(row0 + l) * 768 + 512 + h * 64 + e]);
            HS[l * 65 + e] = (ints[l] * hq[i][r] + hs2[i][r]) * dinv[l] / (1.f + __expf(-og)); } }
    __syncthreads();
    {
        const int l = tid >> 3, e0 = (tid & 7) * 8, row = row0 + l;
        float v[8]; float mu = 0.f;
#pragma unroll
        for (int i = 0; i < 8; ++i) { v[i] = HS[l * 65 + e0 + i]; mu += v[i]; }
        mu += sxf<1>(mu); mu += sxf<2>(mu); mu += sxf<4>(mu); mu *= (1.f / 64.f);
        float var = 0.f;
#pragma unroll
        for (int i = 0; i < 8; ++i) { const float dl = v[i] - mu; var += dl * dl; }
        var += sxf<1>(var); var += sxf<2>(var); var += sxf<4>(var);
        const float rs = rsqrtf(var * (1.f / 64.f) + EPS);
        const v4u x4 = *(const v4u*)((const bf16*)(ws + WS_XC) + (size_t)row * 256 + h * 64 + e0);
        float xv[8]; xv[0] = __uint_as_float(x4.x << 16); xv[1] = __uint_as_float(x4.x & 0xffff0000u); xv[2] = __uint_as_float(x4.y << 16); xv[3] = __uint_as_float(x4.y & 0xffff0000u);
        xv[4] = __uint_as_float(x4.z << 16); xv[5] = __uint_as_float(x4.z & 0xffff0000u); xv[6] = __uint_as_float(x4.w << 16); xv[7] = __uint_as_float(x4.w & 0xffff0000u);
        float r[8];
#pragma unroll
        for (int i = 0; i < 8; ++i) r[i] = (v[i] - mu) * rs * gmh[h * 64 + e0 + i] + skip[h * 64 + e0 + i] * xv[i];
        v4u w4; w4.x = cvtpk(r[0], r[1]); w4.y = cvtpk(r[2], r[3]); w4.z = cvtpk(r[4], r[5]); w4.w = cvtpk(r[6], r[7]);
        *(v4u*)((bf16*)(ws + WS_HB) + (size_t)row * D_ + 768 + h * 64 + e0) = w4;
    }
    __syncthreads();
}

__global__ void __launch_bounds__(NTHR, 2) mega(MP p_unused) {
    extern __shared__ __attribute__((aligned(16))) unsigned char lds_raw[];
    LAS unsigned char* lds = (LAS unsigned char*)lds_raw;
    const int wave0 = __builtin_amdgcn_readfirstlane((int)threadIdx.x >> 6);
    const int tid0 = wave0 * 64 + fresh_lane();
    const int xcc = (int)(__builtin_amdgcn_s_getreg((3 << 11) | 20) & 7u);
    volatile LAS unsigned* MISC = (volatile LAS unsigned*)(lds + MISC_OFF);
    for (int u = tid0; u < (LDS_BYTES - RING_BYTES) / 4; u += NTHR) ((LAS unsigned*)(lds + RING_BYTES))[u] = 0u;
    __syncthreads();
    typedef const __attribute__((address_space(4))) MP* kmp_t;
    kmp_t kp0 = (kmp_t)__builtin_amdgcn_kernarg_segment_ptr();
    unsigned char* ws0 = kp0->ws; const int coop = kp0->coop, ph_lo = kp0->ph_lo, ph_hi = kp0->ph_hi;
    XcdBarrier bar; bar.bar = (unsigned*)(ws0 + WS_CTL) + CW_BAR; bar.x = 0; bar.st = nullptr;
    if (coop) bar = xcd_barrier_post((unsigned*)(ws0 + WS_CTL) + CW_BAR, MISC + 8, tid0);
    if (coop == 2) cooperative_groups::this_grid().sync();
    int ph = ph_lo;
    if (ph == 0) {
        const MPK p{kp0}; ph_p0(p, lds, wave0 * 64 + fresh_lane()); ph = 1;
        if (ph < ph_hi) xcd_barrier(bar, wave0 * 64 + fresh_lane());
    }
    bool second = false;
    for (; ph < ph_hi; ++ph) {
        kmp_t kp = kp0; asm volatile("" : "+s"(kp));
        const MPK p{kp}; unsigned char* ws = kp->ws;
#define TID_ (wave0 * 64 + fresh_lane())
#define GW_ (blockIdx.x * NWAVES + wave0)
#define NGW_ (gridDim.x * NWAVES)
        const int l = (ph - 1) / PPL, ty = (ph == 0) ? -1 : (ph == NPH - 1) ? -2 : (ph - 1) % PPL;
        const float* modl = (const float*)(ws + WS_MOD) + (size_t)l * 8 * 6144;
        if (ty == -2) { norm_rows(p.k->out, PIN(I_GFIN), nullptr, nullptr, nullptr, p.k->out, 2, GW_, NGW_, fresh_lane());
            if (PROBE_SEL != 0 && blockIdx.x == 0 && TID_ == 0) { asm volatile("s_waitcnt vmcnt(0)" ::: "memory"); p.k->out[0] = ((const float*)(ws + WS_CTL))[100] * 0.001f; } }
        else if (ty == 0 && (PHM & 2)) ph_prep(p, l, lds, TID_);
        else if (ty == 1 && (PHM & 4)) {
            pg8::Gemm g{(const bf16*)(ws + WS_HB), (const bf16*)(ws + WT_IN), T_, 2560, D_}; pg8::StaticOrder S; S.init(T_, 2560, gridDim.x, blockIdx.x);
            pg8::EpiIn E{ws, PIN(I_BIG) + l * 4, PIN(I_BFG) + l * 4};
            pg8::gemm_phase<pg8::EpiIn, pg8::StaticOrder, true, true>(lds, g, S, E, wave0);
            late_transposes(p, l, lds, TID_, 640 % (int)gridDim.x);
        }
        else if (ty == 2 && (PHM & 64)) {
            { pg8::Gemm g{(const bf16*)(ws + WS_KVL), (const bf16*)(ws + WT_UKV), T_, 768, 128}; pg8::StaticOrder S; S.init(T_, 768, gridDim.x, blockIdx.x);
              pg8::EpiUKV E{(bf16*)(ws + WS_KVM), (const float*)(ws + WS_SSKV)}; pg8::gemm_phase<pg8::EpiUKV, pg8::StaticOrder, true, true>(lds, g, S, E, wave0); }
            { pg8::Gemm g{(const bf16*)(ws + WS_QL), (const bf16*)(ws + WT_UQ), T_, 768, 256}; pg8::StaticOrder S; S.init(T_, 768, gridDim.x, blockIdx.x);
              pg8::EpiPlain E{(bf16*)(ws + WS_OSLC), 768}; pg8::gemm_phase<pg8::EpiPlain, pg8::StaticOrder, true, true>(lds, g, S, E, wave0); }
            post_misc(ws, PIN(I_BIG) + l * 4, PIN(I_BFG) + l * 4, TID_);
            unsigned* ctrs = (unsigned*)(ws + WS_CTL) + 8192 + ph * 256 + (second ? 128 : 0); int ks = 0;
            for (;;) { const int it = next_item_q(ctrs, lds, wave0, 160, xcc, ks); if (it < 0) break; const int b = it >> 16, j = it & 0xffff;
                if (second && (REP_MASK & (1 << 18)) && j >= 128) continue; if (second && (REP_MASK & (1 << 19)) && j < 128) continue;
                if (j < 128) mlocal_item(ws, lds, PIN(I_CONVW) + l * 1024, PIN(I_CONVB) + l * 256, PIN(I_BIG) + l * 4, PIN(I_BFG) + l * 4, b * 128 + j, wave0);
                else { const int k = j - 128; compress_item(ws, lds, PIN(I_CMPPOS) + l * 2048, ((k >> 4) << 7) | (b << 4) | (k & 15), wave0); } }
        }
        else if (ty == 3 && (PHM & 128)) {
            unsigned* ctrs = (unsigned*)(ws + WS_CTL) + 8192 + ph * 256 + (second ? 128 : 0); int ks = 0;
            for (;;) { const int it = next_item_q(ctrs, lds, wave0, second ? 64 : 100, xcc, ks); if (it < 0) break; const int b = it >> 16, j = it & 0xffff;
                if (second && (REP_MASK & (1 << 20)) && j >= 48) continue; if (second && (REP_MASK & (1 << 21)) && j < 48) continue;
                if (j < 18) mla_unit(ws, lds, b, j % 6, 7 - j / 6, wave0);
                else if (j < 34) cmp_unit(ws, lds, b, (j - 18) >> 3, 7 - ((j - 18) & 7), wave0);
                else if (j < 64) { const int u = j - 16; mla_unit(ws, lds, b, u % 6, 7 - u / 6, wave0); }
                else mscan_item(ws, b * 36 + (j - 64), wave0); }
        }
        else if (ty == 4 && (PHM & 256)) {
            unsigned* ctrs = (unsigned*)(ws + WS_CTL) + 8192 + ph * 256 + (second ? 128 : 0); int ks = 0;
            for (;;) { const int it = next_item_q(ctrs, lds, wave0, 224, xcc, ks); if (it < 0) break; const int b = it >> 16, j = it & 0xffff;
                if (second && (REP_MASK & (1 << 16)) && j >= 96) continue; if (second && (REP_MASK & (1 << 17)) && j < 96) continue;
                if (j < 36) nsa_branch_unit<AM_SLC>(ws, lds, b, j % 6, 7 - j / 6, wave0);
                else if (j < 84) nsa_branch_unit<AM_WINDOW>(ws, lds, b, (j - 36) % 6, 7 - (j - 36) / 6, wave0);
                else if (j < 96) { const int u = j - 48; nsa_branch_unit<AM_SLC>(ws, lds, b, u % 6, 7 - u / 6, wave0); }
                else mout_item(ws, lds, PIN(I_GMH) + l * 256, PIN(I_SKIP) + l * 256, b * 128 + (j - 96), wave0); }
        }
        else if (ty == 5) ph_mixnorm(p, l, TID_);
        else if (ty == 6 && (PHM & 8)) {
            pg8::Gemm g{(const bf16*)(ws + WS_HB), (const bf16*)(ws + WT_OUT), T_, D_, D_}; pg8::StaticOrder S; S.init(T_, D_, gridDim.x, blockIdx.x);
            pg8::EpiRes E{(l == 0) ? PIN(I_X) : p.k->out, p.k->out, modl + 2048};
            pg8::gemm_phase<pg8::EpiRes, pg8::StaticOrder, true, true>(lds, g, S, E, wave0);
        }
        else if (ty == 7) norm_rows(p.k->out, PIN(I_GN2) + l * D_, modl + 3072, modl + 4096, (bf16*)(ws + WS_HB), nullptr, 1, GW_, NGW_, fresh_lane());
        else if (ty == 8 && (PHM & 16)) {
            pg8::Gemm g{(const bf16*)(ws + WS_HB), (const bf16*)(ws + WT_GU), T_, 2 * FF, D_}; pg8::StaticOrder S; S.init(T_, 2 * FF, gridDim.x, blockIdx.x);
            pg8::EpiGU E{(bf16*)(ws + WS_ACT)};
            pg8::gemm_phase<pg8::EpiGU, pg8::StaticOrder, true, true>(lds, g, S, E, wave0);
            if (l + 1 < DEPTH) early_transposes(p, l + 1, lds, TID_, 1408 % (int)gridDim.x);
        }
        else if (ty == 9 && (PHM & 32)) {
            pg8::Gemm g{(const bf16*)(ws + WS_ACT), (const bf16*)(ws + WT_DOWN), T_, D_, FF}; pg8::StaticOrder S; S.init(T_, D_, gridDim.x, blockIdx.x);
            pg8::EpiRes E{p.k->out, p.k->out, modl + 5120};
            pg8::gemm_phase<pg8::EpiRes, pg8::StaticOrder, true, true>(lds, g, S, E, wave0);
        }
        if (REP_MASK != 0 && ty >= 0 && ((REP_MASK >> ty) & 1) && !second) { second = true; --ph; } else second = false;
        if (ph + 1 < ph_hi) xcd_barrier(bar, wave0 * 64 + fresh_lane());
    }
}

extern "C" void kernel_launch(void* const* d_in, const int* in_sizes, int n_in, void* d_out, int out_size, void* d_ws, size_t ws_size, hipStream_t stream) {
    if (n_in != N_IN || ws_size < WS_END) { fprintf(stderr, "kernel_launch: unexpected n_in %d / ws %zu\n", n_in, ws_size); return; }
    static int inited = 0;
    if (!inited) { if (hipFuncSetAttribute((const void*)mega, hipFuncAttributeMaxDynamicSharedMemorySize, LDS_BYTES) != hipSuccess) fprintf(stderr, "hipFuncSetAttribute failed\n"); inited = 1; }
    unsigned char* ws = (unsigned char*)d_ws;
    MP base{}; for (int i = 0; i < N_IN; ++i) base.in[i] = (const float*)d_in[i]; base.out = (float*)d_out; base.ws = ws;
    (void)hipMemsetAsync(ws + WS_CTL, 0, CTL_ZERO_BYTES, stream);
    static int grid = 0;
    if (!grid) {
        int dev = 0, cus = 0, per_cu = 0;
        (void)hipGetDevice(&dev); (void)hipDeviceGetAttribute(&cus, hipDeviceAttributeMultiprocessorCount, dev);
        if (hipOccupancyMaxActiveBlocksPerMultiprocessor(&per_cu, (const void*)mega, NTHR, LDS_BYTES) != hipSuccess || per_cu < 1) { fprintf(stderr, "kernel_launch: occupancy query says %d blocks per CU\n", per_cu); per_cu = 1; }
        (void)hipGetLastError();
        grid = cus;
    }
    MP a = base; a.ph_lo = 0; a.ph_hi = NPH; a.coop = 1;
    void* args[] = {&a};
    const hipError_t e = hipLaunchCooperativeKernel((const void*)mega, dim3(grid), dim3(NTHR), args, LDS_BYTES, stream);
    if (e != hipSuccess) fprintf(stderr, "kernel_launch: cooperative launch failed: %s (grid %d)\n", hipGetErrorString(e), grid);
}
```

```cpp
#include <hip/hip_runtime.h>
#include <cstdint>
#include <cstdio>
#include <hip/hip_cooperative_groups.h>

constexpr int B_ = 8, S_ = 2048, T_ = B_ * S_, D_ = 1024, DIN = 2362, FF = 2816, DEPTH = 2;
constexpr float EPS = 1e-6f;
constexpr float LOG2E = 1.4426950408889634f;
constexpr float QSCALE = 0.125f * LOG2E;
constexpr float MSCALE = 0.10206207261596577f * LOG2E;
enum { I_X = 0, I_C, I_POS, I_GN1, I_GN2, I_WADA, I_BADA, I_WIN, I_CMPPOS, I_WCK, I_WCV, I_GOA, I_GQL, I_WUQ, I_GKVL, I_WUKV, I_GOB,
       I_CONVW, I_CONVB, I_WQM, I_WKM, I_BIG, I_BFG, I_GMH, I_SKIP, I_WOUT, I_WGU, I_WDOWN, I_GFIN, N_IN };

constexpr size_t MiB = 1u << 20;
constexpr size_t WS_CTL = 0;
constexpr size_t WS_MOD = 1 * MiB;
constexpr size_t WS_COSP = WS_MOD + 512 * 1024;
constexpr size_t WS_SINP = WS_COSP + 512 * 1024;
constexpr size_t WS_COSM = WS_SINP + 512 * 1024;
constexpr size_t WS_SINM = WS_COSM + 1 * MiB;
constexpr size_t WS_SSQL = WS_SINM + 1 * MiB;
constexpr size_t WS_SSKV = WS_SSQL + 64 * 1024;
constexpr size_t WS_ML = WS_SSKV + 64 * 1024;
constexpr size_t WS_BL = WS_ML + 4096;
constexpr size_t WS_MP = WS_BL + 4096;
constexpr size_t WS_NL = WS_MP + 4096;
constexpr size_t WS_WT = 8 * MiB;
constexpr size_t WS_RAW = WS_WT;
constexpr size_t WS_HB = 34 * MiB;
constexpr size_t WS_NSA = 66 * MiB;
constexpr size_t WS_KVL = 102 * MiB;
constexpr size_t WS_QL = 106 * MiB;
constexpr size_t WS_CM = 114 * MiB;
constexpr size_t WS_GM = 138 * MiB;
constexpr size_t WS_KM = 140 * MiB;
constexpr size_t WS_QM = 158 * MiB;
constexpr size_t WS_VM = 176 * MiB;
constexpr size_t WS_KCV = 188 * MiB;
constexpr size_t WS_OCMP = 189 * MiB;
constexpr size_t WS_SEL = 201 * MiB;
constexpr size_t WS_XC = 202 * MiB;
constexpr size_t WS_MQ = 210 * MiB;
constexpr size_t WS_MK = 218 * MiB;
constexpr size_t WS_CT = 226 * MiB;
constexpr size_t WS_MISCRAW = 242 * MiB;
constexpr size_t WS_KVM = 140 * MiB;
constexpr size_t WS_KR = 246 * MiB;
constexpr size_t WS_OSLC = 164 * MiB;
constexpr size_t WS_OWIN = 176 * MiB;
constexpr size_t WS_ACT = 66 * MiB;
constexpr size_t WS_END = 256 * MiB;
static_assert(WS_NL + 1024 * 64 * 4 <= WS_WT, "tab");
static_assert(WS_ACT + (size_t)T_ * FF * 2 <= WS_KCV, "act overlay");

typedef unsigned short bf16;
__device__ __forceinline__ float bf2f(bf16 v) { return __uint_as_float(((unsigned)v) << 16); }
__device__ __forceinline__ bf16 f2bf(float f) { unsigned u = __float_as_uint(f); return (bf16)((u + 0x7fffu + ((u >> 16) & 1u)) >> 16); }
__device__ __forceinline__ float sigmoidf_(float x) { return 1.f / (1.f + __expf(-x)); }
__device__ __forceinline__ float siluf_(float x) { return x / (1.f + __expf(-x)); }
__device__ __forceinline__ float wave_sum(float v) {
#pragma unroll
    for (int o = 1; o < 64; o <<= 1) v += __shfl_xor(v, o);
    return v;
}

__device__ __forceinline__ int fresh_lane() { int l; asm volatile("v_mbcnt_lo_u32_b32 %0, -1, 0\n\tv_mbcnt_hi_u32_b32 %0, -1, %0" : "=&v"(l)); return l; }
template <int M> __device__ __forceinline__ float sxf(float v) { static_assert(M >= 1 && M < 32, "swizzle xor mask"); return __int_as_float(__builtin_amdgcn_ds_swizzle(__float_as_int(v), (M << 10) | 0x1f)); }
__device__ __forceinline__ float red32_max(float v) { auto r = __builtin_amdgcn_permlane32_swap(__float_as_uint(v), __float_as_uint(v), false, false); return fmaxf(__uint_as_float(r[0]), __uint_as_float(r[1])); }
__device__ __forceinline__ float red32_sum(float v) { auto r = __builtin_amdgcn_permlane32_swap(__float_as_uint(v), __float_as_uint(v), false, false); return __uint_as_float(r[0]) + __uint_as_float(r[1]); }
__device__ __forceinline__ unsigned red32_or(unsigned v) { auto r = __builtin_amdgcn_permlane32_swap(v, v, false, false); return r[0] | r[1]; }
__device__ __forceinline__ float bperm(float v, int src_lane) { return __int_as_float(__builtin_amdgcn_ds_bpermute(src_lane << 2, __float_as_int(v))); }
__device__ __forceinline__ float wave_sum2(float v) { v += sxf<1>(v); v += sxf<2>(v); v += sxf<4>(v); v += sxf<8>(v); v += sxf<16>(v); return red32_sum(v); }
__device__ __forceinline__ float wave_max2(float v) { v = fmaxf(v, sxf<1>(v)); v = fmaxf(v, sxf<2>(v)); v = fmaxf(v, sxf<4>(v)); v = fmaxf(v, sxf<8>(v)); v = fmaxf(v, sxf<16>(v)); return red32_max(v); }
namespace pg8 {
#define PG8_LAS __attribute__((address_space(3)))
typedef unsigned short bf16_t;
typedef short bf16x8 __attribute__((ext_vector_type(8)));
typedef float f32x4 __attribute__((ext_vector_type(4)));
typedef unsigned u32x4 __attribute__((ext_vector_type(4)));
constexpr int BM = 256, BK = 64, HALF = 128, HTB = HALF * BK * 2  , STAGE_BYTES = 8 * HTB, NXCD = 8, WGM = 8;

__host__ __device__ __forceinline__ int lds_byte(int r, int c) { const int st = (r >> 4) * 2 + (c >> 5), rr = r & 15, cc = c & 31, ob = rr * 64 + cc * 2; return st * 1024 + (ob ^ (((ob >> 9) & 1) << 5)); }
__host__ __device__ __forceinline__ void stage_rc(int b, int& R, int& C) { const int st = b / 1024, sb = b % 1024, swz = sb ^ (((sb >> 9) & 1) << 5); R = (st >> 1) * 16 + swz / 64; C = (st & 1) * 32 + (swz % 64) / 2; }
__host__ __device__ __forceinline__ int perm32(int rho) { const int n = rho >> 4, i = rho & 15; return 8 * (i >> 2) + 4 * n + (i & 3); }

struct Unit { int pm, pn; };
struct Gemm { const bf16_t* A; const bf16_t* Bt; int M, N, K; };

struct StaticOrder {
    int nM, nN, nwg, G, c;
    __host__ __device__ void init(int M, int N, int G_, int c_) { nM = M / BM; nN = N / BM; nwg = nM * nN; G = G_; c = c_; }
    __host__ __device__ bool next(int i, Unit& u) const {
        const long L = (long)i * G + c; if (L >= nwg) return false;
        int wgid = (int)L; { const int q = nwg / NXCD, r = nwg % NXCD, xcd = wgid % NXCD, off = wgid / NXCD; wgid = (xcd < r ? xcd * (q + 1) : r * (q + 1) + (xcd - r) * q) + off; }
        const int nig = WGM * nN, gid = wgid / nig, fm = gid * WGM, gsz = (nM - fm) < WGM ? (nM - fm) : WGM;
        u.pm = fm + ((wgid % nig) % gsz); u.pn = (wgid % nig) / gsz; return true;
    }
    __device__ __forceinline__ void a_ready(const Unit&) const {}
    __device__ __forceinline__ void done(const Unit&) const {}
};

__device__ __forceinline__ unsigned cvt_pk_bf16(float lo, float hi) { unsigned r; asm volatile("v_cvt_pk_bf16_f32 %0, %1, %2" : "=v"(r) : "v"(lo), "v"(hi)); return r; }
typedef float f32x2 __attribute__((ext_vector_type(2)));

typedef unsigned u32x4 __attribute__((ext_vector_type(4)));
typedef unsigned u32x2 __attribute__((ext_vector_type(2)));
struct EpiIn {
    static constexpr bool PERM = true, AFTER_DRAIN = false;
    unsigned char* ws; const float *big, *bfg;
#define EPI_ROWS(...) _Pragma("unroll") for (int ai = 0; ai < 2; ++ai) _Pragma("unroll") for (int m = 0; m < 4; ++m) { \
        const int row = u.pm * BM + ai * HALF + wr * 64 + m * 16 + fr; float v[8]; \
        _Pragma("unroll") for (int i = 0; i < 4; ++i) { v[i] = acc[ai][bj][m][0][i]; v[4 + i] = acc[ai][bj][m][1][i]; } \
        asm volatile("" : "+v"(v[0]), "+v"(v[1]), "+v"(v[2]), "+v"(v[3]), "+v"(v[4]), "+v"(v[5]), "+v"(v[6]), "+v"(v[7])); \
        __VA_ARGS__ asm volatile("" ::: "memory"); }
#define EPI_PACK(w) u32x4 w; w.x = cvt_pk_bf16(v[0], v[1]); w.y = cvt_pk_bf16(v[2], v[3]); w.z = cvt_pk_bf16(v[4], v[5]); w.w = cvt_pk_bf16(v[6], v[7]);
    __device__ __forceinline__ void operator()(const f32x4 (&acc)[2][2][4][2], const Unit& u, int wr, int wc, int fr, int fq) const {
        half<0>(acc, u, wr, wc, fr, fq); half<1>(acc, u, wr, wc, fr, fq);
    }
    template <int bj> __device__ __forceinline__ void half(const f32x4 (&acc)[2][2][4][2], const Unit& u, int wr, int wc, int fr, int fq) const {
        {
            const int hb = 2 * u.pn + bj;
            int cb = 32 * wc + 8 * fq; asm volatile("" : "+v"(cb), "+v"(fr));
            if (hb <= 8) {
                bf16_t* nsa = (bf16_t*)(ws + WS_NSA) + hb * 128 + cb;
                const bool rope_hb = (hb <= 3) || hb == 5 || hb == 7;
                if (rope_hb) {
                    const float* cosP = (const float*)(ws + WS_COSP); const float* sinP = (const float*)(ws + WS_SINP);
                    const bool mine = ((wc & 1) == 0) && fq < 2; const float sg = (fq == 0) ? -1.f : 1.f; const float sc = (hb < 3) ? QSCALE : 1.f;
                    EPI_ROWS({
                        float pv[8];
                        _Pragma("unroll") for (int i = 0; i < 8; ++i) pv[i] = sxf<16>(v[i]);
                        if (mine) {
                            const f32x4 c0 = *(const f32x4*)(cosP + row * 8), c1 = *(const f32x4*)(cosP + row * 8 + 4), s0 = *(const f32x4*)(sinP + row * 8), s1 = *(const f32x4*)(sinP + row * 8 + 4);
                            _Pragma("unroll") for (int i = 0; i < 4; ++i) { v[i] = v[i] * c0[i] + sg * pv[i] * s0[i]; v[4 + i] = v[4 + i] * c1[i] + sg * pv[4 + i] * s1[i]; }
                        }
                        _Pragma("unroll") for (int i = 0; i < 8; ++i) v[i] *= sc;
                        EPI_PACK(w) *(u32x4*)(nsa + (size_t)row * 1152) = w;
                    })
                } else {
                    EPI_ROWS({ EPI_PACK(w) *(u32x4*)(nsa + (size_t)row * 1152) = w; })
                }
            } else if (hb <= 11) {
                bf16_t* dst = (hb == 9) ? (bf16_t*)(ws + WS_KVL) + cb : (bf16_t*)(ws + WS_QL) + (hb - 10) * 128 + cb;
                const int ld = (hb == 9) ? 128 : 256;
                float* ssq = (hb == 9) ? (float*)(ws + WS_SSKV) : (float*)(ws + WS_SSQL);
                EPI_ROWS({ EPI_PACK(w) *(u32x4*)(dst + (size_t)row * ld) = w;
                    float sq = 0.f;
                    _Pragma("unroll") for (int i = 0; i < 8; ++i) sq += v[i] * v[i];
                    sq += sxf<16>(sq); sq = red32_sum(sq);
                    if (fq == 0) atomicAdd(ssq + row, sq); })
            } else if (hb <= 17) {
                bf16_t* cm = (bf16_t*)(ws + WS_CM) + (hb - 12) * 128 + cb;
                EPI_ROWS({ EPI_PACK(w) *(u32x4*)(cm + (size_t)row * 768) = w; })
            } else if (hb == 18) {
                float* mr = (float*)(ws + WS_MISCRAW) + cb;
                if (wc < 2) { EPI_ROWS({ *(f32x4*)(mr + (size_t)row * 64) = (f32x4){v[0], v[1], v[2], v[3]}; *(f32x4*)(mr + (size_t)row * 64 + 4) = (f32x4){v[4], v[5], v[6], v[7]}; }) }
            }
        }
    }
#undef EPI_ROWS
#undef EPI_PACK
};
struct EpiUKV {
    static constexpr bool PERM = true, AFTER_DRAIN = false;
    bf16_t* kvm; const float* sskv;
    __device__ __forceinline__ void operator()(const f32x4 (&acc)[2][2][4][2], const Unit& u, int wr, int wc, int fr, int fq) const {
        asm volatile("" : "+v"(fq), "+v"(fr));
        const int col0 = u.pn * BM + wc * 32 + 8 * fq;
#pragma unroll
        for (int ai = 0; ai < 2; ++ai)
#pragma unroll
            for (int m = 0; m < 4; ++m) { const int row = u.pm * BM + ai * HALF + wr * 64 + m * 16 + fr; bf16_t* rowp = kvm + (size_t)row * 768 + col0;
                const float rs = rsqrtf(sskv[row] * (1.f / 128.f) + EPS);
#pragma unroll
                for (int bj = 0; bj < 2; ++bj) { const f32x4 a = acc[ai][bj][m][0] * rs, b = acc[ai][bj][m][1] * rs;
                    u32x4 w; w.x = cvt_pk_bf16(a[0], a[1]); w.y = cvt_pk_bf16(a[2], a[3]); w.z = cvt_pk_bf16(b[0], b[1]); w.w = cvt_pk_bf16(b[2], b[3]);
                    *(u32x4*)(rowp + bj * HALF) = w; }
                asm volatile("" ::: "memory"); }
    }
};
struct EpiPlain {
    static constexpr bool PERM = true, AFTER_DRAIN = false;
    bf16_t* out; int ld;
    __device__ __forceinline__ void operator()(const f32x4 (&acc)[2][2][4][2], const Unit& u, int wr, int wc, int fr, int fq) const {
        asm volatile("" : "+v"(fq), "+v"(fr));
        const int col0 = u.pn * BM + wc * 32 + 8 * fq;
#pragma unroll
        for (int ai = 0; ai < 2; ++ai)
#pragma unroll
            for (int m = 0; m < 4; ++m) { bf16_t* rowp = out + (size_t)(u.pm * BM + ai * HALF + wr * 64 + m * 16 + fr) * ld + col0;
#pragma unroll
                for (int bj = 0; bj < 2; ++bj) { const f32x4 a = acc[ai][bj][m][0], b = acc[ai][bj][m][1];
                    u32x4 w; w.x = cvt_pk_bf16(a[0], a[1]); w.y = cvt_pk_bf16(a[2], a[3]); w.z = cvt_pk_bf16(b[0], b[1]); w.w = cvt_pk_bf16(b[2], b[3]);
                    *(u32x4*)(rowp + bj * HALF) = w; } }
    }
};
struct EpiRes {
    static constexpr bool PERM = false, AFTER_DRAIN = false;
    const float* xin; float* xout; const float* gate;
    __device__ __forceinline__ void operator()(const f32x4 (&acc)[2][2][4][2], const Unit& u, int wr, int wc, int fr, int fq) const {
        asm volatile("" : "+v"(fq), "+v"(fr));
        const int b = (u.pm * BM) / S_; const int col0 = u.pn * BM + wc * 32 + 4 * fq;
        f32x4 gv[2][2];
#pragma unroll
        for (int bj = 0; bj < 2; ++bj)
#pragma unroll
            for (int n = 0; n < 2; ++n) gv[bj][n] = *(const f32x4*)(gate + (size_t)b * 6144 + col0 + bj * HALF + n * 16);
#pragma unroll
        for (int ai = 0; ai < 2; ++ai)
#pragma unroll
            for (int m = 0; m < 4; ++m) { const size_t off = (size_t)(u.pm * BM + ai * HALF + wr * 64 + m * 16 + fr) * D_ + col0;
#pragma unroll
                for (int bj = 0; bj < 2; ++bj)
#pragma unroll
                    for (int n = 0; n < 2; ++n) { const f32x4 xi = *(const f32x4*)(xin + off + bj * HALF + n * 16); *(f32x4*)(xout + off + bj * HALF + n * 16) = xi + gv[bj][n] * acc[ai][bj][m][n]; } }
    }
};
struct EpiGU {
    static constexpr bool PERM = true, AFTER_DRAIN = false;
    bf16_t* act;
    __device__ __forceinline__ void operator()(const f32x4 (&acc)[2][2][4][2], const Unit& u, int wr, int wc, int fr, int fq) const {
        asm volatile("" : "+v"(fq), "+v"(fr));
        const int col0 = u.pn * HALF + wc * 32 + 8 * fq;
#pragma unroll
        for (int ai = 0; ai < 2; ++ai)
#pragma unroll
            for (int m = 0; m < 4; ++m) { const int row = u.pm * BM + ai * HALF + wr * 64 + m * 16 + fr; float o[8];
#pragma unroll
                for (int n = 0; n < 2; ++n)
#pragma unroll
                    for (int i = 0; i < 4; ++i) { const float g = acc[ai][0][m][n][i], up = acc[ai][1][m][n][i]; o[4 * n + i] = g / (1.f + __expf(-g)) * up; }
                u32x4 w; w.x = cvt_pk_bf16(o[0], o[1]); w.y = cvt_pk_bf16(o[2], o[3]); w.z = cvt_pk_bf16(o[4], o[5]); w.w = cvt_pk_bf16(o[6], o[7]);
                *(u32x4*)(act + (size_t)row * FF + col0) = w; }
    }
};
template <class Epi, class Sched, bool ALIGN_EPI = false, bool SP2 = false>
__device__ __forceinline__ void gemm_phase(PG8_LAS unsigned char* lds, const Gemm g, const Sched& S, const Epi& E, int wid_in) {
    const int wid = __builtin_amdgcn_readfirstlane(wid_in), lane = fresh_lane(), tid = wid * 64 + lane, wr = wid >> 2, wc = wid & 3;
    const int K = g.K, nt = K / BK;
    unsigned voffA[2], voffB[2];
#pragma unroll
    for (int i = 0; i < 2; ++i) { int R, C; stage_rc(tid * 16 + i * 8192, R, C); const int Rb = Epi::PERM ? ((R & ~31) + perm32(R & 31)) : R;
        voffA[i] = (unsigned)(R * K + C) * 2u; voffB[i] = (unsigned)(Rb * K + C) * 2u; }
    const size_t kstep = (size_t)(BK * 2);
    const size_t hstep = (size_t)HALF * K * 2;
    const size_t tstep = 2 * hstep;
    const unsigned ldsw = (unsigned)wid * 1024u;
    const int aoff = lds_byte(wr * 64 + (lane & 15), (lane >> 4) * 8), boff = lds_byte(wc * 32 + (lane & 15), (lane >> 4) * 8);
#define PG8_SA(b, h) (((b) * 2 + (h)) * HTB)
#define PG8_SB(b, h) ((4 + (b) * 2 + (h)) * HTB)
#define PG8_STAGE(bufoff, gbase, voff) do { _Pragma("unroll") for (int _i = 0; _i < 2; ++_i) \
        __builtin_amdgcn_global_load_lds((const unsigned*)((const char*)(gbase) + (voff)[_i]), (PG8_LAS unsigned*)(lds + (bufoff) + ldsw + _i * 8192), 16, 0, 0); } while (0)
#define PG8_LDA(dst, b, h) do { _Pragma("unroll") for (int m = 0; m < 4; ++m) _Pragma("unroll") for (int k = 0; k < 2; ++k) dst[m][k] = *(const PG8_LAS bf16x8*)(lds + PG8_SA(b, h) + aoff + m * 2048 + k * 1024); } while (0)
#define PG8_LDB(dst, b, h) do { _Pragma("unroll") for (int n = 0; n < 2; ++n) _Pragma("unroll") for (int k = 0; k < 2; ++k) dst[n][k] = *(const PG8_LAS bf16x8*)(lds + PG8_SB(b, h) + boff + n * 2048 + k * 1024); } while (0)
#define PG8_MMA(ai, bj, At, Bt) do { __builtin_amdgcn_s_setprio(1); _Pragma("unroll") for (int m = 0; m < 4; ++m) _Pragma("unroll") for (int n = 0; n < 2; ++n) _Pragma("unroll") for (int k = 0; k < 2; ++k) \
        acc[ai][bj][m][n] = __builtin_amdgcn_mfma_f32_16x16x32_bf16(Bt[n][k], At[m][k], acc[ai][bj][m][n], 0, 0, 0); __builtin_amdgcn_s_setprio(0); } while (0)
#define PG8_WAIT_V(n) asm volatile("s_waitcnt vmcnt(" #n ")" ::: "memory")
#define PG8_WAIT_L(n) asm volatile("s_waitcnt lgkmcnt(" #n ")" ::: "memory")
#define PG8_BAR __builtin_amdgcn_s_barrier()
#define PG8_SCHED __builtin_amdgcn_sched_barrier(0)
    Unit cur, nxt; int ui = 0;
    if (!S.next(0, cur)) return;
    f32x4 acc[2][2][4][2];
#pragma unroll
    for (int a = 0; a < 2; ++a)
#pragma unroll
        for (int b = 0; b < 2; ++b)
#pragma unroll
            for (int m = 0; m < 4; ++m)
#pragma unroll
                for (int n = 0; n < 2; ++n) acc[a][b][m][n] = (f32x4){0.f, 0.f, 0.f, 0.f};
    bf16x8 At[4][2], B0[2][2], B1[2][2];
    const char* cA = (const char*)g.A + (size_t)cur.pm * tstep; const char* cB = (const char*)g.Bt + (size_t)cur.pn * tstep;
    S.a_ready(cur);
    if constexpr (SP2) {
        PG8_STAGE(PG8_SB(0, 0), cB, voffB); PG8_STAGE(PG8_SB(0, 1), cB + hstep, voffB); PG8_STAGE(PG8_SA(0, 0), cA, voffA); PG8_STAGE(PG8_SA(0, 1), cA + hstep, voffA);
        if (wr == 1) PG8_BAR;
        PG8_WAIT_V(2); PG8_BAR;
        PG8_STAGE(PG8_SB(1, 0), cB + kstep, voffB); PG8_STAGE(PG8_SA(1, 0), cA + kstep, voffA); PG8_STAGE(PG8_SB(1, 1), cB + hstep + kstep, voffB);
        PG8_WAIT_V(6); PG8_BAR;
    } else {
        PG8_STAGE(PG8_SB(0, 0), cB, voffB); PG8_STAGE(PG8_SA(0, 0), cA, voffA); PG8_STAGE(PG8_SB(0, 1), cB + hstep, voffB); PG8_STAGE(PG8_SA(0, 1), cA + hstep, voffA);
        if (wr == 1) PG8_BAR;
        PG8_WAIT_V(4); PG8_BAR;
        PG8_STAGE(PG8_SB(1, 0), cB + kstep, voffB); PG8_STAGE(PG8_SA(1, 0), cA + kstep, voffA); PG8_STAGE(PG8_SB(1, 1), cB + hstep + kstep, voffB);
        PG8_WAIT_V(6); PG8_BAR;
    }
    for (;;) {
        const bool has_next = S.next(ui + 1, nxt);
        const char* nA = has_next ? (const char*)g.A + (size_t)nxt.pm * tstep : cA; const char* nB = has_next ? (const char*)g.Bt + (size_t)nxt.pn * tstep : cB;
        for (int t = 0; t < nt; t += 2) {
            const bool last = (t == nt - 2);
            const char* a1 = cA + (size_t)(t + 1) * kstep;
            const char* a2 = last ? nA : cA + (size_t)(t + 2) * kstep; const char* b2 = last ? nB : cB + (size_t)(t + 2) * kstep;
            const char* a3 = a2 + kstep; const char* b3 = b2 + kstep;
            if (last && has_next) S.a_ready(nxt);
            if constexpr (SP2) {
            PG8_LDB(B0, 0, 0); PG8_LDB(B1, 0, 1); PG8_SCHED; PG8_LDA(At, 0, 0); PG8_STAGE(PG8_SA(1, 1), a1 + hstep, voffA);
            PG8_WAIT_V(8); PG8_WAIT_L(0); PG8_BAR; PG8_MMA(0, 0, At, B0); PG8_MMA(0, 1, At, B1); PG8_BAR; PG8_SCHED;
            PG8_LDA(At, 0, 1); PG8_STAGE(PG8_SB(0, 0), b2, voffB); PG8_STAGE(PG8_SB(0, 1), b2 + hstep, voffB); PG8_STAGE(PG8_SA(0, 0), a2, voffA);
            PG8_WAIT_V(8); PG8_WAIT_L(0); PG8_BAR; PG8_MMA(1, 0, At, B0); PG8_MMA(1, 1, At, B1); PG8_BAR; PG8_SCHED;
            PG8_LDB(B0, 1, 0); PG8_LDB(B1, 1, 1); PG8_SCHED; PG8_LDA(At, 1, 0); PG8_STAGE(PG8_SA(0, 1), a2 + hstep, voffA);
            PG8_WAIT_V(8); PG8_WAIT_L(0); PG8_BAR; PG8_MMA(0, 0, At, B0); PG8_MMA(0, 1, At, B1); PG8_BAR; PG8_SCHED;
            PG8_LDA(At, 1, 1); PG8_STAGE(PG8_SB(1, 0), b3, voffB); PG8_STAGE(PG8_SB(1, 1), b3 + hstep, voffB); PG8_STAGE(PG8_SA(1, 0), a3, voffA);
            PG8_WAIT_V(8); PG8_WAIT_L(0); PG8_BAR; PG8_MMA(1, 0, At, B0); PG8_MMA(1, 1, At, B1); PG8_BAR; PG8_SCHED;
            } else {
            PG8_LDB(B0, 0, 0); PG8_SCHED; PG8_LDA(At, 0, 0); PG8_STAGE(PG8_SA(1, 1), a1 + hstep, voffA);
            PG8_WAIT_L(8); PG8_BAR; PG8_WAIT_L(0); PG8_MMA(0, 0, At, B0); PG8_BAR; PG8_SCHED;
            PG8_LDB(B1, 0, 1); PG8_STAGE(PG8_SB(0, 0), b2, voffB);
            PG8_BAR; PG8_WAIT_L(0); PG8_MMA(0, 1, At, B1); PG8_BAR;
            PG8_LDA(At, 0, 1); PG8_STAGE(PG8_SA(0, 0), a2, voffA);
            PG8_BAR; PG8_WAIT_L(0); PG8_MMA(1, 0, At, B0); PG8_BAR; PG8_SCHED;
            PG8_STAGE(PG8_SB(0, 1), b2 + hstep, voffB);
            PG8_WAIT_V(6); PG8_BAR; PG8_MMA(1, 1, At, B1); PG8_BAR;
            PG8_LDB(B0, 1, 0); PG8_SCHED; PG8_LDA(At, 1, 0); PG8_STAGE(PG8_SA(0, 1), a2 + hstep, voffA);
            PG8_WAIT_L(8); PG8_BAR; PG8_WAIT_L(0); PG8_MMA(0, 0, At, B0); PG8_BAR; PG8_SCHED;
            PG8_LDB(B1, 1, 1); PG8_STAGE(PG8_SB(1, 0), b3, voffB);
            PG8_BAR; PG8_WAIT_L(0); PG8_MMA(0, 1, At, B1); PG8_BAR;
            PG8_LDA(At, 1, 1); PG8_STAGE(PG8_SA(1, 0), a3, voffA);
            PG8_BAR; PG8_WAIT_L(0); PG8_MMA(1, 0, At, B0); PG8_BAR; PG8_SCHED;
            PG8_STAGE(PG8_SB(1, 1), b3 + hstep, voffB);
            PG8_WAIT_V(6); PG8_BAR; PG8_MMA(1, 1, At, B1); PG8_BAR;
            }
        }
        if constexpr (ALIGN_EPI) { if (wr == 0) PG8_BAR; }
        if constexpr (!Epi::AFTER_DRAIN) { const int ln = fresh_lane(); E(acc, cur, wr, wc, ln & 15, ln >> 4); S.done(cur); }
        if (!has_next) break;
#pragma unroll
        for (int a = 0; a < 2; ++a)
#pragma unroll
            for (int b = 0; b < 2; ++b)
#pragma unroll
                for (int m = 0; m < 4; ++m)
#pragma unroll
                    for (int n = 0; n < 2; ++n) acc[a][b][m][n] = (f32x4){0.f, 0.f, 0.f, 0.f};
        cur = nxt; cA = nA; cB = nB; ++ui;
        if constexpr (ALIGN_EPI) { if (wr == 1) PG8_BAR; }
    }
    PG8_WAIT_V(0);
    if constexpr (!ALIGN_EPI) { if (wr == 0) PG8_BAR; }
    PG8_BAR;
    if constexpr (Epi::AFTER_DRAIN) { const int ln = fresh_lane(); E.fused(acc, cur, wr, wc, ln & 15, ln >> 4, lds, wid, ln); S.done(cur); }
#undef PG8_SA
#undef PG8_SB
#undef PG8_STAGE
#undef PG8_LDA
#undef PG8_LDB
#undef PG8_MMA
#undef PG8_WAIT_V
#undef PG8_WAIT_L
#undef PG8_BAR
#undef PG8_SCHED
}
}

#define GAS __attribute__((address_space(1)))
#define LAS __attribute__((address_space(3)))
typedef float f32x4 __attribute__((ext_vector_type(4)));
typedef unsigned v4u __attribute__((ext_vector_type(4)));
typedef GAS unsigned gu32;
#define XB_TMO      128
#define XB_XCNT(j)  (256  + 64 * (j))
#define XB_XSUB(j)  (1280 + 64 * (j))
#define XB_XGEN(j)  (2304 + 64 * (j))
#define XB_TOP      3328
#define XB_TOPGEN   3392
#define XCD_BAR_WORDS 3456
#define XB_SPIN_CAP (1u << 18)

__device__ __forceinline__ unsigned xb_ld(unsigned* p)              { return __hip_atomic_load(p, __ATOMIC_RELAXED, __HIP_MEMORY_SCOPE_AGENT); }
__device__ __forceinline__ unsigned xb_add(unsigned* p, unsigned v) { return __hip_atomic_fetch_add(p, v, __ATOMIC_RELAXED, __HIP_MEMORY_SCOPE_AGENT); }
__device__ __forceinline__ unsigned xb_xcc_id() { return (unsigned)__builtin_amdgcn_s_getreg((3 << 11) | 20) & 0xFu; }
#define XB_SPIN(cond, bar) do { unsigned _sp = 0; while (cond) { __builtin_amdgcn_s_sleep(1); \
    if ((++_sp & 255u) == 0u) { if (xb_ld(&(bar)[XB_TMO])) break; if (_sp > XB_SPIN_CAP) { atomicAdd(&(bar)[XB_TMO], 1u); break; } } } } while (0)

struct XcdBarrier {
    unsigned* bar; unsigned x;
    volatile LAS unsigned* st;
};

__device__ __forceinline__ XcdBarrier xcd_barrier_post(unsigned* bar, volatile LAS unsigned* st, int tid) {
    XcdBarrier b; b.bar = bar; b.x = xb_xcc_id(); b.st = st;
    if (tid == 0) (void)xb_add(&bar[XB_XCNT(b.x)], 1u);
    return b;
}
__device__ __forceinline__ void xcd_barrier_complete(unsigned* bar, unsigned x, unsigned& nloc, unsigned& nx) {
    const unsigned G = gridDim.x * gridDim.y * gridDim.z;
    unsigned sum, cnt, mine, sp = 0u;
    for (;;) {
        sum = 0u; cnt = 0u; mine = 0u;
#pragma unroll
        for (unsigned j = 0; j < 16; ++j) { const unsigned c = xb_ld(&bar[XB_XCNT(j)]); sum += c; cnt += (c > 0u) ? 1u : 0u; mine = (j == x) ? c : mine; }
        if (sum == G) break;
        __builtin_amdgcn_s_sleep(1);
        if ((++sp & 255u) == 0u) { if (xb_ld(&bar[XB_TMO])) break; if (sp > XB_SPIN_CAP) { atomicAdd(&bar[XB_TMO], 1u); break; } }
    }
    nloc = mine > 0u ? mine : 1u; nx = cnt > 0u ? cnt : 1u;
}

__device__ __forceinline__ void xcd_barrier(const XcdBarrier& b, int tid) {
    asm volatile("s_waitcnt vmcnt(0)" ::: "memory");
    __syncthreads();
    if (tid == 0) {
        unsigned* bar = b.bar;
        __builtin_amdgcn_s_waitcnt(0);
        unsigned nloc = b.st[0], nx = b.st[1];
        if (nloc == 0u) { xcd_barrier_complete(bar, b.x, nloc, nx); b.st[0] = nloc; b.st[1] = nx; }
        const unsigned old = xb_add(&bar[XB_XSUB(b.x)], 1u);
        const unsigned gen = old / nloc;
        if (old + 1u == (gen + 1u) * nloc) {
            __builtin_amdgcn_fence(__ATOMIC_RELEASE, "agent");
            asm volatile("s_waitcnt vmcnt(0)" ::: "memory");
            const unsigned og = xb_add(&bar[XB_TOP], 1u);
            const unsigned tg = og / nx;
            if (og + 1u == (tg + 1u) * nx) xb_add(&bar[XB_TOPGEN], 1u);
            else XB_SPIN(xb_ld(&bar[XB_TOPGEN]) == tg, bar);
            __builtin_amdgcn_fence(__ATOMIC_ACQUIRE, "agent");
            xb_add(&bar[XB_XGEN(b.x)], 1u);
            asm volatile("s_waitcnt vmcnt(0)" ::: "memory");
        } else {
            XB_SPIN(xb_ld(&bar[XB_XGEN(b.x)]) == gen, bar);
            __builtin_amdgcn_fence(__ATOMIC_ACQUIRE, "agent");
            asm volatile("s_waitcnt vmcnt(0)" ::: "memory");
        }
    }
    __syncthreads();
}

constexpr int NTHR = 512, NWAVES = 8;
constexpr int RING_BYTES = 131072, MISC_OFF = RING_BYTES + 320, LDS_BYTES = 147456;
constexpr int CW_BAR = 4096;
constexpr size_t CTL_ZERO_BYTES = 64 * 1024;
constexpr size_t WT_IN = WS_WT, WT_OUT = WT_IN + (size_t)2560 * 1024 * 2, WT_GU = WT_OUT + (size_t)1024 * 1024 * 2, WT_DOWN = WT_GU + (size_t)5632 * 1024 * 2,
                 WT_UQ = WT_DOWN + (size_t)1024 * 2816 * 2, WT_UKV = WT_UQ + (size_t)768 * 256 * 2, WT_CK = WT_UKV + (size_t)768 * 128 * 2, WT_CV = WT_CK + (size_t)64 * 2048 * 2,
                 WT_QM = WT_CV + (size_t)64 * 2048 * 2, WT_KM = WT_QM + 4 * 64 * 64 * 2, WT_END = WT_KM + 4 * 64 * 64 * 2;
static_assert(WT_END <= WS_HB, "weights");
constexpr int NPH = 22, PPL = 10;
constexpr int PROBE_SEL = 0;
constexpr int REP_MASK = 0;
#ifndef PHM
#define PHM 0xffff
#endif
struct MP { const float* in[N_IN]; float* out; unsigned char* ws; int ph_lo, ph_hi, coop, pad; };

struct MPK {
    const __attribute__((address_space(4))) MP* k;
    struct InArr { const __attribute__((address_space(4))) MP* k; __device__ __forceinline__ const float* operator[](int i) const { return k->in[i]; } };
    __device__ __forceinline__ InArr in_() const { return InArr{k}; }
};
#define PIN(i) (p.k->in[i])
__device__ __forceinline__ unsigned pk2(float lo, float hi) { return (unsigned)f2bf(lo) | ((unsigned)f2bf(hi) << 16); }
struct MapId { int n; __device__ __forceinline__ int operator()(int c) const { return c < n ? c : -1; } };
struct MapIn { __device__ __forceinline__ int operator()(int c) const {
    if (c < 1152) return c; if (c < 1280) return 1426 + (c - 1152); if (c < 1536) return 1170 + (c - 1280); if (c < 2304) return 1586 + (c - 1536);
    if (c < 2336) return 1554 + (c - 2304); if (c < 2354) return 1152 + (c - 2336); if (c < 2362) return c; return -1; } };
struct MapGU { __device__ __forceinline__ int operator()(int c) const { const int t = c >> 8, w = c & 255; return (w < 128) ? t * 128 + w : FF + t * 128 + (w - 128); } };
template <class Map> __device__ __forceinline__ void transpose_item(const float* W, int K, int ldw, const Map& map, const float* kscale, bf16* WT, LAS float* scr, int item, int nblk, int lane) {
    const int kb = item / nblk, nb = item % nblk, k0 = 64 * kb, n0 = 32 * nb;
    const int np = 2 * (lane & 15);
    const int sc = map(n0 + np);
#pragma unroll 8
    for (int i = 0; i < 16; ++i) { const int kk = 4 * i + (lane >> 4); float2 v = (sc >= 0) ? *(const float2*)(W + (size_t)(k0 + kk) * ldw + sc) : make_float2(0.f, 0.f);
        if (kscale) { const float ksc = kscale[k0 + kk]; v.x *= ksc; v.y *= ksc; } scr[kk * 33 + np] = v.x; scr[kk * 33 + np + 1] = v.y; }
    asm volatile("s_waitcnt lgkmcnt(0)" ::: "memory");
    const int c = lane & 7;
#pragma unroll
    for (int j = 0; j < 4; ++j) { const int n = (lane >> 3) + 8 * j; const LAS float* s = scr + (8 * c) * 33 + n;
        v4u o; o.x = pk2(s[0 * 33], s[1 * 33]); o.y = pk2(s[2 * 33], s[3 * 33]); o.z = pk2(s[4 * 33], s[5 * 33]); o.w = pk2(s[6 * 33], s[7 * 33]);
        *(v4u*)(WT + (size_t)(n0 + n) * K + k0 + 8 * c) = o; }
    asm volatile("s_waitcnt lgkmcnt(0)" ::: "memory");
}
__device__ __forceinline__ void norm_row_finish(const float4 (&v)[4], float ssq, const float* g, const float* shift, const float* scale, bf16* hb, float* outf, int mode, int m, int lane) {
    const float rstd = rsqrtf(ssq * (1.f / D_) + EPS);
    const int b = m / S_;
#pragma unroll
    for (int j = 0; j < 4; ++j) {
        const int col = 4 * lane + 256 * j;
        const float4 gg = *(const float4*)(g + col);
        float4 o; o.x = v[j].x * rstd * gg.x; o.y = v[j].y * rstd * gg.y; o.z = v[j].z * rstd * gg.z; o.w = v[j].w * rstd * gg.w;
        if (mode == 2) { *(float4*)(outf + (size_t)m * D_ + col) = o; }
        else {
            const float4 sc = *(const float4*)(scale + (size_t)b * 6144 + col), sh = *(const float4*)(shift + (size_t)b * 6144 + col);
            o.x = o.x * (1.f + sc.x) + sh.x; o.y = o.y * (1.f + sc.y) + sh.y; o.z = o.z * (1.f + sc.z) + sh.z; o.w = o.w * (1.f + sc.w) + sh.w;
            uint2 w; w.x = pk2(o.x, o.y); w.y = pk2(o.z, o.w);
            *(uint2*)(hb + (size_t)m * D_ + col) = w;
        }
    }
}
__device__ __forceinline__ void norm_rows(const float* x, const float* g, const float* shift, const float* scale, bf16* hb, float* outf, int mode, int gw, int ngw, int lane) {
    for (int m = gw; m < T_; m += 2 * ngw) {
        const int m2 = m + ngw;
        const float4* xr = (const float4*)(x + (size_t)m * D_) + lane; const float4* xr2 = (const float4*)(x + (size_t)m2 * D_) + lane;
        float4 v[4], w[4]; float s = 0.f, s2 = 0.f;
#pragma unroll
        for (int j = 0; j < 4; ++j) { v[j] = xr[64 * j]; w[j] = xr2[64 * j]; }
#pragma unroll
        for (int j = 0; j < 4; ++j) { s += v[j].x * v[j].x + v[j].y * v[j].y + v[j].z * v[j].z + v[j].w * v[j].w; s2 += w[j].x * w[j].x + w[j].y * w[j].y + w[j].z * w[j].z + w[j].w * w[j].w; }
        norm_row_finish(v, wave_sum2(s), g, shift, scale, hb, outf, mode, m, lane);
        norm_row_finish(w, wave_sum2(s2), g, shift, scale, hb, outf, mode, m2, lane);
    }
}
__device__ __forceinline__ void ph_p0(const MPK& p, LAS unsigned char* lds, int tid) {
    const int wave = tid >> 6, lane = tid & 63;
    LAS float* ca = (LAS float*)lds; LAS float* red = ca + 8192;
    unsigned char* ws = p.k->ws; float* mod = (float*)(ws + WS_MOD);
    const float* c = PIN(I_C);
    for (int i = tid; i < 8192; i += NTHR) ca[i] = siluf_(c[i]);
    __syncthreads();
    for (int item = blockIdx.x; item < 192; item += gridDim.x) {
        const int l = item / 96, j = (item % 96) * 64 + lane;
        const float* w = PIN(I_WADA) + (size_t)l * 1024 * 6144 + j;
        float acc[8];
#pragma unroll
        for (int b = 0; b < 8; ++b) acc[b] = 0.f;
#pragma unroll 4
        for (int k = wave * 128; k < wave * 128 + 128; ++k) {
            const float wv = w[(size_t)k * 6144];
#pragma unroll
            for (int b = 0; b < 8; ++b) acc[b] += ca[b * 1024 + k] * wv;
        }
#pragma unroll
        for (int b = 0; b < 8; ++b) red[(wave * 8 + b) * 64 + lane] = acc[b];
        __syncthreads();
        { const int b = wave; float s = 0.f;
#pragma unroll
          for (int w8 = 0; w8 < 8; ++w8) s += red[(w8 * 8 + b) * 64 + lane];
          mod[((size_t)l * 8 + b) * 6144 + j] = s + PIN(I_BADA)[l * 6144 + j]; }
        __syncthreads();
    }
    const int* pos = (const int*)PIN(I_POS);
    float *cosP = (float*)(ws + WS_COSP), *sinP = (float*)(ws + WS_SINP), *cosM = (float*)(ws + WS_COSM), *sinM = (float*)(ws + WS_SINM);
    for (int i = blockIdx.x * NTHR + tid; i < T_ * 24; i += gridDim.x * NTHR) {
        const int m = i / 24, f = i % 24;
        double inv; if (f < 8) inv = pow(500000.0, -(double)(2 * f) / 16.0); else inv = pow(500000.0, -(double)(2 * (f - 8)) / 32.0);
        const float ang = (float)pos[m] * (float)inv;
        const double a = (double)ang, kq = rint(a * 0.15915494309189535), r = a - kq * 6.283185307179586476925;
        const float cs = (float)cos(r), sn = (float)sin(r);
        if (f < 8) { cosP[m * 8 + f] = cs; sinP[m * 8 + f] = sn; } else { cosM[m * 16 + f - 8] = cs; sinM[m * 16 + f - 8] = sn; }
    }
}
__device__ __forceinline__ void early_transposes(const MPK& p, int l, LAS unsigned char* lds, int tid, int first) {
    const int wave = tid >> 6, lane = tid & 63;
    if ((int)blockIdx.x < first) return;
    const int gw = ((int)blockIdx.x - first) * NWAVES + wave, ngw = ((int)gridDim.x - first) * NWAVES;
    unsigned char* ws = p.k->ws;
    LAS float* scr = (LAS float*)(lds + wave * 8704);
    constexpr int I0 = 16 * 80, I4 = 4 * 24, I5 = 2 * 24, I6 = 32 * 2, I7 = 32 * 2, I8 = 8, I9 = 8;
    constexpr int NIT = I0 + I4 + I5 + I6 + I7 + I8 + I9;
    for (int it = gw; it < NIT; it += ngw) {
        int r = it;
        if (r < I0) { transpose_item(PIN(I_WIN) + (size_t)l * D_ * DIN, D_, DIN, MapIn{}, nullptr, (bf16*)(ws + WT_IN), scr, r, 80, lane); continue; } r -= I0;
        if (r < I4) { transpose_item(PIN(I_WUQ) + (size_t)l * 256 * 576, 256, 576, MapId{576}, PIN(I_GQL) + l * 256, (bf16*)(ws + WT_UQ), scr, r, 24, lane); continue; } r -= I4;
        if (r < I5) { transpose_item(PIN(I_WUKV) + (size_t)l * 128 * 768, 128, 768, MapId{768}, PIN(I_GKVL) + l * 128, (bf16*)(ws + WT_UKV), scr, r, 24, lane); continue; } r -= I5;
        if (r < I6) { transpose_item(PIN(I_WCK) + (size_t)l * 2048 * 64, 2048, 64, MapId{64}, nullptr, (bf16*)(ws + WT_CK), scr, r, 2, lane); continue; } r -= I6;
        if (r < I7) { transpose_item(PIN(I_WCV) + (size_t)l * 2048 * 64, 2048, 64, MapId{64}, nullptr, (bf16*)(ws + WT_CV), scr, r, 2, lane); continue; } r -= I7;
        if (r < I8) { const int h = r >> 1; transpose_item(PIN(I_WQM) + (size_t)l * 16384 + h * 4096, 64, 64, MapId{64}, nullptr, (bf16*)(ws + WT_QM) + h * 4096, scr, r & 1, 2, lane); continue; } r -= I8;
        { const int h = r >> 1; transpose_item(PIN(I_WKM) + (size_t)l * 16384 + h * 4096, 64, 64, MapId{64}, nullptr, (bf16*)(ws + WT_KM) + h * 4096, scr, r & 1, 2, lane); }
    }
}
__device__ __forceinline__ void ph_prep(const MPK& p, int l, LAS unsigned char* lds, int tid) {
    const int wave = tid >> 6, lane = tid & 63;
    const int gw = blockIdx.x * NWAVES + wave, ngw = gridDim.x * NWAVES;
    unsigned char* ws = p.k->ws;
    LAS float* scr = (LAS float*)(lds + wave * 8704);
    for (int i = blockIdx.x * NTHR + tid; i < 2 * T_; i += gridDim.x * NTHR) ((float*)(ws + WS_SSQL))[i] = 0.f;
    if (l == 0) early_transposes(p, l, lds, tid, 0);
    const float* xin = (l == 0) ? PIN(I_X) : p.k->out;
    const float* modl = (const float*)(ws + WS_MOD) + (size_t)l * 8 * 6144;
    norm_rows(xin, PIN(I_GN1) + l * D_, modl + 0, modl + 1024, (bf16*)(ws + WS_HB), nullptr, 0, gw, ngw, lane);
}
__device__ __forceinline__ void late_transposes(const MPK& p, int l, LAS unsigned char* lds, int tid, int first) {
    const int wave = tid >> 6, lane = tid & 63;
    if ((int)blockIdx.x < first) return;
    const int gw = ((int)blockIdx.x - first) * NWAVES + wave, ngw = ((int)gridDim.x - first) * NWAVES;
    unsigned char* ws = p.k->ws;
    LAS float* scr = (LAS float*)(lds + wave * 8704);
    constexpr int I1 = 16 * 32, I2 = 16 * 176, I3 = 44 * 32;
    for (int it = gw; it < I1 + I2 + I3; it += ngw) {
        int r = it;
        if (r < I1) { transpose_item(PIN(I_WOUT) + (size_t)l * D_ * D_, D_, D_, MapId{D_}, nullptr, (bf16*)(ws + WT_OUT), scr, r, 32, lane); continue; } r -= I1;
        if (r < I2) { transpose_item(PIN(I_WGU) + (size_t)l * D_ * 2 * FF, D_, 2 * FF, MapGU{}, nullptr, (bf16*)(ws + WT_GU), scr, r, 176, lane); continue; } r -= I2;
        transpose_item(PIN(I_WDOWN) + (size_t)l * FF * D_, FF, D_, MapId{D_}, nullptr, (bf16*)(ws + WT_DOWN), scr, r, 32, lane);
    }
}
__device__ __forceinline__ void ph_mixnorm(const MPK& p, int l, int tid) {
    const int gw = blockIdx.x * NWAVES + (tid >> 6), ngw = gridDim.x * NWAVES, lane = tid & 63;
    unsigned char* ws = p.k->ws;
    bf16* mix = (bf16*)(ws + WS_HB); const float* ga = PIN(I_GOA) + l * 384; const float* gb = PIN(I_GOB) + l * 384;
    const bf16 *oc = (const bf16*)(ws + WS_OCMP), *os = (const bf16*)(ws + WS_OSLC), *ow = (const bf16*)(ws + WS_OWIN); const float* gm = (const float*)(ws + WS_GM);
#define UNPK8(dst, src) dst[0] = __uint_as_float(src.x << 16); dst[1] = __uint_as_float(src.x & 0xffff0000u); dst[2] = __uint_as_float(src.y << 16); dst[3] = __uint_as_float(src.y & 0xffff0000u); \
    dst[4] = __uint_as_float(src.z << 16); dst[5] = __uint_as_float(src.z & 0xffff0000u); dst[6] = __uint_as_float(src.w << 16); dst[7] = __uint_as_float(src.w & 0xffff0000u);
    for (int m = gw; m < T_; m += ngw) {
        bf16* r = mix + (size_t)m * D_;
        float v0[8], v1[8]; float sa = 0.f, sb = 0.f;
        if (lane < 48) {
            const size_t o = (size_t)m * 384 + lane * 8; const float* g3 = gm + (size_t)m * 32 + 3 * (lane >> 3);
            const float g0 = g3[0], g1 = g3[1], g2 = g3[2];
            const v4u c4 = *(const v4u*)(oc + o), s4 = *(const v4u*)(os + o), w4 = *(const v4u*)(ow + o);
            float c8[8], s8[8], w8[8]; UNPK8(c8, c4) UNPK8(s8, s4) UNPK8(w8, w4)
#pragma unroll
            for (int i = 0; i < 8; ++i) { v0[i] = g0 * c8[i] + g1 * s8[i] + g2 * w8[i]; sa += v0[i] * v0[i]; }
        } else {
            const v4u y4 = *(const v4u*)(r + 384 + (lane - 48) * 8); UNPK8(v0, y4)
#pragma unroll
            for (int i = 0; i < 8; ++i) sb += v0[i] * v0[i];
        }
        if (lane < 32) { const v4u y4 = *(const v4u*)(r + 384 + (16 + lane) * 8); UNPK8(v1, y4)
#pragma unroll
            for (int i = 0; i < 8; ++i) sb += v1[i] * v1[i]; }
        const float ra = rsqrtf(wave_sum2(sa) * (1.f / 384.f) + EPS), rb = rsqrtf(wave_sum2(sb) * (1.f / 384.f) + EPS);
        {
            const int col = (lane < 48) ? lane * 8 : 384 + (lane - 48) * 8; const float* gg = (lane < 48) ? ga + lane * 8 : gb + (lane - 48) * 8; const float rr = (lane < 48) ? ra : rb;
            const float4 g0 = *(const float4*)gg, g1 = *(const float4*)(gg + 4);
            v4u w; w.x = pk2(v0[0] * rr * g0.x, v0[1] * rr * g0.y); w.y = pk2(v0[2] * rr * g0.z, v0[3] * rr * g0.w); w.z = pk2(v0[4] * rr * g1.x, v0[5] * rr * g1.y); w.w = pk2(v0[6] * rr * g1.z, v0[7] * rr * g1.w);
            *(v4u*)(r + col) = w;
        }
        if (lane < 32) { const float* gg = gb + (16 + lane) * 8; const float4 g0 = *(const float4*)gg, g1 = *(const float4*)(gg + 4);
            v4u w; w.x = pk2(v1[0] * rb * g0.x, v1[1] * rb * g0.y); w.y = pk2(v1[2] * rb * g0.z, v1[3] * rb * g0.w); w.z = pk2(v1[4] * rb * g1.x, v1[5] * rb * g1.y); w.w = pk2(v1[6] * rb * g1.z, v1[7] * rb * g1.w);
            *(v4u*)(r + 384 + (16 + lane) * 8) = w; }
    }
#undef UNPK8
}


typedef short bf16x8 __attribute__((ext_vector_type(8)));
typedef short s16x4 __attribute__((ext_vector_type(4)));
typedef float f32x16 __attribute__((ext_vector_type(16)));
typedef unsigned u32x2v __attribute__((ext_vector_type(2)));
constexpr int AT_BUF = 20480, AT_K32 = 8192, AT_V = 12288;
__device__ __forceinline__ unsigned cvtpk(float lo, float hi) { unsigned r; asm volatile("v_cvt_pk_bf16_f32 %0, %1, %2" : "=v"(r) : "v"(lo), "v"(hi)); return r; }
__device__ __forceinline__ float max3f(float a, float b, float c) { float r; asm("v_max3_f32 %0, %1, %2, %3" : "=v"(r) : "v"(a), "v"(b), "v"(c)); return r; }
__device__ __forceinline__ int crow(int r, int hi) { return (r & 3) + 8 * (r >> 2) + 4 * hi; }
__device__ __forceinline__ s16x4 vtr(LAS const unsigned char* p) { return __builtin_bit_cast(s16x4, __builtin_amdgcn_ds_read_tr16_b64_v4i16((LAS s16x4*)p)); }
enum { AM_CAUSAL = 0, AM_WINDOW = 1, AM_SLC = 2 };
struct AttnState { float m, l; f32x16 o[2]; f32x16 negm; bool started; long long twait; };
template <int NC> struct TileRegs { v4u k; v4u k2; v4u v; };
template <int NC> __device__ __forceinline__ void at_load(TileRegs<NC>& r, const bf16* Kg, int ldk, const bf16* Vg, int ldv, const bf16* K2g, int ldk2, int tile, int tid) {
    const int key = tid >> 3, c = tid & 7;
    r.k = *(const v4u*)(Kg + (size_t)(tile * 64 + key) * ldk + 8 * c);
    r.v = *(const v4u*)(Vg + (size_t)(tile * 64 + key) * ldv + 8 * c);
    if (NC == 6) { if (tid < 256) r.k2 = *(const v4u*)(K2g + (size_t)(tile * 64 + (tid >> 2)) * ldk2 + 8 * (tid & 3)); }
}
template <int NC> __device__ __forceinline__ void at_store(const TileRegs<NC>& r, LAS unsigned char* buf, int tid) {
    const int key = tid >> 3, c = tid & 7;
    *(LAS v4u*)(buf + key * 128 + 16 * (c ^ ((key >> 1) & 7))) = r.k;
    *(LAS v4u*)(buf + AT_V + (c >> 2) * 4096 + key * 64 + (c & 3) * 16) = r.v;
    if (NC == 6) { if (tid < 256) { const int k2 = tid >> 2, c2 = tid & 3; *(LAS v4u*)(buf + AT_K32 + k2 * 64 + 16 * (c2 ^ ((k2 >> 2) & 3))) = r.k2; } }
}
template <int NC> __device__ __forceinline__ void qk_tile(f32x16& p0, f32x16& p1, LAS const unsigned char* buf, const bf16x8 (&qf)[NC], const f32x16& negm, int lane) {
    const int r32 = lane & 31, hi = lane >> 5;
    p0 = negm; p1 = negm;
#pragma unroll
    for (int cc = 0; cc < NC; ++cc) {
        bf16x8 k0, k1;
        if (cc < 4) { const int k0r = r32, k1r = 32 + r32;
            k0 = *(LAS const bf16x8*)(buf + k0r * 128 + 16 * ((2 * cc + hi) ^ ((k0r >> 1) & 7)));
            k1 = *(LAS const bf16x8*)(buf + k1r * 128 + 16 * ((2 * cc + hi) ^ ((k1r >> 1) & 7))); }
        else { const int k0r = r32, k1r = 32 + r32, c2 = 2 * (cc - 4) + hi;
            k0 = *(LAS const bf16x8*)(buf + AT_K32 + k0r * 64 + 16 * (c2 ^ ((k0r >> 2) & 3)));
            k1 = *(LAS const bf16x8*)(buf + AT_K32 + k1r * 64 + 16 * (c2 ^ ((k1r >> 2) & 3))); }
        p0 = __builtin_amdgcn_mfma_f32_32x32x16_bf16(k0, qf[cc], p0, 0, 0, 0);
        p1 = __builtin_amdgcn_mfma_f32_32x32x16_bf16(k1, qf[cc], p1, 0, 0, 0);
    }
}
template <int MODE> __device__ __forceinline__ void mask_tile(f32x16& p0, f32x16& p1, int kpos0, int qpos, bool need_mask, bool sel_ok, int lane) {
    const int hi = lane >> 5;
    if (need_mask) {
        const int qw0m = __builtin_amdgcn_readfirstlane(qpos) & ~31;
        const bool diag = (kpos0 + 63 > qw0m), old = (MODE == AM_WINDOW) && (kpos0 < qw0m + 31 - 511);
        if (diag || old) {
            const float selterm = (MODE == AM_SLC && !sel_ok) ? -INFINITY : INFINITY;
            const int dbase = qpos - kpos0 - 4 * hi;
#pragma unroll
            for (int r = 0; r < 16; ++r) {
                const int d0 = dbase - ((r & 3) + 8 * (r >> 2)), d1 = d0 - 32;
                float l0 = ((float)d0 + 0.5f) * INFINITY, l1 = ((float)d1 + 0.5f) * INFINITY;
                if (MODE == AM_WINDOW) { l0 = fminf(l0, ((float)(511 - d0) + 0.5f) * INFINITY); l1 = fminf(l1, ((float)(511 - d1) + 0.5f) * INFINITY); }
                if (MODE == AM_SLC) { l0 = fminf(l0, selterm); l1 = fminf(l1, selterm); }
                p0[r] = fminf(p0[r], l0); p1[r] = fminf(p1[r], l1);
            }
        } else if (MODE == AM_SLC) {
            const float selterm = sel_ok ? INFINITY : -INFINITY;
#pragma unroll
            for (int r = 0; r < 16; ++r) { p0[r] = fminf(p0[r], selterm); p1[r] = fminf(p1[r], selterm); }
        }
    }
}
template <int MODE> __device__ __forceinline__ void softmax_tile(AttnState& st, f32x16& p0, f32x16& p1, bf16x8 (&pf)[4], int kpos0, int qpos, bool need_mask, bool sel_ok, int lane) {
    mask_tile<MODE>(p0, p1, kpos0, qpos, need_mask, sel_ok, lane);
    float mx = max3f(p0[0], p1[0], p0[1]), mx2 = max3f(p1[1], p0[2], p1[2]);
#pragma unroll
    for (int r = 3; r < 15; r += 2) { mx = max3f(mx, p0[r], p1[r]); mx2 = max3f(mx2, p0[r + 1], p1[r + 1]); }
    mx = max3f(mx, p0[15], p1[15]); mx = max3f(mx, mx2, mx2);
    mx = red32_max(mx);
    if (!st.started || __any(mx > 0.f)) {
        float dl = st.started ? fmaxf(mx, 0.f) : mx;
        dl = (dl > -1e30f) ? dl : 0.f;
        st.started = true;
        const float alpha = __builtin_amdgcn_exp2f(-dl);
        st.m += dl; st.l *= alpha;
#pragma unroll
        for (int r = 0; r < 16; ++r) { st.o[0][r] *= alpha; st.o[1][r] *= alpha; p0[r] -= dl; p1[r] -= dl; st.negm[r] = -st.m; }
    }
    float sum = 0.f;
#pragma unroll
    for (int r = 0; r < 16; ++r) { p0[r] = __builtin_amdgcn_exp2f(p0[r]); p1[r] = __builtin_amdgcn_exp2f(p1[r]); sum += p0[r] + p1[r]; }
    st.l += sum;
#pragma unroll
    for (int s2 = 0; s2 < 2; ++s2) {
        v4u a, b;
        a.x = cvtpk(p0[8 * s2 + 0], p0[8 * s2 + 1]); a.y = cvtpk(p0[8 * s2 + 2], p0[8 * s2 + 3]); a.z = cvtpk(p0[8 * s2 + 4], p0[8 * s2 + 5]); a.w = cvtpk(p0[8 * s2 + 6], p0[8 * s2 + 7]);
        b.x = cvtpk(p1[8 * s2 + 0], p1[8 * s2 + 1]); b.y = cvtpk(p1[8 * s2 + 2], p1[8 * s2 + 3]); b.z = cvtpk(p1[8 * s2 + 4], p1[8 * s2 + 5]); b.w = cvtpk(p1[8 * s2 + 6], p1[8 * s2 + 7]);
        pf[s2] = __builtin_bit_cast(bf16x8, a); pf[2 + s2] = __builtin_bit_cast(bf16x8, b);
    }
}
struct TileFlags { bool skip, need_mask, sel_ok; };
__device__ __forceinline__ void pack_p(bf16x8 (&pf)[4], const f32x16& p0, const f32x16& p1) {
#pragma unroll
    for (int s2 = 0; s2 < 2; ++s2) {
        v4u a, b;
        a.x = cvtpk(p0[8 * s2 + 0], p0[8 * s2 + 1]); a.y = cvtpk(p0[8 * s2 + 2], p0[8 * s2 + 3]); a.z = cvtpk(p0[8 * s2 + 4], p0[8 * s2 + 5]); a.w = cvtpk(p0[8 * s2 + 6], p0[8 * s2 + 7]);
        b.x = cvtpk(p1[8 * s2 + 0], p1[8 * s2 + 1]); b.y = cvtpk(p1[8 * s2 + 2], p1[8 * s2 + 3]); b.z = cvtpk(p1[8 * s2 + 4], p1[8 * s2 + 5]); b.w = cvtpk(p1[8 * s2 + 6], p1[8 * s2 + 7]);
        pf[s2] = __builtin_bit_cast(bf16x8, a); pf[2 + s2] = __builtin_bit_cast(bf16x8, b);
    }
}
template <int MODE> __device__ __forceinline__ void softmax_pair(AttnState& st, f32x16& a0, f32x16& a1, f32x16& b0, f32x16& b1, int kpos0, int qpos, const TileFlags& fa, const TileFlags& fb, int lane) {
    mask_tile<MODE>(a0, a1, kpos0, qpos, fa.need_mask, fa.sel_ok, lane);
    mask_tile<MODE>(b0, b1, kpos0 + 64, qpos, fb.need_mask, fb.sel_ok, lane);
    float mx = max3f(a0[0], a1[0], b0[0]), mx2 = max3f(b1[0], a0[1], a1[1]);
#pragma unroll
    for (int r = 1; r < 16; ++r) { mx = max3f(mx, b0[r], b1[r]); if (r > 1) mx2 = max3f(mx2, a0[r], a1[r]); }
    mx = max3f(mx, mx2, mx2);
    mx = red32_max(mx);
    if (!st.started || __any(mx > 0.f)) {
        float dl = st.started ? fmaxf(mx, 0.f) : mx;
        dl = (dl > -1e30f) ? dl : 0.f;
        st.started = true;
        const float alpha = __builtin_amdgcn_exp2f(-dl);
        st.m += dl; st.l *= alpha;
#pragma unroll
        for (int r = 0; r < 16; ++r) { st.o[0][r] *= alpha; st.o[1][r] *= alpha; a0[r] -= dl; a1[r] -= dl; b0[r] -= dl; b1[r] -= dl; st.negm[r] = -st.m; }
    }
    float sum = 0.f;
#pragma unroll
    for (int r = 0; r < 16; ++r) { a0[r] = __builtin_amdgcn_exp2f(a0[r]); a1[r] = __builtin_amdgcn_exp2f(a1[r]); b0[r] = __builtin_amdgcn_exp2f(b0[r]); b1[r] = __builtin_amdgcn_exp2f(b1[r]); sum += (a0[r] + a1[r]) + (b0[r] + b1[r]); }
    st.l += sum;
}
__device__ __forceinline__ void pv_tile(AttnState& st, LAS const unsigned char* buf, const bf16x8 (&pf)[4], int lane) {
    const int hi = lane >> 5;
    const unsigned vb = (unsigned)(uintptr_t)(buf + AT_V + (4 * hi + ((lane & 15) >> 2)) * 64 + ((lane >> 4) & 1) * 32 + (lane & 3) * 8);
#pragma unroll
    for (int dh = 0; dh < 2; ++dh) {
        s16x4 lo[4], hh[4];
#pragma unroll
        for (int s4 = 0; s4 < 4; ++s4) {
            asm volatile("ds_read_b64_tr_b16 %0, %1 offset:%c2" : "=&v"(lo[s4]) : "v"(vb), "i"(dh * 4096 + s4 * 1024) : "memory");
            asm volatile("ds_read_b64_tr_b16 %0, %1 offset:%c2" : "=&v"(hh[s4]) : "v"(vb), "i"(dh * 4096 + s4 * 1024 + 512) : "memory");
        }
        asm volatile("s_waitcnt lgkmcnt(0)" : "+v"(lo[0]), "+v"(lo[1]), "+v"(lo[2]), "+v"(lo[3]), "+v"(hh[0]), "+v"(hh[1]), "+v"(hh[2]), "+v"(hh[3]) :: "memory");
#pragma unroll
        for (int s4 = 0; s4 < 4; ++s4) {
            const bf16x8 vf = {lo[s4][0], lo[s4][1], lo[s4][2], lo[s4][3], hh[s4][0], hh[s4][1], hh[s4][2], hh[s4][3]};
            st.o[dh] = __builtin_amdgcn_mfma_f32_32x32x16_bf16(vf, pf[s4], st.o[dh], 0, 0, 0);
        }
    }
}
template <int MODE> __device__ __forceinline__ TileFlags tile_flags(int t, int qw0, unsigned selbits) {
    const int k0 = t * 64; TileFlags f;
    f.skip = k0 > qw0 + 31; f.need_mask = (k0 + 63 > qw0); f.sel_ok = true;
    if (MODE == AM_WINDOW) { f.skip = f.skip || (k0 + 63 < qw0 - 511); f.need_mask = f.need_mask || (k0 < qw0 + 31 - 511); }
    if (MODE == AM_SLC) { f.sel_ok = (selbits >> t) & 1u; const unsigned long long bal = __ballot(f.sel_ok); f.skip = f.skip || (bal == 0ull); f.need_mask = f.need_mask || (bal != ~0ull); }
    return f;
}
struct DmaOff { unsigned k, v, k2; };
template <int NC> __device__ __forceinline__ DmaOff at_dma_off(int ldk, int ldv, int ldk2, int wave, int lane) {
    const int L = wave * 64 + lane; DmaOff o;
    { const int key = L >> 3, c = (L & 7) ^ ((key >> 1) & 7); o.k = (unsigned)(key * ldk + 8 * c) * 2u; }
    { const int key = (L >> 2) & 63, c = (L >> 8) * 4 + (L & 3); o.v = (unsigned)(key * ldv + 8 * c) * 2u; }
    { const int key = (L >> 2) & 63, c2 = (L & 3) ^ ((key >> 2) & 3); o.k2 = (unsigned)(key * ldk2 + 8 * c2) * 2u; }
    return o;
}
template <int NC> __device__ __forceinline__ void at_dma(const DmaOff& o, const bf16* Kg, int ldk, const bf16* Vg, int ldv, const bf16* K2g, int ldk2, int tile, LAS unsigned char* slot, int wave) {
    __builtin_amdgcn_global_load_lds((const unsigned*)((const char*)(Kg + (size_t)tile * 64 * ldk) + o.k), (LAS unsigned*)(slot + wave * 1024), 16, 0, 0);
    __builtin_amdgcn_global_load_lds((const unsigned*)((const char*)(Vg + (size_t)tile * 64 * ldv) + o.v), (LAS unsigned*)(slot + AT_V + wave * 1024), 16, 0, 0);
    if (NC == 6) { if (wave < 4) __builtin_amdgcn_global_load_lds((const unsigned*)((const char*)(K2g + (size_t)tile * 64 * ldk2) + o.k2), (LAS unsigned*)(slot + AT_K32 + wave * 1024), 16, 0, 0); }
}
__device__ __forceinline__ void at_wait_bar(int keep) {
    if (keep == 0) asm volatile("s_waitcnt vmcnt(0) lgkmcnt(0)" ::: "memory");
    else if (keep == 4) asm volatile("s_waitcnt vmcnt(4) lgkmcnt(0)" ::: "memory");
    else asm volatile("s_waitcnt vmcnt(6) lgkmcnt(0)" ::: "memory");
    __builtin_amdgcn_s_barrier();
    asm volatile("" ::: "memory");
}
template <int NC, int MODE> __device__ __forceinline__ void at_stream(AttnState& st, LAS unsigned char* lds, const bf16* Kg, int ldk, const bf16* Vg, int ldv, const bf16* K2g, int ldk2, int t0, int t1,
                                                                       const bf16x8 (&qf)[NC], int qpos, int qw0, unsigned selbits, int tid) {
    const int lane = tid & 63, wave = __builtin_amdgcn_readfirstlane(tid >> 6), np = (t1 - t0) >> 1;
    const int nper2 = (NC == 6 && wave < 4) ? 6 : 4;
    const DmaOff dof = at_dma_off<NC>(ldk, ldv, ldk2, wave, lane);
    at_dma<NC>(dof, Kg, ldk, Vg, ldv, K2g, ldk2, t0, lds, wave); at_dma<NC>(dof, Kg, ldk, Vg, ldv, K2g, ldk2, t0 + 1, lds + AT_BUF, wave);
    if (np > 1) { at_dma<NC>(dof, Kg, ldk, Vg, ldv, K2g, ldk2, t0 + 2, lds + 2 * AT_BUF, wave); at_dma<NC>(dof, Kg, ldk, Vg, ldv, K2g, ldk2, t0 + 3, lds + 3 * AT_BUF, wave); }
    at_wait_bar(np > 1 ? nper2 : 0);
    int s0 = 0, s1 = 2 * AT_BUF, s2 = 4 * AT_BUF;
    for (int j = 0; j < np; ++j) {
        const int t = t0 + 2 * j; const bool has_2 = (j + 2 < np);
        if (has_2) { at_dma<NC>(dof, Kg, ldk, Vg, ldv, K2g, ldk2, t + 4, lds + s2, wave); at_dma<NC>(dof, Kg, ldk, Vg, ldv, K2g, ldk2, t + 5, lds + s2 + AT_BUF, wave); }
        const TileFlags fa = tile_flags<MODE>(t, qw0, selbits), fb = tile_flags<MODE>(t + 1, qw0, selbits);
        if (!fa.skip && !fb.skip) {
            f32x16 a0, a1, b0, b1; bf16x8 pf[4];
            qk_tile<NC>(a0, a1, lds + s0, qf, st.negm, lane);
            qk_tile<NC>(b0, b1, lds + s0 + AT_BUF, qf, st.negm, lane);
            softmax_pair<MODE>(st, a0, a1, b0, b1, t * 64, qpos, fa, fb, lane);
            pack_p(pf, a0, a1); pv_tile(st, lds + s0, pf, lane);
            pack_p(pf, b0, b1); pv_tile(st, lds + s0 + AT_BUF, pf, lane);
        } else {
            if (!fa.skip) { f32x16 p0, p1; bf16x8 pf[4]; qk_tile<NC>(p0, p1, lds + s0, qf, st.negm, lane); softmax_tile<MODE>(st, p0, p1, pf, t * 64, qpos, fa.need_mask, fa.sel_ok, lane); pv_tile(st, lds + s0, pf, lane); }
            if (!fb.skip) { f32x16 p0, p1; bf16x8 pf[4]; qk_tile<NC>(p0, p1, lds + s0 + AT_BUF, qf, st.negm, lane); softmax_tile<MODE>(st, p0, p1, pf, (t + 1) * 64, qpos, fb.need_mask, fb.sel_ok, lane); pv_tile(st, lds + s0 + AT_BUF, pf, lane); }
        }
        at_wait_bar(has_2 ? nper2 : 0);
        const int tmp = s0; s0 = s1; s1 = s2; s2 = tmp;
    }
}
__device__ __forceinline__ int next_item_q(unsigned* ctrs, LAS unsigned char* lds, int wave_u, int count, int q0, int& kstart) {
    const int tid = wave_u * 64 + fresh_lane();
    LAS int* slot = (LAS int*)(lds + RING_BYTES + 64);
    if (tid == 0) {
        int r = -1, k = kstart;
        for (; k < 8; ++k) { const int q = (q0 + k) & 7; const unsigned v = atomicAdd(ctrs + q * 16, 1u); if (v < (unsigned)count) { r = (q << 16) | (int)v; break; } }
        slot[0] = r; slot[1] = k;
    }
    __syncthreads();
    const int v = slot[0]; kstart = slot[1];
    __syncthreads();
    return v;
}
__device__ __forceinline__ void mla_unit(unsigned char* ws, LAS unsigned char* lds, int b, int h, int qt, int wave_u) {
    const int tid = wave_u * 64 + fresh_lane();
    const int lane = tid & 63, wave = tid >> 6, r32 = lane & 31, hi = lane >> 5;
    const int qw0 = qt * 256 + wave * 32, qpos = qw0 + r32; const size_t row = (size_t)b * S_ + qpos;
    const long long tq0 = (PROBE_SEL != 0) ? (long long)__builtin_amdgcn_s_memtime() : 0ll;
    bf16x8 qf[6];
    {
        const bf16* qp = (const bf16*)(ws + WS_OSLC) + row * 768 + h * 96 + 8 * hi;
        v4u raw[6];
#pragma unroll
        for (int cc = 0; cc < 6; ++cc) raw[cc] = *(const v4u*)(qp + 16 * cc);
        float msc = MSCALE; asm volatile("" : "+v"(msc));
        const float rs = rsqrtf(((const float*)(ws + WS_SSQL))[row] * (1.f / 256.f) + EPS) * msc;
        const float* cm_ = (const float*)(ws + WS_COSM) + row * 16 + 8 * hi; const float* sm_ = (const float*)(ws + WS_SINM) + row * 16 + 8 * hi;
#define UNPKQ(dst, src) dst[0] = __uint_as_float(src.x << 16); dst[1] = __uint_as_float(src.x & 0xffff0000u); dst[2] = __uint_as_float(src.y << 16); dst[3] = __uint_as_float(src.y & 0xffff0000u); \
        dst[4] = __uint_as_float(src.z << 16); dst[5] = __uint_as_float(src.z & 0xffff0000u); dst[6] = __uint_as_float(src.w << 16); dst[7] = __uint_as_float(src.w & 0xffff0000u);
#pragma unroll
        for (int cc = 0; cc < 4; ++cc) { float f[8]; UNPKQ(f, raw[cc])
            v4u w; w.x = cvtpk(f[0] * rs, f[1] * rs); w.y = cvtpk(f[2] * rs, f[3] * rs); w.z = cvtpk(f[4] * rs, f[5] * rs); w.w = cvtpk(f[6] * rs, f[7] * rs); qf[cc] = __builtin_bit_cast(bf16x8, w); }
        { float x1[8], x2[8], o1[8], o2[8]; UNPKQ(x1, raw[4]) UNPKQ(x2, raw[5])
#pragma unroll
          for (int j = 0; j < 8; ++j) { const float cs = cm_[j] * rs, sn = sm_[j] * rs; o1[j] = x1[j] * cs - x2[j] * sn; o2[j] = x1[j] * sn + x2[j] * cs; }
          v4u w; w.x = cvtpk(o1[0], o1[1]); w.y = cvtpk(o1[2], o1[3]); w.z = cvtpk(o1[4], o1[5]); w.w = cvtpk(o1[6], o1[7]); qf[4] = __builtin_bit_cast(bf16x8, w);
          w.x = cvtpk(o2[0], o2[1]); w.y = cvtpk(o2[2], o2[3]); w.z = cvtpk(o2[4], o2[5]); w.w = cvtpk(o2[6], o2[7]); qf[5] = __builtin_bit_cast(bf16x8, w); }
#undef UNPKQ
    }
    const long long tq1 = (PROBE_SEL != 0) ? (long long)__builtin_amdgcn_s_memtime() : 0ll;
    AttnState st; st.m = 0.f; st.l = 0.f; st.o[0] = f32x16{}; st.o[1] = f32x16{}; st.negm = f32x16{}; st.started = false; st.twait = 0;
    const bf16* kvb = (const bf16*)(ws + WS_KVM) + (size_t)b * S_ * 768 + h * 128;
    at_stream<6, AM_CAUSAL>(st, lds, kvb, 768, kvb + 64, 768, (const bf16*)(ws + WS_KR) + (size_t)b * S_ * 32, 32, 0, 4 * qt + 4, qf, qpos, qw0, 0u, tid);
    if (PROBE_SEL >= 1 && PROBE_SEL <= 3 && b == 0 && h == 0 && qt == 7 && tid == 0) { const long long tq2 = (long long)__builtin_amdgcn_s_memtime();
        ((float*)(ws + WS_CTL))[100] = (PROBE_SEL == 1) ? (float)(tq2 - tq1) : (PROBE_SEL == 2) ? (float)st.twait : (float)(tq1 - tq0); }
    const float lt = red32_sum(st.l), il = 1.f / lt;
    bf16* op = (bf16*)(ws + WS_HB) + row * D_ + 384 + h * 64 + 4 * hi;
#pragma unroll
    for (int dh = 0; dh < 2; ++dh)
#pragma unroll
        for (int g4 = 0; g4 < 4; ++g4) { u32x2v w; w.x = cvtpk(st.o[dh][4 * g4] * il, st.o[dh][4 * g4 + 1] * il); w.y = cvtpk(st.o[dh][4 * g4 + 2] * il, st.o[dh][4 * g4 + 3] * il);
            *(u32x2v*)(op + dh * 32 + 8 * g4) = w; }
}
template <int MODE> __device__ __forceinline__ void nsa_branch_unit(unsigned char* ws, LAS unsigned char* lds, int b, int h, int qt, int wave_u) {
    const int tid = wave_u * 64 + fresh_lane();
    const int lane = tid & 63, wave = tid >> 6, r32 = lane & 31, hi = lane >> 5, g = h / 3;
    const int qw0 = qt * 256 + wave * 32, qpos = qw0 + r32; const size_t row = (size_t)b * S_ + qpos;
    const bf16* nsa = (const bf16*)(ws + WS_NSA);
    const bf16* qp = nsa + row * 1152 + h * 64 + 8 * hi;
    bf16x8 qf[4];
#pragma unroll
    for (int cc = 0; cc < 4; ++cc) qf[cc] = *(const bf16x8*)(qp + 16 * cc);
    unsigned selbits = 0u; if (MODE == AM_SLC) selbits = ((const unsigned*)(ws + WS_SEL))[(size_t)(b * 2 + g) * S_ + qpos];
    const bf16* kb = nsa + (size_t)b * S_ * 1152 + g * 64 + (MODE == AM_SLC ? 640 : 896);
    AttnState st; st.m = 0.f; st.l = 0.f; st.o[0] = f32x16{}; st.o[1] = f32x16{}; st.negm = f32x16{}; st.started = false; st.twait = 0;
    const long long tn0 = (PROBE_SEL != 0) ? (long long)__builtin_amdgcn_s_memtime() : 0ll;
    const int t0 = (MODE == AM_SLC) ? 0 : ((4 * qt - 8 > 0) ? 4 * qt - 8 : 0);
    at_stream<4, MODE>(st, lds, kb, 1152, kb + 128, 1152, nullptr, 0, t0, 4 * qt + 4, qf, qpos, qw0, selbits, tid);
    if (PROBE_SEL >= 4 && PROBE_SEL <= 5 && MODE == AM_SLC && b == 0 && h == 0 && qt == 7 && tid == 0) { const long long tn1 = (long long)__builtin_amdgcn_s_memtime();
        ((float*)(ws + WS_CTL))[100] = (PROBE_SEL == 4) ? (float)(tn1 - tn0) : (float)st.twait; }
    const float lt = red32_sum(st.l), il = 1.f / lt;
    bf16* op = (bf16*)(ws + (MODE == AM_SLC ? WS_OSLC : WS_OWIN)) + row * 384 + h * 64 + 4 * hi;
#pragma unroll
    for (int dh = 0; dh < 2; ++dh)
#pragma unroll
        for (int g4 = 0; g4 < 4; ++g4) { u32x2v w; w.x = cvtpk(st.o[dh][4 * g4] * il, st.o[dh][4 * g4 + 1] * il); w.y = cvtpk(st.o[dh][4 * g4 + 2] * il, st.o[dh][4 * g4 + 3] * il);
            *(u32x2v*)(op + dh * 32 + 8 * g4) = w; }
}
__device__ __forceinline__ void cmp_unit(unsigned char* ws, LAS unsigned char* lds, int b, int g, int qt, int wave_u) {
    const int tid = wave_u * 64 + fresh_lane();
    const int lane = tid & 63, wave = tid >> 6, r32 = lane & 31, hi = lane >> 5;
    const int qpos = qt * 256 + wave * 32 + r32; const size_t row = (size_t)b * S_ + qpos;
    const bf16* kc = (const bf16*)(ws + WS_KCV) + (size_t)(b * 2 + g) * 128 * 64; const bf16* vc = kc + (size_t)8 * 2 * 128 * 64;
    { TileRegs<4> tr; at_load<4>(tr, kc, 64, vc, 64, nullptr, 0, 0, tid); at_store<4>(tr, lds, tid); at_load<4>(tr, kc, 64, vc, 64, nullptr, 0, 1, tid); at_store<4>(tr, lds + AT_BUF, tid); }
    __syncthreads();
    int nvis = (qpos >= 31) ? ((qpos - 31) >> 4) + 1 : 0; if (nvis > 127) nvis = 127;
    LAS float* IG = (LAS float*)(lds + 2 * AT_BUF) + wave * (32 * 33) + r32 * 33;
    LAS float* IL = IG + 8 * 32 * 33;
    const bf16* nsa = (const bf16*)(ws + WS_NSA);
    LAS const unsigned char* vb = lds + AT_V + (4 * hi + ((lane & 15) >> 2)) * 64 + ((lane >> 4) & 1) * 32 + (lane & 3) * 8;
    for (int r3 = 0; r3 < 3; ++r3) {
        const int h = 3 * g + r3;
        const bf16* qp = nsa + row * 1152 + h * 64 + 8 * hi;
        bf16x8 qf[4];
#pragma unroll
        for (int cc = 0; cc < 4; ++cc) qf[cc] = *(const bf16x8*)(qp + 16 * cc);
        f32x16 p[4];
#pragma unroll
        for (int tb = 0; tb < 4; ++tb) {
            LAS const unsigned char* buf = lds + (tb >> 1) * AT_BUF; const int kr = (tb & 1) * 32 + r32;
            p[tb] = f32x16{};
#pragma unroll
            for (int cc = 0; cc < 4; ++cc) { const bf16x8 kf = *(LAS const bf16x8*)(buf + kr * 128 + 16 * ((2 * cc + hi) ^ ((kr >> 1) & 7)));
                p[tb] = __builtin_amdgcn_mfma_f32_32x32x16_bf16(kf, qf[cc], p[tb], 0, 0, 0); }
        }
        float mx = -1e30f;
#pragma unroll
        for (int tb = 0; tb < 4; ++tb)
#pragma unroll
            for (int r = 0; r < 16; ++r) { const int n = 32 * tb + crow(r, hi); p[tb][r] = fminf(p[tb][r], ((float)(nvis - n) - 0.5f) * INFINITY); mx = fmaxf(mx, p[tb][r]); }
        mx = red32_max(mx);
        float sum = 0.f;
#pragma unroll
        for (int tb = 0; tb < 4; ++tb)
#pragma unroll
            for (int r = 0; r < 16; ++r) { p[tb][r] = __builtin_amdgcn_exp2f(p[tb][r] - mx); sum += p[tb][r]; }
        sum = red32_sum(sum);
        const float il = (nvis > 0) ? 1.f / sum : 0.f;
#pragma unroll
        for (int tb = 0; tb < 4; ++tb)
#pragma unroll
            for (int k = 0; k < 4; ++k) { const float a0 = p[tb][4 * k] * il, a1 = p[tb][4 * k + 1] * il, a2 = p[tb][4 * k + 2] * il, a3 = p[tb][4 * k + 3] * il;
                const int j = 2 * (4 * tb + k) + hi;
                const float gs = (a0 + a1) + (a2 + a3);
                if (r3 == 0) { IG[j] = gs; IL[j + 1] = a3; } else { IG[j] += gs; IL[j + 1] += a3; } }
        f32x16 o[2] = {f32x16{}, f32x16{}};
#pragma unroll
        for (int tb = 0; tb < 4; ++tb)
#pragma unroll
            for (int s2 = 0; s2 < 2; ++s2) {
                v4u a; a.x = cvtpk(p[tb][8 * s2 + 0], p[tb][8 * s2 + 1]); a.y = cvtpk(p[tb][8 * s2 + 2], p[tb][8 * s2 + 3]); a.z = cvtpk(p[tb][8 * s2 + 4], p[tb][8 * s2 + 5]); a.w = cvtpk(p[tb][8 * s2 + 6], p[tb][8 * s2 + 7]);
                const bf16x8 pf = __builtin_bit_cast(bf16x8, a);
                LAS const unsigned char* vbb = vb + (tb >> 1) * AT_BUF + ((tb & 1) * 2 + s2) * 1024;
#pragma unroll
                for (int dh = 0; dh < 2; ++dh) { const s16x4 lo = vtr(vbb + dh * 4096), hh = vtr(vbb + dh * 4096 + 512);
                    const bf16x8 vf = {lo[0], lo[1], lo[2], lo[3], hh[0], hh[1], hh[2], hh[3]};
                    o[dh] = __builtin_amdgcn_mfma_f32_32x32x16_bf16(vf, pf, o[dh], 0, 0, 0); }
                asm volatile("" ::: "memory");
            }
        bf16* op = (bf16*)(ws + WS_OCMP) + row * 384 + h * 64 + 4 * hi;
#pragma unroll
        for (int dh = 0; dh < 2; ++dh)
#pragma unroll
            for (int g4 = 0; g4 < 4; ++g4) { u32x2v w; w.x = cvtpk(o[dh][4 * g4] * il, o[dh][4 * g4 + 1] * il); w.y = cvtpk(o[dh][4 * g4 + 2] * il, o[dh][4 * g4 + 3] * il);
                *(u32x2v*)(op + dh * 32 + 8 * g4) = w; }
    }
    const int cur = qpos >> 6;
    LAS float* imp = IG;
#pragma unroll 1
    for (int jj = 0; jj < 16; ++jj) {
        const int j = 16 * hi + jj;
        float v = IG[j] + (j > 0 ? IL[j] : 0.f);
        if (j == 0 || j == cur || j == cur - 1) v = INFINITY;
        if (j * 64 > qpos) v = -INFINITY;
        IL[j] = v;
    }
#pragma unroll 1
    for (int jj = 0; jj < 16; ++jj) { const int j = 16 * hi + jj; imp[j] = IL[j]; }
    unsigned mask = 0;
#pragma unroll 1
    for (int jj = 0; jj < 16; ++jj) {
        const int j = 16 * hi + jj; const float v = imp[j]; int rank = 0;
#pragma unroll 4
        for (int k = 0; k < 32; ++k) { const float u2 = imp[k]; rank += (u2 > v || (u2 == v && k < j)) ? 1 : 0; }
        if (rank < 16) mask |= 1u << j;
    }
    mask = red32_or(mask);
    if (hi == 0) ((unsigned*)(ws + WS_SEL))[(size_t)(b * 2 + g) * S_ + qpos] = mask;
    __syncthreads();
}
__device__ __forceinline__ void lora_rows(unsigned char* ws, int tid) {
    const int gw = blockIdx.x * NWAVES + (tid >> 6), ngw = gridDim.x * NWAVES, lane = tid & 63;
    bf16* kvl = (bf16*)(ws + WS_KVL); const bf16* ql = (const bf16*)(ws + WS_QL); float* ssql = (float*)(ws + WS_SSQL);
    for (int m = gw; m < T_; m += ngw) {
        const unsigned kv = *(const unsigned*)(kvl + (size_t)m * 128 + 2 * lane);
        const float k0 = __uint_as_float(kv << 16), k1 = __uint_as_float(kv & 0xffff0000u);
        const uint2 qv = *(const uint2*)(ql + (size_t)m * 256 + 4 * lane);
        const float q0 = __uint_as_float(qv.x << 16), q1 = __uint_as_float(qv.x & 0xffff0000u), q2 = __uint_as_float(qv.y << 16), q3 = __uint_as_float(qv.y & 0xffff0000u);
        const float sk = wave_sum2(k0 * k0 + k1 * k1), sq = wave_sum2((q0 * q0 + q1 * q1) + (q2 * q2 + q3 * q3));
        const float rk = rsqrtf(sk * (1.f / 128.f) + EPS);
        *(unsigned*)(kvl + (size_t)m * 128 + 2 * lane) = pk2(k0 * rk, k1 * rk);
        if (lane == 0) ssql[m] = sq;
    }
}
__device__ __forceinline__ void post_misc(unsigned char* ws, const float* big, const float* bfg, int tid) {
    const float* mr = (const float*)(ws + WS_MISCRAW); const float* cosM = (const float*)(ws + WS_COSM); const float* sinM = (const float*)(ws + WS_SINM);
    bf16* kr = (bf16*)(ws + WS_KR); float* gm = (float*)(ws + WS_GM);
    for (int idx = blockIdx.x * NTHR + tid; idx < T_ * 64; idx += gridDim.x * NTHR) {
        const int row = idx >> 6, c = idx & 63; const float* r = mr + (size_t)row * 64; const float v = r[c];
        if (c < 32) { const int i = c & 15; const float x1 = r[i], x2 = r[16 + i], cs = cosM[row * 16 + i], sn = sinM[row * 16 + i];
            kr[(size_t)row * 32 + c] = f2bf((c < 16) ? x1 * cs - x2 * sn : x1 * sn + x2 * cs); }
        else if (c < 50) gm[(size_t)row * 32 + (c - 32)] = 1.f / (1.f + __expf(-v));
        else if (c < 54) gm[(size_t)row * 32 + 18 + (c - 50)] = v + big[c - 50];
        else if (c < 58) { const float z = v + bfg[c - 54]; gm[(size_t)row * 32 + 22 + (c - 54)] = fminf(z, 0.f) - __logf(1.f + __expf(-fabsf(z))); }
    }
}

typedef float f32x4v __attribute__((ext_vector_type(4)));
__device__ __forceinline__ void compress_item(unsigned char* ws, LAS unsigned char* lds, const float* cmp_pos, int item, int wave_u) {
    const int lane = fresh_lane(), tid = wave_u * 64 + lane;
    const int nb = item & 7, g = (item >> 3) & 1, b = (item >> 4) & 7, kv = item >> 7;
    const bf16* tok = (const bf16*)(ws + WS_NSA) + (size_t)b * S_ * 1152 + (kv ? 512 : 384) + g * 64;
    const bf16* wt = (const bf16*)(ws + (kv ? WT_CV : WT_CK));
    const int nrow = nb * 16 + (lane & 15), kq = lane >> 4;
    f32x4v acc[4] = {f32x4v{}, f32x4v{}, f32x4v{}, f32x4v{}};
#pragma unroll 4
    for (int ks = 0; ks < 8; ++ks) {
        const int k = wave_u * 256 + ks * 32 + kq * 8, l = k >> 6, d = k & 63;
        int trow = 16 * nrow + l; trow = trow < S_ ? trow : S_ - 1;
        const v4u t4 = *(const v4u*)(tok + (size_t)trow * 1152 + d);
        const f32x4v p0 = *(const f32x4v*)(cmp_pos + k), p1 = *(const f32x4v*)(cmp_pos + k + 4);
        v4u a4;
        a4.x = cvtpk(__uint_as_float(t4.x << 16) + p0[0], __uint_as_float(t4.x & 0xffff0000u) + p0[1]); a4.y = cvtpk(__uint_as_float(t4.y << 16) + p0[2], __uint_as_float(t4.y & 0xffff0000u) + p0[3]);
        a4.z = cvtpk(__uint_as_float(t4.z << 16) + p1[0], __uint_as_float(t4.z & 0xffff0000u) + p1[1]); a4.w = cvtpk(__uint_as_float(t4.w << 16) + p1[2], __uint_as_float(t4.w & 0xffff0000u) + p1[3]);
        const bf16x8 af = __builtin_bit_cast(bf16x8, a4);
#pragma unroll
        for (int cb = 0; cb < 4; ++cb) { const bf16x8 bfr = *(const bf16x8*)(wt + (size_t)(cb * 16 + (lane & 15)) * 2048 + k);
            acc[cb] = __builtin_amdgcn_mfma_f32_16x16x32_bf16(af, bfr, acc[cb], 0, 0, 0); }
    }
    LAS float* red = (LAS float*)lds + wave_u * 1024;
#pragma unroll
    for (int cb = 0; cb < 4; ++cb)
#pragma unroll
        for (int r = 0; r < 4; ++r) red[(4 * (lane >> 4) + r) * 64 + cb * 16 + (lane & 15)] = acc[cb][r];
    __syncthreads();
    bf16* out = (bf16*)(ws + WS_KCV) + (size_t)kv * (8 * 2 * 128 * 64) + ((size_t)(b * 2 + g) * 128 + nb * 16) * 64;
    for (int o = tid; o < 1024; o += NTHR) { float sum = 0.f;
#pragma unroll
        for (int w8 = 0; w8 < 8; ++w8) sum += ((LAS float*)lds)[w8 * 1024 + o];
        out[o] = f2bf(sum); }
    __syncthreads();
}
__device__ __forceinline__ f32x4v mm16(const LAS bf16* A, int lda, int arow0, const LAS bf16* Bt, int ldb, int bcol0, int K, int lane, f32x4v acc) {
    const LAS bf16* ap = A + (arow0 + (lane & 15)) * lda + 8 * (lane >> 4); const LAS bf16* bp = Bt + (bcol0 + (lane & 15)) * ldb + 8 * (lane >> 4);
    for (int k = 0; k < K; k += 32) acc = __builtin_amdgcn_mfma_f32_16x16x32_bf16(*(const LAS bf16x8*)(ap + k), *(const LAS bf16x8*)(bp + k), acc, 0, 0, 0);
    return acc;
}
constexpr int ML_LD = 72;
constexpr int ML_STRIDE = 3 * 64 * ML_LD * 2 + 256;
__device__ __forceinline__ void mlocal_item(unsigned char* ws, LAS unsigned char* lds, const float* convw, const float* convb, const float* big, const float* bfg, int chunk0, int wave_u) {
    const int lane = fresh_lane(), tid = wave_u * 64 + lane;
    const int h = (chunk0 >> 5) & 3, b = chunk0 >> 7;
    LAS bf16* WQ = (LAS bf16*)lds;
    LAS bf16* WK = WQ + 64 * ML_LD;
    const bf16* cm = (const bf16*)(ws + WS_CM);
#define ML_PTRS(ch) const int chunk = chunk0 + (ch); const int c = chunk & 31; const int row0 = b * S_ + c * 64; LAS bf16* XS = WK + 64 * ML_LD + (ch) * (ML_STRIDE / 2); \
    LAS bf16* VT = XS + 64 * ML_LD; LAS bf16* WKT = VT + 64 * ML_LD; LAS float* wl = (LAS float*)(WKT + 64 * ML_LD); (void)c; (void)row0; (void)XS; (void)VT; (void)WKT; (void)wl; (void)chunk;
#pragma unroll
    for (int ch = 0; ch < 2; ++ch) { ML_PTRS(ch)
        const int l = tid >> 3, ch0 = (tid & 7) * 8, row = row0 + l, s = c * 64 + l;
        float a[8];
#pragma unroll
        for (int i = 0; i < 8; ++i) a[i] = convb[h * 64 + ch0 + i];
#pragma unroll
        for (int j = 0; j < 4; ++j) { if (s - 3 + j >= 0) { const v4u x4 = *(const v4u*)(cm + (size_t)(row - 3 + j) * 768 + h * 64 + ch0);
            const float* cw = convw + j * 256 + h * 64 + ch0;
            a[0] += cw[0] * __uint_as_float(x4.x << 16); a[1] += cw[1] * __uint_as_float(x4.x & 0xffff0000u); a[2] += cw[2] * __uint_as_float(x4.y << 16); a[3] += cw[3] * __uint_as_float(x4.y & 0xffff0000u);
            a[4] += cw[4] * __uint_as_float(x4.z << 16); a[5] += cw[5] * __uint_as_float(x4.z & 0xffff0000u); a[6] += cw[6] * __uint_as_float(x4.w << 16); a[7] += cw[7] * __uint_as_float(x4.w & 0xffff0000u); } }
        v4u o4; float r[8];
#pragma unroll
        for (int i = 0; i < 8; ++i) r[i] = a[i] / (1.f + __expf(-a[i]));
        o4.x = cvtpk(r[0], r[1]); o4.y = cvtpk(r[2], r[3]); o4.z = cvtpk(r[4], r[5]); o4.w = cvtpk(r[6], r[7]);
        *(v4u*)((bf16*)(ws + WS_XC) + (size_t)row * 256 + h * 64 + ch0) = o4;
        *(LAS v4u*)(XS + l * ML_LD + ch0) = o4;
        const v4u v4 = *(const v4u*)(cm + (size_t)row * 768 + 256 + h * 64 + ch0);
        VT[(ch0 + 0) * ML_LD + l] = (bf16)(v4.x & 0xffffu); VT[(ch0 + 1) * ML_LD + l] = (bf16)(v4.x >> 16); VT[(ch0 + 2) * ML_LD + l] = (bf16)(v4.y & 0xffffu); VT[(ch0 + 3) * ML_LD + l] = (bf16)(v4.y >> 16);
        VT[(ch0 + 4) * ML_LD + l] = (bf16)(v4.z & 0xffffu); VT[(ch0 + 5) * ML_LD + l] = (bf16)(v4.z >> 16); VT[(ch0 + 6) * ML_LD + l] = (bf16)(v4.w & 0xffffu); VT[(ch0 + 7) * ML_LD + l] = (bf16)(v4.w >> 16);
    }
    {
        const int e = tid >> 3, d0 = (tid & 7) * 8;
        *(LAS v4u*)(WQ + e * ML_LD + d0) = *(const v4u*)((const bf16*)(ws + WT_QM) + h * 4096 + e * 64 + d0);
        *(LAS v4u*)(WK + e * ML_LD + d0) = *(const v4u*)((const bf16*)(ws + WT_KM) + h * 4096 + e * 64 + d0);
    }
    if (wave_u < 2) { ML_PTRS(wave_u)
        const float* mr = (const float*)(ws + WS_MISCRAW) + (size_t)(row0 + lane) * 64;
        const float z = mr[54 + h] + bfg[h]; float lf = fminf(z, 0.f) - __logf(1.f + __expf(-fabsf(z)));
        const float ig = mr[50 + h] + big[h];
#pragma unroll
        for (int o = 1; o < 64; o <<= 1) { const float t = bperm(lf, lane - o); if (lane >= o) lf += t; }
        const float bL = __int_as_float(__builtin_amdgcn_readlane(__float_as_int(lf), 63));
        const float a = bL - lf + ig; const float mx = wave_max2(a);
        wl[lane] = __expf(a - mx);
        if (lane == 0) { ((float*)(ws + WS_ML))[chunk] = mx; ((float*)(ws + WS_BL))[chunk] = bL; }
    }
    __syncthreads();
#pragma unroll
    for (int ch = 0; ch < 2; ++ch) { ML_PTRS(ch)
        const int lb = wave_u & 3; const bool isk = wave_u >= 4;
        const LAS bf16* Wt = isk ? WK : WQ;
        bf16* og = (bf16*)(ws + (isk ? WS_MK : WS_MQ)) + (size_t)(row0 + 16 * lb + 4 * (lane >> 4)) * 256 + h * 64 + (lane & 15);
        float w4[4];
#pragma unroll
        for (int r = 0; r < 4; ++r) w4[r] = wl[16 * lb + 4 * (lane >> 4) + r];
#pragma unroll
        for (int eb = 0; eb < 4; ++eb) {
            f32x4v acc = mm16(XS, ML_LD, 16 * lb, Wt, ML_LD, 16 * eb, 64, lane, f32x4v{});
            if (!isk) {
#pragma unroll
                for (int r = 0; r < 4; ++r) og[(size_t)r * 256 + 16 * eb] = f2bf(acc[r] * 0.125f);
            } else {
                bf16 kb[4];
#pragma unroll
                for (int r = 0; r < 4; ++r) { kb[r] = f2bf(acc[r]); og[(size_t)r * 256 + 16 * eb] = kb[r]; }
                u32x2v w2; w2.x = cvtpk(bf2f(kb[0]) * w4[0], bf2f(kb[1]) * w4[1]); w2.y = cvtpk(bf2f(kb[2]) * w4[2], bf2f(kb[3]) * w4[3]);
                *(LAS u32x2v*)(WKT + (16 * eb + (lane & 15)) * ML_LD + 16 * lb + 4 * (lane >> 4)) = w2;
            }
        }
    }
    __syncthreads();
#pragma unroll
    for (int ch = 0; ch < 2; ++ch) { ML_PTRS(ch)
        float* ct = (float*)(ws + WS_CT) + (size_t)chunk * 4096;
#pragma unroll
        for (int i = 0; i < 2; ++i) { const int blk = wave_u * 2 + i, eb = blk >> 2, db = blk & 3;
            const f32x4v acc = mm16(VT, ML_LD, 16 * eb, WKT, ML_LD, 16 * db, 64, lane, f32x4v{});
#pragma unroll
            for (int r = 0; r < 4; ++r) ct[(16 * eb + 4 * (lane >> 4) + r) * 64 + 16 * db + (lane & 15)] = acc[r]; }
    }
    if (tid < 128) { ML_PTRS(tid >> 6)
        const int d = tid & 63; float n = 0.f; const LAS bf16* wr_ = WKT + d * ML_LD;
        for (int l = 0; l < 64; ++l) n += bf2f(wr_[l]);
        ((float*)(ws + WS_NL))[chunk * 64 + d] = n; }
#undef ML_PTRS
    __syncthreads();
}
__device__ __forceinline__ void mscan_item(unsigned char* ws, int item, int wave_u) {
    const int tid = wave_u * 64 + fresh_lane();
    const int bh = item / 9, part = item % 9;
    if (part == 8 && tid >= 64) return;
    float* base; size_t stride;
    if (part < 8) { base = (float*)(ws + WS_CT) + (size_t)bh * 32 * 4096 + part * 512 + tid; stride = 4096; } else { base = (float*)(ws + WS_NL) + (size_t)bh * 32 * 64 + tid; stride = 64; }
    const float* ML = (const float*)(ws + WS_ML); const float* BL = (const float*)(ws + WS_BL); float* MPv = (float*)(ws + WS_MP);
    float Cv = 0.f, m = 0.f;
    for (int c = 0; c < 32; ++c) {
        const float cl = base[(size_t)c * stride], ml = ML[bh * 32 + c], bl = BL[bh * 32 + c];
        base[(size_t)c * stride] = Cv;
        if (part == 8 && tid == 0) MPv[bh * 32 + c] = m;
        const float mn = fmaxf(bl + m, ml);
        Cv = __expf(bl + m - mn) * Cv + __expf(ml - mn) * cl; m = mn;
    }
}
constexpr int MO_STRIDE = 5 * 64 * ML_LD * 2 + 64 * 65 * 4 + 6 * 64 * 4;
__device__ __forceinline__ void mout_item(unsigned char* ws, LAS unsigned char* lds, const float* gmh, const float* skip, int chunk0, int wave_u) {
    const int lane = fresh_lane(), tid = wave_u * 64 + lane;
    const int h = (chunk0 >> 5) & 3, b = chunk0 >> 7;
    const float* gm = (const float*)(ws + WS_GM);
#define MO_PTRS(ch) const int chunk = chunk0 + (ch); const int row0 = b * S_ + (chunk & 31) * 64; LAS unsigned char* cb_ = lds + (ch) * MO_STRIDE; \
    LAS bf16* QS = (LAS bf16*)cb_; LAS bf16* KS = QS + 64 * ML_LD; LAS bf16* VT = KS + 64 * ML_LD; LAS bf16* CP = VT + 64 * ML_LD; LAS bf16* SW = CP + 64 * ML_LD; \
    LAS float* HS = (LAS float*)(SW + 64 * ML_LD); LAS float* bs = HS + 64 * 65; LAS float* us = bs + 64; LAS float* ns = us + 64; LAS float* mts = ns + 64; LAS float* ints = mts + 64; LAS float* dinv = ints + 64; \
    (void)row0; (void)QS; (void)KS; (void)VT; (void)CP; (void)SW; (void)HS; (void)bs; (void)us; (void)ns; (void)mts; (void)ints; (void)dinv; (void)chunk;
#pragma unroll
    for (int ch = 0; ch < 2; ++ch) { MO_PTRS(ch)
        const int l = tid >> 3, c0 = (tid & 7) * 8, row = row0 + l;
        *(LAS v4u*)(QS + l * ML_LD + c0) = *(const v4u*)((const bf16*)(ws + WS_MQ) + (size_t)row * 256 + h * 64 + c0);
        *(LAS v4u*)(KS + l * ML_LD + c0) = *(const v4u*)((const bf16*)(ws + WS_MK) + (size_t)row * 256 + h * 64 + c0);
        const v4u v4 = *(const v4u*)((const bf16*)(ws + WS_CM) + (size_t)row * 768 + 256 + h * 64 + c0);
        VT[(c0 + 0) * ML_LD + l] = (bf16)(v4.x & 0xffffu); VT[(c0 + 1) * ML_LD + l] = (bf16)(v4.x >> 16); VT[(c0 + 2) * ML_LD + l] = (bf16)(v4.y & 0xffffu); VT[(c0 + 3) * ML_LD + l] = (bf16)(v4.y >> 16);
        VT[(c0 + 4) * ML_LD + l] = (bf16)(v4.z & 0xffffu); VT[(c0 + 5) * ML_LD + l] = (bf16)(v4.z >> 16); VT[(c0 + 6) * ML_LD + l] = (bf16)(v4.w & 0xffffu); VT[(c0 + 7) * ML_LD + l] = (bf16)(v4.w >> 16);
        const float* ct = (const float*)(ws + WS_CT) + (size_t)chunk * 4096 + l * 64 + c0;
        const f32x4v c0v = *(const f32x4v*)ct, c1v = *(const f32x4v*)(ct + 4);
        v4u cw; cw.x = cvtpk(c0v[0], c0v[1]); cw.y = cvtpk(c0v[2], c0v[3]); cw.z = cvtpk(c1v[0], c1v[1]); cw.w = cvtpk(c1v[2], c1v[3]);
        *(LAS v4u*)(CP + l * ML_LD + c0) = cw;
    }
    if (wave_u < 2) { MO_PTRS(wave_u)
        const float ig = gm[(size_t)(row0 + lane) * 32 + 18 + h]; float lf = gm[(size_t)(row0 + lane) * 32 + 22 + h];
#pragma unroll
        for (int o = 1; o < 64; o <<= 1) { const float t = bperm(lf, lane - o); if (lane >= o) lf += t; }
        const float u = ig - lf; float cu = u;
#pragma unroll
        for (int o = 1; o < 64; o <<= 1) { const float t = bperm(cu, lane - o); if (lane >= o) cu = fmaxf(cu, t); }
        const float mprev = ((const float*)(ws + WS_MP))[chunk];
        const float mt = lf + fmaxf(mprev, cu);
        bs[lane] = lf; us[lane] = u; mts[lane] = mt; ints[lane] = __expf(lf + mprev - mt); ns[lane] = ((const float*)(ws + WS_NL))[chunk * 64 + lane];
    }
    __syncthreads();
#pragma unroll
    for (int ch = 0; ch < 2; ++ch) { MO_PTRS(ch)
#pragma unroll
        for (int i = 0; i < 2; ++i) { const int blk = wave_u * 2 + i, lb = blk >> 2, sb = blk & 3;
            f32x4v acc = f32x4v{};
            if (sb <= lb) acc = mm16(QS, ML_LD, 16 * lb, KS, ML_LD, 16 * sb, 64, lane, acc);
            const int sidx = 16 * sb + (lane & 15); const float usv = us[sidx];
#pragma unroll
            for (int r = 0; r < 4; ++r) { const int l = 16 * lb + 4 * (lane >> 4) + r;
                const float v = (sidx <= l) ? acc[r] * __expf(bs[l] + usv - mts[l]) : 0.f;
                SW[l * ML_LD + sidx] = f2bf(v); } }
    }
    __syncthreads();
    if (tid < 128) { MO_PTRS(tid >> 6)
        const int l = tid & 63; float qn = 0.f, ssum = 0.f;
        for (int d = 0; d < 64; ++d) { qn += bf2f(QS[l * ML_LD + d]) * ns[d]; ssum += bf2f(SW[l * ML_LD + d]); }
        const float den = ints[l] * qn + ssum;
        dinv[l] = 1.f / fmaxf(fabsf(den), __expf(-mts[l]));
    }
    f32x4v hq[2][2], hs2[2][2];
#pragma unroll
    for (int ch = 0; ch < 2; ++ch) { MO_PTRS(ch)
#pragma unroll
        for (int i = 0; i < 2; ++i) { const int blk = wave_u * 2 + i, lb = blk >> 2, eb = blk & 3;
            hq[ch][i] = mm16(QS, ML_LD, 16 * lb, CP, ML_LD, 16 * eb, 64, lane, f32x4v{});
            hs2[ch][i] = mm16(SW, ML_LD, 16 * lb, VT, ML_LD, 16 * eb, 16 * lb + 16 <= 32 ? 32 : 64, lane, f32x4v{}); }
    }
    __syncthreads();
#pragma unroll
    for (int ch = 0; ch < 2; ++ch) { MO_PTRS(ch)
#pragma unroll
        for (int i = 0; i < 2; ++i) { const int blk = wave_u * 2 + i, lb = blk >> 2, eb = blk & 3; const int e = 16 * eb + (lane & 15);
#pragma unroll
            for (int r = 0; r < 4; ++r) { const int l = 16 * lb + 4 * (lane >> 4) + r;
                const float og = bf2f(((const bf16*)(ws + WS_CM))[(size_t)(row0 + l) * 768 + 512 + h * 64 + e]);
                HS[l * 65 + e] = (ints[l] * hq[ch][i][r] + hs2[ch][i][r]) * dinv[l] / (1.f + __expf(-og)); } }
    }
    __syncthreads();
#pragma unroll
    for (int ch = 0; ch < 2; ++ch) { MO_PTRS(ch)
        const int l = tid >> 3, e0 = (tid & 7) * 8, row = row0 + l;
        float v[8]; float mu = 0.f;
#pragma unroll
        for (int i = 0; i < 8; ++i) { v[i] = HS[l * 65 + e0 + i]; mu += v[i]; }
        mu += sxf<1>(mu); mu += sxf<2>(mu); mu += sxf<4>(mu); mu *= (1.f / 64.f);
        float var = 0.f;
#pragma unroll
        for (int i = 0; i < 8; ++i) { const float dl = v[i] - mu; var += dl * dl; }
        var += sxf<1>(var); var += sxf<2>(var); var += sxf<4>(var);
        const float rs = rsqrtf(var * (1.f / 64.f) + EPS);
        const v4u x4 = *(const v4u*)((const bf16*)(ws + WS_XC) + (size_t)row * 256 + h * 64 + e0);
        float xv[8]; xv[0] = __uint_as_float(x4.x << 16); xv[1] = __uint_as_float(x4.x & 0xffff0000u); xv[2] = __uint_as_float(x4.y << 16); xv[3] = __uint_as_float(x4.y & 0xffff0000u);
        xv[4] = __uint_as_float(x4.z << 16); xv[5] = __uint_as_float(x4.z & 0xffff0000u); xv[6] = __uint_as_float(x4.w << 16); xv[7] = __uint_as_float(x4.w & 0xffff0000u);
        float r[8];
#pragma unroll
        for (int i = 0; i < 8; ++i) r[i] = (v[i] - mu) * rs * gmh[h * 64 + e0 + i] + skip[h * 64 + e0 + i] * xv[i];
        v4u w4; w4.x = cvtpk(r[0], r[1]); w4.y = cvtpk(r[2], r[3]); w4.z = cvtpk(r[4], r[5]); w4.w = cvtpk(r[6], r[7]);
        *(v4u*)((bf16*)(ws + WS_HB) + (size_t)row * D_ + 768 + h * 64 + e0) = w4;
    }
#undef MO_PTRS
    __syncthreads();
}

__global__ void __launch_bounds__(NTHR, 2) mega(MP p_unused) {
    extern __shared__ __attribute__((aligned(16))) unsigned char lds_raw[];
    LAS unsigned char* lds = (LAS unsigned char*)lds_raw;
    const int wave0 = __builtin_amdgcn_readfirstlane((int)threadIdx.x >> 6);
    const int tid0 = wave0 * 64 + fresh_lane();
    const int xcc = (int)(__builtin_amdgcn_s_getreg((3 << 11) | 20) & 7u);
    volatile LAS unsigned* MISC = (volatile LAS unsigned*)(lds + MISC_OFF);
    for (int u = tid0; u < (LDS_BYTES - RING_BYTES) / 4; u += NTHR) ((LAS unsigned*)(lds + RING_BYTES))[u] = 0u;
    __syncthreads();
    typedef const __attribute__((address_space(4))) MP* kmp_t;
    kmp_t kp0 = (kmp_t)__builtin_amdgcn_kernarg_segment_ptr();
    unsigned char* ws0 = kp0->ws; const int coop = kp0->coop, ph_lo = kp0->ph_lo, ph_hi = kp0->ph_hi;
    XcdBarrier bar; bar.bar = (unsigned*)(ws0 + WS_CTL) + CW_BAR; bar.x = 0; bar.st = nullptr;
    if (coop) bar = xcd_barrier_post((unsigned*)(ws0 + WS_CTL) + CW_BAR, MISC + 8, tid0);
    if (coop == 2) cooperative_groups::this_grid().sync();
    int ph = ph_lo;
    if (ph == 0) {
        const MPK p{kp0}; ph_p0(p, lds, wave0 * 64 + fresh_lane()); ph = 1;
        if (ph < ph_hi) xcd_barrier(bar, wave0 * 64 + fresh_lane());
    }
    bool second = false;
    for (; ph < ph_hi; ++ph) {
        kmp_t kp = kp0; asm volatile("" : "+s"(kp));
        const MPK p{kp}; unsigned char* ws = kp->ws;
#define TID_ (wave0 * 64 + fresh_lane())
#define GW_ (blockIdx.x * NWAVES + wave0)
#define NGW_ (gridDim.x * NWAVES)
        const int l = (ph - 1) / PPL, ty = (ph == 0) ? -1 : (ph == NPH - 1) ? -2 : (ph - 1) % PPL;
        const float* modl = (const float*)(ws + WS_MOD) + (size_t)l * 8 * 6144;
        if (ty == -2) { norm_rows(p.k->out, PIN(I_GFIN), nullptr, nullptr, nullptr, p.k->out, 2, GW_, NGW_, fresh_lane());
            if (PROBE_SEL != 0 && blockIdx.x == 0 && TID_ == 0) { asm volatile("s_waitcnt vmcnt(0)" ::: "memory"); p.k->out[0] = ((const float*)(ws + WS_CTL))[100] * 0.001f; } }
        else if (ty == 0 && (PHM & 2)) ph_prep(p, l, lds, TID_);
        else if (ty == 1 && (PHM & 4)) {
            pg8::Gemm g{(const bf16*)(ws + WS_HB), (const bf16*)(ws + WT_IN), T_, 2560, D_}; pg8::StaticOrder S; S.init(T_, 2560, gridDim.x, blockIdx.x);
            pg8::EpiIn E{ws, PIN(I_BIG) + l * 4, PIN(I_BFG) + l * 4};
            pg8::gemm_phase<pg8::EpiIn, pg8::StaticOrder, true, true>(lds, g, S, E, wave0);
            late_transposes(p, l, lds, TID_, 640 % (int)gridDim.x);
        }
        else if (ty == 2 && (PHM & 64)) {
            { pg8::Gemm g{(const bf16*)(ws + WS_KVL), (const bf16*)(ws + WT_UKV), T_, 768, 128}; pg8::StaticOrder S; S.init(T_, 768, gridDim.x, blockIdx.x);
              pg8::EpiUKV E{(bf16*)(ws + WS_KVM), (const float*)(ws + WS_SSKV)}; pg8::gemm_phase<pg8::EpiUKV, pg8::StaticOrder, true, true>(lds, g, S, E, wave0); }
            { pg8::Gemm g{(const bf16*)(ws + WS_QL), (const bf16*)(ws + WT_UQ), T_, 768, 256}; pg8::StaticOrder S; S.init(T_, 768, gridDim.x, blockIdx.x);
              pg8::EpiPlain E{(bf16*)(ws + WS_OSLC), 768}; pg8::gemm_phase<pg8::EpiPlain, pg8::StaticOrder, true, true>(lds, g, S, E, wave0); }
            post_misc(ws, PIN(I_BIG) + l * 4, PIN(I_BFG) + l * 4, TID_);
            unsigned* ctrs = (unsigned*)(ws + WS_CTL) + 8192 + ph * 256 + (second ? 128 : 0); int ks = 0;
            for (;;) { const int it = next_item_q(ctrs, lds, wave0, 96, xcc, ks); if (it < 0) break; const int b = it >> 16, j = it & 0xffff;
                if (j < 64) mlocal_item(ws, lds, PIN(I_CONVW) + l * 1024, PIN(I_CONVB) + l * 256, PIN(I_BIG) + l * 4, PIN(I_BFG) + l * 4, b * 128 + 2 * j, wave0);
                else { const int k = j - 64; compress_item(ws, lds, PIN(I_CMPPOS) + l * 2048, ((k >> 4) << 7) | (b << 4) | (k & 15), wave0); } }
        }
        else if (ty == 3 && (PHM & 128)) {
            unsigned* ctrs = (unsigned*)(ws + WS_CTL) + 8192 + ph * 256 + (second ? 128 : 0); int ks = 0;
            for (;;) { const int it = next_item_q(ctrs, lds, wave0, second ? 64 : 100, xcc, ks); if (it < 0) break; const int b = it >> 16, j = it & 0xffff;
                if (second && (REP_MASK & (1 << 20)) && j >= 48) continue; if (second && (REP_MASK & (1 << 21)) && j < 48) continue;
                if (j < 18) mla_unit(ws, lds, b, j % 6, 7 - j / 6, wave0);
                else if (j < 34) cmp_unit(ws, lds, b, (j - 18) >> 3, 7 - ((j - 18) & 7), wave0);
                else if (j < 64) { const int u = j - 16; mla_unit(ws, lds, b, u % 6, 7 - u / 6, wave0); }
                else mscan_item(ws, b * 36 + (j - 64), wave0); }
        }
        else if (ty == 4 && (PHM & 256)) {
            unsigned* ctrs = (unsigned*)(ws + WS_CTL) + 8192 + ph * 256 + (second ? 128 : 0); int ks = 0;
            for (;;) { const int it = next_item_q(ctrs, lds, wave0, 160, xcc, ks); if (it < 0) break; const int b = it >> 16, j = it & 0xffff;
                if (second && (REP_MASK & (1 << 16)) && j >= 96) continue; if (second && (REP_MASK & (1 << 17)) && j < 96) continue;
                if (j < 36) nsa_branch_unit<AM_SLC>(ws, lds, b, j % 6, 7 - j / 6, wave0);
                else if (j < 84) nsa_branch_unit<AM_WINDOW>(ws, lds, b, (j - 36) % 6, 7 - (j - 36) / 6, wave0);
                else if (j < 96) { const int u = j - 48; nsa_branch_unit<AM_SLC>(ws, lds, b, u % 6, 7 - u / 6, wave0); }
                else mout_item(ws, lds, PIN(I_GMH) + l * 256, PIN(I_SKIP) + l * 256, b * 128 + 2 * (j - 96), wave0); }
        }
        else if (ty == 5) ph_mixnorm(p, l, TID_);
        else if (ty == 6 && (PHM & 8)) {
            pg8::Gemm g{(const bf16*)(ws + WS_HB), (const bf16*)(ws + WT_OUT), T_, D_, D_}; pg8::StaticOrder S; S.init(T_, D_, gridDim.x, blockIdx.x);
            pg8::EpiRes E{(l == 0) ? PIN(I_X) : p.k->out, p.k->out, modl + 2048};
            pg8::gemm_phase<pg8::EpiRes, pg8::StaticOrder, true, true>(lds, g, S, E, wave0);
        }
        else if (ty == 7) norm_rows(p.k->out, PIN(I_GN2) + l * D_, modl + 3072, modl + 4096, (bf16*)(ws + WS_HB), nullptr, 1, GW_, NGW_, fresh_lane());
        else if (ty == 8 && (PHM & 16)) {
            pg8::Gemm g{(const bf16*)(ws + WS_HB), (const bf16*)(ws + WT_GU), T_, 2 * FF, D_}; pg8::StaticOrder S; S.init(T_, 2 * FF, gridDim.x, blockIdx.x);
            pg8::EpiGU E{(bf16*)(ws + WS_ACT)};
            pg8::gemm_phase<pg8::EpiGU, pg8::StaticOrder, true, true>(lds, g, S, E, wave0);
            if (l + 1 < DEPTH) early_transposes(p, l + 1, lds, TID_, 1408 % (int)gridDim.x);
        }
        else if (ty == 9 && (PHM & 32)) {
            pg8::Gemm g{(const bf16*)(ws + WS_ACT), (const bf16*)(ws + WT_DOWN), T_, D_, FF}; pg8::StaticOrder S; S.init(T_, D_, gridDim.x, blockIdx.x);
            pg8::EpiRes E{p.k->out, p.k->out, modl + 5120};
            pg8::gemm_phase<pg8::EpiRes, pg8::StaticOrder, true, true>(lds, g, S, E, wave0);
        }
        if (REP_MASK != 0 && ty >= 0 && ((REP_MASK >> ty) & 1) && !second) { second = true; --ph; } else second = false;
        if (ph + 1 < ph_hi) xcd_barrier(bar, wave0 * 64 + fresh_lane());
    }
}

extern "C" void kernel_launch(void* const* d_in, const int* in_sizes, int n_in, void* d_out, int out_size, void* d_ws, size_t ws_size, hipStream_t stream) {
    if (n_in != N_IN || ws_size < WS_END) { fprintf(stderr, "kernel_launch: unexpected n_in %d / ws %zu\n", n_in, ws_size); return; }
    static int inited = 0;
    if (!inited) { if (hipFuncSetAttribute((const void*)mega, hipFuncAttributeMaxDynamicSharedMemorySize, LDS_BYTES) != hipSuccess) fprintf(stderr, "hipFuncSetAttribute failed\n"); inited = 1; }
    unsigned char* ws = (unsigned char*)d_ws;
    MP base{}; for (int i = 0; i < N_IN; ++i) base.in[i] = (const float*)d_in[i]; base.out = (float*)d_out; base.ws = ws;
    (void)hipMemsetAsync(ws + WS_CTL, 0, CTL_ZERO_BYTES, stream);
    static int grid = 0;
    if (!grid) {
        int dev = 0, cus = 0, per_cu = 0;
        (void)hipGetDevice(&dev); (void)hipDeviceGetAttribute(&cus, hipDeviceAttributeMultiprocessorCount, dev);
        if (hipOccupancyMaxActiveBlocksPerMultiprocessor(&per_cu, (const void*)mega, NTHR, LDS_BYTES) != hipSuccess || per_cu < 1) { fprintf(stderr, "kernel_launch: occupancy query says %d blocks per CU\n", per_cu); per_cu = 1; }
        (void)hipGetLastError();
        grid = cus;
    }
    MP a = base; a.ph_lo = 0; a.ph_hi = NPH; a.coop = 1;
    void* args[] = {&a};
    const hipError_t e = hipLaunchCooperativeKernel((const void*)mega, dim3(grid), dim3(NTHR), args, LDS_BYTES, stream);
    if (e != hipSuccess) fprintf(stderr, "kernel_launch: cooperative launch failed: %s (grid %d)\n", hipGetErrorString(e), grid);
}
```

```cpp
#include <hip/hip_runtime.h>
#include <cstdint>
#include <cstdio>
#include <hip/hip_cooperative_groups.h>

constexpr int B_ = 8, S_ = 2048, T_ = B_ * S_, D_ = 1024, DIN = 2362, FF = 2816, DEPTH = 2;
constexpr float EPS = 1e-6f;
constexpr float LOG2E = 1.4426950408889634f;
constexpr float QSCALE = 0.125f * LOG2E;
constexpr float MSCALE = 0.10206207261596577f * LOG2E;
enum { I_X = 0, I_C, I_POS, I_GN1, I_GN2, I_WADA, I_BADA, I_WIN, I_CMPPOS, I_WCK, I_WCV, I_GOA, I_GQL, I_WUQ, I_GKVL, I_WUKV, I_GOB,
       I_CONVW, I_CONVB, I_WQM, I_WKM, I_BIG, I_BFG, I_GMH, I_SKIP, I_WOUT, I_WGU, I_WDOWN, I_GFIN, N_IN };

constexpr size_t MiB = 1u << 20;
constexpr size_t WS_CTL = 0;
constexpr size_t WS_MOD = 1 * MiB;
constexpr size_t WS_COSP = WS_MOD + 512 * 1024;
constexpr size_t WS_SINP = WS_COSP + 512 * 1024;
constexpr size_t WS_COSM = WS_SINP + 512 * 1024;
constexpr size_t WS_SINM = WS_COSM + 1 * MiB;
constexpr size_t WS_SSQL = WS_SINM + 1 * MiB;
constexpr size_t WS_SSKV = WS_SSQL + 64 * 1024;
constexpr size_t WS_ML = WS_SSKV + 64 * 1024;
constexpr size_t WS_BL = WS_ML + 4096;
constexpr size_t WS_MP = WS_BL + 4096;
constexpr size_t WS_NL = WS_MP + 4096;
constexpr size_t WS_WT = 8 * MiB;
constexpr size_t WS_RAW = WS_WT;
constexpr size_t WS_HB = 34 * MiB;
constexpr size_t WS_NSA = 66 * MiB;
constexpr size_t WS_KVL = 102 * MiB;
constexpr size_t WS_QL = 106 * MiB;
constexpr size_t WS_CM = 114 * MiB;
constexpr size_t WS_GM = 138 * MiB;
constexpr size_t WS_KM = 140 * MiB;
constexpr size_t WS_QM = 158 * MiB;
constexpr size_t WS_VM = 176 * MiB;
constexpr size_t WS_KCV = 188 * MiB;
constexpr size_t WS_OCMP = 189 * MiB;
constexpr size_t WS_SEL = 201 * MiB;
constexpr size_t WS_XC = 202 * MiB;
constexpr size_t WS_MQ = 210 * MiB;
constexpr size_t WS_MK = 218 * MiB;
constexpr size_t WS_CT = 226 * MiB;
constexpr size_t WS_MISCRAW = 242 * MiB;
constexpr size_t WS_KVM = 140 * MiB;
constexpr size_t WS_KR = 246 * MiB;
constexpr size_t WS_OSLC = 164 * MiB;
constexpr size_t WS_OWIN = 176 * MiB;
constexpr size_t WS_ACT = 66 * MiB;
constexpr size_t WS_END = 256 * MiB;
static_assert(WS_NL + 1024 * 64 * 4 <= WS_WT, "tab");
static_assert(WS_ACT + (size_t)T_ * FF * 2 <= WS_KCV, "act overlay");

typedef unsigned short bf16;
__device__ __forceinline__ float bf2f(bf16 v) { return __uint_as_float(((unsigned)v) << 16); }
__device__ __forceinline__ bf16 f2bf(float f) { unsigned u = __float_as_uint(f); return (bf16)((u + 0x7fffu + ((u >> 16) & 1u)) >> 16); }
__device__ __forceinline__ float sigmoidf_(float x) { return 1.f / (1.f + __expf(-x)); }
__device__ __forceinline__ float siluf_(float x) { return x / (1.f + __expf(-x)); }
__device__ __forceinline__ float wave_sum(float v) {
#pragma unroll
    for (int o = 1; o < 64; o <<= 1) v += __shfl_xor(v, o);
    return v;
}

__device__ __forceinline__ int fresh_lane() { int l; asm volatile("v_mbcnt_lo_u32_b32 %0, -1, 0\n\tv_mbcnt_hi_u32_b32 %0, -1, %0" : "=&v"(l)); return l; }
template <int M> __device__ __forceinline__ float sxf(float v) { static_assert(M >= 1 && M < 32, "swizzle xor mask"); return __int_as_float(__builtin_amdgcn_ds_swizzle(__float_as_int(v), (M << 10) | 0x1f)); }
__device__ __forceinline__ float red32_max(float v) { auto r = __builtin_amdgcn_permlane32_swap(__float_as_uint(v), __float_as_uint(v), false, false); return fmaxf(__uint_as_float(r[0]), __uint_as_float(r[1])); }
__device__ __forceinline__ float red32_sum(float v) { auto r = __builtin_amdgcn_permlane32_swap(__float_as_uint(v), __float_as_uint(v), false, false); return __uint_as_float(r[0]) + __uint_as_float(r[1]); }
__device__ __forceinline__ unsigned red32_or(unsigned v) { auto r = __builtin_amdgcn_permlane32_swap(v, v, false, false); return r[0] | r[1]; }
__device__ __forceinline__ float bperm(float v, int src_lane) { return __int_as_float(__builtin_amdgcn_ds_bpermute(src_lane << 2, __float_as_int(v))); }
__device__ __forceinline__ float wave_sum2(float v) { v += sxf<1>(v); v += sxf<2>(v); v += sxf<4>(v); v += sxf<8>(v); v += sxf<16>(v); return red32_sum(v); }
__device__ __forceinline__ float wave_max2(float v) { v = fmaxf(v, sxf<1>(v)); v = fmaxf(v, sxf<2>(v)); v = fmaxf(v, sxf<4>(v)); v = fmaxf(v, sxf<8>(v)); v = fmaxf(v, sxf<16>(v)); return red32_max(v); }
namespace pg8 {
#define PG8_LAS __attribute__((address_space(3)))
typedef unsigned short bf16_t;
typedef short bf16x8 __attribute__((ext_vector_type(8)));
typedef float f32x4 __attribute__((ext_vector_type(4)));
typedef unsigned u32x4 __attribute__((ext_vector_type(4)));
constexpr int BM = 256, BK = 64, HALF = 128, HTB = HALF * BK * 2  , STAGE_BYTES = 8 * HTB, NXCD = 8, WGM = 8;

__host__ __device__ __forceinline__ int lds_byte(int r, int c) { const int st = (r >> 4) * 2 + (c >> 5), rr = r & 15, cc = c & 31, ob = rr * 64 + cc * 2; return st * 1024 + (ob ^ (((ob >> 9) & 1) << 5)); }
__host__ __device__ __forceinline__ void stage_rc(int b, int& R, int& C) { const int st = b / 1024, sb = b % 1024, swz = sb ^ (((sb >> 9) & 1) << 5); R = (st >> 1) * 16 + swz / 64; C = (st & 1) * 32 + (swz % 64) / 2; }
__host__ __device__ __forceinline__ int perm32(int rho) { const int n = rho >> 4, i = rho & 15; return 8 * (i >> 2) + 4 * n + (i & 3); }

struct Unit { int pm, pn; };
struct Gemm { const bf16_t* A; const bf16_t* Bt; int M, N, K; };

struct StaticOrder {
    int nM, nN, nwg, G, c;
    __host__ __device__ void init(int M, int N, int G_, int c_) { nM = M / BM; nN = N / BM; nwg = nM * nN; G = G_; c = c_; }
    __host__ __device__ bool next(int i, Unit& u) const {
        const long L = (long)i * G + c; if (L >= nwg) return false;
        int wgid = (int)L; { const int q = nwg / NXCD, r = nwg % NXCD, xcd = wgid % NXCD, off = wgid / NXCD; wgid = (xcd < r ? xcd * (q + 1) : r * (q + 1) + (xcd - r) * q) + off; }
        const int nig = WGM * nN, gid = wgid / nig, fm = gid * WGM, gsz = (nM - fm) < WGM ? (nM - fm) : WGM;
        u.pm = fm + ((wgid % nig) % gsz); u.pn = (wgid % nig) / gsz; return true;
    }
    __device__ __forceinline__ void a_ready(const Unit&) const {}
    __device__ __forceinline__ void done(const Unit&) const {}
};

__device__ __forceinline__ unsigned cvt_pk_bf16(float lo, float hi) { unsigned r; asm volatile("v_cvt_pk_bf16_f32 %0, %1, %2" : "=v"(r) : "v"(lo), "v"(hi)); return r; }
typedef float f32x2 __attribute__((ext_vector_type(2)));

typedef unsigned u32x4 __attribute__((ext_vector_type(4)));
typedef unsigned u32x2 __attribute__((ext_vector_type(2)));
struct EpiIn {
    static constexpr bool PERM = true, AFTER_DRAIN = false;
    unsigned char* ws; const float *big, *bfg;
#define EPI_ROWS(...) _Pragma("unroll") for (int ai = 0; ai < 2; ++ai) _Pragma("unroll") for (int m = 0; m < 4; ++m) { \
        const int row = u.pm * BM + ai * HALF + wr * 64 + m * 16 + fr; float v[8]; \
        _Pragma("unroll") for (int i = 0; i < 4; ++i) { v[i] = acc[ai][bj][m][0][i]; v[4 + i] = acc[ai][bj][m][1][i]; } \
        asm volatile("" : "+v"(v[0]), "+v"(v[1]), "+v"(v[2]), "+v"(v[3]), "+v"(v[4]), "+v"(v[5]), "+v"(v[6]), "+v"(v[7])); \
        __VA_ARGS__ asm volatile("" ::: "memory"); }
#define EPI_PACK(w) u32x4 w; w.x = cvt_pk_bf16(v[0], v[1]); w.y = cvt_pk_bf16(v[2], v[3]); w.z = cvt_pk_bf16(v[4], v[5]); w.w = cvt_pk_bf16(v[6], v[7]);
    __device__ __forceinline__ void operator()(const f32x4 (&acc)[2][2][4][2], const Unit& u, int wr, int wc, int fr, int fq) const {
        half<0>(acc, u, wr, wc, fr, fq); half<1>(acc, u, wr, wc, fr, fq);
    }
    template <int bj> __device__ __forceinline__ void half(const f32x4 (&acc)[2][2][4][2], const Unit& u, int wr, int wc, int fr, int fq) const {
        {
            const int hb = 2 * u.pn + bj;
            int cb = 32 * wc + 8 * fq; asm volatile("" : "+v"(cb), "+v"(fr));
            if (hb <= 8) {
                bf16_t* nsa = (bf16_t*)(ws + WS_NSA) + hb * 128 + cb;
                const bool rope_hb = (hb <= 3) || hb == 5 || hb == 7;
                if (rope_hb) {
                    const float* cosP = (const float*)(ws + WS_COSP); const float* sinP = (const float*)(ws + WS_SINP);
                    const bool mine = ((wc & 1) == 0) && fq < 2; const float sg = (fq == 0) ? -1.f : 1.f; const float sc = (hb < 3) ? QSCALE : 1.f;
                    EPI_ROWS({
                        float pv[8];
                        _Pragma("unroll") for (int i = 0; i < 8; ++i) pv[i] = sxf<16>(v[i]);
                        if (mine) {
                            const f32x4 c0 = *(const f32x4*)(cosP + row * 8), c1 = *(const f32x4*)(cosP + row * 8 + 4), s0 = *(const f32x4*)(sinP + row * 8), s1 = *(const f32x4*)(sinP + row * 8 + 4);
                            _Pragma("unroll") for (int i = 0; i < 4; ++i) { v[i] = v[i] * c0[i] + sg * pv[i] * s0[i]; v[4 + i] = v[4 + i] * c1[i] + sg * pv[4 + i] * s1[i]; }
                        }
                        _Pragma("unroll") for (int i = 0; i < 8; ++i) v[i] *= sc;
                        EPI_PACK(w) *(u32x4*)(nsa + (size_t)row * 1152) = w;
                    })
                } else {
                    EPI_ROWS({ EPI_PACK(w) *(u32x4*)(nsa + (size_t)row * 1152) = w; })
                }
            } else if (hb <= 11) {
                bf16_t* dst = (hb == 9) ? (bf16_t*)(ws + WS_KVL) + cb : (bf16_t*)(ws + WS_QL) + (hb - 10) * 128 + cb;
                const int ld = (hb == 9) ? 128 : 256;
                float* ssq = (hb == 9) ? (float*)(ws + WS_SSKV) : (float*)(ws + WS_SSQL);
                EPI_ROWS({ EPI_PACK(w) *(u32x4*)(dst + (size_t)row * ld) = w;
                    float sq = 0.f;
                    _Pragma("unroll") for (int i = 0; i < 8; ++i) sq += v[i] * v[i];
                    sq += sxf<16>(sq); sq = red32_sum(sq);
                    if (fq == 0) atomicAdd(ssq + row, sq); })
            } else if (hb <= 17) {
                bf16_t* cm = (bf16_t*)(ws + WS_CM) + (hb - 12) * 128 + cb;
                EPI_ROWS({ EPI_PACK(w) *(u32x4*)(cm + (size_t)row * 768) = w; })
            } else if (hb == 18) {
                float* mr = (float*)(ws + WS_MISCRAW) + cb;
                if (wc < 2) { EPI_ROWS({ *(f32x4*)(mr + (size_t)row * 64) = (f32x4){v[0], v[1], v[2], v[3]}; *(f32x4*)(mr + (size_t)row * 64 + 4) = (f32x4){v[4], v[5], v[6], v[7]}; }) }
            }
        }
    }
#undef EPI_ROWS
#undef EPI_PACK
};
struct EpiUKV {
    static constexpr bool PERM = true, AFTER_DRAIN = false;
    bf16_t* kvm; const float* sskv;
    __device__ __forceinline__ void operator()(const f32x4 (&acc)[2][2][4][2], const Unit& u, int wr, int wc, int fr, int fq) const {
        asm volatile("" : "+v"(fq), "+v"(fr));
        const int col0 = u.pn * BM + wc * 32 + 8 * fq;
#pragma unroll
        for (int ai = 0; ai < 2; ++ai)
#pragma unroll
            for (int m = 0; m < 4; ++m) { const int row = u.pm * BM + ai * HALF + wr * 64 + m * 16 + fr; bf16_t* rowp = kvm + (size_t)row * 768 + col0;
                const float rs = rsqrtf(sskv[row] * (1.f / 128.f) + EPS);
#pragma unroll
                for (int bj = 0; bj < 2; ++bj) { const f32x4 a = acc[ai][bj][m][0] * rs, b = acc[ai][bj][m][1] * rs;
                    u32x4 w; w.x = cvt_pk_bf16(a[0], a[1]); w.y = cvt_pk_bf16(a[2], a[3]); w.z = cvt_pk_bf16(b[0], b[1]); w.w = cvt_pk_bf16(b[2], b[3]);
                    *(u32x4*)(rowp + bj * HALF) = w; }
                asm volatile("" ::: "memory"); }
    }
};
struct EpiPlain {
    static constexpr bool PERM = true, AFTER_DRAIN = false;
    bf16_t* out; int ld;
    __device__ __forceinline__ void operator()(const f32x4 (&acc)[2][2][4][2], const Unit& u, int wr, int wc, int fr, int fq) const {
        asm volatile("" : "+v"(fq), "+v"(fr));
        const int col0 = u.pn * BM + wc * 32 + 8 * fq;
#pragma unroll
        for (int ai = 0; ai < 2; ++ai)
#pragma unroll
            for (int m = 0; m < 4; ++m) { bf16_t* rowp = out + (size_t)(u.pm * BM + ai * HALF + wr * 64 + m * 16 + fr) * ld + col0;
#pragma unroll
                for (int bj = 0; bj < 2; ++bj) { const f32x4 a = acc[ai][bj][m][0], b = acc[ai][bj][m][1];
                    u32x4 w; w.x = cvt_pk_bf16(a[0], a[1]); w.y = cvt_pk_bf16(a[2], a[3]); w.z = cvt_pk_bf16(b[0], b[1]); w.w = cvt_pk_bf16(b[2], b[3]);
                    *(u32x4*)(rowp + bj * HALF) = w; } }
    }
};
struct EpiRes {
    static constexpr bool PERM = false, AFTER_DRAIN = false;
    const float* xin; float* xout; const float* gate;
    __device__ __forceinline__ void operator()(const f32x4 (&acc)[2][2][4][2], const Unit& u, int wr, int wc, int fr, int fq) const {
        asm volatile("" : "+v"(fq), "+v"(fr));
        const int b = (u.pm * BM) / S_; const int col0 = u.pn * BM + wc * 32 + 4 * fq;
        f32x4 gv[2][2];
#pragma unroll
        for (int bj = 0; bj < 2; ++bj)
#pragma unroll
            for (int n = 0; n < 2; ++n) gv[bj][n] = *(const f32x4*)(gate + (size_t)b * 6144 + col0 + bj * HALF + n * 16);
#pragma unroll
        for (int ai = 0; ai < 2; ++ai)
#pragma unroll
            for (int m = 0; m < 4; ++m) { const size_t off = (size_t)(u.pm * BM + ai * HALF + wr * 64 + m * 16 + fr) * D_ + col0;
#pragma unroll
                for (int bj = 0; bj < 2; ++bj)
#pragma unroll
                    for (int n = 0; n < 2; ++n) { const f32x4 xi = *(const f32x4*)(xin + off + bj * HALF + n * 16); *(f32x4*)(xout + off + bj * HALF + n * 16) = xi + gv[bj][n] * acc[ai][bj][m][n]; } }
    }
};
struct EpiGU {
    static constexpr bool PERM = true, AFTER_DRAIN = false;
    bf16_t* act;
    __device__ __forceinline__ void operator()(const f32x4 (&acc)[2][2][4][2], const Unit& u, int wr, int wc, int fr, int fq) const {
        asm volatile("" : "+v"(fq), "+v"(fr));
        const int col0 = u.pn * HALF + wc * 32 + 8 * fq;
#pragma unroll
        for (int ai = 0; ai < 2; ++ai)
#pragma unroll
            for (int m = 0; m < 4; ++m) { const int row = u.pm * BM + ai * HALF + wr * 64 + m * 16 + fr; float o[8];
#pragma unroll
                for (int n = 0; n < 2; ++n)
#pragma unroll
                    for (int i = 0; i < 4; ++i) { const float g = acc[ai][0][m][n][i], up = acc[ai][1][m][n][i]; o[4 * n + i] = g / (1.f + __expf(-g)) * up; }
                u32x4 w; w.x = cvt_pk_bf16(o[0], o[1]); w.y = cvt_pk_bf16(o[2], o[3]); w.z = cvt_pk_bf16(o[4], o[5]); w.w = cvt_pk_bf16(o[6], o[7]);
                *(u32x4*)(act + (size_t)row * FF + col0) = w; }
    }
};
template <class Epi, class Sched, bool ALIGN_EPI = false, bool SP2 = false>
__device__ __forceinline__ void gemm_phase(PG8_LAS unsigned char* lds, const Gemm g, const Sched& S, const Epi& E, int wid_in) {
    const int wid = __builtin_amdgcn_readfirstlane(wid_in), lane = fresh_lane(), tid = wid * 64 + lane, wr = wid >> 2, wc = wid & 3;
    const int K = g.K, nt = K / BK;
    unsigned voffA[2], voffB[2];
#pragma unroll
    for (int i = 0; i < 2; ++i) { int R, C; stage_rc(tid * 16 + i * 8192, R, C); const int Rb = Epi::PERM ? ((R & ~31) + perm32(R & 31)) : R;
        voffA[i] = (unsigned)(R * K + C) * 2u; voffB[i] = (unsigned)(Rb * K + C) * 2u; }
    const size_t kstep = (size_t)(BK * 2);
    const size_t hstep = (size_t)HALF * K * 2;
    const size_t tstep = 2 * hstep;
    const unsigned ldsw = (unsigned)wid * 1024u;
    const int aoff = lds_byte(wr * 64 + (lane & 15), (lane >> 4) * 8), boff = lds_byte(wc * 32 + (lane & 15), (lane >> 4) * 8);
#define PG8_SA(b, h) (((b) * 2 + (h)) * HTB)
#define PG8_SB(b, h) ((4 + (b) * 2 + (h)) * HTB)
#define PG8_STAGE(bufoff, gbase, voff) do { _Pragma("unroll") for (int _i = 0; _i < 2; ++_i) \
        __builtin_amdgcn_global_load_lds((const unsigned*)((const char*)(gbase) + (voff)[_i]), (PG8_LAS unsigned*)(lds + (bufoff) + ldsw + _i * 8192), 16, 0, 0); } while (0)
#define PG8_LDA(dst, b, h) do { _Pragma("unroll") for (int m = 0; m < 4; ++m) _Pragma("unroll") for (int k = 0; k < 2; ++k) dst[m][k] = *(const PG8_LAS bf16x8*)(lds + PG8_SA(b, h) + aoff + m * 2048 + k * 1024); } while (0)
#define PG8_LDB(dst, b, h) do { _Pragma("unroll") for (int n = 0; n < 2; ++n) _Pragma("unroll") for (int k = 0; k < 2; ++k) dst[n][k] = *(const PG8_LAS bf16x8*)(lds + PG8_SB(b, h) + boff + n * 2048 + k * 1024); } while (0)
#define PG8_MMA(ai, bj, At, Bt) do { __builtin_amdgcn_s_setprio(1); _Pragma("unroll") for (int m = 0; m < 4; ++m) _Pragma("unroll") for (int n = 0; n < 2; ++n) _Pragma("unroll") for (int k = 0; k < 2; ++k) \
        acc[ai][bj][m][n] = __builtin_amdgcn_mfma_f32_16x16x32_bf16(Bt[n][k], At[m][k], acc[ai][bj][m][n], 0, 0, 0); __builtin_amdgcn_s_setprio(0); } while (0)
#define PG8_WAIT_V(n) asm volatile("s_waitcnt vmcnt(" #n ")" ::: "memory")
#define PG8_WAIT_L(n) asm volatile("s_waitcnt lgkmcnt(" #n ")" ::: "memory")
#define PG8_BAR __builtin_amdgcn_s_barrier()
#define PG8_SCHED __builtin_amdgcn_sched_barrier(0)
    Unit cur, nxt; int ui = 0;
    if (!S.next(0, cur)) return;
    f32x4 acc[2][2][4][2];
#pragma unroll
    for (int a = 0; a < 2; ++a)
#pragma unroll
        for (int b = 0; b < 2; ++b)
#pragma unroll
            for (int m = 0; m < 4; ++m)
#pragma unroll
                for (int n = 0; n < 2; ++n) acc[a][b][m][n] = (f32x4){0.f, 0.f, 0.f, 0.f};
    bf16x8 At[4][2], B0[2][2], B1[2][2];
    const char* cA = (const char*)g.A + (size_t)cur.pm * tstep; const char* cB = (const char*)g.Bt + (size_t)cur.pn * tstep;
    S.a_ready(cur);
    if constexpr (SP2) {
        PG8_STAGE(PG8_SB(0, 0), cB, voffB); PG8_STAGE(PG8_SB(0, 1), cB + hstep, voffB); PG8_STAGE(PG8_SA(0, 0), cA, voffA); PG8_STAGE(PG8_SA(0, 1), cA + hstep, voffA);
        if (wr == 1) PG8_BAR;
        PG8_WAIT_V(2); PG8_BAR;
        PG8_STAGE(PG8_SB(1, 0), cB + kstep, voffB); PG8_STAGE(PG8_SA(1, 0), cA + kstep, voffA); PG8_STAGE(PG8_SB(1, 1), cB + hstep + kstep, voffB);
        PG8_WAIT_V(6); PG8_BAR;
    } else {
        PG8_STAGE(PG8_SB(0, 0), cB, voffB); PG8_STAGE(PG8_SA(0, 0), cA, voffA); PG8_STAGE(PG8_SB(0, 1), cB + hstep, voffB); PG8_STAGE(PG8_SA(0, 1), cA + hstep, voffA);
        if (wr == 1) PG8_BAR;
        PG8_WAIT_V(4); PG8_BAR;
        PG8_STAGE(PG8_SB(1, 0), cB + kstep, voffB); PG8_STAGE(PG8_SA(1, 0), cA + kstep, voffA); PG8_STAGE(PG8_SB(1, 1), cB + hstep + kstep, voffB);
        PG8_WAIT_V(6); PG8_BAR;
    }
    for (;;) {
        const bool has_next = S.next(ui + 1, nxt);
        const char* nA = has_next ? (const char*)g.A + (size_t)nxt.pm * tstep : cA; const char* nB = has_next ? (const char*)g.Bt + (size_t)nxt.pn * tstep : cB;
        for (int t = 0; t < nt; t += 2) {
            const bool last = (t == nt - 2);
            const char* a1 = cA + (size_t)(t + 1) * kstep;
            const char* a2 = last ? nA : cA + (size_t)(t + 2) * kstep; const char* b2 = last ? nB : cB + (size_t)(t + 2) * kstep;
            const char* a3 = a2 + kstep; const char* b3 = b2 + kstep;
            if (last && has_next) S.a_ready(nxt);
            if constexpr (SP2) {
            PG8_LDB(B0, 0, 0); PG8_LDB(B1, 0, 1); PG8_SCHED; PG8_LDA(At, 0, 0); PG8_STAGE(PG8_SA(1, 1), a1 + hstep, voffA);
            PG8_WAIT_V(8); PG8_WAIT_L(0); PG8_BAR; PG8_MMA(0, 0, At, B0); PG8_MMA(0, 1, At, B1); PG8_BAR; PG8_SCHED;
            PG8_LDA(At, 0, 1); PG8_STAGE(PG8_SB(0, 0), b2, voffB); PG8_STAGE(PG8_SB(0, 1), b2 + hstep, voffB); PG8_STAGE(PG8_SA(0, 0), a2, voffA);
            PG8_WAIT_V(8); PG8_WAIT_L(0); PG8_BAR; PG8_MMA(1, 0, At, B0); PG8_MMA(1, 1, At, B1); PG8_BAR; PG8_SCHED;
            PG8_LDB(B0, 1, 0); PG8_LDB(B1, 1, 1); PG8_SCHED; PG8_LDA(At, 1, 0); PG8_STAGE(PG8_SA(0, 1), a2 + hstep, voffA);
            PG8_WAIT_V(8); PG8_WAIT_L(0); PG8_BAR; PG8_MMA(0, 0, At, B0); PG8_MMA(0, 1, At, B1); PG8_BAR; PG8_SCHED;
            PG8_LDA(At, 1, 1); PG8_STAGE(PG8_SB(1, 0), b3, voffB); PG8_STAGE(PG8_SB(1, 1), b3 + hstep, voffB); PG8_STAGE(PG8_SA(1, 0), a3, voffA);
            PG8_WAIT_V(8); PG8_WAIT_L(0); PG8_BAR; PG8_MMA(1, 0, At, B0); PG8_MMA(1, 1, At, B1); PG8_BAR; PG8_SCHED;
            } else {
            PG8_LDB(B0, 0, 0); PG8_SCHED; PG8_LDA(At, 0, 0); PG8_STAGE(PG8_SA(1, 1), a1 + hstep, voffA);
            PG8_WAIT_L(8); PG8_BAR; PG8_WAIT_L(0); PG8_MMA(0, 0, At, B0); PG8_BAR; PG8_SCHED;
            PG8_LDB(B1, 0, 1); PG8_STAGE(PG8_SB(0, 0), b2, voffB);
            PG8_BAR; PG8_WAIT_L(0); PG8_MMA(0, 1, At, B1); PG8_BAR;
            PG8_LDA(At, 0, 1); PG8_STAGE(PG8_SA(0, 0), a2, voffA);
            PG8_BAR; PG8_WAIT_L(0); PG8_MMA(1, 0, At, B0); PG8_BAR; PG8_SCHED;
            PG8_STAGE(PG8_SB(0, 1), b2 + hstep, voffB);
            PG8_WAIT_V(6); PG8_BAR; PG8_MMA(1, 1, At, B1); PG8_BAR;
            PG8_LDB(B0, 1, 0); PG8_SCHED; PG8_LDA(At, 1, 0); PG8_STAGE(PG8_SA(0, 1), a2 + hstep, voffA);
            PG8_WAIT_L(8); PG8_BAR; PG8_WAIT_L(0); PG8_MMA(0, 0, At, B0); PG8_BAR; PG8_SCHED;
            PG8_LDB(B1, 1, 1); PG8_STAGE(PG8_SB(1, 0), b3, voffB);
            PG8_BAR; PG8_WAIT_L(0); PG8_MMA(0, 1, At, B1); PG8_BAR;
            PG8_LDA(At, 1, 1); PG8_STAGE(PG8_SA(1, 0), a3, voffA);
            PG8_BAR; PG8_WAIT_L(0); PG8_MMA(1, 0, At, B0); PG8_BAR; PG8_SCHED;
            PG8_STAGE(PG8_SB(1, 1), b3 + hstep, voffB);
            PG8_WAIT_V(6); PG8_BAR; PG8_MMA(1, 1, At, B1); PG8_BAR;
            }
        }
        if constexpr (ALIGN_EPI) { if (wr == 0) PG8_BAR; }
        if constexpr (!Epi::AFTER_DRAIN) { const int ln = fresh_lane(); E(acc, cur, wr, wc, ln & 15, ln >> 4); S.done(cur); }
        if (!has_next) break;
#pragma unroll
        for (int a = 0; a < 2; ++a)
#pragma unroll
            for (int b = 0; b < 2; ++b)
#pragma unroll
                for (int m = 0; m < 4; ++m)
#pragma unroll
                    for (int n = 0; n < 2; ++n) acc[a][b][m][n] = (f32x4){0.f, 0.f, 0.f, 0.f};
        cur = nxt; cA = nA; cB = nB; ++ui;
        if constexpr (ALIGN_EPI) { if (wr == 1) PG8_BAR; }
    }
    PG8_WAIT_V(0);
    if constexpr (!ALIGN_EPI) { if (wr == 0) PG8_BAR; }
    PG8_BAR;
    if constexpr (Epi::AFTER_DRAIN) { const int ln = fresh_lane(); E.fused(acc, cur, wr, wc, ln & 15, ln >> 4, lds, wid, ln); S.done(cur); }
#undef PG8_SA
#undef PG8_SB
#undef PG8_STAGE
#undef PG8_LDA
#undef PG8_LDB
#undef PG8_MMA
#undef PG8_WAIT_V
#undef PG8_WAIT_L
#undef PG8_BAR
#undef PG8_SCHED
}
}

#define GAS __attribute__((address_space(1)))
#define LAS __attribute__((address_space(3)))
typedef float f32x4 __attribute__((ext_vector_type(4)));
typedef unsigned v4u __attribute__((ext_vector_type(4)));
typedef GAS unsigned gu32;
#define XB_TMO      128
#define XB_XCNT(j)  (256  + 64 * (j))
#define XB_XSUB(j)  (1280 + 64 * (j))
#define XB_XGEN(j)  (2304 + 64 * (j))
#define XB_TOP      3328
#define XB_TOPGEN   3392
#define XCD_BAR_WORDS 3456
#define XB_SPIN_CAP (1u << 18)

__device__ __forceinline__ unsigned xb_ld(unsigned* p)              { return __hip_atomic_load(p, __ATOMIC_RELAXED, __HIP_MEMORY_SCOPE_AGENT); }
__device__ __forceinline__ unsigned xb_add(unsigned* p, unsigned v) { return __hip_atomic_fetch_add(p, v, __ATOMIC_RELAXED, __HIP_MEMORY_SCOPE_AGENT); }
__device__ __forceinline__ unsigned xb_xcc_id() { return (unsigned)__builtin_amdgcn_s_getreg((3 << 11) | 20) & 0xFu; }
#define XB_SPIN(cond, bar) do { unsigned _sp = 0; while (cond) { __builtin_amdgcn_s_sleep(1); \
    if ((++_sp & 255u) == 0u) { if (xb_ld(&(bar)[XB_TMO])) break; if (_sp > XB_SPIN_CAP) { atomicAdd(&(bar)[XB_TMO], 1u); break; } } } } while (0)

struct XcdBarrier {
    unsigned* bar; unsigned x;
    volatile LAS unsigned* st;
};

__device__ __forceinline__ XcdBarrier xcd_barrier_post(unsigned* bar, volatile LAS unsigned* st, int tid) {
    XcdBarrier b; b.bar = bar; b.x = xb_xcc_id(); b.st = st;
    if (tid == 0) (void)xb_add(&bar[XB_XCNT(b.x)], 1u);
    return b;
}
__device__ __forceinline__ void xcd_barrier_complete(unsigned* bar, unsigned x, unsigned& nloc, unsigned& nx) {
    const unsigned G = gridDim.x * gridDim.y * gridDim.z;
    unsigned sum, cnt, mine, sp = 0u;
    for (;;) {
        sum = 0u; cnt = 0u; mine = 0u;
#pragma unroll
        for (unsigned j = 0; j < 16; ++j) { const unsigned c = xb_ld(&bar[XB_XCNT(j)]); sum += c; cnt += (c > 0u) ? 1u : 0u; mine = (j == x) ? c : mine; }
        if (sum == G) break;
        __builtin_amdgcn_s_sleep(1);
        if ((++sp & 255u) == 0u) { if (xb_ld(&bar[XB_TMO])) break; if (sp > XB_SPIN_CAP) { atomicAdd(&bar[XB_TMO], 1u); break; } }
    }
    nloc = mine > 0u ? mine : 1u; nx = cnt > 0u ? cnt : 1u;
}

__device__ __forceinline__ void xcd_barrier(const XcdBarrier& b, int tid) {
    asm volatile("s_waitcnt vmcnt(0)" ::: "memory");
    __syncthreads();
    if (tid == 0) {
        unsigned* bar = b.bar;
        __builtin_amdgcn_s_waitcnt(0);
        unsigned nloc = b.st[0], nx = b.st[1];
        if (nloc == 0u) { xcd_barrier_complete(bar, b.x, nloc, nx); b.st[0] = nloc; b.st[1] = nx; }
        const unsigned old = xb_add(&bar[XB_XSUB(b.x)], 1u);
        const unsigned gen = old / nloc;
        if (old + 1u == (gen + 1u) * nloc) {
            __builtin_amdgcn_fence(__ATOMIC_RELEASE, "agent");
            asm volatile("s_waitcnt vmcnt(0)" ::: "memory");
            const unsigned og = xb_add(&bar[XB_TOP], 1u);
            const unsigned tg = og / nx;
            if (og + 1u == (tg + 1u) * nx) xb_add(&bar[XB_TOPGEN], 1u);
            else XB_SPIN(xb_ld(&bar[XB_TOPGEN]) == tg, bar);
            __builtin_amdgcn_fence(__ATOMIC_ACQUIRE, "agent");
            xb_add(&bar[XB_XGEN(b.x)], 1u);
            asm volatile("s_waitcnt vmcnt(0)" ::: "memory");
        } else {
            XB_SPIN(xb_ld(&bar[XB_XGEN(b.x)]) == gen, bar);
            __builtin_amdgcn_fence(__ATOMIC_ACQUIRE, "agent");
            asm volatile("s_waitcnt vmcnt(0)" ::: "memory");
        }
    }
    __syncthreads();
}

constexpr int NTHR = 512, NWAVES = 8;
constexpr int RING_BYTES = 131072, MISC_OFF = RING_BYTES + 320, LDS_BYTES = 147456;
constexpr int CW_BAR = 4096;
constexpr size_t CTL_ZERO_BYTES = 64 * 1024;
constexpr size_t WT_IN = WS_WT, WT_OUT = WT_IN + (size_t)2560 * 1024 * 2, WT_GU = WT_OUT + (size_t)1024 * 1024 * 2, WT_DOWN = WT_GU + (size_t)5632 * 1024 * 2,
                 WT_UQ = WT_DOWN + (size_t)1024 * 2816 * 2, WT_UKV = WT_UQ + (size_t)768 * 256 * 2, WT_CK = WT_UKV + (size_t)768 * 128 * 2, WT_CV = WT_CK + (size_t)64 * 2048 * 2,
                 WT_QM = WT_CV + (size_t)64 * 2048 * 2, WT_KM = WT_QM + 4 * 64 * 64 * 2, WT_END = WT_KM + 4 * 64 * 64 * 2;
static_assert(WT_END <= WS_HB, "weights");
constexpr int NPH = 22, PPL = 10;
constexpr int PROBE_SEL = 0;
constexpr int REP_MASK = 0;
#ifndef PHM
#define PHM 0xffff
#endif
struct MP { const float* in[N_IN]; float* out; unsigned char* ws; int ph_lo, ph_hi, coop, pad; };

struct MPK {
    const __attribute__((address_space(4))) MP* k;
    struct InArr { const __attribute__((address_space(4))) MP* k; __device__ __forceinline__ const float* operator[](int i) const { return k->in[i]; } };
    __device__ __forceinline__ InArr in_() const { return InArr{k}; }
};
#define PIN(i) (p.k->in[i])
__device__ __forceinline__ unsigned pk2(float lo, float hi) { return (unsigned)f2bf(lo) | ((unsigned)f2bf(hi) << 16); }
struct MapId { int n; __device__ __forceinline__ int operator()(int c) const { return c < n ? c : -1; } };
struct MapIn { __device__ __forceinline__ int operator()(int c) const {
    if (c < 1152) return c; if (c < 1280) return 1426 + (c - 1152); if (c < 1536) return 1170 + (c - 1280); if (c < 2304) return 1586 + (c - 1536);
    if (c < 2336) return 1554 + (c - 2304); if (c < 2354) return 1152 + (c - 2336); if (c < 2362) return c; return -1; } };
struct MapGU { __device__ __forceinline__ int operator()(int c) const { const int t = c >> 8, w = c & 255; return (w < 128) ? t * 128 + w : FF + t * 128 + (w - 128); } };
template <class Map> __device__ __forceinline__ void transpose_item(const float* W, int K, int ldw, const Map& map, const float* kscale, bf16* WT, LAS float* scr, int item, int nblk, int lane) {
    const int kb = item / nblk, nb = item % nblk, k0 = 64 * kb, n0 = 32 * nb;
    const int np = 2 * (lane & 15);
    const int sc = map(n0 + np);
#pragma unroll 8
    for (int i = 0; i < 16; ++i) { const int kk = 4 * i + (lane >> 4); float2 v = (sc >= 0) ? *(const float2*)(W + (size_t)(k0 + kk) * ldw + sc) : make_float2(0.f, 0.f);
        if (kscale) { const float ksc = kscale[k0 + kk]; v.x *= ksc; v.y *= ksc; } scr[kk * 33 + np] = v.x; scr[kk * 33 + np + 1] = v.y; }
    asm volatile("s_waitcnt lgkmcnt(0)" ::: "memory");
    const int c = lane & 7;
#pragma unroll
    for (int j = 0; j < 4; ++j) { const int n = (lane >> 3) + 8 * j; const LAS float* s = scr + (8 * c) * 33 + n;
        v4u o; o.x = pk2(s[0 * 33], s[1 * 33]); o.y = pk2(s[2 * 33], s[3 * 33]); o.z = pk2(s[4 * 33], s[5 * 33]); o.w = pk2(s[6 * 33], s[7 * 33]);
        *(v4u*)(WT + (size_t)(n0 + n) * K + k0 + 8 * c) = o; }
    asm volatile("s_waitcnt lgkmcnt(0)" ::: "memory");
}
__device__ __forceinline__ void norm_rows(const float* x, const float* g, const float* shift, const float* scale, bf16* hb, float* outf, int mode, int gw, int ngw, int lane) {
    const int rpw = T_ / ngw, m0 = gw * rpw, b = m0 / S_;
    float4 gs[4], sh[4];
#pragma unroll
    for (int j = 0; j < 4; ++j) { const int col = 4 * lane + 256 * j; gs[j] = *(const float4*)(g + col);
        if (mode != 2) { const float4 sc = *(const float4*)(scale + (size_t)b * 6144 + col); sh[j] = *(const float4*)(shift + (size_t)b * 6144 + col);
            gs[j].x *= 1.f + sc.x; gs[j].y *= 1.f + sc.y; gs[j].z *= 1.f + sc.z; gs[j].w *= 1.f + sc.w; }
        else sh[j] = make_float4(0.f, 0.f, 0.f, 0.f); }
    for (int r = 0; r < rpw; r += 2) {
        const int m = m0 + r;
        const float4* xr = (const float4*)(x + (size_t)m * D_) + lane; const float4* xr2 = xr + D_ / 4;
        float4 v[4], w[4]; float s = 0.f, s2 = 0.f;
#pragma unroll
        for (int j = 0; j < 4; ++j) { v[j] = xr[64 * j]; w[j] = xr2[64 * j]; }
#pragma unroll
        for (int j = 0; j < 4; ++j) { s += v[j].x * v[j].x + v[j].y * v[j].y + v[j].z * v[j].z + v[j].w * v[j].w; s2 += w[j].x * w[j].x + w[j].y * w[j].y + w[j].z * w[j].z + w[j].w * w[j].w; }
        const float r1 = rsqrtf(wave_sum2(s) * (1.f / D_) + EPS), r2 = rsqrtf(wave_sum2(s2) * (1.f / D_) + EPS);
#pragma unroll
        for (int j = 0; j < 4; ++j) {
            const int col = 4 * lane + 256 * j;
            float4 o, o2;
            o.x = v[j].x * r1 * gs[j].x + sh[j].x; o.y = v[j].y * r1 * gs[j].y + sh[j].y; o.z = v[j].z * r1 * gs[j].z + sh[j].z; o.w = v[j].w * r1 * gs[j].w + sh[j].w;
            o2.x = w[j].x * r2 * gs[j].x + sh[j].x; o2.y = w[j].y * r2 * gs[j].y + sh[j].y; o2.z = w[j].z * r2 * gs[j].z + sh[j].z; o2.w = w[j].w * r2 * gs[j].w + sh[j].w;
            if (mode == 2) { *(float4*)(outf + (size_t)m * D_ + col) = o; *(float4*)(outf + (size_t)(m + 1) * D_ + col) = o2; }
            else { uint2 q; q.x = pk2(o.x, o.y); q.y = pk2(o.z, o.w); *(uint2*)(hb + (size_t)m * D_ + col) = q;
                   uint2 q2; q2.x = pk2(o2.x, o2.y); q2.y = pk2(o2.z, o2.w); *(uint2*)(hb + (size_t)(m + 1) * D_ + col) = q2; }
        }
    }
}
__device__ __forceinline__ void ph_p0(const MPK& p, LAS unsigned char* lds, int tid) {
    const int wave = tid >> 6, lane = tid & 63;
    LAS float* ca = (LAS float*)lds; LAS float* red = ca + 8192;
    unsigned char* ws = p.k->ws; float* mod = (float*)(ws + WS_MOD);
    const float* c = PIN(I_C);
    for (int i = tid; i < 8192; i += NTHR) ca[i] = siluf_(c[i]);
    __syncthreads();
    for (int item = blockIdx.x; item < 192; item += gridDim.x) {
        const int l = item / 96, j = (item % 96) * 64 + lane;
        const float* w = PIN(I_WADA) + (size_t)l * 1024 * 6144 + j;
        float acc[8];
#pragma unroll
        for (int b = 0; b < 8; ++b) acc[b] = 0.f;
#pragma unroll 4
        for (int k = wave * 128; k < wave * 128 + 128; ++k) {
            const float wv = w[(size_t)k * 6144];
#pragma unroll
            for (int b = 0; b < 8; ++b) acc[b] += ca[b * 1024 + k] * wv;
        }
#pragma unroll
        for (int b = 0; b < 8; ++b) red[(wave * 8 + b) * 64 + lane] = acc[b];
        __syncthreads();
        { const int b = wave; float s = 0.f;
#pragma unroll
          for (int w8 = 0; w8 < 8; ++w8) s += red[(w8 * 8 + b) * 64 + lane];
          mod[((size_t)l * 8 + b) * 6144 + j] = s + PIN(I_BADA)[l * 6144 + j]; }
        __syncthreads();
    }
    const int* pos = (const int*)PIN(I_POS);
    float *cosP = (float*)(ws + WS_COSP), *sinP = (float*)(ws + WS_SINP), *cosM = (float*)(ws + WS_COSM), *sinM = (float*)(ws + WS_SINM);
    for (int i = blockIdx.x * NTHR + tid; i < T_ * 24; i += gridDim.x * NTHR) {
        const int m = i / 24, f = i % 24;
        double inv; if (f < 8) inv = pow(500000.0, -(double)(2 * f) / 16.0); else inv = pow(500000.0, -(double)(2 * (f - 8)) / 32.0);
        const float ang = (float)pos[m] * (float)inv;
        const double a = (double)ang, kq = rint(a * 0.15915494309189535), r = a - kq * 6.283185307179586476925;
        const float cs = (float)cos(r), sn = (float)sin(r);
        if (f < 8) { cosP[m * 8 + f] = cs; sinP[m * 8 + f] = sn; } else { cosM[m * 16 + f - 8] = cs; sinM[m * 16 + f - 8] = sn; }
    }
}
__device__ __forceinline__ void early_transposes(const MPK& p, int l, LAS unsigned char* lds, int tid, int first) {
    const int wave = tid >> 6, lane = tid & 63;
    if ((int)blockIdx.x < first) return;
    const int gw = ((int)blockIdx.x - first) * NWAVES + wave, ngw = ((int)gridDim.x - first) * NWAVES;
    unsigned char* ws = p.k->ws;
    LAS float* scr = (LAS float*)(lds + wave * 8704);
    constexpr int I0 = 16 * 80, I4 = 4 * 24, I5 = 2 * 24, I6 = 32 * 2, I7 = 32 * 2, I8 = 8, I9 = 8;
    constexpr int NIT = I0 + I4 + I5 + I6 + I7 + I8 + I9;
    for (int it = gw; it < NIT; it += ngw) {
        int r = it;
        if (r < I0) { transpose_item(PIN(I_WIN) + (size_t)l * D_ * DIN, D_, DIN, MapIn{}, nullptr, (bf16*)(ws + WT_IN), scr, r, 80, lane); continue; } r -= I0;
        if (r < I4) { transpose_item(PIN(I_WUQ) + (size_t)l * 256 * 576, 256, 576, MapId{576}, PIN(I_GQL) + l * 256, (bf16*)(ws + WT_UQ), scr, r, 24, lane); continue; } r -= I4;
        if (r < I5) { transpose_item(PIN(I_WUKV) + (size_t)l * 128 * 768, 128, 768, MapId{768}, PIN(I_GKVL) + l * 128, (bf16*)(ws + WT_UKV), scr, r, 24, lane); continue; } r -= I5;
        if (r < I6) { transpose_item(PIN(I_WCK) + (size_t)l * 2048 * 64, 2048, 64, MapId{64}, nullptr, (bf16*)(ws + WT_CK), scr, r, 2, lane); continue; } r -= I6;
        if (r < I7) { transpose_item(PIN(I_WCV) + (size_t)l * 2048 * 64, 2048, 64, MapId{64}, nullptr, (bf16*)(ws + WT_CV), scr, r, 2, lane); continue; } r -= I7;
        if (r < I8) { const int h = r >> 1; transpose_item(PIN(I_WQM) + (size_t)l * 16384 + h * 4096, 64, 64, MapId{64}, nullptr, (bf16*)(ws + WT_QM) + h * 4096, scr, r & 1, 2, lane); continue; } r -= I8;
        { const int h = r >> 1; transpose_item(PIN(I_WKM) + (size_t)l * 16384 + h * 4096, 64, 64, MapId{64}, nullptr, (bf16*)(ws + WT_KM) + h * 4096, scr, r & 1, 2, lane); }
    }
}
__device__ __forceinline__ void ph_prep(const MPK& p, int l, LAS unsigned char* lds, int tid) {
    const int wave = tid >> 6, lane = tid & 63;
    const int gw = blockIdx.x * NWAVES + wave, ngw = gridDim.x * NWAVES;
    unsigned char* ws = p.k->ws;
    LAS float* scr = (LAS float*)(lds + wave * 8704);
    for (int i = blockIdx.x * NTHR + tid; i < 2 * T_; i += gridDim.x * NTHR) ((float*)(ws + WS_SSQL))[i] = 0.f;
    if (l == 0) early_transposes(p, l, lds, tid, 0);
    const float* xin = (l == 0) ? PIN(I_X) : p.k->out;
    const float* modl = (const float*)(ws + WS_MOD) + (size_t)l * 8 * 6144;
    norm_rows(xin, PIN(I_GN1) + l * D_, modl + 0, modl + 1024, (bf16*)(ws + WS_HB), nullptr, 0, gw, ngw, lane);
}
__device__ __forceinline__ void late_transposes(const MPK& p, int l, LAS unsigned char* lds, int tid, int first) {
    const int wave = tid >> 6, lane = tid & 63;
    if ((int)blockIdx.x < first) return;
    const int gw = ((int)blockIdx.x - first) * NWAVES + wave, ngw = ((int)gridDim.x - first) * NWAVES;
    unsigned char* ws = p.k->ws;
    LAS float* scr = (LAS float*)(lds + wave * 8704);
    constexpr int I1 = 16 * 32, I2 = 16 * 176, I3 = 44 * 32;
    for (int it = gw; it < I1 + I2 + I3; it += ngw) {
        int r = it;
        if (r < I1) { transpose_item(PIN(I_WOUT) + (size_t)l * D_ * D_, D_, D_, MapId{D_}, nullptr, (bf16*)(ws + WT_OUT), scr, r, 32, lane); continue; } r -= I1;
        if (r < I2) { transpose_item(PIN(I_WGU) + (size_t)l * D_ * 2 * FF, D_, 2 * FF, MapGU{}, nullptr, (bf16*)(ws + WT_GU), scr, r, 176, lane); continue; } r -= I2;
        transpose_item(PIN(I_WDOWN) + (size_t)l * FF * D_, FF, D_, MapId{D_}, nullptr, (bf16*)(ws + WT_DOWN), scr, r, 32, lane);
    }
}
__device__ __forceinline__ void ph_mixnorm(const MPK& p, int l, int tid) {
    const int gw = blockIdx.x * NWAVES + (tid >> 6), ngw = gridDim.x * NWAVES, lane = tid & 63;
    unsigned char* ws = p.k->ws;
    bf16* mix = (bf16*)(ws + WS_HB); const float* ga = PIN(I_GOA) + l * 384; const float* gb = PIN(I_GOB) + l * 384;
    const bf16 *oc = (const bf16*)(ws + WS_OCMP), *os = (const bf16*)(ws + WS_OSLC), *ow = (const bf16*)(ws + WS_OWIN); const float* gm = (const float*)(ws + WS_GM);
#define UNPK8(dst, src) dst[0] = __uint_as_float(src.x << 16); dst[1] = __uint_as_float(src.x & 0xffff0000u); dst[2] = __uint_as_float(src.y << 16); dst[3] = __uint_as_float(src.y & 0xffff0000u); \
    dst[4] = __uint_as_float(src.z << 16); dst[5] = __uint_as_float(src.z & 0xffff0000u); dst[6] = __uint_as_float(src.w << 16); dst[7] = __uint_as_float(src.w & 0xffff0000u);
    const int rpw = T_ / ngw;
    const float* ggp = (lane < 48) ? ga + lane * 8 : gb + (lane - 48) * 8; const float4 gA0 = *(const float4*)ggp, gA1 = *(const float4*)(ggp + 4);
    const float* ggq = gb + (16 + (lane & 31)) * 8; const float4 gB0 = *(const float4*)ggq, gB1 = *(const float4*)(ggq + 4);
    for (int m = gw * rpw; m < gw * rpw + rpw; ++m) {
        bf16* r = mix + (size_t)m * D_;
        float v0[8], v1[8]; float sa = 0.f, sb = 0.f;
        if (lane < 48) {
            const size_t o = (size_t)m * 384 + lane * 8; const float* g3 = gm + (size_t)m * 32 + 3 * (lane >> 3);
            const float g0 = g3[0], g1 = g3[1], g2 = g3[2];
            const v4u c4 = *(const v4u*)(oc + o), s4 = *(const v4u*)(os + o), w4 = *(const v4u*)(ow + o);
            float c8[8], s8[8], w8[8]; UNPK8(c8, c4) UNPK8(s8, s4) UNPK8(w8, w4)
#pragma unroll
            for (int i = 0; i < 8; ++i) { v0[i] = g0 * c8[i] + g1 * s8[i] + g2 * w8[i]; sa += v0[i] * v0[i]; }
        } else {
            const v4u y4 = *(const v4u*)(r + 384 + (lane - 48) * 8); UNPK8(v0, y4)
#pragma unroll
            for (int i = 0; i < 8; ++i) sb += v0[i] * v0[i];
        }
        if (lane < 32) { const v4u y4 = *(const v4u*)(r + 384 + (16 + lane) * 8); UNPK8(v1, y4)
#pragma unroll
            for (int i = 0; i < 8; ++i) sb += v1[i] * v1[i]; }
        const float ra = rsqrtf(wave_sum2(sa) * (1.f / 384.f) + EPS), rb = rsqrtf(wave_sum2(sb) * (1.f / 384.f) + EPS);
        {
            const int col = (lane < 48) ? lane * 8 : 384 + (lane - 48) * 8; const float rr = (lane < 48) ? ra : rb;
            const float4 g0 = gA0, g1 = gA1;
            v4u w; w.x = pk2(v0[0] * rr * g0.x, v0[1] * rr * g0.y); w.y = pk2(v0[2] * rr * g0.z, v0[3] * rr * g0.w); w.z = pk2(v0[4] * rr * g1.x, v0[5] * rr * g1.y); w.w = pk2(v0[6] * rr * g1.z, v0[7] * rr * g1.w);
            *(v4u*)(r + col) = w;
        }
        if (lane < 32) { const float4 g0 = gB0, g1 = gB1;
            v4u w; w.x = pk2(v1[0] * rb * g0.x, v1[1] * rb * g0.y); w.y = pk2(v1[2] * rb * g0.z, v1[3] * rb * g0.w); w.z = pk2(v1[4] * rb * g1.x, v1[5] * rb * g1.y); w.w = pk2(v1[6] * rb * g1.z, v1[7] * rb * g1.w);
            *(v4u*)(r + 384 + (16 + lane) * 8) = w; }
    }
#undef UNPK8
}


typedef short bf16x8 __attribute__((ext_vector_type(8)));
typedef short s16x4 __attribute__((ext_vector_type(4)));
typedef float f32x16 __attribute__((ext_vector_type(16)));
typedef unsigned u32x2v __attribute__((ext_vector_type(2)));
constexpr int AT_BUF = 20480, AT_K32 = 8192, AT_V = 12288;
__device__ __forceinline__ unsigned cvtpk(float lo, float hi) { unsigned r; asm volatile("v_cvt_pk_bf16_f32 %0, %1, %2" : "=v"(r) : "v"(lo), "v"(hi)); return r; }
__device__ __forceinline__ float max3f(float a, float b, float c) { float r; asm("v_max3_f32 %0, %1, %2, %3" : "=v"(r) : "v"(a), "v"(b), "v"(c)); return r; }
__device__ __forceinline__ int crow(int r, int hi) { return (r & 3) + 8 * (r >> 2) + 4 * hi; }
__device__ __forceinline__ s16x4 vtr(LAS const unsigned char* p) { return __builtin_bit_cast(s16x4, __builtin_amdgcn_ds_read_tr16_b64_v4i16((LAS s16x4*)p)); }
enum { AM_CAUSAL = 0, AM_WINDOW = 1, AM_SLC = 2 };
struct AttnState { float m, l; f32x16 o[2]; f32x16 negm; bool started; long long twait; };
template <int NC> struct TileRegs { v4u k; v4u k2; v4u v; };
template <int NC> __device__ __forceinline__ void at_load(TileRegs<NC>& r, const bf16* Kg, int ldk, const bf16* Vg, int ldv, const bf16* K2g, int ldk2, int tile, int tid) {
    const int key = tid >> 3, c = tid & 7;
    r.k = *(const v4u*)(Kg + (size_t)(tile * 64 + key) * ldk + 8 * c);
    r.v = *(const v4u*)(Vg + (size_t)(tile * 64 + key) * ldv + 8 * c);
    if (NC == 6) { if (tid < 256) r.k2 = *(const v4u*)(K2g + (size_t)(tile * 64 + (tid >> 2)) * ldk2 + 8 * (tid & 3)); }
}
template <int NC> __device__ __forceinline__ void at_store(const TileRegs<NC>& r, LAS unsigned char* buf, int tid) {
    const int key = tid >> 3, c = tid & 7;
    *(LAS v4u*)(buf + key * 128 + 16 * (c ^ ((key >> 1) & 7))) = r.k;
    *(LAS v4u*)(buf + AT_V + (c >> 2) * 4096 + key * 64 + (c & 3) * 16) = r.v;
    if (NC == 6) { if (tid < 256) { const int k2 = tid >> 2, c2 = tid & 3; *(LAS v4u*)(buf + AT_K32 + k2 * 64 + 16 * (c2 ^ ((k2 >> 2) & 3))) = r.k2; } }
}
template <int NC> __device__ __forceinline__ void qk_tile(f32x16& p0, f32x16& p1, LAS const unsigned char* buf, const bf16x8 (&qf)[NC], const f32x16& negm, int lane) {
    const int r32 = lane & 31, hi = lane >> 5;
    p0 = negm; p1 = negm;
#pragma unroll
    for (int cc = 0; cc < NC; ++cc) {
        bf16x8 k0, k1;
        if (cc < 4) { const int k0r = r32, k1r = 32 + r32;
            k0 = *(LAS const bf16x8*)(buf + k0r * 128 + 16 * ((2 * cc + hi) ^ ((k0r >> 1) & 7)));
            k1 = *(LAS const bf16x8*)(buf + k1r * 128 + 16 * ((2 * cc + hi) ^ ((k1r >> 1) & 7))); }
        else { const int k0r = r32, k1r = 32 + r32, c2 = 2 * (cc - 4) + hi;
            k0 = *(LAS const bf16x8*)(buf + AT_K32 + k0r * 64 + 16 * (c2 ^ ((k0r >> 2) & 3)));
            k1 = *(LAS const bf16x8*)(buf + AT_K32 + k1r * 64 + 16 * (c2 ^ ((k1r >> 2) & 3))); }
        p0 = __builtin_amdgcn_mfma_f32_32x32x16_bf16(k0, qf[cc], p0, 0, 0, 0);
        p1 = __builtin_amdgcn_mfma_f32_32x32x16_bf16(k1, qf[cc], p1, 0, 0, 0);
    }
}
template <int MODE> __device__ __forceinline__ void mask_tile(f32x16& p0, f32x16& p1, int kpos0, int qpos, bool need_mask, bool sel_ok, int lane) {
    const int hi = lane >> 5;
    if (need_mask) {
        const int qw0m = __builtin_amdgcn_readfirstlane(qpos) & ~31;
        const bool diag = (kpos0 + 63 > qw0m), old = (MODE == AM_WINDOW) && (kpos0 < qw0m + 31 - 511);
        if (diag || old) {
            const float selterm = (MODE == AM_SLC && !sel_ok) ? -INFINITY : INFINITY;
            const int dbase = qpos - kpos0 - 4 * hi;
#pragma unroll
            for (int r = 0; r < 16; ++r) {
                const int d0 = dbase - ((r & 3) + 8 * (r >> 2)), d1 = d0 - 32;
                float l0 = ((float)d0 + 0.5f) * INFINITY, l1 = ((float)d1 + 0.5f) * INFINITY;
                if (MODE == AM_WINDOW) { l0 = fminf(l0, ((float)(511 - d0) + 0.5f) * INFINITY); l1 = fminf(l1, ((float)(511 - d1) + 0.5f) * INFINITY); }
                if (MODE == AM_SLC) { l0 = fminf(l0, selterm); l1 = fminf(l1, selterm); }
                p0[r] = fminf(p0[r], l0); p1[r] = fminf(p1[r], l1);
            }
        } else if (MODE == AM_SLC) {
            const float selterm = sel_ok ? INFINITY : -INFINITY;
#pragma unroll
            for (int r = 0; r < 16; ++r) { p0[r] = fminf(p0[r], selterm); p1[r] = fminf(p1[r], selterm); }
        }
    }
}
template <int MODE> __device__ __forceinline__ void softmax_tile(AttnState& st, f32x16& p0, f32x16& p1, bf16x8 (&pf)[4], int kpos0, int qpos, bool need_mask, bool sel_ok, int lane) {
    mask_tile<MODE>(p0, p1, kpos0, qpos, need_mask, sel_ok, lane);
    float mx = max3f(p0[0], p1[0], p0[1]), mx2 = max3f(p1[1], p0[2], p1[2]);
#pragma unroll
    for (int r = 3; r < 15; r += 2) { mx = max3f(mx, p0[r], p1[r]); mx2 = max3f(mx2, p0[r + 1], p1[r + 1]); }
    mx = max3f(mx, p0[15], p1[15]); mx = max3f(mx, mx2, mx2);
    mx = red32_max(mx);
    if (!st.started || __any(mx > 0.f)) {
        float dl = st.started ? fmaxf(mx, 0.f) : mx;
        dl = (dl > -1e30f) ? dl : 0.f;
        st.started = true;
        const float alpha = __builtin_amdgcn_exp2f(-dl);
        st.m += dl; st.l *= alpha;
#pragma unroll
        for (int r = 0; r < 16; ++r) { st.o[0][r] *= alpha; st.o[1][r] *= alpha; p0[r] -= dl; p1[r] -= dl; st.negm[r] = -st.m; }
    }
    float sum = 0.f;
#pragma unroll
    for (int r = 0; r < 16; ++r) { p0[r] = __builtin_amdgcn_exp2f(p0[r]); p1[r] = __builtin_amdgcn_exp2f(p1[r]); sum += p0[r] + p1[r]; }
    st.l += sum;
#pragma unroll
    for (int s2 = 0; s2 < 2; ++s2) {
        v4u a, b;
        a.x = cvtpk(p0[8 * s2 + 0], p0[8 * s2 + 1]); a.y = cvtpk(p0[8 * s2 + 2], p0[8 * s2 + 3]); a.z = cvtpk(p0[8 * s2 + 4], p0[8 * s2 + 5]); a.w = cvtpk(p0[8 * s2 + 6], p0[8 * s2 + 7]);
        b.x = cvtpk(p1[8 * s2 + 0], p1[8 * s2 + 1]); b.y = cvtpk(p1[8 * s2 + 2], p1[8 * s2 + 3]); b.z = cvtpk(p1[8 * s2 + 4], p1[8 * s2 + 5]); b.w = cvtpk(p1[8 * s2 + 6], p1[8 * s2 + 7]);
        pf[s2] = __builtin_bit_cast(bf16x8, a); pf[2 + s2] = __builtin_bit_cast(bf16x8, b);
    }
}
struct TileFlags { bool skip, need_mask, sel_ok; };
__device__ __forceinline__ void pack_p(bf16x8 (&pf)[4], const f32x16& p0, const f32x16& p1) {
#pragma unroll
    for (int s2 = 0; s2 < 2; ++s2) {
        v4u a, b;
        a.x = cvtpk(p0[8 * s2 + 0], p0[8 * s2 + 1]); a.y = cvtpk(p0[8 * s2 + 2], p0[8 * s2 + 3]); a.z = cvtpk(p0[8 * s2 + 4], p0[8 * s2 + 5]); a.w = cvtpk(p0[8 * s2 + 6], p0[8 * s2 + 7]);
        b.x = cvtpk(p1[8 * s2 + 0], p1[8 * s2 + 1]); b.y = cvtpk(p1[8 * s2 + 2], p1[8 * s2 + 3]); b.z = cvtpk(p1[8 * s2 + 4], p1[8 * s2 + 5]); b.w = cvtpk(p1[8 * s2 + 6], p1[8 * s2 + 7]);
        pf[s2] = __builtin_bit_cast(bf16x8, a); pf[2 + s2] = __builtin_bit_cast(bf16x8, b);
    }
}
template <int MODE> __device__ __forceinline__ void softmax_pair(AttnState& st, f32x16& a0, f32x16& a1, f32x16& b0, f32x16& b1, int kpos0, int qpos, const TileFlags& fa, const TileFlags& fb, int lane) {
    mask_tile<MODE>(a0, a1, kpos0, qpos, fa.need_mask, fa.sel_ok, lane);
    mask_tile<MODE>(b0, b1, kpos0 + 64, qpos, fb.need_mask, fb.sel_ok, lane);
    float mx = max3f(a0[0], a1[0], b0[0]), mx2 = max3f(b1[0], a0[1], a1[1]);
#pragma unroll
    for (int r = 1; r < 16; ++r) { mx = max3f(mx, b0[r], b1[r]); if (r > 1) mx2 = max3f(mx2, a0[r], a1[r]); }
    mx = max3f(mx, mx2, mx2);
    mx = red32_max(mx);
    if (!st.started || __any(mx > 0.f)) {
        float dl = st.started ? fmaxf(mx, 0.f) : mx;
        dl = (dl > -1e30f) ? dl : 0.f;
        st.started = true;
        const float alpha = __builtin_amdgcn_exp2f(-dl);
        st.m += dl; st.l *= alpha;
#pragma unroll
        for (int r = 0; r < 16; ++r) { st.o[0][r] *= alpha; st.o[1][r] *= alpha; a0[r] -= dl; a1[r] -= dl; b0[r] -= dl; b1[r] -= dl; st.negm[r] = -st.m; }
    }
    float sum = 0.f;
#pragma unroll
    for (int r = 0; r < 16; ++r) { a0[r] = __builtin_amdgcn_exp2f(a0[r]); a1[r] = __builtin_amdgcn_exp2f(a1[r]); b0[r] = __builtin_amdgcn_exp2f(b0[r]); b1[r] = __builtin_amdgcn_exp2f(b1[r]); sum += (a0[r] + a1[r]) + (b0[r] + b1[r]); }
    st.l += sum;
}
__device__ __forceinline__ void pv_tile(AttnState& st, LAS const unsigned char* buf, const bf16x8 (&pf)[4], int lane) {
    const int hi = lane >> 5;
    const unsigned vb = (unsigned)(uintptr_t)(buf + AT_V + (4 * hi + ((lane & 15) >> 2)) * 64 + ((lane >> 4) & 1) * 32 + (lane & 3) * 8);
#pragma unroll
    for (int dh = 0; dh < 2; ++dh) {
        s16x4 lo[4], hh[4];
#pragma unroll
        for (int s4 = 0; s4 < 4; ++s4) {
            asm volatile("ds_read_b64_tr_b16 %0, %1 offset:%c2" : "=&v"(lo[s4]) : "v"(vb), "i"(dh * 4096 + s4 * 1024) : "memory");
            asm volatile("ds_read_b64_tr_b16 %0, %1 offset:%c2" : "=&v"(hh[s4]) : "v"(vb), "i"(dh * 4096 + s4 * 1024 + 512) : "memory");
        }
        asm volatile("s_waitcnt lgkmcnt(0)" : "+v"(lo[0]), "+v"(lo[1]), "+v"(lo[2]), "+v"(lo[3]), "+v"(hh[0]), "+v"(hh[1]), "+v"(hh[2]), "+v"(hh[3]) :: "memory");
#pragma unroll
        for (int s4 = 0; s4 < 4; ++s4) {
            const bf16x8 vf = {lo[s4][0], lo[s4][1], lo[s4][2], lo[s4][3], hh[s4][0], hh[s4][1], hh[s4][2], hh[s4][3]};
            st.o[dh] = __builtin_amdgcn_mfma_f32_32x32x16_bf16(vf, pf[s4], st.o[dh], 0, 0, 0);
        }
    }
}
template <int MODE> __device__ __forceinline__ TileFlags tile_flags(int t, int qw0, unsigned selbits) {
    const int k0 = t * 64; TileFlags f;
    f.skip = k0 > qw0 + 31; f.need_mask = (k0 + 63 > qw0); f.sel_ok = true;
    if (MODE == AM_WINDOW) { f.skip = f.skip || (k0 + 63 < qw0 - 511); f.need_mask = f.need_mask || (k0 < qw0 + 31 - 511); }
    if (MODE == AM_SLC) { f.sel_ok = (selbits >> t) & 1u; const unsigned long long bal = __ballot(f.sel_ok); f.skip = f.skip || (bal == 0ull); f.need_mask = f.need_mask || (bal != ~0ull); }
    return f;
}
struct DmaOff { unsigned k, v, k2; };
template <int NC> __device__ __forceinline__ DmaOff at_dma_off(int ldk, int ldv, int ldk2, int wave, int lane) {
    const int L = wave * 64 + lane; DmaOff o;
    { const int key = L >> 3, c = (L & 7) ^ ((key >> 1) & 7); o.k = (unsigned)(key * ldk + 8 * c) * 2u; }
    { const int key = (L >> 2) & 63, c = (L >> 8) * 4 + (L & 3); o.v = (unsigned)(key * ldv + 8 * c) * 2u; }
    { const int key = (L >> 2) & 63, c2 = (L & 3) ^ ((key >> 2) & 3); o.k2 = (unsigned)(key * ldk2 + 8 * c2) * 2u; }
    return o;
}
template <int NC> __device__ __forceinline__ void at_dma(const DmaOff& o, const bf16* Kg, int ldk, const bf16* Vg, int ldv, const bf16* K2g, int ldk2, int tile, LAS unsigned char* slot, int wave) {
    __builtin_amdgcn_global_load_lds((const unsigned*)((const char*)(Kg + (size_t)tile * 64 * ldk) + o.k), (LAS unsigned*)(slot + wave * 1024), 16, 0, 0);
    __builtin_amdgcn_global_load_lds((const unsigned*)((const char*)(Vg + (size_t)tile * 64 * ldv) + o.v), (LAS unsigned*)(slot + AT_V + wave * 1024), 16, 0, 0);
    if (NC == 6) { if (wave < 4) __builtin_amdgcn_global_load_lds((const unsigned*)((const char*)(K2g + (size_t)tile * 64 * ldk2) + o.k2), (LAS unsigned*)(slot + AT_K32 + wave * 1024), 16, 0, 0); }
}
__device__ __forceinline__ void at_wait_bar(int keep) {
    if (keep == 0) asm volatile("s_waitcnt vmcnt(0) lgkmcnt(0)" ::: "memory");
    else if (keep == 4) asm volatile("s_waitcnt vmcnt(4) lgkmcnt(0)" ::: "memory");
    else asm volatile("s_waitcnt vmcnt(6) lgkmcnt(0)" ::: "memory");
    __builtin_amdgcn_s_barrier();
    asm volatile("" ::: "memory");
}
template <int NC, int MODE> __device__ __forceinline__ void at_stream(AttnState& st, LAS unsigned char* lds, const bf16* Kg, int ldk, const bf16* Vg, int ldv, const bf16* K2g, int ldk2, int t0, int t1,
                                                                       const bf16x8 (&qf)[NC], int qpos, int qw0, unsigned selbits, int tid) {
    const int lane = tid & 63, wave = __builtin_amdgcn_readfirstlane(tid >> 6), np = (t1 - t0) >> 1;
    const int nper2 = (NC == 6 && wave < 4) ? 6 : 4;
    const DmaOff dof = at_dma_off<NC>(ldk, ldv, ldk2, wave, lane);
    at_dma<NC>(dof, Kg, ldk, Vg, ldv, K2g, ldk2, t0, lds, wave); at_dma<NC>(dof, Kg, ldk, Vg, ldv, K2g, ldk2, t0 + 1, lds + AT_BUF, wave);
    if (np > 1) { at_dma<NC>(dof, Kg, ldk, Vg, ldv, K2g, ldk2, t0 + 2, lds + 2 * AT_BUF, wave); at_dma<NC>(dof, Kg, ldk, Vg, ldv, K2g, ldk2, t0 + 3, lds + 3 * AT_BUF, wave); }
    at_wait_bar(np > 1 ? nper2 : 0);
    int s0 = 0, s1 = 2 * AT_BUF, s2 = 4 * AT_BUF;
    for (int j = 0; j < np; ++j) {
        const int t = t0 + 2 * j; const bool has_2 = (j + 2 < np);
        if (has_2) { at_dma<NC>(dof, Kg, ldk, Vg, ldv, K2g, ldk2, t + 4, lds + s2, wave); at_dma<NC>(dof, Kg, ldk, Vg, ldv, K2g, ldk2, t + 5, lds + s2 + AT_BUF, wave); }
        const TileFlags fa = tile_flags<MODE>(t, qw0, selbits), fb = tile_flags<MODE>(t + 1, qw0, selbits);
        if (!fa.skip && !fb.skip) {
            f32x16 a0, a1, b0, b1; bf16x8 pf[4];
            qk_tile<NC>(a0, a1, lds + s0, qf, st.negm, lane);
            qk_tile<NC>(b0, b1, lds + s0 + AT_BUF, qf, st.negm, lane);
            softmax_pair<MODE>(st, a0, a1, b0, b1, t * 64, qpos, fa, fb, lane);
            pack_p(pf, a0, a1); pv_tile(st, lds + s0, pf, lane);
            pack_p(pf, b0, b1); pv_tile(st, lds + s0 + AT_BUF, pf, lane);
        } else {
            if (!fa.skip) { f32x16 p0, p1; bf16x8 pf[4]; qk_tile<NC>(p0, p1, lds + s0, qf, st.negm, lane); softmax_tile<MODE>(st, p0, p1, pf, t * 64, qpos, fa.need_mask, fa.sel_ok, lane); pv_tile(st, lds + s0, pf, lane); }
            if (!fb.skip) { f32x16 p0, p1; bf16x8 pf[4]; qk_tile<NC>(p0, p1, lds + s0 + AT_BUF, qf, st.negm, lane); softmax_tile<MODE>(st, p0, p1, pf, (t + 1) * 64, qpos, fb.need_mask, fb.sel_ok, lane); pv_tile(st, lds + s0 + AT_BUF, pf, lane); }
        }
        at_wait_bar(has_2 ? nper2 : 0);
        const int tmp = s0; s0 = s1; s1 = s2; s2 = tmp;
    }
}
__device__ __forceinline__ int next_item_q(unsigned* ctrs, LAS unsigned char* lds, int wave_u, int count, int q0, int& kstart) {
    const int tid = wave_u * 64 + fresh_lane();
    LAS int* slot = (LAS int*)(lds + RING_BYTES + 64);
    if (tid == 0) {
        int r = -1, k = kstart;
        for (; k < 8; ++k) { const int q = (q0 + k) & 7; const unsigned v = atomicAdd(ctrs + q * 16, 1u); if (v < (unsigned)count) { r = (q << 16) | (int)v; break; } }
        slot[0] = r; slot[1] = k;
    }
    __syncthreads();
    const int v = slot[0]; kstart = slot[1];
    __syncthreads();
    return v;
}
__device__ __forceinline__ void mla_unit(unsigned char* ws, LAS unsigned char* lds, int b, int h, int qt, int wave_u) {
    const int tid = wave_u * 64 + fresh_lane();
    const int lane = tid & 63, wave = tid >> 6, r32 = lane & 31, hi = lane >> 5;
    const int qw0 = qt * 256 + wave * 32, qpos = qw0 + r32; const size_t row = (size_t)b * S_ + qpos;
    const long long tq0 = (PROBE_SEL != 0) ? (long long)__builtin_amdgcn_s_memtime() : 0ll;
    bf16x8 qf[6];
    {
        const bf16* qp = (const bf16*)(ws + WS_OSLC) + row * 768 + h * 96 + 8 * hi;
        v4u raw[6];
#pragma unroll
        for (int cc = 0; cc < 6; ++cc) raw[cc] = *(const v4u*)(qp + 16 * cc);
        float msc = MSCALE; asm volatile("" : "+v"(msc));
        const float rs = rsqrtf(((const float*)(ws + WS_SSQL))[row] * (1.f / 256.f) + EPS) * msc;
        const float* cm_ = (const float*)(ws + WS_COSM) + row * 16 + 8 * hi; const float* sm_ = (const float*)(ws + WS_SINM) + row * 16 + 8 * hi;
#define UNPKQ(dst, src) dst[0] = __uint_as_float(src.x << 16); dst[1] = __uint_as_float(src.x & 0xffff0000u); dst[2] = __uint_as_float(src.y << 16); dst[3] = __uint_as_float(src.y & 0xffff0000u); \
        dst[4] = __uint_as_float(src.z << 16); dst[5] = __uint_as_float(src.z & 0xffff0000u); dst[6] = __uint_as_float(src.w << 16); dst[7] = __uint_as_float(src.w & 0xffff0000u);
#pragma unroll
        for (int cc = 0; cc < 4; ++cc) { float f[8]; UNPKQ(f, raw[cc])
            v4u w; w.x = cvtpk(f[0] * rs, f[1] * rs); w.y = cvtpk(f[2] * rs, f[3] * rs); w.z = cvtpk(f[4] * rs, f[5] * rs); w.w = cvtpk(f[6] * rs, f[7] * rs); qf[cc] = __builtin_bit_cast(bf16x8, w); }
        { float x1[8], x2[8], o1[8], o2[8]; UNPKQ(x1, raw[4]) UNPKQ(x2, raw[5])
#pragma unroll
          for (int j = 0; j < 8; ++j) { const float cs = cm_[j] * rs, sn = sm_[j] * rs; o1[j] = x1[j] * cs - x2[j] * sn; o2[j] = x1[j] * sn + x2[j] * cs; }
          v4u w; w.x = cvtpk(o1[0], o1[1]); w.y = cvtpk(o1[2], o1[3]); w.z = cvtpk(o1[4], o1[5]); w.w = cvtpk(o1[6], o1[7]); qf[4] = __builtin_bit_cast(bf16x8, w);
          w.x = cvtpk(o2[0], o2[1]); w.y = cvtpk(o2[2], o2[3]); w.z = cvtpk(o2[4], o2[5]); w.w = cvtpk(o2[6], o2[7]); qf[5] = __builtin_bit_cast(bf16x8, w); }
#undef UNPKQ
    }
    const long long tq1 = (PROBE_SEL != 0) ? (long long)__builtin_amdgcn_s_memtime() : 0ll;
    AttnState st; st.m = 0.f; st.l = 0.f; st.o[0] = f32x16{}; st.o[1] = f32x16{}; st.negm = f32x16{}; st.started = false; st.twait = 0;
    const bf16* kvb = (const bf16*)(ws + WS_KVM) + (size_t)b * S_ * 768 + h * 128;
    at_stream<6, AM_CAUSAL>(st, lds, kvb, 768, kvb + 64, 768, (const bf16*)(ws + WS_KR) + (size_t)b * S_ * 32, 32, 0, 4 * qt + 4, qf, qpos, qw0, 0u, tid);
    if (PROBE_SEL >= 1 && PROBE_SEL <= 3 && b == 0 && h == 0 && qt == 7 && tid == 0) { const long long tq2 = (long long)__builtin_amdgcn_s_memtime();
        ((float*)(ws + WS_CTL))[100] = (PROBE_SEL == 1) ? (float)(tq2 - tq1) : (PROBE_SEL == 2) ? (float)st.twait : (float)(tq1 - tq0); }
    const float lt = red32_sum(st.l), il = 1.f / lt;
    bf16* op = (bf16*)(ws + WS_HB) + row * D_ + 384 + h * 64 + 4 * hi;
#pragma unroll
    for (int dh = 0; dh < 2; ++dh)
#pragma unroll
        for (int g4 = 0; g4 < 4; ++g4) { u32x2v w; w.x = cvtpk(st.o[dh][4 * g4] * il, st.o[dh][4 * g4 + 1] * il); w.y = cvtpk(st.o[dh][4 * g4 + 2] * il, st.o[dh][4 * g4 + 3] * il);
            *(u32x2v*)(op + dh * 32 + 8 * g4) = w; }
}
template <int MODE> __device__ __forceinline__ void nsa_branch_unit(unsigned char* ws, LAS unsigned char* lds, int b, int h, int qt, int wave_u) {
    const int tid = wave_u * 64 + fresh_lane();
    const int lane = tid & 63, wave = tid >> 6, r32 = lane & 31, hi = lane >> 5, g = h / 3;
    const int qw0 = qt * 256 + wave * 32, qpos = qw0 + r32; const size_t row = (size_t)b * S_ + qpos;
    const bf16* nsa = (const bf16*)(ws + WS_NSA);
    const bf16* qp = nsa + row * 1152 + h * 64 + 8 * hi;
    bf16x8 qf[4];
#pragma unroll
    for (int cc = 0; cc < 4; ++cc) qf[cc] = *(const bf16x8*)(qp + 16 * cc);
    unsigned selbits = 0u; if (MODE == AM_SLC) selbits = ((const unsigned*)(ws + WS_SEL))[(size_t)(b * 2 + g) * S_ + qpos];
    const bf16* kb = nsa + (size_t)b * S_ * 1152 + g * 64 + (MODE == AM_SLC ? 640 : 896);
    AttnState st; st.m = 0.f; st.l = 0.f; st.o[0] = f32x16{}; st.o[1] = f32x16{}; st.negm = f32x16{}; st.started = false; st.twait = 0;
    const long long tn0 = (PROBE_SEL != 0) ? (long long)__builtin_amdgcn_s_memtime() : 0ll;
    const int t0 = (MODE == AM_SLC) ? 0 : ((4 * qt - 8 > 0) ? 4 * qt - 8 : 0);
    at_stream<4, MODE>(st, lds, kb, 1152, kb + 128, 1152, nullptr, 0, t0, 4 * qt + 4, qf, qpos, qw0, selbits, tid);
    if (PROBE_SEL >= 4 && PROBE_SEL <= 5 && MODE == AM_SLC && b == 0 && h == 0 && qt == 7 && tid == 0) { const long long tn1 = (long long)__builtin_amdgcn_s_memtime();
        ((float*)(ws + WS_CTL))[100] = (PROBE_SEL == 4) ? (float)(tn1 - tn0) : (float)st.twait; }
    const float lt = red32_sum(st.l), il = 1.f / lt;
    bf16* op = (bf16*)(ws + (MODE == AM_SLC ? WS_OSLC : WS_OWIN)) + row * 384 + h * 64 + 4 * hi;
#pragma unroll
    for (int dh = 0; dh < 2; ++dh)
#pragma unroll
        for (int g4 = 0; g4 < 4; ++g4) { u32x2v w; w.x = cvtpk(st.o[dh][4 * g4] * il, st.o[dh][4 * g4 + 1] * il); w.y = cvtpk(st.o[dh][4 * g4 + 2] * il, st.o[dh][4 * g4 + 3] * il);
            *(u32x2v*)(op + dh * 32 + 8 * g4) = w; }
}
__device__ __forceinline__ void cmp_unit(unsigned char* ws, LAS unsigned char* lds, int b, int g, int qt, int wave_u) {
    const int tid = wave_u * 64 + fresh_lane();
    const int lane = tid & 63, wave = tid >> 6, r32 = lane & 31, hi = lane >> 5;
    const int qpos = qt * 256 + wave * 32 + r32; const size_t row = (size_t)b * S_ + qpos;
    const bf16* kc = (const bf16*)(ws + WS_KCV) + (size_t)(b * 2 + g) * 128 * 64; const bf16* vc = kc + (size_t)8 * 2 * 128 * 64;
    { TileRegs<4> tr; at_load<4>(tr, kc, 64, vc, 64, nullptr, 0, 0, tid); at_store<4>(tr, lds, tid); at_load<4>(tr, kc, 64, vc, 64, nullptr, 0, 1, tid); at_store<4>(tr, lds + AT_BUF, tid); }
    __syncthreads();
    int nvis = (qpos >= 31) ? ((qpos - 31) >> 4) + 1 : 0; if (nvis > 127) nvis = 127;
    LAS float* IG = (LAS float*)(lds + 2 * AT_BUF) + wave * (32 * 33) + r32 * 33;
    LAS float* IL = IG + 8 * 32 * 33;
    const bf16* nsa = (const bf16*)(ws + WS_NSA);
    LAS const unsigned char* vb = lds + AT_V + (4 * hi + ((lane & 15) >> 2)) * 64 + ((lane >> 4) & 1) * 32 + (lane & 3) * 8;
    for (int r3 = 0; r3 < 3; ++r3) {
        const int h = 3 * g + r3;
        const bf16* qp = nsa + row * 1152 + h * 64 + 8 * hi;
        bf16x8 qf[4];
#pragma unroll
        for (int cc = 0; cc < 4; ++cc) qf[cc] = *(const bf16x8*)(qp + 16 * cc);
        f32x16 p[4];
#pragma unroll
        for (int tb = 0; tb < 4; ++tb) {
            LAS const unsigned char* buf = lds + (tb >> 1) * AT_BUF; const int kr = (tb & 1) * 32 + r32;
            p[tb] = f32x16{};
#pragma unroll
            for (int cc = 0; cc < 4; ++cc) { const bf16x8 kf = *(LAS const bf16x8*)(buf + kr * 128 + 16 * ((2 * cc + hi) ^ ((kr >> 1) & 7)));
                p[tb] = __builtin_amdgcn_mfma_f32_32x32x16_bf16(kf, qf[cc], p[tb], 0, 0, 0); }
        }
        float mx = -1e30f;
#pragma unroll
        for (int tb = 0; tb < 4; ++tb)
#pragma unroll
            for (int r = 0; r < 16; ++r) { const int n = 32 * tb + crow(r, hi); p[tb][r] = fminf(p[tb][r], ((float)(nvis - n) - 0.5f) * INFINITY); mx = fmaxf(mx, p[tb][r]); }
        mx = red32_max(mx);
        float sum = 0.f;
#pragma unroll
        for (int tb = 0; tb < 4; ++tb)
#pragma unroll
            for (int r = 0; r < 16; ++r) { p[tb][r] = __builtin_amdgcn_exp2f(p[tb][r] - mx); sum += p[tb][r]; }
        sum = red32_sum(sum);
        const float il = (nvis > 0) ? 1.f / sum : 0.f;
#pragma unroll
        for (int tb = 0; tb < 4; ++tb)
#pragma unroll
            for (int k = 0; k < 4; ++k) { const float a0 = p[tb][4 * k] * il, a1 = p[tb][4 * k + 1] * il, a2 = p[tb][4 * k + 2] * il, a3 = p[tb][4 * k + 3] * il;
                const int j = 2 * (4 * tb + k) + hi;
                const float gs = (a0 + a1) + (a2 + a3);
                if (r3 == 0) { IG[j] = gs; IL[j + 1] = a3; } else { IG[j] += gs; IL[j + 1] += a3; } }
        f32x16 o[2] = {f32x16{}, f32x16{}};
#pragma unroll
        for (int tb = 0; tb < 4; ++tb)
#pragma unroll
            for (int s2 = 0; s2 < 2; ++s2) {
                v4u a; a.x = cvtpk(p[tb][8 * s2 + 0], p[tb][8 * s2 + 1]); a.y = cvtpk(p[tb][8 * s2 + 2], p[tb][8 * s2 + 3]); a.z = cvtpk(p[tb][8 * s2 + 4], p[tb][8 * s2 + 5]); a.w = cvtpk(p[tb][8 * s2 + 6], p[tb][8 * s2 + 7]);
                const bf16x8 pf = __builtin_bit_cast(bf16x8, a);
                LAS const unsigned char* vbb = vb + (tb >> 1) * AT_BUF + ((tb & 1) * 2 + s2) * 1024;
#pragma unroll
                for (int dh = 0; dh < 2; ++dh) { const s16x4 lo = vtr(vbb + dh * 4096), hh = vtr(vbb + dh * 4096 + 512);
                    const bf16x8 vf = {lo[0], lo[1], lo[2], lo[3], hh[0], hh[1], hh[2], hh[3]};
                    o[dh] = __builtin_amdgcn_mfma_f32_32x32x16_bf16(vf, pf, o[dh], 0, 0, 0); }
                asm volatile("" ::: "memory");
            }
        bf16* op = (bf16*)(ws + WS_OCMP) + row * 384 + h * 64 + 4 * hi;
#pragma unroll
        for (int dh = 0; dh < 2; ++dh)
#pragma unroll
            for (int g4 = 0; g4 < 4; ++g4) { u32x2v w; w.x = cvtpk(o[dh][4 * g4] * il, o[dh][4 * g4 + 1] * il); w.y = cvtpk(o[dh][4 * g4 + 2] * il, o[dh][4 * g4 + 3] * il);
                *(u32x2v*)(op + dh * 32 + 8 * g4) = w; }
    }
    const int cur = qpos >> 6;
    LAS float* imp = IG;
#pragma unroll 1
    for (int jj = 0; jj < 16; ++jj) {
        const int j = 16 * hi + jj;
        float v = IG[j] + (j > 0 ? IL[j] : 0.f);
        if (j == 0 || j == cur || j == cur - 1) v = INFINITY;
        if (j * 64 > qpos) v = -INFINITY;
        IL[j] = v;
    }
#pragma unroll 1
    for (int jj = 0; jj < 16; ++jj) { const int j = 16 * hi + jj; imp[j] = IL[j]; }
    unsigned mask = 0;
#pragma unroll 1
    for (int jj = 0; jj < 16; ++jj) {
        const int j = 16 * hi + jj; const float v = imp[j]; int rank = 0;
#pragma unroll 4
        for (int k = 0; k < 32; ++k) { const float u2 = imp[k]; rank += (u2 > v || (u2 == v && k < j)) ? 1 : 0; }
        if (rank < 16) mask |= 1u << j;
    }
    mask = red32_or(mask);
    if (hi == 0) ((unsigned*)(ws + WS_SEL))[(size_t)(b * 2 + g) * S_ + qpos] = mask;
    __syncthreads();
}
__device__ __forceinline__ void lora_rows(unsigned char* ws, int tid) {
    const int gw = blockIdx.x * NWAVES + (tid >> 6), ngw = gridDim.x * NWAVES, lane = tid & 63;
    bf16* kvl = (bf16*)(ws + WS_KVL); const bf16* ql = (const bf16*)(ws + WS_QL); float* ssql = (float*)(ws + WS_SSQL);
    for (int m = gw; m < T_; m += ngw) {
        const unsigned kv = *(const unsigned*)(kvl + (size_t)m * 128 + 2 * lane);
        const float k0 = __uint_as_float(kv << 16), k1 = __uint_as_float(kv & 0xffff0000u);
        const uint2 qv = *(const uint2*)(ql + (size_t)m * 256 + 4 * lane);
        const float q0 = __uint_as_float(qv.x << 16), q1 = __uint_as_float(qv.x & 0xffff0000u), q2 = __uint_as_float(qv.y << 16), q3 = __uint_as_float(qv.y & 0xffff0000u);
        const float sk = wave_sum2(k0 * k0 + k1 * k1), sq = wave_sum2((q0 * q0 + q1 * q1) + (q2 * q2 + q3 * q3));
        const float rk = rsqrtf(sk * (1.f / 128.f) + EPS);
        *(unsigned*)(kvl + (size_t)m * 128 + 2 * lane) = pk2(k0 * rk, k1 * rk);
        if (lane == 0) ssql[m] = sq;
    }
}
__device__ __forceinline__ void post_misc(unsigned char* ws, const float* big, const float* bfg, int tid) {
    const float* mr = (const float*)(ws + WS_MISCRAW); const float* cosM = (const float*)(ws + WS_COSM); const float* sinM = (const float*)(ws + WS_SINM);
    bf16* kr = (bf16*)(ws + WS_KR); float* gm = (float*)(ws + WS_GM);
    for (int idx = blockIdx.x * NTHR + tid; idx < T_ * 64; idx += gridDim.x * NTHR) {
        const int row = idx >> 6, c = idx & 63; const float* r = mr + (size_t)row * 64; const float v = r[c];
        if (c < 32) { const int i = c & 15; const float x1 = r[i], x2 = r[16 + i], cs = cosM[row * 16 + i], sn = sinM[row * 16 + i];
            kr[(size_t)row * 32 + c] = f2bf((c < 16) ? x1 * cs - x2 * sn : x1 * sn + x2 * cs); }
        else if (c < 50) gm[(size_t)row * 32 + (c - 32)] = 1.f / (1.f + __expf(-v));
        else if (c < 54) gm[(size_t)row * 32 + 18 + (c - 50)] = v + big[c - 50];
        else if (c < 58) { const float z = v + bfg[c - 54]; gm[(size_t)row * 32 + 22 + (c - 54)] = fminf(z, 0.f) - __logf(1.f + __expf(-fabsf(z))); }
    }
}

typedef float f32x4v __attribute__((ext_vector_type(4)));
__device__ __forceinline__ void compress_item(unsigned char* ws, LAS unsigned char* lds, const float* cmp_pos, int item, int wave_u) {
    const int lane = fresh_lane(), tid = wave_u * 64 + lane;
    const int nb = item & 7, g = (item >> 3) & 1, b = (item >> 4) & 7, kv = item >> 7;
    const bf16* tok = (const bf16*)(ws + WS_NSA) + (size_t)b * S_ * 1152 + (kv ? 512 : 384) + g * 64;
    const bf16* wt = (const bf16*)(ws + (kv ? WT_CV : WT_CK));
    const int nrow = nb * 16 + (lane & 15), kq = lane >> 4;
    f32x4v acc[4] = {f32x4v{}, f32x4v{}, f32x4v{}, f32x4v{}};
#pragma unroll 4
    for (int ks = 0; ks < 8; ++ks) {
        const int k = wave_u * 256 + ks * 32 + kq * 8, l = k >> 6, d = k & 63;
        int trow = 16 * nrow + l; trow = trow < S_ ? trow : S_ - 1;
        const v4u t4 = *(const v4u*)(tok + (size_t)trow * 1152 + d);
        const f32x4v p0 = *(const f32x4v*)(cmp_pos + k), p1 = *(const f32x4v*)(cmp_pos + k + 4);
        v4u a4;
        a4.x = cvtpk(__uint_as_float(t4.x << 16) + p0[0], __uint_as_float(t4.x & 0xffff0000u) + p0[1]); a4.y = cvtpk(__uint_as_float(t4.y << 16) + p0[2], __uint_as_float(t4.y & 0xffff0000u) + p0[3]);
        a4.z = cvtpk(__uint_as_float(t4.z << 16) + p1[0], __uint_as_float(t4.z & 0xffff0000u) + p1[1]); a4.w = cvtpk(__uint_as_float(t4.w << 16) + p1[2], __uint_as_float(t4.w & 0xffff0000u) + p1[3]);
        const bf16x8 af = __builtin_bit_cast(bf16x8, a4);
#pragma unroll
        for (int cb = 0; cb < 4; ++cb) { const bf16x8 bfr = *(const bf16x8*)(wt + (size_t)(cb * 16 + (lane & 15)) * 2048 + k);
            acc[cb] = __builtin_amdgcn_mfma_f32_16x16x32_bf16(af, bfr, acc[cb], 0, 0, 0); }
    }
    LAS float* red = (LAS float*)lds + wave_u * 1024;
#pragma unroll
    for (int cb = 0; cb < 4; ++cb)
#pragma unroll
        for (int r = 0; r < 4; ++r) red[(4 * (lane >> 4) + r) * 64 + cb * 16 + (lane & 15)] = acc[cb][r];
    __syncthreads();
    bf16* out = (bf16*)(ws + WS_KCV) + (size_t)kv * (8 * 2 * 128 * 64) + ((size_t)(b * 2 + g) * 128 + nb * 16) * 64;
    for (int o = tid; o < 1024; o += NTHR) { float sum = 0.f;
#pragma unroll
        for (int w8 = 0; w8 < 8; ++w8) sum += ((LAS float*)lds)[w8 * 1024 + o];
        out[o] = f2bf(sum); }
    __syncthreads();
}
__device__ __forceinline__ f32x4v mm16(const LAS bf16* A, int lda, int arow0, const LAS bf16* Bt, int ldb, int bcol0, int K, int lane, f32x4v acc) {
    const LAS bf16* ap = A + (arow0 + (lane & 15)) * lda + 8 * (lane >> 4); const LAS bf16* bp = Bt + (bcol0 + (lane & 15)) * ldb + 8 * (lane >> 4);
    for (int k = 0; k < K; k += 32) acc = __builtin_amdgcn_mfma_f32_16x16x32_bf16(*(const LAS bf16x8*)(ap + k), *(const LAS bf16x8*)(bp + k), acc, 0, 0, 0);
    return acc;
}
constexpr int ML_LD = 72;
constexpr int ML_STRIDE = 3 * 64 * ML_LD * 2 + 256;
__device__ __forceinline__ void mlocal_item(unsigned char* ws, LAS unsigned char* lds, const float* convw, const float* convb, const float* big, const float* bfg, int chunk0, int wave_u) {
    const int lane = fresh_lane(), tid = wave_u * 64 + lane;
    const int h = (chunk0 >> 5) & 3, b = chunk0 >> 7;
    LAS bf16* WQ = (LAS bf16*)lds;
    LAS bf16* WK = WQ + 64 * ML_LD;
    const bf16* cm = (const bf16*)(ws + WS_CM);
#define ML_PTRS(ch) const int chunk = chunk0 + (ch); const int c = chunk & 31; const int row0 = b * S_ + c * 64; LAS bf16* XS = WK + 64 * ML_LD + (ch) * (ML_STRIDE / 2); \
    LAS bf16* VT = XS + 64 * ML_LD; LAS bf16* WKT = VT + 64 * ML_LD; LAS float* wl = (LAS float*)(WKT + 64 * ML_LD); (void)c; (void)row0; (void)XS; (void)VT; (void)WKT; (void)wl; (void)chunk;
#pragma unroll
    for (int ch = 0; ch < 2; ++ch) { ML_PTRS(ch)
        const int l = tid >> 3, ch0 = (tid & 7) * 8, row = row0 + l, s = c * 64 + l;
        float a[8];
#pragma unroll
        for (int i = 0; i < 8; ++i) a[i] = convb[h * 64 + ch0 + i];
#pragma unroll
        for (int j = 0; j < 4; ++j) { if (s - 3 + j >= 0) { const v4u x4 = *(const v4u*)(cm + (size_t)(row - 3 + j) * 768 + h * 64 + ch0);
            const float* cw = convw + j * 256 + h * 64 + ch0;
            a[0] += cw[0] * __uint_as_float(x4.x << 16); a[1] += cw[1] * __uint_as_float(x4.x & 0xffff0000u); a[2] += cw[2] * __uint_as_float(x4.y << 16); a[3] += cw[3] * __uint_as_float(x4.y & 0xffff0000u);
            a[4] += cw[4] * __uint_as_float(x4.z << 16); a[5] += cw[5] * __uint_as_float(x4.z & 0xffff0000u); a[6] += cw[6] * __uint_as_float(x4.w << 16); a[7] += cw[7] * __uint_as_float(x4.w & 0xffff0000u); } }
        v4u o4; float r[8];
#pragma unroll
        for (int i = 0; i < 8; ++i) r[i] = a[i] / (1.f + __expf(-a[i]));
        o4.x = cvtpk(r[0], r[1]); o4.y = cvtpk(r[2], r[3]); o4.z = cvtpk(r[4], r[5]); o4.w = cvtpk(r[6], r[7]);
        *(v4u*)((bf16*)(ws + WS_XC) + (size_t)row * 256 + h * 64 + ch0) = o4;
        *(LAS v4u*)(XS + l * ML_LD + ch0) = o4;
        const v4u v4 = *(const v4u*)(cm + (size_t)row * 768 + 256 + h * 64 + ch0);
        VT[(ch0 + 0) * ML_LD + l] = (bf16)(v4.x & 0xffffu); VT[(ch0 + 1) * ML_LD + l] = (bf16)(v4.x >> 16); VT[(ch0 + 2) * ML_LD + l] = (bf16)(v4.y & 0xffffu); VT[(ch0 + 3) * ML_LD + l] = (bf16)(v4.y >> 16);
        VT[(ch0 + 4) * ML_LD + l] = (bf16)(v4.z & 0xffffu); VT[(ch0 + 5) * ML_LD + l] = (bf16)(v4.z >> 16); VT[(ch0 + 6) * ML_LD + l] = (bf16)(v4.w & 0xffffu); VT[(ch0 + 7) * ML_LD + l] = (bf16)(v4.w >> 16);
    }
    {
        const int e = tid >> 3, d0 = (tid & 7) * 8;
        *(LAS v4u*)(WQ + e * ML_LD + d0) = *(const v4u*)((const bf16*)(ws + WT_QM) + h * 4096 + e * 64 + d0);
        *(LAS v4u*)(WK + e * ML_LD + d0) = *(const v4u*)((const bf16*)(ws + WT_KM) + h * 4096 + e * 64 + d0);
    }
    if (wave_u < 2) { ML_PTRS(wave_u)
        const float* mr = (const float*)(ws + WS_MISCRAW) + (size_t)(row0 + lane) * 64;
        const float z = mr[54 + h] + bfg[h]; float lf = fminf(z, 0.f) - __logf(1.f + __expf(-fabsf(z)));
        const float ig = mr[50 + h] + big[h];
#pragma unroll
        for (int o = 1; o < 64; o <<= 1) { const float t = bperm(lf, lane - o); if (lane >= o) lf += t; }
        const float bL = __int_as_float(__builtin_amdgcn_readlane(__float_as_int(lf), 63));
        const float a = bL - lf + ig; const float mx = wave_max2(a);
        wl[lane] = __expf(a - mx);
        if (lane == 0) { ((float*)(ws + WS_ML))[chunk] = mx; ((float*)(ws + WS_BL))[chunk] = bL; }
    }
    __syncthreads();
#pragma unroll
    for (int ch = 0; ch < 2; ++ch) { ML_PTRS(ch)
        const int lb = wave_u & 3; const bool isk = wave_u >= 4;
        const LAS bf16* Wt = isk ? WK : WQ;
        bf16* og = (bf16*)(ws + (isk ? WS_MK : WS_MQ)) + (size_t)(row0 + 16 * lb + 4 * (lane >> 4)) * 256 + h * 64 + (lane & 15);
        float w4[4];
#pragma unroll
        for (int r = 0; r < 4; ++r) w4[r] = wl[16 * lb + 4 * (lane >> 4) + r];
#pragma unroll
        for (int eb = 0; eb < 4; ++eb) {
            f32x4v acc = mm16(XS, ML_LD, 16 * lb, Wt, ML_LD, 16 * eb, 64, lane, f32x4v{});
            if (!isk) {
#pragma unroll
                for (int r = 0; r < 4; ++r) og[(size_t)r * 256 + 16 * eb] = f2bf(acc[r] * 0.125f);
            } else {
                bf16 kb[4];
#pragma unroll
                for (int r = 0; r < 4; ++r) { kb[r] = f2bf(acc[r]); og[(size_t)r * 256 + 16 * eb] = kb[r]; }
                u32x2v w2; w2.x = cvtpk(bf2f(kb[0]) * w4[0], bf2f(kb[1]) * w4[1]); w2.y = cvtpk(bf2f(kb[2]) * w4[2], bf2f(kb[3]) * w4[3]);
                *(LAS u32x2v*)(WKT + (16 * eb + (lane & 15)) * ML_LD + 16 * lb + 4 * (lane >> 4)) = w2;
            }
        }
    }
    __syncthreads();
#pragma unroll
    for (int ch = 0; ch < 2; ++ch) { ML_PTRS(ch)
        float* ct = (float*)(ws + WS_CT) + (size_t)chunk * 4096;
#pragma unroll
        for (int i = 0; i < 2; ++i) { const int blk = wave_u * 2 + i, eb = blk >> 2, db = blk & 3;
            const f32x4v acc = mm16(VT, ML_LD, 16 * eb, WKT, ML_LD, 16 * db, 64, lane, f32x4v{});
#pragma unroll
            for (int r = 0; r < 4; ++r) ct[(16 * eb + 4 * (lane >> 4) + r) * 64 + 16 * db + (lane & 15)] = acc[r]; }
    }
    if (tid < 128) { ML_PTRS(tid >> 6)
        const int d = tid & 63; float n = 0.f; const LAS bf16* wr_ = WKT + d * ML_LD;
        for (int l = 0; l < 64; ++l) n += bf2f(wr_[l]);
        ((float*)(ws + WS_NL))[chunk * 64 + d] = n; }
#undef ML_PTRS
    __syncthreads();
}
__device__ __forceinline__ void mscan_item(unsigned char* ws, int item, int wave_u) {
    const int tid = wave_u * 64 + fresh_lane();
    const int bh = item / 9, part = item % 9;
    if (part == 8 && tid >= 64) return;
    float* base; size_t stride;
    if (part < 8) { base = (float*)(ws + WS_CT) + (size_t)bh * 32 * 4096 + part * 512 + tid; stride = 4096; } else { base = (float*)(ws + WS_NL) + (size_t)bh * 32 * 64 + tid; stride = 64; }
    const float* ML = (const float*)(ws + WS_ML); const float* BL = (const float*)(ws + WS_BL); float* MPv = (float*)(ws + WS_MP);
    float Cv = 0.f, m = 0.f;
    for (int c = 0; c < 32; ++c) {
        const float cl = base[(size_t)c * stride], ml = ML[bh * 32 + c], bl = BL[bh * 32 + c];
        base[(size_t)c * stride] = Cv;
        if (part == 8 && tid == 0) MPv[bh * 32 + c] = m;
        const float mn = fmaxf(bl + m, ml);
        Cv = __expf(bl + m - mn) * Cv + __expf(ml - mn) * cl; m = mn;
    }
}
constexpr int MO_STRIDE = 5 * 64 * ML_LD * 2 + 64 * 65 * 4 + 6 * 64 * 4;
__device__ __forceinline__ void mout_item(unsigned char* ws, LAS unsigned char* lds, const float* gmh, const float* skip, int chunk0, int wave_u) {
    const int lane = fresh_lane(), tid = wave_u * 64 + lane;
    const int h = (chunk0 >> 5) & 3, b = chunk0 >> 7;
    const float* gm = (const float*)(ws + WS_GM);
#define MO_PTRS(ch) const int chunk = chunk0 + (ch); const int row0 = b * S_ + (chunk & 31) * 64; LAS unsigned char* cb_ = lds + (ch) * MO_STRIDE; \
    LAS bf16* QS = (LAS bf16*)cb_; LAS bf16* KS = QS + 64 * ML_LD; LAS bf16* VT = KS + 64 * ML_LD; LAS bf16* CP = VT + 64 * ML_LD; LAS bf16* SW = CP + 64 * ML_LD; \
    LAS float* HS = (LAS float*)(SW + 64 * ML_LD); LAS float* bs = HS + 64 * 65; LAS float* us = bs + 64; LAS float* ns = us + 64; LAS float* mts = ns + 64; LAS float* ints = mts + 64; LAS float* dinv = ints + 64; \
    (void)row0; (void)QS; (void)KS; (void)VT; (void)CP; (void)SW; (void)HS; (void)bs; (void)us; (void)ns; (void)mts; (void)ints; (void)dinv; (void)chunk;
#pragma unroll
    for (int ch = 0; ch < 2; ++ch) { MO_PTRS(ch)
        const int l = tid >> 3, c0 = (tid & 7) * 8, row = row0 + l;
        *(LAS v4u*)(QS + l * ML_LD + c0) = *(const v4u*)((const bf16*)(ws + WS_MQ) + (size_t)row * 256 + h * 64 + c0);
        *(LAS v4u*)(KS + l * ML_LD + c0) = *(const v4u*)((const bf16*)(ws + WS_MK) + (size_t)row * 256 + h * 64 + c0);
        const v4u v4 = *(const v4u*)((const bf16*)(ws + WS_CM) + (size_t)row * 768 + 256 + h * 64 + c0);
        VT[(c0 + 0) * ML_LD + l] = (bf16)(v4.x & 0xffffu); VT[(c0 + 1) * ML_LD + l] = (bf16)(v4.x >> 16); VT[(c0 + 2) * ML_LD + l] = (bf16)(v4.y & 0xffffu); VT[(c0 + 3) * ML_LD + l] = (bf16)(v4.y >> 16);
        VT[(c0 + 4) * ML_LD + l] = (bf16)(v4.z & 0xffffu); VT[(c0 + 5) * ML_LD + l] = (bf16)(v4.z >> 16); VT[(c0 + 6) * ML_LD + l] = (bf16)(v4.w & 0xffffu); VT[(c0 + 7) * ML_LD + l] = (bf16)(v4.w >> 16);
        const float* ct = (const float*)(ws + WS_CT) + (size_t)chunk * 4096 + l * 64 + c0;
        const f32x4v c0v = *(const f32x4v*)ct, c1v = *(const f32x4v*)(ct + 4);
        v4u cw; cw.x = cvtpk(c0v[0], c0v[1]); cw.y = cvtpk(c0v[2], c0v[3]); cw.z = cvtpk(c1v[0], c1v[1]); cw.w = cvtpk(c1v[2], c1v[3]);
        *(LAS v4u*)(CP + l * ML_LD + c0) = cw;
    }
    if (wave_u < 2) { MO_PTRS(wave_u)
        const float ig = gm[(size_t)(row0 + lane) * 32 + 18 + h]; float lf = gm[(size_t)(row0 + lane) * 32 + 22 + h];
#pragma unroll
        for (int o = 1; o < 64; o <<= 1) { const float t = bperm(lf, lane - o); if (lane >= o) lf += t; }
        const float u = ig - lf; float cu = u;
#pragma unroll
        for (int o = 1; o < 64; o <<= 1) { const float t = bperm(cu, lane - o); if (lane >= o) cu = fmaxf(cu, t); }
        const float mprev = ((const float*)(ws + WS_MP))[chunk];
        const float mt = lf + fmaxf(mprev, cu);
        bs[lane] = lf; us[lane] = u; mts[lane] = mt; ints[lane] = __expf(lf + mprev - mt); ns[lane] = ((const float*)(ws + WS_NL))[chunk * 64 + lane];
    }
    __syncthreads();
#pragma unroll
    for (int ch = 0; ch < 2; ++ch) { MO_PTRS(ch)
#pragma unroll
        for (int i = 0; i < 2; ++i) { const int blk = wave_u * 2 + i, lb = blk >> 2, sb = blk & 3;
            f32x4v acc = f32x4v{};
            if (sb <= lb) acc = mm16(QS, ML_LD, 16 * lb, KS, ML_LD, 16 * sb, 64, lane, acc);
            const int sidx = 16 * sb + (lane & 15); const float usv = us[sidx];
#pragma unroll
            for (int r = 0; r < 4; ++r) { const int l = 16 * lb + 4 * (lane >> 4) + r;
                const float v = (sidx <= l) ? acc[r] * __expf(bs[l] + usv - mts[l]) : 0.f;
                SW[l * ML_LD + sidx] = f2bf(v); } }
    }
    __syncthreads();
    if (tid < 128) { MO_PTRS(tid >> 6)
        const int l = tid & 63; float qn = 0.f, ssum = 0.f;
        for (int d = 0; d < 64; ++d) { qn += bf2f(QS[l * ML_LD + d]) * ns[d]; ssum += bf2f(SW[l * ML_LD + d]); }
        const float den = ints[l] * qn + ssum;
        dinv[l] = 1.f / fmaxf(fabsf(den), __expf(-mts[l]));
    }
    f32x4v hq[2][2], hs2[2][2];
#pragma unroll
    for (int ch = 0; ch < 2; ++ch) { MO_PTRS(ch)
#pragma unroll
        for (int i = 0; i < 2; ++i) { const int blk = wave_u * 2 + i, lb = blk >> 2, eb = blk & 3;
            hq[ch][i] = mm16(QS, ML_LD, 16 * lb, CP, ML_LD, 16 * eb, 64, lane, f32x4v{});
            hs2[ch][i] = mm16(SW, ML_LD, 16 * lb, VT, ML_LD, 16 * eb, 16 * lb + 16 <= 32 ? 32 : 64, lane, f32x4v{}); }
    }
    __syncthreads();
#pragma unroll
    for (int ch = 0; ch < 2; ++ch) { MO_PTRS(ch)
#pragma unroll
        for (int i = 0; i < 2; ++i) { const int blk = wave_u * 2 + i, lb = blk >> 2, eb = blk & 3; const int e = 16 * eb + (lane & 15);
#pragma unroll
            for (int r = 0; r < 4; ++r) { const int l = 16 * lb + 4 * (lane >> 4) + r;
                const float og = bf2f(((const bf16*)(ws + WS_CM))[(size_t)(row0 + l) * 768 + 512 + h * 64 + e]);
                HS[l * 65 + e] = (ints[l] * hq[ch][i][r] + hs2[ch][i][r]) * dinv[l] / (1.f + __expf(-og)); } }
    }
    __syncthreads();
#pragma unroll
    for (int ch = 0; ch < 2; ++ch) { MO_PTRS(ch)
        const int l = tid >> 3, e0 = (tid & 7) * 8, row = row0 + l;
        float v[8]; float mu = 0.f;
#pragma unroll
        for (int i = 0; i < 8; ++i) { v[i] = HS[l * 65 + e0 + i]; mu += v[i]; }
        mu += sxf<1>(mu); mu += sxf<2>(mu); mu += sxf<4>(mu); mu *= (1.f / 64.f);
        float var = 0.f;
#pragma unroll
        for (int i = 0; i < 8; ++i) { const float dl = v[i] - mu; var += dl * dl; }
        var += sxf<1>(var); var += sxf<2>(var); var += sxf<4>(var);
        const float rs = rsqrtf(var * (1.f / 64.f) + EPS);
        const v4u x4 = *(const v4u*)((const bf16*)(ws + WS_XC) + (size_t)row * 256 + h * 64 + e0);
        float xv[8]; xv[0] = __uint_as_float(x4.x << 16); xv[1] = __uint_as_float(x4.x & 0xffff0000u); xv[2] = __uint_as_float(x4.y << 16); xv[3] = __uint_as_float(x4.y & 0xffff0000u);
        xv[4] = __uint_as_float(x4.z << 16); xv[5] = __uint_as_float(x4.z & 0xffff0000u); xv[6] = __uint_as_float(x4.w << 16); xv[7] = __uint_as_float(x4.w & 0xffff0000u);
        float r[8];
#pragma unroll
        for (int i = 0; i < 8; ++i) r[i] = (v[i] - mu) * rs * gmh[h * 64 + e0 + i] + skip[h * 64 + e0 + i] * xv[i];
        v4u w4; w4.x = cvtpk(r[0], r[1]); w4.y = cvtpk(r[2], r[3]); w4.z = cvtpk(r[4], r[5]); w4.w = cvtpk(r[6], r[7]);
        *(v4u*)((bf16*)(ws + WS_HB) + (size_t)row * D_ + 768 + h * 64 + e0) = w4;
    }
#undef MO_PTRS
    __syncthreads();
}

__global__ void __launch_bounds__(NTHR, 2) mega(MP p_unused) {
    extern __shared__ __attribute__((aligned(16))) unsigned char lds_raw[];
    LAS unsigned char* lds = (LAS unsigned char*)lds_raw;
    const int wave0 = __builtin_amdgcn_readfirstlane((int)threadIdx.x >> 6);
    const int tid0 = wave0 * 64 + fresh_lane();
    const int xcc = (int)(__builtin_amdgcn_s_getreg((3 << 11) | 20) & 7u);
    volatile LAS unsigned* MISC = (volatile LAS unsigned*)(lds + MISC_OFF);
    for (int u = tid0; u < (LDS_BYTES - RING_BYTES) / 4; u += NTHR) ((LAS unsigned*)(lds + RING_BYTES))[u] = 0u;
    __syncthreads();
    typedef const __attribute__((address_space(4))) MP* kmp_t;
    kmp_t kp0 = (kmp_t)__builtin_amdgcn_kernarg_segment_ptr();
    unsigned char* ws0 = kp0->ws; const int coop = kp0->coop, ph_lo = kp0->ph_lo, ph_hi = kp0->ph_hi;
    XcdBarrier bar; bar.bar = (unsigned*)(ws0 + WS_CTL) + CW_BAR; bar.x = 0; bar.st = nullptr;
    if (coop) bar = xcd_barrier_post((unsigned*)(ws0 + WS_CTL) + CW_BAR, MISC + 8, tid0);
    if (coop == 2) cooperative_groups::this_grid().sync();
    int ph = ph_lo;
    if (ph == 0) {
        const MPK p{kp0}; ph_p0(p, lds, wave0 * 64 + fresh_lane()); ph = 1;
        if (ph < ph_hi) xcd_barrier(bar, wave0 * 64 + fresh_lane());
    }
    bool second = false;
    for (; ph < ph_hi; ++ph) {
        kmp_t kp = kp0; asm volatile("" : "+s"(kp));
        const MPK p{kp}; unsigned char* ws = kp->ws;
#define TID_ (wave0 * 64 + fresh_lane())
#define GW_ (blockIdx.x * NWAVES + wave0)
#define NGW_ (gridDim.x * NWAVES)
        const int l = (ph - 1) / PPL, ty = (ph == 0) ? -1 : (ph == NPH - 1) ? -2 : (ph - 1) % PPL;
        const float* modl = (const float*)(ws + WS_MOD) + (size_t)l * 8 * 6144;
        if (ty == -2) { norm_rows(p.k->out, PIN(I_GFIN), nullptr, nullptr, nullptr, p.k->out, 2, GW_, NGW_, fresh_lane());
            if (PROBE_SEL != 0 && blockIdx.x == 0 && TID_ == 0) { asm volatile("s_waitcnt vmcnt(0)" ::: "memory"); p.k->out[0] = ((const float*)(ws + WS_CTL))[100] * 0.001f; } }
        else if (ty == 0 && (PHM & 2)) ph_prep(p, l, lds, TID_);
        else if (ty == 1 && (PHM & 4)) {
            pg8::Gemm g{(const bf16*)(ws + WS_HB), (const bf16*)(ws + WT_IN), T_, 2560, D_}; pg8::StaticOrder S; S.init(T_, 2560, gridDim.x, blockIdx.x);
            pg8::EpiIn E{ws, PIN(I_BIG) + l * 4, PIN(I_BFG) + l * 4};
            pg8::gemm_phase<pg8::EpiIn, pg8::StaticOrder, true, true>(lds, g, S, E, wave0);
            late_transposes(p, l, lds, TID_, 640 % (int)gridDim.x);
        }
        else if (ty == 2 && (PHM & 64)) {
            { pg8::Gemm g{(const bf16*)(ws + WS_KVL), (const bf16*)(ws + WT_UKV), T_, 768, 128}; pg8::StaticOrder S; S.init(T_, 768, gridDim.x, blockIdx.x);
              pg8::EpiUKV E{(bf16*)(ws + WS_KVM), (const float*)(ws + WS_SSKV)}; pg8::gemm_phase<pg8::EpiUKV, pg8::StaticOrder, true, true>(lds, g, S, E, wave0); }
            { pg8::Gemm g{(const bf16*)(ws + WS_QL), (const bf16*)(ws + WT_UQ), T_, 768, 256}; pg8::StaticOrder S; S.init(T_, 768, gridDim.x, blockIdx.x);
              pg8::EpiPlain E{(bf16*)(ws + WS_OSLC), 768}; pg8::gemm_phase<pg8::EpiPlain, pg8::StaticOrder, true, true>(lds, g, S, E, wave0); }
            post_misc(ws, PIN(I_BIG) + l * 4, PIN(I_BFG) + l * 4, TID_);
            unsigned* ctrs = (unsigned*)(ws + WS_CTL) + 8192 + ph * 256 + (second ? 128 : 0); int ks = 0;
            for (;;) { const int it = next_item_q(ctrs, lds, wave0, 96, xcc, ks); if (it < 0) break; const int b = it >> 16, j = it & 0xffff;
                if (j < 64) mlocal_item(ws, lds, PIN(I_CONVW) + l * 1024, PIN(I_CONVB) + l * 256, PIN(I_BIG) + l * 4, PIN(I_BFG) + l * 4, b * 128 + 2 * j, wave0);
                else { const int k = j - 64; compress_item(ws, lds, PIN(I_CMPPOS) + l * 2048, ((k >> 4) << 7) | (b << 4) | (k & 15), wave0); } }
        }
        else if (ty == 3 && (PHM & 128)) {
            unsigned* ctrs = (unsigned*)(ws + WS_CTL) + 8192 + ph * 256 + (second ? 128 : 0); int ks = 0;
            for (;;) { const int it = next_item_q(ctrs, lds, wave0, second ? 64 : 100, xcc, ks); if (it < 0) break; const int b = it >> 16, j = it & 0xffff;
                if (second && (REP_MASK & (1 << 20)) && j >= 48) continue; if (second && (REP_MASK & (1 << 21)) && j < 48) continue;
                if (j < 18) mla_unit(ws, lds, b, j % 6, 7 - j / 6, wave0);
                else if (j < 34) cmp_unit(ws, lds, b, (j - 18) >> 3, 7 - ((j - 18) & 7), wave0);
                else if (j < 64) { const int u = j - 16; mla_unit(ws, lds, b, u % 6, 7 - u / 6, wave0); }
                else mscan_item(ws, b * 36 + (j - 64), wave0); }
        }
        else if (ty == 4 && (PHM & 256)) {
            unsigned* ctrs = (unsigned*)(ws + WS_CTL) + 8192 + ph * 256 + (second ? 128 : 0); int ks = 0;
            for (;;) { const int it = next_item_q(ctrs, lds, wave0, 160, xcc, ks); if (it < 0) break; const int b = it >> 16, j = it & 0xffff;
                if (second && (REP_MASK & (1 << 16)) && j >= 96) continue; if (second && (REP_MASK & (1 << 17)) && j < 96) continue;
                if (j < 36) nsa_branch_unit<AM_SLC>(ws, lds, b, j % 6, 7 - j / 6, wave0);
                else if (j < 84) nsa_branch_unit<AM_WINDOW>(ws, lds, b, (j - 36) % 6, 7 - (j - 36) / 6, wave0);
                else if (j < 96) { const int u = j - 48; nsa_branch_unit<AM_SLC>(ws, lds, b, u % 6, 7 - u / 6, wave0); }
                else mout_item(ws, lds, PIN(I_GMH) + l * 256, PIN(I_SKIP) + l * 256, b * 128 + 2 * (j - 96), wave0); }
        }
        else if (ty == 5) ph_mixnorm(p, l, TID_);
        else if (ty == 6 && (PHM & 8)) {
            pg8::Gemm g{(const bf16*)(ws + WS_HB), (const bf16*)(ws + WT_OUT), T_, D_, D_}; pg8::StaticOrder S; S.init(T_, D_, gridDim.x, blockIdx.x);
            pg8::EpiRes E{(l == 0) ? PIN(I_X) : p.k->out, p.k->out, modl + 2048};
            pg8::gemm_phase<pg8::EpiRes, pg8::StaticOrder, true, true>(lds, g, S, E, wave0);
        }
        else if (ty == 7) norm_rows(p.k->out, PIN(I_GN2) + l * D_, modl + 3072, modl + 4096, (bf16*)(ws + WS_HB), nullptr, 1, GW_, NGW_, fresh_lane());
        else if (ty == 8 && (PHM & 16)) {
            pg8::Gemm g{(const bf16*)(ws + WS_HB), (const bf16*)(ws + WT_GU), T_, 2 * FF, D_}; pg8::StaticOrder S; S.init(T_, 2 * FF, gridDim.x, blockIdx.x);
            pg8::EpiGU E{(bf16*)(ws + WS_ACT)};
            pg8::gemm_phase<pg8::EpiGU, pg8::StaticOrder, true, true>(lds, g, S, E, wave0);
            if (l + 1 < DEPTH) early_transposes(p, l + 1, lds, TID_, 1408 % (int)gridDim.x);
        }
        else if (ty == 9 && (PHM & 32)) {
            pg8::Gemm g{(const bf16*)(ws + WS_ACT), (const bf16*)(ws + WT_DOWN), T_, D_, FF}; pg8::StaticOrder S; S.init(T_, D_, gridDim.x, blockIdx.x);
            pg8::EpiRes E{p.k->out, p.k->out, modl + 5120};
            pg8::gemm_phase<pg8::EpiRes, pg8::StaticOrder, true, true>(lds, g, S, E, wave0);
        }
        if (REP_MASK != 0 && ty >= 0 && ((REP_MASK >> ty) & 1) && !second) { second = true; --ph; } else second = false;
        if (ph + 1 < ph_hi) xcd_barrier(bar, wave0 * 64 + fresh_lane());
    }
}

extern "C" void kernel_launch(void* const* d_in, const int* in_sizes, int n_in, void* d_out, int out_size, void* d_ws, size_t ws_size, hipStream_t stream) {
    if (n_in != N_IN || ws_size < WS_END) { fprintf(stderr, "kernel_launch: unexpected n_in %d / ws %zu\n", n_in, ws_size); return; }
    static int inited = 0;
    if (!inited) { if (hipFuncSetAttribute((const void*)mega, hipFuncAttributeMaxDynamicSharedMemorySize, LDS_BYTES) != hipSuccess) fprintf(stderr, "hipFuncSetAttribute failed\n"); inited = 1; }
    unsigned char* ws = (unsigned char*)d_ws;
    MP base{}; for (int i = 0; i < N_IN; ++i) base.in[i] = (const float*)d_in[i]; base.out = (float*)d_out; base.ws = ws;
    (void)hipMemsetAsync(ws + WS_CTL, 0, CTL_ZERO_BYTES, stream);
    static int grid = 0;
    if (!grid) {
        int dev = 0, cus = 0, per_cu = 0;
        (void)hipGetDevice(&dev); (void)hipDeviceGetAttribute(&cus, hipDeviceAttributeMultiprocessorCount, dev);
        if (hipOccupancyMaxActiveBlocksPerMultiprocessor(&per_cu, (const void*)mega, NTHR, LDS_BYTES) != hipSuccess || per_cu < 1) { fprintf(stderr, "kernel_launch: occupancy query says %d blocks per CU\n", per_cu); per_cu = 1; }
        (void)hipGetLastError();
        grid = cus;
    }
    MP a = base; a.ph_lo = 0; a.ph_hi = NPH; a.coop = 1;
    void* args[] = {&a};
    const hipError_t e = hipLaunchCooperativeKernel((const void*)mega, dim3(grid), dim3(NTHR), args, LDS_BYTES, stream);
    if (e != hipSuccess) fprintf(stderr, "kernel_launch: cooperative launch failed: %s (grid %d)\n", hipGetErrorString(e), grid);
}
```

```cpp
#include <hip/hip_runtime.h>
#include <cstdint>
#include <cstdio>
#include <hip/hip_cooperative_groups.h>

constexpr int B_ = 8, S_ = 2048, T_ = B_ * S_, D_ = 1024, DIN = 2362, FF = 2816, DEPTH = 2;
constexpr float EPS = 1e-6f;
constexpr float LOG2E = 1.4426950408889634f;
constexpr float QSCALE = 0.125f * LOG2E;
constexpr float MSCALE = 0.10206207261596577f * LOG2E;
enum { I_X = 0, I_C, I_POS, I_GN1, I_GN2, I_WADA, I_BADA, I_WIN, I_CMPPOS, I_WCK, I_WCV, I_GOA, I_GQL, I_WUQ, I_GKVL, I_WUKV, I_GOB,
       I_CONVW, I_CONVB, I_WQM, I_WKM, I_BIG, I_BFG, I_GMH, I_SKIP, I_WOUT, I_WGU, I_WDOWN, I_GFIN, N_IN };

constexpr size_t MiB = 1u << 20;
constexpr size_t WS_CTL = 0;
constexpr size_t WS_MOD = 1 * MiB;
constexpr size_t WS_COSP = WS_MOD + 512 * 1024;
constexpr size_t WS_SINP = WS_COSP + 512 * 1024;
constexpr size_t WS_COSM = WS_SINP + 512 * 1024;
constexpr size_t WS_SINM = WS_COSM + 1 * MiB;
constexpr size_t WS_SSQL = WS_SINM + 1 * MiB;
constexpr size_t WS_SSKV = WS_SSQL + 64 * 1024;
constexpr size_t WS_ML = WS_SSKV + 64 * 1024;
constexpr size_t WS_BL = WS_ML + 4096;
constexpr size_t WS_MP = WS_BL + 4096;
constexpr size_t WS_NL = WS_MP + 4096;
constexpr size_t WS_WT = 8 * MiB;
constexpr size_t WS_RAW = WS_WT;
constexpr size_t WS_HB = 34 * MiB;
constexpr size_t WS_NSA = 66 * MiB;
constexpr size_t WS_KVL = 102 * MiB;
constexpr size_t WS_QL = 106 * MiB;
constexpr size_t WS_CM = 114 * MiB;
constexpr size_t WS_GM = 138 * MiB;
constexpr size_t WS_KM = 140 * MiB;
constexpr size_t WS_QM = 158 * MiB;
constexpr size_t WS_VM = 176 * MiB;
constexpr size_t WS_KCV = 188 * MiB;
constexpr size_t WS_OCMP = 189 * MiB;
constexpr size_t WS_SEL = 201 * MiB;
constexpr size_t WS_XC = 202 * MiB;
constexpr size_t WS_MQ = 210 * MiB;
constexpr size_t WS_MK = 218 * MiB;
constexpr size_t WS_CT = 226 * MiB;
constexpr size_t WS_MISCRAW = 242 * MiB;
constexpr size_t WS_KVM = 140 * MiB;
constexpr size_t WS_KR = 246 * MiB;
constexpr size_t WS_OSLC = 164 * MiB;
constexpr size_t WS_OWIN = 176 * MiB;
constexpr size_t WS_ACT = 66 * MiB;
constexpr size_t WS_END = 256 * MiB;
static_assert(WS_NL + 1024 * 64 * 4 <= WS_WT, "tab");
static_assert(WS_ACT + (size_t)T_ * FF * 2 <= WS_KCV, "act overlay");

typedef unsigned short bf16;
__device__ __forceinline__ float bf2f(bf16 v) { return __uint_as_float(((unsigned)v) << 16); }
__device__ __forceinline__ bf16 f2bf(float f) { unsigned u = __float_as_uint(f); return (bf16)((u + 0x7fffu + ((u >> 16) & 1u)) >> 16); }
__device__ __forceinline__ float sigmoidf_(float x) { return 1.f / (1.f + __expf(-x)); }
__device__ __forceinline__ float siluf_(float x) { return x / (1.f + __expf(-x)); }
__device__ __forceinline__ float wave_sum(float v) {
#pragma unroll
    for (int o = 1; o < 64; o <<= 1) v += __shfl_xor(v, o);
    return v;
}

__device__ __forceinline__ int fresh_lane() { int l; asm volatile("v_mbcnt_lo_u32_b32 %0, -1, 0\n\tv_mbcnt_hi_u32_b32 %0, -1, %0" : "=&v"(l)); return l; }
template <int M> __device__ __forceinline__ float sxf(float v) { static_assert(M >= 1 && M < 32, "swizzle xor mask"); return __int_as_float(__builtin_amdgcn_ds_swizzle(__float_as_int(v), (M << 10) | 0x1f)); }
__device__ __forceinline__ float red32_max(float v) { auto r = __builtin_amdgcn_permlane32_swap(__float_as_uint(v), __float_as_uint(v), false, false); return fmaxf(__uint_as_float(r[0]), __uint_as_float(r[1])); }
__device__ __forceinline__ float red32_sum(float v) { auto r = __builtin_amdgcn_permlane32_swap(__float_as_uint(v), __float_as_uint(v), false, false); return __uint_as_float(r[0]) + __uint_as_float(r[1]); }
__device__ __forceinline__ unsigned red32_or(unsigned v) { auto r = __builtin_amdgcn_permlane32_swap(v, v, false, false); return r[0] | r[1]; }
__device__ __forceinline__ float bperm(float v, int src_lane) { return __int_as_float(__builtin_amdgcn_ds_bpermute(src_lane << 2, __float_as_int(v))); }
__device__ __forceinline__ float wave_sum2(float v) { v += sxf<1>(v); v += sxf<2>(v); v += sxf<4>(v); v += sxf<8>(v); v += sxf<16>(v); return red32_sum(v); }
__device__ __forceinline__ float wave_max2(float v) { v = fmaxf(v, sxf<1>(v)); v = fmaxf(v, sxf<2>(v)); v = fmaxf(v, sxf<4>(v)); v = fmaxf(v, sxf<8>(v)); v = fmaxf(v, sxf<16>(v)); return red32_max(v); }
namespace pg8 {
#define PG8_LAS __attribute__((address_space(3)))
typedef unsigned short bf16_t;
typedef short bf16x8 __attribute__((ext_vector_type(8)));
typedef float f32x4 __attribute__((ext_vector_type(4)));
typedef unsigned u32x4 __attribute__((ext_vector_type(4)));
constexpr int BM = 256, BK = 64, HALF = 128, HTB = HALF * BK * 2  , STAGE_BYTES = 8 * HTB, NXCD = 8, WGM = 8;

__host__ __device__ __forceinline__ int lds_byte(int r, int c) { const int st = (r >> 4) * 2 + (c >> 5), rr = r & 15, cc = c & 31, ob = rr * 64 + cc * 2; return st * 1024 + (ob ^ (((ob >> 9) & 1) << 5)); }
__host__ __device__ __forceinline__ void stage_rc(int b, int& R, int& C) { const int st = b / 1024, sb = b % 1024, swz = sb ^ (((sb >> 9) & 1) << 5); R = (st >> 1) * 16 + swz / 64; C = (st & 1) * 32 + (swz % 64) / 2; }
__host__ __device__ __forceinline__ int perm32(int rho) { const int n = rho >> 4, i = rho & 15; return 8 * (i >> 2) + 4 * n + (i & 3); }

struct Unit { int pm, pn; };
struct Gemm { const bf16_t* A; const bf16_t* Bt; int M, N, K; };

struct StaticOrder {
    int nM, nN, nwg, G, c;
    __host__ __device__ void init(int M, int N, int G_, int c_) { nM = M / BM; nN = N / BM; nwg = nM * nN; G = G_; c = c_; }
    __host__ __device__ bool next(int i, Unit& u) const {
        const long L = (long)i * G + c; if (L >= nwg) return false;
        int wgid = (int)L; { const int q = nwg / NXCD, r = nwg % NXCD, xcd = wgid % NXCD, off = wgid / NXCD; wgid = (xcd < r ? xcd * (q + 1) : r * (q + 1) + (xcd - r) * q) + off; }
        const int nig = WGM * nN, gid = wgid / nig, fm = gid * WGM, gsz = (nM - fm) < WGM ? (nM - fm) : WGM;
        u.pm = fm + ((wgid % nig) % gsz); u.pn = (wgid % nig) / gsz; return true;
    }
    __device__ __forceinline__ void a_ready(const Unit&) const {}
    __device__ __forceinline__ void done(const Unit&) const {}
};

__device__ __forceinline__ unsigned cvt_pk_bf16(float lo, float hi) { unsigned r; asm volatile("v_cvt_pk_bf16_f32 %0, %1, %2" : "=v"(r) : "v"(lo), "v"(hi)); return r; }
typedef float f32x2 __attribute__((ext_vector_type(2)));

typedef unsigned u32x4 __attribute__((ext_vector_type(4)));
typedef unsigned u32x2 __attribute__((ext_vector_type(2)));
struct EpiIn {
    static constexpr bool PERM = true, AFTER_DRAIN = false;
    unsigned char* ws; const float *big, *bfg;
#define EPI_ROWS(...) _Pragma("unroll") for (int ai = 0; ai < 2; ++ai) _Pragma("unroll") for (int m = 0; m < 4; ++m) { \
        const int row = u.pm * BM + ai * HALF + wr * 64 + m * 16 + fr; float v[8]; \
        _Pragma("unroll") for (int i = 0; i < 4; ++i) { v[i] = acc[ai][bj][m][0][i]; v[4 + i] = acc[ai][bj][m][1][i]; } \
        asm volatile("" : "+v"(v[0]), "+v"(v[1]), "+v"(v[2]), "+v"(v[3]), "+v"(v[4]), "+v"(v[5]), "+v"(v[6]), "+v"(v[7])); \
        __VA_ARGS__ asm volatile("" ::: "memory"); }
#define EPI_PACK(w) u32x4 w; w.x = cvt_pk_bf16(v[0], v[1]); w.y = cvt_pk_bf16(v[2], v[3]); w.z = cvt_pk_bf16(v[4], v[5]); w.w = cvt_pk_bf16(v[6], v[7]);
    __device__ __forceinline__ void operator()(const f32x4 (&acc)[2][2][4][2], const Unit& u, int wr, int wc, int fr, int fq) const {
        half<0>(acc, u, wr, wc, fr, fq); half<1>(acc, u, wr, wc, fr, fq);
    }
    template <int bj> __device__ __forceinline__ void half(const f32x4 (&acc)[2][2][4][2], const Unit& u, int wr, int wc, int fr, int fq) const {
        {
            const int hb = 2 * u.pn + bj;
            int cb = 32 * wc + 8 * fq; asm volatile("" : "+v"(cb), "+v"(fr));
            if (hb <= 8) {
                bf16_t* nsa = (bf16_t*)(ws + WS_NSA) + hb * 128 + cb;
                const bool rope_hb = (hb <= 3) || hb == 5 || hb == 7;
                if (rope_hb) {
                    const float* cosP = (const float*)(ws + WS_COSP); const float* sinP = (const float*)(ws + WS_SINP);
                    const bool mine = ((wc & 1) == 0) && fq < 2; const float sg = (fq == 0) ? -1.f : 1.f; const float sc = (hb < 3) ? QSCALE : 1.f;
                    EPI_ROWS({
                        float pv[8];
                        _Pragma("unroll") for (int i = 0; i < 8; ++i) pv[i] = sxf<16>(v[i]);
                        if (mine) {
                            const f32x4 c0 = *(const f32x4*)(cosP + row * 8), c1 = *(const f32x4*)(cosP + row * 8 + 4), s0 = *(const f32x4*)(sinP + row * 8), s1 = *(const f32x4*)(sinP + row * 8 + 4);
                            _Pragma("unroll") for (int i = 0; i < 4; ++i) { v[i] = v[i] * c0[i] + sg * pv[i] * s0[i]; v[4 + i] = v[4 + i] * c1[i] + sg * pv[4 + i] * s1[i]; }
                        }
                        _Pragma("unroll") for (int i = 0; i < 8; ++i) v[i] *= sc;
                        EPI_PACK(w) *(u32x4*)(nsa + (size_t)row * 1152) = w;
                    })
                } else {
                    EPI_ROWS({ EPI_PACK(w) *(u32x4*)(nsa + (size_t)row * 1152) = w; })
                }
            } else if (hb <= 11) {
                bf16_t* dst = (hb == 9) ? (bf16_t*)(ws + WS_KVL) + cb : (bf16_t*)(ws + WS_QL) + (hb - 10) * 128 + cb;
                const int ld = (hb == 9) ? 128 : 256;
                float* ssq = (hb == 9) ? (float*)(ws + WS_SSKV) : (float*)(ws + WS_SSQL);
                EPI_ROWS({ EPI_PACK(w) *(u32x4*)(dst + (size_t)row * ld) = w;
                    float sq = 0.f;
                    _Pragma("unroll") for (int i = 0; i < 8; ++i) sq += v[i] * v[i];
                    sq += sxf<16>(sq); sq = red32_sum(sq);
                    if (fq == 0) atomicAdd(ssq + row, sq); })
            } else if (hb <= 17) {
                bf16_t* cm = (bf16_t*)(ws + WS_CM) + (hb - 12) * 128 + cb;
                EPI_ROWS({ EPI_PACK(w) *(u32x4*)(cm + (size_t)row * 768) = w; })
            } else if (hb == 18) {
                float* mr = (float*)(ws + WS_MISCRAW) + cb;
                if (wc < 2) { EPI_ROWS({ *(f32x4*)(mr + (size_t)row * 64) = (f32x4){v[0], v[1], v[2], v[3]}; *(f32x4*)(mr + (size_t)row * 64 + 4) = (f32x4){v[4], v[5], v[6], v[7]}; }) }
            }
        }
    }
#undef EPI_ROWS
#undef EPI_PACK
};
struct EpiUKV {
    static constexpr bool PERM = true, AFTER_DRAIN = false;
    bf16_t* kvm; const float* sskv;
    __device__ __forceinline__ void operator()(const f32x4 (&acc)[2][2][4][2], const Unit& u, int wr, int wc, int fr, int fq) const {
        asm volatile("" : "+v"(fq), "+v"(fr));
        const int col0 = u.pn * BM + wc * 32 + 8 * fq;
#pragma unroll
        for (int ai = 0; ai < 2; ++ai)
#pragma unroll
            for (int m = 0; m < 4; ++m) { const int row = u.pm * BM + ai * HALF + wr * 64 + m * 16 + fr; bf16_t* rowp = kvm + (size_t)row * 768 + col0;
                const float rs = rsqrtf(sskv[row] * (1.f / 128.f) + EPS);
#pragma unroll
                for (int bj = 0; bj < 2; ++bj) { const f32x4 a = acc[ai][bj][m][0] * rs, b = acc[ai][bj][m][1] * rs;
                    u32x4 w; w.x = cvt_pk_bf16(a[0], a[1]); w.y = cvt_pk_bf16(a[2], a[3]); w.z = cvt_pk_bf16(b[0], b[1]); w.w = cvt_pk_bf16(b[2], b[3]);
                    *(u32x4*)(rowp + bj * HALF) = w; }
                asm volatile("" ::: "memory"); }
    }
};
struct EpiPlain {
    static constexpr bool PERM = true, AFTER_DRAIN = false;
    bf16_t* out; int ld;
    __device__ __forceinline__ void operator()(const f32x4 (&acc)[2][2][4][2], const Unit& u, int wr, int wc, int fr, int fq) const {
        asm volatile("" : "+v"(fq), "+v"(fr));
        const int col0 = u.pn * BM + wc * 32 + 8 * fq;
#pragma unroll
        for (int ai = 0; ai < 2; ++ai)
#pragma unroll
            for (int m = 0; m < 4; ++m) { bf16_t* rowp = out + (size_t)(u.pm * BM + ai * HALF + wr * 64 + m * 16 + fr) * ld + col0;
#pragma unroll
                for (int bj = 0; bj < 2; ++bj) { const f32x4 a = acc[ai][bj][m][0], b = acc[ai][bj][m][1];
                    u32x4 w; w.x = cvt_pk_bf16(a[0], a[1]); w.y = cvt_pk_bf16(a[2], a[3]); w.z = cvt_pk_bf16(b[0], b[1]); w.w = cvt_pk_bf16(b[2], b[3]);
                    *(u32x4*)(rowp + bj * HALF) = w; } }
    }
};
struct EpiRes {
    static constexpr bool PERM = false, AFTER_DRAIN = false;
    const float* xin; float* xout; const float* gate;
    __device__ __forceinline__ void operator()(const f32x4 (&acc)[2][2][4][2], const Unit& u, int wr, int wc, int fr, int fq) const {
        asm volatile("" : "+v"(fq), "+v"(fr));
        const int b = (u.pm * BM) / S_; const int col0 = u.pn * BM + wc * 32 + 4 * fq;
        f32x4 gv[2][2];
#pragma unroll
        for (int bj = 0; bj < 2; ++bj)
#pragma unroll
            for (int n = 0; n < 2; ++n) gv[bj][n] = *(const f32x4*)(gate + (size_t)b * 6144 + col0 + bj * HALF + n * 16);
#pragma unroll
        for (int ai = 0; ai < 2; ++ai)
#pragma unroll
            for (int m = 0; m < 4; ++m) { const size_t off = (size_t)(u.pm * BM + ai * HALF + wr * 64 + m * 16 + fr) * D_ + col0;
#pragma unroll
                for (int bj = 0; bj < 2; ++bj)
#pragma unroll
                    for (int n = 0; n < 2; ++n) { const f32x4 xi = *(const f32x4*)(xin + off + bj * HALF + n * 16); *(f32x4*)(xout + off + bj * HALF + n * 16) = xi + gv[bj][n] * acc[ai][bj][m][n]; } }
    }
};
struct EpiGU {
    static constexpr bool PERM = true, AFTER_DRAIN = false;
    bf16_t* act;
    __device__ __forceinline__ void operator()(const f32x4 (&acc)[2][2][4][2], const Unit& u, int wr, int wc, int fr, int fq) const {
        asm volatile("" : "+v"(fq), "+v"(fr));
        const int col0 = u.pn * HALF + wc * 32 + 8 * fq;
#pragma unroll
        for (int ai = 0; ai < 2; ++ai)
#pragma unroll
            for (int m = 0; m < 4; ++m) { const int row = u.pm * BM + ai * HALF + wr * 64 + m * 16 + fr; float o[8];
#pragma unroll
                for (int n = 0; n < 2; ++n)
#pragma unroll
                    for (int i = 0; i < 4; ++i) { const float g = acc[ai][0][m][n][i], up = acc[ai][1][m][n][i]; o[4 * n + i] = g / (1.f + __expf(-g)) * up; }
                u32x4 w; w.x = cvt_pk_bf16(o[0], o[1]); w.y = cvt_pk_bf16(o[2], o[3]); w.z = cvt_pk_bf16(o[4], o[5]); w.w = cvt_pk_bf16(o[6], o[7]);
                *(u32x4*)(act + (size_t)row * FF + col0) = w; }
    }
};
template <class Epi, class Sched, bool ALIGN_EPI = false, bool SP2 = false>
__device__ __forceinline__ void gemm_phase(PG8_LAS unsigned char* lds, const Gemm g, const Sched& S, const Epi& E, int wid_in) {
    const int wid = __builtin_amdgcn_readfirstlane(wid_in), lane = fresh_lane(), tid = wid * 64 + lane, wr = wid >> 2, wc = wid & 3;
    const int K = g.K, nt = K / BK;
    unsigned voffA[2], voffB[2];
#pragma unroll
    for (int i = 0; i < 2; ++i) { int R, C; stage_rc(tid * 16 + i * 8192, R, C); const int Rb = Epi::PERM ? ((R & ~31) + perm32(R & 31)) : R;
        voffA[i] = (unsigned)(R * K + C) * 2u; voffB[i] = (unsigned)(Rb * K + C) * 2u; }
    const size_t kstep = (size_t)(BK * 2);
    const size_t hstep = (size_t)HALF * K * 2;
    const size_t tstep = 2 * hstep;
    const unsigned ldsw = (unsigned)wid * 1024u;
    const int aoff = lds_byte(wr * 64 + (lane & 15), (lane >> 4) * 8), boff = lds_byte(wc * 32 + (lane & 15), (lane >> 4) * 8);
#define PG8_SA(b, h) (((b) * 2 + (h)) * HTB)
#define PG8_SB(b, h) ((4 + (b) * 2 + (h)) * HTB)
#define PG8_STAGE(bufoff, gbase, voff) do { _Pragma("unroll") for (int _i = 0; _i < 2; ++_i) \
        __builtin_amdgcn_global_load_lds((const unsigned*)((const char*)(gbase) + (voff)[_i]), (PG8_LAS unsigned*)(lds + (bufoff) + ldsw + _i * 8192), 16, 0, 0); } while (0)
#define PG8_LDA(dst, b, h) do { _Pragma("unroll") for (int m = 0; m < 4; ++m) _Pragma("unroll") for (int k = 0; k < 2; ++k) dst[m][k] = *(const PG8_LAS bf16x8*)(lds + PG8_SA(b, h) + aoff + m * 2048 + k * 1024); } while (0)
#define PG8_LDB(dst, b, h) do { _Pragma("unroll") for (int n = 0; n < 2; ++n) _Pragma("unroll") for (int k = 0; k < 2; ++k) dst[n][k] = *(const PG8_LAS bf16x8*)(lds + PG8_SB(b, h) + boff + n * 2048 + k * 1024); } while (0)
#define PG8_MMA(ai, bj, At, Bt) do { __builtin_amdgcn_s_setprio(1); _Pragma("unroll") for (int m = 0; m < 4; ++m) _Pragma("unroll") for (int n = 0; n < 2; ++n) _Pragma("unroll") for (int k = 0; k < 2; ++k) \
        acc[ai][bj][m][n] = __builtin_amdgcn_mfma_f32_16x16x32_bf16(Bt[n][k], At[m][k], acc[ai][bj][m][n], 0, 0, 0); __builtin_amdgcn_s_setprio(0); } while (0)
#define PG8_WAIT_V(n) asm volatile("s_waitcnt vmcnt(" #n ")" ::: "memory")
#define PG8_WAIT_L(n) asm volatile("s_waitcnt lgkmcnt(" #n ")" ::: "memory")
#define PG8_BAR __builtin_amdgcn_s_barrier()
#define PG8_SCHED __builtin_amdgcn_sched_barrier(0)
    Unit cur, nxt; int ui = 0;
    if (!S.next(0, cur)) return;
    f32x4 acc[2][2][4][2];
#pragma unroll
    for (int a = 0; a < 2; ++a)
#pragma unroll
        for (int b = 0; b < 2; ++b)
#pragma unroll
            for (int m = 0; m < 4; ++m)
#pragma unroll
                for (int n = 0; n < 2; ++n) acc[a][b][m][n] = (f32x4){0.f, 0.f, 0.f, 0.f};
    bf16x8 At[4][2], B0[2][2], B1[2][2];
    const char* cA = (const char*)g.A + (size_t)cur.pm * tstep; const char* cB = (const char*)g.Bt + (size_t)cur.pn * tstep;
    S.a_ready(cur);
    if constexpr (SP2) {
        PG8_STAGE(PG8_SB(0, 0), cB, voffB); PG8_STAGE(PG8_SB(0, 1), cB + hstep, voffB); PG8_STAGE(PG8_SA(0, 0), cA, voffA); PG8_STAGE(PG8_SA(0, 1), cA + hstep, voffA);
        if (wr == 1) PG8_BAR;
        PG8_WAIT_V(2); PG8_BAR;
        PG8_STAGE(PG8_SB(1, 0), cB + kstep, voffB); PG8_STAGE(PG8_SA(1, 0), cA + kstep, voffA); PG8_STAGE(PG8_SB(1, 1), cB + hstep + kstep, voffB);
        PG8_WAIT_V(6); PG8_BAR;
    } else {
        PG8_STAGE(PG8_SB(0, 0), cB, voffB); PG8_STAGE(PG8_SA(0, 0), cA, voffA); PG8_STAGE(PG8_SB(0, 1), cB + hstep, voffB); PG8_STAGE(PG8_SA(0, 1), cA + hstep, voffA);
        if (wr == 1) PG8_BAR;
        PG8_WAIT_V(4); PG8_BAR;
        PG8_STAGE(PG8_SB(1, 0), cB + kstep, voffB); PG8_STAGE(PG8_SA(1, 0), cA + kstep, voffA); PG8_STAGE(PG8_SB(1, 1), cB + hstep + kstep, voffB);
        PG8_WAIT_V(6); PG8_BAR;
    }
    for (;;) {
        const bool has_next = S.next(ui + 1, nxt);
        const char* nA = has_next ? (const char*)g.A + (size_t)nxt.pm * tstep : cA; const char* nB = has_next ? (const char*)g.Bt + (size_t)nxt.pn * tstep : cB;
        for (int t = 0; t < nt; t += 2) {
            const bool last = (t == nt - 2);
            const char* a1 = cA + (size_t)(t + 1) * kstep;
            const char* a2 = last ? nA : cA + (size_t)(t + 2) * kstep; const char* b2 = last ? nB : cB + (size_t)(t + 2) * kstep;
            const char* a3 = a2 + kstep; const char* b3 = b2 + kstep;
            if (last && has_next) S.a_ready(nxt);
            if constexpr (SP2) {
            PG8_LDB(B0, 0, 0); PG8_LDB(B1, 0, 1); PG8_SCHED; PG8_LDA(At, 0, 0); PG8_STAGE(PG8_SA(1, 1), a1 + hstep, voffA);
            PG8_WAIT_V(8); PG8_WAIT_L(0); PG8_BAR; PG8_MMA(0, 0, At, B0); PG8_MMA(0, 1, At, B1); PG8_BAR; PG8_SCHED;
            PG8_LDA(At, 0, 1); PG8_STAGE(PG8_SB(0, 0), b2, voffB); PG8_STAGE(PG8_SB(0, 1), b2 + hstep, voffB); PG8_STAGE(PG8_SA(0, 0), a2, voffA);
            PG8_WAIT_V(8); PG8_WAIT_L(0); PG8_BAR; PG8_MMA(1, 0, At, B0); PG8_MMA(1, 1, At, B1); PG8_BAR; PG8_SCHED;
            PG8_LDB(B0, 1, 0); PG8_LDB(B1, 1, 1); PG8_SCHED; PG8_LDA(At, 1, 0); PG8_STAGE(PG8_SA(0, 1), a2 + hstep, voffA);
            PG8_WAIT_V(8); PG8_WAIT_L(0); PG8_BAR; PG8_MMA(0, 0, At, B0); PG8_MMA(0, 1, At, B1); PG8_BAR; PG8_SCHED;
            PG8_LDA(At, 1, 1); PG8_STAGE(PG8_SB(1, 0), b3, voffB); PG8_STAGE(PG8_SB(1, 1), b3 + hstep, voffB); PG8_STAGE(PG8_SA(1, 0), a3, voffA);
            PG8_WAIT_V(8); PG8_WAIT_L(0); PG8_BAR; PG8_MMA(1, 0, At, B0); PG8_MMA(1, 1, At, B1); PG8_BAR; PG8_SCHED;
            } else {
            PG8_LDB(B0, 0, 0); PG8_SCHED; PG8_LDA(At, 0, 0); PG8_STAGE(PG8_SA(1, 1), a1 + hstep, voffA);
            PG8_WAIT_L(8); PG8_BAR; PG8_WAIT_L(0); PG8_MMA(0, 0, At, B0); PG8_BAR; PG8_SCHED;
            PG8_LDB(B1, 0, 1); PG8_STAGE(PG8_SB(0, 0), b2, voffB);
            PG8_BAR; PG8_WAIT_L(0); PG8_MMA(0, 1, At, B1); PG8_BAR;
            PG8_LDA(At, 0, 1); PG8_STAGE(PG8_SA(0, 0), a2, voffA);
            PG8_BAR; PG8_WAIT_L(0); PG8_MMA(1, 0, At, B0); PG8_BAR; PG8_SCHED;
            PG8_STAGE(PG8_SB(0, 1), b2 + hstep, voffB);
            PG8_WAIT_V(6); PG8_BAR; PG8_MMA(1, 1, At, B1); PG8_BAR;
            PG8_LDB(B0, 1, 0); PG8_SCHED; PG8_LDA(At, 1, 0); PG8_STAGE(PG8_SA(0, 1), a2 + hstep, voffA);
            PG8_WAIT_L(8); PG8_BAR; PG8_WAIT_L(0); PG8_MMA(0, 0, At, B0); PG8_BAR; PG8_SCHED;
            PG8_LDB(B1, 1, 1); PG8_STAGE(PG8_SB(1, 0), b3, voffB);
            PG8_BAR; PG8_WAIT_L(0); PG8_MMA(0, 1, At, B1); PG8_BAR;
            PG8_LDA(At, 1, 1); PG8_STAGE(PG8_SA(1, 0), a3, voffA);
            PG8_BAR; PG8_WAIT_L(0); PG8_MMA(1, 0, At, B0); PG8_BAR; PG8_SCHED;
            PG8_STAGE(PG8_SB(1, 1), b3 + hstep, voffB);
            PG8_WAIT_V(6); PG8_BAR; PG8_MMA(1, 1, At, B1); PG8_BAR;
            }
        }
        if constexpr (ALIGN_EPI) { if (wr == 0) PG8_BAR; }
        if constexpr (!Epi::AFTER_DRAIN) { const int ln = fresh_lane(); E(acc, cur, wr, wc, ln & 15, ln >> 4); S.done(cur); }
        if (!has_next) break;
#pragma unroll
        for (int a = 0; a < 2; ++a)
#pragma unroll
            for (int b = 0; b < 2; ++b)
#pragma unroll
                for (int m = 0; m < 4; ++m)
#pragma unroll
                    for (int n = 0; n < 2; ++n) acc[a][b][m][n] = (f32x4){0.f, 0.f, 0.f, 0.f};
        cur = nxt; cA = nA; cB = nB; ++ui;
        if constexpr (ALIGN_EPI) { if (wr == 1) PG8_BAR; }
    }
    PG8_WAIT_V(0);
    if constexpr (!ALIGN_EPI) { if (wr == 0) PG8_BAR; }
    PG8_BAR;
    if constexpr (Epi::AFTER_DRAIN) { const int ln = fresh_lane(); E.fused(acc, cur, wr, wc, ln & 15, ln >> 4, lds, wid, ln); S.done(cur); }
#undef PG8_SA
#undef PG8_SB
#undef PG8_STAGE
#undef PG8_LDA
#undef PG8_LDB
#undef PG8_MMA
#undef PG8_WAIT_V
#undef PG8_WAIT_L
#undef PG8_BAR
#undef PG8_SCHED
}
}

#define GAS __attribute__((address_space(1)))
#define LAS __attribute__((address_space(3)))
typedef float f32x4 __attribute__((ext_vector_type(4)));
typedef unsigned v4u __attribute__((ext_vector_type(4)));
typedef GAS unsigned gu32;
#define XB_TMO      128
#define XB_XCNT(j)  (256  + 64 * (j))
#define XB_XSUB(j)  (1280 + 64 * (j))
#define XB_XGEN(j)  (2304 + 64 * (j))
#define XB_TOP      3328
#define XB_TOPGEN   3392
#define XCD_BAR_WORDS 3456
#define XB_SPIN_CAP (1u << 18)

__device__ __forceinline__ unsigned xb_ld(unsigned* p)              { return __hip_atomic_load(p, __ATOMIC_RELAXED, __HIP_MEMORY_SCOPE_AGENT); }
__device__ __forceinline__ unsigned xb_add(unsigned* p, unsigned v) { return __hip_atomic_fetch_add(p, v, __ATOMIC_RELAXED, __HIP_MEMORY_SCOPE_AGENT); }
__device__ __forceinline__ unsigned xb_xcc_id() { return (unsigned)__builtin_amdgcn_s_getreg((3 << 11) | 20) & 0xFu; }
#define XB_SPIN(cond, bar) do { unsigned _sp = 0; while (cond) { __builtin_amdgcn_s_sleep(1); \
    if ((++_sp & 255u) == 0u) { if (xb_ld(&(bar)[XB_TMO])) break; if (_sp > XB_SPIN_CAP) { atomicAdd(&(bar)[XB_TMO], 1u); break; } } } } while (0)

struct XcdBarrier {
    unsigned* bar; unsigned x;
    volatile LAS unsigned* st;
};

__device__ __forceinline__ XcdBarrier xcd_barrier_post(unsigned* bar, volatile LAS unsigned* st, int tid) {
    XcdBarrier b; b.bar = bar; b.x = xb_xcc_id(); b.st = st;
    if (tid == 0) (void)xb_add(&bar[XB_XCNT(b.x)], 1u);
    return b;
}
__device__ __forceinline__ void xcd_barrier_complete(unsigned* bar, unsigned x, unsigned& nloc, unsigned& nx) {
    const unsigned G = gridDim.x * gridDim.y * gridDim.z;
    unsigned sum, cnt, mine, sp = 0u;
    for (;;) {
        sum = 0u; cnt = 0u; mine = 0u;
#pragma unroll
        for (unsigned j = 0; j < 16; ++j) { const unsigned c = xb_ld(&bar[XB_XCNT(j)]); sum += c; cnt += (c > 0u) ? 1u : 0u; mine = (j == x) ? c : mine; }
        if (sum == G) break;
        __builtin_amdgcn_s_sleep(1);
        if ((++sp & 255u) == 0u) { if (xb_ld(&bar[XB_TMO])) break; if (sp > XB_SPIN_CAP) { atomicAdd(&bar[XB_TMO], 1u); break; } }
    }
    nloc = mine > 0u ? mine : 1u; nx = cnt > 0u ? cnt : 1u;
}

__device__ __forceinline__ void xcd_barrier(const XcdBarrier& b, int tid) {
    asm volatile("s_waitcnt vmcnt(0)" ::: "memory");
    __syncthreads();
    if (tid == 0) {
        unsigned* bar = b.bar;
        __builtin_amdgcn_s_waitcnt(0);
        unsigned nloc = b.st[0], nx = b.st[1];
        if (nloc == 0u) { xcd_barrier_complete(bar, b.x, nloc, nx); b.st[0] = nloc; b.st[1] = nx; }
        const unsigned old = xb_add(&bar[XB_XSUB(b.x)], 1u);
        const unsigned gen = old / nloc;
        if (old + 1u == (gen + 1u) * nloc) {
            __builtin_amdgcn_fence(__ATOMIC_RELEASE, "agent");
            asm volatile("s_waitcnt vmcnt(0)" ::: "memory");
            const unsigned og = xb_add(&bar[XB_TOP], 1u);
            const unsigned tg = og / nx;
            if (og + 1u == (tg + 1u) * nx) xb_add(&bar[XB_TOPGEN], 1u);
            else XB_SPIN(xb_ld(&bar[XB_TOPGEN]) == tg, bar);
            __builtin_amdgcn_fence(__ATOMIC_ACQUIRE, "agent");
            xb_add(&bar[XB_XGEN(b.x)], 1u);
            asm volatile("s_waitcnt vmcnt(0)" ::: "memory");
        } else {
            XB_SPIN(xb_ld(&bar[XB_XGEN(b.x)]) == gen, bar);
            __builtin_amdgcn_fence(__ATOMIC_ACQUIRE, "agent");
            asm volatile("s_waitcnt vmcnt(0)" ::: "memory");
        }
    }
    __syncthreads();
}

constexpr int NTHR = 512, NWAVES = 8;
constexpr int RING_BYTES = 131072, MISC_OFF = RING_BYTES + 320, LDS_BYTES = 147456;
constexpr int CW_BAR = 4096;
constexpr size_t CTL_ZERO_BYTES = 64 * 1024;
constexpr size_t WT_IN = WS_WT, WT_OUT = WT_IN + (size_t)2560 * 1024 * 2, WT_GU = WT_OUT + (size_t)1024 * 1024 * 2, WT_DOWN = WT_GU + (size_t)5632 * 1024 * 2,
                 WT_UQ = WT_DOWN + (size_t)1024 * 2816 * 2, WT_UKV = WT_UQ + (size_t)768 * 256 * 2, WT_CK = WT_UKV + (size_t)768 * 128 * 2, WT_CV = WT_CK + (size_t)64 * 2048 * 2,
                 WT_QM = WT_CV + (size_t)64 * 2048 * 2, WT_KM = WT_QM + 4 * 64 * 64 * 2, WT_END = WT_KM + 4 * 64 * 64 * 2;
static_assert(WT_END <= WS_HB, "weights");
constexpr int NPH = 22, PPL = 10;
constexpr int PROBE_SEL = 0;
constexpr int REP_MASK = 0;
#ifndef PHM
#define PHM 0xffff
#endif
struct MP { const float* in[N_IN]; float* out; unsigned char* ws; int ph_lo, ph_hi, coop, pad; };

struct MPK {
    const __attribute__((address_space(4))) MP* k;
    struct InArr { const __attribute__((address_space(4))) MP* k; __device__ __forceinline__ const float* operator[](int i) const { return k->in[i]; } };
    __device__ __forceinline__ InArr in_() const { return InArr{k}; }
};
#define PIN(i) (p.k->in[i])
__device__ __forceinline__ unsigned pk2(float lo, float hi) { return (unsigned)f2bf(lo) | ((unsigned)f2bf(hi) << 16); }
struct MapId { int n; __device__ __forceinline__ int operator()(int c) const { return c < n ? c : -1; } };
struct MapIn { __device__ __forceinline__ int operator()(int c) const {
    if (c < 1152) return c; if (c < 1280) return 1426 + (c - 1152); if (c < 1536) return 1170 + (c - 1280); if (c < 2304) return 1586 + (c - 1536);
    if (c < 2336) return 1554 + (c - 2304); if (c < 2354) return 1152 + (c - 2336); if (c < 2362) return c; return -1; } };
struct MapGU { __device__ __forceinline__ int operator()(int c) const { const int t = c >> 8, w = c & 255; return (w < 128) ? t * 128 + w : FF + t * 128 + (w - 128); } };
template <class Map> __device__ __forceinline__ void transpose_item(const float* W, int K, int ldw, const Map& map, const float* kscale, bf16* WT, LAS float* scr, int item, int nblk, int lane) {
    const int kb = item / nblk, nb = item % nblk, k0 = 64 * kb, n0 = 32 * nb;
    const int np = 2 * (lane & 15);
    const int sc = map(n0 + np);
#pragma unroll 8
    for (int i = 0; i < 16; ++i) { const int kk = 4 * i + (lane >> 4); float2 v = (sc >= 0) ? *(const float2*)(W + (size_t)(k0 + kk) * ldw + sc) : make_float2(0.f, 0.f);
        if (kscale) { const float ksc = kscale[k0 + kk]; v.x *= ksc; v.y *= ksc; } scr[kk * 33 + np] = v.x; scr[kk * 33 + np + 1] = v.y; }
    asm volatile("s_waitcnt lgkmcnt(0)" ::: "memory");
    const int c = lane & 7;
#pragma unroll
    for (int j = 0; j < 4; ++j) { const int n = (lane >> 3) + 8 * j; const LAS float* s = scr + (8 * c) * 33 + n;
        v4u o; o.x = pk2(s[0 * 33], s[1 * 33]); o.y = pk2(s[2 * 33], s[3 * 33]); o.z = pk2(s[4 * 33], s[5 * 33]); o.w = pk2(s[6 * 33], s[7 * 33]);
        *(v4u*)(WT + (size_t)(n0 + n) * K + k0 + 8 * c) = o; }
    asm volatile("s_waitcnt lgkmcnt(0)" ::: "memory");
}
__device__ __forceinline__ void norm_rows(const float* x, const float* g, const float* shift, const float* scale, bf16* hb, float* outf, int mode, int gw, int ngw, int lane) {
    const int rpw = T_ / ngw, m0 = gw * rpw, b = m0 / S_;
    float4 gs[4], sh[4];
#pragma unroll
    for (int j = 0; j < 4; ++j) { const int col = 4 * lane + 256 * j; gs[j] = *(const float4*)(g + col);
        if (mode != 2) { const float4 sc = *(const float4*)(scale + (size_t)b * 6144 + col); sh[j] = *(const float4*)(shift + (size_t)b * 6144 + col);
            gs[j].x *= 1.f + sc.x; gs[j].y *= 1.f + sc.y; gs[j].z *= 1.f + sc.z; gs[j].w *= 1.f + sc.w; }
        else sh[j] = make_float4(0.f, 0.f, 0.f, 0.f); }
    float4 nv[4], nw[4];
    { const float4* xr = (const float4*)(x + (size_t)m0 * D_) + lane;
#pragma unroll
      for (int j = 0; j < 4; ++j) { nv[j] = xr[64 * j]; nw[j] = xr[D_ / 4 + 64 * j]; } }
    for (int r = 0; r < rpw; r += 2) {
        const int m = m0 + r;
        float4 v[4], w[4]; float s = 0.f, s2 = 0.f;
#pragma unroll
        for (int j = 0; j < 4; ++j) { v[j] = nv[j]; w[j] = nw[j]; }
        if (r + 2 < rpw) { const float4* xr = (const float4*)(x + (size_t)(m + 2) * D_) + lane;
#pragma unroll
            for (int j = 0; j < 4; ++j) { nv[j] = xr[64 * j]; nw[j] = xr[D_ / 4 + 64 * j]; } }
#pragma unroll
        for (int j = 0; j < 4; ++j) { s += v[j].x * v[j].x + v[j].y * v[j].y + v[j].z * v[j].z + v[j].w * v[j].w; s2 += w[j].x * w[j].x + w[j].y * w[j].y + w[j].z * w[j].z + w[j].w * w[j].w; }
        const float r1 = rsqrtf(wave_sum2(s) * (1.f / D_) + EPS), r2 = rsqrtf(wave_sum2(s2) * (1.f / D_) + EPS);
#pragma unroll
        for (int j = 0; j < 4; ++j) {
            const int col = 4 * lane + 256 * j;
            float4 o, o2;
            o.x = v[j].x * r1 * gs[j].x + sh[j].x; o.y = v[j].y * r1 * gs[j].y + sh[j].y; o.z = v[j].z * r1 * gs[j].z + sh[j].z; o.w = v[j].w * r1 * gs[j].w + sh[j].w;
            o2.x = w[j].x * r2 * gs[j].x + sh[j].x; o2.y = w[j].y * r2 * gs[j].y + sh[j].y; o2.z = w[j].z * r2 * gs[j].z + sh[j].z; o2.w = w[j].w * r2 * gs[j].w + sh[j].w;
            if (mode == 2) { *(float4*)(outf + (size_t)m * D_ + col) = o; *(float4*)(outf + (size_t)(m + 1) * D_ + col) = o2; }
            else { uint2 q; q.x = pk2(o.x, o.y); q.y = pk2(o.z, o.w); *(uint2*)(hb + (size_t)m * D_ + col) = q;
                   uint2 q2; q2.x = pk2(o2.x, o2.y); q2.y = pk2(o2.z, o2.w); *(uint2*)(hb + (size_t)(m + 1) * D_ + col) = q2; }
        }
    }
}
__device__ __forceinline__ void ph_p0(const MPK& p, LAS unsigned char* lds, int tid) {
    const int wave = tid >> 6, lane = tid & 63;
    LAS float* ca = (LAS float*)lds; LAS float* red = ca + 8192;
    unsigned char* ws = p.k->ws; float* mod = (float*)(ws + WS_MOD);
    const float* c = PIN(I_C);
    for (int i = tid; i < 8192; i += NTHR) ca[i] = siluf_(c[i]);
    __syncthreads();
    for (int item = blockIdx.x; item < 96; item += gridDim.x) {
        const int l = item / 48, j = (item % 48) * 128 + 2 * lane;
        const float* w = PIN(I_WADA) + (size_t)l * 1024 * 6144 + j;
        float acc[8][2];
#pragma unroll
        for (int b = 0; b < 8; ++b) { acc[b][0] = 0.f; acc[b][1] = 0.f; }
#pragma unroll 8
        for (int k = wave * 128; k < wave * 128 + 128; ++k) {
            const float2 wv = *(const float2*)(w + (size_t)k * 6144);
#pragma unroll
            for (int b = 0; b < 8; ++b) { const float cv = ca[b * 1024 + k]; acc[b][0] += cv * wv.x; acc[b][1] += cv * wv.y; }
        }
#pragma unroll
        for (int b = 0; b < 8; ++b) { red[(wave * 8 + b) * 128 + 2 * lane] = acc[b][0]; red[(wave * 8 + b) * 128 + 2 * lane + 1] = acc[b][1]; }
        __syncthreads();
        { const int b = wave;
#pragma unroll
          for (int c2 = 0; c2 < 2; ++c2) { float s2 = 0.f;
#pragma unroll
            for (int w8 = 0; w8 < 8; ++w8) s2 += red[(w8 * 8 + b) * 128 + c2 * 64 + lane];
            mod[((size_t)l * 8 + b) * 6144 + (item % 48) * 128 + c2 * 64 + lane] = s2 + PIN(I_BADA)[l * 6144 + (item % 48) * 128 + c2 * 64 + lane]; } }
        __syncthreads();
    }
    const int* pos = (const int*)PIN(I_POS);
    float *cosP = (float*)(ws + WS_COSP), *sinP = (float*)(ws + WS_SINP), *cosM = (float*)(ws + WS_COSM), *sinM = (float*)(ws + WS_SINM);
    for (int i = blockIdx.x * NTHR + tid; i < T_ * 24; i += gridDim.x * NTHR) {
        const int m = i / 24, f = i % 24;
        double inv; if (f < 8) inv = pow(500000.0, -(double)(2 * f) / 16.0); else inv = pow(500000.0, -(double)(2 * (f - 8)) / 32.0);
        const float ang = (float)pos[m] * (float)inv;
        const double a = (double)ang, kq = rint(a * 0.15915494309189535), r = a - kq * 6.283185307179586476925;
        const float cs = (float)cos(r), sn = (float)sin(r);
        if (f < 8) { cosP[m * 8 + f] = cs; sinP[m * 8 + f] = sn; } else { cosM[m * 16 + f - 8] = cs; sinM[m * 16 + f - 8] = sn; }
    }
}
__device__ __forceinline__ void early_transposes(const MPK& p, int l, LAS unsigned char* lds, int tid, int first) {
    const int wave = tid >> 6, lane = tid & 63;
    if ((int)blockIdx.x < first) return;
    const int gw = ((int)blockIdx.x - first) * NWAVES + wave, ngw = ((int)gridDim.x - first) * NWAVES;
    unsigned char* ws = p.k->ws;
    LAS float* scr = (LAS float*)(lds + wave * 8704);
    constexpr int I0 = 16 * 80, I4 = 4 * 24, I5 = 2 * 24, I6 = 32 * 2, I7 = 32 * 2, I8 = 8, I9 = 8;
    constexpr int NIT = I0 + I4 + I5 + I6 + I7 + I8 + I9;
    for (int it = gw; it < NIT; it += ngw) {
        int r = it;
        if (r < I0) { transpose_item(PIN(I_WIN) + (size_t)l * D_ * DIN, D_, DIN, MapIn{}, nullptr, (bf16*)(ws + WT_IN), scr, r, 80, lane); continue; } r -= I0;
        if (r < I4) { transpose_item(PIN(I_WUQ) + (size_t)l * 256 * 576, 256, 576, MapId{576}, PIN(I_GQL) + l * 256, (bf16*)(ws + WT_UQ), scr, r, 24, lane); continue; } r -= I4;
        if (r < I5) { transpose_item(PIN(I_WUKV) + (size_t)l * 128 * 768, 128, 768, MapId{768}, PIN(I_GKVL) + l * 128, (bf16*)(ws + WT_UKV), scr, r, 24, lane); continue; } r -= I5;
        if (r < I6) { transpose_item(PIN(I_WCK) + (size_t)l * 2048 * 64, 2048, 64, MapId{64}, nullptr, (bf16*)(ws + WT_CK), scr, r, 2, lane); continue; } r -= I6;
        if (r < I7) { transpose_item(PIN(I_WCV) + (size_t)l * 2048 * 64, 2048, 64, MapId{64}, nullptr, (bf16*)(ws + WT_CV), scr, r, 2, lane); continue; } r -= I7;
        if (r < I8) { const int h = r >> 1; transpose_item(PIN(I_WQM) + (size_t)l * 16384 + h * 4096, 64, 64, MapId{64}, nullptr, (bf16*)(ws + WT_QM) + h * 4096, scr, r & 1, 2, lane); continue; } r -= I8;
        { const int h = r >> 1; transpose_item(PIN(I_WKM) + (size_t)l * 16384 + h * 4096, 64, 64, MapId{64}, nullptr, (bf16*)(ws + WT_KM) + h * 4096, scr, r & 1, 2, lane); }
    }
}
__device__ __forceinline__ void ph_prep(const MPK& p, int l, LAS unsigned char* lds, int tid) {
    const int wave = tid >> 6, lane = tid & 63;
    const int gw = blockIdx.x * NWAVES + wave, ngw = gridDim.x * NWAVES;
    unsigned char* ws = p.k->ws;
    LAS float* scr = (LAS float*)(lds + wave * 8704);
    for (int i = blockIdx.x * NTHR + tid; i < 2 * T_; i += gridDim.x * NTHR) ((float*)(ws + WS_SSQL))[i] = 0.f;
    if (l == 0) early_transposes(p, l, lds, tid, 0);
    const float* xin = (l == 0) ? PIN(I_X) : p.k->out;
    const float* modl = (const float*)(ws + WS_MOD) + (size_t)l * 8 * 6144;
    norm_rows(xin, PIN(I_GN1) + l * D_, modl + 0, modl + 1024, (bf16*)(ws + WS_HB), nullptr, 0, gw, ngw, lane);
}
__device__ __forceinline__ void late_transposes(const MPK& p, int l, LAS unsigned char* lds, int tid, int first) {
    const int wave = tid >> 6, lane = tid & 63;
    if ((int)blockIdx.x < first) return;
    const int gw = ((int)blockIdx.x - first) * NWAVES + wave, ngw = ((int)gridDim.x - first) * NWAVES;
    unsigned char* ws = p.k->ws;
    LAS float* scr = (LAS float*)(lds + wave * 8704);
    constexpr int I1 = 16 * 32, I2 = 16 * 176, I3 = 44 * 32;
    for (int it = gw; it < I1 + I2 + I3; it += ngw) {
        int r = it;
        if (r < I1) { transpose_item(PIN(I_WOUT) + (size_t)l * D_ * D_, D_, D_, MapId{D_}, nullptr, (bf16*)(ws + WT_OUT), scr, r, 32, lane); continue; } r -= I1;
        if (r < I2) { transpose_item(PIN(I_WGU) + (size_t)l * D_ * 2 * FF, D_, 2 * FF, MapGU{}, nullptr, (bf16*)(ws + WT_GU), scr, r, 176, lane); continue; } r -= I2;
        transpose_item(PIN(I_WDOWN) + (size_t)l * FF * D_, FF, D_, MapId{D_}, nullptr, (bf16*)(ws + WT_DOWN), scr, r, 32, lane);
    }
}
__device__ __forceinline__ void ph_mixnorm(const MPK& p, int l, int tid) {
    const int gw = blockIdx.x * NWAVES + (tid >> 6), ngw = gridDim.x * NWAVES, lane = tid & 63;
    unsigned char* ws = p.k->ws;
    bf16* mix = (bf16*)(ws + WS_HB); const float* ga = PIN(I_GOA) + l * 384; const float* gb = PIN(I_GOB) + l * 384;
    const bf16 *oc = (const bf16*)(ws + WS_OCMP), *os = (const bf16*)(ws + WS_OSLC), *ow = (const bf16*)(ws + WS_OWIN); const float* gm = (const float*)(ws + WS_GM);
#define UNPK8(dst, src) dst[0] = __uint_as_float(src.x << 16); dst[1] = __uint_as_float(src.x & 0xffff0000u); dst[2] = __uint_as_float(src.y << 16); dst[3] = __uint_as_float(src.y & 0xffff0000u); \
    dst[4] = __uint_as_float(src.z << 16); dst[5] = __uint_as_float(src.z & 0xffff0000u); dst[6] = __uint_as_float(src.w << 16); dst[7] = __uint_as_float(src.w & 0xffff0000u);
    const int rpw = T_ / ngw;
    const float* ggp = (lane < 48) ? ga + lane * 8 : gb + (lane - 48) * 8; const float4 gA0 = *(const float4*)ggp, gA1 = *(const float4*)(ggp + 4);
    const float* ggq = gb + (16 + (lane & 31)) * 8; const float4 gB0 = *(const float4*)ggq, gB1 = *(const float4*)(ggq + 4);
    v4u ra4, rb4, rc4, ry4; float rg0, rg1, rg2;
#define MIX_LOAD(m_) do { const bf16* r_ = mix + (size_t)(m_) * D_; \
        if (lane < 48) { const size_t o_ = (size_t)(m_) * 384 + lane * 8; const float* g3_ = gm + (size_t)(m_) * 32 + 3 * (lane >> 3); rg0 = g3_[0]; rg1 = g3_[1]; rg2 = g3_[2]; \
            ra4 = *(const v4u*)(oc + o_); rb4 = *(const v4u*)(os + o_); rc4 = *(const v4u*)(ow + o_); } \
        else { ra4 = *(const v4u*)(r_ + 384 + (lane - 48) * 8); rb4 = ra4; rc4 = ra4; rg0 = 0.f; rg1 = 0.f; rg2 = 0.f; } \
        if (lane < 32) ry4 = *(const v4u*)(r_ + 384 + (16 + lane) * 8); else ry4 = ra4; } while (0)
    const int mend = gw * rpw + rpw;
    MIX_LOAD(gw * rpw);
    for (int m = gw * rpw; m < mend; ++m) {
        bf16* r = mix + (size_t)m * D_;
        const v4u ca4 = ra4, cb4 = rb4, cc4 = rc4, cy4 = ry4; const float g0 = rg0, g1 = rg1, g2 = rg2;
        if (m + 1 < mend) MIX_LOAD(m + 1);
        float v0[8], v1[8]; float sa = 0.f, sb = 0.f;
        if (lane < 48) {
            float c8[8], s8[8], w8[8]; UNPK8(c8, ca4) UNPK8(s8, cb4) UNPK8(w8, cc4)
#pragma unroll
            for (int i = 0; i < 8; ++i) { v0[i] = g0 * c8[i] + g1 * s8[i] + g2 * w8[i]; sa += v0[i] * v0[i]; }
        } else {
            UNPK8(v0, ca4)
#pragma unroll
            for (int i = 0; i < 8; ++i) sb += v0[i] * v0[i];
        }
        if (lane < 32) { UNPK8(v1, cy4)
#pragma unroll
            for (int i = 0; i < 8; ++i) sb += v1[i] * v1[i]; }
        const float ra = rsqrtf(wave_sum2(sa) * (1.f / 384.f) + EPS), rb = rsqrtf(wave_sum2(sb) * (1.f / 384.f) + EPS);
        {
            const int col = (lane < 48) ? lane * 8 : 384 + (lane - 48) * 8; const float rr = (lane < 48) ? ra : rb;
            const float4 q0 = gA0, q1 = gA1;
            v4u w; w.x = pk2(v0[0] * rr * q0.x, v0[1] * rr * q0.y); w.y = pk2(v0[2] * rr * q0.z, v0[3] * rr * q0.w); w.z = pk2(v0[4] * rr * q1.x, v0[5] * rr * q1.y); w.w = pk2(v0[6] * rr * q1.z, v0[7] * rr * q1.w);
            *(v4u*)(r + col) = w;
        }
        if (lane < 32) { const float4 q0 = gB0, q1 = gB1;
            v4u w; w.x = pk2(v1[0] * rb * q0.x, v1[1] * rb * q0.y); w.y = pk2(v1[2] * rb * q0.z, v1[3] * rb * q0.w); w.z = pk2(v1[4] * rb * q1.x, v1[5] * rb * q1.y); w.w = pk2(v1[6] * rb * q1.z, v1[7] * rb * q1.w);
            *(v4u*)(r + 384 + (16 + lane) * 8) = w; }
    }
#undef MIX_LOAD
#undef UNPK8
}


typedef short bf16x8 __attribute__((ext_vector_type(8)));
typedef short s16x4 __attribute__((ext_vector_type(4)));
typedef float f32x16 __attribute__((ext_vector_type(16)));
typedef unsigned u32x2v __attribute__((ext_vector_type(2)));
constexpr int AT_BUF = 20480, AT_K32 = 8192, AT_V = 12288;
__device__ __forceinline__ unsigned cvtpk(float lo, float hi) { unsigned r; asm volatile("v_cvt_pk_bf16_f32 %0, %1, %2" : "=v"(r) : "v"(lo), "v"(hi)); return r; }
__device__ __forceinline__ float max3f(float a, float b, float c) { float r; asm("v_max3_f32 %0, %1, %2, %3" : "=v"(r) : "v"(a), "v"(b), "v"(c)); return r; }
__device__ __forceinline__ int crow(int r, int hi) { return (r & 3) + 8 * (r >> 2) + 4 * hi; }
__device__ __forceinline__ s16x4 vtr(LAS const unsigned char* p) { return __builtin_bit_cast(s16x4, __builtin_amdgcn_ds_read_tr16_b64_v4i16((LAS s16x4*)p)); }
enum { AM_CAUSAL = 0, AM_WINDOW = 1, AM_SLC = 2 };
struct AttnState { float m, l; f32x16 o[2]; f32x16 negm; bool started; long long twait; };
template <int NC> struct TileRegs { v4u k; v4u k2; v4u v; };
template <int NC> __device__ __forceinline__ void at_load(TileRegs<NC>& r, const bf16* Kg, int ldk, const bf16* Vg, int ldv, const bf16* K2g, int ldk2, int tile, int tid) {
    const int key = tid >> 3, c = tid & 7;
    r.k = *(const v4u*)(Kg + (size_t)(tile * 64 + key) * ldk + 8 * c);
    r.v = *(const v4u*)(Vg + (size_t)(tile * 64 + key) * ldv + 8 * c);
    if (NC == 6) { if (tid < 256) r.k2 = *(const v4u*)(K2g + (size_t)(tile * 64 + (tid >> 2)) * ldk2 + 8 * (tid & 3)); }
}
template <int NC> __device__ __forceinline__ void at_store(const TileRegs<NC>& r, LAS unsigned char* buf, int tid) {
    const int key = tid >> 3, c = tid & 7;
    *(LAS v4u*)(buf + key * 128 + 16 * (c ^ ((key >> 1) & 7))) = r.k;
    *(LAS v4u*)(buf + AT_V + (c >> 2) * 4096 + key * 64 + (c & 3) * 16) = r.v;
    if (NC == 6) { if (tid < 256) { const int k2 = tid >> 2, c2 = tid & 3; *(LAS v4u*)(buf + AT_K32 + k2 * 64 + 16 * (c2 ^ ((k2 >> 2) & 3))) = r.k2; } }
}
template <int NC> __device__ __forceinline__ void qk_tile(f32x16& p0, f32x16& p1, LAS const unsigned char* buf, const bf16x8 (&qf)[NC], const f32x16& negm, int lane) {
    const int r32 = lane & 31, hi = lane >> 5;
    p0 = negm; p1 = negm;
#pragma unroll
    for (int cc = 0; cc < NC; ++cc) {
        bf16x8 k0, k1;
        if (cc < 4) { const int k0r = r32, k1r = 32 + r32;
            k0 = *(LAS const bf16x8*)(buf + k0r * 128 + 16 * ((2 * cc + hi) ^ ((k0r >> 1) & 7)));
            k1 = *(LAS const bf16x8*)(buf + k1r * 128 + 16 * ((2 * cc + hi) ^ ((k1r >> 1) & 7))); }
        else { const int k0r = r32, k1r = 32 + r32, c2 = 2 * (cc - 4) + hi;
            k0 = *(LAS const bf16x8*)(buf + AT_K32 + k0r * 64 + 16 * (c2 ^ ((k0r >> 2) & 3)));
            k1 = *(LAS const bf16x8*)(buf + AT_K32 + k1r * 64 + 16 * (c2 ^ ((k1r >> 2) & 3))); }
        p0 = __builtin_amdgcn_mfma_f32_32x32x16_bf16(k0, qf[cc], p0, 0, 0, 0);
        p1 = __builtin_amdgcn_mfma_f32_32x32x16_bf16(k1, qf[cc], p1, 0, 0, 0);
    }
}
template <int MODE> __device__ __forceinline__ void mask_tile(f32x16& p0, f32x16& p1, int kpos0, int qpos, bool need_mask, bool sel_ok, int lane) {
    const int hi = lane >> 5;
    if (need_mask) {
        const int qw0m = __builtin_amdgcn_readfirstlane(qpos) & ~31;
        const bool diag = (kpos0 + 63 > qw0m), old = (MODE == AM_WINDOW) && (kpos0 < qw0m + 31 - 511);
        if (diag || old) {
            const float selterm = (MODE == AM_SLC && !sel_ok) ? -INFINITY : INFINITY;
            const int dbase = qpos - kpos0 - 4 * hi;
#pragma unroll
            for (int r = 0; r < 16; ++r) {
                const int d0 = dbase - ((r & 3) + 8 * (r >> 2)), d1 = d0 - 32;
                float l0 = ((float)d0 + 0.5f) * INFINITY, l1 = ((float)d1 + 0.5f) * INFINITY;
                if (MODE == AM_WINDOW) { l0 = fminf(l0, ((float)(511 - d0) + 0.5f) * INFINITY); l1 = fminf(l1, ((float)(511 - d1) + 0.5f) * INFINITY); }
                if (MODE == AM_SLC) { l0 = fminf(l0, selterm); l1 = fminf(l1, selterm); }
                p0[r] = fminf(p0[r], l0); p1[r] = fminf(p1[r], l1);
            }
        } else if (MODE == AM_SLC) {
            const float selterm = sel_ok ? INFINITY : -INFINITY;
#pragma unroll
            for (int r = 0; r < 16; ++r) { p0[r] = fminf(p0[r], selterm); p1[r] = fminf(p1[r], selterm); }
        }
    }
}
template <int MODE> __device__ __forceinline__ void softmax_tile(AttnState& st, f32x16& p0, f32x16& p1, bf16x8 (&pf)[4], int kpos0, int qpos, bool need_mask, bool sel_ok, int lane) {
    mask_tile<MODE>(p0, p1, kpos0, qpos, need_mask, sel_ok, lane);
    float mx = max3f(p0[0], p1[0], p0[1]), mx2 = max3f(p1[1], p0[2], p1[2]);
#pragma unroll
    for (int r = 3; r < 15; r += 2) { mx = max3f(mx, p0[r], p1[r]); mx2 = max3f(mx2, p0[r + 1], p1[r + 1]); }
    mx = max3f(mx, p0[15], p1[15]); mx = max3f(mx, mx2, mx2);
    mx = red32_max(mx);
    if (!st.started || __any(mx > 0.f)) {
        float dl = st.started ? fmaxf(mx, 0.f) : mx;
        dl = (dl > -1e30f) ? dl : 0.f;
        st.started = true;
        const float alpha = __builtin_amdgcn_exp2f(-dl);
        st.m += dl; st.l *= alpha;
#pragma unroll
        for (int r = 0; r < 16; ++r) { st.o[0][r] *= alpha; st.o[1][r] *= alpha; p0[r] -= dl; p1[r] -= dl; st.negm[r] = -st.m; }
    }
    float sum = 0.f;
#pragma unroll
    for (int r = 0; r < 16; ++r) { p0[r] = __builtin_amdgcn_exp2f(p0[r]); p1[r] = __builtin_amdgcn_exp2f(p1[r]); sum += p0[r] + p1[r]; }
    st.l += sum;
#pragma unroll
    for (int s2 = 0; s2 < 2; ++s2) {
        v4u a, b;
        a.x = cvtpk(p0[8 * s2 + 0], p0[8 * s2 + 1]); a.y = cvtpk(p0[8 * s2 + 2], p0[8 * s2 + 3]); a.z = cvtpk(p0[8 * s2 + 4], p0[8 * s2 + 5]); a.w = cvtpk(p0[8 * s2 + 6], p0[8 * s2 + 7]);
        b.x = cvtpk(p1[8 * s2 + 0], p1[8 * s2 + 1]); b.y = cvtpk(p1[8 * s2 + 2], p1[8 * s2 + 3]); b.z = cvtpk(p1[8 * s2 + 4], p1[8 * s2 + 5]); b.w = cvtpk(p1[8 * s2 + 6], p1[8 * s2 + 7]);
        pf[s2] = __builtin_bit_cast(bf16x8, a); pf[2 + s2] = __builtin_bit_cast(bf16x8, b);
    }
}
struct TileFlags { bool skip, need_mask, sel_ok; };
__device__ __forceinline__ void pack_p(bf16x8 (&pf)[4], const f32x16& p0, const f32x16& p1) {
#pragma unroll
    for (int s2 = 0; s2 < 2; ++s2) {
        v4u a, b;
        a.x = cvtpk(p0[8 * s2 + 0], p0[8 * s2 + 1]); a.y = cvtpk(p0[8 * s2 + 2], p0[8 * s2 + 3]); a.z = cvtpk(p0[8 * s2 + 4], p0[8 * s2 + 5]); a.w = cvtpk(p0[8 * s2 + 6], p0[8 * s2 + 7]);
        b.x = cvtpk(p1[8 * s2 + 0], p1[8 * s2 + 1]); b.y = cvtpk(p1[8 * s2 + 2], p1[8 * s2 + 3]); b.z = cvtpk(p1[8 * s2 + 4], p1[8 * s2 + 5]); b.w = cvtpk(p1[8 * s2 + 6], p1[8 * s2 + 7]);
        pf[s2] = __builtin_bit_cast(bf16x8, a); pf[2 + s2] = __builtin_bit_cast(bf16x8, b);
    }
}
template <int MODE> __device__ __forceinline__ void softmax_pair(AttnState& st, f32x16& a0, f32x16& a1, f32x16& b0, f32x16& b1, int kpos0, int qpos, const TileFlags& fa, const TileFlags& fb, int lane) {
    mask_tile<MODE>(a0, a1, kpos0, qpos, fa.need_mask, fa.sel_ok, lane);
    mask_tile<MODE>(b0, b1, kpos0 + 64, qpos, fb.need_mask, fb.sel_ok, lane);
    float mx = max3f(a0[0], a1[0], b0[0]), mx2 = max3f(b1[0], a0[1], a1[1]);
#pragma unroll
    for (int r = 1; r < 16; ++r) { mx = max3f(mx, b0[r], b1[r]); if (r > 1) mx2 = max3f(mx2, a0[r], a1[r]); }
    mx = max3f(mx, mx2, mx2);
    mx = red32_max(mx);
    if (!st.started || __any(mx > 0.f)) {
        float dl = st.started ? fmaxf(mx, 0.f) : mx;
        dl = (dl > -1e30f) ? dl : 0.f;
        st.started = true;
        const float alpha = __builtin_amdgcn_exp2f(-dl);
        st.m += dl; st.l *= alpha;
#pragma unroll
        for (int r = 0; r < 16; ++r) { st.o[0][r] *= alpha; st.o[1][r] *= alpha; a0[r] -= dl; a1[r] -= dl; b0[r] -= dl; b1[r] -= dl; st.negm[r] = -st.m; }
    }
    float sum = 0.f;
#pragma unroll
    for (int r = 0; r < 16; ++r) { a0[r] = __builtin_amdgcn_exp2f(a0[r]); a1[r] = __builtin_amdgcn_exp2f(a1[r]); b0[r] = __builtin_amdgcn_exp2f(b0[r]); b1[r] = __builtin_amdgcn_exp2f(b1[r]); sum += (a0[r] + a1[r]) + (b0[r] + b1[r]); }
    st.l += sum;
}
__device__ __forceinline__ void pv_tile(AttnState& st, LAS const unsigned char* buf, const bf16x8 (&pf)[4], int lane) {
    const int hi = lane >> 5;
    const unsigned vb = (unsigned)(uintptr_t)(buf + AT_V + (4 * hi + ((lane & 15) >> 2)) * 64 + ((lane >> 4) & 1) * 32 + (lane & 3) * 8);
#pragma unroll
    for (int dh = 0; dh < 2; ++dh) {
        s16x4 lo[4], hh[4];
#pragma unroll
        for (int s4 = 0; s4 < 4; ++s4) {
            asm volatile("ds_read_b64_tr_b16 %0, %1 offset:%c2" : "=&v"(lo[s4]) : "v"(vb), "i"(dh * 4096 + s4 * 1024) : "memory");
            asm volatile("ds_read_b64_tr_b16 %0, %1 offset:%c2" : "=&v"(hh[s4]) : "v"(vb), "i"(dh * 4096 + s4 * 1024 + 512) : "memory");
        }
        asm volatile("s_waitcnt lgkmcnt(0)" : "+v"(lo[0]), "+v"(lo[1]), "+v"(lo[2]), "+v"(lo[3]), "+v"(hh[0]), "+v"(hh[1]), "+v"(hh[2]), "+v"(hh[3]) :: "memory");
#pragma unroll
        for (int s4 = 0; s4 < 4; ++s4) {
            const bf16x8 vf = {lo[s4][0], lo[s4][1], lo[s4][2], lo[s4][3], hh[s4][0], hh[s4][1], hh[s4][2], hh[s4][3]};
            st.o[dh] = __builtin_amdgcn_mfma_f32_32x32x16_bf16(vf, pf[s4], st.o[dh], 0, 0, 0);
        }
    }
}
template <int MODE> __device__ __forceinline__ TileFlags tile_flags(int t, int qw0, unsigned selbits) {
    const int k0 = t * 64; TileFlags f;
    f.skip = k0 > qw0 + 31; f.need_mask = (k0 + 63 > qw0); f.sel_ok = true;
    if (MODE == AM_WINDOW) { f.skip = f.skip || (k0 + 63 < qw0 - 511); f.need_mask = f.need_mask || (k0 < qw0 + 31 - 511); }
    if (MODE == AM_SLC) { f.sel_ok = (selbits >> t) & 1u; const unsigned long long bal = __ballot(f.sel_ok); f.skip = f.skip || (bal == 0ull); f.need_mask = f.need_mask || (bal != ~0ull); }
    return f;
}
struct DmaOff { unsigned k, v, k2; };
template <int NC> __device__ __forceinline__ DmaOff at_dma_off(int ldk, int ldv, int ldk2, int wave, int lane) {
    const int L = wave * 64 + lane; DmaOff o;
    { const int key = L >> 3, c = (L & 7) ^ ((key >> 1) & 7); o.k = (unsigned)(key * ldk + 8 * c) * 2u; }
    { const int key = (L >> 2) & 63, c = (L >> 8) * 4 + (L & 3); o.v = (unsigned)(key * ldv + 8 * c) * 2u; }
    { const int key = (L >> 2) & 63, c2 = (L & 3) ^ ((key >> 2) & 3); o.k2 = (unsigned)(key * ldk2 + 8 * c2) * 2u; }
    return o;
}
template <int NC> __device__ __forceinline__ void at_dma(const DmaOff& o, const bf16* Kg, int ldk, const bf16* Vg, int ldv, const bf16* K2g, int ldk2, int tile, LAS unsigned char* slot, int wave) {
    __builtin_amdgcn_global_load_lds((const unsigned*)((const char*)(Kg + (size_t)tile * 64 * ldk) + o.k), (LAS unsigned*)(slot + wave * 1024), 16, 0, 0);
    __builtin_amdgcn_global_load_lds((const unsigned*)((const char*)(Vg + (size_t)tile * 64 * ldv) + o.v), (LAS unsigned*)(slot + AT_V + wave * 1024), 16, 0, 0);
    if (NC == 6) { if (wave < 4) __builtin_amdgcn_global_load_lds((const unsigned*)((const char*)(K2g + (size_t)tile * 64 * ldk2) + o.k2), (LAS unsigned*)(slot + AT_K32 + wave * 1024), 16, 0, 0); }
}
__device__ __forceinline__ void at_wait_bar(int keep) {
    if (keep == 0) asm volatile("s_waitcnt vmcnt(0) lgkmcnt(0)" ::: "memory");
    else if (keep == 4) asm volatile("s_waitcnt vmcnt(4) lgkmcnt(0)" ::: "memory");
    else asm volatile("s_waitcnt vmcnt(6) lgkmcnt(0)" ::: "memory");
    __builtin_amdgcn_s_barrier();
    asm volatile("" ::: "memory");
}
template <int NC, int MODE> __device__ __forceinline__ void at_stream(AttnState& st, LAS unsigned char* lds, const bf16* Kg, int ldk, const bf16* Vg, int ldv, const bf16* K2g, int ldk2, int t0, int t1,
                                                                       const bf16x8 (&qf)[NC], int qpos, int qw0, unsigned selbits, int tid) {
    const int lane = tid & 63, wave = __builtin_amdgcn_readfirstlane(tid >> 6), np = (t1 - t0) >> 1;
    const int nper2 = (NC == 6 && wave < 4) ? 6 : 4;
    const DmaOff dof = at_dma_off<NC>(ldk, ldv, ldk2, wave, lane);
    at_dma<NC>(dof, Kg, ldk, Vg, ldv, K2g, ldk2, t0, lds, wave); at_dma<NC>(dof, Kg, ldk, Vg, ldv, K2g, ldk2, t0 + 1, lds + AT_BUF, wave);
    if (np > 1) { at_dma<NC>(dof, Kg, ldk, Vg, ldv, K2g, ldk2, t0 + 2, lds + 2 * AT_BUF, wave); at_dma<NC>(dof, Kg, ldk, Vg, ldv, K2g, ldk2, t0 + 3, lds + 3 * AT_BUF, wave); }
    at_wait_bar(np > 1 ? nper2 : 0);
    int s0 = 0, s1 = 2 * AT_BUF, s2 = 4 * AT_BUF;
    for (int j = 0; j < np; ++j) {
        const int t = t0 + 2 * j; const bool has_2 = (j + 2 < np);
        if (has_2) { at_dma<NC>(dof, Kg, ldk, Vg, ldv, K2g, ldk2, t + 4, lds + s2, wave); at_dma<NC>(dof, Kg, ldk, Vg, ldv, K2g, ldk2, t + 5, lds + s2 + AT_BUF, wave); }
        const TileFlags fa = tile_flags<MODE>(t, qw0, selbits), fb = tile_flags<MODE>(t + 1, qw0, selbits);
        if (!fa.skip && !fb.skip) {
            f32x16 a0, a1, b0, b1; bf16x8 pf[4];
            qk_tile<NC>(a0, a1, lds + s0, qf, st.negm, lane);
            qk_tile<NC>(b0, b1, lds + s0 + AT_BUF, qf, st.negm, lane);
            softmax_pair<MODE>(st, a0, a1, b0, b1, t * 64, qpos, fa, fb, lane);
            pack_p(pf, a0, a1); pv_tile(st, lds + s0, pf, lane);
            pack_p(pf, b0, b1); pv_tile(st, lds + s0 + AT_BUF, pf, lane);
        } else {
            if (!fa.skip) { f32x16 p0, p1; bf16x8 pf[4]; qk_tile<NC>(p0, p1, lds + s0, qf, st.negm, lane); softmax_tile<MODE>(st, p0, p1, pf, t * 64, qpos, fa.need_mask, fa.sel_ok, lane); pv_tile(st, lds + s0, pf, lane); }
            if (!fb.skip) { f32x16 p0, p1; bf16x8 pf[4]; qk_tile<NC>(p0, p1, lds + s0 + AT_BUF, qf, st.negm, lane); softmax_tile<MODE>(st, p0, p1, pf, (t + 1) * 64, qpos, fb.need_mask, fb.sel_ok, lane); pv_tile(st, lds + s0 + AT_BUF, pf, lane); }
        }
        at_wait_bar(has_2 ? nper2 : 0);
        const int tmp = s0; s0 = s1; s1 = s2; s2 = tmp;
    }
}
__device__ __forceinline__ int next_item_q(unsigned* ctrs, LAS unsigned char* lds, int wave_u, int count, int q0, int& kstart) {
    const int tid = wave_u * 64 + fresh_lane();
    LAS int* slot = (LAS int*)(lds + RING_BYTES + 64);
    if (tid == 0) {
        int r = -1, k = kstart;
        for (; k < 8; ++k) { const int q = (q0 + k) & 7; const unsigned v = atomicAdd(ctrs + q * 16, 1u); if (v < (unsigned)count) { r = (q << 16) | (int)v; break; } }
        slot[0] = r; slot[1] = k;
    }
    __syncthreads();
    const int v = slot[0]; kstart = slot[1];
    __syncthreads();
    return v;
}
__device__ __forceinline__ void mla_unit(unsigned char* ws, LAS unsigned char* lds, int b, int h, int qt, int wave_u) {
    const int tid = wave_u * 64 + fresh_lane();
    const int lane = tid & 63, wave = tid >> 6, r32 = lane & 31, hi = lane >> 5;
    const int qw0 = qt * 256 + wave * 32, qpos = qw0 + r32; const size_t row = (size_t)b * S_ + qpos;
    const long long tq0 = (PROBE_SEL != 0) ? (long long)__builtin_amdgcn_s_memtime() : 0ll;
    bf16x8 qf[6];
    {
        const bf16* qp = (const bf16*)(ws + WS_OSLC) + row * 768 + h * 96 + 8 * hi;
        v4u raw[6];
#pragma unroll
        for (int cc = 0; cc < 6; ++cc) raw[cc] = *(const v4u*)(qp + 16 * cc);
        float msc = MSCALE; asm volatile("" : "+v"(msc));
        const float rs = rsqrtf(((const float*)(ws + WS_SSQL))[row] * (1.f / 256.f) + EPS) * msc;
        const float* cm_ = (const float*)(ws + WS_COSM) + row * 16 + 8 * hi; const float* sm_ = (const float*)(ws + WS_SINM) + row * 16 + 8 * hi;
#define UNPKQ(dst, src) dst[0] = __uint_as_float(src.x << 16); dst[1] = __uint_as_float(src.x & 0xffff0000u); dst[2] = __uint_as_float(src.y << 16); dst[3] = __uint_as_float(src.y & 0xffff0000u); \
        dst[4] = __uint_as_float(src.z << 16); dst[5] = __uint_as_float(src.z & 0xffff0000u); dst[6] = __uint_as_float(src.w << 16); dst[7] = __uint_as_float(src.w & 0xffff0000u);
#pragma unroll
        for (int cc = 0; cc < 4; ++cc) { float f[8]; UNPKQ(f, raw[cc])
            v4u w; w.x = cvtpk(f[0] * rs, f[1] * rs); w.y = cvtpk(f[2] * rs, f[3] * rs); w.z = cvtpk(f[4] * rs, f[5] * rs); w.w = cvtpk(f[6] * rs, f[7] * rs); qf[cc] = __builtin_bit_cast(bf16x8, w); }
        { float x1[8], x2[8], o1[8], o2[8]; UNPKQ(x1, raw[4]) UNPKQ(x2, raw[5])
#pragma unroll
          for (int j = 0; j < 8; ++j) { const float cs = cm_[j] * rs, sn = sm_[j] * rs; o1[j] = x1[j] * cs - x2[j] * sn; o2[j] = x1[j] * sn + x2[j] * cs; }
          v4u w; w.x = cvtpk(o1[0], o1[1]); w.y = cvtpk(o1[2], o1[3]); w.z = cvtpk(o1[4], o1[5]); w.w = cvtpk(o1[6], o1[7]); qf[4] = __builtin_bit_cast(bf16x8, w);
          w.x = cvtpk(o2[0], o2[1]); w.y = cvtpk(o2[2], o2[3]); w.z = cvtpk(o2[4], o2[5]); w.w = cvtpk(o2[6], o2[7]); qf[5] = __builtin_bit_cast(bf16x8, w); }
#undef UNPKQ
    }
    const long long tq1 = (PROBE_SEL != 0) ? (long long)__builtin_amdgcn_s_memtime() : 0ll;
    AttnState st; st.m = 0.f; st.l = 0.f; st.o[0] = f32x16{}; st.o[1] = f32x16{}; st.negm = f32x16{}; st.started = false; st.twait = 0;
    const bf16* kvb = (const bf16*)(ws + WS_KVM) + (size_t)b * S_ * 768 + h * 128;
    at_stream<6, AM_CAUSAL>(st, lds, kvb, 768, kvb + 64, 768, (const bf16*)(ws + WS_KR) + (size_t)b * S_ * 32, 32, 0, 4 * qt + 4, qf, qpos, qw0, 0u, tid);
    if (PROBE_SEL >= 1 && PROBE_SEL <= 3 && b == 0 && h == 0 && qt == 7 && tid == 0) { const long long tq2 = (long long)__builtin_amdgcn_s_memtime();
        ((float*)(ws + WS_CTL))[100] = (PROBE_SEL == 1) ? (float)(tq2 - tq1) : (PROBE_SEL == 2) ? (float)st.twait : (float)(tq1 - tq0); }
    const float lt = red32_sum(st.l), il = 1.f / lt;
    bf16* op = (bf16*)(ws + WS_HB) + row * D_ + 384 + h * 64 + 4 * hi;
#pragma unroll
    for (int dh = 0; dh < 2; ++dh)
#pragma unroll
        for (int g4 = 0; g4 < 4; ++g4) { u32x2v w; w.x = cvtpk(st.o[dh][4 * g4] * il, st.o[dh][4 * g4 + 1] * il); w.y = cvtpk(st.o[dh][4 * g4 + 2] * il, st.o[dh][4 * g4 + 3] * il);
            *(u32x2v*)(op + dh * 32 + 8 * g4) = w; }
}
template <int MODE> __device__ __forceinline__ void nsa_branch_unit(unsigned char* ws, LAS unsigned char* lds, int b, int h, int qt, int wave_u) {
    const int tid = wave_u * 64 + fresh_lane();
    const int lane = tid & 63, wave = tid >> 6, r32 = lane & 31, hi = lane >> 5, g = h / 3;
    const int qw0 = qt * 256 + wave * 32, qpos = qw0 + r32; const size_t row = (size_t)b * S_ + qpos;
    const bf16* nsa = (const bf16*)(ws + WS_NSA);
    const bf16* qp = nsa + row * 1152 + h * 64 + 8 * hi;
    bf16x8 qf[4];
#pragma unroll
    for (int cc = 0; cc < 4; ++cc) qf[cc] = *(const bf16x8*)(qp + 16 * cc);
    unsigned selbits = 0u; if (MODE == AM_SLC) selbits = ((const unsigned*)(ws + WS_SEL))[(size_t)(b * 2 + g) * S_ + qpos];
    const bf16* kb = nsa + (size_t)b * S_ * 1152 + g * 64 + (MODE == AM_SLC ? 640 : 896);
    AttnState st; st.m = 0.f; st.l = 0.f; st.o[0] = f32x16{}; st.o[1] = f32x16{}; st.negm = f32x16{}; st.started = false; st.twait = 0;
    const long long tn0 = (PROBE_SEL != 0) ? (long long)__builtin_amdgcn_s_memtime() : 0ll;
    const int t0 = (MODE == AM_SLC) ? 0 : ((4 * qt - 8 > 0) ? 4 * qt - 8 : 0);
    at_stream<4, MODE>(st, lds, kb, 1152, kb + 128, 1152, nullptr, 0, t0, 4 * qt + 4, qf, qpos, qw0, selbits, tid);
    if (PROBE_SEL >= 4 && PROBE_SEL <= 5 && MODE == AM_SLC && b == 0 && h == 0 && qt == 7 && tid == 0) { const long long tn1 = (long long)__builtin_amdgcn_s_memtime();
        ((float*)(ws + WS_CTL))[100] = (PROBE_SEL == 4) ? (float)(tn1 - tn0) : (float)st.twait; }
    const float lt = red32_sum(st.l), il = 1.f / lt;
    bf16* op = (bf16*)(ws + (MODE == AM_SLC ? WS_OSLC : WS_OWIN)) + row * 384 + h * 64 + 4 * hi;
#pragma unroll
    for (int dh = 0; dh < 2; ++dh)
#pragma unroll
        for (int g4 = 0; g4 < 4; ++g4) { u32x2v w; w.x = cvtpk(st.o[dh][4 * g4] * il, st.o[dh][4 * g4 + 1] * il); w.y = cvtpk(st.o[dh][4 * g4 + 2] * il, st.o[dh][4 * g4 + 3] * il);
            *(u32x2v*)(op + dh * 32 + 8 * g4) = w; }
}
__device__ __forceinline__ void cmp_unit(unsigned char* ws, LAS unsigned char* lds, int b, int g, int qt, int wave_u) {
    const int tid = wave_u * 64 + fresh_lane();
    const int lane = tid & 63, wave = tid >> 6, r32 = lane & 31, hi = lane >> 5;
    const int qpos = qt * 256 + wave * 32 + r32; const size_t row = (size_t)b * S_ + qpos;
    const bf16* kc = (const bf16*)(ws + WS_KCV) + (size_t)(b * 2 + g) * 128 * 64; const bf16* vc = kc + (size_t)8 * 2 * 128 * 64;
    { TileRegs<4> tr; at_load<4>(tr, kc, 64, vc, 64, nullptr, 0, 0, tid); at_store<4>(tr, lds, tid); at_load<4>(tr, kc, 64, vc, 64, nullptr, 0, 1, tid); at_store<4>(tr, lds + AT_BUF, tid); }
    __syncthreads();
    int nvis = (qpos >= 31) ? ((qpos - 31) >> 4) + 1 : 0; if (nvis > 127) nvis = 127;
    LAS float* IG = (LAS float*)(lds + 2 * AT_BUF) + wave * (32 * 33) + r32 * 33;
    LAS float* IL = IG + 8 * 32 * 33;
    const bf16* nsa = (const bf16*)(ws + WS_NSA);
    LAS const unsigned char* vb = lds + AT_V + (4 * hi + ((lane & 15) >> 2)) * 64 + ((lane >> 4) & 1) * 32 + (lane & 3) * 8;
    for (int r3 = 0; r3 < 3; ++r3) {
        const int h = 3 * g + r3;
        const bf16* qp = nsa + row * 1152 + h * 64 + 8 * hi;
        bf16x8 qf[4];
#pragma unroll
        for (int cc = 0; cc < 4; ++cc) qf[cc] = *(const bf16x8*)(qp + 16 * cc);
        f32x16 p[4];
#pragma unroll
        for (int tb = 0; tb < 4; ++tb) {
            LAS const unsigned char* buf = lds + (tb >> 1) * AT_BUF; const int kr = (tb & 1) * 32 + r32;
            p[tb] = f32x16{};
#pragma unroll
            for (int cc = 0; cc < 4; ++cc) { const bf16x8 kf = *(LAS const bf16x8*)(buf + kr * 128 + 16 * ((2 * cc + hi) ^ ((kr >> 1) & 7)));
                p[tb] = __builtin_amdgcn_mfma_f32_32x32x16_bf16(kf, qf[cc], p[tb], 0, 0, 0); }
        }
        float mx = -1e30f;
#pragma unroll
        for (int tb = 0; tb < 4; ++tb)
#pragma unroll
            for (int r = 0; r < 16; ++r) { const int n = 32 * tb + crow(r, hi); p[tb][r] = fminf(p[tb][r], ((float)(nvis - n) - 0.5f) * INFINITY); mx = fmaxf(mx, p[tb][r]); }
        mx = red32_max(mx);
        float sum = 0.f;
#pragma unroll
        for (int tb = 0; tb < 4; ++tb)
#pragma unroll
            for (int r = 0; r < 16; ++r) { p[tb][r] = __builtin_amdgcn_exp2f(p[tb][r] - mx); sum += p[tb][r]; }
        sum = red32_sum(sum);
        const float il = (nvis > 0) ? 1.f / sum : 0.f;
#pragma unroll
        for (int tb = 0; tb < 4; ++tb)
#pragma unroll
            for (int k = 0; k < 4; ++k) { const float a0 = p[tb][4 * k] * il, a1 = p[tb][4 * k + 1] * il, a2 = p[tb][4 * k + 2] * il, a3 = p[tb][4 * k + 3] * il;
                const int j = 2 * (4 * tb + k) + hi;
                const float gs = (a0 + a1) + (a2 + a3);
                if (r3 == 0) { IG[j] = gs; IL[j + 1] = a3; } else { IG[j] += gs; IL[j + 1] += a3; } }
        f32x16 o[2] = {f32x16{}, f32x16{}};
#pragma unroll
        for (int tb = 0; tb < 4; ++tb)
#pragma unroll
            for (int s2 = 0; s2 < 2; ++s2) {
                v4u a; a.x = cvtpk(p[tb][8 * s2 + 0], p[tb][8 * s2 + 1]); a.y = cvtpk(p[tb][8 * s2 + 2], p[tb][8 * s2 + 3]); a.z = cvtpk(p[tb][8 * s2 + 4], p[tb][8 * s2 + 5]); a.w = cvtpk(p[tb][8 * s2 + 6], p[tb][8 * s2 + 7]);
                const bf16x8 pf = __builtin_bit_cast(bf16x8, a);
                LAS const unsigned char* vbb = vb + (tb >> 1) * AT_BUF + ((tb & 1) * 2 + s2) * 1024;
#pragma unroll
                for (int dh = 0; dh < 2; ++dh) { const s16x4 lo = vtr(vbb + dh * 4096), hh = vtr(vbb + dh * 4096 + 512);
                    const bf16x8 vf = {lo[0], lo[1], lo[2], lo[3], hh[0], hh[1], hh[2], hh[3]};
                    o[dh] = __builtin_amdgcn_mfma_f32_32x32x16_bf16(vf, pf, o[dh], 0, 0, 0); }
                asm volatile("" ::: "memory");
            }
        bf16* op = (bf16*)(ws + WS_OCMP) + row * 384 + h * 64 + 4 * hi;
#pragma unroll
        for (int dh = 0; dh < 2; ++dh)
#pragma unroll
            for (int g4 = 0; g4 < 4; ++g4) { u32x2v w; w.x = cvtpk(o[dh][4 * g4] * il, o[dh][4 * g4 + 1] * il); w.y = cvtpk(o[dh][4 * g4 + 2] * il, o[dh][4 * g4 + 3] * il);
                *(u32x2v*)(op + dh * 32 + 8 * g4) = w; }
    }
    const int cur = qpos >> 6;
    LAS float* imp = IG;
#pragma unroll 1
    for (int jj = 0; jj < 16; ++jj) {
        const int j = 16 * hi + jj;
        float v = IG[j] + (j > 0 ? IL[j] : 0.f);
        if (j == 0 || j == cur || j == cur - 1) v = INFINITY;
        if (j * 64 > qpos) v = -INFINITY;
        IL[j] = v;
    }
#pragma unroll 1
    for (int jj = 0; jj < 16; ++jj) { const int j = 16 * hi + jj; imp[j] = IL[j]; }
    unsigned mask = 0;
#pragma unroll 1
    for (int jj = 0; jj < 16; ++jj) {
        const int j = 16 * hi + jj; const float v = imp[j]; int rank = 0;
#pragma unroll 4
        for (int k = 0; k < 32; ++k) { const float u2 = imp[k]; rank += (u2 > v || (u2 == v && k < j)) ? 1 : 0; }
        if (rank < 16) mask |= 1u << j;
    }
    mask = red32_or(mask);
    if (hi == 0) ((unsigned*)(ws + WS_SEL))[(size_t)(b * 2 + g) * S_ + qpos] = mask;
    __syncthreads();
}
__device__ __forceinline__ void lora_rows(unsigned char* ws, int tid) {
    const int gw = blockIdx.x * NWAVES + (tid >> 6), ngw = gridDim.x * NWAVES, lane = tid & 63;
    bf16* kvl = (bf16*)(ws + WS_KVL); const bf16* ql = (const bf16*)(ws + WS_QL); float* ssql = (float*)(ws + WS_SSQL);
    for (int m = gw; m < T_; m += ngw) {
        const unsigned kv = *(const unsigned*)(kvl + (size_t)m * 128 + 2 * lane);
        const float k0 = __uint_as_float(kv << 16), k1 = __uint_as_float(kv & 0xffff0000u);
        const uint2 qv = *(const uint2*)(ql + (size_t)m * 256 + 4 * lane);
        const float q0 = __uint_as_float(qv.x << 16), q1 = __uint_as_float(qv.x & 0xffff0000u), q2 = __uint_as_float(qv.y << 16), q3 = __uint_as_float(qv.y & 0xffff0000u);
        const float sk = wave_sum2(k0 * k0 + k1 * k1), sq = wave_sum2((q0 * q0 + q1 * q1) + (q2 * q2 + q3 * q3));
        const float rk = rsqrtf(sk * (1.f / 128.f) + EPS);
        *(unsigned*)(kvl + (size_t)m * 128 + 2 * lane) = pk2(k0 * rk, k1 * rk);
        if (lane == 0) ssql[m] = sq;
    }
}
__device__ __forceinline__ void post_misc(unsigned char* ws, const float* big, const float* bfg, int tid) {
    const float* mr = (const float*)(ws + WS_MISCRAW); const float* cosM = (const float*)(ws + WS_COSM); const float* sinM = (const float*)(ws + WS_SINM);
    bf16* kr = (bf16*)(ws + WS_KR); float* gm = (float*)(ws + WS_GM);
    for (int idx = blockIdx.x * NTHR + tid; idx < T_ * 64; idx += gridDim.x * NTHR) {
        const int row = idx >> 6, c = idx & 63; const float* r = mr + (size_t)row * 64; const float v = r[c];
        if (c < 32) { const int i = c & 15; const float x1 = r[i], x2 = r[16 + i], cs = cosM[row * 16 + i], sn = sinM[row * 16 + i];
            kr[(size_t)row * 32 + c] = f2bf((c < 16) ? x1 * cs - x2 * sn : x1 * sn + x2 * cs); }
        else if (c < 50) gm[(size_t)row * 32 + (c - 32)] = 1.f / (1.f + __expf(-v));
        else if (c < 54) gm[(size_t)row * 32 + 18 + (c - 50)] = v + big[c - 50];
        else if (c < 58) { const float z = v + bfg[c - 54]; gm[(size_t)row * 32 + 22 + (c - 54)] = fminf(z, 0.f) - __logf(1.f + __expf(-fabsf(z))); }
    }
}

typedef float f32x4v __attribute__((ext_vector_type(4)));
__device__ __forceinline__ void compress_item(unsigned char* ws, LAS unsigned char* lds, const float* cmp_pos, int item, int wave_u) {
    const int lane = fresh_lane(), tid = wave_u * 64 + lane;
    const int nb = item & 7, g = (item >> 3) & 1, b = (item >> 4) & 7, kv = item >> 7;
    const bf16* tok = (const bf16*)(ws + WS_NSA) + (size_t)b * S_ * 1152 + (kv ? 512 : 384) + g * 64;
    const bf16* wt = (const bf16*)(ws + (kv ? WT_CV : WT_CK));
    const int nrow = nb * 16 + (lane & 15), kq = lane >> 4;
    f32x4v acc[4] = {f32x4v{}, f32x4v{}, f32x4v{}, f32x4v{}};
#pragma unroll 4
    for (int ks = 0; ks < 8; ++ks) {
        const int k = wave_u * 256 + ks * 32 + kq * 8, l = k >> 6, d = k & 63;
        int trow = 16 * nrow + l; trow = trow < S_ ? trow : S_ - 1;
        const v4u t4 = *(const v4u*)(tok + (size_t)trow * 1152 + d);
        const f32x4v p0 = *(const f32x4v*)(cmp_pos + k), p1 = *(const f32x4v*)(cmp_pos + k + 4);
        v4u a4;
        a4.x = cvtpk(__uint_as_float(t4.x << 16) + p0[0], __uint_as_float(t4.x & 0xffff0000u) + p0[1]); a4.y = cvtpk(__uint_as_float(t4.y << 16) + p0[2], __uint_as_float(t4.y & 0xffff0000u) + p0[3]);
        a4.z = cvtpk(__uint_as_float(t4.z << 16) + p1[0], __uint_as_float(t4.z & 0xffff0000u) + p1[1]); a4.w = cvtpk(__uint_as_float(t4.w << 16) + p1[2], __uint_as_float(t4.w & 0xffff0000u) + p1[3]);
        const bf16x8 af = __builtin_bit_cast(bf16x8, a4);
#pragma unroll
        for (int cb = 0; cb < 4; ++cb) { const bf16x8 bfr = *(const bf16x8*)(wt + (size_t)(cb * 16 + (lane & 15)) * 2048 + k);
            acc[cb] = __builtin_amdgcn_mfma_f32_16x16x32_bf16(af, bfr, acc[cb], 0, 0, 0); }
    }
    LAS float* red = (LAS float*)lds + wave_u * 1024;
#pragma unroll
    for (int cb = 0; cb < 4; ++cb)
#pragma unroll
        for (int r = 0; r < 4; ++r) red[(4 * (lane >> 4) + r) * 64 + cb * 16 + (lane & 15)] = acc[cb][r];
    __syncthreads();
    bf16* out = (bf16*)(ws + WS_KCV) + (size_t)kv * (8 * 2 * 128 * 64) + ((size_t)(b * 2 + g) * 128 + nb * 16) * 64;
    for (int o = tid; o < 1024; o += NTHR) { float sum = 0.f;
#pragma unroll
        for (int w8 = 0; w8 < 8; ++w8) sum += ((LAS float*)lds)[w8 * 1024 + o];
        out[o] = f2bf(sum); }
    __syncthreads();
}
__device__ __forceinline__ f32x4v mm16(const LAS bf16* A, int lda, int arow0, const LAS bf16* Bt, int ldb, int bcol0, int K, int lane, f32x4v acc) {
    const LAS bf16* ap = A + (arow0 + (lane & 15)) * lda + 8 * (lane >> 4); const LAS bf16* bp = Bt + (bcol0 + (lane & 15)) * ldb + 8 * (lane >> 4);
    for (int k = 0; k < K; k += 32) acc = __builtin_amdgcn_mfma_f32_16x16x32_bf16(*(const LAS bf16x8*)(ap + k), *(const LAS bf16x8*)(bp + k), acc, 0, 0, 0);
    return acc;
}
constexpr int ML_LD = 72;
constexpr int ML_STRIDE = 3 * 64 * ML_LD * 2 + 256;
__device__ __forceinline__ void mlocal_item(unsigned char* ws, LAS unsigned char* lds, const float* convw, const float* convb, const float* big, const float* bfg, int chunk0, int wave_u) {
    const int lane = fresh_lane(), tid = wave_u * 64 + lane;
    const int h = (chunk0 >> 5) & 3, b = chunk0 >> 7;
    LAS bf16* WQ = (LAS bf16*)lds;
    LAS bf16* WK = WQ + 64 * ML_LD;
    const bf16* cm = (const bf16*)(ws + WS_CM);
#define ML_PTRS(ch) const int chunk = chunk0 + (ch); const int c = chunk & 31; const int row0 = b * S_ + c * 64; LAS bf16* XS = WK + 64 * ML_LD + (ch) * (ML_STRIDE / 2); \
    LAS bf16* VT = XS + 64 * ML_LD; LAS bf16* WKT = VT + 64 * ML_LD; LAS float* wl = (LAS float*)(WKT + 64 * ML_LD); (void)c; (void)row0; (void)XS; (void)VT; (void)WKT; (void)wl; (void)chunk;
#pragma unroll
    for (int ch = 0; ch < 2; ++ch) { ML_PTRS(ch)
        const int l = tid >> 3, ch0 = (tid & 7) * 8, row = row0 + l, s = c * 64 + l;
        float a[8];
#pragma unroll
        for (int i = 0; i < 8; ++i) a[i] = convb[h * 64 + ch0 + i];
#pragma unroll
        for (int j = 0; j < 4; ++j) { if (s - 3 + j >= 0) { const v4u x4 = *(const v4u*)(cm + (size_t)(row - 3 + j) * 768 + h * 64 + ch0);
            const float* cw = convw + j * 256 + h * 64 + ch0;
            a[0] += cw[0] * __uint_as_float(x4.x << 16); a[1] += cw[1] * __uint_as_float(x4.x & 0xffff0000u); a[2] += cw[2] * __uint_as_float(x4.y << 16); a[3] += cw[3] * __uint_as_float(x4.y & 0xffff0000u);
            a[4] += cw[4] * __uint_as_float(x4.z << 16); a[5] += cw[5] * __uint_as_float(x4.z & 0xffff0000u); a[6] += cw[6] * __uint_as_float(x4.w << 16); a[7] += cw[7] * __uint_as_float(x4.w & 0xffff0000u); } }
        v4u o4; float r[8];
#pragma unroll
        for (int i = 0; i < 8; ++i) r[i] = a[i] / (1.f + __expf(-a[i]));
        o4.x = cvtpk(r[0], r[1]); o4.y = cvtpk(r[2], r[3]); o4.z = cvtpk(r[4], r[5]); o4.w = cvtpk(r[6], r[7]);
        *(v4u*)((bf16*)(ws + WS_XC) + (size_t)row * 256 + h * 64 + ch0) = o4;
        *(LAS v4u*)(XS + l * ML_LD + ch0) = o4;
        const v4u v4 = *(const v4u*)(cm + (size_t)row * 768 + 256 + h * 64 + ch0);
        VT[(ch0 + 0) * ML_LD + l] = (bf16)(v4.x & 0xffffu); VT[(ch0 + 1) * ML_LD + l] = (bf16)(v4.x >> 16); VT[(ch0 + 2) * ML_LD + l] = (bf16)(v4.y & 0xffffu); VT[(ch0 + 3) * ML_LD + l] = (bf16)(v4.y >> 16);
        VT[(ch0 + 4) * ML_LD + l] = (bf16)(v4.z & 0xffffu); VT[(ch0 + 5) * ML_LD + l] = (bf16)(v4.z >> 16); VT[(ch0 + 6) * ML_LD + l] = (bf16)(v4.w & 0xffffu); VT[(ch0 + 7) * ML_LD + l] = (bf16)(v4.w >> 16);
    }
    {
        const int e = tid >> 3, d0 = (tid & 7) * 8;
        *(LAS v4u*)(WQ + e * ML_LD + d0) = *(const v4u*)((const bf16*)(ws + WT_QM) + h * 4096 + e * 64 + d0);
        *(LAS v4u*)(WK + e * ML_LD + d0) = *(const v4u*)((const bf16*)(ws + WT_KM) + h * 4096 + e * 64 + d0);
    }
    if (wave_u < 2) { ML_PTRS(wave_u)
        const float* mr = (const float*)(ws + WS_MISCRAW) + (size_t)(row0 + lane) * 64;
        const float z = mr[54 + h] + bfg[h]; float lf = fminf(z, 0.f) - __logf(1.f + __expf(-fabsf(z)));
        const float ig = mr[50 + h] + big[h];
#pragma unroll
        for (int o = 1; o < 64; o <<= 1) { const float t = bperm(lf, lane - o); if (lane >= o) lf += t; }
        const float bL = __int_as_float(__builtin_amdgcn_readlane(__float_as_int(lf), 63));
        const float a = bL - lf + ig; const float mx = wave_max2(a);
        wl[lane] = __expf(a - mx);
        if (lane == 0) { ((float*)(ws + WS_ML))[chunk] = mx; ((float*)(ws + WS_BL))[chunk] = bL; }
    }
    __syncthreads();
#pragma unroll
    for (int ch = 0; ch < 2; ++ch) { ML_PTRS(ch)
        const int lb = wave_u & 3; const bool isk = wave_u >= 4;
        const LAS bf16* Wt = isk ? WK : WQ;
        bf16* og = (bf16*)(ws + (isk ? WS_MK : WS_MQ)) + (size_t)(row0 + 16 * lb + 4 * (lane >> 4)) * 256 + h * 64 + (lane & 15);
        float w4[4];
#pragma unroll
        for (int r = 0; r < 4; ++r) w4[r] = wl[16 * lb + 4 * (lane >> 4) + r];
#pragma unroll
        for (int eb = 0; eb < 4; ++eb) {
            f32x4v acc = mm16(XS, ML_LD, 16 * lb, Wt, ML_LD, 16 * eb, 64, lane, f32x4v{});
            if (!isk) {
#pragma unroll
                for (int r = 0; r < 4; ++r) og[(size_t)r * 256 + 16 * eb] = f2bf(acc[r] * 0.125f);
            } else {
                bf16 kb[4];
#pragma unroll
                for (int r = 0; r < 4; ++r) { kb[r] = f2bf(acc[r]); og[(size_t)r * 256 + 16 * eb] = kb[r]; }
                u32x2v w2; w2.x = cvtpk(bf2f(kb[0]) * w4[0], bf2f(kb[1]) * w4[1]); w2.y = cvtpk(bf2f(kb[2]) * w4[2], bf2f(kb[3]) * w4[3]);
                *(LAS u32x2v*)(WKT + (16 * eb + (lane & 15)) * ML_LD + 16 * lb + 4 * (lane >> 4)) = w2;
            }
        }
    }
    __syncthreads();
#pragma unroll
    for (int ch = 0; ch < 2; ++ch) { ML_PTRS(ch)
        float* ct = (float*)(ws + WS_CT) + (size_t)chunk * 4096;
#pragma unroll
        for (int i = 0; i < 2; ++i) { const int blk = wave_u * 2 + i, eb = blk >> 2, db = blk & 3;
            const f32x4v acc = mm16(VT, ML_LD, 16 * eb, WKT, ML_LD, 16 * db, 64, lane, f32x4v{});
#pragma unroll
            for (int r = 0; r < 4; ++r) ct[(16 * eb + 4 * (lane >> 4) + r) * 64 + 16 * db + (lane & 15)] = acc[r]; }
    }
    if (tid < 128) { ML_PTRS(tid >> 6)
        const int d = tid & 63; float n = 0.f; const LAS bf16* wr_ = WKT + d * ML_LD;
        for (int l = 0; l < 64; ++l) n += bf2f(wr_[l]);
        ((float*)(ws + WS_NL))[chunk * 64 + d] = n; }
#undef ML_PTRS
    __syncthreads();
}
__device__ __forceinline__ void mscan_item(unsigned char* ws, int item, int wave_u) {
    const int tid = wave_u * 64 + fresh_lane();
    const int bh = item / 9, part = item % 9;
    if (part == 8 && tid >= 64) return;
    float* base; size_t stride;
    if (part < 8) { base = (float*)(ws + WS_CT) + (size_t)bh * 32 * 4096 + part * 512 + tid; stride = 4096; } else { base = (float*)(ws + WS_NL) + (size_t)bh * 32 * 64 + tid; stride = 64; }
    const float* ML = (const float*)(ws + WS_ML); const float* BL = (const float*)(ws + WS_BL); float* MPv = (float*)(ws + WS_MP);
    float cl[32];
#pragma unroll
    for (int c = 0; c < 32; ++c) cl[c] = base[(size_t)c * stride];
    float Cv = 0.f, m = 0.f;
#pragma unroll
    for (int c = 0; c < 32; ++c) {
        const float ml = ML[bh * 32 + c], bl = BL[bh * 32 + c];
        base[(size_t)c * stride] = Cv;
        if (part == 8 && tid == 0) MPv[bh * 32 + c] = m;
        const float mn = fmaxf(bl + m, ml);
        Cv = __expf(bl + m - mn) * Cv + __expf(ml - mn) * cl[c]; m = mn;
    }
}
constexpr int MO_STRIDE = 5 * 64 * ML_LD * 2 + 64 * 65 * 4 + 6 * 64 * 4;
__device__ __forceinline__ void mout_item(unsigned char* ws, LAS unsigned char* lds, const float* gmh, const float* skip, int chunk0, int wave_u) {
    const int lane = fresh_lane(), tid = wave_u * 64 + lane;
    const int h = (chunk0 >> 5) & 3, b = chunk0 >> 7;
    const float* gm = (const float*)(ws + WS_GM);
#define MO_PTRS(ch) const int chunk = chunk0 + (ch); const int row0 = b * S_ + (chunk & 31) * 64; LAS unsigned char* cb_ = lds + (ch) * MO_STRIDE; \
    LAS bf16* QS = (LAS bf16*)cb_; LAS bf16* KS = QS + 64 * ML_LD; LAS bf16* VT = KS + 64 * ML_LD; LAS bf16* CP = VT + 64 * ML_LD; LAS bf16* SW = CP + 64 * ML_LD; \
    LAS float* HS = (LAS float*)(SW + 64 * ML_LD); LAS float* bs = HS + 64 * 65; LAS float* us = bs + 64; LAS float* ns = us + 64; LAS float* mts = ns + 64; LAS float* ints = mts + 64; LAS float* dinv = ints + 64; \
    (void)row0; (void)QS; (void)KS; (void)VT; (void)CP; (void)SW; (void)HS; (void)bs; (void)us; (void)ns; (void)mts; (void)ints; (void)dinv; (void)chunk;
#pragma unroll
    for (int ch = 0; ch < 2; ++ch) { MO_PTRS(ch)
        const int l = tid >> 3, c0 = (tid & 7) * 8, row = row0 + l;
        *(LAS v4u*)(QS + l * ML_LD + c0) = *(const v4u*)((const bf16*)(ws + WS_MQ) + (size_t)row * 256 + h * 64 + c0);
        *(LAS v4u*)(KS + l * ML_LD + c0) = *(const v4u*)((const bf16*)(ws + WS_MK) + (size_t)row * 256 + h * 64 + c0);
        const v4u v4 = *(const v4u*)((const bf16*)(ws + WS_CM) + (size_t)row * 768 + 256 + h * 64 + c0);
        VT[(c0 + 0) * ML_LD + l] = (bf16)(v4.x & 0xffffu); VT[(c0 + 1) * ML_LD + l] = (bf16)(v4.x >> 16); VT[(c0 + 2) * ML_LD + l] = (bf16)(v4.y & 0xffffu); VT[(c0 + 3) * ML_LD + l] = (bf16)(v4.y >> 16);
        VT[(c0 + 4) * ML_LD + l] = (bf16)(v4.z & 0xffffu); VT[(c0 + 5) * ML_LD + l] = (bf16)(v4.z >> 16); VT[(c0 + 6) * ML_LD + l] = (bf16)(v4.w & 0xffffu); VT[(c0 + 7) * ML_LD + l] = (bf16)(v4.w >> 16);
        const float* ct = (const float*)(ws + WS_CT) + (size_t)chunk * 4096 + l * 64 + c0;
        const f32x4v c0v = *(const f32x4v*)ct, c1v = *(const f32x4v*)(ct + 4);
        v4u cw; cw.x = cvtpk(c0v[0], c0v[1]); cw.y = cvtpk(c0v[2], c0v[3]); cw.z = cvtpk(c1v[0], c1v[1]); cw.w = cvtpk(c1v[2], c1v[3]);
        *(LAS v4u*)(CP + l * ML_LD + c0) = cw;
    }
    if (wave_u < 2) { MO_PTRS(wave_u)
        const float ig = gm[(size_t)(row0 + lane) * 32 + 18 + h]; float lf = gm[(size_t)(row0 + lane) * 32 + 22 + h];
#pragma unroll
        for (int o = 1; o < 64; o <<= 1) { const float t = bperm(lf, lane - o); if (lane >= o) lf += t; }
        const float u = ig - lf; float cu = u;
#pragma unroll
        for (int o = 1; o < 64; o <<= 1) { const float t = bperm(cu, lane - o); if (lane >= o) cu = fmaxf(cu, t); }
        const float mprev = ((const float*)(ws + WS_MP))[chunk];
        const float mt = lf + fmaxf(mprev, cu);
        bs[lane] = lf; us[lane] = u; mts[lane] = mt; ints[lane] = __expf(lf + mprev - mt); ns[lane] = ((const float*)(ws + WS_NL))[chunk * 64 + lane];
    }
    __syncthreads();
#pragma unroll
    for (int ch = 0; ch < 2; ++ch) { MO_PTRS(ch)
#pragma unroll
        for (int i = 0; i < 2; ++i) { const int blk = wave_u * 2 + i, lb = blk >> 2, sb = blk & 3;
            f32x4v acc = f32x4v{};
            if (sb <= lb) acc = mm16(QS, ML_LD, 16 * lb, KS, ML_LD, 16 * sb, 64, lane, acc);
            const int sidx = 16 * sb + (lane & 15); const float usv = us[sidx];
#pragma unroll
            for (int r = 0; r < 4; ++r) { const int l = 16 * lb + 4 * (lane >> 4) + r;
                const float v = (sidx <= l) ? acc[r] * __expf(bs[l] + usv - mts[l]) : 0.f;
                SW[l * ML_LD + sidx] = f2bf(v); } }
    }
    __syncthreads();
    if (tid < 128) { MO_PTRS(tid >> 6)
        const int l = tid & 63; float qn = 0.f, ssum = 0.f;
        for (int d = 0; d < 64; ++d) { qn += bf2f(QS[l * ML_LD + d]) * ns[d]; ssum += bf2f(SW[l * ML_LD + d]); }
        const float den = ints[l] * qn + ssum;
        dinv[l] = 1.f / fmaxf(fabsf(den), __expf(-mts[l]));
    }
    f32x4v hq[2][2], hs2[2][2];
#pragma unroll
    for (int ch = 0; ch < 2; ++ch) { MO_PTRS(ch)
#pragma unroll
        for (int i = 0; i < 2; ++i) { const int blk = wave_u * 2 + i, lb = blk >> 2, eb = blk & 3;
            hq[ch][i] = mm16(QS, ML_LD, 16 * lb, CP, ML_LD, 16 * eb, 64, lane, f32x4v{});
            hs2[ch][i] = mm16(SW, ML_LD, 16 * lb, VT, ML_LD, 16 * eb, 16 * lb + 16 <= 32 ? 32 : 64, lane, f32x4v{}); }
    }
    __syncthreads();
#pragma unroll
    for (int ch = 0; ch < 2; ++ch) { MO_PTRS(ch)
#pragma unroll
        for (int i = 0; i < 2; ++i) { const int blk = wave_u * 2 + i, lb = blk >> 2, eb = blk & 3; const int e = 16 * eb + (lane & 15);
#pragma unroll
            for (int r = 0; r < 4; ++r) { const int l = 16 * lb + 4 * (lane >> 4) + r;
                const float og = bf2f(((const bf16*)(ws + WS_CM))[(size_t)(row0 + l) * 768 + 512 + h * 64 + e]);
                HS[l * 65 + e] = (ints[l] * hq[ch][i][r] + hs2[ch][i][r]) * dinv[l] / (1.f + __expf(-og)); } }
    }
    __syncthreads();
#pragma unroll
    for (int ch = 0; ch < 2; ++ch) { MO_PTRS(ch)
        const int l = tid >> 3, e0 = (tid & 7) * 8, row = row0 + l;
        float v[8]; float mu = 0.f;
#pragma unroll
        for (int i = 0; i < 8; ++i) { v[i] = HS[l * 65 + e0 + i]; mu += v[i]; }
        mu += sxf<1>(mu); mu += sxf<2>(mu); mu += sxf<4>(mu); mu *= (1.f / 64.f);
        float var = 0.f;
#pragma unroll
        for (int i = 0; i < 8; ++i) { const float dl = v[i] - mu; var += dl * dl; }
        var += sxf<1>(var); var += sxf<2>(var); var += sxf<4>(var);
        const float rs = rsqrtf(var * (1.f / 64.f) + EPS);
        const v4u x4 = *(const v4u*)((const bf16*)(ws + WS_XC) + (size_t)row * 256 + h * 64 + e0);
        float xv[8]; xv[0] = __uint_as_float(x4.x << 16); xv[1] = __uint_as_float(x4.x & 0xffff0000u); xv[2] = __uint_as_float(x4.y << 16); xv[3] = __uint_as_float(x4.y & 0xffff0000u);
        xv[4] = __uint_as_float(x4.z << 16); xv[5] = __uint_as_float(x4.z & 0xffff0000u); xv[6] = __uint_as_float(x4.w << 16); xv[7] = __uint_as_float(x4.w & 0xffff0000u);
        float r[8];
#pragma unroll
        for (int i = 0; i < 8; ++i) r[i] = (v[i] - mu) * rs * gmh[h * 64 + e0 + i] + skip[h * 64 + e0 + i] * xv[i];
        v4u w4; w4.x = cvtpk(r[0], r[1]); w4.y = cvtpk(r[2], r[3]); w4.z = cvtpk(r[4], r[5]); w4.w = cvtpk(r[6], r[7]);
        *(v4u*)((bf16*)(ws + WS_HB) + (size_t)row * D_ + 768 + h * 64 + e0) = w4;
    }
#undef MO_PTRS
    __syncthreads();
}

__global__ void __launch_bounds__(NTHR, 2) mega(MP p_unused) {
    extern __shared__ __attribute__((aligned(16))) unsigned char lds_raw[];
    LAS unsigned char* lds = (LAS unsigned char*)lds_raw;
    const int wave0 = __builtin_amdgcn_readfirstlane((int)threadIdx.x >> 6);
    const int tid0 = wave0 * 64 + fresh_lane();
    const int xcc = (int)(__builtin_amdgcn_s_getreg((3 << 11) | 20) & 7u);
    volatile LAS unsigned* MISC = (volatile LAS unsigned*)(lds + MISC_OFF);
    for (int u = tid0; u < (LDS_BYTES - RING_BYTES) / 4; u += NTHR) ((LAS unsigned*)(lds + RING_BYTES))[u] = 0u;
    __syncthreads();
    typedef const __attribute__((address_space(4))) MP* kmp_t;
    kmp_t kp0 = (kmp_t)__builtin_amdgcn_kernarg_segment_ptr();
    unsigned char* ws0 = kp0->ws; const int coop = kp0->coop, ph_lo = kp0->ph_lo, ph_hi = kp0->ph_hi;
    XcdBarrier bar; bar.bar = (unsigned*)(ws0 + WS_CTL) + CW_BAR; bar.x = 0; bar.st = nullptr;
    if (coop) bar = xcd_barrier_post((unsigned*)(ws0 + WS_CTL) + CW_BAR, MISC + 8, tid0);
    if (coop == 2) cooperative_groups::this_grid().sync();
    int ph = ph_lo;
    if (ph == 0) {
        const MPK p{kp0}; ph_p0(p, lds, wave0 * 64 + fresh_lane()); ph = 1;
        if (ph < ph_hi) xcd_barrier(bar, wave0 * 64 + fresh_lane());
    }
    bool second = false;
    for (; ph < ph_hi; ++ph) {
        kmp_t kp = kp0; asm volatile("" : "+s"(kp));
        const MPK p{kp}; unsigned char* ws = kp->ws;
#define TID_ (wave0 * 64 + fresh_lane())
#define GW_ (blockIdx.x * NWAVES + wave0)
#define NGW_ (gridDim.x * NWAVES)
        const int l = (ph - 1) / PPL, ty = (ph == 0) ? -1 : (ph == NPH - 1) ? -2 : (ph - 1) % PPL;
        const float* modl = (const float*)(ws + WS_MOD) + (size_t)l * 8 * 6144;
        if (ty == -2) { norm_rows(p.k->out, PIN(I_GFIN), nullptr, nullptr, nullptr, p.k->out, 2, GW_, NGW_, fresh_lane());
            if (PROBE_SEL != 0 && blockIdx.x == 0 && TID_ == 0) { asm volatile("s_waitcnt vmcnt(0)" ::: "memory"); p.k->out[0] = ((const float*)(ws + WS_CTL))[100] * 0.001f; } }
        else if (ty == 0 && (PHM & 2)) ph_prep(p, l, lds, TID_);
        else if (ty == 1 && (PHM & 4)) {
            pg8::Gemm g{(const bf16*)(ws + WS_HB), (const bf16*)(ws + WT_IN), T_, 2560, D_}; pg8::StaticOrder S; S.init(T_, 2560, gridDim.x, blockIdx.x);
            pg8::EpiIn E{ws, PIN(I_BIG) + l * 4, PIN(I_BFG) + l * 4};
            pg8::gemm_phase<pg8::EpiIn, pg8::StaticOrder, true, true>(lds, g, S, E, wave0);
            late_transposes(p, l, lds, TID_, 640 % (int)gridDim.x);
        }
        else if (ty == 2 && (PHM & 64)) {
            { pg8::Gemm g{(const bf16*)(ws + WS_KVL), (const bf16*)(ws + WT_UKV), T_, 768, 128}; pg8::StaticOrder S; S.init(T_, 768, gridDim.x, blockIdx.x);
              pg8::EpiUKV E{(bf16*)(ws + WS_KVM), (const float*)(ws + WS_SSKV)}; pg8::gemm_phase<pg8::EpiUKV, pg8::StaticOrder, true, true>(lds, g, S, E, wave0); }
            { pg8::Gemm g{(const bf16*)(ws + WS_QL), (const bf16*)(ws + WT_UQ), T_, 768, 256}; pg8::StaticOrder S; S.init(T_, 768, gridDim.x, blockIdx.x);
              pg8::EpiPlain E{(bf16*)(ws + WS_OSLC), 768}; pg8::gemm_phase<pg8::EpiPlain, pg8::StaticOrder, true, true>(lds, g, S, E, wave0); }
            post_misc(ws, PIN(I_BIG) + l * 4, PIN(I_BFG) + l * 4, TID_);
            unsigned* ctrs = (unsigned*)(ws + WS_CTL) + 8192 + ph * 256 + (second ? 128 : 0); int ks = 0;
            for (;;) { const int it = next_item_q(ctrs, lds, wave0, 96, xcc, ks); if (it < 0) break; const int b = it >> 16, j = it & 0xffff;
                if (j < 64) mlocal_item(ws, lds, PIN(I_CONVW) + l * 1024, PIN(I_CONVB) + l * 256, PIN(I_BIG) + l * 4, PIN(I_BFG) + l * 4, b * 128 + 2 * j, wave0);
                else { const int k = j - 64; compress_item(ws, lds, PIN(I_CMPPOS) + l * 2048, ((k >> 4) << 7) | (b << 4) | (k & 15), wave0); } }
        }
        else if (ty == 3 && (PHM & 128)) {
            unsigned* ctrs = (unsigned*)(ws + WS_CTL) + 8192 + ph * 256 + (second ? 128 : 0); int ks = 0;
            for (;;) { const int it = next_item_q(ctrs, lds, wave0, second ? 64 : 100, xcc, ks); if (it < 0) break; const int b = it >> 16, j = it & 0xffff;
                if (second && (REP_MASK & (1 << 20)) && j >= 48) continue; if (second && (REP_MASK & (1 << 21)) && j < 48) continue;
                if (j < 18) mla_unit(ws, lds, b, j % 6, 7 - j / 6, wave0);
                else if (j < 34) cmp_unit(ws, lds, b, (j - 18) >> 3, 7 - ((j - 18) & 7), wave0);
                else if (j < 64) { const int u = j - 16; mla_unit(ws, lds, b, u % 6, 7 - u / 6, wave0); }
                else mscan_item(ws, b * 36 + (j - 64), wave0); }
        }
        else if (ty == 4 && (PHM & 256)) {
            unsigned* ctrs = (unsigned*)(ws + WS_CTL) + 8192 + ph * 256 + (second ? 128 : 0); int ks = 0;
            for (;;) { const int it = next_item_q(ctrs, lds, wave0, 160, xcc, ks); if (it < 0) break; const int b = it >> 16, j = it & 0xffff;
                if (second && (REP_MASK & (1 << 16)) && j >= 96) continue; if (second && (REP_MASK & (1 << 17)) && j < 96) continue;
                if (j < 36) nsa_branch_unit<AM_SLC>(ws, lds, b, j % 6, 7 - j / 6, wave0);
                else if (j < 84) nsa_branch_unit<AM_WINDOW>(ws, lds, b, (j - 36) % 6, 7 - (j - 36) / 6, wave0);
                else if (j < 96) { const int u = j - 48; nsa_branch_unit<AM_SLC>(ws, lds, b, u % 6, 7 - u / 6, wave0); }
                else mout_item(ws, lds, PIN(I_GMH) + l * 256, PIN(I_SKIP) + l * 256, b * 128 + 2 * (j - 96), wave0); }
        }
        else if (ty == 5) ph_mixnorm(p, l, TID_);
        else if (ty == 6 && (PHM & 8)) {
            pg8::Gemm g{(const bf16*)(ws + WS_HB), (const bf16*)(ws + WT_OUT), T_, D_, D_}; pg8::StaticOrder S; S.init(T_, D_, gridDim.x, blockIdx.x);
            pg8::EpiRes E{(l == 0) ? PIN(I_X) : p.k->out, p.k->out, modl + 2048};
            pg8::gemm_phase<pg8::EpiRes, pg8::StaticOrder, true, true>(lds, g, S, E, wave0);
        }
        else if (ty == 7) norm_rows(p.k->out, PIN(I_GN2) + l * D_, modl + 3072, modl + 4096, (bf16*)(ws + WS_HB), nullptr, 1, GW_, NGW_, fresh_lane());
        else if (ty == 8 && (PHM & 16)) {
            pg8::Gemm g{(const bf16*)(ws + WS_HB), (const bf16*)(ws + WT_GU), T_, 2 * FF, D_}; pg8::StaticOrder S; S.init(T_, 2 * FF, gridDim.x, blockIdx.x);
            pg8::EpiGU E{(bf16*)(ws + WS_ACT)};
            pg8::gemm_phase<pg8::EpiGU, pg8::StaticOrder, true, true>(lds, g, S, E, wave0);
            if (l + 1 < DEPTH) early_transposes(p, l + 1, lds, TID_, 1408 % (int)gridDim.x);
        }
        else if (ty == 9 && (PHM & 32)) {
            pg8::Gemm g{(const bf16*)(ws + WS_ACT), (const bf16*)(ws + WT_DOWN), T_, D_, FF}; pg8::StaticOrder S; S.init(T_, D_, gridDim.x, blockIdx.x);
            pg8::EpiRes E{p.k->out, p.k->out, modl + 5120};
            pg8::gemm_phase<pg8::EpiRes, pg8::StaticOrder, true, true>(lds, g, S, E, wave0);
        }
        if (REP_MASK != 0 && ty >= 0 && ((REP_MASK >> ty) & 1) && !second) { second = true; --ph; } else second = false;
        if (ph + 1 < ph_hi) xcd_barrier(bar, wave0 * 64 + fresh_lane());
    }
}

extern "C" void kernel_launch(void* const* d_in, const int* in_sizes, int n_in, void* d_out, int out_size, void* d_ws, size_t ws_size, hipStream_t stream) {
    if (n_in != N_IN || ws_size < WS_END) { fprintf(stderr, "kernel_launch: unexpected n_in %d / ws %zu\n", n_in, ws_size); return; }
    static int inited = 0;
    if (!inited) { if (hipFuncSetAttribute((const void*)mega, hipFuncAttributeMaxDynamicSharedMemorySize, LDS_BYTES) != hipSuccess) fprintf(stderr, "hipFuncSetAttribute failed\n"); inited = 1; }
    unsigned char* ws = (unsigned char*)d_ws;
    MP base{}; for (int i = 0; i < N_IN; ++i) base.in[i] = (const float*)d_in[i]; base.out = (float*)d_out; base.ws = ws;
    (void)hipMemsetAsync(ws + WS_CTL, 0, CTL_ZERO_BYTES, stream);
    static int grid = 0;
    if (!grid) {
        int dev = 0, cus = 0, per_cu = 0;
        (void)hipGetDevice(&dev); (void)hipDeviceGetAttribute(&cus, hipDeviceAttributeMultiprocessorCount, dev);
        if (hipOccupancyMaxActiveBlocksPerMultiprocessor(&per_cu, (const void*)mega, NTHR, LDS_BYTES) != hipSuccess || per_cu < 1) { fprintf(stderr, "kernel_launch: occupancy query says %d blocks per CU\n", per_cu); per_cu = 1; }
        (void)hipGetLastError();
        grid = cus;
    }
    MP a = base; a.ph_lo = 0; a.ph_hi = NPH; a.coop = 1;
    void* args[] = {&a};
    const hipError_t e = hipLaunchCooperativeKernel((const void*)mega, dim3(grid), dim3(NTHR), args, LDS_BYTES, stream);
    if (e != hipSuccess) fprintf(stderr, "kernel_launch: cooperative launch failed: %s (grid %d)\n", hipGetErrorString(e), grid);
}
```

```cpp
#include <hip/hip_runtime.h>
#include <cstdint>
#include <cstdio>
#include <hip/hip_cooperative_groups.h>

constexpr int B_ = 8, S_ = 2048, T_ = B_ * S_, D_ = 1024, DIN = 2362, FF = 2816, DEPTH = 2;
constexpr float EPS = 1e-6f;
constexpr float LOG2E = 1.4426950408889634f;
constexpr float QSCALE = 0.125f * LOG2E;
constexpr float MSCALE = 0.10206207261596577f * LOG2E;
enum { I_X = 0, I_C, I_POS, I_GN1, I_GN2, I_WADA, I_BADA, I_WIN, I_CMPPOS, I_WCK, I_WCV, I_GOA, I_GQL, I_WUQ, I_GKVL, I_WUKV, I_GOB,
       I_CONVW, I_CONVB, I_WQM, I_WKM, I_BIG, I_BFG, I_GMH, I_SKIP, I_WOUT, I_WGU, I_WDOWN, I_GFIN, N_IN };

constexpr size_t MiB = 1u << 20;
constexpr size_t WS_CTL = 0;
constexpr size_t WS_MOD = 1 * MiB;
constexpr size_t WS_COSP = WS_MOD + 512 * 1024;
constexpr size_t WS_SINP = WS_COSP + 512 * 1024;
constexpr size_t WS_COSM = WS_SINP + 512 * 1024;
constexpr size_t WS_SINM = WS_COSM + 1 * MiB;
constexpr size_t WS_SSQL = WS_SINM + 1 * MiB;
constexpr size_t WS_SSKV = WS_SSQL + 64 * 1024;
constexpr size_t WS_ML = WS_SSKV + 64 * 1024;
constexpr size_t WS_BL = WS_ML + 4096;
constexpr size_t WS_MP = WS_BL + 4096;
constexpr size_t WS_NL = WS_MP + 4096;
constexpr size_t WS_WT = 8 * MiB;
constexpr size_t WS_RAW = WS_WT;
constexpr size_t WS_HB = 34 * MiB;
constexpr size_t WS_NSA = 66 * MiB;
constexpr size_t WS_KVL = 102 * MiB;
constexpr size_t WS_QL = 106 * MiB;
constexpr size_t WS_CM = 114 * MiB;
constexpr size_t WS_GM = 138 * MiB;
constexpr size_t WS_KM = 140 * MiB;
constexpr size_t WS_QM = 158 * MiB;
constexpr size_t WS_VM = 176 * MiB;
constexpr size_t WS_KCV = 188 * MiB;
constexpr size_t WS_OCMP = 189 * MiB;
constexpr size_t WS_SEL = 201 * MiB;
constexpr size_t WS_XC = 202 * MiB;
constexpr size_t WS_MQ = 210 * MiB;
constexpr size_t WS_MK = 218 * MiB;
constexpr size_t WS_CT = 226 * MiB;
constexpr size_t WS_MISCRAW = 242 * MiB;
constexpr size_t WS_KVM = 140 * MiB;
constexpr size_t WS_KR = 246 * MiB;
constexpr size_t WS_OSLC = 164 * MiB;
constexpr size_t WS_OWIN = 176 * MiB;
constexpr size_t WS_ACT = 66 * MiB;
constexpr size_t WS_END = 256 * MiB;
static_assert(WS_NL + 1024 * 64 * 4 <= WS_WT, "tab");
static_assert(WS_ACT + (size_t)T_ * FF * 2 <= WS_KCV, "act overlay");

typedef unsigned short bf16;
__device__ __forceinline__ float bf2f(bf16 v) { return __uint_as_float(((unsigned)v) << 16); }
__device__ __forceinline__ bf16 f2bf(float f) { unsigned u = __float_as_uint(f); return (bf16)((u + 0x7fffu + ((u >> 16) & 1u)) >> 16); }
__device__ __forceinline__ float sigmoidf_(float x) { return 1.f / (1.f + __expf(-x)); }
__device__ __forceinline__ float siluf_(float x) { return x / (1.f + __expf(-x)); }
__device__ __forceinline__ float wave_sum(float v) {
#pragma unroll
    for (int o = 1; o < 64; o <<= 1) v += __shfl_xor(v, o);
    return v;
}

__device__ __forceinline__ int fresh_lane() { int l; asm volatile("v_mbcnt_lo_u32_b32 %0, -1, 0\n\tv_mbcnt_hi_u32_b32 %0, -1, %0" : "=&v"(l)); return l; }
template <int M> __device__ __forceinline__ float sxf(float v) { static_assert(M >= 1 && M < 32, "swizzle xor mask"); return __int_as_float(__builtin_amdgcn_ds_swizzle(__float_as_int(v), (M << 10) | 0x1f)); }
__device__ __forceinline__ float red32_max(float v) { auto r = __builtin_amdgcn_permlane32_swap(__float_as_uint(v), __float_as_uint(v), false, false); return fmaxf(__uint_as_float(r[0]), __uint_as_float(r[1])); }
__device__ __forceinline__ float red32_sum(float v) { auto r = __builtin_amdgcn_permlane32_swap(__float_as_uint(v), __float_as_uint(v), false, false); return __uint_as_float(r[0]) + __uint_as_float(r[1]); }
__device__ __forceinline__ unsigned red32_or(unsigned v) { auto r = __builtin_amdgcn_permlane32_swap(v, v, false, false); return r[0] | r[1]; }
__device__ __forceinline__ float bperm(float v, int src_lane) { return __int_as_float(__builtin_amdgcn_ds_bpermute(src_lane << 2, __float_as_int(v))); }
__device__ __forceinline__ float wave_sum2(float v) { v += sxf<1>(v); v += sxf<2>(v); v += sxf<4>(v); v += sxf<8>(v); v += sxf<16>(v); return red32_sum(v); }
__device__ __forceinline__ float wave_max2(float v) { v = fmaxf(v, sxf<1>(v)); v = fmaxf(v, sxf<2>(v)); v = fmaxf(v, sxf<4>(v)); v = fmaxf(v, sxf<8>(v)); v = fmaxf(v, sxf<16>(v)); return red32_max(v); }
namespace pg8 {
#define PG8_LAS __attribute__((address_space(3)))
typedef unsigned short bf16_t;
typedef short bf16x8 __attribute__((ext_vector_type(8)));
typedef float f32x4 __attribute__((ext_vector_type(4)));
typedef unsigned u32x4 __attribute__((ext_vector_type(4)));
constexpr int BM = 256, BK = 64, HALF = 128, HTB = HALF * BK * 2  , STAGE_BYTES = 8 * HTB, NXCD = 8, WGM = 8;

__host__ __device__ __forceinline__ int lds_byte(int r, int c) { const int st = (r >> 4) * 2 + (c >> 5), rr = r & 15, cc = c & 31, ob = rr * 64 + cc * 2; return st * 1024 + (ob ^ (((ob >> 9) & 1) << 5)); }
__host__ __device__ __forceinline__ void stage_rc(int b, int& R, int& C) { const int st = b / 1024, sb = b % 1024, swz = sb ^ (((sb >> 9) & 1) << 5); R = (st >> 1) * 16 + swz / 64; C = (st & 1) * 32 + (swz % 64) / 2; }
__host__ __device__ __forceinline__ int perm32(int rho) { const int n = rho >> 4, i = rho & 15; return 8 * (i >> 2) + 4 * n + (i & 3); }

struct Unit { int pm, pn; };
struct Gemm { const bf16_t* A; const bf16_t* Bt; int M, N, K; };

struct StaticOrder {
    int nM, nN, nwg, G, c;
    __host__ __device__ void init(int M, int N, int G_, int c_) { nM = M / BM; nN = N / BM; nwg = nM * nN; G = G_; c = c_; }
    __host__ __device__ bool next(int i, Unit& u) const {
        const long L = (long)i * G + c; if (L >= nwg) return false;
        int wgid = (int)L; { const int q = nwg / NXCD, r = nwg % NXCD, xcd = wgid % NXCD, off = wgid / NXCD; wgid = (xcd < r ? xcd * (q + 1) : r * (q + 1) + (xcd - r) * q) + off; }
        const int nig = WGM * nN, gid = wgid / nig, fm = gid * WGM, gsz = (nM - fm) < WGM ? (nM - fm) : WGM;
        u.pm = fm + ((wgid % nig) % gsz); u.pn = (wgid % nig) / gsz; return true;
    }
    __device__ __forceinline__ void a_ready(const Unit&) const {}
    __device__ __forceinline__ void done(const Unit&) const {}
};

__device__ __forceinline__ unsigned cvt_pk_bf16(float lo, float hi) { unsigned r; asm volatile("v_cvt_pk_bf16_f32 %0, %1, %2" : "=v"(r) : "v"(lo), "v"(hi)); return r; }
typedef float f32x2 __attribute__((ext_vector_type(2)));

typedef unsigned u32x4 __attribute__((ext_vector_type(4)));
typedef unsigned u32x2 __attribute__((ext_vector_type(2)));
struct EpiIn {
    static constexpr bool PERM = true, AFTER_DRAIN = false;
    unsigned char* ws; const float *big, *bfg;
#define EPI_ROWS(...) _Pragma("unroll") for (int ai = 0; ai < 2; ++ai) _Pragma("unroll") for (int m = 0; m < 4; ++m) { \
        const int row = u.pm * BM + ai * HALF + wr * 64 + m * 16 + fr; float v[8]; \
        _Pragma("unroll") for (int i = 0; i < 4; ++i) { v[i] = acc[ai][bj][m][0][i]; v[4 + i] = acc[ai][bj][m][1][i]; } \
        asm volatile("" : "+v"(v[0]), "+v"(v[1]), "+v"(v[2]), "+v"(v[3]), "+v"(v[4]), "+v"(v[5]), "+v"(v[6]), "+v"(v[7])); \
        __VA_ARGS__ asm volatile("" ::: "memory"); }
#define EPI_PACK(w) u32x4 w; w.x = cvt_pk_bf16(v[0], v[1]); w.y = cvt_pk_bf16(v[2], v[3]); w.z = cvt_pk_bf16(v[4], v[5]); w.w = cvt_pk_bf16(v[6], v[7]);
    __device__ __forceinline__ void operator()(const f32x4 (&acc)[2][2][4][2], const Unit& u, int wr, int wc, int fr, int fq) const {
        half<0>(acc, u, wr, wc, fr, fq); half<1>(acc, u, wr, wc, fr, fq);
    }
    template <int bj> __device__ __forceinline__ void half(const f32x4 (&acc)[2][2][4][2], const Unit& u, int wr, int wc, int fr, int fq) const {
        {
            const int hb = 2 * u.pn + bj;
            int cb = 32 * wc + 8 * fq; asm volatile("" : "+v"(cb), "+v"(fr));
            if (hb <= 8) {
                bf16_t* nsa = (bf16_t*)(ws + WS_NSA) + hb * 128 + cb;
                const bool rope_hb = (hb <= 3) || hb == 5 || hb == 7;
                if (rope_hb) {
                    const float* cosP = (const float*)(ws + WS_COSP); const float* sinP = (const float*)(ws + WS_SINP);
                    const bool mine = ((wc & 1) == 0) && fq < 2; const float sg = (fq == 0) ? -1.f : 1.f; const float sc = (hb < 3) ? QSCALE : 1.f;
                    f32x4 tc0 = {0.f, 0.f, 0.f, 0.f}, tc1 = tc0, ts0 = tc0, ts1 = tc0;
                    if (mine) { const int r0 = u.pm * BM + wr * 64 + fr; tc0 = *(const f32x4*)(cosP + r0 * 8); tc1 = *(const f32x4*)(cosP + r0 * 8 + 4); ts0 = *(const f32x4*)(sinP + r0 * 8); ts1 = *(const f32x4*)(sinP + r0 * 8 + 4); }
                    EPI_ROWS({
                        float pv[8];
                        _Pragma("unroll") for (int i = 0; i < 8; ++i) pv[i] = sxf<16>(v[i]);
                        const f32x4 c0 = tc0, c1 = tc1, s0 = ts0, s1 = ts1;
                        if (mine && (ai * 4 + m) < 7) { const int nx = ai * 4 + m + 1; const int rn = u.pm * BM + (nx >> 2) * HALF + wr * 64 + (nx & 3) * 16 + fr;
                            tc0 = *(const f32x4*)(cosP + rn * 8); tc1 = *(const f32x4*)(cosP + rn * 8 + 4); ts0 = *(const f32x4*)(sinP + rn * 8); ts1 = *(const f32x4*)(sinP + rn * 8 + 4); }
                        if (mine) {
                            _Pragma("unroll") for (int i = 0; i < 4; ++i) { v[i] = v[i] * c0[i] + sg * pv[i] * s0[i]; v[4 + i] = v[4 + i] * c1[i] + sg * pv[4 + i] * s1[i]; }
                        }
                        _Pragma("unroll") for (int i = 0; i < 8; ++i) v[i] *= sc;
                        EPI_PACK(w) *(u32x4*)(nsa + (size_t)row * 1152) = w;
                    })
                } else {
                    EPI_ROWS({ EPI_PACK(w) *(u32x4*)(nsa + (size_t)row * 1152) = w; })
                }
            } else if (hb <= 11) {
                bf16_t* dst = (hb == 9) ? (bf16_t*)(ws + WS_KVL) + cb : (bf16_t*)(ws + WS_QL) + (hb - 10) * 128 + cb;
                const int ld = (hb == 9) ? 128 : 256;
                float* ssq = (hb == 9) ? (float*)(ws + WS_SSKV) : (float*)(ws + WS_SSQL);
                EPI_ROWS({ EPI_PACK(w) *(u32x4*)(dst + (size_t)row * ld) = w;
                    float sq = 0.f;
                    _Pragma("unroll") for (int i = 0; i < 8; ++i) sq += v[i] * v[i];
                    sq += sxf<16>(sq); sq = red32_sum(sq);
                    if (fq == 0) atomicAdd(ssq + row, sq); })
            } else if (hb <= 17) {
                bf16_t* cm = (bf16_t*)(ws + WS_CM) + (hb - 12) * 128 + cb;
                EPI_ROWS({ EPI_PACK(w) *(u32x4*)(cm + (size_t)row * 768) = w; })
            } else if (hb == 18) {
                float* mr = (float*)(ws + WS_MISCRAW) + cb;
                if (wc < 2) { EPI_ROWS({ *(f32x4*)(mr + (size_t)row * 64) = (f32x4){v[0], v[1], v[2], v[3]}; *(f32x4*)(mr + (size_t)row * 64 + 4) = (f32x4){v[4], v[5], v[6], v[7]}; }) }
            }
        }
    }
#undef EPI_ROWS
#undef EPI_PACK
};
struct EpiUKV {
    static constexpr bool PERM = true, AFTER_DRAIN = false;
    bf16_t* kvm; const float* sskv;
    __device__ __forceinline__ void operator()(const f32x4 (&acc)[2][2][4][2], const Unit& u, int wr, int wc, int fr, int fq) const {
        asm volatile("" : "+v"(fq), "+v"(fr));
        const int col0 = u.pn * BM + wc * 32 + 8 * fq;
        float rs8[8];
#pragma unroll
        for (int i = 0; i < 8; ++i) rs8[i] = sskv[u.pm * BM + (i >> 2) * HALF + wr * 64 + (i & 3) * 16 + fr];
#pragma unroll
        for (int i = 0; i < 8; ++i) rs8[i] = rsqrtf(rs8[i] * (1.f / 128.f) + EPS);
#pragma unroll
        for (int ai = 0; ai < 2; ++ai)
#pragma unroll
            for (int m = 0; m < 4; ++m) { const int row = u.pm * BM + ai * HALF + wr * 64 + m * 16 + fr; bf16_t* rowp = kvm + (size_t)row * 768 + col0;
                const float rs = rs8[ai * 4 + m];
#pragma unroll
                for (int bj = 0; bj < 2; ++bj) { const f32x4 a = acc[ai][bj][m][0] * rs, b = acc[ai][bj][m][1] * rs;
                    u32x4 w; w.x = cvt_pk_bf16(a[0], a[1]); w.y = cvt_pk_bf16(a[2], a[3]); w.z = cvt_pk_bf16(b[0], b[1]); w.w = cvt_pk_bf16(b[2], b[3]);
                    *(u32x4*)(rowp + bj * HALF) = w; } }
    }
};
struct EpiPlain {
    static constexpr bool PERM = true, AFTER_DRAIN = false;
    bf16_t* out; int ld;
    __device__ __forceinline__ void operator()(const f32x4 (&acc)[2][2][4][2], const Unit& u, int wr, int wc, int fr, int fq) const {
        asm volatile("" : "+v"(fq), "+v"(fr));
        const int col0 = u.pn * BM + wc * 32 + 8 * fq;
#pragma unroll
        for (int ai = 0; ai < 2; ++ai)
#pragma unroll
            for (int m = 0; m < 4; ++m) { bf16_t* rowp = out + (size_t)(u.pm * BM + ai * HALF + wr * 64 + m * 16 + fr) * ld + col0;
#pragma unroll
                for (int bj = 0; bj < 2; ++bj) { const f32x4 a = acc[ai][bj][m][0], b = acc[ai][bj][m][1];
                    u32x4 w; w.x = cvt_pk_bf16(a[0], a[1]); w.y = cvt_pk_bf16(a[2], a[3]); w.z = cvt_pk_bf16(b[0], b[1]); w.w = cvt_pk_bf16(b[2], b[3]);
                    *(u32x4*)(rowp + bj * HALF) = w; } }
    }
};
struct EpiRes {
    static constexpr bool PERM = false, AFTER_DRAIN = false;
    const float* xin; float* xout; const float* gate;
    __device__ __forceinline__ void operator()(const f32x4 (&acc)[2][2][4][2], const Unit& u, int wr, int wc, int fr, int fq) const {
        asm volatile("" : "+v"(fq), "+v"(fr));
        const int b = (u.pm * BM) / S_; const int col0 = u.pn * BM + wc * 32 + 4 * fq;
        f32x4 gv[2][2];
#pragma unroll
        for (int bj = 0; bj < 2; ++bj)
#pragma unroll
            for (int n = 0; n < 2; ++n) gv[bj][n] = *(const f32x4*)(gate + (size_t)b * 6144 + col0 + bj * HALF + n * 16);
#pragma unroll
        for (int ai = 0; ai < 2; ++ai)
#pragma unroll
            for (int m = 0; m < 4; ++m) { const size_t off = (size_t)(u.pm * BM + ai * HALF + wr * 64 + m * 16 + fr) * D_ + col0;
#pragma unroll
                for (int bj = 0; bj < 2; ++bj)
#pragma unroll
                    for (int n = 0; n < 2; ++n) { const f32x4 xi = *(const f32x4*)(xin + off + bj * HALF + n * 16); *(f32x4*)(xout + off + bj * HALF + n * 16) = xi + gv[bj][n] * acc[ai][bj][m][n]; } }
    }
};
struct EpiGU {
    static constexpr bool PERM = true, AFTER_DRAIN = false;
    bf16_t* act;
    __device__ __forceinline__ void operator()(const f32x4 (&acc)[2][2][4][2], const Unit& u, int wr, int wc, int fr, int fq) const {
        asm volatile("" : "+v"(fq), "+v"(fr));
        const int col0 = u.pn * HALF + wc * 32 + 8 * fq;
#pragma unroll
        for (int ai = 0; ai < 2; ++ai)
#pragma unroll
            for (int m = 0; m < 4; ++m) { const int row = u.pm * BM + ai * HALF + wr * 64 + m * 16 + fr; float o[8];
#pragma unroll
                for (int n = 0; n < 2; ++n)
#pragma unroll
                    for (int i = 0; i < 4; ++i) { const float g = acc[ai][0][m][n][i], up = acc[ai][1][m][n][i]; o[4 * n + i] = g / (1.f + __expf(-g)) * up; }
                u32x4 w; w.x = cvt_pk_bf16(o[0], o[1]); w.y = cvt_pk_bf16(o[2], o[3]); w.z = cvt_pk_bf16(o[4], o[5]); w.w = cvt_pk_bf16(o[6], o[7]);
                *(u32x4*)(act + (size_t)row * FF + col0) = w; }
    }
};
template <class Epi, class Sched, bool ALIGN_EPI = false, bool SP2 = false>
__device__ __forceinline__ void gemm_phase(PG8_LAS unsigned char* lds, const Gemm g, const Sched& S, const Epi& E, int wid_in) {
    const int wid = __builtin_amdgcn_readfirstlane(wid_in), lane = fresh_lane(), tid = wid * 64 + lane, wr = wid >> 2, wc = wid & 3;
    const int K = g.K, nt = K / BK;
    unsigned voffA[2], voffB[2];
#pragma unroll
    for (int i = 0; i < 2; ++i) { int R, C; stage_rc(tid * 16 + i * 8192, R, C); const int Rb = Epi::PERM ? ((R & ~31) + perm32(R & 31)) : R;
        voffA[i] = (unsigned)(R * K + C) * 2u; voffB[i] = (unsigned)(Rb * K + C) * 2u; }
    const size_t kstep = (size_t)(BK * 2);
    const size_t hstep = (size_t)HALF * K * 2;
    const size_t tstep = 2 * hstep;
    const unsigned ldsw = (unsigned)wid * 1024u;
    const int aoff = lds_byte(wr * 64 + (lane & 15), (lane >> 4) * 8), boff = lds_byte(wc * 32 + (lane & 15), (lane >> 4) * 8);
#define PG8_SA(b, h) (((b) * 2 + (h)) * HTB)
#define PG8_SB(b, h) ((4 + (b) * 2 + (h)) * HTB)
#define PG8_STAGE(bufoff, gbase, voff) do { _Pragma("unroll") for (int _i = 0; _i < 2; ++_i) \
        __builtin_amdgcn_global_load_lds((const unsigned*)((const char*)(gbase) + (voff)[_i]), (PG8_LAS unsigned*)(lds + (bufoff) + ldsw + _i * 8192), 16, 0, 0); } while (0)
#define PG8_LDA(dst, b, h) do { _Pragma("unroll") for (int m = 0; m < 4; ++m) _Pragma("unroll") for (int k = 0; k < 2; ++k) dst[m][k] = *(const PG8_LAS bf16x8*)(lds + PG8_SA(b, h) + aoff + m * 2048 + k * 1024); } while (0)
#define PG8_LDB(dst, b, h) do { _Pragma("unroll") for (int n = 0; n < 2; ++n) _Pragma("unroll") for (int k = 0; k < 2; ++k) dst[n][k] = *(const PG8_LAS bf16x8*)(lds + PG8_SB(b, h) + boff + n * 2048 + k * 1024); } while (0)
#define PG8_MMA(ai, bj, At, Bt) do { __builtin_amdgcn_s_setprio(1); _Pragma("unroll") for (int m = 0; m < 4; ++m) _Pragma("unroll") for (int n = 0; n < 2; ++n) _Pragma("unroll") for (int k = 0; k < 2; ++k) \
        acc[ai][bj][m][n] = __builtin_amdgcn_mfma_f32_16x16x32_bf16(Bt[n][k], At[m][k], acc[ai][bj][m][n], 0, 0, 0); __builtin_amdgcn_s_setprio(0); } while (0)
#define PG8_WAIT_V(n) asm volatile("s_waitcnt vmcnt(" #n ")" ::: "memory")
#define PG8_WAIT_L(n) asm volatile("s_waitcnt lgkmcnt(" #n ")" ::: "memory")
#define PG8_BAR __builtin_amdgcn_s_barrier()
#define PG8_SCHED __builtin_amdgcn_sched_barrier(0)
    Unit cur, nxt; int ui = 0;
    if (!S.next(0, cur)) return;
    f32x4 acc[2][2][4][2];
#pragma unroll
    for (int a = 0; a < 2; ++a)
#pragma unroll
        for (int b = 0; b < 2; ++b)
#pragma unroll
            for (int m = 0; m < 4; ++m)
#pragma unroll
                for (int n = 0; n < 2; ++n) acc[a][b][m][n] = (f32x4){0.f, 0.f, 0.f, 0.f};
    bf16x8 At[4][2], B0[2][2], B1[2][2];
    const char* cA = (const char*)g.A + (size_t)cur.pm * tstep; const char* cB = (const char*)g.Bt + (size_t)cur.pn * tstep;
    S.a_ready(cur);
    if constexpr (SP2) {
        PG8_STAGE(PG8_SB(0, 0), cB, voffB); PG8_STAGE(PG8_SB(0, 1), cB + hstep, voffB); PG8_STAGE(PG8_SA(0, 0), cA, voffA); PG8_STAGE(PG8_SA(0, 1), cA + hstep, voffA);
        if (wr == 1) PG8_BAR;
        PG8_WAIT_V(2); PG8_BAR;
        PG8_STAGE(PG8_SB(1, 0), cB + kstep, voffB); PG8_STAGE(PG8_SA(1, 0), cA + kstep, voffA); PG8_STAGE(PG8_SB(1, 1), cB + hstep + kstep, voffB);
        PG8_WAIT_V(6); PG8_BAR;
    } else {
        PG8_STAGE(PG8_SB(0, 0), cB, voffB); PG8_STAGE(PG8_SA(0, 0), cA, voffA); PG8_STAGE(PG8_SB(0, 1), cB + hstep, voffB); PG8_STAGE(PG8_SA(0, 1), cA + hstep, voffA);
        if (wr == 1) PG8_BAR;
        PG8_WAIT_V(4); PG8_BAR;
        PG8_STAGE(PG8_SB(1, 0), cB + kstep, voffB); PG8_STAGE(PG8_SA(1, 0), cA + kstep, voffA); PG8_STAGE(PG8_SB(1, 1), cB + hstep + kstep, voffB);
        PG8_WAIT_V(6); PG8_BAR;
    }
    for (;;) {
        const bool has_next = S.next(ui + 1, nxt);
        const char* nA = has_next ? (const char*)g.A + (size_t)nxt.pm * tstep : cA; const char* nB = has_next ? (const char*)g.Bt + (size_t)nxt.pn * tstep : cB;
        for (int t = 0; t < nt; t += 2) {
            const bool last = (t == nt - 2);
            const char* a1 = cA + (size_t)(t + 1) * kstep;
            const char* a2 = last ? nA : cA + (size_t)(t + 2) * kstep; const char* b2 = last ? nB : cB + (size_t)(t + 2) * kstep;
            const char* a3 = a2 + kstep; const char* b3 = b2 + kstep;
            if (last && has_next) S.a_ready(nxt);
            if constexpr (SP2) {
            PG8_LDB(B0, 0, 0); PG8_LDB(B1, 0, 1); PG8_SCHED; PG8_LDA(At, 0, 0); PG8_STAGE(PG8_SA(1, 1), a1 + hstep, voffA);
            PG8_WAIT_V(8); PG8_WAIT_L(0); PG8_BAR; PG8_MMA(0, 0, At, B0); PG8_MMA(0, 1, At, B1); PG8_BAR; PG8_SCHED;
            PG8_LDA(At, 0, 1); PG8_STAGE(PG8_SB(0, 0), b2, voffB); PG8_STAGE(PG8_SB(0, 1), b2 + hstep, voffB); PG8_STAGE(PG8_SA(0, 0), a2, voffA);
            PG8_WAIT_V(8); PG8_WAIT_L(0); PG8_BAR; PG8_MMA(1, 0, At, B0); PG8_MMA(1, 1, At, B1); PG8_BAR; PG8_SCHED;
            PG8_LDB(B0, 1, 0); PG8_LDB(B1, 1, 1); PG8_SCHED; PG8_LDA(At, 1, 0); PG8_STAGE(PG8_SA(0, 1), a2 + hstep, voffA);
            PG8_WAIT_V(8); PG8_WAIT_L(0); PG8_BAR; PG8_MMA(0, 0, At, B0); PG8_MMA(0, 1, At, B1); PG8_BAR; PG8_SCHED;
            PG8_LDA(At, 1, 1); PG8_STAGE(PG8_SB(1, 0), b3, voffB); PG8_STAGE(PG8_SB(1, 1), b3 + hstep, voffB); PG8_STAGE(PG8_SA(1, 0), a3, voffA);
            PG8_WAIT_V(8); PG8_WAIT_L(0); PG8_BAR; PG8_MMA(1, 0, At, B0); PG8_MMA(1, 1, At, B1); PG8_BAR; PG8_SCHED;
            } else {
            PG8_LDB(B0, 0, 0); PG8_SCHED; PG8_LDA(At, 0, 0); PG8_STAGE(PG8_SA(1, 1), a1 + hstep, voffA);
            PG8_WAIT_L(8); PG8_BAR; PG8_WAIT_L(0); PG8_MMA(0, 0, At, B0); PG8_BAR; PG8_SCHED;
            PG8_LDB(B1, 0, 1); PG8_STAGE(PG8_SB(0, 0), b2, voffB);
            PG8_BAR; PG8_WAIT_L(0); PG8_MMA(0, 1, At, B1); PG8_BAR;
            PG8_LDA(At, 0, 1); PG8_STAGE(PG8_SA(0, 0), a2, voffA);
            PG8_BAR; PG8_WAIT_L(0); PG8_MMA(1, 0, At, B0); PG8_BAR; PG8_SCHED;
            PG8_STAGE(PG8_SB(0, 1), b2 + hstep, voffB);
            PG8_WAIT_V(6); PG8_BAR; PG8_MMA(1, 1, At, B1); PG8_BAR;
            PG8_LDB(B0, 1, 0); PG8_SCHED; PG8_LDA(At, 1, 0); PG8_STAGE(PG8_SA(0, 1), a2 + hstep, voffA);
            PG8_WAIT_L(8); PG8_BAR; PG8_WAIT_L(0); PG8_MMA(0, 0, At, B0); PG8_BAR; PG8_SCHED;
            PG8_LDB(B1, 1, 1); PG8_STAGE(PG8_SB(1, 0), b3, voffB);
            PG8_BAR; PG8_WAIT_L(0); PG8_MMA(0, 1, At, B1); PG8_BAR;
            PG8_LDA(At, 1, 1); PG8_STAGE(PG8_SA(1, 0), a3, voffA);
            PG8_BAR; PG8_WAIT_L(0); PG8_MMA(1, 0, At, B0); PG8_BAR; PG8_SCHED;
            PG8_STAGE(PG8_SB(1, 1), b3 + hstep, voffB);
            PG8_WAIT_V(6); PG8_BAR; PG8_MMA(1, 1, At, B1); PG8_BAR;
            }
        }
        if constexpr (ALIGN_EPI) { if (wr == 0) PG8_BAR; }
        if constexpr (!Epi::AFTER_DRAIN) { const int ln = fresh_lane(); E(acc, cur, wr, wc, ln & 15, ln >> 4); S.done(cur); }
        if (!has_next) break;
#pragma unroll
        for (int a = 0; a < 2; ++a)
#pragma unroll
            for (int b = 0; b < 2; ++b)
#pragma unroll
                for (int m = 0; m < 4; ++m)
#pragma unroll
                    for (int n = 0; n < 2; ++n) acc[a][b][m][n] = (f32x4){0.f, 0.f, 0.f, 0.f};
        cur = nxt; cA = nA; cB = nB; ++ui;
        if constexpr (ALIGN_EPI) { if (wr == 1) PG8_BAR; }
    }
    PG8_WAIT_V(0);
    if constexpr (!ALIGN_EPI) { if (wr == 0) PG8_BAR; }
    PG8_BAR;
    if constexpr (Epi::AFTER_DRAIN) { const int ln = fresh_lane(); E.fused(acc, cur, wr, wc, ln & 15, ln >> 4, lds, wid, ln); S.done(cur); }
#undef PG8_SA
#undef PG8_SB
#undef PG8_STAGE
#undef PG8_LDA
#undef PG8_LDB
#undef PG8_MMA
#undef PG8_WAIT_V
#undef PG8_WAIT_L
#undef PG8_BAR
#undef PG8_SCHED
}
}

#define GAS __attribute__((address_space(1)))
#define LAS __attribute__((address_space(3)))
typedef float f32x4 __attribute__((ext_vector_type(4)));
typedef unsigned v4u __attribute__((ext_vector_type(4)));
typedef GAS unsigned gu32;
#define XB_TMO      128
#define XB_XCNT(j)  (256  + 64 * (j))
#define XB_XSUB(j)  (1280 + 64 * (j))
#define XB_XGEN(j)  (2304 + 64 * (j))
#define XB_TOP      3328
#define XB_TOPGEN   3392
#define XCD_BAR_WORDS 3456
#define XB_SPIN_CAP (1u << 18)

__device__ __forceinline__ unsigned xb_ld(unsigned* p)              { return __hip_atomic_load(p, __ATOMIC_RELAXED, __HIP_MEMORY_SCOPE_AGENT); }
__device__ __forceinline__ unsigned xb_add(unsigned* p, unsigned v) { return __hip_atomic_fetch_add(p, v, __ATOMIC_RELAXED, __HIP_MEMORY_SCOPE_AGENT); }
__device__ __forceinline__ unsigned xb_xcc_id() { return (unsigned)__builtin_amdgcn_s_getreg((3 << 11) | 20) & 0xFu; }
#define XB_SPIN(cond, bar) do { unsigned _sp = 0; while (cond) { __builtin_amdgcn_s_sleep(1); \
    if ((++_sp & 255u) == 0u) { if (xb_ld(&(bar)[XB_TMO])) break; if (_sp > XB_SPIN_CAP) { atomicAdd(&(bar)[XB_TMO], 1u); break; } } } } while (0)

struct XcdBarrier {
    unsigned* bar; unsigned x;
    volatile LAS unsigned* st;
};

__device__ __forceinline__ XcdBarrier xcd_barrier_post(unsigned* bar, volatile LAS unsigned* st, int tid) {
    XcdBarrier b; b.bar = bar; b.x = xb_xcc_id(); b.st = st;
    if (tid == 0) (void)xb_add(&bar[XB_XCNT(b.x)], 1u);
    return b;
}
__device__ __forceinline__ void xcd_barrier_complete(unsigned* bar, unsigned x, unsigned& nloc, unsigned& nx) {
    const unsigned G = gridDim.x * gridDim.y * gridDim.z;
    unsigned sum, cnt, mine, sp = 0u;
    for (;;) {
        sum = 0u; cnt = 0u; mine = 0u;
#pragma unroll
        for (unsigned j = 0; j < 16; ++j) { const unsigned c = xb_ld(&bar[XB_XCNT(j)]); sum += c; cnt += (c > 0u) ? 1u : 0u; mine = (j == x) ? c : mine; }
        if (sum == G) break;
        __builtin_amdgcn_s_sleep(1);
        if ((++sp & 255u) == 0u) { if (xb_ld(&bar[XB_TMO])) break; if (sp > XB_SPIN_CAP) { atomicAdd(&bar[XB_TMO], 1u); break; } }
    }
    nloc = mine > 0u ? mine : 1u; nx = cnt > 0u ? cnt : 1u;
}

__device__ __forceinline__ void xcd_barrier(const XcdBarrier& b, int tid) {
    asm volatile("s_waitcnt vmcnt(0)" ::: "memory");
    __syncthreads();
    if (tid == 0) {
        unsigned* bar = b.bar;
        __builtin_amdgcn_s_waitcnt(0);
        unsigned nloc = b.st[0], nx = b.st[1];
        if (nloc == 0u) { xcd_barrier_complete(bar, b.x, nloc, nx); b.st[0] = nloc; b.st[1] = nx; }
        const unsigned old = xb_add(&bar[XB_XSUB(b.x)], 1u);
        const unsigned gen = old / nloc;
        if (old + 1u == (gen + 1u) * nloc) {
            __builtin_amdgcn_fence(__ATOMIC_RELEASE, "agent");
            asm volatile("s_waitcnt vmcnt(0)" ::: "memory");
            const unsigned og = xb_add(&bar[XB_TOP], 1u);
            const unsigned tg = og / nx;
            if (og + 1u == (tg + 1u) * nx) xb_add(&bar[XB_TOPGEN], 1u);
            else XB_SPIN(xb_ld(&bar[XB_TOPGEN]) == tg, bar);
            __builtin_amdgcn_fence(__ATOMIC_ACQUIRE, "agent");
            xb_add(&bar[XB_XGEN(b.x)], 1u);
            asm volatile("s_waitcnt vmcnt(0)" ::: "memory");
        } else {
            XB_SPIN(xb_ld(&bar[XB_XGEN(b.x)]) == gen, bar);
            __builtin_amdgcn_fence(__ATOMIC_ACQUIRE, "agent");
            asm volatile("s_waitcnt vmcnt(0)" ::: "memory");
        }
    }
    __syncthreads();
}

constexpr int NTHR = 512, NWAVES = 8;
constexpr int RING_BYTES = 131072, MISC_OFF = RING_BYTES + 320, LDS_BYTES = 147456;
constexpr int CW_BAR = 4096;
constexpr size_t CTL_ZERO_BYTES = 64 * 1024;
constexpr size_t WT_IN = WS_WT, WT_OUT = WT_IN + (size_t)2560 * 1024 * 2, WT_GU = WT_OUT + (size_t)1024 * 1024 * 2, WT_DOWN = WT_GU + (size_t)5632 * 1024 * 2,
                 WT_UQ = WT_DOWN + (size_t)1024 * 2816 * 2, WT_UKV = WT_UQ + (size_t)768 * 256 * 2, WT_CK = WT_UKV + (size_t)768 * 128 * 2, WT_CV = WT_CK + (size_t)64 * 2048 * 2,
                 WT_QM = WT_CV + (size_t)64 * 2048 * 2, WT_KM = WT_QM + 4 * 64 * 64 * 2, WT_END = WT_KM + 4 * 64 * 64 * 2;
static_assert(WT_END <= WS_HB, "weights");
constexpr int NPH = 22, PPL = 10;
constexpr int PROBE_SEL = 0;
constexpr int REP_MASK = 0;
#ifndef PHM
#define PHM 0xffff
#endif
struct MP { const float* in[N_IN]; float* out; unsigned char* ws; int ph_lo, ph_hi, coop, pad; };

struct MPK {
    const __attribute__((address_space(4))) MP* k;
    struct InArr { const __attribute__((address_space(4))) MP* k; __device__ __forceinline__ const float* operator[](int i) const { return k->in[i]; } };
    __device__ __forceinline__ InArr in_() const { return InArr{k}; }
};
#define PIN(i) (p.k->in[i])
__device__ __forceinline__ unsigned pk2(float lo, float hi) { return (unsigned)f2bf(lo) | ((unsigned)f2bf(hi) << 16); }
struct MapId { int n; __device__ __forceinline__ int operator()(int c) const { return c < n ? c : -1; } };
struct MapIn { __device__ __forceinline__ int operator()(int c) const {
    if (c < 1152) return c; if (c < 1280) return 1426 + (c - 1152); if (c < 1536) return 1170 + (c - 1280); if (c < 2304) return 1586 + (c - 1536);
    if (c < 2336) return 1554 + (c - 2304); if (c < 2354) return 1152 + (c - 2336); if (c < 2362) return c; return -1; } };
struct MapGU { __device__ __forceinline__ int operator()(int c) const { const int t = c >> 8, w = c & 255; return (w < 128) ? t * 128 + w : FF + t * 128 + (w - 128); } };
template <class Map> __device__ __forceinline__ void transpose_item(const float* W, int K, int ldw, const Map& map, const float* kscale, bf16* WT, LAS float* scr, int item, int nblk, int lane) {
    const int kb = item / nblk, nb = item % nblk, k0 = 64 * kb, n0 = 32 * nb;
    const int np = 2 * (lane & 15);
    const int sc = map(n0 + np);
#pragma unroll 8
    for (int i = 0; i < 16; ++i) { const int kk = 4 * i + (lane >> 4); float2 v = (sc >= 0) ? *(const float2*)(W + (size_t)(k0 + kk) * ldw + sc) : make_float2(0.f, 0.f);
        if (kscale) { const float ksc = kscale[k0 + kk]; v.x *= ksc; v.y *= ksc; } scr[kk * 33 + np] = v.x; scr[kk * 33 + np + 1] = v.y; }
    asm volatile("s_waitcnt lgkmcnt(0)" ::: "memory");
    const int c = lane & 7;
#pragma unroll
    for (int j = 0; j < 4; ++j) { const int n = (lane >> 3) + 8 * j; const LAS float* s = scr + (8 * c) * 33 + n;
        v4u o; o.x = pk2(s[0 * 33], s[1 * 33]); o.y = pk2(s[2 * 33], s[3 * 33]); o.z = pk2(s[4 * 33], s[5 * 33]); o.w = pk2(s[6 * 33], s[7 * 33]);
        *(v4u*)(WT + (size_t)(n0 + n) * K + k0 + 8 * c) = o; }
    asm volatile("s_waitcnt lgkmcnt(0)" ::: "memory");
}
__device__ __forceinline__ void norm_rows(const float* x, const float* g, const float* shift, const float* scale, bf16* hb, float* outf, int mode, int gw, int ngw, int lane) {
    const int rpw = T_ / ngw, m0 = gw * rpw, b = m0 / S_;
    float4 gs[4], sh[4];
#pragma unroll
    for (int j = 0; j < 4; ++j) { const int col = 4 * lane + 256 * j; gs[j] = *(const float4*)(g + col);
        if (mode != 2) { const float4 sc = *(const float4*)(scale + (size_t)b * 6144 + col); sh[j] = *(const float4*)(shift + (size_t)b * 6144 + col);
            gs[j].x *= 1.f + sc.x; gs[j].y *= 1.f + sc.y; gs[j].z *= 1.f + sc.z; gs[j].w *= 1.f + sc.w; }
        else sh[j] = make_float4(0.f, 0.f, 0.f, 0.f); }
    float4 nv[4], nw[4];
    { const float4* xr = (const float4*)(x + (size_t)m0 * D_) + lane;
#pragma unroll
      for (int j = 0; j < 4; ++j) { nv[j] = xr[64 * j]; nw[j] = xr[D_ / 4 + 64 * j]; } }
    for (int r = 0; r < rpw; r += 2) {
        const int m = m0 + r;
        float4 v[4], w[4]; float s = 0.f, s2 = 0.f;
#pragma unroll
        for (int j = 0; j < 4; ++j) { v[j] = nv[j]; w[j] = nw[j]; }
        if (r + 2 < rpw) { const float4* xr = (const float4*)(x + (size_t)(m + 2) * D_) + lane;
#pragma unroll
            for (int j = 0; j < 4; ++j) { nv[j] = xr[64 * j]; nw[j] = xr[D_ / 4 + 64 * j]; } }
#pragma unroll
        for (int j = 0; j < 4; ++j) { s += v[j].x * v[j].x + v[j].y * v[j].y + v[j].z * v[j].z + v[j].w * v[j].w; s2 += w[j].x * w[j].x + w[j].y * w[j].y + w[j].z * w[j].z + w[j].w * w[j].w; }
        const float r1 = rsqrtf(wave_sum2(s) * (1.f / D_) + EPS), r2 = rsqrtf(wave_sum2(s2) * (1.f / D_) + EPS);
#pragma unroll
        for (int j = 0; j < 4; ++j) {
            const int col = 4 * lane + 256 * j;
            float4 o, o2;
            o.x = v[j].x * r1 * gs[j].x + sh[j].x; o.y = v[j].y * r1 * gs[j].y + sh[j].y; o.z = v[j].z * r1 * gs[j].z + sh[j].z; o.w = v[j].w * r1 * gs[j].w + sh[j].w;
            o2.x = w[j].x * r2 * gs[j].x + sh[j].x; o2.y = w[j].y * r2 * gs[j].y + sh[j].y; o2.z = w[j].z * r2 * gs[j].z + sh[j].z; o2.w = w[j].w * r2 * gs[j].w + sh[j].w;
            if (mode == 2) { *(float4*)(outf + (size_t)m * D_ + col) = o; *(float4*)(outf + (size_t)(m + 1) * D_ + col) = o2; }
            else { uint2 q; q.x = pk2(o.x, o.y); q.y = pk2(o.z, o.w); *(uint2*)(hb + (size_t)m * D_ + col) = q;
                   uint2 q2; q2.x = pk2(o2.x, o2.y); q2.y = pk2(o2.z, o2.w); *(uint2*)(hb + (size_t)(m + 1) * D_ + col) = q2; }
        }
    }
}
__device__ __forceinline__ void ph_p0(const MPK& p, LAS unsigned char* lds, int tid) {
    const int wave = tid >> 6, lane = tid & 63;
    LAS float* ca = (LAS float*)lds; LAS float* red = ca + 8192;
    unsigned char* ws = p.k->ws; float* mod = (float*)(ws + WS_MOD);
    const float* c = PIN(I_C);
    for (int i = tid; i < 8192; i += NTHR) ca[i] = siluf_(c[i]);
    __syncthreads();
    for (int item = blockIdx.x; item < 96; item += gridDim.x) {
        const int l = item / 48, j = (item % 48) * 128 + 2 * lane;
        const float* w = PIN(I_WADA) + (size_t)l * 1024 * 6144 + j;
        float acc[8][2];
#pragma unroll
        for (int b = 0; b < 8; ++b) { acc[b][0] = 0.f; acc[b][1] = 0.f; }
#pragma unroll 8
        for (int k = wave * 128; k < wave * 128 + 128; ++k) {
            const float2 wv = *(const float2*)(w + (size_t)k * 6144);
#pragma unroll
            for (int b = 0; b < 8; ++b) { const float cv = ca[b * 1024 + k]; acc[b][0] += cv * wv.x; acc[b][1] += cv * wv.y; }
        }
#pragma unroll
        for (int b = 0; b < 8; ++b) { red[(wave * 8 + b) * 128 + 2 * lane] = acc[b][0]; red[(wave * 8 + b) * 128 + 2 * lane + 1] = acc[b][1]; }
        __syncthreads();
        { const int b = wave;
#pragma unroll
          for (int c2 = 0; c2 < 2; ++c2) { float s2 = 0.f;
#pragma unroll
            for (int w8 = 0; w8 < 8; ++w8) s2 += red[(w8 * 8 + b) * 128 + c2 * 64 + lane];
            mod[((size_t)l * 8 + b) * 6144 + (item % 48) * 128 + c2 * 64 + lane] = s2 + PIN(I_BADA)[l * 6144 + (item % 48) * 128 + c2 * 64 + lane]; } }
        __syncthreads();
    }
    const int* pos = (const int*)PIN(I_POS);
    float *cosP = (float*)(ws + WS_COSP), *sinP = (float*)(ws + WS_SINP), *cosM = (float*)(ws + WS_COSM), *sinM = (float*)(ws + WS_SINM);
    for (int i = blockIdx.x * NTHR + tid; i < T_ * 24; i += gridDim.x * NTHR) {
        const int m = i / 24, f = i % 24;
        double inv; if (f < 8) inv = pow(500000.0, -(double)(2 * f) / 16.0); else inv = pow(500000.0, -(double)(2 * (f - 8)) / 32.0);
        const float ang = (float)pos[m] * (float)inv;
        const double a = (double)ang, kq = rint(a * 0.15915494309189535), r = a - kq * 6.283185307179586476925;
        const float cs = (float)cos(r), sn = (float)sin(r);
        if (f < 8) { cosP[m * 8 + f] = cs; sinP[m * 8 + f] = sn; } else { cosM[m * 16 + f - 8] = cs; sinM[m * 16 + f - 8] = sn; }
    }
}
__device__ __forceinline__ void early_transposes(const MPK& p, int l, LAS unsigned char* lds, int tid, int first) {
    const int wave = tid >> 6, lane = tid & 63;
    if ((int)blockIdx.x < first) return;
    const int gw = ((int)blockIdx.x - first) * NWAVES + wave, ngw = ((int)gridDim.x - first) * NWAVES;
    unsigned char* ws = p.k->ws;
    LAS float* scr = (LAS float*)(lds + wave * 8704);
    constexpr int I0 = 16 * 80, I4 = 4 * 24, I5 = 2 * 24, I6 = 32 * 2, I7 = 32 * 2, I8 = 8, I9 = 8;
    constexpr int NIT = I0 + I4 + I5 + I6 + I7 + I8 + I9;
    for (int it = gw; it < NIT; it += ngw) {
        int r = it;
        if (r < I0) { transpose_item(PIN(I_WIN) + (size_t)l * D_ * DIN, D_, DIN, MapIn{}, nullptr, (bf16*)(ws + WT_IN), scr, r, 80, lane); continue; } r -= I0;
        if (r < I4) { transpose_item(PIN(I_WUQ) + (size_t)l * 256 * 576, 256, 576, MapId{576}, PIN(I_GQL) + l * 256, (bf16*)(ws + WT_UQ), scr, r, 24, lane); continue; } r -= I4;
        if (r < I5) { transpose_item(PIN(I_WUKV) + (size_t)l * 128 * 768, 128, 768, MapId{768}, PIN(I_GKVL) + l * 128, (bf16*)(ws + WT_UKV), scr, r, 24, lane); continue; } r -= I5;
        if (r < I6) { transpose_item(PIN(I_WCK) + (size_t)l * 2048 * 64, 2048, 64, MapId{64}, nullptr, (bf16*)(ws + WT_CK), scr, r, 2, lane); continue; } r -= I6;
        if (r < I7) { transpose_item(PIN(I_WCV) + (size_t)l * 2048 * 64, 2048, 64, MapId{64}, nullptr, (bf16*)(ws + WT_CV), scr, r, 2, lane); continue; } r -= I7;
        if (r < I8) { const int h = r >> 1; transpose_item(PIN(I_WQM) + (size_t)l * 16384 + h * 4096, 64, 64, MapId{64}, nullptr, (bf16*)(ws + WT_QM) + h * 4096, scr, r & 1, 2, lane); continue; } r -= I8;
        { const int h = r >> 1; transpose_item(PIN(I_WKM) + (size_t)l * 16384 + h * 4096, 64, 64, MapId{64}, nullptr, (bf16*)(ws + WT_KM) + h * 4096, scr, r & 1, 2, lane); }
    }
}
__device__ __forceinline__ void ph_prep(const MPK& p, int l, LAS unsigned char* lds, int tid) {
    const int wave = tid >> 6, lane = tid & 63;
    const int gw = blockIdx.x * NWAVES + wave, ngw = gridDim.x * NWAVES;
    unsigned char* ws = p.k->ws;
    LAS float* scr = (LAS float*)(lds + wave * 8704);
    for (int i = blockIdx.x * NTHR + tid; i < 2 * T_; i += gridDim.x * NTHR) ((float*)(ws + WS_SSQL))[i] = 0.f;
    if (l == 0) early_transposes(p, l, lds, tid, 0);
    const float* xin = (l == 0) ? PIN(I_X) : p.k->out;
    const float* modl = (const float*)(ws + WS_MOD) + (size_t)l * 8 * 6144;
    norm_rows(xin, PIN(I_GN1) + l * D_, modl + 0, modl + 1024, (bf16*)(ws + WS_HB), nullptr, 0, gw, ngw, lane);
}
__device__ __forceinline__ void late_transposes(const MPK& p, int l, LAS unsigned char* lds, int tid, int first) {
    const int wave = tid >> 6, lane = tid & 63;
    if ((int)blockIdx.x < first) return;
    const int gw = ((int)blockIdx.x - first) * NWAVES + wave, ngw = ((int)gridDim.x - first) * NWAVES;
    unsigned char* ws = p.k->ws;
    LAS float* scr = (LAS float*)(lds + wave * 8704);
    constexpr int I1 = 16 * 32, I2 = 16 * 176, I3 = 44 * 32;
    for (int it = gw; it < I1 + I2 + I3; it += ngw) {
        int r = it;
        if (r < I1) { transpose_item(PIN(I_WOUT) + (size_t)l * D_ * D_, D_, D_, MapId{D_}, nullptr, (bf16*)(ws + WT_OUT), scr, r, 32, lane); continue; } r -= I1;
        if (r < I2) { transpose_item(PIN(I_WGU) + (size_t)l * D_ * 2 * FF, D_, 2 * FF, MapGU{}, nullptr, (bf16*)(ws + WT_GU), scr, r, 176, lane); continue; } r -= I2;
        transpose_item(PIN(I_WDOWN) + (size_t)l * FF * D_, FF, D_, MapId{D_}, nullptr, (bf16*)(ws + WT_DOWN), scr, r, 32, lane);
    }
}
__device__ __forceinline__ void ph_mixnorm(const MPK& p, int l, int tid) {
    const int gw = blockIdx.x * NWAVES + (tid >> 6), ngw = gridDim.x * NWAVES, lane = tid & 63;
    unsigned char* ws = p.k->ws;
    bf16* mix = (bf16*)(ws + WS_HB); const float* ga = PIN(I_GOA) + l * 384; const float* gb = PIN(I_GOB) + l * 384;
    const bf16 *oc = (const bf16*)(ws + WS_OCMP), *os = (const bf16*)(ws + WS_OSLC), *ow = (const bf16*)(ws + WS_OWIN); const float* gm = (const float*)(ws + WS_GM);
#define UNPK8(dst, src) dst[0] = __uint_as_float(src.x << 16); dst[1] = __uint_as_float(src.x & 0xffff0000u); dst[2] = __uint_as_float(src.y << 16); dst[3] = __uint_as_float(src.y & 0xffff0000u); \
    dst[4] = __uint_as_float(src.z << 16); dst[5] = __uint_as_float(src.z & 0xffff0000u); dst[6] = __uint_as_float(src.w << 16); dst[7] = __uint_as_float(src.w & 0xffff0000u);
    const int rpw = T_ / ngw;
    const float* ggp = (lane < 48) ? ga + lane * 8 : gb + (lane - 48) * 8; const float4 gA0 = *(const float4*)ggp, gA1 = *(const float4*)(ggp + 4);
    const float* ggq = gb + (16 + (lane & 31)) * 8; const float4 gB0 = *(const float4*)ggq, gB1 = *(const float4*)(ggq + 4);
    v4u ra4, rb4, rc4, ry4; float rg0, rg1, rg2;
#define MIX_LOAD(m_) do { const bf16* r_ = mix + (size_t)(m_) * D_; \
        if (lane < 48) { const size_t o_ = (size_t)(m_) * 384 + lane * 8; const float* g3_ = gm + (size_t)(m_) * 32 + 3 * (lane >> 3); rg0 = g3_[0]; rg1 = g3_[1]; rg2 = g3_[2]; \
            ra4 = *(const v4u*)(oc + o_); rb4 = *(const v4u*)(os + o_); rc4 = *(const v4u*)(ow + o_); } \
        else { ra4 = *(const v4u*)(r_ + 384 + (lane - 48) * 8); rb4 = ra4; rc4 = ra4; rg0 = 0.f; rg1 = 0.f; rg2 = 0.f; } \
        if (lane < 32) ry4 = *(const v4u*)(r_ + 384 + (16 + lane) * 8); else ry4 = ra4; } while (0)
    const int mend = gw * rpw + rpw;
    MIX_LOAD(gw * rpw);
    for (int m = gw * rpw; m < mend; ++m) {
        bf16* r = mix + (size_t)m * D_;
        const v4u ca4 = ra4, cb4 = rb4, cc4 = rc4, cy4 = ry4; const float g0 = rg0, g1 = rg1, g2 = rg2;
        if (m + 1 < mend) MIX_LOAD(m + 1);
        float v0[8], v1[8]; float sa = 0.f, sb = 0.f;
        if (lane < 48) {
            float c8[8], s8[8], w8[8]; UNPK8(c8, ca4) UNPK8(s8, cb4) UNPK8(w8, cc4)
#pragma unroll
            for (int i = 0; i < 8; ++i) { v0[i] = g0 * c8[i] + g1 * s8[i] + g2 * w8[i]; sa += v0[i] * v0[i]; }
        } else {
            UNPK8(v0, ca4)
#pragma unroll
            for (int i = 0; i < 8; ++i) sb += v0[i] * v0[i];
        }
        if (lane < 32) { UNPK8(v1, cy4)
#pragma unroll
            for (int i = 0; i < 8; ++i) sb += v1[i] * v1[i]; }
        const float ra = rsqrtf(wave_sum2(sa) * (1.f / 384.f) + EPS), rb = rsqrtf(wave_sum2(sb) * (1.f / 384.f) + EPS);
        {
            const int col = (lane < 48) ? lane * 8 : 384 + (lane - 48) * 8; const float rr = (lane < 48) ? ra : rb;
            const float4 q0 = gA0, q1 = gA1;
            v4u w; w.x = pk2(v0[0] * rr * q0.x, v0[1] * rr * q0.y); w.y = pk2(v0[2] * rr * q0.z, v0[3] * rr * q0.w); w.z = pk2(v0[4] * rr * q1.x, v0[5] * rr * q1.y); w.w = pk2(v0[6] * rr * q1.z, v0[7] * rr * q1.w);
            *(v4u*)(r + col) = w;
        }
        if (lane < 32) { const float4 q0 = gB0, q1 = gB1;
            v4u w; w.x = pk2(v1[0] * rb * q0.x, v1[1] * rb * q0.y); w.y = pk2(v1[2] * rb * q0.z, v1[3] * rb * q0.w); w.z = pk2(v1[4] * rb * q1.x, v1[5] * rb * q1.y); w.w = pk2(v1[6] * rb * q1.z, v1[7] * rb * q1.w);
            *(v4u*)(r + 384 + (16 + lane) * 8) = w; }
    }
#undef MIX_LOAD
#undef UNPK8
}


typedef short bf16x8 __attribute__((ext_vector_type(8)));
typedef short s16x4 __attribute__((ext_vector_type(4)));
typedef float f32x16 __attribute__((ext_vector_type(16)));
typedef unsigned u32x2v __attribute__((ext_vector_type(2)));
constexpr int AT_BUF = 20480, AT_K32 = 8192, AT_V = 12288;
__device__ __forceinline__ unsigned cvtpk(float lo, float hi) { unsigned r; asm volatile("v_cvt_pk_bf16_f32 %0, %1, %2" : "=v"(r) : "v"(lo), "v"(hi)); return r; }
__device__ __forceinline__ float max3f(float a, float b, float c) { float r; asm("v_max3_f32 %0, %1, %2, %3" : "=v"(r) : "v"(a), "v"(b), "v"(c)); return r; }
__device__ __forceinline__ int crow(int r, int hi) { return (r & 3) + 8 * (r >> 2) + 4 * hi; }
__device__ __forceinline__ s16x4 vtr(LAS const unsigned char* p) { return __builtin_bit_cast(s16x4, __builtin_amdgcn_ds_read_tr16_b64_v4i16((LAS s16x4*)p)); }
enum { AM_CAUSAL = 0, AM_WINDOW = 1, AM_SLC = 2 };
struct AttnState { float m, l; f32x16 o[2]; f32x16 negm; bool started; long long twait; };
template <int NC> struct TileRegs { v4u k; v4u k2; v4u v; };
template <int NC> __device__ __forceinline__ void at_load(TileRegs<NC>& r, const bf16* Kg, int ldk, const bf16* Vg, int ldv, const bf16* K2g, int ldk2, int tile, int tid) {
    const int key = tid >> 3, c = tid & 7;
    r.k = *(const v4u*)(Kg + (size_t)(tile * 64 + key) * ldk + 8 * c);
    r.v = *(const v4u*)(Vg + (size_t)(tile * 64 + key) * ldv + 8 * c);
    if (NC == 6) { if (tid < 256) r.k2 = *(const v4u*)(K2g + (size_t)(tile * 64 + (tid >> 2)) * ldk2 + 8 * (tid & 3)); }
}
template <int NC> __device__ __forceinline__ void at_store(const TileRegs<NC>& r, LAS unsigned char* buf, int tid) {
    const int key = tid >> 3, c = tid & 7;
    *(LAS v4u*)(buf + key * 128 + 16 * (c ^ ((key >> 1) & 7))) = r.k;
    *(LAS v4u*)(buf + AT_V + (c >> 2) * 4096 + key * 64 + (c & 3) * 16) = r.v;
    if (NC == 6) { if (tid < 256) { const int k2 = tid >> 2, c2 = tid & 3; *(LAS v4u*)(buf + AT_K32 + k2 * 64 + 16 * (c2 ^ ((k2 >> 2) & 3))) = r.k2; } }
}
template <int NC> __device__ __forceinline__ void qk_tile(f32x16& p0, f32x16& p1, LAS const unsigned char* buf, const bf16x8 (&qf)[NC], const f32x16& negm, int lane) {
    const int r32 = lane & 31, hi = lane >> 5;
    p0 = negm; p1 = negm;
#pragma unroll
    for (int cc = 0; cc < NC; ++cc) {
        bf16x8 k0, k1;
        if (cc < 4) { const int k0r = r32, k1r = 32 + r32;
            k0 = *(LAS const bf16x8*)(buf + k0r * 128 + 16 * ((2 * cc + hi) ^ ((k0r >> 1) & 7)));
            k1 = *(LAS const bf16x8*)(buf + k1r * 128 + 16 * ((2 * cc + hi) ^ ((k1r >> 1) & 7))); }
        else { const int k0r = r32, k1r = 32 + r32, c2 = 2 * (cc - 4) + hi;
            k0 = *(LAS const bf16x8*)(buf + AT_K32 + k0r * 64 + 16 * (c2 ^ ((k0r >> 2) & 3)));
            k1 = *(LAS const bf16x8*)(buf + AT_K32 + k1r * 64 + 16 * (c2 ^ ((k1r >> 2) & 3))); }
        p0 = __builtin_amdgcn_mfma_f32_32x32x16_bf16(k0, qf[cc], p0, 0, 0, 0);
        p1 = __builtin_amdgcn_mfma_f32_32x32x16_bf16(k1, qf[cc], p1, 0, 0, 0);
    }
}
template <int MODE> __device__ __forceinline__ void mask_tile(f32x16& p0, f32x16& p1, int kpos0, int qpos, bool need_mask, bool sel_ok, int lane) {
    const int hi = lane >> 5;
    if (need_mask) {
        const int qw0m = __builtin_amdgcn_readfirstlane(qpos) & ~31;
        const bool diag = (kpos0 + 63 > qw0m), old = (MODE == AM_WINDOW) && (kpos0 < qw0m + 31 - 511);
        if (diag || old) {
            const float selterm = (MODE == AM_SLC && !sel_ok) ? -INFINITY : INFINITY;
            const int dbase = qpos - kpos0 - 4 * hi;
#pragma unroll
            for (int r = 0; r < 16; ++r) {
                const int d0 = dbase - ((r & 3) + 8 * (r >> 2)), d1 = d0 - 32;
                float l0 = ((float)d0 + 0.5f) * INFINITY, l1 = ((float)d1 + 0.5f) * INFINITY;
                if (MODE == AM_WINDOW) { l0 = fminf(l0, ((float)(511 - d0) + 0.5f) * INFINITY); l1 = fminf(l1, ((float)(511 - d1) + 0.5f) * INFINITY); }
                if (MODE == AM_SLC) { l0 = fminf(l0, selterm); l1 = fminf(l1, selterm); }
                p0[r] = fminf(p0[r], l0); p1[r] = fminf(p1[r], l1);
            }
        } else if (MODE == AM_SLC) {
            const float selterm = sel_ok ? INFINITY : -INFINITY;
#pragma unroll
            for (int r = 0; r < 16; ++r) { p0[r] = fminf(p0[r], selterm); p1[r] = fminf(p1[r], selterm); }
        }
    }
}
template <int MODE> __device__ __forceinline__ void softmax_tile(AttnState& st, f32x16& p0, f32x16& p1, bf16x8 (&pf)[4], int kpos0, int qpos, bool need_mask, bool sel_ok, int lane) {
    mask_tile<MODE>(p0, p1, kpos0, qpos, need_mask, sel_ok, lane);
    float mx = max3f(p0[0], p1[0], p0[1]), mx2 = max3f(p1[1], p0[2], p1[2]);
#pragma unroll
    for (int r = 3; r < 15; r += 2) { mx = max3f(mx, p0[r], p1[r]); mx2 = max3f(mx2, p0[r + 1], p1[r + 1]); }
    mx = max3f(mx, p0[15], p1[15]); mx = max3f(mx, mx2, mx2);
    mx = red32_max(mx);
    if (!st.started || __any(mx > 0.f)) {
        float dl = st.started ? fmaxf(mx, 0.f) : mx;
        dl = (dl > -1e30f) ? dl : 0.f;
        st.started = true;
        const float alpha = __builtin_amdgcn_exp2f(-dl);
        st.m += dl; st.l *= alpha;
#pragma unroll
        for (int r = 0; r < 16; ++r) { st.o[0][r] *= alpha; st.o[1][r] *= alpha; p0[r] -= dl; p1[r] -= dl; st.negm[r] = -st.m; }
    }
    float sum = 0.f;
#pragma unroll
    for (int r = 0; r < 16; ++r) { p0[r] = __builtin_amdgcn_exp2f(p0[r]); p1[r] = __builtin_amdgcn_exp2f(p1[r]); sum += p0[r] + p1[r]; }
    st.l += sum;
#pragma unroll
    for (int s2 = 0; s2 < 2; ++s2) {
        v4u a, b;
        a.x = cvtpk(p0[8 * s2 + 0], p0[8 * s2 + 1]); a.y = cvtpk(p0[8 * s2 + 2], p0[8 * s2 + 3]); a.z = cvtpk(p0[8 * s2 + 4], p0[8 * s2 + 5]); a.w = cvtpk(p0[8 * s2 + 6], p0[8 * s2 + 7]);
        b.x = cvtpk(p1[8 * s2 + 0], p1[8 * s2 + 1]); b.y = cvtpk(p1[8 * s2 + 2], p1[8 * s2 + 3]); b.z = cvtpk(p1[8 * s2 + 4], p1[8 * s2 + 5]); b.w = cvtpk(p1[8 * s2 + 6], p1[8 * s2 + 7]);
        pf[s2] = __builtin_bit_cast(bf16x8, a); pf[2 + s2] = __builtin_bit_cast(bf16x8, b);
    }
}
struct TileFlags { bool skip, need_mask, sel_ok; };
__device__ __forceinline__ void pack_p(bf16x8 (&pf)[4], const f32x16& p0, const f32x16& p1) {
#pragma unroll
    for (int s2 = 0; s2 < 2; ++s2) {
        v4u a, b;
        a.x = cvtpk(p0[8 * s2 + 0], p0[8 * s2 + 1]); a.y = cvtpk(p0[8 * s2 + 2], p0[8 * s2 + 3]); a.z = cvtpk(p0[8 * s2 + 4], p0[8 * s2 + 5]); a.w = cvtpk(p0[8 * s2 + 6], p0[8 * s2 + 7]);
        b.x = cvtpk(p1[8 * s2 + 0], p1[8 * s2 + 1]); b.y = cvtpk(p1[8 * s2 + 2], p1[8 * s2 + 3]); b.z = cvtpk(p1[8 * s2 + 4], p1[8 * s2 + 5]); b.w = cvtpk(p1[8 * s2 + 6], p1[8 * s2 + 7]);
        pf[s2] = __builtin_bit_cast(bf16x8, a); pf[2 + s2] = __builtin_bit_cast(bf16x8, b);
    }
}
template <int MODE> __device__ __forceinline__ void softmax_pair(AttnState& st, f32x16& a0, f32x16& a1, f32x16& b0, f32x16& b1, int kpos0, int qpos, const TileFlags& fa, const TileFlags& fb, int lane) {
    mask_tile<MODE>(a0, a1, kpos0, qpos, fa.need_mask, fa.sel_ok, lane);
    mask_tile<MODE>(b0, b1, kpos0 + 64, qpos, fb.need_mask, fb.sel_ok, lane);
    float mx = max3f(a0[0], a1[0], b0[0]), mx2 = max3f(b1[0], a0[1], a1[1]);
#pragma unroll
    for (int r = 1; r < 16; ++r) { mx = max3f(mx, b0[r], b1[r]); if (r > 1) mx2 = max3f(mx2, a0[r], a1[r]); }
    mx = max3f(mx, mx2, mx2);
    mx = red32_max(mx);
    if (!st.started || __any(mx > 0.f)) {
        float dl = st.started ? fmaxf(mx, 0.f) : mx;
        dl = (dl > -1e30f) ? dl : 0.f;
        st.started = true;
        const float alpha = __builtin_amdgcn_exp2f(-dl);
        st.m += dl; st.l *= alpha;
#pragma unroll
        for (int r = 0; r < 16; ++r) { st.o[0][r] *= alpha; st.o[1][r] *= alpha; a0[r] -= dl; a1[r] -= dl; b0[r] -= dl; b1[r] -= dl; st.negm[r] = -st.m; }
    }
    float sum = 0.f;
#pragma unroll
    for (int r = 0; r < 16; ++r) { a0[r] = __builtin_amdgcn_exp2f(a0[r]); a1[r] = __builtin_amdgcn_exp2f(a1[r]); b0[r] = __builtin_amdgcn_exp2f(b0[r]); b1[r] = __builtin_amdgcn_exp2f(b1[r]); sum += (a0[r] + a1[r]) + (b0[r] + b1[r]); }
    st.l += sum;
}
__device__ __forceinline__ void pv_tile(AttnState& st, LAS const unsigned char* buf, const bf16x8 (&pf)[4], int lane) {
    const int hi = lane >> 5;
    const unsigned vb = (unsigned)(uintptr_t)(buf + AT_V + (4 * hi + ((lane & 15) >> 2)) * 64 + ((lane >> 4) & 1) * 32 + (lane & 3) * 8);
#pragma unroll
    for (int dh = 0; dh < 2; ++dh) {
        s16x4 lo[4], hh[4];
#pragma unroll
        for (int s4 = 0; s4 < 4; ++s4) {
            asm volatile("ds_read_b64_tr_b16 %0, %1 offset:%c2" : "=&v"(lo[s4]) : "v"(vb), "i"(dh * 4096 + s4 * 1024) : "memory");
            asm volatile("ds_read_b64_tr_b16 %0, %1 offset:%c2" : "=&v"(hh[s4]) : "v"(vb), "i"(dh * 4096 + s4 * 1024 + 512) : "memory");
        }
        asm volatile("s_waitcnt lgkmcnt(0)" : "+v"(lo[0]), "+v"(lo[1]), "+v"(lo[2]), "+v"(lo[3]), "+v"(hh[0]), "+v"(hh[1]), "+v"(hh[2]), "+v"(hh[3]) :: "memory");
#pragma unroll
        for (int s4 = 0; s4 < 4; ++s4) {
            const bf16x8 vf = {lo[s4][0], lo[s4][1], lo[s4][2], lo[s4][3], hh[s4][0], hh[s4][1], hh[s4][2], hh[s4][3]};
            st.o[dh] = __builtin_amdgcn_mfma_f32_32x32x16_bf16(vf, pf[s4], st.o[dh], 0, 0, 0);
        }
    }
}
template <int MODE> __device__ __forceinline__ TileFlags tile_flags(int t, int qw0, unsigned selbits) {
    const int k0 = t * 64; TileFlags f;
    f.skip = k0 > qw0 + 31; f.need_mask = (k0 + 63 > qw0); f.sel_ok = true;
    if (MODE == AM_WINDOW) { f.skip = f.skip || (k0 + 63 < qw0 - 511); f.need_mask = f.need_mask || (k0 < qw0 + 31 - 511); }
    if (MODE == AM_SLC) { f.sel_ok = (selbits >> t) & 1u; const unsigned long long bal = __ballot(f.sel_ok); f.skip = f.skip || (bal == 0ull); f.need_mask = f.need_mask || (bal != ~0ull); }
    return f;
}
struct DmaOff { unsigned k, v, k2; };
template <int NC> __device__ __forceinline__ DmaOff at_dma_off(int ldk, int ldv, int ldk2, int wave, int lane) {
    const int L = wave * 64 + lane; DmaOff o;
    { const int key = L >> 3, c = (L & 7) ^ ((key >> 1) & 7); o.k = (unsigned)(key * ldk + 8 * c) * 2u; }
    { const int key = (L >> 2) & 63, c = (L >> 8) * 4 + (L & 3); o.v = (unsigned)(key * ldv + 8 * c) * 2u; }
    { const int key = (L >> 2) & 63, c2 = (L & 3) ^ ((key >> 2) & 3); o.k2 = (unsigned)(key * ldk2 + 8 * c2) * 2u; }
    return o;
}
template <int NC> __device__ __forceinline__ void at_dma(const DmaOff& o, const bf16* Kg, int ldk, const bf16* Vg, int ldv, const bf16* K2g, int ldk2, int tile, LAS unsigned char* slot, int wave) {
    __builtin_amdgcn_global_load_lds((const unsigned*)((const char*)(Kg + (size_t)tile * 64 * ldk) + o.k), (LAS unsigned*)(slot + wave * 1024), 16, 0, 0);
    __builtin_amdgcn_global_load_lds((const unsigned*)((const char*)(Vg + (size_t)tile * 64 * ldv) + o.v), (LAS unsigned*)(slot + AT_V + wave * 1024), 16, 0, 0);
    if (NC == 6) { if (wave < 4) __builtin_amdgcn_global_load_lds((const unsigned*)((const char*)(K2g + (size_t)tile * 64 * ldk2) + o.k2), (LAS unsigned*)(slot + AT_K32 + wave * 1024), 16, 0, 0); }
}
__device__ __forceinline__ void at_wait_bar(int keep) {
    if (keep == 0) asm volatile("s_waitcnt vmcnt(0) lgkmcnt(0)" ::: "memory");
    else if (keep == 4) asm volatile("s_waitcnt vmcnt(4) lgkmcnt(0)" ::: "memory");
    else asm volatile("s_waitcnt vmcnt(6) lgkmcnt(0)" ::: "memory");
    __builtin_amdgcn_s_barrier();
    asm volatile("" ::: "memory");
}
template <int NC, int MODE> __device__ __forceinline__ void at_stream(AttnState& st, LAS unsigned char* lds, const bf16* Kg, int ldk, const bf16* Vg, int ldv, const bf16* K2g, int ldk2, int t0, int t1,
                                                                       const bf16x8 (&qf)[NC], int qpos, int qw0, unsigned selbits, int tid) {
    const int lane = tid & 63, wave = __builtin_amdgcn_readfirstlane(tid >> 6), np = (t1 - t0) >> 1;
    const int nper2 = (NC == 6 && wave < 4) ? 6 : 4;
    const DmaOff dof = at_dma_off<NC>(ldk, ldv, ldk2, wave, lane);
    at_dma<NC>(dof, Kg, ldk, Vg, ldv, K2g, ldk2, t0, lds, wave); at_dma<NC>(dof, Kg, ldk, Vg, ldv, K2g, ldk2, t0 + 1, lds + AT_BUF, wave);
    if (np > 1) { at_dma<NC>(dof, Kg, ldk, Vg, ldv, K2g, ldk2, t0 + 2, lds + 2 * AT_BUF, wave); at_dma<NC>(dof, Kg, ldk, Vg, ldv, K2g, ldk2, t0 + 3, lds + 3 * AT_BUF, wave); }
    at_wait_bar(np > 1 ? nper2 : 0);
    int s0 = 0, s1 = 2 * AT_BUF, s2 = 4 * AT_BUF;
    for (int j = 0; j < np; ++j) {
        const int t = t0 + 2 * j; const bool has_2 = (j + 2 < np);
        if (has_2) { at_dma<NC>(dof, Kg, ldk, Vg, ldv, K2g, ldk2, t + 4, lds + s2, wave); at_dma<NC>(dof, Kg, ldk, Vg, ldv, K2g, ldk2, t + 5, lds + s2 + AT_BUF, wave); }
        const TileFlags fa = tile_flags<MODE>(t, qw0, selbits), fb = tile_flags<MODE>(t + 1, qw0, selbits);
        if (!fa.skip && !fb.skip) {
            f32x16 a0, a1, b0, b1; bf16x8 pf[4];
            qk_tile<NC>(a0, a1, lds + s0, qf, st.negm, lane);
            qk_tile<NC>(b0, b1, lds + s0 + AT_BUF, qf, st.negm, lane);
            softmax_pair<MODE>(st, a0, a1, b0, b1, t * 64, qpos, fa, fb, lane);
            pack_p(pf, a0, a1); pv_tile(st, lds + s0, pf, lane);
            pack_p(pf, b0, b1); pv_tile(st, lds + s0 + AT_BUF, pf, lane);
        } else {
            if (!fa.skip) { f32x16 p0, p1; bf16x8 pf[4]; qk_tile<NC>(p0, p1, lds + s0, qf, st.negm, lane); softmax_tile<MODE>(st, p0, p1, pf, t * 64, qpos, fa.need_mask, fa.sel_ok, lane); pv_tile(st, lds + s0, pf, lane); }
            if (!fb.skip) { f32x16 p0, p1; bf16x8 pf[4]; qk_tile<NC>(p0, p1, lds + s0 + AT_BUF, qf, st.negm, lane); softmax_tile<MODE>(st, p0, p1, pf, (t + 1) * 64, qpos, fb.need_mask, fb.sel_ok, lane); pv_tile(st, lds + s0 + AT_BUF, pf, lane); }
        }
        at_wait_bar(has_2 ? nper2 : 0);
        const int tmp = s0; s0 = s1; s1 = s2; s2 = tmp;
    }
}
__device__ __forceinline__ int next_item_q(unsigned* ctrs, LAS unsigned char* lds, int wave_u, int count, int q0, int& kstart) {
    const int tid = wave_u * 64 + fresh_lane();
    LAS int* slot = (LAS int*)(lds + RING_BYTES + 64);
    if (tid == 0) {
        int r = -1, k = kstart;
        for (; k < 8; ++k) { const int q = (q0 + k) & 7; const unsigned v = atomicAdd(ctrs + q * 16, 1u); if (v < (unsigned)count) { r = (q << 16) | (int)v; break; } }
        slot[0] = r; slot[1] = k;
    }
    __syncthreads();
    const int v = slot[0]; kstart = slot[1];
    __syncthreads();
    return v;
}
__device__ __forceinline__ void mla_unit(unsigned char* ws, LAS unsigned char* lds, int b, int h, int qt, int wave_u) {
    const int tid = wave_u * 64 + fresh_lane();
    const int lane = tid & 63, wave = tid >> 6, r32 = lane & 31, hi = lane >> 5;
    const int qw0 = qt * 256 + wave * 32, qpos = qw0 + r32; const size_t row = (size_t)b * S_ + qpos;
    const long long tq0 = (PROBE_SEL != 0) ? (long long)__builtin_amdgcn_s_memtime() : 0ll;
    bf16x8 qf[6];
    {
        const bf16* qp = (const bf16*)(ws + WS_OSLC) + row * 768 + h * 96 + 8 * hi;
        v4u raw[6];
#pragma unroll
        for (int cc = 0; cc < 6; ++cc) raw[cc] = *(const v4u*)(qp + 16 * cc);
        float msc = MSCALE; asm volatile("" : "+v"(msc));
        const float rs = rsqrtf(((const float*)(ws + WS_SSQL))[row] * (1.f / 256.f) + EPS) * msc;
        const float* cm_ = (const float*)(ws + WS_COSM) + row * 16 + 8 * hi; const float* sm_ = (const float*)(ws + WS_SINM) + row * 16 + 8 * hi;
#define UNPKQ(dst, src) dst[0] = __uint_as_float(src.x << 16); dst[1] = __uint_as_float(src.x & 0xffff0000u); dst[2] = __uint_as_float(src.y << 16); dst[3] = __uint_as_float(src.y & 0xffff0000u); \
        dst[4] = __uint_as_float(src.z << 16); dst[5] = __uint_as_float(src.z & 0xffff0000u); dst[6] = __uint_as_float(src.w << 16); dst[7] = __uint_as_float(src.w & 0xffff0000u);
#pragma unroll
        for (int cc = 0; cc < 4; ++cc) { float f[8]; UNPKQ(f, raw[cc])
            v4u w; w.x = cvtpk(f[0] * rs, f[1] * rs); w.y = cvtpk(f[2] * rs, f[3] * rs); w.z = cvtpk(f[4] * rs, f[5] * rs); w.w = cvtpk(f[6] * rs, f[7] * rs); qf[cc] = __builtin_bit_cast(bf16x8, w); }
        { float x1[8], x2[8], o1[8], o2[8]; UNPKQ(x1, raw[4]) UNPKQ(x2, raw[5])
#pragma unroll
          for (int j = 0; j < 8; ++j) { const float cs = cm_[j] * rs, sn = sm_[j] * rs; o1[j] = x1[j] * cs - x2[j] * sn; o2[j] = x1[j] * sn + x2[j] * cs; }
          v4u w; w.x = cvtpk(o1[0], o1[1]); w.y = cvtpk(o1[2], o1[3]); w.z = cvtpk(o1[4], o1[5]); w.w = cvtpk(o1[6], o1[7]); qf[4] = __builtin_bit_cast(bf16x8, w);
          w.x = cvtpk(o2[0], o2[1]); w.y = cvtpk(o2[2], o2[3]); w.z = cvtpk(o2[4], o2[5]); w.w = cvtpk(o2[6], o2[7]); qf[5] = __builtin_bit_cast(bf16x8, w); }
#undef UNPKQ
    }
    const long long tq1 = (PROBE_SEL != 0) ? (long long)__builtin_amdgcn_s_memtime() : 0ll;
    AttnState st; st.m = 0.f; st.l = 0.f; st.o[0] = f32x16{}; st.o[1] = f32x16{}; st.negm = f32x16{}; st.started = false; st.twait = 0;
    const bf16* kvb = (const bf16*)(ws + WS_KVM) + (size_t)b * S_ * 768 + h * 128;
    at_stream<6, AM_CAUSAL>(st, lds, kvb, 768, kvb + 64, 768, (const bf16*)(ws + WS_KR) + (size_t)b * S_ * 32, 32, 0, 4 * qt + 4, qf, qpos, qw0, 0u, tid);
    if (PROBE_SEL >= 1 && PROBE_SEL <= 3 && b == 0 && h == 0 && qt == 7 && tid == 0) { const long long tq2 = (long long)__builtin_amdgcn_s_memtime();
        ((float*)(ws + WS_CTL))[100] = (PROBE_SEL == 1) ? (float)(tq2 - tq1) : (PROBE_SEL == 2) ? (float)st.twait : (float)(tq1 - tq0); }
    const float lt = red32_sum(st.l), il = 1.f / lt;
    bf16* op = (bf16*)(ws + WS_HB) + row * D_ + 384 + h * 64 + 4 * hi;
#pragma unroll
    for (int dh = 0; dh < 2; ++dh)
#pragma unroll
        for (int g4 = 0; g4 < 4; ++g4) { u32x2v w; w.x = cvtpk(st.o[dh][4 * g4] * il, st.o[dh][4 * g4 + 1] * il); w.y = cvtpk(st.o[dh][4 * g4 + 2] * il, st.o[dh][4 * g4 + 3] * il);
            *(u32x2v*)(op + dh * 32 + 8 * g4) = w; }
}
template <int MODE> __device__ __forceinline__ void nsa_branch_unit(unsigned char* ws, LAS unsigned char* lds, int b, int h, int qt, int wave_u) {
    const int tid = wave_u * 64 + fresh_lane();
    const int lane = tid & 63, wave = tid >> 6, r32 = lane & 31, hi = lane >> 5, g = h / 3;
    const int qw0 = qt * 256 + wave * 32, qpos = qw0 + r32; const size_t row = (size_t)b * S_ + qpos;
    const bf16* nsa = (const bf16*)(ws + WS_NSA);
    const bf16* qp = nsa + row * 1152 + h * 64 + 8 * hi;
    bf16x8 qf[4];
#pragma unroll
    for (int cc = 0; cc < 4; ++cc) qf[cc] = *(const bf16x8*)(qp + 16 * cc);
    unsigned selbits = 0u; if (MODE == AM_SLC) selbits = ((const unsigned*)(ws + WS_SEL))[(size_t)(b * 2 + g) * S_ + qpos];
    const bf16* kb = nsa + (size_t)b * S_ * 1152 + g * 64 + (MODE == AM_SLC ? 640 : 896);
    AttnState st; st.m = 0.f; st.l = 0.f; st.o[0] = f32x16{}; st.o[1] = f32x16{}; st.negm = f32x16{}; st.started = false; st.twait = 0;
    const long long tn0 = (PROBE_SEL != 0) ? (long long)__builtin_amdgcn_s_memtime() : 0ll;
    const int t0 = (MODE == AM_SLC) ? 0 : ((4 * qt - 8 > 0) ? 4 * qt - 8 : 0);
    at_stream<4, MODE>(st, lds, kb, 1152, kb + 128, 1152, nullptr, 0, t0, 4 * qt + 4, qf, qpos, qw0, selbits, tid);
    if (PROBE_SEL >= 4 && PROBE_SEL <= 5 && MODE == AM_SLC && b == 0 && h == 0 && qt == 7 && tid == 0) { const long long tn1 = (long long)__builtin_amdgcn_s_memtime();
        ((float*)(ws + WS_CTL))[100] = (PROBE_SEL == 4) ? (float)(tn1 - tn0) : (float)st.twait; }
    const float lt = red32_sum(st.l), il = 1.f / lt;
    bf16* op = (bf16*)(ws + (MODE == AM_SLC ? WS_OSLC : WS_OWIN)) + row * 384 + h * 64 + 4 * hi;
#pragma unroll
    for (int dh = 0; dh < 2; ++dh)
#pragma unroll
        for (int g4 = 0; g4 < 4; ++g4) { u32x2v w; w.x = cvtpk(st.o[dh][4 * g4] * il, st.o[dh][4 * g4 + 1] * il); w.y = cvtpk(st.o[dh][4 * g4 + 2] * il, st.o[dh][4 * g4 + 3] * il);
            *(u32x2v*)(op + dh * 32 + 8 * g4) = w; }
}
__device__ __forceinline__ void cmp_unit(unsigned char* ws, LAS unsigned char* lds, int b, int g, int qt, int wave_u) {
    const int tid = wave_u * 64 + fresh_lane();
    const int lane = tid & 63, wave = tid >> 6, r32 = lane & 31, hi = lane >> 5;
    const int qpos = qt * 256 + wave * 32 + r32; const size_t row = (size_t)b * S_ + qpos;
    const bf16* kc = (const bf16*)(ws + WS_KCV) + (size_t)(b * 2 + g) * 128 * 64; const bf16* vc = kc + (size_t)8 * 2 * 128 * 64;
    { TileRegs<4> tr; at_load<4>(tr, kc, 64, vc, 64, nullptr, 0, 0, tid); at_store<4>(tr, lds, tid); at_load<4>(tr, kc, 64, vc, 64, nullptr, 0, 1, tid); at_store<4>(tr, lds + AT_BUF, tid); }
    __syncthreads();
    int nvis = (qpos >= 31) ? ((qpos - 31) >> 4) + 1 : 0; if (nvis > 127) nvis = 127;
    LAS float* IG = (LAS float*)(lds + 2 * AT_BUF) + wave * (32 * 33) + r32 * 33;
    LAS float* IL = IG + 8 * 32 * 33;
    const bf16* nsa = (const bf16*)(ws + WS_NSA);
    LAS const unsigned char* vb = lds + AT_V + (4 * hi + ((lane & 15) >> 2)) * 64 + ((lane >> 4) & 1) * 32 + (lane & 3) * 8;
    for (int r3 = 0; r3 < 3; ++r3) {
        const int h = 3 * g + r3;
        const bf16* qp = nsa + row * 1152 + h * 64 + 8 * hi;
        bf16x8 qf[4];
#pragma unroll
        for (int cc = 0; cc < 4; ++cc) qf[cc] = *(const bf16x8*)(qp + 16 * cc);
        f32x16 p[4];
#pragma unroll
        for (int tb = 0; tb < 4; ++tb) {
            LAS const unsigned char* buf = lds + (tb >> 1) * AT_BUF; const int kr = (tb & 1) * 32 + r32;
            p[tb] = f32x16{};
#pragma unroll
            for (int cc = 0; cc < 4; ++cc) { const bf16x8 kf = *(LAS const bf16x8*)(buf + kr * 128 + 16 * ((2 * cc + hi) ^ ((kr >> 1) & 7)));
                p[tb] = __builtin_amdgcn_mfma_f32_32x32x16_bf16(kf, qf[cc], p[tb], 0, 0, 0); }
        }
        float mx = -1e30f;
#pragma unroll
        for (int tb = 0; tb < 4; ++tb)
#pragma unroll
            for (int r = 0; r < 16; ++r) { const int n = 32 * tb + crow(r, hi); p[tb][r] = fminf(p[tb][r], ((float)(nvis - n) - 0.5f) * INFINITY); mx = fmaxf(mx, p[tb][r]); }
        mx = red32_max(mx);
        float sum = 0.f;
#pragma unroll
        for (int tb = 0; tb < 4; ++tb)
#pragma unroll
            for (int r = 0; r < 16; ++r) { p[tb][r] = __builtin_amdgcn_exp2f(p[tb][r] - mx); sum += p[tb][r]; }
        sum = red32_sum(sum);
        const float il = (nvis > 0) ? 1.f / sum : 0.f;
#pragma unroll
        for (int tb = 0; tb < 4; ++tb)
#pragma unroll
            for (int k = 0; k < 4; ++k) { const float a0 = p[tb][4 * k] * il, a1 = p[tb][4 * k + 1] * il, a2 = p[tb][4 * k + 2] * il, a3 = p[tb][4 * k + 3] * il;
                const int j = 2 * (4 * tb + k) + hi;
                const float gs = (a0 + a1) + (a2 + a3);
                if (r3 == 0) { IG[j] = gs; IL[j + 1] = a3; } else { IG[j] += gs; IL[j + 1] += a3; } }
        f32x16 o[2] = {f32x16{}, f32x16{}};
#pragma unroll
        for (int tb = 0; tb < 4; ++tb)
#pragma unroll
            for (int s2 = 0; s2 < 2; ++s2) {
                v4u a; a.x = cvtpk(p[tb][8 * s2 + 0], p[tb][8 * s2 + 1]); a.y = cvtpk(p[tb][8 * s2 + 2], p[tb][8 * s2 + 3]); a.z = cvtpk(p[tb][8 * s2 + 4], p[tb][8 * s2 + 5]); a.w = cvtpk(p[tb][8 * s2 + 6], p[tb][8 * s2 + 7]);
                const bf16x8 pf = __builtin_bit_cast(bf16x8, a);
                LAS const unsigned char* vbb = vb + (tb >> 1) * AT_BUF + ((tb & 1) * 2 + s2) * 1024;
#pragma unroll
                for (int dh = 0; dh < 2; ++dh) { const s16x4 lo = vtr(vbb + dh * 4096), hh = vtr(vbb + dh * 4096 + 512);
                    const bf16x8 vf = {lo[0], lo[1], lo[2], lo[3], hh[0], hh[1], hh[2], hh[3]};
                    o[dh] = __builtin_amdgcn_mfma_f32_32x32x16_bf16(vf, pf, o[dh], 0, 0, 0); }
                asm volatile("" ::: "memory");
            }
        bf16* op = (bf16*)(ws + WS_OCMP) + row * 384 + h * 64 + 4 * hi;
#pragma unroll
        for (int dh = 0; dh < 2; ++dh)
#pragma unroll
            for (int g4 = 0; g4 < 4; ++g4) { u32x2v w; w.x = cvtpk(o[dh][4 * g4] * il, o[dh][4 * g4 + 1] * il); w.y = cvtpk(o[dh][4 * g4 + 2] * il, o[dh][4 * g4 + 3] * il);
                *(u32x2v*)(op + dh * 32 + 8 * g4) = w; }
    }
    const int cur = qpos >> 6;
    LAS float* imp = IG;
#pragma unroll 1
    for (int jj = 0; jj < 16; ++jj) {
        const int j = 16 * hi + jj;
        float v = IG[j] + (j > 0 ? IL[j] : 0.f);
        if (j == 0 || j == cur || j == cur - 1) v = INFINITY;
        if (j * 64 > qpos) v = -INFINITY;
        IL[j] = v;
    }
#pragma unroll 1
    for (int jj = 0; jj < 16; ++jj) { const int j = 16 * hi + jj; imp[j] = IL[j]; }
    unsigned mask = 0;
#pragma unroll 1
    for (int jj = 0; jj < 16; ++jj) {
        const int j = 16 * hi + jj; const float v = imp[j]; int rank = 0;
#pragma unroll 4
        for (int k = 0; k < 32; ++k) { const float u2 = imp[k]; rank += (u2 > v || (u2 == v && k < j)) ? 1 : 0; }
        if (rank < 16) mask |= 1u << j;
    }
    mask = red32_or(mask);
    if (hi == 0) ((unsigned*)(ws + WS_SEL))[(size_t)(b * 2 + g) * S_ + qpos] = mask;
    __syncthreads();
}
__device__ __forceinline__ void lora_rows(unsigned char* ws, int tid) {
    const int gw = blockIdx.x * NWAVES + (tid >> 6), ngw = gridDim.x * NWAVES, lane = tid & 63;
    bf16* kvl = (bf16*)(ws + WS_KVL); const bf16* ql = (const bf16*)(ws + WS_QL); float* ssql = (float*)(ws + WS_SSQL);
    for (int m = gw; m < T_; m += ngw) {
        const unsigned kv = *(const unsigned*)(kvl + (size_t)m * 128 + 2 * lane);
        const float k0 = __uint_as_float(kv << 16), k1 = __uint_as_float(kv & 0xffff0000u);
        const uint2 qv = *(const uint2*)(ql + (size_t)m * 256 + 4 * lane);
        const float q0 = __uint_as_float(qv.x << 16), q1 = __uint_as_float(qv.x & 0xffff0000u), q2 = __uint_as_float(qv.y << 16), q3 = __uint_as_float(qv.y & 0xffff0000u);
        const float sk = wave_sum2(k0 * k0 + k1 * k1), sq = wave_sum2((q0 * q0 + q1 * q1) + (q2 * q2 + q3 * q3));
        const float rk = rsqrtf(sk * (1.f / 128.f) + EPS);
        *(unsigned*)(kvl + (size_t)m * 128 + 2 * lane) = pk2(k0 * rk, k1 * rk);
        if (lane == 0) ssql[m] = sq;
    }
}
__device__ __forceinline__ void post_misc(unsigned char* ws, const float* big, const float* bfg, int tid) {
    const float* mr = (const float*)(ws + WS_MISCRAW); const float* cosM = (const float*)(ws + WS_COSM); const float* sinM = (const float*)(ws + WS_SINM);
    bf16* kr = (bf16*)(ws + WS_KR); float* gm = (float*)(ws + WS_GM);
    for (int idx = blockIdx.x * NTHR + tid; idx < T_ * 64; idx += gridDim.x * NTHR) {
        const int row = idx >> 6, c = idx & 63; const float* r = mr + (size_t)row * 64; const float v = r[c];
        if (c < 32) { const int i = c & 15; const float x1 = r[i], x2 = r[16 + i], cs = cosM[row * 16 + i], sn = sinM[row * 16 + i];
            kr[(size_t)row * 32 + c] = f2bf((c < 16) ? x1 * cs - x2 * sn : x1 * sn + x2 * cs); }
        else if (c < 50) gm[(size_t)row * 32 + (c - 32)] = 1.f / (1.f + __expf(-v));
        else if (c < 54) gm[(size_t)row * 32 + 18 + (c - 50)] = v + big[c - 50];
        else if (c < 58) { const float z = v + bfg[c - 54]; gm[(size_t)row * 32 + 22 + (c - 54)] = fminf(z, 0.f) - __logf(1.f + __expf(-fabsf(z))); }
    }
}

typedef float f32x4v __attribute__((ext_vector_type(4)));
__device__ __forceinline__ void compress_item(unsigned char* ws, LAS unsigned char* lds, const float* cmp_pos, int item, int wave_u) {
    const int lane = fresh_lane(), tid = wave_u * 64 + lane;
    const int nb = item & 7, g = (item >> 3) & 1, b = (item >> 4) & 7, kv = item >> 7;
    const bf16* tok = (const bf16*)(ws + WS_NSA) + (size_t)b * S_ * 1152 + (kv ? 512 : 384) + g * 64;
    const bf16* wt = (const bf16*)(ws + (kv ? WT_CV : WT_CK));
    const int nrow = nb * 16 + (lane & 15), kq = lane >> 4;
    f32x4v acc[4] = {f32x4v{}, f32x4v{}, f32x4v{}, f32x4v{}};
#pragma unroll
    for (int hb = 0; hb < 2; ++hb) {
        v4u t4[4]; f32x4v p0[4], p1[4]; bf16x8 bfr[4][4];
#pragma unroll
        for (int q = 0; q < 4; ++q) {
            const int k = wave_u * 256 + (4 * hb + q) * 32 + kq * 8, l = k >> 6, d = k & 63;
            int trow = 16 * nrow + l; trow = trow < S_ ? trow : S_ - 1;
            t4[q] = *(const v4u*)(tok + (size_t)trow * 1152 + d);
            p0[q] = *(const f32x4v*)(cmp_pos + k); p1[q] = *(const f32x4v*)(cmp_pos + k + 4);
#pragma unroll
            for (int cb = 0; cb < 4; ++cb) bfr[q][cb] = *(const bf16x8*)(wt + (size_t)(cb * 16 + (lane & 15)) * 2048 + k);
        }
        asm volatile("" : "+v"(t4[0]), "+v"(t4[1]), "+v"(t4[2]), "+v"(t4[3]), "+v"(p0[0]), "+v"(p0[1]), "+v"(p0[2]), "+v"(p0[3]), "+v"(p1[0]), "+v"(p1[1]), "+v"(p1[2]), "+v"(p1[3]));
        asm volatile("" : "+v"(bfr[0][0]), "+v"(bfr[0][1]), "+v"(bfr[0][2]), "+v"(bfr[0][3]), "+v"(bfr[1][0]), "+v"(bfr[1][1]), "+v"(bfr[1][2]), "+v"(bfr[1][3]));
        asm volatile("" : "+v"(bfr[2][0]), "+v"(bfr[2][1]), "+v"(bfr[2][2]), "+v"(bfr[2][3]), "+v"(bfr[3][0]), "+v"(bfr[3][1]), "+v"(bfr[3][2]), "+v"(bfr[3][3]));
#pragma unroll
        for (int q = 0; q < 4; ++q) {
            v4u a4;
            a4.x = cvtpk(__uint_as_float(t4[q].x << 16) + p0[q][0], __uint_as_float(t4[q].x & 0xffff0000u) + p0[q][1]); a4.y = cvtpk(__uint_as_float(t4[q].y << 16) + p0[q][2], __uint_as_float(t4[q].y & 0xffff0000u) + p0[q][3]);
            a4.z = cvtpk(__uint_as_float(t4[q].z << 16) + p1[q][0], __uint_as_float(t4[q].z & 0xffff0000u) + p1[q][1]); a4.w = cvtpk(__uint_as_float(t4[q].w << 16) + p1[q][2], __uint_as_float(t4[q].w & 0xffff0000u) + p1[q][3]);
            const bf16x8 af = __builtin_bit_cast(bf16x8, a4);
#pragma unroll
            for (int cb = 0; cb < 4; ++cb) acc[cb] = __builtin_amdgcn_mfma_f32_16x16x32_bf16(af, bfr[q][cb], acc[cb], 0, 0, 0);
        }
    }
    LAS float* red = (LAS float*)lds + wave_u * 1024;
#pragma unroll
    for (int cb = 0; cb < 4; ++cb)
#pragma unroll
        for (int r = 0; r < 4; ++r) red[(4 * (lane >> 4) + r) * 64 + cb * 16 + (lane & 15)] = acc[cb][r];
    __syncthreads();
    bf16* out = (bf16*)(ws + WS_KCV) + (size_t)kv * (8 * 2 * 128 * 64) + ((size_t)(b * 2 + g) * 128 + nb * 16) * 64;
    for (int o = tid; o < 1024; o += NTHR) { float sum = 0.f;
#pragma unroll
        for (int w8 = 0; w8 < 8; ++w8) sum += ((LAS float*)lds)[w8 * 1024 + o];
        out[o] = f2bf(sum); }
    __syncthreads();
}
__device__ __forceinline__ f32x4v mm16(const LAS bf16* A, int lda, int arow0, const LAS bf16* Bt, int ldb, int bcol0, int K, int lane, f32x4v acc) {
    const LAS bf16* ap = A + (arow0 + (lane & 15)) * lda + 8 * (lane >> 4); const LAS bf16* bp = Bt + (bcol0 + (lane & 15)) * ldb + 8 * (lane >> 4);
    for (int k = 0; k < K; k += 32) acc = __builtin_amdgcn_mfma_f32_16x16x32_bf16(*(const LAS bf16x8*)(ap + k), *(const LAS bf16x8*)(bp + k), acc, 0, 0, 0);
    return acc;
}
constexpr int ML_LD = 72;
constexpr int ML_STRIDE = 3 * 64 * ML_LD * 2 + 256;
__device__ __forceinline__ void mlocal_item(unsigned char* ws, LAS unsigned char* lds, const float* convw, const float* convb, const float* big, const float* bfg, int chunk0, int wave_u) {
    const int lane = fresh_lane(), tid = wave_u * 64 + lane;
    const int h = (chunk0 >> 5) & 3, b = chunk0 >> 7;
    LAS bf16* WQ = (LAS bf16*)lds;
    LAS bf16* WK = WQ + 64 * ML_LD;
    const bf16* cm = (const bf16*)(ws + WS_CM);
#define ML_PTRS(ch) const int chunk = chunk0 + (ch); const int c = chunk & 31; const int row0 = b * S_ + c * 64; LAS bf16* XS = WK + 64 * ML_LD + (ch) * (ML_STRIDE / 2); \
    LAS bf16* VT = XS + 64 * ML_LD; LAS bf16* WKT = VT + 64 * ML_LD; LAS float* wl = (LAS float*)(WKT + 64 * ML_LD); (void)c; (void)row0; (void)XS; (void)VT; (void)WKT; (void)wl; (void)chunk;
#pragma unroll
    for (int ch = 0; ch < 2; ++ch) { ML_PTRS(ch)
        const int l = tid >> 3, ch0 = (tid & 7) * 8, row = row0 + l, s = c * 64 + l;
        float a[8];
#pragma unroll
        for (int i = 0; i < 8; ++i) a[i] = convb[h * 64 + ch0 + i];
#pragma unroll
        for (int j = 0; j < 4; ++j) { if (s - 3 + j >= 0) { const v4u x4 = *(const v4u*)(cm + (size_t)(row - 3 + j) * 768 + h * 64 + ch0);
            const float* cw = convw + j * 256 + h * 64 + ch0;
            a[0] += cw[0] * __uint_as_float(x4.x << 16); a[1] += cw[1] * __uint_as_float(x4.x & 0xffff0000u); a[2] += cw[2] * __uint_as_float(x4.y << 16); a[3] += cw[3] * __uint_as_float(x4.y & 0xffff0000u);
            a[4] += cw[4] * __uint_as_float(x4.z << 16); a[5] += cw[5] * __uint_as_float(x4.z & 0xffff0000u); a[6] += cw[6] * __uint_as_float(x4.w << 16); a[7] += cw[7] * __uint_as_float(x4.w & 0xffff0000u); } }
        v4u o4; float r[8];
#pragma unroll
        for (int i = 0; i < 8; ++i) r[i] = a[i] / (1.f + __expf(-a[i]));
        o4.x = cvtpk(r[0], r[1]); o4.y = cvtpk(r[2], r[3]); o4.z = cvtpk(r[4], r[5]); o4.w = cvtpk(r[6], r[7]);
        *(v4u*)((bf16*)(ws + WS_XC) + (size_t)row * 256 + h * 64 + ch0) = o4;
        *(LAS v4u*)(XS + l * ML_LD + ch0) = o4;
        const v4u v4 = *(const v4u*)(cm + (size_t)row * 768 + 256 + h * 64 + ch0);
        VT[(ch0 + 0) * ML_LD + l] = (bf16)(v4.x & 0xffffu); VT[(ch0 + 1) * ML_LD + l] = (bf16)(v4.x >> 16); VT[(ch0 + 2) * ML_LD + l] = (bf16)(v4.y & 0xffffu); VT[(ch0 + 3) * ML_LD + l] = (bf16)(v4.y >> 16);
        VT[(ch0 + 4) * ML_LD + l] = (bf16)(v4.z & 0xffffu); VT[(ch0 + 5) * ML_LD + l] = (bf16)(v4.z >> 16); VT[(ch0 + 6) * ML_LD + l] = (bf16)(v4.w & 0xffffu); VT[(ch0 + 7) * ML_LD + l] = (bf16)(v4.w >> 16);
    }
    {
        const int e = tid >> 3, d0 = (tid & 7) * 8;
        *(LAS v4u*)(WQ + e * ML_LD + d0) = *(const v4u*)((const bf16*)(ws + WT_QM) + h * 4096 + e * 64 + d0);
        *(LAS v4u*)(WK + e * ML_LD + d0) = *(const v4u*)((const bf16*)(ws + WT_KM) + h * 4096 + e * 64 + d0);
    }
    if (wave_u < 2) { ML_PTRS(wave_u)
        const float* mr = (const float*)(ws + WS_MISCRAW) + (size_t)(row0 + lane) * 64;
        const float z = mr[54 + h] + bfg[h]; float lf = fminf(z, 0.f) - __logf(1.f + __expf(-fabsf(z)));
        const float ig = mr[50 + h] + big[h];
#pragma unroll
        for (int o = 1; o < 64; o <<= 1) { const float t = bperm(lf, lane - o); if (lane >= o) lf += t; }
        const float bL = __int_as_float(__builtin_amdgcn_readlane(__float_as_int(lf), 63));
        const float a = bL - lf + ig; const float mx = wave_max2(a);
        wl[lane] = __expf(a - mx);
        if (lane == 0) { ((float*)(ws + WS_ML))[chunk] = mx; ((float*)(ws + WS_BL))[chunk] = bL; }
    }
    __syncthreads();
#pragma unroll
    for (int ch = 0; ch < 2; ++ch) { ML_PTRS(ch)
        const int lb = wave_u & 3; const bool isk = wave_u >= 4;
        const LAS bf16* Wt = isk ? WK : WQ;
        bf16* og = (bf16*)(ws + (isk ? WS_MK : WS_MQ)) + (size_t)(row0 + 16 * lb + 4 * (lane >> 4)) * 256 + h * 64 + (lane & 15);
        float w4[4];
#pragma unroll
        for (int r = 0; r < 4; ++r) w4[r] = wl[16 * lb + 4 * (lane >> 4) + r];
#pragma unroll
        for (int eb = 0; eb < 4; ++eb) {
            f32x4v acc = mm16(XS, ML_LD, 16 * lb, Wt, ML_LD, 16 * eb, 64, lane, f32x4v{});
            if (!isk) {
#pragma unroll
                for (int r = 0; r < 4; ++r) og[(size_t)r * 256 + 16 * eb] = f2bf(acc[r] * 0.125f);
            } else {
                bf16 kb[4];
#pragma unroll
                for (int r = 0; r < 4; ++r) { kb[r] = f2bf(acc[r]); og[(size_t)r * 256 + 16 * eb] = kb[r]; }
                u32x2v w2; w2.x = cvtpk(bf2f(kb[0]) * w4[0], bf2f(kb[1]) * w4[1]); w2.y = cvtpk(bf2f(kb[2]) * w4[2], bf2f(kb[3]) * w4[3]);
                *(LAS u32x2v*)(WKT + (16 * eb + (lane & 15)) * ML_LD + 16 * lb + 4 * (lane >> 4)) = w2;
            }
        }
    }
    __syncthreads();
#pragma unroll
    for (int ch = 0; ch < 2; ++ch) { ML_PTRS(ch)
        float* ct = (float*)(ws + WS_CT) + (size_t)chunk * 4096;
#pragma unroll
        for (int i = 0; i < 2; ++i) { const int blk = wave_u * 2 + i, eb = blk >> 2, db = blk & 3;
            const f32x4v acc = mm16(VT, ML_LD, 16 * eb, WKT, ML_LD, 16 * db, 64, lane, f32x4v{});
#pragma unroll
            for (int r = 0; r < 4; ++r) ct[(16 * eb + 4 * (lane >> 4) + r) * 64 + 16 * db + (lane & 15)] = acc[r]; }
    }
    if (tid < 128) { ML_PTRS(tid >> 6)
        const int d = tid & 63; float n = 0.f; const LAS bf16* wr_ = WKT + d * ML_LD;
        for (int l = 0; l < 64; ++l) n += bf2f(wr_[l]);
        ((float*)(ws + WS_NL))[chunk * 64 + d] = n; }
#undef ML_PTRS
    __syncthreads();
}
__device__ __forceinline__ void mscan_item(unsigned char* ws, int item, int wave_u) {
    const int tid = wave_u * 64 + fresh_lane();
    const int bh = item / 9, part = item % 9;
    if (part == 8 && tid >= 64) return;
    float* base; size_t stride;
    if (part < 8) { base = (float*)(ws + WS_CT) + (size_t)bh * 32 * 4096 + part * 512 + tid; stride = 4096; } else { base = (float*)(ws + WS_NL) + (size_t)bh * 32 * 64 + tid; stride = 64; }
    const float* ML = (const float*)(ws + WS_ML); const float* BL = (const float*)(ws + WS_BL); float* MPv = (float*)(ws + WS_MP);
    float cl[32];
#pragma unroll
    for (int c = 0; c < 32; ++c) cl[c] = base[(size_t)c * stride];
    float Cv = 0.f, m = 0.f;
#pragma unroll
    for (int c = 0; c < 32; ++c) {
        const float ml = ML[bh * 32 + c], bl = BL[bh * 32 + c];
        base[(size_t)c * stride] = Cv;
        if (part == 8 && tid == 0) MPv[bh * 32 + c] = m;
        const float mn = fmaxf(bl + m, ml);
        Cv = __expf(bl + m - mn) * Cv + __expf(ml - mn) * cl[c]; m = mn;
    }
}
constexpr int MO_STRIDE = 5 * 64 * ML_LD * 2 + 64 * 65 * 4 + 6 * 64 * 4;
__device__ __forceinline__ void mout_item(unsigned char* ws, LAS unsigned char* lds, const float* gmh, const float* skip, int chunk0, int wave_u) {
    const int lane = fresh_lane(), tid = wave_u * 64 + lane;
    const int h = (chunk0 >> 5) & 3, b = chunk0 >> 7;
    const float* gm = (const float*)(ws + WS_GM);
#define MO_PTRS(ch) const int chunk = chunk0 + (ch); const int row0 = b * S_ + (chunk & 31) * 64; LAS unsigned char* cb_ = lds + (ch) * MO_STRIDE; \
    LAS bf16* QS = (LAS bf16*)cb_; LAS bf16* KS = QS + 64 * ML_LD; LAS bf16* VT = KS + 64 * ML_LD; LAS bf16* CP = VT + 64 * ML_LD; LAS bf16* SW = CP + 64 * ML_LD; \
    LAS float* HS = (LAS float*)(SW + 64 * ML_LD); LAS float* bs = HS + 64 * 65; LAS float* us = bs + 64; LAS float* ns = us + 64; LAS float* mts = ns + 64; LAS float* ints = mts + 64; LAS float* dinv = ints + 64; \
    (void)row0; (void)QS; (void)KS; (void)VT; (void)CP; (void)SW; (void)HS; (void)bs; (void)us; (void)ns; (void)mts; (void)ints; (void)dinv; (void)chunk;
    {
        v4u gq[2], gk[2], gv[2]; f32x4v gc0[2], gc1[2];
        const int l = tid >> 3, c0 = (tid & 7) * 8;
#pragma unroll
        for (int ch = 0; ch < 2; ++ch) { MO_PTRS(ch) const int row = row0 + l;
            gq[ch] = *(const v4u*)((const bf16*)(ws + WS_MQ) + (size_t)row * 256 + h * 64 + c0); gk[ch] = *(const v4u*)((const bf16*)(ws + WS_MK) + (size_t)row * 256 + h * 64 + c0);
            gv[ch] = *(const v4u*)((const bf16*)(ws + WS_CM) + (size_t)row * 768 + 256 + h * 64 + c0);
            const float* ct = (const float*)(ws + WS_CT) + (size_t)chunk * 4096 + l * 64 + c0;
            gc0[ch] = *(const f32x4v*)ct; gc1[ch] = *(const f32x4v*)(ct + 4); }
        asm volatile("" : "+v"(gq[0]), "+v"(gq[1]), "+v"(gk[0]), "+v"(gk[1]), "+v"(gv[0]), "+v"(gv[1]), "+v"(gc0[0]), "+v"(gc0[1]), "+v"(gc1[0]), "+v"(gc1[1]));
#pragma unroll
        for (int ch = 0; ch < 2; ++ch) { MO_PTRS(ch)
            *(LAS v4u*)(QS + l * ML_LD + c0) = gq[ch]; *(LAS v4u*)(KS + l * ML_LD + c0) = gk[ch];
            const v4u v4 = gv[ch];
            VT[(c0 + 0) * ML_LD + l] = (bf16)(v4.x & 0xffffu); VT[(c0 + 1) * ML_LD + l] = (bf16)(v4.x >> 16); VT[(c0 + 2) * ML_LD + l] = (bf16)(v4.y & 0xffffu); VT[(c0 + 3) * ML_LD + l] = (bf16)(v4.y >> 16);
            VT[(c0 + 4) * ML_LD + l] = (bf16)(v4.z & 0xffffu); VT[(c0 + 5) * ML_LD + l] = (bf16)(v4.z >> 16); VT[(c0 + 6) * ML_LD + l] = (bf16)(v4.w & 0xffffu); VT[(c0 + 7) * ML_LD + l] = (bf16)(v4.w >> 16);
            const f32x4v c0v = gc0[ch], c1v = gc1[ch];
            v4u cw; cw.x = cvtpk(c0v[0], c0v[1]); cw.y = cvtpk(c0v[2], c0v[3]); cw.z = cvtpk(c1v[0], c1v[1]); cw.w = cvtpk(c1v[2], c1v[3]);
            *(LAS v4u*)(CP + l * ML_LD + c0) = cw; }
    }
    if (wave_u < 2) { MO_PTRS(wave_u)
        const float ig = gm[(size_t)(row0 + lane) * 32 + 18 + h]; float lf = gm[(size_t)(row0 + lane) * 32 + 22 + h];
#pragma unroll
        for (int o = 1; o < 64; o <<= 1) { const float t = bperm(lf, lane - o); if (lane >= o) lf += t; }
        const float u = ig - lf; float cu = u;
#pragma unroll
        for (int o = 1; o < 64; o <<= 1) { const float t = bperm(cu, lane - o); if (lane >= o) cu = fmaxf(cu, t); }
        const float mprev = ((const float*)(ws + WS_MP))[chunk];
        const float mt = lf + fmaxf(mprev, cu);
        bs[lane] = lf; us[lane] = u; mts[lane] = mt; ints[lane] = __expf(lf + mprev - mt); ns[lane] = ((const float*)(ws + WS_NL))[chunk * 64 + lane];
    }
    __syncthreads();
#pragma unroll
    for (int ch = 0; ch < 2; ++ch) { MO_PTRS(ch)
#pragma unroll
        for (int i = 0; i < 2; ++i) { const int blk = wave_u * 2 + i, lb = blk >> 2, sb = blk & 3;
            f32x4v acc = f32x4v{};
            if (sb <= lb) acc = mm16(QS, ML_LD, 16 * lb, KS, ML_LD, 16 * sb, 64, lane, acc);
            const int sidx = 16 * sb + (lane & 15); const float usv = us[sidx];
#pragma unroll
            for (int r = 0; r < 4; ++r) { const int l = 16 * lb + 4 * (lane >> 4) + r;
                const float v = (sidx <= l) ? acc[r] * __expf(bs[l] + usv - mts[l]) : 0.f;
                SW[l * ML_LD + sidx] = f2bf(v); } }
    }
    __syncthreads();
    if (tid < 128) { MO_PTRS(tid >> 6)
        const int l = tid & 63; float qn = 0.f, ssum = 0.f;
        for (int d = 0; d < 64; ++d) { qn += bf2f(QS[l * ML_LD + d]) * ns[d]; ssum += bf2f(SW[l * ML_LD + d]); }
        const float den = ints[l] * qn + ssum;
        dinv[l] = 1.f / fmaxf(fabsf(den), __expf(-mts[l]));
    }
    f32x4v hq[2][2], hs2[2][2];
#pragma unroll
    for (int ch = 0; ch < 2; ++ch) { MO_PTRS(ch)
#pragma unroll
        for (int i = 0; i < 2; ++i) { const int blk = wave_u * 2 + i, lb = blk >> 2, eb = blk & 3;
            hq[ch][i] = mm16(QS, ML_LD, 16 * lb, CP, ML_LD, 16 * eb, 64, lane, f32x4v{});
            hs2[ch][i] = mm16(SW, ML_LD, 16 * lb, VT, ML_LD, 16 * eb, 16 * lb + 16 <= 32 ? 32 : 64, lane, f32x4v{}); }
    }
    __syncthreads();
#pragma unroll
    for (int ch = 0; ch < 2; ++ch) { MO_PTRS(ch)
#pragma unroll
        for (int i = 0; i < 2; ++i) { const int blk = wave_u * 2 + i, lb = blk >> 2, eb = blk & 3; const int e = 16 * eb + (lane & 15);
#pragma unroll
            for (int r = 0; r < 4; ++r) { const int l = 16 * lb + 4 * (lane >> 4) + r;
                const float og = bf2f(((const bf16*)(ws + WS_CM))[(size_t)(row0 + l) * 768 + 512 + h * 64 + e]);
                HS[l * 65 + e] = (ints[l] * hq[ch][i][r] + hs2[ch][i][r]) * dinv[l] / (1.f + __expf(-og)); } }
    }
    __syncthreads();
#pragma unroll
    for (int ch = 0; ch < 2; ++ch) { MO_PTRS(ch)
        const int l = tid >> 3, e0 = (tid & 7) * 8, row = row0 + l;
        float v[8]; float mu = 0.f;
#pragma unroll
        for (int i = 0; i < 8; ++i) { v[i] = HS[l * 65 + e0 + i]; mu += v[i]; }
        mu += sxf<1>(mu); mu += sxf<2>(mu); mu += sxf<4>(mu); mu *= (1.f / 64.f);
        float var = 0.f;
#pragma unroll
        for (int i = 0; i < 8; ++i) { const float dl = v[i] - mu; var += dl * dl; }
        var += sxf<1>(var); var += sxf<2>(var); var += sxf<4>(var);
        const float rs = rsqrtf(var * (1.f / 64.f) + EPS);
        const v4u x4 = *(const v4u*)((const bf16*)(ws + WS_XC) + (size_t)row * 256 + h * 64 + e0);
        float xv[8]; xv[0] = __uint_as_float(x4.x << 16); xv[1] = __uint_as_float(x4.x & 0xffff0000u); xv[2] = __uint_as_float(x4.y << 16); xv[3] = __uint_as_float(x4.y & 0xffff0000u);
        xv[4] = __uint_as_float(x4.z << 16); xv[5] = __uint_as_float(x4.z & 0xffff0000u); xv[6] = __uint_as_float(x4.w << 16); xv[7] = __uint_as_float(x4.w & 0xffff0000u);
        float r[8];
#pragma unroll
        for (int i = 0; i < 8; ++i) r[i] = (v[i] - mu) * rs * gmh[h * 64 + e0 + i] + skip[h * 64 + e0 + i] * xv[i];
        v4u w4; w4.x = cvtpk(r[0], r[1]); w4.y = cvtpk(r[2], r[3]); w4.z = cvtpk(r[4], r[5]); w4.w = cvtpk(r[6], r[7]);
        *(v4u*)((bf16*)(ws + WS_HB) + (size_t)row * D_ + 768 + h * 64 + e0) = w4;
    }
#undef MO_PTRS
    __syncthreads();
}

__global__ void __launch_bounds__(NTHR, 2) mega(MP p_unused) {
    extern __shared__ __attribute__((aligned(16))) unsigned char lds_raw[];
    LAS unsigned char* lds = (LAS unsigned char*)lds_raw;
    const int wave0 = __builtin_amdgcn_readfirstlane((int)threadIdx.x >> 6);
    const int tid0 = wave0 * 64 + fresh_lane();
    const int xcc = (int)(__builtin_amdgcn_s_getreg((3 << 11) | 20) & 7u);
    volatile LAS unsigned* MISC = (volatile LAS unsigned*)(lds + MISC_OFF);
    for (int u = tid0; u < (LDS_BYTES - RING_BYTES) / 4; u += NTHR) ((LAS unsigned*)(lds + RING_BYTES))[u] = 0u;
    __syncthreads();
    typedef const __attribute__((address_space(4))) MP* kmp_t;
    kmp_t kp0 = (kmp_t)__builtin_amdgcn_kernarg_segment_ptr();
    unsigned char* ws0 = kp0->ws; const int coop = kp0->coop, ph_lo = kp0->ph_lo, ph_hi = kp0->ph_hi;
    XcdBarrier bar; bar.bar = (unsigned*)(ws0 + WS_CTL) + CW_BAR; bar.x = 0; bar.st = nullptr;
    if (coop) bar = xcd_barrier_post((unsigned*)(ws0 + WS_CTL) + CW_BAR, MISC + 8, tid0);
    if (coop == 2) cooperative_groups::this_grid().sync();
    int ph = ph_lo;
    if (ph == 0) {
        const MPK p{kp0}; ph_p0(p, lds, wave0 * 64 + fresh_lane()); ph = 1;
        if (ph < ph_hi) xcd_barrier(bar, wave0 * 64 + fresh_lane());
    }
    bool second = false;
    for (; ph < ph_hi; ++ph) {
        kmp_t kp = kp0; asm volatile("" : "+s"(kp));
        const MPK p{kp}; unsigned char* ws = kp->ws;
#define TID_ (wave0 * 64 + fresh_lane())
#define GW_ (blockIdx.x * NWAVES + wave0)
#define NGW_ (gridDim.x * NWAVES)
        const int l = (ph - 1) / PPL, ty = (ph == 0) ? -1 : (ph == NPH - 1) ? -2 : (ph - 1) % PPL;
        const float* modl = (const float*)(ws + WS_MOD) + (size_t)l * 8 * 6144;
        if (ty == -2) { norm_rows(p.k->out, PIN(I_GFIN), nullptr, nullptr, nullptr, p.k->out, 2, GW_, NGW_, fresh_lane());
            if (PROBE_SEL != 0 && blockIdx.x == 0 && TID_ == 0) { asm volatile("s_waitcnt vmcnt(0)" ::: "memory"); p.k->out[0] = ((const float*)(ws + WS_CTL))[100] * 0.001f; } }
        else if (ty == 0 && (PHM & 2)) ph_prep(p, l, lds, TID_);
        else if (ty == 1 && (PHM & 4)) {
            pg8::Gemm g{(const bf16*)(ws + WS_HB), (const bf16*)(ws + WT_IN), T_, 2560, D_}; pg8::StaticOrder S; S.init(T_, 2560, gridDim.x, blockIdx.x);
            pg8::EpiIn E{ws, PIN(I_BIG) + l * 4, PIN(I_BFG) + l * 4};
            pg8::gemm_phase<pg8::EpiIn, pg8::StaticOrder, true, true>(lds, g, S, E, wave0);
            late_transposes(p, l, lds, TID_, 640 % (int)gridDim.x);
        }
        else if (ty == 2 && (PHM & 64)) {
            { pg8::Gemm g{(const bf16*)(ws + WS_KVL), (const bf16*)(ws + WT_UKV), T_, 768, 128}; pg8::StaticOrder S; S.init(T_, 768, gridDim.x, blockIdx.x);
              pg8::EpiUKV E{(bf16*)(ws + WS_KVM), (const float*)(ws + WS_SSKV)}; pg8::gemm_phase<pg8::EpiUKV, pg8::StaticOrder, true, true>(lds, g, S, E, wave0); }
            { pg8::Gemm g{(const bf16*)(ws + WS_QL), (const bf16*)(ws + WT_UQ), T_, 768, 256}; pg8::StaticOrder S; S.init(T_, 768, gridDim.x, blockIdx.x);
              pg8::EpiPlain E{(bf16*)(ws + WS_OSLC), 768}; pg8::gemm_phase<pg8::EpiPlain, pg8::StaticOrder, true, true>(lds, g, S, E, wave0); }
            post_misc(ws, PIN(I_BIG) + l * 4, PIN(I_BFG) + l * 4, TID_);
            unsigned* ctrs = (unsigned*)(ws + WS_CTL) + 8192 + ph * 256 + (second ? 128 : 0); int ks = 0;
            for (;;) { const int it = next_item_q(ctrs, lds, wave0, 96, xcc, ks); if (it < 0) break; const int b = it >> 16, j = it & 0xffff;
                if (j < 64) mlocal_item(ws, lds, PIN(I_CONVW) + l * 1024, PIN(I_CONVB) + l * 256, PIN(I_BIG) + l * 4, PIN(I_BFG) + l * 4, b * 128 + 2 * j, wave0);
                else { const int k = j - 64; compress_item(ws, lds, PIN(I_CMPPOS) + l * 2048, ((k >> 4) << 7) | (b << 4) | (k & 15), wave0); } }
        }
        else if (ty == 3 && (PHM & 128)) {
            unsigned* ctrs = (unsigned*)(ws + WS_CTL) + 8192 + ph * 256 + (second ? 128 : 0); int ks = 0;
            for (;;) { const int it = next_item_q(ctrs, lds, wave0, second ? 64 : 100, xcc, ks); if (it < 0) break; const int b = it >> 16, j = it & 0xffff;
                if (second && (REP_MASK & (1 << 20)) && j >= 48) continue; if (second && (REP_MASK & (1 << 21)) && j < 48) continue;
                if (j < 18) mla_unit(ws, lds, b, j % 6, 7 - j / 6, wave0);
                else if (j < 34) cmp_unit(ws, lds, b, (j - 18) >> 3, 7 - ((j - 18) & 7), wave0);
                else if (j < 64) { const int u = j - 16; mla_unit(ws, lds, b, u % 6, 7 - u / 6, wave0); }
                else mscan_item(ws, b * 36 + (j - 64), wave0); }
        }
        else if (ty == 4 && (PHM & 256)) {
            unsigned* ctrs = (unsigned*)(ws + WS_CTL) + 8192 + ph * 256 + (second ? 128 : 0); int ks = 0;
            for (;;) { const int it = next_item_q(ctrs, lds, wave0, 160, xcc, ks); if (it < 0) break; const int b = it >> 16, j = it & 0xffff;
                if (second && (REP_MASK & (1 << 16)) && j >= 96) continue; if (second && (REP_MASK & (1 << 17)) && j < 96) continue;
                if (j < 36) nsa_branch_unit<AM_SLC>(ws, lds, b, j % 6, 7 - j / 6, wave0);
                else if (j < 84) nsa_branch_unit<AM_WINDOW>(ws, lds, b, (j - 36) % 6, 7 - (j - 36) / 6, wave0);
                else if (j < 96) { const int u = j - 48; nsa_branch_unit<AM_SLC>(ws, lds, b, u % 6, 7 - u / 6, wave0); }
                else mout_item(ws, lds, PIN(I_GMH) + l * 256, PIN(I_SKIP) + l * 256, b * 128 + 2 * (j - 96), wave0); }
        }
        else if (ty == 5) ph_mixnorm(p, l, TID_);
        else if (ty == 6 && (PHM & 8)) {
            pg8::Gemm g{(const bf16*)(ws + WS_HB), (const bf16*)(ws + WT_OUT), T_, D_, D_}; pg8::StaticOrder S; S.init(T_, D_, gridDim.x, blockIdx.x);
            pg8::EpiRes E{(l == 0) ? PIN(I_X) : p.k->out, p.k->out, modl + 2048};
            pg8::gemm_phase<pg8::EpiRes, pg8::StaticOrder, true, true>(lds, g, S, E, wave0);
        }
        else if (ty == 7) norm_rows(p.k->out, PIN(I_GN2) + l * D_, modl + 3072, modl + 4096, (bf16*)(ws + WS_HB), nullptr, 1, GW_, NGW_, fresh_lane());
        else if (ty == 8 && (PHM & 16)) {
            pg8::Gemm g{(const bf16*)(ws + WS_HB), (const bf16*)(ws + WT_GU), T_, 2 * FF, D_}; pg8::StaticOrder S; S.init(T_, 2 * FF, gridDim.x, blockIdx.x);
            pg8::EpiGU E{(bf16*)(ws + WS_ACT)};
            pg8::gemm_phase<pg8::EpiGU, pg8::StaticOrder, true, true>(lds, g, S, E, wave0);
            if (l + 1 < DEPTH) early_transposes(p, l + 1, lds, TID_, 1408 % (int)gridDim.x);
        }
        else if (ty == 9 && (PHM & 32)) {
            pg8::Gemm g{(const bf16*)(ws + WS_ACT), (const bf16*)(ws + WT_DOWN), T_, D_, FF}; pg8::StaticOrder S; S.init(T_, D_, gridDim.x, blockIdx.x);
            pg8::EpiRes E{p.k->out, p.k->out, modl + 5120};
            pg8::gemm_phase<pg8::EpiRes, pg8::StaticOrder, true, true>(lds, g, S, E, wave0);
        }
        if (REP_MASK != 0 && ty >= 0 && ((REP_MASK >> ty) & 1) && !second) { second = true; --ph; } else second = false;
        if (ph + 1 < ph_hi) xcd_barrier(bar, wave0 * 64 + fresh_lane());
    }
}

extern "C" void kernel_launch(void* const* d_in, const int* in_sizes, int n_in, void* d_out, int out_size, void* d_ws, size_t ws_size, hipStream_t stream) {
    if (n_in != N_IN || ws_size < WS_END) { fprintf(stderr, "kernel_launch: unexpected n_in %d / ws %zu\n", n_in, ws_size); return; }
    static int inited = 0;
    if (!inited) { if (hipFuncSetAttribute((const void*)mega, hipFuncAttributeMaxDynamicSharedMemorySize, LDS_BYTES) != hipSuccess) fprintf(stderr, "hipFuncSetAttribute failed\n"); inited = 1; }
    unsigned char* ws = (unsigned char*)d_ws;
    MP base{}; for (int i = 0; i < N_IN; ++i) base.in[i] = (const float*)d_in[i]; base.out = (float*)d_out; base.ws = ws;
    (void)hipMemsetAsync(ws + WS_CTL, 0, CTL_ZERO_BYTES, stream);
    static int grid = 0;
    if (!grid) {
        int dev = 0, cus = 0, per_cu = 0;
        (void)hipGetDevice(&dev); (void)hipDeviceGetAttribute(&cus, hipDeviceAttributeMultiprocessorCount, dev);
        if (hipOccupancyMaxActiveBlocksPerMultiprocessor(&per_cu, (const void*)mega, NTHR, LDS_BYTES) != hipSuccess || per_cu < 1) { fprintf(stderr, "kernel_launch: occupancy query says %d blocks per CU\n", per_cu); per_cu = 1; }
        (void)hipGetLastError();
        grid = cus;
    }
    MP a = base; a.ph_lo = 0; a.ph_hi = NPH; a.coop = 1;
    void* args[] = {&a};
    const hipError_t e = hipLaunchCooperativeKernel((const void*)mega, dim3(grid), dim3(NTHR), args, LDS_BYTES, stream);
    if (e != hipSuccess) fprintf(stderr, "kernel_launch: cooperative launch failed: %s (grid %d)\n", hipGetErrorString(e), grid);
}
```

```cpp
#include <hip/hip_runtime.h>
#include <cstdint>
#include <cstdio>
#include <hip/hip_cooperative_groups.h>

constexpr int B_ = 8, S_ = 2048, T_ = B_ * S_, D_ = 1024, DIN = 2362, FF = 2816, DEPTH = 2;
constexpr float EPS = 1e-6f;
constexpr float LOG2E = 1.4426950408889634f;
constexpr float QSCALE = 0.125f * LOG2E;
constexpr float MSCALE = 0.10206207261596577f * LOG2E;
enum { I_X = 0, I_C, I_POS, I_GN1, I_GN2, I_WADA, I_BADA, I_WIN, I_CMPPOS, I_WCK, I_WCV, I_GOA, I_GQL, I_WUQ, I_GKVL, I_WUKV, I_GOB,
       I_CONVW, I_CONVB, I_WQM, I_WKM, I_BIG, I_BFG, I_GMH, I_SKIP, I_WOUT, I_WGU, I_WDOWN, I_GFIN, N_IN };

constexpr size_t MiB = 1u << 20;
constexpr size_t WS_CTL = 0;
constexpr size_t WS_MOD = 1 * MiB;
constexpr size_t WS_COSP = WS_MOD + 512 * 1024;
constexpr size_t WS_SINP = WS_COSP + 512 * 1024;
constexpr size_t WS_COSM = WS_SINP + 512 * 1024;
constexpr size_t WS_SINM = WS_COSM + 1 * MiB;
constexpr size_t WS_SSQL = WS_SINM + 1 * MiB;
constexpr size_t WS_SSKV = WS_SSQL + 64 * 1024;
constexpr size_t WS_ML = WS_SSKV + 64 * 1024;
constexpr size_t WS_BL = WS_ML + 4096;
constexpr size_t WS_MP = WS_BL + 4096;
constexpr size_t WS_NL = WS_MP + 4096;
constexpr size_t WS_WT = 8 * MiB;
constexpr size_t WS_RAW = WS_WT;
constexpr size_t WS_HB = 34 * MiB;
constexpr size_t WS_NSA = 66 * MiB;
constexpr size_t WS_KVL = 102 * MiB;
constexpr size_t WS_QL = 106 * MiB;
constexpr size_t WS_CM = 114 * MiB;
constexpr size_t WS_GM = 138 * MiB;
constexpr size_t WS_KM = 140 * MiB;
constexpr size_t WS_QM = 158 * MiB;
constexpr size_t WS_VM = 176 * MiB;
constexpr size_t WS_KCV = 188 * MiB;
constexpr size_t WS_OCMP = 189 * MiB;
constexpr size_t WS_SEL = 201 * MiB;
constexpr size_t WS_XC = 202 * MiB;
constexpr size_t WS_MQ = 210 * MiB;
constexpr size_t WS_MK = 218 * MiB;
constexpr size_t WS_CT = 226 * MiB;
constexpr size_t WS_MISCRAW = 242 * MiB;
constexpr size_t WS_KVM = 140 * MiB;
constexpr size_t WS_KR = 246 * MiB;
constexpr size_t WS_OSLC = 164 * MiB;
constexpr size_t WS_OWIN = 176 * MiB;
constexpr size_t WS_ACT = 66 * MiB;
constexpr size_t WS_END = 256 * MiB;
static_assert(WS_NL + 1024 * 64 * 4 <= WS_WT, "tab");
static_assert(WS_ACT + (size_t)T_ * FF * 2 <= WS_KCV, "act overlay");

typedef unsigned short bf16;
__device__ __forceinline__ float bf2f(bf16 v) { return __uint_as_float(((unsigned)v) << 16); }
__device__ __forceinline__ bf16 f2bf(float f) { unsigned u = __float_as_uint(f); return (bf16)((u + 0x7fffu + ((u >> 16) & 1u)) >> 16); }
__device__ __forceinline__ float sigmoidf_(float x) { return 1.f / (1.f + __expf(-x)); }
__device__ __forceinline__ float siluf_(float x) { return x / (1.f + __expf(-x)); }
__device__ __forceinline__ float wave_sum(float v) {
#pragma unroll
    for (int o = 1; o < 64; o <<= 1) v += __shfl_xor(v, o);
    return v;
}

__device__ __forceinline__ int fresh_lane() { int l; asm volatile("v_mbcnt_lo_u32_b32 %0, -1, 0\n\tv_mbcnt_hi_u32_b32 %0, -1, %0" : "=&v"(l)); return l; }
template <int M> __device__ __forceinline__ float sxf(float v) { static_assert(M >= 1 && M < 32, "swizzle xor mask"); return __int_as_float(__builtin_amdgcn_ds_swizzle(__float_as_int(v), (M << 10) | 0x1f)); }
__device__ __forceinline__ float red32_max(float v) { auto r = __builtin_amdgcn_permlane32_swap(__float_as_uint(v), __float_as_uint(v), false, false); return fmaxf(__uint_as_float(r[0]), __uint_as_float(r[1])); }
__device__ __forceinline__ float red32_sum(float v) { auto r = __builtin_amdgcn_permlane32_swap(__float_as_uint(v), __float_as_uint(v), false, false); return __uint_as_float(r[0]) + __uint_as_float(r[1]); }
__device__ __forceinline__ unsigned red32_or(unsigned v) { auto r = __builtin_amdgcn_permlane32_swap(v, v, false, false); return r[0] | r[1]; }
__device__ __forceinline__ float bperm(float v, int src_lane) { return __int_as_float(__builtin_amdgcn_ds_bpermute(src_lane << 2, __float_as_int(v))); }
__device__ __forceinline__ float wave_sum2(float v) { v += sxf<1>(v); v += sxf<2>(v); v += sxf<4>(v); v += sxf<8>(v); v += sxf<16>(v); return red32_sum(v); }
__device__ __forceinline__ float wave_max2(float v) { v = fmaxf(v, sxf<1>(v)); v = fmaxf(v, sxf<2>(v)); v = fmaxf(v, sxf<4>(v)); v = fmaxf(v, sxf<8>(v)); v = fmaxf(v, sxf<16>(v)); return red32_max(v); }
namespace pg8 {
#define PG8_LAS __attribute__((address_space(3)))
typedef unsigned short bf16_t;
typedef short bf16x8 __attribute__((ext_vector_type(8)));
typedef float f32x4 __attribute__((ext_vector_type(4)));
typedef unsigned u32x4 __attribute__((ext_vector_type(4)));
constexpr int BM = 256, BK = 64, HALF = 128, HTB = HALF * BK * 2  , STAGE_BYTES = 8 * HTB, NXCD = 8, WGM = 8;

__host__ __device__ __forceinline__ int lds_byte(int r, int c) { const int st = (r >> 4) * 2 + (c >> 5), rr = r & 15, cc = c & 31, ob = rr * 64 + cc * 2; return st * 1024 + (ob ^ (((ob >> 9) & 1) << 5)); }
__host__ __device__ __forceinline__ void stage_rc(int b, int& R, int& C) { const int st = b / 1024, sb = b % 1024, swz = sb ^ (((sb >> 9) & 1) << 5); R = (st >> 1) * 16 + swz / 64; C = (st & 1) * 32 + (swz % 64) / 2; }
__host__ __device__ __forceinline__ int perm32(int rho) { const int n = rho >> 4, i = rho & 15; return 8 * (i >> 2) + 4 * n + (i & 3); }

struct Unit { int pm, pn; };
struct Gemm { const bf16_t* A; const bf16_t* Bt; int M, N, K; };

struct StaticOrder {
    int nM, nN, nwg, G, c;
    __host__ __device__ void init(int M, int N, int G_, int c_) { nM = M / BM; nN = N / BM; nwg = nM * nN; G = G_; c = c_; }
    __host__ __device__ bool next(int i, Unit& u) const {
        const long L = (long)i * G + c; if (L >= nwg) return false;
        int wgid = (int)L; { const int q = nwg / NXCD, r = nwg % NXCD, xcd = wgid % NXCD, off = wgid / NXCD; wgid = (xcd < r ? xcd * (q + 1) : r * (q + 1) + (xcd - r) * q) + off; }
        const int nig = WGM * nN, gid = wgid / nig, fm = gid * WGM, gsz = (nM - fm) < WGM ? (nM - fm) : WGM;
        u.pm = fm + ((wgid % nig) % gsz); u.pn = (wgid % nig) / gsz; return true;
    }
    __device__ __forceinline__ void a_ready(const Unit&) const {}
    __device__ __forceinline__ void done(const Unit&) const {}
};

__device__ __forceinline__ unsigned cvt_pk_bf16(float lo, float hi) { unsigned r; asm volatile("v_cvt_pk_bf16_f32 %0, %1, %2" : "=v"(r) : "v"(lo), "v"(hi)); return r; }
typedef float f32x2 __attribute__((ext_vector_type(2)));

typedef unsigned u32x4 __attribute__((ext_vector_type(4)));
typedef unsigned u32x2 __attribute__((ext_vector_type(2)));
struct EpiIn {
    static constexpr bool PERM = true, AFTER_DRAIN = false;
    unsigned char* ws; const float *big, *bfg;
#define EPI_ROWS(...) _Pragma("unroll") for (int ai = 0; ai < 2; ++ai) _Pragma("unroll") for (int m = 0; m < 4; ++m) { \
        const int row = u.pm * BM + ai * HALF + wr * 64 + m * 16 + fr; float v[8]; \
        _Pragma("unroll") for (int i = 0; i < 4; ++i) { v[i] = acc[ai][bj][m][0][i]; v[4 + i] = acc[ai][bj][m][1][i]; } \
        asm volatile("" : "+v"(v[0]), "+v"(v[1]), "+v"(v[2]), "+v"(v[3]), "+v"(v[4]), "+v"(v[5]), "+v"(v[6]), "+v"(v[7])); \
        __VA_ARGS__ asm volatile("" ::: "memory"); }
#define EPI_PACK(w) u32x4 w; w.x = cvt_pk_bf16(v[0], v[1]); w.y = cvt_pk_bf16(v[2], v[3]); w.z = cvt_pk_bf16(v[4], v[5]); w.w = cvt_pk_bf16(v[6], v[7]);
    __device__ __forceinline__ void operator()(const f32x4 (&acc)[2][2][4][2], const Unit& u, int wr, int wc, int fr, int fq) const {
        half<0>(acc, u, wr, wc, fr, fq); half<1>(acc, u, wr, wc, fr, fq);
    }
    template <int bj> __device__ __forceinline__ void half(const f32x4 (&acc)[2][2][4][2], const Unit& u, int wr, int wc, int fr, int fq) const {
        {
            const int hb = 2 * u.pn + bj;
            int cb = 32 * wc + 8 * fq; asm volatile("" : "+v"(cb), "+v"(fr));
            if (hb <= 8) {
                bf16_t* nsa = (bf16_t*)(ws + WS_NSA) + hb * 128 + cb;
                const bool rope_hb = (hb <= 3) || hb == 5 || hb == 7;
                if (rope_hb) {
                    const float* cosP = (const float*)(ws + WS_COSP); const float* sinP = (const float*)(ws + WS_SINP);
                    const bool mine = ((wc & 1) == 0) && fq < 2; const float sg = (fq == 0) ? -1.f : 1.f; const float sc = (hb < 3) ? QSCALE : 1.f;
                    f32x4 tc0 = {0.f, 0.f, 0.f, 0.f}, tc1 = tc0, ts0 = tc0, ts1 = tc0;
                    if (mine) { const int r0 = u.pm * BM + wr * 64 + fr; tc0 = *(const f32x4*)(cosP + r0 * 8); tc1 = *(const f32x4*)(cosP + r0 * 8 + 4); ts0 = *(const f32x4*)(sinP + r0 * 8); ts1 = *(const f32x4*)(sinP + r0 * 8 + 4); }
                    EPI_ROWS({
                        float pv[8];
                        _Pragma("unroll") for (int i = 0; i < 8; ++i) pv[i] = sxf<16>(v[i]);
                        const f32x4 c0 = tc0, c1 = tc1, s0 = ts0, s1 = ts1;
                        if (mine && (ai * 4 + m) < 7) { const int nx = ai * 4 + m + 1; const int rn = u.pm * BM + (nx >> 2) * HALF + wr * 64 + (nx & 3) * 16 + fr;
                            tc0 = *(const f32x4*)(cosP + rn * 8); tc1 = *(const f32x4*)(cosP + rn * 8 + 4); ts0 = *(const f32x4*)(sinP + rn * 8); ts1 = *(const f32x4*)(sinP + rn * 8 + 4); }
                        if (mine) {
                            _Pragma("unroll") for (int i = 0; i < 4; ++i) { v[i] = v[i] * c0[i] + sg * pv[i] * s0[i]; v[4 + i] = v[4 + i] * c1[i] + sg * pv[4 + i] * s1[i]; }
                        }
                        _Pragma("unroll") for (int i = 0; i < 8; ++i) v[i] *= sc;
                        EPI_PACK(w) *(u32x4*)(nsa + (size_t)row * 1152) = w;
                    })
                } else {
                    EPI_ROWS({ EPI_PACK(w) *(u32x4*)(nsa + (size_t)row * 1152) = w; })
                }
            } else if (hb <= 11) {
                bf16_t* dst = (hb == 9) ? (bf16_t*)(ws + WS_KVL) + cb : (bf16_t*)(ws + WS_QL) + (hb - 10) * 128 + cb;
                const int ld = (hb == 9) ? 128 : 256;
                float* ssq = (hb == 9) ? (float*)(ws + WS_SSKV) : (float*)(ws + WS_SSQL);
                EPI_ROWS({ EPI_PACK(w) *(u32x4*)(dst + (size_t)row * ld) = w;
                    float sq = 0.f;
                    _Pragma("unroll") for (int i = 0; i < 8; ++i) sq += v[i] * v[i];
                    sq += sxf<16>(sq); sq = red32_sum(sq);
                    if (fq == 0) atomicAdd(ssq + row, sq); })
            } else if (hb <= 17) {
                bf16_t* cm = (bf16_t*)(ws + WS_CM) + (hb - 12) * 128 + cb;
                EPI_ROWS({ EPI_PACK(w) *(u32x4*)(cm + (size_t)row * 768) = w; })
            } else if (hb == 18) {
                float* mr = (float*)(ws + WS_MISCRAW) + cb;
                if (wc < 2) { EPI_ROWS({ *(f32x4*)(mr + (size_t)row * 64) = (f32x4){v[0], v[1], v[2], v[3]}; *(f32x4*)(mr + (size_t)row * 64 + 4) = (f32x4){v[4], v[5], v[6], v[7]}; }) }
            }
        }
    }
#undef EPI_ROWS
#undef EPI_PACK
};
struct EpiUKV {
    static constexpr bool PERM = true, AFTER_DRAIN = false;
    bf16_t* kvm; const float* sskv;
    __device__ __forceinline__ void operator()(const f32x4 (&acc)[2][2][4][2], const Unit& u, int wr, int wc, int fr, int fq) const {
        asm volatile("" : "+v"(fq), "+v"(fr));
        const int col0 = u.pn * BM + wc * 32 + 8 * fq;
        float rs8[8];
#pragma unroll
        for (int i = 0; i < 8; ++i) rs8[i] = sskv[u.pm * BM + (i >> 2) * HALF + wr * 64 + (i & 3) * 16 + fr];
#pragma unroll
        for (int i = 0; i < 8; ++i) rs8[i] = rsqrtf(rs8[i] * (1.f / 128.f) + EPS);
#pragma unroll
        for (int ai = 0; ai < 2; ++ai)
#pragma unroll
            for (int m = 0; m < 4; ++m) { const int row = u.pm * BM + ai * HALF + wr * 64 + m * 16 + fr; bf16_t* rowp = kvm + (size_t)row * 768 + col0;
                const float rs = rs8[ai * 4 + m];
#pragma unroll
                for (int bj = 0; bj < 2; ++bj) { const f32x4 a = acc[ai][bj][m][0] * rs, b = acc[ai][bj][m][1] * rs;
                    u32x4 w; w.x = cvt_pk_bf16(a[0], a[1]); w.y = cvt_pk_bf16(a[2], a[3]); w.z = cvt_pk_bf16(b[0], b[1]); w.w = cvt_pk_bf16(b[2], b[3]);
                    *(u32x4*)(rowp + bj * HALF) = w; } }
    }
};
struct EpiPlain {
    static constexpr bool PERM = true, AFTER_DRAIN = false;
    bf16_t* out; int ld;
    __device__ __forceinline__ void operator()(const f32x4 (&acc)[2][2][4][2], const Unit& u, int wr, int wc, int fr, int fq) const {
        asm volatile("" : "+v"(fq), "+v"(fr));
        const int col0 = u.pn * BM + wc * 32 + 8 * fq;
#pragma unroll
        for (int ai = 0; ai < 2; ++ai)
#pragma unroll
            for (int m = 0; m < 4; ++m) { bf16_t* rowp = out + (size_t)(u.pm * BM + ai * HALF + wr * 64 + m * 16 + fr) * ld + col0;
#pragma unroll
                for (int bj = 0; bj < 2; ++bj) { const f32x4 a = acc[ai][bj][m][0], b = acc[ai][bj][m][1];
                    u32x4 w; w.x = cvt_pk_bf16(a[0], a[1]); w.y = cvt_pk_bf16(a[2], a[3]); w.z = cvt_pk_bf16(b[0], b[1]); w.w = cvt_pk_bf16(b[2], b[3]);
                    *(u32x4*)(rowp + bj * HALF) = w; } }
    }
};
struct EpiRes {
    static constexpr bool PERM = false, AFTER_DRAIN = false;
    const float* xin; float* xout; const float* gate;
    __device__ __forceinline__ void operator()(const f32x4 (&acc)[2][2][4][2], const Unit& u, int wr, int wc, int fr, int fq) const {
        asm volatile("" : "+v"(fq), "+v"(fr));
        const int b = (u.pm * BM) / S_; const int col0 = u.pn * BM + wc * 32 + 4 * fq;
        f32x4 gv[2][2];
#pragma unroll
        for (int bj = 0; bj < 2; ++bj)
#pragma unroll
            for (int n = 0; n < 2; ++n) gv[bj][n] = *(const f32x4*)(gate + (size_t)b * 6144 + col0 + bj * HALF + n * 16);
#pragma unroll
        for (int ai = 0; ai < 2; ++ai)
#pragma unroll
            for (int m = 0; m < 4; ++m) { const size_t off = (size_t)(u.pm * BM + ai * HALF + wr * 64 + m * 16 + fr) * D_ + col0;
#pragma unroll
                for (int bj = 0; bj < 2; ++bj)
#pragma unroll
                    for (int n = 0; n < 2; ++n) { const f32x4 xi = *(const f32x4*)(xin + off + bj * HALF + n * 16); *(f32x4*)(xout + off + bj * HALF + n * 16) = xi + gv[bj][n] * acc[ai][bj][m][n]; } }
    }
};
struct EpiGU {
    static constexpr bool PERM = true, AFTER_DRAIN = false;
    bf16_t* act;
    __device__ __forceinline__ void operator()(const f32x4 (&acc)[2][2][4][2], const Unit& u, int wr, int wc, int fr, int fq) const {
        asm volatile("" : "+v"(fq), "+v"(fr));
        const int col0 = u.pn * HALF + wc * 32 + 8 * fq;
#pragma unroll
        for (int ai = 0; ai < 2; ++ai)
#pragma unroll
            for (int m = 0; m < 4; ++m) { const int row = u.pm * BM + ai * HALF + wr * 64 + m * 16 + fr; float o[8];
#pragma unroll
                for (int n = 0; n < 2; ++n)
#pragma unroll
                    for (int i = 0; i < 4; ++i) { const float g = acc[ai][0][m][n][i], up = acc[ai][1][m][n][i]; o[4 * n + i] = g / (1.f + __expf(-g)) * up; }
                u32x4 w; w.x = cvt_pk_bf16(o[0], o[1]); w.y = cvt_pk_bf16(o[2], o[3]); w.z = cvt_pk_bf16(o[4], o[5]); w.w = cvt_pk_bf16(o[6], o[7]);
                *(u32x4*)(act + (size_t)row * FF + col0) = w; }
    }
};
template <class Epi, class Sched, bool ALIGN_EPI = false, bool SP2 = false>
__device__ __forceinline__ void gemm_phase(PG8_LAS unsigned char* lds, const Gemm g, const Sched& S, const Epi& E, int wid_in) {
    const int wid = __builtin_amdgcn_readfirstlane(wid_in), lane = fresh_lane(), tid = wid * 64 + lane, wr = wid >> 2, wc = wid & 3;
    const int K = g.K, nt = K / BK;
    unsigned voffA[2], voffB[2];
#pragma unroll
    for (int i = 0; i < 2; ++i) { int R, C; stage_rc(tid * 16 + i * 8192, R, C); const int Rb = Epi::PERM ? ((R & ~31) + perm32(R & 31)) : R;
        voffA[i] = (unsigned)(R * K + C) * 2u; voffB[i] = (unsigned)(Rb * K + C) * 2u; }
    const size_t kstep = (size_t)(BK * 2);
    const size_t hstep = (size_t)HALF * K * 2;
    const size_t tstep = 2 * hstep;
    const unsigned ldsw = (unsigned)wid * 1024u;
    const int aoff = lds_byte(wr * 64 + (lane & 15), (lane >> 4) * 8), boff = lds_byte(wc * 32 + (lane & 15), (lane >> 4) * 8);
#define PG8_SA(b, h) (((b) * 2 + (h)) * HTB)
#define PG8_SB(b, h) ((4 + (b) * 2 + (h)) * HTB)
#define PG8_STAGE(bufoff, gbase, voff) do { _Pragma("unroll") for (int _i = 0; _i < 2; ++_i) \
        __builtin_amdgcn_global_load_lds((const unsigned*)((const char*)(gbase) + (voff)[_i]), (PG8_LAS unsigned*)(lds + (bufoff) + ldsw + _i * 8192), 16, 0, 0); } while (0)
#define PG8_LDA(dst, b, h) do { _Pragma("unroll") for (int m = 0; m < 4; ++m) _Pragma("unroll") for (int k = 0; k < 2; ++k) dst[m][k] = *(const PG8_LAS bf16x8*)(lds + PG8_SA(b, h) + aoff + m * 2048 + k * 1024); } while (0)
#define PG8_LDB(dst, b, h) do { _Pragma("unroll") for (int n = 0; n < 2; ++n) _Pragma("unroll") for (int k = 0; k < 2; ++k) dst[n][k] = *(const PG8_LAS bf16x8*)(lds + PG8_SB(b, h) + boff + n * 2048 + k * 1024); } while (0)
#define PG8_MMA(ai, bj, At, Bt) do { __builtin_amdgcn_s_setprio(1); _Pragma("unroll") for (int m = 0; m < 4; ++m) _Pragma("unroll") for (int n = 0; n < 2; ++n) _Pragma("unroll") for (int k = 0; k < 2; ++k) \
        acc[ai][bj][m][n] = __builtin_amdgcn_mfma_f32_16x16x32_bf16(Bt[n][k], At[m][k], acc[ai][bj][m][n], 0, 0, 0); __builtin_amdgcn_s_setprio(0); } while (0)
#define PG8_WAIT_V(n) asm volatile("s_waitcnt vmcnt(" #n ")" ::: "memory")
#define PG8_WAIT_L(n) asm volatile("s_waitcnt lgkmcnt(" #n ")" ::: "memory")
#define PG8_BAR __builtin_amdgcn_s_barrier()
#define PG8_SCHED __builtin_amdgcn_sched_barrier(0)
    Unit cur, nxt; int ui = 0;
    if (!S.next(0, cur)) return;
    f32x4 acc[2][2][4][2];
#pragma unroll
    for (int a = 0; a < 2; ++a)
#pragma unroll
        for (int b = 0; b < 2; ++b)
#pragma unroll
            for (int m = 0; m < 4; ++m)
#pragma unroll
                for (int n = 0; n < 2; ++n) acc[a][b][m][n] = (f32x4){0.f, 0.f, 0.f, 0.f};
    bf16x8 At[4][2], B0[2][2], B1[2][2];
    const char* cA = (const char*)g.A + (size_t)cur.pm * tstep; const char* cB = (const char*)g.Bt + (size_t)cur.pn * tstep;
    S.a_ready(cur);
    if constexpr (SP2) {
        PG8_STAGE(PG8_SB(0, 0), cB, voffB); PG8_STAGE(PG8_SB(0, 1), cB + hstep, voffB); PG8_STAGE(PG8_SA(0, 0), cA, voffA); PG8_STAGE(PG8_SA(0, 1), cA + hstep, voffA);
        if (wr == 1) PG8_BAR;
        PG8_WAIT_V(2); PG8_BAR;
        PG8_STAGE(PG8_SB(1, 0), cB + kstep, voffB); PG8_STAGE(PG8_SA(1, 0), cA + kstep, voffA); PG8_STAGE(PG8_SB(1, 1), cB + hstep + kstep, voffB);
        PG8_WAIT_V(6); PG8_BAR;
    } else {
        PG8_STAGE(PG8_SB(0, 0), cB, voffB); PG8_STAGE(PG8_SA(0, 0), cA, voffA); PG8_STAGE(PG8_SB(0, 1), cB + hstep, voffB); PG8_STAGE(PG8_SA(0, 1), cA + hstep, voffA);
        if (wr == 1) PG8_BAR;
        PG8_WAIT_V(4); PG8_BAR;
        PG8_STAGE(PG8_SB(1, 0), cB + kstep, voffB); PG8_STAGE(PG8_SA(1, 0), cA + kstep, voffA); PG8_STAGE(PG8_SB(1, 1), cB + hstep + kstep, voffB);
        PG8_WAIT_V(6); PG8_BAR;
    }
    for (;;) {
        const bool has_next = S.next(ui + 1, nxt);
        const char* nA = has_next ? (const char*)g.A + (size_t)nxt.pm * tstep : cA; const char* nB = has_next ? (const char*)g.Bt + (size_t)nxt.pn * tstep : cB;
        for (int t = 0; t < nt; t += 2) {
            const bool last = (t == nt - 2);
            const char* a1 = cA + (size_t)(t + 1) * kstep;
            const char* a2 = last ? nA : cA + (size_t)(t + 2) * kstep; const char* b2 = last ? nB : cB + (size_t)(t + 2) * kstep;
            const char* a3 = a2 + kstep; const char* b3 = b2 + kstep;
            if (last && has_next) S.a_ready(nxt);
            if constexpr (SP2) {
            PG8_LDB(B0, 0, 0); PG8_LDB(B1, 0, 1); PG8_SCHED; PG8_LDA(At, 0, 0); PG8_STAGE(PG8_SA(1, 1), a1 + hstep, voffA);
            PG8_WAIT_V(8); PG8_WAIT_L(0); PG8_BAR; PG8_MMA(0, 0, At, B0); PG8_MMA(0, 1, At, B1); PG8_BAR; PG8_SCHED;
            PG8_LDA(At, 0, 1); PG8_STAGE(PG8_SB(0, 0), b2, voffB); PG8_STAGE(PG8_SB(0, 1), b2 + hstep, voffB); PG8_STAGE(PG8_SA(0, 0), a2, voffA);
            PG8_WAIT_V(8); PG8_WAIT_L(0); PG8_BAR; PG8_MMA(1, 0, At, B0); PG8_MMA(1, 1, At, B1); PG8_BAR; PG8_SCHED;
            PG8_LDB(B0, 1, 0); PG8_LDB(B1, 1, 1); PG8_SCHED; PG8_LDA(At, 1, 0); PG8_STAGE(PG8_SA(0, 1), a2 + hstep, voffA);
            PG8_WAIT_V(8); PG8_WAIT_L(0); PG8_BAR; PG8_MMA(0, 0, At, B0); PG8_MMA(0, 1, At, B1); PG8_BAR; PG8_SCHED;
            PG8_LDA(At, 1, 1); PG8_STAGE(PG8_SB(1, 0), b3, voffB); PG8_STAGE(PG8_SB(1, 1), b3 + hstep, voffB); PG8_STAGE(PG8_SA(1, 0), a3, voffA);
            PG8_WAIT_V(8); PG8_WAIT_L(0); PG8_BAR; PG8_MMA(1, 0, At, B0); PG8_MMA(1, 1, At, B1); PG8_BAR; PG8_SCHED;
            } else {
            PG8_LDB(B0, 0, 0); PG8_SCHED; PG8_LDA(At, 0, 0); PG8_STAGE(PG8_SA(1, 1), a1 + hstep, voffA);
            PG8_WAIT_L(8); PG8_BAR; PG8_WAIT_L(0); PG8_MMA(0, 0, At, B0); PG8_BAR; PG8_SCHED;
            PG8_LDB(B1, 0, 1); PG8_STAGE(PG8_SB(0, 0), b2, voffB);
            PG8_BAR; PG8_WAIT_L(0); PG8_MMA(0, 1, At, B1); PG8_BAR;
            PG8_LDA(At, 0, 1); PG8_STAGE(PG8_SA(0, 0), a2, voffA);
            PG8_BAR; PG8_WAIT_L(0); PG8_MMA(1, 0, At, B0); PG8_BAR; PG8_SCHED;
            PG8_STAGE(PG8_SB(0, 1), b2 + hstep, voffB);
            PG8_WAIT_V(6); PG8_BAR; PG8_MMA(1, 1, At, B1); PG8_BAR;
            PG8_LDB(B0, 1, 0); PG8_SCHED; PG8_LDA(At, 1, 0); PG8_STAGE(PG8_SA(0, 1), a2 + hstep, voffA);
            PG8_WAIT_L(8); PG8_BAR; PG8_WAIT_L(0); PG8_MMA(0, 0, At, B0); PG8_BAR; PG8_SCHED;
            PG8_LDB(B1, 1, 1); PG8_STAGE(PG8_SB(1, 0), b3, voffB);
            PG8_BAR; PG8_WAIT_L(0); PG8_MMA(0, 1, At, B1); PG8_BAR;
            PG8_LDA(At, 1, 1); PG8_STAGE(PG8_SA(1, 0), a3, voffA);
            PG8_BAR; PG8_WAIT_L(0); PG8_MMA(1, 0, At, B0); PG8_BAR; PG8_SCHED;
            PG8_STAGE(PG8_SB(1, 1), b3 + hstep, voffB);
            PG8_WAIT_V(6); PG8_BAR; PG8_MMA(1, 1, At, B1); PG8_BAR;
            }
        }
        if constexpr (ALIGN_EPI) { if (wr == 0) PG8_BAR; }
        if constexpr (!Epi::AFTER_DRAIN) { const int ln = fresh_lane(); E(acc, cur, wr, wc, ln & 15, ln >> 4); S.done(cur); }
        if (!has_next) break;
#pragma unroll
        for (int a = 0; a < 2; ++a)
#pragma unroll
            for (int b = 0; b < 2; ++b)
#pragma unroll
                for (int m = 0; m < 4; ++m)
#pragma unroll
                    for (int n = 0; n < 2; ++n) acc[a][b][m][n] = (f32x4){0.f, 0.f, 0.f, 0.f};
        cur = nxt; cA = nA; cB = nB; ++ui;
        if constexpr (ALIGN_EPI) { if (wr == 1) PG8_BAR; }
    }
    PG8_WAIT_V(0);
    if constexpr (!ALIGN_EPI) { if (wr == 0) PG8_BAR; }
    PG8_BAR;
    if constexpr (Epi::AFTER_DRAIN) { const int ln = fresh_lane(); E.fused(acc, cur, wr, wc, ln & 15, ln >> 4, lds, wid, ln); S.done(cur); }
#undef PG8_SA
#undef PG8_SB
#undef PG8_STAGE
#undef PG8_LDA
#undef PG8_LDB
#undef PG8_MMA
#undef PG8_WAIT_V
#undef PG8_WAIT_L
#undef PG8_BAR
#undef PG8_SCHED
}
}

#define GAS __attribute__((address_space(1)))
#define LAS __attribute__((address_space(3)))
typedef float f32x4 __attribute__((ext_vector_type(4)));
typedef unsigned v4u __attribute__((ext_vector_type(4)));
typedef GAS unsigned gu32;
#define XB_TMO      128
#define XB_XCNT(j)  (256  + 64 * (j))
#define XB_XSUB(j)  (1280 + 64 * (j))
#define XB_XGEN(j)  (2304 + 64 * (j))
#define XB_TOP      3328
#define XB_TOPGEN   3392
#define XCD_BAR_WORDS 3456
#define XB_SPIN_CAP (1u << 18)

__device__ __forceinline__ unsigned xb_ld(unsigned* p)              { return __hip_atomic_load(p, __ATOMIC_RELAXED, __HIP_MEMORY_SCOPE_AGENT); }
__device__ __forceinline__ unsigned xb_add(unsigned* p, unsigned v) { return __hip_atomic_fetch_add(p, v, __ATOMIC_RELAXED, __HIP_MEMORY_SCOPE_AGENT); }
__device__ __forceinline__ unsigned xb_xcc_id() { return (unsigned)__builtin_amdgcn_s_getreg((3 << 11) | 20) & 0xFu; }
#define XB_SPIN(cond, bar) do { unsigned _sp = 0; while (cond) { __builtin_amdgcn_s_sleep(1); \
    if ((++_sp & 255u) == 0u) { if (xb_ld(&(bar)[XB_TMO])) break; if (_sp > XB_SPIN_CAP) { atomicAdd(&(bar)[XB_TMO], 1u); break; } } } } while (0)

struct XcdBarrier {
    unsigned* bar; unsigned x;
    volatile LAS unsigned* st;
};

__device__ __forceinline__ XcdBarrier xcd_barrier_post(unsigned* bar, volatile LAS unsigned* st, int tid) {
    XcdBarrier b; b.bar = bar; b.x = xb_xcc_id(); b.st = st;
    if (tid == 0) (void)xb_add(&bar[XB_XCNT(b.x)], 1u);
    return b;
}
__device__ __forceinline__ void xcd_barrier_complete(unsigned* bar, unsigned x, unsigned& nloc, unsigned& nx) {
    const unsigned G = gridDim.x * gridDim.y * gridDim.z;
    unsigned sum, cnt, mine, sp = 0u;
    for (;;) {
        sum = 0u; cnt = 0u; mine = 0u;
#pragma unroll
        for (unsigned j = 0; j < 16; ++j) { const unsigned c = xb_ld(&bar[XB_XCNT(j)]); sum += c; cnt += (c > 0u) ? 1u : 0u; mine = (j == x) ? c : mine; }
        if (sum == G) break;
        __builtin_amdgcn_s_sleep(1);
        if ((++sp & 255u) == 0u) { if (xb_ld(&bar[XB_TMO])) break; if (sp > XB_SPIN_CAP) { atomicAdd(&bar[XB_TMO], 1u); break; } }
    }
    nloc = mine > 0u ? mine : 1u; nx = cnt > 0u ? cnt : 1u;
}

__device__ __forceinline__ void xcd_barrier(const XcdBarrier& b, int tid) {
    asm volatile("s_waitcnt vmcnt(0)" ::: "memory");
    __syncthreads();
    if (tid == 0) {
        unsigned* bar = b.bar;
        __builtin_amdgcn_s_waitcnt(0);
        unsigned nloc = b.st[0], nx = b.st[1];
        if (nloc == 0u) { xcd_barrier_complete(bar, b.x, nloc, nx); b.st[0] = nloc; b.st[1] = nx; }
        const unsigned old = xb_add(&bar[XB_XSUB(b.x)], 1u);
        const unsigned gen = old / nloc;
        if (old + 1u == (gen + 1u) * nloc) {
            __builtin_amdgcn_fence(__ATOMIC_RELEASE, "agent");
            asm volatile("s_waitcnt vmcnt(0)" ::: "memory");
            const unsigned og = xb_add(&bar[XB_TOP], 1u);
            const unsigned tg = og / nx;
            if (og + 1u == (tg + 1u) * nx) xb_add(&bar[XB_TOPGEN], 1u);
            else XB_SPIN(xb_ld(&bar[XB_TOPGEN]) == tg, bar);
            __builtin_amdgcn_fence(__ATOMIC_ACQUIRE, "agent");
            xb_add(&bar[XB_XGEN(b.x)], 1u);
            asm volatile("s_waitcnt vmcnt(0)" ::: "memory");
        } else {
            XB_SPIN(xb_ld(&bar[XB_XGEN(b.x)]) == gen, bar);
            __builtin_amdgcn_fence(__ATOMIC_ACQUIRE, "agent");
            asm volatile("s_waitcnt vmcnt(0)" ::: "memory");
        }
    }
    __syncthreads();
}

constexpr int NTHR = 512, NWAVES = 8;
constexpr int RING_BYTES = 131072, MISC_OFF = RING_BYTES + 320, LDS_BYTES = 147456;
constexpr int CW_BAR = 4096;
constexpr size_t CTL_ZERO_BYTES = 64 * 1024;
constexpr size_t WT_IN = WS_WT, WT_OUT = WT_IN + (size_t)2560 * 1024 * 2, WT_GU = WT_OUT + (size_t)1024 * 1024 * 2, WT_DOWN = WT_GU + (size_t)5632 * 1024 * 2,
                 WT_UQ = WT_DOWN + (size_t)1024 * 2816 * 2, WT_UKV = WT_UQ + (size_t)768 * 256 * 2, WT_CK = WT_UKV + (size_t)768 * 128 * 2, WT_CV = WT_CK + (size_t)64 * 2048 * 2,
                 WT_QM = WT_CV + (size_t)64 * 2048 * 2, WT_KM = WT_QM + 4 * 64 * 64 * 2, WT_END = WT_KM + 4 * 64 * 64 * 2;
static_assert(WT_END <= WS_HB, "weights");
constexpr int NPH = 22, PPL = 10;
constexpr int PROBE_SEL = 0;
constexpr int REP_MASK = 0;
#ifndef PHM
#define PHM 0xffff
#endif
struct MP { const float* in[N_IN]; float* out; unsigned char* ws; int ph_lo, ph_hi, coop, pad; };

struct MPK {
    const __attribute__((address_space(4))) MP* k;
    struct InArr { const __attribute__((address_space(4))) MP* k; __device__ __forceinline__ const float* operator[](int i) const { return k->in[i]; } };
    __device__ __forceinline__ InArr in_() const { return InArr{k}; }
};
#define PIN(i) (p.k->in[i])
__device__ __forceinline__ unsigned pk2(float lo, float hi) { return (unsigned)f2bf(lo) | ((unsigned)f2bf(hi) << 16); }
struct MapId { int n; __device__ __forceinline__ int operator()(int c) const { return c < n ? c : -1; } };
struct MapIn { __device__ __forceinline__ int operator()(int c) const {
    if (c < 1152) return c; if (c < 1280) return 1426 + (c - 1152); if (c < 1536) return 1170 + (c - 1280); if (c < 2304) return 1586 + (c - 1536);
    if (c < 2336) return 1554 + (c - 2304); if (c < 2354) return 1152 + (c - 2336); if (c < 2362) return c; return -1; } };
struct MapGU { __device__ __forceinline__ int operator()(int c) const { const int t = c >> 8, w = c & 255; return (w < 128) ? t * 128 + w : FF + t * 128 + (w - 128); } };
template <class Map> __device__ __forceinline__ void transpose_item(const float* W, int K, int ldw, const Map& map, const float* kscale, bf16* WT, LAS float* scr, int item, int nblk, int lane) {
    const int kb = item / nblk, nb = item % nblk, k0 = 64 * kb, n0 = 32 * nb;
    const int np = 2 * (lane & 15);
    const int sc = map(n0 + np);
    float2 tv[16];
#pragma unroll
    for (int i = 0; i < 16; ++i) { const int kk = 4 * i + (lane >> 4); tv[i] = (sc >= 0) ? *(const float2*)(W + (size_t)(k0 + kk) * ldw + sc) : make_float2(0.f, 0.f); }
    asm volatile("" : "+v"(tv[0]), "+v"(tv[1]), "+v"(tv[2]), "+v"(tv[3]), "+v"(tv[4]), "+v"(tv[5]), "+v"(tv[6]), "+v"(tv[7]));
    asm volatile("" : "+v"(tv[8]), "+v"(tv[9]), "+v"(tv[10]), "+v"(tv[11]), "+v"(tv[12]), "+v"(tv[13]), "+v"(tv[14]), "+v"(tv[15]));
#pragma unroll
    for (int i = 0; i < 16; ++i) { const int kk = 4 * i + (lane >> 4); float2 v = tv[i];
        if (kscale) { const float ksc = kscale[k0 + kk]; v.x *= ksc; v.y *= ksc; } scr[kk * 33 + np] = v.x; scr[kk * 33 + np + 1] = v.y; }
    asm volatile("s_waitcnt lgkmcnt(0)" ::: "memory");
    const int c = lane & 7;
#pragma unroll
    for (int j = 0; j < 4; ++j) { const int n = (lane >> 3) + 8 * j; const LAS float* s = scr + (8 * c) * 33 + n;
        v4u o; o.x = pk2(s[0 * 33], s[1 * 33]); o.y = pk2(s[2 * 33], s[3 * 33]); o.z = pk2(s[4 * 33], s[5 * 33]); o.w = pk2(s[6 * 33], s[7 * 33]);
        *(v4u*)(WT + (size_t)(n0 + n) * K + k0 + 8 * c) = o; }
    asm volatile("s_waitcnt lgkmcnt(0)" ::: "memory");
}
__device__ __forceinline__ void norm_rows(const float* x, const float* g, const float* shift, const float* scale, bf16* hb, float* outf, int mode, int gw, int ngw, int lane) {
    const int rpw = T_ / ngw, m0 = gw * rpw, b = m0 / S_;
    float4 gs[4], sh[4];
#pragma unroll
    for (int j = 0; j < 4; ++j) { const int col = 4 * lane + 256 * j; gs[j] = *(const float4*)(g + col);
        if (mode != 2) { const float4 sc = *(const float4*)(scale + (size_t)b * 6144 + col); sh[j] = *(const float4*)(shift + (size_t)b * 6144 + col);
            gs[j].x *= 1.f + sc.x; gs[j].y *= 1.f + sc.y; gs[j].z *= 1.f + sc.z; gs[j].w *= 1.f + sc.w; }
        else sh[j] = make_float4(0.f, 0.f, 0.f, 0.f); }
    float4 nv[4], nw[4];
    { const float4* xr = (const float4*)(x + (size_t)m0 * D_) + lane;
#pragma unroll
      for (int j = 0; j < 4; ++j) { nv[j] = xr[64 * j]; nw[j] = xr[D_ / 4 + 64 * j]; } }
    for (int r = 0; r < rpw; r += 2) {
        const int m = m0 + r;
        float4 v[4], w[4]; float s = 0.f, s2 = 0.f;
#pragma unroll
        for (int j = 0; j < 4; ++j) { v[j] = nv[j]; w[j] = nw[j]; }
        if (r + 2 < rpw) { const float4* xr = (const float4*)(x + (size_t)(m + 2) * D_) + lane;
#pragma unroll
            for (int j = 0; j < 4; ++j) { nv[j] = xr[64 * j]; nw[j] = xr[D_ / 4 + 64 * j]; } }
#pragma unroll
        for (int j = 0; j < 4; ++j) { s += v[j].x * v[j].x + v[j].y * v[j].y + v[j].z * v[j].z + v[j].w * v[j].w; s2 += w[j].x * w[j].x + w[j].y * w[j].y + w[j].z * w[j].z + w[j].w * w[j].w; }
        const float r1 = rsqrtf(wave_sum2(s) * (1.f / D_) + EPS), r2 = rsqrtf(wave_sum2(s2) * (1.f / D_) + EPS);
#pragma unroll
        for (int j = 0; j < 4; ++j) {
            const int col = 4 * lane + 256 * j;
            float4 o, o2;
            o.x = v[j].x * r1 * gs[j].x + sh[j].x; o.y = v[j].y * r1 * gs[j].y + sh[j].y; o.z = v[j].z * r1 * gs[j].z + sh[j].z; o.w = v[j].w * r1 * gs[j].w + sh[j].w;
            o2.x = w[j].x * r2 * gs[j].x + sh[j].x; o2.y = w[j].y * r2 * gs[j].y + sh[j].y; o2.z = w[j].z * r2 * gs[j].z + sh[j].z; o2.w = w[j].w * r2 * gs[j].w + sh[j].w;
            if (mode == 2) { *(float4*)(outf + (size_t)m * D_ + col) = o; *(float4*)(outf + (size_t)(m + 1) * D_ + col) = o2; }
            else { uint2 q; q.x = pk2(o.x, o.y); q.y = pk2(o.z, o.w); *(uint2*)(hb + (size_t)m * D_ + col) = q;
                   uint2 q2; q2.x = pk2(o2.x, o2.y); q2.y = pk2(o2.z, o2.w); *(uint2*)(hb + (size_t)(m + 1) * D_ + col) = q2; }
        }
    }
}
__device__ __forceinline__ void ph_p0(const MPK& p, LAS unsigned char* lds, int tid) {
    const int wave = tid >> 6, lane = tid & 63;
    LAS float* ca = (LAS float*)lds; LAS float* red = ca + 8192;
    unsigned char* ws = p.k->ws; float* mod = (float*)(ws + WS_MOD);
    const float* c = PIN(I_C);
    for (int i = tid; i < 8192; i += NTHR) ca[i] = siluf_(c[i]);
    __syncthreads();
    for (int item = blockIdx.x; item < 96; item += gridDim.x) {
        const int l = item / 48, j = (item % 48) * 128 + 2 * lane;
        const float* w = PIN(I_WADA) + (size_t)l * 1024 * 6144 + j;
        float acc[8][2];
#pragma unroll
        for (int b = 0; b < 8; ++b) { acc[b][0] = 0.f; acc[b][1] = 0.f; }
#pragma unroll 8
        for (int k = wave * 128; k < wave * 128 + 128; ++k) {
            const float2 wv = *(const float2*)(w + (size_t)k * 6144);
#pragma unroll
            for (int b = 0; b < 8; ++b) { const float cv = ca[b * 1024 + k]; acc[b][0] += cv * wv.x; acc[b][1] += cv * wv.y; }
        }
#pragma unroll
        for (int b = 0; b < 8; ++b) { red[(wave * 8 + b) * 128 + 2 * lane] = acc[b][0]; red[(wave * 8 + b) * 128 + 2 * lane + 1] = acc[b][1]; }
        __syncthreads();
        { const int b = wave;
#pragma unroll
          for (int c2 = 0; c2 < 2; ++c2) { float s2 = 0.f;
#pragma unroll
            for (int w8 = 0; w8 < 8; ++w8) s2 += red[(w8 * 8 + b) * 128 + c2 * 64 + lane];
            mod[((size_t)l * 8 + b) * 6144 + (item % 48) * 128 + c2 * 64 + lane] = s2 + PIN(I_BADA)[l * 6144 + (item % 48) * 128 + c2 * 64 + lane]; } }
        __syncthreads();
    }
    const int* pos = (const int*)PIN(I_POS);
    float *cosP = (float*)(ws + WS_COSP), *sinP = (float*)(ws + WS_SINP), *cosM = (float*)(ws + WS_COSM), *sinM = (float*)(ws + WS_SINM);
    for (int i = blockIdx.x * NTHR + tid; i < T_ * 24; i += gridDim.x * NTHR) {
        const int m = i / 24, f = i % 24;
        double inv; if (f < 8) inv = pow(500000.0, -(double)(2 * f) / 16.0); else inv = pow(500000.0, -(double)(2 * (f - 8)) / 32.0);
        const float ang = (float)pos[m] * (float)inv;
        const double a = (double)ang, kq = rint(a * 0.15915494309189535), r = a - kq * 6.283185307179586476925;
        const float cs = (float)cos(r), sn = (float)sin(r);
        if (f < 8) { cosP[m * 8 + f] = cs; sinP[m * 8 + f] = sn; } else { cosM[m * 16 + f - 8] = cs; sinM[m * 16 + f - 8] = sn; }
    }
}
__device__ __forceinline__ void early_transposes(const MPK& p, int l, LAS unsigned char* lds, int tid, int first) {
    const int wave = tid >> 6, lane = tid & 63;
    if ((int)blockIdx.x < first) return;
    const int gw = ((int)blockIdx.x - first) * NWAVES + wave, ngw = ((int)gridDim.x - first) * NWAVES;
    unsigned char* ws = p.k->ws;
    LAS float* scr = (LAS float*)(lds + wave * 8704);
    constexpr int I0 = 16 * 80, I4 = 4 * 24, I5 = 2 * 24, I6 = 32 * 2, I7 = 32 * 2, I8 = 8, I9 = 8;
    constexpr int NIT = I0 + I4 + I5 + I6 + I7 + I8 + I9;
    for (int it = gw; it < NIT; it += ngw) {
        int r = it;
        if (r < I0) { transpose_item(PIN(I_WIN) + (size_t)l * D_ * DIN, D_, DIN, MapIn{}, nullptr, (bf16*)(ws + WT_IN), scr, r, 80, lane); continue; } r -= I0;
        if (r < I4) { transpose_item(PIN(I_WUQ) + (size_t)l * 256 * 576, 256, 576, MapId{576}, PIN(I_GQL) + l * 256, (bf16*)(ws + WT_UQ), scr, r, 24, lane); continue; } r -= I4;
        if (r < I5) { transpose_item(PIN(I_WUKV) + (size_t)l * 128 * 768, 128, 768, MapId{768}, PIN(I_GKVL) + l * 128, (bf16*)(ws + WT_UKV), scr, r, 24, lane); continue; } r -= I5;
        if (r < I6) { transpose_item(PIN(I_WCK) + (size_t)l * 2048 * 64, 2048, 64, MapId{64}, nullptr, (bf16*)(ws + WT_CK), scr, r, 2, lane); continue; } r -= I6;
        if (r < I7) { transpose_item(PIN(I_WCV) + (size_t)l * 2048 * 64, 2048, 64, MapId{64}, nullptr, (bf16*)(ws + WT_CV), scr, r, 2, lane); continue; } r -= I7;
        if (r < I8) { const int h = r >> 1; transpose_item(PIN(I_WQM) + (size_t)l * 16384 + h * 4096, 64, 64, MapId{64}, nullptr, (bf16*)(ws + WT_QM) + h * 4096, scr, r & 1, 2, lane); continue; } r -= I8;
        { const int h = r >> 1; transpose_item(PIN(I_WKM) + (size_t)l * 16384 + h * 4096, 64, 64, MapId{64}, nullptr, (bf16*)(ws + WT_KM) + h * 4096, scr, r & 1, 2, lane); }
    }
}
__device__ __forceinline__ void ph_prep(const MPK& p, int l, LAS unsigned char* lds, int tid) {
    const int wave = tid >> 6, lane = tid & 63;
    const int gw = blockIdx.x * NWAVES + wave, ngw = gridDim.x * NWAVES;
    unsigned char* ws = p.k->ws;
    LAS float* scr = (LAS float*)(lds + wave * 8704);
    for (int i = blockIdx.x * NTHR + tid; i < 2 * T_; i += gridDim.x * NTHR) ((float*)(ws + WS_SSQL))[i] = 0.f;
    if (l == 0) early_transposes(p, l, lds, tid, 0);
    const float* xin = (l == 0) ? PIN(I_X) : p.k->out;
    const float* modl = (const float*)(ws + WS_MOD) + (size_t)l * 8 * 6144;
    norm_rows(xin, PIN(I_GN1) + l * D_, modl + 0, modl + 1024, (bf16*)(ws + WS_HB), nullptr, 0, gw, ngw, lane);
}
__device__ __forceinline__ void late_transposes(const MPK& p, int l, LAS unsigned char* lds, int tid, int first) {
    const int wave = tid >> 6, lane = tid & 63;
    if ((int)blockIdx.x < first) return;
    const int gw = ((int)blockIdx.x - first) * NWAVES + wave, ngw = ((int)gridDim.x - first) * NWAVES;
    unsigned char* ws = p.k->ws;
    LAS float* scr = (LAS float*)(lds + wave * 8704);
    constexpr int I1 = 16 * 32, I2 = 16 * 176, I3 = 44 * 32;
    for (int it = gw; it < I1 + I2 + I3; it += ngw) {
        int r = it;
        if (r < I1) { transpose_item(PIN(I_WOUT) + (size_t)l * D_ * D_, D_, D_, MapId{D_}, nullptr, (bf16*)(ws + WT_OUT), scr, r, 32, lane); continue; } r -= I1;
        if (r < I2) { transpose_item(PIN(I_WGU) + (size_t)l * D_ * 2 * FF, D_, 2 * FF, MapGU{}, nullptr, (bf16*)(ws + WT_GU), scr, r, 176, lane); continue; } r -= I2;
        transpose_item(PIN(I_WDOWN) + (size_t)l * FF * D_, FF, D_, MapId{D_}, nullptr, (bf16*)(ws + WT_DOWN), scr, r, 32, lane);
    }
}
__device__ __forceinline__ void ph_mixnorm(const MPK& p, int l, int tid) {
    const int gw = blockIdx.x * NWAVES + (tid >> 6), ngw = gridDim.x * NWAVES, lane = tid & 63;
    unsigned char* ws = p.k->ws;
    bf16* mix = (bf16*)(ws + WS_HB); const float* ga = PIN(I_GOA) + l * 384; const float* gb = PIN(I_GOB) + l * 384;
    const bf16 *oc = (const bf16*)(ws + WS_OCMP), *os = (const bf16*)(ws + WS_OSLC), *ow = (const bf16*)(ws + WS_OWIN); const float* gm = (const float*)(ws + WS_GM);
#define UNPK8(dst, src) dst[0] = __uint_as_float(src.x << 16); dst[1] = __uint_as_float(src.x & 0xffff0000u); dst[2] = __uint_as_float(src.y << 16); dst[3] = __uint_as_float(src.y & 0xffff0000u); \
    dst[4] = __uint_as_float(src.z << 16); dst[5] = __uint_as_float(src.z & 0xffff0000u); dst[6] = __uint_as_float(src.w << 16); dst[7] = __uint_as_float(src.w & 0xffff0000u);
    const int rpw = T_ / ngw;
    const float* ggp = (lane < 48) ? ga + lane * 8 : gb + (lane - 48) * 8; const float4 gA0 = *(const float4*)ggp, gA1 = *(const float4*)(ggp + 4);
    const float* ggq = gb + (16 + (lane & 31)) * 8; const float4 gB0 = *(const float4*)ggq, gB1 = *(const float4*)(ggq + 4);
    v4u ra4, rb4, rc4, ry4; float rg0, rg1, rg2;
#define MIX_LOAD(m_) do { const bf16* r_ = mix + (size_t)(m_) * D_; \
        if (lane < 48) { const size_t o_ = (size_t)(m_) * 384 + lane * 8; const float* g3_ = gm + (size_t)(m_) * 32 + 3 * (lane >> 3); rg0 = g3_[0]; rg1 = g3_[1]; rg2 = g3_[2]; \
            ra4 = *(const v4u*)(oc + o_); rb4 = *(const v4u*)(os + o_); rc4 = *(const v4u*)(ow + o_); } \
        else { ra4 = *(const v4u*)(r_ + 384 + (lane - 48) * 8); rb4 = ra4; rc4 = ra4; rg0 = 0.f; rg1 = 0.f; rg2 = 0.f; } \
        if (lane < 32) ry4 = *(const v4u*)(r_ + 384 + (16 + lane) * 8); else ry4 = ra4; } while (0)
    const int mend = gw * rpw + rpw;
    MIX_LOAD(gw * rpw);
    for (int m = gw * rpw; m < mend; ++m) {
        bf16* r = mix + (size_t)m * D_;
        const v4u ca4 = ra4, cb4 = rb4, cc4 = rc4, cy4 = ry4; const float g0 = rg0, g1 = rg1, g2 = rg2;
        if (m + 1 < mend) MIX_LOAD(m + 1);
        float v0[8], v1[8]; float sa = 0.f, sb = 0.f;
        if (lane < 48) {
            float c8[8], s8[8], w8[8]; UNPK8(c8, ca4) UNPK8(s8, cb4) UNPK8(w8, cc4)
#pragma unroll
            for (int i = 0; i < 8; ++i) { v0[i] = g0 * c8[i] + g1 * s8[i] + g2 * w8[i]; sa += v0[i] * v0[i]; }
        } else {
            UNPK8(v0, ca4)
#pragma unroll
            for (int i = 0; i < 8; ++i) sb += v0[i] * v0[i];
        }
        if (lane < 32) { UNPK8(v1, cy4)
#pragma unroll
            for (int i = 0; i < 8; ++i) sb += v1[i] * v1[i]; }
        const float ra = rsqrtf(wave_sum2(sa) * (1.f / 384.f) + EPS), rb = rsqrtf(wave_sum2(sb) * (1.f / 384.f) + EPS);
        {
            const int col = (lane < 48) ? lane * 8 : 384 + (lane - 48) * 8; const float rr = (lane < 48) ? ra : rb;
            const float4 q0 = gA0, q1 = gA1;
            v4u w; w.x = pk2(v0[0] * rr * q0.x, v0[1] * rr * q0.y); w.y = pk2(v0[2] * rr * q0.z, v0[3] * rr * q0.w); w.z = pk2(v0[4] * rr * q1.x, v0[5] * rr * q1.y); w.w = pk2(v0[6] * rr * q1.z, v0[7] * rr * q1.w);
            *(v4u*)(r + col) = w;
        }
        if (lane < 32) { const float4 q0 = gB0, q1 = gB1;
            v4u w; w.x = pk2(v1[0] * rb * q0.x, v1[1] * rb * q0.y); w.y = pk2(v1[2] * rb * q0.z, v1[3] * rb * q0.w); w.z = pk2(v1[4] * rb * q1.x, v1[5] * rb * q1.y); w.w = pk2(v1[6] * rb * q1.z, v1[7] * rb * q1.w);
            *(v4u*)(r + 384 + (16 + lane) * 8) = w; }
    }
#undef MIX_LOAD
#undef UNPK8
}


typedef short bf16x8 __attribute__((ext_vector_type(8)));
typedef short s16x4 __attribute__((ext_vector_type(4)));
typedef float f32x16 __attribute__((ext_vector_type(16)));
typedef unsigned u32x2v __attribute__((ext_vector_type(2)));
constexpr int AT_BUF = 20480, AT_K32 = 8192, AT_V = 12288;
__device__ __forceinline__ unsigned cvtpk(float lo, float hi) { unsigned r; asm volatile("v_cvt_pk_bf16_f32 %0, %1, %2" : "=v"(r) : "v"(lo), "v"(hi)); return r; }
__device__ __forceinline__ float max3f(float a, float b, float c) { float r; asm("v_max3_f32 %0, %1, %2, %3" : "=v"(r) : "v"(a), "v"(b), "v"(c)); return r; }
__device__ __forceinline__ int crow(int r, int hi) { return (r & 3) + 8 * (r >> 2) + 4 * hi; }
__device__ __forceinline__ s16x4 vtr(LAS const unsigned char* p) { return __builtin_bit_cast(s16x4, __builtin_amdgcn_ds_read_tr16_b64_v4i16((LAS s16x4*)p)); }
enum { AM_CAUSAL = 0, AM_WINDOW = 1, AM_SLC = 2 };
struct AttnState { float m, l; f32x16 o[2]; f32x16 negm; bool started; long long twait; };
template <int NC> struct TileRegs { v4u k; v4u k2; v4u v; };
template <int NC> __device__ __forceinline__ void at_load(TileRegs<NC>& r, const bf16* Kg, int ldk, const bf16* Vg, int ldv, const bf16* K2g, int ldk2, int tile, int tid) {
    const int key = tid >> 3, c = tid & 7;
    r.k = *(const v4u*)(Kg + (size_t)(tile * 64 + key) * ldk + 8 * c);
    r.v = *(const v4u*)(Vg + (size_t)(tile * 64 + key) * ldv + 8 * c);
    if (NC == 6) { if (tid < 256) r.k2 = *(const v4u*)(K2g + (size_t)(tile * 64 + (tid >> 2)) * ldk2 + 8 * (tid & 3)); }
}
template <int NC> __device__ __forceinline__ void at_store(const TileRegs<NC>& r, LAS unsigned char* buf, int tid) {
    const int key = tid >> 3, c = tid & 7;
    *(LAS v4u*)(buf + key * 128 + 16 * (c ^ ((key >> 1) & 7))) = r.k;
    *(LAS v4u*)(buf + AT_V + (c >> 2) * 4096 + key * 64 + (c & 3) * 16) = r.v;
    if (NC == 6) { if (tid < 256) { const int k2 = tid >> 2, c2 = tid & 3; *(LAS v4u*)(buf + AT_K32 + k2 * 64 + 16 * (c2 ^ ((k2 >> 2) & 3))) = r.k2; } }
}
template <int NC> __device__ __forceinline__ void qk_tile(f32x16& p0, f32x16& p1, LAS const unsigned char* buf, const bf16x8 (&qf)[NC], const f32x16& negm, int lane) {
    const int r32 = lane & 31, hi = lane >> 5;
    p0 = negm; p1 = negm;
#pragma unroll
    for (int cc = 0; cc < NC; ++cc) {
        bf16x8 k0, k1;
        if (cc < 4) { const int k0r = r32, k1r = 32 + r32;
            k0 = *(LAS const bf16x8*)(buf + k0r * 128 + 16 * ((2 * cc + hi) ^ ((k0r >> 1) & 7)));
            k1 = *(LAS const bf16x8*)(buf + k1r * 128 + 16 * ((2 * cc + hi) ^ ((k1r >> 1) & 7))); }
        else { const int k0r = r32, k1r = 32 + r32, c2 = 2 * (cc - 4) + hi;
            k0 = *(LAS const bf16x8*)(buf + AT_K32 + k0r * 64 + 16 * (c2 ^ ((k0r >> 2) & 3)));
            k1 = *(LAS const bf16x8*)(buf + AT_K32 + k1r * 64 + 16 * (c2 ^ ((k1r >> 2) & 3))); }
        p0 = __builtin_amdgcn_mfma_f32_32x32x16_bf16(k0, qf[cc], p0, 0, 0, 0);
        p1 = __builtin_amdgcn_mfma_f32_32x32x16_bf16(k1, qf[cc], p1, 0, 0, 0);
    }
}
template <int MODE> __device__ __forceinline__ void mask_tile(f32x16& p0, f32x16& p1, int kpos0, int qpos, bool need_mask, bool sel_ok, int lane) {
    const int hi = lane >> 5;
    if (need_mask) {
        const int qw0m = __builtin_amdgcn_readfirstlane(qpos) & ~31;
        const bool diag = (kpos0 + 63 > qw0m), old = (MODE == AM_WINDOW) && (kpos0 < qw0m + 31 - 511);
        if (diag || old) {
            const float selterm = (MODE == AM_SLC && !sel_ok) ? -INFINITY : INFINITY;
            const int dbase = qpos - kpos0 - 4 * hi;
#pragma unroll
            for (int r = 0; r < 16; ++r) {
                const int d0 = dbase - ((r & 3) + 8 * (r >> 2)), d1 = d0 - 32;
                float l0 = ((float)d0 + 0.5f) * INFINITY, l1 = ((float)d1 + 0.5f) * INFINITY;
                if (MODE == AM_WINDOW) { l0 = fminf(l0, ((float)(511 - d0) + 0.5f) * INFINITY); l1 = fminf(l1, ((float)(511 - d1) + 0.5f) * INFINITY); }
                if (MODE == AM_SLC) { l0 = fminf(l0, selterm); l1 = fminf(l1, selterm); }
                p0[r] = fminf(p0[r], l0); p1[r] = fminf(p1[r], l1);
            }
        } else if (MODE == AM_SLC) {
            const float selterm = sel_ok ? INFINITY : -INFINITY;
#pragma unroll
            for (int r = 0; r < 16; ++r) { p0[r] = fminf(p0[r], selterm); p1[r] = fminf(p1[r], selterm); }
        }
    }
}
template <int MODE> __device__ __forceinline__ void softmax_tile(AttnState& st, f32x16& p0, f32x16& p1, bf16x8 (&pf)[4], int kpos0, int qpos, bool need_mask, bool sel_ok, int lane) {
    mask_tile<MODE>(p0, p1, kpos0, qpos, need_mask, sel_ok, lane);
    float mx = max3f(p0[0], p1[0], p0[1]), mx2 = max3f(p1[1], p0[2], p1[2]);
#pragma unroll
    for (int r = 3; r < 15; r += 2) { mx = max3f(mx, p0[r], p1[r]); mx2 = max3f(mx2, p0[r + 1], p1[r + 1]); }
    mx = max3f(mx, p0[15], p1[15]); mx = max3f(mx, mx2, mx2);
    mx = red32_max(mx);
    if (!st.started || __any(mx > 0.f)) {
        float dl = st.started ? fmaxf(mx, 0.f) : mx;
        dl = (dl > -1e30f) ? dl : 0.f;
        st.started = true;
        const float alpha = __builtin_amdgcn_exp2f(-dl);
        st.m += dl; st.l *= alpha;
#pragma unroll
        for (int r = 0; r < 16; ++r) { st.o[0][r] *= alpha; st.o[1][r] *= alpha; p0[r] -= dl; p1[r] -= dl; st.negm[r] = -st.m; }
    }
    float sum = 0.f;
#pragma unroll
    for (int r = 0; r < 16; ++r) { p0[r] = __builtin_amdgcn_exp2f(p0[r]); p1[r] = __builtin_amdgcn_exp2f(p1[r]); sum += p0[r] + p1[r]; }
    st.l += sum;
#pragma unroll
    for (int s2 = 0; s2 < 2; ++s2) {
        v4u a, b;
        a.x = cvtpk(p0[8 * s2 + 0], p0[8 * s2 + 1]); a.y = cvtpk(p0[8 * s2 + 2], p0[8 * s2 + 3]); a.z = cvtpk(p0[8 * s2 + 4], p0[8 * s2 + 5]); a.w = cvtpk(p0[8 * s2 + 6], p0[8 * s2 + 7]);
        b.x = cvtpk(p1[8 * s2 + 0], p1[8 * s2 + 1]); b.y = cvtpk(p1[8 * s2 + 2], p1[8 * s2 + 3]); b.z = cvtpk(p1[8 * s2 + 4], p1[8 * s2 + 5]); b.w = cvtpk(p1[8 * s2 + 6], p1[8 * s2 + 7]);
        pf[s2] = __builtin_bit_cast(bf16x8, a); pf[2 + s2] = __builtin_bit_cast(bf16x8, b);
    }
}
struct TileFlags { bool skip, need_mask, sel_ok; };
__device__ __forceinline__ void pack_p(bf16x8 (&pf)[4], const f32x16& p0, const f32x16& p1) {
#pragma unroll
    for (int s2 = 0; s2 < 2; ++s2) {
        v4u a, b;
        a.x = cvtpk(p0[8 * s2 + 0], p0[8 * s2 + 1]); a.y = cvtpk(p0[8 * s2 + 2], p0[8 * s2 + 3]); a.z = cvtpk(p0[8 * s2 + 4], p0[8 * s2 + 5]); a.w = cvtpk(p0[8 * s2 + 6], p0[8 * s2 + 7]);
        b.x = cvtpk(p1[8 * s2 + 0], p1[8 * s2 + 1]); b.y = cvtpk(p1[8 * s2 + 2], p1[8 * s2 + 3]); b.z = cvtpk(p1[8 * s2 + 4], p1[8 * s2 + 5]); b.w = cvtpk(p1[8 * s2 + 6], p1[8 * s2 + 7]);
        pf[s2] = __builtin_bit_cast(bf16x8, a); pf[2 + s2] = __builtin_bit_cast(bf16x8, b);
    }
}
template <int MODE> __device__ __forceinline__ void softmax_pair(AttnState& st, f32x16& a0, f32x16& a1, f32x16& b0, f32x16& b1, int kpos0, int qpos, const TileFlags& fa, const TileFlags& fb, int lane) {
    mask_tile<MODE>(a0, a1, kpos0, qpos, fa.need_mask, fa.sel_ok, lane);
    mask_tile<MODE>(b0, b1, kpos0 + 64, qpos, fb.need_mask, fb.sel_ok, lane);
    float mx = max3f(a0[0], a1[0], b0[0]), mx2 = max3f(b1[0], a0[1], a1[1]);
#pragma unroll
    for (int r = 1; r < 16; ++r) { mx = max3f(mx, b0[r], b1[r]); if (r > 1) mx2 = max3f(mx2, a0[r], a1[r]); }
    mx = max3f(mx, mx2, mx2);
    mx = red32_max(mx);
    if (!st.started || __any(mx > 0.f)) {
        float dl = st.started ? fmaxf(mx, 0.f) : mx;
        dl = (dl > -1e30f) ? dl : 0.f;
        st.started = true;
        const float alpha = __builtin_amdgcn_exp2f(-dl);
        st.m += dl; st.l *= alpha;
#pragma unroll
        for (int r = 0; r < 16; ++r) { st.o[0][r] *= alpha; st.o[1][r] *= alpha; a0[r] -= dl; a1[r] -= dl; b0[r] -= dl; b1[r] -= dl; st.negm[r] = -st.m; }
    }
    float sum = 0.f;
#pragma unroll
    for (int r = 0; r < 16; ++r) { a0[r] = __builtin_amdgcn_exp2f(a0[r]); a1[r] = __builtin_amdgcn_exp2f(a1[r]); b0[r] = __builtin_amdgcn_exp2f(b0[r]); b1[r] = __builtin_amdgcn_exp2f(b1[r]); sum += (a0[r] + a1[r]) + (b0[r] + b1[r]); }
    st.l += sum;
}
__device__ __forceinline__ void pv_tile(AttnState& st, LAS const unsigned char* buf, const bf16x8 (&pf)[4], int lane) {
    const int hi = lane >> 5;
    const unsigned vb = (unsigned)(uintptr_t)(buf + AT_V + (4 * hi + ((lane & 15) >> 2)) * 64 + ((lane >> 4) & 1) * 32 + (lane & 3) * 8);
#pragma unroll
    for (int dh = 0; dh < 2; ++dh) {
        s16x4 lo[4], hh[4];
#pragma unroll
        for (int s4 = 0; s4 < 4; ++s4) {
            asm volatile("ds_read_b64_tr_b16 %0, %1 offset:%c2" : "=&v"(lo[s4]) : "v"(vb), "i"(dh * 4096 + s4 * 1024) : "memory");
            asm volatile("ds_read_b64_tr_b16 %0, %1 offset:%c2" : "=&v"(hh[s4]) : "v"(vb), "i"(dh * 4096 + s4 * 1024 + 512) : "memory");
        }
        asm volatile("s_waitcnt lgkmcnt(0)" : "+v"(lo[0]), "+v"(lo[1]), "+v"(lo[2]), "+v"(lo[3]), "+v"(hh[0]), "+v"(hh[1]), "+v"(hh[2]), "+v"(hh[3]) :: "memory");
#pragma unroll
        for (int s4 = 0; s4 < 4; ++s4) {
            const bf16x8 vf = {lo[s4][0], lo[s4][1], lo[s4][2], lo[s4][3], hh[s4][0], hh[s4][1], hh[s4][2], hh[s4][3]};
            st.o[dh] = __builtin_amdgcn_mfma_f32_32x32x16_bf16(vf, pf[s4], st.o[dh], 0, 0, 0);
        }
    }
}
template <int MODE> __device__ __forceinline__ TileFlags tile_flags(int t, int qw0, unsigned selbits) {
    const int k0 = t * 64; TileFlags f;
    f.skip = k0 > qw0 + 31; f.need_mask = (k0 + 63 > qw0); f.sel_ok = true;
    if (MODE == AM_WINDOW) { f.skip = f.skip || (k0 + 63 < qw0 - 511); f.need_mask = f.need_mask || (k0 < qw0 + 31 - 511); }
    if (MODE == AM_SLC) { f.sel_ok = (selbits >> t) & 1u; const unsigned long long bal = __ballot(f.sel_ok); f.skip = f.skip || (bal == 0ull); f.need_mask = f.need_mask || (bal != ~0ull); }
    return f;
}
struct DmaOff { unsigned k, v, k2; };
template <int NC> __device__ __forceinline__ DmaOff at_dma_off(int ldk, int ldv, int ldk2, int wave, int lane) {
    const int L = wave * 64 + lane; DmaOff o;
    { const int key = L >> 3, c = (L & 7) ^ ((key >> 1) & 7); o.k = (unsigned)(key * ldk + 8 * c) * 2u; }
    { const int key = (L >> 2) & 63, c = (L >> 8) * 4 + (L & 3); o.v = (unsigned)(key * ldv + 8 * c) * 2u; }
    { const int key = (L >> 2) & 63, c2 = (L & 3) ^ ((key >> 2) & 3); o.k2 = (unsigned)(key * ldk2 + 8 * c2) * 2u; }
    return o;
}
template <int NC> __device__ __forceinline__ void at_dma(const DmaOff& o, const bf16* Kg, int ldk, const bf16* Vg, int ldv, const bf16* K2g, int ldk2, int tile, LAS unsigned char* slot, int wave) {
    __builtin_amdgcn_global_load_lds((const unsigned*)((const char*)(Kg + (size_t)tile * 64 * ldk) + o.k), (LAS unsigned*)(slot + wave * 1024), 16, 0, 0);
    __builtin_amdgcn_global_load_lds((const unsigned*)((const char*)(Vg + (size_t)tile * 64 * ldv) + o.v), (LAS unsigned*)(slot + AT_V + wave * 1024), 16, 0, 0);
    if (NC == 6) { if (wave < 4) __builtin_amdgcn_global_load_lds((const unsigned*)((const char*)(K2g + (size_t)tile * 64 * ldk2) + o.k2), (LAS unsigned*)(slot + AT_K32 + wave * 1024), 16, 0, 0); }
}
__device__ __forceinline__ void at_wait_bar(int keep) {
    if (keep == 0) asm volatile("s_waitcnt vmcnt(0) lgkmcnt(0)" ::: "memory");
    else if (keep == 4) asm volatile("s_waitcnt vmcnt(4) lgkmcnt(0)" ::: "memory");
    else asm volatile("s_waitcnt vmcnt(6) lgkmcnt(0)" ::: "memory");
    __builtin_amdgcn_s_barrier();
    asm volatile("" ::: "memory");
}
template <int NC, int MODE> __device__ __forceinline__ void at_stream(AttnState& st, LAS unsigned char* lds, const bf16* Kg, int ldk, const bf16* Vg, int ldv, const bf16* K2g, int ldk2, int t0, int t1,
                                                                       const bf16x8 (&qf)[NC], int qpos, int qw0, unsigned selbits, int tid) {
    const int lane = tid & 63, wave = __builtin_amdgcn_readfirstlane(tid >> 6), np = (t1 - t0) >> 1;
    const int nper2 = (NC == 6 && wave < 4) ? 6 : 4;
    const DmaOff dof = at_dma_off<NC>(ldk, ldv, ldk2, wave, lane);
    at_dma<NC>(dof, Kg, ldk, Vg, ldv, K2g, ldk2, t0, lds, wave); at_dma<NC>(dof, Kg, ldk, Vg, ldv, K2g, ldk2, t0 + 1, lds + AT_BUF, wave);
    if (np > 1) { at_dma<NC>(dof, Kg, ldk, Vg, ldv, K2g, ldk2, t0 + 2, lds + 2 * AT_BUF, wave); at_dma<NC>(dof, Kg, ldk, Vg, ldv, K2g, ldk2, t0 + 3, lds + 3 * AT_BUF, wave); }
    at_wait_bar(np > 1 ? nper2 : 0);
    int s0 = 0, s1 = 2 * AT_BUF, s2 = 4 * AT_BUF;
    for (int j = 0; j < np; ++j) {
        const int t = t0 + 2 * j; const bool has_2 = (j + 2 < np);
        if (has_2) { at_dma<NC>(dof, Kg, ldk, Vg, ldv, K2g, ldk2, t + 4, lds + s2, wave); at_dma<NC>(dof, Kg, ldk, Vg, ldv, K2g, ldk2, t + 5, lds + s2 + AT_BUF, wave); }
        const TileFlags fa = tile_flags<MODE>(t, qw0, selbits), fb = tile_flags<MODE>(t + 1, qw0, selbits);
        if (!fa.skip && !fb.skip) {
            f32x16 a0, a1, b0, b1; bf16x8 pf[4];
            qk_tile<NC>(a0, a1, lds + s0, qf, st.negm, lane);
            qk_tile<NC>(b0, b1, lds + s0 + AT_BUF, qf, st.negm, lane);
            softmax_pair<MODE>(st, a0, a1, b0, b1, t * 64, qpos, fa, fb, lane);
            pack_p(pf, a0, a1); pv_tile(st, lds + s0, pf, lane);
            pack_p(pf, b0, b1); pv_tile(st, lds + s0 + AT_BUF, pf, lane);
        } else {
            if (!fa.skip) { f32x16 p0, p1; bf16x8 pf[4]; qk_tile<NC>(p0, p1, lds + s0, qf, st.negm, lane); softmax_tile<MODE>(st, p0, p1, pf, t * 64, qpos, fa.need_mask, fa.sel_ok, lane); pv_tile(st, lds + s0, pf, lane); }
            if (!fb.skip) { f32x16 p0, p1; bf16x8 pf[4]; qk_tile<NC>(p0, p1, lds + s0 + AT_BUF, qf, st.negm, lane); softmax_tile<MODE>(st, p0, p1, pf, (t + 1) * 64, qpos, fb.need_mask, fb.sel_ok, lane); pv_tile(st, lds + s0 + AT_BUF, pf, lane); }
        }
        at_wait_bar(has_2 ? nper2 : 0);
        const int tmp = s0; s0 = s1; s1 = s2; s2 = tmp;
    }
}
__device__ __forceinline__ int next_item_q(unsigned* ctrs, LAS unsigned char* lds, int wave_u, int count, int q0, int& kstart) {
    const int tid = wave_u * 64 + fresh_lane();
    LAS int* slot = (LAS int*)(lds + RING_BYTES + 64);
    if (tid == 0) {
        int r = -1, k = kstart;
        for (; k < 8; ++k) { const int q = (q0 + k) & 7; const unsigned v = atomicAdd(ctrs + q * 16, 1u); if (v < (unsigned)count) { r = (q << 16) | (int)v; break; } }
        slot[0] = r; slot[1] = k;
    }
    __syncthreads();
    const int v = slot[0]; kstart = slot[1];
    __syncthreads();
    return v;
}
__device__ __forceinline__ void mla_unit(unsigned char* ws, LAS unsigned char* lds, int b, int h, int qt, int wave_u) {
    const int tid = wave_u * 64 + fresh_lane();
    const int lane = tid & 63, wave = tid >> 6, r32 = lane & 31, hi = lane >> 5;
    const int qw0 = qt * 256 + wave * 32, qpos = qw0 + r32; const size_t row = (size_t)b * S_ + qpos;
    const long long tq0 = (PROBE_SEL != 0) ? (long long)__builtin_amdgcn_s_memtime() : 0ll;
    bf16x8 qf[6];
    {
        const bf16* qp = (const bf16*)(ws + WS_OSLC) + row * 768 + h * 96 + 8 * hi;
        v4u raw[6];
#pragma unroll
        for (int cc = 0; cc < 6; ++cc) raw[cc] = *(const v4u*)(qp + 16 * cc);
        float msc = MSCALE; asm volatile("" : "+v"(msc));
        const float rs = rsqrtf(((const float*)(ws + WS_SSQL))[row] * (1.f / 256.f) + EPS) * msc;
        const float* cm_ = (const float*)(ws + WS_COSM) + row * 16 + 8 * hi; const float* sm_ = (const float*)(ws + WS_SINM) + row * 16 + 8 * hi;
#define UNPKQ(dst, src) dst[0] = __uint_as_float(src.x << 16); dst[1] = __uint_as_float(src.x & 0xffff0000u); dst[2] = __uint_as_float(src.y << 16); dst[3] = __uint_as_float(src.y & 0xffff0000u); \
        dst[4] = __uint_as_float(src.z << 16); dst[5] = __uint_as_float(src.z & 0xffff0000u); dst[6] = __uint_as_float(src.w << 16); dst[7] = __uint_as_float(src.w & 0xffff0000u);
#pragma unroll
        for (int cc = 0; cc < 4; ++cc) { float f[8]; UNPKQ(f, raw[cc])
            v4u w; w.x = cvtpk(f[0] * rs, f[1] * rs); w.y = cvtpk(f[2] * rs, f[3] * rs); w.z = cvtpk(f[4] * rs, f[5] * rs); w.w = cvtpk(f[6] * rs, f[7] * rs); qf[cc] = __builtin_bit_cast(bf16x8, w); }
        { float x1[8], x2[8], o1[8], o2[8]; UNPKQ(x1, raw[4]) UNPKQ(x2, raw[5])
#pragma unroll
          for (int j = 0; j < 8; ++j) { const float cs = cm_[j] * rs, sn = sm_[j] * rs; o1[j] = x1[j] * cs - x2[j] * sn; o2[j] = x1[j] * sn + x2[j] * cs; }
          v4u w; w.x = cvtpk(o1[0], o1[1]); w.y = cvtpk(o1[2], o1[3]); w.z = cvtpk(o1[4], o1[5]); w.w = cvtpk(o1[6], o1[7]); qf[4] = __builtin_bit_cast(bf16x8, w);
          w.x = cvtpk(o2[0], o2[1]); w.y = cvtpk(o2[2], o2[3]); w.z = cvtpk(o2[4], o2[5]); w.w = cvtpk(o2[6], o2[7]); qf[5] = __builtin_bit_cast(bf16x8, w); }
#undef UNPKQ
    }
    const long long tq1 = (PROBE_SEL != 0) ? (long long)__builtin_amdgcn_s_memtime() : 0ll;
    AttnState st; st.m = 0.f; st.l = 0.f; st.o[0] = f32x16{}; st.o[1] = f32x16{}; st.negm = f32x16{}; st.started = false; st.twait = 0;
    const bf16* kvb = (const bf16*)(ws + WS_KVM) + (size_t)b * S_ * 768 + h * 128;
    at_stream<6, AM_CAUSAL>(st, lds, kvb, 768, kvb + 64, 768, (const bf16*)(ws + WS_KR) + (size_t)b * S_ * 32, 32, 0, 4 * qt + 4, qf, qpos, qw0, 0u, tid);
    if (PROBE_SEL >= 1 && PROBE_SEL <= 3 && b == 0 && h == 0 && qt == 7 && tid == 0) { const long long tq2 = (long long)__builtin_amdgcn_s_memtime();
        ((float*)(ws + WS_CTL))[100] = (PROBE_SEL == 1) ? (float)(tq2 - tq1) : (PROBE_SEL == 2) ? (float)st.twait : (float)(tq1 - tq0); }
    const float lt = red32_sum(st.l), il = 1.f / lt;
    bf16* op = (bf16*)(ws + WS_HB) + row * D_ + 384 + h * 64 + 4 * hi;
#pragma unroll
    for (int dh = 0; dh < 2; ++dh)
#pragma unroll
        for (int g4 = 0; g4 < 4; ++g4) { u32x2v w; w.x = cvtpk(st.o[dh][4 * g4] * il, st.o[dh][4 * g4 + 1] * il); w.y = cvtpk(st.o[dh][4 * g4 + 2] * il, st.o[dh][4 * g4 + 3] * il);
            *(u32x2v*)(op + dh * 32 + 8 * g4) = w; }
}
template <int MODE> __device__ __forceinline__ void nsa_branch_unit(unsigned char* ws, LAS unsigned char* lds, int b, int h, int qt, int wave_u) {
    const int tid = wave_u * 64 + fresh_lane();
    const int lane = tid & 63, wave = tid >> 6, r32 = lane & 31, hi = lane >> 5, g = h / 3;
    const int qw0 = qt * 256 + wave * 32, qpos = qw0 + r32; const size_t row = (size_t)b * S_ + qpos;
    const bf16* nsa = (const bf16*)(ws + WS_NSA);
    const bf16* qp = nsa + row * 1152 + h * 64 + 8 * hi;
    bf16x8 qf[4];
#pragma unroll
    for (int cc = 0; cc < 4; ++cc) qf[cc] = *(const bf16x8*)(qp + 16 * cc);
    unsigned selbits = 0u; if (MODE == AM_SLC) selbits = ((const unsigned*)(ws + WS_SEL))[(size_t)(b * 2 + g) * S_ + qpos];
    const bf16* kb = nsa + (size_t)b * S_ * 1152 + g * 64 + (MODE == AM_SLC ? 640 : 896);
    AttnState st; st.m = 0.f; st.l = 0.f; st.o[0] = f32x16{}; st.o[1] = f32x16{}; st.negm = f32x16{}; st.started = false; st.twait = 0;
    const long long tn0 = (PROBE_SEL != 0) ? (long long)__builtin_amdgcn_s_memtime() : 0ll;
    const int t0 = (MODE == AM_SLC) ? 0 : ((4 * qt - 8 > 0) ? 4 * qt - 8 : 0);
    at_stream<4, MODE>(st, lds, kb, 1152, kb + 128, 1152, nullptr, 0, t0, 4 * qt + 4, qf, qpos, qw0, selbits, tid);
    if (PROBE_SEL >= 4 && PROBE_SEL <= 5 && MODE == AM_SLC && b == 0 && h == 0 && qt == 7 && tid == 0) { const long long tn1 = (long long)__builtin_amdgcn_s_memtime();
        ((float*)(ws + WS_CTL))[100] = (PROBE_SEL == 4) ? (float)(tn1 - tn0) : (float)st.twait; }
    const float lt = red32_sum(st.l), il = 1.f / lt;
    bf16* op = (bf16*)(ws + (MODE == AM_SLC ? WS_OSLC : WS_OWIN)) + row * 384 + h * 64 + 4 * hi;
#pragma unroll
    for (int dh = 0; dh < 2; ++dh)
#pragma unroll
        for (int g4 = 0; g4 < 4; ++g4) { u32x2v w; w.x = cvtpk(st.o[dh][4 * g4] * il, st.o[dh][4 * g4 + 1] * il); w.y = cvtpk(st.o[dh][4 * g4 + 2] * il, st.o[dh][4 * g4 + 3] * il);
            *(u32x2v*)(op + dh * 32 + 8 * g4) = w; }
}
__device__ __forceinline__ void cmp_unit(unsigned char* ws, LAS unsigned char* lds, int b, int g, int qt, int wave_u) {
    const int tid = wave_u * 64 + fresh_lane();
    const int lane = tid & 63, wave = tid >> 6, r32 = lane & 31, hi = lane >> 5;
    const int qpos = qt * 256 + wave * 32 + r32; const size_t row = (size_t)b * S_ + qpos;
    const bf16* kc = (const bf16*)(ws + WS_KCV) + (size_t)(b * 2 + g) * 128 * 64; const bf16* vc = kc + (size_t)8 * 2 * 128 * 64;
    { TileRegs<4> tr; at_load<4>(tr, kc, 64, vc, 64, nullptr, 0, 0, tid); at_store<4>(tr, lds, tid); at_load<4>(tr, kc, 64, vc, 64, nullptr, 0, 1, tid); at_store<4>(tr, lds + AT_BUF, tid); }
    __syncthreads();
    int nvis = (qpos >= 31) ? ((qpos - 31) >> 4) + 1 : 0; if (nvis > 127) nvis = 127;
    LAS float* IG = (LAS float*)(lds + 2 * AT_BUF) + wave * (32 * 33) + r32 * 33;
    LAS float* IL = IG + 8 * 32 * 33;
    const bf16* nsa = (const bf16*)(ws + WS_NSA);
    LAS const unsigned char* vb = lds + AT_V + (4 * hi + ((lane & 15) >> 2)) * 64 + ((lane >> 4) & 1) * 32 + (lane & 3) * 8;
    for (int r3 = 0; r3 < 3; ++r3) {
        const int h = 3 * g + r3;
        const bf16* qp = nsa + row * 1152 + h * 64 + 8 * hi;
        bf16x8 qf[4];
#pragma unroll
        for (int cc = 0; cc < 4; ++cc) qf[cc] = *(const bf16x8*)(qp + 16 * cc);
        f32x16 p[4];
#pragma unroll
        for (int tb = 0; tb < 4; ++tb) {
            LAS const unsigned char* buf = lds + (tb >> 1) * AT_BUF; const int kr = (tb & 1) * 32 + r32;
            p[tb] = f32x16{};
#pragma unroll
            for (int cc = 0; cc < 4; ++cc) { const bf16x8 kf = *(LAS const bf16x8*)(buf + kr * 128 + 16 * ((2 * cc + hi) ^ ((kr >> 1) & 7)));
                p[tb] = __builtin_amdgcn_mfma_f32_32x32x16_bf16(kf, qf[cc], p[tb], 0, 0, 0); }
        }
        float mx = -1e30f;
#pragma unroll
        for (int tb = 0; tb < 4; ++tb)
#pragma unroll
            for (int r = 0; r < 16; ++r) { const int n = 32 * tb + crow(r, hi); p[tb][r] = fminf(p[tb][r], ((float)(nvis - n) - 0.5f) * INFINITY); mx = fmaxf(mx, p[tb][r]); }
        mx = red32_max(mx);
        float sum = 0.f;
#pragma unroll
        for (int tb = 0; tb < 4; ++tb)
#pragma unroll
            for (int r = 0; r < 16; ++r) { p[tb][r] = __builtin_amdgcn_exp2f(p[tb][r] - mx); sum += p[tb][r]; }
        sum = red32_sum(sum);
        const float il = (nvis > 0) ? 1.f / sum : 0.f;
#pragma unroll
        for (int tb = 0; tb < 4; ++tb)
#pragma unroll
            for (int k = 0; k < 4; ++k) { const float a0 = p[tb][4 * k] * il, a1 = p[tb][4 * k + 1] * il, a2 = p[tb][4 * k + 2] * il, a3 = p[tb][4 * k + 3] * il;
                const int j = 2 * (4 * tb + k) + hi;
                const float gs = (a0 + a1) + (a2 + a3);
                if (r3 == 0) { IG[j] = gs; IL[j + 1] = a3; } else { IG[j] += gs; IL[j + 1] += a3; } }
        f32x16 o[2] = {f32x16{}, f32x16{}};
#pragma unroll
        for (int tb = 0; tb < 4; ++tb)
#pragma unroll
            for (int s2 = 0; s2 < 2; ++s2) {
                v4u a; a.x = cvtpk(p[tb][8 * s2 + 0], p[tb][8 * s2 + 1]); a.y = cvtpk(p[tb][8 * s2 + 2], p[tb][8 * s2 + 3]); a.z = cvtpk(p[tb][8 * s2 + 4], p[tb][8 * s2 + 5]); a.w = cvtpk(p[tb][8 * s2 + 6], p[tb][8 * s2 + 7]);
                const bf16x8 pf = __builtin_bit_cast(bf16x8, a);
                LAS const unsigned char* vbb = vb + (tb >> 1) * AT_BUF + ((tb & 1) * 2 + s2) * 1024;
#pragma unroll
                for (int dh = 0; dh < 2; ++dh) { const s16x4 lo = vtr(vbb + dh * 4096), hh = vtr(vbb + dh * 4096 + 512);
                    const bf16x8 vf = {lo[0], lo[1], lo[2], lo[3], hh[0], hh[1], hh[2], hh[3]};
                    o[dh] = __builtin_amdgcn_mfma_f32_32x32x16_bf16(vf, pf, o[dh], 0, 0, 0); }
                asm volatile("" ::: "memory");
            }
        bf16* op = (bf16*)(ws + WS_OCMP) + row * 384 + h * 64 + 4 * hi;
#pragma unroll
        for (int dh = 0; dh < 2; ++dh)
#pragma unroll
            for (int g4 = 0; g4 < 4; ++g4) { u32x2v w; w.x = cvtpk(o[dh][4 * g4] * il, o[dh][4 * g4 + 1] * il); w.y = cvtpk(o[dh][4 * g4 + 2] * il, o[dh][4 * g4 + 3] * il);
                *(u32x2v*)(op + dh * 32 + 8 * g4) = w; }
    }
    const int cur = qpos >> 6;
    LAS float* imp = IG;
#pragma unroll 1
    for (int jj = 0; jj < 16; ++jj) {
        const int j = 16 * hi + jj;
        float v = IG[j] + (j > 0 ? IL[j] : 0.f);
        if (j == 0 || j == cur || j == cur - 1) v = INFINITY;
        if (j * 64 > qpos) v = -INFINITY;
        IL[j] = v;
    }
#pragma unroll 1
    for (int jj = 0; jj < 16; ++jj) { const int j = 16 * hi + jj; imp[j] = IL[j]; }
    unsigned mask = 0;
#pragma unroll 1
    for (int jj = 0; jj < 16; ++jj) {
        const int j = 16 * hi + jj; const float v = imp[j]; int rank = 0;
#pragma unroll 4
        for (int k = 0; k < 32; ++k) { const float u2 = imp[k]; rank += (u2 > v || (u2 == v && k < j)) ? 1 : 0; }
        if (rank < 16) mask |= 1u << j;
    }
    mask = red32_or(mask);
    if (hi == 0) ((unsigned*)(ws + WS_SEL))[(size_t)(b * 2 + g) * S_ + qpos] = mask;
    __syncthreads();
}
__device__ __forceinline__ void lora_rows(unsigned char* ws, int tid) {
    const int gw = blockIdx.x * NWAVES + (tid >> 6), ngw = gridDim.x * NWAVES, lane = tid & 63;
    bf16* kvl = (bf16*)(ws + WS_KVL); const bf16* ql = (const bf16*)(ws + WS_QL); float* ssql = (float*)(ws + WS_SSQL);
    for (int m = gw; m < T_; m += ngw) {
        const unsigned kv = *(const unsigned*)(kvl + (size_t)m * 128 + 2 * lane);
        const float k0 = __uint_as_float(kv << 16), k1 = __uint_as_float(kv & 0xffff0000u);
        const uint2 qv = *(const uint2*)(ql + (size_t)m * 256 + 4 * lane);
        const float q0 = __uint_as_float(qv.x << 16), q1 = __uint_as_float(qv.x & 0xffff0000u), q2 = __uint_as_float(qv.y << 16), q3 = __uint_as_float(qv.y & 0xffff0000u);
        const float sk = wave_sum2(k0 * k0 + k1 * k1), sq = wave_sum2((q0 * q0 + q1 * q1) + (q2 * q2 + q3 * q3));
        const float rk = rsqrtf(sk * (1.f / 128.f) + EPS);
        *(unsigned*)(kvl + (size_t)m * 128 + 2 * lane) = pk2(k0 * rk, k1 * rk);
        if (lane == 0) ssql[m] = sq;
    }
}
__device__ __forceinline__ void post_misc(unsigned char* ws, const float* big, const float* bfg, int tid) {
    const float* mr = (const float*)(ws + WS_MISCRAW); const float* cosM = (const float*)(ws + WS_COSM); const float* sinM = (const float*)(ws + WS_SINM);
    bf16* kr = (bf16*)(ws + WS_KR); float* gm = (float*)(ws + WS_GM);
    for (int idx = blockIdx.x * NTHR + tid; idx < T_ * 64; idx += gridDim.x * NTHR) {
        const int row = idx >> 6, c = idx & 63; const float* r = mr + (size_t)row * 64; const float v = r[c];
        if (c < 32) { const int i = c & 15; const float x1 = r[i], x2 = r[16 + i], cs = cosM[row * 16 + i], sn = sinM[row * 16 + i];
            kr[(size_t)row * 32 + c] = f2bf((c < 16) ? x1 * cs - x2 * sn : x1 * sn + x2 * cs); }
        else if (c < 50) gm[(size_t)row * 32 + (c - 32)] = 1.f / (1.f + __expf(-v));
        else if (c < 54) gm[(size_t)row * 32 + 18 + (c - 50)] = v + big[c - 50];
        else if (c < 58) { const float z = v + bfg[c - 54]; gm[(size_t)row * 32 + 22 + (c - 54)] = fminf(z, 0.f) - __logf(1.f + __expf(-fabsf(z))); }
    }
}

typedef float f32x4v __attribute__((ext_vector_type(4)));
__device__ __forceinline__ void compress_item(unsigned char* ws, LAS unsigned char* lds, const float* cmp_pos, int item, int wave_u) {
    const int lane = fresh_lane(), tid = wave_u * 64 + lane;
    const int nb = item & 7, g = (item >> 3) & 1, b = (item >> 4) & 7, kv = item >> 7;
    const bf16* tok = (const bf16*)(ws + WS_NSA) + (size_t)b * S_ * 1152 + (kv ? 512 : 384) + g * 64;
    const bf16* wt = (const bf16*)(ws + (kv ? WT_CV : WT_CK));
    const int nrow = nb * 16 + (lane & 15), kq = lane >> 4;
    f32x4v acc[4] = {f32x4v{}, f32x4v{}, f32x4v{}, f32x4v{}};
#pragma unroll
    for (int hb = 0; hb < 2; ++hb) {
        v4u t4[4]; f32x4v p0[4], p1[4]; bf16x8 bfr[4][4];
#pragma unroll
        for (int q = 0; q < 4; ++q) {
            const int k = wave_u * 256 + (4 * hb + q) * 32 + kq * 8, l = k >> 6, d = k & 63;
            int trow = 16 * nrow + l; trow = trow < S_ ? trow : S_ - 1;
            t4[q] = *(const v4u*)(tok + (size_t)trow * 1152 + d);
            p0[q] = *(const f32x4v*)(cmp_pos + k); p1[q] = *(const f32x4v*)(cmp_pos + k + 4);
#pragma unroll
            for (int cb = 0; cb < 4; ++cb) bfr[q][cb] = *(const bf16x8*)(wt + (size_t)(cb * 16 + (lane & 15)) * 2048 + k);
        }
        asm volatile("" : "+v"(t4[0]), "+v"(t4[1]), "+v"(t4[2]), "+v"(t4[3]), "+v"(p0[0]), "+v"(p0[1]), "+v"(p0[2]), "+v"(p0[3]), "+v"(p1[0]), "+v"(p1[1]), "+v"(p1[2]), "+v"(p1[3]));
        asm volatile("" : "+v"(bfr[0][0]), "+v"(bfr[0][1]), "+v"(bfr[0][2]), "+v"(bfr[0][3]), "+v"(bfr[1][0]), "+v"(bfr[1][1]), "+v"(bfr[1][2]), "+v"(bfr[1][3]));
        asm volatile("" : "+v"(bfr[2][0]), "+v"(bfr[2][1]), "+v"(bfr[2][2]), "+v"(bfr[2][3]), "+v"(bfr[3][0]), "+v"(bfr[3][1]), "+v"(bfr[3][2]), "+v"(bfr[3][3]));
#pragma unroll
        for (int q = 0; q < 4; ++q) {
            v4u a4;
            a4.x = cvtpk(__uint_as_float(t4[q].x << 16) + p0[q][0], __uint_as_float(t4[q].x & 0xffff0000u) + p0[q][1]); a4.y = cvtpk(__uint_as_float(t4[q].y << 16) + p0[q][2], __uint_as_float(t4[q].y & 0xffff0000u) + p0[q][3]);
            a4.z = cvtpk(__uint_as_float(t4[q].z << 16) + p1[q][0], __uint_as_float(t4[q].z & 0xffff0000u) + p1[q][1]); a4.w = cvtpk(__uint_as_float(t4[q].w << 16) + p1[q][2], __uint_as_float(t4[q].w & 0xffff0000u) + p1[q][3]);
            const bf16x8 af = __builtin_bit_cast(bf16x8, a4);
#pragma unroll
            for (int cb = 0; cb < 4; ++cb) acc[cb] = __builtin_amdgcn_mfma_f32_16x16x32_bf16(af, bfr[q][cb], acc[cb], 0, 0, 0);
        }
    }
    LAS float* red = (LAS float*)lds + wave_u * 1024;
#pragma unroll
    for (int cb = 0; cb < 4; ++cb)
#pragma unroll
        for (int r = 0; r < 4; ++r) red[(4 * (lane >> 4) + r) * 64 + cb * 16 + (lane & 15)] = acc[cb][r];
    __syncthreads();
    bf16* out = (bf16*)(ws + WS_KCV) + (size_t)kv * (8 * 2 * 128 * 64) + ((size_t)(b * 2 + g) * 128 + nb * 16) * 64;
    for (int o = tid; o < 1024; o += NTHR) { float sum = 0.f;
#pragma unroll
        for (int w8 = 0; w8 < 8; ++w8) sum += ((LAS float*)lds)[w8 * 1024 + o];
        out[o] = f2bf(sum); }
    __syncthreads();
}
__device__ __forceinline__ f32x4v mm16(const LAS bf16* A, int lda, int arow0, const LAS bf16* Bt, int ldb, int bcol0, int K, int lane, f32x4v acc) {
    const LAS bf16* ap = A + (arow0 + (lane & 15)) * lda + 8 * (lane >> 4); const LAS bf16* bp = Bt + (bcol0 + (lane & 15)) * ldb + 8 * (lane >> 4);
    for (int k = 0; k < K; k += 32) acc = __builtin_amdgcn_mfma_f32_16x16x32_bf16(*(const LAS bf16x8*)(ap + k), *(const LAS bf16x8*)(bp + k), acc, 0, 0, 0);
    return acc;
}
constexpr int ML_LD = 72;
constexpr int ML_STRIDE = 3 * 64 * ML_LD * 2 + 256;
__device__ __forceinline__ void mlocal_item(unsigned char* ws, LAS unsigned char* lds, const float* convw, const float* convb, const float* big, const float* bfg, int chunk0, int wave_u) {
    const int lane = fresh_lane(), tid = wave_u * 64 + lane;
    const int h = (chunk0 >> 5) & 3, b = chunk0 >> 7;
    LAS bf16* WQ = (LAS bf16*)lds;
    LAS bf16* WK = WQ + 64 * ML_LD;
    const bf16* cm = (const bf16*)(ws + WS_CM);
#define ML_PTRS(ch) const int chunk = chunk0 + (ch); const int c = chunk & 31; const int row0 = b * S_ + c * 64; LAS bf16* XS = WK + 64 * ML_LD + (ch) * (ML_STRIDE / 2); \
    LAS bf16* VT = XS + 64 * ML_LD; LAS bf16* WKT = VT + 64 * ML_LD; LAS float* wl = (LAS float*)(WKT + 64 * ML_LD); (void)c; (void)row0; (void)XS; (void)VT; (void)WKT; (void)wl; (void)chunk;
    {
        v4u gx[2][4], gv[2]; const int l = tid >> 3, ch0 = (tid & 7) * 8;
#pragma unroll
        for (int ch = 0; ch < 2; ++ch) { ML_PTRS(ch) const int row = row0 + l, s = c * 64 + l;
#pragma unroll
            for (int j = 0; j < 4; ++j) gx[ch][j] = (s - 3 + j >= 0) ? *(const v4u*)(cm + (size_t)(row - 3 + j) * 768 + h * 64 + ch0) : v4u{0u, 0u, 0u, 0u};
            gv[ch] = *(const v4u*)(cm + (size_t)row * 768 + 256 + h * 64 + ch0); }
        asm volatile("" : "+v"(gx[0][0]), "+v"(gx[0][1]), "+v"(gx[0][2]), "+v"(gx[0][3]), "+v"(gx[1][0]), "+v"(gx[1][1]), "+v"(gx[1][2]), "+v"(gx[1][3]), "+v"(gv[0]), "+v"(gv[1]));
#pragma unroll
        for (int ch = 0; ch < 2; ++ch) { ML_PTRS(ch) const int row = row0 + l;
            float a[8];
#pragma unroll
            for (int i = 0; i < 8; ++i) a[i] = convb[h * 64 + ch0 + i];
#pragma unroll
            for (int j = 0; j < 4; ++j) { const v4u x4 = gx[ch][j];
                const float* cw = convw + j * 256 + h * 64 + ch0;
                a[0] += cw[0] * __uint_as_float(x4.x << 16); a[1] += cw[1] * __uint_as_float(x4.x & 0xffff0000u); a[2] += cw[2] * __uint_as_float(x4.y << 16); a[3] += cw[3] * __uint_as_float(x4.y & 0xffff0000u);
                a[4] += cw[4] * __uint_as_float(x4.z << 16); a[5] += cw[5] * __uint_as_float(x4.z & 0xffff0000u); a[6] += cw[6] * __uint_as_float(x4.w << 16); a[7] += cw[7] * __uint_as_float(x4.w & 0xffff0000u); }
            v4u o4; float r[8];
#pragma unroll
            for (int i = 0; i < 8; ++i) r[i] = a[i] / (1.f + __expf(-a[i]));
            o4.x = cvtpk(r[0], r[1]); o4.y = cvtpk(r[2], r[3]); o4.z = cvtpk(r[4], r[5]); o4.w = cvtpk(r[6], r[7]);
            *(v4u*)((bf16*)(ws + WS_XC) + (size_t)row * 256 + h * 64 + ch0) = o4;
            *(LAS v4u*)(XS + l * ML_LD + ch0) = o4;
            const v4u v4 = gv[ch];
            VT[(ch0 + 0) * ML_LD + l] = (bf16)(v4.x & 0xffffu); VT[(ch0 + 1) * ML_LD + l] = (bf16)(v4.x >> 16); VT[(ch0 + 2) * ML_LD + l] = (bf16)(v4.y & 0xffffu); VT[(ch0 + 3) * ML_LD + l] = (bf16)(v4.y >> 16);
            VT[(ch0 + 4) * ML_LD + l] = (bf16)(v4.z & 0xffffu); VT[(ch0 + 5) * ML_LD + l] = (bf16)(v4.z >> 16); VT[(ch0 + 6) * ML_LD + l] = (bf16)(v4.w & 0xffffu); VT[(ch0 + 7) * ML_LD + l] = (bf16)(v4.w >> 16);
        }
    }
    {
        const int e = tid >> 3, d0 = (tid & 7) * 8;
        *(LAS v4u*)(WQ + e * ML_LD + d0) = *(const v4u*)((const bf16*)(ws + WT_QM) + h * 4096 + e * 64 + d0);
        *(LAS v4u*)(WK + e * ML_LD + d0) = *(const v4u*)((const bf16*)(ws + WT_KM) + h * 4096 + e * 64 + d0);
    }
    if (wave_u < 2) { ML_PTRS(wave_u)
        const float* mr = (const float*)(ws + WS_MISCRAW) + (size_t)(row0 + lane) * 64;
        const float z = mr[54 + h] + bfg[h]; float lf = fminf(z, 0.f) - __logf(1.f + __expf(-fabsf(z)));
        const float ig = mr[50 + h] + big[h];
#pragma unroll
        for (int o = 1; o < 64; o <<= 1) { const float t = bperm(lf, lane - o); if (lane >= o) lf += t; }
        const float bL = __int_as_float(__builtin_amdgcn_readlane(__float_as_int(lf), 63));
        const float a = bL - lf + ig; const float mx = wave_max2(a);
        wl[lane] = __expf(a - mx);
        if (lane == 0) { ((float*)(ws + WS_ML))[chunk] = mx; ((float*)(ws + WS_BL))[chunk] = bL; }
    }
    __syncthreads();
#pragma unroll
    for (int ch = 0; ch < 2; ++ch) { ML_PTRS(ch)
        const int lb = wave_u & 3; const bool isk = wave_u >= 4;
        const LAS bf16* Wt = isk ? WK : WQ;
        bf16* og = (bf16*)(ws + (isk ? WS_MK : WS_MQ)) + (size_t)(row0 + 16 * lb + 4 * (lane >> 4)) * 256 + h * 64 + (lane & 15);
        float w4[4];
#pragma unroll
        for (int r = 0; r < 4; ++r) w4[r] = wl[16 * lb + 4 * (lane >> 4) + r];
#pragma unroll
        for (int eb = 0; eb < 4; ++eb) {
            f32x4v acc = mm16(XS, ML_LD, 16 * lb, Wt, ML_LD, 16 * eb, 64, lane, f32x4v{});
            if (!isk) {
#pragma unroll
                for (int r = 0; r < 4; ++r) og[(size_t)r * 256 + 16 * eb] = f2bf(acc[r] * 0.125f);
            } else {
                bf16 kb[4];
#pragma unroll
                for (int r = 0; r < 4; ++r) { kb[r] = f2bf(acc[r]); og[(size_t)r * 256 + 16 * eb] = kb[r]; }
                u32x2v w2; w2.x = cvtpk(bf2f(kb[0]) * w4[0], bf2f(kb[1]) * w4[1]); w2.y = cvtpk(bf2f(kb[2]) * w4[2], bf2f(kb[3]) * w4[3]);
                *(LAS u32x2v*)(WKT + (16 * eb + (lane & 15)) * ML_LD + 16 * lb + 4 * (lane >> 4)) = w2;
            }
        }
    }
    __syncthreads();
#pragma unroll
    for (int ch = 0; ch < 2; ++ch) { ML_PTRS(ch)
        float* ct = (float*)(ws + WS_CT) + (size_t)chunk * 4096;
#pragma unroll
        for (int i = 0; i < 2; ++i) { const int blk = wave_u * 2 + i, eb = blk >> 2, db = blk & 3;
            const f32x4v acc = mm16(VT, ML_LD, 16 * eb, WKT, ML_LD, 16 * db, 64, lane, f32x4v{});
#pragma unroll
            for (int r = 0; r < 4; ++r) ct[(16 * eb + 4 * (lane >> 4) + r) * 64 + 16 * db + (lane & 15)] = acc[r]; }
    }
    if (tid < 128) { ML_PTRS(tid >> 6)
        const int d = tid & 63; float n = 0.f; const LAS bf16* wr_ = WKT + d * ML_LD;
        for (int l = 0; l < 64; ++l) n += bf2f(wr_[l]);
        ((float*)(ws + WS_NL))[chunk * 64 + d] = n; }
#undef ML_PTRS
    __syncthreads();
}
__device__ __forceinline__ void mscan_item(unsigned char* ws, int item, int wave_u) {
    const int tid = wave_u * 64 + fresh_lane();
    const int bh = item / 9, part = item % 9;
    if (part == 8 && tid >= 64) return;
    float* base; size_t stride;
    if (part < 8) { base = (float*)(ws + WS_CT) + (size_t)bh * 32 * 4096 + part * 512 + tid; stride = 4096; } else { base = (float*)(ws + WS_NL) + (size_t)bh * 32 * 64 + tid; stride = 64; }
    const float* ML = (const float*)(ws + WS_ML); const float* BL = (const float*)(ws + WS_BL); float* MPv = (float*)(ws + WS_MP);
    float cl[32];
#pragma unroll
    for (int c = 0; c < 32; ++c) cl[c] = base[(size_t)c * stride];
    float Cv = 0.f, m = 0.f;
#pragma unroll
    for (int c = 0; c < 32; ++c) {
        const float ml = ML[bh * 32 + c], bl = BL[bh * 32 + c];
        base[(size_t)c * stride] = Cv;
        if (part == 8 && tid == 0) MPv[bh * 32 + c] = m;
        const float mn = fmaxf(bl + m, ml);
        Cv = __expf(bl + m - mn) * Cv + __expf(ml - mn) * cl[c]; m = mn;
    }
}
constexpr int MO_STRIDE = 5 * 64 * ML_LD * 2 + 64 * 65 * 4 + 6 * 64 * 4;
__device__ __forceinline__ void mout_item(unsigned char* ws, LAS unsigned char* lds, const float* gmh, const float* skip, int chunk0, int wave_u) {
    const int lane = fresh_lane(), tid = wave_u * 64 + lane;
    const int h = (chunk0 >> 5) & 3, b = chunk0 >> 7;
    const float* gm = (const float*)(ws + WS_GM);
#define MO_PTRS(ch) const int chunk = chunk0 + (ch); const int row0 = b * S_ + (chunk & 31) * 64; LAS unsigned char* cb_ = lds + (ch) * MO_STRIDE; \
    LAS bf16* QS = (LAS bf16*)cb_; LAS bf16* KS = QS + 64 * ML_LD; LAS bf16* VT = KS + 64 * ML_LD; LAS bf16* CP = VT + 64 * ML_LD; LAS bf16* SW = CP + 64 * ML_LD; \
    LAS float* HS = (LAS float*)(SW + 64 * ML_LD); LAS float* bs = HS + 64 * 65; LAS float* us = bs + 64; LAS float* ns = us + 64; LAS float* mts = ns + 64; LAS float* ints = mts + 64; LAS float* dinv = ints + 64; \
    (void)row0; (void)QS; (void)KS; (void)VT; (void)CP; (void)SW; (void)HS; (void)bs; (void)us; (void)ns; (void)mts; (void)ints; (void)dinv; (void)chunk;
    {
        v4u gq[2], gk[2], gv[2]; f32x4v gc0[2], gc1[2];
        const int l = tid >> 3, c0 = (tid & 7) * 8;
#pragma unroll
        for (int ch = 0; ch < 2; ++ch) { MO_PTRS(ch) const int row = row0 + l;
            gq[ch] = *(const v4u*)((const bf16*)(ws + WS_MQ) + (size_t)row * 256 + h * 64 + c0); gk[ch] = *(const v4u*)((const bf16*)(ws + WS_MK) + (size_t)row * 256 + h * 64 + c0);
            gv[ch] = *(const v4u*)((const bf16*)(ws + WS_CM) + (size_t)row * 768 + 256 + h * 64 + c0);
            const float* ct = (const float*)(ws + WS_CT) + (size_t)chunk * 4096 + l * 64 + c0;
            gc0[ch] = *(const f32x4v*)ct; gc1[ch] = *(const f32x4v*)(ct + 4); }
        asm volatile("" : "+v"(gq[0]), "+v"(gq[1]), "+v"(gk[0]), "+v"(gk[1]), "+v"(gv[0]), "+v"(gv[1]), "+v"(gc0[0]), "+v"(gc0[1]), "+v"(gc1[0]), "+v"(gc1[1]));
#pragma unroll
        for (int ch = 0; ch < 2; ++ch) { MO_PTRS(ch)
            *(LAS v4u*)(QS + l * ML_LD + c0) = gq[ch]; *(LAS v4u*)(KS + l * ML_LD + c0) = gk[ch];
            const v4u v4 = gv[ch];
            VT[(c0 + 0) * ML_LD + l] = (bf16)(v4.x & 0xffffu); VT[(c0 + 1) * ML_LD + l] = (bf16)(v4.x >> 16); VT[(c0 + 2) * ML_LD + l] = (bf16)(v4.y & 0xffffu); VT[(c0 + 3) * ML_LD + l] = (bf16)(v4.y >> 16);
            VT[(c0 + 4) * ML_LD + l] = (bf16)(v4.z & 0xffffu); VT[(c0 + 5) * ML_LD + l] = (bf16)(v4.z >> 16); VT[(c0 + 6) * ML_LD + l] = (bf16)(v4.w & 0xffffu); VT[(c0 + 7) * ML_LD + l] = (bf16)(v4.w >> 16);
            const f32x4v c0v = gc0[ch], c1v = gc1[ch];
            v4u cw; cw.x = cvtpk(c0v[0], c0v[1]); cw.y = cvtpk(c0v[2], c0v[3]); cw.z = cvtpk(c1v[0], c1v[1]); cw.w = cvtpk(c1v[2], c1v[3]);
            *(LAS v4u*)(CP + l * ML_LD + c0) = cw; }
    }
    if (wave_u < 2) { MO_PTRS(wave_u)
        const float ig = gm[(size_t)(row0 + lane) * 32 + 18 + h]; float lf = gm[(size_t)(row0 + lane) * 32 + 22 + h];
#pragma unroll
        for (int o = 1; o < 64; o <<= 1) { const float t = bperm(lf, lane - o); if (lane >= o) lf += t; }
        const float u = ig - lf; float cu = u;
#pragma unroll
        for (int o = 1; o < 64; o <<= 1) { const float t = bperm(cu, lane - o); if (lane >= o) cu = fmaxf(cu, t); }
        const float mprev = ((const float*)(ws + WS_MP))[chunk];
        const float mt = lf + fmaxf(mprev, cu);
        bs[lane] = lf; us[lane] = u; mts[lane] = mt; ints[lane] = __expf(lf + mprev - mt); ns[lane] = ((const float*)(ws + WS_NL))[chunk * 64 + lane];
    }
    __syncthreads();
#pragma unroll
    for (int ch = 0; ch < 2; ++ch) { MO_PTRS(ch)
#pragma unroll
        for (int i = 0; i < 2; ++i) { const int blk = wave_u * 2 + i, lb = blk >> 2, sb = blk & 3;
            f32x4v acc = f32x4v{};
            if (sb <= lb) acc = mm16(QS, ML_LD, 16 * lb, KS, ML_LD, 16 * sb, 64, lane, acc);
            const int sidx = 16 * sb + (lane & 15); const float usv = us[sidx];
#pragma unroll
            for (int r = 0; r < 4; ++r) { const int l = 16 * lb + 4 * (lane >> 4) + r;
                const float v = (sidx <= l) ? acc[r] * __expf(bs[l] + usv - mts[l]) : 0.f;
                SW[l * ML_LD + sidx] = f2bf(v); } }
    }
    __syncthreads();
    if (tid < 128) { MO_PTRS(tid >> 6)
        const int l = tid & 63; float qn = 0.f, ssum = 0.f;
        for (int d = 0; d < 64; ++d) { qn += bf2f(QS[l * ML_LD + d]) * ns[d]; ssum += bf2f(SW[l * ML_LD + d]); }
        const float den = ints[l] * qn + ssum;
        dinv[l] = 1.f / fmaxf(fabsf(den), __expf(-mts[l]));
    }
    f32x4v hq[2][2], hs2[2][2];
#pragma unroll
    for (int ch = 0; ch < 2; ++ch) { MO_PTRS(ch)
#pragma unroll
        for (int i = 0; i < 2; ++i) { const int blk = wave_u * 2 + i, lb = blk >> 2, eb = blk & 3;
            hq[ch][i] = mm16(QS, ML_LD, 16 * lb, CP, ML_LD, 16 * eb, 64, lane, f32x4v{});
            hs2[ch][i] = mm16(SW, ML_LD, 16 * lb, VT, ML_LD, 16 * eb, 16 * lb + 16 <= 32 ? 32 : 64, lane, f32x4v{}); }
    }
    __syncthreads();
#pragma unroll
    for (int ch = 0; ch < 2; ++ch) { MO_PTRS(ch)
#pragma unroll
        for (int i = 0; i < 2; ++i) { const int blk = wave_u * 2 + i, lb = blk >> 2, eb = blk & 3; const int e = 16 * eb + (lane & 15);
#pragma unroll
            for (int r = 0; r < 4; ++r) { const int l = 16 * lb + 4 * (lane >> 4) + r;
                const float og = bf2f(((const bf16*)(ws + WS_CM))[(size_t)(row0 + l) * 768 + 512 + h * 64 + e]);
                HS[l * 65 + e] = (ints[l] * hq[ch][i][r] + hs2[ch][i][r]) * dinv[l] / (1.f + __expf(-og)); } }
    }
    __syncthreads();
#pragma unroll
    for (int ch = 0; ch < 2; ++ch) { MO_PTRS(ch)
        const int l = tid >> 3, e0 = (tid & 7) * 8, row = row0 + l;
        float v[8]; float mu = 0.f;
#pragma unroll
        for (int i = 0; i < 8; ++i) { v[i] = HS[l * 65 + e0 + i]; mu += v[i]; }
        mu += sxf<1>(mu); mu += sxf<2>(mu); mu += sxf<4>(mu); mu *= (1.f / 64.f);
        float var = 0.f;
#pragma unroll
        for (int i = 0; i < 8; ++i) { const float dl = v[i] - mu; var += dl * dl; }
        var += sxf<1>(var); var += sxf<2>(var); var += sxf<4>(var);
        const float rs = rsqrtf(var * (1.f / 64.f) + EPS);
        const v4u x4 = *(const v4u*)((const bf16*)(ws + WS_XC) + (size_t)row * 256 + h * 64 + e0);
        float xv[8]; xv[0] = __uint_as_float(x4.x << 16); xv[1] = __uint_as_float(x4.x & 0xffff0000u); xv[2] = __uint_as_float(x4.y << 16); xv[3] = __uint_as_float(x4.y & 0xffff0000u);
        xv[4] = __uint_as_float(x4.z << 16); xv[5] = __uint_as_float(x4.z & 0xffff0000u); xv[6] = __uint_as_float(x4.w << 16); xv[7] = __uint_as_float(x4.w & 0xffff0000u);
        float r[8];
#pragma unroll
        for (int i = 0; i < 8; ++i) r[i] = (v[i] - mu) * rs * gmh[h * 64 + e0 + i] + skip[h * 64 + e0 + i] * xv[i];
        v4u w4; w4.x = cvtpk(r[0], r[1]); w4.y = cvtpk(r[2], r[3]); w4.z = cvtpk(r[4], r[5]); w4.w = cvtpk(r[6], r[7]);
        *(v4u*)((bf16*)(ws + WS_HB) + (size_t)row * D_ + 768 + h * 64 + e0) = w4;
    }
#undef MO_PTRS
    __syncthreads();
}

__global__ void __launch_bounds__(NTHR, 2) mega(MP p_unused) {
    extern __shared__ __attribute__((aligned(16))) unsigned char lds_raw[];
    LAS unsigned char* lds = (LAS unsigned char*)lds_raw;
    const int wave0 = __builtin_amdgcn_readfirstlane((int)threadIdx.x >> 6);
    const int tid0 = wave0 * 64 + fresh_lane();
    const int xcc = (int)(__builtin_amdgcn_s_getreg((3 << 11) | 20) & 7u);
    volatile LAS unsigned* MISC = (volatile LAS unsigned*)(lds + MISC_OFF);
    for (int u = tid0; u < (LDS_BYTES - RING_BYTES) / 4; u += NTHR) ((LAS unsigned*)(lds + RING_BYTES))[u] = 0u;
    __syncthreads();
    typedef const __attribute__((address_space(4))) MP* kmp_t;
    kmp_t kp0 = (kmp_t)__builtin_amdgcn_kernarg_segment_ptr();
    unsigned char* ws0 = kp0->ws; const int coop = kp0->coop, ph_lo = kp0->ph_lo, ph_hi = kp0->ph_hi;
    XcdBarrier bar; bar.bar = (unsigned*)(ws0 + WS_CTL) + CW_BAR; bar.x = 0; bar.st = nullptr;
    if (coop) bar = xcd_barrier_post((unsigned*)(ws0 + WS_CTL) + CW_BAR, MISC + 8, tid0);
    if (coop == 2) cooperative_groups::this_grid().sync();
    int ph = ph_lo;
    if (ph == 0) {
        const MPK p{kp0}; ph_p0(p, lds, wave0 * 64 + fresh_lane()); ph = 1;
        if (ph < ph_hi) xcd_barrier(bar, wave0 * 64 + fresh_lane());
    }
    bool second = false;
    for (; ph < ph_hi; ++ph) {
        kmp_t kp = kp0; asm volatile("" : "+s"(kp));
        const MPK p{kp}; unsigned char* ws = kp->ws;
#define TID_ (wave0 * 64 + fresh_lane())
#define GW_ (blockIdx.x * NWAVES + wave0)
#define NGW_ (gridDim.x * NWAVES)
        const int l = (ph - 1) / PPL, ty = (ph == 0) ? -1 : (ph == NPH - 1) ? -2 : (ph - 1) % PPL;
        const float* modl = (const float*)(ws + WS_MOD) + (size_t)l * 8 * 6144;
        if (ty == -2) { norm_rows(p.k->out, PIN(I_GFIN), nullptr, nullptr, nullptr, p.k->out, 2, GW_, NGW_, fresh_lane());
            if (PROBE_SEL != 0 && blockIdx.x == 0 && TID_ == 0) { asm volatile("s_waitcnt vmcnt(0)" ::: "memory"); p.k->out[0] = ((const float*)(ws + WS_CTL))[100] * 0.001f; } }
        else if (ty == 0 && (PHM & 2)) ph_prep(p, l, lds, TID_);
        else if (ty == 1 && (PHM & 4)) {
            pg8::Gemm g{(const bf16*)(ws + WS_HB), (const bf16*)(ws + WT_IN), T_, 2560, D_}; pg8::StaticOrder S; S.init(T_, 2560, gridDim.x, blockIdx.x);
            pg8::EpiIn E{ws, PIN(I_BIG) + l * 4, PIN(I_BFG) + l * 4};
            pg8::gemm_phase<pg8::EpiIn, pg8::StaticOrder, true, true>(lds, g, S, E, wave0);
            late_transposes(p, l, lds, TID_, 640 % (int)gridDim.x);
        }
        else if (ty == 2 && (PHM & 64)) {
            { pg8::Gemm g{(const bf16*)(ws + WS_KVL), (const bf16*)(ws + WT_UKV), T_, 768, 128}; pg8::StaticOrder S; S.init(T_, 768, gridDim.x, blockIdx.x);
              pg8::EpiUKV E{(bf16*)(ws + WS_KVM), (const float*)(ws + WS_SSKV)}; pg8::gemm_phase<pg8::EpiUKV, pg8::StaticOrder, true, true>(lds, g, S, E, wave0); }
            { pg8::Gemm g{(const bf16*)(ws + WS_QL), (const bf16*)(ws + WT_UQ), T_, 768, 256}; pg8::StaticOrder S; S.init(T_, 768, gridDim.x, blockIdx.x);
              pg8::EpiPlain E{(bf16*)(ws + WS_OSLC), 768}; pg8::gemm_phase<pg8::EpiPlain, pg8::StaticOrder, true, true>(lds, g, S, E, wave0); }
            post_misc(ws, PIN(I_BIG) + l * 4, PIN(I_BFG) + l * 4, TID_);
            unsigned* ctrs = (unsigned*)(ws + WS_CTL) + 8192 + ph * 256 + (second ? 128 : 0); int ks = 0;
            for (;;) { const int it = next_item_q(ctrs, lds, wave0, 96, xcc, ks); if (it < 0) break; const int b = it >> 16, j = it & 0xffff;
                if (j < 64) mlocal_item(ws, lds, PIN(I_CONVW) + l * 1024, PIN(I_CONVB) + l * 256, PIN(I_BIG) + l * 4, PIN(I_BFG) + l * 4, b * 128 + 2 * j, wave0);
                else { const int k = j - 64; compress_item(ws, lds, PIN(I_CMPPOS) + l * 2048, ((k >> 4) << 7) | (b << 4) | (k & 15), wave0); } }
        }
        else if (ty == 3 && (PHM & 128)) {
            unsigned* ctrs = (unsigned*)(ws + WS_CTL) + 8192 + ph * 256 + (second ? 128 : 0); int ks = 0;
            for (;;) { const int it = next_item_q(ctrs, lds, wave0, second ? 64 : 100, xcc, ks); if (it < 0) break; const int b = it >> 16, j = it & 0xffff;
                if (second && (REP_MASK & (1 << 20)) && j >= 48) continue; if (second && (REP_MASK & (1 << 21)) && j < 48) continue;
                if (j < 18) mla_unit(ws, lds, b, j % 6, 7 - j / 6, wave0);
                else if (j < 34) cmp_unit(ws, lds, b, (j - 18) >> 3, 7 - ((j - 18) & 7), wave0);
                else if (j < 64) { const int u = j - 16; mla_unit(ws, lds, b, u % 6, 7 - u / 6, wave0); }
                else mscan_item(ws, b * 36 + (j - 64), wave0); }
        }
        else if (ty == 4 && (PHM & 256)) {
            unsigned* ctrs = (unsigned*)(ws + WS_CTL) + 8192 + ph * 256 + (second ? 128 : 0); int ks = 0;
            for (;;) { const int it = next_item_q(ctrs, lds, wave0, 160, xcc, ks); if (it < 0) break; const int b = it >> 16, j = it & 0xffff;
                if (second && (REP_MASK & (1 << 16)) && j >= 96) continue; if (second && (REP_MASK & (1 << 17)) && j < 96) continue;
                if (j < 36) nsa_branch_unit<AM_SLC>(ws, lds, b, j % 6, 7 - j / 6, wave0);
                else if (j < 84) nsa_branch_unit<AM_WINDOW>(ws, lds, b, (j - 36) % 6, 7 - (j - 36) / 6, wave0);
                else if (j < 96) { const int u = j - 48; nsa_branch_unit<AM_SLC>(ws, lds, b, u % 6, 7 - u / 6, wave0); }
                else mout_item(ws, lds, PIN(I_GMH) + l * 256, PIN(I_SKIP) + l * 256, b * 128 + 2 * (j - 96), wave0); }
        }
        else if (ty == 5) ph_mixnorm(p, l, TID_);
        else if (ty == 6 && (PHM & 8)) {
            pg8::Gemm g{(const bf16*)(ws + WS_HB), (const bf16*)(ws + WT_OUT), T_, D_, D_}; pg8::StaticOrder S; S.init(T_, D_, gridDim.x, blockIdx.x);
            pg8::EpiRes E{(l == 0) ? PIN(I_X) : p.k->out, p.k->out, modl + 2048};
            pg8::gemm_phase<pg8::EpiRes, pg8::StaticOrder, true, true>(lds, g, S, E, wave0);
        }
        else if (ty == 7) norm_rows(p.k->out, PIN(I_GN2) + l * D_, modl + 3072, modl + 4096, (bf16*)(ws + WS_HB), nullptr, 1, GW_, NGW_, fresh_lane());
        else if (ty == 8 && (PHM & 16)) {
            pg8::Gemm g{(const bf16*)(ws + WS_HB), (const bf16*)(ws + WT_GU), T_, 2 * FF, D_}; pg8::StaticOrder S; S.init(T_, 2 * FF, gridDim.x, blockIdx.x);
            pg8::EpiGU E{(bf16*)(ws + WS_ACT)};
            pg8::gemm_phase<pg8::EpiGU, pg8::StaticOrder, true, true>(lds, g, S, E, wave0);
            if (l + 1 < DEPTH) early_transposes(p, l + 1, lds, TID_, 1408 % (int)gridDim.x);
        }
        else if (ty == 9 && (PHM & 32)) {
            pg8::Gemm g{(const bf16*)(ws + WS_ACT), (const bf16*)(ws + WT_DOWN), T_, D_, FF}; pg8::StaticOrder S; S.init(T_, D_, gridDim.x, blockIdx.x);
            pg8::EpiRes E{p.k->out, p.k->out, modl + 5120};
            pg8::gemm_phase<pg8::EpiRes, pg8::StaticOrder, true, true>(lds, g, S, E, wave0);
        }
        if (REP_MASK != 0 && ty >= 0 && ((REP_MASK >> ty) & 1) && !second) { second = true; --ph; } else second = false;
        if (ph + 1 < ph_hi) xcd_barrier(bar, wave0 * 64 + fresh_lane());
    }
}

extern "C" void kernel_launch(void* const* d_in, const int* in_sizes, int n_in, void* d_out, int out_size, void* d_ws, size_t ws_size, hipStream_t stream) {
    if (n_in != N_IN || ws_size < WS_END) { fprintf(stderr, "kernel_launch: unexpected n_in %d / ws %zu\n", n_in, ws_size); return; }
    static int inited = 0;
    if (!inited) { if (hipFuncSetAttribute((const void*)mega, hipFuncAttributeMaxDynamicSharedMemorySize, LDS_BYTES) != hipSuccess) fprintf(stderr, "hipFuncSetAttribute failed\n"); inited = 1; }
    unsigned char* ws = (unsigned char*)d_ws;
    MP base{}; for (int i = 0; i < N_IN; ++i) base.in[i] = (const float*)d_in[i]; base.out = (float*)d_out; base.ws = ws;
    (void)hipMemsetAsync(ws + WS_CTL, 0, CTL_ZERO_BYTES, stream);
    static int grid = 0;
    if (!grid) {
        int dev = 0, cus = 0, per_cu = 0;
        (void)hipGetDevice(&dev); (void)hipDeviceGetAttribute(&cus, hipDeviceAttributeMultiprocessorCount, dev);
        if (hipOccupancyMaxActiveBlocksPerMultiprocessor(&per_cu, (const void*)mega, NTHR, LDS_BYTES) != hipSuccess || per_cu < 1) { fprintf(stderr, "kernel_launch: occupancy query says %d blocks per CU\n", per_cu); per_cu = 1; }
        (void)hipGetLastError();
        grid = cus;
    }
    MP a = base; a.ph_lo = 0; a.ph_hi = NPH; a.coop = 1;
    void* args[] = {&a};
    const hipError_t e = hipLaunchCooperativeKernel((const void*)mega, dim3(grid), dim3(NTHR), args, LDS_BYTES, stream);
    if (e != hipSuccess) fprintf(stderr, "kernel_launch: cooperative launch failed: %s (grid %d)\n", hipGetErrorString(e), grid);
}
```

```cpp
#include <hip/hip_runtime.h>
#include <cstdint>
#include <cstdio>
#include <hip/hip_cooperative_groups.h>

constexpr int B_ = 8, S_ = 2048, T_ = B_ * S_, D_ = 1024, DIN = 2362, FF = 2816, DEPTH = 2;
constexpr float EPS = 1e-6f;
constexpr float LOG2E = 1.4426950408889634f;
constexpr float QSCALE = 0.125f * LOG2E;
constexpr float MSCALE = 0.10206207261596577f * LOG2E;
enum { I_X = 0, I_C, I_POS, I_GN1, I_GN2, I_WADA, I_BADA, I_WIN, I_CMPPOS, I_WCK, I_WCV, I_GOA, I_GQL, I_WUQ, I_GKVL, I_WUKV, I_GOB,
       I_CONVW, I_CONVB, I_WQM, I_WKM, I_BIG, I_BFG, I_GMH, I_SKIP, I_WOUT, I_WGU, I_WDOWN, I_GFIN, N_IN };

constexpr size_t MiB = 1u << 20;
constexpr size_t WS_CTL = 0;
constexpr size_t WS_MOD = 1 * MiB;
constexpr size_t WS_COSP = WS_MOD + 512 * 1024;
constexpr size_t WS_SINP = WS_COSP + 512 * 1024;
constexpr size_t WS_COSM = WS_SINP + 512 * 1024;
constexpr size_t WS_SINM = WS_COSM + 1 * MiB;
constexpr size_t WS_SSQL = WS_SINM + 1 * MiB;
constexpr size_t WS_SSKV = WS_SSQL + 64 * 1024;
constexpr size_t WS_ML = WS_SSKV + 64 * 1024;
constexpr size_t WS_BL = WS_ML + 4096;
constexpr size_t WS_MP = WS_BL + 4096;
constexpr size_t WS_NL = WS_MP + 4096;
constexpr size_t WS_WT = 8 * MiB;
constexpr size_t WS_RAW = WS_WT;
constexpr size_t WS_HB = 34 * MiB;
constexpr size_t WS_NSA = 66 * MiB;
constexpr size_t WS_KVL = 102 * MiB;
constexpr size_t WS_QL = 106 * MiB;
constexpr size_t WS_CM = 114 * MiB;
constexpr size_t WS_GM = 138 * MiB;
constexpr size_t WS_KM = 140 * MiB;
constexpr size_t WS_QM = 158 * MiB;
constexpr size_t WS_VM = 176 * MiB;
constexpr size_t WS_KCV = 188 * MiB;
constexpr size_t WS_OCMP = 189 * MiB;
constexpr size_t WS_SEL = 201 * MiB;
constexpr size_t WS_XC = 202 * MiB;
constexpr size_t WS_MQ = 210 * MiB;
constexpr size_t WS_MK = 218 * MiB;
constexpr size_t WS_CT = 226 * MiB;
constexpr size_t WS_MISCRAW = 242 * MiB;
constexpr size_t WS_KVM = 140 * MiB;
constexpr size_t WS_KR = 246 * MiB;
constexpr size_t WS_OSLC = 164 * MiB;
constexpr size_t WS_OWIN = 176 * MiB;
constexpr size_t WS_ACT = 66 * MiB;
constexpr size_t WS_END = 256 * MiB;
static_assert(WS_NL + 1024 * 64 * 4 <= WS_WT, "tab");
static_assert(WS_ACT + (size_t)T_ * FF * 2 <= WS_KCV, "act overlay");

typedef unsigned short bf16;
__device__ __forceinline__ float bf2f(bf16 v) { return __uint_as_float(((unsigned)v) << 16); }
__device__ __forceinline__ bf16 f2bf(float f) { unsigned u = __float_as_uint(f); return (bf16)((u + 0x7fffu + ((u >> 16) & 1u)) >> 16); }
__device__ __forceinline__ float sigmoidf_(float x) { return 1.f / (1.f + __expf(-x)); }
__device__ __forceinline__ float siluf_(float x) { return x / (1.f + __expf(-x)); }
__device__ __forceinline__ float wave_sum(float v) {
#pragma unroll
    for (int o = 1; o < 64; o <<= 1) v += __shfl_xor(v, o);
    return v;
}

__device__ __forceinline__ int fresh_lane() { int l; asm volatile("v_mbcnt_lo_u32_b32 %0, -1, 0\n\tv_mbcnt_hi_u32_b32 %0, -1, %0" : "=&v"(l)); return l; }
template <int M> __device__ __forceinline__ float sxf(float v) { static_assert(M >= 1 && M < 32, "swizzle xor mask"); return __int_as_float(__builtin_amdgcn_ds_swizzle(__float_as_int(v), (M << 10) | 0x1f)); }
__device__ __forceinline__ float red32_max(float v) { auto r = __builtin_amdgcn_permlane32_swap(__float_as_uint(v), __float_as_uint(v), false, false); return fmaxf(__uint_as_float(r[0]), __uint_as_float(r[1])); }
__device__ __forceinline__ float red32_sum(float v) { auto r = __builtin_amdgcn_permlane32_swap(__float_as_uint(v), __float_as_uint(v), false, false); return __uint_as_float(r[0]) + __uint_as_float(r[1]); }
__device__ __forceinline__ unsigned red32_or(unsigned v) { auto r = __builtin_amdgcn_permlane32_swap(v, v, false, false); return r[0] | r[1]; }
__device__ __forceinline__ float bperm(float v, int src_lane) { return __int_as_float(__builtin_amdgcn_ds_bpermute(src_lane << 2, __float_as_int(v))); }
__device__ __forceinline__ float wave_sum2(float v) { v += sxf<1>(v); v += sxf<2>(v); v += sxf<4>(v); v += sxf<8>(v); v += sxf<16>(v); return red32_sum(v); }
__device__ __forceinline__ float wave_max2(float v) { v = fmaxf(v, sxf<1>(v)); v = fmaxf(v, sxf<2>(v)); v = fmaxf(v, sxf<4>(v)); v = fmaxf(v, sxf<8>(v)); v = fmaxf(v, sxf<16>(v)); return red32_max(v); }
namespace pg8 {
#define PG8_LAS __attribute__((address_space(3)))
typedef unsigned short bf16_t;
typedef short bf16x8 __attribute__((ext_vector_type(8)));
typedef float f32x4 __attribute__((ext_vector_type(4)));
typedef unsigned u32x4 __attribute__((ext_vector_type(4)));
constexpr int BM = 256, BK = 64, HALF = 128, HTB = HALF * BK * 2  , STAGE_BYTES = 8 * HTB, NXCD = 8, WGM = 8;

__host__ __device__ __forceinline__ int lds_byte(int r, int c) { const int st = (r >> 4) * 2 + (c >> 5), rr = r & 15, cc = c & 31, ob = rr * 64 + cc * 2; return st * 1024 + (ob ^ (((ob >> 9) & 1) << 5)); }
__host__ __device__ __forceinline__ void stage_rc(int b, int& R, int& C) { const int st = b / 1024, sb = b % 1024, swz = sb ^ (((sb >> 9) & 1) << 5); R = (st >> 1) * 16 + swz / 64; C = (st & 1) * 32 + (swz % 64) / 2; }
__host__ __device__ __forceinline__ int perm32(int rho) { const int n = rho >> 4, i = rho & 15; return 8 * (i >> 2) + 4 * n + (i & 3); }

struct Unit { int pm, pn; };
struct Gemm { const bf16_t* A; const bf16_t* Bt; int M, N, K; };

struct StaticOrder {
    int nM, nN, nwg, G, c;
    __host__ __device__ void init(int M, int N, int G_, int c_) { nM = M / BM; nN = N / BM; nwg = nM * nN; G = G_; c = c_; }
    __host__ __device__ bool next(int i, Unit& u) const {
        const long L = (long)i * G + c; if (L >= nwg) return false;
        int wgid = (int)L; { const int q = nwg / NXCD, r = nwg % NXCD, xcd = wgid % NXCD, off = wgid / NXCD; wgid = (xcd < r ? xcd * (q + 1) : r * (q + 1) + (xcd - r) * q) + off; }
        const int nig = WGM * nN, gid = wgid / nig, fm = gid * WGM, gsz = (nM - fm) < WGM ? (nM - fm) : WGM;
        u.pm = fm + ((wgid % nig) % gsz); u.pn = (wgid % nig) / gsz; return true;
    }
    __device__ __forceinline__ void a_ready(const Unit&) const {}
    __device__ __forceinline__ void done(const Unit&) const {}
};

__device__ __forceinline__ unsigned cvt_pk_bf16(float lo, float hi) { unsigned r; asm volatile("v_cvt_pk_bf16_f32 %0, %1, %2" : "=v"(r) : "v"(lo), "v"(hi)); return r; }
typedef float f32x2 __attribute__((ext_vector_type(2)));

typedef unsigned u32x4 __attribute__((ext_vector_type(4)));
typedef unsigned u32x2 __attribute__((ext_vector_type(2)));
struct EpiIn {
    static constexpr bool PERM = true, AFTER_DRAIN = false;
    unsigned char* ws; const float *big, *bfg;
#define EPI_ROWS(...) _Pragma("unroll") for (int ai = 0; ai < 2; ++ai) _Pragma("unroll") for (int m = 0; m < 4; ++m) { \
        const int row = u.pm * BM + ai * HALF + wr * 64 + m * 16 + fr; float v[8]; \
        _Pragma("unroll") for (int i = 0; i < 4; ++i) { v[i] = acc[ai][bj][m][0][i]; v[4 + i] = acc[ai][bj][m][1][i]; } \
        asm volatile("" : "+v"(v[0]), "+v"(v[1]), "+v"(v[2]), "+v"(v[3]), "+v"(v[4]), "+v"(v[5]), "+v"(v[6]), "+v"(v[7])); \
        __VA_ARGS__ asm volatile("" ::: "memory"); }
#define EPI_PACK(w) u32x4 w; w.x = cvt_pk_bf16(v[0], v[1]); w.y = cvt_pk_bf16(v[2], v[3]); w.z = cvt_pk_bf16(v[4], v[5]); w.w = cvt_pk_bf16(v[6], v[7]);
    __device__ __forceinline__ void operator()(const f32x4 (&acc)[2][2][4][2], const Unit& u, int wr, int wc, int fr, int fq) const {
        half<0>(acc, u, wr, wc, fr, fq); half<1>(acc, u, wr, wc, fr, fq);
    }
    template <int bj> __device__ __forceinline__ void half(const f32x4 (&acc)[2][2][4][2], const Unit& u, int wr, int wc, int fr, int fq) const {
        {
            const int hb = 2 * u.pn + bj;
            int cb = 32 * wc + 8 * fq; asm volatile("" : "+v"(cb), "+v"(fr));
            if (hb <= 8) {
                bf16_t* nsa = (bf16_t*)(ws + WS_NSA) + hb * 128 + cb;
                const bool rope_hb = (hb <= 3) || hb == 5 || hb == 7;
                if (rope_hb) {
                    const float* cosP = (const float*)(ws + WS_COSP); const float* sinP = (const float*)(ws + WS_SINP);
                    const bool mine = ((wc & 1) == 0) && fq < 2; const float sg = (fq == 0) ? -1.f : 1.f; const float sc = (hb < 3) ? QSCALE : 1.f;
                    f32x4 tc0 = {0.f, 0.f, 0.f, 0.f}, tc1 = tc0, ts0 = tc0, ts1 = tc0;
                    if (mine) { const int r0 = u.pm * BM + wr * 64 + fr; tc0 = *(const f32x4*)(cosP + r0 * 8); tc1 = *(const f32x4*)(cosP + r0 * 8 + 4); ts0 = *(const f32x4*)(sinP + r0 * 8); ts1 = *(const f32x4*)(sinP + r0 * 8 + 4); }
                    EPI_ROWS({
                        float pv[8];
                        _Pragma("unroll") for (int i = 0; i < 8; ++i) pv[i] = sxf<16>(v[i]);
                        const f32x4 c0 = tc0, c1 = tc1, s0 = ts0, s1 = ts1;
                        if (mine && (ai * 4 + m) < 7) { const int nx = ai * 4 + m + 1; const int rn = u.pm * BM + (nx >> 2) * HALF + wr * 64 + (nx & 3) * 16 + fr;
                            tc0 = *(const f32x4*)(cosP + rn * 8); tc1 = *(const f32x4*)(cosP + rn * 8 + 4); ts0 = *(const f32x4*)(sinP + rn * 8); ts1 = *(const f32x4*)(sinP + rn * 8 + 4); }
                        if (mine) {
                            _Pragma("unroll") for (int i = 0; i < 4; ++i) { v[i] = v[i] * c0[i] + sg * pv[i] * s0[i]; v[4 + i] = v[4 + i] * c1[i] + sg * pv[4 + i] * s1[i]; }
                        }
                        _Pragma("unroll") for (int i = 0; i < 8; ++i) v[i] *= sc;
                        EPI_PACK(w) *(u32x4*)(nsa + (size_t)row * 1152) = w;
                    })
                } else {
                    EPI_ROWS({ EPI_PACK(w) *(u32x4*)(nsa + (size_t)row * 1152) = w; })
                }
            } else if (hb <= 11) {
                bf16_t* dst = (hb == 9) ? (bf16_t*)(ws + WS_KVL) + cb : (bf16_t*)(ws + WS_QL) + (hb - 10) * 128 + cb;
                const int ld = (hb == 9) ? 128 : 256;
                float* ssq = (hb == 9) ? (float*)(ws + WS_SSKV) : (float*)(ws + WS_SSQL);
                EPI_ROWS({ EPI_PACK(w) *(u32x4*)(dst + (size_t)row * ld) = w;
                    float sq = 0.f;
                    _Pragma("unroll") for (int i = 0; i < 8; ++i) sq += v[i] * v[i];
                    sq += sxf<16>(sq); sq = red32_sum(sq);
                    if (fq == 0) atomicAdd(ssq + row, sq); })
            } else if (hb <= 17) {
                bf16_t* cm = (bf16_t*)(ws + WS_CM) + (hb - 12) * 128 + cb;
                EPI_ROWS({ EPI_PACK(w) *(u32x4*)(cm + (size_t)row * 768) = w; })
            } else if (hb == 18) {
                float* mr = (float*)(ws + WS_MISCRAW) + cb;
                if (wc < 2) { EPI_ROWS({ *(f32x4*)(mr + (size_t)row * 64) = (f32x4){v[0], v[1], v[2], v[3]}; *(f32x4*)(mr + (size_t)row * 64 + 4) = (f32x4){v[4], v[5], v[6], v[7]}; }) }
            }
        }
    }
#undef EPI_ROWS
#undef EPI_PACK
};
struct EpiUKV {
    static constexpr bool PERM = true, AFTER_DRAIN = false;
    bf16_t* kvm; const float* sskv;
    __device__ __forceinline__ void operator()(const f32x4 (&acc)[2][2][4][2], const Unit& u, int wr, int wc, int fr, int fq) const {
        asm volatile("" : "+v"(fq), "+v"(fr));
        const int col0 = u.pn * BM + wc * 32 + 8 * fq;
        float rs8[8];
#pragma unroll
        for (int i = 0; i < 8; ++i) rs8[i] = sskv[u.pm * BM + (i >> 2) * HALF + wr * 64 + (i & 3) * 16 + fr];
#pragma unroll
        for (int i = 0; i < 8; ++i) rs8[i] = rsqrtf(rs8[i] * (1.f / 128.f) + EPS);
#pragma unroll
        for (int ai = 0; ai < 2; ++ai)
#pragma unroll
            for (int m = 0; m < 4; ++m) { const int row = u.pm * BM + ai * HALF + wr * 64 + m * 16 + fr; bf16_t* rowp = kvm + (size_t)row * 768 + col0;
                const float rs = rs8[ai * 4 + m];
#pragma unroll
                for (int bj = 0; bj < 2; ++bj) { const f32x4 a = acc[ai][bj][m][0] * rs, b = acc[ai][bj][m][1] * rs;
                    u32x4 w; w.x = cvt_pk_bf16(a[0], a[1]); w.y = cvt_pk_bf16(a[2], a[3]); w.z = cvt_pk_bf16(b[0], b[1]); w.w = cvt_pk_bf16(b[2], b[3]);
                    *(u32x4*)(rowp + bj * HALF) = w; } }
    }
};
struct EpiPlain {
    static constexpr bool PERM = true, AFTER_DRAIN = false;
    bf16_t* out; int ld;
    __device__ __forceinline__ void operator()(const f32x4 (&acc)[2][2][4][2], const Unit& u, int wr, int wc, int fr, int fq) const {
        asm volatile("" : "+v"(fq), "+v"(fr));
        const int col0 = u.pn * BM + wc * 32 + 8 * fq;
#pragma unroll
        for (int ai = 0; ai < 2; ++ai)
#pragma unroll
            for (int m = 0; m < 4; ++m) { bf16_t* rowp = out + (size_t)(u.pm * BM + ai * HALF + wr * 64 + m * 16 + fr) * ld + col0;
#pragma unroll
                for (int bj = 0; bj < 2; ++bj) { const f32x4 a = acc[ai][bj][m][0], b = acc[ai][bj][m][1];
                    u32x4 w; w.x = cvt_pk_bf16(a[0], a[1]); w.y = cvt_pk_bf16(a[2], a[3]); w.z = cvt_pk_bf16(b[0], b[1]); w.w = cvt_pk_bf16(b[2], b[3]);
                    *(u32x4*)(rowp + bj * HALF) = w; } }
    }
};
struct EpiRes {
    static constexpr bool PERM = false, AFTER_DRAIN = false;
    const float* xin; float* xout; const float* gate;
    __device__ __forceinline__ void operator()(const f32x4 (&acc)[2][2][4][2], const Unit& u, int wr, int wc, int fr, int fq) const {
        asm volatile("" : "+v"(fq), "+v"(fr));
        const int b = (u.pm * BM) / S_; const int col0 = u.pn * BM + wc * 32 + 4 * fq;
        f32x4 gv[2][2];
#pragma unroll
        for (int bj = 0; bj < 2; ++bj)
#pragma unroll
            for (int n = 0; n < 2; ++n) gv[bj][n] = *(const f32x4*)(gate + (size_t)b * 6144 + col0 + bj * HALF + n * 16);
#pragma unroll
        for (int ai = 0; ai < 2; ++ai)
#pragma unroll
            for (int m = 0; m < 4; ++m) { const size_t off = (size_t)(u.pm * BM + ai * HALF + wr * 64 + m * 16 + fr) * D_ + col0;
#pragma unroll
                for (int bj = 0; bj < 2; ++bj)
#pragma unroll
                    for (int n = 0; n < 2; ++n) { const f32x4 xi = *(const f32x4*)(xin + off + bj * HALF + n * 16); *(f32x4*)(xout + off + bj * HALF + n * 16) = xi + gv[bj][n] * acc[ai][bj][m][n]; } }
    }
};
struct EpiGU {
    static constexpr bool PERM = true, AFTER_DRAIN = false;
    bf16_t* act;
    __device__ __forceinline__ void operator()(const f32x4 (&acc)[2][2][4][2], const Unit& u, int wr, int wc, int fr, int fq) const {
        asm volatile("" : "+v"(fq), "+v"(fr));
        const int col0 = u.pn * HALF + wc * 32 + 8 * fq;
#pragma unroll
        for (int ai = 0; ai < 2; ++ai)
#pragma unroll
            for (int m = 0; m < 4; ++m) { const int row = u.pm * BM + ai * HALF + wr * 64 + m * 16 + fr; float o[8];
#pragma unroll
                for (int n = 0; n < 2; ++n)
#pragma unroll
                    for (int i = 0; i < 4; ++i) { const float g = acc[ai][0][m][n][i], up = acc[ai][1][m][n][i]; o[4 * n + i] = g / (1.f + __expf(-g)) * up; }
                u32x4 w; w.x = cvt_pk_bf16(o[0], o[1]); w.y = cvt_pk_bf16(o[2], o[3]); w.z = cvt_pk_bf16(o[4], o[5]); w.w = cvt_pk_bf16(o[6], o[7]);
                *(u32x4*)(act + (size_t)row * FF + col0) = w; }
    }
};
template <class Epi, class Sched, bool ALIGN_EPI = false, bool SP2 = false>
__device__ __forceinline__ void gemm_phase(PG8_LAS unsigned char* lds, const Gemm g, const Sched& S, const Epi& E, int wid_in) {
    const int wid = __builtin_amdgcn_readfirstlane(wid_in), lane = fresh_lane(), tid = wid * 64 + lane, wr = wid >> 2, wc = wid & 3;
    const int K = g.K, nt = K / BK;
    unsigned voffA[2], voffB[2];
#pragma unroll
    for (int i = 0; i < 2; ++i) { int R, C; stage_rc(tid * 16 + i * 8192, R, C); const int Rb = Epi::PERM ? ((R & ~31) + perm32(R & 31)) : R;
        voffA[i] = (unsigned)(R * K + C) * 2u; voffB[i] = (unsigned)(Rb * K + C) * 2u; }
    const size_t kstep = (size_t)(BK * 2);
    const size_t hstep = (size_t)HALF * K * 2;
    const size_t tstep = 2 * hstep;
    const unsigned ldsw = (unsigned)wid * 1024u;
    const int aoff = lds_byte(wr * 64 + (lane & 15), (lane >> 4) * 8), boff = lds_byte(wc * 32 + (lane & 15), (lane >> 4) * 8);
#define PG8_SA(b, h) (((b) * 2 + (h)) * HTB)
#define PG8_SB(b, h) ((4 + (b) * 2 + (h)) * HTB)
#define PG8_STAGE(bufoff, gbase, voff) do { _Pragma("unroll") for (int _i = 0; _i < 2; ++_i) \
        __builtin_amdgcn_global_load_lds((const unsigned*)((const char*)(gbase) + (voff)[_i]), (PG8_LAS unsigned*)(lds + (bufoff) + ldsw + _i * 8192), 16, 0, 0); } while (0)
#define PG8_LDA(dst, b, h) do { _Pragma("unroll") for (int m = 0; m < 4; ++m) _Pragma("unroll") for (int k = 0; k < 2; ++k) dst[m][k] = *(const PG8_LAS bf16x8*)(lds + PG8_SA(b, h) + aoff + m * 2048 + k * 1024); } while (0)
#define PG8_LDB(dst, b, h) do { _Pragma("unroll") for (int n = 0; n < 2; ++n) _Pragma("unroll") for (int k = 0; k < 2; ++k) dst[n][k] = *(const PG8_LAS bf16x8*)(lds + PG8_SB(b, h) + boff + n * 2048 + k * 1024); } while (0)
#define PG8_MMA(ai, bj, At, Bt) do { __builtin_amdgcn_s_setprio(1); _Pragma("unroll") for (int m = 0; m < 4; ++m) _Pragma("unroll") for (int n = 0; n < 2; ++n) _Pragma("unroll") for (int k = 0; k < 2; ++k) \
        acc[ai][bj][m][n] = __builtin_amdgcn_mfma_f32_16x16x32_bf16(Bt[n][k], At[m][k], acc[ai][bj][m][n], 0, 0, 0); __builtin_amdgcn_s_setprio(0); } while (0)
#define PG8_WAIT_V(n) asm volatile("s_waitcnt vmcnt(" #n ")" ::: "memory")
#define PG8_WAIT_L(n) asm volatile("s_waitcnt lgkmcnt(" #n ")" ::: "memory")
#define PG8_BAR __builtin_amdgcn_s_barrier()
#define PG8_SCHED __builtin_amdgcn_sched_barrier(0)
    Unit cur, nxt; int ui = 0;
    if (!S.next(0, cur)) return;
    f32x4 acc[2][2][4][2];
#pragma unroll
    for (int a = 0; a < 2; ++a)
#pragma unroll
        for (int b = 0; b < 2; ++b)
#pragma unroll
            for (int m = 0; m < 4; ++m)
#pragma unroll
                for (int n = 0; n < 2; ++n) acc[a][b][m][n] = (f32x4){0.f, 0.f, 0.f, 0.f};
    bf16x8 At[4][2], B0[2][2], B1[2][2];
    const char* cA = (const char*)g.A + (size_t)cur.pm * tstep; const char* cB = (const char*)g.Bt + (size_t)cur.pn * tstep;
    S.a_ready(cur);
    if constexpr (SP2) {
        PG8_STAGE(PG8_SB(0, 0), cB, voffB); PG8_STAGE(PG8_SB(0, 1), cB + hstep, voffB); PG8_STAGE(PG8_SA(0, 0), cA, voffA); PG8_STAGE(PG8_SA(0, 1), cA + hstep, voffA);
        if (wr == 1) PG8_BAR;
        PG8_WAIT_V(2); PG8_BAR;
        PG8_STAGE(PG8_SB(1, 0), cB + kstep, voffB); PG8_STAGE(PG8_SA(1, 0), cA + kstep, voffA); PG8_STAGE(PG8_SB(1, 1), cB + hstep + kstep, voffB);
        PG8_WAIT_V(6); PG8_BAR;
    } else {
        PG8_STAGE(PG8_SB(0, 0), cB, voffB); PG8_STAGE(PG8_SA(0, 0), cA, voffA); PG8_STAGE(PG8_SB(0, 1), cB + hstep, voffB); PG8_STAGE(PG8_SA(0, 1), cA + hstep, voffA);
        if (wr == 1) PG8_BAR;
        PG8_WAIT_V(4); PG8_BAR;
        PG8_STAGE(PG8_SB(1, 0), cB + kstep, voffB); PG8_STAGE(PG8_SA(1, 0), cA + kstep, voffA); PG8_STAGE(PG8_SB(1, 1), cB + hstep + kstep, voffB);
        PG8_WAIT_V(6); PG8_BAR;
    }
    for (;;) {
        const bool has_next = S.next(ui + 1, nxt);
        const char* nA = has_next ? (const char*)g.A + (size_t)nxt.pm * tstep : cA; const char* nB = has_next ? (const char*)g.Bt + (size_t)nxt.pn * tstep : cB;
        for (int t = 0; t < nt; t += 2) {
            const bool last = (t == nt - 2);
            const char* a1 = cA + (size_t)(t + 1) * kstep;
            const char* a2 = last ? nA : cA + (size_t)(t + 2) * kstep; const char* b2 = last ? nB : cB + (size_t)(t + 2) * kstep;
            const char* a3 = a2 + kstep; const char* b3 = b2 + kstep;
            if (last && has_next) S.a_ready(nxt);
            if constexpr (SP2) {
            PG8_LDB(B0, 0, 0); PG8_LDB(B1, 0, 1); PG8_SCHED; PG8_LDA(At, 0, 0); PG8_STAGE(PG8_SA(1, 1), a1 + hstep, voffA);
            PG8_WAIT_V(8); PG8_WAIT_L(0); PG8_BAR; PG8_MMA(0, 0, At, B0); PG8_MMA(0, 1, At, B1); PG8_BAR; PG8_SCHED;
            PG8_LDA(At, 0, 1); PG8_STAGE(PG8_SB(0, 0), b2, voffB); PG8_STAGE(PG8_SB(0, 1), b2 + hstep, voffB); PG8_STAGE(PG8_SA(0, 0), a2, voffA);
            PG8_WAIT_V(8); PG8_WAIT_L(0); PG8_BAR; PG8_MMA(1, 0, At, B0); PG8_MMA(1, 1, At, B1); PG8_BAR; PG8_SCHED;
            PG8_LDB(B0, 1, 0); PG8_LDB(B1, 1, 1); PG8_SCHED; PG8_LDA(At, 1, 0); PG8_STAGE(PG8_SA(0, 1), a2 + hstep, voffA);
            PG8_WAIT_V(8); PG8_WAIT_L(0); PG8_BAR; PG8_MMA(0, 0, At, B0); PG8_MMA(0, 1, At, B1); PG8_BAR; PG8_SCHED;
            PG8_LDA(At, 1, 1); PG8_STAGE(PG8_SB(1, 0), b3, voffB); PG8_STAGE(PG8_SB(1, 1), b3 + hstep, voffB); PG8_STAGE(PG8_SA(1, 0), a3, voffA);
            PG8_WAIT_V(8); PG8_WAIT_L(0); PG8_BAR; PG8_MMA(1, 0, At, B0); PG8_MMA(1, 1, At, B1); PG8_BAR; PG8_SCHED;
            } else {
            PG8_LDB(B0, 0, 0); PG8_SCHED; PG8_LDA(At, 0, 0); PG8_STAGE(PG8_SA(1, 1), a1 + hstep, voffA);
            PG8_WAIT_L(8); PG8_BAR; PG8_WAIT_L(0); PG8_MMA(0, 0, At, B0); PG8_BAR; PG8_SCHED;
            PG8_LDB(B1, 0, 1); PG8_STAGE(PG8_SB(0, 0), b2, voffB);
            PG8_BAR; PG8_WAIT_L(0); PG8_MMA(0, 1, At, B1); PG8_BAR;
            PG8_LDA(At, 0, 1); PG8_STAGE(PG8_SA(0, 0), a2, voffA);
            PG8_BAR; PG8_WAIT_L(0); PG8_MMA(1, 0, At, B0); PG8_BAR; PG8_SCHED;
            PG8_STAGE(PG8_SB(0, 1), b2 + hstep, voffB);
            PG8_WAIT_V(6); PG8_BAR; PG8_MMA(1, 1, At, B1); PG8_BAR;
            PG8_LDB(B0, 1, 0); PG8_SCHED; PG8_LDA(At, 1, 0); PG8_STAGE(PG8_SA(0, 1), a2 + hstep, voffA);
            PG8_WAIT_L(8); PG8_BAR; PG8_WAIT_L(0); PG8_MMA(0, 0, At, B0); PG8_BAR; PG8_SCHED;
            PG8_LDB(B1, 1, 1); PG8_STAGE(PG8_SB(1, 0), b3, voffB);
            PG8_BAR; PG8_WAIT_L(0); PG8_MMA(0, 1, At, B1); PG8_BAR;
            PG8_LDA(At, 1, 1); PG8_STAGE(PG8_SA(1, 0), a3, voffA);
            PG8_BAR; PG8_WAIT_L(0); PG8_MMA(1, 0, At, B0); PG8_BAR; PG8_SCHED;
            PG8_STAGE(PG8_SB(1, 1), b3 + hstep, voffB);
            PG8_WAIT_V(6); PG8_BAR; PG8_MMA(1, 1, At, B1); PG8_BAR;
            }
        }
        if constexpr (ALIGN_EPI) { if (wr == 0) PG8_BAR; }
        if constexpr (!Epi::AFTER_DRAIN) { const int ln = fresh_lane(); E(acc, cur, wr, wc, ln & 15, ln >> 4); S.done(cur); }
        if (!has_next) break;
#pragma unroll
        for (int a = 0; a < 2; ++a)
#pragma unroll
            for (int b = 0; b < 2; ++b)
#pragma unroll
                for (int m = 0; m < 4; ++m)
#pragma unroll
                    for (int n = 0; n < 2; ++n) acc[a][b][m][n] = (f32x4){0.f, 0.f, 0.f, 0.f};
        cur = nxt; cA = nA; cB = nB; ++ui;
        if constexpr (ALIGN_EPI) { if (wr == 1) PG8_BAR; }
    }
    PG8_WAIT_V(0);
    if constexpr (!ALIGN_EPI) { if (wr == 0) PG8_BAR; }
    PG8_BAR;
    if constexpr (Epi::AFTER_DRAIN) { const int ln = fresh_lane(); E.fused(acc, cur, wr, wc, ln & 15, ln >> 4, lds, wid, ln); S.done(cur); }
#undef PG8_SA
#undef PG8_SB
#undef PG8_STAGE
#undef PG8_LDA
#undef PG8_LDB
#undef PG8_MMA
#undef PG8_WAIT_V
#undef PG8_WAIT_L
#undef PG8_BAR
#undef PG8_SCHED
}
}

#define GAS __attribute__((address_space(1)))
#define LAS __attribute__((address_space(3)))
typedef float f32x4 __attribute__((ext_vector_type(4)));
typedef unsigned v4u __attribute__((ext_vector_type(4)));
typedef GAS unsigned gu32;
#define XB_TMO      128
#define XB_XCNT(j)  (256  + 64 * (j))
#define XB_XSUB(j)  (1280 + 64 * (j))
#define XB_XGEN(j)  (2304 + 64 * (j))
#define XB_TOP      3328
#define XB_TOPGEN   3392
#define XCD_BAR_WORDS 3456
#define XB_SPIN_CAP (1u << 18)

__device__ __forceinline__ unsigned xb_ld(unsigned* p)              { return __hip_atomic_load(p, __ATOMIC_RELAXED, __HIP_MEMORY_SCOPE_AGENT); }
__device__ __forceinline__ unsigned xb_add(unsigned* p, unsigned v) { return __hip_atomic_fetch_add(p, v, __ATOMIC_RELAXED, __HIP_MEMORY_SCOPE_AGENT); }
__device__ __forceinline__ unsigned xb_xcc_id() { return (unsigned)__builtin_amdgcn_s_getreg((3 << 11) | 20) & 0xFu; }
#define XB_SPIN(cond, bar) do { unsigned _sp = 0; while (cond) { __builtin_amdgcn_s_sleep(1); \
    if ((++_sp & 255u) == 0u) { if (xb_ld(&(bar)[XB_TMO])) break; if (_sp > XB_SPIN_CAP) { atomicAdd(&(bar)[XB_TMO], 1u); break; } } } } while (0)

struct XcdBarrier {
    unsigned* bar; unsigned x;
    volatile LAS unsigned* st;
};

__device__ __forceinline__ XcdBarrier xcd_barrier_post(unsigned* bar, volatile LAS unsigned* st, int tid) {
    XcdBarrier b; b.bar = bar; b.x = xb_xcc_id(); b.st = st;
    if (tid == 0) (void)xb_add(&bar[XB_XCNT(b.x)], 1u);
    return b;
}
__device__ __forceinline__ void xcd_barrier_complete(unsigned* bar, unsigned x, unsigned& nloc, unsigned& nx) {
    const unsigned G = gridDim.x * gridDim.y * gridDim.z;
    unsigned sum, cnt, mine, sp = 0u;
    for (;;) {
        sum = 0u; cnt = 0u; mine = 0u;
#pragma unroll
        for (unsigned j = 0; j < 16; ++j) { const unsigned c = xb_ld(&bar[XB_XCNT(j)]); sum += c; cnt += (c > 0u) ? 1u : 0u; mine = (j == x) ? c : mine; }
        if (sum == G) break;
        __builtin_amdgcn_s_sleep(1);
        if ((++sp & 255u) == 0u) { if (xb_ld(&bar[XB_TMO])) break; if (sp > XB_SPIN_CAP) { atomicAdd(&bar[XB_TMO], 1u); break; } }
    }
    nloc = mine > 0u ? mine : 1u; nx = cnt > 0u ? cnt : 1u;
}

__device__ __forceinline__ void xcd_barrier(const XcdBarrier& b, int tid) {
    asm volatile("s_waitcnt vmcnt(0)" ::: "memory");
    __syncthreads();
    if (tid == 0) {
        unsigned* bar = b.bar;
        __builtin_amdgcn_s_waitcnt(0);
        unsigned nloc = b.st[0], nx = b.st[1];
        if (nloc == 0u) { xcd_barrier_complete(bar, b.x, nloc, nx); b.st[0] = nloc; b.st[1] = nx; }
        const unsigned old = xb_add(&bar[XB_XSUB(b.x)], 1u);
        const unsigned gen = old / nloc;
        if (old + 1u == (gen + 1u) * nloc) {
            __builtin_amdgcn_fence(__ATOMIC_RELEASE, "agent");
            asm volatile("s_waitcnt vmcnt(0)" ::: "memory");
            const unsigned og = xb_add(&bar[XB_TOP], 1u);
            const unsigned tg = og / nx;
            if (og + 1u == (tg + 1u) * nx) xb_add(&bar[XB_TOPGEN], 1u);
            else XB_SPIN(xb_ld(&bar[XB_TOPGEN]) == tg, bar);
            __builtin_amdgcn_fence(__ATOMIC_ACQUIRE, "agent");
            xb_add(&bar[XB_XGEN(b.x)], 1u);
            asm volatile("s_waitcnt vmcnt(0)" ::: "memory");
        } else {
            XB_SPIN(xb_ld(&bar[XB_XGEN(b.x)]) == gen, bar);
            __builtin_amdgcn_fence(__ATOMIC_ACQUIRE, "agent");
            asm volatile("s_waitcnt vmcnt(0)" ::: "memory");
        }
    }
    __syncthreads();
}

constexpr int NTHR = 512, NWAVES = 8;
constexpr int RING_BYTES = 131072, MISC_OFF = RING_BYTES + 320, LDS_BYTES = 147456;
constexpr int CW_BAR = 4096;
constexpr size_t CTL_ZERO_BYTES = 64 * 1024;
constexpr size_t WT_IN = WS_WT, WT_OUT = WT_IN + (size_t)2560 * 1024 * 2, WT_GU = WT_OUT + (size_t)1024 * 1024 * 2, WT_DOWN = WT_GU + (size_t)5632 * 1024 * 2,
                 WT_UQ = WT_DOWN + (size_t)1024 * 2816 * 2, WT_UKV = WT_UQ + (size_t)768 * 256 * 2, WT_CK = WT_UKV + (size_t)768 * 128 * 2, WT_CV = WT_CK + (size_t)64 * 2048 * 2,
                 WT_QM = WT_CV + (size_t)64 * 2048 * 2, WT_KM = WT_QM + 4 * 64 * 64 * 2, WT_END = WT_KM + 4 * 64 * 64 * 2;
static_assert(WT_END <= WS_HB, "weights");
constexpr int NPH = 22, PPL = 10;
constexpr int PROBE_SEL = 0;
constexpr int REP_MASK = 0;
#ifndef PHM
#define PHM 0xffff
#endif
struct MP { const float* in[N_IN]; float* out; unsigned char* ws; int ph_lo, ph_hi, coop, pad; };

struct MPK {
    const __attribute__((address_space(4))) MP* k;
    struct InArr { const __attribute__((address_space(4))) MP* k; __device__ __forceinline__ const float* operator[](int i) const { return k->in[i]; } };
    __device__ __forceinline__ InArr in_() const { return InArr{k}; }
};
#define PIN(i) (p.k->in[i])
__device__ __forceinline__ unsigned pk2(float lo, float hi) { return (unsigned)f2bf(lo) | ((unsigned)f2bf(hi) << 16); }
struct MapId { int n; __device__ __forceinline__ int operator()(int c) const { return c < n ? c : -1; } };
struct MapIn { __device__ __forceinline__ int operator()(int c) const {
    if (c < 1152) return c; if (c < 1280) return 1426 + (c - 1152); if (c < 1536) return 1170 + (c - 1280); if (c < 2304) return 1586 + (c - 1536);
    if (c < 2336) return 1554 + (c - 2304); if (c < 2354) return 1152 + (c - 2336); if (c < 2362) return c; return -1; } };
struct MapGU { __device__ __forceinline__ int operator()(int c) const { const int t = c >> 8, w = c & 255; return (w < 128) ? t * 128 + w : FF + t * 128 + (w - 128); } };
template <class Map> __device__ __forceinline__ void transpose_item(const float* W, int K, int ldw, const Map& map, const float* kscale, bf16* WT, LAS float* scr, int item, int nblk, int lane) {
    const int kb = item / nblk, nb = item % nblk, k0 = 64 * kb, n0 = 32 * nb;
    const int np = 2 * (lane & 15);
    const int sc = map(n0 + np);
    float2 tv[16];
#pragma unroll
    for (int i = 0; i < 16; ++i) { const int kk = 4 * i + (lane >> 4); tv[i] = (sc >= 0) ? *(const float2*)(W + (size_t)(k0 + kk) * ldw + sc) : make_float2(0.f, 0.f); }
    asm volatile("" : "+v"(tv[0]), "+v"(tv[1]), "+v"(tv[2]), "+v"(tv[3]), "+v"(tv[4]), "+v"(tv[5]), "+v"(tv[6]), "+v"(tv[7]));
    asm volatile("" : "+v"(tv[8]), "+v"(tv[9]), "+v"(tv[10]), "+v"(tv[11]), "+v"(tv[12]), "+v"(tv[13]), "+v"(tv[14]), "+v"(tv[15]));
#pragma unroll
    for (int i = 0; i < 16; ++i) { const int kk = 4 * i + (lane >> 4); float2 v = tv[i];
        if (kscale) { const float ksc = kscale[k0 + kk]; v.x *= ksc; v.y *= ksc; } scr[kk * 33 + np] = v.x; scr[kk * 33 + np + 1] = v.y; }
    asm volatile("s_waitcnt lgkmcnt(0)" ::: "memory");
    const int c = lane & 7;
#pragma unroll
    for (int j = 0; j < 4; ++j) { const int n = (lane >> 3) + 8 * j; const LAS float* s = scr + (8 * c) * 33 + n;
        v4u o; o.x = pk2(s[0 * 33], s[1 * 33]); o.y = pk2(s[2 * 33], s[3 * 33]); o.z = pk2(s[4 * 33], s[5 * 33]); o.w = pk2(s[6 * 33], s[7 * 33]);
        *(v4u*)(WT + (size_t)(n0 + n) * K + k0 + 8 * c) = o; }
    asm volatile("s_waitcnt lgkmcnt(0)" ::: "memory");
}
__device__ __forceinline__ void norm_rows(const float* x, const float* g, const float* shift, const float* scale, bf16* hb, float* outf, int mode, int gw, int ngw, int lane) {
    const int rpw = T_ / ngw, m0 = gw * rpw, b = m0 / S_;
    float4 gs[4], sh[4];
#pragma unroll
    for (int j = 0; j < 4; ++j) { const int col = 4 * lane + 256 * j; gs[j] = *(const float4*)(g + col);
        if (mode != 2) { const float4 sc = *(const float4*)(scale + (size_t)b * 6144 + col); sh[j] = *(const float4*)(shift + (size_t)b * 6144 + col);
            gs[j].x *= 1.f + sc.x; gs[j].y *= 1.f + sc.y; gs[j].z *= 1.f + sc.z; gs[j].w *= 1.f + sc.w; }
        else sh[j] = make_float4(0.f, 0.f, 0.f, 0.f); }
    float4 nv[4], nw[4];
    { const float4* xr = (const float4*)(x + (size_t)m0 * D_) + lane;
#pragma unroll
      for (int j = 0; j < 4; ++j) { nv[j] = xr[64 * j]; nw[j] = xr[D_ / 4 + 64 * j]; } }
    for (int r = 0; r < rpw; r += 2) {
        const int m = m0 + r;
        float4 v[4], w[4]; float s = 0.f, s2 = 0.f;
#pragma unroll
        for (int j = 0; j < 4; ++j) { v[j] = nv[j]; w[j] = nw[j]; }
        if (r + 2 < rpw) { const float4* xr = (const float4*)(x + (size_t)(m + 2) * D_) + lane;
#pragma unroll
            for (int j = 0; j < 4; ++j) { nv[j] = xr[64 * j]; nw[j] = xr[D_ / 4 + 64 * j]; } }
#pragma unroll
        for (int j = 0; j < 4; ++j) { s += v[j].x * v[j].x + v[j].y * v[j].y + v[j].z * v[j].z + v[j].w * v[j].w; s2 += w[j].x * w[j].x + w[j].y * w[j].y + w[j].z * w[j].z + w[j].w * w[j].w; }
        const float r1 = rsqrtf(wave_sum2(s) * (1.f / D_) + EPS), r2 = rsqrtf(wave_sum2(s2) * (1.f / D_) + EPS);
#pragma unroll
        for (int j = 0; j < 4; ++j) {
            const int col = 4 * lane + 256 * j;
            float4 o, o2;
            o.x = v[j].x * r1 * gs[j].x + sh[j].x; o.y = v[j].y * r1 * gs[j].y + sh[j].y; o.z = v[j].z * r1 * gs[j].z + sh[j].z; o.w = v[j].w * r1 * gs[j].w + sh[j].w;
            o2.x = w[j].x * r2 * gs[j].x + sh[j].x; o2.y = w[j].y * r2 * gs[j].y + sh[j].y; o2.z = w[j].z * r2 * gs[j].z + sh[j].z; o2.w = w[j].w * r2 * gs[j].w + sh[j].w;
            if (mode == 2) { *(float4*)(outf + (size_t)m * D_ + col) = o; *(float4*)(outf + (size_t)(m + 1) * D_ + col) = o2; }
            else { uint2 q; q.x = pk2(o.x, o.y); q.y = pk2(o.z, o.w); *(uint2*)(hb + (size_t)m * D_ + col) = q;
                   uint2 q2; q2.x = pk2(o2.x, o2.y); q2.y = pk2(o2.z, o2.w); *(uint2*)(hb + (size_t)(m + 1) * D_ + col) = q2; }
        }
    }
}
__device__ __forceinline__ void ph_p0(const MPK& p, LAS unsigned char* lds, int tid) {
    const int wave = tid >> 6, lane = tid & 63;
    LAS float* ca = (LAS float*)lds; LAS float* red = ca + 8192;
    unsigned char* ws = p.k->ws; float* mod = (float*)(ws + WS_MOD);
    const float* c = PIN(I_C);
    for (int i = tid; i < 8192; i += NTHR) ca[i] = siluf_(c[i]);
    __syncthreads();
    for (int item = blockIdx.x; item < 96; item += gridDim.x) {
        const int l = item / 48, j = (item % 48) * 128 + 2 * lane;
        const float* w = PIN(I_WADA) + (size_t)l * 1024 * 6144 + j;
        float acc[8][2];
#pragma unroll
        for (int b = 0; b < 8; ++b) { acc[b][0] = 0.f; acc[b][1] = 0.f; }
#pragma unroll 8
        for (int k = wave * 128; k < wave * 128 + 128; ++k) {
            const float2 wv = *(const float2*)(w + (size_t)k * 6144);
#pragma unroll
            for (int b = 0; b < 8; ++b) { const float cv = ca[b * 1024 + k]; acc[b][0] += cv * wv.x; acc[b][1] += cv * wv.y; }
        }
#pragma unroll
        for (int b = 0; b < 8; ++b) { red[(wave * 8 + b) * 128 + 2 * lane] = acc[b][0]; red[(wave * 8 + b) * 128 + 2 * lane + 1] = acc[b][1]; }
        __syncthreads();
        { const int b = wave;
#pragma unroll
          for (int c2 = 0; c2 < 2; ++c2) { float s2 = 0.f;
#pragma unroll
            for (int w8 = 0; w8 < 8; ++w8) s2 += red[(w8 * 8 + b) * 128 + c2 * 64 + lane];
            mod[((size_t)l * 8 + b) * 6144 + (item % 48) * 128 + c2 * 64 + lane] = s2 + PIN(I_BADA)[l * 6144 + (item % 48) * 128 + c2 * 64 + lane]; } }
        __syncthreads();
    }
    const int* pos = (const int*)PIN(I_POS);
    float *cosP = (float*)(ws + WS_COSP), *sinP = (float*)(ws + WS_SINP), *cosM = (float*)(ws + WS_COSM), *sinM = (float*)(ws + WS_SINM);
    for (int i = blockIdx.x * NTHR + tid; i < T_ * 24; i += gridDim.x * NTHR) {
        const int m = i / 24, f = i % 24;
        double inv; if (f < 8) inv = pow(500000.0, -(double)(2 * f) / 16.0); else inv = pow(500000.0, -(double)(2 * (f - 8)) / 32.0);
        const float ang = (float)pos[m] * (float)inv;
        const double a = (double)ang, kq = rint(a * 0.15915494309189535), r = a - kq * 6.283185307179586476925;
        const float cs = (float)cos(r), sn = (float)sin(r);
        if (f < 8) { cosP[m * 8 + f] = cs; sinP[m * 8 + f] = sn; } else { cosM[m * 16 + f - 8] = cs; sinM[m * 16 + f - 8] = sn; }
    }
}
__device__ __forceinline__ void early_transposes(const MPK& p, int l, LAS unsigned char* lds, int tid, int first) {
    const int wave = tid >> 6, lane = tid & 63;
    if ((int)blockIdx.x < first) return;
    const int gw = ((int)blockIdx.x - first) * NWAVES + wave, ngw = ((int)gridDim.x - first) * NWAVES;
    unsigned char* ws = p.k->ws;
    LAS float* scr = (LAS float*)(lds + wave * 8704);
    constexpr int I0 = 16 * 80, I4 = 4 * 24, I5 = 2 * 24, I6 = 32 * 2, I7 = 32 * 2, I8 = 8, I9 = 8;
    constexpr int NIT = I0 + I4 + I5 + I6 + I7 + I8 + I9;
    for (int it = gw; it < NIT; it += ngw) {
        int r = it;
        if (r < I0) { transpose_item(PIN(I_WIN) + (size_t)l * D_ * DIN, D_, DIN, MapIn{}, nullptr, (bf16*)(ws + WT_IN), scr, r, 80, lane); continue; } r -= I0;
        if (r < I4) { transpose_item(PIN(I_WUQ) + (size_t)l * 256 * 576, 256, 576, MapId{576}, PIN(I_GQL) + l * 256, (bf16*)(ws + WT_UQ), scr, r, 24, lane); continue; } r -= I4;
        if (r < I5) { transpose_item(PIN(I_WUKV) + (size_t)l * 128 * 768, 128, 768, MapId{768}, PIN(I_GKVL) + l * 128, (bf16*)(ws + WT_UKV), scr, r, 24, lane); continue; } r -= I5;
        if (r < I6) { transpose_item(PIN(I_WCK) + (size_t)l * 2048 * 64, 2048, 64, MapId{64}, nullptr, (bf16*)(ws + WT_CK), scr, r, 2, lane); continue; } r -= I6;
        if (r < I7) { transpose_item(PIN(I_WCV) + (size_t)l * 2048 * 64, 2048, 64, MapId{64}, nullptr, (bf16*)(ws + WT_CV), scr, r, 2, lane); continue; } r -= I7;
        if (r < I8) { const int h = r >> 1; transpose_item(PIN(I_WQM) + (size_t)l * 16384 + h * 4096, 64, 64, MapId{64}, nullptr, (bf16*)(ws + WT_QM) + h * 4096, scr, r & 1, 2, lane); continue; } r -= I8;
        { const int h = r >> 1; transpose_item(PIN(I_WKM) + (size_t)l * 16384 + h * 4096, 64, 64, MapId{64}, nullptr, (bf16*)(ws + WT_KM) + h * 4096, scr, r & 1, 2, lane); }
    }
}
__device__ __forceinline__ void ph_prep(const MPK& p, int l, LAS unsigned char* lds, int tid) {
    const int wave = tid >> 6, lane = tid & 63;
    const int gw = blockIdx.x * NWAVES + wave, ngw = gridDim.x * NWAVES;
    unsigned char* ws = p.k->ws;
    LAS float* scr = (LAS float*)(lds + wave * 8704);
    for (int i = blockIdx.x * NTHR + tid; i < 2 * T_; i += gridDim.x * NTHR) ((float*)(ws + WS_SSQL))[i] = 0.f;
    if (l == 0) early_transposes(p, l, lds, tid, 0);
    const float* xin = (l == 0) ? PIN(I_X) : p.k->out;
    const float* modl = (const float*)(ws + WS_MOD) + (size_t)l * 8 * 6144;
    norm_rows(xin, PIN(I_GN1) + l * D_, modl + 0, modl + 1024, (bf16*)(ws + WS_HB), nullptr, 0, gw, ngw, lane);
}
__device__ __forceinline__ void late_transposes(const MPK& p, int l, LAS unsigned char* lds, int tid, int first) {
    const int wave = tid >> 6, lane = tid & 63;
    if ((int)blockIdx.x < first) return;
    const int gw = ((int)blockIdx.x - first) * NWAVES + wave, ngw = ((int)gridDim.x - first) * NWAVES;
    unsigned char* ws = p.k->ws;
    LAS float* scr = (LAS float*)(lds + wave * 8704);
    constexpr int I1 = 16 * 32, I2 = 16 * 176, I3 = 44 * 32;
    for (int it = gw; it < I1 + I2 + I3; it += ngw) {
        int r = it;
        if (r < I1) { transpose_item(PIN(I_WOUT) + (size_t)l * D_ * D_, D_, D_, MapId{D_}, nullptr, (bf16*)(ws + WT_OUT), scr, r, 32, lane); continue; } r -= I1;
        if (r < I2) { transpose_item(PIN(I_WGU) + (size_t)l * D_ * 2 * FF, D_, 2 * FF, MapGU{}, nullptr, (bf16*)(ws + WT_GU), scr, r, 176, lane); continue; } r -= I2;
        transpose_item(PIN(I_WDOWN) + (size_t)l * FF * D_, FF, D_, MapId{D_}, nullptr, (bf16*)(ws + WT_DOWN), scr, r, 32, lane);
    }
}
__device__ __forceinline__ void ph_mixnorm(const MPK& p, int l, int tid) {
    const int gw = blockIdx.x * NWAVES + (tid >> 6), ngw = gridDim.x * NWAVES, lane = tid & 63;
    unsigned char* ws = p.k->ws;
    bf16* mix = (bf16*)(ws + WS_HB); const float* ga = PIN(I_GOA) + l * 384; const float* gb = PIN(I_GOB) + l * 384;
    const bf16 *oc = (const bf16*)(ws + WS_OCMP), *os = (const bf16*)(ws + WS_OSLC), *ow = (const bf16*)(ws + WS_OWIN); const float* gm = (const float*)(ws + WS_GM);
#define UNPK8(dst, src) dst[0] = __uint_as_float(src.x << 16); dst[1] = __uint_as_float(src.x & 0xffff0000u); dst[2] = __uint_as_float(src.y << 16); dst[3] = __uint_as_float(src.y & 0xffff0000u); \
    dst[4] = __uint_as_float(src.z << 16); dst[5] = __uint_as_float(src.z & 0xffff0000u); dst[6] = __uint_as_float(src.w << 16); dst[7] = __uint_as_float(src.w & 0xffff0000u);
    const int rpw = T_ / ngw;
    const float* ggp = (lane < 48) ? ga + lane * 8 : gb + (lane - 48) * 8; const float4 gA0 = *(const float4*)ggp, gA1 = *(const float4*)(ggp + 4);
    const float* ggq = gb + (16 + (lane & 31)) * 8; const float4 gB0 = *(const float4*)ggq, gB1 = *(const float4*)(ggq + 4);
    v4u ra4, rb4, rc4, ry4; float rg0, rg1, rg2;
#define MIX_LOAD(m_) do { const bf16* r_ = mix + (size_t)(m_) * D_; \
        if (lane < 48) { const size_t o_ = (size_t)(m_) * 384 + lane * 8; const float* g3_ = gm + (size_t)(m_) * 32 + 3 * (lane >> 3); rg0 = g3_[0]; rg1 = g3_[1]; rg2 = g3_[2]; \
            ra4 = *(const v4u*)(oc + o_); rb4 = *(const v4u*)(os + o_); rc4 = *(const v4u*)(ow + o_); } \
        else { ra4 = *(const v4u*)(r_ + 384 + (lane - 48) * 8); rb4 = ra4; rc4 = ra4; rg0 = 0.f; rg1 = 0.f; rg2 = 0.f; } \
        if (lane < 32) ry4 = *(const v4u*)(r_ + 384 + (16 + lane) * 8); else ry4 = ra4; } while (0)
    const int mend = gw * rpw + rpw;
    MIX_LOAD(gw * rpw);
    for (int m = gw * rpw; m < mend; ++m) {
        bf16* r = mix + (size_t)m * D_;
        const v4u ca4 = ra4, cb4 = rb4, cc4 = rc4, cy4 = ry4; const float g0 = rg0, g1 = rg1, g2 = rg2;
        if (m + 1 < mend) MIX_LOAD(m + 1);
        float v0[8], v1[8]; float sa = 0.f, sb = 0.f;
        if (lane < 48) {
            float c8[8], s8[8], w8[8]; UNPK8(c8, ca4) UNPK8(s8, cb4) UNPK8(w8, cc4)
#pragma unroll
            for (int i = 0; i < 8; ++i) { v0[i] = g0 * c8[i] + g1 * s8[i] + g2 * w8[i]; sa += v0[i] * v0[i]; }
        } else {
            UNPK8(v0, ca4)
#pragma unroll
            for (int i = 0; i < 8; ++i) sb += v0[i] * v0[i];
        }
        if (lane < 32) { UNPK8(v1, cy4)
#pragma unroll
            for (int i = 0; i < 8; ++i) sb += v1[i] * v1[i]; }
        const float ra = rsqrtf(wave_sum2(sa) * (1.f / 384.f) + EPS), rb = rsqrtf(wave_sum2(sb) * (1.f / 384.f) + EPS);
        {
            const int col = (lane < 48) ? lane * 8 : 384 + (lane - 48) * 8; const float rr = (lane < 48) ? ra : rb;
            const float4 q0 = gA0, q1 = gA1;
            v4u w; w.x = pk2(v0[0] * rr * q0.x, v0[1] * rr * q0.y); w.y = pk2(v0[2] * rr * q0.z, v0[3] * rr * q0.w); w.z = pk2(v0[4] * rr * q1.x, v0[5] * rr * q1.y); w.w = pk2(v0[6] * rr * q1.z, v0[7] * rr * q1.w);
            *(v4u*)(r + col) = w;
        }
        if (lane < 32) { const float4 q0 = gB0, q1 = gB1;
            v4u w; w.x = pk2(v1[0] * rb * q0.x, v1[1] * rb * q0.y); w.y = pk2(v1[2] * rb * q0.z, v1[3] * rb * q0.w); w.z = pk2(v1[4] * rb * q1.x, v1[5] * rb * q1.y); w.w = pk2(v1[6] * rb * q1.z, v1[7] * rb * q1.w);
            *(v4u*)(r + 384 + (16 + lane) * 8) = w; }
    }
#undef MIX_LOAD
#undef UNPK8
}


typedef short bf16x8 __attribute__((ext_vector_type(8)));
typedef short s16x4 __attribute__((ext_vector_type(4)));
typedef float f32x16 __attribute__((ext_vector_type(16)));
typedef unsigned u32x2v __attribute__((ext_vector_type(2)));
constexpr int AT_BUF = 20480, AT_K32 = 8192, AT_V = 12288;
__device__ __forceinline__ unsigned cvtpk(float lo, float hi) { unsigned r; asm volatile("v_cvt_pk_bf16_f32 %0, %1, %2" : "=v"(r) : "v"(lo), "v"(hi)); return r; }
__device__ __forceinline__ float max3f(float a, float b, float c) { float r; asm("v_max3_f32 %0, %1, %2, %3" : "=v"(r) : "v"(a), "v"(b), "v"(c)); return r; }
__device__ __forceinline__ int crow(int r, int hi) { return (r & 3) + 8 * (r >> 2) + 4 * hi; }
__device__ __forceinline__ s16x4 vtr(LAS const unsigned char* p) { return __builtin_bit_cast(s16x4, __builtin_amdgcn_ds_read_tr16_b64_v4i16((LAS s16x4*)p)); }
enum { AM_CAUSAL = 0, AM_WINDOW = 1, AM_SLC = 2 };
struct AttnState { float m, l; f32x16 o[2]; f32x16 negm; bool started; long long twait; };
template <int NC> struct TileRegs { v4u k; v4u k2; v4u v; };
template <int NC> __device__ __forceinline__ void at_load(TileRegs<NC>& r, const bf16* Kg, int ldk, const bf16* Vg, int ldv, const bf16* K2g, int ldk2, int tile, int tid) {
    const int key = tid >> 3, c = tid & 7;
    r.k = *(const v4u*)(Kg + (size_t)(tile * 64 + key) * ldk + 8 * c);
    r.v = *(const v4u*)(Vg + (size_t)(tile * 64 + key) * ldv + 8 * c);
    if (NC == 6) { if (tid < 256) r.k2 = *(const v4u*)(K2g + (size_t)(tile * 64 + (tid >> 2)) * ldk2 + 8 * (tid & 3)); }
}
template <int NC> __device__ __forceinline__ void at_store(const TileRegs<NC>& r, LAS unsigned char* buf, int tid) {
    const int key = tid >> 3, c = tid & 7;
    *(LAS v4u*)(buf + key * 128 + 16 * (c ^ ((key >> 1) & 7))) = r.k;
    *(LAS v4u*)(buf + AT_V + (c >> 2) * 4096 + key * 64 + (c & 3) * 16) = r.v;
    if (NC == 6) { if (tid < 256) { const int k2 = tid >> 2, c2 = tid & 3; *(LAS v4u*)(buf + AT_K32 + k2 * 64 + 16 * (c2 ^ ((k2 >> 2) & 3))) = r.k2; } }
}
template <int NC> __device__ __forceinline__ void qk_tile(f32x16& p0, f32x16& p1, LAS const unsigned char* buf, const bf16x8 (&qf)[NC], const f32x16& negm, int lane) {
    const int r32 = lane & 31, hi = lane >> 5;
    p0 = negm; p1 = negm;
#pragma unroll
    for (int cc = 0; cc < NC; ++cc) {
        bf16x8 k0, k1;
        if (cc < 4) { const int k0r = r32, k1r = 32 + r32;
            k0 = *(LAS const bf16x8*)(buf + k0r * 128 + 16 * ((2 * cc + hi) ^ ((k0r >> 1) & 7)));
            k1 = *(LAS const bf16x8*)(buf + k1r * 128 + 16 * ((2 * cc + hi) ^ ((k1r >> 1) & 7))); }
        else { const int k0r = r32, k1r = 32 + r32, c2 = 2 * (cc - 4) + hi;
            k0 = *(LAS const bf16x8*)(buf + AT_K32 + k0r * 64 + 16 * (c2 ^ ((k0r >> 2) & 3)));
            k1 = *(LAS const bf16x8*)(buf + AT_K32 + k1r * 64 + 16 * (c2 ^ ((k1r >> 2) & 3))); }
        p0 = __builtin_amdgcn_mfma_f32_32x32x16_bf16(k0, qf[cc], p0, 0, 0, 0);
        p1 = __builtin_amdgcn_mfma_f32_32x32x16_bf16(k1, qf[cc], p1, 0, 0, 0);
    }
}
template <int MODE> __device__ __forceinline__ void mask_tile(f32x16& p0, f32x16& p1, int kpos0, int qpos, bool need_mask, bool sel_ok, int lane) {
    const int hi = lane >> 5;
    if (need_mask) {
        const int qw0m = __builtin_amdgcn_readfirstlane(qpos) & ~31;
        const bool diag = (kpos0 + 63 > qw0m), old = (MODE == AM_WINDOW) && (kpos0 < qw0m + 31 - 511);
        if (diag || old) {
            const float selterm = (MODE == AM_SLC && !sel_ok) ? -INFINITY : INFINITY;
            const int dbase = qpos - kpos0 - 4 * hi;
#pragma unroll
            for (int r = 0; r < 16; ++r) {
                const int d0 = dbase - ((r & 3) + 8 * (r >> 2)), d1 = d0 - 32;
                float l0 = ((float)d0 + 0.5f) * INFINITY, l1 = ((float)d1 + 0.5f) * INFINITY;
                if (MODE == AM_WINDOW) { l0 = fminf(l0, ((float)(511 - d0) + 0.5f) * INFINITY); l1 = fminf(l1, ((float)(511 - d1) + 0.5f) * INFINITY); }
                if (MODE == AM_SLC) { l0 = fminf(l0, selterm); l1 = fminf(l1, selterm); }
                p0[r] = fminf(p0[r], l0); p1[r] = fminf(p1[r], l1);
            }
        } else if (MODE == AM_SLC) {
            const float selterm = sel_ok ? INFINITY : -INFINITY;
#pragma unroll
            for (int r = 0; r < 16; ++r) { p0[r] = fminf(p0[r], selterm); p1[r] = fminf(p1[r], selterm); }
        }
    }
}
template <int MODE> __device__ __forceinline__ void softmax_tile(AttnState& st, f32x16& p0, f32x16& p1, bf16x8 (&pf)[4], int kpos0, int qpos, bool need_mask, bool sel_ok, int lane) {
    mask_tile<MODE>(p0, p1, kpos0, qpos, need_mask, sel_ok, lane);
    float mx = max3f(p0[0], p1[0], p0[1]), mx2 = max3f(p1[1], p0[2], p1[2]);
#pragma unroll
    for (int r = 3; r < 15; r += 2) { mx = max3f(mx, p0[r], p1[r]); mx2 = max3f(mx2, p0[r + 1], p1[r + 1]); }
    mx = max3f(mx, p0[15], p1[15]); mx = max3f(mx, mx2, mx2);
    mx = red32_max(mx);
    if (!st.started || __any(mx > 0.f)) {
        float dl = st.started ? fmaxf(mx, 0.f) : mx;
        dl = (dl > -1e30f) ? dl : 0.f;
        st.started = true;
        const float alpha = __builtin_amdgcn_exp2f(-dl);
        st.m += dl; st.l *= alpha;
#pragma unroll
        for (int r = 0; r < 16; ++r) { st.o[0][r] *= alpha; st.o[1][r] *= alpha; p0[r] -= dl; p1[r] -= dl; st.negm[r] = -st.m; }
    }
    float sum = 0.f;
#pragma unroll
    for (int r = 0; r < 16; ++r) { p0[r] = __builtin_amdgcn_exp2f(p0[r]); p1[r] = __builtin_amdgcn_exp2f(p1[r]); sum += p0[r] + p1[r]; }
    st.l += sum;
#pragma unroll
    for (int s2 = 0; s2 < 2; ++s2) {
        v4u a, b;
        a.x = cvtpk(p0[8 * s2 + 0], p0[8 * s2 + 1]); a.y = cvtpk(p0[8 * s2 + 2], p0[8 * s2 + 3]); a.z = cvtpk(p0[8 * s2 + 4], p0[8 * s2 + 5]); a.w = cvtpk(p0[8 * s2 + 6], p0[8 * s2 + 7]);
        b.x = cvtpk(p1[8 * s2 + 0], p1[8 * s2 + 1]); b.y = cvtpk(p1[8 * s2 + 2], p1[8 * s2 + 3]); b.z = cvtpk(p1[8 * s2 + 4], p1[8 * s2 + 5]); b.w = cvtpk(p1[8 * s2 + 6], p1[8 * s2 + 7]);
        pf[s2] = __builtin_bit_cast(bf16x8, a); pf[2 + s2] = __builtin_bit_cast(bf16x8, b);
    }
}
struct TileFlags { bool skip, need_mask, sel_ok; };
__device__ __forceinline__ void pack_p(bf16x8 (&pf)[4], const f32x16& p0, const f32x16& p1) {
#pragma unroll
    for (int s2 = 0; s2 < 2; ++s2) {
        v4u a, b;
        a.x = cvtpk(p0[8 * s2 + 0], p0[8 * s2 + 1]); a.y = cvtpk(p0[8 * s2 + 2], p0[8 * s2 + 3]); a.z = cvtpk(p0[8 * s2 + 4], p0[8 * s2 + 5]); a.w = cvtpk(p0[8 * s2 + 6], p0[8 * s2 + 7]);
        b.x = cvtpk(p1[8 * s2 + 0], p1[8 * s2 + 1]); b.y = cvtpk(p1[8 * s2 + 2], p1[8 * s2 + 3]); b.z = cvtpk(p1[8 * s2 + 4], p1[8 * s2 + 5]); b.w = cvtpk(p1[8 * s2 + 6], p1[8 * s2 + 7]);
        pf[s2] = __builtin_bit_cast(bf16x8, a); pf[2 + s2] = __builtin_bit_cast(bf16x8, b);
    }
}
template <int MODE> __device__ __forceinline__ void softmax_pair(AttnState& st, f32x16& a0, f32x16& a1, f32x16& b0, f32x16& b1, int kpos0, int qpos, const TileFlags& fa, const TileFlags& fb, int lane) {
    mask_tile<MODE>(a0, a1, kpos0, qpos, fa.need_mask, fa.sel_ok, lane);
    mask_tile<MODE>(b0, b1, kpos0 + 64, qpos, fb.need_mask, fb.sel_ok, lane);
    float mx = max3f(a0[0], a1[0], b0[0]), mx2 = max3f(b1[0], a0[1], a1[1]);
#pragma unroll
    for (int r = 1; r < 16; ++r) { mx = max3f(mx, b0[r], b1[r]); if (r > 1) mx2 = max3f(mx2, a0[r], a1[r]); }
    mx = max3f(mx, mx2, mx2);
    mx = red32_max(mx);
    if (!st.started || __any(mx > 0.f)) {
        float dl = st.started ? fmaxf(mx, 0.f) : mx;
        dl = (dl > -1e30f) ? dl : 0.f;
        st.started = true;
        const float alpha = __builtin_amdgcn_exp2f(-dl);
        st.m += dl; st.l *= alpha;
#pragma unroll
        for (int r = 0; r < 16; ++r) { st.o[0][r] *= alpha; st.o[1][r] *= alpha; a0[r] -= dl; a1[r] -= dl; b0[r] -= dl; b1[r] -= dl; st.negm[r] = -st.m; }
    }
    float sum = 0.f;
#pragma unroll
    for (int r = 0; r < 16; ++r) { a0[r] = __builtin_amdgcn_exp2f(a0[r]); a1[r] = __builtin_amdgcn_exp2f(a1[r]); b0[r] = __builtin_amdgcn_exp2f(b0[r]); b1[r] = __builtin_amdgcn_exp2f(b1[r]); sum += (a0[r] + a1[r]) + (b0[r] + b1[r]); }
    st.l += sum;
}
__device__ __forceinline__ void pv_tile(AttnState& st, LAS const unsigned char* buf, const bf16x8 (&pf)[4], int lane) {
    const int hi = lane >> 5;
    const unsigned vb = (unsigned)(uintptr_t)(buf + AT_V + (4 * hi + ((lane & 15) >> 2)) * 64 + ((lane >> 4) & 1) * 32 + (lane & 3) * 8);
#pragma unroll
    for (int dh = 0; dh < 2; ++dh) {
        s16x4 lo[4], hh[4];
#pragma unroll
        for (int s4 = 0; s4 < 4; ++s4) {
            asm volatile("ds_read_b64_tr_b16 %0, %1 offset:%c2" : "=&v"(lo[s4]) : "v"(vb), "i"(dh * 4096 + s4 * 1024) : "memory");
            asm volatile("ds_read_b64_tr_b16 %0, %1 offset:%c2" : "=&v"(hh[s4]) : "v"(vb), "i"(dh * 4096 + s4 * 1024 + 512) : "memory");
        }
        asm volatile("s_waitcnt lgkmcnt(0)" : "+v"(lo[0]), "+v"(lo[1]), "+v"(lo[2]), "+v"(lo[3]), "+v"(hh[0]), "+v"(hh[1]), "+v"(hh[2]), "+v"(hh[3]) :: "memory");
#pragma unroll
        for (int s4 = 0; s4 < 4; ++s4) {
            const bf16x8 vf = {lo[s4][0], lo[s4][1], lo[s4][2], lo[s4][3], hh[s4][0], hh[s4][1], hh[s4][2], hh[s4][3]};
            st.o[dh] = __builtin_amdgcn_mfma_f32_32x32x16_bf16(vf, pf[s4], st.o[dh], 0, 0, 0);
        }
    }
}
template <int MODE> __device__ __forceinline__ TileFlags tile_flags(int t, int qw0, unsigned selbits) {
    const int k0 = t * 64; TileFlags f;
    f.skip = k0 > qw0 + 31; f.need_mask = (k0 + 63 > qw0); f.sel_ok = true;
    if (MODE == AM_WINDOW) { f.skip = f.skip || (k0 + 63 < qw0 - 511); f.need_mask = f.need_mask || (k0 < qw0 + 31 - 511); }
    if (MODE == AM_SLC) { f.sel_ok = (selbits >> t) & 1u; const unsigned long long bal = __ballot(f.sel_ok); f.skip = f.skip || (bal == 0ull); f.need_mask = f.need_mask || (bal != ~0ull); }
    return f;
}
struct DmaOff { unsigned k, v, k2; };
template <int NC> __device__ __forceinline__ DmaOff at_dma_off(int ldk, int ldv, int ldk2, int wave, int lane) {
    const int L = wave * 64 + lane; DmaOff o;
    { const int key = L >> 3, c = (L & 7) ^ ((key >> 1) & 7); o.k = (unsigned)(key * ldk + 8 * c) * 2u; }
    { const int key = (L >> 2) & 63, c = (L >> 8) * 4 + (L & 3); o.v = (unsigned)(key * ldv + 8 * c) * 2u; }
    { const int key = (L >> 2) & 63, c2 = (L & 3) ^ ((key >> 2) & 3); o.k2 = (unsigned)(key * ldk2 + 8 * c2) * 2u; }
    return o;
}
template <int NC> __device__ __forceinline__ void at_dma(const DmaOff& o, const bf16* Kg, int ldk, const bf16* Vg, int ldv, const bf16* K2g, int ldk2, int tile, LAS unsigned char* slot, int wave) {
    __builtin_amdgcn_global_load_lds((const unsigned*)((const char*)(Kg + (size_t)tile * 64 * ldk) + o.k), (LAS unsigned*)(slot + wave * 1024), 16, 0, 0);
    __builtin_amdgcn_global_load_lds((const unsigned*)((const char*)(Vg + (size_t)tile * 64 * ldv) + o.v), (LAS unsigned*)(slot + AT_V + wave * 1024), 16, 0, 0);
    if (NC == 6) { if (wave < 4) __builtin_amdgcn_global_load_lds((const unsigned*)((const char*)(K2g + (size_t)tile * 64 * ldk2) + o.k2), (LAS unsigned*)(slot + AT_K32 + wave * 1024), 16, 0, 0); }
}
__device__ __forceinline__ void at_wait_bar(int keep) {
    if (keep == 0) asm volatile("s_waitcnt vmcnt(0) lgkmcnt(0)" ::: "memory");
    else if (keep == 4) asm volatile("s_waitcnt vmcnt(4) lgkmcnt(0)" ::: "memory");
    else asm volatile("s_waitcnt vmcnt(6) lgkmcnt(0)" ::: "memory");
    __builtin_amdgcn_s_barrier();
    asm volatile("" ::: "memory");
}
template <int NC, int MODE> __device__ __forceinline__ void at_stream(AttnState& st, LAS unsigned char* lds, const bf16* Kg, int ldk, const bf16* Vg, int ldv, const bf16* K2g, int ldk2, int t0, int t1,
                                                                       const bf16x8 (&qf)[NC], int qpos, int qw0, unsigned selbits, int tid) {
    const int lane = tid & 63, wave = __builtin_amdgcn_readfirstlane(tid >> 6), np = (t1 - t0) >> 1;
    const int nper2 = (NC == 6 && wave < 4) ? 6 : 4;
    const DmaOff dof = at_dma_off<NC>(ldk, ldv, ldk2, wave, lane);
    at_dma<NC>(dof, Kg, ldk, Vg, ldv, K2g, ldk2, t0, lds, wave); at_dma<NC>(dof, Kg, ldk, Vg, ldv, K2g, ldk2, t0 + 1, lds + AT_BUF, wave);
    if (np > 1) { at_dma<NC>(dof, Kg, ldk, Vg, ldv, K2g, ldk2, t0 + 2, lds + 2 * AT_BUF, wave); at_dma<NC>(dof, Kg, ldk, Vg, ldv, K2g, ldk2, t0 + 3, lds + 3 * AT_BUF, wave); }
    at_wait_bar(np > 1 ? nper2 : 0);
    int s0 = 0, s1 = 2 * AT_BUF, s2 = 4 * AT_BUF;
    for (int j = 0; j < np; ++j) {
        const int t = t0 + 2 * j; const bool has_2 = (j + 2 < np);
        if (has_2) { at_dma<NC>(dof, Kg, ldk, Vg, ldv, K2g, ldk2, t + 4, lds + s2, wave); at_dma<NC>(dof, Kg, ldk, Vg, ldv, K2g, ldk2, t + 5, lds + s2 + AT_BUF, wave); }
        const TileFlags fa = tile_flags<MODE>(t, qw0, selbits), fb = tile_flags<MODE>(t + 1, qw0, selbits);
        if (!fa.skip && !fb.skip) {
            f32x16 a0, a1, b0, b1; bf16x8 pf[4];
            qk_tile<NC>(a0, a1, lds + s0, qf, st.negm, lane);
            qk_tile<NC>(b0, b1, lds + s0 + AT_BUF, qf, st.negm, lane);
            softmax_pair<MODE>(st, a0, a1, b0, b1, t * 64, qpos, fa, fb, lane);
            pack_p(pf, a0, a1); pv_tile(st, lds + s0, pf, lane);
            pack_p(pf, b0, b1); pv_tile(st, lds + s0 + AT_BUF, pf, lane);
        } else {
            if (!fa.skip) { f32x16 p0, p1; bf16x8 pf[4]; qk_tile<NC>(p0, p1, lds + s0, qf, st.negm, lane); softmax_tile<MODE>(st, p0, p1, pf, t * 64, qpos, fa.need_mask, fa.sel_ok, lane); pv_tile(st, lds + s0, pf, lane); }
            if (!fb.skip) { f32x16 p0, p1; bf16x8 pf[4]; qk_tile<NC>(p0, p1, lds + s0 + AT_BUF, qf, st.negm, lane); softmax_tile<MODE>(st, p0, p1, pf, (t + 1) * 64, qpos, fb.need_mask, fb.sel_ok, lane); pv_tile(st, lds + s0 + AT_BUF, pf, lane); }
        }
        at_wait_bar(has_2 ? nper2 : 0);
        const int tmp = s0; s0 = s1; s1 = s2; s2 = tmp;
    }
}
__device__ __forceinline__ int next_item_q(unsigned* ctrs, LAS unsigned char* lds, int wave_u, int count, int q0, int& kstart) {
    const int tid = wave_u * 64 + fresh_lane();
    LAS int* slot = (LAS int*)(lds + RING_BYTES + 64);
    if (tid == 0) { const unsigned v = atomicAdd(ctrs, 1u); slot[0] = (v < 8u * (unsigned)count) ? (int)(((v & 7u) << 16) | (v >> 3)) : -1; }
    __syncthreads();
    const int v = slot[0];
    __syncthreads();
    (void)q0; (void)kstart;
    return v;
}
__device__ __forceinline__ void mla_unit(unsigned char* ws, LAS unsigned char* lds, int b, int h, int qt, int wave_u) {
    const int tid = wave_u * 64 + fresh_lane();
    const int lane = tid & 63, wave = tid >> 6, r32 = lane & 31, hi = lane >> 5;
    const int qw0 = qt * 256 + wave * 32, qpos = qw0 + r32; const size_t row = (size_t)b * S_ + qpos;
    const long long tq0 = (PROBE_SEL != 0) ? (long long)__builtin_amdgcn_s_memtime() : 0ll;
    bf16x8 qf[6];
    {
        const bf16* qp = (const bf16*)(ws + WS_OSLC) + row * 768 + h * 96 + 8 * hi;
        v4u raw[6];
#pragma unroll
        for (int cc = 0; cc < 6; ++cc) raw[cc] = *(const v4u*)(qp + 16 * cc);
        float msc = MSCALE; asm volatile("" : "+v"(msc));
        const float rs = rsqrtf(((const float*)(ws + WS_SSQL))[row] * (1.f / 256.f) + EPS) * msc;
        const float* cm_ = (const float*)(ws + WS_COSM) + row * 16 + 8 * hi; const float* sm_ = (const float*)(ws + WS_SINM) + row * 16 + 8 * hi;
#define UNPKQ(dst, src) dst[0] = __uint_as_float(src.x << 16); dst[1] = __uint_as_float(src.x & 0xffff0000u); dst[2] = __uint_as_float(src.y << 16); dst[3] = __uint_as_float(src.y & 0xffff0000u); \
        dst[4] = __uint_as_float(src.z << 16); dst[5] = __uint_as_float(src.z & 0xffff0000u); dst[6] = __uint_as_float(src.w << 16); dst[7] = __uint_as_float(src.w & 0xffff0000u);
#pragma unroll
        for (int cc = 0; cc < 4; ++cc) { float f[8]; UNPKQ(f, raw[cc])
            v4u w; w.x = cvtpk(f[0] * rs, f[1] * rs); w.y = cvtpk(f[2] * rs, f[3] * rs); w.z = cvtpk(f[4] * rs, f[5] * rs); w.w = cvtpk(f[6] * rs, f[7] * rs); qf[cc] = __builtin_bit_cast(bf16x8, w); }
        { float x1[8], x2[8], o1[8], o2[8]; UNPKQ(x1, raw[4]) UNPKQ(x2, raw[5])
#pragma unroll
          for (int j = 0; j < 8; ++j) { const float cs = cm_[j] * rs, sn = sm_[j] * rs; o1[j] = x1[j] * cs - x2[j] * sn; o2[j] = x1[j] * sn + x2[j] * cs; }
          v4u w; w.x = cvtpk(o1[0], o1[1]); w.y = cvtpk(o1[2], o1[3]); w.z = cvtpk(o1[4], o1[5]); w.w = cvtpk(o1[6], o1[7]); qf[4] = __builtin_bit_cast(bf16x8, w);
          w.x = cvtpk(o2[0], o2[1]); w.y = cvtpk(o2[2], o2[3]); w.z = cvtpk(o2[4], o2[5]); w.w = cvtpk(o2[6], o2[7]); qf[5] = __builtin_bit_cast(bf16x8, w); }
#undef UNPKQ
    }
    const long long tq1 = (PROBE_SEL != 0) ? (long long)__builtin_amdgcn_s_memtime() : 0ll;
    AttnState st; st.m = 0.f; st.l = 0.f; st.o[0] = f32x16{}; st.o[1] = f32x16{}; st.negm = f32x16{}; st.started = false; st.twait = 0;
    const bf16* kvb = (const bf16*)(ws + WS_KVM) + (size_t)b * S_ * 768 + h * 128;
    at_stream<6, AM_CAUSAL>(st, lds, kvb, 768, kvb + 64, 768, (const bf16*)(ws + WS_KR) + (size_t)b * S_ * 32, 32, 0, 4 * qt + 4, qf, qpos, qw0, 0u, tid);
    if (PROBE_SEL >= 1 && PROBE_SEL <= 3 && b == 0 && h == 0 && qt == 7 && tid == 0) { const long long tq2 = (long long)__builtin_amdgcn_s_memtime();
        ((float*)(ws + WS_CTL))[100] = (PROBE_SEL == 1) ? (float)(tq2 - tq1) : (PROBE_SEL == 2) ? (float)st.twait : (float)(tq1 - tq0); }
    const float lt = red32_sum(st.l), il = 1.f / lt;
    bf16* op = (bf16*)(ws + WS_HB) + row * D_ + 384 + h * 64 + 4 * hi;
#pragma unroll
    for (int dh = 0; dh < 2; ++dh)
#pragma unroll
        for (int g4 = 0; g4 < 4; ++g4) { u32x2v w; w.x = cvtpk(st.o[dh][4 * g4] * il, st.o[dh][4 * g4 + 1] * il); w.y = cvtpk(st.o[dh][4 * g4 + 2] * il, st.o[dh][4 * g4 + 3] * il);
            *(u32x2v*)(op + dh * 32 + 8 * g4) = w; }
}
template <int MODE> __device__ __forceinline__ void nsa_branch_unit(unsigned char* ws, LAS unsigned char* lds, int b, int h, int qt, int wave_u) {
    const int tid = wave_u * 64 + fresh_lane();
    const int lane = tid & 63, wave = tid >> 6, r32 = lane & 31, hi = lane >> 5, g = h / 3;
    const int qw0 = qt * 256 + wave * 32, qpos = qw0 + r32; const size_t row = (size_t)b * S_ + qpos;
    const bf16* nsa = (const bf16*)(ws + WS_NSA);
    const bf16* qp = nsa + row * 1152 + h * 64 + 8 * hi;
    bf16x8 qf[4];
#pragma unroll
    for (int cc = 0; cc < 4; ++cc) qf[cc] = *(const bf16x8*)(qp + 16 * cc);
    unsigned selbits = 0u; if (MODE == AM_SLC) selbits = ((const unsigned*)(ws + WS_SEL))[(size_t)(b * 2 + g) * S_ + qpos];
    const bf16* kb = nsa + (size_t)b * S_ * 1152 + g * 64 + (MODE == AM_SLC ? 640 : 896);
    AttnState st; st.m = 0.f; st.l = 0.f; st.o[0] = f32x16{}; st.o[1] = f32x16{}; st.negm = f32x16{}; st.started = false; st.twait = 0;
    const long long tn0 = (PROBE_SEL != 0) ? (long long)__builtin_amdgcn_s_memtime() : 0ll;
    const int t0 = (MODE == AM_SLC) ? 0 : ((4 * qt - 8 > 0) ? 4 * qt - 8 : 0);
    at_stream<4, MODE>(st, lds, kb, 1152, kb + 128, 1152, nullptr, 0, t0, 4 * qt + 4, qf, qpos, qw0, selbits, tid);
    if (PROBE_SEL >= 4 && PROBE_SEL <= 5 && MODE == AM_SLC && b == 0 && h == 0 && qt == 7 && tid == 0) { const long long tn1 = (long long)__builtin_amdgcn_s_memtime();
        ((float*)(ws + WS_CTL))[100] = (PROBE_SEL == 4) ? (float)(tn1 - tn0) : (float)st.twait; }
    const float lt = red32_sum(st.l), il = 1.f / lt;
    bf16* op = (bf16*)(ws + (MODE == AM_SLC ? WS_OSLC : WS_OWIN)) + row * 384 + h * 64 + 4 * hi;
#pragma unroll
    for (int dh = 0; dh < 2; ++dh)
#pragma unroll
        for (int g4 = 0; g4 < 4; ++g4) { u32x2v w; w.x = cvtpk(st.o[dh][4 * g4] * il, st.o[dh][4 * g4 + 1] * il); w.y = cvtpk(st.o[dh][4 * g4 + 2] * il, st.o[dh][4 * g4 + 3] * il);
            *(u32x2v*)(op + dh * 32 + 8 * g4) = w; }
}
__device__ __forceinline__ void cmp_unit(unsigned char* ws, LAS unsigned char* lds, int b, int g, int qt, int wave_u) {
    const int tid = wave_u * 64 + fresh_lane();
    const int lane = tid & 63, wave = tid >> 6, r32 = lane & 31, hi = lane >> 5;
    const int qpos = qt * 256 + wave * 32 + r32; const size_t row = (size_t)b * S_ + qpos;
    const bf16* kc = (const bf16*)(ws + WS_KCV) + (size_t)(b * 2 + g) * 128 * 64; const bf16* vc = kc + (size_t)8 * 2 * 128 * 64;
    { TileRegs<4> tr; at_load<4>(tr, kc, 64, vc, 64, nullptr, 0, 0, tid); at_store<4>(tr, lds, tid); at_load<4>(tr, kc, 64, vc, 64, nullptr, 0, 1, tid); at_store<4>(tr, lds + AT_BUF, tid); }
    __syncthreads();
    int nvis = (qpos >= 31) ? ((qpos - 31) >> 4) + 1 : 0; if (nvis > 127) nvis = 127;
    LAS float* IG = (LAS float*)(lds + 2 * AT_BUF) + wave * (32 * 33) + r32 * 33;
    LAS float* IL = IG + 8 * 32 * 33;
    const bf16* nsa = (const bf16*)(ws + WS_NSA);
    LAS const unsigned char* vb = lds + AT_V + (4 * hi + ((lane & 15) >> 2)) * 64 + ((lane >> 4) & 1) * 32 + (lane & 3) * 8;
    for (int r3 = 0; r3 < 3; ++r3) {
        const int h = 3 * g + r3;
        const bf16* qp = nsa + row * 1152 + h * 64 + 8 * hi;
        bf16x8 qf[4];
#pragma unroll
        for (int cc = 0; cc < 4; ++cc) qf[cc] = *(const bf16x8*)(qp + 16 * cc);
        f32x16 p[4];
#pragma unroll
        for (int tb = 0; tb < 4; ++tb) {
            LAS const unsigned char* buf = lds + (tb >> 1) * AT_BUF; const int kr = (tb & 1) * 32 + r32;
            p[tb] = f32x16{};
#pragma unroll
            for (int cc = 0; cc < 4; ++cc) { const bf16x8 kf = *(LAS const bf16x8*)(buf + kr * 128 + 16 * ((2 * cc + hi) ^ ((kr >> 1) & 7)));
                p[tb] = __builtin_amdgcn_mfma_f32_32x32x16_bf16(kf, qf[cc], p[tb], 0, 0, 0); }
        }
        float mx = -1e30f;
#pragma unroll
        for (int tb = 0; tb < 4; ++tb)
#pragma unroll
            for (int r = 0; r < 16; ++r) { const int n = 32 * tb + crow(r, hi); p[tb][r] = fminf(p[tb][r], ((float)(nvis - n) - 0.5f) * INFINITY); mx = fmaxf(mx, p[tb][r]); }
        mx = red32_max(mx);
        float sum = 0.f;
#pragma unroll
        for (int tb = 0; tb < 4; ++tb)
#pragma unroll
            for (int r = 0; r < 16; ++r) { p[tb][r] = __builtin_amdgcn_exp2f(p[tb][r] - mx); sum += p[tb][r]; }
        sum = red32_sum(sum);
        const float il = (nvis > 0) ? 1.f / sum : 0.f;
#pragma unroll
        for (int tb = 0; tb < 4; ++tb)
#pragma unroll
            for (int k = 0; k < 4; ++k) { const float a0 = p[tb][4 * k] * il, a1 = p[tb][4 * k + 1] * il, a2 = p[tb][4 * k + 2] * il, a3 = p[tb][4 * k + 3] * il;
                const int j = 2 * (4 * tb + k) + hi;
                const float gs = (a0 + a1) + (a2 + a3);
                if (r3 == 0) { IG[j] = gs; IL[j + 1] = a3; } else { IG[j] += gs; IL[j + 1] += a3; } }
        f32x16 o[2] = {f32x16{}, f32x16{}};
#pragma unroll
        for (int tb = 0; tb < 4; ++tb)
#pragma unroll
            for (int s2 = 0; s2 < 2; ++s2) {
                v4u a; a.x = cvtpk(p[tb][8 * s2 + 0], p[tb][8 * s2 + 1]); a.y = cvtpk(p[tb][8 * s2 + 2], p[tb][8 * s2 + 3]); a.z = cvtpk(p[tb][8 * s2 + 4], p[tb][8 * s2 + 5]); a.w = cvtpk(p[tb][8 * s2 + 6], p[tb][8 * s2 + 7]);
                const bf16x8 pf = __builtin_bit_cast(bf16x8, a);
                LAS const unsigned char* vbb = vb + (tb >> 1) * AT_BUF + ((tb & 1) * 2 + s2) * 1024;
#pragma unroll
                for (int dh = 0; dh < 2; ++dh) { const s16x4 lo = vtr(vbb + dh * 4096), hh = vtr(vbb + dh * 4096 + 512);
                    const bf16x8 vf = {lo[0], lo[1], lo[2], lo[3], hh[0], hh[1], hh[2], hh[3]};
                    o[dh] = __builtin_amdgcn_mfma_f32_32x32x16_bf16(vf, pf, o[dh], 0, 0, 0); }
                asm volatile("" ::: "memory");
            }
        bf16* op = (bf16*)(ws + WS_OCMP) + row * 384 + h * 64 + 4 * hi;
#pragma unroll
        for (int dh = 0; dh < 2; ++dh)
#pragma unroll
            for (int g4 = 0; g4 < 4; ++g4) { u32x2v w; w.x = cvtpk(o[dh][4 * g4] * il, o[dh][4 * g4 + 1] * il); w.y = cvtpk(o[dh][4 * g4 + 2] * il, o[dh][4 * g4 + 3] * il);
                *(u32x2v*)(op + dh * 32 + 8 * g4) = w; }
    }
    const int cur = qpos >> 6;
    LAS float* imp = IG;
#pragma unroll 1
    for (int jj = 0; jj < 16; ++jj) {
        const int j = 16 * hi + jj;
        float v = IG[j] + (j > 0 ? IL[j] : 0.f);
        if (j == 0 || j == cur || j == cur - 1) v = INFINITY;
        if (j * 64 > qpos) v = -INFINITY;
        IL[j] = v;
    }
#pragma unroll 1
    for (int jj = 0; jj < 16; ++jj) { const int j = 16 * hi + jj; imp[j] = IL[j]; }
    unsigned mask = 0;
#pragma unroll 1
    for (int jj = 0; jj < 16; ++jj) {
        const int j = 16 * hi + jj; const float v = imp[j]; int rank = 0;
#pragma unroll 4
        for (int k = 0; k < 32; ++k) { const float u2 = imp[k]; rank += (u2 > v || (u2 == v && k < j)) ? 1 : 0; }
        if (rank < 16) mask |= 1u << j;
    }
    mask = red32_or(mask);
    if (hi == 0) ((unsigned*)(ws + WS_SEL))[(size_t)(b * 2 + g) * S_ + qpos] = mask;
    __syncthreads();
}
__device__ __forceinline__ void lora_rows(unsigned char* ws, int tid) {
    const int gw = blockIdx.x * NWAVES + (tid >> 6), ngw = gridDim.x * NWAVES, lane = tid & 63;
    bf16* kvl = (bf16*)(ws + WS_KVL); const bf16* ql = (const bf16*)(ws + WS_QL); float* ssql = (float*)(ws + WS_SSQL);
    for (int m = gw; m < T_; m += ngw) {
        const unsigned kv = *(const unsigned*)(kvl + (size_t)m * 128 + 2 * lane);
        const float k0 = __uint_as_float(kv << 16), k1 = __uint_as_float(kv & 0xffff0000u);
        const uint2 qv = *(const uint2*)(ql + (size_t)m * 256 + 4 * lane);
        const float q0 = __uint_as_float(qv.x << 16), q1 = __uint_as_float(qv.x & 0xffff0000u), q2 = __uint_as_float(qv.y << 16), q3 = __uint_as_float(qv.y & 0xffff0000u);
        const float sk = wave_sum2(k0 * k0 + k1 * k1), sq = wave_sum2((q0 * q0 + q1 * q1) + (q2 * q2 + q3 * q3));
        const float rk = rsqrtf(sk * (1.f / 128.f) + EPS);
        *(unsigned*)(kvl + (size_t)m * 128 + 2 * lane) = pk2(k0 * rk, k1 * rk);
        if (lane == 0) ssql[m] = sq;
    }
}
__device__ __forceinline__ void post_misc(unsigned char* ws, const float* big, const float* bfg, int tid) {
    const float* mr = (const float*)(ws + WS_MISCRAW); const float* cosM = (const float*)(ws + WS_COSM); const float* sinM = (const float*)(ws + WS_SINM);
    bf16* kr = (bf16*)(ws + WS_KR); float* gm = (float*)(ws + WS_GM);
    for (int idx = blockIdx.x * NTHR + tid; idx < T_ * 64; idx += gridDim.x * NTHR) {
        const int row = idx >> 6, c = idx & 63; const float* r = mr + (size_t)row * 64; const float v = r[c];
        if (c < 32) { const int i = c & 15; const float x1 = r[i], x2 = r[16 + i], cs = cosM[row * 16 + i], sn = sinM[row * 16 + i];
            kr[(size_t)row * 32 + c] = f2bf((c < 16) ? x1 * cs - x2 * sn : x1 * sn + x2 * cs); }
        else if (c < 50) gm[(size_t)row * 32 + (c - 32)] = 1.f / (1.f + __expf(-v));
        else if (c < 54) gm[(size_t)row * 32 + 18 + (c - 50)] = v + big[c - 50];
        else if (c < 58) { const float z = v + bfg[c - 54]; gm[(size_t)row * 32 + 22 + (c - 54)] = fminf(z, 0.f) - __logf(1.f + __expf(-fabsf(z))); }
    }
}

typedef float f32x4v __attribute__((ext_vector_type(4)));
__device__ __forceinline__ void compress_item(unsigned char* ws, LAS unsigned char* lds, const float* cmp_pos, int item, int wave_u) {
    const int lane = fresh_lane(), tid = wave_u * 64 + lane;
    const int nb = item & 7, g = (item >> 3) & 1, b = (item >> 4) & 7, kv = item >> 7;
    const bf16* tok = (const bf16*)(ws + WS_NSA) + (size_t)b * S_ * 1152 + (kv ? 512 : 384) + g * 64;
    const bf16* wt = (const bf16*)(ws + (kv ? WT_CV : WT_CK));
    const int nrow = nb * 16 + (lane & 15), kq = lane >> 4;
    f32x4v acc[4] = {f32x4v{}, f32x4v{}, f32x4v{}, f32x4v{}};
#pragma unroll
    for (int hb = 0; hb < 2; ++hb) {
        v4u t4[4]; f32x4v p0[4], p1[4]; bf16x8 bfr[4][4];
#pragma unroll
        for (int q = 0; q < 4; ++q) {
            const int k = wave_u * 256 + (4 * hb + q) * 32 + kq * 8, l = k >> 6, d = k & 63;
            int trow = 16 * nrow + l; trow = trow < S_ ? trow : S_ - 1;
            t4[q] = *(const v4u*)(tok + (size_t)trow * 1152 + d);
            p0[q] = *(const f32x4v*)(cmp_pos + k); p1[q] = *(const f32x4v*)(cmp_pos + k + 4);
#pragma unroll
            for (int cb = 0; cb < 4; ++cb) bfr[q][cb] = *(const bf16x8*)(wt + (size_t)(cb * 16 + (lane & 15)) * 2048 + k);
        }
        asm volatile("" : "+v"(t4[0]), "+v"(t4[1]), "+v"(t4[2]), "+v"(t4[3]), "+v"(p0[0]), "+v"(p0[1]), "+v"(p0[2]), "+v"(p0[3]), "+v"(p1[0]), "+v"(p1[1]), "+v"(p1[2]), "+v"(p1[3]));
        asm volatile("" : "+v"(bfr[0][0]), "+v"(bfr[0][1]), "+v"(bfr[0][2]), "+v"(bfr[0][3]), "+v"(bfr[1][0]), "+v"(bfr[1][1]), "+v"(bfr[1][2]), "+v"(bfr[1][3]));
        asm volatile("" : "+v"(bfr[2][0]), "+v"(bfr[2][1]), "+v"(bfr[2][2]), "+v"(bfr[2][3]), "+v"(bfr[3][0]), "+v"(bfr[3][1]), "+v"(bfr[3][2]), "+v"(bfr[3][3]));
#pragma unroll
        for (int q = 0; q < 4; ++q) {
            v4u a4;
            a4.x = cvtpk(__uint_as_float(t4[q].x << 16) + p0[q][0], __uint_as_float(t4[q].x & 0xffff0000u) + p0[q][1]); a4.y = cvtpk(__uint_as_float(t4[q].y << 16) + p0[q][2], __uint_as_float(t4[q].y & 0xffff0000u) + p0[q][3]);
            a4.z = cvtpk(__uint_as_float(t4[q].z << 16) + p1[q][0], __uint_as_float(t4[q].z & 0xffff0000u) + p1[q][1]); a4.w = cvtpk(__uint_as_float(t4[q].w << 16) + p1[q][2], __uint_as_float(t4[q].w & 0xffff0000u) + p1[q][3]);
            const bf16x8 af = __builtin_bit_cast(bf16x8, a4);
#pragma unroll
            for (int cb = 0; cb < 4; ++cb) acc[cb] = __builtin_amdgcn_mfma_f32_16x16x32_bf16(af, bfr[q][cb], acc[cb], 0, 0, 0);
        }
    }
    LAS float* red = (LAS float*)lds + wave_u * 1024;
#pragma unroll
    for (int cb = 0; cb < 4; ++cb)
#pragma unroll
        for (int r = 0; r < 4; ++r) red[(4 * (lane >> 4) + r) * 64 + cb * 16 + (lane & 15)] = acc[cb][r];
    __syncthreads();
    bf16* out = (bf16*)(ws + WS_KCV) + (size_t)kv * (8 * 2 * 128 * 64) + ((size_t)(b * 2 + g) * 128 + nb * 16) * 64;
    for (int o = tid; o < 1024; o += NTHR) { float sum = 0.f;
#pragma unroll
        for (int w8 = 0; w8 < 8; ++w8) sum += ((LAS float*)lds)[w8 * 1024 + o];
        out[o] = f2bf(sum); }
    __syncthreads();
}
__device__ __forceinline__ f32x4v mm16(const LAS bf16* A, int lda, int arow0, const LAS bf16* Bt, int ldb, int bcol0, int K, int lane, f32x4v acc) {
    const LAS bf16* ap = A + (arow0 + (lane & 15)) * lda + 8 * (lane >> 4); const LAS bf16* bp = Bt + (bcol0 + (lane & 15)) * ldb + 8 * (lane >> 4);
    for (int k = 0; k < K; k += 32) acc = __builtin_amdgcn_mfma_f32_16x16x32_bf16(*(const LAS bf16x8*)(ap + k), *(const LAS bf16x8*)(bp + k), acc, 0, 0, 0);
    return acc;
}
constexpr int ML_LD = 72;
constexpr int ML_STRIDE = 3 * 64 * ML_LD * 2 + 256;
__device__ __forceinline__ void mlocal_item(unsigned char* ws, LAS unsigned char* lds, const float* convw, const float* convb, const float* big, const float* bfg, int chunk0, int wave_u) {
    const int lane = fresh_lane(), tid = wave_u * 64 + lane;
    const int h = (chunk0 >> 5) & 3, b = chunk0 >> 7;
    LAS bf16* WQ = (LAS bf16*)lds;
    LAS bf16* WK = WQ + 64 * ML_LD;
    const bf16* cm = (const bf16*)(ws + WS_CM);
#define ML_PTRS(ch) const int chunk = chunk0 + (ch); const int c = chunk & 31; const int row0 = b * S_ + c * 64; LAS bf16* XS = WK + 64 * ML_LD + (ch) * (ML_STRIDE / 2); \
    LAS bf16* VT = XS + 64 * ML_LD; LAS bf16* WKT = VT + 64 * ML_LD; LAS float* wl = (LAS float*)(WKT + 64 * ML_LD); (void)c; (void)row0; (void)XS; (void)VT; (void)WKT; (void)wl; (void)chunk;
    {
        v4u gx[2][4], gv[2]; const int l = tid >> 3, ch0 = (tid & 7) * 8;
#pragma unroll
        for (int ch = 0; ch < 2; ++ch) { ML_PTRS(ch) const int row = row0 + l, s = c * 64 + l;
#pragma unroll
            for (int j = 0; j < 4; ++j) gx[ch][j] = (s - 3 + j >= 0) ? *(const v4u*)(cm + (size_t)(row - 3 + j) * 768 + h * 64 + ch0) : v4u{0u, 0u, 0u, 0u};
            gv[ch] = *(const v4u*)(cm + (size_t)row * 768 + 256 + h * 64 + ch0); }
        asm volatile("" : "+v"(gx[0][0]), "+v"(gx[0][1]), "+v"(gx[0][2]), "+v"(gx[0][3]), "+v"(gx[1][0]), "+v"(gx[1][1]), "+v"(gx[1][2]), "+v"(gx[1][3]), "+v"(gv[0]), "+v"(gv[1]));
#pragma unroll
        for (int ch = 0; ch < 2; ++ch) { ML_PTRS(ch) const int row = row0 + l;
            float a[8];
#pragma unroll
            for (int i = 0; i < 8; ++i) a[i] = convb[h * 64 + ch0 + i];
#pragma unroll
            for (int j = 0; j < 4; ++j) { const v4u x4 = gx[ch][j];
                const float* cw = convw + j * 256 + h * 64 + ch0;
                a[0] += cw[0] * __uint_as_float(x4.x << 16); a[1] += cw[1] * __uint_as_float(x4.x & 0xffff0000u); a[2] += cw[2] * __uint_as_float(x4.y << 16); a[3] += cw[3] * __uint_as_float(x4.y & 0xffff0000u);
                a[4] += cw[4] * __uint_as_float(x4.z << 16); a[5] += cw[5] * __uint_as_float(x4.z & 0xffff0000u); a[6] += cw[6] * __uint_as_float(x4.w << 16); a[7] += cw[7] * __uint_as_float(x4.w & 0xffff0000u); }
            v4u o4; float r[8];
#pragma unroll
            for (int i = 0; i < 8; ++i) r[i] = a[i] / (1.f + __expf(-a[i]));
            o4.x = cvtpk(r[0], r[1]); o4.y = cvtpk(r[2], r[3]); o4.z = cvtpk(r[4], r[5]); o4.w = cvtpk(r[6], r[7]);
            *(v4u*)((bf16*)(ws + WS_XC) + (size_t)row * 256 + h * 64 + ch0) = o4;
            *(LAS v4u*)(XS + l * ML_LD + ch0) = o4;
            const v4u v4 = gv[ch];
            VT[(ch0 + 0) * ML_LD + l] = (bf16)(v4.x & 0xffffu); VT[(ch0 + 1) * ML_LD + l] = (bf16)(v4.x >> 16); VT[(ch0 + 2) * ML_LD + l] = (bf16)(v4.y & 0xffffu); VT[(ch0 + 3) * ML_LD + l] = (bf16)(v4.y >> 16);
            VT[(ch0 + 4) * ML_LD + l] = (bf16)(v4.z & 0xffffu); VT[(ch0 + 5) * ML_LD + l] = (bf16)(v4.z >> 16); VT[(ch0 + 6) * ML_LD + l] = (bf16)(v4.w & 0xffffu); VT[(ch0 + 7) * ML_LD + l] = (bf16)(v4.w >> 16);
        }
    }
    {
        const int e = tid >> 3, d0 = (tid & 7) * 8;
        *(LAS v4u*)(WQ + e * ML_LD + d0) = *(const v4u*)((const bf16*)(ws + WT_QM) + h * 4096 + e * 64 + d0);
        *(LAS v4u*)(WK + e * ML_LD + d0) = *(const v4u*)((const bf16*)(ws + WT_KM) + h * 4096 + e * 64 + d0);
    }
    if (wave_u < 2) { ML_PTRS(wave_u)
        const float* mr = (const float*)(ws + WS_MISCRAW) + (size_t)(row0 + lane) * 64;
        const float z = mr[54 + h] + bfg[h]; float lf = fminf(z, 0.f) - __logf(1.f + __expf(-fabsf(z)));
        const float ig = mr[50 + h] + big[h];
#pragma unroll
        for (int o = 1; o < 64; o <<= 1) { const float t = bperm(lf, lane - o); if (lane >= o) lf += t; }
        const float bL = __int_as_float(__builtin_amdgcn_readlane(__float_as_int(lf), 63));
        const float a = bL - lf + ig; const float mx = wave_max2(a);
        wl[lane] = __expf(a - mx);
        if (lane == 0) { ((float*)(ws + WS_ML))[chunk] = mx; ((float*)(ws + WS_BL))[chunk] = bL; }
    }
    __syncthreads();
#pragma unroll
    for (int ch = 0; ch < 2; ++ch) { ML_PTRS(ch)
        const int lb = wave_u & 3; const bool isk = wave_u >= 4;
        const LAS bf16* Wt = isk ? WK : WQ;
        bf16* og = (bf16*)(ws + (isk ? WS_MK : WS_MQ)) + (size_t)(row0 + 16 * lb + 4 * (lane >> 4)) * 256 + h * 64 + (lane & 15);
        float w4[4];
#pragma unroll
        for (int r = 0; r < 4; ++r) w4[r] = wl[16 * lb + 4 * (lane >> 4) + r];
#pragma unroll
        for (int eb = 0; eb < 4; ++eb) {
            f32x4v acc = mm16(XS, ML_LD, 16 * lb, Wt, ML_LD, 16 * eb, 64, lane, f32x4v{});
            if (!isk) {
#pragma unroll
                for (int r = 0; r < 4; ++r) og[(size_t)r * 256 + 16 * eb] = f2bf(acc[r] * 0.125f);
            } else {
                bf16 kb[4];
#pragma unroll
                for (int r = 0; r < 4; ++r) { kb[r] = f2bf(acc[r]); og[(size_t)r * 256 + 16 * eb] = kb[r]; }
                u32x2v w2; w2.x = cvtpk(bf2f(kb[0]) * w4[0], bf2f(kb[1]) * w4[1]); w2.y = cvtpk(bf2f(kb[2]) * w4[2], bf2f(kb[3]) * w4[3]);
                *(LAS u32x2v*)(WKT + (16 * eb + (lane & 15)) * ML_LD + 16 * lb + 4 * (lane >> 4)) = w2;
            }
        }
    }
    __syncthreads();
#pragma unroll
    for (int ch = 0; ch < 2; ++ch) { ML_PTRS(ch)
        float* ct = (float*)(ws + WS_CT) + (size_t)chunk * 4096;
#pragma unroll
        for (int i = 0; i < 2; ++i) { const int blk = wave_u * 2 + i, eb = blk >> 2, db = blk & 3;
            const f32x4v acc = mm16(VT, ML_LD, 16 * eb, WKT, ML_LD, 16 * db, 64, lane, f32x4v{});
#pragma unroll
            for (int r = 0; r < 4; ++r) ct[(16 * eb + 4 * (lane >> 4) + r) * 64 + 16 * db + (lane & 15)] = acc[r]; }
    }
    if (tid < 128) { ML_PTRS(tid >> 6)
        const int d = tid & 63; float n = 0.f; const LAS bf16* wr_ = WKT + d * ML_LD;
        for (int l = 0; l < 64; ++l) n += bf2f(wr_[l]);
        ((float*)(ws + WS_NL))[chunk * 64 + d] = n; }
#undef ML_PTRS
    __syncthreads();
}
__device__ __forceinline__ void mscan_item(unsigned char* ws, int item, int wave_u) {
    const int tid = wave_u * 64 + fresh_lane();
    const int bh = item / 9, part = item % 9;
    if (part == 8 && tid >= 64) return;
    float* base; size_t stride;
    if (part < 8) { base = (float*)(ws + WS_CT) + (size_t)bh * 32 * 4096 + part * 512 + tid; stride = 4096; } else { base = (float*)(ws + WS_NL) + (size_t)bh * 32 * 64 + tid; stride = 64; }
    const float* ML = (const float*)(ws + WS_ML); const float* BL = (const float*)(ws + WS_BL); float* MPv = (float*)(ws + WS_MP);
    float cl[32];
#pragma unroll
    for (int c = 0; c < 32; ++c) cl[c] = base[(size_t)c * stride];
    float Cv = 0.f, m = 0.f;
#pragma unroll
    for (int c = 0; c < 32; ++c) {
        const float ml = ML[bh * 32 + c], bl = BL[bh * 32 + c];
        base[(size_t)c * stride] = Cv;
        if (part == 8 && tid == 0) MPv[bh * 32 + c] = m;
        const float mn = fmaxf(bl + m, ml);
        Cv = __expf(bl + m - mn) * Cv + __expf(ml - mn) * cl[c]; m = mn;
    }
}
constexpr int MO_STRIDE = 5 * 64 * ML_LD * 2 + 64 * 65 * 4 + 6 * 64 * 4;
__device__ __forceinline__ void mout_item(unsigned char* ws, LAS unsigned char* lds, const float* gmh, const float* skip, int chunk0, int wave_u) {
    const int lane = fresh_lane(), tid = wave_u * 64 + lane;
    const int h = (chunk0 >> 5) & 3, b = chunk0 >> 7;
    const float* gm = (const float*)(ws + WS_GM);
#define MO_PTRS(ch) const int chunk = chunk0 + (ch); const int row0 = b * S_ + (chunk & 31) * 64; LAS unsigned char* cb_ = lds + (ch) * MO_STRIDE; \
    LAS bf16* QS = (LAS bf16*)cb_; LAS bf16* KS = QS + 64 * ML_LD; LAS bf16* VT = KS + 64 * ML_LD; LAS bf16* CP = VT + 64 * ML_LD; LAS bf16* SW = CP + 64 * ML_LD; \
    LAS float* HS = (LAS float*)(SW + 64 * ML_LD); LAS float* bs = HS + 64 * 65; LAS float* us = bs + 64; LAS float* ns = us + 64; LAS float* mts = ns + 64; LAS float* ints = mts + 64; LAS float* dinv = ints + 64; \
    (void)row0; (void)QS; (void)KS; (void)VT; (void)CP; (void)SW; (void)HS; (void)bs; (void)us; (void)ns; (void)mts; (void)ints; (void)dinv; (void)chunk;
    {
        v4u gq[2], gk[2], gv[2]; f32x4v gc0[2], gc1[2];
        const int l = tid >> 3, c0 = (tid & 7) * 8;
#pragma unroll
        for (int ch = 0; ch < 2; ++ch) { MO_PTRS(ch) const int row = row0 + l;
            gq[ch] = *(const v4u*)((const bf16*)(ws + WS_MQ) + (size_t)row * 256 + h * 64 + c0); gk[ch] = *(const v4u*)((const bf16*)(ws + WS_MK) + (size_t)row * 256 + h * 64 + c0);
            gv[ch] = *(const v4u*)((const bf16*)(ws + WS_CM) + (size_t)row * 768 + 256 + h * 64 + c0);
            const float* ct = (const float*)(ws + WS_CT) + (size_t)chunk * 4096 + l * 64 + c0;
            gc0[ch] = *(const f32x4v*)ct; gc1[ch] = *(const f32x4v*)(ct + 4); }
        asm volatile("" : "+v"(gq[0]), "+v"(gq[1]), "+v"(gk[0]), "+v"(gk[1]), "+v"(gv[0]), "+v"(gv[1]), "+v"(gc0[0]), "+v"(gc0[1]), "+v"(gc1[0]), "+v"(gc1[1]));
#pragma unroll
        for (int ch = 0; ch < 2; ++ch) { MO_PTRS(ch)
            *(LAS v4u*)(QS + l * ML_LD + c0) = gq[ch]; *(LAS v4u*)(KS + l * ML_LD + c0) = gk[ch];
            const v4u v4 = gv[ch];
            VT[(c0 + 0) * ML_LD + l] = (bf16)(v4.x & 0xffffu); VT[(c0 + 1) * ML_LD + l] = (bf16)(v4.x >> 16); VT[(c0 + 2) * ML_LD + l] = (bf16)(v4.y & 0xffffu); VT[(c0 + 3) * ML_LD + l] = (bf16)(v4.y >> 16);
            VT[(c0 + 4) * ML_LD + l] = (bf16)(v4.z & 0xffffu); VT[(c0 + 5) * ML_LD + l] = (bf16)(v4.z >> 16); VT[(c0 + 6) * ML_LD + l] = (bf16)(v4.w & 0xffffu); VT[(c0 + 7) * ML_LD + l] = (bf16)(v4.w >> 16);
            const f32x4v c0v = gc0[ch], c1v = gc1[ch];
            v4u cw; cw.x = cvtpk(c0v[0], c0v[1]); cw.y = cvtpk(c0v[2], c0v[3]); cw.z = cvtpk(c1v[0], c1v[1]); cw.w = cvtpk(c1v[2], c1v[3]);
            *(LAS v4u*)(CP + l * ML_LD + c0) = cw; }
    }
    if (wave_u < 2) { MO_PTRS(wave_u)
        const float ig = gm[(size_t)(row0 + lane) * 32 + 18 + h]; float lf = gm[(size_t)(row0 + lane) * 32 + 22 + h];
#pragma unroll
        for (int o = 1; o < 64; o <<= 1) { const float t = bperm(lf, lane - o); if (lane >= o) lf += t; }
        const float u = ig - lf; float cu = u;
#pragma unroll
        for (int o = 1; o < 64; o <<= 1) { const float t = bperm(cu, lane - o); if (lane >= o) cu = fmaxf(cu, t); }
        const float mprev = ((const float*)(ws + WS_MP))[chunk];
        const float mt = lf + fmaxf(mprev, cu);
        bs[lane] = lf; us[lane] = u; mts[lane] = mt; ints[lane] = __expf(lf + mprev - mt); ns[lane] = ((const float*)(ws + WS_NL))[chunk * 64 + lane];
    }
    __syncthreads();
#pragma unroll
    for (int ch = 0; ch < 2; ++ch) { MO_PTRS(ch)
#pragma unroll
        for (int i = 0; i < 2; ++i) { const int blk = wave_u * 2 + i, lb = blk >> 2, sb = blk & 3;
            f32x4v acc = f32x4v{};
            if (sb <= lb) acc = mm16(QS, ML_LD, 16 * lb, KS, ML_LD, 16 * sb, 64, lane, acc);
            const int sidx = 16 * sb + (lane & 15); const float usv = us[sidx];
#pragma unroll
            for (int r = 0; r < 4; ++r) { const int l = 16 * lb + 4 * (lane >> 4) + r;
                const float v = (sidx <= l) ? acc[r] * __expf(bs[l] + usv - mts[l]) : 0.f;
                SW[l * ML_LD + sidx] = f2bf(v); } }
    }
    __syncthreads();
    if (tid < 128) { MO_PTRS(tid >> 6)
        const int l = tid & 63; float qn = 0.f, ssum = 0.f;
        for (int d = 0; d < 64; ++d) { qn += bf2f(QS[l * ML_LD + d]) * ns[d]; ssum += bf2f(SW[l * ML_LD + d]); }
        const float den = ints[l] * qn + ssum;
        dinv[l] = 1.f / fmaxf(fabsf(den), __expf(-mts[l]));
    }
    f32x4v hq[2][2], hs2[2][2];
#pragma unroll
    for (int ch = 0; ch < 2; ++ch) { MO_PTRS(ch)
#pragma unroll
        for (int i = 0; i < 2; ++i) { const int blk = wave_u * 2 + i, lb = blk >> 2, eb = blk & 3;
            hq[ch][i] = mm16(QS, ML_LD, 16 * lb, CP, ML_LD, 16 * eb, 64, lane, f32x4v{});
            hs2[ch][i] = mm16(SW, ML_LD, 16 * lb, VT, ML_LD, 16 * eb, 16 * lb + 16 <= 32 ? 32 : 64, lane, f32x4v{}); }
    }
    __syncthreads();
#pragma unroll
    for (int ch = 0; ch < 2; ++ch) { MO_PTRS(ch)
#pragma unroll
        for (int i = 0; i < 2; ++i) { const int blk = wave_u * 2 + i, lb = blk >> 2, eb = blk & 3; const int e = 16 * eb + (lane & 15);
#pragma unroll
            for (int r = 0; r < 4; ++r) { const int l = 16 * lb + 4 * (lane >> 4) + r;
                const float og = bf2f(((const bf16*)(ws + WS_CM))[(size_t)(row0 + l) * 768 + 512 + h * 64 + e]);
                HS[l * 65 + e] = (ints[l] * hq[ch][i][r] + hs2[ch][i][r]) * dinv[l] / (1.f + __expf(-og)); } }
    }
    __syncthreads();
#pragma unroll
    for (int ch = 0; ch < 2; ++ch) { MO_PTRS(ch)
        const int l = tid >> 3, e0 = (tid & 7) * 8, row = row0 + l;
        float v[8]; float mu = 0.f;
#pragma unroll
        for (int i = 0; i < 8; ++i) { v[i] = HS[l * 65 + e0 + i]; mu += v[i]; }
        mu += sxf<1>(mu); mu += sxf<2>(mu); mu += sxf<4>(mu); mu *= (1.f / 64.f);
        float var = 0.f;
#pragma unroll
        for (int i = 0; i < 8; ++i) { const float dl = v[i] - mu; var += dl * dl; }
        var += sxf<1>(var); var += sxf<2>(var); var += sxf<4>(var);
        const float rs = rsqrtf(var * (1.f / 64.f) + EPS);
        const v4u x4 = *(const v4u*)((const bf16*)(ws + WS_XC) + (size_t)row * 256 + h * 64 + e0);
        float xv[8]; xv[0] = __uint_as_float(x4.x << 16); xv[1] = __uint_as_float(x4.x & 0xffff0000u); xv[2] = __uint_as_float(x4.y << 16); xv[3] = __uint_as_float(x4.y & 0xffff0000u);
        xv[4] = __uint_as_float(x4.z << 16); xv[5] = __uint_as_float(x4.z & 0xffff0000u); xv[6] = __uint_as_float(x4.w << 16); xv[7] = __uint_as_float(x4.w & 0xffff0000u);
        float r[8];
#pragma unroll
        for (int i = 0; i < 8; ++i) r[i] = (v[i] - mu) * rs * gmh[h * 64 + e0 + i] + skip[h * 64 + e0 + i] * xv[i];
        v4u w4; w4.x = cvtpk(r[0], r[1]); w4.y = cvtpk(r[2], r[3]); w4.z = cvtpk(r[4], r[5]); w4.w = cvtpk(r[6], r[7]);
        *(v4u*)((bf16*)(ws + WS_HB) + (size_t)row * D_ + 768 + h * 64 + e0) = w4;
    }
#undef MO_PTRS
    __syncthreads();
}

__global__ void __launch_bounds__(NTHR, 2) mega(MP p_unused) {
    extern __shared__ __attribute__((aligned(16))) unsigned char lds_raw[];
    LAS unsigned char* lds = (LAS unsigned char*)lds_raw;
    const int wave0 = __builtin_amdgcn_readfirstlane((int)threadIdx.x >> 6);
    const int tid0 = wave0 * 64 + fresh_lane();
    const int xcc = (int)(__builtin_amdgcn_s_getreg((3 << 11) | 20) & 7u);
    volatile LAS unsigned* MISC = (volatile LAS unsigned*)(lds + MISC_OFF);
    for (int u = tid0; u < (LDS_BYTES - RING_BYTES) / 4; u += NTHR) ((LAS unsigned*)(lds + RING_BYTES))[u] = 0u;
    __syncthreads();
    typedef const __attribute__((address_space(4))) MP* kmp_t;
    kmp_t kp0 = (kmp_t)__builtin_amdgcn_kernarg_segment_ptr();
    unsigned char* ws0 = kp0->ws; const int coop = kp0->coop, ph_lo = kp0->ph_lo, ph_hi = kp0->ph_hi;
    XcdBarrier bar; bar.bar = (unsigned*)(ws0 + WS_CTL) + CW_BAR; bar.x = 0; bar.st = nullptr;
    if (coop) bar = xcd_barrier_post((unsigned*)(ws0 + WS_CTL) + CW_BAR, MISC + 8, tid0);
    if (coop == 2) cooperative_groups::this_grid().sync();
    int ph = ph_lo;
    if (ph == 0) {
        const MPK p{kp0}; ph_p0(p, lds, wave0 * 64 + fresh_lane()); ph = 1;
        if (ph < ph_hi) xcd_barrier(bar, wave0 * 64 + fresh_lane());
    }
    bool second = false;
    for (; ph < ph_hi; ++ph) {
        kmp_t kp = kp0; asm volatile("" : "+s"(kp));
        const MPK p{kp}; unsigned char* ws = kp->ws;
#define TID_ (wave0 * 64 + fresh_lane())
#define GW_ (blockIdx.x * NWAVES + wave0)
#define NGW_ (gridDim.x * NWAVES)
        const int l = (ph - 1) / PPL, ty = (ph == 0) ? -1 : (ph == NPH - 1) ? -2 : (ph - 1) % PPL;
        const float* modl = (const float*)(ws + WS_MOD) + (size_t)l * 8 * 6144;
        if (ty == -2) { norm_rows(p.k->out, PIN(I_GFIN), nullptr, nullptr, nullptr, p.k->out, 2, GW_, NGW_, fresh_lane());
            if (PROBE_SEL != 0 && blockIdx.x == 0 && TID_ == 0) { asm volatile("s_waitcnt vmcnt(0)" ::: "memory"); p.k->out[0] = ((const float*)(ws + WS_CTL))[100] * 0.001f; } }
        else if (ty == 0 && (PHM & 2)) ph_prep(p, l, lds, TID_);
        else if (ty == 1 && (PHM & 4)) {
            pg8::Gemm g{(const bf16*)(ws + WS_HB), (const bf16*)(ws + WT_IN), T_, 2560, D_}; pg8::StaticOrder S; S.init(T_, 2560, gridDim.x, blockIdx.x);
            pg8::EpiIn E{ws, PIN(I_BIG) + l * 4, PIN(I_BFG) + l * 4};
            pg8::gemm_phase<pg8::EpiIn, pg8::StaticOrder, true, true>(lds, g, S, E, wave0);
            late_transposes(p, l, lds, TID_, 640 % (int)gridDim.x);
        }
        else if (ty == 2 && (PHM & 64)) {
            { pg8::Gemm g{(const bf16*)(ws + WS_KVL), (const bf16*)(ws + WT_UKV), T_, 768, 128}; pg8::StaticOrder S; S.init(T_, 768, gridDim.x, blockIdx.x);
              pg8::EpiUKV E{(bf16*)(ws + WS_KVM), (const float*)(ws + WS_SSKV)}; pg8::gemm_phase<pg8::EpiUKV, pg8::StaticOrder, true, true>(lds, g, S, E, wave0); }
            { pg8::Gemm g{(const bf16*)(ws + WS_QL), (const bf16*)(ws + WT_UQ), T_, 768, 256}; pg8::StaticOrder S; S.init(T_, 768, gridDim.x, blockIdx.x);
              pg8::EpiPlain E{(bf16*)(ws + WS_OSLC), 768}; pg8::gemm_phase<pg8::EpiPlain, pg8::StaticOrder, true, true>(lds, g, S, E, wave0); }
            post_misc(ws, PIN(I_BIG) + l * 4, PIN(I_BFG) + l * 4, TID_);
            unsigned* ctrs = (unsigned*)(ws + WS_CTL) + 8192 + ph * 256 + (second ? 128 : 0); int ks = 0;
            for (;;) { const int it = next_item_q(ctrs, lds, wave0, 96, xcc, ks); if (it < 0) break; const int b = it >> 16, j = it & 0xffff;
                if (j < 64) mlocal_item(ws, lds, PIN(I_CONVW) + l * 1024, PIN(I_CONVB) + l * 256, PIN(I_BIG) + l * 4, PIN(I_BFG) + l * 4, b * 128 + 2 * j, wave0);
                else { const int k = j - 64; compress_item(ws, lds, PIN(I_CMPPOS) + l * 2048, ((k >> 4) << 7) | (b << 4) | (k & 15), wave0); } }
        }
        else if (ty == 3 && (PHM & 128)) {
            unsigned* ctrs = (unsigned*)(ws + WS_CTL) + 8192 + ph * 256 + (second ? 128 : 0); int ks = 0;
            for (;;) { const int it = next_item_q(ctrs, lds, wave0, second ? 64 : 100, xcc, ks); if (it < 0) break; const int b = it >> 16, j = it & 0xffff;
                if (second && (REP_MASK & (1 << 20)) && j >= 48) continue; if (second && (REP_MASK & (1 << 21)) && j < 48) continue;
                if (j < 18) mla_unit(ws, lds, b, j % 6, 7 - j / 6, wave0);
                else if (j < 34) cmp_unit(ws, lds, b, (j - 18) >> 3, 7 - ((j - 18) & 7), wave0);
                else if (j < 64) { const int u = j - 16; mla_unit(ws, lds, b, u % 6, 7 - u / 6, wave0); }
                else mscan_item(ws, b * 36 + (j - 64), wave0); }
        }
        else if (ty == 4 && (PHM & 256)) {
            unsigned* ctrs = (unsigned*)(ws + WS_CTL) + 8192 + ph * 256 + (second ? 128 : 0); int ks = 0;
            for (;;) { const int it = next_item_q(ctrs, lds, wave0, 160, xcc, ks); if (it < 0) break; const int b = it >> 16, j = it & 0xffff;
                if (second && (REP_MASK & (1 << 16)) && j >= 96) continue; if (second && (REP_MASK & (1 << 17)) && j < 96) continue;
                if (j < 36) nsa_branch_unit<AM_SLC>(ws, lds, b, j % 6, 7 - j / 6, wave0);
                else if (j < 84) nsa_branch_unit<AM_WINDOW>(ws, lds, b, (j - 36) % 6, 7 - (j - 36) / 6, wave0);
                else if (j < 96) { const int u = j - 48; nsa_branch_unit<AM_SLC>(ws, lds, b, u % 6, 7 - u / 6, wave0); }
                else mout_item(ws, lds, PIN(I_GMH) + l * 256, PIN(I_SKIP) + l * 256, b * 128 + 2 * (j - 96), wave0); }
        }
        else if (ty == 5) ph_mixnorm(p, l, TID_);
        else if (ty == 6 && (PHM & 8)) {
            pg8::Gemm g{(const bf16*)(ws + WS_HB), (const bf16*)(ws + WT_OUT), T_, D_, D_}; pg8::StaticOrder S; S.init(T_, D_, gridDim.x, blockIdx.x);
            pg8::EpiRes E{(l == 0) ? PIN(I_X) : p.k->out, p.k->out, modl + 2048};
            pg8::gemm_phase<pg8::EpiRes, pg8::StaticOrder, true, true>(lds, g, S, E, wave0);
        }
        else if (ty == 7) norm_rows(p.k->out, PIN(I_GN2) + l * D_, modl + 3072, modl + 4096, (bf16*)(ws + WS_HB), nullptr, 1, GW_, NGW_, fresh_lane());
        else if (ty == 8 && (PHM & 16)) {
            pg8::Gemm g{(const bf16*)(ws + WS_HB), (const bf16*)(ws + WT_GU), T_, 2 * FF, D_}; pg8::StaticOrder S; S.init(T_, 2 * FF, gridDim.x, blockIdx.x);
            pg8::EpiGU E{(bf16*)(ws + WS_ACT)};
            pg8::gemm_phase<pg8::EpiGU, pg8::StaticOrder, true, true>(lds, g, S, E, wave0);
            if (l + 1 < DEPTH) early_transposes(p, l + 1, lds, TID_, 1408 % (int)gridDim.x);
        }
        else if (ty == 9 && (PHM & 32)) {
            pg8::Gemm g{(const bf16*)(ws + WS_ACT), (const bf16*)(ws + WT_DOWN), T_, D_, FF}; pg8::StaticOrder S; S.init(T_, D_, gridDim.x, blockIdx.x);
            pg8::EpiRes E{p.k->out, p.k->out, modl + 5120};
            pg8::gemm_phase<pg8::EpiRes, pg8::StaticOrder, true, true>(lds, g, S, E, wave0);
        }
        if (REP_MASK != 0 && ty >= 0 && ((REP_MASK >> ty) & 1) && !second) { second = true; --ph; } else second = false;
        if (ph + 1 < ph_hi) xcd_barrier(bar, wave0 * 64 + fresh_lane());
    }
}

extern "C" void kernel_launch(void* const* d_in, const int* in_sizes, int n_in, void* d_out, int out_size, void* d_ws, size_t ws_size, hipStream_t stream) {
    if (n_in != N_IN || ws_size < WS_END) { fprintf(stderr, "kernel_launch: unexpected n_in %d / ws %zu\n", n_in, ws_size); return; }
    static int inited = 0;
    if (!inited) { if (hipFuncSetAttribute((const void*)mega, hipFuncAttributeMaxDynamicSharedMemorySize, LDS_BYTES) != hipSuccess) fprintf(stderr, "hipFuncSetAttribute failed\n"); inited = 1; }
    unsigned char* ws = (unsigned char*)d_ws;
    MP base{}; for (int i = 0; i < N_IN; ++i) base.in[i] = (const float*)d_in[i]; base.out = (float*)d_out; base.ws = ws;
    (void)hipMemsetAsync(ws + WS_CTL, 0, CTL_ZERO_BYTES, stream);
    static int grid = 0;
    if (!grid) {
        int dev = 0, cus = 0, per_cu = 0;
        (void)hipGetDevice(&dev); (void)hipDeviceGetAttribute(&cus, hipDeviceAttributeMultiprocessorCount, dev);
        if (hipOccupancyMaxActiveBlocksPerMultiprocessor(&per_cu, (const void*)mega, NTHR, LDS_BYTES) != hipSuccess || per_cu < 1) { fprintf(stderr, "kernel_launch: occupancy query says %d blocks per CU\n", per_cu); per_cu = 1; }
        (void)hipGetLastError();
        grid = cus;
    }
    MP a = base; a.ph_lo = 0; a.ph_hi = NPH; a.coop = 1;
    void* args[] = {&a};
    const hipError_t e = hipLaunchCooperativeKernel((const void*)mega, dim3(grid), dim3(NTHR), args, LDS_BYTES, stream);
    if (e != hipSuccess) fprintf(stderr, "kernel_launch: cooperative launch failed: %s (grid %d)\n", hipGetErrorString(e), grid);
}
```

```cpp
#include <hip/hip_runtime.h>
#include <cstdint>
#include <cstdio>
#include <hip/hip_cooperative_groups.h>

constexpr int B_ = 8, S_ = 2048, T_ = B_ * S_, D_ = 1024, DIN = 2362, FF = 2816, DEPTH = 2;
constexpr float EPS = 1e-6f;
constexpr float LOG2E = 1.4426950408889634f;
constexpr float QSCALE = 0.125f * LOG2E;
constexpr float MSCALE = 0.10206207261596577f * LOG2E;
enum { I_X = 0, I_C, I_POS, I_GN1, I_GN2, I_WADA, I_BADA, I_WIN, I_CMPPOS, I_WCK, I_WCV, I_GOA, I_GQL, I_WUQ, I_GKVL, I_WUKV, I_GOB,
       I_CONVW, I_CONVB, I_WQM, I_WKM, I_BIG, I_BFG, I_GMH, I_SKIP, I_WOUT, I_WGU, I_WDOWN, I_GFIN, N_IN };

constexpr size_t MiB = 1u << 20;
constexpr size_t WS_CTL = 0;
constexpr size_t WS_MOD = 1 * MiB;
constexpr size_t WS_COSP = WS_MOD + 512 * 1024;
constexpr size_t WS_SINP = WS_COSP + 512 * 1024;
constexpr size_t WS_COSM = WS_SINP + 512 * 1024;
constexpr size_t WS_SINM = WS_COSM + 1 * MiB;
constexpr size_t WS_SSQL = WS_SINM + 1 * MiB;
constexpr size_t WS_SSKV = WS_SSQL + 64 * 1024;
constexpr size_t WS_ML = WS_SSKV + 64 * 1024;
constexpr size_t WS_BL = WS_ML + 4096;
constexpr size_t WS_MP = WS_BL + 4096;
constexpr size_t WS_NL = WS_MP + 4096;
constexpr size_t WS_WT = 8 * MiB;
constexpr size_t WS_RAW = WS_WT;
constexpr size_t WS_HB = 34 * MiB;
constexpr size_t WS_NSA = 66 * MiB;
constexpr size_t WS_KVL = 102 * MiB;
constexpr size_t WS_QL = 106 * MiB;
constexpr size_t WS_CM = 114 * MiB;
constexpr size_t WS_GM = 138 * MiB;
constexpr size_t WS_KM = 140 * MiB;
constexpr size_t WS_QM = 158 * MiB;
constexpr size_t WS_VM = 176 * MiB;
constexpr size_t WS_KCV = 188 * MiB;
constexpr size_t WS_OCMP = 189 * MiB;
constexpr size_t WS_SEL = 201 * MiB;
constexpr size_t WS_XC = 202 * MiB;
constexpr size_t WS_MQ = 210 * MiB;
constexpr size_t WS_MK = 218 * MiB;
constexpr size_t WS_CT = 226 * MiB;
constexpr size_t WS_MISCRAW = 242 * MiB;
constexpr size_t WS_KVM = 140 * MiB;
constexpr size_t WS_KR = 246 * MiB;
constexpr size_t WS_OSLC = 164 * MiB;
constexpr size_t WS_OWIN = 176 * MiB;
constexpr size_t WS_ACT = 66 * MiB;
constexpr size_t WS_END = 256 * MiB;
static_assert(WS_NL + 1024 * 64 * 4 <= WS_WT, "tab");
static_assert(WS_ACT + (size_t)T_ * FF * 2 <= WS_KCV, "act overlay");

typedef unsigned short bf16;
__device__ __forceinline__ float bf2f(bf16 v) { return __uint_as_float(((unsigned)v) << 16); }
__device__ __forceinline__ bf16 f2bf(float f) { unsigned u = __float_as_uint(f); return (bf16)((u + 0x7fffu + ((u >> 16) & 1u)) >> 16); }
__device__ __forceinline__ float sigmoidf_(float x) { return 1.f / (1.f + __expf(-x)); }
__device__ __forceinline__ float siluf_(float x) { return x / (1.f + __expf(-x)); }
__device__ __forceinline__ float wave_sum(float v) {
#pragma unroll
    for (int o = 1; o < 64; o <<= 1) v += __shfl_xor(v, o);
    return v;
}

__device__ __forceinline__ int fresh_lane() { int l; asm volatile("v_mbcnt_lo_u32_b32 %0, -1, 0\n\tv_mbcnt_hi_u32_b32 %0, -1, %0" : "=&v"(l)); return l; }
template <int M> __device__ __forceinline__ float sxf(float v) { static_assert(M >= 1 && M < 32, "swizzle xor mask"); return __int_as_float(__builtin_amdgcn_ds_swizzle(__float_as_int(v), (M << 10) | 0x1f)); }
__device__ __forceinline__ float red32_max(float v) { auto r = __builtin_amdgcn_permlane32_swap(__float_as_uint(v), __float_as_uint(v), false, false); return fmaxf(__uint_as_float(r[0]), __uint_as_float(r[1])); }
__device__ __forceinline__ float red32_sum(float v) { auto r = __builtin_amdgcn_permlane32_swap(__float_as_uint(v), __float_as_uint(v), false, false); return __uint_as_float(r[0]) + __uint_as_float(r[1]); }
__device__ __forceinline__ unsigned red32_or(unsigned v) { auto r = __builtin_amdgcn_permlane32_swap(v, v, false, false); return r[0] | r[1]; }
__device__ __forceinline__ float bperm(float v, int src_lane) { return __int_as_float(__builtin_amdgcn_ds_bpermute(src_lane << 2, __float_as_int(v))); }
__device__ __forceinline__ float wave_sum2(float v) { v += sxf<1>(v); v += sxf<2>(v); v += sxf<4>(v); v += sxf<8>(v); v += sxf<16>(v); return red32_sum(v); }
__device__ __forceinline__ float wave_max2(float v) { v = fmaxf(v, sxf<1>(v)); v = fmaxf(v, sxf<2>(v)); v = fmaxf(v, sxf<4>(v)); v = fmaxf(v, sxf<8>(v)); v = fmaxf(v, sxf<16>(v)); return red32_max(v); }
namespace pg8 {
#define PG8_LAS __attribute__((address_space(3)))
typedef unsigned short bf16_t;
typedef short bf16x8 __attribute__((ext_vector_type(8)));
typedef float f32x4 __attribute__((ext_vector_type(4)));
typedef unsigned u32x4 __attribute__((ext_vector_type(4)));
constexpr int BM = 256, BK = 64, HALF = 128, HTB = HALF * BK * 2  , STAGE_BYTES = 8 * HTB, NXCD = 8, WGM = 8;

__host__ __device__ __forceinline__ int lds_byte(int r, int c) { const int st = (r >> 4) * 2 + (c >> 5), rr = r & 15, cc = c & 31, ob = rr * 64 + cc * 2; return st * 1024 + (ob ^ (((ob >> 9) & 1) << 5)); }
__host__ __device__ __forceinline__ void stage_rc(int b, int& R, int& C) { const int st = b / 1024, sb = b % 1024, swz = sb ^ (((sb >> 9) & 1) << 5); R = (st >> 1) * 16 + swz / 64; C = (st & 1) * 32 + (swz % 64) / 2; }
__host__ __device__ __forceinline__ int perm32(int rho) { const int n = rho >> 4, i = rho & 15; return 8 * (i >> 2) + 4 * n + (i & 3); }

struct Unit { int pm, pn; };
struct Gemm { const bf16_t* A; const bf16_t* Bt; int M, N, K; };

struct StaticOrder {
    int nM, nN, nwg, G, c;
    __host__ __device__ void init(int M, int N, int G_, int c_) { nM = M / BM; nN = N / BM; nwg = nM * nN; G = G_; c = c_; }
    __host__ __device__ bool next(int i, Unit& u) const {
        const long L = (long)i * G + c; if (L >= nwg) return false;
        int wgid = (int)L; { const int q = nwg / NXCD, r = nwg % NXCD, xcd = wgid % NXCD, off = wgid / NXCD; wgid = (xcd < r ? xcd * (q + 1) : r * (q + 1) + (xcd - r) * q) + off; }
        const int nig = WGM * nN, gid = wgid / nig, fm = gid * WGM, gsz = (nM - fm) < WGM ? (nM - fm) : WGM;
        u.pm = fm + ((wgid % nig) % gsz); u.pn = (wgid % nig) / gsz; return true;
    }
    __device__ __forceinline__ void a_ready(const Unit&) const {}
    __device__ __forceinline__ void done(const Unit&) const {}
};

__device__ __forceinline__ unsigned cvt_pk_bf16(float lo, float hi) { unsigned r; asm volatile("v_cvt_pk_bf16_f32 %0, %1, %2" : "=v"(r) : "v"(lo), "v"(hi)); return r; }
typedef float f32x2 __attribute__((ext_vector_type(2)));

typedef unsigned u32x4 __attribute__((ext_vector_type(4)));
typedef unsigned u32x2 __attribute__((ext_vector_type(2)));
struct EpiIn {
    static constexpr bool PERM = true, AFTER_DRAIN = false;
    unsigned char* ws; const float *big, *bfg;
#define EPI_ROWS(...) _Pragma("unroll") for (int ai = 0; ai < 2; ++ai) _Pragma("unroll") for (int m = 0; m < 4; ++m) { \
        const int row = u.pm * BM + ai * HALF + wr * 64 + m * 16 + fr; float v[8]; \
        _Pragma("unroll") for (int i = 0; i < 4; ++i) { v[i] = acc[ai][bj][m][0][i]; v[4 + i] = acc[ai][bj][m][1][i]; } \
        asm volatile("" : "+v"(v[0]), "+v"(v[1]), "+v"(v[2]), "+v"(v[3]), "+v"(v[4]), "+v"(v[5]), "+v"(v[6]), "+v"(v[7])); \
        __VA_ARGS__ asm volatile("" ::: "memory"); }
#define EPI_PACK(w) u32x4 w; w.x = cvt_pk_bf16(v[0], v[1]); w.y = cvt_pk_bf16(v[2], v[3]); w.z = cvt_pk_bf16(v[4], v[5]); w.w = cvt_pk_bf16(v[6], v[7]);
    __device__ __forceinline__ void operator()(const f32x4 (&acc)[2][2][4][2], const Unit& u, int wr, int wc, int fr, int fq) const {
        half<0>(acc, u, wr, wc, fr, fq); half<1>(acc, u, wr, wc, fr, fq);
    }
    template <int bj> __device__ __forceinline__ void half(const f32x4 (&acc)[2][2][4][2], const Unit& u, int wr, int wc, int fr, int fq) const {
        {
            const int hb = 2 * u.pn + bj;
            int cb = 32 * wc + 8 * fq; asm volatile("" : "+v"(cb), "+v"(fr));
            if (hb <= 8) {
                bf16_t* nsa = (bf16_t*)(ws + WS_NSA) + hb * 128 + cb;
                const bool rope_hb = (hb <= 3) || hb == 5 || hb == 7;
                if (rope_hb) {
                    const float* cosP = (const float*)(ws + WS_COSP); const float* sinP = (const float*)(ws + WS_SINP);
                    const bool mine = ((wc & 1) == 0) && fq < 2; const float sg = (fq == 0) ? -1.f : 1.f; const float sc = (hb < 3) ? QSCALE : 1.f;
                    f32x4 tc0 = {0.f, 0.f, 0.f, 0.f}, tc1 = tc0, ts0 = tc0, ts1 = tc0;
                    if (mine) { const int r0 = u.pm * BM + wr * 64 + fr; tc0 = *(const f32x4*)(cosP + r0 * 8); tc1 = *(const f32x4*)(cosP + r0 * 8 + 4); ts0 = *(const f32x4*)(sinP + r0 * 8); ts1 = *(const f32x4*)(sinP + r0 * 8 + 4); }
                    EPI_ROWS({
                        float pv[8];
                        _Pragma("unroll") for (int i = 0; i < 8; ++i) pv[i] = sxf<16>(v[i]);
                        const f32x4 c0 = tc0, c1 = tc1, s0 = ts0, s1 = ts1;
                        if (mine && (ai * 4 + m) < 7) { const int nx = ai * 4 + m + 1; const int rn = u.pm * BM + (nx >> 2) * HALF + wr * 64 + (nx & 3) * 16 + fr;
                            tc0 = *(const f32x4*)(cosP + rn * 8); tc1 = *(const f32x4*)(cosP + rn * 8 + 4); ts0 = *(const f32x4*)(sinP + rn * 8); ts1 = *(const f32x4*)(sinP + rn * 8 + 4); }
                        if (mine) {
                            _Pragma("unroll") for (int i = 0; i < 4; ++i) { v[i] = v[i] * c0[i] + sg * pv[i] * s0[i]; v[4 + i] = v[4 + i] * c1[i] + sg * pv[4 + i] * s1[i]; }
                        }
                        _Pragma("unroll") for (int i = 0; i < 8; ++i) v[i] *= sc;
                        EPI_PACK(w) *(u32x4*)(nsa + (size_t)row * 1152) = w;
                    })
                } else {
                    EPI_ROWS({ EPI_PACK(w) *(u32x4*)(nsa + (size_t)row * 1152) = w; })
                }
            } else if (hb <= 11) {
                bf16_t* dst = (hb == 9) ? (bf16_t*)(ws + WS_KVL) + cb : (bf16_t*)(ws + WS_QL) + (hb - 10) * 128 + cb;
                const int ld = (hb == 9) ? 128 : 256;
                float* ssq = (hb == 9) ? (float*)(ws + WS_SSKV) : (float*)(ws + WS_SSQL);
                EPI_ROWS({ EPI_PACK(w) *(u32x4*)(dst + (size_t)row * ld) = w;
                    float sq = 0.f;
                    _Pragma("unroll") for (int i = 0; i < 8; ++i) sq += v[i] * v[i];
                    sq += sxf<16>(sq); sq = red32_sum(sq);
                    if (fq == 0) atomicAdd(ssq + row, sq); })
            } else if (hb <= 17) {
                bf16_t* cm = (bf16_t*)(ws + WS_CM) + (hb - 12) * 128 + cb;
                EPI_ROWS({ EPI_PACK(w) *(u32x4*)(cm + (size_t)row * 768) = w; })
            } else if (hb == 18) {
                float* mr = (float*)(ws + WS_MISCRAW) + cb;
                if (wc < 2) { EPI_ROWS({ *(f32x4*)(mr + (size_t)row * 64) = (f32x4){v[0], v[1], v[2], v[3]}; *(f32x4*)(mr + (size_t)row * 64 + 4) = (f32x4){v[4], v[5], v[6], v[7]}; }) }
            }
        }
    }
#undef EPI_ROWS
#undef EPI_PACK
};
struct EpiUKV {
    static constexpr bool PERM = true, AFTER_DRAIN = false;
    bf16_t* kvm; const float* sskv;
    __device__ __forceinline__ void operator()(const f32x4 (&acc)[2][2][4][2], const Unit& u, int wr, int wc, int fr, int fq) const {
        asm volatile("" : "+v"(fq), "+v"(fr));
        const int col0 = u.pn * BM + wc * 32 + 8 * fq;
        float rs8[8];
#pragma unroll
        for (int i = 0; i < 8; ++i) rs8[i] = sskv[u.pm * BM + (i >> 2) * HALF + wr * 64 + (i & 3) * 16 + fr];
#pragma unroll
        for (int i = 0; i < 8; ++i) rs8[i] = rsqrtf(rs8[i] * (1.f / 128.f) + EPS);
#pragma unroll
        for (int ai = 0; ai < 2; ++ai)
#pragma unroll
            for (int m = 0; m < 4; ++m) { const int row = u.pm * BM + ai * HALF + wr * 64 + m * 16 + fr; bf16_t* rowp = kvm + (size_t)row * 768 + col0;
                const float rs = rs8[ai * 4 + m];
#pragma unroll
                for (int bj = 0; bj < 2; ++bj) { const f32x4 a = acc[ai][bj][m][0] * rs, b = acc[ai][bj][m][1] * rs;
                    u32x4 w; w.x = cvt_pk_bf16(a[0], a[1]); w.y = cvt_pk_bf16(a[2], a[3]); w.z = cvt_pk_bf16(b[0], b[1]); w.w = cvt_pk_bf16(b[2], b[3]);
                    *(u32x4*)(rowp + bj * HALF) = w; } }
    }
};
struct EpiPlain {
    static constexpr bool PERM = true, AFTER_DRAIN = false;
    bf16_t* out; int ld;
    __device__ __forceinline__ void operator()(const f32x4 (&acc)[2][2][4][2], const Unit& u, int wr, int wc, int fr, int fq) const {
        asm volatile("" : "+v"(fq), "+v"(fr));
        const int col0 = u.pn * BM + wc * 32 + 8 * fq;
#pragma unroll
        for (int ai = 0; ai < 2; ++ai)
#pragma unroll
            for (int m = 0; m < 4; ++m) { bf16_t* rowp = out + (size_t)(u.pm * BM + ai * HALF + wr * 64 + m * 16 + fr) * ld + col0;
#pragma unroll
                for (int bj = 0; bj < 2; ++bj) { const f32x4 a = acc[ai][bj][m][0], b = acc[ai][bj][m][1];
                    u32x4 w; w.x = cvt_pk_bf16(a[0], a[1]); w.y = cvt_pk_bf16(a[2], a[3]); w.z = cvt_pk_bf16(b[0], b[1]); w.w = cvt_pk_bf16(b[2], b[3]);
                    *(u32x4*)(rowp + bj * HALF) = w; } }
    }
};
struct EpiRes {
    static constexpr bool PERM = false, AFTER_DRAIN = false;
    const float* xin; float* xout; const float* gate;
    __device__ __forceinline__ void operator()(const f32x4 (&acc)[2][2][4][2], const Unit& u, int wr, int wc, int fr, int fq) const {
        asm volatile("" : "+v"(fq), "+v"(fr));
        const int b = (u.pm * BM) / S_; const int col0 = u.pn * BM + wc * 32 + 4 * fq;
        f32x4 gv[2][2];
#pragma unroll
        for (int bj = 0; bj < 2; ++bj)
#pragma unroll
            for (int n = 0; n < 2; ++n) gv[bj][n] = *(const f32x4*)(gate + (size_t)b * 6144 + col0 + bj * HALF + n * 16);
#pragma unroll
        for (int ai = 0; ai < 2; ++ai)
#pragma unroll
            for (int m = 0; m < 4; ++m) { const size_t off = (size_t)(u.pm * BM + ai * HALF + wr * 64 + m * 16 + fr) * D_ + col0;
#pragma unroll
                for (int bj = 0; bj < 2; ++bj)
#pragma unroll
                    for (int n = 0; n < 2; ++n) { const f32x4 xi = *(const f32x4*)(xin + off + bj * HALF + n * 16); *(f32x4*)(xout + off + bj * HALF + n * 16) = xi + gv[bj][n] * acc[ai][bj][m][n]; } }
    }
};
struct EpiGU {
    static constexpr bool PERM = true, AFTER_DRAIN = false;
    bf16_t* act;
    __device__ __forceinline__ void operator()(const f32x4 (&acc)[2][2][4][2], const Unit& u, int wr, int wc, int fr, int fq) const {
        asm volatile("" : "+v"(fq), "+v"(fr));
        const int col0 = u.pn * HALF + wc * 32 + 8 * fq;
#pragma unroll
        for (int ai = 0; ai < 2; ++ai)
#pragma unroll
            for (int m = 0; m < 4; ++m) { const int row = u.pm * BM + ai * HALF + wr * 64 + m * 16 + fr; float o[8];
#pragma unroll
                for (int n = 0; n < 2; ++n)
#pragma unroll
                    for (int i = 0; i < 4; ++i) { const float g = acc[ai][0][m][n][i], up = acc[ai][1][m][n][i]; o[4 * n + i] = g / (1.f + __expf(-g)) * up; }
                u32x4 w; w.x = cvt_pk_bf16(o[0], o[1]); w.y = cvt_pk_bf16(o[2], o[3]); w.z = cvt_pk_bf16(o[4], o[5]); w.w = cvt_pk_bf16(o[6], o[7]);
                *(u32x4*)(act + (size_t)row * FF + col0) = w; }
    }
};
template <class Epi, class Sched, bool ALIGN_EPI = false, bool SP2 = false>
__device__ __forceinline__ void gemm_phase(PG8_LAS unsigned char* lds, const Gemm g, const Sched& S, const Epi& E, int wid_in) {
    const int wid = __builtin_amdgcn_readfirstlane(wid_in), lane = fresh_lane(), tid = wid * 64 + lane, wr = wid >> 2, wc = wid & 3;
    const int K = g.K, nt = K / BK;
    unsigned voffA[2], voffB[2];
#pragma unroll
    for (int i = 0; i < 2; ++i) { int R, C; stage_rc(tid * 16 + i * 8192, R, C); const int Rb = Epi::PERM ? ((R & ~31) + perm32(R & 31)) : R;
        voffA[i] = (unsigned)(R * K + C) * 2u; voffB[i] = (unsigned)(Rb * K + C) * 2u; }
    const size_t kstep = (size_t)(BK * 2);
    const size_t hstep = (size_t)HALF * K * 2;
    const size_t tstep = 2 * hstep;
    const unsigned ldsw = (unsigned)wid * 1024u;
    const int aoff = lds_byte(wr * 64 + (lane & 15), (lane >> 4) * 8), boff = lds_byte(wc * 32 + (lane & 15), (lane >> 4) * 8);
#define PG8_SA(b, h) (((b) * 2 + (h)) * HTB)
#define PG8_SB(b, h) ((4 + (b) * 2 + (h)) * HTB)
#define PG8_STAGE(bufoff, gbase, voff) do { _Pragma("unroll") for (int _i = 0; _i < 2; ++_i) \
        __builtin_amdgcn_global_load_lds((const unsigned*)((const char*)(gbase) + (voff)[_i]), (PG8_LAS unsigned*)(lds + (bufoff) + ldsw + _i * 8192), 16, 0, 0); } while (0)
#define PG8_LDA(dst, b, h) do { _Pragma("unroll") for (int m = 0; m < 4; ++m) _Pragma("unroll") for (int k = 0; k < 2; ++k) dst[m][k] = *(const PG8_LAS bf16x8*)(lds + PG8_SA(b, h) + aoff + m * 2048 + k * 1024); } while (0)
#define PG8_LDB(dst, b, h) do { _Pragma("unroll") for (int n = 0; n < 2; ++n) _Pragma("unroll") for (int k = 0; k < 2; ++k) dst[n][k] = *(const PG8_LAS bf16x8*)(lds + PG8_SB(b, h) + boff + n * 2048 + k * 1024); } while (0)
#define PG8_MMA(ai, bj, At, Bt) do { __builtin_amdgcn_s_setprio(1); _Pragma("unroll") for (int m = 0; m < 4; ++m) _Pragma("unroll") for (int n = 0; n < 2; ++n) _Pragma("unroll") for (int k = 0; k < 2; ++k) \
        acc[ai][bj][m][n] = __builtin_amdgcn_mfma_f32_16x16x32_bf16(Bt[n][k], At[m][k], acc[ai][bj][m][n], 0, 0, 0); __builtin_amdgcn_s_setprio(0); } while (0)
#define PG8_WAIT_V(n) asm volatile("s_waitcnt vmcnt(" #n ")" ::: "memory")
#define PG8_WAIT_L(n) asm volatile("s_waitcnt lgkmcnt(" #n ")" ::: "memory")
#define PG8_BAR __builtin_amdgcn_s_barrier()
#define PG8_SCHED __builtin_amdgcn_sched_barrier(0)
    Unit cur, nxt; int ui = 0;
    if (!S.next(0, cur)) return;
    f32x4 acc[2][2][4][2];
#pragma unroll
    for (int a = 0; a < 2; ++a)
#pragma unroll
        for (int b = 0; b < 2; ++b)
#pragma unroll
            for (int m = 0; m < 4; ++m)
#pragma unroll
                for (int n = 0; n < 2; ++n) acc[a][b][m][n] = (f32x4){0.f, 0.f, 0.f, 0.f};
    bf16x8 At[4][2], B0[2][2], B1[2][2];
    const char* cA = (const char*)g.A + (size_t)cur.pm * tstep; const char* cB = (const char*)g.Bt + (size_t)cur.pn * tstep;
    S.a_ready(cur);
    if constexpr (SP2) {
        PG8_STAGE(PG8_SB(0, 0), cB, voffB); PG8_STAGE(PG8_SB(0, 1), cB + hstep, voffB); PG8_STAGE(PG8_SA(0, 0), cA, voffA); PG8_STAGE(PG8_SA(0, 1), cA + hstep, voffA);
        if (wr == 1) PG8_BAR;
        PG8_WAIT_V(2); PG8_BAR;
        PG8_STAGE(PG8_SB(1, 0), cB + kstep, voffB); PG8_STAGE(PG8_SA(1, 0), cA + kstep, voffA); PG8_STAGE(PG8_SB(1, 1), cB + hstep + kstep, voffB);
        PG8_WAIT_V(6); PG8_BAR;
    } else {
        PG8_STAGE(PG8_SB(0, 0), cB, voffB); PG8_STAGE(PG8_SA(0, 0), cA, voffA); PG8_STAGE(PG8_SB(0, 1), cB + hstep, voffB); PG8_STAGE(PG8_SA(0, 1), cA + hstep, voffA);
        if (wr == 1) PG8_BAR;
        PG8_WAIT_V(4); PG8_BAR;
        PG8_STAGE(PG8_SB(1, 0), cB + kstep, voffB); PG8_STAGE(PG8_SA(1, 0), cA + kstep, voffA); PG8_STAGE(PG8_SB(1, 1), cB + hstep + kstep, voffB);
        PG8_WAIT_V(6); PG8_BAR;
    }
    for (;;) {
        const bool has_next = S.next(ui + 1, nxt);
        const char* nA = has_next ? (const char*)g.A + (size_t)nxt.pm * tstep : cA; const char* nB = has_next ? (const char*)g.Bt + (size_t)nxt.pn * tstep : cB;
        for (int t = 0; t < nt; t += 2) {
            const bool last = (t == nt - 2);
            const char* a1 = cA + (size_t)(t + 1) * kstep;
            const char* a2 = last ? nA : cA + (size_t)(t + 2) * kstep; const char* b2 = last ? nB : cB + (size_t)(t + 2) * kstep;
            const char* a3 = a2 + kstep; const char* b3 = b2 + kstep;
            if (last && has_next) S.a_ready(nxt);
            if constexpr (SP2) {
            PG8_LDB(B0, 0, 0); PG8_LDB(B1, 0, 1); PG8_SCHED; PG8_LDA(At, 0, 0); PG8_STAGE(PG8_SA(1, 1), a1 + hstep, voffA);
            PG8_WAIT_V(8); PG8_WAIT_L(0); PG8_BAR; PG8_MMA(0, 0, At, B0); PG8_MMA(0, 1, At, B1); PG8_BAR; PG8_SCHED;
            PG8_LDA(At, 0, 1); PG8_STAGE(PG8_SB(0, 0), b2, voffB); PG8_STAGE(PG8_SB(0, 1), b2 + hstep, voffB); PG8_STAGE(PG8_SA(0, 0), a2, voffA);
            PG8_WAIT_V(8); PG8_WAIT_L(0); PG8_BAR; PG8_MMA(1, 0, At, B0); PG8_MMA(1, 1, At, B1); PG8_BAR; PG8_SCHED;
            PG8_LDB(B0, 1, 0); PG8_LDB(B1, 1, 1); PG8_SCHED; PG8_LDA(At, 1, 0); PG8_STAGE(PG8_SA(0, 1), a2 + hstep, voffA);
            PG8_WAIT_V(8); PG8_WAIT_L(0); PG8_BAR; PG8_MMA(0, 0, At, B0); PG8_MMA(0, 1, At, B1); PG8_BAR; PG8_SCHED;
            PG8_LDA(At, 1, 1); PG8_STAGE(PG8_SB(1, 0), b3, voffB); PG8_STAGE(PG8_SB(1, 1), b3 + hstep, voffB); PG8_STAGE(PG8_SA(1, 0), a3, voffA);
            PG8_WAIT_V(8); PG8_WAIT_L(0); PG8_BAR; PG8_MMA(1, 0, At, B0); PG8_MMA(1, 1, At, B1); PG8_BAR; PG8_SCHED;
            } else {
            PG8_LDB(B0, 0, 0); PG8_SCHED; PG8_LDA(At, 0, 0); PG8_STAGE(PG8_SA(1, 1), a1 + hstep, voffA);
            PG8_WAIT_L(8); PG8_BAR; PG8_WAIT_L(0); PG8_MMA(0, 0, At, B0); PG8_BAR; PG8_SCHED;
            PG8_LDB(B1, 0, 1); PG8_STAGE(PG8_SB(0, 0), b2, voffB);
            PG8_BAR; PG8_WAIT_L(0); PG8_MMA(0, 1, At, B1); PG8_BAR;
            PG8_LDA(At, 0, 1); PG8_STAGE(PG8_SA(0, 0), a2, voffA);
            PG8_BAR; PG8_WAIT_L(0); PG8_MMA(1, 0, At, B0); PG8_BAR; PG8_SCHED;
            PG8_STAGE(PG8_SB(0, 1), b2 + hstep, voffB);
            PG8_WAIT_V(6); PG8_BAR; PG8_MMA(1, 1, At, B1); PG8_BAR;
            PG8_LDB(B0, 1, 0); PG8_SCHED; PG8_LDA(At, 1, 0); PG8_STAGE(PG8_SA(0, 1), a2 + hstep, voffA);
            PG8_WAIT_L(8); PG8_BAR; PG8_WAIT_L(0); PG8_MMA(0, 0, At, B0); PG8_BAR; PG8_SCHED;
            PG8_LDB(B1, 1, 1); PG8_STAGE(PG8_SB(1, 0), b3, voffB);
            PG8_BAR; PG8_WAIT_L(0); PG8_MMA(0, 1, At, B1); PG8_BAR;
            PG8_LDA(At, 1, 1); PG8_STAGE(PG8_SA(1, 0), a3, voffA);
            PG8_BAR; PG8_WAIT_L(0); PG8_MMA(1, 0, At, B0); PG8_BAR; PG8_SCHED;
            PG8_STAGE(PG8_SB(1, 1), b3 + hstep, voffB);
            PG8_WAIT_V(6); PG8_BAR; PG8_MMA(1, 1, At, B1); PG8_BAR;
            }
        }
        if constexpr (ALIGN_EPI) { if (wr == 0) PG8_BAR; }
        if constexpr (!Epi::AFTER_DRAIN) { const int ln = fresh_lane(); E(acc, cur, wr, wc, ln & 15, ln >> 4); S.done(cur); }
        if (!has_next) break;
#pragma unroll
        for (int a = 0; a < 2; ++a)
#pragma unroll
            for (int b = 0; b < 2; ++b)
#pragma unroll
                for (int m = 0; m < 4; ++m)
#pragma unroll
                    for (int n = 0; n < 2; ++n) acc[a][b][m][n] = (f32x4){0.f, 0.f, 0.f, 0.f};
        cur = nxt; cA = nA; cB = nB; ++ui;
        if constexpr (ALIGN_EPI) { if (wr == 1) PG8_BAR; }
    }
    PG8_WAIT_V(0);
    if constexpr (!ALIGN_EPI) { if (wr == 0) PG8_BAR; }
    PG8_BAR;
    if constexpr (Epi::AFTER_DRAIN) { const int ln = fresh_lane(); E.fused(acc, cur, wr, wc, ln & 15, ln >> 4, lds, wid, ln); S.done(cur); }
#undef PG8_SA
#undef PG8_SB
#undef PG8_STAGE
#undef PG8_LDA
#undef PG8_LDB
#undef PG8_MMA
#undef PG8_WAIT_V
#undef PG8_WAIT_L
#undef PG8_BAR
#undef PG8_SCHED
}
}

#define GAS __attribute__((address_space(1)))
#define LAS __attribute__((address_space(3)))
typedef float f32x4 __attribute__((ext_vector_type(4)));
typedef unsigned v4u __attribute__((ext_vector_type(4)));
typedef GAS unsigned gu32;
#define XB_TMO      128
#define XB_XCNT(j)  (256  + 64 * (j))
#define XB_XSUB(j)  (1280 + 64 * (j))
#define XB_XGEN(j)  (2304 + 64 * (j))
#define XB_TOP      3328
#define XB_TOPGEN   3392
#define XCD_BAR_WORDS 3456
#define XB_SPIN_CAP (1u << 18)

__device__ __forceinline__ unsigned xb_ld(unsigned* p)              { return __hip_atomic_load(p, __ATOMIC_RELAXED, __HIP_MEMORY_SCOPE_AGENT); }
__device__ __forceinline__ unsigned xb_add(unsigned* p, unsigned v) { return __hip_atomic_fetch_add(p, v, __ATOMIC_RELAXED, __HIP_MEMORY_SCOPE_AGENT); }
__device__ __forceinline__ unsigned xb_xcc_id() { return (unsigned)__builtin_amdgcn_s_getreg((3 << 11) | 20) & 0xFu; }
#define XB_SPIN(cond, bar) do { unsigned _sp = 0; while (cond) { __builtin_amdgcn_s_sleep(1); \
    if ((++_sp & 255u) == 0u) { if (xb_ld(&(bar)[XB_TMO])) break; if (_sp > XB_SPIN_CAP) { atomicAdd(&(bar)[XB_TMO], 1u); break; } } } } while (0)

struct XcdBarrier {
    unsigned* bar; unsigned x;
    volatile LAS unsigned* st;
};

__device__ __forceinline__ XcdBarrier xcd_barrier_post(unsigned* bar, volatile LAS unsigned* st, int tid) {
    XcdBarrier b; b.bar = bar; b.x = xb_xcc_id(); b.st = st;
    if (tid == 0) (void)xb_add(&bar[XB_XCNT(b.x)], 1u);
    return b;
}
__device__ __forceinline__ void xcd_barrier_complete(unsigned* bar, unsigned x, unsigned& nloc, unsigned& nx) {
    const unsigned G = gridDim.x * gridDim.y * gridDim.z;
    unsigned sum, cnt, mine, sp = 0u;
    for (;;) {
        sum = 0u; cnt = 0u; mine = 0u;
#pragma unroll
        for (unsigned j = 0; j < 16; ++j) { const unsigned c = xb_ld(&bar[XB_XCNT(j)]); sum += c; cnt += (c > 0u) ? 1u : 0u; mine = (j == x) ? c : mine; }
        if (sum == G) break;
        __builtin_amdgcn_s_sleep(1);
        if ((++sp & 255u) == 0u) { if (xb_ld(&bar[XB_TMO])) break; if (sp > XB_SPIN_CAP) { atomicAdd(&bar[XB_TMO], 1u); break; } }
    }
    nloc = mine > 0u ? mine : 1u; nx = cnt > 0u ? cnt : 1u;
}

__device__ __forceinline__ void xcd_barrier(const XcdBarrier& b, int tid) {
    asm volatile("s_waitcnt vmcnt(0)" ::: "memory");
    __syncthreads();
    if (tid == 0) {
        unsigned* bar = b.bar;
        __builtin_amdgcn_s_waitcnt(0);
        unsigned nloc = b.st[0], nx = b.st[1];
        if (nloc == 0u) { xcd_barrier_complete(bar, b.x, nloc, nx); b.st[0] = nloc; b.st[1] = nx; }
        const unsigned old = xb_add(&bar[XB_XSUB(b.x)], 1u);
        const unsigned gen = old / nloc;
        if (old + 1u == (gen + 1u) * nloc) {
            __builtin_amdgcn_fence(__ATOMIC_RELEASE, "agent");
            asm volatile("s_waitcnt vmcnt(0)" ::: "memory");
            const unsigned og = xb_add(&bar[XB_TOP], 1u);
            const unsigned tg = og / nx;
            if (og + 1u == (tg + 1u) * nx) xb_add(&bar[XB_TOPGEN], 1u);
            else XB_SPIN(xb_ld(&bar[XB_TOPGEN]) == tg, bar);
            __builtin_amdgcn_fence(__ATOMIC_ACQUIRE, "agent");
            xb_add(&bar[XB_XGEN(b.x)], 1u);
            asm volatile("s_waitcnt vmcnt(0)" ::: "memory");
        } else {
            XB_SPIN(xb_ld(&bar[XB_XGEN(b.x)]) == gen, bar);
            __builtin_amdgcn_fence(__ATOMIC_ACQUIRE, "agent");
            asm volatile("s_waitcnt vmcnt(0)" ::: "memory");
        }
    }
    __syncthreads();
}

constexpr int NTHR = 512, NWAVES = 8;
constexpr int RING_BYTES = 131072, MISC_OFF = RING_BYTES + 320, LDS_BYTES = 147456;
constexpr int CW_BAR = 4096;
constexpr size_t CTL_ZERO_BYTES = 64 * 1024;
constexpr size_t WT_IN = WS_WT, WT_OUT = WT_IN + (size_t)2560 * 1024 * 2, WT_GU = WT_OUT + (size_t)1024 * 1024 * 2, WT_DOWN = WT_GU + (size_t)5632 * 1024 * 2,
                 WT_UQ = WT_DOWN + (size_t)1024 * 2816 * 2, WT_UKV = WT_UQ + (size_t)768 * 256 * 2, WT_CK = WT_UKV + (size_t)768 * 128 * 2, WT_CV = WT_CK + (size_t)64 * 2048 * 2,
                 WT_QM = WT_CV + (size_t)64 * 2048 * 2, WT_KM = WT_QM + 4 * 64 * 64 * 2, WT_END = WT_KM + 4 * 64 * 64 * 2;
static_assert(WT_END <= WS_HB, "weights");
constexpr int NPH = 22, PPL = 10;
constexpr int PROBE_SEL = 0;
constexpr int REP_MASK = 0;
#ifndef PHM
#define PHM 0xffff
#endif
struct MP { const float* in[N_IN]; float* out; unsigned char* ws; int ph_lo, ph_hi, coop, pad; };

struct MPK {
    const __attribute__((address_space(4))) MP* k;
    struct InArr { const __attribute__((address_space(4))) MP* k; __device__ __forceinline__ const float* operator[](int i) const { return k->in[i]; } };
    __device__ __forceinline__ InArr in_() const { return InArr{k}; }
};
#define PIN(i) (p.k->in[i])
__device__ __forceinline__ unsigned pk2(float lo, float hi) { return (unsigned)f2bf(lo) | ((unsigned)f2bf(hi) << 16); }
struct MapId { int n; __device__ __forceinline__ int operator()(int c) const { return c < n ? c : -1; } };
struct MapIn { __device__ __forceinline__ int operator()(int c) const {
    if (c < 1152) return c; if (c < 1280) return 1426 + (c - 1152); if (c < 1536) return 1170 + (c - 1280); if (c < 2304) return 1586 + (c - 1536);
    if (c < 2336) return 1554 + (c - 2304); if (c < 2354) return 1152 + (c - 2336); if (c < 2362) return c; return -1; } };
struct MapGU { __device__ __forceinline__ int operator()(int c) const { const int t = c >> 8, w = c & 255; return (w < 128) ? t * 128 + w : FF + t * 128 + (w - 128); } };
template <class Map> __device__ __forceinline__ void transpose_item(const float* W, int K, int ldw, const Map& map, const float* kscale, bf16* WT, LAS float* scr, int item, int nblk, int lane) {
    const int kb = item / nblk, nb = item % nblk, k0 = 64 * kb, n0 = 32 * nb;
    const int np = 2 * (lane & 15);
    const int sc = map(n0 + np);
    float2 tv[16];
#pragma unroll
    for (int i = 0; i < 16; ++i) { const int kk = 4 * i + (lane >> 4); tv[i] = (sc >= 0) ? *(const float2*)(W + (size_t)(k0 + kk) * ldw + sc) : make_float2(0.f, 0.f); }
    asm volatile("" : "+v"(tv[0]), "+v"(tv[1]), "+v"(tv[2]), "+v"(tv[3]), "+v"(tv[4]), "+v"(tv[5]), "+v"(tv[6]), "+v"(tv[7]));
    asm volatile("" : "+v"(tv[8]), "+v"(tv[9]), "+v"(tv[10]), "+v"(tv[11]), "+v"(tv[12]), "+v"(tv[13]), "+v"(tv[14]), "+v"(tv[15]));
#pragma unroll
    for (int i = 0; i < 16; ++i) { const int kk = 4 * i + (lane >> 4); float2 v = tv[i];
        if (kscale) { const float ksc = kscale[k0 + kk]; v.x *= ksc; v.y *= ksc; } scr[kk * 33 + np] = v.x; scr[kk * 33 + np + 1] = v.y; }
    asm volatile("s_waitcnt lgkmcnt(0)" ::: "memory");
    const int c = lane & 7;
#pragma unroll
    for (int j = 0; j < 4; ++j) { const int n = (lane >> 3) + 8 * j; const LAS float* s = scr + (8 * c) * 33 + n;
        v4u o; o.x = pk2(s[0 * 33], s[1 * 33]); o.y = pk2(s[2 * 33], s[3 * 33]); o.z = pk2(s[4 * 33], s[5 * 33]); o.w = pk2(s[6 * 33], s[7 * 33]);
        *(v4u*)(WT + (size_t)(n0 + n) * K + k0 + 8 * c) = o; }
    asm volatile("s_waitcnt lgkmcnt(0)" ::: "memory");
}
__device__ __forceinline__ void norm_rows(const float* x, const float* g, const float* shift, const float* scale, bf16* hb, float* outf, int mode, int gw, int ngw, int lane) {
    const int rpw = T_ / ngw, m0 = gw * rpw, b = m0 / S_;
    float4 gs[4], sh[4];
#pragma unroll
    for (int j = 0; j < 4; ++j) { const int col = 4 * lane + 256 * j; gs[j] = *(const float4*)(g + col);
        if (mode != 2) { const float4 sc = *(const float4*)(scale + (size_t)b * 6144 + col); sh[j] = *(const float4*)(shift + (size_t)b * 6144 + col);
            gs[j].x *= 1.f + sc.x; gs[j].y *= 1.f + sc.y; gs[j].z *= 1.f + sc.z; gs[j].w *= 1.f + sc.w; }
        else sh[j] = make_float4(0.f, 0.f, 0.f, 0.f); }
    float4 nv[4], nw[4];
    { const float4* xr = (const float4*)(x + (size_t)m0 * D_) + lane;
#pragma unroll
      for (int j = 0; j < 4; ++j) { nv[j] = xr[64 * j]; nw[j] = xr[D_ / 4 + 64 * j]; } }
    for (int r = 0; r < rpw; r += 2) {
        const int m = m0 + r;
        float4 v[4], w[4]; float s = 0.f, s2 = 0.f;
#pragma unroll
        for (int j = 0; j < 4; ++j) { v[j] = nv[j]; w[j] = nw[j]; }
        if (r + 2 < rpw) { const float4* xr = (const float4*)(x + (size_t)(m + 2) * D_) + lane;
#pragma unroll
            for (int j = 0; j < 4; ++j) { nv[j] = xr[64 * j]; nw[j] = xr[D_ / 4 + 64 * j]; } }
#pragma unroll
        for (int j = 0; j < 4; ++j) { s += v[j].x * v[j].x + v[j].y * v[j].y + v[j].z * v[j].z + v[j].w * v[j].w; s2 += w[j].x * w[j].x + w[j].y * w[j].y + w[j].z * w[j].z + w[j].w * w[j].w; }
        const float r1 = rsqrtf(wave_sum2(s) * (1.f / D_) + EPS), r2 = rsqrtf(wave_sum2(s2) * (1.f / D_) + EPS);
#pragma unroll
        for (int j = 0; j < 4; ++j) {
            const int col = 4 * lane + 256 * j;
            float4 o, o2;
            o.x = v[j].x * r1 * gs[j].x + sh[j].x; o.y = v[j].y * r1 * gs[j].y + sh[j].y; o.z = v[j].z * r1 * gs[j].z + sh[j].z; o.w = v[j].w * r1 * gs[j].w + sh[j].w;
            o2.x = w[j].x * r2 * gs[j].x + sh[j].x; o2.y = w[j].y * r2 * gs[j].y + sh[j].y; o2.z = w[j].z * r2 * gs[j].z + sh[j].z; o2.w = w[j].w * r2 * gs[j].w + sh[j].w;
            if (mode == 2) { *(float4*)(outf + (size_t)m * D_ + col) = o; *(float4*)(outf + (size_t)(m + 1) * D_ + col) = o2; }
            else { uint2 q; q.x = pk2(o.x, o.y); q.y = pk2(o.z, o.w); *(uint2*)(hb + (size_t)m * D_ + col) = q;
                   uint2 q2; q2.x = pk2(o2.x, o2.y); q2.y = pk2(o2.z, o2.w); *(uint2*)(hb + (size_t)(m + 1) * D_ + col) = q2; }
        }
    }
}
__device__ __forceinline__ void ph_p0(const MPK& p, LAS unsigned char* lds, int tid) {
    const int wave = tid >> 6, lane = tid & 63;
    LAS float* ca = (LAS float*)lds; LAS float* red = ca + 8192;
    unsigned char* ws = p.k->ws; float* mod = (float*)(ws + WS_MOD);
    const float* c = PIN(I_C);
    for (int i = tid; i < 8192; i += NTHR) ca[i] = siluf_(c[i]);
    __syncthreads();
    for (int item = blockIdx.x; item < 96; item += gridDim.x) {
        const int l = item / 48, j = (item % 48) * 128 + 2 * lane;
        const float* w = PIN(I_WADA) + (size_t)l * 1024 * 6144 + j;
        float acc[8][2];
#pragma unroll
        for (int b = 0; b < 8; ++b) { acc[b][0] = 0.f; acc[b][1] = 0.f; }
#pragma unroll 8
        for (int k = wave * 128; k < wave * 128 + 128; ++k) {
            const float2 wv = *(const float2*)(w + (size_t)k * 6144);
#pragma unroll
            for (int b = 0; b < 8; ++b) { const float cv = ca[b * 1024 + k]; acc[b][0] += cv * wv.x; acc[b][1] += cv * wv.y; }
        }
#pragma unroll
        for (int b = 0; b < 8; ++b) { red[(wave * 8 + b) * 128 + 2 * lane] = acc[b][0]; red[(wave * 8 + b) * 128 + 2 * lane + 1] = acc[b][1]; }
        __syncthreads();
        { const int b = wave;
#pragma unroll
          for (int c2 = 0; c2 < 2; ++c2) { float s2 = 0.f;
#pragma unroll
            for (int w8 = 0; w8 < 8; ++w8) s2 += red[(w8 * 8 + b) * 128 + c2 * 64 + lane];
            mod[((size_t)l * 8 + b) * 6144 + (item % 48) * 128 + c2 * 64 + lane] = s2 + PIN(I_BADA)[l * 6144 + (item % 48) * 128 + c2 * 64 + lane]; } }
        __syncthreads();
    }
    const int* pos = (const int*)PIN(I_POS);
    float *cosP = (float*)(ws + WS_COSP), *sinP = (float*)(ws + WS_SINP), *cosM = (float*)(ws + WS_COSM), *sinM = (float*)(ws + WS_SINM);
    for (int i = blockIdx.x * NTHR + tid; i < T_ * 24; i += gridDim.x * NTHR) {
        const int m = i / 24, f = i % 24;
        double inv; if (f < 8) inv = pow(500000.0, -(double)(2 * f) / 16.0); else inv = pow(500000.0, -(double)(2 * (f - 8)) / 32.0);
        const float ang = (float)pos[m] * (float)inv;
        const double a = (double)ang, kq = rint(a * 0.15915494309189535), r = a - kq * 6.283185307179586476925;
        const float cs = (float)cos(r), sn = (float)sin(r);
        if (f < 8) { cosP[m * 8 + f] = cs; sinP[m * 8 + f] = sn; } else { cosM[m * 16 + f - 8] = cs; sinM[m * 16 + f - 8] = sn; }
    }
}
__device__ __forceinline__ void early_transposes(const MPK& p, int l, LAS unsigned char* lds, int tid, int first) {
    const int wave = tid >> 6, lane = tid & 63;
    if ((int)blockIdx.x < first) return;
    const int gw = ((int)blockIdx.x - first) * NWAVES + wave, ngw = ((int)gridDim.x - first) * NWAVES;
    unsigned char* ws = p.k->ws;
    LAS float* scr = (LAS float*)(lds + wave * 8704);
    constexpr int I0 = 16 * 80, I4 = 4 * 24, I5 = 2 * 24, I6 = 32 * 2, I7 = 32 * 2, I8 = 8, I9 = 8;
    constexpr int NIT = I0 + I4 + I5 + I6 + I7 + I8 + I9;
    for (int it = gw; it < NIT; it += ngw) {
        int r = it;
        if (r < I0) { transpose_item(PIN(I_WIN) + (size_t)l * D_ * DIN, D_, DIN, MapIn{}, nullptr, (bf16*)(ws + WT_IN), scr, r, 80, lane); continue; } r -= I0;
        if (r < I4) { transpose_item(PIN(I_WUQ) + (size_t)l * 256 * 576, 256, 576, MapId{576}, PIN(I_GQL) + l * 256, (bf16*)(ws + WT_UQ), scr, r, 24, lane); continue; } r -= I4;
        if (r < I5) { transpose_item(PIN(I_WUKV) + (size_t)l * 128 * 768, 128, 768, MapId{768}, PIN(I_GKVL) + l * 128, (bf16*)(ws + WT_UKV), scr, r, 24, lane); continue; } r -= I5;
        if (r < I6) { transpose_item(PIN(I_WCK) + (size_t)l * 2048 * 64, 2048, 64, MapId{64}, nullptr, (bf16*)(ws + WT_CK), scr, r, 2, lane); continue; } r -= I6;
        if (r < I7) { transpose_item(PIN(I_WCV) + (size_t)l * 2048 * 64, 2048, 64, MapId{64}, nullptr, (bf16*)(ws + WT_CV), scr, r, 2, lane); continue; } r -= I7;
        if (r < I8) { const int h = r >> 1; transpose_item(PIN(I_WQM) + (size_t)l * 16384 + h * 4096, 64, 64, MapId{64}, nullptr, (bf16*)(ws + WT_QM) + h * 4096, scr, r & 1, 2, lane); continue; } r -= I8;
        { const int h = r >> 1; transpose_item(PIN(I_WKM) + (size_t)l * 16384 + h * 4096, 64, 64, MapId{64}, nullptr, (bf16*)(ws + WT_KM) + h * 4096, scr, r & 1, 2, lane); }
    }
}
__device__ __forceinline__ void ph_prep(const MPK& p, int l, LAS unsigned char* lds, int tid) {
    const int wave = tid >> 6, lane = tid & 63;
    const int gw = blockIdx.x * NWAVES + wave, ngw = gridDim.x * NWAVES;
    unsigned char* ws = p.k->ws;
    LAS float* scr = (LAS float*)(lds + wave * 8704);
    for (int i = blockIdx.x * NTHR + tid; i < 2 * T_; i += gridDim.x * NTHR) ((float*)(ws + WS_SSQL))[i] = 0.f;
    if (l == 0) early_transposes(p, l, lds, tid, 0);
    const float* xin = (l == 0) ? PIN(I_X) : p.k->out;
    const float* modl = (const float*)(ws + WS_MOD) + (size_t)l * 8 * 6144;
    norm_rows(xin, PIN(I_GN1) + l * D_, modl + 0, modl + 1024, (bf16*)(ws + WS_HB), nullptr, 0, gw, ngw, lane);
}
__device__ __forceinline__ void late_transposes(const MPK& p, int l, LAS unsigned char* lds, int tid, int first) {
    const int wave = tid >> 6, lane = tid & 63;
    if ((int)blockIdx.x < first) return;
    const int gw = ((int)blockIdx.x - first) * NWAVES + wave, ngw = ((int)gridDim.x - first) * NWAVES;
    unsigned char* ws = p.k->ws;
    LAS float* scr = (LAS float*)(lds + wave * 8704);
    constexpr int I1 = 16 * 32, I2 = 16 * 176, I3 = 44 * 32;
    for (int it = gw; it < I1 + I2 + I3; it += ngw) {
        int r = it;
        if (r < I1) { transpose_item(PIN(I_WOUT) + (size_t)l * D_ * D_, D_, D_, MapId{D_}, nullptr, (bf16*)(ws + WT_OUT), scr, r, 32, lane); continue; } r -= I1;
        if (r < I2) { transpose_item(PIN(I_WGU) + (size_t)l * D_ * 2 * FF, D_, 2 * FF, MapGU{}, nullptr, (bf16*)(ws + WT_GU), scr, r, 176, lane); continue; } r -= I2;
        transpose_item(PIN(I_WDOWN) + (size_t)l * FF * D_, FF, D_, MapId{D_}, nullptr, (bf16*)(ws + WT_DOWN), scr, r, 32, lane);
    }
}
__device__ __forceinline__ void ph_mixnorm(const MPK& p, int l, int tid) {
    const int gw = blockIdx.x * NWAVES + (tid >> 6), ngw = gridDim.x * NWAVES, lane = tid & 63;
    unsigned char* ws = p.k->ws;
    bf16* mix = (bf16*)(ws + WS_HB); const float* ga = PIN(I_GOA) + l * 384; const float* gb = PIN(I_GOB) + l * 384;
    const bf16 *oc = (const bf16*)(ws + WS_OCMP), *os = (const bf16*)(ws + WS_OSLC), *ow = (const bf16*)(ws + WS_OWIN); const float* gm = (const float*)(ws + WS_GM);
#define UNPK8(dst, src) dst[0] = __uint_as_float(src.x << 16); dst[1] = __uint_as_float(src.x & 0xffff0000u); dst[2] = __uint_as_float(src.y << 16); dst[3] = __uint_as_float(src.y & 0xffff0000u); \
    dst[4] = __uint_as_float(src.z << 16); dst[5] = __uint_as_float(src.z & 0xffff0000u); dst[6] = __uint_as_float(src.w << 16); dst[7] = __uint_as_float(src.w & 0xffff0000u);
    const int rpw = T_ / ngw;
    const float* ggp = (lane < 48) ? ga + lane * 8 : gb + (lane - 48) * 8; const float4 gA0 = *(const float4*)ggp, gA1 = *(const float4*)(ggp + 4);
    const float* ggq = gb + (16 + (lane & 31)) * 8; const float4 gB0 = *(const float4*)ggq, gB1 = *(const float4*)(ggq + 4);
    v4u ra4, rb4, rc4, ry4; float rg0, rg1, rg2;
#define MIX_LOAD(m_) do { const bf16* r_ = mix + (size_t)(m_) * D_; \
        if (lane < 48) { const size_t o_ = (size_t)(m_) * 384 + lane * 8; const float* g3_ = gm + (size_t)(m_) * 32 + 3 * (lane >> 3); rg0 = g3_[0]; rg1 = g3_[1]; rg2 = g3_[2]; \
            ra4 = *(const v4u*)(oc + o_); rb4 = *(const v4u*)(os + o_); rc4 = *(const v4u*)(ow + o_); } \
        else { ra4 = *(const v4u*)(r_ + 384 + (lane - 48) * 8); rb4 = ra4; rc4 = ra4; rg0 = 0.f; rg1 = 0.f; rg2 = 0.f; } \
        if (lane < 32) ry4 = *(const v4u*)(r_ + 384 + (16 + lane) * 8); else ry4 = ra4; } while (0)
    const int mend = gw * rpw + rpw;
    MIX_LOAD(gw * rpw);
    for (int m = gw * rpw; m < mend; ++m) {
        bf16* r = mix + (size_t)m * D_;
        const v4u ca4 = ra4, cb4 = rb4, cc4 = rc4, cy4 = ry4; const float g0 = rg0, g1 = rg1, g2 = rg2;
        if (m + 1 < mend) MIX_LOAD(m + 1);
        float v0[8], v1[8]; float sa = 0.f, sb = 0.f;
        if (lane < 48) {
            float c8[8], s8[8], w8[8]; UNPK8(c8, ca4) UNPK8(s8, cb4) UNPK8(w8, cc4)
#pragma unroll
            for (int i = 0; i < 8; ++i) { v0[i] = g0 * c8[i] + g1 * s8[i] + g2 * w8[i]; sa += v0[i] * v0[i]; }
        } else {
            UNPK8(v0, ca4)
#pragma unroll
            for (int i = 0; i < 8; ++i) sb += v0[i] * v0[i];
        }
        if (lane < 32) { UNPK8(v1, cy4)
#pragma unroll
            for (int i = 0; i < 8; ++i) sb += v1[i] * v1[i]; }
        const float ra = rsqrtf(wave_sum2(sa) * (1.f / 384.f) + EPS), rb = rsqrtf(wave_sum2(sb) * (1.f / 384.f) + EPS);
        {
            const int col = (lane < 48) ? lane * 8 : 384 + (lane - 48) * 8; const float rr = (lane < 48) ? ra : rb;
            const float4 q0 = gA0, q1 = gA1;
            v4u w; w.x = pk2(v0[0] * rr * q0.x, v0[1] * rr * q0.y); w.y = pk2(v0[2] * rr * q0.z, v0[3] * rr * q0.w); w.z = pk2(v0[4] * rr * q1.x, v0[5] * rr * q1.y); w.w = pk2(v0[6] * rr * q1.z, v0[7] * rr * q1.w);
            *(v4u*)(r + col) = w;
        }
        if (lane < 32) { const float4 q0 = gB0, q1 = gB1;
            v4u w; w.x = pk2(v1[0] * rb * q0.x, v1[1] * rb * q0.y); w.y = pk2(v1[2] * rb * q0.z, v1[3] * rb * q0.w); w.z = pk2(v1[4] * rb * q1.x, v1[5] * rb * q1.y); w.w = pk2(v1[6] * rb * q1.z, v1[7] * rb * q1.w);
            *(v4u*)(r + 384 + (16 + lane) * 8) = w; }
    }
#undef MIX_LOAD
#undef UNPK8
}


typedef short bf16x8 __attribute__((ext_vector_type(8)));
typedef short s16x4 __attribute__((ext_vector_type(4)));
typedef float f32x16 __attribute__((ext_vector_type(16)));
typedef unsigned u32x2v __attribute__((ext_vector_type(2)));
constexpr int AT_BUF = 20480, AT_K32 = 8192, AT_V = 12288;
__device__ __forceinline__ unsigned cvtpk(float lo, float hi) { unsigned r; asm volatile("v_cvt_pk_bf16_f32 %0, %1, %2" : "=v"(r) : "v"(lo), "v"(hi)); return r; }
__device__ __forceinline__ float max3f(float a, float b, float c) { float r; asm("v_max3_f32 %0, %1, %2, %3" : "=v"(r) : "v"(a), "v"(b), "v"(c)); return r; }
__device__ __forceinline__ int crow(int r, int hi) { return (r & 3) + 8 * (r >> 2) + 4 * hi; }
__device__ __forceinline__ s16x4 vtr(LAS const unsigned char* p) { return __builtin_bit_cast(s16x4, __builtin_amdgcn_ds_read_tr16_b64_v4i16((LAS s16x4*)p)); }
enum { AM_CAUSAL = 0, AM_WINDOW = 1, AM_SLC = 2 };
struct AttnState { float m, l; f32x16 o[2]; f32x16 negm; bool started; long long twait; };
template <int NC> struct TileRegs { v4u k; v4u k2; v4u v; };
template <int NC> __device__ __forceinline__ void at_load(TileRegs<NC>& r, const bf16* Kg, int ldk, const bf16* Vg, int ldv, const bf16* K2g, int ldk2, int tile, int tid) {
    const int key = tid >> 3, c = tid & 7;
    r.k = *(const v4u*)(Kg + (size_t)(tile * 64 + key) * ldk + 8 * c);
    r.v = *(const v4u*)(Vg + (size_t)(tile * 64 + key) * ldv + 8 * c);
    if (NC == 6) { if (tid < 256) r.k2 = *(const v4u*)(K2g + (size_t)(tile * 64 + (tid >> 2)) * ldk2 + 8 * (tid & 3)); }
}
template <int NC> __device__ __forceinline__ void at_store(const TileRegs<NC>& r, LAS unsigned char* buf, int tid) {
    const int key = tid >> 3, c = tid & 7;
    *(LAS v4u*)(buf + key * 128 + 16 * (c ^ ((key >> 1) & 7))) = r.k;
    *(LAS v4u*)(buf + AT_V + (c >> 2) * 4096 + key * 64 + (c & 3) * 16) = r.v;
    if (NC == 6) { if (tid < 256) { const int k2 = tid >> 2, c2 = tid & 3; *(LAS v4u*)(buf + AT_K32 + k2 * 64 + 16 * (c2 ^ ((k2 >> 2) & 3))) = r.k2; } }
}
template <int NC> __device__ __forceinline__ void qk_tile(f32x16& p0, f32x16& p1, LAS const unsigned char* buf, const bf16x8 (&qf)[NC], const f32x16& negm, int lane) {
    const int r32 = lane & 31, hi = lane >> 5;
    p0 = negm; p1 = negm;
#pragma unroll
    for (int cc = 0; cc < NC; ++cc) {
        bf16x8 k0, k1;
        if (cc < 4) { const int k0r = r32, k1r = 32 + r32;
            k0 = *(LAS const bf16x8*)(buf + k0r * 128 + 16 * ((2 * cc + hi) ^ ((k0r >> 1) & 7)));
            k1 = *(LAS const bf16x8*)(buf + k1r * 128 + 16 * ((2 * cc + hi) ^ ((k1r >> 1) & 7))); }
        else { const int k0r = r32, k1r = 32 + r32, c2 = 2 * (cc - 4) + hi;
            k0 = *(LAS const bf16x8*)(buf + AT_K32 + k0r * 64 + 16 * (c2 ^ ((k0r >> 2) & 3)));
            k1 = *(LAS const bf16x8*)(buf + AT_K32 + k1r * 64 + 16 * (c2 ^ ((k1r >> 2) & 3))); }
        p0 = __builtin_amdgcn_mfma_f32_32x32x16_bf16(k0, qf[cc], p0, 0, 0, 0);
        p1 = __builtin_amdgcn_mfma_f32_32x32x16_bf16(k1, qf[cc], p1, 0, 0, 0);
    }
}
template <int MODE> __device__ __forceinline__ void mask_tile(f32x16& p0, f32x16& p1, int kpos0, int qpos, bool need_mask, bool sel_ok, int lane) {
    const int hi = lane >> 5;
    if (need_mask) {
        const int qw0m = __builtin_amdgcn_readfirstlane(qpos) & ~31;
        const bool diag = (kpos0 + 63 > qw0m), old = (MODE == AM_WINDOW) && (kpos0 < qw0m + 31 - 511);
        if (diag || old) {
            const float selterm = (MODE == AM_SLC && !sel_ok) ? -INFINITY : INFINITY;
            const int dbase = qpos - kpos0 - 4 * hi;
#pragma unroll
            for (int r = 0; r < 16; ++r) {
                const int d0 = dbase - ((r & 3) + 8 * (r >> 2)), d1 = d0 - 32;
                float l0 = ((float)d0 + 0.5f) * INFINITY, l1 = ((float)d1 + 0.5f) * INFINITY;
                if (MODE == AM_WINDOW) { l0 = fminf(l0, ((float)(511 - d0) + 0.5f) * INFINITY); l1 = fminf(l1, ((float)(511 - d1) + 0.5f) * INFINITY); }
                if (MODE == AM_SLC) { l0 = fminf(l0, selterm); l1 = fminf(l1, selterm); }
                p0[r] = fminf(p0[r], l0); p1[r] = fminf(p1[r], l1);
            }
        } else if (MODE == AM_SLC) {
            const float selterm = sel_ok ? INFINITY : -INFINITY;
#pragma unroll
            for (int r = 0; r < 16; ++r) { p0[r] = fminf(p0[r], selterm); p1[r] = fminf(p1[r], selterm); }
        }
    }
}
template <int MODE> __device__ __forceinline__ void softmax_tile(AttnState& st, f32x16& p0, f32x16& p1, bf16x8 (&pf)[4], int kpos0, int qpos, bool need_mask, bool sel_ok, int lane) {
    mask_tile<MODE>(p0, p1, kpos0, qpos, need_mask, sel_ok, lane);
    float mx = max3f(p0[0], p1[0], p0[1]), mx2 = max3f(p1[1], p0[2], p1[2]);
#pragma unroll
    for (int r = 3; r < 15; r += 2) { mx = max3f(mx, p0[r], p1[r]); mx2 = max3f(mx2, p0[r + 1], p1[r + 1]); }
    mx = max3f(mx, p0[15], p1[15]); mx = max3f(mx, mx2, mx2);
    mx = red32_max(mx);
    if (!st.started || __any(mx > 0.f)) {
        float dl = st.started ? fmaxf(mx, 0.f) : mx;
        dl = (dl > -1e30f) ? dl : 0.f;
        st.started = true;
        const float alpha = __builtin_amdgcn_exp2f(-dl);
        st.m += dl; st.l *= alpha;
#pragma unroll
        for (int r = 0; r < 16; ++r) { st.o[0][r] *= alpha; st.o[1][r] *= alpha; p0[r] -= dl; p1[r] -= dl; st.negm[r] = -st.m; }
    }
    float sum = 0.f;
#pragma unroll
    for (int r = 0; r < 16; ++r) { p0[r] = __builtin_amdgcn_exp2f(p0[r]); p1[r] = __builtin_amdgcn_exp2f(p1[r]); sum += p0[r] + p1[r]; }
    st.l += sum;
#pragma unroll
    for (int s2 = 0; s2 < 2; ++s2) {
        v4u a, b;
        a.x = cvtpk(p0[8 * s2 + 0], p0[8 * s2 + 1]); a.y = cvtpk(p0[8 * s2 + 2], p0[8 * s2 + 3]); a.z = cvtpk(p0[8 * s2 + 4], p0[8 * s2 + 5]); a.w = cvtpk(p0[8 * s2 + 6], p0[8 * s2 + 7]);
        b.x = cvtpk(p1[8 * s2 + 0], p1[8 * s2 + 1]); b.y = cvtpk(p1[8 * s2 + 2], p1[8 * s2 + 3]); b.z = cvtpk(p1[8 * s2 + 4], p1[8 * s2 + 5]); b.w = cvtpk(p1[8 * s2 + 6], p1[8 * s2 + 7]);
        pf[s2] = __builtin_bit_cast(bf16x8, a); pf[2 + s2] = __builtin_bit_cast(bf16x8, b);
    }
}
struct TileFlags { bool skip, need_mask, sel_ok; };
__device__ __forceinline__ void pack_p(bf16x8 (&pf)[4], const f32x16& p0, const f32x16& p1) {
#pragma unroll
    for (int s2 = 0; s2 < 2; ++s2) {
        v4u a, b;
        a.x = cvtpk(p0[8 * s2 + 0], p0[8 * s2 + 1]); a.y = cvtpk(p0[8 * s2 + 2], p0[8 * s2 + 3]); a.z = cvtpk(p0[8 * s2 + 4], p0[8 * s2 + 5]); a.w = cvtpk(p0[8 * s2 + 6], p0[8 * s2 + 7]);
        b.x = cvtpk(p1[8 * s2 + 0], p1[8 * s2 + 1]); b.y = cvtpk(p1[8 * s2 + 2], p1[8 * s2 + 3]); b.z = cvtpk(p1[8 * s2 + 4], p1[8 * s2 + 5]); b.w = cvtpk(p1[8 * s2 + 6], p1[8 * s2 + 7]);
        pf[s2] = __builtin_bit_cast(bf16x8, a); pf[2 + s2] = __builtin_bit_cast(bf16x8, b);
    }
}
template <int MODE> __device__ __forceinline__ void softmax_pair(AttnState& st, f32x16& a0, f32x16& a1, f32x16& b0, f32x16& b1, int kpos0, int qpos, const TileFlags& fa, const TileFlags& fb, int lane) {
    mask_tile<MODE>(a0, a1, kpos0, qpos, fa.need_mask, fa.sel_ok, lane);
    mask_tile<MODE>(b0, b1, kpos0 + 64, qpos, fb.need_mask, fb.sel_ok, lane);
    float mx = max3f(a0[0], a1[0], b0[0]), mx2 = max3f(b1[0], a0[1], a1[1]);
#pragma unroll
    for (int r = 1; r < 16; ++r) { mx = max3f(mx, b0[r], b1[r]); if (r > 1) mx2 = max3f(mx2, a0[r], a1[r]); }
    mx = max3f(mx, mx2, mx2);
    mx = red32_max(mx);
    if (!st.started || __any(mx > 0.f)) {
        float dl = st.started ? fmaxf(mx, 0.f) : mx;
        dl = (dl > -1e30f) ? dl : 0.f;
        st.started = true;
        const float alpha = __builtin_amdgcn_exp2f(-dl);
        st.m += dl; st.l *= alpha;
#pragma unroll
        for (int r = 0; r < 16; ++r) { st.o[0][r] *= alpha; st.o[1][r] *= alpha; a0[r] -= dl; a1[r] -= dl; b0[r] -= dl; b1[r] -= dl; st.negm[r] = -st.m; }
    }
    float sum = 0.f;
#pragma unroll
    for (int r = 0; r < 16; ++r) { a0[r] = __builtin_amdgcn_exp2f(a0[r]); a1[r] = __builtin_amdgcn_exp2f(a1[r]); b0[r] = __builtin_amdgcn_exp2f(b0[r]); b1[r] = __builtin_amdgcn_exp2f(b1[r]); sum += (a0[r] + a1[r]) + (b0[r] + b1[r]); }
    st.l += sum;
}
__device__ __forceinline__ void pv_tile(AttnState& st, LAS const unsigned char* buf, const bf16x8 (&pf)[4], int lane) {
    const int hi = lane >> 5;
    const unsigned vb = (unsigned)(uintptr_t)(buf + AT_V + (4 * hi + ((lane & 15) >> 2)) * 64 + ((lane >> 4) & 1) * 32 + (lane & 3) * 8);
#pragma unroll
    for (int dh = 0; dh < 2; ++dh) {
        s16x4 lo[4], hh[4];
#pragma unroll
        for (int s4 = 0; s4 < 4; ++s4) {
            asm volatile("ds_read_b64_tr_b16 %0, %1 offset:%c2" : "=&v"(lo[s4]) : "v"(vb), "i"(dh * 4096 + s4 * 1024) : "memory");
            asm volatile("ds_read_b64_tr_b16 %0, %1 offset:%c2" : "=&v"(hh[s4]) : "v"(vb), "i"(dh * 4096 + s4 * 1024 + 512) : "memory");
        }
        asm volatile("s_waitcnt lgkmcnt(0)" : "+v"(lo[0]), "+v"(lo[1]), "+v"(lo[2]), "+v"(lo[3]), "+v"(hh[0]), "+v"(hh[1]), "+v"(hh[2]), "+v"(hh[3]) :: "memory");
#pragma unroll
        for (int s4 = 0; s4 < 4; ++s4) {
            const bf16x8 vf = {lo[s4][0], lo[s4][1], lo[s4][2], lo[s4][3], hh[s4][0], hh[s4][1], hh[s4][2], hh[s4][3]};
            st.o[dh] = __builtin_amdgcn_mfma_f32_32x32x16_bf16(vf, pf[s4], st.o[dh], 0, 0, 0);
        }
    }
}
template <int MODE> __device__ __forceinline__ TileFlags tile_flags(int t, int qw0, unsigned selbits) {
    const int k0 = t * 64; TileFlags f;
    f.skip = k0 > qw0 + 31; f.need_mask = (k0 + 63 > qw0); f.sel_ok = true;
    if (MODE == AM_WINDOW) { f.skip = f.skip || (k0 + 63 < qw0 - 511); f.need_mask = f.need_mask || (k0 < qw0 + 31 - 511); }
    if (MODE == AM_SLC) { f.sel_ok = (selbits >> t) & 1u; const unsigned long long bal = __ballot(f.sel_ok); f.skip = f.skip || (bal == 0ull); f.need_mask = f.need_mask || (bal != ~0ull); }
    return f;
}
struct DmaOff { unsigned k, v, k2; };
template <int NC> __device__ __forceinline__ DmaOff at_dma_off(int ldk, int ldv, int ldk2, int wave, int lane) {
    const int L = wave * 64 + lane; DmaOff o;
    { const int key = L >> 3, c = (L & 7) ^ ((key >> 1) & 7); o.k = (unsigned)(key * ldk + 8 * c) * 2u; }
    { const int key = (L >> 2) & 63, c = (L >> 8) * 4 + (L & 3); o.v = (unsigned)(key * ldv + 8 * c) * 2u; }
    { const int key = (L >> 2) & 63, c2 = (L & 3) ^ ((key >> 2) & 3); o.k2 = (unsigned)(key * ldk2 + 8 * c2) * 2u; }
    return o;
}
template <int NC> __device__ __forceinline__ void at_dma(const DmaOff& o, const bf16* Kg, int ldk, const bf16* Vg, int ldv, const bf16* K2g, int ldk2, int tile, LAS unsigned char* slot, int wave) {
    __builtin_amdgcn_global_load_lds((const unsigned*)((const char*)(Kg + (size_t)tile * 64 * ldk) + o.k), (LAS unsigned*)(slot + wave * 1024), 16, 0, 0);
    __builtin_amdgcn_global_load_lds((const unsigned*)((const char*)(Vg + (size_t)tile * 64 * ldv) + o.v), (LAS unsigned*)(slot + AT_V + wave * 1024), 16, 0, 0);
    if (NC == 6) { if (wave < 4) __builtin_amdgcn_global_load_lds((const unsigned*)((const char*)(K2g + (size_t)tile * 64 * ldk2) + o.k2), (LAS unsigned*)(slot + AT_K32 + wave * 1024), 16, 0, 0); }
}
__device__ __forceinline__ void at_wait_bar(int keep) {
    if (keep == 0) asm volatile("s_waitcnt vmcnt(0) lgkmcnt(0)" ::: "memory");
    else if (keep == 4) asm volatile("s_waitcnt vmcnt(4) lgkmcnt(0)" ::: "memory");
    else asm volatile("s_waitcnt vmcnt(6) lgkmcnt(0)" ::: "memory");
    __builtin_amdgcn_s_barrier();
    asm volatile("" ::: "memory");
}
template <int NC, int MODE> __device__ __forceinline__ void at_stream(AttnState& st, LAS unsigned char* lds, const bf16* Kg, int ldk, const bf16* Vg, int ldv, const bf16* K2g, int ldk2, int t0, int t1,
                                                                       const bf16x8 (&qf)[NC], int qpos, int qw0, unsigned selbits, int tid) {
    const int lane = tid & 63, wave = __builtin_amdgcn_readfirstlane(tid >> 6), np = (t1 - t0) >> 1;
    const int nper2 = (NC == 6 && wave < 4) ? 6 : 4;
    const DmaOff dof = at_dma_off<NC>(ldk, ldv, ldk2, wave, lane);
    at_dma<NC>(dof, Kg, ldk, Vg, ldv, K2g, ldk2, t0, lds, wave); at_dma<NC>(dof, Kg, ldk, Vg, ldv, K2g, ldk2, t0 + 1, lds + AT_BUF, wave);
    if (np > 1) { at_dma<NC>(dof, Kg, ldk, Vg, ldv, K2g, ldk2, t0 + 2, lds + 2 * AT_BUF, wave); at_dma<NC>(dof, Kg, ldk, Vg, ldv, K2g, ldk2, t0 + 3, lds + 3 * AT_BUF, wave); }
    at_wait_bar(np > 1 ? nper2 : 0);
    int s0 = 0, s1 = 2 * AT_BUF, s2 = 4 * AT_BUF;
    for (int j = 0; j < np; ++j) {
        const int t = t0 + 2 * j; const bool has_2 = (j + 2 < np);
        if (has_2) { at_dma<NC>(dof, Kg, ldk, Vg, ldv, K2g, ldk2, t + 4, lds + s2, wave); at_dma<NC>(dof, Kg, ldk, Vg, ldv, K2g, ldk2, t + 5, lds + s2 + AT_BUF, wave); }
        const TileFlags fa = tile_flags<MODE>(t, qw0, selbits), fb = tile_flags<MODE>(t + 1, qw0, selbits);
        if (!fa.skip && !fb.skip) {
            f32x16 a0, a1, b0, b1; bf16x8 pf[4];
            qk_tile<NC>(a0, a1, lds + s0, qf, st.negm, lane);
            qk_tile<NC>(b0, b1, lds + s0 + AT_BUF, qf, st.negm, lane);
            softmax_pair<MODE>(st, a0, a1, b0, b1, t * 64, qpos, fa, fb, lane);
            pack_p(pf, a0, a1); pv_tile(st, lds + s0, pf, lane);
            pack_p(pf, b0, b1); pv_tile(st, lds + s0 + AT_BUF, pf, lane);
        } else {
            if (!fa.skip) { f32x16 p0, p1; bf16x8 pf[4]; qk_tile<NC>(p0, p1, lds + s0, qf, st.negm, lane); softmax_tile<MODE>(st, p0, p1, pf, t * 64, qpos, fa.need_mask, fa.sel_ok, lane); pv_tile(st, lds + s0, pf, lane); }
            if (!fb.skip) { f32x16 p0, p1; bf16x8 pf[4]; qk_tile<NC>(p0, p1, lds + s0 + AT_BUF, qf, st.negm, lane); softmax_tile<MODE>(st, p0, p1, pf, (t + 1) * 64, qpos, fb.need_mask, fb.sel_ok, lane); pv_tile(st, lds + s0 + AT_BUF, pf, lane); }
        }
        at_wait_bar(has_2 ? nper2 : 0);
        const int tmp = s0; s0 = s1; s1 = s2; s2 = tmp;
    }
}
__device__ __forceinline__ int next_item_q(unsigned* ctrs, LAS unsigned char* lds, int wave_u, int count, int q0, int& kstart) {
    const int tid = wave_u * 64 + fresh_lane();
    LAS int* slot = (LAS int*)(lds + RING_BYTES + 64);
    if (tid == 0) { const unsigned v = atomicAdd(ctrs, 1u); slot[0] = (v < 8u * (unsigned)count) ? (int)(((v & 7u) << 16) | (v >> 3)) : -1; }
    __syncthreads();
    const int v = slot[0];
    __syncthreads();
    (void)q0; (void)kstart;
    return v;
}
__device__ __forceinline__ void mla_unit(unsigned char* ws, LAS unsigned char* lds, int b, int h, int qt, int wave_u) {
    const int tid = wave_u * 64 + fresh_lane();
    const int lane = tid & 63, wave = tid >> 6, r32 = lane & 31, hi = lane >> 5;
    const int qw0 = qt * 256 + wave * 32, qpos = qw0 + r32; const size_t row = (size_t)b * S_ + qpos;
    const long long tq0 = (PROBE_SEL != 0) ? (long long)__builtin_amdgcn_s_memtime() : 0ll;
    bf16x8 qf[6];
    {
        const bf16* qp = (const bf16*)(ws + WS_OSLC) + row * 768 + h * 96 + 8 * hi;
        v4u raw[6];
#pragma unroll
        for (int cc = 0; cc < 6; ++cc) raw[cc] = *(const v4u*)(qp + 16 * cc);
        float msc = MSCALE; asm volatile("" : "+v"(msc));
        const float rs = rsqrtf(((const float*)(ws + WS_SSQL))[row] * (1.f / 256.f) + EPS) * msc;
        const float* cm_ = (const float*)(ws + WS_COSM) + row * 16 + 8 * hi; const float* sm_ = (const float*)(ws + WS_SINM) + row * 16 + 8 * hi;
#define UNPKQ(dst, src) dst[0] = __uint_as_float(src.x << 16); dst[1] = __uint_as_float(src.x & 0xffff0000u); dst[2] = __uint_as_float(src.y << 16); dst[3] = __uint_as_float(src.y & 0xffff0000u); \
        dst[4] = __uint_as_float(src.z << 16); dst[5] = __uint_as_float(src.z & 0xffff0000u); dst[6] = __uint_as_float(src.w << 16); dst[7] = __uint_as_float(src.w & 0xffff0000u);
#pragma unroll
        for (int cc = 0; cc < 4; ++cc) { float f[8]; UNPKQ(f, raw[cc])
            v4u w; w.x = cvtpk(f[0] * rs, f[1] * rs); w.y = cvtpk(f[2] * rs, f[3] * rs); w.z = cvtpk(f[4] * rs, f[5] * rs); w.w = cvtpk(f[6] * rs, f[7] * rs); qf[cc] = __builtin_bit_cast(bf16x8, w); }
        { float x1[8], x2[8], o1[8], o2[8]; UNPKQ(x1, raw[4]) UNPKQ(x2, raw[5])
#pragma unroll
          for (int j = 0; j < 8; ++j) { const float cs = cm_[j] * rs, sn = sm_[j] * rs; o1[j] = x1[j] * cs - x2[j] * sn; o2[j] = x1[j] * sn + x2[j] * cs; }
          v4u w; w.x = cvtpk(o1[0], o1[1]); w.y = cvtpk(o1[2], o1[3]); w.z = cvtpk(o1[4], o1[5]); w.w = cvtpk(o1[6], o1[7]); qf[4] = __builtin_bit_cast(bf16x8, w);
          w.x = cvtpk(o2[0], o2[1]); w.y = cvtpk(o2[2], o2[3]); w.z = cvtpk(o2[4], o2[5]); w.w = cvtpk(o2[6], o2[7]); qf[5] = __builtin_bit_cast(bf16x8, w); }
#undef UNPKQ
    }
    const long long tq1 = (PROBE_SEL != 0) ? (long long)__builtin_amdgcn_s_memtime() : 0ll;
    AttnState st; st.m = 0.f; st.l = 0.f; st.o[0] = f32x16{}; st.o[1] = f32x16{}; st.negm = f32x16{}; st.started = false; st.twait = 0;
    const bf16* kvb = (const bf16*)(ws + WS_KVM) + (size_t)b * S_ * 768 + h * 128;
    at_stream<6, AM_CAUSAL>(st, lds, kvb, 768, kvb + 64, 768, (const bf16*)(ws + WS_KR) + (size_t)b * S_ * 32, 32, 0, 4 * qt + 4, qf, qpos, qw0, 0u, tid);
    if (PROBE_SEL >= 1 && PROBE_SEL <= 3 && b == 0 && h == 0 && qt == 7 && tid == 0) { const long long tq2 = (long long)__builtin_amdgcn_s_memtime();
        ((float*)(ws + WS_CTL))[100] = (PROBE_SEL == 1) ? (float)(tq2 - tq1) : (PROBE_SEL == 2) ? (float)st.twait : (float)(tq1 - tq0); }
    const float lt = red32_sum(st.l), il = 1.f / lt;
    bf16* op = (bf16*)(ws + WS_HB) + row * D_ + 384 + h * 64 + 4 * hi;
#pragma unroll
    for (int dh = 0; dh < 2; ++dh)
#pragma unroll
        for (int g4 = 0; g4 < 4; ++g4) { u32x2v w; w.x = cvtpk(st.o[dh][4 * g4] * il, st.o[dh][4 * g4 + 1] * il); w.y = cvtpk(st.o[dh][4 * g4 + 2] * il, st.o[dh][4 * g4 + 3] * il);
            *(u32x2v*)(op + dh * 32 + 8 * g4) = w; }
}
template <int MODE> __device__ __forceinline__ void nsa_branch_unit(unsigned char* ws, LAS unsigned char* lds, int b, int h, int qt, int wave_u) {
    const int tid = wave_u * 64 + fresh_lane();
    const int lane = tid & 63, wave = tid >> 6, r32 = lane & 31, hi = lane >> 5, g = h / 3;
    const int qw0 = qt * 256 + wave * 32, qpos = qw0 + r32; const size_t row = (size_t)b * S_ + qpos;
    const bf16* nsa = (const bf16*)(ws + WS_NSA);
    const bf16* qp = nsa + row * 1152 + h * 64 + 8 * hi;
    bf16x8 qf[4];
#pragma unroll
    for (int cc = 0; cc < 4; ++cc) qf[cc] = *(const bf16x8*)(qp + 16 * cc);
    unsigned selbits = 0u; if (MODE == AM_SLC) selbits = ((const unsigned*)(ws + WS_SEL))[(size_t)(b * 2 + g) * S_ + qpos];
    const bf16* kb = nsa + (size_t)b * S_ * 1152 + g * 64 + (MODE == AM_SLC ? 640 : 896);
    AttnState st; st.m = 0.f; st.l = 0.f; st.o[0] = f32x16{}; st.o[1] = f32x16{}; st.negm = f32x16{}; st.started = false; st.twait = 0;
    const long long tn0 = (PROBE_SEL != 0) ? (long long)__builtin_amdgcn_s_memtime() : 0ll;
    const int t0 = (MODE == AM_SLC) ? 0 : ((4 * qt - 8 > 0) ? 4 * qt - 8 : 0);
    at_stream<4, MODE>(st, lds, kb, 1152, kb + 128, 1152, nullptr, 0, t0, 4 * qt + 4, qf, qpos, qw0, selbits, tid);
    if (PROBE_SEL >= 4 && PROBE_SEL <= 5 && MODE == AM_SLC && b == 0 && h == 0 && qt == 7 && tid == 0) { const long long tn1 = (long long)__builtin_amdgcn_s_memtime();
        ((float*)(ws + WS_CTL))[100] = (PROBE_SEL == 4) ? (float)(tn1 - tn0) : (float)st.twait; }
    const float lt = red32_sum(st.l), il = 1.f / lt;
    bf16* op = (bf16*)(ws + (MODE == AM_SLC ? WS_OSLC : WS_OWIN)) + row * 384 + h * 64 + 4 * hi;
#pragma unroll
    for (int dh = 0; dh < 2; ++dh)
#pragma unroll
        for (int g4 = 0; g4 < 4; ++g4) { u32x2v w; w.x = cvtpk(st.o[dh][4 * g4] * il, st.o[dh][4 * g4 + 1] * il); w.y = cvtpk(st.o[dh][4 * g4 + 2] * il, st.o[dh][4 * g4 + 3] * il);
            *(u32x2v*)(op + dh * 32 + 8 * g4) = w; }
}
__device__ __forceinline__ void cmp_unit(unsigned char* ws, LAS unsigned char* lds, int b, int g, int qt, int wave_u) {
    const int tid = wave_u * 64 + fresh_lane();
    const int lane = tid & 63, wave = tid >> 6, r32 = lane & 31, hi = lane >> 5;
    const int qpos = qt * 256 + wave * 32 + r32; const size_t row = (size_t)b * S_ + qpos;
    const bf16* kc = (const bf16*)(ws + WS_KCV) + (size_t)(b * 2 + g) * 128 * 64; const bf16* vc = kc + (size_t)8 * 2 * 128 * 64;
    { TileRegs<4> tr; at_load<4>(tr, kc, 64, vc, 64, nullptr, 0, 0, tid); at_store<4>(tr, lds, tid); at_load<4>(tr, kc, 64, vc, 64, nullptr, 0, 1, tid); at_store<4>(tr, lds + AT_BUF, tid); }
    __syncthreads();
    int nvis = (qpos >= 31) ? ((qpos - 31) >> 4) + 1 : 0; if (nvis > 127) nvis = 127;
    float G[16], L[16];
#pragma unroll
    for (int i = 0; i < 16; ++i) { G[i] = 0.f; L[i] = 0.f; }
    const bf16* nsa = (const bf16*)(ws + WS_NSA);
    LAS const unsigned char* vb = lds + AT_V + (4 * hi + ((lane & 15) >> 2)) * 64 + ((lane >> 4) & 1) * 32 + (lane & 3) * 8;
    for (int r3 = 0; r3 < 3; ++r3) {
        const int h = 3 * g + r3;
        const bf16* qp = nsa + row * 1152 + h * 64 + 8 * hi;
        bf16x8 qf[4];
#pragma unroll
        for (int cc = 0; cc < 4; ++cc) qf[cc] = *(const bf16x8*)(qp + 16 * cc);
        f32x16 p[4];
#pragma unroll
        for (int tb = 0; tb < 4; ++tb) {
            LAS const unsigned char* buf = lds + (tb >> 1) * AT_BUF; const int kr = (tb & 1) * 32 + r32;
            p[tb] = f32x16{};
#pragma unroll
            for (int cc = 0; cc < 4; ++cc) { const bf16x8 kf = *(LAS const bf16x8*)(buf + kr * 128 + 16 * ((2 * cc + hi) ^ ((kr >> 1) & 7)));
                p[tb] = __builtin_amdgcn_mfma_f32_32x32x16_bf16(kf, qf[cc], p[tb], 0, 0, 0); }
        }
        float mx = -1e30f;
#pragma unroll
        for (int tb = 0; tb < 4; ++tb)
#pragma unroll
            for (int r = 0; r < 16; ++r) { const int n = 32 * tb + crow(r, hi); p[tb][r] = fminf(p[tb][r], ((float)(nvis - n) - 0.5f) * INFINITY); mx = fmaxf(mx, p[tb][r]); }
        mx = red32_max(mx);
        float sum = 0.f;
#pragma unroll
        for (int tb = 0; tb < 4; ++tb)
#pragma unroll
            for (int r = 0; r < 16; ++r) { p[tb][r] = __builtin_amdgcn_exp2f(p[tb][r] - mx); sum += p[tb][r]; }
        sum = red32_sum(sum);
        const float il = (nvis > 0) ? 1.f / sum : 0.f;
#pragma unroll
        for (int tb = 0; tb < 4; ++tb)
#pragma unroll
            for (int k = 0; k < 4; ++k) { const float a0 = p[tb][4 * k] * il, a1 = p[tb][4 * k + 1] * il, a2 = p[tb][4 * k + 2] * il, a3 = p[tb][4 * k + 3] * il;
                G[4 * tb + k] += (a0 + a1) + (a2 + a3); L[4 * tb + k] += a3; }
        f32x16 o[2] = {f32x16{}, f32x16{}};
#pragma unroll
        for (int tb = 0; tb < 4; ++tb)
#pragma unroll
            for (int s2 = 0; s2 < 2; ++s2) {
                v4u a; a.x = cvtpk(p[tb][8 * s2 + 0], p[tb][8 * s2 + 1]); a.y = cvtpk(p[tb][8 * s2 + 2], p[tb][8 * s2 + 3]); a.z = cvtpk(p[tb][8 * s2 + 4], p[tb][8 * s2 + 5]); a.w = cvtpk(p[tb][8 * s2 + 6], p[tb][8 * s2 + 7]);
                const bf16x8 pf = __builtin_bit_cast(bf16x8, a);
                LAS const unsigned char* vbb = vb + (tb >> 1) * AT_BUF + ((tb & 1) * 2 + s2) * 1024;
#pragma unroll
                for (int dh = 0; dh < 2; ++dh) { const s16x4 lo = vtr(vbb + dh * 4096), hh = vtr(vbb + dh * 4096 + 512);
                    const bf16x8 vf = {lo[0], lo[1], lo[2], lo[3], hh[0], hh[1], hh[2], hh[3]};
                    o[dh] = __builtin_amdgcn_mfma_f32_32x32x16_bf16(vf, pf, o[dh], 0, 0, 0); }
                asm volatile("" ::: "memory");
            }
        bf16* op = (bf16*)(ws + WS_OCMP) + row * 384 + h * 64 + 4 * hi;
#pragma unroll
        for (int dh = 0; dh < 2; ++dh)
#pragma unroll
            for (int g4 = 0; g4 < 4; ++g4) { u32x2v w; w.x = cvtpk(o[dh][4 * g4] * il, o[dh][4 * g4 + 1] * il); w.y = cvtpk(o[dh][4 * g4 + 2] * il, o[dh][4 * g4 + 3] * il);
                *(u32x2v*)(op + dh * 32 + 8 * g4) = w; }
    }
    const int cur = qpos >> 6;
    unsigned key[16], okey[16];
#pragma unroll
    for (int jj = 0; jj < 16; ++jj) {
        const auto sw = __builtin_amdgcn_permlane32_swap(__float_as_uint(L[jj]), __float_as_uint(L[jj]), false, false);
        const float lp = __uint_as_float(hi ? sw[0] : sw[1]);
        L[jj] = lp;
    }
#pragma unroll
    for (int jj = 0; jj < 16; ++jj) {
        const int j = 2 * jj + hi;
        float v = G[jj] + (hi ? L[jj] : (jj > 0 ? L[jj > 0 ? jj - 1 : 0] : 0.f));
        if (j == 0 || j == cur || j == cur - 1) v = INFINITY;
        if (j * 64 > qpos) v = -INFINITY;
        const unsigned u = __float_as_uint(v); const unsigned ord = (u & 0x80000000u) ? ~u : (u | 0x80000000u);
        key[jj] = (ord & ~31u) | (unsigned)(31 - j);
    }
#pragma unroll
    for (int jj = 0; jj < 16; ++jj) { const auto sw = __builtin_amdgcn_permlane32_swap(key[jj], key[jj], false, false); okey[jj] = hi ? sw[0] : sw[1]; }
    unsigned mask = 0;
#pragma unroll
    for (int jj = 0; jj < 16; ++jj) {
        int rank = 0;
#pragma unroll
        for (int kk = 0; kk < 16; ++kk) { rank += (key[kk] > key[jj]) ? 1 : 0; rank += (okey[kk] > key[jj]) ? 1 : 0; }
        if (rank < 16) mask |= 1u << (2 * jj + hi);
    }
    mask = red32_or(mask);
    if (hi == 0) ((unsigned*)(ws + WS_SEL))[(size_t)(b * 2 + g) * S_ + qpos] = mask;
    __syncthreads();
}
__device__ __forceinline__ void lora_rows(unsigned char* ws, int tid) {
    const int gw = blockIdx.x * NWAVES + (tid >> 6), ngw = gridDim.x * NWAVES, lane = tid & 63;
    bf16* kvl = (bf16*)(ws + WS_KVL); const bf16* ql = (const bf16*)(ws + WS_QL); float* ssql = (float*)(ws + WS_SSQL);
    for (int m = gw; m < T_; m += ngw) {
        const unsigned kv = *(const unsigned*)(kvl + (size_t)m * 128 + 2 * lane);
        const float k0 = __uint_as_float(kv << 16), k1 = __uint_as_float(kv & 0xffff0000u);
        const uint2 qv = *(const uint2*)(ql + (size_t)m * 256 + 4 * lane);
        const float q0 = __uint_as_float(qv.x << 16), q1 = __uint_as_float(qv.x & 0xffff0000u), q2 = __uint_as_float(qv.y << 16), q3 = __uint_as_float(qv.y & 0xffff0000u);
        const float sk = wave_sum2(k0 * k0 + k1 * k1), sq = wave_sum2((q0 * q0 + q1 * q1) + (q2 * q2 + q3 * q3));
        const float rk = rsqrtf(sk * (1.f / 128.f) + EPS);
        *(unsigned*)(kvl + (size_t)m * 128 + 2 * lane) = pk2(k0 * rk, k1 * rk);
        if (lane == 0) ssql[m] = sq;
    }
}
__device__ __forceinline__ void post_misc(unsigned char* ws, const float* big, const float* bfg, int tid) {
    const float* mr = (const float*)(ws + WS_MISCRAW); const float* cosM = (const float*)(ws + WS_COSM); const float* sinM = (const float*)(ws + WS_SINM);
    bf16* kr = (bf16*)(ws + WS_KR); float* gm = (float*)(ws + WS_GM);
    for (int idx = blockIdx.x * NTHR + tid; idx < T_ * 64; idx += gridDim.x * NTHR) {
        const int row = idx >> 6, c = idx & 63; const float* r = mr + (size_t)row * 64; const float v = r[c];
        if (c < 32) { const int i = c & 15; const float x1 = r[i], x2 = r[16 + i], cs = cosM[row * 16 + i], sn = sinM[row * 16 + i];
            kr[(size_t)row * 32 + c] = f2bf((c < 16) ? x1 * cs - x2 * sn : x1 * sn + x2 * cs); }
        else if (c < 50) gm[(size_t)row * 32 + (c - 32)] = 1.f / (1.f + __expf(-v));
        else if (c < 54) gm[(size_t)row * 32 + 18 + (c - 50)] = v + big[c - 50];
        else if (c < 58) { const float z = v + bfg[c - 54]; gm[(size_t)row * 32 + 22 + (c - 54)] = fminf(z, 0.f) - __logf(1.f + __expf(-fabsf(z))); }
    }
}

typedef float f32x4v __attribute__((ext_vector_type(4)));
__device__ __forceinline__ void compress_item(unsigned char* ws, LAS unsigned char* lds, const float* cmp_pos, int item, int wave_u) {
    const int lane = fresh_lane(), tid = wave_u * 64 + lane;
    const int nb = item & 7, g = (item >> 3) & 1, b = (item >> 4) & 7, kv = item >> 7;
    const bf16* tok = (const bf16*)(ws + WS_NSA) + (size_t)b * S_ * 1152 + (kv ? 512 : 384) + g * 64;
    const bf16* wt = (const bf16*)(ws + (kv ? WT_CV : WT_CK));
    const int nrow = nb * 16 + (lane & 15), kq = lane >> 4;
    f32x4v acc[4] = {f32x4v{}, f32x4v{}, f32x4v{}, f32x4v{}};
#pragma unroll
    for (int hb = 0; hb < 2; ++hb) {
        v4u t4[4]; f32x4v p0[4], p1[4]; bf16x8 bfr[4][4];
#pragma unroll
        for (int q = 0; q < 4; ++q) {
            const int k = wave_u * 256 + (4 * hb + q) * 32 + kq * 8, l = k >> 6, d = k & 63;
            int trow = 16 * nrow + l; trow = trow < S_ ? trow : S_ - 1;
            t4[q] = *(const v4u*)(tok + (size_t)trow * 1152 + d);
            p0[q] = *(const f32x4v*)(cmp_pos + k); p1[q] = *(const f32x4v*)(cmp_pos + k + 4);
#pragma unroll
            for (int cb = 0; cb < 4; ++cb) bfr[q][cb] = *(const bf16x8*)(wt + (size_t)(cb * 16 + (lane & 15)) * 2048 + k);
        }
        asm volatile("" : "+v"(t4[0]), "+v"(t4[1]), "+v"(t4[2]), "+v"(t4[3]), "+v"(p0[0]), "+v"(p0[1]), "+v"(p0[2]), "+v"(p0[3]), "+v"(p1[0]), "+v"(p1[1]), "+v"(p1[2]), "+v"(p1[3]));
        asm volatile("" : "+v"(bfr[0][0]), "+v"(bfr[0][1]), "+v"(bfr[0][2]), "+v"(bfr[0][3]), "+v"(bfr[1][0]), "+v"(bfr[1][1]), "+v"(bfr[1][2]), "+v"(bfr[1][3]));
        asm volatile("" : "+v"(bfr[2][0]), "+v"(bfr[2][1]), "+v"(bfr[2][2]), "+v"(bfr[2][3]), "+v"(bfr[3][0]), "+v"(bfr[3][1]), "+v"(bfr[3][2]), "+v"(bfr[3][3]));
#pragma unroll
        for (int q = 0; q < 4; ++q) {
            v4u a4;
            a4.x = cvtpk(__uint_as_float(t4[q].x << 16) + p0[q][0], __uint_as_float(t4[q].x & 0xffff0000u) + p0[q][1]); a4.y = cvtpk(__uint_as_float(t4[q].y << 16) + p0[q][2], __uint_as_float(t4[q].y & 0xffff0000u) + p0[q][3]);
            a4.z = cvtpk(__uint_as_float(t4[q].z << 16) + p1[q][0], __uint_as_float(t4[q].z & 0xffff0000u) + p1[q][1]); a4.w = cvtpk(__uint_as_float(t4[q].w << 16) + p1[q][2], __uint_as_float(t4[q].w & 0xffff0000u) + p1[q][3]);
            const bf16x8 af = __builtin_bit_cast(bf16x8, a4);
#pragma unroll
            for (int cb = 0; cb < 4; ++cb) acc[cb] = __builtin_amdgcn_mfma_f32_16x16x32_bf16(af, bfr[q][cb], acc[cb], 0, 0, 0);
        }
    }
    LAS float* red = (LAS float*)lds + wave_u * 1024;
#pragma unroll
    for (int cb = 0; cb < 4; ++cb)
#pragma unroll
        for (int r = 0; r < 4; ++r) red[(4 * (lane >> 4) + r) * 64 + cb * 16 + (lane & 15)] = acc[cb][r];
    __syncthreads();
    bf16* out = (bf16*)(ws + WS_KCV) + (size_t)kv * (8 * 2 * 128 * 64) + ((size_t)(b * 2 + g) * 128 + nb * 16) * 64;
    for (int o = tid; o < 1024; o += NTHR) { float sum = 0.f;
#pragma unroll
        for (int w8 = 0; w8 < 8; ++w8) sum += ((LAS float*)lds)[w8 * 1024 + o];
        out[o] = f2bf(sum); }
    __syncthreads();
}
__device__ __forceinline__ f32x4v mm16(const LAS bf16* A, int lda, int arow0, const LAS bf16* Bt, int ldb, int bcol0, int K, int lane, f32x4v acc) {
    const LAS bf16* ap = A + (arow0 + (lane & 15)) * lda + 8 * (lane >> 4); const LAS bf16* bp = Bt + (bcol0 + (lane & 15)) * ldb + 8 * (lane >> 4);
    for (int k = 0; k < K; k += 32) acc = __builtin_amdgcn_mfma_f32_16x16x32_bf16(*(const LAS bf16x8*)(ap + k), *(const LAS bf16x8*)(bp + k), acc, 0, 0, 0);
    return acc;
}
constexpr int ML_LD = 72;
constexpr int ML_STRIDE = 3 * 64 * ML_LD * 2 + 256;
__device__ __forceinline__ void mlocal_item(unsigned char* ws, LAS unsigned char* lds, const float* convw, const float* convb, const float* big, const float* bfg, int chunk0, int wave_u) {
    const int lane = fresh_lane(), tid = wave_u * 64 + lane;
    const int h = (chunk0 >> 5) & 3, b = chunk0 >> 7;
    LAS bf16* WQ = (LAS bf16*)lds;
    LAS bf16* WK = WQ + 64 * ML_LD;
    const bf16* cm = (const bf16*)(ws + WS_CM);
#define ML_PTRS(ch) const int chunk = chunk0 + (ch); const int c = chunk & 31; const int row0 = b * S_ + c * 64; LAS bf16* XS = WK + 64 * ML_LD + (ch) * (ML_STRIDE / 2); \
    LAS bf16* VT = XS + 64 * ML_LD; LAS bf16* WKT = VT + 64 * ML_LD; LAS float* wl = (LAS float*)(WKT + 64 * ML_LD); (void)c; (void)row0; (void)XS; (void)VT; (void)WKT; (void)wl; (void)chunk;
    {
        v4u gx[2][4], gv[2]; const int l = tid >> 3, ch0 = (tid & 7) * 8;
#pragma unroll
        for (int ch = 0; ch < 2; ++ch) { ML_PTRS(ch) const int row = row0 + l, s = c * 64 + l;
#pragma unroll
            for (int j = 0; j < 4; ++j) gx[ch][j] = (s - 3 + j >= 0) ? *(const v4u*)(cm + (size_t)(row - 3 + j) * 768 + h * 64 + ch0) : v4u{0u, 0u, 0u, 0u};
            gv[ch] = *(const v4u*)(cm + (size_t)row * 768 + 256 + h * 64 + ch0); }
        asm volatile("" : "+v"(gx[0][0]), "+v"(gx[0][1]), "+v"(gx[0][2]), "+v"(gx[0][3]), "+v"(gx[1][0]), "+v"(gx[1][1]), "+v"(gx[1][2]), "+v"(gx[1][3]), "+v"(gv[0]), "+v"(gv[1]));
#pragma unroll
        for (int ch = 0; ch < 2; ++ch) { ML_PTRS(ch) const int row = row0 + l;
            float a[8];
#pragma unroll
            for (int i = 0; i < 8; ++i) a[i] = convb[h * 64 + ch0 + i];
#pragma unroll
            for (int j = 0; j < 4; ++j) { const v4u x4 = gx[ch][j];
                const float* cw = convw + j * 256 + h * 64 + ch0;
                a[0] += cw[0] * __uint_as_float(x4.x << 16); a[1] += cw[1] * __uint_as_float(x4.x & 0xffff0000u); a[2] += cw[2] * __uint_as_float(x4.y << 16); a[3] += cw[3] * __uint_as_float(x4.y & 0xffff0000u);
                a[4] += cw[4] * __uint_as_float(x4.z << 16); a[5] += cw[5] * __uint_as_float(x4.z & 0xffff0000u); a[6] += cw[6] * __uint_as_float(x4.w << 16); a[7] += cw[7] * __uint_as_float(x4.w & 0xffff0000u); }
            v4u o4; float r[8];
#pragma unroll
            for (int i = 0; i < 8; ++i) r[i] = a[i] / (1.f + __expf(-a[i]));
            o4.x = cvtpk(r[0], r[1]); o4.y = cvtpk(r[2], r[3]); o4.z = cvtpk(r[4], r[5]); o4.w = cvtpk(r[6], r[7]);
            *(v4u*)((bf16*)(ws + WS_XC) + (size_t)row * 256 + h * 64 + ch0) = o4;
            *(LAS v4u*)(XS + l * ML_LD + ch0) = o4;
            const v4u v4 = gv[ch];
            VT[(ch0 + 0) * ML_LD + l] = (bf16)(v4.x & 0xffffu); VT[(ch0 + 1) * ML_LD + l] = (bf16)(v4.x >> 16); VT[(ch0 + 2) * ML_LD + l] = (bf16)(v4.y & 0xffffu); VT[(ch0 + 3) * ML_LD + l] = (bf16)(v4.y >> 16);
            VT[(ch0 + 4) * ML_LD + l] = (bf16)(v4.z & 0xffffu); VT[(ch0 + 5) * ML_LD + l] = (bf16)(v4.z >> 16); VT[(ch0 + 6) * ML_LD + l] = (bf16)(v4.w & 0xffffu); VT[(ch0 + 7) * ML_LD + l] = (bf16)(v4.w >> 16);
        }
    }
    {
        const int e = tid >> 3, d0 = (tid & 7) * 8;
        *(LAS v4u*)(WQ + e * ML_LD + d0) = *(const v4u*)((const bf16*)(ws + WT_QM) + h * 4096 + e * 64 + d0);
        *(LAS v4u*)(WK + e * ML_LD + d0) = *(const v4u*)((const bf16*)(ws + WT_KM) + h * 4096 + e * 64 + d0);
    }
    if (wave_u < 2) { ML_PTRS(wave_u)
        const float* mr = (const float*)(ws + WS_MISCRAW) + (size_t)(row0 + lane) * 64;
        const float z = mr[54 + h] + bfg[h]; float lf = fminf(z, 0.f) - __logf(1.f + __expf(-fabsf(z)));
        const float ig = mr[50 + h] + big[h];
#pragma unroll
        for (int o = 1; o < 64; o <<= 1) { const float t = bperm(lf, lane - o); if (lane >= o) lf += t; }
        const float bL = __int_as_float(__builtin_amdgcn_readlane(__float_as_int(lf), 63));
        const float a = bL - lf + ig; const float mx = wave_max2(a);
        wl[lane] = __expf(a - mx);
        if (lane == 0) { ((float*)(ws + WS_ML))[chunk] = mx; ((float*)(ws + WS_BL))[chunk] = bL; }
    }
    __syncthreads();
#pragma unroll
    for (int ch = 0; ch < 2; ++ch) { ML_PTRS(ch)
        const int lb = wave_u & 3; const bool isk = wave_u >= 4;
        const LAS bf16* Wt = isk ? WK : WQ;
        bf16* og = (bf16*)(ws + (isk ? WS_MK : WS_MQ)) + (size_t)(row0 + 16 * lb + 4 * (lane >> 4)) * 256 + h * 64 + (lane & 15);
        float w4[4];
#pragma unroll
        for (int r = 0; r < 4; ++r) w4[r] = wl[16 * lb + 4 * (lane >> 4) + r];
#pragma unroll
        for (int eb = 0; eb < 4; ++eb) {
            f32x4v acc = mm16(XS, ML_LD, 16 * lb, Wt, ML_LD, 16 * eb, 64, lane, f32x4v{});
            if (!isk) {
#pragma unroll
                for (int r = 0; r < 4; ++r) og[(size_t)r * 256 + 16 * eb] = f2bf(acc[r] * 0.125f);
            } else {
                bf16 kb[4];
#pragma unroll
                for (int r = 0; r < 4; ++r) { kb[r] = f2bf(acc[r]); og[(size_t)r * 256 + 16 * eb] = kb[r]; }
                u32x2v w2; w2.x = cvtpk(bf2f(kb[0]) * w4[0], bf2f(kb[1]) * w4[1]); w2.y = cvtpk(bf2f(kb[2]) * w4[2], bf2f(kb[3]) * w4[3]);
                *(LAS u32x2v*)(WKT + (16 * eb + (lane & 15)) * ML_LD + 16 * lb + 4 * (lane >> 4)) = w2;
            }
        }
    }
    __syncthreads();
#pragma unroll
    for (int ch = 0; ch < 2; ++ch) { ML_PTRS(ch)
        float* ct = (float*)(ws + WS_CT) + (size_t)chunk * 4096;
#pragma unroll
        for (int i = 0; i < 2; ++i) { const int blk = wave_u * 2 + i, eb = blk >> 2, db = blk & 3;
            const f32x4v acc = mm16(VT, ML_LD, 16 * eb, WKT, ML_LD, 16 * db, 64, lane, f32x4v{});
#pragma unroll
            for (int r = 0; r < 4; ++r) ct[(16 * eb + 4 * (lane >> 4) + r) * 64 + 16 * db + (lane & 15)] = acc[r]; }
    }
    if (tid < 128) { ML_PTRS(tid >> 6)
        const int d = tid & 63; float n = 0.f; const LAS bf16* wr_ = WKT + d * ML_LD;
        for (int l = 0; l < 64; ++l) n += bf2f(wr_[l]);
        ((float*)(ws + WS_NL))[chunk * 64 + d] = n; }
#undef ML_PTRS
    __syncthreads();
}
__device__ __forceinline__ void mscan_item(unsigned char* ws, int item, int wave_u) {
    const int tid = wave_u * 64 + fresh_lane();
    const int bh = item / 9, part = item % 9;
    if (part == 8 && tid >= 64) return;
    float* base; size_t stride;
    if (part < 8) { base = (float*)(ws + WS_CT) + (size_t)bh * 32 * 4096 + part * 512 + tid; stride = 4096; } else { base = (float*)(ws + WS_NL) + (size_t)bh * 32 * 64 + tid; stride = 64; }
    const float* ML = (const float*)(ws + WS_ML); const float* BL = (const float*)(ws + WS_BL); float* MPv = (float*)(ws + WS_MP);
    float cl[32];
#pragma unroll
    for (int c = 0; c < 32; ++c) cl[c] = base[(size_t)c * stride];
    float Cv = 0.f, m = 0.f;
#pragma unroll
    for (int c = 0; c < 32; ++c) {
        const float ml = ML[bh * 32 + c], bl = BL[bh * 32 + c];
        base[(size_t)c * stride] = Cv;
        if (part == 8 && tid == 0) MPv[bh * 32 + c] = m;
        const float mn = fmaxf(bl + m, ml);
        Cv = __expf(bl + m - mn) * Cv + __expf(ml - mn) * cl[c]; m = mn;
    }
}
constexpr int MO_STRIDE = 5 * 64 * ML_LD * 2 + 64 * 65 * 4 + 6 * 64 * 4;
__device__ __forceinline__ void mout_item(unsigned char* ws, LAS unsigned char* lds, const float* gmh, const float* skip, int chunk0, int wave_u) {
    const int lane = fresh_lane(), tid = wave_u * 64 + lane;
    const int h = (chunk0 >> 5) & 3, b = chunk0 >> 7;
    const float* gm = (const float*)(ws + WS_GM);
#define MO_PTRS(ch) const int chunk = chunk0 + (ch); const int row0 = b * S_ + (chunk & 31) * 64; LAS unsigned char* cb_ = lds + (ch) * MO_STRIDE; \
    LAS bf16* QS = (LAS bf16*)cb_; LAS bf16* KS = QS + 64 * ML_LD; LAS bf16* VT = KS + 64 * ML_LD; LAS bf16* CP = VT + 64 * ML_LD; LAS bf16* SW = CP + 64 * ML_LD; \
    LAS float* HS = (LAS float*)(SW + 64 * ML_LD); LAS float* bs = HS + 64 * 65; LAS float* us = bs + 64; LAS float* ns = us + 64; LAS float* mts = ns + 64; LAS float* ints = mts + 64; LAS float* dinv = ints + 64; \
    (void)row0; (void)QS; (void)KS; (void)VT; (void)CP; (void)SW; (void)HS; (void)bs; (void)us; (void)ns; (void)mts; (void)ints; (void)dinv; (void)chunk;
    {
        v4u gq[2], gk[2], gv[2]; f32x4v gc0[2], gc1[2];
        const int l = tid >> 3, c0 = (tid & 7) * 8;
#pragma unroll
        for (int ch = 0; ch < 2; ++ch) { MO_PTRS(ch) const int row = row0 + l;
            gq[ch] = *(const v4u*)((const bf16*)(ws + WS_MQ) + (size_t)row * 256 + h * 64 + c0); gk[ch] = *(const v4u*)((const bf16*)(ws + WS_MK) + (size_t)row * 256 + h * 64 + c0);
            gv[ch] = *(const v4u*)((const bf16*)(ws + WS_CM) + (size_t)row * 768 + 256 + h * 64 + c0);
            const float* ct = (const float*)(ws + WS_CT) + (size_t)chunk * 4096 + l * 64 + c0;
            gc0[ch] = *(const f32x4v*)ct; gc1[ch] = *(const f32x4v*)(ct + 4); }
        asm volatile("" : "+v"(gq[0]), "+v"(gq[1]), "+v"(gk[0]), "+v"(gk[1]), "+v"(gv[0]), "+v"(gv[1]), "+v"(gc0[0]), "+v"(gc0[1]), "+v"(gc1[0]), "+v"(gc1[1]));
#pragma unroll
        for (int ch = 0; ch < 2; ++ch) { MO_PTRS(ch)
            *(LAS v4u*)(QS + l * ML_LD + c0) = gq[ch]; *(LAS v4u*)(KS + l * ML_LD + c0) = gk[ch];
            const v4u v4 = gv[ch];
            VT[(c0 + 0) * ML_LD + l] = (bf16)(v4.x & 0xffffu); VT[(c0 + 1) * ML_LD + l] = (bf16)(v4.x >> 16); VT[(c0 + 2) * ML_LD + l] = (bf16)(v4.y & 0xffffu); VT[(c0 + 3) * ML_LD + l] = (bf16)(v4.y >> 16);
            VT[(c0 + 4) * ML_LD + l] = (bf16)(v4.z & 0xffffu); VT[(c0 + 5) * ML_LD + l] = (bf16)(v4.z >> 16); VT[(c0 + 6) * ML_LD + l] = (bf16)(v4.w & 0xffffu); VT[(c0 + 7) * ML_LD + l] = (bf16)(v4.w >> 16);
            const f32x4v c0v = gc0[ch], c1v = gc1[ch];
            v4u cw; cw.x = cvtpk(c0v[0], c0v[1]); cw.y = cvtpk(c0v[2], c0v[3]); cw.z = cvtpk(c1v[0], c1v[1]); cw.w = cvtpk(c1v[2], c1v[3]);
            *(LAS v4u*)(CP + l * ML_LD + c0) = cw; }
    }
    if (wave_u < 2) { MO_PTRS(wave_u)
        const float ig = gm[(size_t)(row0 + lane) * 32 + 18 + h]; float lf = gm[(size_t)(row0 + lane) * 32 + 22 + h];
#pragma unroll
        for (int o = 1; o < 64; o <<= 1) { const float t = bperm(lf, lane - o); if (lane >= o) lf += t; }
        const float u = ig - lf; float cu = u;
#pragma unroll
        for (int o = 1; o < 64; o <<= 1) { const float t = bperm(cu, lane - o); if (lane >= o) cu = fmaxf(cu, t); }
        const float mprev = ((const float*)(ws + WS_MP))[chunk];
        const float mt = lf + fmaxf(mprev, cu);
        bs[lane] = lf; us[lane] = u; mts[lane] = mt; ints[lane] = __expf(lf + mprev - mt); ns[lane] = ((const float*)(ws + WS_NL))[chunk * 64 + lane];
    }
    __syncthreads();
#pragma unroll
    for (int ch = 0; ch < 2; ++ch) { MO_PTRS(ch)
#pragma unroll
        for (int i = 0; i < 2; ++i) { const int blk = wave_u * 2 + i, lb = blk >> 2, sb = blk & 3;
            f32x4v acc = f32x4v{};
            if (sb <= lb) acc = mm16(QS, ML_LD, 16 * lb, KS, ML_LD, 16 * sb, 64, lane, acc);
            const int sidx = 16 * sb + (lane & 15); const float usv = us[sidx];
#pragma unroll
            for (int r = 0; r < 4; ++r) { const int l = 16 * lb + 4 * (lane >> 4) + r;
                const float v = (sidx <= l) ? acc[r] * __expf(bs[l] + usv - mts[l]) : 0.f;
                SW[l * ML_LD + sidx] = f2bf(v); } }
    }
    __syncthreads();
    if (tid < 128) { MO_PTRS(tid >> 6)
        const int l = tid & 63; float qn = 0.f, ssum = 0.f;
        for (int d = 0; d < 64; ++d) { qn += bf2f(QS[l * ML_LD + d]) * ns[d]; ssum += bf2f(SW[l * ML_LD + d]); }
        const float den = ints[l] * qn + ssum;
        dinv[l] = 1.f / fmaxf(fabsf(den), __expf(-mts[l]));
    }
    f32x4v hq[2][2], hs2[2][2];
#pragma unroll
    for (int ch = 0; ch < 2; ++ch) { MO_PTRS(ch)
#pragma unroll
        for (int i = 0; i < 2; ++i) { const int blk = wave_u * 2 + i, lb = blk >> 2, eb = blk & 3;
            hq[ch][i] = mm16(QS, ML_LD, 16 * lb, CP, ML_LD, 16 * eb, 64, lane, f32x4v{});
            hs2[ch][i] = mm16(SW, ML_LD, 16 * lb, VT, ML_LD, 16 * eb, 16 * lb + 16 <= 32 ? 32 : 64, lane, f32x4v{}); }
    }
    __syncthreads();
#pragma unroll
    for (int ch = 0; ch < 2; ++ch) { MO_PTRS(ch)
#pragma unroll
        for (int i = 0; i < 2; ++i) { const int blk = wave_u * 2 + i, lb = blk >> 2, eb = blk & 3; const int e = 16 * eb + (lane & 15);
#pragma unroll
            for (int r = 0; r < 4; ++r) { const int l = 16 * lb + 4 * (lane >> 4) + r;
                const float og = bf2f(((const bf16*)(ws + WS_CM))[(size_t)(row0 + l) * 768 + 512 + h * 64 + e]);
                HS[l * 65 + e] = (ints[l] * hq[ch][i][r] + hs2[ch][i][r]) * dinv[l] / (1.f + __expf(-og)); } }
    }
    __syncthreads();
#pragma unroll
    for (int ch = 0; ch < 2; ++ch) { MO_PTRS(ch)
        const int l = tid >> 3, e0 = (tid & 7) * 8, row = row0 + l;
        float v[8]; float mu = 0.f;
#pragma unroll
        for (int i = 0; i < 8; ++i) { v[i] = HS[l * 65 + e0 + i]; mu += v[i]; }
        mu += sxf<1>(mu); mu += sxf<2>(mu); mu += sxf<4>(mu); mu *= (1.f / 64.f);
        float var = 0.f;
#pragma unroll
        for (int i = 0; i < 8; ++i) { const float dl = v[i] - mu; var += dl * dl; }
        var += sxf<1>(var); var += sxf<2>(var); var += sxf<4>(var);
        const float rs = rsqrtf(var * (1.f / 64.f) + EPS);
        const v4u x4 = *(const v4u*)((const bf16*)(ws + WS_XC) + (size_t)row * 256 + h * 64 + e0);
        float xv[8]; xv[0] = __uint_as_float(x4.x << 16); xv[1] = __uint_as_float(x4.x & 0xffff0000u); xv[2] = __uint_as_float(x4.y << 16); xv[3] = __uint_as_float(x4.y & 0xffff0000u);
        xv[4] = __uint_as_float(x4.z << 16); xv[5] = __uint_as_float(x4.z & 0xffff0000u); xv[6] = __uint_as_float(x4.w << 16); xv[7] = __uint_as_float(x4.w & 0xffff0000u);
        float r[8];
#pragma unroll
        for (int i = 0; i < 8; ++i) r[i] = (v[i] - mu) * rs * gmh[h * 64 + e0 + i] + skip[h * 64 + e0 + i] * xv[i];
        v4u w4; w4.x = cvtpk(r[0], r[1]); w4.y = cvtpk(r[2], r[3]); w4.z = cvtpk(r[4], r[5]); w4.w = cvtpk(r[6], r[7]);
        *(v4u*)((bf16*)(ws + WS_HB) + (size_t)row * D_ + 768 + h * 64 + e0) = w4;
    }
#undef MO_PTRS
    __syncthreads();
}

__global__ void __launch_bounds__(NTHR, 2) mega(MP p_unused) {
    extern __shared__ __attribute__((aligned(16))) unsigned char lds_raw[];
    LAS unsigned char* lds = (LAS unsigned char*)lds_raw;
    const int wave0 = __builtin_amdgcn_readfirstlane((int)threadIdx.x >> 6);
    const int tid0 = wave0 * 64 + fresh_lane();
    const int xcc = (int)(__builtin_amdgcn_s_getreg((3 << 11) | 20) & 7u);
    volatile LAS unsigned* MISC = (volatile LAS unsigned*)(lds + MISC_OFF);
    for (int u = tid0; u < (LDS_BYTES - RING_BYTES) / 4; u += NTHR) ((LAS unsigned*)(lds + RING_BYTES))[u] = 0u;
    __syncthreads();
    typedef const __attribute__((address_space(4))) MP* kmp_t;
    kmp_t kp0 = (kmp_t)__builtin_amdgcn_kernarg_segment_ptr();
    unsigned char* ws0 = kp0->ws; const int coop = kp0->coop, ph_lo = kp0->ph_lo, ph_hi = kp0->ph_hi;
    XcdBarrier bar; bar.bar = (unsigned*)(ws0 + WS_CTL) + CW_BAR; bar.x = 0; bar.st = nullptr;
    if (coop) bar = xcd_barrier_post((unsigned*)(ws0 + WS_CTL) + CW_BAR, MISC + 8, tid0);
    if (coop == 2) cooperative_groups::this_grid().sync();
    int ph = ph_lo;
    if (ph == 0) {
        const MPK p{kp0}; ph_p0(p, lds, wave0 * 64 + fresh_lane()); ph = 1;
        if (ph < ph_hi) xcd_barrier(bar, wave0 * 64 + fresh_lane());
    }
    bool second = false;
    for (; ph < ph_hi; ++ph) {
        kmp_t kp = kp0; asm volatile("" : "+s"(kp));
        const MPK p{kp}; unsigned char* ws = kp->ws;
#define TID_ (wave0 * 64 + fresh_lane())
#define GW_ (blockIdx.x * NWAVES + wave0)
#define NGW_ (gridDim.x * NWAVES)
        const int l = (ph - 1) / PPL, ty = (ph == 0) ? -1 : (ph == NPH - 1) ? -2 : (ph - 1) % PPL;
        const float* modl = (const float*)(ws + WS_MOD) + (size_t)l * 8 * 6144;
        if (ty == -2) { norm_rows(p.k->out, PIN(I_GFIN), nullptr, nullptr, nullptr, p.k->out, 2, GW_, NGW_, fresh_lane());
            if (PROBE_SEL != 0 && blockIdx.x == 0 && TID_ == 0) { asm volatile("s_waitcnt vmcnt(0)" ::: "memory"); p.k->out[0] = ((const float*)(ws + WS_CTL))[100] * 0.001f; } }
        else if (ty == 0 && (PHM & 2)) ph_prep(p, l, lds, TID_);
        else if (ty == 1 && (PHM & 4)) {
            pg8::Gemm g{(const bf16*)(ws + WS_HB), (const bf16*)(ws + WT_IN), T_, 2560, D_}; pg8::StaticOrder S; S.init(T_, 2560, gridDim.x, blockIdx.x);
            pg8::EpiIn E{ws, PIN(I_BIG) + l * 4, PIN(I_BFG) + l * 4};
            pg8::gemm_phase<pg8::EpiIn, pg8::StaticOrder, true, true>(lds, g, S, E, wave0);
            late_transposes(p, l, lds, TID_, 640 % (int)gridDim.x);
        }
        else if (ty == 2 && (PHM & 64)) {
            { pg8::Gemm g{(const bf16*)(ws + WS_KVL), (const bf16*)(ws + WT_UKV), T_, 768, 128}; pg8::StaticOrder S; S.init(T_, 768, gridDim.x, blockIdx.x);
              pg8::EpiUKV E{(bf16*)(ws + WS_KVM), (const float*)(ws + WS_SSKV)}; pg8::gemm_phase<pg8::EpiUKV, pg8::StaticOrder, true, true>(lds, g, S, E, wave0); }
            { pg8::Gemm g{(const bf16*)(ws + WS_QL), (const bf16*)(ws + WT_UQ), T_, 768, 256}; pg8::StaticOrder S; S.init(T_, 768, gridDim.x, blockIdx.x);
              pg8::EpiPlain E{(bf16*)(ws + WS_OSLC), 768}; pg8::gemm_phase<pg8::EpiPlain, pg8::StaticOrder, true, true>(lds, g, S, E, wave0); }
            post_misc(ws, PIN(I_BIG) + l * 4, PIN(I_BFG) + l * 4, TID_);
            unsigned* ctrs = (unsigned*)(ws + WS_CTL) + 8192 + ph * 256 + (second ? 128 : 0); int ks = 0;
            for (;;) { const int it = next_item_q(ctrs, lds, wave0, 96, xcc, ks); if (it < 0) break; const int b = it >> 16, j = it & 0xffff;
                if (j < 64) mlocal_item(ws, lds, PIN(I_CONVW) + l * 1024, PIN(I_CONVB) + l * 256, PIN(I_BIG) + l * 4, PIN(I_BFG) + l * 4, b * 128 + 2 * j, wave0);
                else { const int k = j - 64; compress_item(ws, lds, PIN(I_CMPPOS) + l * 2048, ((k >> 4) << 7) | (b << 4) | (k & 15), wave0); } }
        }
        else if (ty == 3 && (PHM & 128)) {
            unsigned* ctrs = (unsigned*)(ws + WS_CTL) + 8192 + ph * 256 + (second ? 128 : 0); int ks = 0;
            for (;;) { const int it = next_item_q(ctrs, lds, wave0, second ? 64 : 100, xcc, ks); if (it < 0) break; const int b = it >> 16, j = it & 0xffff;
                if (second && (REP_MASK & (1 << 20)) && j >= 48) continue; if (second && (REP_MASK & (1 << 21)) && j < 48) continue;
                if (j < 18) mla_unit(ws, lds, b, j % 6, 7 - j / 6, wave0);
                else if (j < 34) cmp_unit(ws, lds, b, (j - 18) >> 3, 7 - ((j - 18) & 7), wave0);
                else if (j < 64) { const int u = j - 16; mla_unit(ws, lds, b, u % 6, 7 - u / 6, wave0); }
                else mscan_item(ws, b * 36 + (j - 64), wave0); }
        }
        else if (ty == 4 && (PHM & 256)) {
            unsigned* ctrs = (unsigned*)(ws + WS_CTL) + 8192 + ph * 256 + (second ? 128 : 0); int ks = 0;
            for (;;) { const int it = next_item_q(ctrs, lds, wave0, 160, xcc, ks); if (it < 0) break; const int b = it >> 16, j = it & 0xffff;
                if (second && (REP_MASK & (1 << 16)) && j >= 96) continue; if (second && (REP_MASK & (1 << 17)) && j < 96) continue;
                if (j < 36) nsa_branch_unit<AM_SLC>(ws, lds, b, j % 6, 7 - j / 6, wave0);
                else if (j < 84) nsa_branch_unit<AM_WINDOW>(ws, lds, b, (j - 36) % 6, 7 - (j - 36) / 6, wave0);
                else if (j < 96) { const int u = j - 48; nsa_branch_unit<AM_SLC>(ws, lds, b, u % 6, 7 - u / 6, wave0); }
                else mout_item(ws, lds, PIN(I_GMH) + l * 256, PIN(I_SKIP) + l * 256, b * 128 + 2 * (j - 96), wave0); }
        }
        else if (ty == 5) ph_mixnorm(p, l, TID_);
        else if (ty == 6 && (PHM & 8)) {
            pg8::Gemm g{(const bf16*)(ws + WS_HB), (const bf16*)(ws + WT_OUT), T_, D_, D_}; pg8::StaticOrder S; S.init(T_, D_, gridDim.x, blockIdx.x);
            pg8::EpiRes E{(l == 0) ? PIN(I_X) : p.k->out, p.k->out, modl + 2048};
            pg8::gemm_phase<pg8::EpiRes, pg8::StaticOrder, true, true>(lds, g, S, E, wave0);
        }
        else if (ty == 7) norm_rows(p.k->out, PIN(I_GN2) + l * D_, modl + 3072, modl + 4096, (bf16*)(ws + WS_HB), nullptr, 1, GW_, NGW_, fresh_lane());
        else if (ty == 8 && (PHM & 16)) {
            pg8::Gemm g{(const bf16*)(ws + WS_HB), (const bf16*)(ws + WT_GU), T_, 2 * FF, D_}; pg8::StaticOrder S; S.init(T_, 2 * FF, gridDim.x, blockIdx.x);
            pg8::EpiGU E{(bf16*)(ws + WS_ACT)};
            pg8::gemm_phase<pg8::EpiGU, pg8::StaticOrder, true, true>(lds, g, S, E, wave0);
            if (l + 1 < DEPTH) early_transposes(p, l + 1, lds, TID_, 1408 % (int)gridDim.x);
        }
        else if (ty == 9 && (PHM & 32)) {
            pg8::Gemm g{(const bf16*)(ws + WS_ACT), (const bf16*)(ws + WT_DOWN), T_, D_, FF}; pg8::StaticOrder S; S.init(T_, D_, gridDim.x, blockIdx.x);
            pg8::EpiRes E{p.k->out, p.k->out, modl + 5120};
            pg8::gemm_phase<pg8::EpiRes, pg8::StaticOrder, true, true>(lds, g, S, E, wave0);
        }
        if (REP_MASK != 0 && ty >= 0 && ((REP_MASK >> ty) & 1) && !second) { second = true; --ph; } else second = false;
        if (ph + 1 < ph_hi) xcd_barrier(bar, wave0 * 64 + fresh_lane());
    }
}

extern "C" void kernel_launch(void* const* d_in, const int* in_sizes, int n_in, void* d_out, int out_size, void* d_ws, size_t ws_size, hipStream_t stream) {
    if (n_in != N_IN || ws_size < WS_END) { fprintf(stderr, "kernel_launch: unexpected n_in %d / ws %zu\n", n_in, ws_size); return; }
    static int inited = 0;
    if (!inited) { if (hipFuncSetAttribute((const void*)mega, hipFuncAttributeMaxDynamicSharedMemorySize, LDS_BYTES) != hipSuccess) fprintf(stderr, "hipFuncSetAttribute failed\n"); inited = 1; }
    unsigned char* ws = (unsigned char*)d_ws;
    MP base{}; for (int i = 0; i < N_IN; ++i) base.in[i] = (const float*)d_in[i]; base.out = (float*)d_out; base.ws = ws;
    (void)hipMemsetAsync(ws + WS_CTL, 0, CTL_ZERO_BYTES, stream);
    static int grid = 0;
    if (!grid) {
        int dev = 0, cus = 0, per_cu = 0;
        (void)hipGetDevice(&dev); (void)hipDeviceGetAttribute(&cus, hipDeviceAttributeMultiprocessorCount, dev);
        if (hipOccupancyMaxActiveBlocksPerMultiprocessor(&per_cu, (const void*)mega, NTHR, LDS_BYTES) != hipSuccess || per_cu < 1) { fprintf(stderr, "kernel_launch: occupancy query says %d blocks per CU\n", per_cu); per_cu = 1; }
        (void)hipGetLastError();
        grid = cus;
    }
    MP a = base; a.ph_lo = 0; a.ph_hi = NPH; a.coop = 1;
    void* args[] = {&a};
    const hipError_t e = hipLaunchCooperativeKernel((const void*)mega, dim3(grid), dim3(NTHR), args, LDS_BYTES, stream);
    if (e != hipSuccess) fprintf(stderr, "kernel_launch: cooperative launch failed: %s (grid %d)\n", hipGetErrorString(e), grid);
}
```

```cpp
#include <hip/hip_runtime.h>
#include <cstdint>
#include <cstdio>
#include <type_traits>
#include <hip/hip_cooperative_groups.h>

constexpr int B_ = 8, S_ = 2048, T_ = B_ * S_, D_ = 1024, DIN = 2362, FF = 2816, DEPTH = 2;
constexpr float EPS = 1e-6f;
constexpr float LOG2E = 1.4426950408889634f;
constexpr float QSCALE = 0.125f * LOG2E;
constexpr float MSCALE = 0.10206207261596577f * LOG2E;
enum { I_X = 0, I_C, I_POS, I_GN1, I_GN2, I_WADA, I_BADA, I_WIN, I_CMPPOS, I_WCK, I_WCV, I_GOA, I_GQL, I_WUQ, I_GKVL, I_WUKV, I_GOB,
       I_CONVW, I_CONVB, I_WQM, I_WKM, I_BIG, I_BFG, I_GMH, I_SKIP, I_WOUT, I_WGU, I_WDOWN, I_GFIN, N_IN };

constexpr size_t MiB = 1u << 20;
constexpr size_t WS_CTL = 0;
constexpr size_t WS_MOD = 1 * MiB;
constexpr size_t WS_COSP = WS_MOD + 512 * 1024;
constexpr size_t WS_SINP = WS_COSP + 512 * 1024;
constexpr size_t WS_COSM = WS_SINP + 512 * 1024;
constexpr size_t WS_SINM = WS_COSM + 1 * MiB;
constexpr size_t WS_SSQL = WS_SINM + 1 * MiB;
constexpr size_t WS_SSKV = WS_SSQL + 64 * 1024;
constexpr size_t WS_ML = WS_SSKV + 64 * 1024;
constexpr size_t WS_BL = WS_ML + 4096;
constexpr size_t WS_MP = WS_BL + 4096;
constexpr size_t WS_NL = WS_MP + 4096;
constexpr size_t WS_WT = 8 * MiB;
constexpr size_t WS_RAW = WS_WT;
constexpr size_t WS_HB = 34 * MiB;
constexpr size_t WS_NSA = 66 * MiB;
constexpr size_t WS_KVL = 102 * MiB;
constexpr size_t WS_QL = 106 * MiB;
constexpr size_t WS_CM = 114 * MiB;
constexpr size_t WS_GM = 138 * MiB;
constexpr size_t WS_KM = 140 * MiB;
constexpr size_t WS_QM = 158 * MiB;
constexpr size_t WS_VM = 176 * MiB;
constexpr size_t WS_KCV = 188 * MiB;
constexpr size_t WS_OCMP = 189 * MiB;
constexpr size_t WS_SEL = 201 * MiB;
constexpr size_t WS_XC = 202 * MiB;
constexpr size_t WS_MQ = 210 * MiB;
constexpr size_t WS_MK = 218 * MiB;
constexpr size_t WS_CT = 226 * MiB;
constexpr size_t WS_MISCRAW = 242 * MiB;
constexpr size_t WS_KVM = 140 * MiB;
constexpr size_t WS_KR = 246 * MiB;
constexpr size_t WS_OSLC = 164 * MiB;
constexpr size_t WS_OWIN = 176 * MiB;
constexpr size_t WS_ACT = 66 * MiB;
constexpr size_t WS_END = 256 * MiB;
static_assert(WS_NL + 1024 * 64 * 4 <= WS_WT, "tab");
static_assert(WS_ACT + (size_t)T_ * FF * 2 <= WS_KCV, "act overlay");

typedef unsigned short bf16;
__device__ __forceinline__ float bf2f(bf16 v) { return __uint_as_float(((unsigned)v) << 16); }
__device__ __forceinline__ bf16 f2bf(float f) { unsigned u = __float_as_uint(f); return (bf16)((u + 0x7fffu + ((u >> 16) & 1u)) >> 16); }
__device__ __forceinline__ float sigmoidf_(float x) { return 1.f / (1.f + __expf(-x)); }
__device__ __forceinline__ float siluf_(float x) { return x / (1.f + __expf(-x)); }
__device__ __forceinline__ float wave_sum(float v) {
#pragma unroll
    for (int o = 1; o < 64; o <<= 1) v += __shfl_xor(v, o);
    return v;
}

__device__ __forceinline__ int fresh_lane() { int l; asm volatile("v_mbcnt_lo_u32_b32 %0, -1, 0\n\tv_mbcnt_hi_u32_b32 %0, -1, %0" : "=&v"(l)); return l; }
template <int M> __device__ __forceinline__ float sxf(float v) { static_assert(M >= 1 && M < 32, "swizzle xor mask"); return __int_as_float(__builtin_amdgcn_ds_swizzle(__float_as_int(v), (M << 10) | 0x1f)); }
__device__ __forceinline__ float red32_max(float v) { auto r = __builtin_amdgcn_permlane32_swap(__float_as_uint(v), __float_as_uint(v), false, false); return fmaxf(__uint_as_float(r[0]), __uint_as_float(r[1])); }
__device__ __forceinline__ float red32_sum(float v) { auto r = __builtin_amdgcn_permlane32_swap(__float_as_uint(v), __float_as_uint(v), false, false); return __uint_as_float(r[0]) + __uint_as_float(r[1]); }
__device__ __forceinline__ unsigned red32_or(unsigned v) { auto r = __builtin_amdgcn_permlane32_swap(v, v, false, false); return r[0] | r[1]; }
__device__ __forceinline__ float bperm(float v, int src_lane) { return __int_as_float(__builtin_amdgcn_ds_bpermute(src_lane << 2, __float_as_int(v))); }
__device__ __forceinline__ float wave_sum2(float v) { v += sxf<1>(v); v += sxf<2>(v); v += sxf<4>(v); v += sxf<8>(v); v += sxf<16>(v); return red32_sum(v); }
__device__ __forceinline__ float wave_max2(float v) { v = fmaxf(v, sxf<1>(v)); v = fmaxf(v, sxf<2>(v)); v = fmaxf(v, sxf<4>(v)); v = fmaxf(v, sxf<8>(v)); v = fmaxf(v, sxf<16>(v)); return red32_max(v); }
namespace pg8 {
#define PG8_LAS __attribute__((address_space(3)))
typedef unsigned short bf16_t;
typedef short bf16x8 __attribute__((ext_vector_type(8)));
typedef float f32x4 __attribute__((ext_vector_type(4)));
typedef unsigned u32x4 __attribute__((ext_vector_type(4)));
constexpr int BM = 256, BK = 64, HALF = 128, HTB = HALF * BK * 2  , STAGE_BYTES = 8 * HTB, NXCD = 8, WGM = 8;

__host__ __device__ __forceinline__ int lds_byte(int r, int c) { const int st = (r >> 4) * 2 + (c >> 5), rr = r & 15, cc = c & 31, ob = rr * 64 + cc * 2; return st * 1024 + (ob ^ (((ob >> 9) & 1) << 5)); }
__host__ __device__ __forceinline__ void stage_rc(int b, int& R, int& C) { const int st = b / 1024, sb = b % 1024, swz = sb ^ (((sb >> 9) & 1) << 5); R = (st >> 1) * 16 + swz / 64; C = (st & 1) * 32 + (swz % 64) / 2; }
__host__ __device__ __forceinline__ int perm32(int rho) { const int n = rho >> 4, i = rho & 15; return 8 * (i >> 2) + 4 * n + (i & 3); }

struct Unit { int pm, pn; };
struct Gemm { const bf16_t* A; const bf16_t* Bt; int M, N, K; };

struct StaticOrder {
    int nM, nN, nwg, G, c;
    __host__ __device__ void init(int M, int N, int G_, int c_) { nM = M / BM; nN = N / BM; nwg = nM * nN; G = G_; c = c_; }
    __host__ __device__ bool next(int i, Unit& u) const {
        const long L = (long)i * G + c; if (L >= nwg) return false;
        int wgid = (int)L; { const int q = nwg / NXCD, r = nwg % NXCD, xcd = wgid % NXCD, off = wgid / NXCD; wgid = (xcd < r ? xcd * (q + 1) : r * (q + 1) + (xcd - r) * q) + off; }
        const int nig = WGM * nN, gid = wgid / nig, fm = gid * WGM, gsz = (nM - fm) < WGM ? (nM - fm) : WGM;
        u.pm = fm + ((wgid % nig) % gsz); u.pn = (wgid % nig) / gsz; return true;
    }
    __device__ __forceinline__ void a_ready(const Unit&) const {}
    __device__ __forceinline__ void done(const Unit&) const {}
};

__device__ __forceinline__ unsigned cvt_pk_bf16(float lo, float hi) { unsigned r; asm volatile("v_cvt_pk_bf16_f32 %0, %1, %2" : "=v"(r) : "v"(lo), "v"(hi)); return r; }
typedef float f32x2 __attribute__((ext_vector_type(2)));

typedef unsigned u32x4 __attribute__((ext_vector_type(4)));
typedef unsigned u32x2 __attribute__((ext_vector_type(2)));
struct EpiIn {
    static constexpr bool PERM = true, AFTER_DRAIN = false;
    unsigned char* ws; const float *big, *bfg;
#define EPI_ROWS(...) _Pragma("unroll") for (int ai = 0; ai < 2; ++ai) _Pragma("unroll") for (int m = 0; m < 4; ++m) { \
        const int row = u.pm * BM + ai * HALF + wr * 64 + m * 16 + fr; float v[8]; \
        _Pragma("unroll") for (int i = 0; i < 4; ++i) { v[i] = acc[ai][bj][m][0][i]; v[4 + i] = acc[ai][bj][m][1][i]; } \
        asm volatile("" : "+v"(v[0]), "+v"(v[1]), "+v"(v[2]), "+v"(v[3]), "+v"(v[4]), "+v"(v[5]), "+v"(v[6]), "+v"(v[7])); \
        __VA_ARGS__ asm volatile("" ::: "memory"); }
#define EPI_PACK(w) u32x4 w; w.x = cvt_pk_bf16(v[0], v[1]); w.y = cvt_pk_bf16(v[2], v[3]); w.z = cvt_pk_bf16(v[4], v[5]); w.w = cvt_pk_bf16(v[6], v[7]);
    __device__ __forceinline__ void operator()(const f32x4 (&acc)[2][2][4][2], const Unit& u, int wr, int wc, int fr, int fq) const {
        half<0>(acc, u, wr, wc, fr, fq); half<1>(acc, u, wr, wc, fr, fq);
    }
    template <int bj> __device__ __forceinline__ void half(const f32x4 (&acc)[2][2][4][2], const Unit& u, int wr, int wc, int fr, int fq) const {
        {
            const int hb = 2 * u.pn + bj;
            int cb = 32 * wc + 8 * fq; asm volatile("" : "+v"(cb), "+v"(fr));
            if (hb <= 8) {
                bf16_t* nsa = (bf16_t*)(ws + WS_NSA) + hb * 128 + cb;
                const bool rope_hb = (hb <= 3) || hb == 5 || hb == 7;
                if (rope_hb) {
                    const float* cosP = (const float*)(ws + WS_COSP); const float* sinP = (const float*)(ws + WS_SINP);
                    const bool mine = ((wc & 1) == 0) && fq < 2; const float sg = (fq == 0) ? -1.f : 1.f; const float sc = (hb < 3) ? QSCALE : 1.f;
                    f32x4 tc0 = {0.f, 0.f, 0.f, 0.f}, tc1 = tc0, ts0 = tc0, ts1 = tc0;
                    if (mine) { const int r0 = u.pm * BM + wr * 64 + fr; tc0 = *(const f32x4*)(cosP + r0 * 8); tc1 = *(const f32x4*)(cosP + r0 * 8 + 4); ts0 = *(const f32x4*)(sinP + r0 * 8); ts1 = *(const f32x4*)(sinP + r0 * 8 + 4); }
                    EPI_ROWS({
                        float pv[8];
                        _Pragma("unroll") for (int i = 0; i < 8; ++i) pv[i] = sxf<16>(v[i]);
                        const f32x4 c0 = tc0, c1 = tc1, s0 = ts0, s1 = ts1;
                        if (mine && (ai * 4 + m) < 7) { const int nx = ai * 4 + m + 1; const int rn = u.pm * BM + (nx >> 2) * HALF + wr * 64 + (nx & 3) * 16 + fr;
                            tc0 = *(const f32x4*)(cosP + rn * 8); tc1 = *(const f32x4*)(cosP + rn * 8 + 4); ts0 = *(const f32x4*)(sinP + rn * 8); ts1 = *(const f32x4*)(sinP + rn * 8 + 4); }
                        if (mine) {
                            _Pragma("unroll") for (int i = 0; i < 4; ++i) { v[i] = v[i] * c0[i] + sg * pv[i] * s0[i]; v[4 + i] = v[4 + i] * c1[i] + sg * pv[4 + i] * s1[i]; }
                        }
                        _Pragma("unroll") for (int i = 0; i < 8; ++i) v[i] *= sc;
                        EPI_PACK(w) *(u32x4*)(nsa + (size_t)row * 1152) = w;
                    })
                } else {
                    EPI_ROWS({ EPI_PACK(w) *(u32x4*)(nsa + (size_t)row * 1152) = w; })
                }
            } else if (hb <= 11) {
                bf16_t* dst = (hb == 9) ? (bf16_t*)(ws + WS_KVL) + cb : (bf16_t*)(ws + WS_QL) + (hb - 10) * 128 + cb;
                const int ld = (hb == 9) ? 128 : 256;
                float* ssq = (hb == 9) ? (float*)(ws + WS_SSKV) : (float*)(ws + WS_SSQL);
                EPI_ROWS({ EPI_PACK(w) *(u32x4*)(dst + (size_t)row * ld) = w;
                    float sq = 0.f;
                    _Pragma("unroll") for (int i = 0; i < 8; ++i) sq += v[i] * v[i];
                    sq += sxf<16>(sq); sq = red32_sum(sq);
                    if (fq == 0) atomicAdd(ssq + row, sq); })
            } else if (hb <= 17) {
                bf16_t* cm = (bf16_t*)(ws + WS_CM) + (hb - 12) * 128 + cb;
                EPI_ROWS({ EPI_PACK(w) *(u32x4*)(cm + (size_t)row * 768) = w; })
            } else if (hb == 18) {
                float* mr = (float*)(ws + WS_MISCRAW) + cb;
                if (wc < 2) { EPI_ROWS({ *(f32x4*)(mr + (size_t)row * 64) = (f32x4){v[0], v[1], v[2], v[3]}; *(f32x4*)(mr + (size_t)row * 64 + 4) = (f32x4){v[4], v[5], v[6], v[7]}; }) }
            }
        }
    }
#undef EPI_ROWS
#undef EPI_PACK
};
struct EpiUKV {
    static constexpr bool PERM = true, AFTER_DRAIN = false;
    bf16_t* kvm; const float* sskv;
    __device__ __forceinline__ void operator()(const f32x4 (&acc)[2][2][4][2], const Unit& u, int wr, int wc, int fr, int fq) const {
        asm volatile("" : "+v"(fq), "+v"(fr));
        const int col0 = u.pn * BM + wc * 32 + 8 * fq;
        float rs8[8];
#pragma unroll
        for (int i = 0; i < 8; ++i) rs8[i] = sskv[u.pm * BM + (i >> 2) * HALF + wr * 64 + (i & 3) * 16 + fr];
#pragma unroll
        for (int i = 0; i < 8; ++i) rs8[i] = rsqrtf(rs8[i] * (1.f / 128.f) + EPS);
#pragma unroll
        for (int ai = 0; ai < 2; ++ai)
#pragma unroll
            for (int m = 0; m < 4; ++m) { const int row = u.pm * BM + ai * HALF + wr * 64 + m * 16 + fr; bf16_t* rowp = kvm + (size_t)row * 768 + col0;
                const float rs = rs8[ai * 4 + m];
#pragma unroll
                for (int bj = 0; bj < 2; ++bj) { const f32x4 a = acc[ai][bj][m][0] * rs, b = acc[ai][bj][m][1] * rs;
                    u32x4 w; w.x = cvt_pk_bf16(a[0], a[1]); w.y = cvt_pk_bf16(a[2], a[3]); w.z = cvt_pk_bf16(b[0], b[1]); w.w = cvt_pk_bf16(b[2], b[3]);
                    *(u32x4*)(rowp + bj * HALF) = w; } }
    }
};
struct EpiPlain {
    static constexpr bool PERM = true, AFTER_DRAIN = false;
    bf16_t* out; int ld;
    __device__ __forceinline__ void operator()(const f32x4 (&acc)[2][2][4][2], const Unit& u, int wr, int wc, int fr, int fq) const {
        asm volatile("" : "+v"(fq), "+v"(fr));
        const int col0 = u.pn * BM + wc * 32 + 8 * fq;
#pragma unroll
        for (int ai = 0; ai < 2; ++ai)
#pragma unroll
            for (int m = 0; m < 4; ++m) { bf16_t* rowp = out + (size_t)(u.pm * BM + ai * HALF + wr * 64 + m * 16 + fr) * ld + col0;
#pragma unroll
                for (int bj = 0; bj < 2; ++bj) { const f32x4 a = acc[ai][bj][m][0], b = acc[ai][bj][m][1];
                    u32x4 w; w.x = cvt_pk_bf16(a[0], a[1]); w.y = cvt_pk_bf16(a[2], a[3]); w.z = cvt_pk_bf16(b[0], b[1]); w.w = cvt_pk_bf16(b[2], b[3]);
                    *(u32x4*)(rowp + bj * HALF) = w; } }
    }
};
struct EpiRes {
    static constexpr bool PERM = false, AFTER_DRAIN = false;
    const float* xin_f; const bf16_t* xin_b; bf16_t* xout; const float* gate;
    __device__ __forceinline__ void operator()(const f32x4 (&acc)[2][2][4][2], const Unit& u, int wr, int wc, int fr, int fq) const {
        asm volatile("" : "+v"(fq), "+v"(fr));
        const int b = (u.pm * BM) / S_; const int col0 = u.pn * BM + wc * 32 + 4 * fq;
        f32x4 gv[2][2];
#pragma unroll
        for (int bj = 0; bj < 2; ++bj)
#pragma unroll
            for (int n = 0; n < 2; ++n) gv[bj][n] = *(const f32x4*)(gate + (size_t)b * 6144 + col0 + bj * HALF + n * 16);
        if (xin_f != nullptr) {
#pragma unroll
            for (int ai = 0; ai < 2; ++ai)
#pragma unroll
                for (int m = 0; m < 4; ++m) { const size_t off = (size_t)(u.pm * BM + ai * HALF + wr * 64 + m * 16 + fr) * D_ + col0;
#pragma unroll
                    for (int bj = 0; bj < 2; ++bj)
#pragma unroll
                        for (int n = 0; n < 2; ++n) { const f32x4 xi = *(const f32x4*)(xin_f + off + bj * HALF + n * 16); const f32x4 r = xi + gv[bj][n] * acc[ai][bj][m][n];
                            u32x2 w; w.x = cvt_pk_bf16(r[0], r[1]); w.y = cvt_pk_bf16(r[2], r[3]); *(u32x2*)(xout + off + bj * HALF + n * 16) = w; } }
        } else {
#pragma unroll
            for (int ai = 0; ai < 2; ++ai)
#pragma unroll
                for (int m = 0; m < 4; ++m) { const size_t off = (size_t)(u.pm * BM + ai * HALF + wr * 64 + m * 16 + fr) * D_ + col0;
                    u32x2 xr[2][2];
#pragma unroll
                    for (int bj = 0; bj < 2; ++bj)
#pragma unroll
                        for (int n = 0; n < 2; ++n) xr[bj][n] = *(const u32x2*)(xin_b + off + bj * HALF + n * 16);
#pragma unroll
                    for (int bj = 0; bj < 2; ++bj)
#pragma unroll
                        for (int n = 0; n < 2; ++n) { const u32x2 q = xr[bj][n]; const f32x4 a = acc[ai][bj][m][n], g4 = gv[bj][n];
                            const float r0 = __uint_as_float(q.x << 16) + g4[0] * a[0], r1 = __uint_as_float(q.x & 0xffff0000u) + g4[1] * a[1];
                            const float r2 = __uint_as_float(q.y << 16) + g4[2] * a[2], r3 = __uint_as_float(q.y & 0xffff0000u) + g4[3] * a[3];
                            u32x2 w; w.x = cvt_pk_bf16(r0, r1); w.y = cvt_pk_bf16(r2, r3); *(u32x2*)(xout + off + bj * HALF + n * 16) = w; } }
        }
    }
};
struct EpiGU {
    static constexpr bool PERM = true, AFTER_DRAIN = false;
    bf16_t* act;
    __device__ __forceinline__ void operator()(const f32x4 (&acc)[2][2][4][2], const Unit& u, int wr, int wc, int fr, int fq) const {
        asm volatile("" : "+v"(fq), "+v"(fr));
        const int col0 = u.pn * HALF + wc * 32 + 8 * fq;
#pragma unroll
        for (int ai = 0; ai < 2; ++ai)
#pragma unroll
            for (int m = 0; m < 4; ++m) { const int row = u.pm * BM + ai * HALF + wr * 64 + m * 16 + fr; float o[8];
#pragma unroll
                for (int n = 0; n < 2; ++n)
#pragma unroll
                    for (int i = 0; i < 4; ++i) { const float g = acc[ai][0][m][n][i], up = acc[ai][1][m][n][i]; o[4 * n + i] = g / (1.f + __expf(-g)) * up; }
                u32x4 w; w.x = cvt_pk_bf16(o[0], o[1]); w.y = cvt_pk_bf16(o[2], o[3]); w.z = cvt_pk_bf16(o[4], o[5]); w.w = cvt_pk_bf16(o[6], o[7]);
                *(u32x4*)(act + (size_t)row * FF + col0) = w; }
    }
};
template <class Epi, class Sched, bool ALIGN_EPI = false, bool SP2 = false>
__device__ __forceinline__ void gemm_phase(PG8_LAS unsigned char* lds, const Gemm g, const Sched& S, const Epi& E, int wid_in) {
    const int wid = __builtin_amdgcn_readfirstlane(wid_in), lane = fresh_lane(), tid = wid * 64 + lane, wr = wid >> 2, wc = wid & 3;
    const int K = g.K, nt = K / BK;
    unsigned voffA[2], voffB[2];
#pragma unroll
    for (int i = 0; i < 2; ++i) { int R, C; stage_rc(tid * 16 + i * 8192, R, C); const int Rb = Epi::PERM ? ((R & ~31) + perm32(R & 31)) : R;
        voffA[i] = (unsigned)(R * K + C) * 2u; voffB[i] = (unsigned)(Rb * K + C) * 2u; }
    const size_t kstep = (size_t)(BK * 2);
    const size_t hstep = (size_t)HALF * K * 2;
    const size_t tstep = 2 * hstep;
    const unsigned ldsw = (unsigned)wid * 1024u;
    const int aoff = lds_byte(wr * 64 + (lane & 15), (lane >> 4) * 8), boff = lds_byte(wc * 32 + (lane & 15), (lane >> 4) * 8);
#define PG8_SA(b, h) (((b) * 2 + (h)) * HTB)
#define PG8_SB(b, h) ((4 + (b) * 2 + (h)) * HTB)
#define PG8_STAGE(bufoff, gbase, voff) do { _Pragma("unroll") for (int _i = 0; _i < 2; ++_i) \
        __builtin_amdgcn_global_load_lds((const unsigned*)((const char*)(gbase) + (voff)[_i]), (PG8_LAS unsigned*)(lds + (bufoff) + ldsw + _i * 8192), 16, 0, 0); } while (0)
#define PG8_LDA(dst, b, h) do { _Pragma("unroll") for (int m = 0; m < 4; ++m) _Pragma("unroll") for (int k = 0; k < 2; ++k) dst[m][k] = *(const PG8_LAS bf16x8*)(lds + PG8_SA(b, h) + aoff + m * 2048 + k * 1024); } while (0)
#define PG8_LDB(dst, b, h) do { _Pragma("unroll") for (int n = 0; n < 2; ++n) _Pragma("unroll") for (int k = 0; k < 2; ++k) dst[n][k] = *(const PG8_LAS bf16x8*)(lds + PG8_SB(b, h) + boff + n * 2048 + k * 1024); } while (0)
#define PG8_MMA(ai, bj, At, Bt) do { __builtin_amdgcn_s_setprio(1); _Pragma("unroll") for (int m = 0; m < 4; ++m) _Pragma("unroll") for (int n = 0; n < 2; ++n) _Pragma("unroll") for (int k = 0; k < 2; ++k) \
        acc[ai][bj][m][n] = __builtin_amdgcn_mfma_f32_16x16x32_bf16(Bt[n][k], At[m][k], acc[ai][bj][m][n], 0, 0, 0); __builtin_amdgcn_s_setprio(0); } while (0)
#define PG8_WAIT_V(n) asm volatile("s_waitcnt vmcnt(" #n ")" ::: "memory")
#define PG8_WAIT_L(n) asm volatile("s_waitcnt lgkmcnt(" #n ")" ::: "memory")
#define PG8_BAR __builtin_amdgcn_s_barrier()
#define PG8_SCHED __builtin_amdgcn_sched_barrier(0)
    Unit cur, nxt; int ui = 0;
    if (!S.next(0, cur)) return;
    f32x4 acc[2][2][4][2];
#pragma unroll
    for (int a = 0; a < 2; ++a)
#pragma unroll
        for (int b = 0; b < 2; ++b)
#pragma unroll
            for (int m = 0; m < 4; ++m)
#pragma unroll
                for (int n = 0; n < 2; ++n) acc[a][b][m][n] = (f32x4){0.f, 0.f, 0.f, 0.f};
    bf16x8 At[4][2], B0[2][2], B1[2][2];
    const char* cA = (const char*)g.A + (size_t)cur.pm * tstep; const char* cB = (const char*)g.Bt + (size_t)cur.pn * tstep;
    S.a_ready(cur);
    if constexpr (SP2) {
        PG8_STAGE(PG8_SB(0, 0), cB, voffB); PG8_STAGE(PG8_SB(0, 1), cB + hstep, voffB); PG8_STAGE(PG8_SA(0, 0), cA, voffA); PG8_STAGE(PG8_SA(0, 1), cA + hstep, voffA);
        if (wr == 1) PG8_BAR;
        PG8_WAIT_V(2); PG8_BAR;
        PG8_STAGE(PG8_SB(1, 0), cB + kstep, voffB); PG8_STAGE(PG8_SA(1, 0), cA + kstep, voffA); PG8_STAGE(PG8_SB(1, 1), cB + hstep + kstep, voffB);
        PG8_WAIT_V(6); PG8_BAR;
    } else {
        PG8_STAGE(PG8_SB(0, 0), cB, voffB); PG8_STAGE(PG8_SA(0, 0), cA, voffA); PG8_STAGE(PG8_SB(0, 1), cB + hstep, voffB); PG8_STAGE(PG8_SA(0, 1), cA + hstep, voffA);
        if (wr == 1) PG8_BAR;
        PG8_WAIT_V(4); PG8_BAR;
        PG8_STAGE(PG8_SB(1, 0), cB + kstep, voffB); PG8_STAGE(PG8_SA(1, 0), cA + kstep, voffA); PG8_STAGE(PG8_SB(1, 1), cB + hstep + kstep, voffB);
        PG8_WAIT_V(6); PG8_BAR;
    }
    for (;;) {
        const bool has_next = S.next(ui + 1, nxt);
        const char* nA = has_next ? (const char*)g.A + (size_t)nxt.pm * tstep : cA; const char* nB = has_next ? (const char*)g.Bt + (size_t)nxt.pn * tstep : cB;
        for (int t = 0; t < nt; t += 2) {
            const bool last = (t == nt - 2);
            const char* a1 = cA + (size_t)(t + 1) * kstep;
            const char* a2 = last ? nA : cA + (size_t)(t + 2) * kstep; const char* b2 = last ? nB : cB + (size_t)(t + 2) * kstep;
            const char* a3 = a2 + kstep; const char* b3 = b2 + kstep;
            if (last && has_next) S.a_ready(nxt);
            if constexpr (SP2) {
            PG8_LDB(B0, 0, 0); PG8_LDB(B1, 0, 1); PG8_SCHED; PG8_LDA(At, 0, 0); PG8_STAGE(PG8_SA(1, 1), a1 + hstep, voffA);
            PG8_WAIT_V(8); PG8_WAIT_L(0); PG8_BAR; PG8_MMA(0, 0, At, B0); PG8_MMA(0, 1, At, B1); PG8_BAR; PG8_SCHED;
            PG8_LDA(At, 0, 1); PG8_STAGE(PG8_SB(0, 0), b2, voffB); PG8_STAGE(PG8_SB(0, 1), b2 + hstep, voffB); PG8_STAGE(PG8_SA(0, 0), a2, voffA);
            PG8_WAIT_V(8); PG8_WAIT_L(0); PG8_BAR; PG8_MMA(1, 0, At, B0); PG8_MMA(1, 1, At, B1); PG8_BAR; PG8_SCHED;
            PG8_LDB(B0, 1, 0); PG8_LDB(B1, 1, 1); PG8_SCHED; PG8_LDA(At, 1, 0); PG8_STAGE(PG8_SA(0, 1), a2 + hstep, voffA);
            PG8_WAIT_V(8); PG8_WAIT_L(0); PG8_BAR; PG8_MMA(0, 0, At, B0); PG8_MMA(0, 1, At, B1); PG8_BAR; PG8_SCHED;
            PG8_LDA(At, 1, 1); PG8_STAGE(PG8_SB(1, 0), b3, voffB); PG8_STAGE(PG8_SB(1, 1), b3 + hstep, voffB); PG8_STAGE(PG8_SA(1, 0), a3, voffA);
            PG8_WAIT_V(8); PG8_WAIT_L(0); PG8_BAR; PG8_MMA(1, 0, At, B0); PG8_MMA(1, 1, At, B1); PG8_BAR; PG8_SCHED;
            } else {
            PG8_LDB(B0, 0, 0); PG8_SCHED; PG8_LDA(At, 0, 0); PG8_STAGE(PG8_SA(1, 1), a1 + hstep, voffA);
            PG8_WAIT_L(8); PG8_BAR; PG8_WAIT_L(0); PG8_MMA(0, 0, At, B0); PG8_BAR; PG8_SCHED;
            PG8_LDB(B1, 0, 1); PG8_STAGE(PG8_SB(0, 0), b2, voffB);
            PG8_BAR; PG8_WAIT_L(0); PG8_MMA(0, 1, At, B1); PG8_BAR;
            PG8_LDA(At, 0, 1); PG8_STAGE(PG8_SA(0, 0), a2, voffA);
            PG8_BAR; PG8_WAIT_L(0); PG8_MMA(1, 0, At, B0); PG8_BAR; PG8_SCHED;
            PG8_STAGE(PG8_SB(0, 1), b2 + hstep, voffB);
            PG8_WAIT_V(6); PG8_BAR; PG8_MMA(1, 1, At, B1); PG8_BAR;
            PG8_LDB(B0, 1, 0); PG8_SCHED; PG8_LDA(At, 1, 0); PG8_STAGE(PG8_SA(0, 1), a2 + hstep, voffA);
            PG8_WAIT_L(8); PG8_BAR; PG8_WAIT_L(0); PG8_MMA(0, 0, At, B0); PG8_BAR; PG8_SCHED;
            PG8_LDB(B1, 1, 1); PG8_STAGE(PG8_SB(1, 0), b3, voffB);
            PG8_BAR; PG8_WAIT_L(0); PG8_MMA(0, 1, At, B1); PG8_BAR;
            PG8_LDA(At, 1, 1); PG8_STAGE(PG8_SA(1, 0), a3, voffA);
            PG8_BAR; PG8_WAIT_L(0); PG8_MMA(1, 0, At, B0); PG8_BAR; PG8_SCHED;
            PG8_STAGE(PG8_SB(1, 1), b3 + hstep, voffB);
            PG8_WAIT_V(6); PG8_BAR; PG8_MMA(1, 1, At, B1); PG8_BAR;
            }
        }
        if constexpr (ALIGN_EPI) { if (wr == 0) PG8_BAR; }
        if constexpr (!Epi::AFTER_DRAIN) { const int ln = fresh_lane(); E(acc, cur, wr, wc, ln & 15, ln >> 4); S.done(cur); }
        if (!has_next) break;
#pragma unroll
        for (int a = 0; a < 2; ++a)
#pragma unroll
            for (int b = 0; b < 2; ++b)
#pragma unroll
                for (int m = 0; m < 4; ++m)
#pragma unroll
                    for (int n = 0; n < 2; ++n) acc[a][b][m][n] = (f32x4){0.f, 0.f, 0.f, 0.f};
        cur = nxt; cA = nA; cB = nB; ++ui;
        if constexpr (ALIGN_EPI) { if (wr == 1) PG8_BAR; }
    }
    PG8_WAIT_V(0);
    if constexpr (!ALIGN_EPI) { if (wr == 0) PG8_BAR; }
    PG8_BAR;
    if constexpr (Epi::AFTER_DRAIN) { const int ln = fresh_lane(); E.fused(acc, cur, wr, wc, ln & 15, ln >> 4, lds, wid, ln); S.done(cur); }
#undef PG8_SA
#undef PG8_SB
#undef PG8_STAGE
#undef PG8_LDA
#undef PG8_LDB
#undef PG8_MMA
#undef PG8_WAIT_V
#undef PG8_WAIT_L
#undef PG8_BAR
#undef PG8_SCHED
}
}

#define GAS __attribute__((address_space(1)))
#define LAS __attribute__((address_space(3)))
typedef float f32x4 __attribute__((ext_vector_type(4)));
typedef unsigned v4u __attribute__((ext_vector_type(4)));
typedef GAS unsigned gu32;
#define XB_TMO      128
#define XB_XCNT(j)  (256  + 64 * (j))
#define XB_XSUB(j)  (1280 + 64 * (j))
#define XB_XGEN(j)  (2304 + 64 * (j))
#define XB_TOP      3328
#define XB_TOPGEN   3392
#define XCD_BAR_WORDS 3456
#define XB_SPIN_CAP (1u << 18)

__device__ __forceinline__ unsigned xb_ld(unsigned* p)              { return __hip_atomic_load(p, __ATOMIC_RELAXED, __HIP_MEMORY_SCOPE_AGENT); }
__device__ __forceinline__ unsigned xb_add(unsigned* p, unsigned v) { return __hip_atomic_fetch_add(p, v, __ATOMIC_RELAXED, __HIP_MEMORY_SCOPE_AGENT); }
__device__ __forceinline__ unsigned xb_xcc_id() { return (unsigned)__builtin_amdgcn_s_getreg((3 << 11) | 20) & 0xFu; }
#define XB_SPIN(cond, bar) do { unsigned _sp = 0; while (cond) { __builtin_amdgcn_s_sleep(1); \
    if ((++_sp & 255u) == 0u) { if (xb_ld(&(bar)[XB_TMO])) break; if (_sp > XB_SPIN_CAP) { atomicAdd(&(bar)[XB_TMO], 1u); break; } } } } while (0)

struct XcdBarrier {
    unsigned* bar; unsigned x;
    volatile LAS unsigned* st;
};

__device__ __forceinline__ XcdBarrier xcd_barrier_post(unsigned* bar, volatile LAS unsigned* st, int tid) {
    XcdBarrier b; b.bar = bar; b.x = xb_xcc_id(); b.st = st;
    if (tid == 0) (void)xb_add(&bar[XB_XCNT(b.x)], 1u);
    return b;
}
__device__ __forceinline__ void xcd_barrier_complete(unsigned* bar, unsigned x, unsigned& nloc, unsigned& nx) {
    const unsigned G = gridDim.x * gridDim.y * gridDim.z;
    unsigned sum, cnt, mine, sp = 0u;
    for (;;) {
        sum = 0u; cnt = 0u; mine = 0u;
#pragma unroll
        for (unsigned j = 0; j < 16; ++j) { const unsigned c = xb_ld(&bar[XB_XCNT(j)]); sum += c; cnt += (c > 0u) ? 1u : 0u; mine = (j == x) ? c : mine; }
        if (sum == G) break;
        __builtin_amdgcn_s_sleep(1);
        if ((++sp & 255u) == 0u) { if (xb_ld(&bar[XB_TMO])) break; if (sp > XB_SPIN_CAP) { atomicAdd(&bar[XB_TMO], 1u); break; } }
    }
    nloc = mine > 0u ? mine : 1u; nx = cnt > 0u ? cnt : 1u;
}

__device__ __forceinline__ void xcd_barrier(const XcdBarrier& b, int tid) {
    asm volatile("s_waitcnt vmcnt(0)" ::: "memory");
    __syncthreads();
    if (tid == 0) {
        unsigned* bar = b.bar;
        __builtin_amdgcn_s_waitcnt(0);
        unsigned nloc = b.st[0], nx = b.st[1];
        if (nloc == 0u) { xcd_barrier_complete(bar, b.x, nloc, nx); b.st[0] = nloc; b.st[1] = nx; }
        const unsigned old = xb_add(&bar[XB_XSUB(b.x)], 1u);
        const unsigned gen = old / nloc;
        if (old + 1u == (gen + 1u) * nloc) {
            __builtin_amdgcn_fence(__ATOMIC_RELEASE, "agent");
            asm volatile("s_waitcnt vmcnt(0)" ::: "memory");
            const unsigned og = xb_add(&bar[XB_TOP], 1u);
            const unsigned tg = og / nx;
            if (og + 1u == (tg + 1u) * nx) xb_add(&bar[XB_TOPGEN], 1u);
            else XB_SPIN(xb_ld(&bar[XB_TOPGEN]) == tg, bar);
            __builtin_amdgcn_fence(__ATOMIC_ACQUIRE, "agent");
            xb_add(&bar[XB_XGEN(b.x)], 1u);
            asm volatile("s_waitcnt vmcnt(0)" ::: "memory");
        } else {
            XB_SPIN(xb_ld(&bar[XB_XGEN(b.x)]) == gen, bar);
            __builtin_amdgcn_fence(__ATOMIC_ACQUIRE, "agent");
            asm volatile("s_waitcnt vmcnt(0)" ::: "memory");
        }
    }
    __syncthreads();
}

constexpr int NTHR = 512, NWAVES = 8;
constexpr int RING_BYTES = 131072, MISC_OFF = RING_BYTES + 320, LDS_BYTES = 147456;
constexpr int CW_BAR = 4096;
constexpr size_t CTL_ZERO_BYTES = 64 * 1024;
constexpr size_t WT_IN = WS_WT, WT_OUT = WT_IN + (size_t)2560 * 1024 * 2, WT_GU = WT_OUT + (size_t)1024 * 1024 * 2, WT_DOWN = WT_GU + (size_t)5632 * 1024 * 2,
                 WT_UQ = WT_DOWN + (size_t)1024 * 2816 * 2, WT_UKV = WT_UQ + (size_t)768 * 256 * 2, WT_CK = WT_UKV + (size_t)768 * 128 * 2, WT_CV = WT_CK + (size_t)64 * 2048 * 2,
                 WT_QM = WT_CV + (size_t)64 * 2048 * 2, WT_KM = WT_QM + 4 * 64 * 64 * 2, WT_END = WT_KM + 4 * 64 * 64 * 2;
static_assert(WT_END <= WS_HB, "weights");
constexpr int NPH = 22, PPL = 10;
constexpr int PROBE_SEL = 0;
constexpr int REP_MASK = 0;
#ifndef PHM
#define PHM 0xffff
#endif
struct MP { const float* in[N_IN]; float* out; unsigned char* ws; int ph_lo, ph_hi, coop, pad; };

struct MPK {
    const __attribute__((address_space(4))) MP* k;
    struct InArr { const __attribute__((address_space(4))) MP* k; __device__ __forceinline__ const float* operator[](int i) const { return k->in[i]; } };
    __device__ __forceinline__ InArr in_() const { return InArr{k}; }
};
#define PIN(i) (p.k->in[i])
__device__ __forceinline__ unsigned pk2(float lo, float hi) { return (unsigned)f2bf(lo) | ((unsigned)f2bf(hi) << 16); }
struct MapId { int n; __device__ __forceinline__ int operator()(int c) const { return c < n ? c : -1; } };
struct MapIn { __device__ __forceinline__ int operator()(int c) const {
    if (c < 1152) return c; if (c < 1280) return 1426 + (c - 1152); if (c < 1536) return 1170 + (c - 1280); if (c < 2304) return 1586 + (c - 1536);
    if (c < 2336) return 1554 + (c - 2304); if (c < 2354) return 1152 + (c - 2336); if (c < 2362) return c; return -1; } };
struct MapGU { __device__ __forceinline__ int operator()(int c) const { const int t = c >> 8, w = c & 255; return (w < 128) ? t * 128 + w : FF + t * 128 + (w - 128); } };
template <class Map> __device__ __forceinline__ void transpose_item(const float* W, int K, int ldw, const Map& map, const float* kscale, bf16* WT, LAS float* scr, int item, int nblk, int lane) {
    const int kb = item / nblk, nb = item % nblk, k0 = 64 * kb, n0 = 32 * nb;
    const int np = 2 * (lane & 15);
    const int sc = map(n0 + np);
    float2 tv[16];
#pragma unroll
    for (int i = 0; i < 16; ++i) { const int kk = 4 * i + (lane >> 4); tv[i] = (sc >= 0) ? *(const float2*)(W + (size_t)(k0 + kk) * ldw + sc) : make_float2(0.f, 0.f); }
    asm volatile("" : "+v"(tv[0]), "+v"(tv[1]), "+v"(tv[2]), "+v"(tv[3]), "+v"(tv[4]), "+v"(tv[5]), "+v"(tv[6]), "+v"(tv[7]));
    asm volatile("" : "+v"(tv[8]), "+v"(tv[9]), "+v"(tv[10]), "+v"(tv[11]), "+v"(tv[12]), "+v"(tv[13]), "+v"(tv[14]), "+v"(tv[15]));
#pragma unroll
    for (int i = 0; i < 16; ++i) { const int kk = 4 * i + (lane >> 4); float2 v = tv[i];
        if (kscale) { const float ksc = kscale[k0 + kk]; v.x *= ksc; v.y *= ksc; } scr[kk * 33 + np] = v.x; scr[kk * 33 + np + 1] = v.y; }
    asm volatile("s_waitcnt lgkmcnt(0)" ::: "memory");
    const int c = lane & 7;
#pragma unroll
    for (int j = 0; j < 4; ++j) { const int n = (lane >> 3) + 8 * j; const LAS float* s = scr + (8 * c) * 33 + n;
        v4u o; o.x = pk2(s[0 * 33], s[1 * 33]); o.y = pk2(s[2 * 33], s[3 * 33]); o.z = pk2(s[4 * 33], s[5 * 33]); o.w = pk2(s[6 * 33], s[7 * 33]);
        *(v4u*)(WT + (size_t)(n0 + n) * K + k0 + 8 * c) = o; }
    asm volatile("s_waitcnt lgkmcnt(0)" ::: "memory");
}
typedef unsigned u2raw __attribute__((ext_vector_type(2)));
__device__ __forceinline__ float4 unpk4(uint2 q) { return make_float4(__uint_as_float(q.x << 16), __uint_as_float(q.x & 0xffff0000u), __uint_as_float(q.y << 16), __uint_as_float(q.y & 0xffff0000u)); }
template <bool XBF> __device__ __forceinline__ void norm_rows(const void* xv, const float* g, const float* shift, const float* scale, bf16* hb, int gw, int ngw, int lane) {
    const int rpw = T_ / ngw, m0 = gw * rpw, b = m0 / S_;
    float4 gs[4], sh[4];
#pragma unroll
    for (int j = 0; j < 4; ++j) { const int col = 4 * lane + 256 * j; gs[j] = *(const float4*)(g + col);
        const float4 sc = *(const float4*)(scale + (size_t)b * 6144 + col); sh[j] = *(const float4*)(shift + (size_t)b * 6144 + col);
        gs[j].x *= 1.f + sc.x; gs[j].y *= 1.f + sc.y; gs[j].z *= 1.f + sc.z; gs[j].w *= 1.f + sc.w; }
    typedef typename std::conditional<XBF, uint2, float4>::type raw_t;
    const raw_t* x = (const raw_t*)xv;
    raw_t nv[4], nw[4];
    { const raw_t* xr = x + (size_t)m0 * (D_ / 4) + lane;
#pragma unroll
      for (int j = 0; j < 4; ++j) { nv[j] = xr[64 * j]; nw[j] = xr[D_ / 4 + 64 * j]; } }
    for (int r = 0; r < rpw; r += 2) {
        const int m = m0 + r;
        float4 v[4], w[4]; float s = 0.f, s2 = 0.f;
#pragma unroll
        for (int j = 0; j < 4; ++j) { if constexpr (XBF) { v[j] = unpk4(nv[j]); w[j] = unpk4(nw[j]); } else { v[j] = nv[j]; w[j] = nw[j]; } }
        if (r + 2 < rpw) { const raw_t* xr = x + (size_t)(m + 2) * (D_ / 4) + lane;
#pragma unroll
            for (int j = 0; j < 4; ++j) { nv[j] = xr[64 * j]; nw[j] = xr[D_ / 4 + 64 * j]; } }
#pragma unroll
        for (int j = 0; j < 4; ++j) { s += v[j].x * v[j].x + v[j].y * v[j].y + v[j].z * v[j].z + v[j].w * v[j].w; s2 += w[j].x * w[j].x + w[j].y * w[j].y + w[j].z * w[j].z + w[j].w * w[j].w; }
        const float r1 = rsqrtf(wave_sum2(s) * (1.f / D_) + EPS), r2 = rsqrtf(wave_sum2(s2) * (1.f / D_) + EPS);
#pragma unroll
        for (int j = 0; j < 4; ++j) {
            const int col = 4 * lane + 256 * j;
            float4 o, o2;
            o.x = v[j].x * r1 * gs[j].x + sh[j].x; o.y = v[j].y * r1 * gs[j].y + sh[j].y; o.z = v[j].z * r1 * gs[j].z + sh[j].z; o.w = v[j].w * r1 * gs[j].w + sh[j].w;
            o2.x = w[j].x * r2 * gs[j].x + sh[j].x; o2.y = w[j].y * r2 * gs[j].y + sh[j].y; o2.z = w[j].z * r2 * gs[j].z + sh[j].z; o2.w = w[j].w * r2 * gs[j].w + sh[j].w;
            uint2 q; q.x = pk2(o.x, o.y); q.y = pk2(o.z, o.w); *(uint2*)(hb + (size_t)m * D_ + col) = q;
            uint2 q2; q2.x = pk2(o2.x, o2.y); q2.y = pk2(o2.z, o2.w); *(uint2*)(hb + (size_t)(m + 1) * D_ + col) = q2;
        }
    }
}
__device__ __forceinline__ void final_load(const bf16* xb, LAS unsigned char* lds, int tid) {
    const int rows = T_ / (int)gridDim.x; const v4u* src = (const v4u*)(xb + (size_t)blockIdx.x * rows * D_);
    const int n16 = rows * (D_ / 8);
    for (int i0 = 0; i0 < n16; i0 += 8 * NTHR) {
        v4u t[8];
#pragma unroll
        for (int k = 0; k < 8; ++k) { const int i = i0 + k * NTHR + tid; t[k] = (i < n16) ? src[i] : v4u{0u, 0u, 0u, 0u}; }
#pragma unroll
        for (int k = 0; k < 8; ++k) { const int i = i0 + k * NTHR + tid; if (i < n16) *(LAS v4u*)(lds + (size_t)i * 16) = t[k]; }
    }
}
__device__ __forceinline__ void final_store(const float* g, float* out, LAS const unsigned char* lds, int tid) {
    const int rows = T_ / (int)gridDim.x, wave = tid >> 6, lane = tid & 63;
    float4 gs[4];
#pragma unroll
    for (int j = 0; j < 4; ++j) gs[j] = *(const float4*)(g + 4 * lane + 256 * j);
    for (int r = wave; r < rows; r += NWAVES) {
        float4 v[4]; float s = 0.f;
#pragma unroll
        for (int j = 0; j < 4; ++j) { const u2raw q = *(LAS const u2raw*)(lds + (size_t)r * (D_ * 2) + 8 * lane + 512 * j); v[j] = unpk4(make_uint2(q.x, q.y)); s += v[j].x * v[j].x + v[j].y * v[j].y + v[j].z * v[j].z + v[j].w * v[j].w; }
        const float r1 = rsqrtf(wave_sum2(s) * (1.f / D_) + EPS);
        float* o = out + ((size_t)blockIdx.x * rows + r) * D_ + 4 * lane;
#pragma unroll
        for (int j = 0; j < 4; ++j) *(float4*)(o + 256 * j) = make_float4(v[j].x * r1 * gs[j].x, v[j].y * r1 * gs[j].y, v[j].z * r1 * gs[j].z, v[j].w * r1 * gs[j].w);
    }
}
__device__ __forceinline__ void ph_p0(const MPK& p, LAS unsigned char* lds, int tid) {
    const int wave = tid >> 6, lane = tid & 63;
    LAS float* ca = (LAS float*)lds; LAS float* red = ca + 8192;
    unsigned char* ws = p.k->ws; float* mod = (float*)(ws + WS_MOD);
    const float* c = PIN(I_C);
    for (int i = tid; i < 8192; i += NTHR) ca[i] = siluf_(c[i]);
    __syncthreads();
    for (int item = blockIdx.x; item < 96; item += gridDim.x) {
        const int l = item / 48, j = (item % 48) * 128 + 2 * lane;
        const float* w = PIN(I_WADA) + (size_t)l * 1024 * 6144 + j;
        float acc[8][2];
#pragma unroll
        for (int b = 0; b < 8; ++b) { acc[b][0] = 0.f; acc[b][1] = 0.f; }
#pragma unroll 8
        for (int k = wave * 128; k < wave * 128 + 128; ++k) {
            const float2 wv = *(const float2*)(w + (size_t)k * 6144);
#pragma unroll
            for (int b = 0; b < 8; ++b) { const float cv = ca[b * 1024 + k]; acc[b][0] += cv * wv.x; acc[b][1] += cv * wv.y; }
        }
#pragma unroll
        for (int b = 0; b < 8; ++b) { red[(wave * 8 + b) * 128 + 2 * lane] = acc[b][0]; red[(wave * 8 + b) * 128 + 2 * lane + 1] = acc[b][1]; }
        __syncthreads();
        { const int b = wave;
#pragma unroll
          for (int c2 = 0; c2 < 2; ++c2) { float s2 = 0.f;
#pragma unroll
            for (int w8 = 0; w8 < 8; ++w8) s2 += red[(w8 * 8 + b) * 128 + c2 * 64 + lane];
            mod[((size_t)l * 8 + b) * 6144 + (item % 48) * 128 + c2 * 64 + lane] = s2 + PIN(I_BADA)[l * 6144 + (item % 48) * 128 + c2 * 64 + lane]; } }
        __syncthreads();
    }
    const int* pos = (const int*)PIN(I_POS);
    float *cosP = (float*)(ws + WS_COSP), *sinP = (float*)(ws + WS_SINP), *cosM = (float*)(ws + WS_COSM), *sinM = (float*)(ws + WS_SINM);
    for (int i = blockIdx.x * NTHR + tid; i < T_ * 24; i += gridDim.x * NTHR) {
        const int m = i / 24, f = i % 24;
        double inv; if (f < 8) inv = pow(500000.0, -(double)(2 * f) / 16.0); else inv = pow(500000.0, -(double)(2 * (f - 8)) / 32.0);
        const float ang = (float)pos[m] * (float)inv;
        const double a = (double)ang, kq = rint(a * 0.15915494309189535), r = a - kq * 6.283185307179586476925;
        const float cs = (float)cos(r), sn = (float)sin(r);
        if (f < 8) { cosP[m * 8 + f] = cs; sinP[m * 8 + f] = sn; } else { cosM[m * 16 + f - 8] = cs; sinM[m * 16 + f - 8] = sn; }
    }
}
__device__ __forceinline__ void early_transposes(const MPK& p, int l, LAS unsigned char* lds, int tid, int first) {
    const int wave = tid >> 6, lane = tid & 63;
    if ((int)blockIdx.x < first) return;
    const int gw = ((int)blockIdx.x - first) * NWAVES + wave, ngw = ((int)gridDim.x - first) * NWAVES;
    unsigned char* ws = p.k->ws;
    LAS float* scr = (LAS float*)(lds + wave * 8704);
    constexpr int I0 = 16 * 80, I4 = 4 * 24, I5 = 2 * 24, I6 = 32 * 2, I7 = 32 * 2, I8 = 8, I9 = 8;
    constexpr int NIT = I0 + I4 + I5 + I6 + I7 + I8 + I9;
    for (int it = gw; it < NIT; it += ngw) {
        int r = it;
        if (r < I0) { transpose_item(PIN(I_WIN) + (size_t)l * D_ * DIN, D_, DIN, MapIn{}, nullptr, (bf16*)(ws + WT_IN), scr, r, 80, lane); continue; } r -= I0;
        if (r < I4) { transpose_item(PIN(I_WUQ) + (size_t)l * 256 * 576, 256, 576, MapId{576}, PIN(I_GQL) + l * 256, (bf16*)(ws + WT_UQ), scr, r, 24, lane); continue; } r -= I4;
        if (r < I5) { transpose_item(PIN(I_WUKV) + (size_t)l * 128 * 768, 128, 768, MapId{768}, PIN(I_GKVL) + l * 128, (bf16*)(ws + WT_UKV), scr, r, 24, lane); continue; } r -= I5;
        if (r < I6) { transpose_item(PIN(I_WCK) + (size_t)l * 2048 * 64, 2048, 64, MapId{64}, nullptr, (bf16*)(ws + WT_CK), scr, r, 2, lane); continue; } r -= I6;
        if (r < I7) { transpose_item(PIN(I_WCV) + (size_t)l * 2048 * 64, 2048, 64, MapId{64}, nullptr, (bf16*)(ws + WT_CV), scr, r, 2, lane); continue; } r -= I7;
        if (r < I8) { const int h = r >> 1; transpose_item(PIN(I_WQM) + (size_t)l * 16384 + h * 4096, 64, 64, MapId{64}, nullptr, (bf16*)(ws + WT_QM) + h * 4096, scr, r & 1, 2, lane); continue; } r -= I8;
        { const int h = r >> 1; transpose_item(PIN(I_WKM) + (size_t)l * 16384 + h * 4096, 64, 64, MapId{64}, nullptr, (bf16*)(ws + WT_KM) + h * 4096, scr, r & 1, 2, lane); }
    }
}
__device__ __forceinline__ void ph_prep(const MPK& p, int l, LAS unsigned char* lds, int tid) {
    const int wave = tid >> 6, lane = tid & 63;
    const int gw = blockIdx.x * NWAVES + wave, ngw = gridDim.x * NWAVES;
    unsigned char* ws = p.k->ws;
    LAS float* scr = (LAS float*)(lds + wave * 8704);
    for (int i = blockIdx.x * NTHR + tid; i < 2 * T_; i += gridDim.x * NTHR) ((float*)(ws + WS_SSQL))[i] = 0.f;
    if (l == 0) early_transposes(p, l, lds, tid, 0);
    const float* modl = (const float*)(ws + WS_MOD) + (size_t)l * 8 * 6144;
    if (l == 0) norm_rows<false>(PIN(I_X), PIN(I_GN1) + l * D_, modl + 0, modl + 1024, (bf16*)(ws + WS_HB), gw, ngw, lane);
    else norm_rows<true>(p.k->out, PIN(I_GN1) + l * D_, modl + 0, modl + 1024, (bf16*)(ws + WS_HB), gw, ngw, lane);
}
__device__ __forceinline__ void late_transposes(const MPK& p, int l, LAS unsigned char* lds, int tid, int first) {
    const int wave = tid >> 6, lane = tid & 63;
    if ((int)blockIdx.x < first) return;
    const int gw = ((int)blockIdx.x - first) * NWAVES + wave, ngw = ((int)gridDim.x - first) * NWAVES;
    unsigned char* ws = p.k->ws;
    LAS float* scr = (LAS float*)(lds + wave * 8704);
    constexpr int I1 = 16 * 32, I2 = 16 * 176, I3 = 44 * 32;
    for (int it = gw; it < I1 + I2 + I3; it += ngw) {
        int r = it;
        if (r < I1) { transpose_item(PIN(I_WOUT) + (size_t)l * D_ * D_, D_, D_, MapId{D_}, nullptr, (bf16*)(ws + WT_OUT), scr, r, 32, lane); continue; } r -= I1;
        if (r < I2) { transpose_item(PIN(I_WGU) + (size_t)l * D_ * 2 * FF, D_, 2 * FF, MapGU{}, nullptr, (bf16*)(ws + WT_GU), scr, r, 176, lane); continue; } r -= I2;
        transpose_item(PIN(I_WDOWN) + (size_t)l * FF * D_, FF, D_, MapId{D_}, nullptr, (bf16*)(ws + WT_DOWN), scr, r, 32, lane);
    }
}
__device__ __forceinline__ void ph_mixnorm(const MPK& p, int l, int tid) {
    const int gw = blockIdx.x * NWAVES + (tid >> 6), ngw = gridDim.x * NWAVES, lane = tid & 63;
    unsigned char* ws = p.k->ws;
    bf16* mix = (bf16*)(ws + WS_HB); const float* ga = PIN(I_GOA) + l * 384; const float* gb = PIN(I_GOB) + l * 384;
    const bf16 *oc = (const bf16*)(ws + WS_OCMP), *os = (const bf16*)(ws + WS_OSLC), *ow = (const bf16*)(ws + WS_OWIN); const float* gm = (const float*)(ws + WS_GM);
#define UNPK8(dst, src) dst[0] = __uint_as_float(src.x << 16); dst[1] = __uint_as_float(src.x & 0xffff0000u); dst[2] = __uint_as_float(src.y << 16); dst[3] = __uint_as_float(src.y & 0xffff0000u); \
    dst[4] = __uint_as_float(src.z << 16); dst[5] = __uint_as_float(src.z & 0xffff0000u); dst[6] = __uint_as_float(src.w << 16); dst[7] = __uint_as_float(src.w & 0xffff0000u);
    const int rpw = T_ / ngw;
    const float* ggp = (lane < 48) ? ga + lane * 8 : gb + (lane - 48) * 8; const float4 gA0 = *(const float4*)ggp, gA1 = *(const float4*)(ggp + 4);
    const float* ggq = gb + (16 + (lane & 31)) * 8; const float4 gB0 = *(const float4*)ggq, gB1 = *(const float4*)(ggq + 4);
    v4u ra4, rb4, rc4, ry4; float rg0, rg1, rg2;
#define MIX_LOAD(m_) do { const bf16* r_ = mix + (size_t)(m_) * D_; \
        if (lane < 48) { const size_t o_ = (size_t)(m_) * 384 + lane * 8; const float* g3_ = gm + (size_t)(m_) * 32 + 3 * (lane >> 3); rg0 = g3_[0]; rg1 = g3_[1]; rg2 = g3_[2]; \
            ra4 = *(const v4u*)(oc + o_); rb4 = *(const v4u*)(os + o_); rc4 = *(const v4u*)(ow + o_); } \
        else { ra4 = *(const v4u*)(r_ + 384 + (lane - 48) * 8); rb4 = ra4; rc4 = ra4; rg0 = 0.f; rg1 = 0.f; rg2 = 0.f; } \
        if (lane < 32) ry4 = *(const v4u*)(r_ + 384 + (16 + lane) * 8); else ry4 = ra4; } while (0)
    const int mend = gw * rpw + rpw;
    MIX_LOAD(gw * rpw);
    for (int m = gw * rpw; m < mend; ++m) {
        bf16* r = mix + (size_t)m * D_;
        const v4u ca4 = ra4, cb4 = rb4, cc4 = rc4, cy4 = ry4; const float g0 = rg0, g1 = rg1, g2 = rg2;
        if (m + 1 < mend) MIX_LOAD(m + 1);
        float v0[8], v1[8]; float sa = 0.f, sb = 0.f;
        if (lane < 48) {
            float c8[8], s8[8], w8[8]; UNPK8(c8, ca4) UNPK8(s8, cb4) UNPK8(w8, cc4)
#pragma unroll
            for (int i = 0; i < 8; ++i) { v0[i] = g0 * c8[i] + g1 * s8[i] + g2 * w8[i]; sa += v0[i] * v0[i]; }
        } else {
            UNPK8(v0, ca4)
#pragma unroll
            for (int i = 0; i < 8; ++i) sb += v0[i] * v0[i];
        }
        if (lane < 32) { UNPK8(v1, cy4)
#pragma unroll
            for (int i = 0; i < 8; ++i) sb += v1[i] * v1[i]; }
        const float ra = rsqrtf(wave_sum2(sa) * (1.f / 384.f) + EPS), rb = rsqrtf(wave_sum2(sb) * (1.f / 384.f) + EPS);
        {
            const int col = (lane < 48) ? lane * 8 : 384 + (lane - 48) * 8; const float rr = (lane < 48) ? ra : rb;
            const float4 q0 = gA0, q1 = gA1;
            v4u w; w.x = pk2(v0[0] * rr * q0.x, v0[1] * rr * q0.y); w.y = pk2(v0[2] * rr * q0.z, v0[3] * rr * q0.w); w.z = pk2(v0[4] * rr * q1.x, v0[5] * rr * q1.y); w.w = pk2(v0[6] * rr * q1.z, v0[7] * rr * q1.w);
            *(v4u*)(r + col) = w;
        }
        if (lane < 32) { const float4 q0 = gB0, q1 = gB1;
            v4u w; w.x = pk2(v1[0] * rb * q0.x, v1[1] * rb * q0.y); w.y = pk2(v1[2] * rb * q0.z, v1[3] * rb * q0.w); w.z = pk2(v1[4] * rb * q1.x, v1[5] * rb * q1.y); w.w = pk2(v1[6] * rb * q1.z, v1[7] * rb * q1.w);
            *(v4u*)(r + 384 + (16 + lane) * 8) = w; }
    }
#undef MIX_LOAD
#undef UNPK8
}


typedef short bf16x8 __attribute__((ext_vector_type(8)));
typedef short s16x4 __attribute__((ext_vector_type(4)));
typedef float f32x16 __attribute__((ext_vector_type(16)));
typedef unsigned u32x2v __attribute__((ext_vector_type(2)));
constexpr int AT_BUF = 20480, AT_K32 = 8192, AT_V = 12288;
__device__ __forceinline__ unsigned cvtpk(float lo, float hi) { unsigned r; asm volatile("v_cvt_pk_bf16_f32 %0, %1, %2" : "=v"(r) : "v"(lo), "v"(hi)); return r; }
__device__ __forceinline__ float max3f(float a, float b, float c) { float r; asm("v_max3_f32 %0, %1, %2, %3" : "=v"(r) : "v"(a), "v"(b), "v"(c)); return r; }
__device__ __forceinline__ int crow(int r, int hi) { return (r & 3) + 8 * (r >> 2) + 4 * hi; }
__device__ __forceinline__ s16x4 vtr(LAS const unsigned char* p) { return __builtin_bit_cast(s16x4, __builtin_amdgcn_ds_read_tr16_b64_v4i16((LAS s16x4*)p)); }
enum { AM_CAUSAL = 0, AM_WINDOW = 1, AM_SLC = 2 };
struct AttnState { float m, l; f32x16 o[2]; f32x16 negm; bool started; long long twait; };
template <int NC> struct TileRegs { v4u k; v4u k2; v4u v; };
template <int NC> __device__ __forceinline__ void at_load(TileRegs<NC>& r, const bf16* Kg, int ldk, const bf16* Vg, int ldv, const bf16* K2g, int ldk2, int tile, int tid) {
    const int key = tid >> 3, c = tid & 7;
    r.k = *(const v4u*)(Kg + (size_t)(tile * 64 + key) * ldk + 8 * c);
    r.v = *(const v4u*)(Vg + (size_t)(tile * 64 + key) * ldv + 8 * c);
    if (NC == 6) { if (tid < 256) r.k2 = *(const v4u*)(K2g + (size_t)(tile * 64 + (tid >> 2)) * ldk2 + 8 * (tid & 3)); }
}
template <int NC> __device__ __forceinline__ void at_store(const TileRegs<NC>& r, LAS unsigned char* buf, int tid) {
    const int key = tid >> 3, c = tid & 7;
    *(LAS v4u*)(buf + key * 128 + 16 * (c ^ ((key >> 1) & 7))) = r.k;
    *(LAS v4u*)(buf + AT_V + (c >> 2) * 4096 + key * 64 + (c & 3) * 16) = r.v;
    if (NC == 6) { if (tid < 256) { const int k2 = tid >> 2, c2 = tid & 3; *(LAS v4u*)(buf + AT_K32 + k2 * 64 + 16 * (c2 ^ ((k2 >> 2) & 3))) = r.k2; } }
}
template <int NC> __device__ __forceinline__ void qk_tile(f32x16& p0, f32x16& p1, LAS const unsigned char* buf, const bf16x8 (&qf)[NC], const f32x16& negm, int lane) {
    const int r32 = lane & 31, hi = lane >> 5;
    p0 = negm; p1 = negm;
#pragma unroll
    for (int cc = 0; cc < NC; ++cc) {
        bf16x8 k0, k1;
        if (cc < 4) { const int k0r = r32, k1r = 32 + r32;
            k0 = *(LAS const bf16x8*)(buf + k0r * 128 + 16 * ((2 * cc + hi) ^ ((k0r >> 1) & 7)));
            k1 = *(LAS const bf16x8*)(buf + k1r * 128 + 16 * ((2 * cc + hi) ^ ((k1r >> 1) & 7))); }
        else { const int k0r = r32, k1r = 32 + r32, c2 = 2 * (cc - 4) + hi;
            k0 = *(LAS const bf16x8*)(buf + AT_K32 + k0r * 64 + 16 * (c2 ^ ((k0r >> 2) & 3)));
            k1 = *(LAS const bf16x8*)(buf + AT_K32 + k1r * 64 + 16 * (c2 ^ ((k1r >> 2) & 3))); }
        p0 = __builtin_amdgcn_mfma_f32_32x32x16_bf16(k0, qf[cc], p0, 0, 0, 0);
        p1 = __builtin_amdgcn_mfma_f32_32x32x16_bf16(k1, qf[cc], p1, 0, 0, 0);
    }
}
template <int MODE> __device__ __forceinline__ void mask_tile(f32x16& p0, f32x16& p1, int kpos0, int qpos, bool need_mask, bool sel_ok, int lane) {
    const int hi = lane >> 5;
    if (need_mask) {
        const int qw0m = __builtin_amdgcn_readfirstlane(qpos) & ~31;
        const bool diag = (kpos0 + 63 > qw0m), old = (MODE == AM_WINDOW) && (kpos0 < qw0m + 31 - 511);
        if (diag || old) {
            const float selterm = (MODE == AM_SLC && !sel_ok) ? -INFINITY : INFINITY;
            const int dbase = qpos - kpos0 - 4 * hi;
#pragma unroll
            for (int r = 0; r < 16; ++r) {
                const int d0 = dbase - ((r & 3) + 8 * (r >> 2)), d1 = d0 - 32;
                float l0 = ((float)d0 + 0.5f) * INFINITY, l1 = ((float)d1 + 0.5f) * INFINITY;
                if (MODE == AM_WINDOW) { l0 = fminf(l0, ((float)(511 - d0) + 0.5f) * INFINITY); l1 = fminf(l1, ((float)(511 - d1) + 0.5f) * INFINITY); }
                if (MODE == AM_SLC) { l0 = fminf(l0, selterm); l1 = fminf(l1, selterm); }
                p0[r] = fminf(p0[r], l0); p1[r] = fminf(p1[r], l1);
            }
        } else if (MODE == AM_SLC) {
            const float selterm = sel_ok ? INFINITY : -INFINITY;
#pragma unroll
            for (int r = 0; r < 16; ++r) { p0[r] = fminf(p0[r], selterm); p1[r] = fminf(p1[r], selterm); }
        }
    }
}
template <int MODE> __device__ __forceinline__ void softmax_tile(AttnState& st, f32x16& p0, f32x16& p1, bf16x8 (&pf)[4], int kpos0, int qpos, bool need_mask, bool sel_ok, int lane) {
    mask_tile<MODE>(p0, p1, kpos0, qpos, need_mask, sel_ok, lane);
    float mx = max3f(p0[0], p1[0], p0[1]), mx2 = max3f(p1[1], p0[2], p1[2]);
#pragma unroll
    for (int r = 3; r < 15; r += 2) { mx = max3f(mx, p0[r], p1[r]); mx2 = max3f(mx2, p0[r + 1], p1[r + 1]); }
    mx = max3f(mx, p0[15], p1[15]); mx = max3f(mx, mx2, mx2);
    mx = red32_max(mx);
    if (!st.started || __any(mx > 0.f)) {
        float dl = st.started ? fmaxf(mx, 0.f) : mx;
        dl = (dl > -1e30f) ? dl : 0.f;
        st.started = true;
        const float alpha = __builtin_amdgcn_exp2f(-dl);
        st.m += dl; st.l *= alpha;
#pragma unroll
        for (int r = 0; r < 16; ++r) { st.o[0][r] *= alpha; st.o[1][r] *= alpha; p0[r] -= dl; p1[r] -= dl; st.negm[r] = -st.m; }
    }
    float sum = 0.f;
#pragma unroll
    for (int r = 0; r < 16; ++r) { p0[r] = __builtin_amdgcn_exp2f(p0[r]); p1[r] = __builtin_amdgcn_exp2f(p1[r]); sum += p0[r] + p1[r]; }
    st.l += sum;
#pragma unroll
    for (int s2 = 0; s2 < 2; ++s2) {
        v4u a, b;
        a.x = cvtpk(p0[8 * s2 + 0], p0[8 * s2 + 1]); a.y = cvtpk(p0[8 * s2 + 2], p0[8 * s2 + 3]); a.z = cvtpk(p0[8 * s2 + 4], p0[8 * s2 + 5]); a.w = cvtpk(p0[8 * s2 + 6], p0[8 * s2 + 7]);
        b.x = cvtpk(p1[8 * s2 + 0], p1[8 * s2 + 1]); b.y = cvtpk(p1[8 * s2 + 2], p1[8 * s2 + 3]); b.z = cvtpk(p1[8 * s2 + 4], p1[8 * s2 + 5]); b.w = cvtpk(p1[8 * s2 + 6], p1[8 * s2 + 7]);
        pf[s2] = __builtin_bit_cast(bf16x8, a); pf[2 + s2] = __builtin_bit_cast(bf16x8, b);
    }
}
struct TileFlags { bool skip, need_mask, sel_ok; };
__device__ __forceinline__ void pack_p(bf16x8 (&pf)[4], const f32x16& p0, const f32x16& p1) {
#pragma unroll
    for (int s2 = 0; s2 < 2; ++s2) {
        v4u a, b;
        a.x = cvtpk(p0[8 * s2 + 0], p0[8 * s2 + 1]); a.y = cvtpk(p0[8 * s2 + 2], p0[8 * s2 + 3]); a.z = cvtpk(p0[8 * s2 + 4], p0[8 * s2 + 5]); a.w = cvtpk(p0[8 * s2 + 6], p0[8 * s2 + 7]);
        b.x = cvtpk(p1[8 * s2 + 0], p1[8 * s2 + 1]); b.y = cvtpk(p1[8 * s2 + 2], p1[8 * s2 + 3]); b.z = cvtpk(p1[8 * s2 + 4], p1[8 * s2 + 5]); b.w = cvtpk(p1[8 * s2 + 6], p1[8 * s2 + 7]);
        pf[s2] = __builtin_bit_cast(bf16x8, a); pf[2 + s2] = __builtin_bit_cast(bf16x8, b);
    }
}
template <int MODE> __device__ __forceinline__ void softmax_pair(AttnState& st, f32x16& a0, f32x16& a1, f32x16& b0, f32x16& b1, int kpos0, int qpos, const TileFlags& fa, const TileFlags& fb, int lane) {
    mask_tile<MODE>(a0, a1, kpos0, qpos, fa.need_mask, fa.sel_ok, lane);
    mask_tile<MODE>(b0, b1, kpos0 + 64, qpos, fb.need_mask, fb.sel_ok, lane);
    float mx = max3f(a0[0], a1[0], b0[0]), mx2 = max3f(b1[0], a0[1], a1[1]);
#pragma unroll
    for (int r = 1; r < 16; ++r) { mx = max3f(mx, b0[r], b1[r]); if (r > 1) mx2 = max3f(mx2, a0[r], a1[r]); }
    mx = max3f(mx, mx2, mx2);
    mx = red32_max(mx);
    if (!st.started || __any(mx > 0.f)) {
        float dl = st.started ? fmaxf(mx, 0.f) : mx;
        dl = (dl > -1e30f) ? dl : 0.f;
        st.started = true;
        const float alpha = __builtin_amdgcn_exp2f(-dl);
        st.m += dl; st.l *= alpha;
#pragma unroll
        for (int r = 0; r < 16; ++r) { st.o[0][r] *= alpha; st.o[1][r] *= alpha; a0[r] -= dl; a1[r] -= dl; b0[r] -= dl; b1[r] -= dl; st.negm[r] = -st.m; }
    }
    float sum = 0.f;
#pragma unroll
    for (int r = 0; r < 16; ++r) { a0[r] = __builtin_amdgcn_exp2f(a0[r]); a1[r] = __builtin_amdgcn_exp2f(a1[r]); b0[r] = __builtin_amdgcn_exp2f(b0[r]); b1[r] = __builtin_amdgcn_exp2f(b1[r]); sum += (a0[r] + a1[r]) + (b0[r] + b1[r]); }
    st.l += sum;
}
__device__ __forceinline__ void pv_tile(AttnState& st, LAS const unsigned char* buf, const bf16x8 (&pf)[4], int lane) {
    const int hi = lane >> 5;
    const unsigned vb = (unsigned)(uintptr_t)(buf + AT_V + (4 * hi + ((lane & 15) >> 2)) * 64 + ((lane >> 4) & 1) * 32 + (lane & 3) * 8);
#pragma unroll
    for (int dh = 0; dh < 2; ++dh) {
        s16x4 lo[4], hh[4];
#pragma unroll
        for (int s4 = 0; s4 < 4; ++s4) {
            asm volatile("ds_read_b64_tr_b16 %0, %1 offset:%c2" : "=&v"(lo[s4]) : "v"(vb), "i"(dh * 4096 + s4 * 1024) : "memory");
            asm volatile("ds_read_b64_tr_b16 %0, %1 offset:%c2" : "=&v"(hh[s4]) : "v"(vb), "i"(dh * 4096 + s4 * 1024 + 512) : "memory");
        }
        asm volatile("s_waitcnt lgkmcnt(0)" : "+v"(lo[0]), "+v"(lo[1]), "+v"(lo[2]), "+v"(lo[3]), "+v"(hh[0]), "+v"(hh[1]), "+v"(hh[2]), "+v"(hh[3]) :: "memory");
#pragma unroll
        for (int s4 = 0; s4 < 4; ++s4) {
            const bf16x8 vf = {lo[s4][0], lo[s4][1], lo[s4][2], lo[s4][3], hh[s4][0], hh[s4][1], hh[s4][2], hh[s4][3]};
            st.o[dh] = __builtin_amdgcn_mfma_f32_32x32x16_bf16(vf, pf[s4], st.o[dh], 0, 0, 0);
        }
    }
}
template <int MODE> __device__ __forceinline__ TileFlags tile_flags(int t, int qw0, unsigned selbits) {
    const int k0 = t * 64; TileFlags f;
    f.skip = k0 > qw0 + 31; f.need_mask = (k0 + 63 > qw0); f.sel_ok = true;
    if (MODE == AM_WINDOW) { f.skip = f.skip || (k0 + 63 < qw0 - 511); f.need_mask = f.need_mask || (k0 < qw0 + 31 - 511); }
    if (MODE == AM_SLC) { f.sel_ok = (selbits >> t) & 1u; const unsigned long long bal = __ballot(f.sel_ok); f.skip = f.skip || (bal == 0ull); f.need_mask = f.need_mask || (bal != ~0ull); }
    return f;
}
struct DmaOff { unsigned k, v, k2; };
template <int NC> __device__ __forceinline__ DmaOff at_dma_off(int ldk, int ldv, int ldk2, int wave, int lane) {
    const int L = wave * 64 + lane; DmaOff o;
    { const int key = L >> 3, c = (L & 7) ^ ((key >> 1) & 7); o.k = (unsigned)(key * ldk + 8 * c) * 2u; }
    { const int key = (L >> 2) & 63, c = (L >> 8) * 4 + (L & 3); o.v = (unsigned)(key * ldv + 8 * c) * 2u; }
    { const int key = (L >> 2) & 63, c2 = (L & 3) ^ ((key >> 2) & 3); o.k2 = (unsigned)(key * ldk2 + 8 * c2) * 2u; }
    return o;
}
template <int NC> __device__ __forceinline__ void at_dma(const DmaOff& o, const bf16* Kg, int ldk, const bf16* Vg, int ldv, const bf16* K2g, int ldk2, int tile, LAS unsigned char* slot, int wave) {
    __builtin_amdgcn_global_load_lds((const unsigned*)((const char*)(Kg + (size_t)tile * 64 * ldk) + o.k), (LAS unsigned*)(slot + wave * 1024), 16, 0, 0);
    __builtin_amdgcn_global_load_lds((const unsigned*)((const char*)(Vg + (size_t)tile * 64 * ldv) + o.v), (LAS unsigned*)(slot + AT_V + wave * 1024), 16, 0, 0);
    if (NC == 6) { if (wave < 4) __builtin_amdgcn_global_load_lds((const unsigned*)((const char*)(K2g + (size_t)tile * 64 * ldk2) + o.k2), (LAS unsigned*)(slot + AT_K32 + wave * 1024), 16, 0, 0); }
}
__device__ __forceinline__ void at_wait_bar(int keep) {
    if (keep == 0) asm volatile("s_waitcnt vmcnt(0) lgkmcnt(0)" ::: "memory");
    else if (keep == 4) asm volatile("s_waitcnt vmcnt(4) lgkmcnt(0)" ::: "memory");
    else asm volatile("s_waitcnt vmcnt(6) lgkmcnt(0)" ::: "memory");
    __builtin_amdgcn_s_barrier();
    asm volatile("" ::: "memory");
}
template <int NC, int MODE> __device__ __forceinline__ void at_stream(AttnState& st, LAS unsigned char* lds, const bf16* Kg, int ldk, const bf16* Vg, int ldv, const bf16* K2g, int ldk2, int t0, int t1,
                                                                       const bf16x8 (&qf)[NC], int qpos, int qw0, unsigned selbits, int tid) {
    const int lane = tid & 63, wave = __builtin_amdgcn_readfirstlane(tid >> 6), np = (t1 - t0) >> 1;
    const int nper2 = (NC == 6 && wave < 4) ? 6 : 4;
    const DmaOff dof = at_dma_off<NC>(ldk, ldv, ldk2, wave, lane);
    at_dma<NC>(dof, Kg, ldk, Vg, ldv, K2g, ldk2, t0, lds, wave); at_dma<NC>(dof, Kg, ldk, Vg, ldv, K2g, ldk2, t0 + 1, lds + AT_BUF, wave);
    if (np > 1) { at_dma<NC>(dof, Kg, ldk, Vg, ldv, K2g, ldk2, t0 + 2, lds + 2 * AT_BUF, wave); at_dma<NC>(dof, Kg, ldk, Vg, ldv, K2g, ldk2, t0 + 3, lds + 3 * AT_BUF, wave); }
    at_wait_bar(np > 1 ? nper2 : 0);
    int s0 = 0, s1 = 2 * AT_BUF, s2 = 4 * AT_BUF;
    for (int j = 0; j < np; ++j) {
        const int t = t0 + 2 * j; const bool has_2 = (j + 2 < np);
        if (has_2) { at_dma<NC>(dof, Kg, ldk, Vg, ldv, K2g, ldk2, t + 4, lds + s2, wave); at_dma<NC>(dof, Kg, ldk, Vg, ldv, K2g, ldk2, t + 5, lds + s2 + AT_BUF, wave); }
        const TileFlags fa = tile_flags<MODE>(t, qw0, selbits), fb = tile_flags<MODE>(t + 1, qw0, selbits);
        if (!fa.skip && !fb.skip) {
            f32x16 a0, a1, b0, b1; bf16x8 pf[4];
            qk_tile<NC>(a0, a1, lds + s0, qf, st.negm, lane);
            qk_tile<NC>(b0, b1, lds + s0 + AT_BUF, qf, st.negm, lane);
            softmax_pair<MODE>(st, a0, a1, b0, b1, t * 64, qpos, fa, fb, lane);
            pack_p(pf, a0, a1); pv_tile(st, lds + s0, pf, lane);
            pack_p(pf, b0, b1); pv_tile(st, lds + s0 + AT_BUF, pf, lane);
        } else {
            if (!fa.skip) { f32x16 p0, p1; bf16x8 pf[4]; qk_tile<NC>(p0, p1, lds + s0, qf, st.negm, lane); softmax_tile<MODE>(st, p0, p1, pf, t * 64, qpos, fa.need_mask, fa.sel_ok, lane); pv_tile(st, lds + s0, pf, lane); }
            if (!fb.skip) { f32x16 p0, p1; bf16x8 pf[4]; qk_tile<NC>(p0, p1, lds + s0 + AT_BUF, qf, st.negm, lane); softmax_tile<MODE>(st, p0, p1, pf, (t + 1) * 64, qpos, fb.need_mask, fb.sel_ok, lane); pv_tile(st, lds + s0 + AT_BUF, pf, lane); }
        }
        at_wait_bar(has_2 ? nper2 : 0);
        const int tmp = s0; s0 = s1; s1 = s2; s2 = tmp;
    }
}
__device__ __forceinline__ int next_item_q(unsigned* ctrs, LAS unsigned char* lds, int wave_u, int count, int q0, int& kstart) {
    const int tid = wave_u * 64 + fresh_lane();
    LAS int* slot = (LAS int*)(lds + RING_BYTES + 64);
    if (tid == 0) { const unsigned v = atomicAdd(ctrs, 1u); slot[0] = (v < 8u * (unsigned)count) ? (int)(((v & 7u) << 16) | (v >> 3)) : -1; }
    __syncthreads();
    const int v = slot[0];
    __syncthreads();
    (void)q0; (void)kstart;
    return v;
}
__device__ __forceinline__ void mla_unit(unsigned char* ws, LAS unsigned char* lds, int b, int h, int qt, int wave_u) {
    const int tid = wave_u * 64 + fresh_lane();
    const int lane = tid & 63, wave = tid >> 6, r32 = lane & 31, hi = lane >> 5;
    const int qw0 = qt * 256 + wave * 32, qpos = qw0 + r32; const size_t row = (size_t)b * S_ + qpos;
    const long long tq0 = (PROBE_SEL != 0) ? (long long)__builtin_amdgcn_s_memtime() : 0ll;
    bf16x8 qf[6];
    {
        const bf16* qp = (const bf16*)(ws + WS_OSLC) + row * 768 + h * 96 + 8 * hi;
        v4u raw[6];
#pragma unroll
        for (int cc = 0; cc < 6; ++cc) raw[cc] = *(const v4u*)(qp + 16 * cc);
        float msc = MSCALE; asm volatile("" : "+v"(msc));
        const float rs = rsqrtf(((const float*)(ws + WS_SSQL))[row] * (1.f / 256.f) + EPS) * msc;
        const float* cm_ = (const float*)(ws + WS_COSM) + row * 16 + 8 * hi; const float* sm_ = (const float*)(ws + WS_SINM) + row * 16 + 8 * hi;
#define UNPKQ(dst, src) dst[0] = __uint_as_float(src.x << 16); dst[1] = __uint_as_float(src.x & 0xffff0000u); dst[2] = __uint_as_float(src.y << 16); dst[3] = __uint_as_float(src.y & 0xffff0000u); \
        dst[4] = __uint_as_float(src.z << 16); dst[5] = __uint_as_float(src.z & 0xffff0000u); dst[6] = __uint_as_float(src.w << 16); dst[7] = __uint_as_float(src.w & 0xffff0000u);
#pragma unroll
        for (int cc = 0; cc < 4; ++cc) { float f[8]; UNPKQ(f, raw[cc])
            v4u w; w.x = cvtpk(f[0] * rs, f[1] * rs); w.y = cvtpk(f[2] * rs, f[3] * rs); w.z = cvtpk(f[4] * rs, f[5] * rs); w.w = cvtpk(f[6] * rs, f[7] * rs); qf[cc] = __builtin_bit_cast(bf16x8, w); }
        { float x1[8], x2[8], o1[8], o2[8]; UNPKQ(x1, raw[4]) UNPKQ(x2, raw[5])
#pragma unroll
          for (int j = 0; j < 8; ++j) { const float cs = cm_[j] * rs, sn = sm_[j] * rs; o1[j] = x1[j] * cs - x2[j] * sn; o2[j] = x1[j] * sn + x2[j] * cs; }
          v4u w; w.x = cvtpk(o1[0], o1[1]); w.y = cvtpk(o1[2], o1[3]); w.z = cvtpk(o1[4], o1[5]); w.w = cvtpk(o1[6], o1[7]); qf[4] = __builtin_bit_cast(bf16x8, w);
          w.x = cvtpk(o2[0], o2[1]); w.y = cvtpk(o2[2], o2[3]); w.z = cvtpk(o2[4], o2[5]); w.w = cvtpk(o2[6], o2[7]); qf[5] = __builtin_bit_cast(bf16x8, w); }
#undef UNPKQ
    }
    const long long tq1 = (PROBE_SEL != 0) ? (long long)__builtin_amdgcn_s_memtime() : 0ll;
    AttnState st; st.m = 0.f; st.l = 0.f; st.o[0] = f32x16{}; st.o[1] = f32x16{}; st.negm = f32x16{}; st.started = false; st.twait = 0;
    const bf16* kvb = (const bf16*)(ws + WS_KVM) + (size_t)b * S_ * 768 + h * 128;
    at_stream<6, AM_CAUSAL>(st, lds, kvb, 768, kvb + 64, 768, (const bf16*)(ws + WS_KR) + (size_t)b * S_ * 32, 32, 0, 4 * qt + 4, qf, qpos, qw0, 0u, tid);
    if (PROBE_SEL >= 1 && PROBE_SEL <= 3 && b == 0 && h == 0 && qt == 7 && tid == 0) { const long long tq2 = (long long)__builtin_amdgcn_s_memtime();
        ((float*)(ws + WS_CTL))[100] = (PROBE_SEL == 1) ? (float)(tq2 - tq1) : (PROBE_SEL == 2) ? (float)st.twait : (float)(tq1 - tq0); }
    const float lt = red32_sum(st.l), il = 1.f / lt;
    bf16* op = (bf16*)(ws + WS_HB) + row * D_ + 384 + h * 64 + 4 * hi;
#pragma unroll
    for (int dh = 0; dh < 2; ++dh)
#pragma unroll
        for (int g4 = 0; g4 < 4; ++g4) { u32x2v w; w.x = cvtpk(st.o[dh][4 * g4] * il, st.o[dh][4 * g4 + 1] * il); w.y = cvtpk(st.o[dh][4 * g4 + 2] * il, st.o[dh][4 * g4 + 3] * il);
            *(u32x2v*)(op + dh * 32 + 8 * g4) = w; }
}
template <int MODE> __device__ __forceinline__ void nsa_branch_unit(unsigned char* ws, LAS unsigned char* lds, int b, int h, int qt, int wave_u) {
    const int tid = wave_u * 64 + fresh_lane();
    const int lane = tid & 63, wave = tid >> 6, r32 = lane & 31, hi = lane >> 5, g = h / 3;
    const int qw0 = qt * 256 + wave * 32, qpos = qw0 + r32; const size_t row = (size_t)b * S_ + qpos;
    const bf16* nsa = (const bf16*)(ws + WS_NSA);
    const bf16* qp = nsa + row * 1152 + h * 64 + 8 * hi;
    bf16x8 qf[4];
#pragma unroll
    for (int cc = 0; cc < 4; ++cc) qf[cc] = *(const bf16x8*)(qp + 16 * cc);
    unsigned selbits = 0u; if (MODE == AM_SLC) selbits = ((const unsigned*)(ws + WS_SEL))[(size_t)(b * 2 + g) * S_ + qpos];
    const bf16* kb = nsa + (size_t)b * S_ * 1152 + g * 64 + (MODE == AM_SLC ? 640 : 896);
    AttnState st; st.m = 0.f; st.l = 0.f; st.o[0] = f32x16{}; st.o[1] = f32x16{}; st.negm = f32x16{}; st.started = false; st.twait = 0;
    const long long tn0 = (PROBE_SEL != 0) ? (long long)__builtin_amdgcn_s_memtime() : 0ll;
    const int t0 = (MODE == AM_SLC) ? 0 : ((4 * qt - 8 > 0) ? 4 * qt - 8 : 0);
    at_stream<4, MODE>(st, lds, kb, 1152, kb + 128, 1152, nullptr, 0, t0, 4 * qt + 4, qf, qpos, qw0, selbits, tid);
    if (PROBE_SEL >= 4 && PROBE_SEL <= 5 && MODE == AM_SLC && b == 0 && h == 0 && qt == 7 && tid == 0) { const long long tn1 = (long long)__builtin_amdgcn_s_memtime();
        ((float*)(ws + WS_CTL))[100] = (PROBE_SEL == 4) ? (float)(tn1 - tn0) : (float)st.twait; }
    const float lt = red32_sum(st.l), il = 1.f / lt;
    bf16* op = (bf16*)(ws + (MODE == AM_SLC ? WS_OSLC : WS_OWIN)) + row * 384 + h * 64 + 4 * hi;
#pragma unroll
    for (int dh = 0; dh < 2; ++dh)
#pragma unroll
        for (int g4 = 0; g4 < 4; ++g4) { u32x2v w; w.x = cvtpk(st.o[dh][4 * g4] * il, st.o[dh][4 * g4 + 1] * il); w.y = cvtpk(st.o[dh][4 * g4 + 2] * il, st.o[dh][4 * g4 + 3] * il);
            *(u32x2v*)(op + dh * 32 + 8 * g4) = w; }
}
__device__ __forceinline__ void cmp_unit(unsigned char* ws, LAS unsigned char* lds, int b, int g, int qt, int wave_u) {
    const int tid = wave_u * 64 + fresh_lane();
    const int lane = tid & 63, wave = tid >> 6, r32 = lane & 31, hi = lane >> 5;
    const int qpos = qt * 256 + wave * 32 + r32; const size_t row = (size_t)b * S_ + qpos;
    const bf16* kc = (const bf16*)(ws + WS_KCV) + (size_t)(b * 2 + g) * 128 * 64; const bf16* vc = kc + (size_t)8 * 2 * 128 * 64;
    { TileRegs<4> tr; at_load<4>(tr, kc, 64, vc, 64, nullptr, 0, 0, tid); at_store<4>(tr, lds, tid); at_load<4>(tr, kc, 64, vc, 64, nullptr, 0, 1, tid); at_store<4>(tr, lds + AT_BUF, tid); }
    __syncthreads();
    int nvis = (qpos >= 31) ? ((qpos - 31) >> 4) + 1 : 0; if (nvis > 127) nvis = 127;
    float G[16], L[16];
#pragma unroll
    for (int i = 0; i < 16; ++i) { G[i] = 0.f; L[i] = 0.f; }
    const bf16* nsa = (const bf16*)(ws + WS_NSA);
    LAS const unsigned char* vb = lds + AT_V + (4 * hi + ((lane & 15) >> 2)) * 64 + ((lane >> 4) & 1) * 32 + (lane & 3) * 8;
    for (int r3 = 0; r3 < 3; ++r3) {
        const int h = 3 * g + r3;
        const bf16* qp = nsa + row * 1152 + h * 64 + 8 * hi;
        bf16x8 qf[4];
#pragma unroll
        for (int cc = 0; cc < 4; ++cc) qf[cc] = *(const bf16x8*)(qp + 16 * cc);
        f32x16 p[4];
#pragma unroll
        for (int tb = 0; tb < 4; ++tb) {
            LAS const unsigned char* buf = lds + (tb >> 1) * AT_BUF; const int kr = (tb & 1) * 32 + r32;
            p[tb] = f32x16{};
#pragma unroll
            for (int cc = 0; cc < 4; ++cc) { const bf16x8 kf = *(LAS const bf16x8*)(buf + kr * 128 + 16 * ((2 * cc + hi) ^ ((kr >> 1) & 7)));
                p[tb] = __builtin_amdgcn_mfma_f32_32x32x16_bf16(kf, qf[cc], p[tb], 0, 0, 0); }
        }
        float mx = -1e30f;
#pragma unroll
        for (int tb = 0; tb < 4; ++tb)
#pragma unroll
            for (int r = 0; r < 16; ++r) { const int n = 32 * tb + crow(r, hi); p[tb][r] = fminf(p[tb][r], ((float)(nvis - n) - 0.5f) * INFINITY); mx = fmaxf(mx, p[tb][r]); }
        mx = red32_max(mx);
        float sum = 0.f;
#pragma unroll
        for (int tb = 0; tb < 4; ++tb)
#pragma unroll
            for (int r = 0; r < 16; ++r) { p[tb][r] = __builtin_amdgcn_exp2f(p[tb][r] - mx); sum += p[tb][r]; }
        sum = red32_sum(sum);
        const float il = (nvis > 0) ? 1.f / sum : 0.f;
#pragma unroll
        for (int tb = 0; tb < 4; ++tb)
#pragma unroll
            for (int k = 0; k < 4; ++k) { const float a0 = p[tb][4 * k] * il, a1 = p[tb][4 * k + 1] * il, a2 = p[tb][4 * k + 2] * il, a3 = p[tb][4 * k + 3] * il;
                G[4 * tb + k] += (a0 + a1) + (a2 + a3); L[4 * tb + k] += a3; }
        f32x16 o[2] = {f32x16{}, f32x16{}};
#pragma unroll
        for (int tb = 0; tb < 4; ++tb)
#pragma unroll
            for (int s2 = 0; s2 < 2; ++s2) {
                v4u a; a.x = cvtpk(p[tb][8 * s2 + 0], p[tb][8 * s2 + 1]); a.y = cvtpk(p[tb][8 * s2 + 2], p[tb][8 * s2 + 3]); a.z = cvtpk(p[tb][8 * s2 + 4], p[tb][8 * s2 + 5]); a.w = cvtpk(p[tb][8 * s2 + 6], p[tb][8 * s2 + 7]);
                const bf16x8 pf = __builtin_bit_cast(bf16x8, a);
                LAS const unsigned char* vbb = vb + (tb >> 1) * AT_BUF + ((tb & 1) * 2 + s2) * 1024;
#pragma unroll
                for (int dh = 0; dh < 2; ++dh) { const s16x4 lo = vtr(vbb + dh * 4096), hh = vtr(vbb + dh * 4096 + 512);
                    const bf16x8 vf = {lo[0], lo[1], lo[2], lo[3], hh[0], hh[1], hh[2], hh[3]};
                    o[dh] = __builtin_amdgcn_mfma_f32_32x32x16_bf16(vf, pf, o[dh], 0, 0, 0); }
                asm volatile("" ::: "memory");
            }
        bf16* op = (bf16*)(ws + WS_OCMP) + row * 384 + h * 64 + 4 * hi;
#pragma unroll
        for (int dh = 0; dh < 2; ++dh)
#pragma unroll
            for (int g4 = 0; g4 < 4; ++g4) { u32x2v w; w.x = cvtpk(o[dh][4 * g4] * il, o[dh][4 * g4 + 1] * il); w.y = cvtpk(o[dh][4 * g4 + 2] * il, o[dh][4 * g4 + 3] * il);
                *(u32x2v*)(op + dh * 32 + 8 * g4) = w; }
    }
    const int cur = qpos >> 6;
    unsigned key[16], okey[16];
#pragma unroll
    for (int jj = 0; jj < 16; ++jj) {
        const auto sw = __builtin_amdgcn_permlane32_swap(__float_as_uint(L[jj]), __float_as_uint(L[jj]), false, false);
        const float lp = __uint_as_float(hi ? sw[0] : sw[1]);
        L[jj] = lp;
    }
#pragma unroll
    for (int jj = 0; jj < 16; ++jj) {
        const int j = 2 * jj + hi;
        float v = G[jj] + (hi ? L[jj] : (jj > 0 ? L[jj > 0 ? jj - 1 : 0] : 0.f));
        if (j == 0 || j == cur || j == cur - 1) v = INFINITY;
        if (j * 64 > qpos) v = -INFINITY;
        const unsigned u = __float_as_uint(v); const unsigned ord = (u & 0x80000000u) ? ~u : (u | 0x80000000u);
        key[jj] = (ord & ~31u) | (unsigned)(31 - j);
    }
#pragma unroll
    for (int jj = 0; jj < 16; ++jj) { const auto sw = __builtin_amdgcn_permlane32_swap(key[jj], key[jj], false, false); okey[jj] = hi ? sw[0] : sw[1]; }
    unsigned mask = 0;
#pragma unroll
    for (int jj = 0; jj < 16; ++jj) {
        int rank = 0;
#pragma unroll
        for (int kk = 0; kk < 16; ++kk) { rank += (key[kk] > key[jj]) ? 1 : 0; rank += (okey[kk] > key[jj]) ? 1 : 0; }
        if (rank < 16) mask |= 1u << (2 * jj + hi);
    }
    mask = red32_or(mask);
    if (hi == 0) ((unsigned*)(ws + WS_SEL))[(size_t)(b * 2 + g) * S_ + qpos] = mask;
    __syncthreads();
}
__device__ __forceinline__ void lora_rows(unsigned char* ws, int tid) {
    const int gw = blockIdx.x * NWAVES + (tid >> 6), ngw = gridDim.x * NWAVES, lane = tid & 63;
    bf16* kvl = (bf16*)(ws + WS_KVL); const bf16* ql = (const bf16*)(ws + WS_QL); float* ssql = (float*)(ws + WS_SSQL);
    for (int m = gw; m < T_; m += ngw) {
        const unsigned kv = *(const unsigned*)(kvl + (size_t)m * 128 + 2 * lane);
        const float k0 = __uint_as_float(kv << 16), k1 = __uint_as_float(kv & 0xffff0000u);
        const uint2 qv = *(const uint2*)(ql + (size_t)m * 256 + 4 * lane);
        const float q0 = __uint_as_float(qv.x << 16), q1 = __uint_as_float(qv.x & 0xffff0000u), q2 = __uint_as_float(qv.y << 16), q3 = __uint_as_float(qv.y & 0xffff0000u);
        const float sk = wave_sum2(k0 * k0 + k1 * k1), sq = wave_sum2((q0 * q0 + q1 * q1) + (q2 * q2 + q3 * q3));
        const float rk = rsqrtf(sk * (1.f / 128.f) + EPS);
        *(unsigned*)(kvl + (size_t)m * 128 + 2 * lane) = pk2(k0 * rk, k1 * rk);
        if (lane == 0) ssql[m] = sq;
    }
}
__device__ __forceinline__ void post_misc(unsigned char* ws, const float* big, const float* bfg, int tid) {
    const float* mr = (const float*)(ws + WS_MISCRAW); const float* cosM = (const float*)(ws + WS_COSM); const float* sinM = (const float*)(ws + WS_SINM);
    bf16* kr = (bf16*)(ws + WS_KR); float* gm = (float*)(ws + WS_GM);
    for (int idx = blockIdx.x * NTHR + tid; idx < T_ * 64; idx += gridDim.x * NTHR) {
        const int row = idx >> 6, c = idx & 63; const float* r = mr + (size_t)row * 64; const float v = r[c];
        if (c < 32) { const int i = c & 15; const float x1 = r[i], x2 = r[16 + i], cs = cosM[row * 16 + i], sn = sinM[row * 16 + i];
            kr[(size_t)row * 32 + c] = f2bf((c < 16) ? x1 * cs - x2 * sn : x1 * sn + x2 * cs); }
        else if (c < 50) gm[(size_t)row * 32 + (c - 32)] = 1.f / (1.f + __expf(-v));
        else if (c < 54) gm[(size_t)row * 32 + 18 + (c - 50)] = v + big[c - 50];
        else if (c < 58) { const float z = v + bfg[c - 54]; gm[(size_t)row * 32 + 22 + (c - 54)] = fminf(z, 0.f) - __logf(1.f + __expf(-fabsf(z))); }
    }
}

typedef float f32x4v __attribute__((ext_vector_type(4)));
__device__ __forceinline__ void compress_item(unsigned char* ws, LAS unsigned char* lds, const float* cmp_pos, int item, int wave_u) {
    const int lane = fresh_lane(), tid = wave_u * 64 + lane;
    const int nb = item & 7, g = (item >> 3) & 1, b = (item >> 4) & 7, kv = item >> 7;
    const bf16* tok = (const bf16*)(ws + WS_NSA) + (size_t)b * S_ * 1152 + (kv ? 512 : 384) + g * 64;
    const bf16* wt = (const bf16*)(ws + (kv ? WT_CV : WT_CK));
    const int nrow = nb * 16 + (lane & 15), kq = lane >> 4;
    f32x4v acc[4] = {f32x4v{}, f32x4v{}, f32x4v{}, f32x4v{}};
#pragma unroll
    for (int hb = 0; hb < 2; ++hb) {
        v4u t4[4]; f32x4v p0[4], p1[4]; bf16x8 bfr[4][4];
#pragma unroll
        for (int q = 0; q < 4; ++q) {
            const int k = wave_u * 256 + (4 * hb + q) * 32 + kq * 8, l = k >> 6, d = k & 63;
            int trow = 16 * nrow + l; trow = trow < S_ ? trow : S_ - 1;
            t4[q] = *(const v4u*)(tok + (size_t)trow * 1152 + d);
            p0[q] = *(const f32x4v*)(cmp_pos + k); p1[q] = *(const f32x4v*)(cmp_pos + k + 4);
#pragma unroll
            for (int cb = 0; cb < 4; ++cb) bfr[q][cb] = *(const bf16x8*)(wt + (size_t)(cb * 16 + (lane & 15)) * 2048 + k);
        }
        asm volatile("" : "+v"(t4[0]), "+v"(t4[1]), "+v"(t4[2]), "+v"(t4[3]), "+v"(p0[0]), "+v"(p0[1]), "+v"(p0[2]), "+v"(p0[3]), "+v"(p1[0]), "+v"(p1[1]), "+v"(p1[2]), "+v"(p1[3]));
        asm volatile("" : "+v"(bfr[0][0]), "+v"(bfr[0][1]), "+v"(bfr[0][2]), "+v"(bfr[0][3]), "+v"(bfr[1][0]), "+v"(bfr[1][1]), "+v"(bfr[1][2]), "+v"(bfr[1][3]));
        asm volatile("" : "+v"(bfr[2][0]), "+v"(bfr[2][1]), "+v"(bfr[2][2]), "+v"(bfr[2][3]), "+v"(bfr[3][0]), "+v"(bfr[3][1]), "+v"(bfr[3][2]), "+v"(bfr[3][3]));
#pragma unroll
        for (int q = 0; q < 4; ++q) {
            v4u a4;
            a4.x = cvtpk(__uint_as_float(t4[q].x << 16) + p0[q][0], __uint_as_float(t4[q].x & 0xffff0000u) + p0[q][1]); a4.y = cvtpk(__uint_as_float(t4[q].y << 16) + p0[q][2], __uint_as_float(t4[q].y & 0xffff0000u) + p0[q][3]);
            a4.z = cvtpk(__uint_as_float(t4[q].z << 16) + p1[q][0], __uint_as_float(t4[q].z & 0xffff0000u) + p1[q][1]); a4.w = cvtpk(__uint_as_float(t4[q].w << 16) + p1[q][2], __uint_as_float(t4[q].w & 0xffff0000u) + p1[q][3]);
            const bf16x8 af = __builtin_bit_cast(bf16x8, a4);
#pragma unroll
            for (int cb = 0; cb < 4; ++cb) acc[cb] = __builtin_amdgcn_mfma_f32_16x16x32_bf16(af, bfr[q][cb], acc[cb], 0, 0, 0);
        }
    }
    LAS float* red = (LAS float*)lds + wave_u * 1024;
#pragma unroll
    for (int cb = 0; cb < 4; ++cb)
#pragma unroll
        for (int r = 0; r < 4; ++r) red[(4 * (lane >> 4) + r) * 64 + cb * 16 + (lane & 15)] = acc[cb][r];
    __syncthreads();
    bf16* out = (bf16*)(ws + WS_KCV) + (size_t)kv * (8 * 2 * 128 * 64) + ((size_t)(b * 2 + g) * 128 + nb * 16) * 64;
    for (int o = tid; o < 1024; o += NTHR) { float sum = 0.f;
#pragma unroll
        for (int w8 = 0; w8 < 8; ++w8) sum += ((LAS float*)lds)[w8 * 1024 + o];
        out[o] = f2bf(sum); }
    __syncthreads();
}
__device__ __forceinline__ f32x4v mm16(const LAS bf16* A, int lda, int arow0, const LAS bf16* Bt, int ldb, int bcol0, int K, int lane, f32x4v acc) {
    const LAS bf16* ap = A + (arow0 + (lane & 15)) * lda + 8 * (lane >> 4); const LAS bf16* bp = Bt + (bcol0 + (lane & 15)) * ldb + 8 * (lane >> 4);
    for (int k = 0; k < K; k += 32) acc = __builtin_amdgcn_mfma_f32_16x16x32_bf16(*(const LAS bf16x8*)(ap + k), *(const LAS bf16x8*)(bp + k), acc, 0, 0, 0);
    return acc;
}
constexpr int ML_LD = 72;
constexpr int ML_STRIDE = 3 * 64 * ML_LD * 2 + 256;
__device__ __forceinline__ void mlocal_item(unsigned char* ws, LAS unsigned char* lds, const float* convw, const float* convb, const float* big, const float* bfg, int chunk0, int wave_u) {
    const int lane = fresh_lane(), tid = wave_u * 64 + lane;
    const int h = (chunk0 >> 5) & 3, b = chunk0 >> 7;
    LAS bf16* WQ = (LAS bf16*)lds;
    LAS bf16* WK = WQ + 64 * ML_LD;
    const bf16* cm = (const bf16*)(ws + WS_CM);
#define ML_PTRS(ch) const int chunk = chunk0 + (ch); const int c = chunk & 31; const int row0 = b * S_ + c * 64; LAS bf16* XS = WK + 64 * ML_LD + (ch) * (ML_STRIDE / 2); \
    LAS bf16* VT = XS + 64 * ML_LD; LAS bf16* WKT = VT + 64 * ML_LD; LAS float* wl = (LAS float*)(WKT + 64 * ML_LD); (void)c; (void)row0; (void)XS; (void)VT; (void)WKT; (void)wl; (void)chunk;
    {
        v4u gx[2][4], gv[2]; const int l = tid >> 3, ch0 = (tid & 7) * 8;
#pragma unroll
        for (int ch = 0; ch < 2; ++ch) { ML_PTRS(ch) const int row = row0 + l, s = c * 64 + l;
#pragma unroll
            for (int j = 0; j < 4; ++j) gx[ch][j] = (s - 3 + j >= 0) ? *(const v4u*)(cm + (size_t)(row - 3 + j) * 768 + h * 64 + ch0) : v4u{0u, 0u, 0u, 0u};
            gv[ch] = *(const v4u*)(cm + (size_t)row * 768 + 256 + h * 64 + ch0); }
        asm volatile("" : "+v"(gx[0][0]), "+v"(gx[0][1]), "+v"(gx[0][2]), "+v"(gx[0][3]), "+v"(gx[1][0]), "+v"(gx[1][1]), "+v"(gx[1][2]), "+v"(gx[1][3]), "+v"(gv[0]), "+v"(gv[1]));
#pragma unroll
        for (int ch = 0; ch < 2; ++ch) { ML_PTRS(ch) const int row = row0 + l;
            float a[8];
#pragma unroll
            for (int i = 0; i < 8; ++i) a[i] = convb[h * 64 + ch0 + i];
#pragma unroll
            for (int j = 0; j < 4; ++j) { const v4u x4 = gx[ch][j];
                const float* cw = convw + j * 256 + h * 64 + ch0;
                a[0] += cw[0] * __uint_as_float(x4.x << 16); a[1] += cw[1] * __uint_as_float(x4.x & 0xffff0000u); a[2] += cw[2] * __uint_as_float(x4.y << 16); a[3] += cw[3] * __uint_as_float(x4.y & 0xffff0000u);
                a[4] += cw[4] * __uint_as_float(x4.z << 16); a[5] += cw[5] * __uint_as_float(x4.z & 0xffff0000u); a[6] += cw[6] * __uint_as_float(x4.w << 16); a[7] += cw[7] * __uint_as_float(x4.w & 0xffff0000u); }
            v4u o4; float r[8];
#pragma unroll
            for (int i = 0; i < 8; ++i) r[i] = a[i] / (1.f + __expf(-a[i]));
            o4.x = cvtpk(r[0], r[1]); o4.y = cvtpk(r[2], r[3]); o4.z = cvtpk(r[4], r[5]); o4.w = cvtpk(r[6], r[7]);
            *(v4u*)((bf16*)(ws + WS_XC) + (size_t)row * 256 + h * 64 + ch0) = o4;
            *(LAS v4u*)(XS + l * ML_LD + ch0) = o4;
            const v4u v4 = gv[ch];
            VT[(ch0 + 0) * ML_LD + l] = (bf16)(v4.x & 0xffffu); VT[(ch0 + 1) * ML_LD + l] = (bf16)(v4.x >> 16); VT[(ch0 + 2) * ML_LD + l] = (bf16)(v4.y & 0xffffu); VT[(ch0 + 3) * ML_LD + l] = (bf16)(v4.y >> 16);
            VT[(ch0 + 4) * ML_LD + l] = (bf16)(v4.z & 0xffffu); VT[(ch0 + 5) * ML_LD + l] = (bf16)(v4.z >> 16); VT[(ch0 + 6) * ML_LD + l] = (bf16)(v4.w & 0xffffu); VT[(ch0 + 7) * ML_LD + l] = (bf16)(v4.w >> 16);
        }
    }
    {
        const int e = tid >> 3, d0 = (tid & 7) * 8;
        *(LAS v4u*)(WQ + e * ML_LD + d0) = *(const v4u*)((const bf16*)(ws + WT_QM) + h * 4096 + e * 64 + d0);
        *(LAS v4u*)(WK + e * ML_LD + d0) = *(const v4u*)((const bf16*)(ws + WT_KM) + h * 4096 + e * 64 + d0);
    }
    if (wave_u < 2) { ML_PTRS(wave_u)
        const float* mr = (const float*)(ws + WS_MISCRAW) + (size_t)(row0 + lane) * 64;
        const float z = mr[54 + h] + bfg[h]; float lf = fminf(z, 0.f) - __logf(1.f + __expf(-fabsf(z)));
        const float ig = mr[50 + h] + big[h];
#pragma unroll
        for (int o = 1; o < 64; o <<= 1) { const float t = bperm(lf, lane - o); if (lane >= o) lf += t; }
        const float bL = __int_as_float(__builtin_amdgcn_readlane(__float_as_int(lf), 63));
        const float a = bL - lf + ig; const float mx = wave_max2(a);
        wl[lane] = __expf(a - mx);
        if (lane == 0) { ((float*)(ws + WS_ML))[chunk] = mx; ((float*)(ws + WS_BL))[chunk] = bL; }
    }
    __syncthreads();
#pragma unroll
    for (int ch = 0; ch < 2; ++ch) { ML_PTRS(ch)
        const int lb = wave_u & 3; const bool isk = wave_u >= 4;
        const LAS bf16* Wt = isk ? WK : WQ;
        bf16* og = (bf16*)(ws + (isk ? WS_MK : WS_MQ)) + (size_t)(row0 + 16 * lb + 4 * (lane >> 4)) * 256 + h * 64 + (lane & 15);
        float w4[4];
#pragma unroll
        for (int r = 0; r < 4; ++r) w4[r] = wl[16 * lb + 4 * (lane >> 4) + r];
#pragma unroll
        for (int eb = 0; eb < 4; ++eb) {
            f32x4v acc = mm16(XS, ML_LD, 16 * lb, Wt, ML_LD, 16 * eb, 64, lane, f32x4v{});
            if (!isk) {
#pragma unroll
                for (int r = 0; r < 4; ++r) og[(size_t)r * 256 + 16 * eb] = f2bf(acc[r] * 0.125f);
            } else {
                bf16 kb[4];
#pragma unroll
                for (int r = 0; r < 4; ++r) { kb[r] = f2bf(acc[r]); og[(size_t)r * 256 + 16 * eb] = kb[r]; }
                u32x2v w2; w2.x = cvtpk(bf2f(kb[0]) * w4[0], bf2f(kb[1]) * w4[1]); w2.y = cvtpk(bf2f(kb[2]) * w4[2], bf2f(kb[3]) * w4[3]);
                *(LAS u32x2v*)(WKT + (16 * eb + (lane & 15)) * ML_LD + 16 * lb + 4 * (lane >> 4)) = w2;
            }
        }
    }
    __syncthreads();
#pragma unroll
    for (int ch = 0; ch < 2; ++ch) { ML_PTRS(ch)
        float* ct = (float*)(ws + WS_CT) + (size_t)chunk * 4096;
#pragma unroll
        for (int i = 0; i < 2; ++i) { const int blk = wave_u * 2 + i, eb = blk >> 2, db = blk & 3;
            const f32x4v acc = mm16(VT, ML_LD, 16 * eb, WKT, ML_LD, 16 * db, 64, lane, f32x4v{});
#pragma unroll
            for (int r = 0; r < 4; ++r) ct[(16 * eb + 4 * (lane >> 4) + r) * 64 + 16 * db + (lane & 15)] = acc[r]; }
    }
    if (tid < 128) { ML_PTRS(tid >> 6)
        const int d = tid & 63; float n = 0.f; const LAS bf16* wr_ = WKT + d * ML_LD;
        for (int l = 0; l < 64; ++l) n += bf2f(wr_[l]);
        ((float*)(ws + WS_NL))[chunk * 64 + d] = n; }
#undef ML_PTRS
    __syncthreads();
}
__device__ __forceinline__ void mscan_item(unsigned char* ws, int item, int wave_u) {
    const int tid = wave_u * 64 + fresh_lane();
    const int bh = item / 9, part = item % 9;
    if (part == 8 && tid >= 64) return;
    float* base; size_t stride;
    if (part < 8) { base = (float*)(ws + WS_CT) + (size_t)bh * 32 * 4096 + part * 512 + tid; stride = 4096; } else { base = (float*)(ws + WS_NL) + (size_t)bh * 32 * 64 + tid; stride = 64; }
    const float* ML = (const float*)(ws + WS_ML); const float* BL = (const float*)(ws + WS_BL); float* MPv = (float*)(ws + WS_MP);
    float cl[32];
#pragma unroll
    for (int c = 0; c < 32; ++c) cl[c] = base[(size_t)c * stride];
    float Cv = 0.f, m = 0.f;
#pragma unroll
    for (int c = 0; c < 32; ++c) {
        const float ml = ML[bh * 32 + c], bl = BL[bh * 32 + c];
        base[(size_t)c * stride] = Cv;
        if (part == 8 && tid == 0) MPv[bh * 32 + c] = m;
        const float mn = fmaxf(bl + m, ml);
        Cv = __expf(bl + m - mn) * Cv + __expf(ml - mn) * cl[c]; m = mn;
    }
}
constexpr int MO_STRIDE = 5 * 64 * ML_LD * 2 + 64 * 65 * 4 + 6 * 64 * 4;
__device__ __forceinline__ void mout_item(unsigned char* ws, LAS unsigned char* lds, const float* gmh, const float* skip, int chunk0, int wave_u) {
    const int lane = fresh_lane(), tid = wave_u * 64 + lane;
    const int h = (chunk0 >> 5) & 3, b = chunk0 >> 7;
    const float* gm = (const float*)(ws + WS_GM);
#define MO_PTRS(ch) const int chunk = chunk0 + (ch); const int row0 = b * S_ + (chunk & 31) * 64; LAS unsigned char* cb_ = lds + (ch) * MO_STRIDE; \
    LAS bf16* QS = (LAS bf16*)cb_; LAS bf16* KS = QS + 64 * ML_LD; LAS bf16* VT = KS + 64 * ML_LD; LAS bf16* CP = VT + 64 * ML_LD; LAS bf16* SW = CP + 64 * ML_LD; \
    LAS float* HS = (LAS float*)(SW + 64 * ML_LD); LAS float* bs = HS + 64 * 65; LAS float* us = bs + 64; LAS float* ns = us + 64; LAS float* mts = ns + 64; LAS float* ints = mts + 64; LAS float* dinv = ints + 64; \
    (void)row0; (void)QS; (void)KS; (void)VT; (void)CP; (void)SW; (void)HS; (void)bs; (void)us; (void)ns; (void)mts; (void)ints; (void)dinv; (void)chunk;
    {
        v4u gq[2], gk[2], gv[2]; f32x4v gc0[2], gc1[2];
        const int l = tid >> 3, c0 = (tid & 7) * 8;
#pragma unroll
        for (int ch = 0; ch < 2; ++ch) { MO_PTRS(ch) const int row = row0 + l;
            gq[ch] = *(const v4u*)((const bf16*)(ws + WS_MQ) + (size_t)row * 256 + h * 64 + c0); gk[ch] = *(const v4u*)((const bf16*)(ws + WS_MK) + (size_t)row * 256 + h * 64 + c0);
            gv[ch] = *(const v4u*)((const bf16*)(ws + WS_CM) + (size_t)row * 768 + 256 + h * 64 + c0);
            const float* ct = (const float*)(ws + WS_CT) + (size_t)chunk * 4096 + l * 64 + c0;
            gc0[ch] = *(const f32x4v*)ct; gc1[ch] = *(const f32x4v*)(ct + 4); }
        asm volatile("" : "+v"(gq[0]), "+v"(gq[1]), "+v"(gk[0]), "+v"(gk[1]), "+v"(gv[0]), "+v"(gv[1]), "+v"(gc0[0]), "+v"(gc0[1]), "+v"(gc1[0]), "+v"(gc1[1]));
#pragma unroll
        for (int ch = 0; ch < 2; ++ch) { MO_PTRS(ch)
            *(LAS v4u*)(QS + l * ML_LD + c0) = gq[ch]; *(LAS v4u*)(KS + l * ML_LD + c0) = gk[ch];
            const v4u v4 = gv[ch];
            VT[(c0 + 0) * ML_LD + l] = (bf16)(v4.x & 0xffffu); VT[(c0 + 1) * ML_LD + l] = (bf16)(v4.x >> 16); VT[(c0 + 2) * ML_LD + l] = (bf16)(v4.y & 0xffffu); VT[(c0 + 3) * ML_LD + l] = (bf16)(v4.y >> 16);
            VT[(c0 + 4) * ML_LD + l] = (bf16)(v4.z & 0xffffu); VT[(c0 + 5) * ML_LD + l] = (bf16)(v4.z >> 16); VT[(c0 + 6) * ML_LD + l] = (bf16)(v4.w & 0xffffu); VT[(c0 + 7) * ML_LD + l] = (bf16)(v4.w >> 16);
            const f32x4v c0v = gc0[ch], c1v = gc1[ch];
            v4u cw; cw.x = cvtpk(c0v[0], c0v[1]); cw.y = cvtpk(c0v[2], c0v[3]); cw.z = cvtpk(c1v[0], c1v[1]); cw.w = cvtpk(c1v[2], c1v[3]);
            *(LAS v4u*)(CP + l * ML_LD + c0) = cw; }
    }
    if (wave_u < 2) { MO_PTRS(wave_u)
        const float ig = gm[(size_t)(row0 + lane) * 32 + 18 + h]; float lf = gm[(size_t)(row0 + lane) * 32 + 22 + h];
#pragma unroll
        for (int o = 1; o < 64; o <<= 1) { const float t = bperm(lf, lane - o); if (lane >= o) lf += t; }
        const float u = ig - lf; float cu = u;
#pragma unroll
        for (int o = 1; o < 64; o <<= 1) { const float t = bperm(cu, lane - o); if (lane >= o) cu = fmaxf(cu, t); }
        const float mprev = ((const float*)(ws + WS_MP))[chunk];
        const float mt = lf + fmaxf(mprev, cu);
        bs[lane] = lf; us[lane] = u; mts[lane] = mt; ints[lane] = __expf(lf + mprev - mt); ns[lane] = ((const float*)(ws + WS_NL))[chunk * 64 + lane];
    }
    __syncthreads();
#pragma unroll
    for (int ch = 0; ch < 2; ++ch) { MO_PTRS(ch)
#pragma unroll
        for (int i = 0; i < 2; ++i) { const int blk = wave_u * 2 + i, lb = blk >> 2, sb = blk & 3;
            f32x4v acc = f32x4v{};
            if (sb <= lb) acc = mm16(QS, ML_LD, 16 * lb, KS, ML_LD, 16 * sb, 64, lane, acc);
            const int sidx = 16 * sb + (lane & 15); const float usv = us[sidx];
#pragma unroll
            for (int r = 0; r < 4; ++r) { const int l = 16 * lb + 4 * (lane >> 4) + r;
                const float v = (sidx <= l) ? acc[r] * __expf(bs[l] + usv - mts[l]) : 0.f;
                SW[l * ML_LD + sidx] = f2bf(v); } }
    }
    __syncthreads();
    if (tid < 128) { MO_PTRS(tid >> 6)
        const int l = tid & 63; float qn = 0.f, ssum = 0.f;
        for (int d = 0; d < 64; ++d) { qn += bf2f(QS[l * ML_LD + d]) * ns[d]; ssum += bf2f(SW[l * ML_LD + d]); }
        const float den = ints[l] * qn + ssum;
        dinv[l] = 1.f / fmaxf(fabsf(den), __expf(-mts[l]));
    }
    f32x4v hq[2][2], hs2[2][2];
#pragma unroll
    for (int ch = 0; ch < 2; ++ch) { MO_PTRS(ch)
#pragma unroll
        for (int i = 0; i < 2; ++i) { const int blk = wave_u * 2 + i, lb = blk >> 2, eb = blk & 3;
            hq[ch][i] = mm16(QS, ML_LD, 16 * lb, CP, ML_LD, 16 * eb, 64, lane, f32x4v{});
            hs2[ch][i] = mm16(SW, ML_LD, 16 * lb, VT, ML_LD, 16 * eb, 16 * lb + 16 <= 32 ? 32 : 64, lane, f32x4v{}); }
    }
    __syncthreads();
#pragma unroll
    for (int ch = 0; ch < 2; ++ch) { MO_PTRS(ch)
#pragma unroll
        for (int i = 0; i < 2; ++i) { const int blk = wave_u * 2 + i, lb = blk >> 2, eb = blk & 3; const int e = 16 * eb + (lane & 15);
#pragma unroll
            for (int r = 0; r < 4; ++r) { const int l = 16 * lb + 4 * (lane >> 4) + r;
                const float og = bf2f(((const bf16*)(ws + WS_CM))[(size_t)(row0 + l) * 768 + 512 + h * 64 + e]);
                HS[l * 65 + e] = (ints[l] * hq[ch][i][r] + hs2[ch][i][r]) * dinv[l] / (1.f + __expf(-og)); } }
    }
    __syncthreads();
#pragma unroll
    for (int ch = 0; ch < 2; ++ch) { MO_PTRS(ch)
        const int l = tid >> 3, e0 = (tid & 7) * 8, row = row0 + l;
        float v[8]; float mu = 0.f;
#pragma unroll
        for (int i = 0; i < 8; ++i) { v[i] = HS[l * 65 + e0 + i]; mu += v[i]; }
        mu += sxf<1>(mu); mu += sxf<2>(mu); mu += sxf<4>(mu); mu *= (1.f / 64.f);
        float var = 0.f;
#pragma unroll
        for (int i = 0; i < 8; ++i) { const float dl = v[i] - mu; var += dl * dl; }
        var += sxf<1>(var); var += sxf<2>(var); var += sxf<4>(var);
        const float rs = rsqrtf(var * (1.f / 64.f) + EPS);
        const v4u x4 = *(const v4u*)((const bf16*)(ws + WS_XC) + (size_t)row * 256 + h * 64 + e0);
        float xv[8]; xv[0] = __uint_as_float(x4.x << 16); xv[1] = __uint_as_float(x4.x & 0xffff0000u); xv[2] = __uint_as_float(x4.y << 16); xv[3] = __uint_as_float(x4.y & 0xffff0000u);
        xv[4] = __uint_as_float(x4.z << 16); xv[5] = __uint_as_float(x4.z & 0xffff0000u); xv[6] = __uint_as_float(x4.w << 16); xv[7] = __uint_as_float(x4.w & 0xffff0000u);
        float r[8];
#pragma unroll
        for (int i = 0; i < 8; ++i) r[i] = (v[i] - mu) * rs * gmh[h * 64 + e0 + i] + skip[h * 64 + e0 + i] * xv[i];
        v4u w4; w4.x = cvtpk(r[0], r[1]); w4.y = cvtpk(r[2], r[3]); w4.z = cvtpk(r[4], r[5]); w4.w = cvtpk(r[6], r[7]);
        *(v4u*)((bf16*)(ws + WS_HB) + (size_t)row * D_ + 768 + h * 64 + e0) = w4;
    }
#undef MO_PTRS
    __syncthreads();
}

__global__ void __launch_bounds__(NTHR, 2) mega(MP p_unused) {
    extern __shared__ __attribute__((aligned(16))) unsigned char lds_raw[];
    LAS unsigned char* lds = (LAS unsigned char*)lds_raw;
    const int wave0 = __builtin_amdgcn_readfirstlane((int)threadIdx.x >> 6);
    const int tid0 = wave0 * 64 + fresh_lane();
    const int xcc = (int)(__builtin_amdgcn_s_getreg((3 << 11) | 20) & 7u);
    volatile LAS unsigned* MISC = (volatile LAS unsigned*)(lds + MISC_OFF);
    for (int u = tid0; u < (LDS_BYTES - RING_BYTES) / 4; u += NTHR) ((LAS unsigned*)(lds + RING_BYTES))[u] = 0u;
    __syncthreads();
    typedef const __attribute__((address_space(4))) MP* kmp_t;
    kmp_t kp0 = (kmp_t)__builtin_amdgcn_kernarg_segment_ptr();
    unsigned char* ws0 = kp0->ws; const int coop = kp0->coop, ph_lo = kp0->ph_lo, ph_hi = kp0->ph_hi;
    XcdBarrier bar; bar.bar = (unsigned*)(ws0 + WS_CTL) + CW_BAR; bar.x = 0; bar.st = nullptr;
    if (coop) bar = xcd_barrier_post((unsigned*)(ws0 + WS_CTL) + CW_BAR, MISC + 8, tid0);
    if (coop == 2) cooperative_groups::this_grid().sync();
    int ph = ph_lo;
    if (ph == 0) {
        const MPK p{kp0}; ph_p0(p, lds, wave0 * 64 + fresh_lane()); ph = 1;
        if (ph < ph_hi) xcd_barrier(bar, wave0 * 64 + fresh_lane());
    }
    bool second = false;
    for (; ph < ph_hi; ++ph) {
        kmp_t kp = kp0; asm volatile("" : "+s"(kp));
        const MPK p{kp}; unsigned char* ws = kp->ws;
#define TID_ (wave0 * 64 + fresh_lane())
#define GW_ (blockIdx.x * NWAVES + wave0)
#define NGW_ (gridDim.x * NWAVES)
        const int l = (ph - 1) / PPL, ty = (ph == 0) ? -1 : (ph == NPH - 1) ? -2 : (ph - 1) % PPL;
        const float* modl = (const float*)(ws + WS_MOD) + (size_t)l * 8 * 6144;
        if (ty == -2) { final_load((const bf16*)p.k->out, lds, TID_); xcd_barrier(bar, TID_); final_store(PIN(I_GFIN), p.k->out, lds, TID_);
            if (PROBE_SEL != 0 && blockIdx.x == 0 && TID_ == 0) { asm volatile("s_waitcnt vmcnt(0)" ::: "memory"); p.k->out[0] = ((const float*)(ws + WS_CTL))[100] * 0.001f; } }
        else if (ty == 0 && (PHM & 2)) ph_prep(p, l, lds, TID_);
        else if (ty == 1 && (PHM & 4)) {
            pg8::Gemm g{(const bf16*)(ws + WS_HB), (const bf16*)(ws + WT_IN), T_, 2560, D_}; pg8::StaticOrder S; S.init(T_, 2560, gridDim.x, blockIdx.x);
            pg8::EpiIn E{ws, PIN(I_BIG) + l * 4, PIN(I_BFG) + l * 4};
            pg8::gemm_phase<pg8::EpiIn, pg8::StaticOrder, true, true>(lds, g, S, E, wave0);
            late_transposes(p, l, lds, TID_, 640 % (int)gridDim.x);
        }
        else if (ty == 2 && (PHM & 64)) {
            { pg8::Gemm g{(const bf16*)(ws + WS_KVL), (const bf16*)(ws + WT_UKV), T_, 768, 128}; pg8::StaticOrder S; S.init(T_, 768, gridDim.x, blockIdx.x);
              pg8::EpiUKV E{(bf16*)(ws + WS_KVM), (const float*)(ws + WS_SSKV)}; pg8::gemm_phase<pg8::EpiUKV, pg8::StaticOrder, true, true>(lds, g, S, E, wave0); }
            { pg8::Gemm g{(const bf16*)(ws + WS_QL), (const bf16*)(ws + WT_UQ), T_, 768, 256}; pg8::StaticOrder S; S.init(T_, 768, gridDim.x, blockIdx.x);
              pg8::EpiPlain E{(bf16*)(ws + WS_OSLC), 768}; pg8::gemm_phase<pg8::EpiPlain, pg8::StaticOrder, true, true>(lds, g, S, E, wave0); }
            post_misc(ws, PIN(I_BIG) + l * 4, PIN(I_BFG) + l * 4, TID_);
            unsigned* ctrs = (unsigned*)(ws + WS_CTL) + 8192 + ph * 256 + (second ? 128 : 0); int ks = 0;
            for (;;) { const int it = next_item_q(ctrs, lds, wave0, 96, xcc, ks); if (it < 0) break; const int b = it >> 16, j = it & 0xffff;
                if (j < 64) mlocal_item(ws, lds, PIN(I_CONVW) + l * 1024, PIN(I_CONVB) + l * 256, PIN(I_BIG) + l * 4, PIN(I_BFG) + l * 4, b * 128 + 2 * j, wave0);
                else { const int k = j - 64; compress_item(ws, lds, PIN(I_CMPPOS) + l * 2048, ((k >> 4) << 7) | (b << 4) | (k & 15), wave0); } }
        }
        else if (ty == 3 && (PHM & 128)) {
            unsigned* ctrs = (unsigned*)(ws + WS_CTL) + 8192 + ph * 256 + (second ? 128 : 0); int ks = 0;
            for (;;) { const int it = next_item_q(ctrs, lds, wave0, second ? 64 : 100, xcc, ks); if (it < 0) break; const int b = it >> 16, j = it & 0xffff;
                if (second && (REP_MASK & (1 << 20)) && j >= 48) continue; if (second && (REP_MASK & (1 << 21)) && j < 48) continue;
                if (j < 18) mla_unit(ws, lds, b, j % 6, 7 - j / 6, wave0);
                else if (j < 34) cmp_unit(ws, lds, b, (j - 18) >> 3, 7 - ((j - 18) & 7), wave0);
                else if (j < 64) { const int u = j - 16; mla_unit(ws, lds, b, u % 6, 7 - u / 6, wave0); }
                else mscan_item(ws, b * 36 + (j - 64), wave0); }
        }
        else if (ty == 4 && (PHM & 256)) {
            unsigned* ctrs = (unsigned*)(ws + WS_CTL) + 8192 + ph * 256 + (second ? 128 : 0); int ks = 0;
            for (;;) { const int it = next_item_q(ctrs, lds, wave0, 160, xcc, ks); if (it < 0) break; const int b = it >> 16, j = it & 0xffff;
                if (second && (REP_MASK & (1 << 16)) && j >= 96) continue; if (second && (REP_MASK & (1 << 17)) && j < 96) continue;
                if (j < 36) nsa_branch_unit<AM_SLC>(ws, lds, b, j % 6, 7 - j / 6, wave0);
                else if (j < 84) nsa_branch_unit<AM_WINDOW>(ws, lds, b, (j - 36) % 6, 7 - (j - 36) / 6, wave0);
                else if (j < 96) { const int u = j - 48; nsa_branch_unit<AM_SLC>(ws, lds, b, u % 6, 7 - u / 6, wave0); }
                else mout_item(ws, lds, PIN(I_GMH) + l * 256, PIN(I_SKIP) + l * 256, b * 128 + 2 * (j - 96), wave0); }
        }
        else if (ty == 5) ph_mixnorm(p, l, TID_);
        else if (ty == 6 && (PHM & 8)) {
            pg8::Gemm g{(const bf16*)(ws + WS_HB), (const bf16*)(ws + WT_OUT), T_, D_, D_}; pg8::StaticOrder S; S.init(T_, D_, gridDim.x, blockIdx.x);
            pg8::EpiRes E{(l == 0) ? PIN(I_X) : nullptr, (const bf16*)p.k->out, (bf16*)p.k->out, modl + 2048};
            pg8::gemm_phase<pg8::EpiRes, pg8::StaticOrder, true, true>(lds, g, S, E, wave0);
        }
        else if (ty == 7) norm_rows<true>(p.k->out, PIN(I_GN2) + l * D_, modl + 3072, modl + 4096, (bf16*)(ws + WS_HB), GW_, NGW_, fresh_lane());
        else if (ty == 8 && (PHM & 16)) {
            pg8::Gemm g{(const bf16*)(ws + WS_HB), (const bf16*)(ws + WT_GU), T_, 2 * FF, D_}; pg8::StaticOrder S; S.init(T_, 2 * FF, gridDim.x, blockIdx.x);
            pg8::EpiGU E{(bf16*)(ws + WS_ACT)};
            pg8::gemm_phase<pg8::EpiGU, pg8::StaticOrder, true, true>(lds, g, S, E, wave0);
            if (l + 1 < DEPTH) early_transposes(p, l + 1, lds, TID_, 1408 % (int)gridDim.x);
        }
        else if (ty == 9 && (PHM & 32)) {
            pg8::Gemm g{(const bf16*)(ws + WS_ACT), (const bf16*)(ws + WT_DOWN), T_, D_, FF}; pg8::StaticOrder S; S.init(T_, D_, gridDim.x, blockIdx.x);
            pg8::EpiRes E{nullptr, (const bf16*)p.k->out, (bf16*)p.k->out, modl + 5120};
            pg8::gemm_phase<pg8::EpiRes, pg8::StaticOrder, true, true>(lds, g, S, E, wave0);
        }
        if (REP_MASK != 0 && ty >= 0 && ((REP_MASK >> ty) & 1) && !second) { second = true; --ph; } else second = false;
        if (ph + 1 < ph_hi) xcd_barrier(bar, wave0 * 64 + fresh_lane());
    }
}

extern "C" void kernel_launch(void* const* d_in, const int* in_sizes, int n_in, void* d_out, int out_size, void* d_ws, size_t ws_size, hipStream_t stream) {
    if (n_in != N_IN || ws_size < WS_END) { fprintf(stderr, "kernel_launch: unexpected n_in %d / ws %zu\n", n_in, ws_size); return; }
    static int inited = 0;
    if (!inited) { if (hipFuncSetAttribute((const void*)mega, hipFuncAttributeMaxDynamicSharedMemorySize, LDS_BYTES) != hipSuccess) fprintf(stderr, "hipFuncSetAttribute failed\n"); inited = 1; }
    unsigned char* ws = (unsigned char*)d_ws;
    MP base{}; for (int i = 0; i < N_IN; ++i) base.in[i] = (const float*)d_in[i]; base.out = (float*)d_out; base.ws = ws;
    (void)hipMemsetAsync(ws + WS_CTL, 0, CTL_ZERO_BYTES, stream);
    static int grid = 0;
    if (!grid) {
        int dev = 0, cus = 0, per_cu = 0;
        (void)hipGetDevice(&dev); (void)hipDeviceGetAttribute(&cus, hipDeviceAttributeMultiprocessorCount, dev);
        if (hipOccupancyMaxActiveBlocksPerMultiprocessor(&per_cu, (const void*)mega, NTHR, LDS_BYTES) != hipSuccess || per_cu < 1) { fprintf(stderr, "kernel_launch: occupancy query says %d blocks per CU\n", per_cu); per_cu = 1; }
        (void)hipGetLastError();
        grid = cus;
    }
    MP a = base; a.ph_lo = 0; a.ph_hi = NPH; a.coop = 1;
    void* args[] = {&a};
    const hipError_t e = hipLaunchCooperativeKernel((const void*)mega, dim3(grid), dim3(NTHR), args, LDS_BYTES, stream);
    if (e != hipSuccess) fprintf(stderr, "kernel_launch: cooperative launch failed: %s (grid %d)\n", hipGetErrorString(e), grid);
}
```

```cpp
#include <hip/hip_runtime.h>
#include <cstdint>
#include <cstdio>
#include <type_traits>
#include <hip/hip_cooperative_groups.h>

constexpr int B_ = 8, S_ = 2048, T_ = B_ * S_, D_ = 1024, DIN = 2362, FF = 2816, DEPTH = 2;
constexpr float EPS = 1e-6f;
constexpr float LOG2E = 1.4426950408889634f;
constexpr float QSCALE = 0.125f * LOG2E;
constexpr float MSCALE = 0.10206207261596577f * LOG2E;
enum { I_X = 0, I_C, I_POS, I_GN1, I_GN2, I_WADA, I_BADA, I_WIN, I_CMPPOS, I_WCK, I_WCV, I_GOA, I_GQL, I_WUQ, I_GKVL, I_WUKV, I_GOB,
       I_CONVW, I_CONVB, I_WQM, I_WKM, I_BIG, I_BFG, I_GMH, I_SKIP, I_WOUT, I_WGU, I_WDOWN, I_GFIN, N_IN };

constexpr size_t MiB = 1u << 20;
constexpr size_t WS_CTL = 0;
constexpr size_t WS_MOD = 1 * MiB;
constexpr size_t WS_COSP = WS_MOD + 512 * 1024;
constexpr size_t WS_SINP = WS_COSP + 512 * 1024;
constexpr size_t WS_COSM = WS_SINP + 512 * 1024;
constexpr size_t WS_SINM = WS_COSM + 1 * MiB;
constexpr size_t WS_SSQL = WS_SINM + 1 * MiB;
constexpr size_t WS_SSKV = WS_SSQL + 64 * 1024;
constexpr size_t WS_ML = WS_SSKV + 64 * 1024;
constexpr size_t WS_BL = WS_ML + 4096;
constexpr size_t WS_MP = WS_BL + 4096;
constexpr size_t WS_NL = WS_MP + 4096;
constexpr size_t WS_WT = 8 * MiB;
constexpr size_t WS_RAW = WS_WT;
constexpr size_t WS_HB = 34 * MiB;
constexpr size_t WS_NSA = 66 * MiB;
constexpr size_t WS_KVL = 102 * MiB;
constexpr size_t WS_QL = 106 * MiB;
constexpr size_t WS_CM = 114 * MiB;
constexpr size_t WS_GM = 138 * MiB;
constexpr size_t WS_KM = 140 * MiB;
constexpr size_t WS_QM = 158 * MiB;
constexpr size_t WS_VM = 176 * MiB;
constexpr size_t WS_KCV = 188 * MiB;
constexpr size_t WS_OCMP = 189 * MiB;
constexpr size_t WS_SEL = 201 * MiB;
constexpr size_t WS_XC = 202 * MiB;
constexpr size_t WS_MQ = 210 * MiB;
constexpr size_t WS_MK = 218 * MiB;
constexpr size_t WS_CT = 226 * MiB;
constexpr size_t WS_MISCRAW = 242 * MiB;
constexpr size_t WS_KVM = 140 * MiB;
constexpr size_t WS_KR = 246 * MiB;
constexpr size_t WS_OSLC = 164 * MiB;
constexpr size_t WS_OWIN = 176 * MiB;
constexpr size_t WS_ACT = 66 * MiB;
constexpr size_t WS_END = 256 * MiB;
static_assert(WS_NL + 1024 * 64 * 4 <= WS_WT, "tab");
static_assert(WS_ACT + (size_t)T_ * FF * 2 <= WS_KCV, "act overlay");

typedef unsigned short bf16;
__device__ __forceinline__ float bf2f(bf16 v) { return __uint_as_float(((unsigned)v) << 16); }
__device__ __forceinline__ bf16 f2bf(float f) { unsigned u = __float_as_uint(f); return (bf16)((u + 0x7fffu + ((u >> 16) & 1u)) >> 16); }
__device__ __forceinline__ float sigmoidf_(float x) { return 1.f / (1.f + __expf(-x)); }
__device__ __forceinline__ float siluf_(float x) { return x / (1.f + __expf(-x)); }
__device__ __forceinline__ float wave_sum(float v) {
#pragma unroll
    for (int o = 1; o < 64; o <<= 1) v += __shfl_xor(v, o);
    return v;
}

__device__ __forceinline__ int fresh_lane() { int l; asm volatile("v_mbcnt_lo_u32_b32 %0, -1, 0\n\tv_mbcnt_hi_u32_b32 %0, -1, %0" : "=&v"(l)); return l; }
template <int M> __device__ __forceinline__ float sxf(float v) { static_assert(M >= 1 && M < 32, "swizzle xor mask"); return __int_as_float(__builtin_amdgcn_ds_swizzle(__float_as_int(v), (M << 10) | 0x1f)); }
__device__ __forceinline__ float red32_max(float v) { auto r = __builtin_amdgcn_permlane32_swap(__float_as_uint(v), __float_as_uint(v), false, false); return fmaxf(__uint_as_float(r[0]), __uint_as_float(r[1])); }
__device__ __forceinline__ float red32_sum(float v) { auto r = __builtin_amdgcn_permlane32_swap(__float_as_uint(v), __float_as_uint(v), false, false); return __uint_as_float(r[0]) + __uint_as_float(r[1]); }
__device__ __forceinline__ unsigned red32_or(unsigned v) { auto r = __builtin_amdgcn_permlane32_swap(v, v, false, false); return r[0] | r[1]; }
__device__ __forceinline__ float bperm(float v, int src_lane) { return __int_as_float(__builtin_amdgcn_ds_bpermute(src_lane << 2, __float_as_int(v))); }
__device__ __forceinline__ float wave_sum2(float v) { v += sxf<1>(v); v += sxf<2>(v); v += sxf<4>(v); v += sxf<8>(v); v += sxf<16>(v); return red32_sum(v); }
__device__ __forceinline__ float wave_max2(float v) { v = fmaxf(v, sxf<1>(v)); v = fmaxf(v, sxf<2>(v)); v = fmaxf(v, sxf<4>(v)); v = fmaxf(v, sxf<8>(v)); v = fmaxf(v, sxf<16>(v)); return red32_max(v); }
namespace pg8 {
#define PG8_LAS __attribute__((address_space(3)))
typedef unsigned short bf16_t;
typedef short bf16x8 __attribute__((ext_vector_type(8)));
typedef float f32x4 __attribute__((ext_vector_type(4)));
typedef unsigned u32x4 __attribute__((ext_vector_type(4)));
constexpr int BM = 256, BK = 64, HALF = 128, HTB = HALF * BK * 2  , STAGE_BYTES = 8 * HTB, NXCD = 8, WGM = 8;

__host__ __device__ __forceinline__ int lds_byte(int r, int c) { const int st = (r >> 4) * 2 + (c >> 5), rr = r & 15, cc = c & 31, ob = rr * 64 + cc * 2; return st * 1024 + (ob ^ (((ob >> 9) & 1) << 5)); }
__host__ __device__ __forceinline__ void stage_rc(int b, int& R, int& C) { const int st = b / 1024, sb = b % 1024, swz = sb ^ (((sb >> 9) & 1) << 5); R = (st >> 1) * 16 + swz / 64; C = (st & 1) * 32 + (swz % 64) / 2; }
__host__ __device__ __forceinline__ int perm32(int rho) { const int n = rho >> 4, i = rho & 15; return 8 * (i >> 2) + 4 * n + (i & 3); }

struct Unit { int pm, pn; };
struct Gemm { const bf16_t* A; const bf16_t* Bt; int M, N, K; };

struct StaticOrder {
    int nM, nN, nwg, G, c;
    __host__ __device__ void init(int M, int N, int G_, int c_) { nM = M / BM; nN = N / BM; nwg = nM * nN; G = G_; c = c_; }
    __host__ __device__ bool next(int i, Unit& u) const {
        const long L = (long)i * G + c; if (L >= nwg) return false;
        int wgid = (int)L; { const int q = nwg / NXCD, r = nwg % NXCD, xcd = wgid % NXCD, off = wgid / NXCD; wgid = (xcd < r ? xcd * (q + 1) : r * (q + 1) + (xcd - r) * q) + off; }
        const int nig = WGM * nN, gid = wgid / nig, fm = gid * WGM, gsz = (nM - fm) < WGM ? (nM - fm) : WGM;
        u.pm = fm + ((wgid % nig) % gsz); u.pn = (wgid % nig) / gsz; return true;
    }
    __device__ __forceinline__ void a_ready(const Unit&) const {}
    __device__ __forceinline__ void done(const Unit&) const {}
};

__device__ __forceinline__ unsigned cvt_pk_bf16(float lo, float hi) { unsigned r; asm volatile("v_cvt_pk_bf16_f32 %0, %1, %2" : "=v"(r) : "v"(lo), "v"(hi)); return r; }
typedef float f32x2 __attribute__((ext_vector_type(2)));

typedef unsigned u32x4 __attribute__((ext_vector_type(4)));
typedef unsigned u32x2 __attribute__((ext_vector_type(2)));
struct EpiIn {
    static constexpr bool PERM = true, AFTER_DRAIN = false;
    unsigned char* ws; const float *big, *bfg;
#define EPI_ROWS(...) _Pragma("unroll") for (int ai = 0; ai < 2; ++ai) _Pragma("unroll") for (int m = 0; m < 4; ++m) { \
        const int row = u.pm * BM + ai * HALF + wr * 64 + m * 16 + fr; float v[8]; \
        _Pragma("unroll") for (int i = 0; i < 4; ++i) { v[i] = acc[ai][bj][m][0][i]; v[4 + i] = acc[ai][bj][m][1][i]; } \
        asm volatile("" : "+v"(v[0]), "+v"(v[1]), "+v"(v[2]), "+v"(v[3]), "+v"(v[4]), "+v"(v[5]), "+v"(v[6]), "+v"(v[7])); \
        __VA_ARGS__ asm volatile("" ::: "memory"); }
#define EPI_PACK(w) u32x4 w; w.x = cvt_pk_bf16(v[0], v[1]); w.y = cvt_pk_bf16(v[2], v[3]); w.z = cvt_pk_bf16(v[4], v[5]); w.w = cvt_pk_bf16(v[6], v[7]);
    __device__ __forceinline__ void operator()(const f32x4 (&acc)[2][2][4][2], const Unit& u, int wr, int wc, int fr, int fq) const {
        half<0>(acc, u, wr, wc, fr, fq); half<1>(acc, u, wr, wc, fr, fq);
    }
    template <int bj> __device__ __forceinline__ void half(const f32x4 (&acc)[2][2][4][2], const Unit& u, int wr, int wc, int fr, int fq) const {
        {
            const int hb = 2 * u.pn + bj;
            int cb = 32 * wc + 8 * fq; asm volatile("" : "+v"(cb), "+v"(fr));
            if (hb <= 8) {
                bf16_t* nsa = (bf16_t*)(ws + WS_NSA) + hb * 128 + cb;
                const bool rope_hb = (hb <= 3) || hb == 5 || hb == 7;
                if (rope_hb) {
                    const float* cosP = (const float*)(ws + WS_COSP); const float* sinP = (const float*)(ws + WS_SINP);
                    const bool mine = ((wc & 1) == 0) && fq < 2; const float sg = (fq == 0) ? -1.f : 1.f; const float sc = (hb < 3) ? QSCALE : 1.f;
                    f32x4 tc0 = {0.f, 0.f, 0.f, 0.f}, tc1 = tc0, ts0 = tc0, ts1 = tc0;
                    if (mine) { const int r0 = u.pm * BM + wr * 64 + fr; tc0 = *(const f32x4*)(cosP + r0 * 8); tc1 = *(const f32x4*)(cosP + r0 * 8 + 4); ts0 = *(const f32x4*)(sinP + r0 * 8); ts1 = *(const f32x4*)(sinP + r0 * 8 + 4); }
                    EPI_ROWS({
                        float pv[8];
                        _Pragma("unroll") for (int i = 0; i < 8; ++i) pv[i] = sxf<16>(v[i]);
                        const f32x4 c0 = tc0, c1 = tc1, s0 = ts0, s1 = ts1;
                        if (mine && (ai * 4 + m) < 7) { const int nx = ai * 4 + m + 1; const int rn = u.pm * BM + (nx >> 2) * HALF + wr * 64 + (nx & 3) * 16 + fr;
                            tc0 = *(const f32x4*)(cosP + rn * 8); tc1 = *(const f32x4*)(cosP + rn * 8 + 4); ts0 = *(const f32x4*)(sinP + rn * 8); ts1 = *(const f32x4*)(sinP + rn * 8 + 4); }
                        if (mine) {
                            _Pragma("unroll") for (int i = 0; i < 4; ++i) { v[i] = v[i] * c0[i] + sg * pv[i] * s0[i]; v[4 + i] = v[4 + i] * c1[i] + sg * pv[4 + i] * s1[i]; }
                        }
                        _Pragma("unroll") for (int i = 0; i < 8; ++i) v[i] *= sc;
                        EPI_PACK(w) *(u32x4*)(nsa + (size_t)row * 1152) = w;
                    })
                } else {
                    EPI_ROWS({ EPI_PACK(w) *(u32x4*)(nsa + (size_t)row * 1152) = w; })
                }
            } else if (hb <= 11) {
                bf16_t* dst = (hb == 9) ? (bf16_t*)(ws + WS_KVL) + cb : (bf16_t*)(ws + WS_QL) + (hb - 10) * 128 + cb;
                const int ld = (hb == 9) ? 128 : 256;
                float* ssq = (hb == 9) ? (float*)(ws + WS_SSKV) : (float*)(ws + WS_SSQL);
                EPI_ROWS({ EPI_PACK(w) *(u32x4*)(dst + (size_t)row * ld) = w;
                    float sq = 0.f;
                    _Pragma("unroll") for (int i = 0; i < 8; ++i) sq += v[i] * v[i];
                    sq += sxf<16>(sq); sq = red32_sum(sq);
                    if (fq == 0) atomicAdd(ssq + row, sq); })
            } else if (hb <= 17) {
                bf16_t* cm = (bf16_t*)(ws + WS_CM) + (hb - 12) * 128 + cb;
                EPI_ROWS({ EPI_PACK(w) *(u32x4*)(cm + (size_t)row * 768) = w; })
            } else if (hb == 18) {
                float* mr = (float*)(ws + WS_MISCRAW) + cb;
                if (wc < 2) { EPI_ROWS({ *(f32x4*)(mr + (size_t)row * 64) = (f32x4){v[0], v[1], v[2], v[3]}; *(f32x4*)(mr + (size_t)row * 64 + 4) = (f32x4){v[4], v[5], v[6], v[7]}; }) }
            }
        }
    }
#undef EPI_ROWS
#undef EPI_PACK
};
struct EpiUKV {
    static constexpr bool PERM = true, AFTER_DRAIN = false;
    bf16_t* kvm; const float* sskv;
    __device__ __forceinline__ void operator()(const f32x4 (&acc)[2][2][4][2], const Unit& u, int wr, int wc, int fr, int fq) const {
        asm volatile("" : "+v"(fq), "+v"(fr));
        const int col0 = u.pn * BM + wc * 32 + 8 * fq;
        float rs8[8];
#pragma unroll
        for (int i = 0; i < 8; ++i) rs8[i] = sskv[u.pm * BM + (i >> 2) * HALF + wr * 64 + (i & 3) * 16 + fr];
#pragma unroll
        for (int i = 0; i < 8; ++i) rs8[i] = rsqrtf(rs8[i] * (1.f / 128.f) + EPS);
#pragma unroll
        for (int ai = 0; ai < 2; ++ai)
#pragma unroll
            for (int m = 0; m < 4; ++m) { const int row = u.pm * BM + ai * HALF + wr * 64 + m * 16 + fr; bf16_t* rowp = kvm + (size_t)row * 768 + col0;
                const float rs = rs8[ai * 4 + m];
#pragma unroll
                for (int bj = 0; bj < 2; ++bj) { const f32x4 a = acc[ai][bj][m][0] * rs, b = acc[ai][bj][m][1] * rs;
                    u32x4 w; w.x = cvt_pk_bf16(a[0], a[1]); w.y = cvt_pk_bf16(a[2], a[3]); w.z = cvt_pk_bf16(b[0], b[1]); w.w = cvt_pk_bf16(b[2], b[3]);
                    *(u32x4*)(rowp + bj * HALF) = w; } }
    }
};
struct EpiPlain {
    static constexpr bool PERM = true, AFTER_DRAIN = false;
    bf16_t* out; int ld;
    __device__ __forceinline__ void operator()(const f32x4 (&acc)[2][2][4][2], const Unit& u, int wr, int wc, int fr, int fq) const {
        asm volatile("" : "+v"(fq), "+v"(fr));
        const int col0 = u.pn * BM + wc * 32 + 8 * fq;
#pragma unroll
        for (int ai = 0; ai < 2; ++ai)
#pragma unroll
            for (int m = 0; m < 4; ++m) { bf16_t* rowp = out + (size_t)(u.pm * BM + ai * HALF + wr * 64 + m * 16 + fr) * ld + col0;
#pragma unroll
                for (int bj = 0; bj < 2; ++bj) { const f32x4 a = acc[ai][bj][m][0], b = acc[ai][bj][m][1];
                    u32x4 w; w.x = cvt_pk_bf16(a[0], a[1]); w.y = cvt_pk_bf16(a[2], a[3]); w.z = cvt_pk_bf16(b[0], b[1]); w.w = cvt_pk_bf16(b[2], b[3]);
                    *(u32x4*)(rowp + bj * HALF) = w; } }
    }
};
struct EpiRes {
    static constexpr bool PERM = false, AFTER_DRAIN = false;
    const float* xin_f; const bf16_t* xin_b; bf16_t* xout; const float* gate;
    __device__ __forceinline__ void operator()(const f32x4 (&acc)[2][2][4][2], const Unit& u, int wr, int wc, int fr, int fq) const {
        asm volatile("" : "+v"(fq), "+v"(fr));
        const int b = (u.pm * BM) / S_; const int col0 = u.pn * BM + wc * 32 + 4 * fq;
        f32x4 gv[2][2];
#pragma unroll
        for (int bj = 0; bj < 2; ++bj)
#pragma unroll
            for (int n = 0; n < 2; ++n) gv[bj][n] = *(const f32x4*)(gate + (size_t)b * 6144 + col0 + bj * HALF + n * 16);
        if (xin_f != nullptr) {
#pragma unroll
            for (int ai = 0; ai < 2; ++ai)
#pragma unroll
                for (int m = 0; m < 4; ++m) { const size_t off = (size_t)(u.pm * BM + ai * HALF + wr * 64 + m * 16 + fr) * D_ + col0;
#pragma unroll
                    for (int bj = 0; bj < 2; ++bj)
#pragma unroll
                        for (int n = 0; n < 2; ++n) { const f32x4 xi = *(const f32x4*)(xin_f + off + bj * HALF + n * 16); const f32x4 r = xi + gv[bj][n] * acc[ai][bj][m][n];
                            u32x2 w; w.x = cvt_pk_bf16(r[0], r[1]); w.y = cvt_pk_bf16(r[2], r[3]); *(u32x2*)(xout + off + bj * HALF + n * 16) = w; } }
        } else {
#pragma unroll
            for (int ai = 0; ai < 2; ++ai)
#pragma unroll
                for (int m = 0; m < 4; ++m) { const size_t off = (size_t)(u.pm * BM + ai * HALF + wr * 64 + m * 16 + fr) * D_ + col0;
                    u32x2 xr[2][2];
#pragma unroll
                    for (int bj = 0; bj < 2; ++bj)
#pragma unroll
                        for (int n = 0; n < 2; ++n) xr[bj][n] = *(const u32x2*)(xin_b + off + bj * HALF + n * 16);
#pragma unroll
                    for (int bj = 0; bj < 2; ++bj)
#pragma unroll
                        for (int n = 0; n < 2; ++n) { const u32x2 q = xr[bj][n]; const f32x4 a = acc[ai][bj][m][n], g4 = gv[bj][n];
                            const float r0 = __uint_as_float(q.x << 16) + g4[0] * a[0], r1 = __uint_as_float(q.x & 0xffff0000u) + g4[1] * a[1];
                            const float r2 = __uint_as_float(q.y << 16) + g4[2] * a[2], r3 = __uint_as_float(q.y & 0xffff0000u) + g4[3] * a[3];
                            u32x2 w; w.x = cvt_pk_bf16(r0, r1); w.y = cvt_pk_bf16(r2, r3); *(u32x2*)(xout + off + bj * HALF + n * 16) = w; } }
        }
    }
};
struct EpiGU {
    static constexpr bool PERM = true, AFTER_DRAIN = false;
    bf16_t* act;
    __device__ __forceinline__ void operator()(const f32x4 (&acc)[2][2][4][2], const Unit& u, int wr, int wc, int fr, int fq) const {
        asm volatile("" : "+v"(fq), "+v"(fr));
        const int col0 = u.pn * HALF + wc * 32 + 8 * fq;
#pragma unroll
        for (int ai = 0; ai < 2; ++ai)
#pragma unroll
            for (int m = 0; m < 4; ++m) { const int row = u.pm * BM + ai * HALF + wr * 64 + m * 16 + fr; float o[8];
#pragma unroll
                for (int n = 0; n < 2; ++n)
#pragma unroll
                    for (int i = 0; i < 4; ++i) { const float g = acc[ai][0][m][n][i], up = acc[ai][1][m][n][i]; o[4 * n + i] = g / (1.f + __expf(-g)) * up; }
                u32x4 w; w.x = cvt_pk_bf16(o[0], o[1]); w.y = cvt_pk_bf16(o[2], o[3]); w.z = cvt_pk_bf16(o[4], o[5]); w.w = cvt_pk_bf16(o[6], o[7]);
                *(u32x4*)(act + (size_t)row * FF + col0) = w; }
    }
};
template <class Epi, class Sched, bool ALIGN_EPI = false, bool SP2 = false>
__device__ __forceinline__ void gemm_phase(PG8_LAS unsigned char* lds, const Gemm g, const Sched& S, const Epi& E, int wid_in) {
    const int wid = __builtin_amdgcn_readfirstlane(wid_in), lane = fresh_lane(), tid = wid * 64 + lane, wr = wid >> 2, wc = wid & 3;
    const int K = g.K, nt = K / BK;
    unsigned voffA[2], voffB[2];
#pragma unroll
    for (int i = 0; i < 2; ++i) { int R, C; stage_rc(tid * 16 + i * 8192, R, C); const int Rb = Epi::PERM ? ((R & ~31) + perm32(R & 31)) : R;
        voffA[i] = (unsigned)(R * K + C) * 2u; voffB[i] = (unsigned)(Rb * K + C) * 2u; }
    const size_t kstep = (size_t)(BK * 2);
    const size_t hstep = (size_t)HALF * K * 2;
    const size_t tstep = 2 * hstep;
    const unsigned ldsw = (unsigned)wid * 1024u;
    const int aoff = lds_byte(wr * 64 + (lane & 15), (lane >> 4) * 8), boff = lds_byte(wc * 32 + (lane & 15), (lane >> 4) * 8);
#define PG8_SA(b, h) (((b) * 2 + (h)) * HTB)
#define PG8_SB(b, h) ((4 + (b) * 2 + (h)) * HTB)
#define PG8_STAGE(bufoff, gbase, voff) do { _Pragma("unroll") for (int _i = 0; _i < 2; ++_i) \
        __builtin_amdgcn_global_load_lds((const unsigned*)((const char*)(gbase) + (voff)[_i]), (PG8_LAS unsigned*)(lds + (bufoff) + ldsw + _i * 8192), 16, 0, 0); } while (0)
#define PG8_LDA(dst, b, h) do { _Pragma("unroll") for (int m = 0; m < 4; ++m) _Pragma("unroll") for (int k = 0; k < 2; ++k) dst[m][k] = *(const PG8_LAS bf16x8*)(lds + PG8_SA(b, h) + aoff + m * 2048 + k * 1024); } while (0)
#define PG8_LDB(dst, b, h) do { _Pragma("unroll") for (int n = 0; n < 2; ++n) _Pragma("unroll") for (int k = 0; k < 2; ++k) dst[n][k] = *(const PG8_LAS bf16x8*)(lds + PG8_SB(b, h) + boff + n * 2048 + k * 1024); } while (0)
#define PG8_MMA(ai, bj, At, Bt) do { __builtin_amdgcn_s_setprio(1); _Pragma("unroll") for (int m = 0; m < 4; ++m) _Pragma("unroll") for (int n = 0; n < 2; ++n) _Pragma("unroll") for (int k = 0; k < 2; ++k) \
        acc[ai][bj][m][n] = __builtin_amdgcn_mfma_f32_16x16x32_bf16(Bt[n][k], At[m][k], acc[ai][bj][m][n], 0, 0, 0); __builtin_amdgcn_s_setprio(0); } while (0)
#define PG8_WAIT_V(n) asm volatile("s_waitcnt vmcnt(" #n ")" ::: "memory")
#define PG8_WAIT_L(n) asm volatile("s_waitcnt lgkmcnt(" #n ")" ::: "memory")
#define PG8_BAR __builtin_amdgcn_s_barrier()
#define PG8_SCHED __builtin_amdgcn_sched_barrier(0)
    Unit cur, nxt; int ui = 0;
    if (!S.next(0, cur)) return;
    f32x4 acc[2][2][4][2];
#pragma unroll
    for (int a = 0; a < 2; ++a)
#pragma unroll
        for (int b = 0; b < 2; ++b)
#pragma unroll
            for (int m = 0; m < 4; ++m)
#pragma unroll
                for (int n = 0; n < 2; ++n) acc[a][b][m][n] = (f32x4){0.f, 0.f, 0.f, 0.f};
    bf16x8 At[4][2], B0[2][2], B1[2][2];
    const char* cA = (const char*)g.A + (size_t)cur.pm * tstep; const char* cB = (const char*)g.Bt + (size_t)cur.pn * tstep;
    S.a_ready(cur);
    if constexpr (SP2) {
        PG8_STAGE(PG8_SB(0, 0), cB, voffB); PG8_STAGE(PG8_SB(0, 1), cB + hstep, voffB); PG8_STAGE(PG8_SA(0, 0), cA, voffA); PG8_STAGE(PG8_SA(0, 1), cA + hstep, voffA);
        if (wr == 1) PG8_BAR;
        PG8_WAIT_V(2); PG8_BAR;
        PG8_STAGE(PG8_SB(1, 0), cB + kstep, voffB); PG8_STAGE(PG8_SA(1, 0), cA + kstep, voffA); PG8_STAGE(PG8_SB(1, 1), cB + hstep + kstep, voffB);
        PG8_WAIT_V(6); PG8_BAR;
    } else {
        PG8_STAGE(PG8_SB(0, 0), cB, voffB); PG8_STAGE(PG8_SA(0, 0), cA, voffA); PG8_STAGE(PG8_SB(0, 1), cB + hstep, voffB); PG8_STAGE(PG8_SA(0, 1), cA + hstep, voffA);
        if (wr == 1) PG8_BAR;
        PG8_WAIT_V(4); PG8_BAR;
        PG8_STAGE(PG8_SB(1, 0), cB + kstep, voffB); PG8_STAGE(PG8_SA(1, 0), cA + kstep, voffA); PG8_STAGE(PG8_SB(1, 1), cB + hstep + kstep, voffB);
        PG8_WAIT_V(6); PG8_BAR;
    }
    for (;;) {
        const bool has_next = S.next(ui + 1, nxt);
        const char* nA = has_next ? (const char*)g.A + (size_t)nxt.pm * tstep : cA; const char* nB = has_next ? (const char*)g.Bt + (size_t)nxt.pn * tstep : cB;
        for (int t = 0; t < nt; t += 2) {
            const bool last = (t == nt - 2);
            const char* a1 = cA + (size_t)(t + 1) * kstep;
            const char* a2 = last ? nA : cA + (size_t)(t + 2) * kstep; const char* b2 = last ? nB : cB + (size_t)(t + 2) * kstep;
            const char* a3 = a2 + kstep; const char* b3 = b2 + kstep;
            if (last && has_next) S.a_ready(nxt);
            if constexpr (SP2) {
            PG8_LDB(B0, 0, 0); PG8_LDB(B1, 0, 1); PG8_SCHED; PG8_LDA(At, 0, 0); PG8_STAGE(PG8_SA(1, 1), a1 + hstep, voffA);
            PG8_WAIT_V(8); PG8_WAIT_L(0); PG8_BAR; PG8_MMA(0, 0, At, B0); PG8_MMA(0, 1, At, B1); PG8_BAR; PG8_SCHED;
            PG8_LDA(At, 0, 1); PG8_STAGE(PG8_SB(0, 0), b2, voffB); PG8_STAGE(PG8_SB(0, 1), b2 + hstep, voffB); PG8_STAGE(PG8_SA(0, 0), a2, voffA);
            PG8_WAIT_V(8); PG8_WAIT_L(0); PG8_BAR; PG8_MMA(1, 0, At, B0); PG8_MMA(1, 1, At, B1); PG8_BAR; PG8_SCHED;
            PG8_LDB(B0, 1, 0); PG8_LDB(B1, 1, 1); PG8_SCHED; PG8_LDA(At, 1, 0); PG8_STAGE(PG8_SA(0, 1), a2 + hstep, voffA);
            PG8_WAIT_V(8); PG8_WAIT_L(0); PG8_BAR; PG8_MMA(0, 0, At, B0); PG8_MMA(0, 1, At, B1); PG8_BAR; PG8_SCHED;
            PG8_LDA(At, 1, 1); PG8_STAGE(PG8_SB(1, 0), b3, voffB); PG8_STAGE(PG8_SB(1, 1), b3 + hstep, voffB); PG8_STAGE(PG8_SA(1, 0), a3, voffA);
            PG8_WAIT_V(8); PG8_WAIT_L(0); PG8_BAR; PG8_MMA(1, 0, At, B0); PG8_MMA(1, 1, At, B1); PG8_BAR; PG8_SCHED;
            } else {
            PG8_LDB(B0, 0, 0); PG8_SCHED; PG8_LDA(At, 0, 0); PG8_STAGE(PG8_SA(1, 1), a1 + hstep, voffA);
            PG8_WAIT_L(8); PG8_BAR; PG8_WAIT_L(0); PG8_MMA(0, 0, At, B0); PG8_BAR; PG8_SCHED;
            PG8_LDB(B1, 0, 1); PG8_STAGE(PG8_SB(0, 0), b2, voffB);
            PG8_BAR; PG8_WAIT_L(0); PG8_MMA(0, 1, At, B1); PG8_BAR;
            PG8_LDA(At, 0, 1); PG8_STAGE(PG8_SA(0, 0), a2, voffA);
            PG8_BAR; PG8_WAIT_L(0); PG8_MMA(1, 0, At, B0); PG8_BAR; PG8_SCHED;
            PG8_STAGE(PG8_SB(0, 1), b2 + hstep, voffB);
            PG8_WAIT_V(6); PG8_BAR; PG8_MMA(1, 1, At, B1); PG8_BAR;
            PG8_LDB(B0, 1, 0); PG8_SCHED; PG8_LDA(At, 1, 0); PG8_STAGE(PG8_SA(0, 1), a2 + hstep, voffA);
            PG8_WAIT_L(8); PG8_BAR; PG8_WAIT_L(0); PG8_MMA(0, 0, At, B0); PG8_BAR; PG8_SCHED;
            PG8_LDB(B1, 1, 1); PG8_STAGE(PG8_SB(1, 0), b3, voffB);
            PG8_BAR; PG8_WAIT_L(0); PG8_MMA(0, 1, At, B1); PG8_BAR;
            PG8_LDA(At, 1, 1); PG8_STAGE(PG8_SA(1, 0), a3, voffA);
            PG8_BAR; PG8_WAIT_L(0); PG8_MMA(1, 0, At, B0); PG8_BAR; PG8_SCHED;
            PG8_STAGE(PG8_SB(1, 1), b3 + hstep, voffB);
            PG8_WAIT_V(6); PG8_BAR; PG8_MMA(1, 1, At, B1); PG8_BAR;
            }
        }
        if constexpr (ALIGN_EPI) { if (wr == 0) PG8_BAR; }
        if constexpr (!Epi::AFTER_DRAIN) { const int ln = fresh_lane(); E(acc, cur, wr, wc, ln & 15, ln >> 4); S.done(cur); }
        if (!has_next) break;
#pragma unroll
        for (int a = 0; a < 2; ++a)
#pragma unroll
            for (int b = 0; b < 2; ++b)
#pragma unroll
                for (int m = 0; m < 4; ++m)
#pragma unroll
                    for (int n = 0; n < 2; ++n) acc[a][b][m][n] = (f32x4){0.f, 0.f, 0.f, 0.f};
        cur = nxt; cA = nA; cB = nB; ++ui;
        if constexpr (ALIGN_EPI) { if (wr == 1) PG8_BAR; }
    }
    PG8_WAIT_V(0);
    if constexpr (!ALIGN_EPI) { if (wr == 0) PG8_BAR; }
    PG8_BAR;
    if constexpr (Epi::AFTER_DRAIN) { const int ln = fresh_lane(); E.fused(acc, cur, wr, wc, ln & 15, ln >> 4, lds, wid, ln); S.done(cur); }
#undef PG8_SA
#undef PG8_SB
#undef PG8_STAGE
#undef PG8_LDA
#undef PG8_LDB
#undef PG8_MMA
#undef PG8_WAIT_V
#undef PG8_WAIT_L
#undef PG8_BAR
#undef PG8_SCHED
}
}

#define GAS __attribute__((address_space(1)))
#define LAS __attribute__((address_space(3)))
typedef float f32x4 __attribute__((ext_vector_type(4)));
typedef unsigned v4u __attribute__((ext_vector_type(4)));
typedef GAS unsigned gu32;
#define XB_TMO      128
#define XB_XCNT(j)  (256  + 64 * (j))
#define XB_XSUB(j)  (1280 + 64 * (j))
#define XB_XGEN(j)  (2304 + 64 * (j))
#define XB_TOP      3328
#define XB_TOPGEN   3392
#define XCD_BAR_WORDS 3456
#define XB_SPIN_CAP (1u << 18)

__device__ __forceinline__ unsigned xb_ld(unsigned* p)              { return __hip_atomic_load(p, __ATOMIC_RELAXED, __HIP_MEMORY_SCOPE_AGENT); }
__device__ __forceinline__ unsigned xb_add(unsigned* p, unsigned v) { return __hip_atomic_fetch_add(p, v, __ATOMIC_RELAXED, __HIP_MEMORY_SCOPE_AGENT); }
__device__ __forceinline__ unsigned xb_xcc_id() { return (unsigned)__builtin_amdgcn_s_getreg((3 << 11) | 20) & 0xFu; }
#define XB_SPIN(cond, bar) do { unsigned _sp = 0; while (cond) { __builtin_amdgcn_s_sleep(1); \
    if ((++_sp & 255u) == 0u) { if (xb_ld(&(bar)[XB_TMO])) break; if (_sp > XB_SPIN_CAP) { atomicAdd(&(bar)[XB_TMO], 1u); break; } } } } while (0)

struct XcdBarrier {
    unsigned* bar; unsigned x;
    volatile LAS unsigned* st;
};

__device__ __forceinline__ XcdBarrier xcd_barrier_post(unsigned* bar, volatile LAS unsigned* st, int tid) {
    XcdBarrier b; b.bar = bar; b.x = xb_xcc_id(); b.st = st;
    if (tid == 0) (void)xb_add(&bar[XB_XCNT(b.x)], 1u);
    return b;
}
__device__ __forceinline__ void xcd_barrier_complete(unsigned* bar, unsigned x, unsigned& nloc, unsigned& nx) {
    const unsigned G = gridDim.x * gridDim.y * gridDim.z;
    unsigned sum, cnt, mine, sp = 0u;
    for (;;) {
        sum = 0u; cnt = 0u; mine = 0u;
#pragma unroll
        for (unsigned j = 0; j < 16; ++j) { const unsigned c = xb_ld(&bar[XB_XCNT(j)]); sum += c; cnt += (c > 0u) ? 1u : 0u; mine = (j == x) ? c : mine; }
        if (sum == G) break;
        __builtin_amdgcn_s_sleep(1);
        if ((++sp & 255u) == 0u) { if (xb_ld(&bar[XB_TMO])) break; if (sp > XB_SPIN_CAP) { atomicAdd(&bar[XB_TMO], 1u); break; } }
    }
    nloc = mine > 0u ? mine : 1u; nx = cnt > 0u ? cnt : 1u;
}

__device__ __forceinline__ void xcd_barrier(const XcdBarrier& b, int tid) {
    asm volatile("s_waitcnt vmcnt(0)" ::: "memory");
    __syncthreads();
    if (tid == 0) {
        unsigned* bar = b.bar;
        __builtin_amdgcn_s_waitcnt(0);
        unsigned nloc = b.st[0], nx = b.st[1];
        if (nloc == 0u) { xcd_barrier_complete(bar, b.x, nloc, nx); b.st[0] = nloc; b.st[1] = nx; }
        const unsigned old = xb_add(&bar[XB_XSUB(b.x)], 1u);
        const unsigned gen = old / nloc;
        if (old + 1u == (gen + 1u) * nloc) {
            __builtin_amdgcn_fence(__ATOMIC_RELEASE, "agent");
            asm volatile("s_waitcnt vmcnt(0)" ::: "memory");
            const unsigned og = xb_add(&bar[XB_TOP], 1u);
            const unsigned tg = og / nx;
            if (og + 1u == (tg + 1u) * nx) xb_add(&bar[XB_TOPGEN], 1u);
            else XB_SPIN(xb_ld(&bar[XB_TOPGEN]) == tg, bar);
            __builtin_amdgcn_fence(__ATOMIC_ACQUIRE, "agent");
            xb_add(&bar[XB_XGEN(b.x)], 1u);
            asm volatile("s_waitcnt vmcnt(0)" ::: "memory");
        } else {
            XB_SPIN(xb_ld(&bar[XB_XGEN(b.x)]) == gen, bar);
            __builtin_amdgcn_fence(__ATOMIC_ACQUIRE, "agent");
            asm volatile("s_waitcnt vmcnt(0)" ::: "memory");
        }
    }
    __syncthreads();
}

constexpr int NTHR = 512, NWAVES = 8;
constexpr int RING_BYTES = 131072, MISC_OFF = RING_BYTES + 320, LDS_BYTES = 147456;
constexpr int CW_BAR = 4096;
constexpr size_t CTL_ZERO_BYTES = 64 * 1024;
constexpr size_t WT_IN = WS_WT, WT_OUT = WT_IN + (size_t)2560 * 1024 * 2, WT_GU = WT_OUT + (size_t)1024 * 1024 * 2, WT_DOWN = WT_GU + (size_t)5632 * 1024 * 2,
                 WT_UQ = WT_DOWN + (size_t)1024 * 2816 * 2, WT_UKV = WT_UQ + (size_t)768 * 256 * 2, WT_CK = WT_UKV + (size_t)768 * 128 * 2, WT_CV = WT_CK + (size_t)64 * 2048 * 2,
                 WT_QM = WT_CV + (size_t)64 * 2048 * 2, WT_KM = WT_QM + 4 * 64 * 64 * 2, WT_END = WT_KM + 4 * 64 * 64 * 2;
static_assert(WT_END <= WS_HB, "weights");
constexpr int NPH = 22, PPL = 10;
constexpr int PROBE_SEL = 0;
constexpr int REP_MASK = 0;
#ifndef PHM
#define PHM 0xffff
#endif
struct MP { const float* in[N_IN]; float* out; unsigned char* ws; int ph_lo, ph_hi, coop, pad; };

struct MPK {
    const __attribute__((address_space(4))) MP* k;
    struct InArr { const __attribute__((address_space(4))) MP* k; __device__ __forceinline__ const float* operator[](int i) const { return k->in[i]; } };
    __device__ __forceinline__ InArr in_() const { return InArr{k}; }
};
#define PIN(i) (p.k->in[i])
__device__ __forceinline__ unsigned pk2(float lo, float hi) { return (unsigned)f2bf(lo) | ((unsigned)f2bf(hi) << 16); }
struct MapId { int n; __device__ __forceinline__ int operator()(int c) const { return c < n ? c : -1; } };
struct MapIn { __device__ __forceinline__ int operator()(int c) const {
    if (c < 1152) return c; if (c < 1280) return 1426 + (c - 1152); if (c < 1536) return 1170 + (c - 1280); if (c < 2304) return 1586 + (c - 1536);
    if (c < 2336) return 1554 + (c - 2304); if (c < 2354) return 1152 + (c - 2336); if (c < 2362) return c; return -1; } };
struct MapGU { __device__ __forceinline__ int operator()(int c) const { const int t = c >> 8, w = c & 255; return (w < 128) ? t * 128 + w : FF + t * 128 + (w - 128); } };
template <class Map> __device__ __forceinline__ void transpose_item(const float* W, int K, int ldw, const Map& map, const float* kscale, bf16* WT, LAS float* scr, int item, int nblk, int lane) {
    const int kb = item / nblk, nb = item % nblk, k0 = 64 * kb, n0 = 32 * nb;
    const int np = 2 * (lane & 15);
    const int sc = map(n0 + np);
    float2 tv[16];
#pragma unroll
    for (int i = 0; i < 16; ++i) { const int kk = 4 * i + (lane >> 4); tv[i] = (sc >= 0) ? *(const float2*)(W + (size_t)(k0 + kk) * ldw + sc) : make_float2(0.f, 0.f); }
    asm volatile("" : "+v"(tv[0]), "+v"(tv[1]), "+v"(tv[2]), "+v"(tv[3]), "+v"(tv[4]), "+v"(tv[5]), "+v"(tv[6]), "+v"(tv[7]));
    asm volatile("" : "+v"(tv[8]), "+v"(tv[9]), "+v"(tv[10]), "+v"(tv[11]), "+v"(tv[12]), "+v"(tv[13]), "+v"(tv[14]), "+v"(tv[15]));
#pragma unroll
    for (int i = 0; i < 16; ++i) { const int kk = 4 * i + (lane >> 4); float2 v = tv[i];
        if (kscale) { const float ksc = kscale[k0 + kk]; v.x *= ksc; v.y *= ksc; } scr[kk * 33 + np] = v.x; scr[kk * 33 + np + 1] = v.y; }
    asm volatile("s_waitcnt lgkmcnt(0)" ::: "memory");
    const int c = lane & 7;
#pragma unroll
    for (int j = 0; j < 4; ++j) { const int n = (lane >> 3) + 8 * j; const LAS float* s = scr + (8 * c) * 33 + n;
        v4u o; o.x = pk2(s[0 * 33], s[1 * 33]); o.y = pk2(s[2 * 33], s[3 * 33]); o.z = pk2(s[4 * 33], s[5 * 33]); o.w = pk2(s[6 * 33], s[7 * 33]);
        *(v4u*)(WT + (size_t)(n0 + n) * K + k0 + 8 * c) = o; }
    asm volatile("s_waitcnt lgkmcnt(0)" ::: "memory");
}
typedef unsigned u2raw __attribute__((ext_vector_type(2)));
__device__ __forceinline__ float4 unpk4(uint2 q) { return make_float4(__uint_as_float(q.x << 16), __uint_as_float(q.x & 0xffff0000u), __uint_as_float(q.y << 16), __uint_as_float(q.y & 0xffff0000u)); }
template <bool XBF> __device__ __forceinline__ void norm_rows(const void* xv, const float* g, const float* shift, const float* scale, bf16* hb, int gw, int ngw, int lane) {
    const int rpw = T_ / ngw, m0 = gw * rpw, b = m0 / S_;
    float4 gs[4], sh[4];
#pragma unroll
    for (int j = 0; j < 4; ++j) { const int col = 4 * lane + 256 * j; gs[j] = *(const float4*)(g + col);
        const float4 sc = *(const float4*)(scale + (size_t)b * 6144 + col); sh[j] = *(const float4*)(shift + (size_t)b * 6144 + col);
        gs[j].x *= 1.f + sc.x; gs[j].y *= 1.f + sc.y; gs[j].z *= 1.f + sc.z; gs[j].w *= 1.f + sc.w; }
    typedef typename std::conditional<XBF, uint2, float4>::type raw_t;
    const raw_t* x = (const raw_t*)xv;
    raw_t nv[4], nw[4];
    { const raw_t* xr = x + (size_t)m0 * (D_ / 4) + lane;
#pragma unroll
      for (int j = 0; j < 4; ++j) { nv[j] = xr[64 * j]; nw[j] = xr[D_ / 4 + 64 * j]; } }
    for (int r = 0; r < rpw; r += 2) {
        const int m = m0 + r;
        float4 v[4], w[4]; float s = 0.f, s2 = 0.f;
#pragma unroll
        for (int j = 0; j < 4; ++j) { if constexpr (XBF) { v[j] = unpk4(nv[j]); w[j] = unpk4(nw[j]); } else { v[j] = nv[j]; w[j] = nw[j]; } }
        if (r + 2 < rpw) { const raw_t* xr = x + (size_t)(m + 2) * (D_ / 4) + lane;
#pragma unroll
            for (int j = 0; j < 4; ++j) { nv[j] = xr[64 * j]; nw[j] = xr[D_ / 4 + 64 * j]; } }
#pragma unroll
        for (int j = 0; j < 4; ++j) { s += v[j].x * v[j].x + v[j].y * v[j].y + v[j].z * v[j].z + v[j].w * v[j].w; s2 += w[j].x * w[j].x + w[j].y * w[j].y + w[j].z * w[j].z + w[j].w * w[j].w; }
        const float r1 = rsqrtf(wave_sum2(s) * (1.f / D_) + EPS), r2 = rsqrtf(wave_sum2(s2) * (1.f / D_) + EPS);
#pragma unroll
        for (int j = 0; j < 4; ++j) {
            const int col = 4 * lane + 256 * j;
            float4 o, o2;
            o.x = v[j].x * r1 * gs[j].x + sh[j].x; o.y = v[j].y * r1 * gs[j].y + sh[j].y; o.z = v[j].z * r1 * gs[j].z + sh[j].z; o.w = v[j].w * r1 * gs[j].w + sh[j].w;
            o2.x = w[j].x * r2 * gs[j].x + sh[j].x; o2.y = w[j].y * r2 * gs[j].y + sh[j].y; o2.z = w[j].z * r2 * gs[j].z + sh[j].z; o2.w = w[j].w * r2 * gs[j].w + sh[j].w;
            uint2 q; q.x = pk2(o.x, o.y); q.y = pk2(o.z, o.w); *(uint2*)(hb + (size_t)m * D_ + col) = q;
            uint2 q2; q2.x = pk2(o2.x, o2.y); q2.y = pk2(o2.z, o2.w); *(uint2*)(hb + (size_t)(m + 1) * D_ + col) = q2;
        }
    }
}
__device__ __forceinline__ void final_load(const bf16* xb, LAS unsigned char* lds, int tid) {
    const int rows = T_ / (int)gridDim.x; const v4u* src = (const v4u*)(xb + (size_t)blockIdx.x * rows * D_);
    const int n16 = rows * (D_ / 8);
    for (int i0 = 0; i0 < n16; i0 += 8 * NTHR) {
        v4u t[8];
#pragma unroll
        for (int k = 0; k < 8; ++k) { const int i = i0 + k * NTHR + tid; t[k] = (i < n16) ? src[i] : v4u{0u, 0u, 0u, 0u}; }
#pragma unroll
        for (int k = 0; k < 8; ++k) { const int i = i0 + k * NTHR + tid; if (i < n16) *(LAS v4u*)(lds + (size_t)i * 16) = t[k]; }
    }
}
__device__ __forceinline__ void final_store(const float* g, float* out, LAS const unsigned char* lds, int tid) {
    const int rows = T_ / (int)gridDim.x, wave = tid >> 6, lane = tid & 63;
    float4 gs[4];
#pragma unroll
    for (int j = 0; j < 4; ++j) gs[j] = *(const float4*)(g + 4 * lane + 256 * j);
    for (int r = wave; r < rows; r += NWAVES) {
        float4 v[4]; float s = 0.f;
#pragma unroll
        for (int j = 0; j < 4; ++j) { const u2raw q = *(LAS const u2raw*)(lds + (size_t)r * (D_ * 2) + 8 * lane + 512 * j); v[j] = unpk4(make_uint2(q.x, q.y)); s += v[j].x * v[j].x + v[j].y * v[j].y + v[j].z * v[j].z + v[j].w * v[j].w; }
        const float r1 = rsqrtf(wave_sum2(s) * (1.f / D_) + EPS);
        float* o = out + ((size_t)blockIdx.x * rows + r) * D_ + 4 * lane;
#pragma unroll
        for (int j = 0; j < 4; ++j) *(float4*)(o + 256 * j) = make_float4(v[j].x * r1 * gs[j].x, v[j].y * r1 * gs[j].y, v[j].z * r1 * gs[j].z, v[j].w * r1 * gs[j].w);
    }
}
__device__ __forceinline__ void ph_p0(const MPK& p, LAS unsigned char* lds, int tid) {
    const int wave = tid >> 6, lane = tid & 63;
    LAS float* ca = (LAS float*)lds; LAS float* red = ca + 8192;
    unsigned char* ws = p.k->ws; float* mod = (float*)(ws + WS_MOD);
    const float* c = PIN(I_C);
    for (int i = tid; i < 8192; i += NTHR) ca[i] = siluf_(c[i]);
    __syncthreads();
    for (int item = blockIdx.x; item < 192; item += gridDim.x) {
        const int l = item / 96, j = (item % 96) * 64 + lane;
        const float* w = PIN(I_WADA) + (size_t)l * 1024 * 6144 + j + (size_t)(wave * 128) * 6144;
        float acc[8];
#pragma unroll
        for (int b = 0; b < 8; ++b) acc[b] = 0.f;
        float wn[16];
#pragma unroll
        for (int i = 0; i < 16; ++i) wn[i] = w[(size_t)i * 6144];
        for (int k0 = 0; k0 < 128; k0 += 16) {
            float wv[16];
            asm volatile("" : "+v"(wn[0]), "+v"(wn[1]), "+v"(wn[2]), "+v"(wn[3]), "+v"(wn[4]), "+v"(wn[5]), "+v"(wn[6]), "+v"(wn[7]),
                              "+v"(wn[8]), "+v"(wn[9]), "+v"(wn[10]), "+v"(wn[11]), "+v"(wn[12]), "+v"(wn[13]), "+v"(wn[14]), "+v"(wn[15]));
#pragma unroll
            for (int i = 0; i < 16; ++i) wv[i] = wn[i];
            if (k0 + 16 < 128) {
#pragma unroll
                for (int i = 0; i < 16; ++i) wn[i] = w[(size_t)(k0 + 16 + i) * 6144];
            }
#pragma unroll
            for (int i4 = 0; i4 < 4; ++i4)
#pragma unroll
                for (int b = 0; b < 8; ++b) { const f32x4 c4 = *(LAS const f32x4*)(ca + b * 1024 + wave * 128 + k0 + 4 * i4);
                    acc[b] += (c4[0] * wv[4 * i4] + c4[1] * wv[4 * i4 + 1]) + (c4[2] * wv[4 * i4 + 2] + c4[3] * wv[4 * i4 + 3]); }
        }
#pragma unroll
        for (int b = 0; b < 8; ++b) red[(wave * 8 + b) * 64 + lane] = acc[b];
        __syncthreads();
        { const int b = wave; float s2 = 0.f;
#pragma unroll
          for (int w8 = 0; w8 < 8; ++w8) s2 += red[(w8 * 8 + b) * 64 + lane];
          mod[((size_t)l * 8 + b) * 6144 + (item % 96) * 64 + lane] = s2 + PIN(I_BADA)[l * 6144 + (item % 96) * 64 + lane]; }
        __syncthreads();
    }
    const int* pos = (const int*)PIN(I_POS);
    float *cosP = (float*)(ws + WS_COSP), *sinP = (float*)(ws + WS_SINP), *cosM = (float*)(ws + WS_COSM), *sinM = (float*)(ws + WS_SINM);
    for (int i = blockIdx.x * NTHR + tid; i < T_ * 24; i += gridDim.x * NTHR) {
        const int m = i / 24, f = i % 24;
        double inv; if (f < 8) inv = pow(500000.0, -(double)(2 * f) / 16.0); else inv = pow(500000.0, -(double)(2 * (f - 8)) / 32.0);
        const float ang = (float)pos[m] * (float)inv;
        const double a = (double)ang, kq = rint(a * 0.15915494309189535), r = a - kq * 6.283185307179586476925;
        const float cs = (float)cos(r), sn = (float)sin(r);
        if (f < 8) { cosP[m * 8 + f] = cs; sinP[m * 8 + f] = sn; } else { cosM[m * 16 + f - 8] = cs; sinM[m * 16 + f - 8] = sn; }
    }
}
__device__ __forceinline__ void early_transposes(const MPK& p, int l, LAS unsigned char* lds, int tid, int first) {
    const int wave = tid >> 6, lane = tid & 63;
    if ((int)blockIdx.x < first) return;
    const int gw = ((int)blockIdx.x - first) * NWAVES + wave, ngw = ((int)gridDim.x - first) * NWAVES;
    unsigned char* ws = p.k->ws;
    LAS float* scr = (LAS float*)(lds + wave * 8704);
    constexpr int I0 = 16 * 80, I4 = 4 * 24, I5 = 2 * 24, I6 = 32 * 2, I7 = 32 * 2, I8 = 8, I9 = 8;
    constexpr int NIT = I0 + I4 + I5 + I6 + I7 + I8 + I9;
    for (int it = gw; it < NIT; it += ngw) {
        int r = it;
        if (r < I0) { transpose_item(PIN(I_WIN) + (size_t)l * D_ * DIN, D_, DIN, MapIn{}, nullptr, (bf16*)(ws + WT_IN), scr, r, 80, lane); continue; } r -= I0;
        if (r < I4) { transpose_item(PIN(I_WUQ) + (size_t)l * 256 * 576, 256, 576, MapId{576}, PIN(I_GQL) + l * 256, (bf16*)(ws + WT_UQ), scr, r, 24, lane); continue; } r -= I4;
        if (r < I5) { transpose_item(PIN(I_WUKV) + (size_t)l * 128 * 768, 128, 768, MapId{768}, PIN(I_GKVL) + l * 128, (bf16*)(ws + WT_UKV), scr, r, 24, lane); continue; } r -= I5;
        if (r < I6) { transpose_item(PIN(I_WCK) + (size_t)l * 2048 * 64, 2048, 64, MapId{64}, nullptr, (bf16*)(ws + WT_CK), scr, r, 2, lane); continue; } r -= I6;
        if (r < I7) { transpose_item(PIN(I_WCV) + (size_t)l * 2048 * 64, 2048, 64, MapId{64}, nullptr, (bf16*)(ws + WT_CV), scr, r, 2, lane); continue; } r -= I7;
        if (r < I8) { const int h = r >> 1; transpose_item(PIN(I_WQM) + (size_t)l * 16384 + h * 4096, 64, 64, MapId{64}, nullptr, (bf16*)(ws + WT_QM) + h * 4096, scr, r & 1, 2, lane); continue; } r -= I8;
        { const int h = r >> 1; transpose_item(PIN(I_WKM) + (size_t)l * 16384 + h * 4096, 64, 64, MapId{64}, nullptr, (bf16*)(ws + WT_KM) + h * 4096, scr, r & 1, 2, lane); }
    }
}
__device__ __forceinline__ void ph_prep(const MPK& p, int l, LAS unsigned char* lds, int tid) {
    const int wave = tid >> 6, lane = tid & 63;
    const int gw = blockIdx.x * NWAVES + wave, ngw = gridDim.x * NWAVES;
    unsigned char* ws = p.k->ws;
    LAS float* scr = (LAS float*)(lds + wave * 8704);
    for (int i = blockIdx.x * NTHR + tid; i < 2 * T_; i += gridDim.x * NTHR) ((float*)(ws + WS_SSQL))[i] = 0.f;
    if (l == 0) early_transposes(p, l, lds, tid, 0);
    const float* modl = (const float*)(ws + WS_MOD) + (size_t)l * 8 * 6144;
    if (l == 0) norm_rows<false>(PIN(I_X), PIN(I_GN1) + l * D_, modl + 0, modl + 1024, (bf16*)(ws + WS_HB), gw, ngw, lane);
    else norm_rows<true>(p.k->out, PIN(I_GN1) + l * D_, modl + 0, modl + 1024, (bf16*)(ws + WS_HB), gw, ngw, lane);
}
__device__ __forceinline__ void late_transposes(const MPK& p, int l, LAS unsigned char* lds, int tid, int first) {
    const int wave = tid >> 6, lane = tid & 63;
    if ((int)blockIdx.x < first) return;
    const int gw = ((int)blockIdx.x - first) * NWAVES + wave, ngw = ((int)gridDim.x - first) * NWAVES;
    unsigned char* ws = p.k->ws;
    LAS float* scr = (LAS float*)(lds + wave * 8704);
    constexpr int I1 = 16 * 32, I2 = 16 * 176, I3 = 44 * 32;
    for (int it = gw; it < I1 + I2 + I3; it += ngw) {
        int r = it;
        if (r < I1) { transpose_item(PIN(I_WOUT) + (size_t)l * D_ * D_, D_, D_, MapId{D_}, nullptr, (bf16*)(ws + WT_OUT), scr, r, 32, lane); continue; } r -= I1;
        if (r < I2) { transpose_item(PIN(I_WGU) + (size_t)l * D_ * 2 * FF, D_, 2 * FF, MapGU{}, nullptr, (bf16*)(ws + WT_GU), scr, r, 176, lane); continue; } r -= I2;
        transpose_item(PIN(I_WDOWN) + (size_t)l * FF * D_, FF, D_, MapId{D_}, nullptr, (bf16*)(ws + WT_DOWN), scr, r, 32, lane);
    }
}
__device__ __forceinline__ void ph_mixnorm(const MPK& p, int l, int tid) {
    const int gw = blockIdx.x * NWAVES + (tid >> 6), ngw = gridDim.x * NWAVES, lane = tid & 63;
    unsigned char* ws = p.k->ws;
    bf16* mix = (bf16*)(ws + WS_HB); const float* ga = PIN(I_GOA) + l * 384; const float* gb = PIN(I_GOB) + l * 384;
    const bf16 *oc = (const bf16*)(ws + WS_OCMP), *os = (const bf16*)(ws + WS_OSLC), *ow = (const bf16*)(ws + WS_OWIN); const float* gm = (const float*)(ws + WS_GM);
#define UNPK8(dst, src) dst[0] = __uint_as_float(src.x << 16); dst[1] = __uint_as_float(src.x & 0xffff0000u); dst[2] = __uint_as_float(src.y << 16); dst[3] = __uint_as_float(src.y & 0xffff0000u); \
    dst[4] = __uint_as_float(src.z << 16); dst[5] = __uint_as_float(src.z & 0xffff0000u); dst[6] = __uint_as_float(src.w << 16); dst[7] = __uint_as_float(src.w & 0xffff0000u);
    const int rpw = T_ / ngw;
    const float* ggp = (lane < 48) ? ga + lane * 8 : gb + (lane - 48) * 8; const float4 gA0 = *(const float4*)ggp, gA1 = *(const float4*)(ggp + 4);
    const float* ggq = gb + (16 + (lane & 31)) * 8; const float4 gB0 = *(const float4*)ggq, gB1 = *(const float4*)(ggq + 4);
    v4u ra4, rb4, rc4, ry4; float rg0, rg1, rg2;
#define MIX_LOAD(m_) do { const bf16* r_ = mix + (size_t)(m_) * D_; \
        if (lane < 48) { const size_t o_ = (size_t)(m_) * 384 + lane * 8; const float* g3_ = gm + (size_t)(m_) * 32 + 3 * (lane >> 3); rg0 = g3_[0]; rg1 = g3_[1]; rg2 = g3_[2]; \
            ra4 = *(const v4u*)(oc + o_); rb4 = *(const v4u*)(os + o_); rc4 = *(const v4u*)(ow + o_); } \
        else { ra4 = *(const v4u*)(r_ + 384 + (lane - 48) * 8); rb4 = ra4; rc4 = ra4; rg0 = 0.f; rg1 = 0.f; rg2 = 0.f; } \
        if (lane < 32) ry4 = *(const v4u*)(r_ + 384 + (16 + lane) * 8); else ry4 = ra4; } while (0)
    const int mend = gw * rpw + rpw;
    MIX_LOAD(gw * rpw);
    for (int m = gw * rpw; m < mend; ++m) {
        bf16* r = mix + (size_t)m * D_;
        const v4u ca4 = ra4, cb4 = rb4, cc4 = rc4, cy4 = ry4; const float g0 = rg0, g1 = rg1, g2 = rg2;
        if (m + 1 < mend) MIX_LOAD(m + 1);
        float v0[8], v1[8]; float sa = 0.f, sb = 0.f;
        if (lane < 48) {
            float c8[8], s8[8], w8[8]; UNPK8(c8, ca4) UNPK8(s8, cb4) UNPK8(w8, cc4)
#pragma unroll
            for (int i = 0; i < 8; ++i) { v0[i] = g0 * c8[i] + g1 * s8[i] + g2 * w8[i]; sa += v0[i] * v0[i]; }
        } else {
            UNPK8(v0, ca4)
#pragma unroll
            for (int i = 0; i < 8; ++i) sb += v0[i] * v0[i];
        }
        if (lane < 32) { UNPK8(v1, cy4)
#pragma unroll
            for (int i = 0; i < 8; ++i) sb += v1[i] * v1[i]; }
        const float ra = rsqrtf(wave_sum2(sa) * (1.f / 384.f) + EPS), rb = rsqrtf(wave_sum2(sb) * (1.f / 384.f) + EPS);
        {
            const int col = (lane < 48) ? lane * 8 : 384 + (lane - 48) * 8; const float rr = (lane < 48) ? ra : rb;
            const float4 q0 = gA0, q1 = gA1;
            v4u w; w.x = pk2(v0[0] * rr * q0.x, v0[1] * rr * q0.y); w.y = pk2(v0[2] * rr * q0.z, v0[3] * rr * q0.w); w.z = pk2(v0[4] * rr * q1.x, v0[5] * rr * q1.y); w.w = pk2(v0[6] * rr * q1.z, v0[7] * rr * q1.w);
            *(v4u*)(r + col) = w;
        }
        if (lane < 32) { const float4 q0 = gB0, q1 = gB1;
            v4u w; w.x = pk2(v1[0] * rb * q0.x, v1[1] * rb * q0.y); w.y = pk2(v1[2] * rb * q0.z, v1[3] * rb * q0.w); w.z = pk2(v1[4] * rb * q1.x, v1[5] * rb * q1.y); w.w = pk2(v1[6] * rb * q1.z, v1[7] * rb * q1.w);
            *(v4u*)(r + 384 + (16 + lane) * 8) = w; }
    }
#undef MIX_LOAD
#undef UNPK8
}


typedef short bf16x8 __attribute__((ext_vector_type(8)));
typedef short s16x4 __attribute__((ext_vector_type(4)));
typedef float f32x16 __attribute__((ext_vector_type(16)));
typedef unsigned u32x2v __attribute__((ext_vector_type(2)));
constexpr int AT_BUF = 20480, AT_K32 = 8192, AT_V = 12288;
__device__ __forceinline__ unsigned cvtpk(float lo, float hi) { unsigned r; asm volatile("v_cvt_pk_bf16_f32 %0, %1, %2" : "=v"(r) : "v"(lo), "v"(hi)); return r; }
__device__ __forceinline__ float max3f(float a, float b, float c) { float r; asm("v_max3_f32 %0, %1, %2, %3" : "=v"(r) : "v"(a), "v"(b), "v"(c)); return r; }
__device__ __forceinline__ int crow(int r, int hi) { return (r & 3) + 8 * (r >> 2) + 4 * hi; }
__device__ __forceinline__ s16x4 vtr(LAS const unsigned char* p) { return __builtin_bit_cast(s16x4, __builtin_amdgcn_ds_read_tr16_b64_v4i16((LAS s16x4*)p)); }
enum { AM_CAUSAL = 0, AM_WINDOW = 1, AM_SLC = 2 };
struct AttnState { float m, l; f32x16 o[2]; f32x16 negm; bool started; long long twait; };
template <int NC> struct TileRegs { v4u k; v4u k2; v4u v; };
template <int NC> __device__ __forceinline__ void at_load(TileRegs<NC>& r, const bf16* Kg, int ldk, const bf16* Vg, int ldv, const bf16* K2g, int ldk2, int tile, int tid) {
    const int key = tid >> 3, c = tid & 7;
    r.k = *(const v4u*)(Kg + (size_t)(tile * 64 + key) * ldk + 8 * c);
    r.v = *(const v4u*)(Vg + (size_t)(tile * 64 + key) * ldv + 8 * c);
    if (NC == 6) { if (tid < 256) r.k2 = *(const v4u*)(K2g + (size_t)(tile * 64 + (tid >> 2)) * ldk2 + 8 * (tid & 3)); }
}
template <int NC> __device__ __forceinline__ void at_store(const TileRegs<NC>& r, LAS unsigned char* buf, int tid) {
    const int key = tid >> 3, c = tid & 7;
    *(LAS v4u*)(buf + key * 128 + 16 * (c ^ ((key >> 1) & 7))) = r.k;
    *(LAS v4u*)(buf + AT_V + (c >> 2) * 4096 + key * 64 + (c & 3) * 16) = r.v;
    if (NC == 6) { if (tid < 256) { const int k2 = tid >> 2, c2 = tid & 3; *(LAS v4u*)(buf + AT_K32 + k2 * 64 + 16 * (c2 ^ ((k2 >> 2) & 3))) = r.k2; } }
}
template <int NC> __device__ __forceinline__ void qk_tile(f32x16& p0, f32x16& p1, LAS const unsigned char* buf, const bf16x8 (&qf)[NC], const f32x16& negm, int lane) {
    const int r32 = lane & 31, hi = lane >> 5;
    p0 = negm; p1 = negm;
#pragma unroll
    for (int cc = 0; cc < NC; ++cc) {
        bf16x8 k0, k1;
        if (cc < 4) { const int k0r = r32, k1r = 32 + r32;
            k0 = *(LAS const bf16x8*)(buf + k0r * 128 + 16 * ((2 * cc + hi) ^ ((k0r >> 1) & 7)));
            k1 = *(LAS const bf16x8*)(buf + k1r * 128 + 16 * ((2 * cc + hi) ^ ((k1r >> 1) & 7))); }
        else { const int k0r = r32, k1r = 32 + r32, c2 = 2 * (cc - 4) + hi;
            k0 = *(LAS const bf16x8*)(buf + AT_K32 + k0r * 64 + 16 * (c2 ^ ((k0r >> 2) & 3)));
            k1 = *(LAS const bf16x8*)(buf + AT_K32 + k1r * 64 + 16 * (c2 ^ ((k1r >> 2) & 3))); }
        p0 = __builtin_amdgcn_mfma_f32_32x32x16_bf16(k0, qf[cc], p0, 0, 0, 0);
        p1 = __builtin_amdgcn_mfma_f32_32x32x16_bf16(k1, qf[cc], p1, 0, 0, 0);
    }
}
template <int MODE> __device__ __forceinline__ void mask_tile(f32x16& p0, f32x16& p1, int kpos0, int qpos, bool need_mask, bool sel_ok, int lane) {
    const int hi = lane >> 5;
    if (need_mask) {
        const int qw0m = __builtin_amdgcn_readfirstlane(qpos) & ~31;
        const bool diag = (kpos0 + 63 > qw0m), old = (MODE == AM_WINDOW) && (kpos0 < qw0m + 31 - 511);
        if (diag || old) {
            const float selterm = (MODE == AM_SLC && !sel_ok) ? -INFINITY : INFINITY;
            const int dbase = qpos - kpos0 - 4 * hi;
#pragma unroll
            for (int r = 0; r < 16; ++r) {
                const int d0 = dbase - ((r & 3) + 8 * (r >> 2)), d1 = d0 - 32;
                float l0 = ((float)d0 + 0.5f) * INFINITY, l1 = ((float)d1 + 0.5f) * INFINITY;
                if (MODE == AM_WINDOW) { l0 = fminf(l0, ((float)(511 - d0) + 0.5f) * INFINITY); l1 = fminf(l1, ((float)(511 - d1) + 0.5f) * INFINITY); }
                if (MODE == AM_SLC) { l0 = fminf(l0, selterm); l1 = fminf(l1, selterm); }
                p0[r] = fminf(p0[r], l0); p1[r] = fminf(p1[r], l1);
            }
        } else if (MODE == AM_SLC) {
            const float selterm = sel_ok ? INFINITY : -INFINITY;
#pragma unroll
            for (int r = 0; r < 16; ++r) { p0[r] = fminf(p0[r], selterm); p1[r] = fminf(p1[r], selterm); }
        }
    }
}
template <int MODE> __device__ __forceinline__ void softmax_tile(AttnState& st, f32x16& p0, f32x16& p1, bf16x8 (&pf)[4], int kpos0, int qpos, bool need_mask, bool sel_ok, int lane) {
    mask_tile<MODE>(p0, p1, kpos0, qpos, need_mask, sel_ok, lane);
    float mx = max3f(p0[0], p1[0], p0[1]), mx2 = max3f(p1[1], p0[2], p1[2]);
#pragma unroll
    for (int r = 3; r < 15; r += 2) { mx = max3f(mx, p0[r], p1[r]); mx2 = max3f(mx2, p0[r + 1], p1[r + 1]); }
    mx = max3f(mx, p0[15], p1[15]); mx = max3f(mx, mx2, mx2);
    mx = red32_max(mx);
    if (!st.started || __any(mx > 0.f)) {
        float dl = st.started ? fmaxf(mx, 0.f) : mx;
        dl = (dl > -1e30f) ? dl : 0.f;
        st.started = true;
        const float alpha = __builtin_amdgcn_exp2f(-dl);
        st.m += dl; st.l *= alpha;
#pragma unroll
        for (int r = 0; r < 16; ++r) { st.o[0][r] *= alpha; st.o[1][r] *= alpha; p0[r] -= dl; p1[r] -= dl; st.negm[r] = -st.m; }
    }
    float sum = 0.f;
#pragma unroll
    for (int r = 0; r < 16; ++r) { p0[r] = __builtin_amdgcn_exp2f(p0[r]); p1[r] = __builtin_amdgcn_exp2f(p1[r]); sum += p0[r] + p1[r]; }
    st.l += sum;
#pragma unroll
    for (int s2 = 0; s2 < 2; ++s2) {
        v4u a, b;
        a.x = cvtpk(p0[8 * s2 + 0], p0[8 * s2 + 1]); a.y = cvtpk(p0[8 * s2 + 2], p0[8 * s2 + 3]); a.z = cvtpk(p0[8 * s2 + 4], p0[8 * s2 + 5]); a.w = cvtpk(p0[8 * s2 + 6], p0[8 * s2 + 7]);
        b.x = cvtpk(p1[8 * s2 + 0], p1[8 * s2 + 1]); b.y = cvtpk(p1[8 * s2 + 2], p1[8 * s2 + 3]); b.z = cvtpk(p1[8 * s2 + 4], p1[8 * s2 + 5]); b.w = cvtpk(p1[8 * s2 + 6], p1[8 * s2 + 7]);
        pf[s2] = __builtin_bit_cast(bf16x8, a); pf[2 + s2] = __builtin_bit_cast(bf16x8, b);
    }
}
struct TileFlags { bool skip, need_mask, sel_ok; };
__device__ __forceinline__ void pack_p(bf16x8 (&pf)[4], const f32x16& p0, const f32x16& p1) {
#pragma unroll
    for (int s2 = 0; s2 < 2; ++s2) {
        v4u a, b;
        a.x = cvtpk(p0[8 * s2 + 0], p0[8 * s2 + 1]); a.y = cvtpk(p0[8 * s2 + 2], p0[8 * s2 + 3]); a.z = cvtpk(p0[8 * s2 + 4], p0[8 * s2 + 5]); a.w = cvtpk(p0[8 * s2 + 6], p0[8 * s2 + 7]);
        b.x = cvtpk(p1[8 * s2 + 0], p1[8 * s2 + 1]); b.y = cvtpk(p1[8 * s2 + 2], p1[8 * s2 + 3]); b.z = cvtpk(p1[8 * s2 + 4], p1[8 * s2 + 5]); b.w = cvtpk(p1[8 * s2 + 6], p1[8 * s2 + 7]);
        pf[s2] = __builtin_bit_cast(bf16x8, a); pf[2 + s2] = __builtin_bit_cast(bf16x8, b);
    }
}
template <int MODE> __device__ __forceinline__ void softmax_pair(AttnState& st, f32x16& a0, f32x16& a1, f32x16& b0, f32x16& b1, int kpos0, int qpos, const TileFlags& fa, const TileFlags& fb, int lane) {
    mask_tile<MODE>(a0, a1, kpos0, qpos, fa.need_mask, fa.sel_ok, lane);
    mask_tile<MODE>(b0, b1, kpos0 + 64, qpos, fb.need_mask, fb.sel_ok, lane);
    float mx = max3f(a0[0], a1[0], b0[0]), mx2 = max3f(b1[0], a0[1], a1[1]);
#pragma unroll
    for (int r = 1; r < 16; ++r) { mx = max3f(mx, b0[r], b1[r]); if (r > 1) mx2 = max3f(mx2, a0[r], a1[r]); }
    mx = max3f(mx, mx2, mx2);
    mx = red32_max(mx);
    if (!st.started || __any(mx > 0.f)) {
        float dl = st.started ? fmaxf(mx, 0.f) : mx;
        dl = (dl > -1e30f) ? dl : 0.f;
        st.started = true;
        const float alpha = __builtin_amdgcn_exp2f(-dl);
        st.m += dl; st.l *= alpha;
#pragma unroll
        for (int r = 0; r < 16; ++r) { st.o[0][r] *= alpha; st.o[1][r] *= alpha; a0[r] -= dl; a1[r] -= dl; b0[r] -= dl; b1[r] -= dl; st.negm[r] = -st.m; }
    }
    float sum = 0.f;
#pragma unroll
    for (int r = 0; r < 16; ++r) { a0[r] = __builtin_amdgcn_exp2f(a0[r]); a1[r] = __builtin_amdgcn_exp2f(a1[r]); b0[r] = __builtin_amdgcn_exp2f(b0[r]); b1[r] = __builtin_amdgcn_exp2f(b1[r]); sum += (a0[r] + a1[r]) + (b0[r] + b1[r]); }
    st.l += sum;
}
__device__ __forceinline__ void pv_tile(AttnState& st, LAS const unsigned char* buf, const bf16x8 (&pf)[4], int lane) {
    const int hi = lane >> 5;
    const unsigned vb = (unsigned)(uintptr_t)(buf + AT_V + (4 * hi + ((lane & 15) >> 2)) * 64 + ((lane >> 4) & 1) * 32 + (lane & 3) * 8);
#pragma unroll
    for (int dh = 0; dh < 2; ++dh) {
        s16x4 lo[4], hh[4];
#pragma unroll
        for (int s4 = 0; s4 < 4; ++s4) {
            asm volatile("ds_read_b64_tr_b16 %0, %1 offset:%c2" : "=&v"(lo[s4]) : "v"(vb), "i"(dh * 4096 + s4 * 1024) : "memory");
            asm volatile("ds_read_b64_tr_b16 %0, %1 offset:%c2" : "=&v"(hh[s4]) : "v"(vb), "i"(dh * 4096 + s4 * 1024 + 512) : "memory");
        }
        asm volatile("s_waitcnt lgkmcnt(0)" : "+v"(lo[0]), "+v"(lo[1]), "+v"(lo[2]), "+v"(lo[3]), "+v"(hh[0]), "+v"(hh[1]), "+v"(hh[2]), "+v"(hh[3]) :: "memory");
#pragma unroll
        for (int s4 = 0; s4 < 4; ++s4) {
            const bf16x8 vf = {lo[s4][0], lo[s4][1], lo[s4][2], lo[s4][3], hh[s4][0], hh[s4][1], hh[s4][2], hh[s4][3]};
            st.o[dh] = __builtin_amdgcn_mfma_f32_32x32x16_bf16(vf, pf[s4], st.o[dh], 0, 0, 0);
        }
    }
}
template <int MODE> __device__ __forceinline__ TileFlags tile_flags(int t, int qw0, unsigned selbits) {
    const int k0 = t * 64; TileFlags f;
    f.skip = k0 > qw0 + 31; f.need_mask = (k0 + 63 > qw0); f.sel_ok = true;
    if (MODE == AM_WINDOW) { f.skip = f.skip || (k0 + 63 < qw0 - 511); f.need_mask = f.need_mask || (k0 < qw0 + 31 - 511); }
    if (MODE == AM_SLC) { f.sel_ok = (selbits >> t) & 1u; const unsigned long long bal = __ballot(f.sel_ok); f.skip = f.skip || (bal == 0ull); f.need_mask = f.need_mask || (bal != ~0ull); }
    return f;
}
struct DmaOff { unsigned k, v, k2; };
template <int NC> __device__ __forceinline__ DmaOff at_dma_off(int ldk, int ldv, int ldk2, int wave, int lane) {
    const int L = wave * 64 + lane; DmaOff o;
    { const int key = L >> 3, c = (L & 7) ^ ((key >> 1) & 7); o.k = (unsigned)(key * ldk + 8 * c) * 2u; }
    { const int key = (L >> 2) & 63, c = (L >> 8) * 4 + (L & 3); o.v = (unsigned)(key * ldv + 8 * c) * 2u; }
    { const int key = (L >> 2) & 63, c2 = (L & 3) ^ ((key >> 2) & 3); o.k2 = (unsigned)(key * ldk2 + 8 * c2) * 2u; }
    return o;
}
template <int NC> __device__ __forceinline__ void at_dma(const DmaOff& o, const bf16* Kg, int ldk, const bf16* Vg, int ldv, const bf16* K2g, int ldk2, int tile, LAS unsigned char* slot, int wave) {
    __builtin_amdgcn_global_load_lds((const unsigned*)((const char*)(Kg + (size_t)tile * 64 * ldk) + o.k), (LAS unsigned*)(slot + wave * 1024), 16, 0, 0);
    __builtin_amdgcn_global_load_lds((const unsigned*)((const char*)(Vg + (size_t)tile * 64 * ldv) + o.v), (LAS unsigned*)(slot + AT_V + wave * 1024), 16, 0, 0);
    if (NC == 6) { if (wave < 4) __builtin_amdgcn_global_load_lds((const unsigned*)((const char*)(K2g + (size_t)tile * 64 * ldk2) + o.k2), (LAS unsigned*)(slot + AT_K32 + wave * 1024), 16, 0, 0); }
}
__device__ __forceinline__ void at_wait_bar(int keep) {
    if (keep == 0) asm volatile("s_waitcnt vmcnt(0) lgkmcnt(0)" ::: "memory");
    else if (keep == 4) asm volatile("s_waitcnt vmcnt(4) lgkmcnt(0)" ::: "memory");
    else asm volatile("s_waitcnt vmcnt(6) lgkmcnt(0)" ::: "memory");
    __builtin_amdgcn_s_barrier();
    asm volatile("" ::: "memory");
}
template <int NC, int MODE> __device__ __forceinline__ void at_stream(AttnState& st, LAS unsigned char* lds, const bf16* Kg, int ldk, const bf16* Vg, int ldv, const bf16* K2g, int ldk2, int t0, int t1,
                                                                       const bf16x8 (&qf)[NC], int qpos, int qw0, unsigned selbits, int tid) {
    const int lane = tid & 63, wave = __builtin_amdgcn_readfirstlane(tid >> 6), np = (t1 - t0) >> 1;
    const int nper2 = (NC == 6 && wave < 4) ? 6 : 4;
    const DmaOff dof = at_dma_off<NC>(ldk, ldv, ldk2, wave, lane);
    at_dma<NC>(dof, Kg, ldk, Vg, ldv, K2g, ldk2, t0, lds, wave); at_dma<NC>(dof, Kg, ldk, Vg, ldv, K2g, ldk2, t0 + 1, lds + AT_BUF, wave);
    if (np > 1) { at_dma<NC>(dof, Kg, ldk, Vg, ldv, K2g, ldk2, t0 + 2, lds + 2 * AT_BUF, wave); at_dma<NC>(dof, Kg, ldk, Vg, ldv, K2g, ldk2, t0 + 3, lds + 3 * AT_BUF, wave); }
    at_wait_bar(np > 1 ? nper2 : 0);
    int s0 = 0, s1 = 2 * AT_BUF, s2 = 4 * AT_BUF;
    for (int j = 0; j < np; ++j) {
        const int t = t0 + 2 * j; const bool has_2 = (j + 2 < np);
        if (has_2) { at_dma<NC>(dof, Kg, ldk, Vg, ldv, K2g, ldk2, t + 4, lds + s2, wave); at_dma<NC>(dof, Kg, ldk, Vg, ldv, K2g, ldk2, t + 5, lds + s2 + AT_BUF, wave); }
        const TileFlags fa = tile_flags<MODE>(t, qw0, selbits), fb = tile_flags<MODE>(t + 1, qw0, selbits);
        if (!fa.skip && !fb.skip) {
            f32x16 a0, a1, b0, b1; bf16x8 pf[4];
            qk_tile<NC>(a0, a1, lds + s0, qf, st.negm, lane);
            qk_tile<NC>(b0, b1, lds + s0 + AT_BUF, qf, st.negm, lane);
            softmax_pair<MODE>(st, a0, a1, b0, b1, t * 64, qpos, fa, fb, lane);
            pack_p(pf, a0, a1); pv_tile(st, lds + s0, pf, lane);
            pack_p(pf, b0, b1); pv_tile(st, lds + s0 + AT_BUF, pf, lane);
        } else {
            if (!fa.skip) { f32x16 p0, p1; bf16x8 pf[4]; qk_tile<NC>(p0, p1, lds + s0, qf, st.negm, lane); softmax_tile<MODE>(st, p0, p1, pf, t * 64, qpos, fa.need_mask, fa.sel_ok, lane); pv_tile(st, lds + s0, pf, lane); }
            if (!fb.skip) { f32x16 p0, p1; bf16x8 pf[4]; qk_tile<NC>(p0, p1, lds + s0 + AT_BUF, qf, st.negm, lane); softmax_tile<MODE>(st, p0, p1, pf, (t + 1) * 64, qpos, fb.need_mask, fb.sel_ok, lane); pv_tile(st, lds + s0 + AT_BUF, pf, lane); }
        }
        at_wait_bar(has_2 ? nper2 : 0);
        const int tmp = s0; s0 = s1; s1 = s2; s2 = tmp;
    }
}
__device__ __forceinline__ int next_item_q(unsigned* ctrs, LAS unsigned char* lds, int wave_u, int count, int q0, int& kstart) {
    const int tid = wave_u * 64 + fresh_lane();
    LAS int* slot = (LAS int*)(lds + RING_BYTES + 64);
    if (tid == 0) { const unsigned v = atomicAdd(ctrs, 1u); slot[0] = (v < 8u * (unsigned)count) ? (int)(((v & 7u) << 16) | (v >> 3)) : -1; }
    __syncthreads();
    const int v = slot[0];
    __syncthreads();
    (void)q0; (void)kstart;
    return v;
}
__device__ __forceinline__ void mla_unit(unsigned char* ws, LAS unsigned char* lds, int b, int h, int qt, int wave_u) {
    const int tid = wave_u * 64 + fresh_lane();
    const int lane = tid & 63, wave = tid >> 6, r32 = lane & 31, hi = lane >> 5;
    const int qw0 = qt * 256 + wave * 32, qpos = qw0 + r32; const size_t row = (size_t)b * S_ + qpos;
    const long long tq0 = (PROBE_SEL != 0) ? (long long)__builtin_amdgcn_s_memtime() : 0ll;
    bf16x8 qf[6];
    {
        const bf16* qp = (const bf16*)(ws + WS_OSLC) + row * 768 + h * 96 + 8 * hi;
        v4u raw[6];
#pragma unroll
        for (int cc = 0; cc < 6; ++cc) raw[cc] = *(const v4u*)(qp + 16 * cc);
        float msc = MSCALE; asm volatile("" : "+v"(msc));
        const float rs = rsqrtf(((const float*)(ws + WS_SSQL))[row] * (1.f / 256.f) + EPS) * msc;
        const float* cm_ = (const float*)(ws + WS_COSM) + row * 16 + 8 * hi; const float* sm_ = (const float*)(ws + WS_SINM) + row * 16 + 8 * hi;
#define UNPKQ(dst, src) dst[0] = __uint_as_float(src.x << 16); dst[1] = __uint_as_float(src.x & 0xffff0000u); dst[2] = __uint_as_float(src.y << 16); dst[3] = __uint_as_float(src.y & 0xffff0000u); \
        dst[4] = __uint_as_float(src.z << 16); dst[5] = __uint_as_float(src.z & 0xffff0000u); dst[6] = __uint_as_float(src.w << 16); dst[7] = __uint_as_float(src.w & 0xffff0000u);
#pragma unroll
        for (int cc = 0; cc < 4; ++cc) { float f[8]; UNPKQ(f, raw[cc])
            v4u w; w.x = cvtpk(f[0] * rs, f[1] * rs); w.y = cvtpk(f[2] * rs, f[3] * rs); w.z = cvtpk(f[4] * rs, f[5] * rs); w.w = cvtpk(f[6] * rs, f[7] * rs); qf[cc] = __builtin_bit_cast(bf16x8, w); }
        { float x1[8], x2[8], o1[8], o2[8]; UNPKQ(x1, raw[4]) UNPKQ(x2, raw[5])
#pragma unroll
          for (int j = 0; j < 8; ++j) { const float cs = cm_[j] * rs, sn = sm_[j] * rs; o1[j] = x1[j] * cs - x2[j] * sn; o2[j] = x1[j] * sn + x2[j] * cs; }
          v4u w; w.x = cvtpk(o1[0], o1[1]); w.y = cvtpk(o1[2], o1[3]); w.z = cvtpk(o1[4], o1[5]); w.w = cvtpk(o1[6], o1[7]); qf[4] = __builtin_bit_cast(bf16x8, w);
          w.x = cvtpk(o2[0], o2[1]); w.y = cvtpk(o2[2], o2[3]); w.z = cvtpk(o2[4], o2[5]); w.w = cvtpk(o2[6], o2[7]); qf[5] = __builtin_bit_cast(bf16x8, w); }
#undef UNPKQ
    }
    const long long tq1 = (PROBE_SEL != 0) ? (long long)__builtin_amdgcn_s_memtime() : 0ll;
    AttnState st; st.m = 0.f; st.l = 0.f; st.o[0] = f32x16{}; st.o[1] = f32x16{}; st.negm = f32x16{}; st.started = false; st.twait = 0;
    const bf16* kvb = (const bf16*)(ws + WS_KVM) + (size_t)b * S_ * 768 + h * 128;
    at_stream<6, AM_CAUSAL>(st, lds, kvb, 768, kvb + 64, 768, (const bf16*)(ws + WS_KR) + (size_t)b * S_ * 32, 32, 0, 4 * qt + 4, qf, qpos, qw0, 0u, tid);
    if (PROBE_SEL >= 1 && PROBE_SEL <= 3 && b == 0 && h == 0 && qt == 7 && tid == 0) { const long long tq2 = (long long)__builtin_amdgcn_s_memtime();
        ((float*)(ws + WS_CTL))[100] = (PROBE_SEL == 1) ? (float)(tq2 - tq1) : (PROBE_SEL == 2) ? (float)st.twait : (float)(tq1 - tq0); }
    const float lt = red32_sum(st.l), il = 1.f / lt;
    bf16* op = (bf16*)(ws + WS_HB) + row * D_ + 384 + h * 64 + 4 * hi;
#pragma unroll
    for (int dh = 0; dh < 2; ++dh)
#pragma unroll
        for (int g4 = 0; g4 < 4; ++g4) { u32x2v w; w.x = cvtpk(st.o[dh][4 * g4] * il, st.o[dh][4 * g4 + 1] * il); w.y = cvtpk(st.o[dh][4 * g4 + 2] * il, st.o[dh][4 * g4 + 3] * il);
            *(u32x2v*)(op + dh * 32 + 8 * g4) = w; }
}
template <int MODE> __device__ __forceinline__ void nsa_branch_unit(unsigned char* ws, LAS unsigned char* lds, int b, int h, int qt, int wave_u) {
    const int tid = wave_u * 64 + fresh_lane();
    const int lane = tid & 63, wave = tid >> 6, r32 = lane & 31, hi = lane >> 5, g = h / 3;
    const int qw0 = qt * 256 + wave * 32, qpos = qw0 + r32; const size_t row = (size_t)b * S_ + qpos;
    const bf16* nsa = (const bf16*)(ws + WS_NSA);
    const bf16* qp = nsa + row * 1152 + h * 64 + 8 * hi;
    bf16x8 qf[4];
#pragma unroll
    for (int cc = 0; cc < 4; ++cc) qf[cc] = *(const bf16x8*)(qp + 16 * cc);
    unsigned selbits = 0u; if (MODE == AM_SLC) selbits = ((const unsigned*)(ws + WS_SEL))[(size_t)(b * 2 + g) * S_ + qpos];
    const bf16* kb = nsa + (size_t)b * S_ * 1152 + g * 64 + (MODE == AM_SLC ? 640 : 896);
    AttnState st; st.m = 0.f; st.l = 0.f; st.o[0] = f32x16{}; st.o[1] = f32x16{}; st.negm = f32x16{}; st.started = false; st.twait = 0;
    const long long tn0 = (PROBE_SEL != 0) ? (long long)__builtin_amdgcn_s_memtime() : 0ll;
    const int t0 = (MODE == AM_SLC) ? 0 : ((4 * qt - 8 > 0) ? 4 * qt - 8 : 0);
    at_stream<4, MODE>(st, lds, kb, 1152, kb + 128, 1152, nullptr, 0, t0, 4 * qt + 4, qf, qpos, qw0, selbits, tid);
    if (PROBE_SEL >= 4 && PROBE_SEL <= 5 && MODE == AM_SLC && b == 0 && h == 0 && qt == 7 && tid == 0) { const long long tn1 = (long long)__builtin_amdgcn_s_memtime();
        ((float*)(ws + WS_CTL))[100] = (PROBE_SEL == 4) ? (float)(tn1 - tn0) : (float)st.twait; }
    const float lt = red32_sum(st.l), il = 1.f / lt;
    bf16* op = (bf16*)(ws + (MODE == AM_SLC ? WS_OSLC : WS_OWIN)) + row * 384 + h * 64 + 4 * hi;
#pragma unroll
    for (int dh = 0; dh < 2; ++dh)
#pragma unroll
        for (int g4 = 0; g4 < 4; ++g4) { u32x2v w; w.x = cvtpk(st.o[dh][4 * g4] * il, st.o[dh][4 * g4 + 1] * il); w.y = cvtpk(st.o[dh][4 * g4 + 2] * il, st.o[dh][4 * g4 + 3] * il);
            *(u32x2v*)(op + dh * 32 + 8 * g4) = w; }
}
__device__ __forceinline__ void cmp_unit(unsigned char* ws, LAS unsigned char* lds, int b, int g, int qt, int wave_u) {
    const int tid = wave_u * 64 + fresh_lane();
    const int lane = tid & 63, wave = tid >> 6, r32 = lane & 31, hi = lane >> 5;
    const int qpos = qt * 256 + wave * 32 + r32; const size_t row = (size_t)b * S_ + qpos;
    const bf16* kc = (const bf16*)(ws + WS_KCV) + (size_t)(b * 2 + g) * 128 * 64; const bf16* vc = kc + (size_t)8 * 2 * 128 * 64;
    { TileRegs<4> tr; at_load<4>(tr, kc, 64, vc, 64, nullptr, 0, 0, tid); at_store<4>(tr, lds, tid); at_load<4>(tr, kc, 64, vc, 64, nullptr, 0, 1, tid); at_store<4>(tr, lds + AT_BUF, tid); }
    __syncthreads();
    int nvis = (qpos >= 31) ? ((qpos - 31) >> 4) + 1 : 0; if (nvis > 127) nvis = 127;
    float G[16], L[16];
#pragma unroll
    for (int i = 0; i < 16; ++i) { G[i] = 0.f; L[i] = 0.f; }
    const bf16* nsa = (const bf16*)(ws + WS_NSA);
    LAS const unsigned char* vb = lds + AT_V + (4 * hi + ((lane & 15) >> 2)) * 64 + ((lane >> 4) & 1) * 32 + (lane & 3) * 8;
    for (int r3 = 0; r3 < 3; ++r3) {
        const int h = 3 * g + r3;
        const bf16* qp = nsa + row * 1152 + h * 64 + 8 * hi;
        bf16x8 qf[4];
#pragma unroll
        for (int cc = 0; cc < 4; ++cc) qf[cc] = *(const bf16x8*)(qp + 16 * cc);
        f32x16 p[4];
#pragma unroll
        for (int tb = 0; tb < 4; ++tb) {
            LAS const unsigned char* buf = lds + (tb >> 1) * AT_BUF; const int kr = (tb & 1) * 32 + r32;
            p[tb] = f32x16{};
#pragma unroll
            for (int cc = 0; cc < 4; ++cc) { const bf16x8 kf = *(LAS const bf16x8*)(buf + kr * 128 + 16 * ((2 * cc + hi) ^ ((kr >> 1) & 7)));
                p[tb] = __builtin_amdgcn_mfma_f32_32x32x16_bf16(kf, qf[cc], p[tb], 0, 0, 0); }
        }
        float mx = -1e30f;
#pragma unroll
        for (int tb = 0; tb < 4; ++tb)
#pragma unroll
            for (int r = 0; r < 16; ++r) { const int n = 32 * tb + crow(r, hi); p[tb][r] = fminf(p[tb][r], ((float)(nvis - n) - 0.5f) * INFINITY); mx = fmaxf(mx, p[tb][r]); }
        mx = red32_max(mx);
        float sum = 0.f;
#pragma unroll
        for (int tb = 0; tb < 4; ++tb)
#pragma unroll
            for (int r = 0; r < 16; ++r) { p[tb][r] = __builtin_amdgcn_exp2f(p[tb][r] - mx); sum += p[tb][r]; }
        sum = red32_sum(sum);
        const float il = (nvis > 0) ? 1.f / sum : 0.f;
#pragma unroll
        for (int tb = 0; tb < 4; ++tb)
#pragma unroll
            for (int k = 0; k < 4; ++k) { const float a0 = p[tb][4 * k] * il, a1 = p[tb][4 * k + 1] * il, a2 = p[tb][4 * k + 2] * il, a3 = p[tb][4 * k + 3] * il;
                G[4 * tb + k] += (a0 + a1) + (a2 + a3); L[4 * tb + k] += a3; }
        f32x16 o[2] = {f32x16{}, f32x16{}};
#pragma unroll
        for (int tb = 0; tb < 4; ++tb)
#pragma unroll
            for (int s2 = 0; s2 < 2; ++s2) {
                v4u a; a.x = cvtpk(p[tb][8 * s2 + 0], p[tb][8 * s2 + 1]); a.y = cvtpk(p[tb][8 * s2 + 2], p[tb][8 * s2 + 3]); a.z = cvtpk(p[tb][8 * s2 + 4], p[tb][8 * s2 + 5]); a.w = cvtpk(p[tb][8 * s2 + 6], p[tb][8 * s2 + 7]);
                const bf16x8 pf = __builtin_bit_cast(bf16x8, a);
                LAS const unsigned char* vbb = vb + (tb >> 1) * AT_BUF + ((tb & 1) * 2 + s2) * 1024;
#pragma unroll
                for (int dh = 0; dh < 2; ++dh) { const s16x4 lo = vtr(vbb + dh * 4096), hh = vtr(vbb + dh * 4096 + 512);
                    const bf16x8 vf = {lo[0], lo[1], lo[2], lo[3], hh[0], hh[1], hh[2], hh[3]};
                    o[dh] = __builtin_amdgcn_mfma_f32_32x32x16_bf16(vf, pf, o[dh], 0, 0, 0); }
                asm volatile("" ::: "memory");
            }
        bf16* op = (bf16*)(ws + WS_OCMP) + row * 384 + h * 64 + 4 * hi;
#pragma unroll
        for (int dh = 0; dh < 2; ++dh)
#pragma unroll
            for (int g4 = 0; g4 < 4; ++g4) { u32x2v w; w.x = cvtpk(o[dh][4 * g4] * il, o[dh][4 * g4 + 1] * il); w.y = cvtpk(o[dh][4 * g4 + 2] * il, o[dh][4 * g4 + 3] * il);
                *(u32x2v*)(op + dh * 32 + 8 * g4) = w; }
    }
    const int cur = qpos >> 6;
    unsigned key[16], okey[16];
#pragma unroll
    for (int jj = 0; jj < 16; ++jj) {
        const auto sw = __builtin_amdgcn_permlane32_swap(__float_as_uint(L[jj]), __float_as_uint(L[jj]), false, false);
        const float lp = __uint_as_float(hi ? sw[0] : sw[1]);
        L[jj] = lp;
    }
#pragma unroll
    for (int jj = 0; jj < 16; ++jj) {
        const int j = 2 * jj + hi;
        float v = G[jj] + (hi ? L[jj] : (jj > 0 ? L[jj > 0 ? jj - 1 : 0] : 0.f));
        if (j == 0 || j == cur || j == cur - 1) v = INFINITY;
        if (j * 64 > qpos) v = -INFINITY;
        const unsigned u = __float_as_uint(v); const unsigned ord = (u & 0x80000000u) ? ~u : (u | 0x80000000u);
        key[jj] = (ord & ~31u) | (unsigned)(31 - j);
    }
#pragma unroll
    for (int jj = 0; jj < 16; ++jj) { const auto sw = __builtin_amdgcn_permlane32_swap(key[jj], key[jj], false, false); okey[jj] = hi ? sw[0] : sw[1]; }
    unsigned mask = 0;
#pragma unroll
    for (int jj = 0; jj < 16; ++jj) {
        int rank = 0;
#pragma unroll
        for (int kk = 0; kk < 16; ++kk) { rank += (key[kk] > key[jj]) ? 1 : 0; rank += (okey[kk] > key[jj]) ? 1 : 0; }
        if (rank < 16) mask |= 1u << (2 * jj + hi);
    }
    mask = red32_or(mask);
    if (hi == 0) ((unsigned*)(ws + WS_SEL))[(size_t)(b * 2 + g) * S_ + qpos] = mask;
    __syncthreads();
}
__device__ __forceinline__ void lora_rows(unsigned char* ws, int tid) {
    const int gw = blockIdx.x * NWAVES + (tid >> 6), ngw = gridDim.x * NWAVES, lane = tid & 63;
    bf16* kvl = (bf16*)(ws + WS_KVL); const bf16* ql = (const bf16*)(ws + WS_QL); float* ssql = (float*)(ws + WS_SSQL);
    for (int m = gw; m < T_; m += ngw) {
        const unsigned kv = *(const unsigned*)(kvl + (size_t)m * 128 + 2 * lane);
        const float k0 = __uint_as_float(kv << 16), k1 = __uint_as_float(kv & 0xffff0000u);
        const uint2 qv = *(const uint2*)(ql + (size_t)m * 256 + 4 * lane);
        const float q0 = __uint_as_float(qv.x << 16), q1 = __uint_as_float(qv.x & 0xffff0000u), q2 = __uint_as_float(qv.y << 16), q3 = __uint_as_float(qv.y & 0xffff0000u);
        const float sk = wave_sum2(k0 * k0 + k1 * k1), sq = wave_sum2((q0 * q0 + q1 * q1) + (q2 * q2 + q3 * q3));
        const float rk = rsqrtf(sk * (1.f / 128.f) + EPS);
        *(unsigned*)(kvl + (size_t)m * 128 + 2 * lane) = pk2(k0 * rk, k1 * rk);
        if (lane == 0) ssql[m] = sq;
    }
}
__device__ __forceinline__ void post_misc(unsigned char* ws, const float* big, const float* bfg, int tid) {
    const float* mr = (const float*)(ws + WS_MISCRAW); const float* cosM = (const float*)(ws + WS_COSM); const float* sinM = (const float*)(ws + WS_SINM);
    bf16* kr = (bf16*)(ws + WS_KR); float* gm = (float*)(ws + WS_GM);
    for (int idx = blockIdx.x * NTHR + tid; idx < T_ * 64; idx += gridDim.x * NTHR) {
        const int row = idx >> 6, c = idx & 63; const float* r = mr + (size_t)row * 64; const float v = r[c];
        if (c < 32) { const int i = c & 15; const float x1 = r[i], x2 = r[16 + i], cs = cosM[row * 16 + i], sn = sinM[row * 16 + i];
            kr[(size_t)row * 32 + c] = f2bf((c < 16) ? x1 * cs - x2 * sn : x1 * sn + x2 * cs); }
        else if (c < 50) gm[(size_t)row * 32 + (c - 32)] = 1.f / (1.f + __expf(-v));
        else if (c < 54) gm[(size_t)row * 32 + 18 + (c - 50)] = v + big[c - 50];
        else if (c < 58) { const float z = v + bfg[c - 54]; gm[(size_t)row * 32 + 22 + (c - 54)] = fminf(z, 0.f) - __logf(1.f + __expf(-fabsf(z))); }
    }
}

typedef float f32x4v __attribute__((ext_vector_type(4)));
__device__ __forceinline__ void compress_item(unsigned char* ws, LAS unsigned char* lds, const float* cmp_pos, int item, int wave_u) {
    const int lane = fresh_lane(), tid = wave_u * 64 + lane;
    const int nb = item & 7, g = (item >> 3) & 1, b = (item >> 4) & 7, kv = item >> 7;
    const bf16* tok = (const bf16*)(ws + WS_NSA) + (size_t)b * S_ * 1152 + (kv ? 512 : 384) + g * 64;
    const bf16* wt = (const bf16*)(ws + (kv ? WT_CV : WT_CK));
    const int nrow = nb * 16 + (lane & 15), kq = lane >> 4;
    f32x4v acc[4] = {f32x4v{}, f32x4v{}, f32x4v{}, f32x4v{}};
#pragma unroll
    for (int hb = 0; hb < 2; ++hb) {
        v4u t4[4]; f32x4v p0[4], p1[4]; bf16x8 bfr[4][4];
#pragma unroll
        for (int q = 0; q < 4; ++q) {
            const int k = wave_u * 256 + (4 * hb + q) * 32 + kq * 8, l = k >> 6, d = k & 63;
            int trow = 16 * nrow + l; trow = trow < S_ ? trow : S_ - 1;
            t4[q] = *(const v4u*)(tok + (size_t)trow * 1152 + d);
            p0[q] = *(const f32x4v*)(cmp_pos + k); p1[q] = *(const f32x4v*)(cmp_pos + k + 4);
#pragma unroll
            for (int cb = 0; cb < 4; ++cb) bfr[q][cb] = *(const bf16x8*)(wt + (size_t)(cb * 16 + (lane & 15)) * 2048 + k);
        }
        asm volatile("" : "+v"(t4[0]), "+v"(t4[1]), "+v"(t4[2]), "+v"(t4[3]), "+v"(p0[0]), "+v"(p0[1]), "+v"(p0[2]), "+v"(p0[3]), "+v"(p1[0]), "+v"(p1[1]), "+v"(p1[2]), "+v"(p1[3]));
        asm volatile("" : "+v"(bfr[0][0]), "+v"(bfr[0][1]), "+v"(bfr[0][2]), "+v"(bfr[0][3]), "+v"(bfr[1][0]), "+v"(bfr[1][1]), "+v"(bfr[1][2]), "+v"(bfr[1][3]));
        asm volatile("" : "+v"(bfr[2][0]), "+v"(bfr[2][1]), "+v"(bfr[2][2]), "+v"(bfr[2][3]), "+v"(bfr[3][0]), "+v"(bfr[3][1]), "+v"(bfr[3][2]), "+v"(bfr[3][3]));
#pragma unroll
        for (int q = 0; q < 4; ++q) {
            v4u a4;
            a4.x = cvtpk(__uint_as_float(t4[q].x << 16) + p0[q][0], __uint_as_float(t4[q].x & 0xffff0000u) + p0[q][1]); a4.y = cvtpk(__uint_as_float(t4[q].y << 16) + p0[q][2], __uint_as_float(t4[q].y & 0xffff0000u) + p0[q][3]);
            a4.z = cvtpk(__uint_as_float(t4[q].z << 16) + p1[q][0], __uint_as_float(t4[q].z & 0xffff0000u) + p1[q][1]); a4.w = cvtpk(__uint_as_float(t4[q].w << 16) + p1[q][2], __uint_as_float(t4[q].w & 0xffff0000u) + p1[q][3]);
            const bf16x8 af = __builtin_bit_cast(bf16x8, a4);
#pragma unroll
            for (int cb = 0; cb < 4; ++cb) acc[cb] = __builtin_amdgcn_mfma_f32_16x16x32_bf16(af, bfr[q][cb], acc[cb], 0, 0, 0);
        }
    }
    LAS float* red = (LAS float*)lds + wave_u * 1024;
#pragma unroll
    for (int cb = 0; cb < 4; ++cb)
#pragma unroll
        for (int r = 0; r < 4; ++r) red[(4 * (lane >> 4) + r) * 64 + cb * 16 + (lane & 15)] = acc[cb][r];
    __syncthreads();
    bf16* out = (bf16*)(ws + WS_KCV) + (size_t)kv * (8 * 2 * 128 * 64) + ((size_t)(b * 2 + g) * 128 + nb * 16) * 64;
    for (int o = tid; o < 1024; o += NTHR) { float sum = 0.f;
#pragma unroll
        for (int w8 = 0; w8 < 8; ++w8) sum += ((LAS float*)lds)[w8 * 1024 + o];
        out[o] = f2bf(sum); }
    __syncthreads();
}
__device__ __forceinline__ f32x4v mm16(const LAS bf16* A, int lda, int arow0, const LAS bf16* Bt, int ldb, int bcol0, int K, int lane, f32x4v acc) {
    const LAS bf16* ap = A + (arow0 + (lane & 15)) * lda + 8 * (lane >> 4); const LAS bf16* bp = Bt + (bcol0 + (lane & 15)) * ldb + 8 * (lane >> 4);
    for (int k = 0; k < K; k += 32) acc = __builtin_amdgcn_mfma_f32_16x16x32_bf16(*(const LAS bf16x8*)(ap + k), *(const LAS bf16x8*)(bp + k), acc, 0, 0, 0);
    return acc;
}
constexpr int ML_LD = 72;
constexpr int ML_STRIDE = 3 * 64 * ML_LD * 2 + 256;
__device__ __forceinline__ void mlocal_item(unsigned char* ws, LAS unsigned char* lds, const float* convw, const float* convb, const float* big, const float* bfg, int chunk0, int wave_u) {
    const int lane = fresh_lane(), tid = wave_u * 64 + lane;
    const int h = (chunk0 >> 5) & 3, b = chunk0 >> 7;
    LAS bf16* WQ = (LAS bf16*)lds;
    LAS bf16* WK = WQ + 64 * ML_LD;
    const bf16* cm = (const bf16*)(ws + WS_CM);
#define ML_PTRS(ch) const int chunk = chunk0 + (ch); const int c = chunk & 31; const int row0 = b * S_ + c * 64; LAS bf16* XS = WK + 64 * ML_LD + (ch) * (ML_STRIDE / 2); \
    LAS bf16* VT = XS + 64 * ML_LD; LAS bf16* WKT = VT + 64 * ML_LD; LAS float* wl = (LAS float*)(WKT + 64 * ML_LD); (void)c; (void)row0; (void)XS; (void)VT; (void)WKT; (void)wl; (void)chunk;
    {
        v4u gx[2][4], gv[2]; const int l = tid >> 3, ch0 = (tid & 7) * 8;
#pragma unroll
        for (int ch = 0; ch < 2; ++ch) { ML_PTRS(ch) const int row = row0 + l, s = c * 64 + l;
#pragma unroll
            for (int j = 0; j < 4; ++j) gx[ch][j] = (s - 3 + j >= 0) ? *(const v4u*)(cm + (size_t)(row - 3 + j) * 768 + h * 64 + ch0) : v4u{0u, 0u, 0u, 0u};
            gv[ch] = *(const v4u*)(cm + (size_t)row * 768 + 256 + h * 64 + ch0); }
        asm volatile("" : "+v"(gx[0][0]), "+v"(gx[0][1]), "+v"(gx[0][2]), "+v"(gx[0][3]), "+v"(gx[1][0]), "+v"(gx[1][1]), "+v"(gx[1][2]), "+v"(gx[1][3]), "+v"(gv[0]), "+v"(gv[1]));
#pragma unroll
        for (int ch = 0; ch < 2; ++ch) { ML_PTRS(ch) const int row = row0 + l;
            float a[8];
#pragma unroll
            for (int i = 0; i < 8; ++i) a[i] = convb[h * 64 + ch0 + i];
#pragma unroll
            for (int j = 0; j < 4; ++j) { const v4u x4 = gx[ch][j];
                const float* cw = convw + j * 256 + h * 64 + ch0;
                a[0] += cw[0] * __uint_as_float(x4.x << 16); a[1] += cw[1] * __uint_as_float(x4.x & 0xffff0000u); a[2] += cw[2] * __uint_as_float(x4.y << 16); a[3] += cw[3] * __uint_as_float(x4.y & 0xffff0000u);
                a[4] += cw[4] * __uint_as_float(x4.z << 16); a[5] += cw[5] * __uint_as_float(x4.z & 0xffff0000u); a[6] += cw[6] * __uint_as_float(x4.w << 16); a[7] += cw[7] * __uint_as_float(x4.w & 0xffff0000u); }
            v4u o4; float r[8];
#pragma unroll
            for (int i = 0; i < 8; ++i) r[i] = a[i] / (1.f + __expf(-a[i]));
            o4.x = cvtpk(r[0], r[1]); o4.y = cvtpk(r[2], r[3]); o4.z = cvtpk(r[4], r[5]); o4.w = cvtpk(r[6], r[7]);
            *(v4u*)((bf16*)(ws + WS_XC) + (size_t)row * 256 + h * 64 + ch0) = o4;
            *(LAS v4u*)(XS + l * ML_LD + ch0) = o4;
            const v4u v4 = gv[ch];
            VT[(ch0 + 0) * ML_LD + l] = (bf16)(v4.x & 0xffffu); VT[(ch0 + 1) * ML_LD + l] = (bf16)(v4.x >> 16); VT[(ch0 + 2) * ML_LD + l] = (bf16)(v4.y & 0xffffu); VT[(ch0 + 3) * ML_LD + l] = (bf16)(v4.y >> 16);
            VT[(ch0 + 4) * ML_LD + l] = (bf16)(v4.z & 0xffffu); VT[(ch0 + 5) * ML_LD + l] = (bf16)(v4.z >> 16); VT[(ch0 + 6) * ML_LD + l] = (bf16)(v4.w & 0xffffu); VT[(ch0 + 7) * ML_LD + l] = (bf16)(v4.w >> 16);
        }
    }
    {
        const int e = tid >> 3, d0 = (tid & 7) * 8;
        *(LAS v4u*)(WQ + e * ML_LD + d0) = *(const v4u*)((const bf16*)(ws + WT_QM) + h * 4096 + e * 64 + d0);
        *(LAS v4u*)(WK + e * ML_LD + d0) = *(const v4u*)((const bf16*)(ws + WT_KM) + h * 4096 + e * 64 + d0);
    }
    if (wave_u < 2) { ML_PTRS(wave_u)
        const float* mr = (const float*)(ws + WS_MISCRAW) + (size_t)(row0 + lane) * 64;
        const float z = mr[54 + h] + bfg[h]; float lf = fminf(z, 0.f) - __logf(1.f + __expf(-fabsf(z)));
        const float ig = mr[50 + h] + big[h];
#pragma unroll
        for (int o = 1; o < 64; o <<= 1) { const float t = bperm(lf, lane - o); if (lane >= o) lf += t; }
        const float bL = __int_as_float(__builtin_amdgcn_readlane(__float_as_int(lf), 63));
        const float a = bL - lf + ig; const float mx = wave_max2(a);
        wl[lane] = __expf(a - mx);
        if (lane == 0) { ((float*)(ws + WS_ML))[chunk] = mx; ((float*)(ws + WS_BL))[chunk] = bL; }
    }
    __syncthreads();
#pragma unroll
    for (int ch = 0; ch < 2; ++ch) { ML_PTRS(ch)
        const int lb = wave_u & 3; const bool isk = wave_u >= 4;
        const LAS bf16* Wt = isk ? WK : WQ;
        bf16* og = (bf16*)(ws + (isk ? WS_MK : WS_MQ)) + (size_t)(row0 + 16 * lb + 4 * (lane >> 4)) * 256 + h * 64 + (lane & 15);
        float w4[4];
#pragma unroll
        for (int r = 0; r < 4; ++r) w4[r] = wl[16 * lb + 4 * (lane >> 4) + r];
#pragma unroll
        for (int eb = 0; eb < 4; ++eb) {
            f32x4v acc = mm16(XS, ML_LD, 16 * lb, Wt, ML_LD, 16 * eb, 64, lane, f32x4v{});
            if (!isk) {
#pragma unroll
                for (int r = 0; r < 4; ++r) og[(size_t)r * 256 + 16 * eb] = f2bf(acc[r] * 0.125f);
            } else {
                bf16 kb[4];
#pragma unroll
                for (int r = 0; r < 4; ++r) { kb[r] = f2bf(acc[r]); og[(size_t)r * 256 + 16 * eb] = kb[r]; }
                u32x2v w2; w2.x = cvtpk(bf2f(kb[0]) * w4[0], bf2f(kb[1]) * w4[1]); w2.y = cvtpk(bf2f(kb[2]) * w4[2], bf2f(kb[3]) * w4[3]);
                *(LAS u32x2v*)(WKT + (16 * eb + (lane & 15)) * ML_LD + 16 * lb + 4 * (lane >> 4)) = w2;
            }
        }
    }
    __syncthreads();
#pragma unroll
    for (int ch = 0; ch < 2; ++ch) { ML_PTRS(ch)
        float* ct = (float*)(ws + WS_CT) + (size_t)chunk * 4096;
#pragma unroll
        for (int i = 0; i < 2; ++i) { const int blk = wave_u * 2 + i, eb = blk >> 2, db = blk & 3;
            const f32x4v acc = mm16(VT, ML_LD, 16 * eb, WKT, ML_LD, 16 * db, 64, lane, f32x4v{});
#pragma unroll
            for (int r = 0; r < 4; ++r) ct[(16 * eb + 4 * (lane >> 4) + r) * 64 + 16 * db + (lane & 15)] = acc[r]; }
    }
    if (tid < 128) { ML_PTRS(tid >> 6)
        const int d = tid & 63; float n = 0.f; const LAS bf16* wr_ = WKT + d * ML_LD;
        for (int l = 0; l < 64; ++l) n += bf2f(wr_[l]);
        ((float*)(ws + WS_NL))[chunk * 64 + d] = n; }
#undef ML_PTRS
    __syncthreads();
}
__device__ __forceinline__ void mscan_item(unsigned char* ws, int item, int wave_u) {
    const int tid = wave_u * 64 + fresh_lane();
    const int bh = item / 9, part = item % 9;
    if (part == 8 && tid >= 64) return;
    float* base; size_t stride;
    if (part < 8) { base = (float*)(ws + WS_CT) + (size_t)bh * 32 * 4096 + part * 512 + tid; stride = 4096; } else { base = (float*)(ws + WS_NL) + (size_t)bh * 32 * 64 + tid; stride = 64; }
    const float* ML = (const float*)(ws + WS_ML); const float* BL = (const float*)(ws + WS_BL); float* MPv = (float*)(ws + WS_MP);
    float cl[32];
#pragma unroll
    for (int c = 0; c < 32; ++c) cl[c] = base[(size_t)c * stride];
    float Cv = 0.f, m = 0.f;
#pragma unroll
    for (int c = 0; c < 32; ++c) {
        const float ml = ML[bh * 32 + c], bl = BL[bh * 32 + c];
        base[(size_t)c * stride] = Cv;
        if (part == 8 && tid == 0) MPv[bh * 32 + c] = m;
        const float mn = fmaxf(bl + m, ml);
        Cv = __expf(bl + m - mn) * Cv + __expf(ml - mn) * cl[c]; m = mn;
    }
}
constexpr int MO_STRIDE = 5 * 64 * ML_LD * 2 + 64 * 65 * 4 + 6 * 64 * 4;
__device__ __forceinline__ void mout_item(unsigned char* ws, LAS unsigned char* lds, const float* gmh, const float* skip, int chunk0, int wave_u) {
    const int lane = fresh_lane(), tid = wave_u * 64 + lane;
    const int h = (chunk0 >> 5) & 3, b = chunk0 >> 7;
    const float* gm = (const float*)(ws + WS_GM);
#define MO_PTRS(ch) const int chunk = chunk0 + (ch); const int row0 = b * S_ + (chunk & 31) * 64; LAS unsigned char* cb_ = lds + (ch) * MO_STRIDE; \
    LAS bf16* QS = (LAS bf16*)cb_; LAS bf16* KS = QS + 64 * ML_LD; LAS bf16* VT = KS + 64 * ML_LD; LAS bf16* CP = VT + 64 * ML_LD; LAS bf16* SW = CP + 64 * ML_LD; \
    LAS float* HS = (LAS float*)(SW + 64 * ML_LD); LAS float* bs = HS + 64 * 65; LAS float* us = bs + 64; LAS float* ns = us + 64; LAS float* mts = ns + 64; LAS float* ints = mts + 64; LAS float* dinv = ints + 64; \
    (void)row0; (void)QS; (void)KS; (void)VT; (void)CP; (void)SW; (void)HS; (void)bs; (void)us; (void)ns; (void)mts; (void)ints; (void)dinv; (void)chunk;
    {
        v4u gq[2], gk[2], gv[2]; f32x4v gc0[2], gc1[2];
        const int l = tid >> 3, c0 = (tid & 7) * 8;
#pragma unroll
        for (int ch = 0; ch < 2; ++ch) { MO_PTRS(ch) const int row = row0 + l;
            gq[ch] = *(const v4u*)((const bf16*)(ws + WS_MQ) + (size_t)row * 256 + h * 64 + c0); gk[ch] = *(const v4u*)((const bf16*)(ws + WS_MK) + (size_t)row * 256 + h * 64 + c0);
            gv[ch] = *(const v4u*)((const bf16*)(ws + WS_CM) + (size_t)row * 768 + 256 + h * 64 + c0);
            const float* ct = (const float*)(ws + WS_CT) + (size_t)chunk * 4096 + l * 64 + c0;
            gc0[ch] = *(const f32x4v*)ct; gc1[ch] = *(const f32x4v*)(ct + 4); }
        asm volatile("" : "+v"(gq[0]), "+v"(gq[1]), "+v"(gk[0]), "+v"(gk[1]), "+v"(gv[0]), "+v"(gv[1]), "+v"(gc0[0]), "+v"(gc0[1]), "+v"(gc1[0]), "+v"(gc1[1]));
#pragma unroll
        for (int ch = 0; ch < 2; ++ch) { MO_PTRS(ch)
            *(LAS v4u*)(QS + l * ML_LD + c0) = gq[ch]; *(LAS v4u*)(KS + l * ML_LD + c0) = gk[ch];
            const v4u v4 = gv[ch];
            VT[(c0 + 0) * ML_LD + l] = (bf16)(v4.x & 0xffffu); VT[(c0 + 1) * ML_LD + l] = (bf16)(v4.x >> 16); VT[(c0 + 2) * ML_LD + l] = (bf16)(v4.y & 0xffffu); VT[(c0 + 3) * ML_LD + l] = (bf16)(v4.y >> 16);
            VT[(c0 + 4) * ML_LD + l] = (bf16)(v4.z & 0xffffu); VT[(c0 + 5) * ML_LD + l] = (bf16)(v4.z >> 16); VT[(c0 + 6) * ML_LD + l] = (bf16)(v4.w & 0xffffu); VT[(c0 + 7) * ML_LD + l] = (bf16)(v4.w >> 16);
            const f32x4v c0v = gc0[ch], c1v = gc1[ch];
            v4u cw; cw.x = cvtpk(c0v[0], c0v[1]); cw.y = cvtpk(c0v[2], c0v[3]); cw.z = cvtpk(c1v[0], c1v[1]); cw.w = cvtpk(c1v[2], c1v[3]);
            *(LAS v4u*)(CP + l * ML_LD + c0) = cw; }
    }
    if (wave_u < 2) { MO_PTRS(wave_u)
        const float ig = gm[(size_t)(row0 + lane) * 32 + 18 + h]; float lf = gm[(size_t)(row0 + lane) * 32 + 22 + h];
#pragma unroll
        for (int o = 1; o < 64; o <<= 1) { const float t = bperm(lf, lane - o); if (lane >= o) lf += t; }
        const float u = ig - lf; float cu = u;
#pragma unroll
        for (int o = 1; o < 64; o <<= 1) { const float t = bperm(cu, lane - o); if (lane >= o) cu = fmaxf(cu, t); }
        const float mprev = ((const float*)(ws + WS_MP))[chunk];
        const float mt = lf + fmaxf(mprev, cu);
        bs[lane] = lf; us[lane] = u; mts[lane] = mt; ints[lane] = __expf(lf + mprev - mt); ns[lane] = ((const float*)(ws + WS_NL))[chunk * 64 + lane];
    }
    __syncthreads();
#pragma unroll
    for (int ch = 0; ch < 2; ++ch) { MO_PTRS(ch)
#pragma unroll
        for (int i = 0; i < 2; ++i) { const int blk = wave_u * 2 + i, lb = blk >> 2, sb = blk & 3;
            f32x4v acc = f32x4v{};
            if (sb <= lb) acc = mm16(QS, ML_LD, 16 * lb, KS, ML_LD, 16 * sb, 64, lane, acc);
            const int sidx = 16 * sb + (lane & 15); const float usv = us[sidx];
#pragma unroll
            for (int r = 0; r < 4; ++r) { const int l = 16 * lb + 4 * (lane >> 4) + r;
                const float v = (sidx <= l) ? acc[r] * __expf(bs[l] + usv - mts[l]) : 0.f;
                SW[l * ML_LD + sidx] = f2bf(v); } }
    }
    __syncthreads();
    if (tid < 128) { MO_PTRS(tid >> 6)
        const int l = tid & 63; float qn = 0.f, ssum = 0.f;
        for (int d = 0; d < 64; ++d) { qn += bf2f(QS[l * ML_LD + d]) * ns[d]; ssum += bf2f(SW[l * ML_LD + d]); }
        const float den = ints[l] * qn + ssum;
        dinv[l] = 1.f / fmaxf(fabsf(den), __expf(-mts[l]));
    }
    f32x4v hq[2][2], hs2[2][2];
#pragma unroll
    for (int ch = 0; ch < 2; ++ch) { MO_PTRS(ch)
#pragma unroll
        for (int i = 0; i < 2; ++i) { const int blk = wave_u * 2 + i, lb = blk >> 2, eb = blk & 3;
            hq[ch][i] = mm16(QS, ML_LD, 16 * lb, CP, ML_LD, 16 * eb, 64, lane, f32x4v{});
            hs2[ch][i] = mm16(SW, ML_LD, 16 * lb, VT, ML_LD, 16 * eb, 16 * lb + 16 <= 32 ? 32 : 64, lane, f32x4v{}); }
    }
    __syncthreads();
#pragma unroll
    for (int ch = 0; ch < 2; ++ch) { MO_PTRS(ch)
#pragma unroll
        for (int i = 0; i < 2; ++i) { const int blk = wave_u * 2 + i, lb = blk >> 2, eb = blk & 3; const int e = 16 * eb + (lane & 15);
#pragma unroll
            for (int r = 0; r < 4; ++r) { const int l = 16 * lb + 4 * (lane >> 4) + r;
                const float og = bf2f(((const bf16*)(ws + WS_CM))[(size_t)(row0 + l) * 768 + 512 + h * 64 + e]);
                HS[l * 65 + e] = (ints[l] * hq[ch][i][r] + hs2[ch][i][r]) * dinv[l] / (1.f + __expf(-og)); } }
    }
    __syncthreads();
#pragma unroll
    for (int ch = 0; ch < 2; ++ch) { MO_PTRS(ch)
        const int l = tid >> 3, e0 = (tid & 7) * 8, row = row0 + l;
        float v[8]; float mu = 0.f;
#pragma unroll
        for (int i = 0; i < 8; ++i) { v[i] = HS[l * 65 + e0 + i]; mu += v[i]; }
        mu += sxf<1>(mu); mu += sxf<2>(mu); mu += sxf<4>(mu); mu *= (1.f / 64.f);
        float var = 0.f;
#pragma unroll
        for (int i = 0; i < 8; ++i) { const float dl = v[i] - mu; var += dl * dl; }
        var += sxf<1>(var); var += sxf<2>(var); var += sxf<4>(var);
        const float rs = rsqrtf(var * (1.f / 64.f) + EPS);
        const v4u x4 = *(const v4u*)((const bf16*)(ws + WS_XC) + (size_t)row * 256 + h * 64 + e0);
        float xv[8]; xv[0] = __uint_as_float(x4.x << 16); xv[1] = __uint_as_float(x4.x & 0xffff0000u); xv[2] = __uint_as_float(x4.y << 16); xv[3] = __uint_as_float(x4.y & 0xffff0000u);
        xv[4] = __uint_as_float(x4.z << 16); xv[5] = __uint_as_float(x4.z & 0xffff0000u); xv[6] = __uint_as_float(x4.w << 16); xv[7] = __uint_as_float(x4.w & 0xffff0000u);
        float r[8];
#pragma unroll
        for (int i = 0; i < 8; ++i) r[i] = (v[i] - mu) * rs * gmh[h * 64 + e0 + i] + skip[h * 64 + e0 + i] * xv[i];
        v4u w4; w4.x = cvtpk(r[0], r[1]); w4.y = cvtpk(r[2], r[3]); w4.z = cvtpk(r[4], r[5]); w4.w = cvtpk(r[6], r[7]);
        *(v4u*)((bf16*)(ws + WS_HB) + (size_t)row * D_ + 768 + h * 64 + e0) = w4;
    }
#undef MO_PTRS
    __syncthreads();
}

__global__ void __launch_bounds__(NTHR, 2) mega(MP p_unused) {
    extern __shared__ __attribute__((aligned(16))) unsigned char lds_raw[];
    LAS unsigned char* lds = (LAS unsigned char*)lds_raw;
    const int wave0 = __builtin_amdgcn_readfirstlane((int)threadIdx.x >> 6);
    const int tid0 = wave0 * 64 + fresh_lane();
    const int xcc = (int)(__builtin_amdgcn_s_getreg((3 << 11) | 20) & 7u);
    volatile LAS unsigned* MISC = (volatile LAS unsigned*)(lds + MISC_OFF);
    for (int u = tid0; u < (LDS_BYTES - RING_BYTES) / 4; u += NTHR) ((LAS unsigned*)(lds + RING_BYTES))[u] = 0u;
    __syncthreads();
    typedef const __attribute__((address_space(4))) MP* kmp_t;
    kmp_t kp0 = (kmp_t)__builtin_amdgcn_kernarg_segment_ptr();
    unsigned char* ws0 = kp0->ws; const int coop = kp0->coop, ph_lo = kp0->ph_lo, ph_hi = kp0->ph_hi;
    XcdBarrier bar; bar.bar = (unsigned*)(ws0 + WS_CTL) + CW_BAR; bar.x = 0; bar.st = nullptr;
    if (coop) bar = xcd_barrier_post((unsigned*)(ws0 + WS_CTL) + CW_BAR, MISC + 8, tid0);
    if (coop == 2) cooperative_groups::this_grid().sync();
    int ph = ph_lo;
    if (ph == 0) {
        const MPK p{kp0}; ph_p0(p, lds, wave0 * 64 + fresh_lane()); ph = 1;
        if (ph < ph_hi) xcd_barrier(bar, wave0 * 64 + fresh_lane());
    }
    bool second = false;
    for (; ph < ph_hi; ++ph) {
        kmp_t kp = kp0; asm volatile("" : "+s"(kp));
        const MPK p{kp}; unsigned char* ws = kp->ws;
#define TID_ (wave0 * 64 + fresh_lane())
#define GW_ (blockIdx.x * NWAVES + wave0)
#define NGW_ (gridDim.x * NWAVES)
        const int l = (ph - 1) / PPL, ty = (ph == 0) ? -1 : (ph == NPH - 1) ? -2 : (ph - 1) % PPL;
        const float* modl = (const float*)(ws + WS_MOD) + (size_t)l * 8 * 6144;
        if (ty == -2) { final_load((const bf16*)p.k->out, lds, TID_); xcd_barrier(bar, TID_); final_store(PIN(I_GFIN), p.k->out, lds, TID_);
            if (PROBE_SEL != 0 && blockIdx.x == 0 && TID_ == 0) { asm volatile("s_waitcnt vmcnt(0)" ::: "memory"); p.k->out[0] = ((const float*)(ws + WS_CTL))[100] * 0.001f; } }
        else if (ty == 0 && (PHM & 2)) ph_prep(p, l, lds, TID_);
        else if (ty == 1 && (PHM & 4)) {
            pg8::Gemm g{(const bf16*)(ws + WS_HB), (const bf16*)(ws + WT_IN), T_, 2560, D_}; pg8::StaticOrder S; S.init(T_, 2560, gridDim.x, blockIdx.x);
            pg8::EpiIn E{ws, PIN(I_BIG) + l * 4, PIN(I_BFG) + l * 4};
            pg8::gemm_phase<pg8::EpiIn, pg8::StaticOrder, true, true>(lds, g, S, E, wave0);
            late_transposes(p, l, lds, TID_, 640 % (int)gridDim.x);
        }
        else if (ty == 2 && (PHM & 64)) {
            { pg8::Gemm g{(const bf16*)(ws + WS_KVL), (const bf16*)(ws + WT_UKV), T_, 768, 128}; pg8::StaticOrder S; S.init(T_, 768, gridDim.x, blockIdx.x);
              pg8::EpiUKV E{(bf16*)(ws + WS_KVM), (const float*)(ws + WS_SSKV)}; pg8::gemm_phase<pg8::EpiUKV, pg8::StaticOrder, true, true>(lds, g, S, E, wave0); }
            { pg8::Gemm g{(const bf16*)(ws + WS_QL), (const bf16*)(ws + WT_UQ), T_, 768, 256}; pg8::StaticOrder S; S.init(T_, 768, gridDim.x, blockIdx.x);
              pg8::EpiPlain E{(bf16*)(ws + WS_OSLC), 768}; pg8::gemm_phase<pg8::EpiPlain, pg8::StaticOrder, true, true>(lds, g, S, E, wave0); }
            post_misc(ws, PIN(I_BIG) + l * 4, PIN(I_BFG) + l * 4, TID_);
            unsigned* ctrs = (unsigned*)(ws + WS_CTL) + 8192 + ph * 256 + (second ? 128 : 0); int ks = 0;
            for (;;) { const int it = next_item_q(ctrs, lds, wave0, 96, xcc, ks); if (it < 0) break; const int b = it >> 16, j = it & 0xffff;
                if (j < 64) mlocal_item(ws, lds, PIN(I_CONVW) + l * 1024, PIN(I_CONVB) + l * 256, PIN(I_BIG) + l * 4, PIN(I_BFG) + l * 4, b * 128 + 2 * j, wave0);
                else { const int k = j - 64; compress_item(ws, lds, PIN(I_CMPPOS) + l * 2048, ((k >> 4) << 7) | (b << 4) | (k & 15), wave0); } }
        }
        else if (ty == 3 && (PHM & 128)) {
            unsigned* ctrs = (unsigned*)(ws + WS_CTL) + 8192 + ph * 256 + (second ? 128 : 0); int ks = 0;
            for (;;) { const int it = next_item_q(ctrs, lds, wave0, second ? 64 : 100, xcc, ks); if (it < 0) break; const int b = it >> 16, j = it & 0xffff;
                if (second && (REP_MASK & (1 << 20)) && j >= 48) continue; if (second && (REP_MASK & (1 << 21)) && j < 48) continue;
                if (j < 18) mla_unit(ws, lds, b, j % 6, 7 - j / 6, wave0);
                else if (j < 34) cmp_unit(ws, lds, b, (j - 18) >> 3, 7 - ((j - 18) & 7), wave0);
                else if (j < 64) { const int u = j - 16; mla_unit(ws, lds, b, u % 6, 7 - u / 6, wave0); }
                else mscan_item(ws, b * 36 + (j - 64), wave0); }
        }
        else if (ty == 4 && (PHM & 256)) {
            unsigned* ctrs = (unsigned*)(ws + WS_CTL) + 8192 + ph * 256 + (second ? 128 : 0); int ks = 0;
            for (;;) { const int it = next_item_q(ctrs, lds, wave0, 160, xcc, ks); if (it < 0) break; const int b = it >> 16, j = it & 0xffff;
                if (second && (REP_MASK & (1 << 16)) && j >= 96) continue; if (second && (REP_MASK & (1 << 17)) && j < 96) continue;
                if (j < 36) nsa_branch_unit<AM_SLC>(ws, lds, b, j % 6, 7 - j / 6, wave0);
                else if (j < 84) nsa_branch_unit<AM_WINDOW>(ws, lds, b, (j - 36) % 6, 7 - (j - 36) / 6, wave0);
                else if (j < 96) { const int u = j - 48; nsa_branch_unit<AM_SLC>(ws, lds, b, u % 6, 7 - u / 6, wave0); }
                else mout_item(ws, lds, PIN(I_GMH) + l * 256, PIN(I_SKIP) + l * 256, b * 128 + 2 * (j - 96), wave0); }
        }
        else if (ty == 5) ph_mixnorm(p, l, TID_);
        else if (ty == 6 && (PHM & 8)) {
            pg8::Gemm g{(const bf16*)(ws + WS_HB), (const bf16*)(ws + WT_OUT), T_, D_, D_}; pg8::StaticOrder S; S.init(T_, D_, gridDim.x, blockIdx.x);
            pg8::EpiRes E{(l == 0) ? PIN(I_X) : nullptr, (const bf16*)p.k->out, (bf16*)p.k->out, modl + 2048};
            pg8::gemm_phase<pg8::EpiRes, pg8::StaticOrder, true, true>(lds, g, S, E, wave0);
        }
        else if (ty == 7) norm_rows<true>(p.k->out, PIN(I_GN2) + l * D_, modl + 3072, modl + 4096, (bf16*)(ws + WS_HB), GW_, NGW_, fresh_lane());
        else if (ty == 8 && (PHM & 16)) {
            pg8::Gemm g{(const bf16*)(ws + WS_HB), (const bf16*)(ws + WT_GU), T_, 2 * FF, D_}; pg8::StaticOrder S; S.init(T_, 2 * FF, gridDim.x, blockIdx.x);
            pg8::EpiGU E{(bf16*)(ws + WS_ACT)};
            pg8::gemm_phase<pg8::EpiGU, pg8::StaticOrder, true, true>(lds, g, S, E, wave0);
            if (l + 1 < DEPTH) early_transposes(p, l + 1, lds, TID_, 1408 % (int)gridDim.x);
        }
        else if (ty == 9 && (PHM & 32)) {
            pg8::Gemm g{(const bf16*)(ws + WS_ACT), (const bf16*)(ws + WT_DOWN), T_, D_, FF}; pg8::StaticOrder S; S.init(T_, D_, gridDim.x, blockIdx.x);
            pg8::EpiRes E{nullptr, (const bf16*)p.k->out, (bf16*)p.k->out, modl + 5120};
            pg8::gemm_phase<pg8::EpiRes, pg8::StaticOrder, true, true>(lds, g, S, E, wave0);
        }
        if (REP_MASK != 0 && ty >= 0 && ((REP_MASK >> ty) & 1) && !second) { second = true; --ph; } else second = false;
        if (ph + 1 < ph_hi) xcd_barrier(bar, wave0 * 64 + fresh_lane());
    }
}

extern "C" void kernel_launch(void* const* d_in, const int* in_sizes, int n_in, void* d_out, int out_size, void* d_ws, size_t ws_size, hipStream_t stream) {
    if (n_in != N_IN || ws_size < WS_END) { fprintf(stderr, "kernel_launch: unexpected n_in %d / ws %zu\n", n_in, ws_size); return; }
    static int inited = 0;
    if (!inited) { if (hipFuncSetAttribute((const void*)mega, hipFuncAttributeMaxDynamicSharedMemorySize, LDS_BYTES) != hipSuccess) fprintf(stderr, "hipFuncSetAttribute failed\n"); inited = 1; }
    unsigned char* ws = (unsigned char*)d_ws;
    MP base{}; for (int i = 0; i < N_IN; ++i) base.in[i] = (const float*)d_in[i]; base.out = (float*)d_out; base.ws = ws;
    (void)hipMemsetAsync(ws + WS_CTL, 0, CTL_ZERO_BYTES, stream);
    static int grid = 0;
    if (!grid) {
        int dev = 0, cus = 0, per_cu = 0;
        (void)hipGetDevice(&dev); (void)hipDeviceGetAttribute(&cus, hipDeviceAttributeMultiprocessorCount, dev);
        if (hipOccupancyMaxActiveBlocksPerMultiprocessor(&per_cu, (const void*)mega, NTHR, LDS_BYTES) != hipSuccess || per_cu < 1) { fprintf(stderr, "kernel_launch: occupancy query says %d blocks per CU\n", per_cu); per_cu = 1; }
        (void)hipGetLastError();
        grid = cus;
    }
    MP a = base; a.ph_lo = 0; a.ph_hi = NPH; a.coop = 1;
    void* args[] = {&a};
    const hipError_t e = hipLaunchCooperativeKernel((const void*)mega, dim3(grid), dim3(NTHR), args, LDS_BYTES, stream);
    if (e != hipSuccess) fprintf(stderr, "kernel_launch: cooperative launch failed: %s (grid %d)\n", hipGetErrorString(e), grid);
}
```

```cpp
#include <hip/hip_runtime.h>
#include <cstdint>
#include <cstdio>
#include <type_traits>
#include <hip/hip_cooperative_groups.h>

constexpr int B_ = 8, S_ = 2048, T_ = B_ * S_, D_ = 1024, DIN = 2362, FF = 2816, DEPTH = 2;
constexpr float EPS = 1e-6f;
constexpr float LOG2E = 1.4426950408889634f;
constexpr float QSCALE = 0.125f * LOG2E;
constexpr float MSCALE = 0.10206207261596577f * LOG2E;
enum { I_X = 0, I_C, I_POS, I_GN1, I_GN2, I_WADA, I_BADA, I_WIN, I_CMPPOS, I_WCK, I_WCV, I_GOA, I_GQL, I_WUQ, I_GKVL, I_WUKV, I_GOB,
       I_CONVW, I_CONVB, I_WQM, I_WKM, I_BIG, I_BFG, I_GMH, I_SKIP, I_WOUT, I_WGU, I_WDOWN, I_GFIN, N_IN };

constexpr size_t MiB = 1u << 20;
constexpr size_t WS_CTL = 0;
constexpr size_t WS_MOD = 1 * MiB;
constexpr size_t WS_COSP = WS_MOD + 512 * 1024;
constexpr size_t WS_SINP = WS_COSP + 512 * 1024;
constexpr size_t WS_COSM = WS_SINP + 512 * 1024;
constexpr size_t WS_SINM = WS_COSM + 1 * MiB;
constexpr size_t WS_SSQL = WS_SINM + 1 * MiB;
constexpr size_t WS_SSKV = WS_SSQL + 64 * 1024;
constexpr size_t WS_ML = WS_SSKV + 64 * 1024;
constexpr size_t WS_BL = WS_ML + 4096;
constexpr size_t WS_MP = WS_BL + 4096;
constexpr size_t WS_NL = WS_MP + 4096;
constexpr size_t WS_WT = 8 * MiB;
constexpr size_t WS_RAW = WS_WT;
constexpr size_t WS_HB = 34 * MiB;
constexpr size_t WS_NSA = 66 * MiB;
constexpr size_t WS_KVL = 102 * MiB;
constexpr size_t WS_QL = 106 * MiB;
constexpr size_t WS_CM = 114 * MiB;
constexpr size_t WS_GM = 138 * MiB;
constexpr size_t WS_KM = 140 * MiB;
constexpr size_t WS_QM = 158 * MiB;
constexpr size_t WS_VM = 176 * MiB;
constexpr size_t WS_KCV = 188 * MiB;
constexpr size_t WS_OCMP = 189 * MiB;
constexpr size_t WS_SEL = 201 * MiB;
constexpr size_t WS_XC = 202 * MiB;
constexpr size_t WS_MQ = 210 * MiB;
constexpr size_t WS_MK = 218 * MiB;
constexpr size_t WS_CT = 226 * MiB;
constexpr size_t WS_MISCRAW = 242 * MiB;
constexpr size_t WS_KVM = 140 * MiB;
constexpr size_t WS_KR = 246 * MiB;
constexpr size_t WS_OSLC = 164 * MiB;
constexpr size_t WS_OWIN = 176 * MiB;
constexpr size_t WS_ACT = 66 * MiB;
constexpr size_t WS_END = 256 * MiB;
static_assert(WS_NL + 1024 * 64 * 4 <= WS_WT, "tab");
static_assert(WS_ACT + (size_t)T_ * FF * 2 <= WS_KCV, "act overlay");

typedef unsigned short bf16;
__device__ __forceinline__ float bf2f(bf16 v) { return __uint_as_float(((unsigned)v) << 16); }
__device__ __forceinline__ bf16 f2bf(float f) { unsigned u = __float_as_uint(f); return (bf16)((u + 0x7fffu + ((u >> 16) & 1u)) >> 16); }
__device__ __forceinline__ float sigmoidf_(float x) { return 1.f / (1.f + __expf(-x)); }
__device__ __forceinline__ float siluf_(float x) { return x / (1.f + __expf(-x)); }
__device__ __forceinline__ float wave_sum(float v) {
#pragma unroll
    for (int o = 1; o < 64; o <<= 1) v += __shfl_xor(v, o);
    return v;
}

__device__ __forceinline__ int fresh_lane() { int l; asm volatile("v_mbcnt_lo_u32_b32 %0, -1, 0\n\tv_mbcnt_hi_u32_b32 %0, -1, %0" : "=&v"(l)); return l; }
template <int M> __device__ __forceinline__ float sxf(float v) { static_assert(M >= 1 && M < 32, "swizzle xor mask"); return __int_as_float(__builtin_amdgcn_ds_swizzle(__float_as_int(v), (M << 10) | 0x1f)); }
__device__ __forceinline__ float red32_max(float v) { auto r = __builtin_amdgcn_permlane32_swap(__float_as_uint(v), __float_as_uint(v), false, false); return fmaxf(__uint_as_float(r[0]), __uint_as_float(r[1])); }
__device__ __forceinline__ float red32_sum(float v) { auto r = __builtin_amdgcn_permlane32_swap(__float_as_uint(v), __float_as_uint(v), false, false); return __uint_as_float(r[0]) + __uint_as_float(r[1]); }
__device__ __forceinline__ unsigned red32_or(unsigned v) { auto r = __builtin_amdgcn_permlane32_swap(v, v, false, false); return r[0] | r[1]; }
__device__ __forceinline__ float bperm(float v, int src_lane) { return __int_as_float(__builtin_amdgcn_ds_bpermute(src_lane << 2, __float_as_int(v))); }
__device__ __forceinline__ float wave_sum2(float v) { v += sxf<1>(v); v += sxf<2>(v); v += sxf<4>(v); v += sxf<8>(v); v += sxf<16>(v); return red32_sum(v); }
__device__ __forceinline__ float wave_max2(float v) { v = fmaxf(v, sxf<1>(v)); v = fmaxf(v, sxf<2>(v)); v = fmaxf(v, sxf<4>(v)); v = fmaxf(v, sxf<8>(v)); v = fmaxf(v, sxf<16>(v)); return red32_max(v); }
namespace pg8 {
#define PG8_LAS __attribute__((address_space(3)))
typedef unsigned short bf16_t;
typedef short bf16x8 __attribute__((ext_vector_type(8)));
typedef float f32x4 __attribute__((ext_vector_type(4)));
typedef unsigned u32x4 __attribute__((ext_vector_type(4)));
constexpr int BM = 256, BK = 64, HALF = 128, HTB = HALF * BK * 2  , STAGE_BYTES = 8 * HTB, NXCD = 8, WGM = 8;

__host__ __device__ __forceinline__ int lds_byte(int r, int c) { const int st = (r >> 4) * 2 + (c >> 5), rr = r & 15, cc = c & 31, ob = rr * 64 + cc * 2; return st * 1024 + (ob ^ (((ob >> 9) & 1) << 5)); }
__host__ __device__ __forceinline__ void stage_rc(int b, int& R, int& C) { const int st = b / 1024, sb = b % 1024, swz = sb ^ (((sb >> 9) & 1) << 5); R = (st >> 1) * 16 + swz / 64; C = (st & 1) * 32 + (swz % 64) / 2; }
__host__ __device__ __forceinline__ int perm32(int rho) { const int n = rho >> 4, i = rho & 15; return 8 * (i >> 2) + 4 * n + (i & 3); }

struct Unit { int pm, pn; };
struct Gemm { const bf16_t* A; const bf16_t* Bt; int M, N, K; };

struct StaticOrder {
    int nM, nN, nwg, G, c;
    __host__ __device__ void init(int M, int N, int G_, int c_) { nM = M / BM; nN = N / BM; nwg = nM * nN; G = G_; c = c_; }
    __host__ __device__ bool next(int i, Unit& u) const {
        const long L = (long)i * G + c; if (L >= nwg) return false;
        int wgid = (int)L; { const int q = nwg / NXCD, r = nwg % NXCD, xcd = wgid % NXCD, off = wgid / NXCD; wgid = (xcd < r ? xcd * (q + 1) : r * (q + 1) + (xcd - r) * q) + off; }
        const int nig = WGM * nN, gid = wgid / nig, fm = gid * WGM, gsz = (nM - fm) < WGM ? (nM - fm) : WGM;
        u.pm = fm + ((wgid % nig) % gsz); u.pn = (wgid % nig) / gsz; return true;
    }
    __device__ __forceinline__ void a_ready(const Unit&) const {}
    __device__ __forceinline__ void done(const Unit&) const {}
};

__device__ __forceinline__ unsigned cvt_pk_bf16(float lo, float hi) { unsigned r; asm volatile("v_cvt_pk_bf16_f32 %0, %1, %2" : "=v"(r) : "v"(lo), "v"(hi)); return r; }
typedef float f32x2 __attribute__((ext_vector_type(2)));

typedef unsigned u32x4 __attribute__((ext_vector_type(4)));
typedef unsigned u32x2 __attribute__((ext_vector_type(2)));
struct EpiIn {
    static constexpr bool PERM = true, AFTER_DRAIN = false;
    unsigned char* ws; const float *big, *bfg;
#define EPI_ROWS(...) _Pragma("unroll") for (int ai = 0; ai < 2; ++ai) _Pragma("unroll") for (int m = 0; m < 4; ++m) { \
        const int row = u.pm * BM + ai * HALF + wr * 64 + m * 16 + fr; float v[8]; \
        _Pragma("unroll") for (int i = 0; i < 4; ++i) { v[i] = acc[ai][bj][m][0][i]; v[4 + i] = acc[ai][bj][m][1][i]; } \
        asm volatile("" : "+v"(v[0]), "+v"(v[1]), "+v"(v[2]), "+v"(v[3]), "+v"(v[4]), "+v"(v[5]), "+v"(v[6]), "+v"(v[7])); \
        __VA_ARGS__ asm volatile("" ::: "memory"); }
#define EPI_PACK(w) u32x4 w; w.x = cvt_pk_bf16(v[0], v[1]); w.y = cvt_pk_bf16(v[2], v[3]); w.z = cvt_pk_bf16(v[4], v[5]); w.w = cvt_pk_bf16(v[6], v[7]);
    __device__ __forceinline__ void operator()(const f32x4 (&acc)[2][2][4][2], const Unit& u, int wr, int wc, int fr, int fq) const {
        half<0>(acc, u, wr, wc, fr, fq); half<1>(acc, u, wr, wc, fr, fq);
    }
    template <int bj> __device__ __forceinline__ void half(const f32x4 (&acc)[2][2][4][2], const Unit& u, int wr, int wc, int fr, int fq) const {
        {
            const int hb = 2 * u.pn + bj;
            int cb = 32 * wc + 8 * fq; asm volatile("" : "+v"(cb), "+v"(fr));
            if (hb <= 8) {
                bf16_t* nsa = (bf16_t*)(ws + WS_NSA) + hb * 128 + cb;
                const bool rope_hb = (hb <= 3) || hb == 5 || hb == 7;
                if (rope_hb) {
                    const float* cosP = (const float*)(ws + WS_COSP); const float* sinP = (const float*)(ws + WS_SINP);
                    const bool mine = ((wc & 1) == 0) && fq < 2; const float sg = (fq == 0) ? -1.f : 1.f; const float sc = (hb < 3) ? QSCALE : 1.f;
                    f32x4 tc0 = {0.f, 0.f, 0.f, 0.f}, tc1 = tc0, ts0 = tc0, ts1 = tc0;
                    if (mine) { const int r0 = u.pm * BM + wr * 64 + fr; tc0 = *(const f32x4*)(cosP + r0 * 8); tc1 = *(const f32x4*)(cosP + r0 * 8 + 4); ts0 = *(const f32x4*)(sinP + r0 * 8); ts1 = *(const f32x4*)(sinP + r0 * 8 + 4); }
                    EPI_ROWS({
                        float pv[8];
                        _Pragma("unroll") for (int i = 0; i < 8; ++i) pv[i] = sxf<16>(v[i]);
                        const f32x4 c0 = tc0, c1 = tc1, s0 = ts0, s1 = ts1;
                        if (mine && (ai * 4 + m) < 7) { const int nx = ai * 4 + m + 1; const int rn = u.pm * BM + (nx >> 2) * HALF + wr * 64 + (nx & 3) * 16 + fr;
                            tc0 = *(const f32x4*)(cosP + rn * 8); tc1 = *(const f32x4*)(cosP + rn * 8 + 4); ts0 = *(const f32x4*)(sinP + rn * 8); ts1 = *(const f32x4*)(sinP + rn * 8 + 4); }
                        if (mine) {
                            _Pragma("unroll") for (int i = 0; i < 4; ++i) { v[i] = v[i] * c0[i] + sg * pv[i] * s0[i]; v[4 + i] = v[4 + i] * c1[i] + sg * pv[4 + i] * s1[i]; }
                        }
                        _Pragma("unroll") for (int i = 0; i < 8; ++i) v[i] *= sc;
                        EPI_PACK(w) *(u32x4*)(nsa + (size_t)row * 1152) = w;
                    })
                } else {
                    EPI_ROWS({ EPI_PACK(w) *(u32x4*)(nsa + (size_t)row * 1152) = w; })
                }
            } else if (hb <= 11) {
                bf16_t* dst = (hb == 9) ? (bf16_t*)(ws + WS_KVL) + cb : (bf16_t*)(ws + WS_QL) + (hb - 10) * 128 + cb;
                const int ld = (hb == 9) ? 128 : 256;
                float* ssq = (hb == 9) ? (float*)(ws + WS_SSKV) : (float*)(ws + WS_SSQL);
                EPI_ROWS({ EPI_PACK(w) *(u32x4*)(dst + (size_t)row * ld) = w;
                    float sq = 0.f;
                    _Pragma("unroll") for (int i = 0; i < 8; ++i) sq += v[i] * v[i];
                    sq += sxf<16>(sq); sq = red32_sum(sq);
                    if (fq == 0) atomicAdd(ssq + row, sq); })
            } else if (hb <= 17) {
                bf16_t* cm = (bf16_t*)(ws + WS_CM) + (hb - 12) * 128 + cb;
                EPI_ROWS({ EPI_PACK(w) *(u32x4*)(cm + (size_t)row * 768) = w; })
            } else if (hb == 18) {
                float* mr = (float*)(ws + WS_MISCRAW) + cb;
                if (wc < 2) { EPI_ROWS({ *(f32x4*)(mr + (size_t)row * 64) = (f32x4){v[0], v[1], v[2], v[3]}; *(f32x4*)(mr + (size_t)row * 64 + 4) = (f32x4){v[4], v[5], v[6], v[7]}; }) }
            }
        }
    }
#undef EPI_ROWS
#undef EPI_PACK
};
struct EpiUKV {
    static constexpr bool PERM = true, AFTER_DRAIN = false;
    bf16_t* kvm; const float* sskv;
    __device__ __forceinline__ void operator()(const f32x4 (&acc)[2][2][4][2], const Unit& u, int wr, int wc, int fr, int fq) const {
        asm volatile("" : "+v"(fq), "+v"(fr));
        const int col0 = u.pn * BM + wc * 32 + 8 * fq;
        float rs8[8];
#pragma unroll
        for (int i = 0; i < 8; ++i) rs8[i] = sskv[u.pm * BM + (i >> 2) * HALF + wr * 64 + (i & 3) * 16 + fr];
#pragma unroll
        for (int i = 0; i < 8; ++i) rs8[i] = rsqrtf(rs8[i] * (1.f / 128.f) + EPS);
#pragma unroll
        for (int ai = 0; ai < 2; ++ai)
#pragma unroll
            for (int m = 0; m < 4; ++m) { const int row = u.pm * BM + ai * HALF + wr * 64 + m * 16 + fr; bf16_t* rowp = kvm + (size_t)row * 768 + col0;
                const float rs = rs8[ai * 4 + m];
#pragma unroll
                for (int bj = 0; bj < 2; ++bj) { const f32x4 a = acc[ai][bj][m][0] * rs, b = acc[ai][bj][m][1] * rs;
                    u32x4 w; w.x = cvt_pk_bf16(a[0], a[1]); w.y = cvt_pk_bf16(a[2], a[3]); w.z = cvt_pk_bf16(b[0], b[1]); w.w = cvt_pk_bf16(b[2], b[3]);
                    *(u32x4*)(rowp + bj * HALF) = w; } }
    }
};
struct EpiPlain {
    static constexpr bool PERM = true, AFTER_DRAIN = false;
    bf16_t* out; int ld;
    __device__ __forceinline__ void operator()(const f32x4 (&acc)[2][2][4][2], const Unit& u, int wr, int wc, int fr, int fq) const {
        asm volatile("" : "+v"(fq), "+v"(fr));
        const int col0 = u.pn * BM + wc * 32 + 8 * fq;
#pragma unroll
        for (int ai = 0; ai < 2; ++ai)
#pragma unroll
            for (int m = 0; m < 4; ++m) { bf16_t* rowp = out + (size_t)(u.pm * BM + ai * HALF + wr * 64 + m * 16 + fr) * ld + col0;
#pragma unroll
                for (int bj = 0; bj < 2; ++bj) { const f32x4 a = acc[ai][bj][m][0], b = acc[ai][bj][m][1];
                    u32x4 w; w.x = cvt_pk_bf16(a[0], a[1]); w.y = cvt_pk_bf16(a[2], a[3]); w.z = cvt_pk_bf16(b[0], b[1]); w.w = cvt_pk_bf16(b[2], b[3]);
                    *(u32x4*)(rowp + bj * HALF) = w; } }
    }
};
struct EpiRes {
    static constexpr bool PERM = false, AFTER_DRAIN = false;
    const float* xin_f; const bf16_t* xin_b; bf16_t* xout; const float* gate;
    __device__ __forceinline__ void operator()(const f32x4 (&acc)[2][2][4][2], const Unit& u, int wr, int wc, int fr, int fq) const {
        asm volatile("" : "+v"(fq), "+v"(fr));
        const int b = (u.pm * BM) / S_; const int col0 = u.pn * BM + wc * 32 + 4 * fq;
        f32x4 gv[2][2];
#pragma unroll
        for (int bj = 0; bj < 2; ++bj)
#pragma unroll
            for (int n = 0; n < 2; ++n) gv[bj][n] = *(const f32x4*)(gate + (size_t)b * 6144 + col0 + bj * HALF + n * 16);
        if (xin_f != nullptr) {
#pragma unroll
            for (int ai = 0; ai < 2; ++ai)
#pragma unroll
                for (int m = 0; m < 4; ++m) { const size_t off = (size_t)(u.pm * BM + ai * HALF + wr * 64 + m * 16 + fr) * D_ + col0;
#pragma unroll
                    for (int bj = 0; bj < 2; ++bj)
#pragma unroll
                        for (int n = 0; n < 2; ++n) { const f32x4 xi = *(const f32x4*)(xin_f + off + bj * HALF + n * 16); const f32x4 r = xi + gv[bj][n] * acc[ai][bj][m][n];
                            u32x2 w; w.x = cvt_pk_bf16(r[0], r[1]); w.y = cvt_pk_bf16(r[2], r[3]); *(u32x2*)(xout + off + bj * HALF + n * 16) = w; } }
        } else {
#pragma unroll
            for (int ai = 0; ai < 2; ++ai)
#pragma unroll
                for (int m = 0; m < 4; ++m) { const size_t off = (size_t)(u.pm * BM + ai * HALF + wr * 64 + m * 16 + fr) * D_ + col0;
                    u32x2 xr[2][2];
#pragma unroll
                    for (int bj = 0; bj < 2; ++bj)
#pragma unroll
                        for (int n = 0; n < 2; ++n) xr[bj][n] = *(const u32x2*)(xin_b + off + bj * HALF + n * 16);
#pragma unroll
                    for (int bj = 0; bj < 2; ++bj)
#pragma unroll
                        for (int n = 0; n < 2; ++n) { const u32x2 q = xr[bj][n]; const f32x4 a = acc[ai][bj][m][n], g4 = gv[bj][n];
                            const float r0 = __uint_as_float(q.x << 16) + g4[0] * a[0], r1 = __uint_as_float(q.x & 0xffff0000u) + g4[1] * a[1];
                            const float r2 = __uint_as_float(q.y << 16) + g4[2] * a[2], r3 = __uint_as_float(q.y & 0xffff0000u) + g4[3] * a[3];
                            u32x2 w; w.x = cvt_pk_bf16(r0, r1); w.y = cvt_pk_bf16(r2, r3); *(u32x2*)(xout + off + bj * HALF + n * 16) = w; } }
        }
    }
};
struct EpiGU {
    static constexpr bool PERM = true, AFTER_DRAIN = false;
    bf16_t* act;
    __device__ __forceinline__ void operator()(const f32x4 (&acc)[2][2][4][2], const Unit& u, int wr, int wc, int fr, int fq) const {
        asm volatile("" : "+v"(fq), "+v"(fr));
        const int col0 = u.pn * HALF + wc * 32 + 8 * fq;
#pragma unroll
        for (int ai = 0; ai < 2; ++ai)
#pragma unroll
            for (int m = 0; m < 4; ++m) { const int row = u.pm * BM + ai * HALF + wr * 64 + m * 16 + fr; float o[8];
#pragma unroll
                for (int n = 0; n < 2; ++n)
#pragma unroll
                    for (int i = 0; i < 4; ++i) { const float g = acc[ai][0][m][n][i], up = acc[ai][1][m][n][i]; o[4 * n + i] = g / (1.f + __expf(-g)) * up; }
                u32x4 w; w.x = cvt_pk_bf16(o[0], o[1]); w.y = cvt_pk_bf16(o[2], o[3]); w.z = cvt_pk_bf16(o[4], o[5]); w.w = cvt_pk_bf16(o[6], o[7]);
                *(u32x4*)(act + (size_t)row * FF + col0) = w; }
    }
};
template <class Epi, class Sched, bool ALIGN_EPI = false, bool SP2 = false>
__device__ __forceinline__ void gemm_phase(PG8_LAS unsigned char* lds, const Gemm g, const Sched& S, const Epi& E, int wid_in) {
    const int wid = __builtin_amdgcn_readfirstlane(wid_in), lane = fresh_lane(), tid = wid * 64 + lane, wr = wid >> 2, wc = wid & 3;
    const int K = g.K, nt = K / BK;
    unsigned voffA[2], voffB[2];
#pragma unroll
    for (int i = 0; i < 2; ++i) { int R, C; stage_rc(tid * 16 + i * 8192, R, C); const int Rb = Epi::PERM ? ((R & ~31) + perm32(R & 31)) : R;
        voffA[i] = (unsigned)(R * K + C) * 2u; voffB[i] = (unsigned)(Rb * K + C) * 2u; }
    const size_t kstep = (size_t)(BK * 2);
    const size_t hstep = (size_t)HALF * K * 2;
    const size_t tstep = 2 * hstep;
    const unsigned ldsw = (unsigned)wid * 1024u;
    const int aoff = lds_byte(wr * 64 + (lane & 15), (lane >> 4) * 8), boff = lds_byte(wc * 32 + (lane & 15), (lane >> 4) * 8);
#define PG8_SA(b, h) (((b) * 2 + (h)) * HTB)
#define PG8_SB(b, h) ((4 + (b) * 2 + (h)) * HTB)
#define PG8_STAGE(bufoff, gbase, voff) do { _Pragma("unroll") for (int _i = 0; _i < 2; ++_i) \
        __builtin_amdgcn_global_load_lds((const unsigned*)((const char*)(gbase) + (voff)[_i]), (PG8_LAS unsigned*)(lds + (bufoff) + ldsw + _i * 8192), 16, 0, 0); } while (0)
#define PG8_LDA(dst, b, h) do { _Pragma("unroll") for (int m = 0; m < 4; ++m) _Pragma("unroll") for (int k = 0; k < 2; ++k) dst[m][k] = *(const PG8_LAS bf16x8*)(lds + PG8_SA(b, h) + aoff + m * 2048 + k * 1024); } while (0)
#define PG8_LDB(dst, b, h) do { _Pragma("unroll") for (int n = 0; n < 2; ++n) _Pragma("unroll") for (int k = 0; k < 2; ++k) dst[n][k] = *(const PG8_LAS bf16x8*)(lds + PG8_SB(b, h) + boff + n * 2048 + k * 1024); } while (0)
#define PG8_MMA(ai, bj, At, Bt) do { __builtin_amdgcn_s_setprio(1); _Pragma("unroll") for (int m = 0; m < 4; ++m) _Pragma("unroll") for (int n = 0; n < 2; ++n) _Pragma("unroll") for (int k = 0; k < 2; ++k) \
        acc[ai][bj][m][n] = __builtin_amdgcn_mfma_f32_16x16x32_bf16(Bt[n][k], At[m][k], acc[ai][bj][m][n], 0, 0, 0); __builtin_amdgcn_s_setprio(0); } while (0)
#define PG8_WAIT_V(n) asm volatile("s_waitcnt vmcnt(" #n ")" ::: "memory")
#define PG8_WAIT_L(n) asm volatile("s_waitcnt lgkmcnt(" #n ")" ::: "memory")
#define PG8_BAR __builtin_amdgcn_s_barrier()
#define PG8_SCHED __builtin_amdgcn_sched_barrier(0)
    Unit cur, nxt; int ui = 0;
    if (!S.next(0, cur)) return;
    f32x4 acc[2][2][4][2];
#pragma unroll
    for (int a = 0; a < 2; ++a)
#pragma unroll
        for (int b = 0; b < 2; ++b)
#pragma unroll
            for (int m = 0; m < 4; ++m)
#pragma unroll
                for (int n = 0; n < 2; ++n) acc[a][b][m][n] = (f32x4){0.f, 0.f, 0.f, 0.f};
    bf16x8 At[4][2], B0[2][2], B1[2][2];
    const char* cA = (const char*)g.A + (size_t)cur.pm * tstep; const char* cB = (const char*)g.Bt + (size_t)cur.pn * tstep;
    S.a_ready(cur);
    if constexpr (SP2) {
        PG8_STAGE(PG8_SB(0, 0), cB, voffB); PG8_STAGE(PG8_SB(0, 1), cB + hstep, voffB); PG8_STAGE(PG8_SA(0, 0), cA, voffA); PG8_STAGE(PG8_SA(0, 1), cA + hstep, voffA);
        if (wr == 1) PG8_BAR;
        PG8_WAIT_V(2); PG8_BAR;
        PG8_STAGE(PG8_SB(1, 0), cB + kstep, voffB); PG8_STAGE(PG8_SA(1, 0), cA + kstep, voffA); PG8_STAGE(PG8_SB(1, 1), cB + hstep + kstep, voffB);
        PG8_WAIT_V(6); PG8_BAR;
    } else {
        PG8_STAGE(PG8_SB(0, 0), cB, voffB); PG8_STAGE(PG8_SA(0, 0), cA, voffA); PG8_STAGE(PG8_SB(0, 1), cB + hstep, voffB); PG8_STAGE(PG8_SA(0, 1), cA + hstep, voffA);
        if (wr == 1) PG8_BAR;
        PG8_WAIT_V(4); PG8_BAR;
        PG8_STAGE(PG8_SB(1, 0), cB + kstep, voffB); PG8_STAGE(PG8_SA(1, 0), cA + kstep, voffA); PG8_STAGE(PG8_SB(1, 1), cB + hstep + kstep, voffB);
        PG8_WAIT_V(6); PG8_BAR;
    }
    for (;;) {
        const bool has_next = S.next(ui + 1, nxt);
        const char* nA = has_next ? (const char*)g.A + (size_t)nxt.pm * tstep : cA; const char* nB = has_next ? (const char*)g.Bt + (size_t)nxt.pn * tstep : cB;
        for (int t = 0; t < nt; t += 2) {
            const bool last = (t == nt - 2);
            const char* a1 = cA + (size_t)(t + 1) * kstep;
            const char* a2 = last ? nA : cA + (size_t)(t + 2) * kstep; const char* b2 = last ? nB : cB + (size_t)(t + 2) * kstep;
            const char* a3 = a2 + kstep; const char* b3 = b2 + kstep;
            if (last && has_next) S.a_ready(nxt);
            if constexpr (SP2) {
            PG8_LDB(B0, 0, 0); PG8_LDB(B1, 0, 1); PG8_SCHED; PG8_LDA(At, 0, 0); PG8_STAGE(PG8_SA(1, 1), a1 + hstep, voffA);
            PG8_WAIT_V(8); PG8_WAIT_L(0); PG8_BAR; PG8_MMA(0, 0, At, B0); PG8_MMA(0, 1, At, B1); PG8_BAR; PG8_SCHED;
            PG8_LDA(At, 0, 1); PG8_STAGE(PG8_SB(0, 0), b2, voffB); PG8_STAGE(PG8_SB(0, 1), b2 + hstep, voffB); PG8_STAGE(PG8_SA(0, 0), a2, voffA);
            PG8_WAIT_V(8); PG8_WAIT_L(0); PG8_BAR; PG8_MMA(1, 0, At, B0); PG8_MMA(1, 1, At, B1); PG8_BAR; PG8_SCHED;
            PG8_LDB(B0, 1, 0); PG8_LDB(B1, 1, 1); PG8_SCHED; PG8_LDA(At, 1, 0); PG8_STAGE(PG8_SA(0, 1), a2 + hstep, voffA);
            PG8_WAIT_V(8); PG8_WAIT_L(0); PG8_BAR; PG8_MMA(0, 0, At, B0); PG8_MMA(0, 1, At, B1); PG8_BAR; PG8_SCHED;
            PG8_LDA(At, 1, 1); PG8_STAGE(PG8_SB(1, 0), b3, voffB); PG8_STAGE(PG8_SB(1, 1), b3 + hstep, voffB); PG8_STAGE(PG8_SA(1, 0), a3, voffA);
            PG8_WAIT_V(8); PG8_WAIT_L(0); PG8_BAR; PG8_MMA(1, 0, At, B0); PG8_MMA(1, 1, At, B1); PG8_BAR; PG8_SCHED;
            } else {
            PG8_LDB(B0, 0, 0); PG8_SCHED; PG8_LDA(At, 0, 0); PG8_STAGE(PG8_SA(1, 1), a1 + hstep, voffA);
            PG8_WAIT_L(8); PG8_BAR; PG8_WAIT_L(0); PG8_MMA(0, 0, At, B0); PG8_BAR; PG8_SCHED;
            PG8_LDB(B1, 0, 1); PG8_STAGE(PG8_SB(0, 0), b2, voffB);
            PG8_BAR; PG8_WAIT_L(0); PG8_MMA(0, 1, At, B1); PG8_BAR;
            PG8_LDA(At, 0, 1); PG8_STAGE(PG8_SA(0, 0), a2, voffA);
            PG8_BAR; PG8_WAIT_L(0); PG8_MMA(1, 0, At, B0); PG8_BAR; PG8_SCHED;
            PG8_STAGE(PG8_SB(0, 1), b2 + hstep, voffB);
            PG8_WAIT_V(6); PG8_BAR; PG8_MMA(1, 1, At, B1); PG8_BAR;
            PG8_LDB(B0, 1, 0); PG8_SCHED; PG8_LDA(At, 1, 0); PG8_STAGE(PG8_SA(0, 1), a2 + hstep, voffA);
            PG8_WAIT_L(8); PG8_BAR; PG8_WAIT_L(0); PG8_MMA(0, 0, At, B0); PG8_BAR; PG8_SCHED;
            PG8_LDB(B1, 1, 1); PG8_STAGE(PG8_SB(1, 0), b3, voffB);
            PG8_BAR; PG8_WAIT_L(0); PG8_MMA(0, 1, At, B1); PG8_BAR;
            PG8_LDA(At, 1, 1); PG8_STAGE(PG8_SA(1, 0), a3, voffA);
            PG8_BAR; PG8_WAIT_L(0); PG8_MMA(1, 0, At, B0); PG8_BAR; PG8_SCHED;
            PG8_STAGE(PG8_SB(1, 1), b3 + hstep, voffB);
            PG8_WAIT_V(6); PG8_BAR; PG8_MMA(1, 1, At, B1); PG8_BAR;
            }
        }
        if constexpr (ALIGN_EPI) { if (wr == 0) PG8_BAR; }
        if constexpr (!Epi::AFTER_DRAIN) { const int ln = fresh_lane(); E(acc, cur, wr, wc, ln & 15, ln >> 4); S.done(cur); }
        if (!has_next) break;
#pragma unroll
        for (int a = 0; a < 2; ++a)
#pragma unroll
            for (int b = 0; b < 2; ++b)
#pragma unroll
                for (int m = 0; m < 4; ++m)
#pragma unroll
                    for (int n = 0; n < 2; ++n) acc[a][b][m][n] = (f32x4){0.f, 0.f, 0.f, 0.f};
        cur = nxt; cA = nA; cB = nB; ++ui;
        if constexpr (ALIGN_EPI) { if (wr == 1) PG8_BAR; }
    }
    PG8_WAIT_V(0);
    if constexpr (!ALIGN_EPI) { if (wr == 0) PG8_BAR; }
    PG8_BAR;
    if constexpr (Epi::AFTER_DRAIN) { const int ln = fresh_lane(); E.fused(acc, cur, wr, wc, ln & 15, ln >> 4, lds, wid, ln); S.done(cur); }
#undef PG8_SA
#undef PG8_SB
#undef PG8_STAGE
#undef PG8_LDA
#undef PG8_LDB
#undef PG8_MMA
#undef PG8_WAIT_V
#undef PG8_WAIT_L
#undef PG8_BAR
#undef PG8_SCHED
}
}

#define GAS __attribute__((address_space(1)))
#define LAS __attribute__((address_space(3)))
typedef float f32x4 __attribute__((ext_vector_type(4)));
typedef unsigned v4u __attribute__((ext_vector_type(4)));
typedef GAS unsigned gu32;
#define XB_TMO      128
#define XB_XCNT(j)  (256  + 64 * (j))
#define XB_XSUB(j)  (1280 + 64 * (j))
#define XB_XGEN(j)  (2304 + 64 * (j))
#define XB_TOP      3328
#define XB_TOPGEN   3392
#define XCD_BAR_WORDS 3456
#define XB_SPIN_CAP (1u << 18)

__device__ __forceinline__ unsigned xb_ld(unsigned* p)              { return __hip_atomic_load(p, __ATOMIC_RELAXED, __HIP_MEMORY_SCOPE_AGENT); }
__device__ __forceinline__ unsigned xb_add(unsigned* p, unsigned v) { return __hip_atomic_fetch_add(p, v, __ATOMIC_RELAXED, __HIP_MEMORY_SCOPE_AGENT); }
__device__ __forceinline__ unsigned xb_xcc_id() { return (unsigned)__builtin_amdgcn_s_getreg((3 << 11) | 20) & 0xFu; }
#define XB_SPIN(cond, bar) do { unsigned _sp = 0; while (cond) { __builtin_amdgcn_s_sleep(1); \
    if ((++_sp & 255u) == 0u) { if (xb_ld(&(bar)[XB_TMO])) break; if (_sp > XB_SPIN_CAP) { atomicAdd(&(bar)[XB_TMO], 1u); break; } } } } while (0)

struct XcdBarrier {
    unsigned* bar; unsigned x;
    volatile LAS unsigned* st;
};

__device__ __forceinline__ XcdBarrier xcd_barrier_post(unsigned* bar, volatile LAS unsigned* st, int tid) {
    XcdBarrier b; b.bar = bar; b.x = xb_xcc_id(); b.st = st;
    if (tid == 0) (void)xb_add(&bar[XB_XCNT(b.x)], 1u);
    return b;
}
__device__ __forceinline__ void xcd_barrier_complete(unsigned* bar, unsigned x, unsigned& nloc, unsigned& nx) {
    const unsigned G = gridDim.x * gridDim.y * gridDim.z;
    unsigned sum, cnt, mine, sp = 0u;
    for (;;) {
        sum = 0u; cnt = 0u; mine = 0u;
#pragma unroll
        for (unsigned j = 0; j < 16; ++j) { const unsigned c = xb_ld(&bar[XB_XCNT(j)]); sum += c; cnt += (c > 0u) ? 1u : 0u; mine = (j == x) ? c : mine; }
        if (sum == G) break;
        __builtin_amdgcn_s_sleep(1);
        if ((++sp & 255u) == 0u) { if (xb_ld(&bar[XB_TMO])) break; if (sp > XB_SPIN_CAP) { atomicAdd(&bar[XB_TMO], 1u); break; } }
    }
    nloc = mine > 0u ? mine : 1u; nx = cnt > 0u ? cnt : 1u;
}

__device__ __forceinline__ void xcd_barrier(const XcdBarrier& b, int tid) {
    asm volatile("s_waitcnt vmcnt(0)" ::: "memory");
    __syncthreads();
    if (tid == 0) {
        unsigned* bar = b.bar;
        __builtin_amdgcn_s_waitcnt(0);
        unsigned nloc = b.st[0], nx = b.st[1];
        if (nloc == 0u) { xcd_barrier_complete(bar, b.x, nloc, nx); b.st[0] = nloc; b.st[1] = nx; }
        const unsigned old = xb_add(&bar[XB_XSUB(b.x)], 1u);
        const unsigned gen = old / nloc;
        if (old + 1u == (gen + 1u) * nloc) {
            __builtin_amdgcn_fence(__ATOMIC_RELEASE, "agent");
            asm volatile("s_waitcnt vmcnt(0)" ::: "memory");
            const unsigned og = xb_add(&bar[XB_TOP], 1u);
            const unsigned tg = og / nx;
            if (og + 1u == (tg + 1u) * nx) xb_add(&bar[XB_TOPGEN], 1u);
            else XB_SPIN(xb_ld(&bar[XB_TOPGEN]) == tg, bar);
            __builtin_amdgcn_fence(__ATOMIC_ACQUIRE, "agent");
            xb_add(&bar[XB_XGEN(b.x)], 1u);
            asm volatile("s_waitcnt vmcnt(0)" ::: "memory");
        } else {
            XB_SPIN(xb_ld(&bar[XB_XGEN(b.x)]) == gen, bar);
            __builtin_amdgcn_fence(__ATOMIC_ACQUIRE, "agent");
            asm volatile("s_waitcnt vmcnt(0)" ::: "memory");
        }
    }
    __syncthreads();
}

constexpr int NTHR = 512, NWAVES = 8;
constexpr int RING_BYTES = 131072, MISC_OFF = RING_BYTES + 320, LDS_BYTES = 147456;
constexpr int CW_BAR = 4096;
constexpr size_t CTL_ZERO_BYTES = 64 * 1024;
constexpr size_t WT_IN = WS_WT, WT_OUT = WT_IN + (size_t)2560 * 1024 * 2, WT_GU = WT_OUT + (size_t)1024 * 1024 * 2, WT_DOWN = WT_GU + (size_t)5632 * 1024 * 2,
                 WT_UQ = WT_DOWN + (size_t)1024 * 2816 * 2, WT_UKV = WT_UQ + (size_t)768 * 256 * 2, WT_CK = WT_UKV + (size_t)768 * 128 * 2, WT_CV = WT_CK + (size_t)64 * 2048 * 2,
                 WT_QM = WT_CV + (size_t)64 * 2048 * 2, WT_KM = WT_QM + 4 * 64 * 64 * 2, WT_END = WT_KM + 4 * 64 * 64 * 2;
static_assert(WT_END <= WS_HB, "weights");
constexpr int NPH = 22, PPL = 10;
constexpr int PROBE_SEL = 0;
constexpr int REP_MASK = 0;
#ifndef PHM
#define PHM 0xffff
#endif
struct MP { const float* in[N_IN]; float* out; unsigned char* ws; int ph_lo, ph_hi, coop, pad; };

struct MPK {
    const __attribute__((address_space(4))) MP* k;
    struct InArr { const __attribute__((address_space(4))) MP* k; __device__ __forceinline__ const float* operator[](int i) const { return k->in[i]; } };
    __device__ __forceinline__ InArr in_() const { return InArr{k}; }
};
#define PIN(i) (p.k->in[i])
__device__ __forceinline__ unsigned pk2(float lo, float hi) { return (unsigned)f2bf(lo) | ((unsigned)f2bf(hi) << 16); }
struct MapId { int n; __device__ __forceinline__ int operator()(int c) const { return c < n ? c : -1; } };
struct MapIn { __device__ __forceinline__ int operator()(int c) const {
    if (c < 1152) return c; if (c < 1280) return 1426 + (c - 1152); if (c < 1536) return 1170 + (c - 1280); if (c < 2304) return 1586 + (c - 1536);
    if (c < 2336) return 1554 + (c - 2304); if (c < 2354) return 1152 + (c - 2336); if (c < 2362) return c; return -1; } };
struct MapGU { __device__ __forceinline__ int operator()(int c) const { const int t = c >> 8, w = c & 255; return (w < 128) ? t * 128 + w : FF + t * 128 + (w - 128); } };
template <class Map> __device__ __forceinline__ void transpose_item(const float* W, int K, int ldw, const Map& map, const float* kscale, bf16* WT, LAS float* scr, int item, int nblk, int lane) {
    const int kb = item / nblk, nb = item % nblk, k0 = 64 * kb, n0 = 32 * nb;
    const int np = 2 * (lane & 15);
    const int sc = map(n0 + np);
    float2 tv[16];
#pragma unroll
    for (int i = 0; i < 16; ++i) { const int kk = 4 * i + (lane >> 4); tv[i] = (sc >= 0) ? *(const float2*)(W + (size_t)(k0 + kk) * ldw + sc) : make_float2(0.f, 0.f); }
    asm volatile("" : "+v"(tv[0]), "+v"(tv[1]), "+v"(tv[2]), "+v"(tv[3]), "+v"(tv[4]), "+v"(tv[5]), "+v"(tv[6]), "+v"(tv[7]));
    asm volatile("" : "+v"(tv[8]), "+v"(tv[9]), "+v"(tv[10]), "+v"(tv[11]), "+v"(tv[12]), "+v"(tv[13]), "+v"(tv[14]), "+v"(tv[15]));
#pragma unroll
    for (int i = 0; i < 16; ++i) { const int kk = 4 * i + (lane >> 4); float2 v = tv[i];
        if (kscale) { const float ksc = kscale[k0 + kk]; v.x *= ksc; v.y *= ksc; } scr[kk * 33 + np] = v.x; scr[kk * 33 + np + 1] = v.y; }
    asm volatile("s_waitcnt lgkmcnt(0)" ::: "memory");
    const int c = lane & 7;
#pragma unroll
    for (int j = 0; j < 4; ++j) { const int n = (lane >> 3) + 8 * j; const LAS float* s = scr + (8 * c) * 33 + n;
        v4u o; o.x = pk2(s[0 * 33], s[1 * 33]); o.y = pk2(s[2 * 33], s[3 * 33]); o.z = pk2(s[4 * 33], s[5 * 33]); o.w = pk2(s[6 * 33], s[7 * 33]);
        *(v4u*)(WT + (size_t)(n0 + n) * K + k0 + 8 * c) = o; }
    asm volatile("s_waitcnt lgkmcnt(0)" ::: "memory");
}
typedef unsigned u2raw __attribute__((ext_vector_type(2)));
__device__ __forceinline__ float4 unpk4(uint2 q) { return make_float4(__uint_as_float(q.x << 16), __uint_as_float(q.x & 0xffff0000u), __uint_as_float(q.y << 16), __uint_as_float(q.y & 0xffff0000u)); }
template <bool XBF, bool FIN = false> __device__ __forceinline__ void norm_rows(const void* xv, const float* g, const float* shift, const float* scale, bf16* hb, float* outf, int gw, int ngw, int lane) {
    const int rpw = T_ / ngw, m0 = gw * rpw, b = m0 / S_;
    float4 gs[4], sh[4];
#pragma unroll
    for (int j = 0; j < 4; ++j) { const int col = 4 * lane + 256 * j; gs[j] = *(const float4*)(g + col);
        if constexpr (!FIN) { const float4 sc = *(const float4*)(scale + (size_t)b * 6144 + col); sh[j] = *(const float4*)(shift + (size_t)b * 6144 + col);
            gs[j].x *= 1.f + sc.x; gs[j].y *= 1.f + sc.y; gs[j].z *= 1.f + sc.z; gs[j].w *= 1.f + sc.w; }
        else sh[j] = make_float4(0.f, 0.f, 0.f, 0.f); }
    typedef typename std::conditional<XBF, uint2, float4>::type raw_t;
    const raw_t* x = (const raw_t*)xv;
    raw_t nv[4], nw[4];
    { const raw_t* xr = x + (size_t)m0 * (D_ / 4) + lane;
#pragma unroll
      for (int j = 0; j < 4; ++j) { nv[j] = xr[64 * j]; nw[j] = xr[D_ / 4 + 64 * j]; } }
    for (int r = 0; r < rpw; r += 2) {
        const int m = m0 + r;
        float4 v[4], w[4]; float s = 0.f, s2 = 0.f;
#pragma unroll
        for (int j = 0; j < 4; ++j) { if constexpr (XBF) { v[j] = unpk4(nv[j]); w[j] = unpk4(nw[j]); } else { v[j] = nv[j]; w[j] = nw[j]; } }
        if (r + 2 < rpw) { const raw_t* xr = x + (size_t)(m + 2) * (D_ / 4) + lane;
#pragma unroll
            for (int j = 0; j < 4; ++j) { nv[j] = xr[64 * j]; nw[j] = xr[D_ / 4 + 64 * j]; } }
#pragma unroll
        for (int j = 0; j < 4; ++j) { s += v[j].x * v[j].x + v[j].y * v[j].y + v[j].z * v[j].z + v[j].w * v[j].w; s2 += w[j].x * w[j].x + w[j].y * w[j].y + w[j].z * w[j].z + w[j].w * w[j].w; }
        const float r1 = rsqrtf(wave_sum2(s) * (1.f / D_) + EPS), r2 = rsqrtf(wave_sum2(s2) * (1.f / D_) + EPS);
#pragma unroll
        for (int j = 0; j < 4; ++j) {
            const int col = 4 * lane + 256 * j;
            float4 o, o2;
            o.x = v[j].x * r1 * gs[j].x + sh[j].x; o.y = v[j].y * r1 * gs[j].y + sh[j].y; o.z = v[j].z * r1 * gs[j].z + sh[j].z; o.w = v[j].w * r1 * gs[j].w + sh[j].w;
            o2.x = w[j].x * r2 * gs[j].x + sh[j].x; o2.y = w[j].y * r2 * gs[j].y + sh[j].y; o2.z = w[j].z * r2 * gs[j].z + sh[j].z; o2.w = w[j].w * r2 * gs[j].w + sh[j].w;
            if constexpr (FIN) { *(float4*)(outf + (size_t)m * D_ + col) = o; *(float4*)(outf + (size_t)(m + 1) * D_ + col) = o2; }
            else { uint2 q; q.x = pk2(o.x, o.y); q.y = pk2(o.z, o.w); *(uint2*)(hb + (size_t)m * D_ + col) = q;
                   uint2 q2; q2.x = pk2(o2.x, o2.y); q2.y = pk2(o2.z, o2.w); *(uint2*)(hb + (size_t)(m + 1) * D_ + col) = q2; }
        }
    }
}
__device__ __forceinline__ void ph_p0(const MPK& p, LAS unsigned char* lds, int tid) {
    const int wave = tid >> 6, lane = tid & 63;
    LAS float* ca = (LAS float*)lds; LAS float* red = ca + 8192;
    unsigned char* ws = p.k->ws; float* mod = (float*)(ws + WS_MOD);
    const float* c = PIN(I_C);
    for (int i = tid; i < 8192; i += NTHR) ca[i] = siluf_(c[i]);
    __syncthreads();
    for (int item = blockIdx.x; item < 192; item += gridDim.x) {
        const int l = item / 96, j = (item % 96) * 64 + lane;
        const float* w = PIN(I_WADA) + (size_t)l * 1024 * 6144 + j + (size_t)(wave * 128) * 6144;
        float acc[8];
#pragma unroll
        for (int b = 0; b < 8; ++b) acc[b] = 0.f;
        float wn[16];
#pragma unroll
        for (int i = 0; i < 16; ++i) wn[i] = w[(size_t)i * 6144];
        for (int k0 = 0; k0 < 128; k0 += 16) {
            float wv[16];
            asm volatile("" : "+v"(wn[0]), "+v"(wn[1]), "+v"(wn[2]), "+v"(wn[3]), "+v"(wn[4]), "+v"(wn[5]), "+v"(wn[6]), "+v"(wn[7]),
                              "+v"(wn[8]), "+v"(wn[9]), "+v"(wn[10]), "+v"(wn[11]), "+v"(wn[12]), "+v"(wn[13]), "+v"(wn[14]), "+v"(wn[15]));
#pragma unroll
            for (int i = 0; i < 16; ++i) wv[i] = wn[i];
            if (k0 + 16 < 128) {
#pragma unroll
                for (int i = 0; i < 16; ++i) wn[i] = w[(size_t)(k0 + 16 + i) * 6144];
            }
#pragma unroll
            for (int i4 = 0; i4 < 4; ++i4)
#pragma unroll
                for (int b = 0; b < 8; ++b) { const f32x4 c4 = *(LAS const f32x4*)(ca + b * 1024 + wave * 128 + k0 + 4 * i4);
                    acc[b] += (c4[0] * wv[4 * i4] + c4[1] * wv[4 * i4 + 1]) + (c4[2] * wv[4 * i4 + 2] + c4[3] * wv[4 * i4 + 3]); }
        }
#pragma unroll
        for (int b = 0; b < 8; ++b) red[(wave * 8 + b) * 64 + lane] = acc[b];
        __syncthreads();
        { const int b = wave; float s2 = 0.f;
#pragma unroll
          for (int w8 = 0; w8 < 8; ++w8) s2 += red[(w8 * 8 + b) * 64 + lane];
          mod[((size_t)l * 8 + b) * 6144 + (item % 96) * 64 + lane] = s2 + PIN(I_BADA)[l * 6144 + (item % 96) * 64 + lane]; }
        __syncthreads();
    }
    const int* pos = (const int*)PIN(I_POS);
    float *cosP = (float*)(ws + WS_COSP), *sinP = (float*)(ws + WS_SINP), *cosM = (float*)(ws + WS_COSM), *sinM = (float*)(ws + WS_SINM);
    for (int i = blockIdx.x * NTHR + tid; i < T_ * 24; i += gridDim.x * NTHR) {
        const int m = i / 24, f = i % 24;
        double inv; if (f < 8) inv = pow(500000.0, -(double)(2 * f) / 16.0); else inv = pow(500000.0, -(double)(2 * (f - 8)) / 32.0);
        const float ang = (float)pos[m] * (float)inv;
        const double a = (double)ang, kq = rint(a * 0.15915494309189535), r = a - kq * 6.283185307179586476925;
        const float cs = (float)cos(r), sn = (float)sin(r);
        if (f < 8) { cosP[m * 8 + f] = cs; sinP[m * 8 + f] = sn; } else { cosM[m * 16 + f - 8] = cs; sinM[m * 16 + f - 8] = sn; }
    }
}
__device__ __forceinline__ void early_transposes(const MPK& p, int l, LAS unsigned char* lds, int tid, int first) {
    const int wave = tid >> 6, lane = tid & 63;
    if ((int)blockIdx.x < first) return;
    const int gw = ((int)blockIdx.x - first) * NWAVES + wave, ngw = ((int)gridDim.x - first) * NWAVES;
    unsigned char* ws = p.k->ws;
    LAS float* scr = (LAS float*)(lds + wave * 8704);
    constexpr int I0 = 16 * 80, I4 = 4 * 24, I5 = 2 * 24, I6 = 32 * 2, I7 = 32 * 2, I8 = 8, I9 = 8;
    constexpr int NIT = I0 + I4 + I5 + I6 + I7 + I8 + I9;
    for (int it = gw; it < NIT; it += ngw) {
        int r = it;
        if (r < I0) { transpose_item(PIN(I_WIN) + (size_t)l * D_ * DIN, D_, DIN, MapIn{}, nullptr, (bf16*)(ws + WT_IN), scr, r, 80, lane); continue; } r -= I0;
        if (r < I4) { transpose_item(PIN(I_WUQ) + (size_t)l * 256 * 576, 256, 576, MapId{576}, PIN(I_GQL) + l * 256, (bf16*)(ws + WT_UQ), scr, r, 24, lane); continue; } r -= I4;
        if (r < I5) { transpose_item(PIN(I_WUKV) + (size_t)l * 128 * 768, 128, 768, MapId{768}, PIN(I_GKVL) + l * 128, (bf16*)(ws + WT_UKV), scr, r, 24, lane); continue; } r -= I5;
        if (r < I6) { transpose_item(PIN(I_WCK) + (size_t)l * 2048 * 64, 2048, 64, MapId{64}, nullptr, (bf16*)(ws + WT_CK), scr, r, 2, lane); continue; } r -= I6;
        if (r < I7) { transpose_item(PIN(I_WCV) + (size_t)l * 2048 * 64, 2048, 64, MapId{64}, nullptr, (bf16*)(ws + WT_CV), scr, r, 2, lane); continue; } r -= I7;
        if (r < I8) { const int h = r >> 1; transpose_item(PIN(I_WQM) + (size_t)l * 16384 + h * 4096, 64, 64, MapId{64}, nullptr, (bf16*)(ws + WT_QM) + h * 4096, scr, r & 1, 2, lane); continue; } r -= I8;
        { const int h = r >> 1; transpose_item(PIN(I_WKM) + (size_t)l * 16384 + h * 4096, 64, 64, MapId{64}, nullptr, (bf16*)(ws + WT_KM) + h * 4096, scr, r & 1, 2, lane); }
    }
}
__device__ __forceinline__ void ph_prep(const MPK& p, int l, LAS unsigned char* lds, int tid) {
    const int wave = tid >> 6, lane = tid & 63;
    const int gw = blockIdx.x * NWAVES + wave, ngw = gridDim.x * NWAVES;
    unsigned char* ws = p.k->ws;
    LAS float* scr = (LAS float*)(lds + wave * 8704);
    for (int i = blockIdx.x * NTHR + tid; i < 2 * T_; i += gridDim.x * NTHR) ((float*)(ws + WS_SSQL))[i] = 0.f;
    if (l == 0) early_transposes(p, l, lds, tid, 0);
    const float* modl = (const float*)(ws + WS_MOD) + (size_t)l * 8 * 6144;
    if (l == 0) norm_rows<false>(PIN(I_X), PIN(I_GN1) + l * D_, modl + 0, modl + 1024, (bf16*)(ws + WS_HB), nullptr, gw, ngw, lane);
    else norm_rows<true>(p.k->out, PIN(I_GN1) + l * D_, modl + 0, modl + 1024, (bf16*)(ws + WS_HB), nullptr, gw, ngw, lane);
}
__device__ __forceinline__ void late_transposes(const MPK& p, int l, LAS unsigned char* lds, int tid, int first) {
    const int wave = tid >> 6, lane = tid & 63;
    if ((int)blockIdx.x < first) return;
    const int gw = ((int)blockIdx.x - first) * NWAVES + wave, ngw = ((int)gridDim.x - first) * NWAVES;
    unsigned char* ws = p.k->ws;
    LAS float* scr = (LAS float*)(lds + wave * 8704);
    constexpr int I1 = 16 * 32, I2 = 16 * 176, I3 = 44 * 32;
    for (int it = gw; it < I1 + I2 + I3; it += ngw) {
        int r = it;
        if (r < I1) { transpose_item(PIN(I_WOUT) + (size_t)l * D_ * D_, D_, D_, MapId{D_}, nullptr, (bf16*)(ws + WT_OUT), scr, r, 32, lane); continue; } r -= I1;
        if (r < I2) { transpose_item(PIN(I_WGU) + (size_t)l * D_ * 2 * FF, D_, 2 * FF, MapGU{}, nullptr, (bf16*)(ws + WT_GU), scr, r, 176, lane); continue; } r -= I2;
        transpose_item(PIN(I_WDOWN) + (size_t)l * FF * D_, FF, D_, MapId{D_}, nullptr, (bf16*)(ws + WT_DOWN), scr, r, 32, lane);
    }
}
__device__ __forceinline__ void ph_mixnorm(const MPK& p, int l, int tid) {
    const int gw = blockIdx.x * NWAVES + (tid >> 6), ngw = gridDim.x * NWAVES, lane = tid & 63;
    unsigned char* ws = p.k->ws;
    bf16* mix = (bf16*)(ws + WS_HB); const float* ga = PIN(I_GOA) + l * 384; const float* gb = PIN(I_GOB) + l * 384;
    const bf16 *oc = (const bf16*)(ws + WS_OCMP), *os = (const bf16*)(ws + WS_OSLC), *ow = (const bf16*)(ws + WS_OWIN); const float* gm = (const float*)(ws + WS_GM);
#define UNPK8(dst, src) dst[0] = __uint_as_float(src.x << 16); dst[1] = __uint_as_float(src.x & 0xffff0000u); dst[2] = __uint_as_float(src.y << 16); dst[3] = __uint_as_float(src.y & 0xffff0000u); \
    dst[4] = __uint_as_float(src.z << 16); dst[5] = __uint_as_float(src.z & 0xffff0000u); dst[6] = __uint_as_float(src.w << 16); dst[7] = __uint_as_float(src.w & 0xffff0000u);
    const int rpw = T_ / ngw;
    const float* ggp = (lane < 48) ? ga + lane * 8 : gb + (lane - 48) * 8; const float4 gA0 = *(const float4*)ggp, gA1 = *(const float4*)(ggp + 4);
    const float* ggq = gb + (16 + (lane & 31)) * 8; const float4 gB0 = *(const float4*)ggq, gB1 = *(const float4*)(ggq + 4);
    v4u ra4, rb4, rc4, ry4; float rg0, rg1, rg2;
#define MIX_LOAD(m_) do { const bf16* r_ = mix + (size_t)(m_) * D_; \
        if (lane < 48) { const size_t o_ = (size_t)(m_) * 384 + lane * 8; const float* g3_ = gm + (size_t)(m_) * 32 + 3 * (lane >> 3); rg0 = g3_[0]; rg1 = g3_[1]; rg2 = g3_[2]; \
            ra4 = *(const v4u*)(oc + o_); rb4 = *(const v4u*)(os + o_); rc4 = *(const v4u*)(ow + o_); } \
        else { ra4 = *(const v4u*)(r_ + 384 + (lane - 48) * 8); rb4 = ra4; rc4 = ra4; rg0 = 0.f; rg1 = 0.f; rg2 = 0.f; } \
        if (lane < 32) ry4 = *(const v4u*)(r_ + 384 + (16 + lane) * 8); else ry4 = ra4; } while (0)
    const int mend = gw * rpw + rpw;
    MIX_LOAD(gw * rpw);
    for (int m = gw * rpw; m < mend; ++m) {
        bf16* r = mix + (size_t)m * D_;
        const v4u ca4 = ra4, cb4 = rb4, cc4 = rc4, cy4 = ry4; const float g0 = rg0, g1 = rg1, g2 = rg2;
        if (m + 1 < mend) MIX_LOAD(m + 1);
        float v0[8], v1[8]; float sa = 0.f, sb = 0.f;
        if (lane < 48) {
            float c8[8], s8[8], w8[8]; UNPK8(c8, ca4) UNPK8(s8, cb4) UNPK8(w8, cc4)
#pragma unroll
            for (int i = 0; i < 8; ++i) { v0[i] = g0 * c8[i] + g1 * s8[i] + g2 * w8[i]; sa += v0[i] * v0[i]; }
        } else {
            UNPK8(v0, ca4)
#pragma unroll
            for (int i = 0; i < 8; ++i) sb += v0[i] * v0[i];
        }
        if (lane < 32) { UNPK8(v1, cy4)
#pragma unroll
            for (int i = 0; i < 8; ++i) sb += v1[i] * v1[i]; }
        const float ra = rsqrtf(wave_sum2(sa) * (1.f / 384.f) + EPS), rb = rsqrtf(wave_sum2(sb) * (1.f / 384.f) + EPS);
        {
            const int col = (lane < 48) ? lane * 8 : 384 + (lane - 48) * 8; const float rr = (lane < 48) ? ra : rb;
            const float4 q0 = gA0, q1 = gA1;
            v4u w; w.x = pk2(v0[0] * rr * q0.x, v0[1] * rr * q0.y); w.y = pk2(v0[2] * rr * q0.z, v0[3] * rr * q0.w); w.z = pk2(v0[4] * rr * q1.x, v0[5] * rr * q1.y); w.w = pk2(v0[6] * rr * q1.z, v0[7] * rr * q1.w);
            *(v4u*)(r + col) = w;
        }
        if (lane < 32) { const float4 q0 = gB0, q1 = gB1;
            v4u w; w.x = pk2(v1[0] * rb * q0.x, v1[1] * rb * q0.y); w.y = pk2(v1[2] * rb * q0.z, v1[3] * rb * q0.w); w.z = pk2(v1[4] * rb * q1.x, v1[5] * rb * q1.y); w.w = pk2(v1[6] * rb * q1.z, v1[7] * rb * q1.w);
            *(v4u*)(r + 384 + (16 + lane) * 8) = w; }
    }
#undef MIX_LOAD
#undef UNPK8
}


typedef short bf16x8 __attribute__((ext_vector_type(8)));
typedef short s16x4 __attribute__((ext_vector_type(4)));
typedef float f32x16 __attribute__((ext_vector_type(16)));
typedef unsigned u32x2v __attribute__((ext_vector_type(2)));
constexpr int AT_BUF = 20480, AT_K32 = 8192, AT_V = 12288;
__device__ __forceinline__ unsigned cvtpk(float lo, float hi) { unsigned r; asm volatile("v_cvt_pk_bf16_f32 %0, %1, %2" : "=v"(r) : "v"(lo), "v"(hi)); return r; }
__device__ __forceinline__ float max3f(float a, float b, float c) { float r; asm("v_max3_f32 %0, %1, %2, %3" : "=v"(r) : "v"(a), "v"(b), "v"(c)); return r; }
__device__ __forceinline__ int crow(int r, int hi) { return (r & 3) + 8 * (r >> 2) + 4 * hi; }
__device__ __forceinline__ s16x4 vtr(LAS const unsigned char* p) { return __builtin_bit_cast(s16x4, __builtin_amdgcn_ds_read_tr16_b64_v4i16((LAS s16x4*)p)); }
enum { AM_CAUSAL = 0, AM_WINDOW = 1, AM_SLC = 2 };
struct AttnState { float m, l; f32x16 o[2]; f32x16 negm; bool started; long long twait; };
template <int NC> struct TileRegs { v4u k; v4u k2; v4u v; };
template <int NC> __device__ __forceinline__ void at_load(TileRegs<NC>& r, const bf16* Kg, int ldk, const bf16* Vg, int ldv, const bf16* K2g, int ldk2, int tile, int tid) {
    const int key = tid >> 3, c = tid & 7;
    r.k = *(const v4u*)(Kg + (size_t)(tile * 64 + key) * ldk + 8 * c);
    r.v = *(const v4u*)(Vg + (size_t)(tile * 64 + key) * ldv + 8 * c);
    if (NC == 6) { if (tid < 256) r.k2 = *(const v4u*)(K2g + (size_t)(tile * 64 + (tid >> 2)) * ldk2 + 8 * (tid & 3)); }
}
template <int NC> __device__ __forceinline__ void at_store(const TileRegs<NC>& r, LAS unsigned char* buf, int tid) {
    const int key = tid >> 3, c = tid & 7;
    *(LAS v4u*)(buf + key * 128 + 16 * (c ^ ((key >> 1) & 7))) = r.k;
    *(LAS v4u*)(buf + AT_V + (c >> 2) * 4096 + key * 64 + (c & 3) * 16) = r.v;
    if (NC == 6) { if (tid < 256) { const int k2 = tid >> 2, c2 = tid & 3; *(LAS v4u*)(buf + AT_K32 + k2 * 64 + 16 * (c2 ^ ((k2 >> 2) & 3))) = r.k2; } }
}
template <int NC> __device__ __forceinline__ void qk_tile(f32x16& p0, f32x16& p1, LAS const unsigned char* buf, const bf16x8 (&qf)[NC], const f32x16& negm, int lane) {
    const int r32 = lane & 31, hi = lane >> 5;
    p0 = negm; p1 = negm;
#pragma unroll
    for (int cc = 0; cc < NC; ++cc) {
        bf16x8 k0, k1;
        if (cc < 4) { const int k0r = r32, k1r = 32 + r32;
            k0 = *(LAS const bf16x8*)(buf + k0r * 128 + 16 * ((2 * cc + hi) ^ ((k0r >> 1) & 7)));
            k1 = *(LAS const bf16x8*)(buf + k1r * 128 + 16 * ((2 * cc + hi) ^ ((k1r >> 1) & 7))); }
        else { const int k0r = r32, k1r = 32 + r32, c2 = 2 * (cc - 4) + hi;
            k0 = *(LAS const bf16x8*)(buf + AT_K32 + k0r * 64 + 16 * (c2 ^ ((k0r >> 2) & 3)));
            k1 = *(LAS const bf16x8*)(buf + AT_K32 + k1r * 64 + 16 * (c2 ^ ((k1r >> 2) & 3))); }
        p0 = __builtin_amdgcn_mfma_f32_32x32x16_bf16(k0, qf[cc], p0, 0, 0, 0);
        p1 = __builtin_amdgcn_mfma_f32_32x32x16_bf16(k1, qf[cc], p1, 0, 0, 0);
    }
}
template <int MODE> __device__ __forceinline__ void mask_tile(f32x16& p0, f32x16& p1, int kpos0, int qpos, bool need_mask, bool sel_ok, int lane) {
    const int hi = lane >> 5;
    if (need_mask) {
        const int qw0m = __builtin_amdgcn_readfirstlane(qpos) & ~31;
        const bool diag = (kpos0 + 63 > qw0m), old = (MODE == AM_WINDOW) && (kpos0 < qw0m + 31 - 511);
        if (diag || old) {
            const float selterm = (MODE == AM_SLC && !sel_ok) ? -INFINITY : INFINITY;
            const int dbase = qpos - kpos0 - 4 * hi;
#pragma unroll
            for (int r = 0; r < 16; ++r) {
                const int d0 = dbase - ((r & 3) + 8 * (r >> 2)), d1 = d0 - 32;
                float l0 = ((float)d0 + 0.5f) * INFINITY, l1 = ((float)d1 + 0.5f) * INFINITY;
                if (MODE == AM_WINDOW) { l0 = fminf(l0, ((float)(511 - d0) + 0.5f) * INFINITY); l1 = fminf(l1, ((float)(511 - d1) + 0.5f) * INFINITY); }
                if (MODE == AM_SLC) { l0 = fminf(l0, selterm); l1 = fminf(l1, selterm); }
                p0[r] = fminf(p0[r], l0); p1[r] = fminf(p1[r], l1);
            }
        } else if (MODE == AM_SLC) {
            const float selterm = sel_ok ? INFINITY : -INFINITY;
#pragma unroll
            for (int r = 0; r < 16; ++r) { p0[r] = fminf(p0[r], selterm); p1[r] = fminf(p1[r], selterm); }
        }
    }
}
template <int MODE> __device__ __forceinline__ void softmax_tile(AttnState& st, f32x16& p0, f32x16& p1, bf16x8 (&pf)[4], int kpos0, int qpos, bool need_mask, bool sel_ok, int lane) {
    mask_tile<MODE>(p0, p1, kpos0, qpos, need_mask, sel_ok, lane);
    float mx = max3f(p0[0], p1[0], p0[1]), mx2 = max3f(p1[1], p0[2], p1[2]);
#pragma unroll
    for (int r = 3; r < 15; r += 2) { mx = max3f(mx, p0[r], p1[r]); mx2 = max3f(mx2, p0[r + 1], p1[r + 1]); }
    mx = max3f(mx, p0[15], p1[15]); mx = max3f(mx, mx2, mx2);
    mx = red32_max(mx);
    if (!st.started || __any(mx > 0.f)) {
        float dl = st.started ? fmaxf(mx, 0.f) : mx;
        dl = (dl > -1e30f) ? dl : 0.f;
        st.started = true;
        const float alpha = __builtin_amdgcn_exp2f(-dl);
        st.m += dl; st.l *= alpha;
#pragma unroll
        for (int r = 0; r < 16; ++r) { st.o[0][r] *= alpha; st.o[1][r] *= alpha; p0[r] -= dl; p1[r] -= dl; st.negm[r] = -st.m; }
    }
    float sum = 0.f;
#pragma unroll
    for (int r = 0; r < 16; ++r) { p0[r] = __builtin_amdgcn_exp2f(p0[r]); p1[r] = __builtin_amdgcn_exp2f(p1[r]); sum += p0[r] + p1[r]; }
    st.l += sum;
#pragma unroll
    for (int s2 = 0; s2 < 2; ++s2) {
        v4u a, b;
        a.x = cvtpk(p0[8 * s2 + 0], p0[8 * s2 + 1]); a.y = cvtpk(p0[8 * s2 + 2], p0[8 * s2 + 3]); a.z = cvtpk(p0[8 * s2 + 4], p0[8 * s2 + 5]); a.w = cvtpk(p0[8 * s2 + 6], p0[8 * s2 + 7]);
        b.x = cvtpk(p1[8 * s2 + 0], p1[8 * s2 + 1]); b.y = cvtpk(p1[8 * s2 + 2], p1[8 * s2 + 3]); b.z = cvtpk(p1[8 * s2 + 4], p1[8 * s2 + 5]); b.w = cvtpk(p1[8 * s2 + 6], p1[8 * s2 + 7]);
        pf[s2] = __builtin_bit_cast(bf16x8, a); pf[2 + s2] = __builtin_bit_cast(bf16x8, b);
    }
}
struct TileFlags { bool skip, need_mask, sel_ok; };
__device__ __forceinline__ void pack_p(bf16x8 (&pf)[4], const f32x16& p0, const f32x16& p1) {
#pragma unroll
    for (int s2 = 0; s2 < 2; ++s2) {
        v4u a, b;
        a.x = cvtpk(p0[8 * s2 + 0], p0[8 * s2 + 1]); a.y = cvtpk(p0[8 * s2 + 2], p0[8 * s2 + 3]); a.z = cvtpk(p0[8 * s2 + 4], p0[8 * s2 + 5]); a.w = cvtpk(p0[8 * s2 + 6], p0[8 * s2 + 7]);
        b.x = cvtpk(p1[8 * s2 + 0], p1[8 * s2 + 1]); b.y = cvtpk(p1[8 * s2 + 2], p1[8 * s2 + 3]); b.z = cvtpk(p1[8 * s2 + 4], p1[8 * s2 + 5]); b.w = cvtpk(p1[8 * s2 + 6], p1[8 * s2 + 7]);
        pf[s2] = __builtin_bit_cast(bf16x8, a); pf[2 + s2] = __builtin_bit_cast(bf16x8, b);
    }
}
template <int MODE> __device__ __forceinline__ void softmax_pair(AttnState& st, f32x16& a0, f32x16& a1, f32x16& b0, f32x16& b1, int kpos0, int qpos, const TileFlags& fa, const TileFlags& fb, int lane) {
    mask_tile<MODE>(a0, a1, kpos0, qpos, fa.need_mask, fa.sel_ok, lane);
    mask_tile<MODE>(b0, b1, kpos0 + 64, qpos, fb.need_mask, fb.sel_ok, lane);
    float mx = max3f(a0[0], a1[0], b0[0]), mx2 = max3f(b1[0], a0[1], a1[1]);
#pragma unroll
    for (int r = 1; r < 16; ++r) { mx = max3f(mx, b0[r], b1[r]); if (r > 1) mx2 = max3f(mx2, a0[r], a1[r]); }
    mx = max3f(mx, mx2, mx2);
    mx = red32_max(mx);
    if (!st.started || __any(mx > 0.f)) {
        float dl = st.started ? fmaxf(mx, 0.f) : mx;
        dl = (dl > -1e30f) ? dl : 0.f;
        st.started = true;
        const float alpha = __builtin_amdgcn_exp2f(-dl);
        st.m += dl; st.l *= alpha;
#pragma unroll
        for (int r = 0; r < 16; ++r) { st.o[0][r] *= alpha; st.o[1][r] *= alpha; a0[r] -= dl; a1[r] -= dl; b0[r] -= dl; b1[r] -= dl; st.negm[r] = -st.m; }
    }
    float sum = 0.f;
#pragma unroll
    for (int r = 0; r < 16; ++r) { a0[r] = __builtin_amdgcn_exp2f(a0[r]); a1[r] = __builtin_amdgcn_exp2f(a1[r]); b0[r] = __builtin_amdgcn_exp2f(b0[r]); b1[r] = __builtin_amdgcn_exp2f(b1[r]); sum += (a0[r] + a1[r]) + (b0[r] + b1[r]); }
    st.l += sum;
}
__device__ __forceinline__ void pv_tile(AttnState& st, LAS const unsigned char* buf, const bf16x8 (&pf)[4], int lane) {
    const int hi = lane >> 5;
    const unsigned vb = (unsigned)(uintptr_t)(buf + AT_V + (4 * hi + ((lane & 15) >> 2)) * 64 + ((lane >> 4) & 1) * 32 + (lane & 3) * 8);
#pragma unroll
    for (int dh = 0; dh < 2; ++dh) {
        s16x4 lo[4], hh[4];
#pragma unroll
        for (int s4 = 0; s4 < 4; ++s4) {
            asm volatile("ds_read_b64_tr_b16 %0, %1 offset:%c2" : "=&v"(lo[s4]) : "v"(vb), "i"(dh * 4096 + s4 * 1024) : "memory");
            asm volatile("ds_read_b64_tr_b16 %0, %1 offset:%c2" : "=&v"(hh[s4]) : "v"(vb), "i"(dh * 4096 + s4 * 1024 + 512) : "memory");
        }
        asm volatile("s_waitcnt lgkmcnt(0)" : "+v"(lo[0]), "+v"(lo[1]), "+v"(lo[2]), "+v"(lo[3]), "+v"(hh[0]), "+v"(hh[1]), "+v"(hh[2]), "+v"(hh[3]) :: "memory");
#pragma unroll
        for (int s4 = 0; s4 < 4; ++s4) {
            const bf16x8 vf = {lo[s4][0], lo[s4][1], lo[s4][2], lo[s4][3], hh[s4][0], hh[s4][1], hh[s4][2], hh[s4][3]};
            st.o[dh] = __builtin_amdgcn_mfma_f32_32x32x16_bf16(vf, pf[s4], st.o[dh], 0, 0, 0);
        }
    }
}
template <int MODE> __device__ __forceinline__ TileFlags tile_flags(int t, int qw0, unsigned selbits) {
    const int k0 = t * 64; TileFlags f;
    f.skip = k0 > qw0 + 31; f.need_mask = (k0 + 63 > qw0); f.sel_ok = true;
    if (MODE == AM_WINDOW) { f.skip = f.skip || (k0 + 63 < qw0 - 511); f.need_mask = f.need_mask || (k0 < qw0 + 31 - 511); }
    if (MODE == AM_SLC) { f.sel_ok = (selbits >> t) & 1u; const unsigned long long bal = __ballot(f.sel_ok); f.skip = f.skip || (bal == 0ull); f.need_mask = f.need_mask || (bal != ~0ull); }
    return f;
}
struct DmaOff { unsigned k, v, k2; };
template <int NC> __device__ __forceinline__ DmaOff at_dma_off(int ldk, int ldv, int ldk2, int wave, int lane) {
    const int L = wave * 64 + lane; DmaOff o;
    { const int key = L >> 3, c = (L & 7) ^ ((key >> 1) & 7); o.k = (unsigned)(key * ldk + 8 * c) * 2u; }
    { const int key = (L >> 2) & 63, c = (L >> 8) * 4 + (L & 3); o.v = (unsigned)(key * ldv + 8 * c) * 2u; }
    { const int key = (L >> 2) & 63, c2 = (L & 3) ^ ((key >> 2) & 3); o.k2 = (unsigned)(key * ldk2 + 8 * c2) * 2u; }
    return o;
}
template <int NC> __device__ __forceinline__ void at_dma(const DmaOff& o, const bf16* Kg, int ldk, const bf16* Vg, int ldv, const bf16* K2g, int ldk2, int tile, LAS unsigned char* slot, int wave) {
    __builtin_amdgcn_global_load_lds((const unsigned*)((const char*)(Kg + (size_t)tile * 64 * ldk) + o.k), (LAS unsigned*)(slot + wave * 1024), 16, 0, 0);
    __builtin_amdgcn_global_load_lds((const unsigned*)((const char*)(Vg + (size_t)tile * 64 * ldv) + o.v), (LAS unsigned*)(slot + AT_V + wave * 1024), 16, 0, 0);
    if (NC == 6) { if (wave < 4) __builtin_amdgcn_global_load_lds((const unsigned*)((const char*)(K2g + (size_t)tile * 64 * ldk2) + o.k2), (LAS unsigned*)(slot + AT_K32 + wave * 1024), 16, 0, 0); }
}
__device__ __forceinline__ void at_wait_bar(int keep) {
    if (keep == 0) asm volatile("s_waitcnt vmcnt(0) lgkmcnt(0)" ::: "memory");
    else if (keep == 4) asm volatile("s_waitcnt vmcnt(4) lgkmcnt(0)" ::: "memory");
    else asm volatile("s_waitcnt vmcnt(6) lgkmcnt(0)" ::: "memory");
    __builtin_amdgcn_s_barrier();
    asm volatile("" ::: "memory");
}
template <int NC, int MODE> __device__ __forceinline__ void at_stream(AttnState& st, LAS unsigned char* lds, const bf16* Kg, int ldk, const bf16* Vg, int ldv, const bf16* K2g, int ldk2, int t0, int t1,
                                                                       const bf16x8 (&qf)[NC], int qpos, int qw0, unsigned selbits, int tid) {
    const int lane = tid & 63, wave = __builtin_amdgcn_readfirstlane(tid >> 6), np = (t1 - t0) >> 1;
    const int nper2 = (NC == 6 && wave < 4) ? 6 : 4;
    const DmaOff dof = at_dma_off<NC>(ldk, ldv, ldk2, wave, lane);
    at_dma<NC>(dof, Kg, ldk, Vg, ldv, K2g, ldk2, t0, lds, wave); at_dma<NC>(dof, Kg, ldk, Vg, ldv, K2g, ldk2, t0 + 1, lds + AT_BUF, wave);
    if (np > 1) { at_dma<NC>(dof, Kg, ldk, Vg, ldv, K2g, ldk2, t0 + 2, lds + 2 * AT_BUF, wave); at_dma<NC>(dof, Kg, ldk, Vg, ldv, K2g, ldk2, t0 + 3, lds + 3 * AT_BUF, wave); }
    at_wait_bar(np > 1 ? nper2 : 0);
    int s0 = 0, s1 = 2 * AT_BUF, s2 = 4 * AT_BUF;
    for (int j = 0; j < np; ++j) {
        const int t = t0 + 2 * j; const bool has_2 = (j + 2 < np);
        if (has_2) { at_dma<NC>(dof, Kg, ldk, Vg, ldv, K2g, ldk2, t + 4, lds + s2, wave); at_dma<NC>(dof, Kg, ldk, Vg, ldv, K2g, ldk2, t + 5, lds + s2 + AT_BUF, wave); }
        const TileFlags fa = tile_flags<MODE>(t, qw0, selbits), fb = tile_flags<MODE>(t + 1, qw0, selbits);
        if (!fa.skip && !fb.skip) {
            f32x16 a0, a1, b0, b1; bf16x8 pf[4];
            qk_tile<NC>(a0, a1, lds + s0, qf, st.negm, lane);
            qk_tile<NC>(b0, b1, lds + s0 + AT_BUF, qf, st.negm, lane);
            softmax_pair<MODE>(st, a0, a1, b0, b1, t * 64, qpos, fa, fb, lane);
            pack_p(pf, a0, a1); pv_tile(st, lds + s0, pf, lane);
            pack_p(pf, b0, b1); pv_tile(st, lds + s0 + AT_BUF, pf, lane);
        } else {
            if (!fa.skip) { f32x16 p0, p1; bf16x8 pf[4]; qk_tile<NC>(p0, p1, lds + s0, qf, st.negm, lane); softmax_tile<MODE>(st, p0, p1, pf, t * 64, qpos, fa.need_mask, fa.sel_ok, lane); pv_tile(st, lds + s0, pf, lane); }
            if (!fb.skip) { f32x16 p0, p1; bf16x8 pf[4]; qk_tile<NC>(p0, p1, lds + s0 + AT_BUF, qf, st.negm, lane); softmax_tile<MODE>(st, p0, p1, pf, (t + 1) * 64, qpos, fb.need_mask, fb.sel_ok, lane); pv_tile(st, lds + s0 + AT_BUF, pf, lane); }
        }
        at_wait_bar(has_2 ? nper2 : 0);
        const int tmp = s0; s0 = s1; s1 = s2; s2 = tmp;
    }
}
__device__ __forceinline__ int next_item_q(unsigned* ctrs, LAS unsigned char* lds, int wave_u, int count, int q0, int& kstart) {
    const int tid = wave_u * 64 + fresh_lane();
    LAS int* slot = (LAS int*)(lds + RING_BYTES + 64);
    if (tid == 0) { const unsigned v = atomicAdd(ctrs, 1u); slot[0] = (v < 8u * (unsigned)count) ? (int)(((v & 7u) << 16) | (v >> 3)) : -1; }
    __syncthreads();
    const int v = slot[0];
    __syncthreads();
    (void)q0; (void)kstart;
    return v;
}
__device__ __forceinline__ void mla_unit(unsigned char* ws, LAS unsigned char* lds, int b, int h, int qt, int wave_u) {
    const int tid = wave_u * 64 + fresh_lane();
    const int lane = tid & 63, wave = tid >> 6, r32 = lane & 31, hi = lane >> 5;
    const int qw0 = qt * 256 + wave * 32, qpos = qw0 + r32; const size_t row = (size_t)b * S_ + qpos;
    const long long tq0 = (PROBE_SEL != 0) ? (long long)__builtin_amdgcn_s_memtime() : 0ll;
    bf16x8 qf[6];
    {
        const bf16* qp = (const bf16*)(ws + WS_OSLC) + row * 768 + h * 96 + 8 * hi;
        v4u raw[6];
#pragma unroll
        for (int cc = 0; cc < 6; ++cc) raw[cc] = *(const v4u*)(qp + 16 * cc);
        float msc = MSCALE; asm volatile("" : "+v"(msc));
        const float rs = rsqrtf(((const float*)(ws + WS_SSQL))[row] * (1.f / 256.f) + EPS) * msc;
        const float* cm_ = (const float*)(ws + WS_COSM) + row * 16 + 8 * hi; const float* sm_ = (const float*)(ws + WS_SINM) + row * 16 + 8 * hi;
#define UNPKQ(dst, src) dst[0] = __uint_as_float(src.x << 16); dst[1] = __uint_as_float(src.x & 0xffff0000u); dst[2] = __uint_as_float(src.y << 16); dst[3] = __uint_as_float(src.y & 0xffff0000u); \
        dst[4] = __uint_as_float(src.z << 16); dst[5] = __uint_as_float(src.z & 0xffff0000u); dst[6] = __uint_as_float(src.w << 16); dst[7] = __uint_as_float(src.w & 0xffff0000u);
#pragma unroll
        for (int cc = 0; cc < 4; ++cc) { float f[8]; UNPKQ(f, raw[cc])
            v4u w; w.x = cvtpk(f[0] * rs, f[1] * rs); w.y = cvtpk(f[2] * rs, f[3] * rs); w.z = cvtpk(f[4] * rs, f[5] * rs); w.w = cvtpk(f[6] * rs, f[7] * rs); qf[cc] = __builtin_bit_cast(bf16x8, w); }
        { float x1[8], x2[8], o1[8], o2[8]; UNPKQ(x1, raw[4]) UNPKQ(x2, raw[5])
#pragma unroll
          for (int j = 0; j < 8; ++j) { const float cs = cm_[j] * rs, sn = sm_[j] * rs; o1[j] = x1[j] * cs - x2[j] * sn; o2[j] = x1[j] * sn + x2[j] * cs; }
          v4u w; w.x = cvtpk(o1[0], o1[1]); w.y = cvtpk(o1[2], o1[3]); w.z = cvtpk(o1[4], o1[5]); w.w = cvtpk(o1[6], o1[7]); qf[4] = __builtin_bit_cast(bf16x8, w);
          w.x = cvtpk(o2[0], o2[1]); w.y = cvtpk(o2[2], o2[3]); w.z = cvtpk(o2[4], o2[5]); w.w = cvtpk(o2[6], o2[7]); qf[5] = __builtin_bit_cast(bf16x8, w); }
#undef UNPKQ
    }
    const long long tq1 = (PROBE_SEL != 0) ? (long long)__builtin_amdgcn_s_memtime() : 0ll;
    AttnState st; st.m = 0.f; st.l = 0.f; st.o[0] = f32x16{}; st.o[1] = f32x16{}; st.negm = f32x16{}; st.started = false; st.twait = 0;
    const bf16* kvb = (const bf16*)(ws + WS_KVM) + (size_t)b * S_ * 768 + h * 128;
    at_stream<6, AM_CAUSAL>(st, lds, kvb, 768, kvb + 64, 768, (const bf16*)(ws + WS_KR) + (size_t)b * S_ * 32, 32, 0, 4 * qt + 4, qf, qpos, qw0, 0u, tid);
    if (PROBE_SEL >= 1 && PROBE_SEL <= 3 && b == 0 && h == 0 && qt == 7 && tid == 0) { const long long tq2 = (long long)__builtin_amdgcn_s_memtime();
        ((float*)(ws + WS_CTL))[100] = (PROBE_SEL == 1) ? (float)(tq2 - tq1) : (PROBE_SEL == 2) ? (float)st.twait : (float)(tq1 - tq0); }
    const float lt = red32_sum(st.l), il = 1.f / lt;
    bf16* op = (bf16*)(ws + WS_HB) + row * D_ + 384 + h * 64 + 4 * hi;
#pragma unroll
    for (int dh = 0; dh < 2; ++dh)
#pragma unroll
        for (int g4 = 0; g4 < 4; ++g4) { u32x2v w; w.x = cvtpk(st.o[dh][4 * g4] * il, st.o[dh][4 * g4 + 1] * il); w.y = cvtpk(st.o[dh][4 * g4 + 2] * il, st.o[dh][4 * g4 + 3] * il);
            *(u32x2v*)(op + dh * 32 + 8 * g4) = w; }
}
template <int MODE> __device__ __forceinline__ void nsa_branch_unit(unsigned char* ws, LAS unsigned char* lds, int b, int h, int qt, int wave_u) {
    const int tid = wave_u * 64 + fresh_lane();
    const int lane = tid & 63, wave = tid >> 6, r32 = lane & 31, hi = lane >> 5, g = h / 3;
    const int qw0 = qt * 256 + wave * 32, qpos = qw0 + r32; const size_t row = (size_t)b * S_ + qpos;
    const bf16* nsa = (const bf16*)(ws + WS_NSA);
    const bf16* qp = nsa + row * 1152 + h * 64 + 8 * hi;
    bf16x8 qf[4];
#pragma unroll
    for (int cc = 0; cc < 4; ++cc) qf[cc] = *(const bf16x8*)(qp + 16 * cc);
    unsigned selbits = 0u; if (MODE == AM_SLC) selbits = ((const unsigned*)(ws + WS_SEL))[(size_t)(b * 2 + g) * S_ + qpos];
    const bf16* kb = nsa + (size_t)b * S_ * 1152 + g * 64 + (MODE == AM_SLC ? 640 : 896);
    AttnState st; st.m = 0.f; st.l = 0.f; st.o[0] = f32x16{}; st.o[1] = f32x16{}; st.negm = f32x16{}; st.started = false; st.twait = 0;
    const long long tn0 = (PROBE_SEL != 0) ? (long long)__builtin_amdgcn_s_memtime() : 0ll;
    const int t0 = (MODE == AM_SLC) ? 0 : ((4 * qt - 8 > 0) ? 4 * qt - 8 : 0);
    at_stream<4, MODE>(st, lds, kb, 1152, kb + 128, 1152, nullptr, 0, t0, 4 * qt + 4, qf, qpos, qw0, selbits, tid);
    if (PROBE_SEL >= 4 && PROBE_SEL <= 5 && MODE == AM_SLC && b == 0 && h == 0 && qt == 7 && tid == 0) { const long long tn1 = (long long)__builtin_amdgcn_s_memtime();
        ((float*)(ws + WS_CTL))[100] = (PROBE_SEL == 4) ? (float)(tn1 - tn0) : (float)st.twait; }
    const float lt = red32_sum(st.l), il = 1.f / lt;
    bf16* op = (bf16*)(ws + (MODE == AM_SLC ? WS_OSLC : WS_OWIN)) + row * 384 + h * 64 + 4 * hi;
#pragma unroll
    for (int dh = 0; dh < 2; ++dh)
#pragma unroll
        for (int g4 = 0; g4 < 4; ++g4) { u32x2v w; w.x = cvtpk(st.o[dh][4 * g4] * il, st.o[dh][4 * g4 + 1] * il); w.y = cvtpk(st.o[dh][4 * g4 + 2] * il, st.o[dh][4 * g4 + 3] * il);
            *(u32x2v*)(op + dh * 32 + 8 * g4) = w; }
}
__device__ __forceinline__ void cmp_unit(unsigned char* ws, LAS unsigned char* lds, int b, int g, int qt, int wave_u) {
    const int tid = wave_u * 64 + fresh_lane();
    const int lane = tid & 63, wave = tid >> 6, r32 = lane & 31, hi = lane >> 5;
    const int qpos = qt * 256 + wave * 32 + r32; const size_t row = (size_t)b * S_ + qpos;
    const bf16* kc = (const bf16*)(ws + WS_KCV) + (size_t)(b * 2 + g) * 128 * 64; const bf16* vc = kc + (size_t)8 * 2 * 128 * 64;
    { TileRegs<4> tr; at_load<4>(tr, kc, 64, vc, 64, nullptr, 0, 0, tid); at_store<4>(tr, lds, tid); at_load<4>(tr, kc, 64, vc, 64, nullptr, 0, 1, tid); at_store<4>(tr, lds + AT_BUF, tid); }
    __syncthreads();
    int nvis = (qpos >= 31) ? ((qpos - 31) >> 4) + 1 : 0; if (nvis > 127) nvis = 127;
    float G[16], L[16];
#pragma unroll
    for (int i = 0; i < 16; ++i) { G[i] = 0.f; L[i] = 0.f; }
    const bf16* nsa = (const bf16*)(ws + WS_NSA);
    LAS const unsigned char* vb = lds + AT_V + (4 * hi + ((lane & 15) >> 2)) * 64 + ((lane >> 4) & 1) * 32 + (lane & 3) * 8;
    for (int r3 = 0; r3 < 3; ++r3) {
        const int h = 3 * g + r3;
        const bf16* qp = nsa + row * 1152 + h * 64 + 8 * hi;
        bf16x8 qf[4];
#pragma unroll
        for (int cc = 0; cc < 4; ++cc) qf[cc] = *(const bf16x8*)(qp + 16 * cc);
        f32x16 p[4];
#pragma unroll
        for (int tb = 0; tb < 4; ++tb) {
            LAS const unsigned char* buf = lds + (tb >> 1) * AT_BUF; const int kr = (tb & 1) * 32 + r32;
            p[tb] = f32x16{};
#pragma unroll
            for (int cc = 0; cc < 4; ++cc) { const bf16x8 kf = *(LAS const bf16x8*)(buf + kr * 128 + 16 * ((2 * cc + hi) ^ ((kr >> 1) & 7)));
                p[tb] = __builtin_amdgcn_mfma_f32_32x32x16_bf16(kf, qf[cc], p[tb], 0, 0, 0); }
        }
        float mx = -1e30f;
#pragma unroll
        for (int tb = 0; tb < 4; ++tb)
#pragma unroll
            for (int r = 0; r < 16; ++r) { const int n = 32 * tb + crow(r, hi); p[tb][r] = fminf(p[tb][r], ((float)(nvis - n) - 0.5f) * INFINITY); mx = fmaxf(mx, p[tb][r]); }
        mx = red32_max(mx);
        float sum = 0.f;
#pragma unroll
        for (int tb = 0; tb < 4; ++tb)
#pragma unroll
            for (int r = 0; r < 16; ++r) { p[tb][r] = __builtin_amdgcn_exp2f(p[tb][r] - mx); sum += p[tb][r]; }
        sum = red32_sum(sum);
        const float il = (nvis > 0) ? 1.f / sum : 0.f;
#pragma unroll
        for (int tb = 0; tb < 4; ++tb)
#pragma unroll
            for (int k = 0; k < 4; ++k) { const float a0 = p[tb][4 * k] * il, a1 = p[tb][4 * k + 1] * il, a2 = p[tb][4 * k + 2] * il, a3 = p[tb][4 * k + 3] * il;
                G[4 * tb + k] += (a0 + a1) + (a2 + a3); L[4 * tb + k] += a3; }
        f32x16 o[2] = {f32x16{}, f32x16{}};
#pragma unroll
        for (int tb = 0; tb < 4; ++tb)
#pragma unroll
            for (int s2 = 0; s2 < 2; ++s2) {
                v4u a; a.x = cvtpk(p[tb][8 * s2 + 0], p[tb][8 * s2 + 1]); a.y = cvtpk(p[tb][8 * s2 + 2], p[tb][8 * s2 + 3]); a.z = cvtpk(p[tb][8 * s2 + 4], p[tb][8 * s2 + 5]); a.w = cvtpk(p[tb][8 * s2 + 6], p[tb][8 * s2 + 7]);
                const bf16x8 pf = __builtin_bit_cast(bf16x8, a);
                LAS const unsigned char* vbb = vb + (tb >> 1) * AT_BUF + ((tb & 1) * 2 + s2) * 1024;
#pragma unroll
                for (int dh = 0; dh < 2; ++dh) { const s16x4 lo = vtr(vbb + dh * 4096), hh = vtr(vbb + dh * 4096 + 512);
                    const bf16x8 vf = {lo[0], lo[1], lo[2], lo[3], hh[0], hh[1], hh[2], hh[3]};
                    o[dh] = __builtin_amdgcn_mfma_f32_32x32x16_bf16(vf, pf, o[dh], 0, 0, 0); }
                asm volatile("" ::: "memory");
            }
        bf16* op = (bf16*)(ws + WS_OCMP) + row * 384 + h * 64 + 4 * hi;
#pragma unroll
        for (int dh = 0; dh < 2; ++dh)
#pragma unroll
            for (int g4 = 0; g4 < 4; ++g4) { u32x2v w; w.x = cvtpk(o[dh][4 * g4] * il, o[dh][4 * g4 + 1] * il); w.y = cvtpk(o[dh][4 * g4 + 2] * il, o[dh][4 * g4 + 3] * il);
                *(u32x2v*)(op + dh * 32 + 8 * g4) = w; }
    }
    const int cur = qpos >> 6;
    unsigned key[16], okey[16];
#pragma unroll
    for (int jj = 0; jj < 16; ++jj) {
        const auto sw = __builtin_amdgcn_permlane32_swap(__float_as_uint(L[jj]), __float_as_uint(L[jj]), false, false);
        const float lp = __uint_as_float(hi ? sw[0] : sw[1]);
        L[jj] = lp;
    }
#pragma unroll
    for (int jj = 0; jj < 16; ++jj) {
        const int j = 2 * jj + hi;
        float v = G[jj] + (hi ? L[jj] : (jj > 0 ? L[jj > 0 ? jj - 1 : 0] : 0.f));
        if (j == 0 || j == cur || j == cur - 1) v = INFINITY;
        if (j * 64 > qpos) v = -INFINITY;
        const unsigned u = __float_as_uint(v); const unsigned ord = (u & 0x80000000u) ? ~u : (u | 0x80000000u);
        key[jj] = (ord & ~31u) | (unsigned)(31 - j);
    }
#pragma unroll
    for (int jj = 0; jj < 16; ++jj) { const auto sw = __builtin_amdgcn_permlane32_swap(key[jj], key[jj], false, false); okey[jj] = hi ? sw[0] : sw[1]; }
    unsigned mask = 0;
#pragma unroll
    for (int jj = 0; jj < 16; ++jj) {
        int rank = 0;
#pragma unroll
        for (int kk = 0; kk < 16; ++kk) { rank += (key[kk] > key[jj]) ? 1 : 0; rank += (okey[kk] > key[jj]) ? 1 : 0; }
        if (rank < 16) mask |= 1u << (2 * jj + hi);
    }
    mask = red32_or(mask);
    if (hi == 0) ((unsigned*)(ws + WS_SEL))[(size_t)(b * 2 + g) * S_ + qpos] = mask;
    __syncthreads();
}
__device__ __forceinline__ void lora_rows(unsigned char* ws, int tid) {
    const int gw = blockIdx.x * NWAVES + (tid >> 6), ngw = gridDim.x * NWAVES, lane = tid & 63;
    bf16* kvl = (bf16*)(ws + WS_KVL); const bf16* ql = (const bf16*)(ws + WS_QL); float* ssql = (float*)(ws + WS_SSQL);
    for (int m = gw; m < T_; m += ngw) {
        const unsigned kv = *(const unsigned*)(kvl + (size_t)m * 128 + 2 * lane);
        const float k0 = __uint_as_float(kv << 16), k1 = __uint_as_float(kv & 0xffff0000u);
        const uint2 qv = *(const uint2*)(ql + (size_t)m * 256 + 4 * lane);
        const float q0 = __uint_as_float(qv.x << 16), q1 = __uint_as_float(qv.x & 0xffff0000u), q2 = __uint_as_float(qv.y << 16), q3 = __uint_as_float(qv.y & 0xffff0000u);
        const float sk = wave_sum2(k0 * k0 + k1 * k1), sq = wave_sum2((q0 * q0 + q1 * q1) + (q2 * q2 + q3 * q3));
        const float rk = rsqrtf(sk * (1.f / 128.f) + EPS);
        *(unsigned*)(kvl + (size_t)m * 128 + 2 * lane) = pk2(k0 * rk, k1 * rk);
        if (lane == 0) ssql[m] = sq;
    }
}
__device__ __forceinline__ void post_misc(unsigned char* ws, const float* big, const float* bfg, int tid) {
    const float* mr = (const float*)(ws + WS_MISCRAW); const float* cosM = (const float*)(ws + WS_COSM); const float* sinM = (const float*)(ws + WS_SINM);
    bf16* kr = (bf16*)(ws + WS_KR); float* gm = (float*)(ws + WS_GM);
    for (int idx = blockIdx.x * NTHR + tid; idx < T_ * 64; idx += gridDim.x * NTHR) {
        const int row = idx >> 6, c = idx & 63; const float* r = mr + (size_t)row * 64; const float v = r[c];
        if (c < 32) { const int i = c & 15; const float x1 = r[i], x2 = r[16 + i], cs = cosM[row * 16 + i], sn = sinM[row * 16 + i];
            kr[(size_t)row * 32 + c] = f2bf((c < 16) ? x1 * cs - x2 * sn : x1 * sn + x2 * cs); }
        else if (c < 50) gm[(size_t)row * 32 + (c - 32)] = 1.f / (1.f + __expf(-v));
        else if (c < 54) gm[(size_t)row * 32 + 18 + (c - 50)] = v + big[c - 50];
        else if (c < 58) { const float z = v + bfg[c - 54]; gm[(size_t)row * 32 + 22 + (c - 54)] = fminf(z, 0.f) - __logf(1.f + __expf(-fabsf(z))); }
    }
}

typedef float f32x4v __attribute__((ext_vector_type(4)));
__device__ __forceinline__ void compress_item(unsigned char* ws, LAS unsigned char* lds, const float* cmp_pos, int item, int wave_u) {
    const int lane = fresh_lane(), tid = wave_u * 64 + lane;
    const int nb = item & 7, g = (item >> 3) & 1, b = (item >> 4) & 7, kv = item >> 7;
    const bf16* tok = (const bf16*)(ws + WS_NSA) + (size_t)b * S_ * 1152 + (kv ? 512 : 384) + g * 64;
    const bf16* wt = (const bf16*)(ws + (kv ? WT_CV : WT_CK));
    const int nrow = nb * 16 + (lane & 15), kq = lane >> 4;
    f32x4v acc[4] = {f32x4v{}, f32x4v{}, f32x4v{}, f32x4v{}};
#pragma unroll
    for (int hb = 0; hb < 2; ++hb) {
        v4u t4[4]; f32x4v p0[4], p1[4]; bf16x8 bfr[4][4];
#pragma unroll
        for (int q = 0; q < 4; ++q) {
            const int k = wave_u * 256 + (4 * hb + q) * 32 + kq * 8, l = k >> 6, d = k & 63;
            int trow = 16 * nrow + l; trow = trow < S_ ? trow : S_ - 1;
            t4[q] = *(const v4u*)(tok + (size_t)trow * 1152 + d);
            p0[q] = *(const f32x4v*)(cmp_pos + k); p1[q] = *(const f32x4v*)(cmp_pos + k + 4);
#pragma unroll
            for (int cb = 0; cb < 4; ++cb) bfr[q][cb] = *(const bf16x8*)(wt + (size_t)(cb * 16 + (lane & 15)) * 2048 + k);
        }
        asm volatile("" : "+v"(t4[0]), "+v"(t4[1]), "+v"(t4[2]), "+v"(t4[3]), "+v"(p0[0]), "+v"(p0[1]), "+v"(p0[2]), "+v"(p0[3]), "+v"(p1[0]), "+v"(p1[1]), "+v"(p1[2]), "+v"(p1[3]));
        asm volatile("" : "+v"(bfr[0][0]), "+v"(bfr[0][1]), "+v"(bfr[0][2]), "+v"(bfr[0][3]), "+v"(bfr[1][0]), "+v"(bfr[1][1]), "+v"(bfr[1][2]), "+v"(bfr[1][3]));
        asm volatile("" : "+v"(bfr[2][0]), "+v"(bfr[2][1]), "+v"(bfr[2][2]), "+v"(bfr[2][3]), "+v"(bfr[3][0]), "+v"(bfr[3][1]), "+v"(bfr[3][2]), "+v"(bfr[3][3]));
#pragma unroll
        for (int q = 0; q < 4; ++q) {
            v4u a4;
            a4.x = cvtpk(__uint_as_float(t4[q].x << 16) + p0[q][0], __uint_as_float(t4[q].x & 0xffff0000u) + p0[q][1]); a4.y = cvtpk(__uint_as_float(t4[q].y << 16) + p0[q][2], __uint_as_float(t4[q].y & 0xffff0000u) + p0[q][3]);
            a4.z = cvtpk(__uint_as_float(t4[q].z << 16) + p1[q][0], __uint_as_float(t4[q].z & 0xffff0000u) + p1[q][1]); a4.w = cvtpk(__uint_as_float(t4[q].w << 16) + p1[q][2], __uint_as_float(t4[q].w & 0xffff0000u) + p1[q][3]);
            const bf16x8 af = __builtin_bit_cast(bf16x8, a4);
#pragma unroll
            for (int cb = 0; cb < 4; ++cb) acc[cb] = __builtin_amdgcn_mfma_f32_16x16x32_bf16(af, bfr[q][cb], acc[cb], 0, 0, 0);
        }
    }
    LAS float* red = (LAS float*)lds + wave_u * 1024;
#pragma unroll
    for (int cb = 0; cb < 4; ++cb)
#pragma unroll
        for (int r = 0; r < 4; ++r) red[(4 * (lane >> 4) + r) * 64 + cb * 16 + (lane & 15)] = acc[cb][r];
    __syncthreads();
    bf16* out = (bf16*)(ws + WS_KCV) + (size_t)kv * (8 * 2 * 128 * 64) + ((size_t)(b * 2 + g) * 128 + nb * 16) * 64;
    for (int o = tid; o < 1024; o += NTHR) { float sum = 0.f;
#pragma unroll
        for (int w8 = 0; w8 < 8; ++w8) sum += ((LAS float*)lds)[w8 * 1024 + o];
        out[o] = f2bf(sum); }
    __syncthreads();
}
__device__ __forceinline__ f32x4v mm16(const LAS bf16* A, int lda, int arow0, const LAS bf16* Bt, int ldb, int bcol0, int K, int lane, f32x4v acc) {
    const LAS bf16* ap = A + (arow0 + (lane & 15)) * lda + 8 * (lane >> 4); const LAS bf16* bp = Bt + (bcol0 + (lane & 15)) * ldb + 8 * (lane >> 4);
    for (int k = 0; k < K; k += 32) acc = __builtin_amdgcn_mfma_f32_16x16x32_bf16(*(const LAS bf16x8*)(ap + k), *(const LAS bf16x8*)(bp + k), acc, 0, 0, 0);
    return acc;
}
constexpr int ML_LD = 72;
constexpr int ML_STRIDE = 3 * 64 * ML_LD * 2 + 256;
__device__ __forceinline__ void mlocal_item(unsigned char* ws, LAS unsigned char* lds, const float* convw, const float* convb, const float* big, const float* bfg, int chunk0, int wave_u) {
    const int lane = fresh_lane(), tid = wave_u * 64 + lane;
    const int h = (chunk0 >> 5) & 3, b = chunk0 >> 7;
    LAS bf16* WQ = (LAS bf16*)lds;
    LAS bf16* WK = WQ + 64 * ML_LD;
    const bf16* cm = (const bf16*)(ws + WS_CM);
#define ML_PTRS(ch) const int chunk = chunk0 + (ch); const int c = chunk & 31; const int row0 = b * S_ + c * 64; LAS bf16* XS = WK + 64 * ML_LD + (ch) * (ML_STRIDE / 2); \
    LAS bf16* VT = XS + 64 * ML_LD; LAS bf16* WKT = VT + 64 * ML_LD; LAS float* wl = (LAS float*)(WKT + 64 * ML_LD); (void)c; (void)row0; (void)XS; (void)VT; (void)WKT; (void)wl; (void)chunk;
    {
        v4u gx[2][4], gv[2]; const int l = tid >> 3, ch0 = (tid & 7) * 8;
#pragma unroll
        for (int ch = 0; ch < 2; ++ch) { ML_PTRS(ch) const int row = row0 + l, s = c * 64 + l;
#pragma unroll
            for (int j = 0; j < 4; ++j) gx[ch][j] = (s - 3 + j >= 0) ? *(const v4u*)(cm + (size_t)(row - 3 + j) * 768 + h * 64 + ch0) : v4u{0u, 0u, 0u, 0u};
            gv[ch] = *(const v4u*)(cm + (size_t)row * 768 + 256 + h * 64 + ch0); }
        asm volatile("" : "+v"(gx[0][0]), "+v"(gx[0][1]), "+v"(gx[0][2]), "+v"(gx[0][3]), "+v"(gx[1][0]), "+v"(gx[1][1]), "+v"(gx[1][2]), "+v"(gx[1][3]), "+v"(gv[0]), "+v"(gv[1]));
#pragma unroll
        for (int ch = 0; ch < 2; ++ch) { ML_PTRS(ch) const int row = row0 + l;
            float a[8];
#pragma unroll
            for (int i = 0; i < 8; ++i) a[i] = convb[h * 64 + ch0 + i];
#pragma unroll
            for (int j = 0; j < 4; ++j) { const v4u x4 = gx[ch][j];
                const float* cw = convw + j * 256 + h * 64 + ch0;
                a[0] += cw[0] * __uint_as_float(x4.x << 16); a[1] += cw[1] * __uint_as_float(x4.x & 0xffff0000u); a[2] += cw[2] * __uint_as_float(x4.y << 16); a[3] += cw[3] * __uint_as_float(x4.y & 0xffff0000u);
                a[4] += cw[4] * __uint_as_float(x4.z << 16); a[5] += cw[5] * __uint_as_float(x4.z & 0xffff0000u); a[6] += cw[6] * __uint_as_float(x4.w << 16); a[7] += cw[7] * __uint_as_float(x4.w & 0xffff0000u); }
            v4u o4; float r[8];
#pragma unroll
            for (int i = 0; i < 8; ++i) r[i] = a[i] / (1.f + __expf(-a[i]));
            o4.x = cvtpk(r[0], r[1]); o4.y = cvtpk(r[2], r[3]); o4.z = cvtpk(r[4], r[5]); o4.w = cvtpk(r[6], r[7]);
            *(v4u*)((bf16*)(ws + WS_XC) + (size_t)row * 256 + h * 64 + ch0) = o4;
            *(LAS v4u*)(XS + l * ML_LD + ch0) = o4;
            const v4u v4 = gv[ch];
            VT[(ch0 + 0) * ML_LD + l] = (bf16)(v4.x & 0xffffu); VT[(ch0 + 1) * ML_LD + l] = (bf16)(v4.x >> 16); VT[(ch0 + 2) * ML_LD + l] = (bf16)(v4.y & 0xffffu); VT[(ch0 + 3) * ML_LD + l] = (bf16)(v4.y >> 16);
            VT[(ch0 + 4) * ML_LD + l] = (bf16)(v4.z & 0xffffu); VT[(ch0 + 5) * ML_LD + l] = (bf16)(v4.z >> 16); VT[(ch0 + 6) * ML_LD + l] = (bf16)(v4.w & 0xffffu); VT[(ch0 + 7) * ML_LD + l] = (bf16)(v4.w >> 16);
        }
    }
    {
        const int e = tid >> 3, d0 = (tid & 7) * 8;
        *(LAS v4u*)(WQ + e * ML_LD + d0) = *(const v4u*)((const bf16*)(ws + WT_QM) + h * 4096 + e * 64 + d0);
        *(LAS v4u*)(WK + e * ML_LD + d0) = *(const v4u*)((const bf16*)(ws + WT_KM) + h * 4096 + e * 64 + d0);
    }
    if (wave_u < 2) { ML_PTRS(wave_u)
        const float* mr = (const float*)(ws + WS_MISCRAW) + (size_t)(row0 + lane) * 64;
        const float z = mr[54 + h] + bfg[h]; float lf = fminf(z, 0.f) - __logf(1.f + __expf(-fabsf(z)));
        const float ig = mr[50 + h] + big[h];
#pragma unroll
        for (int o = 1; o < 64; o <<= 1) { const float t = bperm(lf, lane - o); if (lane >= o) lf += t; }
        const float bL = __int_as_float(__builtin_amdgcn_readlane(__float_as_int(lf), 63));
        const float a = bL - lf + ig; const float mx = wave_max2(a);
        wl[lane] = __expf(a - mx);
        if (lane == 0) { ((float*)(ws + WS_ML))[chunk] = mx; ((float*)(ws + WS_BL))[chunk] = bL; }
    }
    __syncthreads();
#pragma unroll
    for (int ch = 0; ch < 2; ++ch) { ML_PTRS(ch)
        const int lb = wave_u & 3; const bool isk = wave_u >= 4;
        const LAS bf16* Wt = isk ? WK : WQ;
        bf16* og = (bf16*)(ws + (isk ? WS_MK : WS_MQ)) + (size_t)(row0 + 16 * lb + 4 * (lane >> 4)) * 256 + h * 64 + (lane & 15);
        float w4[4];
#pragma unroll
        for (int r = 0; r < 4; ++r) w4[r] = wl[16 * lb + 4 * (lane >> 4) + r];
#pragma unroll
        for (int eb = 0; eb < 4; ++eb) {
            f32x4v acc = mm16(XS, ML_LD, 16 * lb, Wt, ML_LD, 16 * eb, 64, lane, f32x4v{});
            if (!isk) {
#pragma unroll
                for (int r = 0; r < 4; ++r) og[(size_t)r * 256 + 16 * eb] = f2bf(acc[r] * 0.125f);
            } else {
                bf16 kb[4];
#pragma unroll
                for (int r = 0; r < 4; ++r) { kb[r] = f2bf(acc[r]); og[(size_t)r * 256 + 16 * eb] = kb[r]; }
                u32x2v w2; w2.x = cvtpk(bf2f(kb[0]) * w4[0], bf2f(kb[1]) * w4[1]); w2.y = cvtpk(bf2f(kb[2]) * w4[2], bf2f(kb[3]) * w4[3]);
                *(LAS u32x2v*)(WKT + (16 * eb + (lane & 15)) * ML_LD + 16 * lb + 4 * (lane >> 4)) = w2;
            }
        }
    }
    __syncthreads();
#pragma unroll
    for (int ch = 0; ch < 2; ++ch) { ML_PTRS(ch)
        float* ct = (float*)(ws + WS_CT) + (size_t)chunk * 4096;
#pragma unroll
        for (int i = 0; i < 2; ++i) { const int blk = wave_u * 2 + i, eb = blk >> 2, db = blk & 3;
            const f32x4v acc = mm16(VT, ML_LD, 16 * eb, WKT, ML_LD, 16 * db, 64, lane, f32x4v{});
#pragma unroll
            for (int r = 0; r < 4; ++r) ct[(16 * eb + 4 * (lane >> 4) + r) * 64 + 16 * db + (lane & 15)] = acc[r]; }
    }
    if (tid < 128) { ML_PTRS(tid >> 6)
        const int d = tid & 63; float n = 0.f; const LAS bf16* wr_ = WKT + d * ML_LD;
        for (int l = 0; l < 64; ++l) n += bf2f(wr_[l]);
        ((float*)(ws + WS_NL))[chunk * 64 + d] = n; }
#undef ML_PTRS
    __syncthreads();
}
__device__ __forceinline__ void mscan_item(unsigned char* ws, int item, int wave_u) {
    const int tid = wave_u * 64 + fresh_lane();
    const int bh = item / 9, part = item % 9;
    if (part == 8 && tid >= 64) return;
    float* base; size_t stride;
    if (part < 8) { base = (float*)(ws + WS_CT) + (size_t)bh * 32 * 4096 + part * 512 + tid; stride = 4096; } else { base = (float*)(ws + WS_NL) + (size_t)bh * 32 * 64 + tid; stride = 64; }
    const float* ML = (const float*)(ws + WS_ML); const float* BL = (const float*)(ws + WS_BL); float* MPv = (float*)(ws + WS_MP);
    float cl[32];
#pragma unroll
    for (int c = 0; c < 32; ++c) cl[c] = base[(size_t)c * stride];
    float Cv = 0.f, m = 0.f;
#pragma unroll
    for (int c = 0; c < 32; ++c) {
        const float ml = ML[bh * 32 + c], bl = BL[bh * 32 + c];
        base[(size_t)c * stride] = Cv;
        if (part == 8 && tid == 0) MPv[bh * 32 + c] = m;
        const float mn = fmaxf(bl + m, ml);
        Cv = __expf(bl + m - mn) * Cv + __expf(ml - mn) * cl[c]; m = mn;
    }
}
constexpr int MO_STRIDE = 5 * 64 * ML_LD * 2 + 64 * 65 * 4 + 6 * 64 * 4;
__device__ __forceinline__ void mout_item(unsigned char* ws, LAS unsigned char* lds, const float* gmh, const float* skip, int chunk0, int wave_u) {
    const int lane = fresh_lane(), tid = wave_u * 64 + lane;
    const int h = (chunk0 >> 5) & 3, b = chunk0 >> 7;
    const float* gm = (const float*)(ws + WS_GM);
#define MO_PTRS(ch) const int chunk = chunk0 + (ch); const int row0 = b * S_ + (chunk & 31) * 64; LAS unsigned char* cb_ = lds + (ch) * MO_STRIDE; \
    LAS bf16* QS = (LAS bf16*)cb_; LAS bf16* KS = QS + 64 * ML_LD; LAS bf16* VT = KS + 64 * ML_LD; LAS bf16* CP = VT + 64 * ML_LD; LAS bf16* SW = CP + 64 * ML_LD; \
    LAS float* HS = (LAS float*)(SW + 64 * ML_LD); LAS float* bs = HS + 64 * 65; LAS float* us = bs + 64; LAS float* ns = us + 64; LAS float* mts = ns + 64; LAS float* ints = mts + 64; LAS float* dinv = ints + 64; \
    (void)row0; (void)QS; (void)KS; (void)VT; (void)CP; (void)SW; (void)HS; (void)bs; (void)us; (void)ns; (void)mts; (void)ints; (void)dinv; (void)chunk;
    {
        v4u gq[2], gk[2], gv[2]; f32x4v gc0[2], gc1[2];
        const int l = tid >> 3, c0 = (tid & 7) * 8;
#pragma unroll
        for (int ch = 0; ch < 2; ++ch) { MO_PTRS(ch) const int row = row0 + l;
            gq[ch] = *(const v4u*)((const bf16*)(ws + WS_MQ) + (size_t)row * 256 + h * 64 + c0); gk[ch] = *(const v4u*)((const bf16*)(ws + WS_MK) + (size_t)row * 256 + h * 64 + c0);
            gv[ch] = *(const v4u*)((const bf16*)(ws + WS_CM) + (size_t)row * 768 + 256 + h * 64 + c0);
            const float* ct = (const float*)(ws + WS_CT) + (size_t)chunk * 4096 + l * 64 + c0;
            gc0[ch] = *(const f32x4v*)ct; gc1[ch] = *(const f32x4v*)(ct + 4); }
        asm volatile("" : "+v"(gq[0]), "+v"(gq[1]), "+v"(gk[0]), "+v"(gk[1]), "+v"(gv[0]), "+v"(gv[1]), "+v"(gc0[0]), "+v"(gc0[1]), "+v"(gc1[0]), "+v"(gc1[1]));
#pragma unroll
        for (int ch = 0; ch < 2; ++ch) { MO_PTRS(ch)
            *(LAS v4u*)(QS + l * ML_LD + c0) = gq[ch]; *(LAS v4u*)(KS + l * ML_LD + c0) = gk[ch];
            const v4u v4 = gv[ch];
            VT[(c0 + 0) * ML_LD + l] = (bf16)(v4.x & 0xffffu); VT[(c0 + 1) * ML_LD + l] = (bf16)(v4.x >> 16); VT[(c0 + 2) * ML_LD + l] = (bf16)(v4.y & 0xffffu); VT[(c0 + 3) * ML_LD + l] = (bf16)(v4.y >> 16);
            VT[(c0 + 4) * ML_LD + l] = (bf16)(v4.z & 0xffffu); VT[(c0 + 5) * ML_LD + l] = (bf16)(v4.z >> 16); VT[(c0 + 6) * ML_LD + l] = (bf16)(v4.w & 0xffffu); VT[(c0 + 7) * ML_LD + l] = (bf16)(v4.w >> 16);
            const f32x4v c0v = gc0[ch], c1v = gc1[ch];
            v4u cw; cw.x = cvtpk(c0v[0], c0v[1]); cw.y = cvtpk(c0v[2], c0v[3]); cw.z = cvtpk(c1v[0], c1v[1]); cw.w = cvtpk(c1v[2], c1v[3]);
            *(LAS v4u*)(CP + l * ML_LD + c0) = cw; }
    }
    if (wave_u < 2) { MO_PTRS(wave_u)
        const float ig = gm[(size_t)(row0 + lane) * 32 + 18 + h]; float lf = gm[(size_t)(row0 + lane) * 32 + 22 + h];
#pragma unroll
        for (int o = 1; o < 64; o <<= 1) { const float t = bperm(lf, lane - o); if (lane >= o) lf += t; }
        const float u = ig - lf; float cu = u;
#pragma unroll
        for (int o = 1; o < 64; o <<= 1) { const float t = bperm(cu, lane - o); if (lane >= o) cu = fmaxf(cu, t); }
        const float mprev = ((const float*)(ws + WS_MP))[chunk];
        const float mt = lf + fmaxf(mprev, cu);
        bs[lane] = lf; us[lane] = u; mts[lane] = mt; ints[lane] = __expf(lf + mprev - mt); ns[lane] = ((const float*)(ws + WS_NL))[chunk * 64 + lane];
    }
    __syncthreads();
#pragma unroll
    for (int ch = 0; ch < 2; ++ch) { MO_PTRS(ch)
#pragma unroll
        for (int i = 0; i < 2; ++i) { const int blk = wave_u * 2 + i, lb = blk >> 2, sb = blk & 3;
            f32x4v acc = f32x4v{};
            if (sb <= lb) acc = mm16(QS, ML_LD, 16 * lb, KS, ML_LD, 16 * sb, 64, lane, acc);
            const int sidx = 16 * sb + (lane & 15); const float usv = us[sidx];
#pragma unroll
            for (int r = 0; r < 4; ++r) { const int l = 16 * lb + 4 * (lane >> 4) + r;
                const float v = (sidx <= l) ? acc[r] * __expf(bs[l] + usv - mts[l]) : 0.f;
                SW[l * ML_LD + sidx] = f2bf(v); } }
    }
    __syncthreads();
    if (tid < 128) { MO_PTRS(tid >> 6)
        const int l = tid & 63; float qn = 0.f, ssum = 0.f;
        for (int d = 0; d < 64; ++d) { qn += bf2f(QS[l * ML_LD + d]) * ns[d]; ssum += bf2f(SW[l * ML_LD + d]); }
        const float den = ints[l] * qn + ssum;
        dinv[l] = 1.f / fmaxf(fabsf(den), __expf(-mts[l]));
    }
    f32x4v hq[2][2], hs2[2][2];
#pragma unroll
    for (int ch = 0; ch < 2; ++ch) { MO_PTRS(ch)
#pragma unroll
        for (int i = 0; i < 2; ++i) { const int blk = wave_u * 2 + i, lb = blk >> 2, eb = blk & 3;
            hq[ch][i] = mm16(QS, ML_LD, 16 * lb, CP, ML_LD, 16 * eb, 64, lane, f32x4v{});
            hs2[ch][i] = mm16(SW, ML_LD, 16 * lb, VT, ML_LD, 16 * eb, 16 * lb + 16 <= 32 ? 32 : 64, lane, f32x4v{}); }
    }
    __syncthreads();
#pragma unroll
    for (int ch = 0; ch < 2; ++ch) { MO_PTRS(ch)
#pragma unroll
        for (int i = 0; i < 2; ++i) { const int blk = wave_u * 2 + i, lb = blk >> 2, eb = blk & 3; const int e = 16 * eb + (lane & 15);
#pragma unroll
            for (int r = 0; r < 4; ++r) { const int l = 16 * lb + 4 * (lane >> 4) + r;
                const float og = bf2f(((const bf16*)(ws + WS_CM))[(size_t)(row0 + l) * 768 + 512 + h * 64 + e]);
                HS[l * 65 + e] = (ints[l] * hq[ch][i][r] + hs2[ch][i][r]) * dinv[l] / (1.f + __expf(-og)); } }
    }
    __syncthreads();
#pragma unroll
    for (int ch = 0; ch < 2; ++ch) { MO_PTRS(ch)
        const int l = tid >> 3, e0 = (tid & 7) * 8, row = row0 + l;
        float v[8]; float mu = 0.f;
#pragma unroll
        for (int i = 0; i < 8; ++i) { v[i] = HS[l * 65 + e0 + i]; mu += v[i]; }
        mu += sxf<1>(mu); mu += sxf<2>(mu); mu += sxf<4>(mu); mu *= (1.f / 64.f);
        float var = 0.f;
#pragma unroll
        for (int i = 0; i < 8; ++i) { const float dl = v[i] - mu; var += dl * dl; }
        var += sxf<1>(var); var += sxf<2>(var); var += sxf<4>(var);
        const float rs = rsqrtf(var * (1.f / 64.f) + EPS);
        const v4u x4 = *(const v4u*)((const bf16*)(ws + WS_XC) + (size_t)row * 256 + h * 64 + e0);
        float xv[8]; xv[0] = __uint_as_float(x4.x << 16); xv[1] = __uint_as_float(x4.x & 0xffff0000u); xv[2] = __uint_as_float(x4.y << 16); xv[3] = __uint_as_float(x4.y & 0xffff0000u);
        xv[4] = __uint_as_float(x4.z << 16); xv[5] = __uint_as_float(x4.z & 0xffff0000u); xv[6] = __uint_as_float(x4.w << 16); xv[7] = __uint_as_float(x4.w & 0xffff0000u);
        float r[8];
#pragma unroll
        for (int i = 0; i < 8; ++i) r[i] = (v[i] - mu) * rs * gmh[h * 64 + e0 + i] + skip[h * 64 + e0 + i] * xv[i];
        v4u w4; w4.x = cvtpk(r[0], r[1]); w4.y = cvtpk(r[2], r[3]); w4.z = cvtpk(r[4], r[5]); w4.w = cvtpk(r[6], r[7]);
        *(v4u*)((bf16*)(ws + WS_HB) + (size_t)row * D_ + 768 + h * 64 + e0) = w4;
    }
#undef MO_PTRS
    __syncthreads();
}

__global__ void __launch_bounds__(NTHR, 2) mega(MP p_unused) {
    extern __shared__ __attribute__((aligned(16))) unsigned char lds_raw[];
    LAS unsigned char* lds = (LAS unsigned char*)lds_raw;
    const int wave0 = __builtin_amdgcn_readfirstlane((int)threadIdx.x >> 6);
    const int tid0 = wave0 * 64 + fresh_lane();
    const int xcc = (int)(__builtin_amdgcn_s_getreg((3 << 11) | 20) & 7u);
    volatile LAS unsigned* MISC = (volatile LAS unsigned*)(lds + MISC_OFF);
    for (int u = tid0; u < (LDS_BYTES - RING_BYTES) / 4; u += NTHR) ((LAS unsigned*)(lds + RING_BYTES))[u] = 0u;
    __syncthreads();
    typedef const __attribute__((address_space(4))) MP* kmp_t;
    kmp_t kp0 = (kmp_t)__builtin_amdgcn_kernarg_segment_ptr();
    unsigned char* ws0 = kp0->ws; const int coop = kp0->coop, ph_lo = kp0->ph_lo, ph_hi = kp0->ph_hi;
    XcdBarrier bar; bar.bar = (unsigned*)(ws0 + WS_CTL) + CW_BAR; bar.x = 0; bar.st = nullptr;
    if (coop) bar = xcd_barrier_post((unsigned*)(ws0 + WS_CTL) + CW_BAR, MISC + 8, tid0);
    if (coop == 2) cooperative_groups::this_grid().sync();
    int ph = ph_lo;
    if (ph == 0) {
        const MPK p{kp0}; ph_p0(p, lds, wave0 * 64 + fresh_lane()); ph = 1;
        if (ph < ph_hi) xcd_barrier(bar, wave0 * 64 + fresh_lane());
    }
    bool second = false;
    for (; ph < ph_hi; ++ph) {
        kmp_t kp = kp0; asm volatile("" : "+s"(kp));
        const MPK p{kp}; unsigned char* ws = kp->ws;
#define TID_ (wave0 * 64 + fresh_lane())
#define GW_ (blockIdx.x * NWAVES + wave0)
#define NGW_ (gridDim.x * NWAVES)
        const int l = (ph - 1) / PPL, ty = (ph == 0) ? -1 : (ph == NPH - 1) ? -2 : (ph - 1) % PPL;
        const float* modl = (const float*)(ws + WS_MOD) + (size_t)l * 8 * 6144;
        if (ty == -2) { norm_rows<true, true>(ws + WS_HB, PIN(I_GFIN), nullptr, nullptr, nullptr, p.k->out, GW_, NGW_, fresh_lane());
            if (PROBE_SEL != 0 && blockIdx.x == 0 && TID_ == 0) { asm volatile("s_waitcnt vmcnt(0)" ::: "memory"); p.k->out[0] = ((const float*)(ws + WS_CTL))[100] * 0.001f; } }
        else if (ty == 0 && (PHM & 2)) ph_prep(p, l, lds, TID_);
        else if (ty == 1 && (PHM & 4)) {
            pg8::Gemm g{(const bf16*)(ws + WS_HB), (const bf16*)(ws + WT_IN), T_, 2560, D_}; pg8::StaticOrder S; S.init(T_, 2560, gridDim.x, blockIdx.x);
            pg8::EpiIn E{ws, PIN(I_BIG) + l * 4, PIN(I_BFG) + l * 4};
            pg8::gemm_phase<pg8::EpiIn, pg8::StaticOrder, true, true>(lds, g, S, E, wave0);
            late_transposes(p, l, lds, TID_, 640 % (int)gridDim.x);
        }
        else if (ty == 2 && (PHM & 64)) {
            { pg8::Gemm g{(const bf16*)(ws + WS_KVL), (const bf16*)(ws + WT_UKV), T_, 768, 128}; pg8::StaticOrder S; S.init(T_, 768, gridDim.x, blockIdx.x);
              pg8::EpiUKV E{(bf16*)(ws + WS_KVM), (const float*)(ws + WS_SSKV)}; pg8::gemm_phase<pg8::EpiUKV, pg8::StaticOrder, true, true>(lds, g, S, E, wave0); }
            { pg8::Gemm g{(const bf16*)(ws + WS_QL), (const bf16*)(ws + WT_UQ), T_, 768, 256}; pg8::StaticOrder S; S.init(T_, 768, gridDim.x, blockIdx.x);
              pg8::EpiPlain E{(bf16*)(ws + WS_OSLC), 768}; pg8::gemm_phase<pg8::EpiPlain, pg8::StaticOrder, true, true>(lds, g, S, E, wave0); }
            post_misc(ws, PIN(I_BIG) + l * 4, PIN(I_BFG) + l * 4, TID_);
            unsigned* ctrs = (unsigned*)(ws + WS_CTL) + 8192 + ph * 256 + (second ? 128 : 0); int ks = 0;
            for (;;) { const int it = next_item_q(ctrs, lds, wave0, 96, xcc, ks); if (it < 0) break; const int b = it >> 16, j = it & 0xffff;
                if (j < 64) mlocal_item(ws, lds, PIN(I_CONVW) + l * 1024, PIN(I_CONVB) + l * 256, PIN(I_BIG) + l * 4, PIN(I_BFG) + l * 4, b * 128 + 2 * j, wave0);
                else { const int k = j - 64; compress_item(ws, lds, PIN(I_CMPPOS) + l * 2048, ((k >> 4) << 7) | (b << 4) | (k & 15), wave0); } }
        }
        else if (ty == 3 && (PHM & 128)) {
            unsigned* ctrs = (unsigned*)(ws + WS_CTL) + 8192 + ph * 256 + (second ? 128 : 0); int ks = 0;
            for (;;) { const int it = next_item_q(ctrs, lds, wave0, second ? 64 : 100, xcc, ks); if (it < 0) break; const int b = it >> 16, j = it & 0xffff;
                if (second && (REP_MASK & (1 << 20)) && j >= 48) continue; if (second && (REP_MASK & (1 << 21)) && j < 48) continue;
                if (j < 18) mla_unit(ws, lds, b, j % 6, 7 - j / 6, wave0);
                else if (j < 34) cmp_unit(ws, lds, b, (j - 18) >> 3, 7 - ((j - 18) & 7), wave0);
                else if (j < 64) { const int u = j - 16; mla_unit(ws, lds, b, u % 6, 7 - u / 6, wave0); }
                else mscan_item(ws, b * 36 + (j - 64), wave0); }
        }
        else if (ty == 4 && (PHM & 256)) {
            unsigned* ctrs = (unsigned*)(ws + WS_CTL) + 8192 + ph * 256 + (second ? 128 : 0); int ks = 0;
            for (;;) { const int it = next_item_q(ctrs, lds, wave0, 160, xcc, ks); if (it < 0) break; const int b = it >> 16, j = it & 0xffff;
                if (second && (REP_MASK & (1 << 16)) && j >= 96) continue; if (second && (REP_MASK & (1 << 17)) && j < 96) continue;
                if (j < 36) nsa_branch_unit<AM_SLC>(ws, lds, b, j % 6, 7 - j / 6, wave0);
                else if (j < 84) nsa_branch_unit<AM_WINDOW>(ws, lds, b, (j - 36) % 6, 7 - (j - 36) / 6, wave0);
                else if (j < 96) { const int u = j - 48; nsa_branch_unit<AM_SLC>(ws, lds, b, u % 6, 7 - u / 6, wave0); }
                else mout_item(ws, lds, PIN(I_GMH) + l * 256, PIN(I_SKIP) + l * 256, b * 128 + 2 * (j - 96), wave0); }
        }
        else if (ty == 5) ph_mixnorm(p, l, TID_);
        else if (ty == 6 && (PHM & 8)) {
            pg8::Gemm g{(const bf16*)(ws + WS_HB), (const bf16*)(ws + WT_OUT), T_, D_, D_}; pg8::StaticOrder S; S.init(T_, D_, gridDim.x, blockIdx.x);
            pg8::EpiRes E{(l == 0) ? PIN(I_X) : nullptr, (const bf16*)p.k->out, (bf16*)p.k->out, modl + 2048};
            pg8::gemm_phase<pg8::EpiRes, pg8::StaticOrder, true, true>(lds, g, S, E, wave0);
        }
        else if (ty == 7) norm_rows<true>(p.k->out, PIN(I_GN2) + l * D_, modl + 3072, modl + 4096, (bf16*)(ws + WS_HB), nullptr, GW_, NGW_, fresh_lane());
        else if (ty == 8 && (PHM & 16)) {
            pg8::Gemm g{(const bf16*)(ws + WS_HB), (const bf16*)(ws + WT_GU), T_, 2 * FF, D_}; pg8::StaticOrder S; S.init(T_, 2 * FF, gridDim.x, blockIdx.x);
            pg8::EpiGU E{(bf16*)(ws + WS_ACT)};
            pg8::gemm_phase<pg8::EpiGU, pg8::StaticOrder, true, true>(lds, g, S, E, wave0);
            if (l + 1 < DEPTH) early_transposes(p, l + 1, lds, TID_, 1408 % (int)gridDim.x);
        }
        else if (ty == 9 && (PHM & 32)) {
            pg8::Gemm g{(const bf16*)(ws + WS_ACT), (const bf16*)(ws + WT_DOWN), T_, D_, FF}; pg8::StaticOrder S; S.init(T_, D_, gridDim.x, blockIdx.x);
            pg8::EpiRes E{nullptr, (const bf16*)p.k->out, (l == DEPTH - 1) ? (bf16*)(ws + WS_HB) : (bf16*)p.k->out, modl + 5120};
            pg8::gemm_phase<pg8::EpiRes, pg8::StaticOrder, true, true>(lds, g, S, E, wave0);
        }
        if (REP_MASK != 0 && ty >= 0 && ((REP_MASK >> ty) & 1) && !second) { second = true; --ph; } else second = false;
        if (ph + 1 < ph_hi) xcd_barrier(bar, wave0 * 64 + fresh_lane());
    }
}

extern "C" void kernel_launch(void* const* d_in, const int* in_sizes, int n_in, void* d_out, int out_size, void* d_ws, size_t ws_size, hipStream_t stream) {
    if (n_in != N_IN || ws_size < WS_END) { fprintf(stderr, "kernel_launch: unexpected n_in %d / ws %zu\n", n_in, ws_size); return; }
    static int inited = 0;
    if (!inited) { if (hipFuncSetAttribute((const void*)mega, hipFuncAttributeMaxDynamicSharedMemorySize, LDS_BYTES) != hipSuccess) fprintf(stderr, "hipFuncSetAttribute failed\n"); inited = 1; }
    unsigned char* ws = (unsigned char*)d_ws;
    MP base{}; for (int i = 0; i < N_IN; ++i) base.in[i] = (const float*)d_in[i]; base.out = (float*)d_out; base.ws = ws;
    (void)hipMemsetAsync(ws + WS_CTL, 0, CTL_ZERO_BYTES, stream);
    static int grid = 0;
    if (!grid) {
        int dev = 0, cus = 0, per_cu = 0;
        (void)hipGetDevice(&dev); (void)hipDeviceGetAttribute(&cus, hipDeviceAttributeMultiprocessorCount, dev);
        if (hipOccupancyMaxActiveBlocksPerMultiprocessor(&per_cu, (const void*)mega, NTHR, LDS_BYTES) != hipSuccess || per_cu < 1) { fprintf(stderr, "kernel_launch: occupancy query says %d blocks per CU\n", per_cu); per_cu = 1; }
        (void)hipGetLastError();
        grid = cus;
    }
    MP a = base; a.ph_lo = 0; a.ph_hi = NPH; a.coop = 1;
    void* args[] = {&a};
    const hipError_t e = hipLaunchCooperativeKernel((const void*)mega, dim3(grid), dim3(NTHR), args, LDS_BYTES, stream);
    if (e != hipSuccess) fprintf(stderr, "kernel_launch: cooperative launch failed: %s (grid %d)\n", hipGetErrorString(e), grid);
}
```

```cpp
#include <hip/hip_runtime.h>
#include <cstdint>
#include <cstdio>
#include <type_traits>
#include <hip/hip_cooperative_groups.h>

constexpr int B_ = 8, S_ = 2048, T_ = B_ * S_, D_ = 1024, DIN = 2362, FF = 2816, DEPTH = 2;
constexpr float EPS = 1e-6f;
constexpr float LOG2E = 1.4426950408889634f;
constexpr float QSCALE = 0.125f * LOG2E;
constexpr float MSCALE = 0.10206207261596577f * LOG2E;
enum { I_X = 0, I_C, I_POS, I_GN1, I_GN2, I_WADA, I_BADA, I_WIN, I_CMPPOS, I_WCK, I_WCV, I_GOA, I_GQL, I_WUQ, I_GKVL, I_WUKV, I_GOB,
       I_CONVW, I_CONVB, I_WQM, I_WKM, I_BIG, I_BFG, I_GMH, I_SKIP, I_WOUT, I_WGU, I_WDOWN, I_GFIN, N_IN };

constexpr size_t MiB = 1u << 20;
constexpr size_t WS_CTL = 0;
constexpr size_t WS_MOD = 1 * MiB;
constexpr size_t WS_COSP = WS_MOD + 512 * 1024;
constexpr size_t WS_SINP = WS_COSP + 512 * 1024;
constexpr size_t WS_COSM = WS_SINP + 512 * 1024;
constexpr size_t WS_SINM = WS_COSM + 1 * MiB;
constexpr size_t WS_SSQL = WS_SINM + 1 * MiB;
constexpr size_t WS_SSKV = WS_SSQL + 64 * 1024;
constexpr size_t WS_ML = WS_SSKV + 64 * 1024;
constexpr size_t WS_BL = WS_ML + 4096;
constexpr size_t WS_MP = WS_BL + 4096;
constexpr size_t WS_NL = WS_MP + 4096;
constexpr size_t WS_WT = 8 * MiB;
constexpr size_t WS_RAW = WS_WT;
constexpr size_t WS_HB = 34 * MiB;
constexpr size_t WS_NSA = 66 * MiB;
constexpr size_t WS_KVL = 102 * MiB;
constexpr size_t WS_QL = 106 * MiB;
constexpr size_t WS_CM = 114 * MiB;
constexpr size_t WS_GM = 138 * MiB;
constexpr size_t WS_KM = 140 * MiB;
constexpr size_t WS_QM = 158 * MiB;
constexpr size_t WS_VM = 176 * MiB;
constexpr size_t WS_KCV = 188 * MiB;
constexpr size_t WS_OCMP = 189 * MiB;
constexpr size_t WS_SEL = 201 * MiB;
constexpr size_t WS_XC = 202 * MiB;
constexpr size_t WS_MQ = 210 * MiB;
constexpr size_t WS_MK = 218 * MiB;
constexpr size_t WS_CT = 226 * MiB;
constexpr size_t WS_MISCRAW = 242 * MiB;
constexpr size_t WS_KVM = 140 * MiB;
constexpr size_t WS_KR = 246 * MiB;
constexpr size_t WS_OSLC = 164 * MiB;
constexpr size_t WS_OWIN = 176 * MiB;
constexpr size_t WS_ACT = 66 * MiB;
constexpr size_t WS_END = 256 * MiB;
static_assert(WS_NL + 1024 * 64 * 4 <= WS_WT, "tab");
static_assert(WS_ACT + (size_t)T_ * FF * 2 <= WS_KCV, "act overlay");

typedef unsigned short bf16;
__device__ __forceinline__ float bf2f(bf16 v) { return __uint_as_float(((unsigned)v) << 16); }
__device__ __forceinline__ bf16 f2bf(float f) { unsigned u = __float_as_uint(f); return (bf16)((u + 0x7fffu + ((u >> 16) & 1u)) >> 16); }
__device__ __forceinline__ float sigmoidf_(float x) { return 1.f / (1.f + __expf(-x)); }
__device__ __forceinline__ float siluf_(float x) { return x / (1.f + __expf(-x)); }
__device__ __forceinline__ float wave_sum(float v) {
#pragma unroll
    for (int o = 1; o < 64; o <<= 1) v += __shfl_xor(v, o);
    return v;
}

__device__ __forceinline__ int fresh_lane() { int l; asm volatile("v_mbcnt_lo_u32_b32 %0, -1, 0\n\tv_mbcnt_hi_u32_b32 %0, -1, %0" : "=&v"(l)); return l; }
template <int M> __device__ __forceinline__ float sxf(float v) { static_assert(M >= 1 && M < 32, "swizzle xor mask"); return __int_as_float(__builtin_amdgcn_ds_swizzle(__float_as_int(v), (M << 10) | 0x1f)); }
__device__ __forceinline__ float red32_max(float v) { auto r = __builtin_amdgcn_permlane32_swap(__float_as_uint(v), __float_as_uint(v), false, false); return fmaxf(__uint_as_float(r[0]), __uint_as_float(r[1])); }
__device__ __forceinline__ float red32_sum(float v) { auto r = __builtin_amdgcn_permlane32_swap(__float_as_uint(v), __float_as_uint(v), false, false); return __uint_as_float(r[0]) + __uint_as_float(r[1]); }
__device__ __forceinline__ unsigned red32_or(unsigned v) { auto r = __builtin_amdgcn_permlane32_swap(v, v, false, false); return r[0] | r[1]; }
__device__ __forceinline__ float bperm(float v, int src_lane) { return __int_as_float(__builtin_amdgcn_ds_bpermute(src_lane << 2, __float_as_int(v))); }
__device__ __forceinline__ float wave_sum2(float v) { v += sxf<1>(v); v += sxf<2>(v); v += sxf<4>(v); v += sxf<8>(v); v += sxf<16>(v); return red32_sum(v); }
__device__ __forceinline__ float wave_max2(float v) { v = fmaxf(v, sxf<1>(v)); v = fmaxf(v, sxf<2>(v)); v = fmaxf(v, sxf<4>(v)); v = fmaxf(v, sxf<8>(v)); v = fmaxf(v, sxf<16>(v)); return red32_max(v); }
namespace pg8 {
#define PG8_LAS __attribute__((address_space(3)))
typedef unsigned short bf16_t;
typedef short bf16x8 __attribute__((ext_vector_type(8)));
typedef float f32x4 __attribute__((ext_vector_type(4)));
typedef unsigned u32x4 __attribute__((ext_vector_type(4)));
constexpr int BM = 256, BK = 64, HALF = 128, HTB = HALF * BK * 2  , STAGE_BYTES = 8 * HTB, NXCD = 8, WGM = 8;

__host__ __device__ __forceinline__ int lds_byte(int r, int c) { const int st = (r >> 4) * 2 + (c >> 5), rr = r & 15, cc = c & 31, ob = rr * 64 + cc * 2; return st * 1024 + (ob ^ (((ob >> 9) & 1) << 5)); }
__host__ __device__ __forceinline__ void stage_rc(int b, int& R, int& C) { const int st = b / 1024, sb = b % 1024, swz = sb ^ (((sb >> 9) & 1) << 5); R = (st >> 1) * 16 + swz / 64; C = (st & 1) * 32 + (swz % 64) / 2; }
__host__ __device__ __forceinline__ int perm32(int rho) { const int n = rho >> 4, i = rho & 15; return 8 * (i >> 2) + 4 * n + (i & 3); }

struct Unit { int pm, pn; };
struct Gemm { const bf16_t* A; const bf16_t* Bt; int M, N, K; };

struct StaticOrder {
    int nM, nN, nwg, G, c;
    __host__ __device__ void init(int M, int N, int G_, int c_) { nM = M / BM; nN = N / BM; nwg = nM * nN; G = G_; c = c_; }
    __host__ __device__ bool next(int i, Unit& u) const {
        const long L = (long)i * G + c; if (L >= nwg) return false;
        int wgid = (int)L; { const int q = nwg / NXCD, r = nwg % NXCD, xcd = wgid % NXCD, off = wgid / NXCD; wgid = (xcd < r ? xcd * (q + 1) : r * (q + 1) + (xcd - r) * q) + off; }
        const int nig = WGM * nN, gid = wgid / nig, fm = gid * WGM, gsz = (nM - fm) < WGM ? (nM - fm) : WGM;
        u.pm = fm + ((wgid % nig) % gsz); u.pn = (wgid % nig) / gsz; return true;
    }
    __device__ __forceinline__ void a_ready(const Unit&) const {}
    __device__ __forceinline__ void done(const Unit&) const {}
};

__device__ __forceinline__ unsigned cvt_pk_bf16(float lo, float hi) { unsigned r; asm volatile("v_cvt_pk_bf16_f32 %0, %1, %2" : "=v"(r) : "v"(lo), "v"(hi)); return r; }
typedef float f32x2 __attribute__((ext_vector_type(2)));

typedef unsigned u32x4 __attribute__((ext_vector_type(4)));
typedef unsigned u32x2 __attribute__((ext_vector_type(2)));
struct EpiIn {
    static constexpr bool PERM = true, AFTER_DRAIN = false;
    unsigned char* ws; const float *big, *bfg;
#define EPI_ROWS(...) _Pragma("unroll") for (int ai = 0; ai < 2; ++ai) _Pragma("unroll") for (int m = 0; m < 4; ++m) { \
        const int row = u.pm * BM + ai * HALF + wr * 64 + m * 16 + fr; float v[8]; \
        _Pragma("unroll") for (int i = 0; i < 4; ++i) { v[i] = acc[ai][bj][m][0][i]; v[4 + i] = acc[ai][bj][m][1][i]; } \
        asm volatile("" : "+v"(v[0]), "+v"(v[1]), "+v"(v[2]), "+v"(v[3]), "+v"(v[4]), "+v"(v[5]), "+v"(v[6]), "+v"(v[7])); \
        __VA_ARGS__ asm volatile("" ::: "memory"); }
#define EPI_PACK(w) u32x4 w; w.x = cvt_pk_bf16(v[0], v[1]); w.y = cvt_pk_bf16(v[2], v[3]); w.z = cvt_pk_bf16(v[4], v[5]); w.w = cvt_pk_bf16(v[6], v[7]);
    __device__ __forceinline__ void operator()(const f32x4 (&acc)[2][2][4][2], const Unit& u, int wr, int wc, int fr, int fq) const {
        half<0>(acc, u, wr, wc, fr, fq); half<1>(acc, u, wr, wc, fr, fq);
    }
    template <int bj> __device__ __forceinline__ void half(const f32x4 (&acc)[2][2][4][2], const Unit& u, int wr, int wc, int fr, int fq) const {
        {
            const int hb = 2 * u.pn + bj;
            int cb = 32 * wc + 8 * fq; asm volatile("" : "+v"(cb), "+v"(fr));
            if (hb <= 8) {
                bf16_t* nsa = (bf16_t*)(ws + WS_NSA) + hb * 128 + cb;
                const bool rope_hb = (hb <= 3) || hb == 5 || hb == 7;
                if (rope_hb) {
                    const float* cosP = (const float*)(ws + WS_COSP); const float* sinP = (const float*)(ws + WS_SINP);
                    const bool mine = ((wc & 1) == 0) && fq < 2; const float sg = (fq == 0) ? -1.f : 1.f; const float sc = (hb < 3) ? QSCALE : 1.f;
                    f32x4 tc0 = {0.f, 0.f, 0.f, 0.f}, tc1 = tc0, ts0 = tc0, ts1 = tc0;
                    if (mine) { const int r0 = u.pm * BM + wr * 64 + fr; tc0 = *(const f32x4*)(cosP + r0 * 8); tc1 = *(const f32x4*)(cosP + r0 * 8 + 4); ts0 = *(const f32x4*)(sinP + r0 * 8); ts1 = *(const f32x4*)(sinP + r0 * 8 + 4); }
                    EPI_ROWS({
                        float pv[8];
                        _Pragma("unroll") for (int i = 0; i < 8; ++i) pv[i] = sxf<16>(v[i]);
                        const f32x4 c0 = tc0, c1 = tc1, s0 = ts0, s1 = ts1;
                        if (mine && (ai * 4 + m) < 7) { const int nx = ai * 4 + m + 1; const int rn = u.pm * BM + (nx >> 2) * HALF + wr * 64 + (nx & 3) * 16 + fr;
                            tc0 = *(const f32x4*)(cosP + rn * 8); tc1 = *(const f32x4*)(cosP + rn * 8 + 4); ts0 = *(const f32x4*)(sinP + rn * 8); ts1 = *(const f32x4*)(sinP + rn * 8 + 4); }
                        if (mine) {
                            _Pragma("unroll") for (int i = 0; i < 4; ++i) { v[i] = v[i] * c0[i] + sg * pv[i] * s0[i]; v[4 + i] = v[4 + i] * c1[i] + sg * pv[4 + i] * s1[i]; }
                        }
                        _Pragma("unroll") for (int i = 0; i < 8; ++i) v[i] *= sc;
                        EPI_PACK(w) *(u32x4*)(nsa + (size_t)row * 1152) = w;
                    })
                } else {
                    EPI_ROWS({ EPI_PACK(w) *(u32x4*)(nsa + (size_t)row * 1152) = w; })
                }
            } else if (hb <= 11) {
                bf16_t* dst = (hb == 9) ? (bf16_t*)(ws + WS_KVL) + cb : (bf16_t*)(ws + WS_QL) + (hb - 10) * 128 + cb;
                const int ld = (hb == 9) ? 128 : 256;
                float* ssq = (hb == 9) ? (float*)(ws + WS_SSKV) : (float*)(ws + WS_SSQL);
                EPI_ROWS({ EPI_PACK(w) *(u32x4*)(dst + (size_t)row * ld) = w;
                    float sq = 0.f;
                    _Pragma("unroll") for (int i = 0; i < 8; ++i) sq += v[i] * v[i];
                    sq += sxf<16>(sq); sq = red32_sum(sq);
                    if (fq == 0) atomicAdd(ssq + row, sq); })
            } else if (hb <= 17) {
                bf16_t* cm = (bf16_t*)(ws + WS_CM) + (hb - 12) * 128 + cb;
                EPI_ROWS({ EPI_PACK(w) *(u32x4*)(cm + (size_t)row * 768) = w; })
            } else if (hb == 18) {
                float* mr = (float*)(ws + WS_MISCRAW) + cb;
                if (wc < 2) { EPI_ROWS({ *(f32x4*)(mr + (size_t)row * 64) = (f32x4){v[0], v[1], v[2], v[3]}; *(f32x4*)(mr + (size_t)row * 64 + 4) = (f32x4){v[4], v[5], v[6], v[7]}; }) }
            }
        }
    }
#undef EPI_ROWS
#undef EPI_PACK
};
struct EpiUKV {
    static constexpr bool PERM = true, AFTER_DRAIN = false;
    bf16_t* kvm; const float* sskv;
    __device__ __forceinline__ void operator()(const f32x4 (&acc)[2][2][4][2], const Unit& u, int wr, int wc, int fr, int fq) const {
        asm volatile("" : "+v"(fq), "+v"(fr));
        const int col0 = u.pn * BM + wc * 32 + 8 * fq;
        float rs8[8];
#pragma unroll
        for (int i = 0; i < 8; ++i) rs8[i] = sskv[u.pm * BM + (i >> 2) * HALF + wr * 64 + (i & 3) * 16 + fr];
#pragma unroll
        for (int i = 0; i < 8; ++i) rs8[i] = rsqrtf(rs8[i] * (1.f / 128.f) + EPS);
#pragma unroll
        for (int ai = 0; ai < 2; ++ai)
#pragma unroll
            for (int m = 0; m < 4; ++m) { const int row = u.pm * BM + ai * HALF + wr * 64 + m * 16 + fr; bf16_t* rowp = kvm + (size_t)row * 768 + col0;
                const float rs = rs8[ai * 4 + m];
#pragma unroll
                for (int bj = 0; bj < 2; ++bj) { const f32x4 a = acc[ai][bj][m][0] * rs, b = acc[ai][bj][m][1] * rs;
                    u32x4 w; w.x = cvt_pk_bf16(a[0], a[1]); w.y = cvt_pk_bf16(a[2], a[3]); w.z = cvt_pk_bf16(b[0], b[1]); w.w = cvt_pk_bf16(b[2], b[3]);
                    *(u32x4*)(rowp + bj * HALF) = w; } }
    }
};
struct EpiPlain {
    static constexpr bool PERM = true, AFTER_DRAIN = false;
    bf16_t* out; int ld;
    __device__ __forceinline__ void operator()(const f32x4 (&acc)[2][2][4][2], const Unit& u, int wr, int wc, int fr, int fq) const {
        asm volatile("" : "+v"(fq), "+v"(fr));
        const int col0 = u.pn * BM + wc * 32 + 8 * fq;
#pragma unroll
        for (int ai = 0; ai < 2; ++ai)
#pragma unroll
            for (int m = 0; m < 4; ++m) { bf16_t* rowp = out + (size_t)(u.pm * BM + ai * HALF + wr * 64 + m * 16 + fr) * ld + col0;
#pragma unroll
                for (int bj = 0; bj < 2; ++bj) { const f32x4 a = acc[ai][bj][m][0], b = acc[ai][bj][m][1];
                    u32x4 w; w.x = cvt_pk_bf16(a[0], a[1]); w.y = cvt_pk_bf16(a[2], a[3]); w.z = cvt_pk_bf16(b[0], b[1]); w.w = cvt_pk_bf16(b[2], b[3]);
                    *(u32x4*)(rowp + bj * HALF) = w; } }
    }
};
struct EpiRes {
    static constexpr bool PERM = true, AFTER_DRAIN = false;
    const float* xin_f; const bf16_t* xin_b; bf16_t* xout; const float* gate;
    __device__ __forceinline__ void operator()(const f32x4 (&acc)[2][2][4][2], const Unit& u, int wr, int wc, int fr, int fq) const {
        asm volatile("" : "+v"(fq), "+v"(fr));
        const int b = (u.pm * BM) / S_; const int col0 = u.pn * BM + wc * 32 + 8 * fq;
        f32x4 gv[2][2];
#pragma unroll
        for (int bj = 0; bj < 2; ++bj)
#pragma unroll
            for (int n = 0; n < 2; ++n) gv[bj][n] = *(const f32x4*)(gate + (size_t)b * 6144 + col0 + bj * HALF + n * 4);
        if (xin_f != nullptr) {
#pragma unroll
            for (int ai = 0; ai < 2; ++ai)
#pragma unroll
                for (int m = 0; m < 4; ++m) { const size_t off = (size_t)(u.pm * BM + ai * HALF + wr * 64 + m * 16 + fr) * D_ + col0;
#pragma unroll
                    for (int bj = 0; bj < 2; ++bj) { const f32x4 x0 = *(const f32x4*)(xin_f + off + bj * HALF), x1 = *(const f32x4*)(xin_f + off + bj * HALF + 4);
                        const f32x4 r0 = x0 + gv[bj][0] * acc[ai][bj][m][0], r1 = x1 + gv[bj][1] * acc[ai][bj][m][1];
                        u32x4 w; w.x = cvt_pk_bf16(r0[0], r0[1]); w.y = cvt_pk_bf16(r0[2], r0[3]); w.z = cvt_pk_bf16(r1[0], r1[1]); w.w = cvt_pk_bf16(r1[2], r1[3]);
                        *(u32x4*)(xout + off + bj * HALF) = w; } }
        } else {
#pragma unroll
            for (int ai = 0; ai < 2; ++ai)
#pragma unroll
                for (int m = 0; m < 4; ++m) { const size_t off = (size_t)(u.pm * BM + ai * HALF + wr * 64 + m * 16 + fr) * D_ + col0;
                    u32x4 xr[2];
#pragma unroll
                    for (int bj = 0; bj < 2; ++bj) xr[bj] = *(const u32x4*)(xin_b + off + bj * HALF);
#pragma unroll
                    for (int bj = 0; bj < 2; ++bj) { const u32x4 q = xr[bj]; const f32x4 a0 = acc[ai][bj][m][0], a1 = acc[ai][bj][m][1], g0 = gv[bj][0], g1 = gv[bj][1];
                        const float r0 = __uint_as_float(q.x << 16) + g0[0] * a0[0], r1 = __uint_as_float(q.x & 0xffff0000u) + g0[1] * a0[1];
                        const float r2 = __uint_as_float(q.y << 16) + g0[2] * a0[2], r3 = __uint_as_float(q.y & 0xffff0000u) + g0[3] * a0[3];
                        const float r4 = __uint_as_float(q.z << 16) + g1[0] * a1[0], r5 = __uint_as_float(q.z & 0xffff0000u) + g1[1] * a1[1];
                        const float r6 = __uint_as_float(q.w << 16) + g1[2] * a1[2], r7 = __uint_as_float(q.w & 0xffff0000u) + g1[3] * a1[3];
                        u32x4 w; w.x = cvt_pk_bf16(r0, r1); w.y = cvt_pk_bf16(r2, r3); w.z = cvt_pk_bf16(r4, r5); w.w = cvt_pk_bf16(r6, r7);
                        *(u32x4*)(xout + off + bj * HALF) = w; } }
        }
    }
};
struct EpiGU {
    static constexpr bool PERM = true, AFTER_DRAIN = false;
    bf16_t* act;
    __device__ __forceinline__ void operator()(const f32x4 (&acc)[2][2][4][2], const Unit& u, int wr, int wc, int fr, int fq) const {
        asm volatile("" : "+v"(fq), "+v"(fr));
        const int col0 = u.pn * HALF + wc * 32 + 8 * fq;
#pragma unroll
        for (int ai = 0; ai < 2; ++ai)
#pragma unroll
            for (int m = 0; m < 4; ++m) { const int row = u.pm * BM + ai * HALF + wr * 64 + m * 16 + fr; float o[8];
#pragma unroll
                for (int n = 0; n < 2; ++n)
#pragma unroll
                    for (int i = 0; i < 4; ++i) { const float g = acc[ai][0][m][n][i], up = acc[ai][1][m][n][i]; o[4 * n + i] = g / (1.f + __expf(-g)) * up; }
                u32x4 w; w.x = cvt_pk_bf16(o[0], o[1]); w.y = cvt_pk_bf16(o[2], o[3]); w.z = cvt_pk_bf16(o[4], o[5]); w.w = cvt_pk_bf16(o[6], o[7]);
                *(u32x4*)(act + (size_t)row * FF + col0) = w; }
    }
};
template <class Epi, class Sched, bool ALIGN_EPI = false, bool SP2 = false>
__device__ __forceinline__ void gemm_phase(PG8_LAS unsigned char* lds, const Gemm g, const Sched& S, const Epi& E, int wid_in) {
    const int wid = __builtin_amdgcn_readfirstlane(wid_in), lane = fresh_lane(), tid = wid * 64 + lane, wr = wid >> 2, wc = wid & 3;
    const int K = g.K, nt = K / BK;
    unsigned voffA[2], voffB[2];
#pragma unroll
    for (int i = 0; i < 2; ++i) { int R, C; stage_rc(tid * 16 + i * 8192, R, C); const int Rb = Epi::PERM ? ((R & ~31) + perm32(R & 31)) : R;
        voffA[i] = (unsigned)(R * K + C) * 2u; voffB[i] = (unsigned)(Rb * K + C) * 2u; }
    const size_t kstep = (size_t)(BK * 2);
    const size_t hstep = (size_t)HALF * K * 2;
    const size_t tstep = 2 * hstep;
    const unsigned ldsw = (unsigned)wid * 1024u;
    const int aoff = lds_byte(wr * 64 + (lane & 15), (lane >> 4) * 8), boff = lds_byte(wc * 32 + (lane & 15), (lane >> 4) * 8);
#define PG8_SA(b, h) (((b) * 2 + (h)) * HTB)
#define PG8_SB(b, h) ((4 + (b) * 2 + (h)) * HTB)
#define PG8_STAGE(bufoff, gbase, voff) do { _Pragma("unroll") for (int _i = 0; _i < 2; ++_i) \
        __builtin_amdgcn_global_load_lds((const unsigned*)((const char*)(gbase) + (voff)[_i]), (PG8_LAS unsigned*)(lds + (bufoff) + ldsw + _i * 8192), 16, 0, 0); } while (0)
#define PG8_LDA(dst, b, h) do { _Pragma("unroll") for (int m = 0; m < 4; ++m) _Pragma("unroll") for (int k = 0; k < 2; ++k) dst[m][k] = *(const PG8_LAS bf16x8*)(lds + PG8_SA(b, h) + aoff + m * 2048 + k * 1024); } while (0)
#define PG8_LDB(dst, b, h) do { _Pragma("unroll") for (int n = 0; n < 2; ++n) _Pragma("unroll") for (int k = 0; k < 2; ++k) dst[n][k] = *(const PG8_LAS bf16x8*)(lds + PG8_SB(b, h) + boff + n * 2048 + k * 1024); } while (0)
#define PG8_MMA(ai, bj, At, Bt) do { __builtin_amdgcn_s_setprio(1); _Pragma("unroll") for (int m = 0; m < 4; ++m) _Pragma("unroll") for (int n = 0; n < 2; ++n) _Pragma("unroll") for (int k = 0; k < 2; ++k) \
        acc[ai][bj][m][n] = __builtin_amdgcn_mfma_f32_16x16x32_bf16(Bt[n][k], At[m][k], acc[ai][bj][m][n], 0, 0, 0); __builtin_amdgcn_s_setprio(0); } while (0)
#define PG8_WAIT_V(n) asm volatile("s_waitcnt vmcnt(" #n ")" ::: "memory")
#define PG8_WAIT_L(n) asm volatile("s_waitcnt lgkmcnt(" #n ")" ::: "memory")
#define PG8_BAR __builtin_amdgcn_s_barrier()
#define PG8_SCHED __builtin_amdgcn_sched_barrier(0)
    Unit cur, nxt; int ui = 0;
    if (!S.next(0, cur)) return;
    f32x4 acc[2][2][4][2];
#pragma unroll
    for (int a = 0; a < 2; ++a)
#pragma unroll
        for (int b = 0; b < 2; ++b)
#pragma unroll
            for (int m = 0; m < 4; ++m)
#pragma unroll
                for (int n = 0; n < 2; ++n) acc[a][b][m][n] = (f32x4){0.f, 0.f, 0.f, 0.f};
    bf16x8 At[4][2], B0[2][2], B1[2][2];
    const char* cA = (const char*)g.A + (size_t)cur.pm * tstep; const char* cB = (const char*)g.Bt + (size_t)cur.pn * tstep;
    S.a_ready(cur);
    if constexpr (SP2) {
        PG8_STAGE(PG8_SB(0, 0), cB, voffB); PG8_STAGE(PG8_SB(0, 1), cB + hstep, voffB); PG8_STAGE(PG8_SA(0, 0), cA, voffA); PG8_STAGE(PG8_SA(0, 1), cA + hstep, voffA);
        if (wr == 1) PG8_BAR;
        PG8_WAIT_V(2); PG8_BAR;
        PG8_STAGE(PG8_SB(1, 0), cB + kstep, voffB); PG8_STAGE(PG8_SA(1, 0), cA + kstep, voffA); PG8_STAGE(PG8_SB(1, 1), cB + hstep + kstep, voffB);
        PG8_WAIT_V(6); PG8_BAR;
    } else {
        PG8_STAGE(PG8_SB(0, 0), cB, voffB); PG8_STAGE(PG8_SA(0, 0), cA, voffA); PG8_STAGE(PG8_SB(0, 1), cB + hstep, voffB); PG8_STAGE(PG8_SA(0, 1), cA + hstep, voffA);
        if (wr == 1) PG8_BAR;
        PG8_WAIT_V(4); PG8_BAR;
        PG8_STAGE(PG8_SB(1, 0), cB + kstep, voffB); PG8_STAGE(PG8_SA(1, 0), cA + kstep, voffA); PG8_STAGE(PG8_SB(1, 1), cB + hstep + kstep, voffB);
        PG8_WAIT_V(6); PG8_BAR;
    }
    for (;;) {
        const bool has_next = S.next(ui + 1, nxt);
        const char* nA = has_next ? (const char*)g.A + (size_t)nxt.pm * tstep : cA; const char* nB = has_next ? (const char*)g.Bt + (size_t)nxt.pn * tstep : cB;
        for (int t = 0; t < nt; t += 2) {
            const bool last = (t == nt - 2);
            const char* a1 = cA + (size_t)(t + 1) * kstep;
            const char* a2 = last ? nA : cA + (size_t)(t + 2) * kstep; const char* b2 = last ? nB : cB + (size_t)(t + 2) * kstep;
            const char* a3 = a2 + kstep; const char* b3 = b2 + kstep;
            if (last && has_next) S.a_ready(nxt);
            if constexpr (SP2) {
            PG8_LDB(B0, 0, 0); PG8_LDB(B1, 0, 1); PG8_SCHED; PG8_LDA(At, 0, 0); PG8_STAGE(PG8_SA(1, 1), a1 + hstep, voffA);
            PG8_WAIT_V(8); PG8_WAIT_L(0); PG8_BAR; PG8_MMA(0, 0, At, B0); PG8_MMA(0, 1, At, B1); PG8_BAR; PG8_SCHED;
            PG8_LDA(At, 0, 1); PG8_STAGE(PG8_SB(0, 0), b2, voffB); PG8_STAGE(PG8_SB(0, 1), b2 + hstep, voffB); PG8_STAGE(PG8_SA(0, 0), a2, voffA);
            PG8_WAIT_V(8); PG8_WAIT_L(0); PG8_BAR; PG8_MMA(1, 0, At, B0); PG8_MMA(1, 1, At, B1); PG8_BAR; PG8_SCHED;
            PG8_LDB(B0, 1, 0); PG8_LDB(B1, 1, 1); PG8_SCHED; PG8_LDA(At, 1, 0); PG8_STAGE(PG8_SA(0, 1), a2 + hstep, voffA);
            PG8_WAIT_V(8); PG8_WAIT_L(0); PG8_BAR; PG8_MMA(0, 0, At, B0); PG8_MMA(0, 1, At, B1); PG8_BAR; PG8_SCHED;
            PG8_LDA(At, 1, 1); PG8_STAGE(PG8_SB(1, 0), b3, voffB); PG8_STAGE(PG8_SB(1, 1), b3 + hstep, voffB); PG8_STAGE(PG8_SA(1, 0), a3, voffA);
            PG8_WAIT_V(8); PG8_WAIT_L(0); PG8_BAR; PG8_MMA(1, 0, At, B0); PG8_MMA(1, 1, At, B1); PG8_BAR; PG8_SCHED;
            } else {
            PG8_LDB(B0, 0, 0); PG8_SCHED; PG8_LDA(At, 0, 0); PG8_STAGE(PG8_SA(1, 1), a1 + hstep, voffA);
            PG8_WAIT_L(8); PG8_BAR; PG8_WAIT_L(0); PG8_MMA(0, 0, At, B0); PG8_BAR; PG8_SCHED;
            PG8_LDB(B1, 0, 1); PG8_STAGE(PG8_SB(0, 0), b2, voffB);
            PG8_BAR; PG8_WAIT_L(0); PG8_MMA(0, 1, At, B1); PG8_BAR;
            PG8_LDA(At, 0, 1); PG8_STAGE(PG8_SA(0, 0), a2, voffA);
            PG8_BAR; PG8_WAIT_L(0); PG8_MMA(1, 0, At, B0); PG8_BAR; PG8_SCHED;
            PG8_STAGE(PG8_SB(0, 1), b2 + hstep, voffB);
            PG8_WAIT_V(6); PG8_BAR; PG8_MMA(1, 1, At, B1); PG8_BAR;
            PG8_LDB(B0, 1, 0); PG8_SCHED; PG8_LDA(At, 1, 0); PG8_STAGE(PG8_SA(0, 1), a2 + hstep, voffA);
            PG8_WAIT_L(8); PG8_BAR; PG8_WAIT_L(0); PG8_MMA(0, 0, At, B0); PG8_BAR; PG8_SCHED;
            PG8_LDB(B1, 1, 1); PG8_STAGE(PG8_SB(1, 0), b3, voffB);
            PG8_BAR; PG8_WAIT_L(0); PG8_MMA(0, 1, At, B1); PG8_BAR;
            PG8_LDA(At, 1, 1); PG8_STAGE(PG8_SA(1, 0), a3, voffA);
            PG8_BAR; PG8_WAIT_L(0); PG8_MMA(1, 0, At, B0); PG8_BAR; PG8_SCHED;
            PG8_STAGE(PG8_SB(1, 1), b3 + hstep, voffB);
            PG8_WAIT_V(6); PG8_BAR; PG8_MMA(1, 1, At, B1); PG8_BAR;
            }
        }
        if constexpr (ALIGN_EPI) { if (wr == 0) PG8_BAR; }
        if constexpr (!Epi::AFTER_DRAIN) { const int ln = fresh_lane(); E(acc, cur, wr, wc, ln & 15, ln >> 4); S.done(cur); }
        if (!has_next) break;
#pragma unroll
        for (int a = 0; a < 2; ++a)
#pragma unroll
            for (int b = 0; b < 2; ++b)
#pragma unroll
                for (int m = 0; m < 4; ++m)
#pragma unroll
                    for (int n = 0; n < 2; ++n) acc[a][b][m][n] = (f32x4){0.f, 0.f, 0.f, 0.f};
        cur = nxt; cA = nA; cB = nB; ++ui;
        if constexpr (ALIGN_EPI) { if (wr == 1) PG8_BAR; }
    }
    PG8_WAIT_V(0);
    if constexpr (!ALIGN_EPI) { if (wr == 0) PG8_BAR; }
    PG8_BAR;
    if constexpr (Epi::AFTER_DRAIN) { const int ln = fresh_lane(); E.fused(acc, cur, wr, wc, ln & 15, ln >> 4, lds, wid, ln); S.done(cur); }
#undef PG8_SA
#undef PG8_SB
#undef PG8_STAGE
#undef PG8_LDA
#undef PG8_LDB
#undef PG8_MMA
#undef PG8_WAIT_V
#undef PG8_WAIT_L
#undef PG8_BAR
#undef PG8_SCHED
}
}

#define GAS __attribute__((address_space(1)))
#define LAS __attribute__((address_space(3)))
typedef float f32x4 __attribute__((ext_vector_type(4)));
typedef unsigned v4u __attribute__((ext_vector_type(4)));
typedef GAS unsigned gu32;
#define XB_TMO      128
#define XB_XCNT(j)  (256  + 64 * (j))
#define XB_XSUB(j)  (1280 + 64 * (j))
#define XB_XGEN(j)  (2304 + 64 * (j))
#define XB_TOP      3328
#define XB_TOPGEN   3392
#define XCD_BAR_WORDS 3456
#define XB_SPIN_CAP (1u << 18)

__device__ __forceinline__ unsigned xb_ld(unsigned* p)              { return __hip_atomic_load(p, __ATOMIC_RELAXED, __HIP_MEMORY_SCOPE_AGENT); }
__device__ __forceinline__ unsigned xb_add(unsigned* p, unsigned v) { return __hip_atomic_fetch_add(p, v, __ATOMIC_RELAXED, __HIP_MEMORY_SCOPE_AGENT); }
__device__ __forceinline__ unsigned xb_xcc_id() { return (unsigned)__builtin_amdgcn_s_getreg((3 << 11) | 20) & 0xFu; }
#define XB_SPIN(cond, bar) do { unsigned _sp = 0; while (cond) { __builtin_amdgcn_s_sleep(1); \
    if ((++_sp & 255u) == 0u) { if (xb_ld(&(bar)[XB_TMO])) break; if (_sp > XB_SPIN_CAP) { atomicAdd(&(bar)[XB_TMO], 1u); break; } } } } while (0)

struct XcdBarrier {
    unsigned* bar; unsigned x;
    volatile LAS unsigned* st;
};

__device__ __forceinline__ XcdBarrier xcd_barrier_post(unsigned* bar, volatile LAS unsigned* st, int tid) {
    XcdBarrier b; b.bar = bar; b.x = xb_xcc_id(); b.st = st;
    if (tid == 0) (void)xb_add(&bar[XB_XCNT(b.x)], 1u);
    return b;
}
__device__ __forceinline__ void xcd_barrier_complete(unsigned* bar, unsigned x, unsigned& nloc, unsigned& nx) {
    const unsigned G = gridDim.x * gridDim.y * gridDim.z;
    unsigned sum, cnt, mine, sp = 0u;
    for (;;) {
        sum = 0u; cnt = 0u; mine = 0u;
#pragma unroll
        for (unsigned j = 0; j < 16; ++j) { const unsigned c = xb_ld(&bar[XB_XCNT(j)]); sum += c; cnt += (c > 0u) ? 1u : 0u; mine = (j == x) ? c : mine; }
        if (sum == G) break;
        __builtin_amdgcn_s_sleep(1);
        if ((++sp & 255u) == 0u) { if (xb_ld(&bar[XB_TMO])) break; if (sp > XB_SPIN_CAP) { atomicAdd(&bar[XB_TMO], 1u); break; } }
    }
    nloc = mine > 0u ? mine : 1u; nx = cnt > 0u ? cnt : 1u;
}

__device__ __forceinline__ void xcd_barrier(const XcdBarrier& b, int tid) {
    asm volatile("s_waitcnt vmcnt(0)" ::: "memory");
    __syncthreads();
    if (tid == 0) {
        unsigned* bar = b.bar;
        __builtin_amdgcn_s_waitcnt(0);
        unsigned nloc = b.st[0], nx = b.st[1];
        if (nloc == 0u) { xcd_barrier_complete(bar, b.x, nloc, nx); b.st[0] = nloc; b.st[1] = nx; }
        const unsigned old = xb_add(&bar[XB_XSUB(b.x)], 1u);
        const unsigned gen = old / nloc;
        if (old + 1u == (gen + 1u) * nloc) {
            __builtin_amdgcn_fence(__ATOMIC_RELEASE, "agent");
            asm volatile("s_waitcnt vmcnt(0)" ::: "memory");
            const unsigned og = xb_add(&bar[XB_TOP], 1u);
            const unsigned tg = og / nx;
            if (og + 1u == (tg + 1u) * nx) xb_add(&bar[XB_TOPGEN], 1u);
            else XB_SPIN(xb_ld(&bar[XB_TOPGEN]) == tg, bar);
            __builtin_amdgcn_fence(__ATOMIC_ACQUIRE, "agent");
            xb_add(&bar[XB_XGEN(b.x)], 1u);
            asm volatile("s_waitcnt vmcnt(0)" ::: "memory");
        } else {
            XB_SPIN(xb_ld(&bar[XB_XGEN(b.x)]) == gen, bar);
            __builtin_amdgcn_fence(__ATOMIC_ACQUIRE, "agent");
            asm volatile("s_waitcnt vmcnt(0)" ::: "memory");
        }
    }
    __syncthreads();
}

constexpr int NTHR = 512, NWAVES = 8;
constexpr int RING_BYTES = 131072, MISC_OFF = RING_BYTES + 320, LDS_BYTES = 147456;
constexpr int CW_BAR = 4096;
constexpr size_t CTL_ZERO_BYTES = 64 * 1024;
constexpr size_t WT_IN = WS_WT, WT_OUT = WT_IN + (size_t)2560 * 1024 * 2, WT_GU = WT_OUT + (size_t)1024 * 1024 * 2, WT_DOWN = WT_GU + (size_t)5632 * 1024 * 2,
                 WT_UQ = WT_DOWN + (size_t)1024 * 2816 * 2, WT_UKV = WT_UQ + (size_t)768 * 256 * 2, WT_CK = WT_UKV + (size_t)768 * 128 * 2, WT_CV = WT_CK + (size_t)64 * 2048 * 2,
                 WT_QM = WT_CV + (size_t)64 * 2048 * 2, WT_KM = WT_QM + 4 * 64 * 64 * 2, WT_END = WT_KM + 4 * 64 * 64 * 2;
static_assert(WT_END <= WS_HB, "weights");
constexpr int NPH = 22, PPL = 10;
constexpr int PROBE_SEL = 0;
constexpr int REP_MASK = 0;
#ifndef PHM
#define PHM 0xffff
#endif
struct MP { const float* in[N_IN]; float* out; unsigned char* ws; int ph_lo, ph_hi, coop, pad; };

struct MPK {
    const __attribute__((address_space(4))) MP* k;
    struct InArr { const __attribute__((address_space(4))) MP* k; __device__ __forceinline__ const float* operator[](int i) const { return k->in[i]; } };
    __device__ __forceinline__ InArr in_() const { return InArr{k}; }
};
#define PIN(i) (p.k->in[i])
__device__ __forceinline__ unsigned pk2(float lo, float hi) { return (unsigned)f2bf(lo) | ((unsigned)f2bf(hi) << 16); }
struct MapId { int n; __device__ __forceinline__ int operator()(int c) const { return c < n ? c : -1; } };
struct MapIn { __device__ __forceinline__ int operator()(int c) const {
    if (c < 1152) return c; if (c < 1280) return 1426 + (c - 1152); if (c < 1536) return 1170 + (c - 1280); if (c < 2304) return 1586 + (c - 1536);
    if (c < 2336) return 1554 + (c - 2304); if (c < 2354) return 1152 + (c - 2336); if (c < 2362) return c; return -1; } };
struct MapGU { __device__ __forceinline__ int operator()(int c) const { const int t = c >> 8, w = c & 255; return (w < 128) ? t * 128 + w : FF + t * 128 + (w - 128); } };
template <class Map> __device__ __forceinline__ void transpose_item(const float* W, int K, int ldw, const Map& map, const float* kscale, bf16* WT, LAS float* scr, int item, int nblk, int lane) {
    const int kb = item / nblk, nb = item % nblk, k0 = 64 * kb, n0 = 32 * nb;
    const int np = 2 * (lane & 15);
    const int sc = map(n0 + np);
    float2 tv[16];
#pragma unroll
    for (int i = 0; i < 16; ++i) { const int kk = 4 * i + (lane >> 4); tv[i] = (sc >= 0) ? *(const float2*)(W + (size_t)(k0 + kk) * ldw + sc) : make_float2(0.f, 0.f); }
    asm volatile("" : "+v"(tv[0]), "+v"(tv[1]), "+v"(tv[2]), "+v"(tv[3]), "+v"(tv[4]), "+v"(tv[5]), "+v"(tv[6]), "+v"(tv[7]));
    asm volatile("" : "+v"(tv[8]), "+v"(tv[9]), "+v"(tv[10]), "+v"(tv[11]), "+v"(tv[12]), "+v"(tv[13]), "+v"(tv[14]), "+v"(tv[15]));
#pragma unroll
    for (int i = 0; i < 16; ++i) { const int kk = 4 * i + (lane >> 4); float2 v = tv[i];
        if (kscale) { const float ksc = kscale[k0 + kk]; v.x *= ksc; v.y *= ksc; } scr[kk * 33 + np] = v.x; scr[kk * 33 + np + 1] = v.y; }
    asm volatile("s_waitcnt lgkmcnt(0)" ::: "memory");
    const int c = lane & 7;
#pragma unroll
    for (int j = 0; j < 4; ++j) { const int n = (lane >> 3) + 8 * j; const LAS float* s = scr + (8 * c) * 33 + n;
        v4u o; o.x = pk2(s[0 * 33], s[1 * 33]); o.y = pk2(s[2 * 33], s[3 * 33]); o.z = pk2(s[4 * 33], s[5 * 33]); o.w = pk2(s[6 * 33], s[7 * 33]);
        *(v4u*)(WT + (size_t)(n0 + n) * K + k0 + 8 * c) = o; }
    asm volatile("s_waitcnt lgkmcnt(0)" ::: "memory");
}
typedef unsigned u2raw __attribute__((ext_vector_type(2)));
__device__ __forceinline__ float4 unpk4(uint2 q) { return make_float4(__uint_as_float(q.x << 16), __uint_as_float(q.x & 0xffff0000u), __uint_as_float(q.y << 16), __uint_as_float(q.y & 0xffff0000u)); }
template <bool XBF, bool FIN = false> __device__ __forceinline__ void norm_rows(const void* xv, const float* g, const float* shift, const float* scale, bf16* hb, float* outf, int gw, int ngw, int lane) {
    const int rpw = T_ / ngw, m0 = gw * rpw, b = m0 / S_;
    float4 gs[4], sh[4];
#pragma unroll
    for (int j = 0; j < 4; ++j) { const int col = 4 * lane + 256 * j; gs[j] = *(const float4*)(g + col);
        if constexpr (!FIN) { const float4 sc = *(const float4*)(scale + (size_t)b * 6144 + col); sh[j] = *(const float4*)(shift + (size_t)b * 6144 + col);
            gs[j].x *= 1.f + sc.x; gs[j].y *= 1.f + sc.y; gs[j].z *= 1.f + sc.z; gs[j].w *= 1.f + sc.w; }
        else sh[j] = make_float4(0.f, 0.f, 0.f, 0.f); }
    typedef typename std::conditional<XBF, uint2, float4>::type raw_t;
    const raw_t* x = (const raw_t*)xv;
    raw_t nv[4], nw[4];
    { const raw_t* xr = x + (size_t)m0 * (D_ / 4) + lane;
#pragma unroll
      for (int j = 0; j < 4; ++j) { nv[j] = xr[64 * j]; nw[j] = xr[D_ / 4 + 64 * j]; } }
    for (int r = 0; r < rpw; r += 2) {
        const int m = m0 + r;
        float4 v[4], w[4]; float s = 0.f, s2 = 0.f;
#pragma unroll
        for (int j = 0; j < 4; ++j) { if constexpr (XBF) { v[j] = unpk4(nv[j]); w[j] = unpk4(nw[j]); } else { v[j] = nv[j]; w[j] = nw[j]; } }
        if (r + 2 < rpw) { const raw_t* xr = x + (size_t)(m + 2) * (D_ / 4) + lane;
#pragma unroll
            for (int j = 0; j < 4; ++j) { nv[j] = xr[64 * j]; nw[j] = xr[D_ / 4 + 64 * j]; } }
#pragma unroll
        for (int j = 0; j < 4; ++j) { s += v[j].x * v[j].x + v[j].y * v[j].y + v[j].z * v[j].z + v[j].w * v[j].w; s2 += w[j].x * w[j].x + w[j].y * w[j].y + w[j].z * w[j].z + w[j].w * w[j].w; }
        const float r1 = rsqrtf(wave_sum2(s) * (1.f / D_) + EPS), r2 = rsqrtf(wave_sum2(s2) * (1.f / D_) + EPS);
#pragma unroll
        for (int j = 0; j < 4; ++j) {
            const int col = 4 * lane + 256 * j;
            float4 o, o2;
            o.x = v[j].x * r1 * gs[j].x + sh[j].x; o.y = v[j].y * r1 * gs[j].y + sh[j].y; o.z = v[j].z * r1 * gs[j].z + sh[j].z; o.w = v[j].w * r1 * gs[j].w + sh[j].w;
            o2.x = w[j].x * r2 * gs[j].x + sh[j].x; o2.y = w[j].y * r2 * gs[j].y + sh[j].y; o2.z = w[j].z * r2 * gs[j].z + sh[j].z; o2.w = w[j].w * r2 * gs[j].w + sh[j].w;
            if constexpr (FIN) { *(float4*)(outf + (size_t)m * D_ + col) = o; *(float4*)(outf + (size_t)(m + 1) * D_ + col) = o2; }
            else { uint2 q; q.x = pk2(o.x, o.y); q.y = pk2(o.z, o.w); *(uint2*)(hb + (size_t)m * D_ + col) = q;
                   uint2 q2; q2.x = pk2(o2.x, o2.y); q2.y = pk2(o2.z, o2.w); *(uint2*)(hb + (size_t)(m + 1) * D_ + col) = q2; }
        }
    }
}
__device__ __forceinline__ void ph_p0(const MPK& p, LAS unsigned char* lds, int tid) {
    const int wave = tid >> 6, lane = tid & 63;
    LAS float* ca = (LAS float*)lds; LAS float* red = ca + 8192;
    unsigned char* ws = p.k->ws; float* mod = (float*)(ws + WS_MOD);
    const float* c = PIN(I_C);
    for (int i = tid; i < 8192; i += NTHR) ca[i] = siluf_(c[i]);
    __syncthreads();
    for (int item = blockIdx.x; item < 192; item += gridDim.x) {
        const int l = item / 96, j = (item % 96) * 64 + lane;
        const float* w = PIN(I_WADA) + (size_t)l * 1024 * 6144 + j + (size_t)(wave * 128) * 6144;
        float acc[8];
#pragma unroll
        for (int b = 0; b < 8; ++b) acc[b] = 0.f;
        float wn[16];
#pragma unroll
        for (int i = 0; i < 16; ++i) wn[i] = w[(size_t)i * 6144];
        for (int k0 = 0; k0 < 128; k0 += 16) {
            float wv[16];
            asm volatile("" : "+v"(wn[0]), "+v"(wn[1]), "+v"(wn[2]), "+v"(wn[3]), "+v"(wn[4]), "+v"(wn[5]), "+v"(wn[6]), "+v"(wn[7]),
                              "+v"(wn[8]), "+v"(wn[9]), "+v"(wn[10]), "+v"(wn[11]), "+v"(wn[12]), "+v"(wn[13]), "+v"(wn[14]), "+v"(wn[15]));
#pragma unroll
            for (int i = 0; i < 16; ++i) wv[i] = wn[i];
            if (k0 + 16 < 128) {
#pragma unroll
                for (int i = 0; i < 16; ++i) wn[i] = w[(size_t)(k0 + 16 + i) * 6144];
            }
#pragma unroll
            for (int i4 = 0; i4 < 4; ++i4)
#pragma unroll
                for (int b = 0; b < 8; ++b) { const f32x4 c4 = *(LAS const f32x4*)(ca + b * 1024 + wave * 128 + k0 + 4 * i4);
                    acc[b] += (c4[0] * wv[4 * i4] + c4[1] * wv[4 * i4 + 1]) + (c4[2] * wv[4 * i4 + 2] + c4[3] * wv[4 * i4 + 3]); }
        }
#pragma unroll
        for (int b = 0; b < 8; ++b) red[(wave * 8 + b) * 64 + lane] = acc[b];
        __syncthreads();
        { const int b = wave; float s2 = 0.f;
#pragma unroll
          for (int w8 = 0; w8 < 8; ++w8) s2 += red[(w8 * 8 + b) * 64 + lane];
          mod[((size_t)l * 8 + b) * 6144 + (item % 96) * 64 + lane] = s2 + PIN(I_BADA)[l * 6144 + (item % 96) * 64 + lane]; }
        __syncthreads();
    }
    const int* pos = (const int*)PIN(I_POS);
    float *cosP = (float*)(ws + WS_COSP), *sinP = (float*)(ws + WS_SINP), *cosM = (float*)(ws + WS_COSM), *sinM = (float*)(ws + WS_SINM);
    for (int i = blockIdx.x * NTHR + tid; i < T_ * 24; i += gridDim.x * NTHR) {
        const int m = i / 24, f = i % 24;
        double inv; if (f < 8) inv = pow(500000.0, -(double)(2 * f) / 16.0); else inv = pow(500000.0, -(double)(2 * (f - 8)) / 32.0);
        const float ang = (float)pos[m] * (float)inv;
        const double a = (double)ang, kq = rint(a * 0.15915494309189535), r = a - kq * 6.283185307179586476925;
        const float cs = (float)cos(r), sn = (float)sin(r);
        if (f < 8) { cosP[m * 8 + f] = cs; sinP[m * 8 + f] = sn; } else { cosM[m * 16 + f - 8] = cs; sinM[m * 16 + f - 8] = sn; }
    }
}
__device__ __forceinline__ void early_transposes(const MPK& p, int l, LAS unsigned char* lds, int tid, int first) {
    const int wave = tid >> 6, lane = tid & 63;
    if ((int)blockIdx.x < first) return;
    const int gw = ((int)blockIdx.x - first) * NWAVES + wave, ngw = ((int)gridDim.x - first) * NWAVES;
    unsigned char* ws = p.k->ws;
    LAS float* scr = (LAS float*)(lds + wave * 8704);
    constexpr int I0 = 16 * 80, I4 = 4 * 24, I5 = 2 * 24, I6 = 32 * 2, I7 = 32 * 2, I8 = 8, I9 = 8;
    constexpr int NIT = I0 + I4 + I5 + I6 + I7 + I8 + I9;
    for (int it = gw; it < NIT; it += ngw) {
        int r = it;
        if (r < I0) { transpose_item(PIN(I_WIN) + (size_t)l * D_ * DIN, D_, DIN, MapIn{}, nullptr, (bf16*)(ws + WT_IN), scr, r, 80, lane); continue; } r -= I0;
        if (r < I4) { transpose_item(PIN(I_WUQ) + (size_t)l * 256 * 576, 256, 576, MapId{576}, PIN(I_GQL) + l * 256, (bf16*)(ws + WT_UQ), scr, r, 24, lane); continue; } r -= I4;
        if (r < I5) { transpose_item(PIN(I_WUKV) + (size_t)l * 128 * 768, 128, 768, MapId{768}, PIN(I_GKVL) + l * 128, (bf16*)(ws + WT_UKV), scr, r, 24, lane); continue; } r -= I5;
        if (r < I6) { transpose_item(PIN(I_WCK) + (size_t)l * 2048 * 64, 2048, 64, MapId{64}, nullptr, (bf16*)(ws + WT_CK), scr, r, 2, lane); continue; } r -= I6;
        if (r < I7) { transpose_item(PIN(I_WCV) + (size_t)l * 2048 * 64, 2048, 64, MapId{64}, nullptr, (bf16*)(ws + WT_CV), scr, r, 2, lane); continue; } r -= I7;
        if (r < I8) { const int h = r >> 1; transpose_item(PIN(I_WQM) + (size_t)l * 16384 + h * 4096, 64, 64, MapId{64}, nullptr, (bf16*)(ws + WT_QM) + h * 4096, scr, r & 1, 2, lane); continue; } r -= I8;
        { const int h = r >> 1; transpose_item(PIN(I_WKM) + (size_t)l * 16384 + h * 4096, 64, 64, MapId{64}, nullptr, (bf16*)(ws + WT_KM) + h * 4096, scr, r & 1, 2, lane); }
    }
}
__device__ __forceinline__ void ph_prep(const MPK& p, int l, LAS unsigned char* lds, int tid) {
    const int wave = tid >> 6, lane = tid & 63;
    const int gw = blockIdx.x * NWAVES + wave, ngw = gridDim.x * NWAVES;
    unsigned char* ws = p.k->ws;
    LAS float* scr = (LAS float*)(lds + wave * 8704);
    for (int i = blockIdx.x * NTHR + tid; i < 2 * T_; i += gridDim.x * NTHR) ((float*)(ws + WS_SSQL))[i] = 0.f;
    if (l == 0) early_transposes(p, l, lds, tid, 0);
    const float* modl = (const float*)(ws + WS_MOD) + (size_t)l * 8 * 6144;
    if (l == 0) norm_rows<false>(PIN(I_X), PIN(I_GN1) + l * D_, modl + 0, modl + 1024, (bf16*)(ws + WS_HB), nullptr, gw, ngw, lane);
    else norm_rows<true>(p.k->out, PIN(I_GN1) + l * D_, modl + 0, modl + 1024, (bf16*)(ws + WS_HB), nullptr, gw, ngw, lane);
}
__device__ __forceinline__ void late_transposes(const MPK& p, int l, LAS unsigned char* lds, int tid, int first) {
    const int wave = tid >> 6, lane = tid & 63;
    if ((int)blockIdx.x < first) return;
    const int gw = ((int)blockIdx.x - first) * NWAVES + wave, ngw = ((int)gridDim.x - first) * NWAVES;
    unsigned char* ws = p.k->ws;
    LAS float* scr = (LAS float*)(lds + wave * 8704);
    constexpr int I1 = 16 * 32, I2 = 16 * 176, I3 = 44 * 32;
    for (int it = gw; it < I1 + I2 + I3; it += ngw) {
        int r = it;
        if (r < I1) { transpose_item(PIN(I_WOUT) + (size_t)l * D_ * D_, D_, D_, MapId{D_}, nullptr, (bf16*)(ws + WT_OUT), scr, r, 32, lane); continue; } r -= I1;
        if (r < I2) { transpose_item(PIN(I_WGU) + (size_t)l * D_ * 2 * FF, D_, 2 * FF, MapGU{}, nullptr, (bf16*)(ws + WT_GU), scr, r, 176, lane); continue; } r -= I2;
        transpose_item(PIN(I_WDOWN) + (size_t)l * FF * D_, FF, D_, MapId{D_}, nullptr, (bf16*)(ws + WT_DOWN), scr, r, 32, lane);
    }
}
__device__ __forceinline__ void ph_mixnorm(const MPK& p, int l, int tid) {
    const int gw = blockIdx.x * NWAVES + (tid >> 6), ngw = gridDim.x * NWAVES, lane = tid & 63;
    unsigned char* ws = p.k->ws;
    bf16* mix = (bf16*)(ws + WS_HB); const float* ga = PIN(I_GOA) + l * 384; const float* gb = PIN(I_GOB) + l * 384;
    const bf16 *oc = (const bf16*)(ws + WS_OCMP), *os = (const bf16*)(ws + WS_OSLC), *ow = (const bf16*)(ws + WS_OWIN); const float* gm = (const float*)(ws + WS_GM);
#define UNPK8(dst, src) dst[0] = __uint_as_float(src.x << 16); dst[1] = __uint_as_float(src.x & 0xffff0000u); dst[2] = __uint_as_float(src.y << 16); dst[3] = __uint_as_float(src.y & 0xffff0000u); \
    dst[4] = __uint_as_float(src.z << 16); dst[5] = __uint_as_float(src.z & 0xffff0000u); dst[6] = __uint_as_float(src.w << 16); dst[7] = __uint_as_float(src.w & 0xffff0000u);
    const int rpw = T_ / ngw;
    const float* ggp = (lane < 48) ? ga + lane * 8 : gb + (lane - 48) * 8; const float4 gA0 = *(const float4*)ggp, gA1 = *(const float4*)(ggp + 4);
    const float* ggq = gb + (16 + (lane & 31)) * 8; const float4 gB0 = *(const float4*)ggq, gB1 = *(const float4*)(ggq + 4);
    v4u ra4, rb4, rc4, ry4; float rg0, rg1, rg2;
#define MIX_LOAD(m_) do { const bf16* r_ = mix + (size_t)(m_) * D_; \
        if (lane < 48) { const size_t o_ = (size_t)(m_) * 384 + lane * 8; const float* g3_ = gm + (size_t)(m_) * 32 + 3 * (lane >> 3); rg0 = g3_[0]; rg1 = g3_[1]; rg2 = g3_[2]; \
            ra4 = *(const v4u*)(oc + o_); rb4 = *(const v4u*)(os + o_); rc4 = *(const v4u*)(ow + o_); } \
        else { ra4 = *(const v4u*)(r_ + 384 + (lane - 48) * 8); rb4 = ra4; rc4 = ra4; rg0 = 0.f; rg1 = 0.f; rg2 = 0.f; } \
        if (lane < 32) ry4 = *(const v4u*)(r_ + 384 + (16 + lane) * 8); else ry4 = ra4; } while (0)
    const int mend = gw * rpw + rpw;
    MIX_LOAD(gw * rpw);
    for (int m = gw * rpw; m < mend; ++m) {
        bf16* r = mix + (size_t)m * D_;
        const v4u ca4 = ra4, cb4 = rb4, cc4 = rc4, cy4 = ry4; const float g0 = rg0, g1 = rg1, g2 = rg2;
        if (m + 1 < mend) MIX_LOAD(m + 1);
        float v0[8], v1[8]; float sa = 0.f, sb = 0.f;
        if (lane < 48) {
            float c8[8], s8[8], w8[8]; UNPK8(c8, ca4) UNPK8(s8, cb4) UNPK8(w8, cc4)
#pragma unroll
            for (int i = 0; i < 8; ++i) { v0[i] = g0 * c8[i] + g1 * s8[i] + g2 * w8[i]; sa += v0[i] * v0[i]; }
        } else {
            UNPK8(v0, ca4)
#pragma unroll
            for (int i = 0; i < 8; ++i) sb += v0[i] * v0[i];
        }
        if (lane < 32) { UNPK8(v1, cy4)
#pragma unroll
            for (int i = 0; i < 8; ++i) sb += v1[i] * v1[i]; }
        const float ra = rsqrtf(wave_sum2(sa) * (1.f / 384.f) + EPS), rb = rsqrtf(wave_sum2(sb) * (1.f / 384.f) + EPS);
        {
            const int col = (lane < 48) ? lane * 8 : 384 + (lane - 48) * 8; const float rr = (lane < 48) ? ra : rb;
            const float4 q0 = gA0, q1 = gA1;
            v4u w; w.x = pk2(v0[0] * rr * q0.x, v0[1] * rr * q0.y); w.y = pk2(v0[2] * rr * q0.z, v0[3] * rr * q0.w); w.z = pk2(v0[4] * rr * q1.x, v0[5] * rr * q1.y); w.w = pk2(v0[6] * rr * q1.z, v0[7] * rr * q1.w);
            *(v4u*)(r + col) = w;
        }
        if (lane < 32) { const float4 q0 = gB0, q1 = gB1;
            v4u w; w.x = pk2(v1[0] * rb * q0.x, v1[1] * rb * q0.y); w.y = pk2(v1[2] * rb * q0.z, v1[3] * rb * q0.w); w.z = pk2(v1[4] * rb * q1.x, v1[5] * rb * q1.y); w.w = pk2(v1[6] * rb * q1.z, v1[7] * rb * q1.w);
            *(v4u*)(r + 384 + (16 + lane) * 8) = w; }
    }
#undef MIX_LOAD
#undef UNPK8
}


typedef short bf16x8 __attribute__((ext_vector_type(8)));
typedef short s16x4 __attribute__((ext_vector_type(4)));
typedef float f32x16 __attribute__((ext_vector_type(16)));
typedef unsigned u32x2v __attribute__((ext_vector_type(2)));
constexpr int AT_BUF = 20480, AT_K32 = 8192, AT_V = 12288;
__device__ __forceinline__ unsigned cvtpk(float lo, float hi) { unsigned r; asm volatile("v_cvt_pk_bf16_f32 %0, %1, %2" : "=v"(r) : "v"(lo), "v"(hi)); return r; }
__device__ __forceinline__ float max3f(float a, float b, float c) { float r; asm("v_max3_f32 %0, %1, %2, %3" : "=v"(r) : "v"(a), "v"(b), "v"(c)); return r; }
__device__ __forceinline__ int crow(int r, int hi) { return (r & 3) + 8 * (r >> 2) + 4 * hi; }
__device__ __forceinline__ s16x4 vtr(LAS const unsigned char* p) { return __builtin_bit_cast(s16x4, __builtin_amdgcn_ds_read_tr16_b64_v4i16((LAS s16x4*)p)); }
enum { AM_CAUSAL = 0, AM_WINDOW = 1, AM_SLC = 2 };
struct AttnState { float m, l; f32x16 o[2]; f32x16 negm; bool started; long long twait; };
template <int NC> struct TileRegs { v4u k; v4u k2; v4u v; };
template <int NC> __device__ __forceinline__ void at_load(TileRegs<NC>& r, const bf16* Kg, int ldk, const bf16* Vg, int ldv, const bf16* K2g, int ldk2, int tile, int tid) {
    const int key = tid >> 3, c = tid & 7;
    r.k = *(const v4u*)(Kg + (size_t)(tile * 64 + key) * ldk + 8 * c);
    r.v = *(const v4u*)(Vg + (size_t)(tile * 64 + key) * ldv + 8 * c);
    if (NC == 6) { if (tid < 256) r.k2 = *(const v4u*)(K2g + (size_t)(tile * 64 + (tid >> 2)) * ldk2 + 8 * (tid & 3)); }
}
template <int NC> __device__ __forceinline__ void at_store(const TileRegs<NC>& r, LAS unsigned char* buf, int tid) {
    const int key = tid >> 3, c = tid & 7;
    *(LAS v4u*)(buf + key * 128 + 16 * (c ^ ((key >> 1) & 7))) = r.k;
    *(LAS v4u*)(buf + AT_V + (c >> 2) * 4096 + key * 64 + (c & 3) * 16) = r.v;
    if (NC == 6) { if (tid < 256) { const int k2 = tid >> 2, c2 = tid & 3; *(LAS v4u*)(buf + AT_K32 + k2 * 64 + 16 * (c2 ^ ((k2 >> 2) & 3))) = r.k2; } }
}
template <int NC> __device__ __forceinline__ void qk_tile(f32x16& p0, f32x16& p1, LAS const unsigned char* buf, const bf16x8 (&qf)[NC], const f32x16& negm, int lane) {
    const int r32 = lane & 31, hi = lane >> 5;
    p0 = negm; p1 = negm;
#pragma unroll
    for (int cc = 0; cc < NC; ++cc) {
        bf16x8 k0, k1;
        if (cc < 4) { const int k0r = r32, k1r = 32 + r32;
            k0 = *(LAS const bf16x8*)(buf + k0r * 128 + 16 * ((2 * cc + hi) ^ ((k0r >> 1) & 7)));
            k1 = *(LAS const bf16x8*)(buf + k1r * 128 + 16 * ((2 * cc + hi) ^ ((k1r >> 1) & 7))); }
        else { const int k0r = r32, k1r = 32 + r32, c2 = 2 * (cc - 4) + hi;
            k0 = *(LAS const bf16x8*)(buf + AT_K32 + k0r * 64 + 16 * (c2 ^ ((k0r >> 2) & 3)));
            k1 = *(LAS const bf16x8*)(buf + AT_K32 + k1r * 64 + 16 * (c2 ^ ((k1r >> 2) & 3))); }
        p0 = __builtin_amdgcn_mfma_f32_32x32x16_bf16(k0, qf[cc], p0, 0, 0, 0);
        p1 = __builtin_amdgcn_mfma_f32_32x32x16_bf16(k1, qf[cc], p1, 0, 0, 0);
    }
}
template <int MODE> __device__ __forceinline__ void mask_tile(f32x16& p0, f32x16& p1, int kpos0, int qpos, bool need_mask, bool sel_ok, int lane) {
    const int hi = lane >> 5;
    if (need_mask) {
        const int qw0m = __builtin_amdgcn_readfirstlane(qpos) & ~31;
        const bool diag = (kpos0 + 63 > qw0m), old = (MODE == AM_WINDOW) && (kpos0 < qw0m + 31 - 511);
        if (diag || old) {
            const float selterm = (MODE == AM_SLC && !sel_ok) ? -INFINITY : INFINITY;
            const int dbase = qpos - kpos0 - 4 * hi;
#pragma unroll
            for (int r = 0; r < 16; ++r) {
                const int d0 = dbase - ((r & 3) + 8 * (r >> 2)), d1 = d0 - 32;
                float l0 = ((float)d0 + 0.5f) * INFINITY, l1 = ((float)d1 + 0.5f) * INFINITY;
                if (MODE == AM_WINDOW) { l0 = fminf(l0, ((float)(511 - d0) + 0.5f) * INFINITY); l1 = fminf(l1, ((float)(511 - d1) + 0.5f) * INFINITY); }
                if (MODE == AM_SLC) { l0 = fminf(l0, selterm); l1 = fminf(l1, selterm); }
                p0[r] = fminf(p0[r], l0); p1[r] = fminf(p1[r], l1);
            }
        } else if (MODE == AM_SLC) {
            const float selterm = sel_ok ? INFINITY : -INFINITY;
#pragma unroll
            for (int r = 0; r < 16; ++r) { p0[r] = fminf(p0[r], selterm); p1[r] = fminf(p1[r], selterm); }
        }
    }
}
template <int MODE> __device__ __forceinline__ void softmax_tile(AttnState& st, f32x16& p0, f32x16& p1, bf16x8 (&pf)[4], int kpos0, int qpos, bool need_mask, bool sel_ok, int lane) {
    mask_tile<MODE>(p0, p1, kpos0, qpos, need_mask, sel_ok, lane);
    float mx = max3f(p0[0], p1[0], p0[1]), mx2 = max3f(p1[1], p0[2], p1[2]);
#pragma unroll
    for (int r = 3; r < 15; r += 2) { mx = max3f(mx, p0[r], p1[r]); mx2 = max3f(mx2, p0[r + 1], p1[r + 1]); }
    mx = max3f(mx, p0[15], p1[15]); mx = max3f(mx, mx2, mx2);
    mx = red32_max(mx);
    if (!st.started || __any(mx > 0.f)) {
        float dl = st.started ? fmaxf(mx, 0.f) : mx;
        dl = (dl > -1e30f) ? dl : 0.f;
        st.started = true;
        const float alpha = __builtin_amdgcn_exp2f(-dl);
        st.m += dl; st.l *= alpha;
#pragma unroll
        for (int r = 0; r < 16; ++r) { st.o[0][r] *= alpha; st.o[1][r] *= alpha; p0[r] -= dl; p1[r] -= dl; st.negm[r] = -st.m; }
    }
    float sum = 0.f;
#pragma unroll
    for (int r = 0; r < 16; ++r) { p0[r] = __builtin_amdgcn_exp2f(p0[r]); p1[r] = __builtin_amdgcn_exp2f(p1[r]); sum += p0[r] + p1[r]; }
    st.l += sum;
#pragma unroll
    for (int s2 = 0; s2 < 2; ++s2) {
        v4u a, b;
        a.x = cvtpk(p0[8 * s2 + 0], p0[8 * s2 + 1]); a.y = cvtpk(p0[8 * s2 + 2], p0[8 * s2 + 3]); a.z = cvtpk(p0[8 * s2 + 4], p0[8 * s2 + 5]); a.w = cvtpk(p0[8 * s2 + 6], p0[8 * s2 + 7]);
        b.x = cvtpk(p1[8 * s2 + 0], p1[8 * s2 + 1]); b.y = cvtpk(p1[8 * s2 + 2], p1[8 * s2 + 3]); b.z = cvtpk(p1[8 * s2 + 4], p1[8 * s2 + 5]); b.w = cvtpk(p1[8 * s2 + 6], p1[8 * s2 + 7]);
        pf[s2] = __builtin_bit_cast(bf16x8, a); pf[2 + s2] = __builtin_bit_cast(bf16x8, b);
    }
}
struct TileFlags { bool skip, need_mask, sel_ok; };
__device__ __forceinline__ void pack_p(bf16x8 (&pf)[4], const f32x16& p0, const f32x16& p1) {
#pragma unroll
    for (int s2 = 0; s2 < 2; ++s2) {
        v4u a, b;
        a.x = cvtpk(p0[8 * s2 + 0], p0[8 * s2 + 1]); a.y = cvtpk(p0[8 * s2 + 2], p0[8 * s2 + 3]); a.z = cvtpk(p0[8 * s2 + 4], p0[8 * s2 + 5]); a.w = cvtpk(p0[8 * s2 + 6], p0[8 * s2 + 7]);
        b.x = cvtpk(p1[8 * s2 + 0], p1[8 * s2 + 1]); b.y = cvtpk(p1[8 * s2 + 2], p1[8 * s2 + 3]); b.z = cvtpk(p1[8 * s2 + 4], p1[8 * s2 + 5]); b.w = cvtpk(p1[8 * s2 + 6], p1[8 * s2 + 7]);
        pf[s2] = __builtin_bit_cast(bf16x8, a); pf[2 + s2] = __builtin_bit_cast(bf16x8, b);
    }
}
template <int MODE> __device__ __forceinline__ void softmax_pair(AttnState& st, f32x16& a0, f32x16& a1, f32x16& b0, f32x16& b1, int kpos0, int qpos, const TileFlags& fa, const TileFlags& fb, int lane) {
    mask_tile<MODE>(a0, a1, kpos0, qpos, fa.need_mask, fa.sel_ok, lane);
    mask_tile<MODE>(b0, b1, kpos0 + 64, qpos, fb.need_mask, fb.sel_ok, lane);
    float mx = max3f(a0[0], a1[0], b0[0]), mx2 = max3f(b1[0], a0[1], a1[1]);
#pragma unroll
    for (int r = 1; r < 16; ++r) { mx = max3f(mx, b0[r], b1[r]); if (r > 1) mx2 = max3f(mx2, a0[r], a1[r]); }
    mx = max3f(mx, mx2, mx2);
    mx = red32_max(mx);
    if (!st.started || __any(mx > 0.f)) {
        float dl = st.started ? fmaxf(mx, 0.f) : mx;
        dl = (dl > -1e30f) ? dl : 0.f;
        st.started = true;
        const float alpha = __builtin_amdgcn_exp2f(-dl);
        st.m += dl; st.l *= alpha;
#pragma unroll
        for (int r = 0; r < 16; ++r) { st.o[0][r] *= alpha; st.o[1][r] *= alpha; a0[r] -= dl; a1[r] -= dl; b0[r] -= dl; b1[r] -= dl; st.negm[r] = -st.m; }
    }
    float sum = 0.f;
#pragma unroll
    for (int r = 0; r < 16; ++r) { a0[r] = __builtin_amdgcn_exp2f(a0[r]); a1[r] = __builtin_amdgcn_exp2f(a1[r]); b0[r] = __builtin_amdgcn_exp2f(b0[r]); b1[r] = __builtin_amdgcn_exp2f(b1[r]); sum += (a0[r] + a1[r]) + (b0[r] + b1[r]); }
    st.l += sum;
}
__device__ __forceinline__ void pv_tile(AttnState& st, LAS const unsigned char* buf, const bf16x8 (&pf)[4], int lane) {
    const int hi = lane >> 5;
    const unsigned vb = (unsigned)(uintptr_t)(buf + AT_V + (4 * hi + ((lane & 15) >> 2)) * 64 + ((lane >> 4) & 1) * 32 + (lane & 3) * 8);
#pragma unroll
    for (int dh = 0; dh < 2; ++dh) {
        s16x4 lo[4], hh[4];
#pragma unroll
        for (int s4 = 0; s4 < 4; ++s4) {
            asm volatile("ds_read_b64_tr_b16 %0, %1 offset:%c2" : "=&v"(lo[s4]) : "v"(vb), "i"(dh * 4096 + s4 * 1024) : "memory");
            asm volatile("ds_read_b64_tr_b16 %0, %1 offset:%c2" : "=&v"(hh[s4]) : "v"(vb), "i"(dh * 4096 + s4 * 1024 + 512) : "memory");
        }
        asm volatile("s_waitcnt lgkmcnt(0)" : "+v"(lo[0]), "+v"(lo[1]), "+v"(lo[2]), "+v"(lo[3]), "+v"(hh[0]), "+v"(hh[1]), "+v"(hh[2]), "+v"(hh[3]) :: "memory");
#pragma unroll
        for (int s4 = 0; s4 < 4; ++s4) {
            const bf16x8 vf = {lo[s4][0], lo[s4][1], lo[s4][2], lo[s4][3], hh[s4][0], hh[s4][1], hh[s4][2], hh[s4][3]};
            st.o[dh] = __builtin_amdgcn_mfma_f32_32x32x16_bf16(vf, pf[s4], st.o[dh], 0, 0, 0);
        }
    }
}
template <int MODE> __device__ __forceinline__ TileFlags tile_flags(int t, int qw0, unsigned selbits) {
    const int k0 = t * 64; TileFlags f;
    f.skip = k0 > qw0 + 31; f.need_mask = (k0 + 63 > qw0); f.sel_ok = true;
    if (MODE == AM_WINDOW) { f.skip = f.skip || (k0 + 63 < qw0 - 511); f.need_mask = f.need_mask || (k0 < qw0 + 31 - 511); }
    if (MODE == AM_SLC) { f.sel_ok = (selbits >> t) & 1u; const unsigned long long bal = __ballot(f.sel_ok); f.skip = f.skip || (bal == 0ull); f.need_mask = f.need_mask || (bal != ~0ull); }
    return f;
}
struct DmaOff { unsigned k, v, k2; };
template <int NC> __device__ __forceinline__ DmaOff at_dma_off(int ldk, int ldv, int ldk2, int wave, int lane) {
    const int L = wave * 64 + lane; DmaOff o;
    { const int key = L >> 3, c = (L & 7) ^ ((key >> 1) & 7); o.k = (unsigned)(key * ldk + 8 * c) * 2u; }
    { const int key = (L >> 2) & 63, c = (L >> 8) * 4 + (L & 3); o.v = (unsigned)(key * ldv + 8 * c) * 2u; }
    { const int key = (L >> 2) & 63, c2 = (L & 3) ^ ((key >> 2) & 3); o.k2 = (unsigned)(key * ldk2 + 8 * c2) * 2u; }
    return o;
}
template <int NC> __device__ __forceinline__ void at_dma(const DmaOff& o, const bf16* Kg, int ldk, const bf16* Vg, int ldv, const bf16* K2g, int ldk2, int tile, LAS unsigned char* slot, int wave) {
    __builtin_amdgcn_global_load_lds((const unsigned*)((const char*)(Kg + (size_t)tile * 64 * ldk) + o.k), (LAS unsigned*)(slot + wave * 1024), 16, 0, 0);
    __builtin_amdgcn_global_load_lds((const unsigned*)((const char*)(Vg + (size_t)tile * 64 * ldv) + o.v), (LAS unsigned*)(slot + AT_V + wave * 1024), 16, 0, 0);
    if (NC == 6) { if (wave < 4) __builtin_amdgcn_global_load_lds((const unsigned*)((const char*)(K2g + (size_t)tile * 64 * ldk2) + o.k2), (LAS unsigned*)(slot + AT_K32 + wave * 1024), 16, 0, 0); }
}
__device__ __forceinline__ void at_wait_bar(int keep) {
    if (keep == 0) asm volatile("s_waitcnt vmcnt(0) lgkmcnt(0)" ::: "memory");
    else if (keep == 4) asm volatile("s_waitcnt vmcnt(4) lgkmcnt(0)" ::: "memory");
    else asm volatile("s_waitcnt vmcnt(6) lgkmcnt(0)" ::: "memory");
    __builtin_amdgcn_s_barrier();
    asm volatile("" ::: "memory");
}
template <int NC, int MODE> __device__ __forceinline__ void at_stream(AttnState& st, LAS unsigned char* lds, const bf16* Kg, int ldk, const bf16* Vg, int ldv, const bf16* K2g, int ldk2, int t0, int t1,
                                                                       const bf16x8 (&qf)[NC], int qpos, int qw0, unsigned selbits, int tid) {
    const int lane = tid & 63, wave = __builtin_amdgcn_readfirstlane(tid >> 6), np = (t1 - t0) >> 1;
    const int nper2 = (NC == 6 && wave < 4) ? 6 : 4;
    const DmaOff dof = at_dma_off<NC>(ldk, ldv, ldk2, wave, lane);
    at_dma<NC>(dof, Kg, ldk, Vg, ldv, K2g, ldk2, t0, lds, wave); at_dma<NC>(dof, Kg, ldk, Vg, ldv, K2g, ldk2, t0 + 1, lds + AT_BUF, wave);
    if (np > 1) { at_dma<NC>(dof, Kg, ldk, Vg, ldv, K2g, ldk2, t0 + 2, lds + 2 * AT_BUF, wave); at_dma<NC>(dof, Kg, ldk, Vg, ldv, K2g, ldk2, t0 + 3, lds + 3 * AT_BUF, wave); }
    at_wait_bar(np > 1 ? nper2 : 0);
    int s0 = 0, s1 = 2 * AT_BUF, s2 = 4 * AT_BUF;
    for (int j = 0; j < np; ++j) {
        const int t = t0 + 2 * j; const bool has_2 = (j + 2 < np);
        if (has_2) { at_dma<NC>(dof, Kg, ldk, Vg, ldv, K2g, ldk2, t + 4, lds + s2, wave); at_dma<NC>(dof, Kg, ldk, Vg, ldv, K2g, ldk2, t + 5, lds + s2 + AT_BUF, wave); }
        const TileFlags fa = tile_flags<MODE>(t, qw0, selbits), fb = tile_flags<MODE>(t + 1, qw0, selbits);
        if (!fa.skip && !fb.skip) {
            f32x16 a0, a1, b0, b1; bf16x8 pf[4];
            qk_tile<NC>(a0, a1, lds + s0, qf, st.negm, lane);
            qk_tile<NC>(b0, b1, lds + s0 + AT_BUF, qf, st.negm, lane);
            softmax_pair<MODE>(st, a0, a1, b0, b1, t * 64, qpos, fa, fb, lane);
            pack_p(pf, a0, a1); pv_tile(st, lds + s0, pf, lane);
            pack_p(pf, b0, b1); pv_tile(st, lds + s0 + AT_BUF, pf, lane);
        } else {
            if (!fa.skip) { f32x16 p0, p1; bf16x8 pf[4]; qk_tile<NC>(p0, p1, lds + s0, qf, st.negm, lane); softmax_tile<MODE>(st, p0, p1, pf, t * 64, qpos, fa.need_mask, fa.sel_ok, lane); pv_tile(st, lds + s0, pf, lane); }
            if (!fb.skip) { f32x16 p0, p1; bf16x8 pf[4]; qk_tile<NC>(p0, p1, lds + s0 + AT_BUF, qf, st.negm, lane); softmax_tile<MODE>(st, p0, p1, pf, (t + 1) * 64, qpos, fb.need_mask, fb.sel_ok, lane); pv_tile(st, lds + s0 + AT_BUF, pf, lane); }
        }
        at_wait_bar(has_2 ? nper2 : 0);
        const int tmp = s0; s0 = s1; s1 = s2; s2 = tmp;
    }
}
__device__ __forceinline__ int next_item_q(unsigned* ctrs, LAS unsigned char* lds, int wave_u, int count, int q0, int& kstart) {
    const int tid = wave_u * 64 + fresh_lane();
    LAS int* slot = (LAS int*)(lds + RING_BYTES + 64);
    if (tid == 0) { const unsigned v = atomicAdd(ctrs, 1u); slot[0] = (v < 8u * (unsigned)count) ? (int)(((v & 7u) << 16) | (v >> 3)) : -1; }
    __syncthreads();
    const int v = slot[0];
    __syncthreads();
    (void)q0; (void)kstart;
    return v;
}
__device__ __forceinline__ void mla_unit(unsigned char* ws, LAS unsigned char* lds, int b, int h, int qt, int wave_u) {
    const int tid = wave_u * 64 + fresh_lane();
    const int lane = tid & 63, wave = tid >> 6, r32 = lane & 31, hi = lane >> 5;
    const int qw0 = qt * 256 + wave * 32, qpos = qw0 + r32; const size_t row = (size_t)b * S_ + qpos;
    const long long tq0 = (PROBE_SEL != 0) ? (long long)__builtin_amdgcn_s_memtime() : 0ll;
    bf16x8 qf[6];
    {
        const bf16* qp = (const bf16*)(ws + WS_OSLC) + row * 768 + h * 96 + 8 * hi;
        v4u raw[6];
#pragma unroll
        for (int cc = 0; cc < 6; ++cc) raw[cc] = *(const v4u*)(qp + 16 * cc);
        float msc = MSCALE; asm volatile("" : "+v"(msc));
        const float rs = rsqrtf(((const float*)(ws + WS_SSQL))[row] * (1.f / 256.f) + EPS) * msc;
        const float* cm_ = (const float*)(ws + WS_COSM) + row * 16 + 8 * hi; const float* sm_ = (const float*)(ws + WS_SINM) + row * 16 + 8 * hi;
#define UNPKQ(dst, src) dst[0] = __uint_as_float(src.x << 16); dst[1] = __uint_as_float(src.x & 0xffff0000u); dst[2] = __uint_as_float(src.y << 16); dst[3] = __uint_as_float(src.y & 0xffff0000u); \
        dst[4] = __uint_as_float(src.z << 16); dst[5] = __uint_as_float(src.z & 0xffff0000u); dst[6] = __uint_as_float(src.w << 16); dst[7] = __uint_as_float(src.w & 0xffff0000u);
#pragma unroll
        for (int cc = 0; cc < 4; ++cc) { float f[8]; UNPKQ(f, raw[cc])
            v4u w; w.x = cvtpk(f[0] * rs, f[1] * rs); w.y = cvtpk(f[2] * rs, f[3] * rs); w.z = cvtpk(f[4] * rs, f[5] * rs); w.w = cvtpk(f[6] * rs, f[7] * rs); qf[cc] = __builtin_bit_cast(bf16x8, w); }
        { float x1[8], x2[8], o1[8], o2[8]; UNPKQ(x1, raw[4]) UNPKQ(x2, raw[5])
#pragma unroll
          for (int j = 0; j < 8; ++j) { const float cs = cm_[j] * rs, sn = sm_[j] * rs; o1[j] = x1[j] * cs - x2[j] * sn; o2[j] = x1[j] * sn + x2[j] * cs; }
          v4u w; w.x = cvtpk(o1[0], o1[1]); w.y = cvtpk(o1[2], o1[3]); w.z = cvtpk(o1[4], o1[5]); w.w = cvtpk(o1[6], o1[7]); qf[4] = __builtin_bit_cast(bf16x8, w);
          w.x = cvtpk(o2[0], o2[1]); w.y = cvtpk(o2[2], o2[3]); w.z = cvtpk(o2[4], o2[5]); w.w = cvtpk(o2[6], o2[7]); qf[5] = __builtin_bit_cast(bf16x8, w); }
#undef UNPKQ
    }
    const long long tq1 = (PROBE_SEL != 0) ? (long long)__builtin_amdgcn_s_memtime() : 0ll;
    AttnState st; st.m = 0.f; st.l = 0.f; st.o[0] = f32x16{}; st.o[1] = f32x16{}; st.negm = f32x16{}; st.started = false; st.twait = 0;
    const bf16* kvb = (const bf16*)(ws + WS_KVM) + (size_t)b * S_ * 768 + h * 128;
    at_stream<6, AM_CAUSAL>(st, lds, kvb, 768, kvb + 64, 768, (const bf16*)(ws + WS_KR) + (size_t)b * S_ * 32, 32, 0, 4 * qt + 4, qf, qpos, qw0, 0u, tid);
    if (PROBE_SEL >= 1 && PROBE_SEL <= 3 && b == 0 && h == 0 && qt == 7 && tid == 0) { const long long tq2 = (long long)__builtin_amdgcn_s_memtime();
        ((float*)(ws + WS_CTL))[100] = (PROBE_SEL == 1) ? (float)(tq2 - tq1) : (PROBE_SEL == 2) ? (float)st.twait : (float)(tq1 - tq0); }
    const float lt = red32_sum(st.l), il = 1.f / lt;
    bf16* op = (bf16*)(ws + WS_HB) + row * D_ + 384 + h * 64 + 4 * hi;
#pragma unroll
    for (int dh = 0; dh < 2; ++dh)
#pragma unroll
        for (int g4 = 0; g4 < 4; ++g4) { u32x2v w; w.x = cvtpk(st.o[dh][4 * g4] * il, st.o[dh][4 * g4 + 1] * il); w.y = cvtpk(st.o[dh][4 * g4 + 2] * il, st.o[dh][4 * g4 + 3] * il);
            *(u32x2v*)(op + dh * 32 + 8 * g4) = w; }
}
template <int MODE> __device__ __forceinline__ void nsa_branch_unit(unsigned char* ws, LAS unsigned char* lds, int b, int h, int qt, int wave_u) {
    const int tid = wave_u * 64 + fresh_lane();
    const int lane = tid & 63, wave = tid >> 6, r32 = lane & 31, hi = lane >> 5, g = h / 3;
    const int qw0 = qt * 256 + wave * 32, qpos = qw0 + r32; const size_t row = (size_t)b * S_ + qpos;
    const bf16* nsa = (const bf16*)(ws + WS_NSA);
    const bf16* qp = nsa + row * 1152 + h * 64 + 8 * hi;
    bf16x8 qf[4];
#pragma unroll
    for (int cc = 0; cc < 4; ++cc) qf[cc] = *(const bf16x8*)(qp + 16 * cc);
    unsigned selbits = 0u; if (MODE == AM_SLC) selbits = ((const unsigned*)(ws + WS_SEL))[(size_t)(b * 2 + g) * S_ + qpos];
    const bf16* kb = nsa + (size_t)b * S_ * 1152 + g * 64 + (MODE == AM_SLC ? 640 : 896);
    AttnState st; st.m = 0.f; st.l = 0.f; st.o[0] = f32x16{}; st.o[1] = f32x16{}; st.negm = f32x16{}; st.started = false; st.twait = 0;
    const long long tn0 = (PROBE_SEL != 0) ? (long long)__builtin_amdgcn_s_memtime() : 0ll;
    const int t0 = (MODE == AM_SLC) ? 0 : ((4 * qt - 8 > 0) ? 4 * qt - 8 : 0);
    at_stream<4, MODE>(st, lds, kb, 1152, kb + 128, 1152, nullptr, 0, t0, 4 * qt + 4, qf, qpos, qw0, selbits, tid);
    if (PROBE_SEL >= 4 && PROBE_SEL <= 5 && MODE == AM_SLC && b == 0 && h == 0 && qt == 7 && tid == 0) { const long long tn1 = (long long)__builtin_amdgcn_s_memtime();
        ((float*)(ws + WS_CTL))[100] = (PROBE_SEL == 4) ? (float)(tn1 - tn0) : (float)st.twait; }
    const float lt = red32_sum(st.l), il = 1.f / lt;
    bf16* op = (bf16*)(ws + (MODE == AM_SLC ? WS_OSLC : WS_OWIN)) + row * 384 + h * 64 + 4 * hi;
#pragma unroll
    for (int dh = 0; dh < 2; ++dh)
#pragma unroll
        for (int g4 = 0; g4 < 4; ++g4) { u32x2v w; w.x = cvtpk(st.o[dh][4 * g4] * il, st.o[dh][4 * g4 + 1] * il); w.y = cvtpk(st.o[dh][4 * g4 + 2] * il, st.o[dh][4 * g4 + 3] * il);
            *(u32x2v*)(op + dh * 32 + 8 * g4) = w; }
}
__device__ __forceinline__ void cmp_unit(unsigned char* ws, LAS unsigned char* lds, int b, int g, int qt, int wave_u) {
    const int tid = wave_u * 64 + fresh_lane();
    const int lane = tid & 63, wave = tid >> 6, r32 = lane & 31, hi = lane >> 5;
    const int qpos = qt * 256 + wave * 32 + r32; const size_t row = (size_t)b * S_ + qpos;
    const bf16* kc = (const bf16*)(ws + WS_KCV) + (size_t)(b * 2 + g) * 128 * 64; const bf16* vc = kc + (size_t)8 * 2 * 128 * 64;
    { TileRegs<4> tr; at_load<4>(tr, kc, 64, vc, 64, nullptr, 0, 0, tid); at_store<4>(tr, lds, tid); at_load<4>(tr, kc, 64, vc, 64, nullptr, 0, 1, tid); at_store<4>(tr, lds + AT_BUF, tid); }
    __syncthreads();
    int nvis = (qpos >= 31) ? ((qpos - 31) >> 4) + 1 : 0; if (nvis > 127) nvis = 127;
    float G[16], L[16];
#pragma unroll
    for (int i = 0; i < 16; ++i) { G[i] = 0.f; L[i] = 0.f; }
    const bf16* nsa = (const bf16*)(ws + WS_NSA);
    LAS const unsigned char* vb = lds + AT_V + (4 * hi + ((lane & 15) >> 2)) * 64 + ((lane >> 4) & 1) * 32 + (lane & 3) * 8;
    for (int r3 = 0; r3 < 3; ++r3) {
        const int h = 3 * g + r3;
        const bf16* qp = nsa + row * 1152 + h * 64 + 8 * hi;
        bf16x8 qf[4];
#pragma unroll
        for (int cc = 0; cc < 4; ++cc) qf[cc] = *(const bf16x8*)(qp + 16 * cc);
        f32x16 p[4];
#pragma unroll
        for (int tb = 0; tb < 4; ++tb) {
            LAS const unsigned char* buf = lds + (tb >> 1) * AT_BUF; const int kr = (tb & 1) * 32 + r32;
            p[tb] = f32x16{};
#pragma unroll
            for (int cc = 0; cc < 4; ++cc) { const bf16x8 kf = *(LAS const bf16x8*)(buf + kr * 128 + 16 * ((2 * cc + hi) ^ ((kr >> 1) & 7)));
                p[tb] = __builtin_amdgcn_mfma_f32_32x32x16_bf16(kf, qf[cc], p[tb], 0, 0, 0); }
        }
        float mx = -1e30f;
#pragma unroll
        for (int tb = 0; tb < 4; ++tb)
#pragma unroll
            for (int r = 0; r < 16; ++r) { const int n = 32 * tb + crow(r, hi); p[tb][r] = fminf(p[tb][r], ((float)(nvis - n) - 0.5f) * INFINITY); mx = fmaxf(mx, p[tb][r]); }
        mx = red32_max(mx);
        float sum = 0.f;
#pragma unroll
        for (int tb = 0; tb < 4; ++tb)
#pragma unroll
            for (int r = 0; r < 16; ++r) { p[tb][r] = __builtin_amdgcn_exp2f(p[tb][r] - mx); sum += p[tb][r]; }
        sum = red32_sum(sum);
        const float il = (nvis > 0) ? 1.f / sum : 0.f;
#pragma unroll
        for (int tb = 0; tb < 4; ++tb)
#pragma unroll
            for (int k = 0; k < 4; ++k) { const float a0 = p[tb][4 * k] * il, a1 = p[tb][4 * k + 1] * il, a2 = p[tb][4 * k + 2] * il, a3 = p[tb][4 * k + 3] * il;
                G[4 * tb + k] += (a0 + a1) + (a2 + a3); L[4 * tb + k] += a3; }
        f32x16 o[2] = {f32x16{}, f32x16{}};
#pragma unroll
        for (int tb = 0; tb < 4; ++tb)
#pragma unroll
            for (int s2 = 0; s2 < 2; ++s2) {
                v4u a; a.x = cvtpk(p[tb][8 * s2 + 0], p[tb][8 * s2 + 1]); a.y = cvtpk(p[tb][8 * s2 + 2], p[tb][8 * s2 + 3]); a.z = cvtpk(p[tb][8 * s2 + 4], p[tb][8 * s2 + 5]); a.w = cvtpk(p[tb][8 * s2 + 6], p[tb][8 * s2 + 7]);
                const bf16x8 pf = __builtin_bit_cast(bf16x8, a);
                LAS const unsigned char* vbb = vb + (tb >> 1) * AT_BUF + ((tb & 1) * 2 + s2) * 1024;
#pragma unroll
                for (int dh = 0; dh < 2; ++dh) { const s16x4 lo = vtr(vbb + dh * 4096), hh = vtr(vbb + dh * 4096 + 512);
                    const bf16x8 vf = {lo[0], lo[1], lo[2], lo[3], hh[0], hh[1], hh[2], hh[3]};
                    o[dh] = __builtin_amdgcn_mfma_f32_32x32x16_bf16(vf, pf, o[dh], 0, 0, 0); }
                asm volatile("" ::: "memory");
            }
        bf16* op = (bf16*)(ws + WS_OCMP) + row * 384 + h * 64 + 4 * hi;
#pragma unroll
        for (int dh = 0; dh < 2; ++dh)
#pragma unroll
            for (int g4 = 0; g4 < 4; ++g4) { u32x2v w; w.x = cvtpk(o[dh][4 * g4] * il, o[dh][4 * g4 + 1] * il); w.y = cvtpk(o[dh][4 * g4 + 2] * il, o[dh][4 * g4 + 3] * il);
                *(u32x2v*)(op + dh * 32 + 8 * g4) = w; }
    }
    const int cur = qpos >> 6;
    unsigned key[16], okey[16];
#pragma unroll
    for (int jj = 0; jj < 16; ++jj) {
        const auto sw = __builtin_amdgcn_permlane32_swap(__float_as_uint(L[jj]), __float_as_uint(L[jj]), false, false);
        const float lp = __uint_as_float(hi ? sw[0] : sw[1]);
        L[jj] = lp;
    }
#pragma unroll
    for (int jj = 0; jj < 16; ++jj) {
        const int j = 2 * jj + hi;
        float v = G[jj] + (hi ? L[jj] : (jj > 0 ? L[jj > 0 ? jj - 1 : 0] : 0.f));
        if (j == 0 || j == cur || j == cur - 1) v = INFINITY;
        if (j * 64 > qpos) v = -INFINITY;
        const unsigned u = __float_as_uint(v); const unsigned ord = (u & 0x80000000u) ? ~u : (u | 0x80000000u);
        key[jj] = (ord & ~31u) | (unsigned)(31 - j);
    }
#pragma unroll
    for (int jj = 0; jj < 16; ++jj) { const auto sw = __builtin_amdgcn_permlane32_swap(key[jj], key[jj], false, false); okey[jj] = hi ? sw[0] : sw[1]; }
    unsigned mask = 0;
#pragma unroll
    for (int jj = 0; jj < 16; ++jj) {
        int rank = 0;
#pragma unroll
        for (int kk = 0; kk < 16; ++kk) { rank += (key[kk] > key[jj]) ? 1 : 0; rank += (okey[kk] > key[jj]) ? 1 : 0; }
        if (rank < 16) mask |= 1u << (2 * jj + hi);
    }
    mask = red32_or(mask);
    if (hi == 0) ((unsigned*)(ws + WS_SEL))[(size_t)(b * 2 + g) * S_ + qpos] = mask;
    __syncthreads();
}
__device__ __forceinline__ void lora_rows(unsigned char* ws, int tid) {
    const int gw = blockIdx.x * NWAVES + (tid >> 6), ngw = gridDim.x * NWAVES, lane = tid & 63;
    bf16* kvl = (bf16*)(ws + WS_KVL); const bf16* ql = (const bf16*)(ws + WS_QL); float* ssql = (float*)(ws + WS_SSQL);
    for (int m = gw; m < T_; m += ngw) {
        const unsigned kv = *(const unsigned*)(kvl + (size_t)m * 128 + 2 * lane);
        const float k0 = __uint_as_float(kv << 16), k1 = __uint_as_float(kv & 0xffff0000u);
        const uint2 qv = *(const uint2*)(ql + (size_t)m * 256 + 4 * lane);
        const float q0 = __uint_as_float(qv.x << 16), q1 = __uint_as_float(qv.x & 0xffff0000u), q2 = __uint_as_float(qv.y << 16), q3 = __uint_as_float(qv.y & 0xffff0000u);
        const float sk = wave_sum2(k0 * k0 + k1 * k1), sq = wave_sum2((q0 * q0 + q1 * q1) + (q2 * q2 + q3 * q3));
        const float rk = rsqrtf(sk * (1.f / 128.f) + EPS);
        *(unsigned*)(kvl + (size_t)m * 128 + 2 * lane) = pk2(k0 * rk, k1 * rk);
        if (lane == 0) ssql[m] = sq;
    }
}
__device__ __forceinline__ void post_misc(unsigned char* ws, const float* big, const float* bfg, int tid) {
    const float* mr = (const float*)(ws + WS_MISCRAW); const float* cosM = (const float*)(ws + WS_COSM); const float* sinM = (const float*)(ws + WS_SINM);
    bf16* kr = (bf16*)(ws + WS_KR); float* gm = (float*)(ws + WS_GM);
    for (int idx = blockIdx.x * NTHR + tid; idx < T_ * 64; idx += gridDim.x * NTHR) {
        const int row = idx >> 6, c = idx & 63; const float* r = mr + (size_t)row * 64; const float v = r[c];
        if (c < 32) { const int i = c & 15; const float x1 = r[i], x2 = r[16 + i], cs = cosM[row * 16 + i], sn = sinM[row * 16 + i];
            kr[(size_t)row * 32 + c] = f2bf((c < 16) ? x1 * cs - x2 * sn : x1 * sn + x2 * cs); }
        else if (c < 50) gm[(size_t)row * 32 + (c - 32)] = 1.f / (1.f + __expf(-v));
        else if (c < 54) gm[(size_t)row * 32 + 18 + (c - 50)] = v + big[c - 50];
        else if (c < 58) { const float z = v + bfg[c - 54]; gm[(size_t)row * 32 + 22 + (c - 54)] = fminf(z, 0.f) - __logf(1.f + __expf(-fabsf(z))); }
    }
}

typedef float f32x4v __attribute__((ext_vector_type(4)));
__device__ __forceinline__ void compress_item(unsigned char* ws, LAS unsigned char* lds, const float* cmp_pos, int item, int wave_u) {
    const int lane = fresh_lane(), tid = wave_u * 64 + lane;
    const int nb = item & 7, g = (item >> 3) & 1, b = (item >> 4) & 7, kv = item >> 7;
    const bf16* tok = (const bf16*)(ws + WS_NSA) + (size_t)b * S_ * 1152 + (kv ? 512 : 384) + g * 64;
    const bf16* wt = (const bf16*)(ws + (kv ? WT_CV : WT_CK));
    const int nrow = nb * 16 + (lane & 15), kq = lane >> 4;
    f32x4v acc[4] = {f32x4v{}, f32x4v{}, f32x4v{}, f32x4v{}};
#pragma unroll
    for (int hb = 0; hb < 2; ++hb) {
        v4u t4[4]; f32x4v p0[4], p1[4]; bf16x8 bfr[4][4];
#pragma unroll
        for (int q = 0; q < 4; ++q) {
            const int k = wave_u * 256 + (4 * hb + q) * 32 + kq * 8, l = k >> 6, d = k & 63;
            int trow = 16 * nrow + l; trow = trow < S_ ? trow : S_ - 1;
            t4[q] = *(const v4u*)(tok + (size_t)trow * 1152 + d);
            p0[q] = *(const f32x4v*)(cmp_pos + k); p1[q] = *(const f32x4v*)(cmp_pos + k + 4);
#pragma unroll
            for (int cb = 0; cb < 4; ++cb) bfr[q][cb] = *(const bf16x8*)(wt + (size_t)(cb * 16 + (lane & 15)) * 2048 + k);
        }
        asm volatile("" : "+v"(t4[0]), "+v"(t4[1]), "+v"(t4[2]), "+v"(t4[3]), "+v"(p0[0]), "+v"(p0[1]), "+v"(p0[2]), "+v"(p0[3]), "+v"(p1[0]), "+v"(p1[1]), "+v"(p1[2]), "+v"(p1[3]));
        asm volatile("" : "+v"(bfr[0][0]), "+v"(bfr[0][1]), "+v"(bfr[0][2]), "+v"(bfr[0][3]), "+v"(bfr[1][0]), "+v"(bfr[1][1]), "+v"(bfr[1][2]), "+v"(bfr[1][3]));
        asm volatile("" : "+v"(bfr[2][0]), "+v"(bfr[2][1]), "+v"(bfr[2][2]), "+v"(bfr[2][3]), "+v"(bfr[3][0]), "+v"(bfr[3][1]), "+v"(bfr[3][2]), "+v"(bfr[3][3]));
#pragma unroll
        for (int q = 0; q < 4; ++q) {
            v4u a4;
            a4.x = cvtpk(__uint_as_float(t4[q].x << 16) + p0[q][0], __uint_as_float(t4[q].x & 0xffff0000u) + p0[q][1]); a4.y = cvtpk(__uint_as_float(t4[q].y << 16) + p0[q][2], __uint_as_float(t4[q].y & 0xffff0000u) + p0[q][3]);
            a4.z = cvtpk(__uint_as_float(t4[q].z << 16) + p1[q][0], __uint_as_float(t4[q].z & 0xffff0000u) + p1[q][1]); a4.w = cvtpk(__uint_as_float(t4[q].w << 16) + p1[q][2], __uint_as_float(t4[q].w & 0xffff0000u) + p1[q][3]);
            const bf16x8 af = __builtin_bit_cast(bf16x8, a4);
#pragma unroll
            for (int cb = 0; cb < 4; ++cb) acc[cb] = __builtin_amdgcn_mfma_f32_16x16x32_bf16(af, bfr[q][cb], acc[cb], 0, 0, 0);
        }
    }
    LAS float* red = (LAS float*)lds + wave_u * 1024;
#pragma unroll
    for (int cb = 0; cb < 4; ++cb)
#pragma unroll
        for (int r = 0; r < 4; ++r) red[(4 * (lane >> 4) + r) * 64 + cb * 16 + (lane & 15)] = acc[cb][r];
    __syncthreads();
    bf16* out = (bf16*)(ws + WS_KCV) + (size_t)kv * (8 * 2 * 128 * 64) + ((size_t)(b * 2 + g) * 128 + nb * 16) * 64;
    for (int o = tid; o < 1024; o += NTHR) { float sum = 0.f;
#pragma unroll
        for (int w8 = 0; w8 < 8; ++w8) sum += ((LAS float*)lds)[w8 * 1024 + o];
        out[o] = f2bf(sum); }
    __syncthreads();
}
__device__ __forceinline__ f32x4v mm16(const LAS bf16* A, int lda, int arow0, const LAS bf16* Bt, int ldb, int bcol0, int K, int lane, f32x4v acc) {
    const LAS bf16* ap = A + (arow0 + (lane & 15)) * lda + 8 * (lane >> 4); const LAS bf16* bp = Bt + (bcol0 + (lane & 15)) * ldb + 8 * (lane >> 4);
    for (int k = 0; k < K; k += 32) acc = __builtin_amdgcn_mfma_f32_16x16x32_bf16(*(const LAS bf16x8*)(ap + k), *(const LAS bf16x8*)(bp + k), acc, 0, 0, 0);
    return acc;
}
constexpr int ML_LD = 72;
constexpr int ML_STRIDE = 3 * 64 * ML_LD * 2 + 256;
__device__ __forceinline__ void mlocal_item(unsigned char* ws, LAS unsigned char* lds, const float* convw, const float* convb, const float* big, const float* bfg, int chunk0, int wave_u) {
    const int lane = fresh_lane(), tid = wave_u * 64 + lane;
    const int h = (chunk0 >> 5) & 3, b = chunk0 >> 7;
    LAS bf16* WQ = (LAS bf16*)lds;
    LAS bf16* WK = WQ + 64 * ML_LD;
    const bf16* cm = (const bf16*)(ws + WS_CM);
#define ML_PTRS(ch) const int chunk = chunk0 + (ch); const int c = chunk & 31; const int row0 = b * S_ + c * 64; LAS bf16* XS = WK + 64 * ML_LD + (ch) * (ML_STRIDE / 2); \
    LAS bf16* VT = XS + 64 * ML_LD; LAS bf16* WKT = VT + 64 * ML_LD; LAS float* wl = (LAS float*)(WKT + 64 * ML_LD); (void)c; (void)row0; (void)XS; (void)VT; (void)WKT; (void)wl; (void)chunk;
    {
        v4u gx[2][4], gv[2]; const int l = tid >> 3, ch0 = (tid & 7) * 8;
#pragma unroll
        for (int ch = 0; ch < 2; ++ch) { ML_PTRS(ch) const int row = row0 + l, s = c * 64 + l;
#pragma unroll
            for (int j = 0; j < 4; ++j) gx[ch][j] = (s - 3 + j >= 0) ? *(const v4u*)(cm + (size_t)(row - 3 + j) * 768 + h * 64 + ch0) : v4u{0u, 0u, 0u, 0u};
            gv[ch] = *(const v4u*)(cm + (size_t)row * 768 + 256 + h * 64 + ch0); }
        asm volatile("" : "+v"(gx[0][0]), "+v"(gx[0][1]), "+v"(gx[0][2]), "+v"(gx[0][3]), "+v"(gx[1][0]), "+v"(gx[1][1]), "+v"(gx[1][2]), "+v"(gx[1][3]), "+v"(gv[0]), "+v"(gv[1]));
#pragma unroll
        for (int ch = 0; ch < 2; ++ch) { ML_PTRS(ch) const int row = row0 + l;
            float a[8];
#pragma unroll
            for (int i = 0; i < 8; ++i) a[i] = convb[h * 64 + ch0 + i];
#pragma unroll
            for (int j = 0; j < 4; ++j) { const v4u x4 = gx[ch][j];
                const float* cw = convw + j * 256 + h * 64 + ch0;
                a[0] += cw[0] * __uint_as_float(x4.x << 16); a[1] += cw[1] * __uint_as_float(x4.x & 0xffff0000u); a[2] += cw[2] * __uint_as_float(x4.y << 16); a[3] += cw[3] * __uint_as_float(x4.y & 0xffff0000u);
                a[4] += cw[4] * __uint_as_float(x4.z << 16); a[5] += cw[5] * __uint_as_float(x4.z & 0xffff0000u); a[6] += cw[6] * __uint_as_float(x4.w << 16); a[7] += cw[7] * __uint_as_float(x4.w & 0xffff0000u); }
            v4u o4; float r[8];
#pragma unroll
            for (int i = 0; i < 8; ++i) r[i] = a[i] / (1.f + __expf(-a[i]));
            o4.x = cvtpk(r[0], r[1]); o4.y = cvtpk(r[2], r[3]); o4.z = cvtpk(r[4], r[5]); o4.w = cvtpk(r[6], r[7]);
            *(v4u*)((bf16*)(ws + WS_XC) + (size_t)row * 256 + h * 64 + ch0) = o4;
            *(LAS v4u*)(XS + l * ML_LD + ch0) = o4;
            const v4u v4 = gv[ch];
            VT[(ch0 + 0) * ML_LD + l] = (bf16)(v4.x & 0xffffu); VT[(ch0 + 1) * ML_LD + l] = (bf16)(v4.x >> 16); VT[(ch0 + 2) * ML_LD + l] = (bf16)(v4.y & 0xffffu); VT[(ch0 + 3) * ML_LD + l] = (bf16)(v4.y >> 16);
            VT[(ch0 + 4) * ML_LD + l] = (bf16)(v4.z & 0xffffu); VT[(ch0 + 5) * ML_LD + l] = (bf16)(v4.z >> 16); VT[(ch0 + 6) * ML_LD + l] = (bf16)(v4.w & 0xffffu); VT[(ch0 + 7) * ML_LD + l] = (bf16)(v4.w >> 16);
        }
    }
    {
        const int e = tid >> 3, d0 = (tid & 7) * 8;
        *(LAS v4u*)(WQ + e * ML_LD + d0) = *(const v4u*)((const bf16*)(ws + WT_QM) + h * 4096 + e * 64 + d0);
        *(LAS v4u*)(WK + e * ML_LD + d0) = *(const v4u*)((const bf16*)(ws + WT_KM) + h * 4096 + e * 64 + d0);
    }
    if (wave_u < 2) { ML_PTRS(wave_u)
        const float* mr = (const float*)(ws + WS_MISCRAW) + (size_t)(row0 + lane) * 64;
        const float z = mr[54 + h] + bfg[h]; float lf = fminf(z, 0.f) - __logf(1.f + __expf(-fabsf(z)));
        const float ig = mr[50 + h] + big[h];
#pragma unroll
        for (int o = 1; o < 64; o <<= 1) { const float t = bperm(lf, lane - o); if (lane >= o) lf += t; }
        const float bL = __int_as_float(__builtin_amdgcn_readlane(__float_as_int(lf), 63));
        const float a = bL - lf + ig; const float mx = wave_max2(a);
        wl[lane] = __expf(a - mx);
        if (lane == 0) { ((float*)(ws + WS_ML))[chunk] = mx; ((float*)(ws + WS_BL))[chunk] = bL; }
    }
    __syncthreads();
#pragma unroll
    for (int ch = 0; ch < 2; ++ch) { ML_PTRS(ch)
        const int lb = wave_u & 3; const bool isk = wave_u >= 4;
        const LAS bf16* Wt = isk ? WK : WQ;
        bf16* og = (bf16*)(ws + (isk ? WS_MK : WS_MQ)) + (size_t)(row0 + 16 * lb + 4 * (lane >> 4)) * 256 + h * 64 + (lane & 15);
        float w4[4];
#pragma unroll
        for (int r = 0; r < 4; ++r) w4[r] = wl[16 * lb + 4 * (lane >> 4) + r];
#pragma unroll
        for (int eb = 0; eb < 4; ++eb) {
            f32x4v acc = mm16(XS, ML_LD, 16 * lb, Wt, ML_LD, 16 * eb, 64, lane, f32x4v{});
            if (!isk) {
#pragma unroll
                for (int r = 0; r < 4; ++r) og[(size_t)r * 256 + 16 * eb] = f2bf(acc[r] * 0.125f);
            } else {
                bf16 kb[4];
#pragma unroll
                for (int r = 0; r < 4; ++r) { kb[r] = f2bf(acc[r]); og[(size_t)r * 256 + 16 * eb] = kb[r]; }
                u32x2v w2; w2.x = cvtpk(bf2f(kb[0]) * w4[0], bf2f(kb[1]) * w4[1]); w2.y = cvtpk(bf2f(kb[2]) * w4[2], bf2f(kb[3]) * w4[3]);
                *(LAS u32x2v*)(WKT + (16 * eb + (lane & 15)) * ML_LD + 16 * lb + 4 * (lane >> 4)) = w2;
            }
        }
    }
    __syncthreads();
#pragma unroll
    for (int ch = 0; ch < 2; ++ch) { ML_PTRS(ch)
        float* ct = (float*)(ws + WS_CT) + (size_t)chunk * 4096;
#pragma unroll
        for (int i = 0; i < 2; ++i) { const int blk = wave_u * 2 + i, eb = blk >> 2, db = blk & 3;
            const f32x4v acc = mm16(VT, ML_LD, 16 * eb, WKT, ML_LD, 16 * db, 64, lane, f32x4v{});
#pragma unroll
            for (int r = 0; r < 4; ++r) ct[(16 * eb + 4 * (lane >> 4) + r) * 64 + 16 * db + (lane & 15)] = acc[r]; }
    }
    if (tid < 128) { ML_PTRS(tid >> 6)
        const int d = tid & 63; float n = 0.f; const LAS bf16* wr_ = WKT + d * ML_LD;
        for (int l = 0; l < 64; ++l) n += bf2f(wr_[l]);
        ((float*)(ws + WS_NL))[chunk * 64 + d] = n; }
#undef ML_PTRS
    __syncthreads();
}
__device__ __forceinline__ void mscan_item(unsigned char* ws, int item, int wave_u) {
    const int tid = wave_u * 64 + fresh_lane();
    const int bh = item / 9, part = item % 9;
    if (part == 8 && tid >= 64) return;
    float* base; size_t stride;
    if (part < 8) { base = (float*)(ws + WS_CT) + (size_t)bh * 32 * 4096 + part * 512 + tid; stride = 4096; } else { base = (float*)(ws + WS_NL) + (size_t)bh * 32 * 64 + tid; stride = 64; }
    const float* ML = (const float*)(ws + WS_ML); const float* BL = (const float*)(ws + WS_BL); float* MPv = (float*)(ws + WS_MP);
    float cl[32];
#pragma unroll
    for (int c = 0; c < 32; ++c) cl[c] = base[(size_t)c * stride];
    float Cv = 0.f, m = 0.f;
#pragma unroll
    for (int c = 0; c < 32; ++c) {
        const float ml = ML[bh * 32 + c], bl = BL[bh * 32 + c];
        base[(size_t)c * stride] = Cv;
        if (part == 8 && tid == 0) MPv[bh * 32 + c] = m;
        const float mn = fmaxf(bl + m, ml);
        Cv = __expf(bl + m - mn) * Cv + __expf(ml - mn) * cl[c]; m = mn;
    }
}
constexpr int MO_STRIDE = 5 * 64 * ML_LD * 2 + 64 * 65 * 4 + 6 * 64 * 4;
__device__ __forceinline__ void mout_item(unsigned char* ws, LAS unsigned char* lds, const float* gmh, const float* skip, int chunk0, int wave_u) {
    const int lane = fresh_lane(), tid = wave_u * 64 + lane;
    const int h = (chunk0 >> 5) & 3, b = chunk0 >> 7;
    const float* gm = (const float*)(ws + WS_GM);
#define MO_PTRS(ch) const int chunk = chunk0 + (ch); const int row0 = b * S_ + (chunk & 31) * 64; LAS unsigned char* cb_ = lds + (ch) * MO_STRIDE; \
    LAS bf16* QS = (LAS bf16*)cb_; LAS bf16* KS = QS + 64 * ML_LD; LAS bf16* VT = KS + 64 * ML_LD; LAS bf16* CP = VT + 64 * ML_LD; LAS bf16* SW = CP + 64 * ML_LD; \
    LAS float* HS = (LAS float*)(SW + 64 * ML_LD); LAS float* bs = HS + 64 * 65; LAS float* us = bs + 64; LAS float* ns = us + 64; LAS float* mts = ns + 64; LAS float* ints = mts + 64; LAS float* dinv = ints + 64; \
    (void)row0; (void)QS; (void)KS; (void)VT; (void)CP; (void)SW; (void)HS; (void)bs; (void)us; (void)ns; (void)mts; (void)ints; (void)dinv; (void)chunk;
    {
        v4u gq[2], gk[2], gv[2]; f32x4v gc0[2], gc1[2];
        const int l = tid >> 3, c0 = (tid & 7) * 8;
#pragma unroll
        for (int ch = 0; ch < 2; ++ch) { MO_PTRS(ch) const int row = row0 + l;
            gq[ch] = *(const v4u*)((const bf16*)(ws + WS_MQ) + (size_t)row * 256 + h * 64 + c0); gk[ch] = *(const v4u*)((const bf16*)(ws + WS_MK) + (size_t)row * 256 + h * 64 + c0);
            gv[ch] = *(const v4u*)((const bf16*)(ws + WS_CM) + (size_t)row * 768 + 256 + h * 64 + c0);
            const float* ct = (const float*)(ws + WS_CT) + (size_t)chunk * 4096 + l * 64 + c0;
            gc0[ch] = *(const f32x4v*)ct; gc1[ch] = *(const f32x4v*)(ct + 4); }
        asm volatile("" : "+v"(gq[0]), "+v"(gq[1]), "+v"(gk[0]), "+v"(gk[1]), "+v"(gv[0]), "+v"(gv[1]), "+v"(gc0[0]), "+v"(gc0[1]), "+v"(gc1[0]), "+v"(gc1[1]));
#pragma unroll
        for (int ch = 0; ch < 2; ++ch) { MO_PTRS(ch)
            *(LAS v4u*)(QS + l * ML_LD + c0) = gq[ch]; *(LAS v4u*)(KS + l * ML_LD + c0) = gk[ch];
            const v4u v4 = gv[ch];
            VT[(c0 + 0) * ML_LD + l] = (bf16)(v4.x & 0xffffu); VT[(c0 + 1) * ML_LD + l] = (bf16)(v4.x >> 16); VT[(c0 + 2) * ML_LD + l] = (bf16)(v4.y & 0xffffu); VT[(c0 + 3) * ML_LD + l] = (bf16)(v4.y >> 16);
            VT[(c0 + 4) * ML_LD + l] = (bf16)(v4.z & 0xffffu); VT[(c0 + 5) * ML_LD + l] = (bf16)(v4.z >> 16); VT[(c0 + 6) * ML_LD + l] = (bf16)(v4.w & 0xffffu); VT[(c0 + 7) * ML_LD + l] = (bf16)(v4.w >> 16);
            const f32x4v c0v = gc0[ch], c1v = gc1[ch];
            v4u cw; cw.x = cvtpk(c0v[0], c0v[1]); cw.y = cvtpk(c0v[2], c0v[3]); cw.z = cvtpk(c1v[0], c1v[1]); cw.w = cvtpk(c1v[2], c1v[3]);
            *(LAS v4u*)(CP + l * ML_LD + c0) = cw; }
    }
    if (wave_u < 2) { MO_PTRS(wave_u)
        const float ig = gm[(size_t)(row0 + lane) * 32 + 18 + h]; float lf = gm[(size_t)(row0 + lane) * 32 + 22 + h];
#pragma unroll
        for (int o = 1; o < 64; o <<= 1) { const float t = bperm(lf, lane - o); if (lane >= o) lf += t; }
        const float u = ig - lf; float cu = u;
#pragma unroll
        for (int o = 1; o < 64; o <<= 1) { const float t = bperm(cu, lane - o); if (lane >= o) cu = fmaxf(cu, t); }
        const float mprev = ((const float*)(ws + WS_MP))[chunk];
        const float mt = lf + fmaxf(mprev, cu);
        bs[lane] = lf; us[lane] = u; mts[lane] = mt; ints[lane] = __expf(lf + mprev - mt); ns[lane] = ((const float*)(ws + WS_NL))[chunk * 64 + lane];
    }
    __syncthreads();
#pragma unroll
    for (int ch = 0; ch < 2; ++ch) { MO_PTRS(ch)
#pragma unroll
        for (int i = 0; i < 2; ++i) { const int blk = wave_u * 2 + i, lb = blk >> 2, sb = blk & 3;
            f32x4v acc = f32x4v{};
            if (sb <= lb) acc = mm16(QS, ML_LD, 16 * lb, KS, ML_LD, 16 * sb, 64, lane, acc);
            const int sidx = 16 * sb + (lane & 15); const float usv = us[sidx];
#pragma unroll
            for (int r = 0; r < 4; ++r) { const int l = 16 * lb + 4 * (lane >> 4) + r;
                const float v = (sidx <= l) ? acc[r] * __expf(bs[l] + usv - mts[l]) : 0.f;
                SW[l * ML_LD + sidx] = f2bf(v); } }
    }
    __syncthreads();
    if (tid < 128) { MO_PTRS(tid >> 6)
        const int l = tid & 63; float qn = 0.f, ssum = 0.f;
        for (int d = 0; d < 64; ++d) { qn += bf2f(QS[l * ML_LD + d]) * ns[d]; ssum += bf2f(SW[l * ML_LD + d]); }
        const float den = ints[l] * qn + ssum;
        dinv[l] = 1.f / fmaxf(fabsf(den), __expf(-mts[l]));
    }
    f32x4v hq[2][2], hs2[2][2];
#pragma unroll
    for (int ch = 0; ch < 2; ++ch) { MO_PTRS(ch)
#pragma unroll
        for (int i = 0; i < 2; ++i) { const int blk = wave_u * 2 + i, lb = blk >> 2, eb = blk & 3;
            hq[ch][i] = mm16(QS, ML_LD, 16 * lb, CP, ML_LD, 16 * eb, 64, lane, f32x4v{});
            hs2[ch][i] = mm16(SW, ML_LD, 16 * lb, VT, ML_LD, 16 * eb, 16 * lb + 16 <= 32 ? 32 : 64, lane, f32x4v{}); }
    }
    __syncthreads();
#pragma unroll
    for (int ch = 0; ch < 2; ++ch) { MO_PTRS(ch)
#pragma unroll
        for (int i = 0; i < 2; ++i) { const int blk = wave_u * 2 + i, lb = blk >> 2, eb = blk & 3; const int e = 16 * eb + (lane & 15);
#pragma unroll
            for (int r = 0; r < 4; ++r) { const int l = 16 * lb + 4 * (lane >> 4) + r;
                const float og = bf2f(((const bf16*)(ws + WS_CM))[(size_t)(row0 + l) * 768 + 512 + h * 64 + e]);
                HS[l * 65 + e] = (ints[l] * hq[ch][i][r] + hs2[ch][i][r]) * dinv[l] / (1.f + __expf(-og)); } }
    }
    __syncthreads();
#pragma unroll
    for (int ch = 0; ch < 2; ++ch) { MO_PTRS(ch)
        const int l = tid >> 3, e0 = (tid & 7) * 8, row = row0 + l;
        float v[8]; float mu = 0.f;
#pragma unroll
        for (int i = 0; i < 8; ++i) { v[i] = HS[l * 65 + e0 + i]; mu += v[i]; }
        mu += sxf<1>(mu); mu += sxf<2>(mu); mu += sxf<4>(mu); mu *= (1.f / 64.f);
        float var = 0.f;
#pragma unroll
        for (int i = 0; i < 8; ++i) { const float dl = v[i] - mu; var += dl * dl; }
        var += sxf<1>(var); var += sxf<2>(var); var += sxf<4>(var);
        const float rs = rsqrtf(var * (1.f / 64.f) + EPS);
        const v4u x4 = *(const v4u*)((const bf16*)(ws + WS_XC) + (size_t)row * 256 + h * 64 + e0);
        float xv[8]; xv[0] = __uint_as_float(x4.x << 16); xv[1] = __uint_as_float(x4.x & 0xffff0000u); xv[2] = __uint_as_float(x4.y << 16); xv[3] = __uint_as_float(x4.y & 0xffff0000u);
        xv[4] = __uint_as_float(x4.z << 16); xv[5] = __uint_as_float(x4.z & 0xffff0000u); xv[6] = __uint_as_float(x4.w << 16); xv[7] = __uint_as_float(x4.w & 0xffff0000u);
        float r[8];
#pragma unroll
        for (int i = 0; i < 8; ++i) r[i] = (v[i] - mu) * rs * gmh[h * 64 + e0 + i] + skip[h * 64 + e0 + i] * xv[i];
        v4u w4; w4.x = cvtpk(r[0], r[1]); w4.y = cvtpk(r[2], r[3]); w4.z = cvtpk(r[4], r[5]); w4.w = cvtpk(r[6], r[7]);
        *(v4u*)((bf16*)(ws + WS_HB) + (size_t)row * D_ + 768 + h * 64 + e0) = w4;
    }
#undef MO_PTRS
    __syncthreads();
}

__global__ void __launch_bounds__(NTHR, 2) mega(MP p_unused) {
    extern __shared__ __attribute__((aligned(16))) unsigned char lds_raw[];
    LAS unsigned char* lds = (LAS unsigned char*)lds_raw;
    const int wave0 = __builtin_amdgcn_readfirstlane((int)threadIdx.x >> 6);
    const int tid0 = wave0 * 64 + fresh_lane();
    const int xcc = (int)(__builtin_amdgcn_s_getreg((3 << 11) | 20) & 7u);
    volatile LAS unsigned* MISC = (volatile LAS unsigned*)(lds + MISC_OFF);
    for (int u = tid0; u < (LDS_BYTES - RING_BYTES) / 4; u += NTHR) ((LAS unsigned*)(lds + RING_BYTES))[u] = 0u;
    __syncthreads();
    typedef const __attribute__((address_space(4))) MP* kmp_t;
    kmp_t kp0 = (kmp_t)__builtin_amdgcn_kernarg_segment_ptr();
    unsigned char* ws0 = kp0->ws; const int coop = kp0->coop, ph_lo = kp0->ph_lo, ph_hi = kp0->ph_hi;
    XcdBarrier bar; bar.bar = (unsigned*)(ws0 + WS_CTL) + CW_BAR; bar.x = 0; bar.st = nullptr;
    if (coop) bar = xcd_barrier_post((unsigned*)(ws0 + WS_CTL) + CW_BAR, MISC + 8, tid0);
    if (coop == 2) cooperative_groups::this_grid().sync();
    int ph = ph_lo;
    if (ph == 0) {
        const MPK p{kp0}; ph_p0(p, lds, wave0 * 64 + fresh_lane()); ph = 1;
        if (ph < ph_hi) xcd_barrier(bar, wave0 * 64 + fresh_lane());
    }
    bool second = false;
    for (; ph < ph_hi; ++ph) {
        kmp_t kp = kp0; asm volatile("" : "+s"(kp));
        const MPK p{kp}; unsigned char* ws = kp->ws;
#define TID_ (wave0 * 64 + fresh_lane())
#define GW_ (blockIdx.x * NWAVES + wave0)
#define NGW_ (gridDim.x * NWAVES)
        const int l = (ph - 1) / PPL, ty = (ph == 0) ? -1 : (ph == NPH - 1) ? -2 : (ph - 1) % PPL;
        const float* modl = (const float*)(ws + WS_MOD) + (size_t)l * 8 * 6144;
        if (ty == -2) { norm_rows<true, true>(ws + WS_HB, PIN(I_GFIN), nullptr, nullptr, nullptr, p.k->out, GW_, NGW_, fresh_lane());
            if (PROBE_SEL != 0 && blockIdx.x == 0 && TID_ == 0) { asm volatile("s_waitcnt vmcnt(0)" ::: "memory"); p.k->out[0] = ((const float*)(ws + WS_CTL))[100] * 0.001f; } }
        else if (ty == 0 && (PHM & 2)) ph_prep(p, l, lds, TID_);
        else if (ty == 1 && (PHM & 4)) {
            pg8::Gemm g{(const bf16*)(ws + WS_HB), (const bf16*)(ws + WT_IN), T_, 2560, D_}; pg8::StaticOrder S; S.init(T_, 2560, gridDim.x, blockIdx.x);
            pg8::EpiIn E{ws, PIN(I_BIG) + l * 4, PIN(I_BFG) + l * 4};
            pg8::gemm_phase<pg8::EpiIn, pg8::StaticOrder, true, true>(lds, g, S, E, wave0);
            late_transposes(p, l, lds, TID_, 640 % (int)gridDim.x);
        }
        else if (ty == 2 && (PHM & 64)) {
            { pg8::Gemm g{(const bf16*)(ws + WS_KVL), (const bf16*)(ws + WT_UKV), T_, 768, 128}; pg8::StaticOrder S; S.init(T_, 768, gridDim.x, blockIdx.x);
              pg8::EpiUKV E{(bf16*)(ws + WS_KVM), (const float*)(ws + WS_SSKV)}; pg8::gemm_phase<pg8::EpiUKV, pg8::StaticOrder, true, true>(lds, g, S, E, wave0); }
            { pg8::Gemm g{(const bf16*)(ws + WS_QL), (const bf16*)(ws + WT_UQ), T_, 768, 256}; pg8::StaticOrder S; S.init(T_, 768, gridDim.x, blockIdx.x);
              pg8::EpiPlain E{(bf16*)(ws + WS_OSLC), 768}; pg8::gemm_phase<pg8::EpiPlain, pg8::StaticOrder, true, true>(lds, g, S, E, wave0); }
            post_misc(ws, PIN(I_BIG) + l * 4, PIN(I_BFG) + l * 4, TID_);
            unsigned* ctrs = (unsigned*)(ws + WS_CTL) + 8192 + ph * 256 + (second ? 128 : 0); int ks = 0;
            for (;;) { const int it = next_item_q(ctrs, lds, wave0, 96, xcc, ks); if (it < 0) break; const int b = it >> 16, j = it & 0xffff;
                if (j < 64) mlocal_item(ws, lds, PIN(I_CONVW) + l * 1024, PIN(I_CONVB) + l * 256, PIN(I_BIG) + l * 4, PIN(I_BFG) + l * 4, b * 128 + 2 * j, wave0);
                else { const int k = j - 64; compress_item(ws, lds, PIN(I_CMPPOS) + l * 2048, ((k >> 4) << 7) | (b << 4) | (k & 15), wave0); } }
        }
        else if (ty == 3 && (PHM & 128)) {
            unsigned* ctrs = (unsigned*)(ws + WS_CTL) + 8192 + ph * 256 + (second ? 128 : 0); int ks = 0;
            for (;;) { const int it = next_item_q(ctrs, lds, wave0, second ? 64 : 100, xcc, ks); if (it < 0) break; const int b = it >> 16, j = it & 0xffff;
                if (second && (REP_MASK & (1 << 20)) && j >= 48) continue; if (second && (REP_MASK & (1 << 21)) && j < 48) continue;
                if (j < 18) mla_unit(ws, lds, b, j % 6, 7 - j / 6, wave0);
                else if (j < 34) cmp_unit(ws, lds, b, (j - 18) >> 3, 7 - ((j - 18) & 7), wave0);
                else if (j < 64) { const int u = j - 16; mla_unit(ws, lds, b, u % 6, 7 - u / 6, wave0); }
                else mscan_item(ws, b * 36 + (j - 64), wave0); }
        }
        else if (ty == 4 && (PHM & 256)) {
            unsigned* ctrs = (unsigned*)(ws + WS_CTL) + 8192 + ph * 256 + (second ? 128 : 0); int ks = 0;
            for (;;) { const int it = next_item_q(ctrs, lds, wave0, 160, xcc, ks); if (it < 0) break; const int b = it >> 16, j = it & 0xffff;
                if (second && (REP_MASK & (1 << 16)) && j >= 96) continue; if (second && (REP_MASK & (1 << 17)) && j < 96) continue;
                if (j < 36) nsa_branch_unit<AM_SLC>(ws, lds, b, j % 6, 7 - j / 6, wave0);
                else if (j < 84) nsa_branch_unit<AM_WINDOW>(ws, lds, b, (j - 36) % 6, 7 - (j - 36) / 6, wave0);
                else if (j < 96) { const int u = j - 48; nsa_branch_unit<AM_SLC>(ws, lds, b, u % 6, 7 - u / 6, wave0); }
                else mout_item(ws, lds, PIN(I_GMH) + l * 256, PIN(I_SKIP) + l * 256, b * 128 + 2 * (j - 96), wave0); }
        }
        else if (ty == 5) ph_mixnorm(p, l, TID_);
        else if (ty == 6 && (PHM & 8)) {
            pg8::Gemm g{(const bf16*)(ws + WS_HB), (const bf16*)(ws + WT_OUT), T_, D_, D_}; pg8::StaticOrder S; S.init(T_, D_, gridDim.x, blockIdx.x);
            pg8::EpiRes E{(l == 0) ? PIN(I_X) : nullptr, (const bf16*)p.k->out, (bf16*)p.k->out, modl + 2048};
            pg8::gemm_phase<pg8::EpiRes, pg8::StaticOrder, true, true>(lds, g, S, E, wave0);
        }
        else if (ty == 7) norm_rows<true>(p.k->out, PIN(I_GN2) + l * D_, modl + 3072, modl + 4096, (bf16*)(ws + WS_HB), nullptr, GW_, NGW_, fresh_lane());
        else if (ty == 8 && (PHM & 16)) {
            pg8::Gemm g{(const bf16*)(ws + WS_HB), (const bf16*)(ws + WT_GU), T_, 2 * FF, D_}; pg8::StaticOrder S; S.init(T_, 2 * FF, gridDim.x, blockIdx.x);
            pg8::EpiGU E{(bf16*)(ws + WS_ACT)};
            pg8::gemm_phase<pg8::EpiGU, pg8::StaticOrder, true, true>(lds, g, S, E, wave0);
            if (l + 1 < DEPTH) early_transposes(p, l + 1, lds, TID_, 1408 % (int)gridDim.x);
        }
        else if (ty == 9 && (PHM & 32)) {
            pg8::Gemm g{(const bf16*)(ws + WS_ACT), (const bf16*)(ws + WT_DOWN), T_, D_, FF}; pg8::StaticOrder S; S.init(T_, D_, gridDim.x, blockIdx.x);
            pg8::EpiRes E{nullptr, (const bf16*)p.k->out, (l == DEPTH - 1) ? (bf16*)(ws + WS_HB) : (bf16*)p.k->out, modl + 5120};
            pg8::gemm_phase<pg8::EpiRes, pg8::StaticOrder, true, true>(lds, g, S, E, wave0);
        }
        if (REP_MASK != 0 && ty >= 0 && ((REP_MASK >> ty) & 1) && !second) { second = true; --ph; } else second = false;
        if (ph + 1 < ph_hi) xcd_barrier(bar, wave0 * 64 + fresh_lane());
    }
}

extern "C" void kernel_launch(void* const* d_in, const int* in_sizes, int n_in, void* d_out, int out_size, void* d_ws, size_t ws_size, hipStream_t stream) {
    if (n_in != N_IN || ws_size < WS_END) { fprintf(stderr, "kernel_launch: unexpected n_in %d / ws %zu\n", n_in, ws_size); return; }
    static int inited = 0;
    if (!inited) { if (hipFuncSetAttribute((const void*)mega, hipFuncAttributeMaxDynamicSharedMemorySize, LDS_BYTES) != hipSuccess) fprintf(stderr, "hipFuncSetAttribute failed\n"); inited = 1; }
    unsigned char* ws = (unsigned char*)d_ws;
    MP base{}; for (int i = 0; i < N_IN; ++i) base.in[i] = (const float*)d_in[i]; base.out = (float*)d_out; base.ws = ws;
    (void)hipMemsetAsync(ws + WS_CTL, 0, CTL_ZERO_BYTES, stream);
    static int grid = 0;
    if (!grid) {
        int dev = 0, cus = 0, per_cu = 0;
        (void)hipGetDevice(&dev); (void)hipDeviceGetAttribute(&cus, hipDeviceAttributeMultiprocessorCount, dev);
        if (hipOccupancyMaxActiveBlocksPerMultiprocessor(&per_cu, (const void*)mega, NTHR, LDS_BYTES) != hipSuccess || per_cu < 1) { fprintf(stderr, "kernel_launch: occupancy query says %d blocks per CU\n", per_cu); per_cu = 1; }
        (void)hipGetLastError();
        grid = cus;
    }
    MP a = base; a.ph_lo = 0; a.ph_hi = NPH; a.coop = 1;
    void* args[] = {&a};
    const hipError_t e = hipLaunchCooperativeKernel((const void*)mega, dim3(grid), dim3(NTHR), args, LDS_BYTES, stream);
    if (e != hipSuccess) fprintf(stderr, "kernel_launch: cooperative launch failed: %s (grid %d)\n", hipGetErrorString(e), grid);
}
```

```cpp
#include <hip/hip_runtime.h>
#include <cstdint>
#include <cstdio>
#include <type_traits>
#include <hip/hip_cooperative_groups.h>

constexpr int B_ = 8, S_ = 2048, T_ = B_ * S_, D_ = 1024, DIN = 2362, FF = 2816, DEPTH = 2;
constexpr float EPS = 1e-6f;
constexpr float LOG2E = 1.4426950408889634f;
constexpr float QSCALE = 0.125f * LOG2E;
constexpr float MSCALE = 0.10206207261596577f * LOG2E;
enum { I_X = 0, I_C, I_POS, I_GN1, I_GN2, I_WADA, I_BADA, I_WIN, I_CMPPOS, I_WCK, I_WCV, I_GOA, I_GQL, I_WUQ, I_GKVL, I_WUKV, I_GOB,
       I_CONVW, I_CONVB, I_WQM, I_WKM, I_BIG, I_BFG, I_GMH, I_SKIP, I_WOUT, I_WGU, I_WDOWN, I_GFIN, N_IN };

constexpr size_t MiB = 1u << 20;
constexpr size_t WS_CTL = 0;
constexpr size_t WS_MOD = 1 * MiB;
constexpr size_t WS_COSP = WS_MOD + 512 * 1024;
constexpr size_t WS_SINP = WS_COSP + 512 * 1024;
constexpr size_t WS_COSM = WS_SINP + 512 * 1024;
constexpr size_t WS_SINM = WS_COSM + 1 * MiB;
constexpr size_t WS_SSQL = WS_SINM + 1 * MiB;
constexpr size_t WS_SSKV = WS_SSQL + 64 * 1024;
constexpr size_t WS_ML = WS_SSKV + 64 * 1024;
constexpr size_t WS_BL = WS_ML + 4096;
constexpr size_t WS_MP = WS_BL + 4096;
constexpr size_t WS_NL = WS_MP + 4096;
constexpr size_t WS_WT = 8 * MiB;
constexpr size_t WS_RAW = WS_WT;
constexpr size_t WS_HB = 34 * MiB;
constexpr size_t WS_NSA = 66 * MiB;
constexpr size_t WS_KVL = 102 * MiB;
constexpr size_t WS_QL = 106 * MiB;
constexpr size_t WS_CM = 114 * MiB;
constexpr size_t WS_GM = 138 * MiB;
constexpr size_t WS_KM = 140 * MiB;
constexpr size_t WS_QM = 158 * MiB;
constexpr size_t WS_VM = 176 * MiB;
constexpr size_t WS_KCV = 188 * MiB;
constexpr size_t WS_OCMP = 189 * MiB;
constexpr size_t WS_SEL = 201 * MiB;
constexpr size_t WS_XC = 202 * MiB;
constexpr size_t WS_MQ = 210 * MiB;
constexpr size_t WS_MK = 218 * MiB;
constexpr size_t WS_CT = 226 * MiB;
constexpr size_t WS_MISCRAW = 242 * MiB;
constexpr size_t WS_KVM = 140 * MiB;
constexpr size_t WS_KR = 246 * MiB;
constexpr size_t WS_OSLC = 164 * MiB;
constexpr size_t WS_OWIN = 176 * MiB;
constexpr size_t WS_ACT = 66 * MiB;
constexpr size_t WS_END = 256 * MiB;
static_assert(WS_NL + 1024 * 64 * 4 <= WS_WT, "tab");
static_assert(WS_ACT + (size_t)T_ * FF * 2 <= WS_KCV, "act overlay");

typedef unsigned short bf16;
__device__ __forceinline__ float bf2f(bf16 v) { return __uint_as_float(((unsigned)v) << 16); }
__device__ __forceinline__ bf16 f2bf(float f) { unsigned u = __float_as_uint(f); return (bf16)((u + 0x7fffu + ((u >> 16) & 1u)) >> 16); }
__device__ __forceinline__ float sigmoidf_(float x) { return __builtin_amdgcn_rcpf(1.f + __expf(-x)); }
__device__ __forceinline__ float siluf_(float x) { return x * __builtin_amdgcn_rcpf(1.f + __expf(-x)); }
__device__ __forceinline__ float wave_sum(float v) {
#pragma unroll
    for (int o = 1; o < 64; o <<= 1) v += __shfl_xor(v, o);
    return v;
}

__device__ __forceinline__ int fresh_lane() { int l; asm volatile("v_mbcnt_lo_u32_b32 %0, -1, 0\n\tv_mbcnt_hi_u32_b32 %0, -1, %0" : "=&v"(l)); return l; }
template <int M> __device__ __forceinline__ float sxf(float v) { static_assert(M >= 1 && M < 32, "swizzle xor mask"); return __int_as_float(__builtin_amdgcn_ds_swizzle(__float_as_int(v), (M << 10) | 0x1f)); }
__device__ __forceinline__ float red32_max(float v) { auto r = __builtin_amdgcn_permlane32_swap(__float_as_uint(v), __float_as_uint(v), false, false); return fmaxf(__uint_as_float(r[0]), __uint_as_float(r[1])); }
__device__ __forceinline__ float red32_sum(float v) { auto r = __builtin_amdgcn_permlane32_swap(__float_as_uint(v), __float_as_uint(v), false, false); return __uint_as_float(r[0]) + __uint_as_float(r[1]); }
__device__ __forceinline__ unsigned red32_or(unsigned v) { auto r = __builtin_amdgcn_permlane32_swap(v, v, false, false); return r[0] | r[1]; }
__device__ __forceinline__ float bperm(float v, int src_lane) { return __int_as_float(__builtin_amdgcn_ds_bpermute(src_lane << 2, __float_as_int(v))); }
__device__ __forceinline__ float wave_sum2(float v) { v += sxf<1>(v); v += sxf<2>(v); v += sxf<4>(v); v += sxf<8>(v); v += sxf<16>(v); return red32_sum(v); }
__device__ __forceinline__ float wave_max2(float v) { v = fmaxf(v, sxf<1>(v)); v = fmaxf(v, sxf<2>(v)); v = fmaxf(v, sxf<4>(v)); v = fmaxf(v, sxf<8>(v)); v = fmaxf(v, sxf<16>(v)); return red32_max(v); }
namespace pg8 {
#define PG8_LAS __attribute__((address_space(3)))
typedef unsigned short bf16_t;
typedef short bf16x8 __attribute__((ext_vector_type(8)));
typedef float f32x4 __attribute__((ext_vector_type(4)));
typedef unsigned u32x4 __attribute__((ext_vector_type(4)));
constexpr int BM = 256, BK = 64, HALF = 128, HTB = HALF * BK * 2  , STAGE_BYTES = 8 * HTB, NXCD = 8, WGM = 8;

__host__ __device__ __forceinline__ int lds_byte(int r, int c) { const int st = (r >> 4) * 2 + (c >> 5), rr = r & 15, cc = c & 31, ob = rr * 64 + cc * 2; return st * 1024 + (ob ^ (((ob >> 9) & 1) << 5)); }
__host__ __device__ __forceinline__ void stage_rc(int b, int& R, int& C) { const int st = b / 1024, sb = b % 1024, swz = sb ^ (((sb >> 9) & 1) << 5); R = (st >> 1) * 16 + swz / 64; C = (st & 1) * 32 + (swz % 64) / 2; }
__host__ __device__ __forceinline__ int perm32(int rho) { const int n = rho >> 4, i = rho & 15; return 8 * (i >> 2) + 4 * n + (i & 3); }

struct Unit { int pm, pn; };
struct Gemm { const bf16_t* A; const bf16_t* Bt; int M, N, K; };

struct StaticOrder {
    int nM, nN, nwg, G, c;
    __host__ __device__ void init(int M, int N, int G_, int c_) { nM = M / BM; nN = N / BM; nwg = nM * nN; G = G_; c = c_; }
    __host__ __device__ bool next(int i, Unit& u) const {
        const long L = (long)i * G + c; if (L >= nwg) return false;
        int wgid = (int)L; { const int q = nwg / NXCD, r = nwg % NXCD, xcd = wgid % NXCD, off = wgid / NXCD; wgid = (xcd < r ? xcd * (q + 1) : r * (q + 1) + (xcd - r) * q) + off; }
        const int nig = WGM * nN, gid = wgid / nig, fm = gid * WGM, gsz = (nM - fm) < WGM ? (nM - fm) : WGM;
        u.pm = fm + ((wgid % nig) % gsz); u.pn = (wgid % nig) / gsz; return true;
    }
    __device__ __forceinline__ void a_ready(const Unit&) const {}
    __device__ __forceinline__ void done(const Unit&) const {}
};

__device__ __forceinline__ unsigned cvt_pk_bf16(float lo, float hi) { unsigned r; asm volatile("v_cvt_pk_bf16_f32 %0, %1, %2" : "=v"(r) : "v"(lo), "v"(hi)); return r; }
typedef float f32x2 __attribute__((ext_vector_type(2)));

typedef unsigned u32x4 __attribute__((ext_vector_type(4)));
typedef unsigned u32x2 __attribute__((ext_vector_type(2)));
struct EpiIn {
    static constexpr bool PERM = true, AFTER_DRAIN = false;
    unsigned char* ws; const float *big, *bfg;
#define EPI_ROWS(...) _Pragma("unroll") for (int ai = 0; ai < 2; ++ai) _Pragma("unroll") for (int m = 0; m < 4; ++m) { \
        const int row = u.pm * BM + ai * HALF + wr * 64 + m * 16 + fr; float v[8]; \
        _Pragma("unroll") for (int i = 0; i < 4; ++i) { v[i] = acc[ai][bj][m][0][i]; v[4 + i] = acc[ai][bj][m][1][i]; } \
        asm volatile("" : "+v"(v[0]), "+v"(v[1]), "+v"(v[2]), "+v"(v[3]), "+v"(v[4]), "+v"(v[5]), "+v"(v[6]), "+v"(v[7])); \
        __VA_ARGS__ asm volatile("" ::: "memory"); }
#define EPI_PACK(w) u32x4 w; w.x = cvt_pk_bf16(v[0], v[1]); w.y = cvt_pk_bf16(v[2], v[3]); w.z = cvt_pk_bf16(v[4], v[5]); w.w = cvt_pk_bf16(v[6], v[7]);
    __device__ __forceinline__ void operator()(const f32x4 (&acc)[2][2][4][2], const Unit& u, int wr, int wc, int fr, int fq) const {
        half<0>(acc, u, wr, wc, fr, fq); half<1>(acc, u, wr, wc, fr, fq);
    }
    template <int bj> __device__ __forceinline__ void half(const f32x4 (&acc)[2][2][4][2], const Unit& u, int wr, int wc, int fr, int fq) const {
        {
            const int hb = 2 * u.pn + bj;
            int cb = 32 * wc + 8 * fq; asm volatile("" : "+v"(cb), "+v"(fr));
            if (hb <= 8) {
                bf16_t* nsa = (bf16_t*)(ws + WS_NSA) + hb * 128 + cb;
                const bool rope_hb = (hb <= 3) || hb == 5 || hb == 7;
                if (rope_hb) {
                    const float* cosP = (const float*)(ws + WS_COSP); const float* sinP = (const float*)(ws + WS_SINP);
                    const bool mine = ((wc & 1) == 0) && fq < 2; const float sg = (fq == 0) ? -1.f : 1.f; const float sc = (hb < 3) ? QSCALE : 1.f;
                    f32x4 tc0 = {0.f, 0.f, 0.f, 0.f}, tc1 = tc0, ts0 = tc0, ts1 = tc0;
                    if (mine) { const int r0 = u.pm * BM + wr * 64 + fr; tc0 = *(const f32x4*)(cosP + r0 * 8); tc1 = *(const f32x4*)(cosP + r0 * 8 + 4); ts0 = *(const f32x4*)(sinP + r0 * 8); ts1 = *(const f32x4*)(sinP + r0 * 8 + 4); }
                    EPI_ROWS({
                        float pv[8];
                        _Pragma("unroll") for (int i = 0; i < 8; ++i) pv[i] = sxf<16>(v[i]);
                        const f32x4 c0 = tc0, c1 = tc1, s0 = ts0, s1 = ts1;
                        if (mine && (ai * 4 + m) < 7) { const int nx = ai * 4 + m + 1; const int rn = u.pm * BM + (nx >> 2) * HALF + wr * 64 + (nx & 3) * 16 + fr;
                            tc0 = *(const f32x4*)(cosP + rn * 8); tc1 = *(const f32x4*)(cosP + rn * 8 + 4); ts0 = *(const f32x4*)(sinP + rn * 8); ts1 = *(const f32x4*)(sinP + rn * 8 + 4); }
                        if (mine) {
                            _Pragma("unroll") for (int i = 0; i < 4; ++i) { v[i] = v[i] * c0[i] + sg * pv[i] * s0[i]; v[4 + i] = v[4 + i] * c1[i] + sg * pv[4 + i] * s1[i]; }
                        }
                        _Pragma("unroll") for (int i = 0; i < 8; ++i) v[i] *= sc;
                        EPI_PACK(w) *(u32x4*)(nsa + (size_t)row * 1152) = w;
                    })
                } else {
                    EPI_ROWS({ EPI_PACK(w) *(u32x4*)(nsa + (size_t)row * 1152) = w; })
                }
            } else if (hb <= 11) {
                bf16_t* dst = (hb == 9) ? (bf16_t*)(ws + WS_KVL) + cb : (bf16_t*)(ws + WS_QL) + (hb - 10) * 128 + cb;
                const int ld = (hb == 9) ? 128 : 256;
                float* ssq = (hb == 9) ? (float*)(ws + WS_SSKV) : (float*)(ws + WS_SSQL);
                EPI_ROWS({ EPI_PACK(w) *(u32x4*)(dst + (size_t)row * ld) = w;
                    float sq = 0.f;
                    _Pragma("unroll") for (int i = 0; i < 8; ++i) sq += v[i] * v[i];
                    sq += sxf<16>(sq); sq = red32_sum(sq);
                    if (fq == 0) atomicAdd(ssq + row, sq); })
            } else if (hb <= 17) {
                bf16_t* cm = (bf16_t*)(ws + WS_CM) + (hb - 12) * 128 + cb;
                EPI_ROWS({ EPI_PACK(w) *(u32x4*)(cm + (size_t)row * 768) = w; })
            } else if (hb == 18) {
                float* mr = (float*)(ws + WS_MISCRAW) + cb;
                if (wc < 2) { EPI_ROWS({ *(f32x4*)(mr + (size_t)row * 64) = (f32x4){v[0], v[1], v[2], v[3]}; *(f32x4*)(mr + (size_t)row * 64 + 4) = (f32x4){v[4], v[5], v[6], v[7]}; }) }
            }
        }
    }
#undef EPI_ROWS
#undef EPI_PACK
};
struct EpiUKV {
    static constexpr bool PERM = true, AFTER_DRAIN = false;
    bf16_t* kvm; const float* sskv;
    __device__ __forceinline__ void operator()(const f32x4 (&acc)[2][2][4][2], const Unit& u, int wr, int wc, int fr, int fq) const {
        asm volatile("" : "+v"(fq), "+v"(fr));
        const int col0 = u.pn * BM + wc * 32 + 8 * fq;
        float rs8[8];
#pragma unroll
        for (int i = 0; i < 8; ++i) rs8[i] = sskv[u.pm * BM + (i >> 2) * HALF + wr * 64 + (i & 3) * 16 + fr];
#pragma unroll
        for (int i = 0; i < 8; ++i) rs8[i] = rsqrtf(rs8[i] * (1.f / 128.f) + EPS);
#pragma unroll
        for (int ai = 0; ai < 2; ++ai)
#pragma unroll
            for (int m = 0; m < 4; ++m) { const int row = u.pm * BM + ai * HALF + wr * 64 + m * 16 + fr; bf16_t* rowp = kvm + (size_t)row * 768 + col0;
                const float rs = rs8[ai * 4 + m];
#pragma unroll
                for (int bj = 0; bj < 2; ++bj) { const f32x4 a = acc[ai][bj][m][0] * rs, b = acc[ai][bj][m][1] * rs;
                    u32x4 w; w.x = cvt_pk_bf16(a[0], a[1]); w.y = cvt_pk_bf16(a[2], a[3]); w.z = cvt_pk_bf16(b[0], b[1]); w.w = cvt_pk_bf16(b[2], b[3]);
                    *(u32x4*)(rowp + bj * HALF) = w; } }
    }
};
struct EpiPlain {
    static constexpr bool PERM = true, AFTER_DRAIN = false;
    bf16_t* out; int ld;
    __device__ __forceinline__ void operator()(const f32x4 (&acc)[2][2][4][2], const Unit& u, int wr, int wc, int fr, int fq) const {
        asm volatile("" : "+v"(fq), "+v"(fr));
        const int col0 = u.pn * BM + wc * 32 + 8 * fq;
#pragma unroll
        for (int ai = 0; ai < 2; ++ai)
#pragma unroll
            for (int m = 0; m < 4; ++m) { bf16_t* rowp = out + (size_t)(u.pm * BM + ai * HALF + wr * 64 + m * 16 + fr) * ld + col0;
#pragma unroll
                for (int bj = 0; bj < 2; ++bj) { const f32x4 a = acc[ai][bj][m][0], b = acc[ai][bj][m][1];
                    u32x4 w; w.x = cvt_pk_bf16(a[0], a[1]); w.y = cvt_pk_bf16(a[2], a[3]); w.z = cvt_pk_bf16(b[0], b[1]); w.w = cvt_pk_bf16(b[2], b[3]);
                    *(u32x4*)(rowp + bj * HALF) = w; } }
    }
};
struct EpiRes {
    static constexpr bool PERM = true, AFTER_DRAIN = false;
    const float* xin_f; const bf16_t* xin_b; bf16_t* xout; const float* gate;
    __device__ __forceinline__ void operator()(const f32x4 (&acc)[2][2][4][2], const Unit& u, int wr, int wc, int fr, int fq) const {
        asm volatile("" : "+v"(fq), "+v"(fr));
        const int b = (u.pm * BM) / S_; const int col0 = u.pn * BM + wc * 32 + 8 * fq;
        f32x4 gv[2][2];
#pragma unroll
        for (int bj = 0; bj < 2; ++bj)
#pragma unroll
            for (int n = 0; n < 2; ++n) gv[bj][n] = *(const f32x4*)(gate + (size_t)b * 6144 + col0 + bj * HALF + n * 4);
        if (xin_f != nullptr) {
#pragma unroll
            for (int ai = 0; ai < 2; ++ai)
#pragma unroll
                for (int m = 0; m < 4; ++m) { const size_t off = (size_t)(u.pm * BM + ai * HALF + wr * 64 + m * 16 + fr) * D_ + col0;
#pragma unroll
                    for (int bj = 0; bj < 2; ++bj) { const f32x4 x0 = *(const f32x4*)(xin_f + off + bj * HALF), x1 = *(const f32x4*)(xin_f + off + bj * HALF + 4);
                        const f32x4 r0 = x0 + gv[bj][0] * acc[ai][bj][m][0], r1 = x1 + gv[bj][1] * acc[ai][bj][m][1];
                        u32x4 w; w.x = cvt_pk_bf16(r0[0], r0[1]); w.y = cvt_pk_bf16(r0[2], r0[3]); w.z = cvt_pk_bf16(r1[0], r1[1]); w.w = cvt_pk_bf16(r1[2], r1[3]);
                        *(u32x4*)(xout + off + bj * HALF) = w; } }
        } else {
#pragma unroll
            for (int ai = 0; ai < 2; ++ai)
#pragma unroll
                for (int m = 0; m < 4; ++m) { const size_t off = (size_t)(u.pm * BM + ai * HALF + wr * 64 + m * 16 + fr) * D_ + col0;
                    u32x4 xr[2];
#pragma unroll
                    for (int bj = 0; bj < 2; ++bj) xr[bj] = *(const u32x4*)(xin_b + off + bj * HALF);
#pragma unroll
                    for (int bj = 0; bj < 2; ++bj) { const u32x4 q = xr[bj]; const f32x4 a0 = acc[ai][bj][m][0], a1 = acc[ai][bj][m][1], g0 = gv[bj][0], g1 = gv[bj][1];
                        const float r0 = __uint_as_float(q.x << 16) + g0[0] * a0[0], r1 = __uint_as_float(q.x & 0xffff0000u) + g0[1] * a0[1];
                        const float r2 = __uint_as_float(q.y << 16) + g0[2] * a0[2], r3 = __uint_as_float(q.y & 0xffff0000u) + g0[3] * a0[3];
                        const float r4 = __uint_as_float(q.z << 16) + g1[0] * a1[0], r5 = __uint_as_float(q.z & 0xffff0000u) + g1[1] * a1[1];
                        const float r6 = __uint_as_float(q.w << 16) + g1[2] * a1[2], r7 = __uint_as_float(q.w & 0xffff0000u) + g1[3] * a1[3];
                        u32x4 w; w.x = cvt_pk_bf16(r0, r1); w.y = cvt_pk_bf16(r2, r3); w.z = cvt_pk_bf16(r4, r5); w.w = cvt_pk_bf16(r6, r7);
                        *(u32x4*)(xout + off + bj * HALF) = w; } }
        }
    }
};
struct EpiGU {
    static constexpr bool PERM = true, AFTER_DRAIN = false;
    bf16_t* act;
    __device__ __forceinline__ void operator()(const f32x4 (&acc)[2][2][4][2], const Unit& u, int wr, int wc, int fr, int fq) const {
        asm volatile("" : "+v"(fq), "+v"(fr));
        const int col0 = u.pn * HALF + wc * 32 + 8 * fq;
#pragma unroll
        for (int ai = 0; ai < 2; ++ai)
#pragma unroll
            for (int m = 0; m < 4; ++m) { const int row = u.pm * BM + ai * HALF + wr * 64 + m * 16 + fr; float o[8];
#pragma unroll
                for (int n = 0; n < 2; ++n)
#pragma unroll
                    for (int i = 0; i < 4; ++i) { const float g = acc[ai][0][m][n][i], up = acc[ai][1][m][n][i]; o[4 * n + i] = g * __builtin_amdgcn_rcpf(1.f + __expf(-g)) * up; }
                u32x4 w; w.x = cvt_pk_bf16(o[0], o[1]); w.y = cvt_pk_bf16(o[2], o[3]); w.z = cvt_pk_bf16(o[4], o[5]); w.w = cvt_pk_bf16(o[6], o[7]);
                *(u32x4*)(act + (size_t)row * FF + col0) = w; }
    }
};
template <class Epi, class Sched, bool ALIGN_EPI = false, bool SP2 = false>
__device__ __forceinline__ void gemm_phase(PG8_LAS unsigned char* lds, const Gemm g, const Sched& S, const Epi& E, int wid_in) {
    const int wid = __builtin_amdgcn_readfirstlane(wid_in), lane = fresh_lane(), tid = wid * 64 + lane, wr = wid >> 2, wc = wid & 3;
    const int K = g.K, nt = K / BK;
    unsigned voffA[2], voffB[2];
#pragma unroll
    for (int i = 0; i < 2; ++i) { int R, C; stage_rc(tid * 16 + i * 8192, R, C); const int Rb = Epi::PERM ? ((R & ~31) + perm32(R & 31)) : R;
        voffA[i] = (unsigned)(R * K + C) * 2u; voffB[i] = (unsigned)(Rb * K + C) * 2u; }
    const size_t kstep = (size_t)(BK * 2);
    const size_t hstep = (size_t)HALF * K * 2;
    const size_t tstep = 2 * hstep;
    const unsigned ldsw = (unsigned)wid * 1024u;
    const int aoff = lds_byte(wr * 64 + (lane & 15), (lane >> 4) * 8), boff = lds_byte(wc * 32 + (lane & 15), (lane >> 4) * 8);
#define PG8_SA(b, h) (((b) * 2 + (h)) * HTB)
#define PG8_SB(b, h) ((4 + (b) * 2 + (h)) * HTB)
#define PG8_STAGE(bufoff, gbase, voff) do { _Pragma("unroll") for (int _i = 0; _i < 2; ++_i) \
        __builtin_amdgcn_global_load_lds((const unsigned*)((const char*)(gbase) + (voff)[_i]), (PG8_LAS unsigned*)(lds + (bufoff) + ldsw + _i * 8192), 16, 0, 0); } while (0)
#define PG8_LDA(dst, b, h) do { _Pragma("unroll") for (int m = 0; m < 4; ++m) _Pragma("unroll") for (int k = 0; k < 2; ++k) dst[m][k] = *(const PG8_LAS bf16x8*)(lds + PG8_SA(b, h) + aoff + m * 2048 + k * 1024); } while (0)
#define PG8_LDB(dst, b, h) do { _Pragma("unroll") for (int n = 0; n < 2; ++n) _Pragma("unroll") for (int k = 0; k < 2; ++k) dst[n][k] = *(const PG8_LAS bf16x8*)(lds + PG8_SB(b, h) + boff + n * 2048 + k * 1024); } while (0)
#define PG8_MMA(ai, bj, At, Bt) do { __builtin_amdgcn_s_setprio(1); _Pragma("unroll") for (int m = 0; m < 4; ++m) _Pragma("unroll") for (int n = 0; n < 2; ++n) _Pragma("unroll") for (int k = 0; k < 2; ++k) \
        acc[ai][bj][m][n] = __builtin_amdgcn_mfma_f32_16x16x32_bf16(Bt[n][k], At[m][k], acc[ai][bj][m][n], 0, 0, 0); __builtin_amdgcn_s_setprio(0); } while (0)
#define PG8_WAIT_V(n) asm volatile("s_waitcnt vmcnt(" #n ")" ::: "memory")
#define PG8_WAIT_L(n) asm volatile("s_waitcnt lgkmcnt(" #n ")" ::: "memory")
#define PG8_BAR __builtin_amdgcn_s_barrier()
#define PG8_SCHED __builtin_amdgcn_sched_barrier(0)
    Unit cur, nxt; int ui = 0;
    if (!S.next(0, cur)) return;
    f32x4 acc[2][2][4][2];
#pragma unroll
    for (int a = 0; a < 2; ++a)
#pragma unroll
        for (int b = 0; b < 2; ++b)
#pragma unroll
            for (int m = 0; m < 4; ++m)
#pragma unroll
                for (int n = 0; n < 2; ++n) acc[a][b][m][n] = (f32x4){0.f, 0.f, 0.f, 0.f};
    bf16x8 At[4][2], B0[2][2], B1[2][2];
    const char* cA = (const char*)g.A + (size_t)cur.pm * tstep; const char* cB = (const char*)g.Bt + (size_t)cur.pn * tstep;
    S.a_ready(cur);
    if constexpr (SP2) {
        PG8_STAGE(PG8_SB(0, 0), cB, voffB); PG8_STAGE(PG8_SB(0, 1), cB + hstep, voffB); PG8_STAGE(PG8_SA(0, 0), cA, voffA); PG8_STAGE(PG8_SA(0, 1), cA + hstep, voffA);
        if (wr == 1) PG8_BAR;
        PG8_WAIT_V(2); PG8_BAR;
        PG8_STAGE(PG8_SB(1, 0), cB + kstep, voffB); PG8_STAGE(PG8_SA(1, 0), cA + kstep, voffA); PG8_STAGE(PG8_SB(1, 1), cB + hstep + kstep, voffB);
        PG8_WAIT_V(6); PG8_BAR;
    } else {
        PG8_STAGE(PG8_SB(0, 0), cB, voffB); PG8_STAGE(PG8_SA(0, 0), cA, voffA); PG8_STAGE(PG8_SB(0, 1), cB + hstep, voffB); PG8_STAGE(PG8_SA(0, 1), cA + hstep, voffA);
        if (wr == 1) PG8_BAR;
        PG8_WAIT_V(4); PG8_BAR;
        PG8_STAGE(PG8_SB(1, 0), cB + kstep, voffB); PG8_STAGE(PG8_SA(1, 0), cA + kstep, voffA); PG8_STAGE(PG8_SB(1, 1), cB + hstep + kstep, voffB);
        PG8_WAIT_V(6); PG8_BAR;
    }
    for (;;) {
        const bool has_next = S.next(ui + 1, nxt);
        const char* nA = has_next ? (const char*)g.A + (size_t)nxt.pm * tstep : cA; const char* nB = has_next ? (const char*)g.Bt + (size_t)nxt.pn * tstep : cB;
        for (int t = 0; t < nt; t += 2) {
            const bool last = (t == nt - 2);
            const char* a1 = cA + (size_t)(t + 1) * kstep;
            const char* a2 = last ? nA : cA + (size_t)(t + 2) * kstep; const char* b2 = last ? nB : cB + (size_t)(t + 2) * kstep;
            const char* a3 = a2 + kstep; const char* b3 = b2 + kstep;
            if (last && has_next) S.a_ready(nxt);
            if constexpr (SP2) {
            PG8_LDB(B0, 0, 0); PG8_LDB(B1, 0, 1); PG8_SCHED; PG8_LDA(At, 0, 0); PG8_STAGE(PG8_SA(1, 1), a1 + hstep, voffA);
            PG8_WAIT_V(8); PG8_WAIT_L(0); PG8_BAR; PG8_MMA(0, 0, At, B0); PG8_MMA(0, 1, At, B1); PG8_BAR; PG8_SCHED;
            PG8_LDA(At, 0, 1); PG8_STAGE(PG8_SB(0, 0), b2, voffB); PG8_STAGE(PG8_SB(0, 1), b2 + hstep, voffB); PG8_STAGE(PG8_SA(0, 0), a2, voffA);
            PG8_WAIT_V(8); PG8_WAIT_L(0); PG8_BAR; PG8_MMA(1, 0, At, B0); PG8_MMA(1, 1, At, B1); PG8_BAR; PG8_SCHED;
            PG8_LDB(B0, 1, 0); PG8_LDB(B1, 1, 1); PG8_SCHED; PG8_LDA(At, 1, 0); PG8_STAGE(PG8_SA(0, 1), a2 + hstep, voffA);
            PG8_WAIT_V(8); PG8_WAIT_L(0); PG8_BAR; PG8_MMA(0, 0, At, B0); PG8_MMA(0, 1, At, B1); PG8_BAR; PG8_SCHED;
            PG8_LDA(At, 1, 1); PG8_STAGE(PG8_SB(1, 0), b3, voffB); PG8_STAGE(PG8_SB(1, 1), b3 + hstep, voffB); PG8_STAGE(PG8_SA(1, 0), a3, voffA);
            PG8_WAIT_V(8); PG8_WAIT_L(0); PG8_BAR; PG8_MMA(1, 0, At, B0); PG8_MMA(1, 1, At, B1); PG8_BAR; PG8_SCHED;
            } else {
            PG8_LDB(B0, 0, 0); PG8_SCHED; PG8_LDA(At, 0, 0); PG8_STAGE(PG8_SA(1, 1), a1 + hstep, voffA);
            PG8_WAIT_L(8); PG8_BAR; PG8_WAIT_L(0); PG8_MMA(0, 0, At, B0); PG8_BAR; PG8_SCHED;
            PG8_LDB(B1, 0, 1); PG8_STAGE(PG8_SB(0, 0), b2, voffB);
            PG8_BAR; PG8_WAIT_L(0); PG8_MMA(0, 1, At, B1); PG8_BAR;
            PG8_LDA(At, 0, 1); PG8_STAGE(PG8_SA(0, 0), a2, voffA);
            PG8_BAR; PG8_WAIT_L(0); PG8_MMA(1, 0, At, B0); PG8_BAR; PG8_SCHED;
            PG8_STAGE(PG8_SB(0, 1), b2 + hstep, voffB);
            PG8_WAIT_V(6); PG8_BAR; PG8_MMA(1, 1, At, B1); PG8_BAR;
            PG8_LDB(B0, 1, 0); PG8_SCHED; PG8_LDA(At, 1, 0); PG8_STAGE(PG8_SA(0, 1), a2 + hstep, voffA);
            PG8_WAIT_L(8); PG8_BAR; PG8_WAIT_L(0); PG8_MMA(0, 0, At, B0); PG8_BAR; PG8_SCHED;
            PG8_LDB(B1, 1, 1); PG8_STAGE(PG8_SB(1, 0), b3, voffB);
            PG8_BAR; PG8_WAIT_L(0); PG8_MMA(0, 1, At, B1); PG8_BAR;
            PG8_LDA(At, 1, 1); PG8_STAGE(PG8_SA(1, 0), a3, voffA);
            PG8_BAR; PG8_WAIT_L(0); PG8_MMA(1, 0, At, B0); PG8_BAR; PG8_SCHED;
            PG8_STAGE(PG8_SB(1, 1), b3 + hstep, voffB);
            PG8_WAIT_V(6); PG8_BAR; PG8_MMA(1, 1, At, B1); PG8_BAR;
            }
        }
        if constexpr (ALIGN_EPI) { if (wr == 0) PG8_BAR; }
        if constexpr (!Epi::AFTER_DRAIN) { const int ln = fresh_lane(); E(acc, cur, wr, wc, ln & 15, ln >> 4); S.done(cur); }
        if (!has_next) break;
#pragma unroll
        for (int a = 0; a < 2; ++a)
#pragma unroll
            for (int b = 0; b < 2; ++b)
#pragma unroll
                for (int m = 0; m < 4; ++m)
#pragma unroll
                    for (int n = 0; n < 2; ++n) acc[a][b][m][n] = (f32x4){0.f, 0.f, 0.f, 0.f};
        cur = nxt; cA = nA; cB = nB; ++ui;
        if constexpr (ALIGN_EPI) { if (wr == 1) PG8_BAR; }
    }
    PG8_WAIT_V(0);
    if constexpr (!ALIGN_EPI) { if (wr == 0) PG8_BAR; }
    PG8_BAR;
    if constexpr (Epi::AFTER_DRAIN) { const int ln = fresh_lane(); E.fused(acc, cur, wr, wc, ln & 15, ln >> 4, lds, wid, ln); S.done(cur); }
#undef PG8_SA
#undef PG8_SB
#undef PG8_STAGE
#undef PG8_LDA
#undef PG8_LDB
#undef PG8_MMA
#undef PG8_WAIT_V
#undef PG8_WAIT_L
#undef PG8_BAR
#undef PG8_SCHED
}
}

#define GAS __attribute__((address_space(1)))
#define LAS __attribute__((address_space(3)))
typedef float f32x4 __attribute__((ext_vector_type(4)));
typedef unsigned v4u __attribute__((ext_vector_type(4)));
typedef GAS unsigned gu32;
#define XB_TMO      128
#define XB_XCNT(j)  (256  + 64 * (j))
#define XB_XSUB(j)  (1280 + 64 * (j))
#define XB_XGEN(j)  (2304 + 64 * (j))
#define XB_TOP      3328
#define XB_TOPGEN   3392
#define XCD_BAR_WORDS 3456
#define XB_SPIN_CAP (1u << 18)

__device__ __forceinline__ unsigned xb_ld(unsigned* p)              { return __hip_atomic_load(p, __ATOMIC_RELAXED, __HIP_MEMORY_SCOPE_AGENT); }
__device__ __forceinline__ unsigned xb_add(unsigned* p, unsigned v) { return __hip_atomic_fetch_add(p, v, __ATOMIC_RELAXED, __HIP_MEMORY_SCOPE_AGENT); }
__device__ __forceinline__ unsigned xb_xcc_id() { return (unsigned)__builtin_amdgcn_s_getreg((3 << 11) | 20) & 0xFu; }
#define XB_SPIN(cond, bar) do { unsigned _sp = 0; while (cond) { __builtin_amdgcn_s_sleep(1); \
    if ((++_sp & 255u) == 0u) { if (xb_ld(&(bar)[XB_TMO])) break; if (_sp > XB_SPIN_CAP) { atomicAdd(&(bar)[XB_TMO], 1u); break; } } } } while (0)

struct XcdBarrier {
    unsigned* bar; unsigned x;
    volatile LAS unsigned* st;
};

__device__ __forceinline__ XcdBarrier xcd_barrier_post(unsigned* bar, volatile LAS unsigned* st, int tid) {
    XcdBarrier b; b.bar = bar; b.x = xb_xcc_id(); b.st = st;
    if (tid == 0) (void)xb_add(&bar[XB_XCNT(b.x)], 1u);
    return b;
}
__device__ __forceinline__ void xcd_barrier_complete(unsigned* bar, unsigned x, unsigned& nloc, unsigned& nx) {
    const unsigned G = gridDim.x * gridDim.y * gridDim.z;
    unsigned sum, cnt, mine, sp = 0u;
    for (;;) {
        sum = 0u; cnt = 0u; mine = 0u;
#pragma unroll
        for (unsigned j = 0; j < 16; ++j) { const unsigned c = xb_ld(&bar[XB_XCNT(j)]); sum += c; cnt += (c > 0u) ? 1u : 0u; mine = (j == x) ? c : mine; }
        if (sum == G) break;
        __builtin_amdgcn_s_sleep(1);
        if ((++sp & 255u) == 0u) { if (xb_ld(&bar[XB_TMO])) break; if (sp > XB_SPIN_CAP) { atomicAdd(&bar[XB_TMO], 1u); break; } }
    }
    nloc = mine > 0u ? mine : 1u; nx = cnt > 0u ? cnt : 1u;
}

__device__ __forceinline__ void xcd_barrier(const XcdBarrier& b, int tid) {
    asm volatile("s_waitcnt vmcnt(0)" ::: "memory");
    __syncthreads();
    if (tid == 0) {
        unsigned* bar = b.bar;
        __builtin_amdgcn_s_waitcnt(0);
        unsigned nloc = b.st[0], nx = b.st[1];
        if (nloc == 0u) { xcd_barrier_complete(bar, b.x, nloc, nx); b.st[0] = nloc; b.st[1] = nx; }
        const unsigned old = xb_add(&bar[XB_XSUB(b.x)], 1u);
        const unsigned gen = old / nloc;
        if (old + 1u == (gen + 1u) * nloc) {
            __builtin_amdgcn_fence(__ATOMIC_RELEASE, "agent");
            asm volatile("s_waitcnt vmcnt(0)" ::: "memory");
            const unsigned og = xb_add(&bar[XB_TOP], 1u);
            const unsigned tg = og / nx;
            if (og + 1u == (tg + 1u) * nx) xb_add(&bar[XB_TOPGEN], 1u);
            else XB_SPIN(xb_ld(&bar[XB_TOPGEN]) == tg, bar);
            __builtin_amdgcn_fence(__ATOMIC_ACQUIRE, "agent");
            xb_add(&bar[XB_XGEN(b.x)], 1u);
            asm volatile("s_waitcnt vmcnt(0)" ::: "memory");
        } else {
            XB_SPIN(xb_ld(&bar[XB_XGEN(b.x)]) == gen, bar);
            __builtin_amdgcn_fence(__ATOMIC_ACQUIRE, "agent");
            asm volatile("s_waitcnt vmcnt(0)" ::: "memory");
        }
    }
    __syncthreads();
}

constexpr int NTHR = 512, NWAVES = 8;
constexpr int RING_BYTES = 131072, MISC_OFF = RING_BYTES + 320, LDS_BYTES = 147456;
constexpr int CW_BAR = 4096;
constexpr size_t CTL_ZERO_BYTES = 64 * 1024;
constexpr size_t WT_IN = WS_WT, WT_OUT = WT_IN + (size_t)2560 * 1024 * 2, WT_GU = WT_OUT + (size_t)1024 * 1024 * 2, WT_DOWN = WT_GU + (size_t)5632 * 1024 * 2,
                 WT_UQ = WT_DOWN + (size_t)1024 * 2816 * 2, WT_UKV = WT_UQ + (size_t)768 * 256 * 2, WT_CK = WT_UKV + (size_t)768 * 128 * 2, WT_CV = WT_CK + (size_t)64 * 2048 * 2,
                 WT_QM = WT_CV + (size_t)64 * 2048 * 2, WT_KM = WT_QM + 4 * 64 * 64 * 2, WT_END = WT_KM + 4 * 64 * 64 * 2;
static_assert(WT_END <= WS_HB, "weights");
constexpr int NPH = 22, PPL = 10;
constexpr int PROBE_SEL = 0;
constexpr int REP_MASK = 0;
#ifndef PHM
#define PHM 0xffff
#endif
struct MP { const float* in[N_IN]; float* out; unsigned char* ws; int ph_lo, ph_hi, coop, pad; };

struct MPK {
    const __attribute__((address_space(4))) MP* k;
    struct InArr { const __attribute__((address_space(4))) MP* k; __device__ __forceinline__ const float* operator[](int i) const { return k->in[i]; } };
    __device__ __forceinline__ InArr in_() const { return InArr{k}; }
};
#define PIN(i) (p.k->in[i])
__device__ __forceinline__ unsigned pk2(float lo, float hi) { return (unsigned)f2bf(lo) | ((unsigned)f2bf(hi) << 16); }
struct MapId { int n; __device__ __forceinline__ int operator()(int c) const { return c < n ? c : -1; } };
struct MapIn { __device__ __forceinline__ int operator()(int c) const {
    if (c < 1152) return c; if (c < 1280) return 1426 + (c - 1152); if (c < 1536) return 1170 + (c - 1280); if (c < 2304) return 1586 + (c - 1536);
    if (c < 2336) return 1554 + (c - 2304); if (c < 2354) return 1152 + (c - 2336); if (c < 2362) return c; return -1; } };
struct MapGU { __device__ __forceinline__ int operator()(int c) const { const int t = c >> 8, w = c & 255; return (w < 128) ? t * 128 + w : FF + t * 128 + (w - 128); } };
template <class Map> __device__ __forceinline__ void transpose_item(const float* W, int K, int ldw, const Map& map, const float* kscale, bf16* WT, LAS float* scr, int item, int nblk, int lane) {
    const int kb = item / nblk, nb = item % nblk, k0 = 64 * kb, n0 = 32 * nb;
    const int np = 2 * (lane & 15);
    const int sc = map(n0 + np);
    float2 tv[16];
#pragma unroll
    for (int i = 0; i < 16; ++i) { const int kk = 4 * i + (lane >> 4); tv[i] = (sc >= 0) ? *(const float2*)(W + (size_t)(k0 + kk) * ldw + sc) : make_float2(0.f, 0.f); }
    asm volatile("" : "+v"(tv[0]), "+v"(tv[1]), "+v"(tv[2]), "+v"(tv[3]), "+v"(tv[4]), "+v"(tv[5]), "+v"(tv[6]), "+v"(tv[7]));
    asm volatile("" : "+v"(tv[8]), "+v"(tv[9]), "+v"(tv[10]), "+v"(tv[11]), "+v"(tv[12]), "+v"(tv[13]), "+v"(tv[14]), "+v"(tv[15]));
#pragma unroll
    for (int i = 0; i < 16; ++i) { const int kk = 4 * i + (lane >> 4); float2 v = tv[i];
        if (kscale) { const float ksc = kscale[k0 + kk]; v.x *= ksc; v.y *= ksc; } scr[kk * 33 + np] = v.x; scr[kk * 33 + np + 1] = v.y; }
    asm volatile("s_waitcnt lgkmcnt(0)" ::: "memory");
    const int c = lane & 7;
#pragma unroll
    for (int j = 0; j < 4; ++j) { const int n = (lane >> 3) + 8 * j; const LAS float* s = scr + (8 * c) * 33 + n;
        v4u o; o.x = pk2(s[0 * 33], s[1 * 33]); o.y = pk2(s[2 * 33], s[3 * 33]); o.z = pk2(s[4 * 33], s[5 * 33]); o.w = pk2(s[6 * 33], s[7 * 33]);
        *(v4u*)(WT + (size_t)(n0 + n) * K + k0 + 8 * c) = o; }
    asm volatile("s_waitcnt lgkmcnt(0)" ::: "memory");
}
typedef unsigned u2raw __attribute__((ext_vector_type(2)));
__device__ __forceinline__ float4 unpk4(uint2 q) { return make_float4(__uint_as_float(q.x << 16), __uint_as_float(q.x & 0xffff0000u), __uint_as_float(q.y << 16), __uint_as_float(q.y & 0xffff0000u)); }
template <bool XBF, bool FIN = false> __device__ __forceinline__ void norm_rows(const void* xv, const float* g, const float* shift, const float* scale, bf16* hb, float* outf, int gw, int ngw, int lane) {
    const int rpw = T_ / ngw, m0 = gw * rpw, b = m0 / S_;
    float4 gs[4], sh[4];
#pragma unroll
    for (int j = 0; j < 4; ++j) { const int col = 4 * lane + 256 * j; gs[j] = *(const float4*)(g + col);
        if constexpr (!FIN) { const float4 sc = *(const float4*)(scale + (size_t)b * 6144 + col); sh[j] = *(const float4*)(shift + (size_t)b * 6144 + col);
            gs[j].x *= 1.f + sc.x; gs[j].y *= 1.f + sc.y; gs[j].z *= 1.f + sc.z; gs[j].w *= 1.f + sc.w; }
        else sh[j] = make_float4(0.f, 0.f, 0.f, 0.f); }
    typedef typename std::conditional<XBF, uint2, float4>::type raw_t;
    const raw_t* x = (const raw_t*)xv;
    raw_t nv[4], nw[4];
    { const raw_t* xr = x + (size_t)m0 * (D_ / 4) + lane;
#pragma unroll
      for (int j = 0; j < 4; ++j) { nv[j] = xr[64 * j]; nw[j] = xr[D_ / 4 + 64 * j]; } }
    for (int r = 0; r < rpw; r += 2) {
        const int m = m0 + r;
        float4 v[4], w[4]; float s = 0.f, s2 = 0.f;
#pragma unroll
        for (int j = 0; j < 4; ++j) { if constexpr (XBF) { v[j] = unpk4(nv[j]); w[j] = unpk4(nw[j]); } else { v[j] = nv[j]; w[j] = nw[j]; } }
        if (r + 2 < rpw) { const raw_t* xr = x + (size_t)(m + 2) * (D_ / 4) + lane;
#pragma unroll
            for (int j = 0; j < 4; ++j) { nv[j] = xr[64 * j]; nw[j] = xr[D_ / 4 + 64 * j]; } }
#pragma unroll
        for (int j = 0; j < 4; ++j) { s += v[j].x * v[j].x + v[j].y * v[j].y + v[j].z * v[j].z + v[j].w * v[j].w; s2 += w[j].x * w[j].x + w[j].y * w[j].y + w[j].z * w[j].z + w[j].w * w[j].w; }
        const float r1 = rsqrtf(wave_sum2(s) * (1.f / D_) + EPS), r2 = rsqrtf(wave_sum2(s2) * (1.f / D_) + EPS);
#pragma unroll
        for (int j = 0; j < 4; ++j) {
            const int col = 4 * lane + 256 * j;
            float4 o, o2;
            o.x = v[j].x * r1 * gs[j].x + sh[j].x; o.y = v[j].y * r1 * gs[j].y + sh[j].y; o.z = v[j].z * r1 * gs[j].z + sh[j].z; o.w = v[j].w * r1 * gs[j].w + sh[j].w;
            o2.x = w[j].x * r2 * gs[j].x + sh[j].x; o2.y = w[j].y * r2 * gs[j].y + sh[j].y; o2.z = w[j].z * r2 * gs[j].z + sh[j].z; o2.w = w[j].w * r2 * gs[j].w + sh[j].w;
            if constexpr (FIN) { *(float4*)(outf + (size_t)m * D_ + col) = o; *(float4*)(outf + (size_t)(m + 1) * D_ + col) = o2; }
            else { uint2 q; q.x = pk2(o.x, o.y); q.y = pk2(o.z, o.w); *(uint2*)(hb + (size_t)m * D_ + col) = q;
                   uint2 q2; q2.x = pk2(o2.x, o2.y); q2.y = pk2(o2.z, o2.w); *(uint2*)(hb + (size_t)(m + 1) * D_ + col) = q2; }
        }
    }
}
__device__ __forceinline__ void ph_p0(const MPK& p, LAS unsigned char* lds, int tid) {
    const int wave = tid >> 6, lane = tid & 63;
    LAS float* ca = (LAS float*)lds; LAS float* red = ca + 8192;
    unsigned char* ws = p.k->ws; float* mod = (float*)(ws + WS_MOD);
    const float* c = PIN(I_C);
    for (int i = tid; i < 8192; i += NTHR) ca[i] = siluf_(c[i]);
    __syncthreads();
    for (int item = blockIdx.x; item < 192; item += gridDim.x) {
        const int l = item / 96, j = (item % 96) * 64 + lane;
        const float* w = PIN(I_WADA) + (size_t)l * 1024 * 6144 + j + (size_t)(wave * 128) * 6144;
        float acc[8];
#pragma unroll
        for (int b = 0; b < 8; ++b) acc[b] = 0.f;
        float wn[16];
#pragma unroll
        for (int i = 0; i < 16; ++i) wn[i] = w[(size_t)i * 6144];
        for (int k0 = 0; k0 < 128; k0 += 16) {
            float wv[16];
            asm volatile("" : "+v"(wn[0]), "+v"(wn[1]), "+v"(wn[2]), "+v"(wn[3]), "+v"(wn[4]), "+v"(wn[5]), "+v"(wn[6]), "+v"(wn[7]),
                              "+v"(wn[8]), "+v"(wn[9]), "+v"(wn[10]), "+v"(wn[11]), "+v"(wn[12]), "+v"(wn[13]), "+v"(wn[14]), "+v"(wn[15]));
#pragma unroll
            for (int i = 0; i < 16; ++i) wv[i] = wn[i];
            if (k0 + 16 < 128) {
#pragma unroll
                for (int i = 0; i < 16; ++i) wn[i] = w[(size_t)(k0 + 16 + i) * 6144];
            }
#pragma unroll
            for (int i4 = 0; i4 < 4; ++i4)
#pragma unroll
                for (int b = 0; b < 8; ++b) { const f32x4 c4 = *(LAS const f32x4*)(ca + b * 1024 + wave * 128 + k0 + 4 * i4);
                    acc[b] += (c4[0] * wv[4 * i4] + c4[1] * wv[4 * i4 + 1]) + (c4[2] * wv[4 * i4 + 2] + c4[3] * wv[4 * i4 + 3]); }
        }
#pragma unroll
        for (int b = 0; b < 8; ++b) red[(wave * 8 + b) * 64 + lane] = acc[b];
        __syncthreads();
        { const int b = wave; float s2 = 0.f;
#pragma unroll
          for (int w8 = 0; w8 < 8; ++w8) s2 += red[(w8 * 8 + b) * 64 + lane];
          mod[((size_t)l * 8 + b) * 6144 + (item % 96) * 64 + lane] = s2 + PIN(I_BADA)[l * 6144 + (item % 96) * 64 + lane]; }
        __syncthreads();
    }
    const int* pos = (const int*)PIN(I_POS);
    float *cosP = (float*)(ws + WS_COSP), *sinP = (float*)(ws + WS_SINP), *cosM = (float*)(ws + WS_COSM), *sinM = (float*)(ws + WS_SINM);
    for (int i = blockIdx.x * NTHR + tid; i < T_ * 24; i += gridDim.x * NTHR) {
        const int m = i / 24, f = i % 24;
        double inv; if (f < 8) inv = pow(500000.0, -(double)(2 * f) / 16.0); else inv = pow(500000.0, -(double)(2 * (f - 8)) / 32.0);
        const float ang = (float)pos[m] * (float)inv;
        const double a = (double)ang, kq = rint(a * 0.15915494309189535), r = a - kq * 6.283185307179586476925;
        const float cs = (float)cos(r), sn = (float)sin(r);
        if (f < 8) { cosP[m * 8 + f] = cs; sinP[m * 8 + f] = sn; } else { cosM[m * 16 + f - 8] = cs; sinM[m * 16 + f - 8] = sn; }
    }
}
__device__ __forceinline__ void early_transposes(const MPK& p, int l, LAS unsigned char* lds, int tid, int first) {
    const int wave = tid >> 6, lane = tid & 63;
    if ((int)blockIdx.x < first) return;
    const int gw = ((int)blockIdx.x - first) * NWAVES + wave, ngw = ((int)gridDim.x - first) * NWAVES;
    unsigned char* ws = p.k->ws;
    LAS float* scr = (LAS float*)(lds + wave * 8704);
    constexpr int I0 = 16 * 80, I4 = 4 * 24, I5 = 2 * 24, I6 = 32 * 2, I7 = 32 * 2, I8 = 8, I9 = 8;
    constexpr int NIT = I0 + I4 + I5 + I6 + I7 + I8 + I9;
    for (int it = gw; it < NIT; it += ngw) {
        int r = it;
        if (r < I0) { transpose_item(PIN(I_WIN) + (size_t)l * D_ * DIN, D_, DIN, MapIn{}, nullptr, (bf16*)(ws + WT_IN), scr, r, 80, lane); continue; } r -= I0;
        if (r < I4) { transpose_item(PIN(I_WUQ) + (size_t)l * 256 * 576, 256, 576, MapId{576}, PIN(I_GQL) + l * 256, (bf16*)(ws + WT_UQ), scr, r, 24, lane); continue; } r -= I4;
        if (r < I5) { transpose_item(PIN(I_WUKV) + (size_t)l * 128 * 768, 128, 768, MapId{768}, PIN(I_GKVL) + l * 128, (bf16*)(ws + WT_UKV), scr, r, 24, lane); continue; } r -= I5;
        if (r < I6) { transpose_item(PIN(I_WCK) + (size_t)l * 2048 * 64, 2048, 64, MapId{64}, nullptr, (bf16*)(ws + WT_CK), scr, r, 2, lane); continue; } r -= I6;
        if (r < I7) { transpose_item(PIN(I_WCV) + (size_t)l * 2048 * 64, 2048, 64, MapId{64}, nullptr, (bf16*)(ws + WT_CV), scr, r, 2, lane); continue; } r -= I7;
        if (r < I8) { const int h = r >> 1; transpose_item(PIN(I_WQM) + (size_t)l * 16384 + h * 4096, 64, 64, MapId{64}, nullptr, (bf16*)(ws + WT_QM) + h * 4096, scr, r & 1, 2, lane); continue; } r -= I8;
        { const int h = r >> 1; transpose_item(PIN(I_WKM) + (size_t)l * 16384 + h * 4096, 64, 64, MapId{64}, nullptr, (bf16*)(ws + WT_KM) + h * 4096, scr, r & 1, 2, lane); }
    }
}
__device__ __forceinline__ void ph_prep(const MPK& p, int l, LAS unsigned char* lds, int tid) {
    const int wave = tid >> 6, lane = tid & 63;
    const int gw = blockIdx.x * NWAVES + wave, ngw = gridDim.x * NWAVES;
    unsigned char* ws = p.k->ws;
    LAS float* scr = (LAS float*)(lds + wave * 8704);
    for (int i = blockIdx.x * NTHR + tid; i < 2 * T_; i += gridDim.x * NTHR) ((float*)(ws + WS_SSQL))[i] = 0.f;
    if (l == 0) early_transposes(p, l, lds, tid, 0);
    const float* modl = (const float*)(ws + WS_MOD) + (size_t)l * 8 * 6144;
    if (l == 0) norm_rows<false>(PIN(I_X), PIN(I_GN1) + l * D_, modl + 0, modl + 1024, (bf16*)(ws + WS_HB), nullptr, gw, ngw, lane);
    else norm_rows<true>(p.k->out, PIN(I_GN1) + l * D_, modl + 0, modl + 1024, (bf16*)(ws + WS_HB), nullptr, gw, ngw, lane);
}
__device__ __forceinline__ void late_transposes(const MPK& p, int l, LAS unsigned char* lds, int tid, int first) {
    const int wave = tid >> 6, lane = tid & 63;
    if ((int)blockIdx.x < first) return;
    const int gw = ((int)blockIdx.x - first) * NWAVES + wave, ngw = ((int)gridDim.x - first) * NWAVES;
    unsigned char* ws = p.k->ws;
    LAS float* scr = (LAS float*)(lds + wave * 8704);
    constexpr int I1 = 16 * 32, I2 = 16 * 176, I3 = 44 * 32;
    for (int it = gw; it < I1 + I2 + I3; it += ngw) {
        int r = it;
        if (r < I1) { transpose_item(PIN(I_WOUT) + (size_t)l * D_ * D_, D_, D_, MapId{D_}, nullptr, (bf16*)(ws + WT_OUT), scr, r, 32, lane); continue; } r -= I1;
        if (r < I2) { transpose_item(PIN(I_WGU) + (size_t)l * D_ * 2 * FF, D_, 2 * FF, MapGU{}, nullptr, (bf16*)(ws + WT_GU), scr, r, 176, lane); continue; } r -= I2;
        transpose_item(PIN(I_WDOWN) + (size_t)l * FF * D_, FF, D_, MapId{D_}, nullptr, (bf16*)(ws + WT_DOWN), scr, r, 32, lane);
    }
}
__device__ __forceinline__ void ph_mixnorm(const MPK& p, int l, int tid) {
    const int gw = blockIdx.x * NWAVES + (tid >> 6), ngw = gridDim.x * NWAVES, lane = tid & 63;
    unsigned char* ws = p.k->ws;
    bf16* mix = (bf16*)(ws + WS_HB); const float* ga = PIN(I_GOA) + l * 384; const float* gb = PIN(I_GOB) + l * 384;
    const bf16 *oc = (const bf16*)(ws + WS_OCMP), *os = (const bf16*)(ws + WS_OSLC), *ow = (const bf16*)(ws + WS_OWIN); const float* gm = (const float*)(ws + WS_GM);
#define UNPK8(dst, src) dst[0] = __uint_as_float(src.x << 16); dst[1] = __uint_as_float(src.x & 0xffff0000u); dst[2] = __uint_as_float(src.y << 16); dst[3] = __uint_as_float(src.y & 0xffff0000u); \
    dst[4] = __uint_as_float(src.z << 16); dst[5] = __uint_as_float(src.z & 0xffff0000u); dst[6] = __uint_as_float(src.w << 16); dst[7] = __uint_as_float(src.w & 0xffff0000u);
    const int rpw = T_ / ngw;
    const float* ggp = (lane < 48) ? ga + lane * 8 : gb + (lane - 48) * 8; const float4 gA0 = *(const float4*)ggp, gA1 = *(const float4*)(ggp + 4);
    const float* ggq = gb + (16 + (lane & 31)) * 8; const float4 gB0 = *(const float4*)ggq, gB1 = *(const float4*)(ggq + 4);
    v4u ra4, rb4, rc4, ry4; float rg0, rg1, rg2;
#define MIX_LOAD(m_) do { const bf16* r_ = mix + (size_t)(m_) * D_; \
        if (lane < 48) { const size_t o_ = (size_t)(m_) * 384 + lane * 8; const float* g3_ = gm + (size_t)(m_) * 32 + 3 * (lane >> 3); rg0 = g3_[0]; rg1 = g3_[1]; rg2 = g3_[2]; \
            ra4 = *(const v4u*)(oc + o_); rb4 = *(const v4u*)(os + o_); rc4 = *(const v4u*)(ow + o_); } \
        else { ra4 = *(const v4u*)(r_ + 384 + (lane - 48) * 8); rb4 = ra4; rc4 = ra4; rg0 = 0.f; rg1 = 0.f; rg2 = 0.f; } \
        if (lane < 32) ry4 = *(const v4u*)(r_ + 384 + (16 + lane) * 8); else ry4 = ra4; } while (0)
    const int mend = gw * rpw + rpw;
    MIX_LOAD(gw * rpw);
    for (int m = gw * rpw; m < mend; ++m) {
        bf16* r = mix + (size_t)m * D_;
        const v4u ca4 = ra4, cb4 = rb4, cc4 = rc4, cy4 = ry4; const float g0 = rg0, g1 = rg1, g2 = rg2;
        if (m + 1 < mend) MIX_LOAD(m + 1);
        float v0[8], v1[8]; float sa = 0.f, sb = 0.f;
        if (lane < 48) {
            float c8[8], s8[8], w8[8]; UNPK8(c8, ca4) UNPK8(s8, cb4) UNPK8(w8, cc4)
#pragma unroll
            for (int i = 0; i < 8; ++i) { v0[i] = g0 * c8[i] + g1 * s8[i] + g2 * w8[i]; sa += v0[i] * v0[i]; }
        } else {
            UNPK8(v0, ca4)
#pragma unroll
            for (int i = 0; i < 8; ++i) sb += v0[i] * v0[i];
        }
        if (lane < 32) { UNPK8(v1, cy4)
#pragma unroll
            for (int i = 0; i < 8; ++i) sb += v1[i] * v1[i]; }
        const float ra = rsqrtf(wave_sum2(sa) * (1.f / 384.f) + EPS), rb = rsqrtf(wave_sum2(sb) * (1.f / 384.f) + EPS);
        {
            const int col = (lane < 48) ? lane * 8 : 384 + (lane - 48) * 8; const float rr = (lane < 48) ? ra : rb;
            const float4 q0 = gA0, q1 = gA1;
            v4u w; w.x = pk2(v0[0] * rr * q0.x, v0[1] * rr * q0.y); w.y = pk2(v0[2] * rr * q0.z, v0[3] * rr * q0.w); w.z = pk2(v0[4] * rr * q1.x, v0[5] * rr * q1.y); w.w = pk2(v0[6] * rr * q1.z, v0[7] * rr * q1.w);
            *(v4u*)(r + col) = w;
        }
        if (lane < 32) { const float4 q0 = gB0, q1 = gB1;
            v4u w; w.x = pk2(v1[0] * rb * q0.x, v1[1] * rb * q0.y); w.y = pk2(v1[2] * rb * q0.z, v1[3] * rb * q0.w); w.z = pk2(v1[4] * rb * q1.x, v1[5] * rb * q1.y); w.w = pk2(v1[6] * rb * q1.z, v1[7] * rb * q1.w);
            *(v4u*)(r + 384 + (16 + lane) * 8) = w; }
    }
#undef MIX_LOAD
#undef UNPK8
}


typedef short bf16x8 __attribute__((ext_vector_type(8)));
typedef short s16x4 __attribute__((ext_vector_type(4)));
typedef float f32x16 __attribute__((ext_vector_type(16)));
typedef unsigned u32x2v __attribute__((ext_vector_type(2)));
constexpr int AT_BUF = 20480, AT_K32 = 8192, AT_V = 12288;
__device__ __forceinline__ unsigned cvtpk(float lo, float hi) { unsigned r; asm volatile("v_cvt_pk_bf16_f32 %0, %1, %2" : "=v"(r) : "v"(lo), "v"(hi)); return r; }
__device__ __forceinline__ float max3f(float a, float b, float c) { float r; asm("v_max3_f32 %0, %1, %2, %3" : "=v"(r) : "v"(a), "v"(b), "v"(c)); return r; }
__device__ __forceinline__ int crow(int r, int hi) { return (r & 3) + 8 * (r >> 2) + 4 * hi; }
__device__ __forceinline__ s16x4 vtr(LAS const unsigned char* p) { return __builtin_bit_cast(s16x4, __builtin_amdgcn_ds_read_tr16_b64_v4i16((LAS s16x4*)p)); }
enum { AM_CAUSAL = 0, AM_WINDOW = 1, AM_SLC = 2 };
struct AttnState { float m, l; f32x16 o[2]; f32x16 negm; bool started; long long twait; };
template <int NC> struct TileRegs { v4u k; v4u k2; v4u v; };
template <int NC> __device__ __forceinline__ void at_load(TileRegs<NC>& r, const bf16* Kg, int ldk, const bf16* Vg, int ldv, const bf16* K2g, int ldk2, int tile, int tid) {
    const int key = tid >> 3, c = tid & 7;
    r.k = *(const v4u*)(Kg + (size_t)(tile * 64 + key) * ldk + 8 * c);
    r.v = *(const v4u*)(Vg + (size_t)(tile * 64 + key) * ldv + 8 * c);
    if (NC == 6) { if (tid < 256) r.k2 = *(const v4u*)(K2g + (size_t)(tile * 64 + (tid >> 2)) * ldk2 + 8 * (tid & 3)); }
}
template <int NC> __device__ __forceinline__ void at_store(const TileRegs<NC>& r, LAS unsigned char* buf, int tid) {
    const int key = tid >> 3, c = tid & 7;
    *(LAS v4u*)(buf + key * 128 + 16 * (c ^ ((key >> 1) & 7))) = r.k;
    *(LAS v4u*)(buf + AT_V + (c >> 2) * 4096 + key * 64 + (c & 3) * 16) = r.v;
    if (NC == 6) { if (tid < 256) { const int k2 = tid >> 2, c2 = tid & 3; *(LAS v4u*)(buf + AT_K32 + k2 * 64 + 16 * (c2 ^ ((k2 >> 2) & 3))) = r.k2; } }
}
template <int NC> __device__ __forceinline__ void qk_tile(f32x16& p0, f32x16& p1, LAS const unsigned char* buf, const bf16x8 (&qf)[NC], const f32x16& negm, int lane) {
    const int r32 = lane & 31, hi = lane >> 5;
    p0 = negm; p1 = negm;
#pragma unroll
    for (int cc = 0; cc < NC; ++cc) {
        bf16x8 k0, k1;
        if (cc < 4) { const int k0r = r32, k1r = 32 + r32;
            k0 = *(LAS const bf16x8*)(buf + k0r * 128 + 16 * ((2 * cc + hi) ^ ((k0r >> 1) & 7)));
            k1 = *(LAS const bf16x8*)(buf + k1r * 128 + 16 * ((2 * cc + hi) ^ ((k1r >> 1) & 7))); }
        else { const int k0r = r32, k1r = 32 + r32, c2 = 2 * (cc - 4) + hi;
            k0 = *(LAS const bf16x8*)(buf + AT_K32 + k0r * 64 + 16 * (c2 ^ ((k0r >> 2) & 3)));
            k1 = *(LAS const bf16x8*)(buf + AT_K32 + k1r * 64 + 16 * (c2 ^ ((k1r >> 2) & 3))); }
        p0 = __builtin_amdgcn_mfma_f32_32x32x16_bf16(k0, qf[cc], p0, 0, 0, 0);
        p1 = __builtin_amdgcn_mfma_f32_32x32x16_bf16(k1, qf[cc], p1, 0, 0, 0);
    }
}
template <int MODE> __device__ __forceinline__ void mask_tile(f32x16& p0, f32x16& p1, int kpos0, int qpos, bool need_mask, bool sel_ok, int lane) {
    const int hi = lane >> 5;
    if (need_mask) {
        const int qw0m = __builtin_amdgcn_readfirstlane(qpos) & ~31;
        const bool diag = (kpos0 + 63 > qw0m), old = (MODE == AM_WINDOW) && (kpos0 < qw0m + 31 - 511);
        if (diag || old) {
            const float selterm = (MODE == AM_SLC && !sel_ok) ? -INFINITY : INFINITY;
            const int dbase = qpos - kpos0 - 4 * hi;
#pragma unroll
            for (int r = 0; r < 16; ++r) {
                const int d0 = dbase - ((r & 3) + 8 * (r >> 2)), d1 = d0 - 32;
                float l0 = ((float)d0 + 0.5f) * INFINITY, l1 = ((float)d1 + 0.5f) * INFINITY;
                if (MODE == AM_WINDOW) { l0 = fminf(l0, ((float)(511 - d0) + 0.5f) * INFINITY); l1 = fminf(l1, ((float)(511 - d1) + 0.5f) * INFINITY); }
                if (MODE == AM_SLC) { l0 = fminf(l0, selterm); l1 = fminf(l1, selterm); }
                p0[r] = fminf(p0[r], l0); p1[r] = fminf(p1[r], l1);
            }
        } else if (MODE == AM_SLC) {
            const float selterm = sel_ok ? INFINITY : -INFINITY;
#pragma unroll
            for (int r = 0; r < 16; ++r) { p0[r] = fminf(p0[r], selterm); p1[r] = fminf(p1[r], selterm); }
        }
    }
}
template <int MODE> __device__ __forceinline__ void softmax_tile(AttnState& st, f32x16& p0, f32x16& p1, bf16x8 (&pf)[4], int kpos0, int qpos, bool need_mask, bool sel_ok, int lane) {
    mask_tile<MODE>(p0, p1, kpos0, qpos, need_mask, sel_ok, lane);
    float mx = max3f(p0[0], p1[0], p0[1]), mx2 = max3f(p1[1], p0[2], p1[2]);
#pragma unroll
    for (int r = 3; r < 15; r += 2) { mx = max3f(mx, p0[r], p1[r]); mx2 = max3f(mx2, p0[r + 1], p1[r + 1]); }
    mx = max3f(mx, p0[15], p1[15]); mx = max3f(mx, mx2, mx2);
    mx = red32_max(mx);
    if (!st.started || __any(mx > 0.f)) {
        float dl = st.started ? fmaxf(mx, 0.f) : mx;
        dl = (dl > -1e30f) ? dl : 0.f;
        st.started = true;
        const float alpha = __builtin_amdgcn_exp2f(-dl);
        st.m += dl; st.l *= alpha;
#pragma unroll
        for (int r = 0; r < 16; ++r) { st.o[0][r] *= alpha; st.o[1][r] *= alpha; p0[r] -= dl; p1[r] -= dl; st.negm[r] = -st.m; }
    }
    float sum = 0.f;
#pragma unroll
    for (int r = 0; r < 16; ++r) { p0[r] = __builtin_amdgcn_exp2f(p0[r]); p1[r] = __builtin_amdgcn_exp2f(p1[r]); sum += p0[r] + p1[r]; }
    st.l += sum;
#pragma unroll
    for (int s2 = 0; s2 < 2; ++s2) {
        v4u a, b;
        a.x = cvtpk(p0[8 * s2 + 0], p0[8 * s2 + 1]); a.y = cvtpk(p0[8 * s2 + 2], p0[8 * s2 + 3]); a.z = cvtpk(p0[8 * s2 + 4], p0[8 * s2 + 5]); a.w = cvtpk(p0[8 * s2 + 6], p0[8 * s2 + 7]);
        b.x = cvtpk(p1[8 * s2 + 0], p1[8 * s2 + 1]); b.y = cvtpk(p1[8 * s2 + 2], p1[8 * s2 + 3]); b.z = cvtpk(p1[8 * s2 + 4], p1[8 * s2 + 5]); b.w = cvtpk(p1[8 * s2 + 6], p1[8 * s2 + 7]);
        pf[s2] = __builtin_bit_cast(bf16x8, a); pf[2 + s2] = __builtin_bit_cast(bf16x8, b);
    }
}
struct TileFlags { bool skip, need_mask, sel_ok; };
__device__ __forceinline__ void pack_p(bf16x8 (&pf)[4], const f32x16& p0, const f32x16& p1) {
#pragma unroll
    for (int s2 = 0; s2 < 2; ++s2) {
        v4u a, b;
        a.x = cvtpk(p0[8 * s2 + 0], p0[8 * s2 + 1]); a.y = cvtpk(p0[8 * s2 + 2], p0[8 * s2 + 3]); a.z = cvtpk(p0[8 * s2 + 4], p0[8 * s2 + 5]); a.w = cvtpk(p0[8 * s2 + 6], p0[8 * s2 + 7]);
        b.x = cvtpk(p1[8 * s2 + 0], p1[8 * s2 + 1]); b.y = cvtpk(p1[8 * s2 + 2], p1[8 * s2 + 3]); b.z = cvtpk(p1[8 * s2 + 4], p1[8 * s2 + 5]); b.w = cvtpk(p1[8 * s2 + 6], p1[8 * s2 + 7]);
        pf[s2] = __builtin_bit_cast(bf16x8, a); pf[2 + s2] = __builtin_bit_cast(bf16x8, b);
    }
}
template <int MODE> __device__ __forceinline__ void softmax_pair(AttnState& st, f32x16& a0, f32x16& a1, f32x16& b0, f32x16& b1, int kpos0, int qpos, const TileFlags& fa, const TileFlags& fb, int lane) {
    mask_tile<MODE>(a0, a1, kpos0, qpos, fa.need_mask, fa.sel_ok, lane);
    mask_tile<MODE>(b0, b1, kpos0 + 64, qpos, fb.need_mask, fb.sel_ok, lane);
    float mx = max3f(a0[0], a1[0], b0[0]), mx2 = max3f(b1[0], a0[1], a1[1]);
#pragma unroll
    for (int r = 1; r < 16; ++r) { mx = max3f(mx, b0[r], b1[r]); if (r > 1) mx2 = max3f(mx2, a0[r], a1[r]); }
    mx = max3f(mx, mx2, mx2);
    mx = red32_max(mx);
    if (!st.started || __any(mx > 0.f)) {
        float dl = st.started ? fmaxf(mx, 0.f) : mx;
        dl = (dl > -1e30f) ? dl : 0.f;
        st.started = true;
        const float alpha = __builtin_amdgcn_exp2f(-dl);
        st.m += dl; st.l *= alpha;
#pragma unroll
        for (int r = 0; r < 16; ++r) { st.o[0][r] *= alpha; st.o[1][r] *= alpha; a0[r] -= dl; a1[r] -= dl; b0[r] -= dl; b1[r] -= dl; st.negm[r] = -st.m; }
    }
    float sum = 0.f;
#pragma unroll
    for (int r = 0; r < 16; ++r) { a0[r] = __builtin_amdgcn_exp2f(a0[r]); a1[r] = __builtin_amdgcn_exp2f(a1[r]); b0[r] = __builtin_amdgcn_exp2f(b0[r]); b1[r] = __builtin_amdgcn_exp2f(b1[r]); sum += (a0[r] + a1[r]) + (b0[r] + b1[r]); }
    st.l += sum;
}
__device__ __forceinline__ void pv_tile(AttnState& st, LAS const unsigned char* buf, const bf16x8 (&pf)[4], int lane) {
    const int hi = lane >> 5;
    const unsigned vb = (unsigned)(uintptr_t)(buf + AT_V + (4 * hi + ((lane & 15) >> 2)) * 64 + ((lane >> 4) & 1) * 32 + (lane & 3) * 8);
#pragma unroll
    for (int dh = 0; dh < 2; ++dh) {
        s16x4 lo[4], hh[4];
#pragma unroll
        for (int s4 = 0; s4 < 4; ++s4) {
            asm volatile("ds_read_b64_tr_b16 %0, %1 offset:%c2" : "=&v"(lo[s4]) : "v"(vb), "i"(dh * 4096 + s4 * 1024) : "memory");
            asm volatile("ds_read_b64_tr_b16 %0, %1 offset:%c2" : "=&v"(hh[s4]) : "v"(vb), "i"(dh * 4096 + s4 * 1024 + 512) : "memory");
        }
        asm volatile("s_waitcnt lgkmcnt(0)" : "+v"(lo[0]), "+v"(lo[1]), "+v"(lo[2]), "+v"(lo[3]), "+v"(hh[0]), "+v"(hh[1]), "+v"(hh[2]), "+v"(hh[3]) :: "memory");
#pragma unroll
        for (int s4 = 0; s4 < 4; ++s4) {
            const bf16x8 vf = {lo[s4][0], lo[s4][1], lo[s4][2], lo[s4][3], hh[s4][0], hh[s4][1], hh[s4][2], hh[s4][3]};
            st.o[dh] = __builtin_amdgcn_mfma_f32_32x32x16_bf16(vf, pf[s4], st.o[dh], 0, 0, 0);
        }
    }
}
template <int MODE> __device__ __forceinline__ TileFlags tile_flags(int t, int qw0, unsigned selbits) {
    const int k0 = t * 64; TileFlags f;
    f.skip = k0 > qw0 + 31; f.need_mask = (k0 + 63 > qw0); f.sel_ok = true;
    if (MODE == AM_WINDOW) { f.skip = f.skip || (k0 + 63 < qw0 - 511); f.need_mask = f.need_mask || (k0 < qw0 + 31 - 511); }
    if (MODE == AM_SLC) { f.sel_ok = (selbits >> t) & 1u; const unsigned long long bal = __ballot(f.sel_ok); f.skip = f.skip || (bal == 0ull); f.need_mask = f.need_mask || (bal != ~0ull); }
    return f;
}
struct DmaOff { unsigned k, v, k2; };
template <int NC> __device__ __forceinline__ DmaOff at_dma_off(int ldk, int ldv, int ldk2, int wave, int lane) {
    const int L = wave * 64 + lane; DmaOff o;
    { const int key = L >> 3, c = (L & 7) ^ ((key >> 1) & 7); o.k = (unsigned)(key * ldk + 8 * c) * 2u; }
    { const int key = (L >> 2) & 63, c = (L >> 8) * 4 + (L & 3); o.v = (unsigned)(key * ldv + 8 * c) * 2u; }
    { const int key = (L >> 2) & 63, c2 = (L & 3) ^ ((key >> 2) & 3); o.k2 = (unsigned)(key * ldk2 + 8 * c2) * 2u; }
    return o;
}
template <int NC> __device__ __forceinline__ void at_dma(const DmaOff& o, const bf16* Kg, int ldk, const bf16* Vg, int ldv, const bf16* K2g, int ldk2, int tile, LAS unsigned char* slot, int wave) {
    __builtin_amdgcn_global_load_lds((const unsigned*)((const char*)(Kg + (size_t)tile * 64 * ldk) + o.k), (LAS unsigned*)(slot + wave * 1024), 16, 0, 0);
    __builtin_amdgcn_global_load_lds((const unsigned*)((const char*)(Vg + (size_t)tile * 64 * ldv) + o.v), (LAS unsigned*)(slot + AT_V + wave * 1024), 16, 0, 0);
    if (NC == 6) { if (wave < 4) __builtin_amdgcn_global_load_lds((const unsigned*)((const char*)(K2g + (size_t)tile * 64 * ldk2) + o.k2), (LAS unsigned*)(slot + AT_K32 + wave * 1024), 16, 0, 0); }
}
__device__ __forceinline__ void at_wait_bar(int keep) {
    if (keep == 0) asm volatile("s_waitcnt vmcnt(0) lgkmcnt(0)" ::: "memory");
    else if (keep == 4) asm volatile("s_waitcnt vmcnt(4) lgkmcnt(0)" ::: "memory");
    else asm volatile("s_waitcnt vmcnt(6) lgkmcnt(0)" ::: "memory");
    __builtin_amdgcn_s_barrier();
    asm volatile("" ::: "memory");
}
template <int NC, int MODE> __device__ __forceinline__ void at_stream(AttnState& st, LAS unsigned char* lds, const bf16* Kg, int ldk, const bf16* Vg, int ldv, const bf16* K2g, int ldk2, int t0, int t1,
                                                                       const bf16x8 (&qf)[NC], int qpos, int qw0, unsigned selbits, int tid) {
    const int lane = tid & 63, wave = __builtin_amdgcn_readfirstlane(tid >> 6), np = (t1 - t0) >> 1;
    const int nper2 = (NC == 6 && wave < 4) ? 6 : 4;
    const DmaOff dof = at_dma_off<NC>(ldk, ldv, ldk2, wave, lane);
    at_dma<NC>(dof, Kg, ldk, Vg, ldv, K2g, ldk2, t0, lds, wave); at_dma<NC>(dof, Kg, ldk, Vg, ldv, K2g, ldk2, t0 + 1, lds + AT_BUF, wave);
    if (np > 1) { at_dma<NC>(dof, Kg, ldk, Vg, ldv, K2g, ldk2, t0 + 2, lds + 2 * AT_BUF, wave); at_dma<NC>(dof, Kg, ldk, Vg, ldv, K2g, ldk2, t0 + 3, lds + 3 * AT_BUF, wave); }
    at_wait_bar(np > 1 ? nper2 : 0);
    int s0 = 0, s1 = 2 * AT_BUF, s2 = 4 * AT_BUF;
    for (int j = 0; j < np; ++j) {
        const int t = t0 + 2 * j; const bool has_2 = (j + 2 < np);
        if (has_2) { at_dma<NC>(dof, Kg, ldk, Vg, ldv, K2g, ldk2, t + 4, lds + s2, wave); at_dma<NC>(dof, Kg, ldk, Vg, ldv, K2g, ldk2, t + 5, lds + s2 + AT_BUF, wave); }
        const TileFlags fa = tile_flags<MODE>(t, qw0, selbits), fb = tile_flags<MODE>(t + 1, qw0, selbits);
        if (!fa.skip && !fb.skip) {
            f32x16 a0, a1, b0, b1; bf16x8 pf[4];
            qk_tile<NC>(a0, a1, lds + s0, qf, st.negm, lane);
            qk_tile<NC>(b0, b1, lds + s0 + AT_BUF, qf, st.negm, lane);
            softmax_pair<MODE>(st, a0, a1, b0, b1, t * 64, qpos, fa, fb, lane);
            pack_p(pf, a0, a1); pv_tile(st, lds + s0, pf, lane);
            pack_p(pf, b0, b1); pv_tile(st, lds + s0 + AT_BUF, pf, lane);
        } else {
            if (!fa.skip) { f32x16 p0, p1; bf16x8 pf[4]; qk_tile<NC>(p0, p1, lds + s0, qf, st.negm, lane); softmax_tile<MODE>(st, p0, p1, pf, t * 64, qpos, fa.need_mask, fa.sel_ok, lane); pv_tile(st, lds + s0, pf, lane); }
            if (!fb.skip) { f32x16 p0, p1; bf16x8 pf[4]; qk_tile<NC>(p0, p1, lds + s0 + AT_BUF, qf, st.negm, lane); softmax_tile<MODE>(st, p0, p1, pf, (t + 1) * 64, qpos, fb.need_mask, fb.sel_ok, lane); pv_tile(st, lds + s0 + AT_BUF, pf, lane); }
        }
        at_wait_bar(has_2 ? nper2 : 0);
        const int tmp = s0; s0 = s1; s1 = s2; s2 = tmp;
    }
}
__device__ __forceinline__ int next_item_q(unsigned* ctrs, LAS unsigned char* lds, int wave_u, int count, int q0, int& kstart) {
    const int tid = wave_u * 64 + fresh_lane();
    LAS int* slot = (LAS int*)(lds + RING_BYTES + 64);
    if (tid == 0) { const unsigned v = atomicAdd(ctrs, 1u); slot[0] = (v < 8u * (unsigned)count) ? (int)(((v & 7u) << 16) | (v >> 3)) : -1; }
    __syncthreads();
    const int v = slot[0];
    __syncthreads();
    (void)q0; (void)kstart;
    return v;
}
__device__ __forceinline__ void mla_unit(unsigned char* ws, LAS unsigned char* lds, int b, int h, int qt, int wave_u) {
    const int tid = wave_u * 64 + fresh_lane();
    const int lane = tid & 63, wave = tid >> 6, r32 = lane & 31, hi = lane >> 5;
    const int qw0 = qt * 256 + wave * 32, qpos = qw0 + r32; const size_t row = (size_t)b * S_ + qpos;
    const long long tq0 = (PROBE_SEL != 0) ? (long long)__builtin_amdgcn_s_memtime() : 0ll;
    bf16x8 qf[6];
    {
        const bf16* qp = (const bf16*)(ws + WS_OSLC) + row * 768 + h * 96 + 8 * hi;
        v4u raw[6];
#pragma unroll
        for (int cc = 0; cc < 6; ++cc) raw[cc] = *(const v4u*)(qp + 16 * cc);
        float msc = MSCALE; asm volatile("" : "+v"(msc));
        const float rs = rsqrtf(((const float*)(ws + WS_SSQL))[row] * (1.f / 256.f) + EPS) * msc;
        const float* cm_ = (const float*)(ws + WS_COSM) + row * 16 + 8 * hi; const float* sm_ = (const float*)(ws + WS_SINM) + row * 16 + 8 * hi;
#define UNPKQ(dst, src) dst[0] = __uint_as_float(src.x << 16); dst[1] = __uint_as_float(src.x & 0xffff0000u); dst[2] = __uint_as_float(src.y << 16); dst[3] = __uint_as_float(src.y & 0xffff0000u); \
        dst[4] = __uint_as_float(src.z << 16); dst[5] = __uint_as_float(src.z & 0xffff0000u); dst[6] = __uint_as_float(src.w << 16); dst[7] = __uint_as_float(src.w & 0xffff0000u);
#pragma unroll
        for (int cc = 0; cc < 4; ++cc) { float f[8]; UNPKQ(f, raw[cc])
            v4u w; w.x = cvtpk(f[0] * rs, f[1] * rs); w.y = cvtpk(f[2] * rs, f[3] * rs); w.z = cvtpk(f[4] * rs, f[5] * rs); w.w = cvtpk(f[6] * rs, f[7] * rs); qf[cc] = __builtin_bit_cast(bf16x8, w); }
        { float x1[8], x2[8], o1[8], o2[8]; UNPKQ(x1, raw[4]) UNPKQ(x2, raw[5])
#pragma unroll
          for (int j = 0; j < 8; ++j) { const float cs = cm_[j] * rs, sn = sm_[j] * rs; o1[j] = x1[j] * cs - x2[j] * sn; o2[j] = x1[j] * sn + x2[j] * cs; }
          v4u w; w.x = cvtpk(o1[0], o1[1]); w.y = cvtpk(o1[2], o1[3]); w.z = cvtpk(o1[4], o1[5]); w.w = cvtpk(o1[6], o1[7]); qf[4] = __builtin_bit_cast(bf16x8, w);
          w.x = cvtpk(o2[0], o2[1]); w.y = cvtpk(o2[2], o2[3]); w.z = cvtpk(o2[4], o2[5]); w.w = cvtpk(o2[6], o2[7]); qf[5] = __builtin_bit_cast(bf16x8, w); }
#undef UNPKQ
    }
    const long long tq1 = (PROBE_SEL != 0) ? (long long)__builtin_amdgcn_s_memtime() : 0ll;
    AttnState st; st.m = 0.f; st.l = 0.f; st.o[0] = f32x16{}; st.o[1] = f32x16{}; st.negm = f32x16{}; st.started = false; st.twait = 0;
    const bf16* kvb = (const bf16*)(ws + WS_KVM) + (size_t)b * S_ * 768 + h * 128;
    at_stream<6, AM_CAUSAL>(st, lds, kvb, 768, kvb + 64, 768, (const bf16*)(ws + WS_KR) + (size_t)b * S_ * 32, 32, 0, 4 * qt + 4, qf, qpos, qw0, 0u, tid);
    if (PROBE_SEL >= 1 && PROBE_SEL <= 3 && b == 0 && h == 0 && qt == 7 && tid == 0) { const long long tq2 = (long long)__builtin_amdgcn_s_memtime();
        ((float*)(ws + WS_CTL))[100] = (PROBE_SEL == 1) ? (float)(tq2 - tq1) : (PROBE_SEL == 2) ? (float)st.twait : (float)(tq1 - tq0); }
    const float lt = red32_sum(st.l), il = 1.f / lt;
    bf16* op = (bf16*)(ws + WS_HB) + row * D_ + 384 + h * 64 + 4 * hi;
#pragma unroll
    for (int dh = 0; dh < 2; ++dh)
#pragma unroll
        for (int g4 = 0; g4 < 4; ++g4) { u32x2v w; w.x = cvtpk(st.o[dh][4 * g4] * il, st.o[dh][4 * g4 + 1] * il); w.y = cvtpk(st.o[dh][4 * g4 + 2] * il, st.o[dh][4 * g4 + 3] * il);
            *(u32x2v*)(op + dh * 32 + 8 * g4) = w; }
}
template <int MODE> __device__ __forceinline__ void nsa_branch_unit(unsigned char* ws, LAS unsigned char* lds, int b, int h, int qt, int wave_u) {
    const int tid = wave_u * 64 + fresh_lane();
    const int lane = tid & 63, wave = tid >> 6, r32 = lane & 31, hi = lane >> 5, g = h / 3;
    const int qw0 = qt * 256 + wave * 32, qpos = qw0 + r32; const size_t row = (size_t)b * S_ + qpos;
    const bf16* nsa = (const bf16*)(ws + WS_NSA);
    const bf16* qp = nsa + row * 1152 + h * 64 + 8 * hi;
    bf16x8 qf[4];
#pragma unroll
    for (int cc = 0; cc < 4; ++cc) qf[cc] = *(const bf16x8*)(qp + 16 * cc);
    unsigned selbits = 0u; if (MODE == AM_SLC) selbits = ((const unsigned*)(ws + WS_SEL))[(size_t)(b * 2 + g) * S_ + qpos];
    const bf16* kb = nsa + (size_t)b * S_ * 1152 + g * 64 + (MODE == AM_SLC ? 640 : 896);
    AttnState st; st.m = 0.f; st.l = 0.f; st.o[0] = f32x16{}; st.o[1] = f32x16{}; st.negm = f32x16{}; st.started = false; st.twait = 0;
    const long long tn0 = (PROBE_SEL != 0) ? (long long)__builtin_amdgcn_s_memtime() : 0ll;
    const int t0 = (MODE == AM_SLC) ? 0 : ((4 * qt - 8 > 0) ? 4 * qt - 8 : 0);
    at_stream<4, MODE>(st, lds, kb, 1152, kb + 128, 1152, nullptr, 0, t0, 4 * qt + 4, qf, qpos, qw0, selbits, tid);
    if (PROBE_SEL >= 4 && PROBE_SEL <= 5 && MODE == AM_SLC && b == 0 && h == 0 && qt == 7 && tid == 0) { const long long tn1 = (long long)__builtin_amdgcn_s_memtime();
        ((float*)(ws + WS_CTL))[100] = (PROBE_SEL == 4) ? (float)(tn1 - tn0) : (float)st.twait; }
    const float lt = red32_sum(st.l), il = 1.f / lt;
    bf16* op = (bf16*)(ws + (MODE == AM_SLC ? WS_OSLC : WS_OWIN)) + row * 384 + h * 64 + 4 * hi;
#pragma unroll
    for (int dh = 0; dh < 2; ++dh)
#pragma unroll
        for (int g4 = 0; g4 < 4; ++g4) { u32x2v w; w.x = cvtpk(st.o[dh][4 * g4] * il, st.o[dh][4 * g4 + 1] * il); w.y = cvtpk(st.o[dh][4 * g4 + 2] * il, st.o[dh][4 * g4 + 3] * il);
            *(u32x2v*)(op + dh * 32 + 8 * g4) = w; }
}
__device__ __forceinline__ void cmp_unit(unsigned char* ws, LAS unsigned char* lds, int b, int g, int qt, int wave_u) {
    const int tid = wave_u * 64 + fresh_lane();
    const int lane = tid & 63, wave = tid >> 6, r32 = lane & 31, hi = lane >> 5;
    const int qpos = qt * 256 + wave * 32 + r32; const size_t row = (size_t)b * S_ + qpos;
    const bf16* kc = (const bf16*)(ws + WS_KCV) + (size_t)(b * 2 + g) * 128 * 64; const bf16* vc = kc + (size_t)8 * 2 * 128 * 64;
    { TileRegs<4> tr; at_load<4>(tr, kc, 64, vc, 64, nullptr, 0, 0, tid); at_store<4>(tr, lds, tid); at_load<4>(tr, kc, 64, vc, 64, nullptr, 0, 1, tid); at_store<4>(tr, lds + AT_BUF, tid); }
    __syncthreads();
    int nvis = (qpos >= 31) ? ((qpos - 31) >> 4) + 1 : 0; if (nvis > 127) nvis = 127;
    float G[16], L[16];
#pragma unroll
    for (int i = 0; i < 16; ++i) { G[i] = 0.f; L[i] = 0.f; }
    const bf16* nsa = (const bf16*)(ws + WS_NSA);
    LAS const unsigned char* vb = lds + AT_V + (4 * hi + ((lane & 15) >> 2)) * 64 + ((lane >> 4) & 1) * 32 + (lane & 3) * 8;
    for (int r3 = 0; r3 < 3; ++r3) {
        const int h = 3 * g + r3;
        const bf16* qp = nsa + row * 1152 + h * 64 + 8 * hi;
        bf16x8 qf[4];
#pragma unroll
        for (int cc = 0; cc < 4; ++cc) qf[cc] = *(const bf16x8*)(qp + 16 * cc);
        f32x16 p[4];
#pragma unroll
        for (int tb = 0; tb < 4; ++tb) {
            LAS const unsigned char* buf = lds + (tb >> 1) * AT_BUF; const int kr = (tb & 1) * 32 + r32;
            p[tb] = f32x16{};
#pragma unroll
            for (int cc = 0; cc < 4; ++cc) { const bf16x8 kf = *(LAS const bf16x8*)(buf + kr * 128 + 16 * ((2 * cc + hi) ^ ((kr >> 1) & 7)));
                p[tb] = __builtin_amdgcn_mfma_f32_32x32x16_bf16(kf, qf[cc], p[tb], 0, 0, 0); }
        }
        float mx = -1e30f;
#pragma unroll
        for (int tb = 0; tb < 4; ++tb)
#pragma unroll
            for (int r = 0; r < 16; ++r) { const int n = 32 * tb + crow(r, hi); p[tb][r] = fminf(p[tb][r], ((float)(nvis - n) - 0.5f) * INFINITY); mx = fmaxf(mx, p[tb][r]); }
        mx = red32_max(mx);
        float sum = 0.f;
#pragma unroll
        for (int tb = 0; tb < 4; ++tb)
#pragma unroll
            for (int r = 0; r < 16; ++r) { p[tb][r] = __builtin_amdgcn_exp2f(p[tb][r] - mx); sum += p[tb][r]; }
        sum = red32_sum(sum);
        const float il = (nvis > 0) ? 1.f / sum : 0.f;
#pragma unroll
        for (int tb = 0; tb < 4; ++tb)
#pragma unroll
            for (int k = 0; k < 4; ++k) { const float a0 = p[tb][4 * k] * il, a1 = p[tb][4 * k + 1] * il, a2 = p[tb][4 * k + 2] * il, a3 = p[tb][4 * k + 3] * il;
                G[4 * tb + k] += (a0 + a1) + (a2 + a3); L[4 * tb + k] += a3; }
        f32x16 o[2] = {f32x16{}, f32x16{}};
#pragma unroll
        for (int tb = 0; tb < 4; ++tb)
#pragma unroll
            for (int s2 = 0; s2 < 2; ++s2) {
                v4u a; a.x = cvtpk(p[tb][8 * s2 + 0], p[tb][8 * s2 + 1]); a.y = cvtpk(p[tb][8 * s2 + 2], p[tb][8 * s2 + 3]); a.z = cvtpk(p[tb][8 * s2 + 4], p[tb][8 * s2 + 5]); a.w = cvtpk(p[tb][8 * s2 + 6], p[tb][8 * s2 + 7]);
                const bf16x8 pf = __builtin_bit_cast(bf16x8, a);
                LAS const unsigned char* vbb = vb + (tb >> 1) * AT_BUF + ((tb & 1) * 2 + s2) * 1024;
#pragma unroll
                for (int dh = 0; dh < 2; ++dh) { const s16x4 lo = vtr(vbb + dh * 4096), hh = vtr(vbb + dh * 4096 + 512);
                    const bf16x8 vf = {lo[0], lo[1], lo[2], lo[3], hh[0], hh[1], hh[2], hh[3]};
                    o[dh] = __builtin_amdgcn_mfma_f32_32x32x16_bf16(vf, pf, o[dh], 0, 0, 0); }
                asm volatile("" ::: "memory");
            }
        bf16* op = (bf16*)(ws + WS_OCMP) + row * 384 + h * 64 + 4 * hi;
#pragma unroll
        for (int dh = 0; dh < 2; ++dh)
#pragma unroll
            for (int g4 = 0; g4 < 4; ++g4) { u32x2v w; w.x = cvtpk(o[dh][4 * g4] * il, o[dh][4 * g4 + 1] * il); w.y = cvtpk(o[dh][4 * g4 + 2] * il, o[dh][4 * g4 + 3] * il);
                *(u32x2v*)(op + dh * 32 + 8 * g4) = w; }
    }
    const int cur = qpos >> 6;
    unsigned key[16], okey[16];
#pragma unroll
    for (int jj = 0; jj < 16; ++jj) {
        const auto sw = __builtin_amdgcn_permlane32_swap(__float_as_uint(L[jj]), __float_as_uint(L[jj]), false, false);
        const float lp = __uint_as_float(hi ? sw[0] : sw[1]);
        L[jj] = lp;
    }
#pragma unroll
    for (int jj = 0; jj < 16; ++jj) {
        const int j = 2 * jj + hi;
        float v = G[jj] + (hi ? L[jj] : (jj > 0 ? L[jj > 0 ? jj - 1 : 0] : 0.f));
        if (j == 0 || j == cur || j == cur - 1) v = INFINITY;
        if (j * 64 > qpos) v = -INFINITY;
        const unsigned u = __float_as_uint(v); const unsigned ord = (u & 0x80000000u) ? ~u : (u | 0x80000000u);
        key[jj] = (ord & ~31u) | (unsigned)(31 - j);
    }
#pragma unroll
    for (int jj = 0; jj < 16; ++jj) { const auto sw = __builtin_amdgcn_permlane32_swap(key[jj], key[jj], false, false); okey[jj] = hi ? sw[0] : sw[1]; }
    unsigned mask = 0;
#pragma unroll
    for (int jj = 0; jj < 16; ++jj) {
        int rank = 0;
#pragma unroll
        for (int kk = 0; kk < 16; ++kk) { rank += (key[kk] > key[jj]) ? 1 : 0; rank += (okey[kk] > key[jj]) ? 1 : 0; }
        if (rank < 16) mask |= 1u << (2 * jj + hi);
    }
    mask = red32_or(mask);
    if (hi == 0) ((unsigned*)(ws + WS_SEL))[(size_t)(b * 2 + g) * S_ + qpos] = mask;
    __syncthreads();
}
__device__ __forceinline__ void lora_rows(unsigned char* ws, int tid) {
    const int gw = blockIdx.x * NWAVES + (tid >> 6), ngw = gridDim.x * NWAVES, lane = tid & 63;
    bf16* kvl = (bf16*)(ws + WS_KVL); const bf16* ql = (const bf16*)(ws + WS_QL); float* ssql = (float*)(ws + WS_SSQL);
    for (int m = gw; m < T_; m += ngw) {
        const unsigned kv = *(const unsigned*)(kvl + (size_t)m * 128 + 2 * lane);
        const float k0 = __uint_as_float(kv << 16), k1 = __uint_as_float(kv & 0xffff0000u);
        const uint2 qv = *(const uint2*)(ql + (size_t)m * 256 + 4 * lane);
        const float q0 = __uint_as_float(qv.x << 16), q1 = __uint_as_float(qv.x & 0xffff0000u), q2 = __uint_as_float(qv.y << 16), q3 = __uint_as_float(qv.y & 0xffff0000u);
        const float sk = wave_sum2(k0 * k0 + k1 * k1), sq = wave_sum2((q0 * q0 + q1 * q1) + (q2 * q2 + q3 * q3));
        const float rk = rsqrtf(sk * (1.f / 128.f) + EPS);
        *(unsigned*)(kvl + (size_t)m * 128 + 2 * lane) = pk2(k0 * rk, k1 * rk);
        if (lane == 0) ssql[m] = sq;
    }
}
__device__ __forceinline__ void post_misc(unsigned char* ws, const float* big, const float* bfg, int tid) {
    const float* mr = (const float*)(ws + WS_MISCRAW); const float* cosM = (const float*)(ws + WS_COSM); const float* sinM = (const float*)(ws + WS_SINM);
    bf16* kr = (bf16*)(ws + WS_KR); float* gm = (float*)(ws + WS_GM);
    for (int idx = blockIdx.x * NTHR + tid; idx < T_ * 64; idx += gridDim.x * NTHR) {
        const int row = idx >> 6, c = idx & 63; const float* r = mr + (size_t)row * 64; const float v = r[c];
        if (c < 32) { const int i = c & 15; const float x1 = r[i], x2 = r[16 + i], cs = cosM[row * 16 + i], sn = sinM[row * 16 + i];
            kr[(size_t)row * 32 + c] = f2bf((c < 16) ? x1 * cs - x2 * sn : x1 * sn + x2 * cs); }
        else if (c < 50) gm[(size_t)row * 32 + (c - 32)] = __builtin_amdgcn_rcpf(1.f + __expf(-v));
        else if (c < 54) gm[(size_t)row * 32 + 18 + (c - 50)] = v + big[c - 50];
        else if (c < 58) { const float z = v + bfg[c - 54]; gm[(size_t)row * 32 + 22 + (c - 54)] = fminf(z, 0.f) - __logf(1.f + __expf(-fabsf(z))); }
    }
}

typedef float f32x4v __attribute__((ext_vector_type(4)));
__device__ __forceinline__ void compress_item(unsigned char* ws, LAS unsigned char* lds, const float* cmp_pos, int item, int wave_u) {
    const int lane = fresh_lane(), tid = wave_u * 64 + lane;
    const int nb = item & 7, g = (item >> 3) & 1, b = (item >> 4) & 7, kv = item >> 7;
    const bf16* tok = (const bf16*)(ws + WS_NSA) + (size_t)b * S_ * 1152 + (kv ? 512 : 384) + g * 64;
    const bf16* wt = (const bf16*)(ws + (kv ? WT_CV : WT_CK));
    const int nrow = nb * 16 + (lane & 15), kq = lane >> 4;
    f32x4v acc[4] = {f32x4v{}, f32x4v{}, f32x4v{}, f32x4v{}};
#pragma unroll
    for (int hb = 0; hb < 2; ++hb) {
        v4u t4[4]; f32x4v p0[4], p1[4]; bf16x8 bfr[4][4];
#pragma unroll
        for (int q = 0; q < 4; ++q) {
            const int k = wave_u * 256 + (4 * hb + q) * 32 + kq * 8, l = k >> 6, d = k & 63;
            int trow = 16 * nrow + l; trow = trow < S_ ? trow : S_ - 1;
            t4[q] = *(const v4u*)(tok + (size_t)trow * 1152 + d);
            p0[q] = *(const f32x4v*)(cmp_pos + k); p1[q] = *(const f32x4v*)(cmp_pos + k + 4);
#pragma unroll
            for (int cb = 0; cb < 4; ++cb) bfr[q][cb] = *(const bf16x8*)(wt + (size_t)(cb * 16 + (lane & 15)) * 2048 + k);
        }
        asm volatile("" : "+v"(t4[0]), "+v"(t4[1]), "+v"(t4[2]), "+v"(t4[3]), "+v"(p0[0]), "+v"(p0[1]), "+v"(p0[2]), "+v"(p0[3]), "+v"(p1[0]), "+v"(p1[1]), "+v"(p1[2]), "+v"(p1[3]));
        asm volatile("" : "+v"(bfr[0][0]), "+v"(bfr[0][1]), "+v"(bfr[0][2]), "+v"(bfr[0][3]), "+v"(bfr[1][0]), "+v"(bfr[1][1]), "+v"(bfr[1][2]), "+v"(bfr[1][3]));
        asm volatile("" : "+v"(bfr[2][0]), "+v"(bfr[2][1]), "+v"(bfr[2][2]), "+v"(bfr[2][3]), "+v"(bfr[3][0]), "+v"(bfr[3][1]), "+v"(bfr[3][2]), "+v"(bfr[3][3]));
#pragma unroll
        for (int q = 0; q < 4; ++q) {
            v4u a4;
            a4.x = cvtpk(__uint_as_float(t4[q].x << 16) + p0[q][0], __uint_as_float(t4[q].x & 0xffff0000u) + p0[q][1]); a4.y = cvtpk(__uint_as_float(t4[q].y << 16) + p0[q][2], __uint_as_float(t4[q].y & 0xffff0000u) + p0[q][3]);
            a4.z = cvtpk(__uint_as_float(t4[q].z << 16) + p1[q][0], __uint_as_float(t4[q].z & 0xffff0000u) + p1[q][1]); a4.w = cvtpk(__uint_as_float(t4[q].w << 16) + p1[q][2], __uint_as_float(t4[q].w & 0xffff0000u) + p1[q][3]);
            const bf16x8 af = __builtin_bit_cast(bf16x8, a4);
#pragma unroll
            for (int cb = 0; cb < 4; ++cb) acc[cb] = __builtin_amdgcn_mfma_f32_16x16x32_bf16(af, bfr[q][cb], acc[cb], 0, 0, 0);
        }
    }
    LAS float* red = (LAS float*)lds + wave_u * 1024;
#pragma unroll
    for (int cb = 0; cb < 4; ++cb)
#pragma unroll
        for (int r = 0; r < 4; ++r) red[(4 * (lane >> 4) + r) * 64 + cb * 16 + (lane & 15)] = acc[cb][r];
    __syncthreads();
    bf16* out = (bf16*)(ws + WS_KCV) + (size_t)kv * (8 * 2 * 128 * 64) + ((size_t)(b * 2 + g) * 128 + nb * 16) * 64;
    for (int o = tid; o < 1024; o += NTHR) { float sum = 0.f;
#pragma unroll
        for (int w8 = 0; w8 < 8; ++w8) sum += ((LAS float*)lds)[w8 * 1024 + o];
        out[o] = f2bf(sum); }
    __syncthreads();
}
__device__ __forceinline__ f32x4v mm16(const LAS bf16* A, int lda, int arow0, const LAS bf16* Bt, int ldb, int bcol0, int K, int lane, f32x4v acc) {
    const LAS bf16* ap = A + (arow0 + (lane & 15)) * lda + 8 * (lane >> 4); const LAS bf16* bp = Bt + (bcol0 + (lane & 15)) * ldb + 8 * (lane >> 4);
    for (int k = 0; k < K; k += 32) acc = __builtin_amdgcn_mfma_f32_16x16x32_bf16(*(const LAS bf16x8*)(ap + k), *(const LAS bf16x8*)(bp + k), acc, 0, 0, 0);
    return acc;
}
constexpr int ML_LD = 72;
constexpr int ML_STRIDE = 3 * 64 * ML_LD * 2 + 256;
__device__ __forceinline__ void mlocal_item(unsigned char* ws, LAS unsigned char* lds, const float* convw, const float* convb, const float* big, const float* bfg, int chunk0, int wave_u) {
    const int lane = fresh_lane(), tid = wave_u * 64 + lane;
    const int h = (chunk0 >> 5) & 3, b = chunk0 >> 7;
    LAS bf16* WQ = (LAS bf16*)lds;
    LAS bf16* WK = WQ + 64 * ML_LD;
    const bf16* cm = (const bf16*)(ws + WS_CM);
#define ML_PTRS(ch) const int chunk = chunk0 + (ch); const int c = chunk & 31; const int row0 = b * S_ + c * 64; LAS bf16* XS = WK + 64 * ML_LD + (ch) * (ML_STRIDE / 2); \
    LAS bf16* VT = XS + 64 * ML_LD; LAS bf16* WKT = VT + 64 * ML_LD; LAS float* wl = (LAS float*)(WKT + 64 * ML_LD); (void)c; (void)row0; (void)XS; (void)VT; (void)WKT; (void)wl; (void)chunk;
    {
        v4u gx[2][4], gv[2]; const int l = tid >> 3, ch0 = (tid & 7) * 8;
#pragma unroll
        for (int ch = 0; ch < 2; ++ch) { ML_PTRS(ch) const int row = row0 + l, s = c * 64 + l;
#pragma unroll
            for (int j = 0; j < 4; ++j) gx[ch][j] = (s - 3 + j >= 0) ? *(const v4u*)(cm + (size_t)(row - 3 + j) * 768 + h * 64 + ch0) : v4u{0u, 0u, 0u, 0u};
            gv[ch] = *(const v4u*)(cm + (size_t)row * 768 + 256 + h * 64 + ch0); }
        asm volatile("" : "+v"(gx[0][0]), "+v"(gx[0][1]), "+v"(gx[0][2]), "+v"(gx[0][3]), "+v"(gx[1][0]), "+v"(gx[1][1]), "+v"(gx[1][2]), "+v"(gx[1][3]), "+v"(gv[0]), "+v"(gv[1]));
#pragma unroll
        for (int ch = 0; ch < 2; ++ch) { ML_PTRS(ch) const int row = row0 + l;
            float a[8];
#pragma unroll
            for (int i = 0; i < 8; ++i) a[i] = convb[h * 64 + ch0 + i];
#pragma unroll
            for (int j = 0; j < 4; ++j) { const v4u x4 = gx[ch][j];
                const float* cw = convw + j * 256 + h * 64 + ch0;
                a[0] += cw[0] * __uint_as_float(x4.x << 16); a[1] += cw[1] * __uint_as_float(x4.x & 0xffff0000u); a[2] += cw[2] * __uint_as_float(x4.y << 16); a[3] += cw[3] * __uint_as_float(x4.y & 0xffff0000u);
                a[4] += cw[4] * __uint_as_float(x4.z << 16); a[5] += cw[5] * __uint_as_float(x4.z & 0xffff0000u); a[6] += cw[6] * __uint_as_float(x4.w << 16); a[7] += cw[7] * __uint_as_float(x4.w & 0xffff0000u); }
            v4u o4; float r[8];
#pragma unroll
            for (int i = 0; i < 8; ++i) r[i] = a[i] * __builtin_amdgcn_rcpf(1.f + __expf(-a[i]));
            o4.x = cvtpk(r[0], r[1]); o4.y = cvtpk(r[2], r[3]); o4.z = cvtpk(r[4], r[5]); o4.w = cvtpk(r[6], r[7]);
            *(v4u*)((bf16*)(ws + WS_XC) + (size_t)row * 256 + h * 64 + ch0) = o4;
            *(LAS v4u*)(XS + l * ML_LD + ch0) = o4;
            const v4u v4 = gv[ch];
            VT[(ch0 + 0) * ML_LD + l] = (bf16)(v4.x & 0xffffu); VT[(ch0 + 1) * ML_LD + l] = (bf16)(v4.x >> 16); VT[(ch0 + 2) * ML_LD + l] = (bf16)(v4.y & 0xffffu); VT[(ch0 + 3) * ML_LD + l] = (bf16)(v4.y >> 16);
            VT[(ch0 + 4) * ML_LD + l] = (bf16)(v4.z & 0xffffu); VT[(ch0 + 5) * ML_LD + l] = (bf16)(v4.z >> 16); VT[(ch0 + 6) * ML_LD + l] = (bf16)(v4.w & 0xffffu); VT[(ch0 + 7) * ML_LD + l] = (bf16)(v4.w >> 16);
        }
    }
    {
        const int e = tid >> 3, d0 = (tid & 7) * 8;
        *(LAS v4u*)(WQ + e * ML_LD + d0) = *(const v4u*)((const bf16*)(ws + WT_QM) + h * 4096 + e * 64 + d0);
        *(LAS v4u*)(WK + e * ML_LD + d0) = *(const v4u*)((const bf16*)(ws + WT_KM) + h * 4096 + e * 64 + d0);
    }
    if (wave_u < 2) { ML_PTRS(wave_u)
        const float* mr = (const float*)(ws + WS_MISCRAW) + (size_t)(row0 + lane) * 64;
        const float z = mr[54 + h] + bfg[h]; float lf = fminf(z, 0.f) - __logf(1.f + __expf(-fabsf(z)));
        const float ig = mr[50 + h] + big[h];
#pragma unroll
        for (int o = 1; o < 64; o <<= 1) { const float t = bperm(lf, lane - o); if (lane >= o) lf += t; }
        const float bL = __int_as_float(__builtin_amdgcn_readlane(__float_as_int(lf), 63));
        const float a = bL - lf + ig; const float mx = wave_max2(a);
        wl[lane] = __expf(a - mx);
        if (lane == 0) { ((float*)(ws + WS_ML))[chunk] = mx; ((float*)(ws + WS_BL))[chunk] = bL; }
    }
    __syncthreads();
#pragma unroll
    for (int ch = 0; ch < 2; ++ch) { ML_PTRS(ch)
        const int lb = wave_u & 3; const bool isk = wave_u >= 4;
        const LAS bf16* Wt = isk ? WK : WQ;
        bf16* og = (bf16*)(ws + (isk ? WS_MK : WS_MQ)) + (size_t)(row0 + 16 * lb + 4 * (lane >> 4)) * 256 + h * 64 + (lane & 15);
        float w4[4];
#pragma unroll
        for (int r = 0; r < 4; ++r) w4[r] = wl[16 * lb + 4 * (lane >> 4) + r];
#pragma unroll
        for (int eb = 0; eb < 4; ++eb) {
            f32x4v acc = mm16(XS, ML_LD, 16 * lb, Wt, ML_LD, 16 * eb, 64, lane, f32x4v{});
            if (!isk) {
#pragma unroll
                for (int r = 0; r < 4; ++r) og[(size_t)r * 256 + 16 * eb] = f2bf(acc[r] * 0.125f);
            } else {
                bf16 kb[4];
#pragma unroll
                for (int r = 0; r < 4; ++r) { kb[r] = f2bf(acc[r]); og[(size_t)r * 256 + 16 * eb] = kb[r]; }
                u32x2v w2; w2.x = cvtpk(bf2f(kb[0]) * w4[0], bf2f(kb[1]) * w4[1]); w2.y = cvtpk(bf2f(kb[2]) * w4[2], bf2f(kb[3]) * w4[3]);
                *(LAS u32x2v*)(WKT + (16 * eb + (lane & 15)) * ML_LD + 16 * lb + 4 * (lane >> 4)) = w2;
            }
        }
    }
    __syncthreads();
#pragma unroll
    for (int ch = 0; ch < 2; ++ch) { ML_PTRS(ch)
        float* ct = (float*)(ws + WS_CT) + (size_t)chunk * 4096;
#pragma unroll
        for (int i = 0; i < 2; ++i) { const int blk = wave_u * 2 + i, eb = blk >> 2, db = blk & 3;
            const f32x4v acc = mm16(VT, ML_LD, 16 * eb, WKT, ML_LD, 16 * db, 64, lane, f32x4v{});
#pragma unroll
            for (int r = 0; r < 4; ++r) ct[(16 * eb + 4 * (lane >> 4) + r) * 64 + 16 * db + (lane & 15)] = acc[r]; }
    }
    if (tid < 128) { ML_PTRS(tid >> 6)
        const int d = tid & 63; float n = 0.f; const LAS bf16* wr_ = WKT + d * ML_LD;
        for (int l = 0; l < 64; ++l) n += bf2f(wr_[l]);
        ((float*)(ws + WS_NL))[chunk * 64 + d] = n; }
#undef ML_PTRS
    __syncthreads();
}
__device__ __forceinline__ void mscan_item(unsigned char* ws, int item, int wave_u) {
    const int tid = wave_u * 64 + fresh_lane();
    const int bh = item / 9, part = item % 9;
    if (part == 8 && tid >= 64) return;
    float* base; size_t stride;
    if (part < 8) { base = (float*)(ws + WS_CT) + (size_t)bh * 32 * 4096 + part * 512 + tid; stride = 4096; } else { base = (float*)(ws + WS_NL) + (size_t)bh * 32 * 64 + tid; stride = 64; }
    const float* ML = (const float*)(ws + WS_ML); const float* BL = (const float*)(ws + WS_BL); float* MPv = (float*)(ws + WS_MP);
    float cl[32];
#pragma unroll
    for (int c = 0; c < 32; ++c) cl[c] = base[(size_t)c * stride];
    float Cv = 0.f, m = 0.f;
#pragma unroll
    for (int c = 0; c < 32; ++c) {
        const float ml = ML[bh * 32 + c], bl = BL[bh * 32 + c];
        base[(size_t)c * stride] = Cv;
        if (part == 8 && tid == 0) MPv[bh * 32 + c] = m;
        const float mn = fmaxf(bl + m, ml);
        Cv = __expf(bl + m - mn) * Cv + __expf(ml - mn) * cl[c]; m = mn;
    }
}
constexpr int MO_STRIDE = 5 * 64 * ML_LD * 2 + 64 * 65 * 4 + 6 * 64 * 4;
__device__ __forceinline__ void mout_item(unsigned char* ws, LAS unsigned char* lds, const float* gmh, const float* skip, int chunk0, int wave_u) {
    const int lane = fresh_lane(), tid = wave_u * 64 + lane;
    const int h = (chunk0 >> 5) & 3, b = chunk0 >> 7;
    const float* gm = (const float*)(ws + WS_GM);
#define MO_PTRS(ch) const int chunk = chunk0 + (ch); const int row0 = b * S_ + (chunk & 31) * 64; LAS unsigned char* cb_ = lds + (ch) * MO_STRIDE; \
    LAS bf16* QS = (LAS bf16*)cb_; LAS bf16* KS = QS + 64 * ML_LD; LAS bf16* VT = KS + 64 * ML_LD; LAS bf16* CP = VT + 64 * ML_LD; LAS bf16* SW = CP + 64 * ML_LD; \
    LAS float* HS = (LAS float*)(SW + 64 * ML_LD); LAS float* bs = HS + 64 * 65; LAS float* us = bs + 64; LAS float* ns = us + 64; LAS float* mts = ns + 64; LAS float* ints = mts + 64; LAS float* dinv = ints + 64; \
    (void)row0; (void)QS; (void)KS; (void)VT; (void)CP; (void)SW; (void)HS; (void)bs; (void)us; (void)ns; (void)mts; (void)ints; (void)dinv; (void)chunk;
    {
        v4u gq[2], gk[2], gv[2]; f32x4v gc0[2], gc1[2];
        const int l = tid >> 3, c0 = (tid & 7) * 8;
#pragma unroll
        for (int ch = 0; ch < 2; ++ch) { MO_PTRS(ch) const int row = row0 + l;
            gq[ch] = *(const v4u*)((const bf16*)(ws + WS_MQ) + (size_t)row * 256 + h * 64 + c0); gk[ch] = *(const v4u*)((const bf16*)(ws + WS_MK) + (size_t)row * 256 + h * 64 + c0);
            gv[ch] = *(const v4u*)((const bf16*)(ws + WS_CM) + (size_t)row * 768 + 256 + h * 64 + c0);
            const float* ct = (const float*)(ws + WS_CT) + (size_t)chunk * 4096 + l * 64 + c0;
            gc0[ch] = *(const f32x4v*)ct; gc1[ch] = *(const f32x4v*)(ct + 4); }
        asm volatile("" : "+v"(gq[0]), "+v"(gq[1]), "+v"(gk[0]), "+v"(gk[1]), "+v"(gv[0]), "+v"(gv[1]), "+v"(gc0[0]), "+v"(gc0[1]), "+v"(gc1[0]), "+v"(gc1[1]));
#pragma unroll
        for (int ch = 0; ch < 2; ++ch) { MO_PTRS(ch)
            *(LAS v4u*)(QS + l * ML_LD + c0) = gq[ch]; *(LAS v4u*)(KS + l * ML_LD + c0) = gk[ch];
            const v4u v4 = gv[ch];
            VT[(c0 + 0) * ML_LD + l] = (bf16)(v4.x & 0xffffu); VT[(c0 + 1) * ML_LD + l] = (bf16)(v4.x >> 16); VT[(c0 + 2) * ML_LD + l] = (bf16)(v4.y & 0xffffu); VT[(c0 + 3) * ML_LD + l] = (bf16)(v4.y >> 16);
            VT[(c0 + 4) * ML_LD + l] = (bf16)(v4.z & 0xffffu); VT[(c0 + 5) * ML_LD + l] = (bf16)(v4.z >> 16); VT[(c0 + 6) * ML_LD + l] = (bf16)(v4.w & 0xffffu); VT[(c0 + 7) * ML_LD + l] = (bf16)(v4.w >> 16);
            const f32x4v c0v = gc0[ch], c1v = gc1[ch];
            v4u cw; cw.x = cvtpk(c0v[0], c0v[1]); cw.y = cvtpk(c0v[2], c0v[3]); cw.z = cvtpk(c1v[0], c1v[1]); cw.w = cvtpk(c1v[2], c1v[3]);
            *(LAS v4u*)(CP + l * ML_LD + c0) = cw; }
    }
    if (wave_u < 2) { MO_PTRS(wave_u)
        const float ig = gm[(size_t)(row0 + lane) * 32 + 18 + h]; float lf = gm[(size_t)(row0 + lane) * 32 + 22 + h];
#pragma unroll
        for (int o = 1; o < 64; o <<= 1) { const float t = bperm(lf, lane - o); if (lane >= o) lf += t; }
        const float u = ig - lf; float cu = u;
#pragma unroll
        for (int o = 1; o < 64; o <<= 1) { const float t = bperm(cu, lane - o); if (lane >= o) cu = fmaxf(cu, t); }
        const float mprev = ((const float*)(ws + WS_MP))[chunk];
        const float mt = lf + fmaxf(mprev, cu);
        bs[lane] = lf; us[lane] = u; mts[lane] = mt; ints[lane] = __expf(lf + mprev - mt); ns[lane] = ((const float*)(ws + WS_NL))[chunk * 64 + lane];
    }
    __syncthreads();
#pragma unroll
    for (int ch = 0; ch < 2; ++ch) { MO_PTRS(ch)
#pragma unroll
        for (int i = 0; i < 2; ++i) { const int blk = wave_u * 2 + i, lb = blk >> 2, sb = blk & 3;
            f32x4v acc = f32x4v{};
            if (sb <= lb) acc = mm16(QS, ML_LD, 16 * lb, KS, ML_LD, 16 * sb, 64, lane, acc);
            const int sidx = 16 * sb + (lane & 15); const float usv = us[sidx];
#pragma unroll
            for (int r = 0; r < 4; ++r) { const int l = 16 * lb + 4 * (lane >> 4) + r;
                const float v = (sidx <= l) ? acc[r] * __expf(bs[l] + usv - mts[l]) : 0.f;
                SW[l * ML_LD + sidx] = f2bf(v); } }
    }
    __syncthreads();
    if (tid < 128) { MO_PTRS(tid >> 6)
        const int l = tid & 63; float qn = 0.f, ssum = 0.f;
        for (int d = 0; d < 64; ++d) { qn += bf2f(QS[l * ML_LD + d]) * ns[d]; ssum += bf2f(SW[l * ML_LD + d]); }
        const float den = ints[l] * qn + ssum;
        dinv[l] = __builtin_amdgcn_rcpf(fmaxf(fabsf(den), __expf(-mts[l])));
    }
    f32x4v hq[2][2], hs2[2][2];
#pragma unroll
    for (int ch = 0; ch < 2; ++ch) { MO_PTRS(ch)
#pragma unroll
        for (int i = 0; i < 2; ++i) { const int blk = wave_u * 2 + i, lb = blk >> 2, eb = blk & 3;
            hq[ch][i] = mm16(QS, ML_LD, 16 * lb, CP, ML_LD, 16 * eb, 64, lane, f32x4v{});
            hs2[ch][i] = mm16(SW, ML_LD, 16 * lb, VT, ML_LD, 16 * eb, 16 * lb + 16 <= 32 ? 32 : 64, lane, f32x4v{}); }
    }
    __syncthreads();
#pragma unroll
    for (int ch = 0; ch < 2; ++ch) { MO_PTRS(ch)
#pragma unroll
        for (int i = 0; i < 2; ++i) { const int blk = wave_u * 2 + i, lb = blk >> 2, eb = blk & 3; const int e = 16 * eb + (lane & 15);
#pragma unroll
            for (int r = 0; r < 4; ++r) { const int l = 16 * lb + 4 * (lane >> 4) + r;
                const float og = bf2f(((const bf16*)(ws + WS_CM))[(size_t)(row0 + l) * 768 + 512 + h * 64 + e]);
                HS[l * 65 + e] = (ints[l] * hq[ch][i][r] + hs2[ch][i][r]) * dinv[l] * __builtin_amdgcn_rcpf(1.f + __expf(-og)); } }
    }
    __syncthreads();
#pragma unroll
    for (int ch = 0; ch < 2; ++ch) { MO_PTRS(ch)
        const int l = tid >> 3, e0 = (tid & 7) * 8, row = row0 + l;
        float v[8]; float mu = 0.f;
#pragma unroll
        for (int i = 0; i < 8; ++i) { v[i] = HS[l * 65 + e0 + i]; mu += v[i]; }
        mu += sxf<1>(mu); mu += sxf<2>(mu); mu += sxf<4>(mu); mu *= (1.f / 64.f);
        float var = 0.f;
#pragma unroll
        for (int i = 0; i < 8; ++i) { const float dl = v[i] - mu; var += dl * dl; }
        var += sxf<1>(var); var += sxf<2>(var); var += sxf<4>(var);
        const float rs = rsqrtf(var * (1.f / 64.f) + EPS);
        const v4u x4 = *(const v4u*)((const bf16*)(ws + WS_XC) + (size_t)row * 256 + h * 64 + e0);
        float xv[8]; xv[0] = __uint_as_float(x4.x << 16); xv[1] = __uint_as_float(x4.x & 0xffff0000u); xv[2] = __uint_as_float(x4.y << 16); xv[3] = __uint_as_float(x4.y & 0xffff0000u);
        xv[4] = __uint_as_float(x4.z << 16); xv[5] = __uint_as_float(x4.z & 0xffff0000u); xv[6] = __uint_as_float(x4.w << 16); xv[7] = __uint_as_float(x4.w & 0xffff0000u);
        float r[8];
#pragma unroll
        for (int i = 0; i < 8; ++i) r[i] = (v[i] - mu) * rs * gmh[h * 64 + e0 + i] + skip[h * 64 + e0 + i] * xv[i];
        v4u w4; w4.x = cvtpk(r[0], r[1]); w4.y = cvtpk(r[2], r[3]); w4.z = cvtpk(r[4], r[5]); w4.w = cvtpk(r[6], r[7]);
        *(v4u*)((bf16*)(ws + WS_HB) + (size_t)row * D_ + 768 + h * 64 + e0) = w4;
    }
#undef MO_PTRS
    __syncthreads();
}

__global__ void __launch_bounds__(NTHR, 2) mega(MP p_unused) {
    extern __shared__ __attribute__((aligned(16))) unsigned char lds_raw[];
    LAS unsigned char* lds = (LAS unsigned char*)lds_raw;
    const int wave0 = __builtin_amdgcn_readfirstlane((int)threadIdx.x >> 6);
    const int tid0 = wave0 * 64 + fresh_lane();
    const int xcc = (int)(__builtin_amdgcn_s_getreg((3 << 11) | 20) & 7u);
    volatile LAS unsigned* MISC = (volatile LAS unsigned*)(lds + MISC_OFF);
    for (int u = tid0; u < (LDS_BYTES - RING_BYTES) / 4; u += NTHR) ((LAS unsigned*)(lds + RING_BYTES))[u] = 0u;
    __syncthreads();
    typedef const __attribute__((address_space(4))) MP* kmp_t;
    kmp_t kp0 = (kmp_t)__builtin_amdgcn_kernarg_segment_ptr();
    unsigned char* ws0 = kp0->ws; const int coop = kp0->coop, ph_lo = kp0->ph_lo, ph_hi = kp0->ph_hi;
    XcdBarrier bar; bar.bar = (unsigned*)(ws0 + WS_CTL) + CW_BAR; bar.x = 0; bar.st = nullptr;
    if (coop) bar = xcd_barrier_post((unsigned*)(ws0 + WS_CTL) + CW_BAR, MISC + 8, tid0);
    if (coop == 2) cooperative_groups::this_grid().sync();
    int ph = ph_lo;
    if (ph == 0) {
        const MPK p{kp0}; ph_p0(p, lds, wave0 * 64 + fresh_lane()); ph = 1;
        if (ph < ph_hi) xcd_barrier(bar, wave0 * 64 + fresh_lane());
    }
    bool second = false;
    for (; ph < ph_hi; ++ph) {
        kmp_t kp = kp0; asm volatile("" : "+s"(kp));
        const MPK p{kp}; unsigned char* ws = kp->ws;
#define TID_ (wave0 * 64 + fresh_lane())
#define GW_ (blockIdx.x * NWAVES + wave0)
#define NGW_ (gridDim.x * NWAVES)
        const int l = (ph - 1) / PPL, ty = (ph == 0) ? -1 : (ph == NPH - 1) ? -2 : (ph - 1) % PPL;
        const float* modl = (const float*)(ws + WS_MOD) + (size_t)l * 8 * 6144;
        if (ty == -2) { norm_rows<true, true>(ws + WS_HB, PIN(I_GFIN), nullptr, nullptr, nullptr, p.k->out, GW_, NGW_, fresh_lane());
            if (PROBE_SEL != 0 && blockIdx.x == 0 && TID_ == 0) { asm volatile("s_waitcnt vmcnt(0)" ::: "memory"); p.k->out[0] = ((const float*)(ws + WS_CTL))[100] * 0.001f; } }
        else if (ty == 0 && (PHM & 2)) ph_prep(p, l, lds, TID_);
        else if (ty == 1 && (PHM & 4)) {
            pg8::Gemm g{(const bf16*)(ws + WS_HB), (const bf16*)(ws + WT_IN), T_, 2560, D_}; pg8::StaticOrder S; S.init(T_, 2560, gridDim.x, blockIdx.x);
            pg8::EpiIn E{ws, PIN(I_BIG) + l * 4, PIN(I_BFG) + l * 4};
            pg8::gemm_phase<pg8::EpiIn, pg8::StaticOrder, true, true>(lds, g, S, E, wave0);
            late_transposes(p, l, lds, TID_, 640 % (int)gridDim.x);
        }
        else if (ty == 2 && (PHM & 64)) {
            { pg8::Gemm g{(const bf16*)(ws + WS_KVL), (const bf16*)(ws + WT_UKV), T_, 768, 128}; pg8::StaticOrder S; S.init(T_, 768, gridDim.x, blockIdx.x);
              pg8::EpiUKV E{(bf16*)(ws + WS_KVM), (const float*)(ws + WS_SSKV)}; pg8::gemm_phase<pg8::EpiUKV, pg8::StaticOrder, true, true>(lds, g, S, E, wave0); }
            { pg8::Gemm g{(const bf16*)(ws + WS_QL), (const bf16*)(ws + WT_UQ), T_, 768, 256}; pg8::StaticOrder S; S.init(T_, 768, gridDim.x, blockIdx.x);
              pg8::EpiPlain E{(bf16*)(ws + WS_OSLC), 768}; pg8::gemm_phase<pg8::EpiPlain, pg8::StaticOrder, true, true>(lds, g, S, E, wave0); }
            post_misc(ws, PIN(I_BIG) + l * 4, PIN(I_BFG) + l * 4, TID_);
            unsigned* ctrs = (unsigned*)(ws + WS_CTL) + 8192 + ph * 256 + (second ? 128 : 0); int ks = 0;
            for (;;) { const int it = next_item_q(ctrs, lds, wave0, 96, xcc, ks); if (it < 0) break; const int b = it >> 16, j = it & 0xffff;
                if (j < 64) mlocal_item(ws, lds, PIN(I_CONVW) + l * 1024, PIN(I_CONVB) + l * 256, PIN(I_BIG) + l * 4, PIN(I_BFG) + l * 4, b * 128 + 2 * j, wave0);
                else { const int k = j - 64; compress_item(ws, lds, PIN(I_CMPPOS) + l * 2048, ((k >> 4) << 7) | (b << 4) | (k & 15), wave0); } }
        }
        else if (ty == 3 && (PHM & 128)) {
            unsigned* ctrs = (unsigned*)(ws + WS_CTL) + 8192 + ph * 256 + (second ? 128 : 0); int ks = 0;
            for (;;) { const int it = next_item_q(ctrs, lds, wave0, second ? 64 : 100, xcc, ks); if (it < 0) break; const int b = it >> 16, j = it & 0xffff;
                if (second && (REP_MASK & (1 << 20)) && j >= 48) continue; if (second && (REP_MASK & (1 << 21)) && j < 48) continue;
                if (j < 18) mla_unit(ws, lds, b, j % 6, 7 - j / 6, wave0);
                else if (j < 34) cmp_unit(ws, lds, b, (j - 18) >> 3, 7 - ((j - 18) & 7), wave0);
                else if (j < 64) { const int u = j - 16; mla_unit(ws, lds, b, u % 6, 7 - u / 6, wave0); }
                else mscan_item(ws, b * 36 + (j - 64), wave0); }
        }
        else if (ty == 4 && (PHM & 256)) {
            unsigned* ctrs = (unsigned*)(ws + WS_CTL) + 8192 + ph * 256 + (second ? 128 : 0); int ks = 0;
            for (;;) { const int it = next_item_q(ctrs, lds, wave0, 160, xcc, ks); if (it < 0) break; const int b = it >> 16, j = it & 0xffff;
                if (second && (REP_MASK & (1 << 16)) && j >= 96) continue; if (second && (REP_MASK & (1 << 17)) && j < 96) continue;
                if (j < 36) nsa_branch_unit<AM_SLC>(ws, lds, b, j % 6, 7 - j / 6, wave0);
                else if (j < 84) nsa_branch_unit<AM_WINDOW>(ws, lds, b, (j - 36) % 6, 7 - (j - 36) / 6, wave0);
                else if (j < 96) { const int u = j - 48; nsa_branch_unit<AM_SLC>(ws, lds, b, u % 6, 7 - u / 6, wave0); }
                else mout_item(ws, lds, PIN(I_GMH) + l * 256, PIN(I_SKIP) + l * 256, b * 128 + 2 * (j - 96), wave0); }
        }
        else if (ty == 5) ph_mixnorm(p, l, TID_);
        else if (ty == 6 && (PHM & 8)) {
            pg8::Gemm g{(const bf16*)(ws + WS_HB), (const bf16*)(ws + WT_OUT), T_, D_, D_}; pg8::StaticOrder S; S.init(T_, D_, gridDim.x, blockIdx.x);
            pg8::EpiRes E{(l == 0) ? PIN(I_X) : nullptr, (const bf16*)p.k->out, (bf16*)p.k->out, modl + 2048};
            pg8::gemm_phase<pg8::EpiRes, pg8::StaticOrder, true, true>(lds, g, S, E, wave0);
        }
        else if (ty == 7) norm_rows<true>(p.k->out, PIN(I_GN2) + l * D_, modl + 3072, modl + 4096, (bf16*)(ws + WS_HB), nullptr, GW_, NGW_, fresh_lane());
        else if (ty == 8 && (PHM & 16)) {
            pg8::Gemm g{(const bf16*)(ws + WS_HB), (const bf16*)(ws + WT_GU), T_, 2 * FF, D_}; pg8::StaticOrder S; S.init(T_, 2 * FF, gridDim.x, blockIdx.x);
            pg8::EpiGU E{(bf16*)(ws + WS_ACT)};
            pg8::gemm_phase<pg8::EpiGU, pg8::StaticOrder, true, true>(lds, g, S, E, wave0);
            if (l + 1 < DEPTH) early_transposes(p, l + 1, lds, TID_, 1408 % (int)gridDim.x);
        }
        else if (ty == 9 && (PHM & 32)) {
            pg8::Gemm g{(const bf16*)(ws + WS_ACT), (const bf16*)(ws + WT_DOWN), T_, D_, FF}; pg8::StaticOrder S; S.init(T_, D_, gridDim.x, blockIdx.x);
            pg8::EpiRes E{nullptr, (const bf16*)p.k->out, (l == DEPTH - 1) ? (bf16*)(ws + WS_HB) : (bf16*)p.k->out, modl + 5120};
            pg8::gemm_phase<pg8::EpiRes, pg8::StaticOrder, true, true>(lds, g, S, E, wave0);
        }
        if (REP_MASK != 0 && ty >= 0 && ((REP_MASK >> ty) & 1) && !second) { second = true; --ph; } else second = false;
        if (ph + 1 < ph_hi) xcd_barrier(bar, wave0 * 64 + fresh_lane());
    }
}

extern "C" void kernel_launch(void* const* d_in, const int* in_sizes, int n_in, void* d_out, int out_size, void* d_ws, size_t ws_size, hipStream_t stream) {
    if (n_in != N_IN || ws_size < WS_END) { fprintf(stderr, "kernel_launch: unexpected n_in %d / ws %zu\n", n_in, ws_size); return; }
    static int inited = 0;
    if (!inited) { if (hipFuncSetAttribute((const void*)mega, hipFuncAttributeMaxDynamicSharedMemorySize, LDS_BYTES) != hipSuccess) fprintf(stderr, "hipFuncSetAttribute failed\n"); inited = 1; }
    unsigned char* ws = (unsigned char*)d_ws;
    MP base{}; for (int i = 0; i < N_IN; ++i) base.in[i] = (const float*)d_in[i]; base.out = (float*)d_out; base.ws = ws;
    (void)hipMemsetAsync(ws + WS_CTL, 0, CTL_ZERO_BYTES, stream);
    static int grid = 0;
    if (!grid) {
        int dev = 0, cus = 0, per_cu = 0;
        (void)hipGetDevice(&dev); (void)hipDeviceGetAttribute(&cus, hipDeviceAttributeMultiprocessorCount, dev);
        if (hipOccupancyMaxActiveBlocksPerMultiprocessor(&per_cu, (const void*)mega, NTHR, LDS_BYTES) != hipSuccess || per_cu < 1) { fprintf(stderr, "kernel_launch: occupancy query says %d blocks per CU\n", per_cu); per_cu = 1; }
        (void)hipGetLastError();
        grid = cus;
    }
    MP a = base; a.ph_lo = 0; a.ph_hi = NPH; a.coop = 1;
    void* args[] = {&a};
    const hipError_t e = hipLaunchCooperativeKernel((const void*)mega, dim3(grid), dim3(NTHR), args, LDS_BYTES, stream);
    if (e != hipSuccess) fprintf(stderr, "kernel_launch: cooperative launch failed: %s (grid %d)\n", hipGetErrorString(e), grid);
}
```

```cpp
#include <hip/hip_runtime.h>
#include <cstdint>
#include <cstdio>
#include <type_traits>
#include <hip/hip_cooperative_groups.h>

constexpr int B_ = 8, S_ = 2048, T_ = B_ * S_, D_ = 1024, DIN = 2362, FF = 2816, DEPTH = 2;
constexpr float EPS = 1e-6f;
constexpr float LOG2E = 1.4426950408889634f;
constexpr float QSCALE = 0.125f * LOG2E;
constexpr float MSCALE = 0.10206207261596577f * LOG2E;
enum { I_X = 0, I_C, I_POS, I_GN1, I_GN2, I_WADA, I_BADA, I_WIN, I_CMPPOS, I_WCK, I_WCV, I_GOA, I_GQL, I_WUQ, I_GKVL, I_WUKV, I_GOB,
       I_CONVW, I_CONVB, I_WQM, I_WKM, I_BIG, I_BFG, I_GMH, I_SKIP, I_WOUT, I_WGU, I_WDOWN, I_GFIN, N_IN };

constexpr size_t MiB = 1u << 20;
constexpr size_t WS_CTL = 0;
constexpr size_t WS_MOD = 1 * MiB;
constexpr size_t WS_COSP = WS_MOD + 512 * 1024;
constexpr size_t WS_SINP = WS_COSP + 512 * 1024;
constexpr size_t WS_COSM = WS_SINP + 512 * 1024;
constexpr size_t WS_SINM = WS_COSM + 1 * MiB;
constexpr size_t WS_SSQL = WS_SINM + 1 * MiB;
constexpr size_t WS_SSKV = WS_SSQL + 64 * 1024;
constexpr size_t WS_ML = WS_SSKV + 64 * 1024;
constexpr size_t WS_BL = WS_ML + 4096;
constexpr size_t WS_MP = WS_BL + 4096;
constexpr size_t WS_NL = WS_MP + 4096;
constexpr size_t WS_WT = 8 * MiB;
constexpr size_t WS_RAW = WS_WT;
constexpr size_t WS_HB = 34 * MiB;
constexpr size_t WS_NSA = 66 * MiB;
constexpr size_t WS_KVL = 102 * MiB;
constexpr size_t WS_QL = 106 * MiB;
constexpr size_t WS_CM = 114 * MiB;
constexpr size_t WS_GM = 138 * MiB;
constexpr size_t WS_KM = 140 * MiB;
constexpr size_t WS_QM = 158 * MiB;
constexpr size_t WS_VM = 176 * MiB;
constexpr size_t WS_KCV = 188 * MiB;
constexpr size_t WS_OCMP = 189 * MiB;
constexpr size_t WS_SEL = 201 * MiB;
constexpr size_t WS_XC = 202 * MiB;
constexpr size_t WS_MQ = 210 * MiB;
constexpr size_t WS_MK = 218 * MiB;
constexpr size_t WS_CT = 226 * MiB;
constexpr size_t WS_MISCRAW = 242 * MiB;
constexpr size_t WS_KVM = 140 * MiB;
constexpr size_t WS_KR = 246 * MiB;
constexpr size_t WS_OSLC = 164 * MiB;
constexpr size_t WS_OWIN = 176 * MiB;
constexpr size_t WS_ACT = 66 * MiB;
constexpr size_t WS_END = 256 * MiB;
static_assert(WS_NL + 1024 * 64 * 4 <= WS_WT, "tab");
static_assert(WS_ACT + (size_t)T_ * FF * 2 <= WS_KCV, "act overlay");

typedef unsigned short bf16;
__device__ __forceinline__ float bf2f(bf16 v) { return __uint_as_float(((unsigned)v) << 16); }
__device__ __forceinline__ bf16 f2bf(float f) { unsigned u = __float_as_uint(f); return (bf16)((u + 0x7fffu + ((u >> 16) & 1u)) >> 16); }
__device__ __forceinline__ float sigmoidf_(float x) { return __builtin_amdgcn_rcpf(1.f + __expf(-x)); }
__device__ __forceinline__ float siluf_(float x) { return x * __builtin_amdgcn_rcpf(1.f + __expf(-x)); }
__device__ __forceinline__ float wave_sum(float v) {
#pragma unroll
    for (int o = 1; o < 64; o <<= 1) v += __shfl_xor(v, o);
    return v;
}

__device__ __forceinline__ int fresh_lane() { int l; asm volatile("v_mbcnt_lo_u32_b32 %0, -1, 0\n\tv_mbcnt_hi_u32_b32 %0, -1, %0" : "=&v"(l)); return l; }
template <int M> __device__ __forceinline__ float sxf(float v) { static_assert(M >= 1 && M < 32, "swizzle xor mask"); return __int_as_float(__builtin_amdgcn_ds_swizzle(__float_as_int(v), (M << 10) | 0x1f)); }
__device__ __forceinline__ float red32_max(float v) { auto r = __builtin_amdgcn_permlane32_swap(__float_as_uint(v), __float_as_uint(v), false, false); return fmaxf(__uint_as_float(r[0]), __uint_as_float(r[1])); }
__device__ __forceinline__ float red32_sum(float v) { auto r = __builtin_amdgcn_permlane32_swap(__float_as_uint(v), __float_as_uint(v), false, false); return __uint_as_float(r[0]) + __uint_as_float(r[1]); }
__device__ __forceinline__ unsigned red32_or(unsigned v) { auto r = __builtin_amdgcn_permlane32_swap(v, v, false, false); return r[0] | r[1]; }
__device__ __forceinline__ float bperm(float v, int src_lane) { return __int_as_float(__builtin_amdgcn_ds_bpermute(src_lane << 2, __float_as_int(v))); }
__device__ __forceinline__ float wave_sum2(float v) { v += sxf<1>(v); v += sxf<2>(v); v += sxf<4>(v); v += sxf<8>(v); v += sxf<16>(v); return red32_sum(v); }
__device__ __forceinline__ float wave_max2(float v) { v = fmaxf(v, sxf<1>(v)); v = fmaxf(v, sxf<2>(v)); v = fmaxf(v, sxf<4>(v)); v = fmaxf(v, sxf<8>(v)); v = fmaxf(v, sxf<16>(v)); return red32_max(v); }
namespace pg8 {
#define PG8_LAS __attribute__((address_space(3)))
typedef unsigned short bf16_t;
typedef short bf16x8 __attribute__((ext_vector_type(8)));
typedef float f32x4 __attribute__((ext_vector_type(4)));
typedef unsigned u32x4 __attribute__((ext_vector_type(4)));
constexpr int BM = 256, BK = 64, HALF = 128, HTB = HALF * BK * 2  , STAGE_BYTES = 8 * HTB, NXCD = 8, WGM = 8;

__host__ __device__ __forceinline__ int lds_byte(int r, int c) { const int st = (r >> 4) * 2 + (c >> 5), rr = r & 15, cc = c & 31, ob = rr * 64 + cc * 2; return st * 1024 + (ob ^ (((ob >> 9) & 1) << 5)); }
__host__ __device__ __forceinline__ void stage_rc(int b, int& R, int& C) { const int st = b / 1024, sb = b % 1024, swz = sb ^ (((sb >> 9) & 1) << 5); R = (st >> 1) * 16 + swz / 64; C = (st & 1) * 32 + (swz % 64) / 2; }
__host__ __device__ __forceinline__ int perm32(int rho) { const int n = rho >> 4, i = rho & 15; return 8 * (i >> 2) + 4 * n + (i & 3); }

struct Unit { int pm, pn; };
struct Gemm { const bf16_t* A; const bf16_t* Bt; int M, N, K; };

struct StaticOrder {
    int nM, nN, nwg, G, c;
    __host__ __device__ void init(int M, int N, int G_, int c_) { nM = M / BM; nN = N / BM; nwg = nM * nN; G = G_; c = c_; }
    __host__ __device__ bool next(int i, Unit& u) const {
        const long L = (long)i * G + c; if (L >= nwg) return false;
        int wgid = (int)L; { const int q = nwg / NXCD, r = nwg % NXCD, xcd = wgid % NXCD, off = wgid / NXCD; wgid = (xcd < r ? xcd * (q + 1) : r * (q + 1) + (xcd - r) * q) + off; }
        const int nig = WGM * nN, gid = wgid / nig, fm = gid * WGM, gsz = (nM - fm) < WGM ? (nM - fm) : WGM;
        u.pm = fm + ((wgid % nig) % gsz); u.pn = (wgid % nig) / gsz; return true;
    }
    __device__ __forceinline__ void a_ready(const Unit&) const {}
    __device__ __forceinline__ void done(const Unit&) const {}
};

__device__ __forceinline__ unsigned cvt_pk_bf16(float lo, float hi) { unsigned r; asm volatile("v_cvt_pk_bf16_f32 %0, %1, %2" : "=v"(r) : "v"(lo), "v"(hi)); return r; }
typedef float f32x2 __attribute__((ext_vector_type(2)));

typedef unsigned u32x4 __attribute__((ext_vector_type(4)));
typedef unsigned u32x2 __attribute__((ext_vector_type(2)));
struct EpiIn {
    static constexpr bool PERM = true, AFTER_DRAIN = false;
    unsigned char* ws; const float *big, *bfg;
#define EPI_ROWS(...) _Pragma("unroll") for (int ai = 0; ai < 2; ++ai) _Pragma("unroll") for (int m = 0; m < 4; ++m) { \
        const int row = u.pm * BM + ai * HALF + wr * 64 + m * 16 + fr; float v[8]; \
        _Pragma("unroll") for (int i = 0; i < 4; ++i) { v[i] = acc[ai][bj][m][0][i]; v[4 + i] = acc[ai][bj][m][1][i]; } \
        asm volatile("" : "+v"(v[0]), "+v"(v[1]), "+v"(v[2]), "+v"(v[3]), "+v"(v[4]), "+v"(v[5]), "+v"(v[6]), "+v"(v[7])); \
        __VA_ARGS__ asm volatile("" ::: "memory"); }
#define EPI_PACK(w) u32x4 w; w.x = cvt_pk_bf16(v[0], v[1]); w.y = cvt_pk_bf16(v[2], v[3]); w.z = cvt_pk_bf16(v[4], v[5]); w.w = cvt_pk_bf16(v[6], v[7]);
    __device__ __forceinline__ void operator()(const f32x4 (&acc)[2][2][4][2], const Unit& u, int wr, int wc, int fr, int fq) const {
        half<0>(acc, u, wr, wc, fr, fq); half<1>(acc, u, wr, wc, fr, fq);
    }
    template <int bj> __device__ __forceinline__ void half(const f32x4 (&acc)[2][2][4][2], const Unit& u, int wr, int wc, int fr, int fq) const {
        {
            const int hb = 2 * u.pn + bj;
            int cb = 32 * wc + 8 * fq; asm volatile("" : "+v"(cb), "+v"(fr));
            if (hb <= 8) {
                bf16_t* nsa = (bf16_t*)(ws + WS_NSA) + hb * 128 + cb;
                const bool rope_hb = (hb <= 3) || hb == 5 || hb == 7;
                if (rope_hb) {
                    const float* cosP = (const float*)(ws + WS_COSP); const float* sinP = (const float*)(ws + WS_SINP);
                    const bool mine = ((wc & 1) == 0) && fq < 2; const float sg = (fq == 0) ? -1.f : 1.f; const float sc = (hb < 3) ? QSCALE : 1.f;
                    f32x4 tc0 = {0.f, 0.f, 0.f, 0.f}, tc1 = tc0, ts0 = tc0, ts1 = tc0;
                    if (mine) { const int r0 = u.pm * BM + wr * 64 + fr; tc0 = *(const f32x4*)(cosP + r0 * 8); tc1 = *(const f32x4*)(cosP + r0 * 8 + 4); ts0 = *(const f32x4*)(sinP + r0 * 8); ts1 = *(const f32x4*)(sinP + r0 * 8 + 4); }
                    EPI_ROWS({
                        float pv[8];
                        _Pragma("unroll") for (int i = 0; i < 8; ++i) pv[i] = sxf<16>(v[i]);
                        const f32x4 c0 = tc0, c1 = tc1, s0 = ts0, s1 = ts1;
                        if (mine && (ai * 4 + m) < 7) { const int nx = ai * 4 + m + 1; const int rn = u.pm * BM + (nx >> 2) * HALF + wr * 64 + (nx & 3) * 16 + fr;
                            tc0 = *(const f32x4*)(cosP + rn * 8); tc1 = *(const f32x4*)(cosP + rn * 8 + 4); ts0 = *(const f32x4*)(sinP + rn * 8); ts1 = *(const f32x4*)(sinP + rn * 8 + 4); }
                        if (mine) {
                            _Pragma("unroll") for (int i = 0; i < 4; ++i) { v[i] = v[i] * c0[i] + sg * pv[i] * s0[i]; v[4 + i] = v[4 + i] * c1[i] + sg * pv[4 + i] * s1[i]; }
                        }
                        _Pragma("unroll") for (int i = 0; i < 8; ++i) v[i] *= sc;
                        EPI_PACK(w) *(u32x4*)(nsa + (size_t)row * 1152) = w;
                    })
                } else {
                    EPI_ROWS({ EPI_PACK(w) *(u32x4*)(nsa + (size_t)row * 1152) = w; })
                }
            } else if (hb <= 11) {
                bf16_t* dst = (hb == 9) ? (bf16_t*)(ws + WS_KVL) + cb : (bf16_t*)(ws + WS_QL) + (hb - 10) * 128 + cb;
                const int ld = (hb == 9) ? 128 : 256;
                float* ssq = (hb == 9) ? (float*)(ws + WS_SSKV) : (float*)(ws + WS_SSQL);
                EPI_ROWS({ EPI_PACK(w) *(u32x4*)(dst + (size_t)row * ld) = w;
                    float sq = 0.f;
                    _Pragma("unroll") for (int i = 0; i < 8; ++i) sq += v[i] * v[i];
                    sq += sxf<16>(sq); sq = red32_sum(sq);
                    if (fq == 0) atomicAdd(ssq + row, sq); })
            } else if (hb <= 17) {
                bf16_t* cm = (bf16_t*)(ws + WS_CM) + (hb - 12) * 128 + cb;
                EPI_ROWS({ EPI_PACK(w) *(u32x4*)(cm + (size_t)row * 768) = w; })
            } else if (hb == 18) {
                float* mr = (float*)(ws + WS_MISCRAW) + cb;
                if (wc < 2) { EPI_ROWS({ *(f32x4*)(mr + (size_t)row * 64) = (f32x4){v[0], v[1], v[2], v[3]}; *(f32x4*)(mr + (size_t)row * 64 + 4) = (f32x4){v[4], v[5], v[6], v[7]}; }) }
            }
        }
    }
#undef EPI_ROWS
#undef EPI_PACK
};
struct EpiUKV {
    static constexpr bool PERM = true, AFTER_DRAIN = false;
    bf16_t* kvm; const float* sskv;
    __device__ __forceinline__ void operator()(const f32x4 (&acc)[2][2][4][2], const Unit& u, int wr, int wc, int fr, int fq) const {
        asm volatile("" : "+v"(fq), "+v"(fr));
        const int col0 = u.pn * BM + wc * 32 + 8 * fq;
        float rs8[8];
#pragma unroll
        for (int i = 0; i < 8; ++i) rs8[i] = sskv[u.pm * BM + (i >> 2) * HALF + wr * 64 + (i & 3) * 16 + fr];
#pragma unroll
        for (int i = 0; i < 8; ++i) rs8[i] = rsqrtf(rs8[i] * (1.f / 128.f) + EPS);
#pragma unroll
        for (int ai = 0; ai < 2; ++ai)
#pragma unroll
            for (int m = 0; m < 4; ++m) { const int row = u.pm * BM + ai * HALF + wr * 64 + m * 16 + fr; bf16_t* rowp = kvm + (size_t)row * 768 + col0;
                const float rs = rs8[ai * 4 + m];
#pragma unroll
                for (int bj = 0; bj < 2; ++bj) { const f32x4 a = acc[ai][bj][m][0] * rs, b = acc[ai][bj][m][1] * rs;
                    u32x4 w; w.x = cvt_pk_bf16(a[0], a[1]); w.y = cvt_pk_bf16(a[2], a[3]); w.z = cvt_pk_bf16(b[0], b[1]); w.w = cvt_pk_bf16(b[2], b[3]);
                    *(u32x4*)(rowp + bj * HALF) = w; } }
    }
};
struct EpiPlain {
    static constexpr bool PERM = true, AFTER_DRAIN = false;
    bf16_t* out; int ld;
    __device__ __forceinline__ void operator()(const f32x4 (&acc)[2][2][4][2], const Unit& u, int wr, int wc, int fr, int fq) const {
        asm volatile("" : "+v"(fq), "+v"(fr));
        const int col0 = u.pn * BM + wc * 32 + 8 * fq;
#pragma unroll
        for (int ai = 0; ai < 2; ++ai)
#pragma unroll
            for (int m = 0; m < 4; ++m) { bf16_t* rowp = out + (size_t)(u.pm * BM + ai * HALF + wr * 64 + m * 16 + fr) * ld + col0;
#pragma unroll
                for (int bj = 0; bj < 2; ++bj) { const f32x4 a = acc[ai][bj][m][0], b = acc[ai][bj][m][1];
                    u32x4 w; w.x = cvt_pk_bf16(a[0], a[1]); w.y = cvt_pk_bf16(a[2], a[3]); w.z = cvt_pk_bf16(b[0], b[1]); w.w = cvt_pk_bf16(b[2], b[3]);
                    *(u32x4*)(rowp + bj * HALF) = w; } }
    }
};
struct EpiRes {
    static constexpr bool PERM = true, AFTER_DRAIN = false;
    const float* xin_f; const bf16_t* xin_b; bf16_t* xout; const float* gate;
    __device__ __forceinline__ void operator()(const f32x4 (&acc)[2][2][4][2], const Unit& u, int wr, int wc, int fr, int fq) const {
        asm volatile("" : "+v"(fq), "+v"(fr));
        const int b = (u.pm * BM) / S_; const int col0 = u.pn * BM + wc * 32 + 8 * fq;
        f32x4 gv[2][2];
#pragma unroll
        for (int bj = 0; bj < 2; ++bj)
#pragma unroll
            for (int n = 0; n < 2; ++n) gv[bj][n] = *(const f32x4*)(gate + (size_t)b * 6144 + col0 + bj * HALF + n * 4);
        if (xin_f != nullptr) {
#pragma unroll
            for (int ai = 0; ai < 2; ++ai)
#pragma unroll
                for (int m = 0; m < 4; ++m) { const size_t off = (size_t)(u.pm * BM + ai * HALF + wr * 64 + m * 16 + fr) * D_ + col0;
#pragma unroll
                    for (int bj = 0; bj < 2; ++bj) { const f32x4 x0 = *(const f32x4*)(xin_f + off + bj * HALF), x1 = *(const f32x4*)(xin_f + off + bj * HALF + 4);
                        const f32x4 r0 = x0 + gv[bj][0] * acc[ai][bj][m][0], r1 = x1 + gv[bj][1] * acc[ai][bj][m][1];
                        u32x4 w; w.x = cvt_pk_bf16(r0[0], r0[1]); w.y = cvt_pk_bf16(r0[2], r0[3]); w.z = cvt_pk_bf16(r1[0], r1[1]); w.w = cvt_pk_bf16(r1[2], r1[3]);
                        *(u32x4*)(xout + off + bj * HALF) = w; } }
        } else {
#pragma unroll
            for (int ai = 0; ai < 2; ++ai)
#pragma unroll
                for (int m = 0; m < 4; ++m) { const size_t off = (size_t)(u.pm * BM + ai * HALF + wr * 64 + m * 16 + fr) * D_ + col0;
                    u32x4 xr[2];
#pragma unroll
                    for (int bj = 0; bj < 2; ++bj) xr[bj] = *(const u32x4*)(xin_b + off + bj * HALF);
#pragma unroll
                    for (int bj = 0; bj < 2; ++bj) { const u32x4 q = xr[bj]; const f32x4 a0 = acc[ai][bj][m][0], a1 = acc[ai][bj][m][1], g0 = gv[bj][0], g1 = gv[bj][1];
                        const float r0 = __uint_as_float(q.x << 16) + g0[0] * a0[0], r1 = __uint_as_float(q.x & 0xffff0000u) + g0[1] * a0[1];
                        const float r2 = __uint_as_float(q.y << 16) + g0[2] * a0[2], r3 = __uint_as_float(q.y & 0xffff0000u) + g0[3] * a0[3];
                        const float r4 = __uint_as_float(q.z << 16) + g1[0] * a1[0], r5 = __uint_as_float(q.z & 0xffff0000u) + g1[1] * a1[1];
                        const float r6 = __uint_as_float(q.w << 16) + g1[2] * a1[2], r7 = __uint_as_float(q.w & 0xffff0000u) + g1[3] * a1[3];
                        u32x4 w; w.x = cvt_pk_bf16(r0, r1); w.y = cvt_pk_bf16(r2, r3); w.z = cvt_pk_bf16(r4, r5); w.w = cvt_pk_bf16(r6, r7);
                        *(u32x4*)(xout + off + bj * HALF) = w; } }
        }
    }
};
struct EpiGU {
    static constexpr bool PERM = true, AFTER_DRAIN = false;
    bf16_t* act;
    __device__ __forceinline__ void operator()(const f32x4 (&acc)[2][2][4][2], const Unit& u, int wr, int wc, int fr, int fq) const {
        asm volatile("" : "+v"(fq), "+v"(fr));
        const int col0 = u.pn * HALF + wc * 32 + 8 * fq;
#pragma unroll
        for (int ai = 0; ai < 2; ++ai)
#pragma unroll
            for (int m = 0; m < 4; ++m) { const int row = u.pm * BM + ai * HALF + wr * 64 + m * 16 + fr; float o[8];
#pragma unroll
                for (int n = 0; n < 2; ++n)
#pragma unroll
                    for (int i = 0; i < 4; ++i) { const float g = acc[ai][0][m][n][i], up = acc[ai][1][m][n][i]; o[4 * n + i] = g * __builtin_amdgcn_rcpf(1.f + __expf(-g)) * up; }
                u32x4 w; w.x = cvt_pk_bf16(o[0], o[1]); w.y = cvt_pk_bf16(o[2], o[3]); w.z = cvt_pk_bf16(o[4], o[5]); w.w = cvt_pk_bf16(o[6], o[7]);
                *(u32x4*)(act + (size_t)row * FF + col0) = w; }
    }
};
template <class Epi, class Sched, bool ALIGN_EPI = false, bool SP2 = false>
__device__ __forceinline__ void gemm_phase(PG8_LAS unsigned char* lds, const Gemm g, const Sched& S, const Epi& E, int wid_in) {
    const int wid = __builtin_amdgcn_readfirstlane(wid_in), lane = fresh_lane(), tid = wid * 64 + lane, wr = wid >> 2, wc = wid & 3;
    const int K = g.K, nt = K / BK;
    unsigned voffA[2], voffB[2];
#pragma unroll
    for (int i = 0; i < 2; ++i) { int R, C; stage_rc(tid * 16 + i * 8192, R, C); const int Rb = Epi::PERM ? ((R & ~31) + perm32(R & 31)) : R;
        voffA[i] = (unsigned)(R * K + C) * 2u; voffB[i] = (unsigned)(Rb * K + C) * 2u; }
    const size_t kstep = (size_t)(BK * 2);
    const size_t hstep = (size_t)HALF * K * 2;
    const size_t tstep = 2 * hstep;
    const unsigned ldsw = (unsigned)wid * 1024u;
    const int aoff = lds_byte(wr * 64 + (lane & 15), (lane >> 4) * 8), boff = lds_byte(wc * 32 + (lane & 15), (lane >> 4) * 8);
#define PG8_SA(b, h) (((b) * 2 + (h)) * HTB)
#define PG8_SB(b, h) ((4 + (b) * 2 + (h)) * HTB)
#define PG8_STAGE(bufoff, gbase, voff) do { _Pragma("unroll") for (int _i = 0; _i < 2; ++_i) \
        __builtin_amdgcn_global_load_lds((const unsigned*)((const char*)(gbase) + (voff)[_i]), (PG8_LAS unsigned*)(lds + (bufoff) + ldsw + _i * 8192), 16, 0, 0); } while (0)
#define PG8_LDA(dst, b, h) do { _Pragma("unroll") for (int m = 0; m < 4; ++m) _Pragma("unroll") for (int k = 0; k < 2; ++k) dst[m][k] = *(const PG8_LAS bf16x8*)(lds + PG8_SA(b, h) + aoff + m * 2048 + k * 1024); } while (0)
#define PG8_LDB(dst, b, h) do { _Pragma("unroll") for (int n = 0; n < 2; ++n) _Pragma("unroll") for (int k = 0; k < 2; ++k) dst[n][k] = *(const PG8_LAS bf16x8*)(lds + PG8_SB(b, h) + boff + n * 2048 + k * 1024); } while (0)
#define PG8_MMA(ai, bj, At, Bt) do { __builtin_amdgcn_s_setprio(1); _Pragma("unroll") for (int m = 0; m < 4; ++m) _Pragma("unroll") for (int n = 0; n < 2; ++n) _Pragma("unroll") for (int k = 0; k < 2; ++k) \
        acc[ai][bj][m][n] = __builtin_amdgcn_mfma_f32_16x16x32_bf16(Bt[n][k], At[m][k], acc[ai][bj][m][n], 0, 0, 0); __builtin_amdgcn_s_setprio(0); } while (0)
#define PG8_WAIT_V(n) asm volatile("s_waitcnt vmcnt(" #n ")" ::: "memory")
#define PG8_WAIT_L(n) asm volatile("s_waitcnt lgkmcnt(" #n ")" ::: "memory")
#define PG8_BAR __builtin_amdgcn_s_barrier()
#define PG8_SCHED __builtin_amdgcn_sched_barrier(0)
    Unit cur, nxt; int ui = 0;
    if (!S.next(0, cur)) return;
    f32x4 acc[2][2][4][2];
#pragma unroll
    for (int a = 0; a < 2; ++a)
#pragma unroll
        for (int b = 0; b < 2; ++b)
#pragma unroll
            for (int m = 0; m < 4; ++m)
#pragma unroll
                for (int n = 0; n < 2; ++n) acc[a][b][m][n] = (f32x4){0.f, 0.f, 0.f, 0.f};
    bf16x8 At[4][2], B0[2][2], B1[2][2];
    const char* cA = (const char*)g.A + (size_t)cur.pm * tstep; const char* cB = (const char*)g.Bt + (size_t)cur.pn * tstep;
    S.a_ready(cur);
    if constexpr (SP2) {
        PG8_STAGE(PG8_SB(0, 0), cB, voffB); PG8_STAGE(PG8_SB(0, 1), cB + hstep, voffB); PG8_STAGE(PG8_SA(0, 0), cA, voffA); PG8_STAGE(PG8_SA(0, 1), cA + hstep, voffA);
        if (wr == 1) PG8_BAR;
        PG8_WAIT_V(2); PG8_BAR;
        PG8_STAGE(PG8_SB(1, 0), cB + kstep, voffB); PG8_STAGE(PG8_SA(1, 0), cA + kstep, voffA); PG8_STAGE(PG8_SB(1, 1), cB + hstep + kstep, voffB);
        PG8_WAIT_V(6); PG8_BAR;
    } else {
        PG8_STAGE(PG8_SB(0, 0), cB, voffB); PG8_STAGE(PG8_SA(0, 0), cA, voffA); PG8_STAGE(PG8_SB(0, 1), cB + hstep, voffB); PG8_STAGE(PG8_SA(0, 1), cA + hstep, voffA);
        if (wr == 1) PG8_BAR;
        PG8_WAIT_V(4); PG8_BAR;
        PG8_STAGE(PG8_SB(1, 0), cB + kstep, voffB); PG8_STAGE(PG8_SA(1, 0), cA + kstep, voffA); PG8_STAGE(PG8_SB(1, 1), cB + hstep + kstep, voffB);
        PG8_WAIT_V(6); PG8_BAR;
    }
    for (;;) {
        const bool has_next = S.next(ui + 1, nxt);
        const char* nA = has_next ? (const char*)g.A + (size_t)nxt.pm * tstep : cA; const char* nB = has_next ? (const char*)g.Bt + (size_t)nxt.pn * tstep : cB;
        for (int t = 0; t < nt; t += 2) {
            const bool last = (t == nt - 2);
            const char* a1 = cA + (size_t)(t + 1) * kstep;
            const char* a2 = last ? nA : cA + (size_t)(t + 2) * kstep; const char* b2 = last ? nB : cB + (size_t)(t + 2) * kstep;
            const char* a3 = a2 + kstep; const char* b3 = b2 + kstep;
            if (last && has_next) S.a_ready(nxt);
            if constexpr (SP2) {
            PG8_LDB(B0, 0, 0); PG8_LDB(B1, 0, 1); PG8_SCHED; PG8_LDA(At, 0, 0); PG8_STAGE(PG8_SA(1, 1), a1 + hstep, voffA);
            PG8_WAIT_V(8); PG8_WAIT_L(0); PG8_BAR; PG8_MMA(0, 0, At, B0); PG8_MMA(0, 1, At, B1); PG8_BAR; PG8_SCHED;
            PG8_LDA(At, 0, 1); PG8_STAGE(PG8_SB(0, 0), b2, voffB); PG8_STAGE(PG8_SB(0, 1), b2 + hstep, voffB); PG8_STAGE(PG8_SA(0, 0), a2, voffA);
            PG8_WAIT_V(8); PG8_WAIT_L(0); PG8_BAR; PG8_MMA(1, 0, At, B0); PG8_MMA(1, 1, At, B1); PG8_BAR; PG8_SCHED;
            PG8_LDB(B0, 1, 0); PG8_LDB(B1, 1, 1); PG8_SCHED; PG8_LDA(At, 1, 0); PG8_STAGE(PG8_SA(0, 1), a2 + hstep, voffA);
            PG8_WAIT_V(8); PG8_WAIT_L(0); PG8_BAR; PG8_MMA(0, 0, At, B0); PG8_MMA(0, 1, At, B1); PG8_BAR; PG8_SCHED;
            PG8_LDA(At, 1, 1); PG8_STAGE(PG8_SB(1, 0), b3, voffB); PG8_STAGE(PG8_SB(1, 1), b3 + hstep, voffB); PG8_STAGE(PG8_SA(1, 0), a3, voffA);
            PG8_WAIT_V(8); PG8_WAIT_L(0); PG8_BAR; PG8_MMA(1, 0, At, B0); PG8_MMA(1, 1, At, B1); PG8_BAR; PG8_SCHED;
            } else {
            PG8_LDB(B0, 0, 0); PG8_SCHED; PG8_LDA(At, 0, 0); PG8_STAGE(PG8_SA(1, 1), a1 + hstep, voffA);
            PG8_WAIT_L(8); PG8_BAR; PG8_WAIT_L(0); PG8_MMA(0, 0, At, B0); PG8_BAR; PG8_SCHED;
            PG8_LDB(B1, 0, 1); PG8_STAGE(PG8_SB(0, 0), b2, voffB);
            PG8_BAR; PG8_WAIT_L(0); PG8_MMA(0, 1, At, B1); PG8_BAR;
            PG8_LDA(At, 0, 1); PG8_STAGE(PG8_SA(0, 0), a2, voffA);
            PG8_BAR; PG8_WAIT_L(0); PG8_MMA(1, 0, At, B0); PG8_BAR; PG8_SCHED;
            PG8_STAGE(PG8_SB(0, 1), b2 + hstep, voffB);
            PG8_WAIT_V(6); PG8_BAR; PG8_MMA(1, 1, At, B1); PG8_BAR;
            PG8_LDB(B0, 1, 0); PG8_SCHED; PG8_LDA(At, 1, 0); PG8_STAGE(PG8_SA(0, 1), a2 + hstep, voffA);
            PG8_WAIT_L(8); PG8_BAR; PG8_WAIT_L(0); PG8_MMA(0, 0, At, B0); PG8_BAR; PG8_SCHED;
            PG8_LDB(B1, 1, 1); PG8_STAGE(PG8_SB(1, 0), b3, voffB);
            PG8_BAR; PG8_WAIT_L(0); PG8_MMA(0, 1, At, B1); PG8_BAR;
            PG8_LDA(At, 1, 1); PG8_STAGE(PG8_SA(1, 0), a3, voffA);
            PG8_BAR; PG8_WAIT_L(0); PG8_MMA(1, 0, At, B0); PG8_BAR; PG8_SCHED;
            PG8_STAGE(PG8_SB(1, 1), b3 + hstep, voffB);
            PG8_WAIT_V(6); PG8_BAR; PG8_MMA(1, 1, At, B1); PG8_BAR;
            }
        }
        if constexpr (ALIGN_EPI) { if (wr == 0) PG8_BAR; }
        if constexpr (!Epi::AFTER_DRAIN) { const int ln = fresh_lane(); E(acc, cur, wr, wc, ln & 15, ln >> 4); S.done(cur); }
        if (!has_next) break;
#pragma unroll
        for (int a = 0; a < 2; ++a)
#pragma unroll
            for (int b = 0; b < 2; ++b)
#pragma unroll
                for (int m = 0; m < 4; ++m)
#pragma unroll
                    for (int n = 0; n < 2; ++n) acc[a][b][m][n] = (f32x4){0.f, 0.f, 0.f, 0.f};
        cur = nxt; cA = nA; cB = nB; ++ui;
        if constexpr (ALIGN_EPI) { if (wr == 1) PG8_BAR; }
    }
    PG8_WAIT_V(0);
    if constexpr (!ALIGN_EPI) { if (wr == 0) PG8_BAR; }
    PG8_BAR;
    if constexpr (Epi::AFTER_DRAIN) { const int ln = fresh_lane(); E.fused(acc, cur, wr, wc, ln & 15, ln >> 4, lds, wid, ln); S.done(cur); }
#undef PG8_SA
#undef PG8_SB
#undef PG8_STAGE
#undef PG8_LDA
#undef PG8_LDB
#undef PG8_MMA
#undef PG8_WAIT_V
#undef PG8_WAIT_L
#undef PG8_BAR
#undef PG8_SCHED
}
}

#define GAS __attribute__((address_space(1)))
#define LAS __attribute__((address_space(3)))
typedef float f32x4 __attribute__((ext_vector_type(4)));
typedef unsigned v4u __attribute__((ext_vector_type(4)));
typedef GAS unsigned gu32;
#define XB_TMO      128
#define XB_XCNT(j)  (256  + 64 * (j))
#define XB_XSUB(j)  (1280 + 64 * (j))
#define XB_XGEN(j)  (2304 + 64 * (j))
#define XB_TOP      3328
#define XB_TOPGEN   3392
#define XCD_BAR_WORDS 3456
#define XB_SPIN_CAP (1u << 18)

__device__ __forceinline__ unsigned xb_ld(unsigned* p)              { return __hip_atomic_load(p, __ATOMIC_RELAXED, __HIP_MEMORY_SCOPE_AGENT); }
__device__ __forceinline__ unsigned xb_add(unsigned* p, unsigned v) { return __hip_atomic_fetch_add(p, v, __ATOMIC_RELAXED, __HIP_MEMORY_SCOPE_AGENT); }
__device__ __forceinline__ unsigned xb_xcc_id() { return (unsigned)__builtin_amdgcn_s_getreg((3 << 11) | 20) & 0xFu; }
#define XB_SPIN(cond, bar) do { unsigned _sp = 0; while (cond) { __builtin_amdgcn_s_sleep(1); \
    if ((++_sp & 255u) == 0u) { if (xb_ld(&(bar)[XB_TMO])) break; if (_sp > XB_SPIN_CAP) { atomicAdd(&(bar)[XB_TMO], 1u); break; } } } } while (0)

struct XcdBarrier {
    unsigned* bar; unsigned x;
    volatile LAS unsigned* st;
};

__device__ __forceinline__ XcdBarrier xcd_barrier_post(unsigned* bar, volatile LAS unsigned* st, int tid) {
    XcdBarrier b; b.bar = bar; b.x = xb_xcc_id(); b.st = st;
    if (tid == 0) (void)xb_add(&bar[XB_XCNT(b.x)], 1u);
    return b;
}
__device__ __forceinline__ void xcd_barrier_complete(unsigned* bar, unsigned x, unsigned& nloc, unsigned& nx) {
    const unsigned G = gridDim.x * gridDim.y * gridDim.z;
    unsigned sum, cnt, mine, sp = 0u;
    for (;;) {
        sum = 0u; cnt = 0u; mine = 0u;
#pragma unroll
        for (unsigned j = 0; j < 16; ++j) { const unsigned c = xb_ld(&bar[XB_XCNT(j)]); sum += c; cnt += (c > 0u) ? 1u : 0u; mine = (j == x) ? c : mine; }
        if (sum == G) break;
        __builtin_amdgcn_s_sleep(1);
        if ((++sp & 255u) == 0u) { if (xb_ld(&bar[XB_TMO])) break; if (sp > XB_SPIN_CAP) { atomicAdd(&bar[XB_TMO], 1u); break; } }
    }
    nloc = mine > 0u ? mine : 1u; nx = cnt > 0u ? cnt : 1u;
}

__device__ __forceinline__ void xcd_barrier(const XcdBarrier& b, int tid) {
    asm volatile("s_waitcnt vmcnt(0)" ::: "memory");
    __syncthreads();
    if (tid == 0) {
        unsigned* bar = b.bar;
        __builtin_amdgcn_s_waitcnt(0);
        unsigned nloc = b.st[0], nx = b.st[1];
        if (nloc == 0u) { xcd_barrier_complete(bar, b.x, nloc, nx); b.st[0] = nloc; b.st[1] = nx; }
        const unsigned old = xb_add(&bar[XB_XSUB(b.x)], 1u);
        const unsigned gen = old / nloc;
        if (old + 1u == (gen + 1u) * nloc) {
            __builtin_amdgcn_fence(__ATOMIC_RELEASE, "agent");
            asm volatile("s_waitcnt vmcnt(0)" ::: "memory");
            const unsigned og = xb_add(&bar[XB_TOP], 1u);
            const unsigned tg = og / nx;
            if (og + 1u == (tg + 1u) * nx) xb_add(&bar[XB_TOPGEN], 1u);
            else XB_SPIN(xb_ld(&bar[XB_TOPGEN]) == tg, bar);
            __builtin_amdgcn_fence(__ATOMIC_ACQUIRE, "agent");
            xb_add(&bar[XB_XGEN(b.x)], 1u);
            asm volatile("s_waitcnt vmcnt(0)" ::: "memory");
        } else {
            XB_SPIN(xb_ld(&bar[XB_XGEN(b.x)]) == gen, bar);
            __builtin_amdgcn_fence(__ATOMIC_ACQUIRE, "agent");
            asm volatile("s_waitcnt vmcnt(0)" ::: "memory");
        }
    }
    __syncthreads();
}

constexpr int NTHR = 512, NWAVES = 8;
constexpr int RING_BYTES = 131072, MISC_OFF = RING_BYTES + 320, LDS_BYTES = 147456;
constexpr int CW_BAR = 4096;
constexpr size_t CTL_ZERO_BYTES = 64 * 1024;
constexpr size_t WT_IN = WS_WT, WT_OUT = WT_IN + (size_t)2560 * 1024 * 2, WT_GU = WT_OUT + (size_t)1024 * 1024 * 2, WT_DOWN = WT_GU + (size_t)5632 * 1024 * 2,
                 WT_UQ = WT_DOWN + (size_t)1024 * 2816 * 2, WT_UKV = WT_UQ + (size_t)768 * 256 * 2, WT_CK = WT_UKV + (size_t)768 * 128 * 2, WT_CV = WT_CK + (size_t)64 * 2048 * 2,
                 WT_QM = WT_CV + (size_t)64 * 2048 * 2, WT_KM = WT_QM + 4 * 64 * 64 * 2, WT_END = WT_KM + 4 * 64 * 64 * 2;
static_assert(WT_END <= WS_HB, "weights");
constexpr int NPH = 22, PPL = 10;
constexpr int PROBE_SEL = 0;
constexpr int REP_MASK = 0;
#ifndef PHM
#define PHM 0xffff
#endif
struct MP { const float* in[N_IN]; float* out; unsigned char* ws; int ph_lo, ph_hi, coop, pad; };

struct MPK {
    const __attribute__((address_space(4))) MP* k;
    struct InArr { const __attribute__((address_space(4))) MP* k; __device__ __forceinline__ const float* operator[](int i) const { return k->in[i]; } };
    __device__ __forceinline__ InArr in_() const { return InArr{k}; }
};
#define PIN(i) (p.k->in[i])
__device__ __forceinline__ unsigned pk2(float lo, float hi) { return (unsigned)f2bf(lo) | ((unsigned)f2bf(hi) << 16); }
struct MapId { int n; __device__ __forceinline__ int operator()(int c) const { return c < n ? c : -1; } };
struct MapIn { __device__ __forceinline__ int operator()(int c) const {
    if (c < 1152) return c; if (c < 1280) return 1426 + (c - 1152); if (c < 1536) return 1170 + (c - 1280); if (c < 2304) return 1586 + (c - 1536);
    if (c < 2336) return 1554 + (c - 2304); if (c < 2354) return 1152 + (c - 2336); if (c < 2362) return c; return -1; } };
struct MapGU { __device__ __forceinline__ int operator()(int c) const { const int t = c >> 8, w = c & 255; return (w < 128) ? t * 128 + w : FF + t * 128 + (w - 128); } };
template <class Map> __device__ __forceinline__ void transpose_item(const float* W, int K, int ldw, const Map& map, const float* kscale, bf16* WT, LAS float* scr, int item, int nblk, int lane) {
    const int kb = item / nblk, nb = item % nblk, k0 = 64 * kb, n0 = 32 * nb;
    const int np = 2 * (lane & 15);
    const int sc = map(n0 + np);
    float2 tv[16];
#pragma unroll
    for (int i = 0; i < 16; ++i) { const int kk = 4 * i + (lane >> 4); tv[i] = (sc >= 0) ? *(const float2*)(W + (size_t)(k0 + kk) * ldw + sc) : make_float2(0.f, 0.f); }
    asm volatile("" : "+v"(tv[0]), "+v"(tv[1]), "+v"(tv[2]), "+v"(tv[3]), "+v"(tv[4]), "+v"(tv[5]), "+v"(tv[6]), "+v"(tv[7]));
    asm volatile("" : "+v"(tv[8]), "+v"(tv[9]), "+v"(tv[10]), "+v"(tv[11]), "+v"(tv[12]), "+v"(tv[13]), "+v"(tv[14]), "+v"(tv[15]));
#pragma unroll
    for (int i = 0; i < 16; ++i) { const int kk = 4 * i + (lane >> 4); float2 v = tv[i];
        if (kscale) { const float ksc = kscale[k0 + kk]; v.x *= ksc; v.y *= ksc; } scr[kk * 33 + np] = v.x; scr[kk * 33 + np + 1] = v.y; }
    asm volatile("s_waitcnt lgkmcnt(0)" ::: "memory");
    const int c = lane & 7;
#pragma unroll
    for (int j = 0; j < 4; ++j) { const int n = (lane >> 3) + 8 * j; const LAS float* s = scr + (8 * c) * 33 + n;
        v4u o; o.x = pk2(s[0 * 33], s[1 * 33]); o.y = pk2(s[2 * 33], s[3 * 33]); o.z = pk2(s[4 * 33], s[5 * 33]); o.w = pk2(s[6 * 33], s[7 * 33]);
        *(v4u*)(WT + (size_t)(n0 + n) * K + k0 + 8 * c) = o; }
    asm volatile("s_waitcnt lgkmcnt(0)" ::: "memory");
}
typedef unsigned u2raw __attribute__((ext_vector_type(2)));
__device__ __forceinline__ float4 unpk4(uint2 q) { return make_float4(__uint_as_float(q.x << 16), __uint_as_float(q.x & 0xffff0000u), __uint_as_float(q.y << 16), __uint_as_float(q.y & 0xffff0000u)); }
template <bool XBF, bool FIN = false> __device__ __forceinline__ void norm_rows(const void* xv, const float* g, const float* shift, const float* scale, bf16* hb, float* outf, int gw, int ngw, int lane) {
    const int rpw = T_ / ngw, m0 = gw * rpw, b = m0 / S_;
    float4 gs[4], sh[4];
#pragma unroll
    for (int j = 0; j < 4; ++j) { const int col = 4 * lane + 256 * j; gs[j] = *(const float4*)(g + col);
        if constexpr (!FIN) { const float4 sc = *(const float4*)(scale + (size_t)b * 6144 + col); sh[j] = *(const float4*)(shift + (size_t)b * 6144 + col);
            gs[j].x *= 1.f + sc.x; gs[j].y *= 1.f + sc.y; gs[j].z *= 1.f + sc.z; gs[j].w *= 1.f + sc.w; }
        else sh[j] = make_float4(0.f, 0.f, 0.f, 0.f); }
    typedef typename std::conditional<XBF, uint2, float4>::type raw_t;
    const raw_t* x = (const raw_t*)xv;
    raw_t nv[4], nw[4];
    { const raw_t* xr = x + (size_t)m0 * (D_ / 4) + lane;
#pragma unroll
      for (int j = 0; j < 4; ++j) { nv[j] = xr[64 * j]; nw[j] = xr[D_ / 4 + 64 * j]; } }
    for (int r = 0; r < rpw; r += 2) {
        const int m = m0 + r;
        float4 v[4], w[4]; float s = 0.f, s2 = 0.f;
#pragma unroll
        for (int j = 0; j < 4; ++j) { if constexpr (XBF) { v[j] = unpk4(nv[j]); w[j] = unpk4(nw[j]); } else { v[j] = nv[j]; w[j] = nw[j]; } }
        if (r + 2 < rpw) { const raw_t* xr = x + (size_t)(m + 2) * (D_ / 4) + lane;
#pragma unroll
            for (int j = 0; j < 4; ++j) { nv[j] = xr[64 * j]; nw[j] = xr[D_ / 4 + 64 * j]; } }
#pragma unroll
        for (int j = 0; j < 4; ++j) { s += v[j].x * v[j].x + v[j].y * v[j].y + v[j].z * v[j].z + v[j].w * v[j].w; s2 += w[j].x * w[j].x + w[j].y * w[j].y + w[j].z * w[j].z + w[j].w * w[j].w; }
        const float r1 = rsqrtf(wave_sum2(s) * (1.f / D_) + EPS), r2 = rsqrtf(wave_sum2(s2) * (1.f / D_) + EPS);
#pragma unroll
        for (int j = 0; j < 4; ++j) {
            const int col = 4 * lane + 256 * j;
            float4 o, o2;
            o.x = v[j].x * r1 * gs[j].x + sh[j].x; o.y = v[j].y * r1 * gs[j].y + sh[j].y; o.z = v[j].z * r1 * gs[j].z + sh[j].z; o.w = v[j].w * r1 * gs[j].w + sh[j].w;
            o2.x = w[j].x * r2 * gs[j].x + sh[j].x; o2.y = w[j].y * r2 * gs[j].y + sh[j].y; o2.z = w[j].z * r2 * gs[j].z + sh[j].z; o2.w = w[j].w * r2 * gs[j].w + sh[j].w;
            if constexpr (FIN) { *(float4*)(outf + (size_t)m * D_ + col) = o; *(float4*)(outf + (size_t)(m + 1) * D_ + col) = o2; }
            else { uint2 q; q.x = pk2(o.x, o.y); q.y = pk2(o.z, o.w); *(uint2*)(hb + (size_t)m * D_ + col) = q;
                   uint2 q2; q2.x = pk2(o2.x, o2.y); q2.y = pk2(o2.z, o2.w); *(uint2*)(hb + (size_t)(m + 1) * D_ + col) = q2; }
        }
    }
}
__device__ __forceinline__ void ph_p0(const MPK& p, LAS unsigned char* lds, int tid) {
    const int wave = tid >> 6, lane = tid & 63;
    LAS float* ca = (LAS float*)lds; LAS float* red = ca + 8192;
    unsigned char* ws = p.k->ws; float* mod = (float*)(ws + WS_MOD);
    const float* c = PIN(I_C);
    for (int i = tid; i < 8192; i += NTHR) ca[i] = siluf_(c[i]);
    __syncthreads();
    for (int item = blockIdx.x; item < 192; item += gridDim.x) {
        const int l = item / 96, j = (item % 96) * 64 + lane;
        const float* w = PIN(I_WADA) + (size_t)l * 1024 * 6144 + j + (size_t)(wave * 128) * 6144;
        float acc[8];
#pragma unroll
        for (int b = 0; b < 8; ++b) acc[b] = 0.f;
        float wn[16];
#pragma unroll
        for (int i = 0; i < 16; ++i) wn[i] = w[(size_t)i * 6144];
        for (int k0 = 0; k0 < 128; k0 += 16) {
            float wv[16];
            asm volatile("" : "+v"(wn[0]), "+v"(wn[1]), "+v"(wn[2]), "+v"(wn[3]), "+v"(wn[4]), "+v"(wn[5]), "+v"(wn[6]), "+v"(wn[7]),
                              "+v"(wn[8]), "+v"(wn[9]), "+v"(wn[10]), "+v"(wn[11]), "+v"(wn[12]), "+v"(wn[13]), "+v"(wn[14]), "+v"(wn[15]));
#pragma unroll
            for (int i = 0; i < 16; ++i) wv[i] = wn[i];
            if (k0 + 16 < 128) {
#pragma unroll
                for (int i = 0; i < 16; ++i) wn[i] = w[(size_t)(k0 + 16 + i) * 6144];
            }
#pragma unroll
            for (int i4 = 0; i4 < 4; ++i4)
#pragma unroll
                for (int b = 0; b < 8; ++b) { const f32x4 c4 = *(LAS const f32x4*)(ca + b * 1024 + wave * 128 + k0 + 4 * i4);
                    acc[b] += (c4[0] * wv[4 * i4] + c4[1] * wv[4 * i4 + 1]) + (c4[2] * wv[4 * i4 + 2] + c4[3] * wv[4 * i4 + 3]); }
        }
#pragma unroll
        for (int b = 0; b < 8; ++b) red[(wave * 8 + b) * 64 + lane] = acc[b];
        __syncthreads();
        { const int b = wave; float s2 = 0.f;
#pragma unroll
          for (int w8 = 0; w8 < 8; ++w8) s2 += red[(w8 * 8 + b) * 64 + lane];
          mod[((size_t)l * 8 + b) * 6144 + (item % 96) * 64 + lane] = s2 + PIN(I_BADA)[l * 6144 + (item % 96) * 64 + lane]; }
        __syncthreads();
    }
    const int* pos = (const int*)PIN(I_POS);
    float *cosP = (float*)(ws + WS_COSP), *sinP = (float*)(ws + WS_SINP), *cosM = (float*)(ws + WS_COSM), *sinM = (float*)(ws + WS_SINM);
    LAS float* invf = red;
    if (tid < 24) { const int f = tid; invf[f] = (float)((f < 8) ? pow(500000.0, -(double)(2 * f) / 16.0) : pow(500000.0, -(double)(2 * (f - 8)) / 32.0)); }
    __syncthreads();
    for (int i = blockIdx.x * NTHR + tid; i < T_ * 24; i += gridDim.x * NTHR) {
        const int m = i / 24, f = i % 24;
        const float ang = (float)pos[m] * invf[f];
        const double t = (double)ang * 0.15915494309189535, fr = t - rint(t);
        const float cs = __builtin_amdgcn_cosf((float)fr), sn = __builtin_amdgcn_sinf((float)fr);
        if (f < 8) { cosP[m * 8 + f] = cs; sinP[m * 8 + f] = sn; } else { cosM[m * 16 + f - 8] = cs; sinM[m * 16 + f - 8] = sn; }
    }
}
__device__ __forceinline__ void early_transposes(const MPK& p, int l, LAS unsigned char* lds, int tid, int first) {
    const int wave = tid >> 6, lane = tid & 63;
    if ((int)blockIdx.x < first) return;
    const int gw = ((int)blockIdx.x - first) * NWAVES + wave, ngw = ((int)gridDim.x - first) * NWAVES;
    unsigned char* ws = p.k->ws;
    LAS float* scr = (LAS float*)(lds + wave * 8704);
    constexpr int I0 = 16 * 80, I4 = 4 * 24, I5 = 2 * 24, I6 = 32 * 2, I7 = 32 * 2, I8 = 8, I9 = 8;
    constexpr int NIT = I0 + I4 + I5 + I6 + I7 + I8 + I9;
    for (int it = gw; it < NIT; it += ngw) {
        int r = it;
        if (r < I0) { transpose_item(PIN(I_WIN) + (size_t)l * D_ * DIN, D_, DIN, MapIn{}, nullptr, (bf16*)(ws + WT_IN), scr, r, 80, lane); continue; } r -= I0;
        if (r < I4) { transpose_item(PIN(I_WUQ) + (size_t)l * 256 * 576, 256, 576, MapId{576}, PIN(I_GQL) + l * 256, (bf16*)(ws + WT_UQ), scr, r, 24, lane); continue; } r -= I4;
        if (r < I5) { transpose_item(PIN(I_WUKV) + (size_t)l * 128 * 768, 128, 768, MapId{768}, PIN(I_GKVL) + l * 128, (bf16*)(ws + WT_UKV), scr, r, 24, lane); continue; } r -= I5;
        if (r < I6) { transpose_item(PIN(I_WCK) + (size_t)l * 2048 * 64, 2048, 64, MapId{64}, nullptr, (bf16*)(ws + WT_CK), scr, r, 2, lane); continue; } r -= I6;
        if (r < I7) { transpose_item(PIN(I_WCV) + (size_t)l * 2048 * 64, 2048, 64, MapId{64}, nullptr, (bf16*)(ws + WT_CV), scr, r, 2, lane); continue; } r -= I7;
        if (r < I8) { const int h = r >> 1; transpose_item(PIN(I_WQM) + (size_t)l * 16384 + h * 4096, 64, 64, MapId{64}, nullptr, (bf16*)(ws + WT_QM) + h * 4096, scr, r & 1, 2, lane); continue; } r -= I8;
        { const int h = r >> 1; transpose_item(PIN(I_WKM) + (size_t)l * 16384 + h * 4096, 64, 64, MapId{64}, nullptr, (bf16*)(ws + WT_KM) + h * 4096, scr, r & 1, 2, lane); }
    }
}
__device__ __forceinline__ void ph_prep(const MPK& p, int l, LAS unsigned char* lds, int tid) {
    const int wave = tid >> 6, lane = tid & 63;
    const int gw = blockIdx.x * NWAVES + wave, ngw = gridDim.x * NWAVES;
    unsigned char* ws = p.k->ws;
    LAS float* scr = (LAS float*)(lds + wave * 8704);
    for (int i = blockIdx.x * NTHR + tid; i < 2 * T_; i += gridDim.x * NTHR) ((float*)(ws + WS_SSQL))[i] = 0.f;
    if (l == 0) early_transposes(p, l, lds, tid, 0);
    const float* modl = (const float*)(ws + WS_MOD) + (size_t)l * 8 * 6144;
    if (l == 0) norm_rows<false>(PIN(I_X), PIN(I_GN1) + l * D_, modl + 0, modl + 1024, (bf16*)(ws + WS_HB), nullptr, gw, ngw, lane);
    else norm_rows<true>(p.k->out, PIN(I_GN1) + l * D_, modl + 0, modl + 1024, (bf16*)(ws + WS_HB), nullptr, gw, ngw, lane);
}
__device__ __forceinline__ void late_transposes(const MPK& p, int l, LAS unsigned char* lds, int tid, int first) {
    const int wave = tid >> 6, lane = tid & 63;
    if ((int)blockIdx.x < first) return;
    const int gw = ((int)blockIdx.x - first) * NWAVES + wave, ngw = ((int)gridDim.x - first) * NWAVES;
    unsigned char* ws = p.k->ws;
    LAS float* scr = (LAS float*)(lds + wave * 8704);
    constexpr int I1 = 16 * 32, I2 = 16 * 176, I3 = 44 * 32;
    for (int it = gw; it < I1 + I2 + I3; it += ngw) {
        int r = it;
        if (r < I1) { transpose_item(PIN(I_WOUT) + (size_t)l * D_ * D_, D_, D_, MapId{D_}, nullptr, (bf16*)(ws + WT_OUT), scr, r, 32, lane); continue; } r -= I1;
        if (r < I2) { transpose_item(PIN(I_WGU) + (size_t)l * D_ * 2 * FF, D_, 2 * FF, MapGU{}, nullptr, (bf16*)(ws + WT_GU), scr, r, 176, lane); continue; } r -= I2;
        transpose_item(PIN(I_WDOWN) + (size_t)l * FF * D_, FF, D_, MapId{D_}, nullptr, (bf16*)(ws + WT_DOWN), scr, r, 32, lane);
    }
}
__device__ __forceinline__ void ph_mixnorm(const MPK& p, int l, int tid) {
    const int gw = blockIdx.x * NWAVES + (tid >> 6), ngw = gridDim.x * NWAVES, lane = tid & 63;
    unsigned char* ws = p.k->ws;
    bf16* mix = (bf16*)(ws + WS_HB); const float* ga = PIN(I_GOA) + l * 384; const float* gb = PIN(I_GOB) + l * 384;
    const bf16 *oc = (const bf16*)(ws + WS_OCMP), *os = (const bf16*)(ws + WS_OSLC), *ow = (const bf16*)(ws + WS_OWIN); const float* gm = (const float*)(ws + WS_GM);
#define UNPK8(dst, src) dst[0] = __uint_as_float(src.x << 16); dst[1] = __uint_as_float(src.x & 0xffff0000u); dst[2] = __uint_as_float(src.y << 16); dst[3] = __uint_as_float(src.y & 0xffff0000u); \
    dst[4] = __uint_as_float(src.z << 16); dst[5] = __uint_as_float(src.z & 0xffff0000u); dst[6] = __uint_as_float(src.w << 16); dst[7] = __uint_as_float(src.w & 0xffff0000u);
    const int rpw = T_ / ngw;
    const float* ggp = (lane < 48) ? ga + lane * 8 : gb + (lane - 48) * 8; const float4 gA0 = *(const float4*)ggp, gA1 = *(const float4*)(ggp + 4);
    const float* ggq = gb + (16 + (lane & 31)) * 8; const float4 gB0 = *(const float4*)ggq, gB1 = *(const float4*)(ggq + 4);
    v4u ra4, rb4, rc4, ry4; float rg0, rg1, rg2;
#define MIX_LOAD(m_) do { const bf16* r_ = mix + (size_t)(m_) * D_; \
        if (lane < 48) { const size_t o_ = (size_t)(m_) * 384 + lane * 8; const float* g3_ = gm + (size_t)(m_) * 32 + 3 * (lane >> 3); rg0 = g3_[0]; rg1 = g3_[1]; rg2 = g3_[2]; \
            ra4 = *(const v4u*)(oc + o_); rb4 = *(const v4u*)(os + o_); rc4 = *(const v4u*)(ow + o_); } \
        else { ra4 = *(const v4u*)(r_ + 384 + (lane - 48) * 8); rb4 = ra4; rc4 = ra4; rg0 = 0.f; rg1 = 0.f; rg2 = 0.f; } \
        if (lane < 32) ry4 = *(const v4u*)(r_ + 384 + (16 + lane) * 8); else ry4 = ra4; } while (0)
    const int mend = gw * rpw + rpw;
    MIX_LOAD(gw * rpw);
    for (int m = gw * rpw; m < mend; ++m) {
        bf16* r = mix + (size_t)m * D_;
        const v4u ca4 = ra4, cb4 = rb4, cc4 = rc4, cy4 = ry4; const float g0 = rg0, g1 = rg1, g2 = rg2;
        if (m + 1 < mend) MIX_LOAD(m + 1);
        float v0[8], v1[8]; float sa = 0.f, sb = 0.f;
        if (lane < 48) {
            float c8[8], s8[8], w8[8]; UNPK8(c8, ca4) UNPK8(s8, cb4) UNPK8(w8, cc4)
#pragma unroll
            for (int i = 0; i < 8; ++i) { v0[i] = g0 * c8[i] + g1 * s8[i] + g2 * w8[i]; sa += v0[i] * v0[i]; }
        } else {
            UNPK8(v0, ca4)
#pragma unroll
            for (int i = 0; i < 8; ++i) sb += v0[i] * v0[i];
        }
        if (lane < 32) { UNPK8(v1, cy4)
#pragma unroll
            for (int i = 0; i < 8; ++i) sb += v1[i] * v1[i]; }
        const float ra = rsqrtf(wave_sum2(sa) * (1.f / 384.f) + EPS), rb = rsqrtf(wave_sum2(sb) * (1.f / 384.f) + EPS);
        {
            const int col = (lane < 48) ? lane * 8 : 384 + (lane - 48) * 8; const float rr = (lane < 48) ? ra : rb;
            const float4 q0 = gA0, q1 = gA1;
            v4u w; w.x = pk2(v0[0] * rr * q0.x, v0[1] * rr * q0.y); w.y = pk2(v0[2] * rr * q0.z, v0[3] * rr * q0.w); w.z = pk2(v0[4] * rr * q1.x, v0[5] * rr * q1.y); w.w = pk2(v0[6] * rr * q1.z, v0[7] * rr * q1.w);
            *(v4u*)(r + col) = w;
        }
        if (lane < 32) { const float4 q0 = gB0, q1 = gB1;
            v4u w; w.x = pk2(v1[0] * rb * q0.x, v1[1] * rb * q0.y); w.y = pk2(v1[2] * rb * q0.z, v1[3] * rb * q0.w); w.z = pk2(v1[4] * rb * q1.x, v1[5] * rb * q1.y); w.w = pk2(v1[6] * rb * q1.z, v1[7] * rb * q1.w);
            *(v4u*)(r + 384 + (16 + lane) * 8) = w; }
    }
#undef MIX_LOAD
#undef UNPK8
}


typedef short bf16x8 __attribute__((ext_vector_type(8)));
typedef short s16x4 __attribute__((ext_vector_type(4)));
typedef float f32x16 __attribute__((ext_vector_type(16)));
typedef unsigned u32x2v __attribute__((ext_vector_type(2)));
constexpr int AT_BUF = 20480, AT_K32 = 8192, AT_V = 12288;
__device__ __forceinline__ unsigned cvtpk(float lo, float hi) { unsigned r; asm volatile("v_cvt_pk_bf16_f32 %0, %1, %2" : "=v"(r) : "v"(lo), "v"(hi)); return r; }
__device__ __forceinline__ float max3f(float a, float b, float c) { float r; asm("v_max3_f32 %0, %1, %2, %3" : "=v"(r) : "v"(a), "v"(b), "v"(c)); return r; }
__device__ __forceinline__ int crow(int r, int hi) { return (r & 3) + 8 * (r >> 2) + 4 * hi; }
__device__ __forceinline__ s16x4 vtr(LAS const unsigned char* p) { return __builtin_bit_cast(s16x4, __builtin_amdgcn_ds_read_tr16_b64_v4i16((LAS s16x4*)p)); }
enum { AM_CAUSAL = 0, AM_WINDOW = 1, AM_SLC = 2 };
struct AttnState { float m, l; f32x16 o[2]; f32x16 negm; bool started; long long twait; };
template <int NC> struct TileRegs { v4u k; v4u k2; v4u v; };
template <int NC> __device__ __forceinline__ void at_load(TileRegs<NC>& r, const bf16* Kg, int ldk, const bf16* Vg, int ldv, const bf16* K2g, int ldk2, int tile, int tid) {
    const int key = tid >> 3, c = tid & 7;
    r.k = *(const v4u*)(Kg + (size_t)(tile * 64 + key) * ldk + 8 * c);
    r.v = *(const v4u*)(Vg + (size_t)(tile * 64 + key) * ldv + 8 * c);
    if (NC == 6) { if (tid < 256) r.k2 = *(const v4u*)(K2g + (size_t)(tile * 64 + (tid >> 2)) * ldk2 + 8 * (tid & 3)); }
}
template <int NC> __device__ __forceinline__ void at_store(const TileRegs<NC>& r, LAS unsigned char* buf, int tid) {
    const int key = tid >> 3, c = tid & 7;
    *(LAS v4u*)(buf + key * 128 + 16 * (c ^ ((key >> 1) & 7))) = r.k;
    *(LAS v4u*)(buf + AT_V + (c >> 2) * 4096 + key * 64 + (c & 3) * 16) = r.v;
    if (NC == 6) { if (tid < 256) { const int k2 = tid >> 2, c2 = tid & 3; *(LAS v4u*)(buf + AT_K32 + k2 * 64 + 16 * (c2 ^ ((k2 >> 2) & 3))) = r.k2; } }
}
template <int NC> __device__ __forceinline__ void qk_tile(f32x16& p0, f32x16& p1, LAS const unsigned char* buf, const bf16x8 (&qf)[NC], const f32x16& negm, int lane) {
    const int r32 = lane & 31, hi = lane >> 5;
    p0 = negm; p1 = negm;
#pragma unroll
    for (int cc = 0; cc < NC; ++cc) {
        bf16x8 k0, k1;
        if (cc < 4) { const int k0r = r32, k1r = 32 + r32;
            k0 = *(LAS const bf16x8*)(buf + k0r * 128 + 16 * ((2 * cc + hi) ^ ((k0r >> 1) & 7)));
            k1 = *(LAS const bf16x8*)(buf + k1r * 128 + 16 * ((2 * cc + hi) ^ ((k1r >> 1) & 7))); }
        else { const int k0r = r32, k1r = 32 + r32, c2 = 2 * (cc - 4) + hi;
            k0 = *(LAS const bf16x8*)(buf + AT_K32 + k0r * 64 + 16 * (c2 ^ ((k0r >> 2) & 3)));
            k1 = *(LAS const bf16x8*)(buf + AT_K32 + k1r * 64 + 16 * (c2 ^ ((k1r >> 2) & 3))); }
        p0 = __builtin_amdgcn_mfma_f32_32x32x16_bf16(k0, qf[cc], p0, 0, 0, 0);
        p1 = __builtin_amdgcn_mfma_f32_32x32x16_bf16(k1, qf[cc], p1, 0, 0, 0);
    }
}
template <int MODE> __device__ __forceinline__ void mask_tile(f32x16& p0, f32x16& p1, int kpos0, int qpos, bool need_mask, bool sel_ok, int lane) {
    const int hi = lane >> 5;
    if (need_mask) {
        const int qw0m = __builtin_amdgcn_readfirstlane(qpos) & ~31;
        const bool diag = (kpos0 + 63 > qw0m), old = (MODE == AM_WINDOW) && (kpos0 < qw0m + 31 - 511);
        if (diag || old) {
            const float selterm = (MODE == AM_SLC && !sel_ok) ? -INFINITY : INFINITY;
            const int dbase = qpos - kpos0 - 4 * hi;
#pragma unroll
            for (int r = 0; r < 16; ++r) {
                const int d0 = dbase - ((r & 3) + 8 * (r >> 2)), d1 = d0 - 32;
                float l0 = ((float)d0 + 0.5f) * INFINITY, l1 = ((float)d1 + 0.5f) * INFINITY;
                if (MODE == AM_WINDOW) { l0 = fminf(l0, ((float)(511 - d0) + 0.5f) * INFINITY); l1 = fminf(l1, ((float)(511 - d1) + 0.5f) * INFINITY); }
                if (MODE == AM_SLC) { l0 = fminf(l0, selterm); l1 = fminf(l1, selterm); }
                p0[r] = fminf(p0[r], l0); p1[r] = fminf(p1[r], l1);
            }
        } else if (MODE == AM_SLC) {
            const float selterm = sel_ok ? INFINITY : -INFINITY;
#pragma unroll
            for (int r = 0; r < 16; ++r) { p0[r] = fminf(p0[r], selterm); p1[r] = fminf(p1[r], selterm); }
        }
    }
}
template <int MODE> __device__ __forceinline__ void softmax_tile(AttnState& st, f32x16& p0, f32x16& p1, bf16x8 (&pf)[4], int kpos0, int qpos, bool need_mask, bool sel_ok, int lane) {
    mask_tile<MODE>(p0, p1, kpos0, qpos, need_mask, sel_ok, lane);
    float mx = max3f(p0[0], p1[0], p0[1]), mx2 = max3f(p1[1], p0[2], p1[2]);
#pragma unroll
    for (int r = 3; r < 15; r += 2) { mx = max3f(mx, p0[r], p1[r]); mx2 = max3f(mx2, p0[r + 1], p1[r + 1]); }
    mx = max3f(mx, p0[15], p1[15]); mx = max3f(mx, mx2, mx2);
    mx = red32_max(mx);
    if (!st.started || __any(mx > 0.f)) {
        float dl = st.started ? fmaxf(mx, 0.f) : mx;
        dl = (dl > -1e30f) ? dl : 0.f;
        st.started = true;
        const float alpha = __builtin_amdgcn_exp2f(-dl);
        st.m += dl; st.l *= alpha;
#pragma unroll
        for (int r = 0; r < 16; ++r) { st.o[0][r] *= alpha; st.o[1][r] *= alpha; p0[r] -= dl; p1[r] -= dl; st.negm[r] = -st.m; }
    }
    float sum = 0.f;
#pragma unroll
    for (int r = 0; r < 16; ++r) { p0[r] = __builtin_amdgcn_exp2f(p0[r]); p1[r] = __builtin_amdgcn_exp2f(p1[r]); sum += p0[r] + p1[r]; }
    st.l += sum;
#pragma unroll
    for (int s2 = 0; s2 < 2; ++s2) {
        v4u a, b;
        a.x = cvtpk(p0[8 * s2 + 0], p0[8 * s2 + 1]); a.y = cvtpk(p0[8 * s2 + 2], p0[8 * s2 + 3]); a.z = cvtpk(p0[8 * s2 + 4], p0[8 * s2 + 5]); a.w = cvtpk(p0[8 * s2 + 6], p0[8 * s2 + 7]);
        b.x = cvtpk(p1[8 * s2 + 0], p1[8 * s2 + 1]); b.y = cvtpk(p1[8 * s2 + 2], p1[8 * s2 + 3]); b.z = cvtpk(p1[8 * s2 + 4], p1[8 * s2 + 5]); b.w = cvtpk(p1[8 * s2 + 6], p1[8 * s2 + 7]);
        pf[s2] = __builtin_bit_cast(bf16x8, a); pf[2 + s2] = __builtin_bit_cast(bf16x8, b);
    }
}
struct TileFlags { bool skip, need_mask, sel_ok; };
__device__ __forceinline__ void pack_p(bf16x8 (&pf)[4], const f32x16& p0, const f32x16& p1) {
#pragma unroll
    for (int s2 = 0; s2 < 2; ++s2) {
        v4u a, b;
        a.x = cvtpk(p0[8 * s2 + 0], p0[8 * s2 + 1]); a.y = cvtpk(p0[8 * s2 + 2], p0[8 * s2 + 3]); a.z = cvtpk(p0[8 * s2 + 4], p0[8 * s2 + 5]); a.w = cvtpk(p0[8 * s2 + 6], p0[8 * s2 + 7]);
        b.x = cvtpk(p1[8 * s2 + 0], p1[8 * s2 + 1]); b.y = cvtpk(p1[8 * s2 + 2], p1[8 * s2 + 3]); b.z = cvtpk(p1[8 * s2 + 4], p1[8 * s2 + 5]); b.w = cvtpk(p1[8 * s2 + 6], p1[8 * s2 + 7]);
        pf[s2] = __builtin_bit_cast(bf16x8, a); pf[2 + s2] = __builtin_bit_cast(bf16x8, b);
    }
}
template <int MODE> __device__ __forceinline__ void softmax_pair(AttnState& st, f32x16& a0, f32x16& a1, f32x16& b0, f32x16& b1, int kpos0, int qpos, const TileFlags& fa, const TileFlags& fb, int lane) {
    mask_tile<MODE>(a0, a1, kpos0, qpos, fa.need_mask, fa.sel_ok, lane);
    mask_tile<MODE>(b0, b1, kpos0 + 64, qpos, fb.need_mask, fb.sel_ok, lane);
    float mx = max3f(a0[0], a1[0], b0[0]), mx2 = max3f(b1[0], a0[1], a1[1]);
#pragma unroll
    for (int r = 1; r < 16; ++r) { mx = max3f(mx, b0[r], b1[r]); if (r > 1) mx2 = max3f(mx2, a0[r], a1[r]); }
    mx = max3f(mx, mx2, mx2);
    mx = red32_max(mx);
    if (!st.started || __any(mx > 0.f)) {
        float dl = st.started ? fmaxf(mx, 0.f) : mx;
        dl = (dl > -1e30f) ? dl : 0.f;
        st.started = true;
        const float alpha = __builtin_amdgcn_exp2f(-dl);
        st.m += dl; st.l *= alpha;
#pragma unroll
        for (int r = 0; r < 16; ++r) { st.o[0][r] *= alpha; st.o[1][r] *= alpha; a0[r] -= dl; a1[r] -= dl; b0[r] -= dl; b1[r] -= dl; st.negm[r] = -st.m; }
    }
    float sum = 0.f;
#pragma unroll
    for (int r = 0; r < 16; ++r) { a0[r] = __builtin_amdgcn_exp2f(a0[r]); a1[r] = __builtin_amdgcn_exp2f(a1[r]); b0[r] = __builtin_amdgcn_exp2f(b0[r]); b1[r] = __builtin_amdgcn_exp2f(b1[r]); sum += (a0[r] + a1[r]) + (b0[r] + b1[r]); }
    st.l += sum;
}
__device__ __forceinline__ void pv_tile(AttnState& st, LAS const unsigned char* buf, const bf16x8 (&pf)[4], int lane) {
    const int hi = lane >> 5;
    const unsigned vb = (unsigned)(uintptr_t)(buf + AT_V + (4 * hi + ((lane & 15) >> 2)) * 64 + ((lane >> 4) & 1) * 32 + (lane & 3) * 8);
#pragma unroll
    for (int dh = 0; dh < 2; ++dh) {
        s16x4 lo[4], hh[4];
#pragma unroll
        for (int s4 = 0; s4 < 4; ++s4) {
            asm volatile("ds_read_b64_tr_b16 %0, %1 offset:%c2" : "=&v"(lo[s4]) : "v"(vb), "i"(dh * 4096 + s4 * 1024) : "memory");
            asm volatile("ds_read_b64_tr_b16 %0, %1 offset:%c2" : "=&v"(hh[s4]) : "v"(vb), "i"(dh * 4096 + s4 * 1024 + 512) : "memory");
        }
        asm volatile("s_waitcnt lgkmcnt(0)" : "+v"(lo[0]), "+v"(lo[1]), "+v"(lo[2]), "+v"(lo[3]), "+v"(hh[0]), "+v"(hh[1]), "+v"(hh[2]), "+v"(hh[3]) :: "memory");
#pragma unroll
        for (int s4 = 0; s4 < 4; ++s4) {
            const bf16x8 vf = {lo[s4][0], lo[s4][1], lo[s4][2], lo[s4][3], hh[s4][0], hh[s4][1], hh[s4][2], hh[s4][3]};
            st.o[dh] = __builtin_amdgcn_mfma_f32_32x32x16_bf16(vf, pf[s4], st.o[dh], 0, 0, 0);
        }
    }
}
template <int MODE> __device__ __forceinline__ TileFlags tile_flags(int t, int qw0, unsigned selbits) {
    const int k0 = t * 64; TileFlags f;
    f.skip = k0 > qw0 + 31; f.need_mask = (k0 + 63 > qw0); f.sel_ok = true;
    if (MODE == AM_WINDOW) { f.skip = f.skip || (k0 + 63 < qw0 - 511); f.need_mask = f.need_mask || (k0 < qw0 + 31 - 511); }
    if (MODE == AM_SLC) { f.sel_ok = (selbits >> t) & 1u; const unsigned long long bal = __ballot(f.sel_ok); f.skip = f.skip || (bal == 0ull); f.need_mask = f.need_mask || (bal != ~0ull); }
    return f;
}
struct DmaOff { unsigned k, v, k2; };
template <int NC> __device__ __forceinline__ DmaOff at_dma_off(int ldk, int ldv, int ldk2, int wave, int lane) {
    const int L = wave * 64 + lane; DmaOff o;
    { const int key = L >> 3, c = (L & 7) ^ ((key >> 1) & 7); o.k = (unsigned)(key * ldk + 8 * c) * 2u; }
    { const int key = (L >> 2) & 63, c = (L >> 8) * 4 + (L & 3); o.v = (unsigned)(key * ldv + 8 * c) * 2u; }
    { const int key = (L >> 2) & 63, c2 = (L & 3) ^ ((key >> 2) & 3); o.k2 = (unsigned)(key * ldk2 + 8 * c2) * 2u; }
    return o;
}
template <int NC> __device__ __forceinline__ void at_dma(const DmaOff& o, const bf16* Kg, int ldk, const bf16* Vg, int ldv, const bf16* K2g, int ldk2, int tile, LAS unsigned char* slot, int wave) {
    __builtin_amdgcn_global_load_lds((const unsigned*)((const char*)(Kg + (size_t)tile * 64 * ldk) + o.k), (LAS unsigned*)(slot + wave * 1024), 16, 0, 0);
    __builtin_amdgcn_global_load_lds((const unsigned*)((const char*)(Vg + (size_t)tile * 64 * ldv) + o.v), (LAS unsigned*)(slot + AT_V + wave * 1024), 16, 0, 0);
    if (NC == 6) { if (wave < 4) __builtin_amdgcn_global_load_lds((const unsigned*)((const char*)(K2g + (size_t)tile * 64 * ldk2) + o.k2), (LAS unsigned*)(slot + AT_K32 + wave * 1024), 16, 0, 0); }
}
__device__ __forceinline__ void at_wait_bar(int keep) {
    if (keep == 0) asm volatile("s_waitcnt vmcnt(0) lgkmcnt(0)" ::: "memory");
    else if (keep == 4) asm volatile("s_waitcnt vmcnt(4) lgkmcnt(0)" ::: "memory");
    else asm volatile("s_waitcnt vmcnt(6) lgkmcnt(0)" ::: "memory");
    __builtin_amdgcn_s_barrier();
    asm volatile("" ::: "memory");
}
template <int NC, int MODE> __device__ __forceinline__ void at_stream(AttnState& st, LAS unsigned char* lds, const bf16* Kg, int ldk, const bf16* Vg, int ldv, const bf16* K2g, int ldk2, int t0, int t1,
                                                                       const bf16x8 (&qf)[NC], int qpos, int qw0, unsigned selbits, int tid) {
    const int lane = tid & 63, wave = __builtin_amdgcn_readfirstlane(tid >> 6), np = (t1 - t0) >> 1;
    const int nper2 = (NC == 6 && wave < 4) ? 6 : 4;
    const DmaOff dof = at_dma_off<NC>(ldk, ldv, ldk2, wave, lane);
    at_dma<NC>(dof, Kg, ldk, Vg, ldv, K2g, ldk2, t0, lds, wave); at_dma<NC>(dof, Kg, ldk, Vg, ldv, K2g, ldk2, t0 + 1, lds + AT_BUF, wave);
    if (np > 1) { at_dma<NC>(dof, Kg, ldk, Vg, ldv, K2g, ldk2, t0 + 2, lds + 2 * AT_BUF, wave); at_dma<NC>(dof, Kg, ldk, Vg, ldv, K2g, ldk2, t0 + 3, lds + 3 * AT_BUF, wave); }
    at_wait_bar(np > 1 ? nper2 : 0);
    int s0 = 0, s1 = 2 * AT_BUF, s2 = 4 * AT_BUF;
    for (int j = 0; j < np; ++j) {
        const int t = t0 + 2 * j; const bool has_2 = (j + 2 < np);
        if (has_2) { at_dma<NC>(dof, Kg, ldk, Vg, ldv, K2g, ldk2, t + 4, lds + s2, wave); at_dma<NC>(dof, Kg, ldk, Vg, ldv, K2g, ldk2, t + 5, lds + s2 + AT_BUF, wave); }
        const TileFlags fa = tile_flags<MODE>(t, qw0, selbits), fb = tile_flags<MODE>(t + 1, qw0, selbits);
        if (!fa.skip && !fb.skip) {
            f32x16 a0, a1, b0, b1; bf16x8 pf[4];
            qk_tile<NC>(a0, a1, lds + s0, qf, st.negm, lane);
            qk_tile<NC>(b0, b1, lds + s0 + AT_BUF, qf, st.negm, lane);
            softmax_pair<MODE>(st, a0, a1, b0, b1, t * 64, qpos, fa, fb, lane);
            pack_p(pf, a0, a1); pv_tile(st, lds + s0, pf, lane);
            pack_p(pf, b0, b1); pv_tile(st, lds + s0 + AT_BUF, pf, lane);
        } else {
            if (!fa.skip) { f32x16 p0, p1; bf16x8 pf[4]; qk_tile<NC>(p0, p1, lds + s0, qf, st.negm, lane); softmax_tile<MODE>(st, p0, p1, pf, t * 64, qpos, fa.need_mask, fa.sel_ok, lane); pv_tile(st, lds + s0, pf, lane); }
            if (!fb.skip) { f32x16 p0, p1; bf16x8 pf[4]; qk_tile<NC>(p0, p1, lds + s0 + AT_BUF, qf, st.negm, lane); softmax_tile<MODE>(st, p0, p1, pf, (t + 1) * 64, qpos, fb.need_mask, fb.sel_ok, lane); pv_tile(st, lds + s0 + AT_BUF, pf, lane); }
        }
        at_wait_bar(has_2 ? nper2 : 0);
        const int tmp = s0; s0 = s1; s1 = s2; s2 = tmp;
    }
}
__device__ __forceinline__ int next_item_q(unsigned* ctrs, LAS unsigned char* lds, int wave_u, int count, int q0, int& kstart) {
    const int tid = wave_u * 64 + fresh_lane();
    LAS int* slot = (LAS int*)(lds + RING_BYTES + 64);
    if (tid == 0) { const unsigned v = atomicAdd(ctrs, 1u); slot[0] = (v < 8u * (unsigned)count) ? (int)(((v & 7u) << 16) | (v >> 3)) : -1; }
    __syncthreads();
    const int v = slot[0];
    __syncthreads();
    (void)q0; (void)kstart;
    return v;
}
__device__ __forceinline__ void mla_unit(unsigned char* ws, LAS unsigned char* lds, int b, int h, int qt, int wave_u) {
    const int tid = wave_u * 64 + fresh_lane();
    const int lane = tid & 63, wave = tid >> 6, r32 = lane & 31, hi = lane >> 5;
    const int qw0 = qt * 256 + wave * 32, qpos = qw0 + r32; const size_t row = (size_t)b * S_ + qpos;
    const long long tq0 = (PROBE_SEL != 0) ? (long long)__builtin_amdgcn_s_memtime() : 0ll;
    bf16x8 qf[6];
    {
        const bf16* qp = (const bf16*)(ws + WS_OSLC) + row * 768 + h * 96 + 8 * hi;
        v4u raw[6];
#pragma unroll
        for (int cc = 0; cc < 6; ++cc) raw[cc] = *(const v4u*)(qp + 16 * cc);
        float msc = MSCALE; asm volatile("" : "+v"(msc));
        const float rs = rsqrtf(((const float*)(ws + WS_SSQL))[row] * (1.f / 256.f) + EPS) * msc;
        const float* cm_ = (const float*)(ws + WS_COSM) + row * 16 + 8 * hi; const float* sm_ = (const float*)(ws + WS_SINM) + row * 16 + 8 * hi;
#define UNPKQ(dst, src) dst[0] = __uint_as_float(src.x << 16); dst[1] = __uint_as_float(src.x & 0xffff0000u); dst[2] = __uint_as_float(src.y << 16); dst[3] = __uint_as_float(src.y & 0xffff0000u); \
        dst[4] = __uint_as_float(src.z << 16); dst[5] = __uint_as_float(src.z & 0xffff0000u); dst[6] = __uint_as_float(src.w << 16); dst[7] = __uint_as_float(src.w & 0xffff0000u);
#pragma unroll
        for (int cc = 0; cc < 4; ++cc) { float f[8]; UNPKQ(f, raw[cc])
            v4u w; w.x = cvtpk(f[0] * rs, f[1] * rs); w.y = cvtpk(f[2] * rs, f[3] * rs); w.z = cvtpk(f[4] * rs, f[5] * rs); w.w = cvtpk(f[6] * rs, f[7] * rs); qf[cc] = __builtin_bit_cast(bf16x8, w); }
        { float x1[8], x2[8], o1[8], o2[8]; UNPKQ(x1, raw[4]) UNPKQ(x2, raw[5])
#pragma unroll
          for (int j = 0; j < 8; ++j) { const float cs = cm_[j] * rs, sn = sm_[j] * rs; o1[j] = x1[j] * cs - x2[j] * sn; o2[j] = x1[j] * sn + x2[j] * cs; }
          v4u w; w.x = cvtpk(o1[0], o1[1]); w.y = cvtpk(o1[2], o1[3]); w.z = cvtpk(o1[4], o1[5]); w.w = cvtpk(o1[6], o1[7]); qf[4] = __builtin_bit_cast(bf16x8, w);
          w.x = cvtpk(o2[0], o2[1]); w.y = cvtpk(o2[2], o2[3]); w.z = cvtpk(o2[4], o2[5]); w.w = cvtpk(o2[6], o2[7]); qf[5] = __builtin_bit_cast(bf16x8, w); }
#undef UNPKQ
    }
    const long long tq1 = (PROBE_SEL != 0) ? (long long)__builtin_amdgcn_s_memtime() : 0ll;
    AttnState st; st.m = 0.f; st.l = 0.f; st.o[0] = f32x16{}; st.o[1] = f32x16{}; st.negm = f32x16{}; st.started = false; st.twait = 0;
    const bf16* kvb = (const bf16*)(ws + WS_KVM) + (size_t)b * S_ * 768 + h * 128;
    at_stream<6, AM_CAUSAL>(st, lds, kvb, 768, kvb + 64, 768, (const bf16*)(ws + WS_KR) + (size_t)b * S_ * 32, 32, 0, 4 * qt + 4, qf, qpos, qw0, 0u, tid);
    if (PROBE_SEL >= 1 && PROBE_SEL <= 3 && b == 0 && h == 0 && qt == 7 && tid == 0) { const long long tq2 = (long long)__builtin_amdgcn_s_memtime();
        ((float*)(ws + WS_CTL))[100] = (PROBE_SEL == 1) ? (float)(tq2 - tq1) : (PROBE_SEL == 2) ? (float)st.twait : (float)(tq1 - tq0); }
    const float lt = red32_sum(st.l), il = 1.f / lt;
    bf16* op = (bf16*)(ws + WS_HB) + row * D_ + 384 + h * 64 + 4 * hi;
#pragma unroll
    for (int dh = 0; dh < 2; ++dh)
#pragma unroll
        for (int g4 = 0; g4 < 4; ++g4) { u32x2v w; w.x = cvtpk(st.o[dh][4 * g4] * il, st.o[dh][4 * g4 + 1] * il); w.y = cvtpk(st.o[dh][4 * g4 + 2] * il, st.o[dh][4 * g4 + 3] * il);
            *(u32x2v*)(op + dh * 32 + 8 * g4) = w; }
}
template <int MODE> __device__ __forceinline__ void nsa_branch_unit(unsigned char* ws, LAS unsigned char* lds, int b, int h, int qt, int wave_u) {
    const int tid = wave_u * 64 + fresh_lane();
    const int lane = tid & 63, wave = tid >> 6, r32 = lane & 31, hi = lane >> 5, g = h / 3;
    const int qw0 = qt * 256 + wave * 32, qpos = qw0 + r32; const size_t row = (size_t)b * S_ + qpos;
    const bf16* nsa = (const bf16*)(ws + WS_NSA);
    const bf16* qp = nsa + row * 1152 + h * 64 + 8 * hi;
    bf16x8 qf[4];
#pragma unroll
    for (int cc = 0; cc < 4; ++cc) qf[cc] = *(const bf16x8*)(qp + 16 * cc);
    unsigned selbits = 0u; if (MODE == AM_SLC) selbits = ((const unsigned*)(ws + WS_SEL))[(size_t)(b * 2 + g) * S_ + qpos];
    const bf16* kb = nsa + (size_t)b * S_ * 1152 + g * 64 + (MODE == AM_SLC ? 640 : 896);
    AttnState st; st.m = 0.f; st.l = 0.f; st.o[0] = f32x16{}; st.o[1] = f32x16{}; st.negm = f32x16{}; st.started = false; st.twait = 0;
    const long long tn0 = (PROBE_SEL != 0) ? (long long)__builtin_amdgcn_s_memtime() : 0ll;
    const int t0 = (MODE == AM_SLC) ? 0 : ((4 * qt - 8 > 0) ? 4 * qt - 8 : 0);
    at_stream<4, MODE>(st, lds, kb, 1152, kb + 128, 1152, nullptr, 0, t0, 4 * qt + 4, qf, qpos, qw0, selbits, tid);
    if (PROBE_SEL >= 4 && PROBE_SEL <= 5 && MODE == AM_SLC && b == 0 && h == 0 && qt == 7 && tid == 0) { const long long tn1 = (long long)__builtin_amdgcn_s_memtime();
        ((float*)(ws + WS_CTL))[100] = (PROBE_SEL == 4) ? (float)(tn1 - tn0) : (float)st.twait; }
    const float lt = red32_sum(st.l), il = 1.f / lt;
    bf16* op = (bf16*)(ws + (MODE == AM_SLC ? WS_OSLC : WS_OWIN)) + row * 384 + h * 64 + 4 * hi;
#pragma unroll
    for (int dh = 0; dh < 2; ++dh)
#pragma unroll
        for (int g4 = 0; g4 < 4; ++g4) { u32x2v w; w.x = cvtpk(st.o[dh][4 * g4] * il, st.o[dh][4 * g4 + 1] * il); w.y = cvtpk(st.o[dh][4 * g4 + 2] * il, st.o[dh][4 * g4 + 3] * il);
            *(u32x2v*)(op + dh * 32 + 8 * g4) = w; }
}
__device__ __forceinline__ void cmp_unit(unsigned char* ws, LAS unsigned char* lds, int b, int g, int qt, int wave_u) {
    const int tid = wave_u * 64 + fresh_lane();
    const int lane = tid & 63, wave = tid >> 6, r32 = lane & 31, hi = lane >> 5;
    const int qpos = qt * 256 + wave * 32 + r32; const size_t row = (size_t)b * S_ + qpos;
    const bf16* kc = (const bf16*)(ws + WS_KCV) + (size_t)(b * 2 + g) * 128 * 64; const bf16* vc = kc + (size_t)8 * 2 * 128 * 64;
    { TileRegs<4> tr; at_load<4>(tr, kc, 64, vc, 64, nullptr, 0, 0, tid); at_store<4>(tr, lds, tid); at_load<4>(tr, kc, 64, vc, 64, nullptr, 0, 1, tid); at_store<4>(tr, lds + AT_BUF, tid); }
    __syncthreads();
    int nvis = (qpos >= 31) ? ((qpos - 31) >> 4) + 1 : 0; if (nvis > 127) nvis = 127;
    float G[16], L[16];
#pragma unroll
    for (int i = 0; i < 16; ++i) { G[i] = 0.f; L[i] = 0.f; }
    const bf16* nsa = (const bf16*)(ws + WS_NSA);
    LAS const unsigned char* vb = lds + AT_V + (4 * hi + ((lane & 15) >> 2)) * 64 + ((lane >> 4) & 1) * 32 + (lane & 3) * 8;
    for (int r3 = 0; r3 < 3; ++r3) {
        const int h = 3 * g + r3;
        const bf16* qp = nsa + row * 1152 + h * 64 + 8 * hi;
        bf16x8 qf[4];
#pragma unroll
        for (int cc = 0; cc < 4; ++cc) qf[cc] = *(const bf16x8*)(qp + 16 * cc);
        f32x16 p[4];
#pragma unroll
        for (int tb = 0; tb < 4; ++tb) {
            LAS const unsigned char* buf = lds + (tb >> 1) * AT_BUF; const int kr = (tb & 1) * 32 + r32;
            p[tb] = f32x16{};
#pragma unroll
            for (int cc = 0; cc < 4; ++cc) { const bf16x8 kf = *(LAS const bf16x8*)(buf + kr * 128 + 16 * ((2 * cc + hi) ^ ((kr >> 1) & 7)));
                p[tb] = __builtin_amdgcn_mfma_f32_32x32x16_bf16(kf, qf[cc], p[tb], 0, 0, 0); }
        }
        float mx = -1e30f;
#pragma unroll
        for (int tb = 0; tb < 4; ++tb)
#pragma unroll
            for (int r = 0; r < 16; ++r) { const int n = 32 * tb + crow(r, hi); p[tb][r] = fminf(p[tb][r], ((float)(nvis - n) - 0.5f) * INFINITY); mx = fmaxf(mx, p[tb][r]); }
        mx = red32_max(mx);
        float sum = 0.f;
#pragma unroll
        for (int tb = 0; tb < 4; ++tb)
#pragma unroll
            for (int r = 0; r < 16; ++r) { p[tb][r] = __builtin_amdgcn_exp2f(p[tb][r] - mx); sum += p[tb][r]; }
        sum = red32_sum(sum);
        const float il = (nvis > 0) ? 1.f / sum : 0.f;
#pragma unroll
        for (int tb = 0; tb < 4; ++tb)
#pragma unroll
            for (int k = 0; k < 4; ++k) { const float a0 = p[tb][4 * k] * il, a1 = p[tb][4 * k + 1] * il, a2 = p[tb][4 * k + 2] * il, a3 = p[tb][4 * k + 3] * il;
                G[4 * tb + k] += (a0 + a1) + (a2 + a3); L[4 * tb + k] += a3; }
        f32x16 o[2] = {f32x16{}, f32x16{}};
#pragma unroll
        for (int tb = 0; tb < 4; ++tb)
#pragma unroll
            for (int s2 = 0; s2 < 2; ++s2) {
                v4u a; a.x = cvtpk(p[tb][8 * s2 + 0], p[tb][8 * s2 + 1]); a.y = cvtpk(p[tb][8 * s2 + 2], p[tb][8 * s2 + 3]); a.z = cvtpk(p[tb][8 * s2 + 4], p[tb][8 * s2 + 5]); a.w = cvtpk(p[tb][8 * s2 + 6], p[tb][8 * s2 + 7]);
                const bf16x8 pf = __builtin_bit_cast(bf16x8, a);
                LAS const unsigned char* vbb = vb + (tb >> 1) * AT_BUF + ((tb & 1) * 2 + s2) * 1024;
#pragma unroll
                for (int dh = 0; dh < 2; ++dh) { const s16x4 lo = vtr(vbb + dh * 4096), hh = vtr(vbb + dh * 4096 + 512);
                    const bf16x8 vf = {lo[0], lo[1], lo[2], lo[3], hh[0], hh[1], hh[2], hh[3]};
                    o[dh] = __builtin_amdgcn_mfma_f32_32x32x16_bf16(vf, pf, o[dh], 0, 0, 0); }
                asm volatile("" ::: "memory");
            }
        bf16* op = (bf16*)(ws + WS_OCMP) + row * 384 + h * 64 + 4 * hi;
#pragma unroll
        for (int dh = 0; dh < 2; ++dh)
#pragma unroll
            for (int g4 = 0; g4 < 4; ++g4) { u32x2v w; w.x = cvtpk(o[dh][4 * g4] * il, o[dh][4 * g4 + 1] * il); w.y = cvtpk(o[dh][4 * g4 + 2] * il, o[dh][4 * g4 + 3] * il);
                *(u32x2v*)(op + dh * 32 + 8 * g4) = w; }
    }
    const int cur = qpos >> 6;
    unsigned key[16], okey[16];
#pragma unroll
    for (int jj = 0; jj < 16; ++jj) {
        const auto sw = __builtin_amdgcn_permlane32_swap(__float_as_uint(L[jj]), __float_as_uint(L[jj]), false, false);
        const float lp = __uint_as_float(hi ? sw[0] : sw[1]);
        L[jj] = lp;
    }
#pragma unroll
    for (int jj = 0; jj < 16; ++jj) {
        const int j = 2 * jj + hi;
        float v = G[jj] + (hi ? L[jj] : (jj > 0 ? L[jj > 0 ? jj - 1 : 0] : 0.f));
        if (j == 0 || j == cur || j == cur - 1) v = INFINITY;
        if (j * 64 > qpos) v = -INFINITY;
        const unsigned u = __float_as_uint(v); const unsigned ord = (u & 0x80000000u) ? ~u : (u | 0x80000000u);
        key[jj] = (ord & ~31u) | (unsigned)(31 - j);
    }
#pragma unroll
    for (int jj = 0; jj < 16; ++jj) { const auto sw = __builtin_amdgcn_permlane32_swap(key[jj], key[jj], false, false); okey[jj] = hi ? sw[0] : sw[1]; }
    unsigned mask = 0;
#pragma unroll
    for (int jj = 0; jj < 16; ++jj) {
        int rank = 0;
#pragma unroll
        for (int kk = 0; kk < 16; ++kk) { rank += (key[kk] > key[jj]) ? 1 : 0; rank += (okey[kk] > key[jj]) ? 1 : 0; }
        if (rank < 16) mask |= 1u << (2 * jj + hi);
    }
    mask = red32_or(mask);
    if (hi == 0) ((unsigned*)(ws + WS_SEL))[(size_t)(b * 2 + g) * S_ + qpos] = mask;
    __syncthreads();
}
__device__ __forceinline__ void lora_rows(unsigned char* ws, int tid) {
    const int gw = blockIdx.x * NWAVES + (tid >> 6), ngw = gridDim.x * NWAVES, lane = tid & 63;
    bf16* kvl = (bf16*)(ws + WS_KVL); const bf16* ql = (const bf16*)(ws + WS_QL); float* ssql = (float*)(ws + WS_SSQL);
    for (int m = gw; m < T_; m += ngw) {
        const unsigned kv = *(const unsigned*)(kvl + (size_t)m * 128 + 2 * lane);
        const float k0 = __uint_as_float(kv << 16), k1 = __uint_as_float(kv & 0xffff0000u);
        const uint2 qv = *(const uint2*)(ql + (size_t)m * 256 + 4 * lane);
        const float q0 = __uint_as_float(qv.x << 16), q1 = __uint_as_float(qv.x & 0xffff0000u), q2 = __uint_as_float(qv.y << 16), q3 = __uint_as_float(qv.y & 0xffff0000u);
        const float sk = wave_sum2(k0 * k0 + k1 * k1), sq = wave_sum2((q0 * q0 + q1 * q1) + (q2 * q2 + q3 * q3));
        const float rk = rsqrtf(sk * (1.f / 128.f) + EPS);
        *(unsigned*)(kvl + (size_t)m * 128 + 2 * lane) = pk2(k0 * rk, k1 * rk);
        if (lane == 0) ssql[m] = sq;
    }
}
__device__ __forceinline__ void post_misc(unsigned char* ws, const float* big, const float* bfg, int tid) {
    const float* mr = (const float*)(ws + WS_MISCRAW); const float* cosM = (const float*)(ws + WS_COSM); const float* sinM = (const float*)(ws + WS_SINM);
    bf16* kr = (bf16*)(ws + WS_KR); float* gm = (float*)(ws + WS_GM);
    for (int idx = blockIdx.x * NTHR + tid; idx < T_ * 64; idx += gridDim.x * NTHR) {
        const int row = idx >> 6, c = idx & 63; const float* r = mr + (size_t)row * 64; const float v = r[c];
        if (c < 32) { const int i = c & 15; const float x1 = r[i], x2 = r[16 + i], cs = cosM[row * 16 + i], sn = sinM[row * 16 + i];
            kr[(size_t)row * 32 + c] = f2bf((c < 16) ? x1 * cs - x2 * sn : x1 * sn + x2 * cs); }
        else if (c < 50) gm[(size_t)row * 32 + (c - 32)] = __builtin_amdgcn_rcpf(1.f + __expf(-v));
        else if (c < 54) gm[(size_t)row * 32 + 18 + (c - 50)] = v + big[c - 50];
        else if (c < 58) { const float z = v + bfg[c - 54]; gm[(size_t)row * 32 + 22 + (c - 54)] = fminf(z, 0.f) - __logf(1.f + __expf(-fabsf(z))); }
    }
}

typedef float f32x4v __attribute__((ext_vector_type(4)));
__device__ __forceinline__ void compress_item(unsigned char* ws, LAS unsigned char* lds, const float* cmp_pos, int item, int wave_u) {
    const int lane = fresh_lane(), tid = wave_u * 64 + lane;
    const int nb = item & 7, g = (item >> 3) & 1, b = (item >> 4) & 7, kv = item >> 7;
    const bf16* tok = (const bf16*)(ws + WS_NSA) + (size_t)b * S_ * 1152 + (kv ? 512 : 384) + g * 64;
    const bf16* wt = (const bf16*)(ws + (kv ? WT_CV : WT_CK));
    const int nrow = nb * 16 + (lane & 15), kq = lane >> 4;
    f32x4v acc[4] = {f32x4v{}, f32x4v{}, f32x4v{}, f32x4v{}};
#pragma unroll
    for (int hb = 0; hb < 2; ++hb) {
        v4u t4[4]; f32x4v p0[4], p1[4]; bf16x8 bfr[4][4];
#pragma unroll
        for (int q = 0; q < 4; ++q) {
            const int k = wave_u * 256 + (4 * hb + q) * 32 + kq * 8, l = k >> 6, d = k & 63;
            int trow = 16 * nrow + l; trow = trow < S_ ? trow : S_ - 1;
            t4[q] = *(const v4u*)(tok + (size_t)trow * 1152 + d);
            p0[q] = *(const f32x4v*)(cmp_pos + k); p1[q] = *(const f32x4v*)(cmp_pos + k + 4);
#pragma unroll
            for (int cb = 0; cb < 4; ++cb) bfr[q][cb] = *(const bf16x8*)(wt + (size_t)(cb * 16 + (lane & 15)) * 2048 + k);
        }
        asm volatile("" : "+v"(t4[0]), "+v"(t4[1]), "+v"(t4[2]), "+v"(t4[3]), "+v"(p0[0]), "+v"(p0[1]), "+v"(p0[2]), "+v"(p0[3]), "+v"(p1[0]), "+v"(p1[1]), "+v"(p1[2]), "+v"(p1[3]));
        asm volatile("" : "+v"(bfr[0][0]), "+v"(bfr[0][1]), "+v"(bfr[0][2]), "+v"(bfr[0][3]), "+v"(bfr[1][0]), "+v"(bfr[1][1]), "+v"(bfr[1][2]), "+v"(bfr[1][3]));
        asm volatile("" : "+v"(bfr[2][0]), "+v"(bfr[2][1]), "+v"(bfr[2][2]), "+v"(bfr[2][3]), "+v"(bfr[3][0]), "+v"(bfr[3][1]), "+v"(bfr[3][2]), "+v"(bfr[3][3]));
#pragma unroll
        for (int q = 0; q < 4; ++q) {
            v4u a4;
            a4.x = cvtpk(__uint_as_float(t4[q].x << 16) + p0[q][0], __uint_as_float(t4[q].x & 0xffff0000u) + p0[q][1]); a4.y = cvtpk(__uint_as_float(t4[q].y << 16) + p0[q][2], __uint_as_float(t4[q].y & 0xffff0000u) + p0[q][3]);
            a4.z = cvtpk(__uint_as_float(t4[q].z << 16) + p1[q][0], __uint_as_float(t4[q].z & 0xffff0000u) + p1[q][1]); a4.w = cvtpk(__uint_as_float(t4[q].w << 16) + p1[q][2], __uint_as_float(t4[q].w & 0xffff0000u) + p1[q][3]);
            const bf16x8 af = __builtin_bit_cast(bf16x8, a4);
#pragma unroll
            for (int cb = 0; cb < 4; ++cb) acc[cb] = __builtin_amdgcn_mfma_f32_16x16x32_bf16(af, bfr[q][cb], acc[cb], 0, 0, 0);
        }
    }
    LAS float* red = (LAS float*)lds + wave_u * 1024;
#pragma unroll
    for (int cb = 0; cb < 4; ++cb)
#pragma unroll
        for (int r = 0; r < 4; ++r) red[(4 * (lane >> 4) + r) * 64 + cb * 16 + (lane & 15)] = acc[cb][r];
    __syncthreads();
    bf16* out = (bf16*)(ws + WS_KCV) + (size_t)kv * (8 * 2 * 128 * 64) + ((size_t)(b * 2 + g) * 128 + nb * 16) * 64;
    for (int o = tid; o < 1024; o += NTHR) { float sum = 0.f;
#pragma unroll
        for (int w8 = 0; w8 < 8; ++w8) sum += ((LAS float*)lds)[w8 * 1024 + o];
        out[o] = f2bf(sum); }
    __syncthreads();
}
__device__ __forceinline__ f32x4v mm16(const LAS bf16* A, int lda, int arow0, const LAS bf16* Bt, int ldb, int bcol0, int K, int lane, f32x4v acc) {
    const LAS bf16* ap = A + (arow0 + (lane & 15)) * lda + 8 * (lane >> 4); const LAS bf16* bp = Bt + (bcol0 + (lane & 15)) * ldb + 8 * (lane >> 4);
    for (int k = 0; k < K; k += 32) acc = __builtin_amdgcn_mfma_f32_16x16x32_bf16(*(const LAS bf16x8*)(ap + k), *(const LAS bf16x8*)(bp + k), acc, 0, 0, 0);
    return acc;
}
constexpr int ML_LD = 72;
constexpr int ML_STRIDE = 3 * 64 * ML_LD * 2 + 256;
__device__ __forceinline__ void mlocal_item(unsigned char* ws, LAS unsigned char* lds, const float* convw, const float* convb, const float* big, const float* bfg, int chunk0, int wave_u) {
    const int lane = fresh_lane(), tid = wave_u * 64 + lane;
    const int h = (chunk0 >> 5) & 3, b = chunk0 >> 7;
    LAS bf16* WQ = (LAS bf16*)lds;
    LAS bf16* WK = WQ + 64 * ML_LD;
    const bf16* cm = (const bf16*)(ws + WS_CM);
#define ML_PTRS(ch) const int chunk = chunk0 + (ch); const int c = chunk & 31; const int row0 = b * S_ + c * 64; LAS bf16* XS = WK + 64 * ML_LD + (ch) * (ML_STRIDE / 2); \
    LAS bf16* VT = XS + 64 * ML_LD; LAS bf16* WKT = VT + 64 * ML_LD; LAS float* wl = (LAS float*)(WKT + 64 * ML_LD); (void)c; (void)row0; (void)XS; (void)VT; (void)WKT; (void)wl; (void)chunk;
    {
        v4u gx[2][4], gv[2]; const int l = tid >> 3, ch0 = (tid & 7) * 8;
#pragma unroll
        for (int ch = 0; ch < 2; ++ch) { ML_PTRS(ch) const int row = row0 + l, s = c * 64 + l;
#pragma unroll
            for (int j = 0; j < 4; ++j) gx[ch][j] = (s - 3 + j >= 0) ? *(const v4u*)(cm + (size_t)(row - 3 + j) * 768 + h * 64 + ch0) : v4u{0u, 0u, 0u, 0u};
            gv[ch] = *(const v4u*)(cm + (size_t)row * 768 + 256 + h * 64 + ch0); }
        asm volatile("" : "+v"(gx[0][0]), "+v"(gx[0][1]), "+v"(gx[0][2]), "+v"(gx[0][3]), "+v"(gx[1][0]), "+v"(gx[1][1]), "+v"(gx[1][2]), "+v"(gx[1][3]), "+v"(gv[0]), "+v"(gv[1]));
#pragma unroll
        for (int ch = 0; ch < 2; ++ch) { ML_PTRS(ch) const int row = row0 + l;
            float a[8];
#pragma unroll
            for (int i = 0; i < 8; ++i) a[i] = convb[h * 64 + ch0 + i];
#pragma unroll
            for (int j = 0; j < 4; ++j) { const v4u x4 = gx[ch][j];
                const float* cw = convw + j * 256 + h * 64 + ch0;
                a[0] += cw[0] * __uint_as_float(x4.x << 16); a[1] += cw[1] * __uint_as_float(x4.x & 0xffff0000u); a[2] += cw[2] * __uint_as_float(x4.y << 16); a[3] += cw[3] * __uint_as_float(x4.y & 0xffff0000u);
                a[4] += cw[4] * __uint_as_float(x4.z << 16); a[5] += cw[5] * __uint_as_float(x4.z & 0xffff0000u); a[6] += cw[6] * __uint_as_float(x4.w << 16); a[7] += cw[7] * __uint_as_float(x4.w & 0xffff0000u); }
            v4u o4; float r[8];
#pragma unroll
            for (int i = 0; i < 8; ++i) r[i] = a[i] * __builtin_amdgcn_rcpf(1.f + __expf(-a[i]));
            o4.x = cvtpk(r[0], r[1]); o4.y = cvtpk(r[2], r[3]); o4.z = cvtpk(r[4], r[5]); o4.w = cvtpk(r[6], r[7]);
            *(v4u*)((bf16*)(ws + WS_XC) + (size_t)row * 256 + h * 64 + ch0) = o4;
            *(LAS v4u*)(XS + l * ML_LD + ch0) = o4;
            const v4u v4 = gv[ch];
            VT[(ch0 + 0) * ML_LD + l] = (bf16)(v4.x & 0xffffu); VT[(ch0 + 1) * ML_LD + l] = (bf16)(v4.x >> 16); VT[(ch0 + 2) * ML_LD + l] = (bf16)(v4.y & 0xffffu); VT[(ch0 + 3) * ML_LD + l] = (bf16)(v4.y >> 16);
            VT[(ch0 + 4) * ML_LD + l] = (bf16)(v4.z & 0xffffu); VT[(ch0 + 5) * ML_LD + l] = (bf16)(v4.z >> 16); VT[(ch0 + 6) * ML_LD + l] = (bf16)(v4.w & 0xffffu); VT[(ch0 + 7) * ML_LD + l] = (bf16)(v4.w >> 16);
        }
    }
    {
        const int e = tid >> 3, d0 = (tid & 7) * 8;
        *(LAS v4u*)(WQ + e * ML_LD + d0) = *(const v4u*)((const bf16*)(ws + WT_QM) + h * 4096 + e * 64 + d0);
        *(LAS v4u*)(WK + e * ML_LD + d0) = *(const v4u*)((const bf16*)(ws + WT_KM) + h * 4096 + e * 64 + d0);
    }
    if (wave_u < 2) { ML_PTRS(wave_u)
        const float* mr = (const float*)(ws + WS_MISCRAW) + (size_t)(row0 + lane) * 64;
        const float z = mr[54 + h] + bfg[h]; float lf = fminf(z, 0.f) - __logf(1.f + __expf(-fabsf(z)));
        const float ig = mr[50 + h] + big[h];
#pragma unroll
        for (int o = 1; o < 64; o <<= 1) { const float t = bperm(lf, lane - o); if (lane >= o) lf += t; }
        const float bL = __int_as_float(__builtin_amdgcn_readlane(__float_as_int(lf), 63));
        const float a = bL - lf + ig; const float mx = wave_max2(a);
        wl[lane] = __expf(a - mx);
        if (lane == 0) { ((float*)(ws + WS_ML))[chunk] = mx; ((float*)(ws + WS_BL))[chunk] = bL; }
    }
    __syncthreads();
#pragma unroll
    for (int ch = 0; ch < 2; ++ch) { ML_PTRS(ch)
        const int lb = wave_u & 3; const bool isk = wave_u >= 4;
        const LAS bf16* Wt = isk ? WK : WQ;
        bf16* og = (bf16*)(ws + (isk ? WS_MK : WS_MQ)) + (size_t)(row0 + 16 * lb + 4 * (lane >> 4)) * 256 + h * 64 + (lane & 15);
        float w4[4];
#pragma unroll
        for (int r = 0; r < 4; ++r) w4[r] = wl[16 * lb + 4 * (lane >> 4) + r];
#pragma unroll
        for (int eb = 0; eb < 4; ++eb) {
            f32x4v acc = mm16(XS, ML_LD, 16 * lb, Wt, ML_LD, 16 * eb, 64, lane, f32x4v{});
            if (!isk) {
#pragma unroll
                for (int r = 0; r < 4; ++r) og[(size_t)r * 256 + 16 * eb] = f2bf(acc[r] * 0.125f);
            } else {
                bf16 kb[4];
#pragma unroll
                for (int r = 0; r < 4; ++r) { kb[r] = f2bf(acc[r]); og[(size_t)r * 256 + 16 * eb] = kb[r]; }
                u32x2v w2; w2.x = cvtpk(bf2f(kb[0]) * w4[0], bf2f(kb[1]) * w4[1]); w2.y = cvtpk(bf2f(kb[2]) * w4[2], bf2f(kb[3]) * w4[3]);
                *(LAS u32x2v*)(WKT + (16 * eb + (lane & 15)) * ML_LD + 16 * lb + 4 * (lane >> 4)) = w2;
            }
        }
    }
    __syncthreads();
#pragma unroll
    for (int ch = 0; ch < 2; ++ch) { ML_PTRS(ch)
        float* ct = (float*)(ws + WS_CT) + (size_t)chunk * 4096;
#pragma unroll
        for (int i = 0; i < 2; ++i) { const int blk = wave_u * 2 + i, eb = blk >> 2, db = blk & 3;
            const f32x4v acc = mm16(VT, ML_LD, 16 * eb, WKT, ML_LD, 16 * db, 64, lane, f32x4v{});
#pragma unroll
            for (int r = 0; r < 4; ++r) ct[(16 * eb + 4 * (lane >> 4) + r) * 64 + 16 * db + (lane & 15)] = acc[r]; }
    }
    if (tid < 128) { ML_PTRS(tid >> 6)
        const int d = tid & 63; float n = 0.f; const LAS bf16* wr_ = WKT + d * ML_LD;
        for (int l = 0; l < 64; ++l) n += bf2f(wr_[l]);
        ((float*)(ws + WS_NL))[chunk * 64 + d] = n; }
#undef ML_PTRS
    __syncthreads();
}
__device__ __forceinline__ void mscan_item(unsigned char* ws, int item, int wave_u) {
    const int tid = wave_u * 64 + fresh_lane();
    const int bh = item / 9, part = item % 9;
    if (part == 8 && tid >= 64) return;
    float* base; size_t stride;
    if (part < 8) { base = (float*)(ws + WS_CT) + (size_t)bh * 32 * 4096 + part * 512 + tid; stride = 4096; } else { base = (float*)(ws + WS_NL) + (size_t)bh * 32 * 64 + tid; stride = 64; }
    const float* ML = (const float*)(ws + WS_ML); const float* BL = (const float*)(ws + WS_BL); float* MPv = (float*)(ws + WS_MP);
    float cl[32];
#pragma unroll
    for (int c = 0; c < 32; ++c) cl[c] = base[(size_t)c * stride];
    float Cv = 0.f, m = 0.f;
#pragma unroll
    for (int c = 0; c < 32; ++c) {
        const float ml = ML[bh * 32 + c], bl = BL[bh * 32 + c];
        base[(size_t)c * stride] = Cv;
        if (part == 8 && tid == 0) MPv[bh * 32 + c] = m;
        const float mn = fmaxf(bl + m, ml);
        Cv = __expf(bl + m - mn) * Cv + __expf(ml - mn) * cl[c]; m = mn;
    }
}
constexpr int MO_STRIDE = 5 * 64 * ML_LD * 2 + 64 * 65 * 4 + 6 * 64 * 4;
__device__ __forceinline__ void mout_item(unsigned char* ws, LAS unsigned char* lds, const float* gmh, const float* skip, int chunk0, int wave_u) {
    const int lane = fresh_lane(), tid = wave_u * 64 + lane;
    const int h = (chunk0 >> 5) & 3, b = chunk0 >> 7;
    const float* gm = (const float*)(ws + WS_GM);
#define MO_PTRS(ch) const int chunk = chunk0 + (ch); const int row0 = b * S_ + (chunk & 31) * 64; LAS unsigned char* cb_ = lds + (ch) * MO_STRIDE; \
    LAS bf16* QS = (LAS bf16*)cb_; LAS bf16* KS = QS + 64 * ML_LD; LAS bf16* VT = KS + 64 * ML_LD; LAS bf16* CP = VT + 64 * ML_LD; LAS bf16* SW = CP + 64 * ML_LD; \
    LAS float* HS = (LAS float*)(SW + 64 * ML_LD); LAS float* bs = HS + 64 * 65; LAS float* us = bs + 64; LAS float* ns = us + 64; LAS float* mts = ns + 64; LAS float* ints = mts + 64; LAS float* dinv = ints + 64; \
    (void)row0; (void)QS; (void)KS; (void)VT; (void)CP; (void)SW; (void)HS; (void)bs; (void)us; (void)ns; (void)mts; (void)ints; (void)dinv; (void)chunk;
    {
        v4u gq[2], gk[2], gv[2]; f32x4v gc0[2], gc1[2];
        const int l = tid >> 3, c0 = (tid & 7) * 8;
#pragma unroll
        for (int ch = 0; ch < 2; ++ch) { MO_PTRS(ch) const int row = row0 + l;
            gq[ch] = *(const v4u*)((const bf16*)(ws + WS_MQ) + (size_t)row * 256 + h * 64 + c0); gk[ch] = *(const v4u*)((const bf16*)(ws + WS_MK) + (size_t)row * 256 + h * 64 + c0);
            gv[ch] = *(const v4u*)((const bf16*)(ws + WS_CM) + (size_t)row * 768 + 256 + h * 64 + c0);
            const float* ct = (const float*)(ws + WS_CT) + (size_t)chunk * 4096 + l * 64 + c0;
            gc0[ch] = *(const f32x4v*)ct; gc1[ch] = *(const f32x4v*)(ct + 4); }
        asm volatile("" : "+v"(gq[0]), "+v"(gq[1]), "+v"(gk[0]), "+v"(gk[1]), "+v"(gv[0]), "+v"(gv[1]), "+v"(gc0[0]), "+v"(gc0[1]), "+v"(gc1[0]), "+v"(gc1[1]));
#pragma unroll
        for (int ch = 0; ch < 2; ++ch) { MO_PTRS(ch)
            *(LAS v4u*)(QS + l * ML_LD + c0) = gq[ch]; *(LAS v4u*)(KS + l * ML_LD + c0) = gk[ch];
            const v4u v4 = gv[ch];
            VT[(c0 + 0) * ML_LD + l] = (bf16)(v4.x & 0xffffu); VT[(c0 + 1) * ML_LD + l] = (bf16)(v4.x >> 16); VT[(c0 + 2) * ML_LD + l] = (bf16)(v4.y & 0xffffu); VT[(c0 + 3) * ML_LD + l] = (bf16)(v4.y >> 16);
            VT[(c0 + 4) * ML_LD + l] = (bf16)(v4.z & 0xffffu); VT[(c0 + 5) * ML_LD + l] = (bf16)(v4.z >> 16); VT[(c0 + 6) * ML_LD + l] = (bf16)(v4.w & 0xffffu); VT[(c0 + 7) * ML_LD + l] = (bf16)(v4.w >> 16);
            const f32x4v c0v = gc0[ch], c1v = gc1[ch];
            v4u cw; cw.x = cvtpk(c0v[0], c0v[1]); cw.y = cvtpk(c0v[2], c0v[3]); cw.z = cvtpk(c1v[0], c1v[1]); cw.w = cvtpk(c1v[2], c1v[3]);
            *(LAS v4u*)(CP + l * ML_LD + c0) = cw; }
    }
    if (wave_u < 2) { MO_PTRS(wave_u)
        const float ig = gm[(size_t)(row0 + lane) * 32 + 18 + h]; float lf = gm[(size_t)(row0 + lane) * 32 + 22 + h];
#pragma unroll
        for (int o = 1; o < 64; o <<= 1) { const float t = bperm(lf, lane - o); if (lane >= o) lf += t; }
        const float u = ig - lf; float cu = u;
#pragma unroll
        for (int o = 1; o < 64; o <<= 1) { const float t = bperm(cu, lane - o); if (lane >= o) cu = fmaxf(cu, t); }
        const float mprev = ((const float*)(ws + WS_MP))[chunk];
        const float mt = lf + fmaxf(mprev, cu);
        bs[lane] = lf; us[lane] = u; mts[lane] = mt; ints[lane] = __expf(lf + mprev - mt); ns[lane] = ((const float*)(ws + WS_NL))[chunk * 64 + lane];
    }
    __syncthreads();
#pragma unroll
    for (int ch = 0; ch < 2; ++ch) { MO_PTRS(ch)
#pragma unroll
        for (int i = 0; i < 2; ++i) { const int blk = wave_u * 2 + i, lb = blk >> 2, sb = blk & 3;
            f32x4v acc = f32x4v{};
            if (sb <= lb) acc = mm16(QS, ML_LD, 16 * lb, KS, ML_LD, 16 * sb, 64, lane, acc);
            const int sidx = 16 * sb + (lane & 15); const float usv = us[sidx];
#pragma unroll
            for (int r = 0; r < 4; ++r) { const int l = 16 * lb + 4 * (lane >> 4) + r;
                const float v = (sidx <= l) ? acc[r] * __expf(bs[l] + usv - mts[l]) : 0.f;
                SW[l * ML_LD + sidx] = f2bf(v); } }
    }
    __syncthreads();
    if (tid < 128) { MO_PTRS(tid >> 6)
        const int l = tid & 63; float qn = 0.f, ssum = 0.f;
        for (int d = 0; d < 64; ++d) { qn += bf2f(QS[l * ML_LD + d]) * ns[d]; ssum += bf2f(SW[l * ML_LD + d]); }
        const float den = ints[l] * qn + ssum;
        dinv[l] = __builtin_amdgcn_rcpf(fmaxf(fabsf(den), __expf(-mts[l])));
    }
    f32x4v hq[2][2], hs2[2][2];
#pragma unroll
    for (int ch = 0; ch < 2; ++ch) { MO_PTRS(ch)
#pragma unroll
        for (int i = 0; i < 2; ++i) { const int blk = wave_u * 2 + i, lb = blk >> 2, eb = blk & 3;
            hq[ch][i] = mm16(QS, ML_LD, 16 * lb, CP, ML_LD, 16 * eb, 64, lane, f32x4v{});
            hs2[ch][i] = mm16(SW, ML_LD, 16 * lb, VT, ML_LD, 16 * eb, 16 * lb + 16 <= 32 ? 32 : 64, lane, f32x4v{}); }
    }
    __syncthreads();
#pragma unroll
    for (int ch = 0; ch < 2; ++ch) { MO_PTRS(ch)
#pragma unroll
        for (int i = 0; i < 2; ++i) { const int blk = wave_u * 2 + i, lb = blk >> 2, eb = blk & 3; const int e = 16 * eb + (lane & 15);
#pragma unroll
            for (int r = 0; r < 4; ++r) { const int l = 16 * lb + 4 * (lane >> 4) + r;
                const float og = bf2f(((const bf16*)(ws + WS_CM))[(size_t)(row0 + l) * 768 + 512 + h * 64 + e]);
                HS[l * 65 + e] = (ints[l] * hq[ch][i][r] + hs2[ch][i][r]) * dinv[l] * __builtin_amdgcn_rcpf(1.f + __expf(-og)); } }
    }
    __syncthreads();
#pragma unroll
    for (int ch = 0; ch < 2; ++ch) { MO_PTRS(ch)
        const int l = tid >> 3, e0 = (tid & 7) * 8, row = row0 + l;
        float v[8]; float mu = 0.f;
#pragma unroll
        for (int i = 0; i < 8; ++i) { v[i] = HS[l * 65 + e0 + i]; mu += v[i]; }
        mu += sxf<1>(mu); mu += sxf<2>(mu); mu += sxf<4>(mu); mu *= (1.f / 64.f);
        float var = 0.f;
#pragma unroll
        for (int i = 0; i < 8; ++i) { const float dl = v[i] - mu; var += dl * dl; }
        var += sxf<1>(var); var += sxf<2>(var); var += sxf<4>(var);
        const float rs = rsqrtf(var * (1.f / 64.f) + EPS);
        const v4u x4 = *(const v4u*)((const bf16*)(ws + WS_XC) + (size_t)row * 256 + h * 64 + e0);
        float xv[8]; xv[0] = __uint_as_float(x4.x << 16); xv[1] = __uint_as_float(x4.x & 0xffff0000u); xv[2] = __uint_as_float(x4.y << 16); xv[3] = __uint_as_float(x4.y & 0xffff0000u);
        xv[4] = __uint_as_float(x4.z << 16); xv[5] = __uint_as_float(x4.z & 0xffff0000u); xv[6] = __uint_as_float(x4.w << 16); xv[7] = __uint_as_float(x4.w & 0xffff0000u);
        float r[8];
#pragma unroll
        for (int i = 0; i < 8; ++i) r[i] = (v[i] - mu) * rs * gmh[h * 64 + e0 + i] + skip[h * 64 + e0 + i] * xv[i];
        v4u w4; w4.x = cvtpk(r[0], r[1]); w4.y = cvtpk(r[2], r[3]); w4.z = cvtpk(r[4], r[5]); w4.w = cvtpk(r[6], r[7]);
        *(v4u*)((bf16*)(ws + WS_HB) + (size_t)row * D_ + 768 + h * 64 + e0) = w4;
    }
#undef MO_PTRS
    __syncthreads();
}

__global__ void __launch_bounds__(NTHR, 2) mega(MP p_unused) {
    extern __shared__ __attribute__((aligned(16))) unsigned char lds_raw[];
    LAS unsigned char* lds = (LAS unsigned char*)lds_raw;
    const int wave0 = __builtin_amdgcn_readfirstlane((int)threadIdx.x >> 6);
    const int tid0 = wave0 * 64 + fresh_lane();
    const int xcc = (int)(__builtin_amdgcn_s_getreg((3 << 11) | 20) & 7u);
    volatile LAS unsigned* MISC = (volatile LAS unsigned*)(lds + MISC_OFF);
    for (int u = tid0; u < (LDS_BYTES - RING_BYTES) / 4; u += NTHR) ((LAS unsigned*)(lds + RING_BYTES))[u] = 0u;
    __syncthreads();
    typedef const __attribute__((address_space(4))) MP* kmp_t;
    kmp_t kp0 = (kmp_t)__builtin_amdgcn_kernarg_segment_ptr();
    unsigned char* ws0 = kp0->ws; const int coop = kp0->coop, ph_lo = kp0->ph_lo, ph_hi = kp0->ph_hi;
    XcdBarrier bar; bar.bar = (unsigned*)(ws0 + WS_CTL) + CW_BAR; bar.x = 0; bar.st = nullptr;
    if (coop) bar = xcd_barrier_post((unsigned*)(ws0 + WS_CTL) + CW_BAR, MISC + 8, tid0);
    if (coop == 2) cooperative_groups::this_grid().sync();
    int ph = ph_lo;
    if (ph == 0) {
        const MPK p{kp0}; ph_p0(p, lds, wave0 * 64 + fresh_lane()); ph = 1;
        if (ph < ph_hi) xcd_barrier(bar, wave0 * 64 + fresh_lane());
    }
    bool second = false;
    for (; ph < ph_hi; ++ph) {
        kmp_t kp = kp0; asm volatile("" : "+s"(kp));
        const MPK p{kp}; unsigned char* ws = kp->ws;
#define TID_ (wave0 * 64 + fresh_lane())
#define GW_ (blockIdx.x * NWAVES + wave0)
#define NGW_ (gridDim.x * NWAVES)
        const int l = (ph - 1) / PPL, ty = (ph == 0) ? -1 : (ph == NPH - 1) ? -2 : (ph - 1) % PPL;
        const float* modl = (const float*)(ws + WS_MOD) + (size_t)l * 8 * 6144;
        if (ty == -2) { norm_rows<true, true>(ws + WS_HB, PIN(I_GFIN), nullptr, nullptr, nullptr, p.k->out, GW_, NGW_, fresh_lane());
            if (PROBE_SEL != 0 && blockIdx.x == 0 && TID_ == 0) { asm volatile("s_waitcnt vmcnt(0)" ::: "memory"); p.k->out[0] = ((const float*)(ws + WS_CTL))[100] * 0.001f; } }
        else if (ty == 0 && (PHM & 2)) ph_prep(p, l, lds, TID_);
        else if (ty == 1 && (PHM & 4)) {
            pg8::Gemm g{(const bf16*)(ws + WS_HB), (const bf16*)(ws + WT_IN), T_, 2560, D_}; pg8::StaticOrder S; S.init(T_, 2560, gridDim.x, blockIdx.x);
            pg8::EpiIn E{ws, PIN(I_BIG) + l * 4, PIN(I_BFG) + l * 4};
            pg8::gemm_phase<pg8::EpiIn, pg8::StaticOrder, true, true>(lds, g, S, E, wave0);
            late_transposes(p, l, lds, TID_, 640 % (int)gridDim.x);
        }
        else if (ty == 2 && (PHM & 64)) {
            { pg8::Gemm g{(const bf16*)(ws + WS_KVL), (const bf16*)(ws + WT_UKV), T_, 768, 128}; pg8::StaticOrder S; S.init(T_, 768, gridDim.x, blockIdx.x);
              pg8::EpiUKV E{(bf16*)(ws + WS_KVM), (const float*)(ws + WS_SSKV)}; pg8::gemm_phase<pg8::EpiUKV, pg8::StaticOrder, true, true>(lds, g, S, E, wave0); }
            { pg8::Gemm g{(const bf16*)(ws + WS_QL), (const bf16*)(ws + WT_UQ), T_, 768, 256}; pg8::StaticOrder S; S.init(T_, 768, gridDim.x, blockIdx.x);
              pg8::EpiPlain E{(bf16*)(ws + WS_OSLC), 768}; pg8::gemm_phase<pg8::EpiPlain, pg8::StaticOrder, true, true>(lds, g, S, E, wave0); }
            post_misc(ws, PIN(I_BIG) + l * 4, PIN(I_BFG) + l * 4, TID_);
            unsigned* ctrs = (unsigned*)(ws + WS_CTL) + 8192 + ph * 256 + (second ? 128 : 0); int ks = 0;
            for (;;) { const int it = next_item_q(ctrs, lds, wave0, 96, xcc, ks); if (it < 0) break; const int b = it >> 16, j = it & 0xffff;
                if (j < 64) mlocal_item(ws, lds, PIN(I_CONVW) + l * 1024, PIN(I_CONVB) + l * 256, PIN(I_BIG) + l * 4, PIN(I_BFG) + l * 4, b * 128 + 2 * j, wave0);
                else { const int k = j - 64; compress_item(ws, lds, PIN(I_CMPPOS) + l * 2048, ((k >> 4) << 7) | (b << 4) | (k & 15), wave0); } }
        }
        else if (ty == 3 && (PHM & 128)) {
            unsigned* ctrs = (unsigned*)(ws + WS_CTL) + 8192 + ph * 256 + (second ? 128 : 0); int ks = 0;
            for (;;) { const int it = next_item_q(ctrs, lds, wave0, second ? 64 : 100, xcc, ks); if (it < 0) break; const int b = it >> 16, j = it & 0xffff;
                if (second && (REP_MASK & (1 << 20)) && j >= 48) continue; if (second && (REP_MASK & (1 << 21)) && j < 48) continue;
                if (j < 18) mla_unit(ws, lds, b, j % 6, 7 - j / 6, wave0);
                else if (j < 34) cmp_unit(ws, lds, b, (j - 18) >> 3, 7 - ((j - 18) & 7), wave0);
                else if (j < 64) { const int u = j - 16; mla_unit(ws, lds, b, u % 6, 7 - u / 6, wave0); }
                else mscan_item(ws, b * 36 + (j - 64), wave0); }
        }
        else if (ty == 4 && (PHM & 256)) {
            unsigned* ctrs = (unsigned*)(ws + WS_CTL) + 8192 + ph * 256 + (second ? 128 : 0); int ks = 0;
            for (;;) { const int it = next_item_q(ctrs, lds, wave0, 160, xcc, ks); if (it < 0) break; const int b = it >> 16, j = it & 0xffff;
                if (second && (REP_MASK & (1 << 16)) && j >= 96) continue; if (second && (REP_MASK & (1 << 17)) && j < 96) continue;
                if (j < 36) nsa_branch_unit<AM_SLC>(ws, lds, b, j % 6, 7 - j / 6, wave0);
                else if (j < 84) nsa_branch_unit<AM_WINDOW>(ws, lds, b, (j - 36) % 6, 7 - (j - 36) / 6, wave0);
                else if (j < 96) { const int u = j - 48; nsa_branch_unit<AM_SLC>(ws, lds, b, u % 6, 7 - u / 6, wave0); }
                else mout_item(ws, lds, PIN(I_GMH) + l * 256, PIN(I_SKIP) + l * 256, b * 128 + 2 * (j - 96), wave0); }
        }
        else if (ty == 5) ph_mixnorm(p, l, TID_);
        else if (ty == 6 && (PHM & 8)) {
            pg8::Gemm g{(const bf16*)(ws + WS_HB), (const bf16*)(ws + WT_OUT), T_, D_, D_}; pg8::StaticOrder S; S.init(T_, D_, gridDim.x, blockIdx.x);
            pg8::EpiRes E{(l == 0) ? PIN(I_X) : nullptr, (const bf16*)p.k->out, (bf16*)p.k->out, modl + 2048};
            pg8::gemm_phase<pg8::EpiRes, pg8::StaticOrder, true, true>(lds, g, S, E, wave0);
        }
        else if (ty == 7) norm_rows<true>(p.k->out, PIN(I_GN2) + l * D_, modl + 3072, modl + 4096, (bf16*)(ws + WS_HB), nullptr, GW_, NGW_, fresh_lane());
        else if (ty == 8 && (PHM & 16)) {
            pg8::Gemm g{(const bf16*)(ws + WS_HB), (const bf16*)(ws + WT_GU), T_, 2 * FF, D_}; pg8::StaticOrder S; S.init(T_, 2 * FF, gridDim.x, blockIdx.x);
            pg8::EpiGU E{(bf16*)(ws + WS_ACT)};
            pg8::gemm_phase<pg8::EpiGU, pg8::StaticOrder, true, true>(lds, g, S, E, wave0);
            if (l + 1 < DEPTH) early_transposes(p, l + 1, lds, TID_, 1408 % (int)gridDim.x);
        }
        else if (ty == 9 && (PHM & 32)) {
            pg8::Gemm g{(const bf16*)(ws + WS_ACT), (const bf16*)(ws + WT_DOWN), T_, D_, FF}; pg8::StaticOrder S; S.init(T_, D_, gridDim.x, blockIdx.x);
            pg8::EpiRes E{nullptr, (const bf16*)p.k->out, (l == DEPTH - 1) ? (bf16*)(ws + WS_HB) : (bf16*)p.k->out, modl + 5120};
            pg8::gemm_phase<pg8::EpiRes, pg8::StaticOrder, true, true>(lds, g, S, E, wave0);
        }
        if (REP_MASK != 0 && ty >= 0 && ((REP_MASK >> ty) & 1) && !second) { second = true; --ph; } else second = false;
        if (ph + 1 < ph_hi) xcd_barrier(bar, wave0 * 64 + fresh_lane());
    }
}

extern "C" void kernel_launch(void* const* d_in, const int* in_sizes, int n_in, void* d_out, int out_size, void* d_ws, size_t ws_size, hipStream_t stream) {
    if (n_in != N_IN || ws_size < WS_END) { fprintf(stderr, "kernel_launch: unexpected n_in %d / ws %zu\n", n_in, ws_size); return; }
    static int inited = 0;
    if (!inited) { if (hipFuncSetAttribute((const void*)mega, hipFuncAttributeMaxDynamicSharedMemorySize, LDS_BYTES) != hipSuccess) fprintf(stderr, "hipFuncSetAttribute failed\n"); inited = 1; }
    unsigned char* ws = (unsigned char*)d_ws;
    MP base{}; for (int i = 0; i < N_IN; ++i) base.in[i] = (const float*)d_in[i]; base.out = (float*)d_out; base.ws = ws;
    (void)hipMemsetAsync(ws + WS_CTL, 0, CTL_ZERO_BYTES, stream);
    static int grid = 0;
    if (!grid) {
        int dev = 0, cus = 0, per_cu = 0;
        (void)hipGetDevice(&dev); (void)hipDeviceGetAttribute(&cus, hipDeviceAttributeMultiprocessorCount, dev);
        if (hipOccupancyMaxActiveBlocksPerMultiprocessor(&per_cu, (const void*)mega, NTHR, LDS_BYTES) != hipSuccess || per_cu < 1) { fprintf(stderr, "kernel_launch: occupancy query says %d blocks per CU\n", per_cu); per_cu = 1; }
        (void)hipGetLastError();
        grid = cus;
    }
    MP a = base; a.ph_lo = 0; a.ph_hi = NPH; a.coop = 1;
    void* args[] = {&a};
    const hipError_t e = hipLaunchCooperativeKernel((const void*)mega, dim3(grid), dim3(NTHR), args, LDS_BYTES, stream);
    if (e != hipSuccess) fprintf(stderr, "kernel_launch: cooperative launch failed: %s (grid %d)\n", hipGetErrorString(e), grid);
}
```
